# Optimizing an MI355X kernel written in HIP

```python
import math
import jax, jax.numpy as jnp
from jax import lax
import numpy as np

D_MODEL = 1024
BATCH = 2
SEQ = 8192
DEPTH = 1

N_MOD = 6
NSA_HEADS = 8
NSA_KV_GROUPS = 2
NSA_HPG = NSA_HEADS // NSA_KV_GROUPS
NSA_HEAD_DIM = 64
CMP_BLOCK = 32
CMP_STRIDE = 16
CMP_HIDDEN = 128
SLC_BLOCK = 64
SLC_TOPN = 16
WINDOW = 512
FORCE_BONUS = 1e4
DSA_HEADS = 8
DSA_HEAD_DIM = 64
DSA_KV_LATENT = 128
IDX_HEADS = 8
IDX_DIM = 64
IDX_TOPK_MAX = 256
N_HEADS_TOTAL = NSA_HEADS + DSA_HEADS
REL_BUCKETS = 32
REL_MAX_DISTANCE = 128
N_EXPERTS = 256
N_EXPERT_GROUPS = 8
TOPK_GROUPS = 4
TOP_K = 8
D_EXPERT = 256
ROUTED_SCALE = 2.5
MOE_BLOCK = 128
Q_BLOCK = 128
RMS_EPS = 1e-6
NEG_INF = -1e30

PROJ_WIDTHS = (
    NSA_HEADS * NSA_HEAD_DIM,
    6 * NSA_KV_GROUPS * NSA_HEAD_DIM,
    3 * NSA_HEADS,
    DSA_HEADS * DSA_HEAD_DIM,
    DSA_KV_LATENT,
    IDX_HEADS * IDX_DIM,
    IDX_DIM,
    IDX_HEADS,
    2 * D_MODEL,
)
D_IN = sum(PROJ_WIDTHS)

kernel_name = 'hybrid_nsa_dsa_moe_block'


def rms_norm(x, g):
    xf = x.astype(jnp.float32)
    y = xf * lax.rsqrt(jnp.mean(xf * xf, axis=-1, keepdims=True) + RMS_EPS)
    return (y * g.astype(jnp.float32)).astype(x.dtype)


def masked_softmax(logits, mask, axes):
    l = jnp.where(mask, logits.astype(jnp.float32), NEG_INF)
    m = jnp.max(l, axis=axes, keepdims=True)
    p = jnp.where(mask, jnp.exp(l - m), 0.0)
    return p / jnp.maximum(jnp.sum(p, axis=axes, keepdims=True), 1e-30)


def t5_bucket(dist):
    n = jnp.maximum(dist, 0)
    exact = REL_BUCKETS // 2
    nf = jnp.maximum(n, 1).astype(jnp.float32)
    large = exact + (jnp.log(nf / exact) / math.log(REL_MAX_DISTANCE / exact)
                     * (REL_BUCKETS - exact)).astype(jnp.int32)
    return jnp.where(n < exact, n, jnp.minimum(large, REL_BUCKETS - 1))


def swiglu(x, wg, wu, wd):
    return (jax.nn.silu(x @ wg) * (x @ wu)) @ wd


def compress_kv(kv, pe, w1, b1, w2):
    T = kv.shape[1]
    n_cmp = (T - CMP_BLOCK) // CMP_STRIDE + 1
    idx = jnp.arange(n_cmp)[:, None] * CMP_STRIDE + jnp.arange(CMP_BLOCK)[None, :]
    blk = kv[:, idx] + pe[None, None, :, None, :]
    z = jax.nn.gelu(jnp.einsum('bnlgd,ldk->bngk', blk, w1) + b1)
    return jnp.einsum('bngk,kd->bngd', z, w2)


def token_mixers(h, w_in, rel_bias, cmp_pe, cmp_w1, cmp_b1, cmp_w2, dsa_kv_norm,
                 dsa_w_uk, dsa_w_uv, w_branch_nsa, w_branch_dsa, w_out):
    B, T, _ = h.shape
    G, HPG, DH = NSA_KV_GROUPS, NSA_HPG, NSA_HEAD_DIM
    n_cmp = (T - CMP_BLOCK) // CMP_STRIDE + 1
    n_slc = T // SLC_BLOCK
    topn = min(SLC_TOPN, n_slc)
    k_dsa = min(IDX_TOPK_MAX, T // 4)
    n_qblk = T // Q_BLOCK
    scale = DH ** -0.5

    proj = jnp.einsum('btd,de->bte', h, w_in)
    splits = [int(s) for s in np.cumsum(PROJ_WIDTHS)[:-1]]
    q_nsa, kv_nsa, g_nsa, q_dsa, ckv, q_idx, k_idx, w_idx, g_merge = jnp.split(proj, splits, axis=-1)

    q_nsa = q_nsa.reshape(B, T, G, HPG, DH)
    kv_nsa = kv_nsa.reshape(B, T, 6, G, DH)
    g_nsa = jax.nn.sigmoid(g_nsa.reshape(B, T, G, HPG, 3))
    k_c = compress_kv(kv_nsa[:, :, 0], cmp_pe[0], cmp_w1[0], cmp_b1[0], cmp_w2[0])
    v_c = compress_kv(kv_nsa[:, :, 1], cmp_pe[1], cmp_w1[1], cmp_b1[1], cmp_w2[1])
    k_sb = kv_nsa[:, :, 2].reshape(B, n_slc, SLC_BLOCK, G, DH).transpose(0, 3, 1, 2, 4)
    v_sb = kv_nsa[:, :, 3].reshape(B, n_slc, SLC_BLOCK, G, DH).transpose(0, 3, 1, 2, 4)
    pad = ((0, 0), (WINDOW, 0), (0, 0), (0, 0))
    k_wp = jnp.pad(kv_nsa[:, :, 4], pad)
    v_wp = jnp.pad(kv_nsa[:, :, 5], pad)
    cmp_start = jnp.arange(n_cmp) * CMP_STRIDE
    cmp_end = cmp_start + (CMP_BLOCK - 1)
    slc_ids = jnp.arange(n_slc)
    slc_start = slc_ids * SLC_BLOCK
    overlap = (jnp.clip(jnp.minimum(cmp_start[:, None] + CMP_BLOCK, slc_start[None, :] + SLC_BLOCK)
                        - jnp.maximum(cmp_start[:, None], slc_start[None, :]), 0, None)
               .astype(jnp.float32) / CMP_BLOCK)
    tab_nsa = rel_bias[:, :NSA_HEADS].reshape(REL_BUCKETS, G, HPG)
    tab_dsa = rel_bias[:, NSA_HEADS:]
    gidx = jnp.arange(G)[None, :, None, None, None]
    gather_bg = jax.vmap(jax.vmap(lambda a, i: a[i]))
    gather_b = jax.vmap(lambda a, i: a[i])

    q_lat = jnp.einsum('bthd,chd->bthc', q_dsa.reshape(B, T, DSA_HEADS, DSA_HEAD_DIM), dsa_w_uk)
    c_kv = rms_norm(ckv, dsa_kv_norm)
    q_idx = q_idx.reshape(B, T, IDX_HEADS, IDX_DIM) * IDX_DIM ** -0.5
    w_idx = w_idx * IDX_HEADS ** -0.5
    key_pos = jnp.arange(T)

    def block(qb):
        qs = qb * Q_BLOCK
        t = qs + jnp.arange(Q_BLOCK)
        sl = lambda a: lax.dynamic_slice_in_dim(a, qs, Q_BLOCK, axis=1)
        q = sl(q_nsa)
        gt = jnp.moveaxis(sl(g_nsa), 1, 3)

        dist_c = t[:, None] - cmp_end[None, :]
        bias_c = jnp.transpose(tab_nsa[t5_bucket(dist_c)], (2, 3, 0, 1))
        s_c = jnp.einsum('bqghd,bngd->bghqn', q, k_c) * scale + bias_c
        p_c = masked_softmax(s_c, dist_c >= 0, -1)
        o_c = jnp.einsum('bghqn,bngd->bghqd', p_c.astype(v_c.dtype), v_c)

        imp = jnp.einsum('bghqn,nj->bgqj', p_c, overlap)
        cur = t // SLC_BLOCK
        admiss = slc_ids[None, :] <= cur[:, None]
        forced = ((slc_ids[None, :] == 0) | (slc_ids[None, :] == cur[:, None])
                  | (slc_ids[None, :] == cur[:, None] - 1))
        score = jnp.where(admiss, imp + jnp.where(forced, FORCE_BONUS, 0.0), NEG_INF)
        _, sel = lax.top_k(score, topn)
        k_sel = gather_bg(k_sb, sel)
        v_sel = gather_bg(v_sb, sel)
        pos = sel[..., None] * SLC_BLOCK + jnp.arange(SLC_BLOCK)
        dist_s = t[None, None, :, None, None] - pos
        bias_s = jnp.moveaxis(tab_nsa[t5_bucket(dist_s), gidx], -1, 2)
        s_s = jnp.einsum('bqghd,bgqnkd->bghqnk', q, k_sel) * scale + bias_s
        p_s = masked_softmax(s_s, (dist_s >= 0)[:, :, None], (-2, -1))
        o_s = jnp.einsum('bghqnk,bgqnkd->bghqd', p_s.astype(v_sel.dtype), v_sel)

        kw = lax.dynamic_slice_in_dim(k_wp, qs, Q_BLOCK + WINDOW, axis=1)
        vw = lax.dynamic_slice_in_dim(v_wp, qs, Q_BLOCK + WINDOW, axis=1)
        s_pos = qs - WINDOW + jnp.arange(Q_BLOCK + WINDOW)
        dist_w = t[:, None] - s_pos[None, :]
        mask_w = (dist_w >= 0) & (dist_w < WINDOW) & (s_pos[None, :] >= 0)
        bias_w = jnp.transpose(tab_nsa[t5_bucket(dist_w)], (2, 3, 0, 1))
        s_w = jnp.einsum('bqghd,bsgd->bghqs', q, kw) * scale + bias_w
        p_w = masked_softmax(s_w, mask_w, -1)
        o_w = jnp.einsum('bghqs,bsgd->bghqd', p_w.astype(vw.dtype), vw)

        o_nsa = gt[..., 0:1] * o_c + gt[..., 1:2] * o_s + gt[..., 2:3] * o_w
        o_nsa = jnp.transpose(o_nsa, (0, 3, 1, 2, 4)).reshape(B, Q_BLOCK, NSA_HEADS, DH)

        rel = jax.nn.relu(jnp.einsum('bqhd,bsd->bqhs', sl(q_idx), k_idx))
        idx_score = jnp.einsum('bqhs,bqh->bqs', rel, sl(w_idx)).astype(jnp.float32)
        idx_score = jnp.where(key_pos[None, None, :] <= t[None, :, None], idx_score, NEG_INF)
        _, sel_k = lax.top_k(idx_score, k_dsa)
        c_sel = gather_b(c_kv, sel_k)
        dist_d = t[None, :, None] - sel_k
        bias_d = jnp.moveaxis(tab_dsa[t5_bucket(dist_d)], -1, 1)
        s_d = jnp.einsum('bqhc,bqkc->bhqk', sl(q_lat), c_sel) * DSA_HEAD_DIM ** -0.5 + bias_d
        p_d = masked_softmax(s_d, (dist_d >= 0)[:, None], -1)
        o_lat = jnp.einsum('bhqk,bqkc->bqhc', p_d.astype(c_sel.dtype), c_sel)
        o_dsa = jnp.einsum('bqhc,chd->bqhd', o_lat, dsa_w_uv)
        return o_nsa, o_dsa

    o_nsa, o_dsa = lax.map(block, jnp.arange(n_qblk))
    o_nsa = jnp.moveaxis(o_nsa, 0, 1).reshape(B, T, NSA_HEADS * DH)
    o_dsa = jnp.moveaxis(o_dsa, 0, 1).reshape(B, T, DSA_HEADS * DSA_HEAD_DIM)
    g_a, g_b = jnp.split(jax.nn.sigmoid(g_merge), 2, axis=-1)
    y = g_a * (o_nsa @ w_branch_nsa) + g_b * (o_dsa @ w_branch_dsa)
    return y @ w_out


def moe_ffn(h, router_w, router_bias, w_g, w_u, w_d, ws_g, ws_u, ws_d):
    B, T, D = h.shape
    N = B * T
    hf = h.reshape(N, D)
    s = jax.nn.sigmoid(jnp.einsum('nd,de->ne', hf, router_w).astype(jnp.float32))
    sel = s + router_bias.astype(jnp.float32)
    grp_score = lax.top_k(sel.reshape(N, N_EXPERT_GROUPS, -1), 2)[0].sum(-1)
    _, gsel = lax.top_k(grp_score, TOPK_GROUPS)
    gmask = jnp.sum(jax.nn.one_hot(gsel, N_EXPERT_GROUPS, dtype=jnp.float32), axis=1) > 0
    emask = jnp.repeat(gmask, N_EXPERTS // N_EXPERT_GROUPS, axis=1)
    _, eidx = lax.top_k(jnp.where(emask, sel, NEG_INF), TOP_K)
    wts = jnp.take_along_axis(s, eidx, axis=1)
    wts = wts / jnp.sum(wts, axis=-1, keepdims=True) * ROUTED_SCALE

    NK = N * TOP_K
    flat_e = eidx.reshape(NK)
    flat_w = wts.reshape(NK)
    flat_tok = jnp.arange(NK, dtype=jnp.int32) // TOP_K
    order = jnp.argsort(flat_e)
    e_sorted = flat_e[order]
    counts = jnp.bincount(flat_e, length=N_EXPERTS)
    padded = (counts + MOE_BLOCK - 1) // MOE_BLOCK * MOE_BLOCK
    start = jnp.cumsum(counts) - counts
    pend = jnp.cumsum(padded)
    pstart = pend - padded
    dest = pstart[e_sorted] + jnp.arange(NK, dtype=jnp.int32) - start[e_sorted]
    n_blocks = (NK + N_EXPERTS * (MOE_BLOCK - 1) + MOE_BLOCK - 1) // MOE_BLOCK
    P = n_blocks * MOE_BLOCK
    slot_tok = jnp.full((P,), N, jnp.int32).at[dest].set(flat_tok[order])
    slot_w = jnp.zeros((P,), jnp.float32).at[dest].set(flat_w[order])
    blk_e = jnp.minimum(jnp.searchsorted(pend, jnp.arange(n_blocks) * MOE_BLOCK, side='right'),
                        N_EXPERTS - 1)
    h_pad = jnp.concatenate([hf, jnp.zeros((1, D), hf.dtype)], axis=0)

    def expert_block(args):
        tok, wt, e = args
        yb = swiglu(h_pad[tok], w_g[e], w_u[e], w_d[e])
        return yb * wt[:, None].astype(yb.dtype)

    yb = lax.map(expert_block, (slot_tok.reshape(n_blocks, MOE_BLOCK),
                                slot_w.reshape(n_blocks, MOE_BLOCK), blk_e))
    routed = jnp.zeros((N + 1, D), h.dtype).at[slot_tok].add(yb.reshape(P, D).astype(h.dtype))[:N]
    shared = swiglu(hf, ws_g, ws_u, ws_d)
    return (routed + shared).reshape(B, T, D)


def setup_inputs(seed: int = 0) -> dict:
    key = jax.random.key(seed)
    ks = jax.random.split(key, 28)
    L, D = DEPTH, D_MODEL
    nrm = lambda i, shape, s: jax.random.normal(ks[i], shape, jnp.float32) * s
    return {
        'x': nrm(0, (BATCH, SEQ, D), 1.0),
        'c': nrm(1, (BATCH, D), 1.0),
        'w_ada': nrm(2, (L, D, N_MOD * D), 0.25 * D ** -0.5),
        'b_ada': nrm(3, (L, N_MOD * D), 0.02),
        'g_pre_mix': 1.0 + nrm(4, (L, D), 0.02),
        'g_post_mix': 1.0 + nrm(5, (L, D), 0.02),
        'g_pre_ffn': 1.0 + nrm(6, (L, D), 0.02),
        'g_post_ffn': 1.0 + nrm(7, (L, D), 0.02),
        'w_in': nrm(8, (L, D, D_IN), D ** -0.5),
        'rel_bias': nrm(9, (REL_BUCKETS, N_HEADS_TOTAL), 0.2),
        'cmp_pe': nrm(10, (L, 2, CMP_BLOCK, NSA_HEAD_DIM), 0.1),
        'cmp_w1': nrm(11, (L, 2, CMP_BLOCK, NSA_HEAD_DIM, CMP_HIDDEN), (CMP_BLOCK * NSA_HEAD_DIM) ** -0.5),
        'cmp_b1': nrm(12, (L, 2, CMP_HIDDEN), 0.02),
        'cmp_w2': nrm(13, (L, 2, CMP_HIDDEN, NSA_HEAD_DIM), CMP_HIDDEN ** -0.5),
        'dsa_kv_norm': 1.0 + nrm(14, (L, DSA_KV_LATENT), 0.02),
        'dsa_w_uk': nrm(15, (L, DSA_KV_LATENT, DSA_HEADS, DSA_HEAD_DIM), DSA_KV_LATENT ** -0.5),
        'dsa_w_uv': nrm(16, (L, DSA_KV_LATENT, DSA_HEADS, DSA_HEAD_DIM), DSA_KV_LATENT ** -0.5),
        'w_branch_nsa': nrm(17, (L, NSA_HEADS * NSA_HEAD_DIM, D), (NSA_HEADS * NSA_HEAD_DIM) ** -0.5),
        'w_branch_dsa': nrm(18, (L, DSA_HEADS * DSA_HEAD_DIM, D), (DSA_HEADS * DSA_HEAD_DIM) ** -0.5),
        'w_out': nrm(19, (L, D, D), D ** -0.5),
        'router_w': nrm(20, (L, D, N_EXPERTS), D ** -0.5),
        'router_bias': nrm(21, (L, N_EXPERTS), 0.01),
        'w_exp_gate': nrm(22, (L, N_EXPERTS, D, D_EXPERT), D ** -0.5),
        'w_exp_up': nrm(23, (L, N_EXPERTS, D, D_EXPERT), D ** -0.5),
        'w_exp_down': nrm(24, (L, N_EXPERTS, D_EXPERT, D), D_EXPERT ** -0.5),
        'w_sh_gate': nrm(25, (L, D, D_EXPERT), D ** -0.5),
        'w_sh_up': nrm(26, (L, D, D_EXPERT), D ** -0.5),
        'w_sh_down': nrm(27, (L, D_EXPERT, D), D_EXPERT ** -0.5),
    }


def reference(x, c, w_ada, b_ada, g_pre_mix, g_post_mix, g_pre_ffn, g_post_ffn, w_in, rel_bias,
              cmp_pe, cmp_w1, cmp_b1, cmp_w2, dsa_kv_norm, dsa_w_uk, dsa_w_uv,
              w_branch_nsa, w_branch_dsa, w_out, router_w, router_bias,
              w_exp_gate, w_exp_up, w_exp_down, w_sh_gate, w_sh_up, w_sh_down):
    for l in range(DEPTH):
        mod = jnp.einsum('bd,de->be', jax.nn.silu(c), w_ada[l]) + b_ada[l]
        sh1, sc1, gt1, sh2, sc2, gt2 = jnp.split(mod[:, None, :], N_MOD, axis=-1)
        h = rms_norm(x, g_pre_mix[l]) * (1.0 + sc1) + sh1
        y = token_mixers(h, w_in[l], rel_bias, cmp_pe[l], cmp_w1[l], cmp_b1[l], cmp_w2[l],
                         dsa_kv_norm[l], dsa_w_uk[l], dsa_w_uv[l],
                         w_branch_nsa[l], w_branch_dsa[l], w_out[l])
        x = x + gt1 * rms_norm(y, g_post_mix[l])
        h = rms_norm(x, g_pre_ffn[l]) * (1.0 + sc2) + sh2
        y = moe_ffn(h, router_w[l], router_bias[l], w_exp_gate[l], w_exp_up[l], w_exp_down[l],
                    w_sh_gate[l], w_sh_up[l], w_sh_down[l])
        x = x + gt2 * rms_norm(y, g_post_ffn[l])
    return x
```

```cpp
#include <hip/hip_runtime.h>
#include <hip/hip_cooperative_groups.h>
#include <cstdio>
namespace cg = cooperative_groups;

#define DI __device__ __forceinline__
typedef unsigned short u16;
typedef unsigned long long u64;
using bf16x8 = __attribute__((ext_vector_type(8))) short;
using f32x16 = __attribute__((ext_vector_type(16))) float;

constexpr int T = 8192;
constexpr int NTOK = 16384;
constexpr int LDP = 4576;
constexpr int C_QN = 0, C_KV = 512, C_GN = 1280, C_QD = 1304, C_CKV = 1816, C_QI = 1944, C_KI = 2456, C_WI = 2520, C_GM = 2528;
constexpr int NSLOT = 131072 + 16384;
constexpr int LDS_BYTES = 40960;

__device__ const unsigned char BUCKET[128] = {
  0, 1, 2, 3, 4, 5, 6, 7, 8, 9, 10, 11, 12, 13, 14, 15, 16, 16, 16, 17, 17, 18, 18, 18, 19, 19, 19, 20, 20, 20, 20, 21,
  21, 21, 21, 22, 22, 22, 22, 22, 23, 23, 23, 23, 23, 23, 24, 24, 24, 24, 24, 24, 25, 25, 25, 25, 25, 25, 25, 26, 26, 26, 26, 26,
  26, 26, 26, 27, 27, 27, 27, 27, 27, 27, 27, 27, 27, 28, 28, 28, 28, 28, 28, 28, 28, 28, 28, 29, 29, 29, 29, 29, 29, 29, 29, 29,
  29, 29, 29, 30, 30, 30, 30, 30, 30, 30, 30, 30, 30, 30, 30, 30, 30, 31, 31, 31, 31, 31, 31, 31, 31, 31, 31, 31, 31, 31, 31, 31};

struct Params {
  const float *x, *c, *w_ada, *b_ada, *g_pre_mix, *g_post_mix, *g_pre_ffn, *g_post_ffn, *w_in, *rel_bias;
  const float *cmp_pe, *cmp_w1, *cmp_b1, *cmp_w2, *dsa_kv_norm, *dsa_w_uk, *dsa_w_uv, *w_bn, *w_bd, *w_out;
  const float *router_w, *router_bias, *w_eg, *w_eu, *w_ed, *w_sg, *w_su, *w_sd;
  float* out;
  float* modp;
  float* mod;
  float* pe_part;
  float* w_ukT;
  u16* h;
  u16* proj;
  float* widx;
  u16* zc;
  u16* kc;
  u16* vc;
  u16* qlat;
  u16* ckv;
  float* scores;
  int* selk;
  u16* onsa;
  u16* olat;
  u16* odsa;
  u16* y;
  u16* z;
  float* x1;
  float* logits;
  int* eidx;
  float* ewt;
  int* erank;
  int* counts;
  int* offs;
  int* tile_e;
  int* tile_r0;
  int* tile_nr;
  int* ntiles;
  int* slot_tok;
  float* slot_wt;
  int* tok_slot;
  u16* H;
  u16* Y;
  int phase_lo, phase_hi;
};

DI float bf2f(u16 v) { return __uint_as_float(((unsigned)v) << 16); }
DI u16 f2bf(float x) { unsigned u = __float_as_uint(x); u += 0x7fffu + ((u >> 16) & 1u); return (u16)(u >> 16); }
DI unsigned pack2(float a, float b) { return (unsigned)f2bf(a) | ((unsigned)f2bf(b) << 16); }
DI float lo16(unsigned u) { return __uint_as_float(u << 16); }
DI float hi16(unsigned u) { return __uint_as_float(u & 0xffff0000u); }
DI float wave_sum(float v) { for (int o = 32; o; o >>= 1) v += __shfl_xor(v, o); return v; }
DI float wave_max(float v) { for (int o = 32; o; o >>= 1) v = fmaxf(v, __shfl_xor(v, o)); return v; }
DI float rdlane(float v, int l) { return __int_as_float(__builtin_amdgcn_readlane(__float_as_int(v), l)); }
DI int rdlane_i(int v, int l) { return __builtin_amdgcn_readlane(v, l); }
DI int TIDX() { int t = threadIdx.x; asm volatile("" : "+v"(t)); return t; }
DI void cbar(const void* p) { asm volatile("" ::"v"(p) : "memory"); }
DI void wave_sync() { asm volatile("s_waitcnt lgkmcnt(0)" ::: "memory"); __builtin_amdgcn_wave_barrier(); }
DI float sigmoidf(float x) { return 1.f / (1.f + __expf(-x)); }
DI float siluf(float x) { return x / (1.f + __expf(-x)); }
DI float gelu_tanh(float x) { float u = 0.7978845608028654f * (x + 0.044715f * x * x * x); float e = __expf(2.f * u); float th = 1.f - 2.f / (e + 1.f); return 0.5f * x * (1.f + th); }

template <class AF, class BF, class EF>
DI void gemm_tile(char* smem, int nk, long a_kstep, const AF& af, const BF& bf, const EF& ef) {
  asm volatile("" ::: "memory");
  u16* As = (u16*)smem;
  u16* Bs = As + 128 * 72;
  const int tid = TIDX(), lane = tid & 63, wid = tid >> 6, wm = wid >> 1, wn = wid & 1;
  const int arow = tid >> 1, ahalf = tid & 1;
  const u16* ap = af(arow);
  if (ap) ap += ahalf * 32;
  const int bkq = lane & 7, bnq = wid * 8 + (lane >> 3);
  const float* bp = bf(bnq * 4);
  const long ldb = bf.ldb;
  if (bp) bp += (long)(bkq * 4) * ldb;
  uint4 ra[4];
  float rb[8][4];
  f32x16 acc[2][2];
#pragma unroll
  for (int a = 0; a < 2; ++a)
#pragma unroll
    for (int b = 0; b < 2; ++b)
#pragma unroll
      for (int i = 0; i < 16; ++i) acc[a][b][i] = 0.f;

#define GEMM_LOAD(KT)                                                                     \
  {                                                                                       \
    if (ap) {                                                                             \
      const uint4* pa_ = (const uint4*)(ap + (long)(KT) * a_kstep);                       \
      _Pragma("unroll") for (int i = 0; i < 4; ++i) ra[i] = pa_[i];                       \
    } else {                                                                              \
      _Pragma("unroll") for (int i = 0; i < 4; ++i) ra[i] = make_uint4(0, 0, 0, 0);       \
    }                                                                                     \
    if (bp) {                                                                             \
      const float* pb_ = bp + (long)(KT) * 64 * ldb;                                      \
      _Pragma("unroll") for (int q = 0; q < 2; ++q)                                       \
      _Pragma("unroll") for (int r = 0; r < 4; ++r) {                                     \
        float4 v_ = *(const float4*)(pb_ + (long)(q * 32 + r) * ldb);                     \
        rb[q * 4 + r][0] = v_.x; rb[q * 4 + r][1] = v_.y; rb[q * 4 + r][2] = v_.z; rb[q * 4 + r][3] = v_.w; \
      }                                                                                   \
    } else {                                                                              \
      _Pragma("unroll") for (int q = 0; q < 8; ++q)                                       \
      _Pragma("unroll") for (int r = 0; r < 4; ++r) rb[q][r] = 0.f;                       \
    }                                                                                     \
  }

  GEMM_LOAD(0)
  for (int kt = 0; kt < nk; ++kt) {
    __syncthreads();
#pragma unroll
    for (int i = 0; i < 4; ++i) *(uint4*)&As[arow * 72 + ahalf * 32 + i * 8] = ra[i];
#pragma unroll
    for (int q = 0; q < 2; ++q)
#pragma unroll
      for (int i = 0; i < 4; ++i) {
        uint2 w;
        w.x = pack2(rb[q * 4 + 0][i], rb[q * 4 + 1][i]);
        w.y = pack2(rb[q * 4 + 2][i], rb[q * 4 + 3][i]);
        *(uint2*)&Bs[(bnq * 4 + i) * 72 + q * 32 + bkq * 4] = w;
      }
    __syncthreads();
    if (kt + 1 < nk) GEMM_LOAD(kt + 1)
#pragma unroll
    for (int ks = 0; ks < 4; ++ks) {
      bf16x8 a[2], b[2];
#pragma unroll
      for (int mt = 0; mt < 2; ++mt) a[mt] = *(const bf16x8*)&As[(wm * 64 + mt * 32 + (lane & 31)) * 72 + ks * 16 + (lane >> 5) * 8];
#pragma unroll
      for (int nt = 0; nt < 2; ++nt) b[nt] = *(const bf16x8*)&Bs[(wn * 64 + nt * 32 + (lane & 31)) * 72 + ks * 16 + (lane >> 5) * 8];
#pragma unroll
      for (int mt = 0; mt < 2; ++mt)
#pragma unroll
        for (int nt = 0; nt < 2; ++nt) acc[mt][nt] = __builtin_amdgcn_mfma_f32_32x32x16_bf16(a[mt], b[nt], acc[mt][nt], 0, 0, 0);
    }
  }
#undef GEMM_LOAD
  ef(acc, wm, wn, lane);
}

#define EPI_FOR                                                   \
  _Pragma("unroll") for (int mt = 0; mt < 2; ++mt)                \
  _Pragma("unroll") for (int nt = 0; nt < 2; ++nt)                \
  _Pragma("unroll") for (int i = 0; i < 16; ++i)
#define EPI_R (wm * 64 + mt * 32 + (i & 3) + 8 * (i >> 2) + 4 * (lane >> 5))
#define EPI_C (wn * 64 + nt * 32 + (lane & 31))

struct ARows { const u16* base; long ld; int nrows; DI const u16* operator()(int r) const { return r < nrows ? base + (long)r * ld : nullptr; } };
struct BMat { const float* base; long ldb; int ncols; DI const float* operator()(int c4) const { return c4 < ncols ? base + c4 : nullptr; } };

DI void phase0(const Params& p, int bid, int nblk) {
  const int tid = TIDX();
  for (int item = bid; item < 384 + 256 + 16 + 1; item += nblk) {
    if (item < 384) {
      const int cc = item % 24, kc = item / 24;
      const int col = cc * 256 + tid;
      float a0 = 0.f, a1 = 0.f;
      for (int k = kc * 64; k < kc * 64 + 64; ++k) {
        const float w = p.w_ada[(long)k * 6144 + col];
        a0 += siluf(p.c[k]) * w;
        a1 += siluf(p.c[1024 + k]) * w;
      }
      p.modp[(kc * 2 + 0) * 6144 + col] = a0;
      p.modp[(kc * 2 + 1) * 6144 + col] = a1;
    } else if (item < 640) {
      const int idx = (item - 384) * 256 + tid;
      const int c = idx & 127, d = (idx >> 7) & 63, h = idx >> 13;
      p.w_ukT[idx] = p.dsa_w_uk[c * 512 + h * 64 + d];
    } else if (item < 656) {
      const int part = item - 640;
      const int slot = tid >> 7, kk = tid & 127;
      float a = 0.f;
      for (int ld = part * 128; ld < part * 128 + 128; ++ld) a += p.cmp_pe[slot * 2048 + ld] * p.cmp_w1[((long)slot * 2048 + ld) * 128 + kk];
      p.pe_part[part * 256 + tid] = a;
    } else {
      p.counts[tid] = 0;
    }
  }
}

DI void phase1(const Params& p, char* smem, int bid, int nblk) {
  const int tid = TIDX(), lane = tid & 63, wid = tid >> 6;
  float* modl = (float*)smem;
  for (int idx = tid; idx < 4096; idx += 256) {
    const int b = idx >> 11, n = idx & 2047;
    float v = p.b_ada[n];
    for (int kc = 0; kc < 16; ++kc) v += p.modp[(kc * 2 + b) * 6144 + n];
    modl[idx] = v;
  }
  if (bid < 48) {
    const int idx = bid * 256 + tid;
    const int b = idx / 6144, n = idx % 6144;
    float v = p.b_ada[n];
    for (int kc = 0; kc < 16; ++kc) v += p.modp[(kc * 2 + b) * 6144 + n];
    p.mod[idx] = v;
  }
  __syncthreads();
  for (int row = bid * 4 + wid; row < NTOK; row += nblk * 4) {
    const int b = row >> 13;
    const float* xr = p.x + (long)row * 1024;
    float4 v[4];
    float ss = 0.f;
#pragma unroll
    for (int i = 0; i < 4; ++i) {
      v[i] = *(const float4*)(xr + i * 256 + lane * 4);
      ss += v[i].x * v[i].x + v[i].y * v[i].y + v[i].z * v[i].z + v[i].w * v[i].w;
    }
    ss = wave_sum(ss);
    const float r = rsqrtf(ss * (1.f / 1024.f) + 1e-6f);
#pragma unroll
    for (int i = 0; i < 4; ++i) {
      const int col = i * 256 + lane * 4;
      const float4 g = *(const float4*)(p.g_pre_mix + col);
      const float* sh = modl + b * 2048 + col;
      const float* sc = modl + b * 2048 + 1024 + col;
      const float o0 = v[i].x * r * g.x * (1.f + sc[0]) + sh[0];
      const float o1 = v[i].y * r * g.y * (1.f + sc[1]) + sh[1];
      const float o2 = v[i].z * r * g.z * (1.f + sc[2]) + sh[2];
      const float o3 = v[i].w * r * g.w * (1.f + sc[3]) + sh[3];
      uint2 w;
      w.x = pack2(o0, o1);
      w.y = pack2(o2, o3);
      *(uint2*)(p.h + (long)row * 1024 + col) = w;
    }
  }
}

struct EpiProj {
  u16* proj; float* widx; int m0, n0;
  DI void operator()(f32x16 (&acc)[2][2], int wm, int wn, int lane) const {
    EPI_FOR {
      const int r = m0 + EPI_R, c = n0 + EPI_C;
      if (c < LDP) {
        float v = acc[mt][nt][i];
        if (c < C_KV) v *= 0.125f;
        else if (c < C_GN) {}
        else if (c < C_QD) v = sigmoidf(v);
        else if (c < C_QI) {}
        else if (c < C_KI) v *= 0.125f;
        else if (c < C_WI) {}
        else if (c < C_GM) { v *= 0.35355339059327373f; widx[(long)r * 8 + (c - C_WI)] = v; }
        else v = sigmoidf(v);
        proj[(long)r * LDP + c] = f2bf(v);
      }
    }
  }
};
DI void phase2(const Params& p, char* smem, int bid, int nblk) {
  for (int item = bid; item < 128 * 36; item += nblk) {
    const int mt_ = item / 36, nt_ = item % 36;
    ARows af{p.h + (long)mt_ * 128 * 1024, 1024, 128};
    BMat bf{p.w_in + nt_ * 128, LDP, LDP - nt_ * 128};
    EpiProj ef{p.proj, p.widx, mt_ * 128, nt_ * 128};
    gemm_tile(smem, 16, 64, af, bf, ef);
  }
}

struct ACmp {
  const u16* proj; int slot, m0;
  DI const u16* operator()(int r) const {
    const int R = m0 + r, bg = R >> 9, n = R & 511, b = bg >> 1, g = bg & 1;
    if (n >= 511) return nullptr;
    return proj + ((long)b * T + 16 * n) * LDP + C_KV + slot * 128 + g * 64;
  }
};
struct EpiCmp1 {
  u16* zc; const float* b1; const float* pe_part; int slot, m0;
  DI void operator()(f32x16 (&acc)[2][2], int wm, int wn, int lane) const {
#pragma unroll
    for (int nt = 0; nt < 2; ++nt) {
      const int c = EPI_C;
      float bias = b1[slot * 128 + c];
      for (int q = 0; q < 16; ++q) bias += pe_part[q * 256 + slot * 128 + c];
#pragma unroll
      for (int mt = 0; mt < 2; ++mt)
#pragma unroll
        for (int i = 0; i < 16; ++i) {
          const int R = m0 + EPI_R;
          zc[((long)slot * 2048 + R) * 128 + c] = f2bf(gelu_tanh(acc[mt][nt][i] + bias));
        }
    }
  }
};
struct EpiQlat {
  u16* qlat; int h, m0;
  DI void operator()(f32x16 (&acc)[2][2], int wm, int wn, int lane) const {
    EPI_FOR {
      const int r = m0 + EPI_R, c = EPI_C;
      qlat[((long)r * 8 + h) * 128 + c] = f2bf(acc[mt][nt][i] * 0.125f);
    }
  }
};
DI void phase3(const Params& p, char* smem, int bid, int nblk) {
  const int tid = TIDX(), lane = tid & 63, wid = tid >> 6;
  for (int item = bid; item < 32 + 1024 + 512; item += nblk) {
    if (item < 32) {
      const int slot = item >> 4, mt_ = item & 15;
      ACmp af{p.proj, slot, mt_ * 128};
      BMat bf{p.cmp_w1 + (long)slot * 2048 * 128, 128, 128};
      EpiCmp1 ef{p.zc, p.cmp_b1, p.pe_part, slot, mt_ * 128};
      gemm_tile(smem, 32, LDP, af, bf, ef);
    } else if (item < 1056) {
      const int it = item - 32, h = it & 7, mt_ = it >> 3;
      ARows af{p.proj + (long)mt_ * 128 * LDP + C_QD + h * 64, LDP, 128};
      BMat bf{p.w_ukT + h * 64 * 128, 128, 128};
      EpiQlat ef{p.qlat, h, mt_ * 128};
      gemm_tile(smem, 1, 64, af, bf, ef);
    } else {
      const int it = item - 1056;
      for (int q = 0; q < 8; ++q) {
        const int row = it * 32 + wid * 8 + q;
        const unsigned u = *(const unsigned*)(p.proj + (long)row * LDP + C_CKV + lane * 2);
        const float a = lo16(u), b = hi16(u);
        const float ss = wave_sum(a * a + b * b);
        const float r = rsqrtf(ss * (1.f / 128.f) + 1e-6f);
        *(unsigned*)(p.ckv + (long)row * 128 + lane * 2) = pack2(a * r * p.dsa_kv_norm[lane * 2], b * r * p.dsa_kv_norm[lane * 2 + 1]);
      }
    }
  }
}

struct EpiCmp2 {
  u16* dst; int m0;
  DI void operator()(f32x16 (&acc)[2][2], int wm, int wn, int lane) const {
    EPI_FOR {
      const int R = m0 + EPI_R, c = EPI_C;
      if (c < 64) dst[(long)R * 64 + c] = f2bf(acc[mt][nt][i]);
    }
  }
};
DI void indexer_item(const Params& p, char* smem, int item) {
  const int tid = TIDX(), lane = tid & 63, wid = tid >> 6;
  int b = 0, rem = item;
  if (rem >= 2080) { b = 1; rem -= 2080; }
  int qt = (int)((sqrtf(8.f * rem + 1.f) - 1.f) * 0.5f);
  while ((qt + 1) * (qt + 2) / 2 <= rem) ++qt;
  while (qt * (qt + 1) / 2 > rem) --qt;
  const int kt = rem - qt * (qt + 1) / 2;
  const int t0 = qt * 128 + (wid >> 1) * 64, s0 = kt * 128 + (wid & 1) * 64;
  if (s0 > t0 + 63) return;
  float* wl = (float*)smem + wid * 512;
  const float* wsrc = p.widx + ((long)b * T + t0) * 8;
#pragma unroll
  for (int i = 0; i < 8; ++i) wl[i * 64 + lane] = wsrc[i * 64 + lane];
  wave_sync();
  const u16* projb = p.proj + (long)b * T * LDP;
  const int r31 = lane & 31, hf = lane >> 5;
  bf16x8 bfr[2][4];
#pragma unroll
  for (int nt = 0; nt < 2; ++nt)
#pragma unroll
    for (int ks = 0; ks < 4; ++ks) bfr[nt][ks] = *(const bf16x8*)(projb + (long)(s0 + nt * 32 + r31) * LDP + C_KI + ks * 16 + hf * 8);
  f32x16 sum[2][2];
#pragma unroll
  for (int a = 0; a < 2; ++a)
#pragma unroll
    for (int c = 0; c < 2; ++c)
#pragma unroll
      for (int i = 0; i < 16; ++i) sum[a][c][i] = 0.f;
  for (int h = 0; h < 8; ++h) {
    bf16x8 afr[2][4];
#pragma unroll
    for (int mt = 0; mt < 2; ++mt)
#pragma unroll
      for (int ks = 0; ks < 4; ++ks) afr[mt][ks] = *(const bf16x8*)(projb + (long)(t0 + mt * 32 + r31) * LDP + C_QI + h * 64 + ks * 16 + hf * 8);
#pragma unroll
    for (int mt = 0; mt < 2; ++mt)
#pragma unroll
      for (int nt = 0; nt < 2; ++nt) {
        f32x16 acc;
#pragma unroll
        for (int i = 0; i < 16; ++i) acc[i] = 0.f;
#pragma unroll
        for (int ks = 0; ks < 4; ++ks) acc = __builtin_amdgcn_mfma_f32_32x32x16_bf16(afr[mt][ks], bfr[nt][ks], acc, 0, 0, 0);
#pragma unroll
        for (int i = 0; i < 16; ++i) {
          const int row = mt * 32 + (i & 3) + 8 * (i >> 2) + 4 * hf;
          sum[mt][nt][i] += wl[row * 8 + h] * fmaxf(acc[i], 0.f);
        }
      }
  }
#pragma unroll
  for (int mt = 0; mt < 2; ++mt)
#pragma unroll
    for (int nt = 0; nt < 2; ++nt)
#pragma unroll
      for (int i = 0; i < 16; ++i) {
        const int row = mt * 32 + (i & 3) + 8 * (i >> 2) + 4 * hf;
        p.scores[((long)b * T + t0 + row) * T + s0 + nt * 32 + r31] = sum[mt][nt][i];
      }
}
DI void phase4(const Params& p, char* smem, int bid, int nblk) {
  for (int item = bid; item < 32 + 4160; item += nblk) {
    __syncthreads();
    if (item < 32) {
      const int slot = item >> 4, mt_ = item & 15;
      ARows af{p.zc + ((long)slot * 2048 + mt_ * 128) * 128, 128, 128};
      BMat bf{p.cmp_w2 + slot * 128 * 64, 64, 64};
      EpiCmp2 ef{slot ? p.vc : p.kc, mt_ * 128};
      gemm_tile(smem, 2, 64, af, bf, ef);
    } else {
      indexer_item(p, smem, item - 32);
    }
  }
}

using f32x4 = __attribute__((ext_vector_type(4))) float;
#define MFMA16(a, b, c) __builtin_amdgcn_mfma_f32_16x16x32_bf16((a), (b), (c), 0, 0, 0)

DI void nsa_scores(f32x4 (&acc)[4], const u16* kbase, long kstride, int key_lo, int key_hi, const bf16x8 (&qf)[2], int lane) {
  const int g = lane >> 4, r16 = lane & 15;
#pragma unroll
  for (int rt = 0; rt < 4; ++rt) {
    int kl = 16 * rt + r16;
    kl = kl < key_lo ? key_lo : (kl > key_hi ? key_hi : kl);
    const u16* kp = kbase + (long)kl * kstride + 8 * g;
    const bf16x8 a0 = *(const bf16x8*)kp;
    const bf16x8 a1 = *(const bf16x8*)(kp + 32);
    f32x4 c = {0.f, 0.f, 0.f, 0.f};
    c = MFMA16(a0, qf[0], c);
    c = MFMA16(a1, qf[1], c);
    acc[rt] = c;
  }
}
DI void nsa_pv(const f32x4 (&acc)[4], const u16* vbase, long vstride, int key_lo, int key_hi, int lane, float (&o)[4]) {
#pragma unroll
  for (int rt = 0; rt < 4; ++rt)
#pragma unroll
    for (int g2 = 0; g2 < 4; ++g2)
#pragma unroll
      for (int r = 0; r < 4; ++r) {
        const int kl = 16 * rt + 4 * g2 + r;
        if (kl >= key_lo && kl <= key_hi) {
          const float v = bf2f(vbase[(long)kl * vstride + lane]);
#pragma unroll
          for (int h = 0; h < 4; ++h) o[h] += rdlane(acc[rt][r], 16 * g2 + h) * v;
        }
      }
}
DI void attend_chunk(const u16* kbase, const u16* vbase, int key_lo, int key_hi, int dist0, const bf16x8 (&qf)[2], const float* btab,
                     int lane, float& m, float& l, float (&o)[4]) {
  const int g = lane >> 4, hh = lane & 3;
  f32x4 acc[4];
  nsa_scores(acc, kbase, LDP, key_lo, key_hi, qf, lane);
  float mx = -1e30f;
#pragma unroll
  for (int rt = 0; rt < 4; ++rt)
#pragma unroll
    for (int r = 0; r < 4; ++r) {
      const int kl = 16 * rt + 4 * g + r;
      const bool valid = kl >= key_lo && kl <= key_hi;
      int dc = dist0 - kl;
      dc = dc < 0 ? 0 : (dc > 128 ? 128 : dc);
      const float sv = valid ? acc[rt][r] + btab[hh * 132 + dc] : -1e30f;
      acc[rt][r] = sv;
      mx = fmaxf(mx, sv);
    }
  mx = fmaxf(mx, __shfl_xor(mx, 16));
  mx = fmaxf(mx, __shfl_xor(mx, 32));
  const float mn = fmaxf(m, mx);
  const float alpha = __expf(m - mn);
  float ls = 0.f;
#pragma unroll
  for (int rt = 0; rt < 4; ++rt)
#pragma unroll
    for (int r = 0; r < 4; ++r) {
      const float pv = acc[rt][r] > -1e29f ? __expf(acc[rt][r] - mn) : 0.f;
      acc[rt][r] = pv;
      ls += pv;
    }
  ls += __shfl_xor(ls, 16);
  ls += __shfl_xor(ls, 32);
  l = l * alpha + ls;
  m = mn;
#pragma unroll
  for (int h = 0; h < 4; ++h) o[h] *= rdlane(alpha, h);
  nsa_pv(acc, vbase, LDP, key_lo, key_hi, lane, o);
}

DI void nsa_query(const Params& p, float* imps, const float* btab, int b, int g, int t, int lane) {
  const long row = (long)b * T + t;
  const u16* prow = p.proj + row * LDP;
  const u16* projb = p.proj + (long)b * T * LDP;
  const int bg = b * 2 + g;
  const int lg = lane >> 4, r16 = lane & 15;
  bf16x8 qf[2];
#pragma unroll
  for (int ks = 0; ks < 2; ++ks) {
    bf16x8 z = {0, 0, 0, 0, 0, 0, 0, 0};
    if (r16 < 4) z = *(const bf16x8*)(prow + C_QN + (g * 4 + r16) * 64 + ks * 32 + lg * 8);
    qf[ks] = z;
  }
  float gate[4][3];
#pragma unroll
  for (int h = 0; h < 4; ++h)
#pragma unroll
    for (int br = 0; br < 3; ++br) gate[h][br] = bf2f(prow[C_GN + (g * 4 + h) * 3 + br]);
  float oacc[4] = {0.f, 0.f, 0.f, 0.f};
  const int cur = t >> 6;
  const int ncv = (t >= 31) ? ((t - 31) >> 4) + 1 : 0;
  wave_sync();
  imps[lane] = 0.f;
  imps[lane + 64] = 0.f;
  if (lane == 0) imps[128] = 0.f;
  wave_sync();
  if (ncv > 0) {
    const u16* kcb = p.kc + (long)bg * 512 * 64;
    const u16* vcb = p.vc + (long)bg * 512 * 64;
    const int hh = lane & 3;
    float m = -1e30f, l = 0.f;
    for (int i = 0; i * 64 < ncv; ++i) {
      const int key_hi = (ncv - 1 - i * 64) > 63 ? 63 : (ncv - 1 - i * 64);
      f32x4 acc[4];
      nsa_scores(acc, kcb + (long)i * 64 * 64, 64, 0, key_hi, qf, lane);
      const int dist0 = t - 31 - 16 * (i * 64);
      float mx = -1e30f;
#pragma unroll
      for (int rt = 0; rt < 4; ++rt)
#pragma unroll
        for (int r = 0; r < 4; ++r) {
          const int kl = 16 * rt + 4 * lg + r;
          int dc = dist0 - 16 * kl;
          dc = dc < 0 ? 0 : (dc > 128 ? 128 : dc);
          const float sv = (kl <= key_hi) ? acc[rt][r] + btab[hh * 132 + dc] : -1e30f;
          acc[rt][r] = sv;
          mx = fmaxf(mx, sv);
        }
      mx = fmaxf(mx, __shfl_xor(mx, 16));
      mx = fmaxf(mx, __shfl_xor(mx, 32));
      const float mn = fmaxf(m, mx);
      float ls = 0.f;
#pragma unroll
      for (int rt = 0; rt < 4; ++rt)
#pragma unroll
        for (int r = 0; r < 4; ++r) ls += acc[rt][r] > -1e29f ? __expf(acc[rt][r] - mn) : 0.f;
      ls += __shfl_xor(ls, 16);
      ls += __shfl_xor(ls, 32);
      l = l * __expf(m - mn) + ls;
      m = mn;
    }
    const float invl = 1.f / fmaxf(l, 1e-30f);
    float oc[4] = {0.f, 0.f, 0.f, 0.f};
    for (int i = 0; i * 64 < ncv; ++i) {
      const int key_hi = (ncv - 1 - i * 64) > 63 ? 63 : (ncv - 1 - i * 64);
      f32x4 acc[4];
      nsa_scores(acc, kcb + (long)i * 64 * 64, 64, 0, key_hi, qf, lane);
      const int dist0 = t - 31 - 16 * (i * 64);
      float part[4], spill[4];
#pragma unroll
      for (int rt = 0; rt < 4; ++rt) {
#pragma unroll
        for (int r = 0; r < 4; ++r) {
          const int kl = 16 * rt + 4 * lg + r;
          int dc = dist0 - 16 * kl;
          dc = dc < 0 ? 0 : (dc > 128 ? 128 : dc);
          acc[rt][r] = (kl <= key_hi) ? __expf(acc[rt][r] + btab[hh * 132 + dc] - m) * invl : 0.f;
        }
        float pa = acc[rt][0] + acc[rt][1] + acc[rt][2] + 0.5f * acc[rt][3];
        float sp = 0.5f * acc[rt][3];
        pa += __shfl_xor(pa, 1); pa += __shfl_xor(pa, 2);
        sp += __shfl_xor(sp, 1); sp += __shfl_xor(sp, 2);
        part[rt] = pa; spill[rt] = sp;
      }
      if (r16 == 0) {
#pragma unroll
        for (int rt = 0; rt < 4; ++rt) imps[16 * i + 4 * rt + lg] += part[rt];
      }
      wave_sync();
      if (r16 == 0) {
#pragma unroll
        for (int rt = 0; rt < 4; ++rt) imps[16 * i + 4 * rt + lg + 1] += spill[rt];
      }
      wave_sync();
      nsa_pv(acc, vcb + (long)i * 64 * 64, 64, 0, key_hi, lane, oc);
    }
#pragma unroll
    for (int h = 0; h < 4; ++h) oacc[h] = gate[h][0] * oc[h];
  }
  wave_sync();
  const float imp_lo = imps[lane], imp_hi = imps[lane + 64];
  bool sel_lo, sel_hi;
  if (cur <= 15) {
    sel_lo = lane <= cur;
    sel_hi = false;
  } else {
    const int jl = lane, jh = lane + 64;
    float c0 = (jl >= 1 && jl <= cur - 2) ? imp_lo : -1.f;
    float c1 = (jh <= cur - 2) ? imp_hi : -1.f;
    sel_lo = (jl == 0) || (jl == cur) || (jl == cur - 1);
    sel_hi = (jh == cur) || (jh == cur - 1);
    for (int r = 0; r < 13; ++r) {
      float bv; int bj;
      if (c0 >= c1) { bv = c0; bj = jl; } else { bv = c1; bj = jh; }
#pragma unroll
      for (int o = 32; o; o >>= 1) {
        const float ov = __shfl_xor(bv, o);
        const int oj = __shfl_xor(bj, o);
        if (ov > bv || (ov == bv && oj < bj)) { bv = ov; bj = oj; }
      }
      if (bj == jl) { sel_lo = true; c0 = -1.f; }
      if (bj == jh) { sel_hi = true; c1 = -1.f; }
    }
  }
  const u64 mask0 = __ballot(sel_lo), mask1 = __ballot(sel_hi);
  {
    float m = -1e30f, l = 0.f, o[4] = {0.f, 0.f, 0.f, 0.f};
    const int kcol = C_KV + 2 * 128 + g * 64, vcol = C_KV + 3 * 128 + g * 64;
    for (int half = 0; half < 2; ++half) {
      for (u64 mk = half ? mask1 : mask0; mk; mk &= mk - 1) {
        const int j = half * 64 + __builtin_ctzll(mk);
        if (j <= cur) {
          const int pos0 = 64 * j;
          const int key_hi = (t - pos0) > 63 ? 63 : (t - pos0);
          attend_chunk(projb + (long)pos0 * LDP + kcol, projb + (long)pos0 * LDP + vcol, 0, key_hi, t - pos0, qf, btab, lane, m, l, o);
        }
      }
    }
    const float invl = 1.f / fmaxf(l, 1e-30f);
#pragma unroll
    for (int h = 0; h < 4; ++h) oacc[h] += gate[h][1] * o[h] * rdlane(invl, h);
  }
  {
    float m = -1e30f, l = 0.f, o[4] = {0.f, 0.f, 0.f, 0.f};
    const int kcol = C_KV + 4 * 128 + g * 64, vcol = C_KV + 5 * 128 + g * 64;
    for (int i = 0; i < 8; ++i) {
      const int pos0 = t - 511 + 64 * i;
      if (pos0 + 63 >= 0) {
        const int key_lo = pos0 < 0 ? -pos0 : 0;
        attend_chunk(projb + (long)pos0 * LDP + kcol, projb + (long)pos0 * LDP + vcol, key_lo, 63, t - pos0, qf, btab, lane, m, l, o);
      }
    }
    const float invl = 1.f / fmaxf(l, 1e-30f);
#pragma unroll
    for (int h = 0; h < 4; ++h) oacc[h] += gate[h][2] * o[h] * rdlane(invl, h);
  }
#pragma unroll
  for (int h = 0; h < 4; ++h) p.onsa[row * 512 + (g * 4 + h) * 64 + lane] = f2bf(oacc[h]);
}

DI void nsa_item(const Params& p, char* smem, int item) {
  const int tid = TIDX(), lane = tid & 63, wid = tid >> 6;
  const int chunk = item & 255, g = (item >> 8) & 1, b = item >> 9;
  const int t0 = chunk * 32;
  float* btab = (float*)smem;
  float* imps = (float*)(smem + 4096) + wid * 160;
  for (int idx = tid; idx < 4 * 129; idx += 256) {
    const int h = idx / 129, d = idx % 129;
    const int bk = d < 128 ? BUCKET[d] : 31;
    btab[h * 132 + d] = p.rel_bias[bk * 16 + g * 4 + h];
  }
  __syncthreads();
  for (int q = 0; q < 8; ++q) nsa_query(p, imps, btab, b, g, t0 + wid * 8 + q, lane);
}

DI unsigned f2ord(float v) { const unsigned u = __float_as_uint(v); return (u & 0x80000000u) ? ~u : (u | 0x80000000u); }

DI void topk_row(const Params& p, int b, int t, int lane) {
  const long row = (long)b * T + t;
  int* dst = p.selk + row * 256;
  if (t < 256) {
#pragma unroll
    for (int i = 0; i < 4; ++i) { const int s = i * 64 + lane; dst[s] = (s <= t) ? s : -1; }
    return;
  }
  const float* srow = p.scores + row * T;
  const int ngrp = (t >> 10) + 1;
  unsigned u[128];
  int ln = lane;
  asm volatile("" : "+v"(ln));
#pragma unroll
  for (int gq = 0; gq < 8; ++gq) {
    if (gq < ngrp) {
#pragma unroll
      for (int j = 0; j < 16; ++j) {
        const int s = (gq * 16 + j) * 64 + ln;
        const float v = srow[s < t ? s : t];
        u[gq * 16 + j] = (s <= t) ? f2ord(v) : 0u;
      }
    } else {
#pragma unroll
      for (int j = 0; j < 16; ++j) u[gq * 16 + j] = 0u;
    }
  }
  unsigned thr = 0u;
  for (int bit = 31; bit >= 0; --bit) {
    const unsigned cand = thr | (1u << bit);
    int cnt = 0;
#pragma unroll
    for (int gq = 0; gq < 8; ++gq) {
      if (gq < ngrp) {
#pragma unroll
        for (int j = 0; j < 16; ++j) cnt += __popcll(__ballot(u[gq * 16 + j] >= cand));
      }
    }
    if (cnt >= 256) thr = cand;
    if (cnt == 256) break;
  }
  int ngt = 0;
#pragma unroll
  for (int gq = 0; gq < 8; ++gq) {
    if (gq < ngrp) {
#pragma unroll
      for (int j = 0; j < 16; ++j) ngt += __popcll(__ballot(u[gq * 16 + j] > thr));
    }
  }
  int base_gt = 0, base_eq = 0;
  const int need_eq = 256 - ngt;
  int ln2 = lane;
  asm volatile("" : "+v"(ln2));
#pragma unroll
  for (int gq = 0; gq < 8; ++gq) {
    if (gq < ngrp) {
#pragma unroll
      for (int j = 0; j < 16; ++j) {
        const int s = (gq * 16 + j) * 64 + ln2;
        const unsigned uv = u[gq * 16 + j];
        const bool gt = uv > thr, eq = uv == thr;
        const u64 mg = __ballot(gt), me = __ballot(eq);
        const int pg = __builtin_amdgcn_mbcnt_hi((unsigned)(mg >> 32), __builtin_amdgcn_mbcnt_lo((unsigned)mg, 0));
        const int pe = __builtin_amdgcn_mbcnt_hi((unsigned)(me >> 32), __builtin_amdgcn_mbcnt_lo((unsigned)me, 0));
        if (gt) dst[base_gt + pg] = s;
        if (eq && (base_eq + pe) < need_eq) dst[ngt + base_eq + pe] = s;
        base_gt += __popcll(mg);
        base_eq += __popcll(me);
      }
    }
  }
}

DI void phase5(const Params& p, char* smem, int bid, int nblk) {
  const int tid = TIDX(), lane = tid & 63, wid = tid >> 6;
  for (int item = bid; item < 1024 + 2048; item += nblk) {
    __syncthreads();
    if (item < 1024) {
      const int it = 1023 - item;
      const int chunk = it >> 2, bgi = it & 3;
      nsa_item(p, smem, (bgi << 8) | chunk);
    } else {
      const int it = 2047 - (item - 1024);
      const int b = it & 1, tb = it >> 1;
#pragma unroll 1
      for (int q = 0; q < 2; ++q) {
        asm volatile("" ::: "memory");
        topk_row(p, b, tb * 8 + wid * 2 + q, lane);
      }
    }
  }
}

DI void dsa_query(const Params& p, const float* btab, int b, int t, int lane) {
  const long row = (long)b * T + t;
  const int lg = lane >> 4, r16 = lane & 15, hh = lane & 7;
  bf16x8 qf[4];
#pragma unroll
  for (int ks = 0; ks < 4; ++ks) {
    bf16x8 z = {0, 0, 0, 0, 0, 0, 0, 0};
    if (r16 < 8) z = *(const bf16x8*)(p.qlat + (row * 8 + r16) * 128 + ks * 32 + lg * 8);
    qf[ks] = z;
  }
  const u16* ckvb = p.ckv + (long)b * T * 128;
  const int nvalid = (t + 1) < 256 ? (t + 1) : 256;
  float m = -1e30f, l = 0.f, o0[8], o1[8];
#pragma unroll
  for (int h = 0; h < 8; ++h) { o0[h] = 0.f; o1[h] = 0.f; }
  for (int i = 0; i * 64 < nvalid; ++i) {
    const int nval = (nvalid - i * 64) > 64 ? 64 : (nvalid - i * 64);
    int kidx = p.selk[row * 256 + i * 64 + lane];
    if (lane >= nval || kidx < 0 || kidx > t) kidx = t;
    f32x4 acc[4];
#pragma unroll
    for (int rt = 0; rt < 4; ++rt) {
      const int kk = __shfl(kidx, 16 * rt + r16);
      const u16* kp = ckvb + (long)kk * 128 + 8 * lg;
      f32x4 c = {0.f, 0.f, 0.f, 0.f};
#pragma unroll
      for (int ks = 0; ks < 4; ++ks) c = MFMA16(*(const bf16x8*)(kp + 32 * ks), qf[ks], c);
      acc[rt] = c;
    }
    float mx = -1e30f;
#pragma unroll
    for (int rt = 0; rt < 4; ++rt)
#pragma unroll
      for (int r = 0; r < 4; ++r) {
        const int pl = 16 * rt + 4 * lg + r;
        const int kk = __shfl(kidx, pl);
        int dc = t - kk;
        dc = dc < 0 ? 0 : (dc > 128 ? 128 : dc);
        const float sv = (pl < nval) ? acc[rt][r] + btab[hh * 132 + dc] : -1e30f;
        acc[rt][r] = sv;
        mx = fmaxf(mx, sv);
      }
    mx = fmaxf(mx, __shfl_xor(mx, 16));
    mx = fmaxf(mx, __shfl_xor(mx, 32));
    const float mn = fmaxf(m, mx);
    const float alpha = __expf(m - mn);
    float ls = 0.f;
#pragma unroll
    for (int rt = 0; rt < 4; ++rt)
#pragma unroll
      for (int r = 0; r < 4; ++r) {
        const float pv = acc[rt][r] > -1e29f ? __expf(acc[rt][r] - mn) : 0.f;
        acc[rt][r] = pv;
        ls += pv;
      }
    ls += __shfl_xor(ls, 16);
    ls += __shfl_xor(ls, 32);
    l = l * alpha + ls;
    m = mn;
#pragma unroll
    for (int h = 0; h < 8; ++h) { const float a = rdlane(alpha, h); o0[h] *= a; o1[h] *= a; }
#pragma unroll
    for (int rt = 0; rt < 4; ++rt)
#pragma unroll
      for (int g2 = 0; g2 < 4; ++g2)
#pragma unroll
        for (int r = 0; r < 4; ++r) {
          const int pl = 16 * rt + 4 * g2 + r;
          if (pl < nval) {
            const int kL = rdlane_i(kidx, pl);
            const unsigned u = *(const unsigned*)(ckvb + (long)kL * 128 + lane * 2);
            const float v0 = lo16(u), v1 = hi16(u);
#pragma unroll
            for (int h = 0; h < 8; ++h) {
              const float pw = rdlane(acc[rt][r], 16 * g2 + h);
              o0[h] += pw * v0;
              o1[h] += pw * v1;
            }
          }
        }
  }
  const float invl = 1.f / fmaxf(l, 1e-30f);
#pragma unroll
  for (int h = 0; h < 8; ++h) {
    const float iv = rdlane(invl, h);
    *(unsigned*)(p.olat + row * 1024 + h * 128 + lane * 2) = pack2(o0[h] * iv, o1[h] * iv);
  }
}
DI void phase6(const Params& p, char* smem, int bid, int nblk) {
  const int tid = TIDX(), lane = tid & 63, wid = tid >> 6;
  float* btab = (float*)smem;
  for (int idx = tid; idx < 8 * 129; idx += 256) {
    const int h = idx / 129, d = idx % 129;
    const int bk = d < 128 ? BUCKET[d] : 31;
    btab[h * 132 + d] = p.rel_bias[bk * 16 + 8 + h];
  }
  __syncthreads();
  for (int item = bid; item < 2048; item += nblk) {
    const int it = 2047 - item;
    const int b = it & 1, tb = it >> 1;
    for (int q = 0; q < 2; ++q) dsa_query(p, btab, b, tb * 8 + wid * 2 + q, lane);
  }
}

struct EpiOdsa {
  u16* odsa; int h, m0;
  DI void operator()(f32x16 (&acc)[2][2], int wm, int wn, int lane) const {
    EPI_FOR {
      const int r = m0 + EPI_R, c = EPI_C;
      if (c < 64) odsa[(long)r * 512 + h * 64 + c] = f2bf(acc[mt][nt][i]);
    }
  }
};
DI void phase7(const Params& p, char* smem, int bid, int nblk) {
  for (int item = bid; item < 1024; item += nblk) {
    const int h = item & 7, mt_ = item >> 3;
    ARows af{p.olat + (long)mt_ * 128 * 1024 + h * 128, 1024, 128};
    BMat bf{p.dsa_w_uv + h * 64, 512, 64};
    EpiOdsa ef{p.odsa, h, mt_ * 128};
    gemm_tile(smem, 2, 64, af, bf, ef);
  }
}

struct EpiY {
  u16* y; const u16* proj; int m0, n0, second;
  DI void operator()(f32x16 (&acc)[2][2], int wm, int wn, int lane) const {
    EPI_FOR {
      const int r = m0 + EPI_R, c = n0 + EPI_C;
      const float g = bf2f(proj[(long)r * LDP + C_GM + second * 1024 + c]);
      float v = g * acc[mt][nt][i];
      if (second) v += bf2f(y[(long)r * 1024 + c]);
      y[(long)r * 1024 + c] = f2bf(v);
    }
  }
};
DI void phase8(const Params& p, char* smem, int bid, int nblk) {
  for (int item = bid; item < 1024; item += nblk) {
    const int nt_ = item & 7, mt_ = item >> 3;
    {
      ARows af{p.onsa + (long)mt_ * 128 * 512, 512, 128};
      BMat bf{p.w_bn + nt_ * 128, 1024, 128};
      EpiY ef{p.y, p.proj, mt_ * 128, nt_ * 128, 0};
      gemm_tile(smem, 8, 64, af, bf, ef);
    }
    {
      ARows af{p.odsa + (long)mt_ * 128 * 512, 512, 128};
      BMat bf{p.w_bd + nt_ * 128, 1024, 128};
      EpiY ef{p.y, p.proj, mt_ * 128, nt_ * 128, 1};
      gemm_tile(smem, 8, 64, af, bf, ef);
    }
  }
}
struct EpiStoreBf {
  u16* dst; long ld; int m0, n0;
  DI void operator()(f32x16 (&acc)[2][2], int wm, int wn, int lane) const {
    EPI_FOR { dst[(long)(m0 + EPI_R) * ld + n0 + EPI_C] = f2bf(acc[mt][nt][i]); }
  }
};
DI void phase9(const Params& p, char* smem, int bid, int nblk) {
  for (int item = bid; item < 1024; item += nblk) {
    const int nt_ = item & 7, mt_ = item >> 3;
    ARows af{p.y + (long)mt_ * 128 * 1024, 1024, 128};
    BMat bf{p.w_out + nt_ * 128, 1024, 128};
    EpiStoreBf ef{p.z, 1024, mt_ * 128, nt_ * 128};
    gemm_tile(smem, 16, 64, af, bf, ef);
  }
}

DI void phase10(const Params& p, int bid, int nblk) {
  const int tid = TIDX(), lane = tid & 63, wid = tid >> 6;
  for (int row = bid * 4 + wid; row < NTOK; row += nblk * 4) {
    const int b = row >> 13;
    const float* modb = p.mod + b * 6144;
    float zv[16], xv[16];
    float ss = 0.f;
#pragma unroll
    for (int i = 0; i < 4; ++i) {
      const int col = i * 256 + lane * 4;
      const uint2 u = *(const uint2*)(p.z + (long)row * 1024 + col);
      zv[i * 4 + 0] = lo16(u.x); zv[i * 4 + 1] = hi16(u.x); zv[i * 4 + 2] = lo16(u.y); zv[i * 4 + 3] = hi16(u.y);
      const float4 xx = *(const float4*)(p.x + (long)row * 1024 + col);
      xv[i * 4 + 0] = xx.x; xv[i * 4 + 1] = xx.y; xv[i * 4 + 2] = xx.z; xv[i * 4 + 3] = xx.w;
#pragma unroll
      for (int j = 0; j < 4; ++j) ss += zv[i * 4 + j] * zv[i * 4 + j];
    }
    ss = wave_sum(ss);
    const float r = rsqrtf(ss * (1.f / 1024.f) + 1e-6f);
    float ss2 = 0.f;
#pragma unroll
    for (int i = 0; i < 4; ++i)
#pragma unroll
      for (int j = 0; j < 4; ++j) {
        const int col = i * 256 + lane * 4 + j;
        const float v = xv[i * 4 + j] + modb[2048 + col] * (zv[i * 4 + j] * r * p.g_post_mix[col]);
        xv[i * 4 + j] = v;
        ss2 += v * v;
      }
    ss2 = wave_sum(ss2);
    const float r2 = rsqrtf(ss2 * (1.f / 1024.f) + 1e-6f);
#pragma unroll
    for (int i = 0; i < 4; ++i) {
      const int col = i * 256 + lane * 4;
      *(float4*)(p.x1 + (long)row * 1024 + col) = make_float4(xv[i * 4], xv[i * 4 + 1], xv[i * 4 + 2], xv[i * 4 + 3]);
      float hv[4];
#pragma unroll
      for (int j = 0; j < 4; ++j) hv[j] = xv[i * 4 + j] * r2 * p.g_pre_ffn[col + j] * (1.f + modb[4096 + col + j]) + modb[3072 + col + j];
      uint2 w;
      w.x = pack2(hv[0], hv[1]);
      w.y = pack2(hv[2], hv[3]);
      *(uint2*)(p.h + (long)row * 1024 + col) = w;
    }
  }
}

struct EpiStoreF32 {
  float* dst; long ld; int m0, n0;
  DI void operator()(f32x16 (&acc)[2][2], int wm, int wn, int lane) const {
    EPI_FOR { dst[(long)(m0 + EPI_R) * ld + n0 + EPI_C] = acc[mt][nt][i]; }
  }
};
DI void phase11(const Params& p, char* smem, int bid, int nblk) {
  for (int item = bid; item < 256; item += nblk) {
    const int nt_ = item & 1, mt_ = item >> 1;
    ARows af{p.h + (long)mt_ * 128 * 1024, 1024, 128};
    BMat bf{p.router_w + nt_ * 128, 256, 128};
    EpiStoreF32 ef{p.logits, 256, mt_ * 128, nt_ * 128};
    gemm_tile(smem, 16, 64, af, bf, ef);
  }
}
DI void phase12(const Params& p, int bid, int nblk) {
  const int tid = TIDX(), lane = tid & 63, wid = tid >> 6;
  for (int tok = bid * 4 + wid; tok < NTOK; tok += nblk * 4) {
    const float4 lg = *(const float4*)(p.logits + (long)tok * 256 + lane * 4);
    const float4 rbv = *(const float4*)(p.router_bias + lane * 4);
    float sg[4] = {sigmoidf(lg.x), sigmoidf(lg.y), sigmoidf(lg.z), sigmoidf(lg.w)};
    float sl[4] = {sg[0] + rbv.x, sg[1] + rbv.y, sg[2] + rbv.z, sg[3] + rbv.w};
    float t1 = fmaxf(sl[0], sl[1]), t2 = fminf(sl[0], sl[1]);
#pragma unroll
    for (int j = 2; j < 4; ++j) {
      const float v = sl[j];
      t2 = fmaxf(t2, fminf(t1, v));
      t1 = fmaxf(t1, v);
    }
#pragma unroll
    for (int o = 1; o < 8; o <<= 1) {
      const float a1 = __shfl_xor(t1, o), a2 = __shfl_xor(t2, o);
      const float n1 = fmaxf(t1, a1);
      const float n2 = fmaxf(fminf(t1, a1), fmaxf(t2, a2));
      t1 = n1; t2 = n2;
    }
    const float gscore = t1 + t2;
    const int grp = lane >> 3;
    int rank = 0;
#pragma unroll
    for (int g2 = 0; g2 < 8; ++g2) {
      const float og = __shfl(gscore, g2 * 8);
      rank += (og > gscore || (og == gscore && g2 < grp)) ? 1 : 0;
    }
    const bool gsel = rank < 4;
    float cv[4];
#pragma unroll
    for (int j = 0; j < 4; ++j) cv[j] = gsel ? sl[j] : -1e30f;
    int my_e = -1; float my_s = 0.f; float ssum = 0.f;
    for (int r = 0; r < 8; ++r) {
      float bv = cv[0]; int bj = 0;
#pragma unroll
      for (int j = 1; j < 4; ++j) if (cv[j] > bv) { bv = cv[j]; bj = j; }
      int be = lane * 4 + bj;
      float bs = bj == 0 ? sg[0] : (bj == 1 ? sg[1] : (bj == 2 ? sg[2] : sg[3]));
#pragma unroll
      for (int o = 32; o; o >>= 1) {
        const float ov = __shfl_xor(bv, o);
        const int oe = __shfl_xor(be, o);
        const float os = __shfl_xor(bs, o);
        if (ov > bv || (ov == bv && oe < be)) { bv = ov; be = oe; bs = os; }
      }
      if ((be >> 2) == lane) {
        const int j = be & 3;
        if (j == 0) cv[0] = -3e30f; else if (j == 1) cv[1] = -3e30f; else if (j == 2) cv[2] = -3e30f; else cv[3] = -3e30f;
      }
      if (lane == r) { my_e = be; my_s = bs; }
      ssum += bs;
    }
    if (lane < 8) {
      const float w = my_s / ssum * 2.5f;
      const int rk = atomicAdd(p.counts + my_e, 1);
      p.eidx[tok * 8 + lane] = my_e;
      p.ewt[tok * 8 + lane] = w;
      p.erank[tok * 8 + lane] = rk;
    }
  }
}
DI void phase13(const Params& p, char* smem, int bid) {
  if (bid != 0) return;
  const int tid = TIDX();
  int* s_cnt = (int*)smem;
  const int cnt = p.counts[tid];
  s_cnt[tid] = cnt;
  __syncthreads();
  int run = 0, nt = 0;
  for (int e = 0; e < tid; ++e) { const int c = s_cnt[e]; run += c; nt += (c + 127) >> 7; }
  p.offs[tid] = run;
  for (int m = 0; m * 128 < cnt; ++m) {
    p.tile_e[nt] = tid;
    p.tile_r0[nt] = run + m * 128;
    p.tile_nr[nt] = (cnt - m * 128) > 128 ? 128 : (cnt - m * 128);
    ++nt;
  }
  if (tid == 255) {
    p.offs[256] = run + cnt;
    for (int m = 0; m < 128; ++m) {
      p.tile_e[nt] = 256;
      p.tile_r0[nt] = 131072 + m * 128;
      p.tile_nr[nt] = 128;
      ++nt;
    }
    p.ntiles[0] = nt;
  }
}
DI void phase14(const Params& p, int bid, int nblk) {
  for (int i = bid * 256 + TIDX(); i < NSLOT; i += nblk * 256) {
    if (i < 131072) {
      const int e = p.eidx[i];
      const int slot = p.offs[e] + p.erank[i];
      p.slot_tok[slot] = i >> 3;
      p.slot_wt[slot] = p.ewt[i];
      p.tok_slot[i] = slot;
    } else {
      p.slot_tok[i] = i - 131072;
      p.slot_wt[i] = 1.f;
    }
  }
}

struct AGather {
  const u16* h; const int* slot_tok; int r0, nr;
  DI const u16* operator()(int r) const { return r < nr ? h + (long)slot_tok[r0 + r] * 1024 : nullptr; }
};
struct BGateUp {
  const float* wg; long udiff; long ldb; int n0;
  DI const float* operator()(int c4) const {
    const int wn = c4 >> 6, ntl = (c4 >> 5) & 1, j = c4 & 31;
    return wg + (long)ntl * udiff + n0 + wn * 32 + j;
  }
};
struct EpiH {
  u16* H; int r0, nr, n0;
  DI void operator()(f32x16 (&acc)[2][2], int wm, int wn, int lane) const {
#pragma unroll
    for (int mt = 0; mt < 2; ++mt)
#pragma unroll
      for (int i = 0; i < 16; ++i) {
        const int r = wm * 64 + mt * 32 + (i & 3) + 8 * (i >> 2) + 4 * (lane >> 5);
        if (r < nr) {
          const float g = acc[mt][0][i], u = acc[mt][1][i];
          H[(long)(r0 + r) * 256 + n0 + wn * 32 + (lane & 31)] = f2bf(siluf(g) * u);
        }
      }
  }
};
DI void phase15(const Params& p, char* smem, int bid, int nblk) {
  const int ntl = p.ntiles[0];
  for (int item = bid; item < ntl * 4; item += nblk) {
    const int ti = item >> 2, nt_ = item & 3;
    const int e = p.tile_e[ti], r0 = p.tile_r0[ti], nr = p.tile_nr[ti];
    AGather af{p.h, p.slot_tok, r0, nr};
    const float* wg = e < 256 ? p.w_eg + (long)e * 1024 * 256 : p.w_sg;
    const float* wu = e < 256 ? p.w_eu + (long)e * 1024 * 256 : p.w_su;
    BGateUp bf{wg, (long)(wu - wg), 256, nt_ * 64};
    EpiH ef{p.H, r0, nr, nt_ * 64};
    gemm_tile(smem, 16, 64, af, bf, ef);
  }
}
struct EpiYexp {
  u16* Y; const float* slot_wt; int r0, nr, n0;
  DI void operator()(f32x16 (&acc)[2][2], int wm, int wn, int lane) const {
    EPI_FOR {
      const int r = EPI_R;
      if (r < nr) Y[(long)(r0 + r) * 1024 + n0 + EPI_C] = f2bf(acc[mt][nt][i] * slot_wt[r0 + r]);
    }
  }
};
DI void phase16(const Params& p, char* smem, int bid, int nblk) {
  const int ntl = p.ntiles[0];
  for (int item = bid; item < ntl * 8; item += nblk) {
    const int ti = item >> 3, nt_ = item & 7;
    const int e = p.tile_e[ti], r0 = p.tile_r0[ti], nr = p.tile_nr[ti];
    ARows af{p.H + (long)r0 * 256, 256, nr};
    const float* wd = e < 256 ? p.w_ed + (long)e * 256 * 1024 : p.w_sd;
    BMat bf{wd + nt_ * 128, 1024, 128};
    EpiYexp ef{p.Y, p.slot_wt, r0, nr, nt_ * 128};
    gemm_tile(smem, 4, 64, af, bf, ef);
  }
}
DI void phase17(const Params& p, int bid, int nblk) {
  const int tid = TIDX(), lane = tid & 63, wid = tid >> 6;
  for (int row = bid * 4 + wid; row < NTOK; row += nblk * 4) {
    const int b = row >> 13;
    const float* modb = p.mod + b * 6144;
    int slots[9];
#pragma unroll
    for (int k = 0; k < 8; ++k) slots[k] = p.tok_slot[row * 8 + k];
    slots[8] = 131072 + row;
    float yv[16];
#pragma unroll
    for (int j = 0; j < 16; ++j) yv[j] = 0.f;
#pragma unroll
    for (int k = 0; k < 9; ++k) {
#pragma unroll
      for (int i = 0; i < 4; ++i) {
        const uint2 u = *(const uint2*)(p.Y + (long)slots[k] * 1024 + i * 256 + lane * 4);
        yv[i * 4 + 0] += lo16(u.x); yv[i * 4 + 1] += hi16(u.x); yv[i * 4 + 2] += lo16(u.y); yv[i * 4 + 3] += hi16(u.y);
      }
    }
    float ss = 0.f;
#pragma unroll
    for (int j = 0; j < 16; ++j) ss += yv[j] * yv[j];
    ss = wave_sum(ss);
    const float r = rsqrtf(ss * (1.f / 1024.f) + 1e-6f);
#pragma unroll
    for (int i = 0; i < 4; ++i) {
      const int col = i * 256 + lane * 4;
      const float4 xx = *(const float4*)(p.x1 + (long)row * 1024 + col);
      float o[4] = {xx.x, xx.y, xx.z, xx.w};
#pragma unroll
      for (int j = 0; j < 4; ++j) o[j] += modb[5120 + col + j] * (yv[i * 4 + j] * r * p.g_post_ffn[col + j]);
      *(float4*)(p.out + (long)row * 1024 + col) = make_float4(o[0], o[1], o[2], o[3]);
    }
  }
}

__global__ void __launch_bounds__(256, 2) mega(Params p) {
  cg::grid_group grid = cg::this_grid();
  __shared__ __attribute__((aligned(16))) char smem[LDS_BYTES];
  const int bid = blockIdx.x, nblk = gridDim.x;
#if !defined(ONLY) || ONLY==0
  if (p.phase_lo <= 0 && 0 < p.phase_hi) {
    phase0(p, bid, nblk);
    if (0 + 1 < p.phase_hi) grid.sync();
  }
#endif
#if !defined(ONLY) || ONLY==1
  if (p.phase_lo <= 1 && 1 < p.phase_hi) {
    phase1(p, smem, bid, nblk);
    if (1 + 1 < p.phase_hi) grid.sync();
  }
#endif
#if !defined(ONLY) || ONLY==2
  if (p.phase_lo <= 2 && 2 < p.phase_hi) {
    phase2(p, smem, bid, nblk);
    if (2 + 1 < p.phase_hi) grid.sync();
  }
#endif
#if !defined(ONLY) || ONLY==3
  if (p.phase_lo <= 3 && 3 < p.phase_hi) {
    phase3(p, smem, bid, nblk);
    if (3 + 1 < p.phase_hi) grid.sync();
  }
#endif
#if !defined(ONLY) || ONLY==4
  if (p.phase_lo <= 4 && 4 < p.phase_hi) {
    phase4(p, smem, bid, nblk);
    if (4 + 1 < p.phase_hi) grid.sync();
  }
#endif
#if !defined(ONLY) || ONLY==5
  if (p.phase_lo <= 5 && 5 < p.phase_hi) {
    phase5(p, smem, bid, nblk);
    if (5 + 1 < p.phase_hi) grid.sync();
  }
#endif
#if !defined(ONLY) || ONLY==6
  if (p.phase_lo <= 6 && 6 < p.phase_hi) {
    phase6(p, smem, bid, nblk);
    if (6 + 1 < p.phase_hi) grid.sync();
  }
#endif
#if !defined(ONLY) || ONLY==7
  if (p.phase_lo <= 7 && 7 < p.phase_hi) {
    phase7(p, smem, bid, nblk);
    if (7 + 1 < p.phase_hi) grid.sync();
  }
#endif
#if !defined(ONLY) || ONLY==8
  if (p.phase_lo <= 8 && 8 < p.phase_hi) {
    phase8(p, smem, bid, nblk);
    if (8 + 1 < p.phase_hi) grid.sync();
  }
#endif
#if !defined(ONLY) || ONLY==9
  if (p.phase_lo <= 9 && 9 < p.phase_hi) {
    phase9(p, smem, bid, nblk);
    if (9 + 1 < p.phase_hi) grid.sync();
  }
#endif
#if !defined(ONLY) || ONLY==10
  if (p.phase_lo <= 10 && 10 < p.phase_hi) {
    phase10(p, bid, nblk);
    if (10 + 1 < p.phase_hi) grid.sync();
  }
#endif
#if !defined(ONLY) || ONLY==11
  if (p.phase_lo <= 11 && 11 < p.phase_hi) {
    phase11(p, smem, bid, nblk);
    if (11 + 1 < p.phase_hi) grid.sync();
  }
#endif
#if !defined(ONLY) || ONLY==12
  if (p.phase_lo <= 12 && 12 < p.phase_hi) {
    phase12(p, bid, nblk);
    if (12 + 1 < p.phase_hi) grid.sync();
  }
#endif
#if !defined(ONLY) || ONLY==13
  if (p.phase_lo <= 13 && 13 < p.phase_hi) {
    phase13(p, smem, bid);
    if (13 + 1 < p.phase_hi) grid.sync();
  }
#endif
#if !defined(ONLY) || ONLY==14
  if (p.phase_lo <= 14 && 14 < p.phase_hi) {
    phase14(p, bid, nblk);
    if (14 + 1 < p.phase_hi) grid.sync();
  }
#endif
#if !defined(ONLY) || ONLY==15
  if (p.phase_lo <= 15 && 15 < p.phase_hi) {
    phase15(p, smem, bid, nblk);
    if (15 + 1 < p.phase_hi) grid.sync();
  }
#endif
#if !defined(ONLY) || ONLY==16
  if (p.phase_lo <= 16 && 16 < p.phase_hi) {
    phase16(p, smem, bid, nblk);
    if (16 + 1 < p.phase_hi) grid.sync();
  }
#endif
#if !defined(ONLY) || ONLY==17
  if (p.phase_lo <= 17 && 17 < p.phase_hi) {
    phase17(p, bid, nblk);
    if (17 + 1 < p.phase_hi) grid.sync();
  }
#endif
}

extern "C" void kernel_launch(void* const* d_in, const int* in_sizes, int n_in, void* d_out, int out_size, void* d_ws, size_t ws_size,
                              hipStream_t stream) {
  static int grid_blocks = 0;
  if (!grid_blocks) {
    int dev = 0, cus = 0, per_cu = 0;
    (void)hipGetDevice(&dev);
    (void)hipDeviceGetAttribute(&cus, hipDeviceAttributeMultiprocessorCount, dev);
    (void)hipOccupancyMaxActiveBlocksPerMultiprocessor(&per_cu, mega, 256, 0);
    if (per_cu > 2) per_cu = 2;
    if (per_cu < 1) per_cu = 1;
    grid_blocks = cus * per_cu;
  }
  Params p{};
  const float* const* in = (const float* const*)d_in;
  p.x = in[0]; p.c = in[1]; p.w_ada = in[2]; p.b_ada = in[3]; p.g_pre_mix = in[4]; p.g_post_mix = in[5]; p.g_pre_ffn = in[6]; p.g_post_ffn = in[7];
  p.w_in = in[8]; p.rel_bias = in[9]; p.cmp_pe = in[10]; p.cmp_w1 = in[11]; p.cmp_b1 = in[12]; p.cmp_w2 = in[13]; p.dsa_kv_norm = in[14];
  p.dsa_w_uk = in[15]; p.dsa_w_uv = in[16]; p.w_bn = in[17]; p.w_bd = in[18]; p.w_out = in[19]; p.router_w = in[20]; p.router_bias = in[21];
  p.w_eg = in[22]; p.w_eu = in[23]; p.w_ed = in[24]; p.w_sg = in[25]; p.w_su = in[26]; p.w_sd = in[27];
  p.out = (float*)d_out;
  char* ws = (char*)d_ws;
  size_t off = 0;
  auto alloc = [&](size_t bytes) { char* r = ws + off; off += (bytes + 255) & ~(size_t)255; return r; };
  p.modp = (float*)alloc(16 * 2 * 6144 * 4);
  p.mod = (float*)alloc(2 * 6144 * 4);
  p.pe_part = (float*)alloc(16 * 256 * 4);
  p.w_ukT = (float*)alloc(8 * 64 * 128 * 4);
  p.counts = (int*)alloc(256 * 4);
  p.offs = (int*)alloc(257 * 4);
  p.tile_e = (int*)alloc(1536 * 4);
  p.tile_r0 = (int*)alloc(1536 * 4);
  p.tile_nr = (int*)alloc(1536 * 4);
  p.ntiles = (int*)alloc(4);
  p.h = (u16*)alloc((size_t)NTOK * 1024 * 2);
  p.proj = (u16*)alloc((size_t)NTOK * LDP * 2);
  p.widx = (float*)alloc((size_t)NTOK * 8 * 4);
  p.zc = (u16*)alloc((size_t)2 * 2048 * 128 * 2);
  p.kc = (u16*)alloc((size_t)4 * 512 * 64 * 2);
  p.vc = (u16*)alloc((size_t)4 * 512 * 64 * 2);
  p.qlat = (u16*)alloc((size_t)NTOK * 1024 * 2);
  p.ckv = (u16*)alloc((size_t)NTOK * 128 * 2);
  p.selk = (int*)alloc((size_t)NTOK * 256 * 4);
  p.onsa = (u16*)alloc((size_t)NTOK * 512 * 2);
  p.olat = (u16*)alloc((size_t)NTOK * 1024 * 2);
  p.odsa = (u16*)alloc((size_t)NTOK * 512 * 2);
  p.y = p.qlat;
  p.z = p.olat;
  p.eidx = (int*)alloc((size_t)NTOK * 8 * 4);
  p.ewt = (float*)alloc((size_t)NTOK * 8 * 4);
  p.erank = (int*)alloc((size_t)NTOK * 8 * 4);
  p.slot_tok = (int*)alloc((size_t)NSLOT * 4);
  p.slot_wt = (float*)alloc((size_t)NSLOT * 4);
  p.tok_slot = (int*)alloc((size_t)NTOK * 8 * 4);
  char* big = alloc((size_t)2 * T * T * 4);
  p.scores = (float*)big;
  {
    size_t o2 = 0;
    auto sub = [&](size_t bytes) { char* r = big + o2; o2 += (bytes + 255) & ~(size_t)255; return r; };
    p.H = (u16*)sub((size_t)NSLOT * 256 * 2);
    p.Y = (u16*)sub((size_t)NSLOT * 1024 * 2);
    p.x1 = (float*)sub((size_t)NTOK * 1024 * 4);
    p.logits = (float*)sub((size_t)NTOK * 256 * 4);
  }
  if (off > ws_size) fprintf(stderr, "workspace too small: need %zu have %zu\n", off, ws_size);
  p.phase_lo = 0;
  p.phase_hi = 18;
  void* args[] = {&p};
  hipError_t e = hipLaunchCooperativeKernel((void*)mega, dim3(grid_blocks), dim3(256), args, 0, stream);
  if (e != hipSuccess) fprintf(stderr, "coop launch failed: %s (grid %d)\n", hipGetErrorString(e), grid_blocks);
}
```

```cpp
#include <hip/hip_runtime.h>
#include <hip/hip_cooperative_groups.h>
#include <cstdio>
namespace cg = cooperative_groups;

#define DI __device__ __forceinline__
typedef unsigned short u16;
typedef unsigned long long u64;
using bf16x8 = __attribute__((ext_vector_type(8))) short;
using f32x16 = __attribute__((ext_vector_type(16))) float;

constexpr int T = 8192;
constexpr int NTOK = 16384;
constexpr int LDP = 4576;
constexpr int C_QN = 0, C_KV = 512, C_GN = 1280, C_QD = 1304, C_CKV = 1816, C_QI = 1944, C_KI = 2456, C_WI = 2520, C_GM = 2528;
constexpr int NSLOT = 131072 + 16384;
constexpr int LDS_BYTES = 40960;

__device__ const unsigned char BUCKET[128] = {
  0, 1, 2, 3, 4, 5, 6, 7, 8, 9, 10, 11, 12, 13, 14, 15, 16, 16, 16, 17, 17, 18, 18, 18, 19, 19, 19, 20, 20, 20, 20, 21,
  21, 21, 21, 22, 22, 22, 22, 22, 23, 23, 23, 23, 23, 23, 24, 24, 24, 24, 24, 24, 25, 25, 25, 25, 25, 25, 25, 26, 26, 26, 26, 26,
  26, 26, 26, 27, 27, 27, 27, 27, 27, 27, 27, 27, 27, 28, 28, 28, 28, 28, 28, 28, 28, 28, 28, 29, 29, 29, 29, 29, 29, 29, 29, 29,
  29, 29, 29, 30, 30, 30, 30, 30, 30, 30, 30, 30, 30, 30, 30, 30, 30, 31, 31, 31, 31, 31, 31, 31, 31, 31, 31, 31, 31, 31, 31, 31};

struct Params {
  const float *x, *c, *w_ada, *b_ada, *g_pre_mix, *g_post_mix, *g_pre_ffn, *g_post_ffn, *w_in, *rel_bias;
  const float *cmp_pe, *cmp_w1, *cmp_b1, *cmp_w2, *dsa_kv_norm, *dsa_w_uk, *dsa_w_uv, *w_bn, *w_bd, *w_out;
  const float *router_w, *router_bias, *w_eg, *w_eu, *w_ed, *w_sg, *w_su, *w_sd;
  float* out;
  float* modp;
  float* mod;
  float* pe_part;
  float* w_ukT;
  u16* h;
  u16* proj;
  float* widx;
  u16* zc;
  u16* kc;
  u16* vc;
  u16* qlat;
  u16* ckv;
  float* scores;
  int* selk;
  u16* onsa;
  u16* olat;
  u16* odsa;
  u16* y;
  u16* z;
  float* x1;
  float* logits;
  int* eidx;
  float* ewt;
  int* erank;
  int* counts;
  int* offs;
  int* tile_e;
  int* tile_r0;
  int* tile_nr;
  int* ntiles;
  int* slot_tok;
  float* slot_wt;
  int* tok_slot;
  u16* H;
  u16* Y;
  int phase_lo, phase_hi;
};

DI float bf2f(u16 v) { return __uint_as_float(((unsigned)v) << 16); }
DI u16 f2bf(float x) { unsigned u = __float_as_uint(x); u += 0x7fffu + ((u >> 16) & 1u); return (u16)(u >> 16); }
DI unsigned pack2(float a, float b) { return (unsigned)f2bf(a) | ((unsigned)f2bf(b) << 16); }
DI float lo16(unsigned u) { return __uint_as_float(u << 16); }
DI float hi16(unsigned u) { return __uint_as_float(u & 0xffff0000u); }
DI float wave_sum(float v) { for (int o = 32; o; o >>= 1) v += __shfl_xor(v, o); return v; }
DI float wave_max(float v) { for (int o = 32; o; o >>= 1) v = fmaxf(v, __shfl_xor(v, o)); return v; }
DI float rdlane(float v, int l) { return __int_as_float(__builtin_amdgcn_readlane(__float_as_int(v), l)); }
DI int rdlane_i(int v, int l) { return __builtin_amdgcn_readlane(v, l); }
DI int TIDX() { int t = threadIdx.x; asm volatile("" : "+v"(t)); return t; }
DI void cbar(const void* p) { asm volatile("" ::"v"(p) : "memory"); }
DI void wave_sync() { asm volatile("s_waitcnt lgkmcnt(0)" ::: "memory"); __builtin_amdgcn_wave_barrier(); }
DI float sigmoidf(float x) { return 1.f / (1.f + __expf(-x)); }
DI float siluf(float x) { return x / (1.f + __expf(-x)); }
DI float gelu_tanh(float x) { float u = 0.7978845608028654f * (x + 0.044715f * x * x * x); float e = __expf(2.f * u); float th = 1.f - 2.f / (e + 1.f); return 0.5f * x * (1.f + th); }

template <class AF, class BF, class EF>
DI void gemm_tile(char* smem, int nk, long a_kstep, const AF& af, const BF& bf, const EF& ef) {
  asm volatile("" ::: "memory");
  u16* As = (u16*)smem;
  u16* Bs = As + 128 * 72;
  const int tid = TIDX(), lane = tid & 63, wid = __builtin_amdgcn_readfirstlane(tid >> 6), wm = wid >> 1, wn = wid & 1;
  const int arow = tid >> 1, ahalf = tid & 1;
  const u16* ap = af(arow);
  if (ap) ap += ahalf * 32;
  const int bkq = lane & 7, bnq = wid * 8 + (lane >> 3);
  const float* bp = bf(bnq * 4);
  const long ldb = bf.ldb;
  if (bp) bp += (long)(bkq * 4) * ldb;
  uint4 ra[4];
  float rb[8][4];
  f32x16 acc[2][2];
#pragma unroll
  for (int a = 0; a < 2; ++a)
#pragma unroll
    for (int b = 0; b < 2; ++b)
#pragma unroll
      for (int i = 0; i < 16; ++i) acc[a][b][i] = 0.f;

#define GEMM_LOAD(KT)                                                                     \
  {                                                                                       \
    if (ap) {                                                                             \
      const uint4* pa_ = (const uint4*)(ap + (long)(KT) * a_kstep);                       \
      _Pragma("unroll") for (int i = 0; i < 4; ++i) ra[i] = pa_[i];                       \
    } else {                                                                              \
      _Pragma("unroll") for (int i = 0; i < 4; ++i) ra[i] = make_uint4(0, 0, 0, 0);       \
    }                                                                                     \
    if (bp) {                                                                             \
      const float* pb_ = bp + (long)(KT) * 64 * ldb;                                      \
      _Pragma("unroll") for (int q = 0; q < 2; ++q)                                       \
      _Pragma("unroll") for (int r = 0; r < 4; ++r) {                                     \
        float4 v_ = *(const float4*)(pb_ + (long)(q * 32 + r) * ldb);                     \
        rb[q * 4 + r][0] = v_.x; rb[q * 4 + r][1] = v_.y; rb[q * 4 + r][2] = v_.z; rb[q * 4 + r][3] = v_.w; \
      }                                                                                   \
    } else {                                                                              \
      _Pragma("unroll") for (int q = 0; q < 8; ++q)                                       \
      _Pragma("unroll") for (int r = 0; r < 4; ++r) rb[q][r] = 0.f;                       \
    }                                                                                     \
  }

  GEMM_LOAD(0)
  for (int kt = 0; kt < nk; ++kt) {
    __syncthreads();
#pragma unroll
    for (int i = 0; i < 4; ++i) *(uint4*)&As[arow * 72 + ahalf * 32 + i * 8] = ra[i];
#pragma unroll
    for (int q = 0; q < 2; ++q)
#pragma unroll
      for (int i = 0; i < 4; ++i) {
        uint2 w;
        w.x = pack2(rb[q * 4 + 0][i], rb[q * 4 + 1][i]);
        w.y = pack2(rb[q * 4 + 2][i], rb[q * 4 + 3][i]);
        *(uint2*)&Bs[(bnq * 4 + i) * 72 + q * 32 + bkq * 4] = w;
      }
    __syncthreads();
    if (kt + 1 < nk) GEMM_LOAD(kt + 1)
#pragma unroll
    for (int ks = 0; ks < 4; ++ks) {
      bf16x8 a[2], b[2];
#pragma unroll
      for (int mt = 0; mt < 2; ++mt) a[mt] = *(const bf16x8*)&As[(wm * 64 + mt * 32 + (lane & 31)) * 72 + ks * 16 + (lane >> 5) * 8];
#pragma unroll
      for (int nt = 0; nt < 2; ++nt) b[nt] = *(const bf16x8*)&Bs[(wn * 64 + nt * 32 + (lane & 31)) * 72 + ks * 16 + (lane >> 5) * 8];
#pragma unroll
      for (int mt = 0; mt < 2; ++mt)
#pragma unroll
        for (int nt = 0; nt < 2; ++nt) acc[mt][nt] = __builtin_amdgcn_mfma_f32_32x32x16_bf16(a[mt], b[nt], acc[mt][nt], 0, 0, 0);
    }
  }
#undef GEMM_LOAD
  ef(acc, wm, wn, lane);
}

#define EPI_FOR                                                   \
  _Pragma("unroll") for (int mt = 0; mt < 2; ++mt)                \
  _Pragma("unroll") for (int nt = 0; nt < 2; ++nt)                \
  _Pragma("unroll") for (int i = 0; i < 16; ++i)
#define EPI_R (wm * 64 + mt * 32 + (i & 3) + 8 * (i >> 2) + 4 * (lane >> 5))
#define EPI_C (wn * 64 + nt * 32 + (lane & 31))

struct ARows { const u16* base; long ld; int nrows; DI const u16* operator()(int r) const { return r < nrows ? base + (long)r * ld : nullptr; } };
struct BMat { const float* base; long ldb; int ncols; DI const float* operator()(int c4) const { return c4 < ncols ? base + c4 : nullptr; } };

DI void phase0(const Params& p, int bid, int nblk) {
  const int tid = TIDX();
  for (int item = bid; item < 384 + 256 + 16 + 1; item += nblk) {
    if (item < 384) {
      const int cc = item % 24, kc = item / 24;
      const int col = cc * 256 + tid;
      float a0 = 0.f, a1 = 0.f;
      for (int k = kc * 64; k < kc * 64 + 64; ++k) {
        const float w = p.w_ada[(long)k * 6144 + col];
        a0 += siluf(p.c[k]) * w;
        a1 += siluf(p.c[1024 + k]) * w;
      }
      p.modp[(kc * 2 + 0) * 6144 + col] = a0;
      p.modp[(kc * 2 + 1) * 6144 + col] = a1;
    } else if (item < 640) {
      const int idx = (item - 384) * 256 + tid;
      const int c = idx & 127, d = (idx >> 7) & 63, h = idx >> 13;
      p.w_ukT[idx] = p.dsa_w_uk[c * 512 + h * 64 + d];
    } else if (item < 656) {
      const int part = item - 640;
      const int slot = tid >> 7, kk = tid & 127;
      float a = 0.f;
      for (int ld = part * 128; ld < part * 128 + 128; ++ld) a += p.cmp_pe[slot * 2048 + ld] * p.cmp_w1[((long)slot * 2048 + ld) * 128 + kk];
      p.pe_part[part * 256 + tid] = a;
    } else {
      p.counts[tid] = 0;
    }
  }
}

DI void phase1(const Params& p, char* smem, int bid, int nblk) {
  const int tid = TIDX(), lane = tid & 63, wid = __builtin_amdgcn_readfirstlane(tid >> 6);
  float* modl = (float*)smem;
  for (int idx = tid; idx < 4096; idx += 256) {
    const int b = idx >> 11, n = idx & 2047;
    float v = p.b_ada[n];
    for (int kc = 0; kc < 16; ++kc) v += p.modp[(kc * 2 + b) * 6144 + n];
    modl[idx] = v;
  }
  if (bid < 48) {
    const int idx = bid * 256 + tid;
    const int b = idx / 6144, n = idx % 6144;
    float v = p.b_ada[n];
    for (int kc = 0; kc < 16; ++kc) v += p.modp[(kc * 2 + b) * 6144 + n];
    p.mod[idx] = v;
  }
  __syncthreads();
  for (int row = bid * 4 + wid; row < NTOK; row += nblk * 4) {
    const int b = row >> 13;
    const float* xr = p.x + (long)row * 1024;
    float4 v[4];
    float ss = 0.f;
#pragma unroll
    for (int i = 0; i < 4; ++i) {
      v[i] = *(const float4*)(xr + i * 256 + lane * 4);
      ss += v[i].x * v[i].x + v[i].y * v[i].y + v[i].z * v[i].z + v[i].w * v[i].w;
    }
    ss = wave_sum(ss);
    const float r = rsqrtf(ss * (1.f / 1024.f) + 1e-6f);
#pragma unroll
    for (int i = 0; i < 4; ++i) {
      const int col = i * 256 + lane * 4;
      const float4 g = *(const float4*)(p.g_pre_mix + col);
      const float* sh = modl + b * 2048 + col;
      const float* sc = modl + b * 2048 + 1024 + col;
      const float o0 = v[i].x * r * g.x * (1.f + sc[0]) + sh[0];
      const float o1 = v[i].y * r * g.y * (1.f + sc[1]) + sh[1];
      const float o2 = v[i].z * r * g.z * (1.f + sc[2]) + sh[2];
      const float o3 = v[i].w * r * g.w * (1.f + sc[3]) + sh[3];
      uint2 w;
      w.x = pack2(o0, o1);
      w.y = pack2(o2, o3);
      *(uint2*)(p.h + (long)row * 1024 + col) = w;
    }
  }
}

struct EpiProj {
  u16* proj; float* widx; int m0, n0;
  DI void operator()(f32x16 (&acc)[2][2], int wm, int wn, int lane) const {
    EPI_FOR {
      const int r = m0 + EPI_R, c = n0 + EPI_C;
      if (c < LDP) {
        float v = acc[mt][nt][i];
        if (c < C_KV) v *= 0.125f;
        else if (c < C_GN) {}
        else if (c < C_QD) v = sigmoidf(v);
        else if (c < C_QI) {}
        else if (c < C_KI) v *= 0.125f;
        else if (c < C_WI) {}
        else if (c < C_GM) { v *= 0.35355339059327373f; widx[(long)r * 8 + (c - C_WI)] = v; }
        else v = sigmoidf(v);
        proj[(long)r * LDP + c] = f2bf(v);
      }
    }
  }
};
DI void phase2(const Params& p, char* smem, int bid, int nblk) {
  for (int item = bid; item < 128 * 36; item += nblk) {
    const int mt_ = item / 36, nt_ = item % 36;
    ARows af{p.h + (long)mt_ * 128 * 1024, 1024, 128};
    BMat bf{p.w_in + nt_ * 128, LDP, LDP - nt_ * 128};
    EpiProj ef{p.proj, p.widx, mt_ * 128, nt_ * 128};
    gemm_tile(smem, 16, 64, af, bf, ef);
  }
}

struct ACmp {
  const u16* proj; int slot, m0;
  DI const u16* operator()(int r) const {
    const int R = m0 + r, bg = R >> 9, n = R & 511, b = bg >> 1, g = bg & 1;
    if (n >= 511) return nullptr;
    return proj + ((long)b * T + 16 * n) * LDP + C_KV + slot * 128 + g * 64;
  }
};
struct EpiCmp1 {
  u16* zc; const float* b1; const float* pe_part; int slot, m0;
  DI void operator()(f32x16 (&acc)[2][2], int wm, int wn, int lane) const {
#pragma unroll
    for (int nt = 0; nt < 2; ++nt) {
      const int c = EPI_C;
      float bias = b1[slot * 128 + c];
      for (int q = 0; q < 16; ++q) bias += pe_part[q * 256 + slot * 128 + c];
#pragma unroll
      for (int mt = 0; mt < 2; ++mt)
#pragma unroll
        for (int i = 0; i < 16; ++i) {
          const int R = m0 + EPI_R;
          zc[((long)slot * 2048 + R) * 128 + c] = f2bf(gelu_tanh(acc[mt][nt][i] + bias));
        }
    }
  }
};
struct EpiQlat {
  u16* qlat; int h, m0;
  DI void operator()(f32x16 (&acc)[2][2], int wm, int wn, int lane) const {
    EPI_FOR {
      const int r = m0 + EPI_R, c = EPI_C;
      qlat[((long)r * 8 + h) * 128 + c] = f2bf(acc[mt][nt][i] * 0.125f);
    }
  }
};
DI void phase3(const Params& p, char* smem, int bid, int nblk) {
  const int tid = TIDX(), lane = tid & 63, wid = __builtin_amdgcn_readfirstlane(tid >> 6);
  for (int item = bid; item < 32 + 1024 + 512; item += nblk) {
    if (item < 32) {
      const int slot = item >> 4, mt_ = item & 15;
      ACmp af{p.proj, slot, mt_ * 128};
      BMat bf{p.cmp_w1 + (long)slot * 2048 * 128, 128, 128};
      EpiCmp1 ef{p.zc, p.cmp_b1, p.pe_part, slot, mt_ * 128};
      gemm_tile(smem, 32, LDP, af, bf, ef);
    } else if (item < 1056) {
      const int it = item - 32, h = it & 7, mt_ = it >> 3;
      ARows af{p.proj + (long)mt_ * 128 * LDP + C_QD + h * 64, LDP, 128};
      BMat bf{p.w_ukT + h * 64 * 128, 128, 128};
      EpiQlat ef{p.qlat, h, mt_ * 128};
      gemm_tile(smem, 1, 64, af, bf, ef);
    } else {
      const int it = item - 1056;
      for (int q = 0; q < 8; ++q) {
        const int row = it * 32 + wid * 8 + q;
        const unsigned u = *(const unsigned*)(p.proj + (long)row * LDP + C_CKV + lane * 2);
        const float a = lo16(u), b = hi16(u);
        const float ss = wave_sum(a * a + b * b);
        const float r = rsqrtf(ss * (1.f / 128.f) + 1e-6f);
        *(unsigned*)(p.ckv + (long)row * 128 + lane * 2) = pack2(a * r * p.dsa_kv_norm[lane * 2], b * r * p.dsa_kv_norm[lane * 2 + 1]);
      }
    }
  }
}

struct EpiCmp2 {
  u16* dst; int m0;
  DI void operator()(f32x16 (&acc)[2][2], int wm, int wn, int lane) const {
    EPI_FOR {
      const int R = m0 + EPI_R, c = EPI_C;
      if (c < 64) dst[(long)R * 64 + c] = f2bf(acc[mt][nt][i]);
    }
  }
};
DI void indexer_item(const Params& p, char* smem, int item) {
  const int tid = TIDX(), lane = tid & 63, wid = __builtin_amdgcn_readfirstlane(tid >> 6);
  int b = 0, rem = item;
  if (rem >= 2080) { b = 1; rem -= 2080; }
  int qt = (int)((sqrtf(8.f * rem + 1.f) - 1.f) * 0.5f);
  while ((qt + 1) * (qt + 2) / 2 <= rem) ++qt;
  while (qt * (qt + 1) / 2 > rem) --qt;
  const int kt = rem - qt * (qt + 1) / 2;
  const int t0 = qt * 128 + (wid >> 1) * 64, s0 = kt * 128 + (wid & 1) * 64;
  if (s0 > t0 + 63) return;
  float* wl = (float*)smem + wid * 512;
  const float* wsrc = p.widx + ((long)b * T + t0) * 8;
#pragma unroll
  for (int i = 0; i < 8; ++i) wl[i * 64 + lane] = wsrc[i * 64 + lane];
  wave_sync();
  const u16* projb = p.proj + (long)b * T * LDP;
  const int r31 = lane & 31, hf = lane >> 5;
  bf16x8 bfr[2][4];
#pragma unroll
  for (int nt = 0; nt < 2; ++nt)
#pragma unroll
    for (int ks = 0; ks < 4; ++ks) bfr[nt][ks] = *(const bf16x8*)(projb + (long)(s0 + nt * 32 + r31) * LDP + C_KI + ks * 16 + hf * 8);
  f32x16 sum[2][2];
#pragma unroll
  for (int a = 0; a < 2; ++a)
#pragma unroll
    for (int c = 0; c < 2; ++c)
#pragma unroll
      for (int i = 0; i < 16; ++i) sum[a][c][i] = 0.f;
  for (int h = 0; h < 8; ++h) {
    bf16x8 afr[2][4];
#pragma unroll
    for (int mt = 0; mt < 2; ++mt)
#pragma unroll
      for (int ks = 0; ks < 4; ++ks) afr[mt][ks] = *(const bf16x8*)(projb + (long)(t0 + mt * 32 + r31) * LDP + C_QI + h * 64 + ks * 16 + hf * 8);
#pragma unroll
    for (int mt = 0; mt < 2; ++mt)
#pragma unroll
      for (int nt = 0; nt < 2; ++nt) {
        f32x16 acc;
#pragma unroll
        for (int i = 0; i < 16; ++i) acc[i] = 0.f;
#pragma unroll
        for (int ks = 0; ks < 4; ++ks) acc = __builtin_amdgcn_mfma_f32_32x32x16_bf16(afr[mt][ks], bfr[nt][ks], acc, 0, 0, 0);
#pragma unroll
        for (int i = 0; i < 16; ++i) {
          const int row = mt * 32 + (i & 3) + 8 * (i >> 2) + 4 * hf;
          sum[mt][nt][i] += wl[row * 8 + h] * fmaxf(acc[i], 0.f);
        }
      }
  }
#pragma unroll
  for (int mt = 0; mt < 2; ++mt)
#pragma unroll
    for (int nt = 0; nt < 2; ++nt)
#pragma unroll
      for (int i = 0; i < 16; ++i) {
        const int row = mt * 32 + (i & 3) + 8 * (i >> 2) + 4 * hf;
        p.scores[((long)b * T + t0 + row) * T + s0 + nt * 32 + r31] = sum[mt][nt][i];
      }
}
DI void phase4(const Params& p, char* smem, int bid, int nblk) {
  for (int item = bid; item < 32 + 4160; item += nblk) {
    __syncthreads();
    if (item < 32) {
      const int slot = item >> 4, mt_ = item & 15;
      ARows af{p.zc + ((long)slot * 2048 + mt_ * 128) * 128, 128, 128};
      BMat bf{p.cmp_w2 + slot * 128 * 64, 64, 64};
      EpiCmp2 ef{slot ? p.vc : p.kc, mt_ * 128};
      gemm_tile(smem, 2, 64, af, bf, ef);
    } else {
      indexer_item(p, smem, item - 32);
    }
  }
}

using f32x4 = __attribute__((ext_vector_type(4))) float;
#define MFMA16(a, b, c) __builtin_amdgcn_mfma_f32_16x16x32_bf16((a), (b), (c), 0, 0, 0)

template <int KSTRIDE>
DI void nsa_scores(f32x4 (&acc)[4], const u16* kbase, const bf16x8 (&qf)[2], int lane) {
  const int g = lane >> 4, r16 = lane & 15;
#pragma unroll
  for (int rt = 0; rt < 4; ++rt) {
    const u16* kp = kbase + (16 * rt + r16) * KSTRIDE + 8 * g;
    const bf16x8 a0 = *(const bf16x8*)kp;
    const bf16x8 a1 = *(const bf16x8*)(kp + 32);
    f32x4 c = {0.f, 0.f, 0.f, 0.f};
    c = MFMA16(a0, qf[0], c);
    c = MFMA16(a1, qf[1], c);
    acc[rt] = c;
  }
}
template <int VSTRIDE>
DI void nsa_pv(const f32x4 (&acc)[4], const u16* vbase, int lane, float (&o)[4]) {
#pragma unroll
  for (int rt = 0; rt < 4; ++rt) {
    asm volatile("" ::: "memory");
#pragma unroll
    for (int g2 = 0; g2 < 4; ++g2)
#pragma unroll
      for (int r = 0; r < 4; ++r) {
        const int kl = 16 * rt + 4 * g2 + r;
        const float v = bf2f(vbase[kl * VSTRIDE + lane]);
#pragma unroll
        for (int h = 0; h < 4; ++h) o[h] += rdlane(acc[rt][r], 16 * g2 + h) * v;
      }
  }
}
DI void attend_chunk(const u16* kbase, const u16* vbase, int key_lo, int key_hi, int dist0, const bf16x8 (&qf)[2], const float* btab,
                     int lane, float& m, float& l, float (&o)[4]) {
  const int g = lane >> 4, hh = lane & 3;
  f32x4 acc[4];
  nsa_scores<LDP>(acc, kbase, qf, lane);
  float mx = -1e30f;
#pragma unroll
  for (int rt = 0; rt < 4; ++rt)
#pragma unroll
    for (int r = 0; r < 4; ++r) {
      const int kl = 16 * rt + 4 * g + r;
      const bool valid = kl >= key_lo && kl <= key_hi;
      int dc = dist0 - kl;
      dc = dc < 0 ? 0 : (dc > 128 ? 128 : dc);
      const float sv = valid ? acc[rt][r] + btab[hh * 132 + dc] : -1e30f;
      acc[rt][r] = sv;
      mx = fmaxf(mx, sv);
    }
  mx = fmaxf(mx, __shfl_xor(mx, 16));
  mx = fmaxf(mx, __shfl_xor(mx, 32));
  const float mn = fmaxf(m, mx);
  const float alpha = __expf(m - mn);
  float ls = 0.f;
#pragma unroll
  for (int rt = 0; rt < 4; ++rt)
#pragma unroll
    for (int r = 0; r < 4; ++r) {
      const float pv = acc[rt][r] > -1e29f ? __expf(acc[rt][r] - mn) : 0.f;
      acc[rt][r] = pv;
      ls += pv;
    }
  ls += __shfl_xor(ls, 16);
  ls += __shfl_xor(ls, 32);
  l = l * alpha + ls;
  m = mn;
#pragma unroll
  for (int h = 0; h < 4; ++h) o[h] *= rdlane(alpha, h);
  nsa_pv<LDP>(acc, vbase, lane, o);
}

DI void nsa_query(const Params& p, float* imps, const float* btab, int b, int g, int t, int lane) {
  const long row = (long)b * T + t;
  const u16* prow = p.proj + row * LDP;
  const u16* projb = p.proj + (long)b * T * LDP;
  const int bg = b * 2 + g;
  const int lg = lane >> 4, r16 = lane & 15;
  bf16x8 qf[2];
#pragma unroll
  for (int ks = 0; ks < 2; ++ks) {
    bf16x8 z = {0, 0, 0, 0, 0, 0, 0, 0};
    if (r16 < 4) z = *(const bf16x8*)(prow + C_QN + (g * 4 + r16) * 64 + ks * 32 + lg * 8);
    qf[ks] = z;
  }
  float gate[4][3];
#pragma unroll
  for (int h = 0; h < 4; ++h)
#pragma unroll
    for (int br = 0; br < 3; ++br) gate[h][br] = bf2f(prow[C_GN + (g * 4 + h) * 3 + br]);
  float oacc[4] = {0.f, 0.f, 0.f, 0.f};
  const int cur = t >> 6;
  const int ncv = (t >= 31) ? ((t - 31) >> 4) + 1 : 0;
  wave_sync();
  imps[lane] = 0.f;
  imps[lane + 64] = 0.f;
  if (lane == 0) imps[128] = 0.f;
  wave_sync();
  if (ncv > 0) {
    const u16* kcb = p.kc + (long)bg * 512 * 64;
    const u16* vcb = p.vc + (long)bg * 512 * 64;
    const int hh = lane & 3;
    float m = -1e30f, l = 0.f;
    for (int i = 0; i * 64 < ncv; ++i) {
      const int key_hi = (ncv - 1 - i * 64) > 63 ? 63 : (ncv - 1 - i * 64);
      f32x4 acc[4];
      nsa_scores<64>(acc, kcb + (long)i * 64 * 64, qf, lane);
      const int dist0 = t - 31 - 16 * (i * 64);
      float mx = -1e30f;
#pragma unroll
      for (int rt = 0; rt < 4; ++rt)
#pragma unroll
        for (int r = 0; r < 4; ++r) {
          const int kl = 16 * rt + 4 * lg + r;
          int dc = dist0 - 16 * kl;
          dc = dc < 0 ? 0 : (dc > 128 ? 128 : dc);
          const float sv = (kl <= key_hi) ? acc[rt][r] + btab[hh * 132 + dc] : -1e30f;
          acc[rt][r] = sv;
          mx = fmaxf(mx, sv);
        }
      mx = fmaxf(mx, __shfl_xor(mx, 16));
      mx = fmaxf(mx, __shfl_xor(mx, 32));
      const float mn = fmaxf(m, mx);
      float ls = 0.f;
#pragma unroll
      for (int rt = 0; rt < 4; ++rt)
#pragma unroll
        for (int r = 0; r < 4; ++r) ls += acc[rt][r] > -1e29f ? __expf(acc[rt][r] - mn) : 0.f;
      ls += __shfl_xor(ls, 16);
      ls += __shfl_xor(ls, 32);
      l = l * __expf(m - mn) + ls;
      m = mn;
    }
    const float invl = 1.f / fmaxf(l, 1e-30f);
    float oc[4] = {0.f, 0.f, 0.f, 0.f};
    for (int i = 0; i * 64 < ncv; ++i) {
      const int key_hi = (ncv - 1 - i * 64) > 63 ? 63 : (ncv - 1 - i * 64);
      f32x4 acc[4];
      nsa_scores<64>(acc, kcb + (long)i * 64 * 64, qf, lane);
      const int dist0 = t - 31 - 16 * (i * 64);
      float part[4], spill[4];
#pragma unroll
      for (int rt = 0; rt < 4; ++rt) {
#pragma unroll
        for (int r = 0; r < 4; ++r) {
          const int kl = 16 * rt + 4 * lg + r;
          int dc = dist0 - 16 * kl;
          dc = dc < 0 ? 0 : (dc > 128 ? 128 : dc);
          acc[rt][r] = (kl <= key_hi) ? __expf(acc[rt][r] + btab[hh * 132 + dc] - m) * invl : 0.f;
        }
        float pa = acc[rt][0] + acc[rt][1] + acc[rt][2] + 0.5f * acc[rt][3];
        float sp = 0.5f * acc[rt][3];
        pa += __shfl_xor(pa, 1); pa += __shfl_xor(pa, 2);
        sp += __shfl_xor(sp, 1); sp += __shfl_xor(sp, 2);
        part[rt] = pa; spill[rt] = sp;
      }
      if (r16 == 0) {
#pragma unroll
        for (int rt = 0; rt < 4; ++rt) imps[16 * i + 4 * rt + lg] += part[rt];
      }
      wave_sync();
      if (r16 == 0) {
#pragma unroll
        for (int rt = 0; rt < 4; ++rt) imps[16 * i + 4 * rt + lg + 1] += spill[rt];
      }
      wave_sync();
      nsa_pv<64>(acc, vcb + (long)i * 64 * 64, lane, oc);
    }
#pragma unroll
    for (int h = 0; h < 4; ++h) oacc[h] = gate[h][0] * oc[h];
  }
  wave_sync();
  const float imp_lo = imps[lane], imp_hi = imps[lane + 64];
  bool sel_lo, sel_hi;
  if (cur <= 15) {
    sel_lo = lane <= cur;
    sel_hi = false;
  } else {
    const int jl = lane, jh = lane + 64;
    float c0 = (jl >= 1 && jl <= cur - 2) ? imp_lo : -1.f;
    float c1 = (jh <= cur - 2) ? imp_hi : -1.f;
    sel_lo = (jl == 0) || (jl == cur) || (jl == cur - 1);
    sel_hi = (jh == cur) || (jh == cur - 1);
    for (int r = 0; r < 13; ++r) {
      float bv; int bj;
      if (c0 >= c1) { bv = c0; bj = jl; } else { bv = c1; bj = jh; }
#pragma unroll
      for (int o = 32; o; o >>= 1) {
        const float ov = __shfl_xor(bv, o);
        const int oj = __shfl_xor(bj, o);
        if (ov > bv || (ov == bv && oj < bj)) { bv = ov; bj = oj; }
      }
      if (bj == jl) { sel_lo = true; c0 = -1.f; }
      if (bj == jh) { sel_hi = true; c1 = -1.f; }
    }
  }
  const u64 mask0 = __ballot(sel_lo), mask1 = __ballot(sel_hi);
  {
    float m = -1e30f, l = 0.f, o[4] = {0.f, 0.f, 0.f, 0.f};
    const int kcol = C_KV + 2 * 128 + g * 64, vcol = C_KV + 3 * 128 + g * 64;
    for (int half = 0; half < 2; ++half) {
      for (u64 mk = half ? mask1 : mask0; mk; mk &= mk - 1) {
        const int j = half * 64 + __builtin_ctzll(mk);
        if (j <= cur) {
          const int pos0 = 64 * j;
          const int key_hi = (t - pos0) > 63 ? 63 : (t - pos0);
          attend_chunk(projb + (long)pos0 * LDP + kcol, projb + (long)pos0 * LDP + vcol, 0, key_hi, t - pos0, qf, btab, lane, m, l, o);
        }
      }
    }
    const float invl = 1.f / fmaxf(l, 1e-30f);
#pragma unroll
    for (int h = 0; h < 4; ++h) oacc[h] += gate[h][1] * o[h] * rdlane(invl, h);
  }
  {
    float m = -1e30f, l = 0.f, o[4] = {0.f, 0.f, 0.f, 0.f};
    const int kcol = C_KV + 4 * 128 + g * 64, vcol = C_KV + 5 * 128 + g * 64;
    const int wlo = t - 511 < 0 ? 0 : t - 511;
    for (int jw = wlo >> 6; jw <= cur; ++jw) {
      const int pos0 = 64 * jw;
      const int key_lo = wlo - pos0 < 0 ? 0 : wlo - pos0;
      const int key_hi = (t - pos0) > 63 ? 63 : (t - pos0);
      attend_chunk(projb + (long)pos0 * LDP + kcol, projb + (long)pos0 * LDP + vcol, key_lo, key_hi, t - pos0, qf, btab, lane, m, l, o);
    }
    const float invl = 1.f / fmaxf(l, 1e-30f);
#pragma unroll
    for (int h = 0; h < 4; ++h) oacc[h] += gate[h][2] * o[h] * rdlane(invl, h);
  }
#pragma unroll
  for (int h = 0; h < 4; ++h) p.onsa[row * 512 + (g * 4 + h) * 64 + lane] = f2bf(oacc[h]);
}

DI void nsa_item(const Params& p, char* smem, int item) {
  const int tid = TIDX(), lane = tid & 63, wid = __builtin_amdgcn_readfirstlane(tid >> 6);
  const int chunk = item & 255, g = (item >> 8) & 1, b = item >> 9;
  const int t0 = chunk * 32;
  float* btab = (float*)smem;
  float* imps = (float*)(smem + 4096) + wid * 160;
  for (int idx = tid; idx < 4 * 129; idx += 256) {
    const int h = idx / 129, d = idx % 129;
    const int bk = d < 128 ? BUCKET[d] : 31;
    btab[h * 132 + d] = p.rel_bias[bk * 16 + g * 4 + h];
  }
  __syncthreads();
  for (int q = 0; q < 8; ++q) nsa_query(p, imps, btab, b, g, t0 + wid * 8 + q, lane);
}

DI unsigned f2ord(float v) { const unsigned u = __float_as_uint(v); return (u & 0x80000000u) ? ~u : (u | 0x80000000u); }

DI void topk_row(const Params& p, int b, int t, int lane) {
  const long row = (long)b * T + t;
  int* dst = p.selk + row * 256;
  if (t < 256) {
#pragma unroll
    for (int i = 0; i < 4; ++i) { const int s = i * 64 + lane; dst[s] = (s <= t) ? s : -1; }
    return;
  }
  const float* srow = p.scores + row * T;
  const int ngrp = (t >> 10) + 1;
  unsigned u[128];
  int ln = lane;
  asm volatile("" : "+v"(ln));
#pragma unroll
  for (int gq = 0; gq < 8; ++gq) {
    if (gq < ngrp) {
#pragma unroll
      for (int j = 0; j < 16; ++j) {
        const int s = (gq * 16 + j) * 64 + ln;
        const float v = srow[s < t ? s : t];
        u[gq * 16 + j] = (s <= t) ? f2ord(v) : 0u;
      }
    } else {
#pragma unroll
      for (int j = 0; j < 16; ++j) u[gq * 16 + j] = 0u;
    }
  }
  unsigned thr = 0u;
  for (int bit = 31; bit >= 0; --bit) {
    const unsigned cand = thr | (1u << bit);
    int cnt = 0;
#pragma unroll
    for (int gq = 0; gq < 8; ++gq) {
      if (gq < ngrp) {
#pragma unroll
        for (int j = 0; j < 16; ++j) cnt += __popcll(__ballot(u[gq * 16 + j] >= cand));
      }
    }
    if (cnt >= 256) thr = cand;
    if (cnt == 256) break;
  }
  int ngt = 0;
#pragma unroll
  for (int gq = 0; gq < 8; ++gq) {
    if (gq < ngrp) {
#pragma unroll
      for (int j = 0; j < 16; ++j) ngt += __popcll(__ballot(u[gq * 16 + j] > thr));
    }
  }
  int base_gt = 0, base_eq = 0;
  const int need_eq = 256 - ngt;
  int ln2 = lane;
  asm volatile("" : "+v"(ln2));
#pragma unroll
  for (int gq = 0; gq < 8; ++gq) {
    if (gq < ngrp) {
#pragma unroll
      for (int j = 0; j < 16; ++j) {
        const int s = (gq * 16 + j) * 64 + ln2;
        const unsigned uv = u[gq * 16 + j];
        const bool gt = uv > thr, eq = uv == thr;
        const u64 mg = __ballot(gt), me = __ballot(eq);
        const int pg = __builtin_amdgcn_mbcnt_hi((unsigned)(mg >> 32), __builtin_amdgcn_mbcnt_lo((unsigned)mg, 0));
        const int pe = __builtin_amdgcn_mbcnt_hi((unsigned)(me >> 32), __builtin_amdgcn_mbcnt_lo((unsigned)me, 0));
        if (gt) dst[base_gt + pg] = s;
        if (eq && (base_eq + pe) < need_eq) dst[ngt + base_eq + pe] = s;
        base_gt += __popcll(mg);
        base_eq += __popcll(me);
      }
    }
  }
}

DI void phase5(const Params& p, char* smem, int bid, int nblk) {
  for (int item = bid; item < 1024; item += nblk) {
    __syncthreads();
    const int it = 1023 - item;
    const int chunk = it >> 2, bgi = it & 3;
    nsa_item(p, smem, (bgi << 8) | chunk);
  }
  {
    const int tid = TIDX(), lane = tid & 63, wid = __builtin_amdgcn_readfirstlane(tid >> 6);
    for (int item = bid; item < 2048; item += nblk) {
      const int it = 2047 - item;
      const int b = it & 1, tb = it >> 1;
#pragma unroll 1
      for (int q = 0; q < 2; ++q) {
        asm volatile("" ::: "memory");
        topk_row(p, b, tb * 8 + wid * 2 + q, lane);
      }
    }
  }
}

DI void dsa_query(const Params& p, const float* btab, int b, int t, int lane) {
  const long row = (long)b * T + t;
  const int lg = lane >> 4, r16 = lane & 15, hh = lane & 7;
  bf16x8 qf[4];
#pragma unroll
  for (int ks = 0; ks < 4; ++ks) {
    bf16x8 z = {0, 0, 0, 0, 0, 0, 0, 0};
    if (r16 < 8) z = *(const bf16x8*)(p.qlat + (row * 8 + r16) * 128 + ks * 32 + lg * 8);
    qf[ks] = z;
  }
  const u16* ckvb = p.ckv + (long)b * T * 128;
  const int nvalid = (t + 1) < 256 ? (t + 1) : 256;
  float m = -1e30f, l = 0.f, o0[8], o1[8];
#pragma unroll
  for (int h = 0; h < 8; ++h) { o0[h] = 0.f; o1[h] = 0.f; }
  for (int i = 0; i * 64 < nvalid; ++i) {
    const int nval = (nvalid - i * 64) > 64 ? 64 : (nvalid - i * 64);
    int kidx = p.selk[row * 256 + i * 64 + lane];
    if (lane >= nval || kidx < 0 || kidx > t) kidx = t;
    f32x4 acc[4];
#pragma unroll
    for (int rt = 0; rt < 4; ++rt) {
      const int kk = __shfl(kidx, 16 * rt + r16);
      const u16* kp = ckvb + (long)kk * 128 + 8 * lg;
      f32x4 c = {0.f, 0.f, 0.f, 0.f};
#pragma unroll
      for (int ks = 0; ks < 4; ++ks) c = MFMA16(*(const bf16x8*)(kp + 32 * ks), qf[ks], c);
      acc[rt] = c;
    }
    float mx = -1e30f;
#pragma unroll
    for (int rt = 0; rt < 4; ++rt)
#pragma unroll
      for (int r = 0; r < 4; ++r) {
        const int pl = 16 * rt + 4 * lg + r;
        const int kk = __shfl(kidx, pl);
        int dc = t - kk;
        dc = dc < 0 ? 0 : (dc > 128 ? 128 : dc);
        const float sv = (pl < nval) ? acc[rt][r] + btab[hh * 132 + dc] : -1e30f;
        acc[rt][r] = sv;
        mx = fmaxf(mx, sv);
      }
    mx = fmaxf(mx, __shfl_xor(mx, 16));
    mx = fmaxf(mx, __shfl_xor(mx, 32));
    const float mn = fmaxf(m, mx);
    const float alpha = __expf(m - mn);
    float ls = 0.f;
#pragma unroll
    for (int rt = 0; rt < 4; ++rt)
#pragma unroll
      for (int r = 0; r < 4; ++r) {
        const float pv = acc[rt][r] > -1e29f ? __expf(acc[rt][r] - mn) : 0.f;
        acc[rt][r] = pv;
        ls += pv;
      }
    ls += __shfl_xor(ls, 16);
    ls += __shfl_xor(ls, 32);
    l = l * alpha + ls;
    m = mn;
#pragma unroll
    for (int h = 0; h < 8; ++h) { const float a = rdlane(alpha, h); o0[h] *= a; o1[h] *= a; }
#pragma unroll
    for (int rt = 0; rt < 4; ++rt) {
      asm volatile("" ::: "memory");
#pragma unroll
      for (int g2 = 0; g2 < 4; ++g2)
#pragma unroll
        for (int r = 0; r < 4; ++r) {
          const int pl = 16 * rt + 4 * g2 + r;
          const int kL = rdlane_i(kidx, pl);
          const unsigned u = *(const unsigned*)(ckvb + (long)kL * 128 + lane * 2);
          const float v0 = lo16(u), v1 = hi16(u);
#pragma unroll
          for (int h = 0; h < 8; ++h) {
            const float pw = rdlane(acc[rt][r], 16 * g2 + h);
            o0[h] += pw * v0;
            o1[h] += pw * v1;
          }
        }
    }
  }
  const float invl = 1.f / fmaxf(l, 1e-30f);
#pragma unroll
  for (int h = 0; h < 8; ++h) {
    const float iv = rdlane(invl, h);
    *(unsigned*)(p.olat + row * 1024 + h * 128 + lane * 2) = pack2(o0[h] * iv, o1[h] * iv);
  }
}
DI void phase6(const Params& p, char* smem, int bid, int nblk) {
  const int tid = TIDX(), lane = tid & 63, wid = __builtin_amdgcn_readfirstlane(tid >> 6);
  float* btab = (float*)smem;
  for (int idx = tid; idx < 8 * 129; idx += 256) {
    const int h = idx / 129, d = idx % 129;
    const int bk = d < 128 ? BUCKET[d] : 31;
    btab[h * 132 + d] = p.rel_bias[bk * 16 + 8 + h];
  }
  __syncthreads();
  for (int item = bid; item < 2048; item += nblk) {
    const int it = 2047 - item;
    const int b = it & 1, tb = it >> 1;
    for (int q = 0; q < 2; ++q) dsa_query(p, btab, b, tb * 8 + wid * 2 + q, lane);
  }
}

struct EpiOdsa {
  u16* odsa; int h, m0;
  DI void operator()(f32x16 (&acc)[2][2], int wm, int wn, int lane) const {
    EPI_FOR {
      const int r = m0 + EPI_R, c = EPI_C;
      if (c < 64) odsa[(long)r * 512 + h * 64 + c] = f2bf(acc[mt][nt][i]);
    }
  }
};
DI void phase7(const Params& p, char* smem, int bid, int nblk) {
  for (int item = bid; item < 1024; item += nblk) {
    const int h = item & 7, mt_ = item >> 3;
    ARows af{p.olat + (long)mt_ * 128 * 1024 + h * 128, 1024, 128};
    BMat bf{p.dsa_w_uv + h * 64, 512, 64};
    EpiOdsa ef{p.odsa, h, mt_ * 128};
    gemm_tile(smem, 2, 64, af, bf, ef);
  }
}

struct EpiY {
  u16* y; const u16* proj; int m0, n0, second;
  DI void operator()(f32x16 (&acc)[2][2], int wm, int wn, int lane) const {
    EPI_FOR {
      const int r = m0 + EPI_R, c = n0 + EPI_C;
      const float g = bf2f(proj[(long)r * LDP + C_GM + second * 1024 + c]);
      float v = g * acc[mt][nt][i];
      if (second) v += bf2f(y[(long)r * 1024 + c]);
      y[(long)r * 1024 + c] = f2bf(v);
    }
  }
};
DI void phase8(const Params& p, char* smem, int bid, int nblk) {
  for (int item = bid; item < 1024; item += nblk) {
    const int nt_ = item & 7, mt_ = item >> 3;
    {
      ARows af{p.onsa + (long)mt_ * 128 * 512, 512, 128};
      BMat bf{p.w_bn + nt_ * 128, 1024, 128};
      EpiY ef{p.y, p.proj, mt_ * 128, nt_ * 128, 0};
      gemm_tile(smem, 8, 64, af, bf, ef);
    }
    {
      ARows af{p.odsa + (long)mt_ * 128 * 512, 512, 128};
      BMat bf{p.w_bd + nt_ * 128, 1024, 128};
      EpiY ef{p.y, p.proj, mt_ * 128, nt_ * 128, 1};
      gemm_tile(smem, 8, 64, af, bf, ef);
    }
  }
}
struct EpiStoreBf {
  u16* dst; long ld; int m0, n0;
  DI void operator()(f32x16 (&acc)[2][2], int wm, int wn, int lane) const {
    EPI_FOR { dst[(long)(m0 + EPI_R) * ld + n0 + EPI_C] = f2bf(acc[mt][nt][i]); }
  }
};
DI void phase9(const Params& p, char* smem, int bid, int nblk) {
  for (int item = bid; item < 1024; item += nblk) {
    const int nt_ = item & 7, mt_ = item >> 3;
    ARows af{p.y + (long)mt_ * 128 * 1024, 1024, 128};
    BMat bf{p.w_out + nt_ * 128, 1024, 128};
    EpiStoreBf ef{p.z, 1024, mt_ * 128, nt_ * 128};
    gemm_tile(smem, 16, 64, af, bf, ef);
  }
}

DI void phase10(const Params& p, int bid, int nblk) {
  const int tid = TIDX(), lane = tid & 63, wid = __builtin_amdgcn_readfirstlane(tid >> 6);
  for (int row = bid * 4 + wid; row < NTOK; row += nblk * 4) {
    const int b = row >> 13;
    const float* modb = p.mod + b * 6144;
    float zv[16], xv[16];
    float ss = 0.f;
#pragma unroll
    for (int i = 0; i < 4; ++i) {
      const int col = i * 256 + lane * 4;
      const uint2 u = *(const uint2*)(p.z + (long)row * 1024 + col);
      zv[i * 4 + 0] = lo16(u.x); zv[i * 4 + 1] = hi16(u.x); zv[i * 4 + 2] = lo16(u.y); zv[i * 4 + 3] = hi16(u.y);
      const float4 xx = *(const float4*)(p.x + (long)row * 1024 + col);
      xv[i * 4 + 0] = xx.x; xv[i * 4 + 1] = xx.y; xv[i * 4 + 2] = xx.z; xv[i * 4 + 3] = xx.w;
#pragma unroll
      for (int j = 0; j < 4; ++j) ss += zv[i * 4 + j] * zv[i * 4 + j];
    }
    ss = wave_sum(ss);
    const float r = rsqrtf(ss * (1.f / 1024.f) + 1e-6f);
    float ss2 = 0.f;
#pragma unroll
    for (int i = 0; i < 4; ++i)
#pragma unroll
      for (int j = 0; j < 4; ++j) {
        const int col = i * 256 + lane * 4 + j;
        const float v = xv[i * 4 + j] + modb[2048 + col] * (zv[i * 4 + j] * r * p.g_post_mix[col]);
        xv[i * 4 + j] = v;
        ss2 += v * v;
      }
    ss2 = wave_sum(ss2);
    const float r2 = rsqrtf(ss2 * (1.f / 1024.f) + 1e-6f);
#pragma unroll
    for (int i = 0; i < 4; ++i) {
      const int col = i * 256 + lane * 4;
      *(float4*)(p.x1 + (long)row * 1024 + col) = make_float4(xv[i * 4], xv[i * 4 + 1], xv[i * 4 + 2], xv[i * 4 + 3]);
      float hv[4];
#pragma unroll
      for (int j = 0; j < 4; ++j) hv[j] = xv[i * 4 + j] * r2 * p.g_pre_ffn[col + j] * (1.f + modb[4096 + col + j]) + modb[3072 + col + j];
      uint2 w;
      w.x = pack2(hv[0], hv[1]);
      w.y = pack2(hv[2], hv[3]);
      *(uint2*)(p.h + (long)row * 1024 + col) = w;
    }
  }
}

struct EpiStoreF32 {
  float* dst; long ld; int m0, n0;
  DI void operator()(f32x16 (&acc)[2][2], int wm, int wn, int lane) const {
    EPI_FOR { dst[(long)(m0 + EPI_R) * ld + n0 + EPI_C] = acc[mt][nt][i]; }
  }
};
DI void phase11(const Params& p, char* smem, int bid, int nblk) {
  for (int item = bid; item < 256; item += nblk) {
    const int nt_ = item & 1, mt_ = item >> 1;
    ARows af{p.h + (long)mt_ * 128 * 1024, 1024, 128};
    BMat bf{p.router_w + nt_ * 128, 256, 128};
    EpiStoreF32 ef{p.logits, 256, mt_ * 128, nt_ * 128};
    gemm_tile(smem, 16, 64, af, bf, ef);
  }
}
DI void phase12(const Params& p, int bid, int nblk) {
  const int tid = TIDX(), lane = tid & 63, wid = __builtin_amdgcn_readfirstlane(tid >> 6);
  for (int tok = bid * 4 + wid; tok < NTOK; tok += nblk * 4) {
    const float4 lg = *(const float4*)(p.logits + (long)tok * 256 + lane * 4);
    const float4 rbv = *(const float4*)(p.router_bias + lane * 4);
    float sg[4] = {sigmoidf(lg.x), sigmoidf(lg.y), sigmoidf(lg.z), sigmoidf(lg.w)};
    float sl[4] = {sg[0] + rbv.x, sg[1] + rbv.y, sg[2] + rbv.z, sg[3] + rbv.w};
    float t1 = fmaxf(sl[0], sl[1]), t2 = fminf(sl[0], sl[1]);
#pragma unroll
    for (int j = 2; j < 4; ++j) {
      const float v = sl[j];
      t2 = fmaxf(t2, fminf(t1, v));
      t1 = fmaxf(t1, v);
    }
#pragma unroll
    for (int o = 1; o < 8; o <<= 1) {
      const float a1 = __shfl_xor(t1, o), a2 = __shfl_xor(t2, o);
      const float n1 = fmaxf(t1, a1);
      const float n2 = fmaxf(fminf(t1, a1), fmaxf(t2, a2));
      t1 = n1; t2 = n2;
    }
    const float gscore = t1 + t2;
    const int grp = lane >> 3;
    int rank = 0;
#pragma unroll
    for (int g2 = 0; g2 < 8; ++g2) {
      const float og = __shfl(gscore, g2 * 8);
      rank += (og > gscore || (og == gscore && g2 < grp)) ? 1 : 0;
    }
    const bool gsel = rank < 4;
    float cv[4];
#pragma unroll
    for (int j = 0; j < 4; ++j) cv[j] = gsel ? sl[j] : -1e30f;
    int my_e = -1; float my_s = 0.f; float ssum = 0.f;
    for (int r = 0; r < 8; ++r) {
      float bv = cv[0]; int bj = 0;
#pragma unroll
      for (int j = 1; j < 4; ++j) if (cv[j] > bv) { bv = cv[j]; bj = j; }
      int be = lane * 4 + bj;
      float bs = bj == 0 ? sg[0] : (bj == 1 ? sg[1] : (bj == 2 ? sg[2] : sg[3]));
#pragma unroll
      for (int o = 32; o; o >>= 1) {
        const float ov = __shfl_xor(bv, o);
        const int oe = __shfl_xor(be, o);
        const float os = __shfl_xor(bs, o);
        if (ov > bv || (ov == bv && oe < be)) { bv = ov; be = oe; bs = os; }
      }
      if ((be >> 2) == lane) {
        const int j = be & 3;
        if (j == 0) cv[0] = -3e30f; else if (j == 1) cv[1] = -3e30f; else if (j == 2) cv[2] = -3e30f; else cv[3] = -3e30f;
      }
      if (lane == r) { my_e = be; my_s = bs; }
      ssum += bs;
    }
    if (lane < 8) {
      const float w = my_s / ssum * 2.5f;
      const int rk = atomicAdd(p.counts + my_e, 1);
      p.eidx[tok * 8 + lane] = my_e;
      p.ewt[tok * 8 + lane] = w;
      p.erank[tok * 8 + lane] = rk;
    }
  }
}
DI void phase13(const Params& p, char* smem, int bid) {
  if (bid != 0) return;
  const int tid = TIDX();
  int* s_cnt = (int*)smem;
  const int cnt = p.counts[tid];
  s_cnt[tid] = cnt;
  __syncthreads();
  int run = 0, nt = 0;
  for (int e = 0; e < tid; ++e) { const int c = s_cnt[e]; run += c; nt += (c + 127) >> 7; }
  p.offs[tid] = run;
  for (int m = 0; m * 128 < cnt; ++m) {
    p.tile_e[nt] = tid;
    p.tile_r0[nt] = run + m * 128;
    p.tile_nr[nt] = (cnt - m * 128) > 128 ? 128 : (cnt - m * 128);
    ++nt;
  }
  if (tid == 255) {
    p.offs[256] = run + cnt;
    for (int m = 0; m < 128; ++m) {
      p.tile_e[nt] = 256;
      p.tile_r0[nt] = 131072 + m * 128;
      p.tile_nr[nt] = 128;
      ++nt;
    }
    p.ntiles[0] = nt;
  }
}
DI void phase14(const Params& p, int bid, int nblk) {
  for (int i = bid * 256 + TIDX(); i < NSLOT; i += nblk * 256) {
    if (i < 131072) {
      const int e = p.eidx[i];
      const int slot = p.offs[e] + p.erank[i];
      p.slot_tok[slot] = i >> 3;
      p.slot_wt[slot] = p.ewt[i];
      p.tok_slot[i] = slot;
    } else {
      p.slot_tok[i] = i - 131072;
      p.slot_wt[i] = 1.f;
    }
  }
}

struct AGather {
  const u16* h; const int* slot_tok; int r0, nr;
  DI const u16* operator()(int r) const { return r < nr ? h + (long)slot_tok[r0 + r] * 1024 : nullptr; }
};
struct BGateUp {
  const float* wg; long udiff; long ldb; int n0;
  DI const float* operator()(int c4) const {
    const int wn = c4 >> 6, ntl = (c4 >> 5) & 1, j = c4 & 31;
    return wg + (long)ntl * udiff + n0 + wn * 32 + j;
  }
};
struct EpiH {
  u16* H; int r0, nr, n0;
  DI void operator()(f32x16 (&acc)[2][2], int wm, int wn, int lane) const {
#pragma unroll
    for (int mt = 0; mt < 2; ++mt)
#pragma unroll
      for (int i = 0; i < 16; ++i) {
        const int r = wm * 64 + mt * 32 + (i & 3) + 8 * (i >> 2) + 4 * (lane >> 5);
        if (r < nr) {
          const float g = acc[mt][0][i], u = acc[mt][1][i];
          H[(long)(r0 + r) * 256 + n0 + wn * 32 + (lane & 31)] = f2bf(siluf(g) * u);
        }
      }
  }
};
DI void phase15(const Params& p, char* smem, int bid, int nblk) {
  const int ntl = p.ntiles[0];
  for (int item = bid; item < ntl * 4; item += nblk) {
    const int ti = item >> 2, nt_ = item & 3;
    const int e = p.tile_e[ti], r0 = p.tile_r0[ti], nr = p.tile_nr[ti];
    AGather af{p.h, p.slot_tok, r0, nr};
    const float* wg = e < 256 ? p.w_eg + (long)e * 1024 * 256 : p.w_sg;
    const float* wu = e < 256 ? p.w_eu + (long)e * 1024 * 256 : p.w_su;
    BGateUp bf{wg, (long)(wu - wg), 256, nt_ * 64};
    EpiH ef{p.H, r0, nr, nt_ * 64};
    gemm_tile(smem, 16, 64, af, bf, ef);
  }
}
struct EpiYexp {
  u16* Y; const float* slot_wt; int r0, nr, n0;
  DI void operator()(f32x16 (&acc)[2][2], int wm, int wn, int lane) const {
    EPI_FOR {
      const int r = EPI_R;
      if (r < nr) Y[(long)(r0 + r) * 1024 + n0 + EPI_C] = f2bf(acc[mt][nt][i] * slot_wt[r0 + r]);
    }
  }
};
DI void phase16(const Params& p, char* smem, int bid, int nblk) {
  const int ntl = p.ntiles[0];
  for (int item = bid; item < ntl * 8; item += nblk) {
    const int ti = item >> 3, nt_ = item & 7;
    const int e = p.tile_e[ti], r0 = p.tile_r0[ti], nr = p.tile_nr[ti];
    ARows af{p.H + (long)r0 * 256, 256, nr};
    const float* wd = e < 256 ? p.w_ed + (long)e * 256 * 1024 : p.w_sd;
    BMat bf{wd + nt_ * 128, 1024, 128};
    EpiYexp ef{p.Y, p.slot_wt, r0, nr, nt_ * 128};
    gemm_tile(smem, 4, 64, af, bf, ef);
  }
}
DI void phase17(const Params& p, int bid, int nblk) {
  const int tid = TIDX(), lane = tid & 63, wid = __builtin_amdgcn_readfirstlane(tid >> 6);
  for (int row = bid * 4 + wid; row < NTOK; row += nblk * 4) {
    const int b = row >> 13;
    const float* modb = p.mod + b * 6144;
    int slots[9];
#pragma unroll
    for (int k = 0; k < 8; ++k) slots[k] = p.tok_slot[row * 8 + k];
    slots[8] = 131072 + row;
    float yv[16];
#pragma unroll
    for (int j = 0; j < 16; ++j) yv[j] = 0.f;
#pragma unroll
    for (int k = 0; k < 9; ++k) {
#pragma unroll
      for (int i = 0; i < 4; ++i) {
        const uint2 u = *(const uint2*)(p.Y + (long)slots[k] * 1024 + i * 256 + lane * 4);
        yv[i * 4 + 0] += lo16(u.x); yv[i * 4 + 1] += hi16(u.x); yv[i * 4 + 2] += lo16(u.y); yv[i * 4 + 3] += hi16(u.y);
      }
    }
    float ss = 0.f;
#pragma unroll
    for (int j = 0; j < 16; ++j) ss += yv[j] * yv[j];
    ss = wave_sum(ss);
    const float r = rsqrtf(ss * (1.f / 1024.f) + 1e-6f);
#pragma unroll
    for (int i = 0; i < 4; ++i) {
      const int col = i * 256 + lane * 4;
      const float4 xx = *(const float4*)(p.x1 + (long)row * 1024 + col);
      float o[4] = {xx.x, xx.y, xx.z, xx.w};
#pragma unroll
      for (int j = 0; j < 4; ++j) o[j] += modb[5120 + col + j] * (yv[i * 4 + j] * r * p.g_post_ffn[col + j]);
      *(float4*)(p.out + (long)row * 1024 + col) = make_float4(o[0], o[1], o[2], o[3]);
    }
  }
}

__global__ void __launch_bounds__(256, 2) mega(Params p) {
  cg::grid_group grid = cg::this_grid();
  __shared__ __attribute__((aligned(16))) char smem[LDS_BYTES];
  const int bid = blockIdx.x, nblk = gridDim.x;
#if !defined(ONLY) || ONLY==0
  if (p.phase_lo <= 0 && 0 < p.phase_hi) {
    phase0(p, bid, nblk);
    if (0 + 1 < p.phase_hi) grid.sync();
  }
#endif
#if !defined(ONLY) || ONLY==1
  if (p.phase_lo <= 1 && 1 < p.phase_hi) {
    phase1(p, smem, bid, nblk);
    if (1 + 1 < p.phase_hi) grid.sync();
  }
#endif
#if !defined(ONLY) || ONLY==2
  if (p.phase_lo <= 2 && 2 < p.phase_hi) {
    phase2(p, smem, bid, nblk);
    if (2 + 1 < p.phase_hi) grid.sync();
  }
#endif
#if !defined(ONLY) || ONLY==3
  if (p.phase_lo <= 3 && 3 < p.phase_hi) {
    phase3(p, smem, bid, nblk);
    if (3 + 1 < p.phase_hi) grid.sync();
  }
#endif
#if !defined(ONLY) || ONLY==4
  if (p.phase_lo <= 4 && 4 < p.phase_hi) {
    phase4(p, smem, bid, nblk);
    if (4 + 1 < p.phase_hi) grid.sync();
  }
#endif
#if !defined(ONLY) || ONLY==5
  if (p.phase_lo <= 5 && 5 < p.phase_hi) {
    phase5(p, smem, bid, nblk);
    if (5 + 1 < p.phase_hi) grid.sync();
  }
#endif
#if !defined(ONLY) || ONLY==6
  if (p.phase_lo <= 6 && 6 < p.phase_hi) {
    phase6(p, smem, bid, nblk);
    if (6 + 1 < p.phase_hi) grid.sync();
  }
#endif
#if !defined(ONLY) || ONLY==7
  if (p.phase_lo <= 7 && 7 < p.phase_hi) {
    phase7(p, smem, bid, nblk);
    if (7 + 1 < p.phase_hi) grid.sync();
  }
#endif
#if !defined(ONLY) || ONLY==8
  if (p.phase_lo <= 8 && 8 < p.phase_hi) {
    phase8(p, smem, bid, nblk);
    if (8 + 1 < p.phase_hi) grid.sync();
  }
#endif
#if !defined(ONLY) || ONLY==9
  if (p.phase_lo <= 9 && 9 < p.phase_hi) {
    phase9(p, smem, bid, nblk);
    if (9 + 1 < p.phase_hi) grid.sync();
  }
#endif
#if !defined(ONLY) || ONLY==10
  if (p.phase_lo <= 10 && 10 < p.phase_hi) {
    phase10(p, bid, nblk);
    if (10 + 1 < p.phase_hi) grid.sync();
  }
#endif
#if !defined(ONLY) || ONLY==11
  if (p.phase_lo <= 11 && 11 < p.phase_hi) {
    phase11(p, smem, bid, nblk);
    if (11 + 1 < p.phase_hi) grid.sync();
  }
#endif
#if !defined(ONLY) || ONLY==12
  if (p.phase_lo <= 12 && 12 < p.phase_hi) {
    phase12(p, bid, nblk);
    if (12 + 1 < p.phase_hi) grid.sync();
  }
#endif
#if !defined(ONLY) || ONLY==13
  if (p.phase_lo <= 13 && 13 < p.phase_hi) {
    phase13(p, smem, bid);
    if (13 + 1 < p.phase_hi) grid.sync();
  }
#endif
#if !defined(ONLY) || ONLY==14
  if (p.phase_lo <= 14 && 14 < p.phase_hi) {
    phase14(p, bid, nblk);
    if (14 + 1 < p.phase_hi) grid.sync();
  }
#endif
#if !defined(ONLY) || ONLY==15
  if (p.phase_lo <= 15 && 15 < p.phase_hi) {
    phase15(p, smem, bid, nblk);
    if (15 + 1 < p.phase_hi) grid.sync();
  }
#endif
#if !defined(ONLY) || ONLY==16
  if (p.phase_lo <= 16 && 16 < p.phase_hi) {
    phase16(p, smem, bid, nblk);
    if (16 + 1 < p.phase_hi) grid.sync();
  }
#endif
#if !defined(ONLY) || ONLY==17
  if (p.phase_lo <= 17 && 17 < p.phase_hi) {
    phase17(p, bid, nblk);
    if (17 + 1 < p.phase_hi) grid.sync();
  }
#endif
}

extern "C" void kernel_launch(void* const* d_in, const int* in_sizes, int n_in, void* d_out, int out_size, void* d_ws, size_t ws_size,
                              hipStream_t stream) {
  static int grid_blocks = 0;
  if (!grid_blocks) {
    int dev = 0, cus = 0, per_cu = 0;
    (void)hipGetDevice(&dev);
    (void)hipDeviceGetAttribute(&cus, hipDeviceAttributeMultiprocessorCount, dev);
    (void)hipOccupancyMaxActiveBlocksPerMultiprocessor(&per_cu, mega, 256, 0);
    if (per_cu > 2) per_cu = 2;
    if (per_cu < 1) per_cu = 1;
    grid_blocks = cus * per_cu;
  }
  Params p{};
  const float* const* in = (const float* const*)d_in;
  p.x = in[0]; p.c = in[1]; p.w_ada = in[2]; p.b_ada = in[3]; p.g_pre_mix = in[4]; p.g_post_mix = in[5]; p.g_pre_ffn = in[6]; p.g_post_ffn = in[7];
  p.w_in = in[8]; p.rel_bias = in[9]; p.cmp_pe = in[10]; p.cmp_w1 = in[11]; p.cmp_b1 = in[12]; p.cmp_w2 = in[13]; p.dsa_kv_norm = in[14];
  p.dsa_w_uk = in[15]; p.dsa_w_uv = in[16]; p.w_bn = in[17]; p.w_bd = in[18]; p.w_out = in[19]; p.router_w = in[20]; p.router_bias = in[21];
  p.w_eg = in[22]; p.w_eu = in[23]; p.w_ed = in[24]; p.w_sg = in[25]; p.w_su = in[26]; p.w_sd = in[27];
  p.out = (float*)d_out;
  char* ws = (char*)d_ws;
  size_t off = 0;
  auto alloc = [&](size_t bytes) { char* r = ws + off; off += (bytes + 255) & ~(size_t)255; return r; };
  p.modp = (float*)alloc(16 * 2 * 6144 * 4);
  p.mod = (float*)alloc(2 * 6144 * 4);
  p.pe_part = (float*)alloc(16 * 256 * 4);
  p.w_ukT = (float*)alloc(8 * 64 * 128 * 4);
  p.counts = (int*)alloc(256 * 4);
  p.offs = (int*)alloc(257 * 4);
  p.tile_e = (int*)alloc(1536 * 4);
  p.tile_r0 = (int*)alloc(1536 * 4);
  p.tile_nr = (int*)alloc(1536 * 4);
  p.ntiles = (int*)alloc(4);
  p.h = (u16*)alloc((size_t)NTOK * 1024 * 2);
  p.proj = (u16*)alloc((size_t)NTOK * LDP * 2);
  p.widx = (float*)alloc((size_t)NTOK * 8 * 4);
  p.zc = (u16*)alloc((size_t)2 * 2048 * 128 * 2);
  p.kc = (u16*)alloc((size_t)4 * 512 * 64 * 2);
  p.vc = (u16*)alloc((size_t)4 * 512 * 64 * 2);
  p.qlat = (u16*)alloc((size_t)NTOK * 1024 * 2);
  p.ckv = (u16*)alloc((size_t)NTOK * 128 * 2);
  p.selk = (int*)alloc((size_t)NTOK * 256 * 4);
  p.onsa = (u16*)alloc((size_t)NTOK * 512 * 2);
  p.olat = (u16*)alloc((size_t)NTOK * 1024 * 2);
  p.odsa = (u16*)alloc((size_t)NTOK * 512 * 2);
  p.y = p.qlat;
  p.z = p.olat;
  p.eidx = (int*)alloc((size_t)NTOK * 8 * 4);
  p.ewt = (float*)alloc((size_t)NTOK * 8 * 4);
  p.erank = (int*)alloc((size_t)NTOK * 8 * 4);
  p.slot_tok = (int*)alloc((size_t)NSLOT * 4);
  p.slot_wt = (float*)alloc((size_t)NSLOT * 4);
  p.tok_slot = (int*)alloc((size_t)NTOK * 8 * 4);
  char* big = alloc((size_t)2 * T * T * 4);
  p.scores = (float*)big;
  {
    size_t o2 = 0;
    auto sub = [&](size_t bytes) { char* r = big + o2; o2 += (bytes + 255) & ~(size_t)255; return r; };
    p.H = (u16*)sub((size_t)NSLOT * 256 * 2);
    p.Y = (u16*)sub((size_t)NSLOT * 1024 * 2);
    p.x1 = (float*)sub((size_t)NTOK * 1024 * 4);
    p.logits = (float*)sub((size_t)NTOK * 256 * 4);
  }
  if (off > ws_size) fprintf(stderr, "workspace too small: need %zu have %zu\n", off, ws_size);
  p.phase_lo = 0;
  p.phase_hi = 18;
  void* args[] = {&p};
  hipError_t e = hipLaunchCooperativeKernel((void*)mega, dim3(grid_blocks), dim3(256), args, 0, stream);
  if (e != hipSuccess) fprintf(stderr, "coop launch failed: %s (grid %d)\n", hipGetErrorString(e), grid_blocks);
}
```

```cpp
#include <hip/hip_runtime.h>
#include <hip/hip_cooperative_groups.h>
#include <cstdio>
namespace cg = cooperative_groups;

#define DI __device__ __forceinline__
typedef unsigned short u16;
typedef unsigned long long u64;
using bf16x8 = __attribute__((ext_vector_type(8))) short;
using f32x16 = __attribute__((ext_vector_type(16))) float;

constexpr int T = 8192;
constexpr int NTOK = 16384;
constexpr int LDP = 4576;
constexpr int C_QN = 0, C_KV = 512, C_GN = 1280, C_QD = 1304, C_CKV = 1816, C_QI = 1944, C_KI = 2456, C_WI = 2520, C_GM = 2528;
constexpr int NSLOT = 131072 + 16384;
constexpr int LDS_BYTES = 57344;
#ifndef REPEAT_MASK
#define REPEAT_MASK 0
#endif

__device__ const unsigned char BUCKET[128] = {
  0, 1, 2, 3, 4, 5, 6, 7, 8, 9, 10, 11, 12, 13, 14, 15, 16, 16, 16, 17, 17, 18, 18, 18, 19, 19, 19, 20, 20, 20, 20, 21,
  21, 21, 21, 22, 22, 22, 22, 22, 23, 23, 23, 23, 23, 23, 24, 24, 24, 24, 24, 24, 25, 25, 25, 25, 25, 25, 25, 26, 26, 26, 26, 26,
  26, 26, 26, 27, 27, 27, 27, 27, 27, 27, 27, 27, 27, 28, 28, 28, 28, 28, 28, 28, 28, 28, 28, 29, 29, 29, 29, 29, 29, 29, 29, 29,
  29, 29, 29, 30, 30, 30, 30, 30, 30, 30, 30, 30, 30, 30, 30, 30, 30, 31, 31, 31, 31, 31, 31, 31, 31, 31, 31, 31, 31, 31, 31, 31};

struct Params {
  const float *x, *c, *w_ada, *b_ada, *g_pre_mix, *g_post_mix, *g_pre_ffn, *g_post_ffn, *w_in, *rel_bias;
  const float *cmp_pe, *cmp_w1, *cmp_b1, *cmp_w2, *dsa_kv_norm, *dsa_w_uk, *dsa_w_uv, *w_bn, *w_bd, *w_out;
  const float *router_w, *router_bias, *w_eg, *w_eu, *w_ed, *w_sg, *w_su, *w_sd;
  float* out;
  float* modp;
  float* mod;
  float* pe_part;
  float* w_ukT;
  u16* h;
  u16* proj;
  float* widx;
  u16* zc;
  u16* kc;
  u16* vcT;
  u16* vts;
  u16* vtw;
  u16* qlat;
  u16* ckv;
  float* scores;
  int* selk;
  u16* onsa;
  u16* olat;
  u16* odsa;
  u16* y;
  u16* z;
  float* x1;
  float* logits;
  int* eidx;
  float* ewt;
  int* erank;
  int* counts;
  int* offs;
  int* tile_e;
  int* tile_r0;
  int* tile_nr;
  int* ntiles;
  int* slot_tok;
  float* slot_wt;
  int* tok_slot;
  u16* H;
  u16* Y;
  int phase_lo, phase_hi;
};

DI float bf2f(u16 v) { return __uint_as_float(((unsigned)v) << 16); }
typedef __bf16 bf16x2_t __attribute__((ext_vector_type(2)));
typedef float f32x2_t __attribute__((ext_vector_type(2)));
DI unsigned pack2(float a, float b) { f32x2_t v = {a, b}; return __builtin_bit_cast(unsigned, __builtin_convertvector(v, bf16x2_t)); }
DI u16 f2bf(float x) { return (u16)(pack2(x, x) & 0xffffu); }
DI float lo16(unsigned u) { return __uint_as_float(u << 16); }
DI float hi16(unsigned u) { return __uint_as_float(u & 0xffff0000u); }
DI float wave_sum(float v) { for (int o = 32; o; o >>= 1) v += __shfl_xor(v, o); return v; }
DI float wave_max(float v) { for (int o = 32; o; o >>= 1) v = fmaxf(v, __shfl_xor(v, o)); return v; }
DI float rdlane(float v, int l) { return __int_as_float(__builtin_amdgcn_readlane(__float_as_int(v), l)); }
DI int rdlane_i(int v, int l) { return __builtin_amdgcn_readlane(v, l); }
DI int TIDX() { int t = threadIdx.x; asm volatile("" : "+v"(t)); return t; }
DI void cbar(const void* p) { asm volatile("" ::"v"(p) : "memory"); }
DI void wave_sync() { asm volatile("s_waitcnt lgkmcnt(0)" ::: "memory"); __builtin_amdgcn_wave_barrier(); }
DI float sigmoidf(float x) { return 1.f / (1.f + __expf(-x)); }
DI float siluf(float x) { return x / (1.f + __expf(-x)); }
DI float gelu_tanh(float x) { float u = 0.7978845608028654f * (x + 0.044715f * x * x * x); float e = __expf(2.f * u); float th = 1.f - 2.f / (e + 1.f); return 0.5f * x * (1.f + th); }

template <class AF, class BF, class EF>
DI void gemm_tile(char* smem, int nk, long a_kstep, const AF& af, const BF& bf, const EF& ef) {
  asm volatile("" ::: "memory");
  u16* As = (u16*)smem;
  u16* Bs = As + 128 * 72;
  const int tid = TIDX(), lane = tid & 63, wid = __builtin_amdgcn_readfirstlane(tid >> 6), wm = wid >> 1, wn = wid & 1;
  const int arow = tid >> 1, ahalf = tid & 1;
  const u16* ap = af(arow);
  if (ap) ap += ahalf * 32;
  const int bkq = lane & 7, bnq = wid * 8 + (lane >> 3);
  const float* bp = bf(bnq * 4);
  const long ldb = bf.ldb;
  if (bp) bp += (long)(bkq * 4) * ldb;
  uint4 ra[4];
  float rb[8][4];
  f32x16 acc[2][2];
#pragma unroll
  for (int a = 0; a < 2; ++a)
#pragma unroll
    for (int b = 0; b < 2; ++b)
#pragma unroll
      for (int i = 0; i < 16; ++i) acc[a][b][i] = 0.f;

#define GEMM_LOAD(KT)                                                                     \
  {                                                                                       \
    if (ap) {                                                                             \
      const uint4* pa_ = (const uint4*)(ap + (long)(KT) * a_kstep);                       \
      _Pragma("unroll") for (int i = 0; i < 4; ++i) ra[i] = pa_[i];                       \
    } else {                                                                              \
      _Pragma("unroll") for (int i = 0; i < 4; ++i) ra[i] = make_uint4(0, 0, 0, 0);       \
    }                                                                                     \
    if (bp) {                                                                             \
      const float* pb_ = bp + (long)(KT) * 64 * ldb;                                      \
      _Pragma("unroll") for (int q = 0; q < 2; ++q)                                       \
      _Pragma("unroll") for (int r = 0; r < 4; ++r) {                                     \
        float4 v_ = *(const float4*)(pb_ + (long)(q * 32 + r) * ldb);                     \
        rb[q * 4 + r][0] = v_.x; rb[q * 4 + r][1] = v_.y; rb[q * 4 + r][2] = v_.z; rb[q * 4 + r][3] = v_.w; \
      }                                                                                   \
    } else {                                                                              \
      _Pragma("unroll") for (int q = 0; q < 8; ++q)                                       \
      _Pragma("unroll") for (int r = 0; r < 4; ++r) rb[q][r] = 0.f;                       \
    }                                                                                     \
  }

  GEMM_LOAD(0)
  for (int kt = 0; kt < nk; ++kt) {
    __syncthreads();
#pragma unroll
    for (int i = 0; i < 4; ++i) *(uint4*)&As[arow * 72 + ahalf * 32 + i * 8] = ra[i];
#pragma unroll
    for (int q = 0; q < 2; ++q)
#pragma unroll
      for (int i = 0; i < 4; ++i) {
        uint2 w;
        w.x = pack2(rb[q * 4 + 0][i], rb[q * 4 + 1][i]);
        w.y = pack2(rb[q * 4 + 2][i], rb[q * 4 + 3][i]);
        *(uint2*)&Bs[(bnq * 4 + i) * 72 + q * 32 + bkq * 4] = w;
      }
    __syncthreads();
    if (kt + 1 < nk) GEMM_LOAD(kt + 1)
#pragma unroll
    for (int ks = 0; ks < 4; ++ks) {
      bf16x8 a[2], b[2];
#pragma unroll
      for (int mt = 0; mt < 2; ++mt) a[mt] = *(const bf16x8*)&As[(wm * 64 + mt * 32 + (lane & 31)) * 72 + ks * 16 + (lane >> 5) * 8];
#pragma unroll
      for (int nt = 0; nt < 2; ++nt) b[nt] = *(const bf16x8*)&Bs[(wn * 64 + nt * 32 + (lane & 31)) * 72 + ks * 16 + (lane >> 5) * 8];
#pragma unroll
      for (int mt = 0; mt < 2; ++mt)
#pragma unroll
        for (int nt = 0; nt < 2; ++nt) acc[mt][nt] = __builtin_amdgcn_mfma_f32_32x32x16_bf16(a[mt], b[nt], acc[mt][nt], 0, 0, 0);
    }
  }
#undef GEMM_LOAD
  ef(acc, wm, wn, lane);
}

#define EPI_FOR                                                   \
  _Pragma("unroll") for (int mt = 0; mt < 2; ++mt)                \
  _Pragma("unroll") for (int nt = 0; nt < 2; ++nt)                \
  _Pragma("unroll") for (int i = 0; i < 16; ++i)
#define EPI_R (wm * 64 + mt * 32 + (i & 3) + 8 * (i >> 2) + 4 * (lane >> 5))
#define EPI_C (wn * 64 + nt * 32 + (lane & 31))

struct ARows { const u16* base; long ld; int nrows; DI const u16* operator()(int r) const { return r < nrows ? base + (long)r * ld : nullptr; } };
struct BMat { const float* base; long ldb; int ncols; DI const float* operator()(int c4) const { return c4 < ncols ? base + c4 : nullptr; } };

DI void phase0(const Params& p, int bid, int nblk) {
  const int tid = TIDX();
  for (int item = bid; item < 384 + 256 + 16 + 1; item += nblk) {
    if (item < 384) {
      const int cc = item % 24, kc = item / 24;
      const int col = cc * 256 + tid;
      float a0 = 0.f, a1 = 0.f;
      for (int k = kc * 64; k < kc * 64 + 64; ++k) {
        const float w = p.w_ada[(long)k * 6144 + col];
        a0 += siluf(p.c[k]) * w;
        a1 += siluf(p.c[1024 + k]) * w;
      }
      p.modp[(kc * 2 + 0) * 6144 + col] = a0;
      p.modp[(kc * 2 + 1) * 6144 + col] = a1;
    } else if (item < 640) {
      const int idx = (item - 384) * 256 + tid;
      const int c = idx & 127, d = (idx >> 7) & 63, h = idx >> 13;
      p.w_ukT[idx] = p.dsa_w_uk[c * 512 + h * 64 + d];
    } else if (item < 656) {
      const int part = item - 640;
      const int slot = tid >> 7, kk = tid & 127;
      float a = 0.f;
      for (int ld = part * 128; ld < part * 128 + 128; ++ld) a += p.cmp_pe[slot * 2048 + ld] * p.cmp_w1[((long)slot * 2048 + ld) * 128 + kk];
      p.pe_part[part * 256 + tid] = a;
    } else {
      p.counts[tid] = 0;
    }
  }
}

DI void phase1(const Params& p, char* smem, int bid, int nblk) {
  const int tid = TIDX(), lane = tid & 63, wid = __builtin_amdgcn_readfirstlane(tid >> 6);
  float* modl = (float*)smem;
  for (int idx = tid; idx < 4096; idx += 256) {
    const int b = idx >> 11, n = idx & 2047;
    float v = p.b_ada[n];
    for (int kc = 0; kc < 16; ++kc) v += p.modp[(kc * 2 + b) * 6144 + n];
    modl[idx] = v;
  }
  if (bid < 48) {
    const int idx = bid * 256 + tid;
    const int b = idx / 6144, n = idx % 6144;
    float v = p.b_ada[n];
    for (int kc = 0; kc < 16; ++kc) v += p.modp[(kc * 2 + b) * 6144 + n];
    p.mod[idx] = v;
  }
  __syncthreads();
  for (int row = bid * 4 + wid; row < NTOK; row += nblk * 4) {
    const int b = row >> 13;
    const float* xr = p.x + (long)row * 1024;
    float4 v[4];
    float ss = 0.f;
#pragma unroll
    for (int i = 0; i < 4; ++i) {
      v[i] = *(const float4*)(xr + i * 256 + lane * 4);
      ss += v[i].x * v[i].x + v[i].y * v[i].y + v[i].z * v[i].z + v[i].w * v[i].w;
    }
    ss = wave_sum(ss);
    const float r = rsqrtf(ss * (1.f / 1024.f) + 1e-6f);
#pragma unroll
    for (int i = 0; i < 4; ++i) {
      const int col = i * 256 + lane * 4;
      const float4 g = *(const float4*)(p.g_pre_mix + col);
      const float* sh = modl + b * 2048 + col;
      const float* sc = modl + b * 2048 + 1024 + col;
      const float o0 = v[i].x * r * g.x * (1.f + sc[0]) + sh[0];
      const float o1 = v[i].y * r * g.y * (1.f + sc[1]) + sh[1];
      const float o2 = v[i].z * r * g.z * (1.f + sc[2]) + sh[2];
      const float o3 = v[i].w * r * g.w * (1.f + sc[3]) + sh[3];
      uint2 w;
      w.x = pack2(o0, o1);
      w.y = pack2(o2, o3);
      *(uint2*)(p.h + (long)row * 1024 + col) = w;
    }
  }
}

struct EpiProj {
  u16* proj; float* widx; int m0, n0;
  DI void operator()(f32x16 (&acc)[2][2], int wm, int wn, int lane) const {
    EPI_FOR {
      const int r = m0 + EPI_R, c = n0 + EPI_C;
      if (c < LDP) {
        float v = acc[mt][nt][i];
        if (c < C_KV) v *= 0.125f;
        else if (c < C_GN) {}
        else if (c < C_QD) v = sigmoidf(v);
        else if (c < C_QI) {}
        else if (c < C_KI) v *= 0.125f;
        else if (c < C_WI) {}
        else if (c < C_GM) { v *= 0.35355339059327373f; widx[(long)r * 8 + (c - C_WI)] = v; }
        else v = sigmoidf(v);
        proj[(long)r * LDP + c] = f2bf(v);
      }
    }
  }
};
struct EpiProjVT {
  u16* vt; int m0;
  DI void operator()(f32x16 (&acc)[2][2], int wm, int wn, int lane) const {
#pragma unroll
    for (int mt = 0; mt < 2; ++mt)
#pragma unroll
      for (int nt = 0; nt < 2; ++nt) {
        const int cc = EPI_C;
#pragma unroll
        for (int q4 = 0; q4 < 4; ++q4) {
          const int r = m0 + wm * 64 + mt * 32 + 8 * q4 + 4 * (lane >> 5);
          const int b = r >> 13, t = r & 8191;
          uint2 w;
          w.x = pack2(acc[mt][nt][q4 * 4 + 0], acc[mt][nt][q4 * 4 + 1]);
          w.y = pack2(acc[mt][nt][q4 * 4 + 2], acc[mt][nt][q4 * 4 + 3]);
          *(uint2*)(vt + ((long)(b * 128 + cc)) * T + t) = w;
        }
      }
  }
};
DI void phase2(const Params& p, char* smem, int bid, int nblk) {
  for (int item = bid; item < 128 * 36; item += nblk) {
    const int mt_ = item / 36, nt_ = item % 36;
    ARows af{p.h + (long)mt_ * 128 * 1024, 1024, 128};
    BMat bf{p.w_in + nt_ * 128, LDP, LDP - nt_ * 128};
    if (nt_ == 7 || nt_ == 9) {
      EpiProjVT ef{nt_ == 7 ? p.vts : p.vtw, mt_ * 128};
      gemm_tile(smem, 16, 64, af, bf, ef);
    } else {
      EpiProj ef{p.proj, p.widx, mt_ * 128, nt_ * 128};
      gemm_tile(smem, 16, 64, af, bf, ef);
    }
  }
}

struct ACmp {
  const u16* proj; int slot, m0;
  DI const u16* operator()(int r) const {
    const int R = m0 + r, bg = R >> 9, n = R & 511, b = bg >> 1, g = bg & 1;
    if (n >= 511) return nullptr;
    return proj + ((long)b * T + 16 * n) * LDP + C_KV + slot * 128 + g * 64;
  }
};
struct EpiCmp1 {
  u16* zc; const float* b1; const float* pe_part; int slot, m0;
  DI void operator()(f32x16 (&acc)[2][2], int wm, int wn, int lane) const {
#pragma unroll
    for (int nt = 0; nt < 2; ++nt) {
      const int c = EPI_C;
      float bias = b1[slot * 128 + c];
      for (int q = 0; q < 16; ++q) bias += pe_part[q * 256 + slot * 128 + c];
#pragma unroll
      for (int mt = 0; mt < 2; ++mt)
#pragma unroll
        for (int i = 0; i < 16; ++i) {
          const int R = m0 + EPI_R;
          zc[((long)slot * 2048 + R) * 128 + c] = f2bf(gelu_tanh(acc[mt][nt][i] + bias));
        }
    }
  }
};
struct EpiQlat {
  u16* qlat; int h, m0;
  DI void operator()(f32x16 (&acc)[2][2], int wm, int wn, int lane) const {
    EPI_FOR {
      const int r = m0 + EPI_R, c = EPI_C;
      qlat[((long)r * 8 + h) * 128 + c] = f2bf(acc[mt][nt][i] * 0.125f);
    }
  }
};
DI void phase3(const Params& p, char* smem, int bid, int nblk) {
  const int tid = TIDX(), lane = tid & 63, wid = __builtin_amdgcn_readfirstlane(tid >> 6);
  for (int item = bid; item < 32 + 1024 + 512; item += nblk) {
    if (item < 32) {
      const int slot = item >> 4, mt_ = item & 15;
      ACmp af{p.proj, slot, mt_ * 128};
      BMat bf{p.cmp_w1 + (long)slot * 2048 * 128, 128, 128};
      EpiCmp1 ef{p.zc, p.cmp_b1, p.pe_part, slot, mt_ * 128};
      gemm_tile(smem, 32, LDP, af, bf, ef);
    } else if (item < 1056) {
      const int it = item - 32, h = it & 7, mt_ = it >> 3;
      ARows af{p.proj + (long)mt_ * 128 * LDP + C_QD + h * 64, LDP, 128};
      BMat bf{p.w_ukT + h * 64 * 128, 128, 128};
      EpiQlat ef{p.qlat, h, mt_ * 128};
      gemm_tile(smem, 1, 64, af, bf, ef);
    } else {
      const int it = item - 1056;
      for (int q = 0; q < 8; ++q) {
        const int row = it * 32 + wid * 8 + q;
        const unsigned u = *(const unsigned*)(p.proj + (long)row * LDP + C_CKV + lane * 2);
        const float a = lo16(u), b = hi16(u);
        const float ss = wave_sum(a * a + b * b);
        const float r = rsqrtf(ss * (1.f / 128.f) + 1e-6f);
        *(unsigned*)(p.ckv + (long)row * 128 + lane * 2) = pack2(a * r * p.dsa_kv_norm[lane * 2], b * r * p.dsa_kv_norm[lane * 2 + 1]);
      }
    }
  }
}

struct EpiCmp2 {
  u16* dst; int m0, transposed;
  DI void operator()(f32x16 (&acc)[2][2], int wm, int wn, int lane) const {
    if (!transposed) {
      EPI_FOR {
        const int R = m0 + EPI_R, c = EPI_C;
        if (c < 64) dst[(long)R * 64 + c] = f2bf(acc[mt][nt][i]);
      }
    } else {
#pragma unroll
      for (int mt = 0; mt < 2; ++mt)
#pragma unroll
        for (int nt = 0; nt < 2; ++nt) {
          const int c = EPI_C;
          if (c < 64) {
#pragma unroll
            for (int q4 = 0; q4 < 4; ++q4) {
              const int R = m0 + wm * 64 + mt * 32 + 8 * q4 + 4 * (lane >> 5);
              const int bg = R >> 9, n = R & 511;
              uint2 w;
              w.x = pack2(acc[mt][nt][q4 * 4 + 0], acc[mt][nt][q4 * 4 + 1]);
              w.y = pack2(acc[mt][nt][q4 * 4 + 2], acc[mt][nt][q4 * 4 + 3]);
              *(uint2*)(dst + ((long)(bg * 64 + c)) * 512 + n) = w;
            }
          }
        }
    }
  }
};
DI void indexer_item(const Params& p, char* smem, int item) {
  const int tid = TIDX(), lane = tid & 63, wid = __builtin_amdgcn_readfirstlane(tid >> 6);
  int b = 0, rem = item;
  if (rem >= 2080) { b = 1; rem -= 2080; }
  int qt = (int)((sqrtf(8.f * rem + 1.f) - 1.f) * 0.5f);
  while ((qt + 1) * (qt + 2) / 2 <= rem) ++qt;
  while (qt * (qt + 1) / 2 > rem) --qt;
  const int kt = rem - qt * (qt + 1) / 2;
  const int t0 = qt * 128 + (wid >> 1) * 64, s0 = kt * 128 + (wid & 1) * 64;
  if (s0 > t0 + 63) return;
  float* wl = (float*)smem + wid * 512;
  const float* wsrc = p.widx + ((long)b * T + t0) * 8;
#pragma unroll
  for (int i = 0; i < 8; ++i) wl[i * 64 + lane] = wsrc[i * 64 + lane];
  wave_sync();
  const u16* projb = p.proj + (long)b * T * LDP;
  const int r31 = lane & 31, hf = lane >> 5;
  bf16x8 bfr[2][4];
#pragma unroll
  for (int nt = 0; nt < 2; ++nt)
#pragma unroll
    for (int ks = 0; ks < 4; ++ks) bfr[nt][ks] = *(const bf16x8*)(projb + (long)(s0 + nt * 32 + r31) * LDP + C_KI + ks * 16 + hf * 8);
  f32x16 sum[2][2];
#pragma unroll
  for (int a = 0; a < 2; ++a)
#pragma unroll
    for (int c = 0; c < 2; ++c)
#pragma unroll
      for (int i = 0; i < 16; ++i) sum[a][c][i] = 0.f;
  for (int h = 0; h < 8; ++h) {
    bf16x8 afr[2][4];
#pragma unroll
    for (int mt = 0; mt < 2; ++mt)
#pragma unroll
      for (int ks = 0; ks < 4; ++ks) afr[mt][ks] = *(const bf16x8*)(projb + (long)(t0 + mt * 32 + r31) * LDP + C_QI + h * 64 + ks * 16 + hf * 8);
#pragma unroll
    for (int mt = 0; mt < 2; ++mt)
#pragma unroll
      for (int nt = 0; nt < 2; ++nt) {
        f32x16 acc;
#pragma unroll
        for (int i = 0; i < 16; ++i) acc[i] = 0.f;
#pragma unroll
        for (int ks = 0; ks < 4; ++ks) acc = __builtin_amdgcn_mfma_f32_32x32x16_bf16(afr[mt][ks], bfr[nt][ks], acc, 0, 0, 0);
#pragma unroll
        for (int i = 0; i < 16; ++i) {
          const int row = mt * 32 + (i & 3) + 8 * (i >> 2) + 4 * hf;
          sum[mt][nt][i] += wl[row * 8 + h] * fmaxf(acc[i], 0.f);
        }
      }
  }
#pragma unroll
  for (int mt = 0; mt < 2; ++mt)
#pragma unroll
    for (int nt = 0; nt < 2; ++nt)
#pragma unroll
      for (int i = 0; i < 16; ++i) {
        const int row = mt * 32 + (i & 3) + 8 * (i >> 2) + 4 * hf;
        p.scores[((long)b * T + t0 + row) * T + s0 + nt * 32 + r31] = sum[mt][nt][i];
      }
}
DI void phase4(const Params& p, char* smem, int bid, int nblk) {
  for (int item = bid; item < 32 + 4160; item += nblk) {
    __syncthreads();
    if (item < 32) {
      const int slot = item >> 4, mt_ = item & 15;
      ARows af{p.zc + ((long)slot * 2048 + mt_ * 128) * 128, 128, 128};
      BMat bf{p.cmp_w2 + slot * 128 * 64, 64, 64};
      EpiCmp2 ef{slot ? p.vcT : p.kc, mt_ * 128, slot};
      gemm_tile(smem, 2, 64, af, bf, ef);
    } else {
      indexer_item(p, smem, item - 32);
    }
  }
}

using f32x4 = __attribute__((ext_vector_type(4))) float;
#define MFMA16(a, b, c) __builtin_amdgcn_mfma_f32_16x16x32_bf16((a), (b), (c), 0, 0, 0)
#define MFMA32(a, b, c) __builtin_amdgcn_mfma_f32_32x32x16_bf16((a), (b), (c), 0, 0, 0)

constexpr int NSA_STAGE_BYTES = 64 * 72 * 2 + 64 * 68 * 2;
DI void dense_scores(f32x16 (&acc)[2], const u16* Ks, const bf16x8 (&qf)[4], int lane) {
  const int r = lane & 31, hf = lane >> 5;
#pragma unroll
  for (int tile = 0; tile < 2; ++tile) {
    const u16* kp = Ks + (32 * tile + r) * 72 + 8 * hf;
    f32x16 c;
#pragma unroll
    for (int i = 0; i < 16; ++i) c[i] = 0.f;
#pragma unroll
    for (int ks = 0; ks < 4; ++ks) c = MFMA32(*(const bf16x8*)(kp + 16 * ks), qf[ks], c);
    acc[tile] = c;
  }
}
DI void dense_pv(const f32x16 (&acc)[2], const u16* Vs, int lane, f32x16 (&o)[2]) {
  const int r = lane & 31, hf = lane >> 5;
#pragma unroll
  for (int tile = 0; tile < 2; ++tile)
#pragma unroll
    for (int s = 0; s < 2; ++s) {
      uint4 w;
      w.x = pack2(acc[tile][8 * s + 0], acc[tile][8 * s + 1]);
      w.y = pack2(acc[tile][8 * s + 2], acc[tile][8 * s + 3]);
      w.z = pack2(acc[tile][8 * s + 4], acc[tile][8 * s + 5]);
      w.w = pack2(acc[tile][8 * s + 6], acc[tile][8 * s + 7]);
      const bf16x8 pb = __builtin_bit_cast(bf16x8, w);
#pragma unroll
      for (int dt = 0; dt < 2; ++dt) {
        const u16* vp = Vs + (32 * dt + r) * 68 + 32 * tile + 16 * s + 4 * hf;
        const uint2 lo = *(const uint2*)vp;
        const uint2 hi = *(const uint2*)(vp + 8);
        uint4 a;
        a.x = lo.x; a.y = lo.y; a.z = hi.x; a.w = hi.y;
        o[dt] = MFMA32(__builtin_bit_cast(bf16x8, a), pb, o[dt]);
      }
    }
}
constexpr float LOG2E = 1.4426950408889634f;
template <int DSTEP>
DI float dense_mask(f32x16 (&acc)[2], bool active, int lo_c, int hi_c, int dist0_c, int dmin_u, const float* btab_h, int lane) {
  const int hf = lane >> 5;
  const bool colfull = !active || (lo_c <= 0 && hi_c >= 63);
  float mx = -INFINITY;
  if (dmin_u >= 128 && __ballot(colfull) == ~0ull) {
    const float be = active ? btab_h[128] : -INFINITY;
#pragma unroll
    for (int tile = 0; tile < 2; ++tile)
#pragma unroll
      for (int i = 0; i < 16; ++i) {
        const float sv = fmaf(acc[tile][i], LOG2E, be);
        acc[tile][i] = sv;
        mx = fmaxf(mx, sv);
      }
  } else {
    const int lo2 = active ? lo_c : 1, hi2 = active ? hi_c : 0;
#pragma unroll
    for (int tile = 0; tile < 2; ++tile)
#pragma unroll
      for (int i = 0; i < 16; ++i) {
        const int kl = 32 * tile + (i & 3) + 8 * (i >> 2) + 4 * hf;
        int dc = dist0_c - DSTEP * kl;
        dc = dc < 0 ? 0 : (dc > 128 ? 128 : dc);
        const float bias = btab_h[dc];
        const float s2 = fmaf(acc[tile][i], LOG2E, bias);
        const float sv = (kl >= lo2 && kl <= hi2) ? s2 : -INFINITY;
        acc[tile][i] = sv;
        mx = fmaxf(mx, sv);
      }
  }
  return fmaxf(mx, __shfl_xor(mx, 32));
}
DI void dense_chunk(const u16* Ks, const u16* Vs, bool active, int lo_c, int hi_c, int dist0_c, int dmin_u, const bf16x8 (&qf)[4],
                    const float* btab_h, int lane, float& m, float& l, f32x16 (&o)[2]) {
  f32x16 acc[2];
  dense_scores(acc, Ks, qf, lane);
  const float mx = dense_mask<1>(acc, active, lo_c, hi_c, dist0_c, dmin_u, btab_h, lane);
  const float mn = fmaxf(m, mx);
  const float alpha = __builtin_amdgcn_exp2f(m - mn);
  float ls = 0.f;
#pragma unroll
  for (int tile = 0; tile < 2; ++tile)
#pragma unroll
    for (int i = 0; i < 16; ++i) {
      const float pv = __builtin_amdgcn_exp2f(acc[tile][i] - mn);
      acc[tile][i] = pv;
      ls += pv;
    }
  ls += __shfl_xor(ls, 32);
  l = l * alpha + ls;
  m = mn;
  o[0] *= alpha;
  o[1] *= alpha;
  dense_pv(acc, Vs, lane, o);
}

template <int KSG, int VSG, bool NEEDV, class Next, class Body>
DI void chunk_pipeline(char* stage, const u16* kg0, const u16* vg0, int first, int tid, const Next& next, const Body& body) {
  const int srow = tid >> 2, spiece = tid & 3;
  uint4 rk0, rk1, rv0, rv1;
  rv0 = rv1 = make_uint4(0, 0, 0, 0);
  int d = first;
#define NSA_GLOAD(D)                                                                      \
  {                                                                                       \
    const uint4* pk_ = (const uint4*)(kg0 + ((long)(D) * 64 + srow) * KSG + spiece * 16); \
    rk0 = pk_[0]; rk1 = pk_[1];                                                           \
    if (NEEDV) {                                                                          \
      const uint4* pv_ = (const uint4*)(vg0 + (long)srow * VSG + (D) * 64 + spiece * 16); \
      rv0 = pv_[0]; rv1 = pv_[1];                                                         \
    }                                                                                     \
  }
  if (d >= 0) NSA_GLOAD(d)
  int ph = 0;
  __syncthreads();
  while (d >= 0) {
    u16* Ks = (u16*)(stage + ph * NSA_STAGE_BYTES);
    u16* Vs = Ks + 64 * 72;
    *(uint4*)(Ks + srow * 72 + spiece * 16) = rk0;
    *(uint4*)(Ks + srow * 72 + spiece * 16 + 8) = rk1;
    if (NEEDV) {
      uint2* dv = (uint2*)(Vs + srow * 68 + spiece * 16);
      dv[0] = make_uint2(rv0.x, rv0.y); dv[1] = make_uint2(rv0.z, rv0.w);
      dv[2] = make_uint2(rv1.x, rv1.y); dv[3] = make_uint2(rv1.z, rv1.w);
    }
    const int dn = next(d);
    if (dn >= 0) NSA_GLOAD(dn)
    __syncthreads();
    body(d, Ks, Vs);
    ph ^= 1;
    d = dn;
  }
#undef NSA_GLOAD
}

DI void nsa_item(const Params& p, char* smem, int item) {
  const int tid = TIDX(), lane = tid & 63, wid = __builtin_amdgcn_readfirstlane(tid >> 6);
  const int chunk = item & 255, g = (item >> 8) & 1, b = item >> 9;
  const int bg = b * 2 + g;
  float* btab = (float*)smem;
  u64* wun = (u64*)(smem + 2304);
  float* imps = (float*)(smem + 4096) + wid * 1056;
  char* stage = smem + 21504;
  for (int idx = tid; idx < 4 * 129; idx += 256) {
    const int h = idx / 129, d = idx % 129;
    const int bk = d < 128 ? BUCKET[d] : 31;
    btab[h * 132 + d] = p.rel_bias[bk * 16 + g * 4 + h] * LOG2E;
  }
  __syncthreads();
  const int t0 = chunk * 32;
  const int tw = t0 + wid * 8;
  const int c = lane & 31, hf = lane >> 5, qi = c >> 2, hh = c & 3;
  const int t_c = tw + qi;
  const int cur = t0 >> 6;
  const long row = (long)b * T + t_c;
  const u16* prow = p.proj + row * LDP;
  const u16* projb = p.proj + (long)b * T * LDP;
  const float* btab_h = btab + hh * 132;
  bf16x8 qf[4];
#pragma unroll
  for (int ks = 0; ks < 4; ++ks) qf[ks] = *(const bf16x8*)(prow + C_QN + (g * 4 + hh) * 64 + ks * 16 + hf * 8);
  const u16* gptr = prow + C_GN + (g * 4 + hh) * 3;
  for (int k = lane; k < 1056; k += 64) imps[k] = 0.f;
  u16* orow = p.onsa + row * 512 + (g * 4 + hh) * 64 + 4 * hf;
  auto emit = [&](const f32x16 (&o)[2], float sc, bool first) {
#pragma unroll
    for (int dt = 0; dt < 2; ++dt)
#pragma unroll
      for (int q4 = 0; q4 < 4; ++q4) {
        uint2* dst = (uint2*)(orow + 32 * dt + 8 * q4);
        float v0 = o[dt][4 * q4 + 0] * sc, v1 = o[dt][4 * q4 + 1] * sc, v2 = o[dt][4 * q4 + 2] * sc, v3 = o[dt][4 * q4 + 3] * sc;
        if (!first) {
          const uint2 u = *dst;
          v0 += lo16(u.x); v1 += hi16(u.x); v2 += lo16(u.y); v3 += hi16(u.y);
        }
        uint2 w;
        w.x = pack2(v0, v1);
        w.y = pack2(v2, v3);
        *dst = w;
      }
  };
  const int ncv_c = (t_c >= 31) ? ((t_c - 31) >> 4) + 1 : 0;
  const int ncv_max = (t0 + 31 >= 31) ? ((t0 + 31 - 31) >> 4) + 1 : 0;
  const int nchunk_c = (ncv_max + 63) >> 6;
  {
    const u16* kcb = p.kc + (long)bg * 512 * 64;
    const u16* vcb = p.vcT + (long)bg * 64 * 512;
    float m = -1e30f, l = 0.f;
    auto next_c = [&](int d) { return d + 1 < nchunk_c ? d + 1 : -1; };
    chunk_pipeline<64, 512, false>(stage, kcb, vcb, 0, tid, next_c, [&](int i, const u16* Ks, const u16* Vs) {
      f32x16 acc[2];
      dense_scores(acc, Ks, qf, lane);
      const float mx = dense_mask<16>(acc, true, 0, ncv_c - 1 - i * 64, t_c - 31 - 1024 * i, tw - 31 - 1024 * i - 1008, btab_h, lane);
      const float mn = fmaxf(m, mx);
      float ls = 0.f;
#pragma unroll
      for (int tile = 0; tile < 2; ++tile)
#pragma unroll
        for (int q = 0; q < 16; ++q) ls += __builtin_amdgcn_exp2f(acc[tile][q] - mn);
      ls += __shfl_xor(ls, 32);
      l = l * __builtin_amdgcn_exp2f(m - mn) + ls;
      m = mn;
    });
    const float invl = 1.f / fmaxf(l, 1e-30f);
    f32x16 oc[2];
#pragma unroll
    for (int i = 0; i < 16; ++i) { oc[0][i] = 0.f; oc[1][i] = 0.f; }
    chunk_pipeline<64, 512, true>(stage, kcb, vcb, 0, tid, next_c, [&](int i, const u16* Ks, const u16* Vs) {
      f32x16 acc[2];
      dense_scores(acc, Ks, qf, lane);
      (void)dense_mask<16>(acc, true, 0, ncv_c - 1 - i * 64, t_c - 31 - 1024 * i, tw - 31 - 1024 * i - 1008, btab_h, lane);
      float part[2][4], spill[2][4];
#pragma unroll
      for (int tile = 0; tile < 2; ++tile) {
#pragma unroll
        for (int q = 0; q < 16; ++q) acc[tile][q] = __builtin_amdgcn_exp2f(acc[tile][q] - m) * invl;
#pragma unroll
        for (int q4 = 0; q4 < 4; ++q4) {
          float pa = acc[tile][4 * q4] + acc[tile][4 * q4 + 1] + acc[tile][4 * q4 + 2] + 0.5f * acc[tile][4 * q4 + 3];
          float sp = 0.5f * acc[tile][4 * q4 + 3];
          pa += __shfl_xor(pa, 1); pa += __shfl_xor(pa, 2);
          sp += __shfl_xor(sp, 1); sp += __shfl_xor(sp, 2);
          part[tile][q4] = pa; spill[tile][q4] = sp;
        }
      }
      if (hh == 0) {
#pragma unroll
        for (int tile = 0; tile < 2; ++tile)
#pragma unroll
          for (int q4 = 0; q4 < 4; ++q4) imps[qi * 132 + 16 * i + 8 * tile + 2 * q4 + hf] += part[tile][q4];
      }
      wave_sync();
      if (hh == 0) {
#pragma unroll
        for (int tile = 0; tile < 2; ++tile)
#pragma unroll
          for (int q4 = 0; q4 < 4; ++q4) imps[qi * 132 + 16 * i + 8 * tile + 2 * q4 + hf + 1] += spill[tile][q4];
      }
      wave_sync();
      dense_pv(acc, Vs, lane, oc);
    });
    emit(oc, bf2f(gptr[0]), true);
  }
  wave_sync();
  u64 my0 = 0, my1 = 0, wu0 = 0, wu1 = 0;
  for (int q = 0; q < 8; ++q) {
    u64 mask0, mask1;
    if (cur <= 15) {
      mask0 = (2ull << cur) - 1ull;
      mask1 = 0ull;
    } else {
      const float imp_lo = imps[q * 132 + lane], imp_hi = imps[q * 132 + lane + 64];
      const int jl = lane, jh = lane + 64;
      float c0 = (jl >= 1 && jl <= cur - 2) ? imp_lo : -1.f;
      float c1 = (jh <= cur - 2) ? imp_hi : -1.f;
      bool sel_lo = (jl == 0) || (jl == cur) || (jl == cur - 1);
      bool sel_hi = (jh == cur) || (jh == cur - 1);
      for (int r = 0; r < 13; ++r) {
        float bv; int bj;
        if (c0 >= c1) { bv = c0; bj = jl; } else { bv = c1; bj = jh; }
#pragma unroll
        for (int o = 32; o; o >>= 1) {
          const float ov = __shfl_xor(bv, o);
          const int oj = __shfl_xor(bj, o);
          if (ov > bv || (ov == bv && oj < bj)) { bv = ov; bj = oj; }
        }
        if (bj == jl) { sel_lo = true; c0 = -1.f; }
        if (bj == jh) { sel_hi = true; c1 = -1.f; }
      }
      mask0 = __ballot(sel_lo);
      mask1 = __ballot(sel_hi);
    }
    if (qi == q) { my0 = mask0; my1 = mask1; }
    wu0 |= mask0; wu1 |= mask1;
  }
  if (lane == 0) { wun[wid * 2] = wu0; wun[wid * 2 + 1] = wu1; }
  __syncthreads();
  u64 bu0 = wun[0] | wun[2] | wun[4] | wun[6], bu1 = wun[1] | wun[3] | wun[5] | wun[7];
  bu0 = ((u64)(unsigned)__builtin_amdgcn_readfirstlane((int)(bu0 >> 32)) << 32) | (unsigned)__builtin_amdgcn_readfirstlane((int)bu0);
  bu1 = ((u64)(unsigned)__builtin_amdgcn_readfirstlane((int)(bu1 >> 32)) << 32) | (unsigned)__builtin_amdgcn_readfirstlane((int)bu1);
  {
    float m = -1e30f, l = 0.f;
    f32x16 o[2];
#pragma unroll
    for (int i = 0; i < 16; ++i) { o[0][i] = 0.f; o[1][i] = 0.f; }
    const int kcol = C_KV + 2 * 128 + g * 64;
    auto next_s = [&](int j) {
      ++j;
      if (j < 64) {
        const u64 mm = bu0 & (~0ull << j);
        if (mm) return (int)__builtin_ctzll(mm);
        j = 64;
      }
      if (j >= 128) return -1;
      const u64 mm = bu1 & (~0ull << (j - 64));
      return mm ? 64 + (int)__builtin_ctzll(mm) : -1;
    };
    chunk_pipeline<LDP, T, true>(stage, projb + kcol, p.vts + (long)bg * 64 * T, 0, tid, next_s, [&](int j, const u16* Ks, const u16* Vs) {
      const bool bit = ((j < 64 ? (my0 >> j) : (my1 >> (j - 64))) & 1ull) != 0;
      if (__ballot(bit) != 0ull) {
        const int pos0 = 64 * j;
        dense_chunk(Ks, Vs, bit, 0, t_c - pos0, t_c - pos0, tw - pos0 - 63, qf, btab_h, lane, m, l, o);
      }
    });
    emit(o, bf2f(gptr[1]) / fmaxf(l, 1e-30f), false);
  }
  {
    float m = -1e30f, l = 0.f;
    f32x16 o[2];
#pragma unroll
    for (int i = 0; i < 16; ++i) { o[0][i] = 0.f; o[1][i] = 0.f; }
    const int kcol = C_KV + 4 * 128 + g * 64;
    const int wlo_c = t_c - 511 < 0 ? 0 : t_c - 511;
    const int wlo_min = t0 - 511 < 0 ? 0 : t0 - 511;
    auto next_w = [&](int j) { return j + 1 <= cur ? j + 1 : -1; };
    chunk_pipeline<LDP, T, true>(stage, projb + kcol, p.vtw + (long)bg * 64 * T, wlo_min >> 6, tid, next_w, [&](int jw, const u16* Ks, const u16* Vs) {
      const int pos0 = 64 * jw;
      const int lo_c = wlo_c - pos0 < 0 ? 0 : wlo_c - pos0;
      dense_chunk(Ks, Vs, true, lo_c, t_c - pos0, t_c - pos0, tw - pos0 - 63, qf, btab_h, lane, m, l, o);
    });
    emit(o, bf2f(gptr[2]) / fmaxf(l, 1e-30f), false);
  }
}

DI unsigned f2ord(float v) { const unsigned u = __float_as_uint(v); return (u & 0x80000000u) ? ~u : (u | 0x80000000u); }

DI void topk_row(const Params& p, int b, int t, int lane) {
  const long row = (long)b * T + t;
  int* dst = p.selk + row * 256;
  if (t < 256) {
#pragma unroll
    for (int i = 0; i < 4; ++i) { const int s = i * 64 + lane; dst[s] = (s <= t) ? s : -1; }
    return;
  }
  const float* srow = p.scores + row * T;
  const int ngrp = (t >> 10) + 1;
  unsigned u[128];
  int ln = lane;
  asm volatile("" : "+v"(ln));
#pragma unroll
  for (int gq = 0; gq < 8; ++gq) {
    if (gq < ngrp) {
#pragma unroll
      for (int j = 0; j < 16; ++j) {
        const int s = (gq * 16 + j) * 64 + ln;
        const float v = srow[s < t ? s : t];
        u[gq * 16 + j] = (s <= t) ? f2ord(v) : 0u;
      }
    } else {
#pragma unroll
      for (int j = 0; j < 16; ++j) u[gq * 16 + j] = 0u;
    }
  }
  unsigned thr = 0u;
  for (int bit = 31; bit >= 0; --bit) {
    const unsigned cand = thr | (1u << bit);
    int cnt = 0;
#pragma unroll
    for (int gq = 0; gq < 8; ++gq) {
      if (gq < ngrp) {
#pragma unroll
        for (int j = 0; j < 16; ++j) cnt += __popcll(__ballot(u[gq * 16 + j] >= cand));
      }
    }
    if (cnt >= 256) thr = cand;
    if (cnt == 256) break;
  }
  int ngt = 0;
#pragma unroll
  for (int gq = 0; gq < 8; ++gq) {
    if (gq < ngrp) {
#pragma unroll
      for (int j = 0; j < 16; ++j) ngt += __popcll(__ballot(u[gq * 16 + j] > thr));
    }
  }
  int base_gt = 0, base_eq = 0;
  const int need_eq = 256 - ngt;
  int ln2 = lane;
  asm volatile("" : "+v"(ln2));
#pragma unroll
  for (int gq = 0; gq < 8; ++gq) {
    if (gq < ngrp) {
#pragma unroll
      for (int j = 0; j < 16; ++j) {
        const int s = (gq * 16 + j) * 64 + ln2;
        const unsigned uv = u[gq * 16 + j];
        const bool gt = uv > thr, eq = uv == thr;
        const u64 mg = __ballot(gt), me = __ballot(eq);
        const int pg = __builtin_amdgcn_mbcnt_hi((unsigned)(mg >> 32), __builtin_amdgcn_mbcnt_lo((unsigned)mg, 0));
        const int pe = __builtin_amdgcn_mbcnt_hi((unsigned)(me >> 32), __builtin_amdgcn_mbcnt_lo((unsigned)me, 0));
        if (gt) dst[base_gt + pg] = s;
        if (eq && (base_eq + pe) < need_eq) dst[ngt + base_eq + pe] = s;
        base_gt += __popcll(mg);
        base_eq += __popcll(me);
      }
    }
  }
}

DI void phase5(const Params& p, char* smem, int bid, int nblk) {
  for (int item = bid; item < 1024; item += nblk) {
    __syncthreads();
    const int it = 1023 - item;
    const int chunk = it >> 2, bgi = it & 3;
    nsa_item(p, smem, (bgi << 8) | chunk);
  }
  {
    const int tid = TIDX(), lane = tid & 63, wid = __builtin_amdgcn_readfirstlane(tid >> 6);
    for (int item = bid; item < 2048; item += nblk) {
      const int it = 2047 - item;
      const int b = it & 1, tb = it >> 1;
#pragma unroll 1
      for (int q = 0; q < 2; ++q) {
        asm volatile("" ::: "memory");
        topk_row(p, b, tb * 8 + wid * 2 + q, lane);
      }
    }
  }
}

DI void dsa_query(const Params& p, const float* btab, int b, int t, int lane) {
  const long row = (long)b * T + t;
  const int lg = lane >> 4, r16 = lane & 15, hh = lane & 7;
  bf16x8 qf[4];
#pragma unroll
  for (int ks = 0; ks < 4; ++ks) {
    bf16x8 z = {0, 0, 0, 0, 0, 0, 0, 0};
    if (r16 < 8) z = *(const bf16x8*)(p.qlat + (row * 8 + r16) * 128 + ks * 32 + lg * 8);
    qf[ks] = z;
  }
  const u16* ckvb = p.ckv + (long)b * T * 128;
  const int nvalid = (t + 1) < 256 ? (t + 1) : 256;
  float m = -1e30f, l = 0.f, o0[8], o1[8];
#pragma unroll
  for (int h = 0; h < 8; ++h) { o0[h] = 0.f; o1[h] = 0.f; }
  for (int i = 0; i * 64 < nvalid; ++i) {
    const int nval = (nvalid - i * 64) > 64 ? 64 : (nvalid - i * 64);
    int kidx = p.selk[row * 256 + i * 64 + lane];
    if (lane >= nval || kidx < 0 || kidx > t) kidx = t;
    f32x4 acc[4];
#pragma unroll
    for (int rt = 0; rt < 4; ++rt) {
      const int kk = __shfl(kidx, 16 * rt + r16);
      const u16* kp = ckvb + (long)kk * 128 + 8 * lg;
      f32x4 c = {0.f, 0.f, 0.f, 0.f};
#pragma unroll
      for (int ks = 0; ks < 4; ++ks) c = MFMA16(*(const bf16x8*)(kp + 32 * ks), qf[ks], c);
      acc[rt] = c;
    }
    float mx = -1e30f;
#pragma unroll
    for (int rt = 0; rt < 4; ++rt)
#pragma unroll
      for (int r = 0; r < 4; ++r) {
        const int pl = 16 * rt + 4 * lg + r;
        const int kk = __shfl(kidx, pl);
        int dc = t - kk;
        dc = dc < 0 ? 0 : (dc > 128 ? 128 : dc);
        const float sv = (pl < nval) ? acc[rt][r] + btab[hh * 132 + dc] : -1e30f;
        acc[rt][r] = sv;
        mx = fmaxf(mx, sv);
      }
    mx = fmaxf(mx, __shfl_xor(mx, 16));
    mx = fmaxf(mx, __shfl_xor(mx, 32));
    const float mn = fmaxf(m, mx);
    const float alpha = __expf(m - mn);
    float ls = 0.f;
#pragma unroll
    for (int rt = 0; rt < 4; ++rt)
#pragma unroll
      for (int r = 0; r < 4; ++r) {
        const float pv = acc[rt][r] > -1e29f ? __expf(acc[rt][r] - mn) : 0.f;
        acc[rt][r] = pv;
        ls += pv;
      }
    ls += __shfl_xor(ls, 16);
    ls += __shfl_xor(ls, 32);
    l = l * alpha + ls;
    m = mn;
#pragma unroll
    for (int h = 0; h < 8; ++h) { const float a = rdlane(alpha, h); o0[h] *= a; o1[h] *= a; }
#pragma unroll
    for (int rt = 0; rt < 4; ++rt) {
      asm volatile("" ::: "memory");
#pragma unroll
      for (int g2 = 0; g2 < 4; ++g2)
#pragma unroll
        for (int r = 0; r < 4; ++r) {
          const int pl = 16 * rt + 4 * g2 + r;
          const int kL = rdlane_i(kidx, pl);
          const unsigned u = *(const unsigned*)(ckvb + (long)kL * 128 + lane * 2);
          const float v0 = lo16(u), v1 = hi16(u);
#pragma unroll
          for (int h = 0; h < 8; ++h) {
            const float pw = rdlane(acc[rt][r], 16 * g2 + h);
            o0[h] += pw * v0;
            o1[h] += pw * v1;
          }
        }
    }
  }
  const float invl = 1.f / fmaxf(l, 1e-30f);
#pragma unroll
  for (int h = 0; h < 8; ++h) {
    const float iv = rdlane(invl, h);
    *(unsigned*)(p.olat + row * 1024 + h * 128 + lane * 2) = pack2(o0[h] * iv, o1[h] * iv);
  }
}
DI void phase6(const Params& p, char* smem, int bid, int nblk) {
  const int tid = TIDX(), lane = tid & 63, wid = __builtin_amdgcn_readfirstlane(tid >> 6);
  float* btab = (float*)smem;
  for (int idx = tid; idx < 8 * 129; idx += 256) {
    const int h = idx / 129, d = idx % 129;
    const int bk = d < 128 ? BUCKET[d] : 31;
    btab[h * 132 + d] = p.rel_bias[bk * 16 + 8 + h];
  }
  __syncthreads();
  for (int item = bid; item < 2048; item += nblk) {
    const int it = 2047 - item;
    const int b = it & 1, tb = it >> 1;
    for (int q = 0; q < 2; ++q) dsa_query(p, btab, b, tb * 8 + wid * 2 + q, lane);
  }
}

struct EpiOdsa {
  u16* odsa; int h, m0;
  DI void operator()(f32x16 (&acc)[2][2], int wm, int wn, int lane) const {
    EPI_FOR {
      const int r = m0 + EPI_R, c = EPI_C;
      if (c < 64) odsa[(long)r * 512 + h * 64 + c] = f2bf(acc[mt][nt][i]);
    }
  }
};
DI void phase7(const Params& p, char* smem, int bid, int nblk) {
  for (int item = bid; item < 1024; item += nblk) {
    const int h = item & 7, mt_ = item >> 3;
    ARows af{p.olat + (long)mt_ * 128 * 1024 + h * 128, 1024, 128};
    BMat bf{p.dsa_w_uv + h * 64, 512, 64};
    EpiOdsa ef{p.odsa, h, mt_ * 128};
    gemm_tile(smem, 2, 64, af, bf, ef);
  }
}

struct EpiY {
  u16* y; const u16* proj; int m0, n0, second;
  DI void operator()(f32x16 (&acc)[2][2], int wm, int wn, int lane) const {
    EPI_FOR {
      const int r = m0 + EPI_R, c = n0 + EPI_C;
      const float g = bf2f(proj[(long)r * LDP + C_GM + second * 1024 + c]);
      float v = g * acc[mt][nt][i];
      if (second) v += bf2f(y[(long)r * 1024 + c]);
      y[(long)r * 1024 + c] = f2bf(v);
    }
  }
};
DI void phase8(const Params& p, char* smem, int bid, int nblk) {
  for (int item = bid; item < 1024; item += nblk) {
    const int nt_ = item & 7, mt_ = item >> 3;
    {
      ARows af{p.onsa + (long)mt_ * 128 * 512, 512, 128};
      BMat bf{p.w_bn + nt_ * 128, 1024, 128};
      EpiY ef{p.y, p.proj, mt_ * 128, nt_ * 128, 0};
      gemm_tile(smem, 8, 64, af, bf, ef);
    }
    {
      ARows af{p.odsa + (long)mt_ * 128 * 512, 512, 128};
      BMat bf{p.w_bd + nt_ * 128, 1024, 128};
      EpiY ef{p.y, p.proj, mt_ * 128, nt_ * 128, 1};
      gemm_tile(smem, 8, 64, af, bf, ef);
    }
  }
}
struct EpiStoreBf {
  u16* dst; long ld; int m0, n0;
  DI void operator()(f32x16 (&acc)[2][2], int wm, int wn, int lane) const {
    EPI_FOR { dst[(long)(m0 + EPI_R) * ld + n0 + EPI_C] = f2bf(acc[mt][nt][i]); }
  }
};
DI void phase9(const Params& p, char* smem, int bid, int nblk) {
  for (int item = bid; item < 1024; item += nblk) {
    const int nt_ = item & 7, mt_ = item >> 3;
    ARows af{p.y + (long)mt_ * 128 * 1024, 1024, 128};
    BMat bf{p.w_out + nt_ * 128, 1024, 128};
    EpiStoreBf ef{p.z, 1024, mt_ * 128, nt_ * 128};
    gemm_tile(smem, 16, 64, af, bf, ef);
  }
}

DI void phase10(const Params& p, int bid, int nblk) {
  const int tid = TIDX(), lane = tid & 63, wid = __builtin_amdgcn_readfirstlane(tid >> 6);
  for (int row = bid * 4 + wid; row < NTOK; row += nblk * 4) {
    const int b = row >> 13;
    const float* modb = p.mod + b * 6144;
    float zv[16], xv[16];
    float ss = 0.f;
#pragma unroll
    for (int i = 0; i < 4; ++i) {
      const int col = i * 256 + lane * 4;
      const uint2 u = *(const uint2*)(p.z + (long)row * 1024 + col);
      zv[i * 4 + 0] = lo16(u.x); zv[i * 4 + 1] = hi16(u.x); zv[i * 4 + 2] = lo16(u.y); zv[i * 4 + 3] = hi16(u.y);
      const float4 xx = *(const float4*)(p.x + (long)row * 1024 + col);
      xv[i * 4 + 0] = xx.x; xv[i * 4 + 1] = xx.y; xv[i * 4 + 2] = xx.z; xv[i * 4 + 3] = xx.w;
#pragma unroll
      for (int j = 0; j < 4; ++j) ss += zv[i * 4 + j] * zv[i * 4 + j];
    }
    ss = wave_sum(ss);
    const float r = rsqrtf(ss * (1.f / 1024.f) + 1e-6f);
    float ss2 = 0.f;
#pragma unroll
    for (int i = 0; i < 4; ++i)
#pragma unroll
      for (int j = 0; j < 4; ++j) {
        const int col = i * 256 + lane * 4 + j;
        const float v = xv[i * 4 + j] + modb[2048 + col] * (zv[i * 4 + j] * r * p.g_post_mix[col]);
        xv[i * 4 + j] = v;
        ss2 += v * v;
      }
    ss2 = wave_sum(ss2);
    const float r2 = rsqrtf(ss2 * (1.f / 1024.f) + 1e-6f);
#pragma unroll
    for (int i = 0; i < 4; ++i) {
      const int col = i * 256 + lane * 4;
      *(float4*)(p.x1 + (long)row * 1024 + col) = make_float4(xv[i * 4], xv[i * 4 + 1], xv[i * 4 + 2], xv[i * 4 + 3]);
      float hv[4];
#pragma unroll
      for (int j = 0; j < 4; ++j) hv[j] = xv[i * 4 + j] * r2 * p.g_pre_ffn[col + j] * (1.f + modb[4096 + col + j]) + modb[3072 + col + j];
      uint2 w;
      w.x = pack2(hv[0], hv[1]);
      w.y = pack2(hv[2], hv[3]);
      *(uint2*)(p.h + (long)row * 1024 + col) = w;
    }
  }
}

struct EpiStoreF32 {
  float* dst; long ld; int m0, n0;
  DI void operator()(f32x16 (&acc)[2][2], int wm, int wn, int lane) const {
    EPI_FOR { dst[(long)(m0 + EPI_R) * ld + n0 + EPI_C] = acc[mt][nt][i]; }
  }
};
DI void phase11(const Params& p, char* smem, int bid, int nblk) {
  for (int item = bid; item < 256; item += nblk) {
    const int nt_ = item & 1, mt_ = item >> 1;
    ARows af{p.h + (long)mt_ * 128 * 1024, 1024, 128};
    BMat bf{p.router_w + nt_ * 128, 256, 128};
    EpiStoreF32 ef{p.logits, 256, mt_ * 128, nt_ * 128};
    gemm_tile(smem, 16, 64, af, bf, ef);
  }
}
DI void phase12(const Params& p, int bid, int nblk) {
  const int tid = TIDX(), lane = tid & 63, wid = __builtin_amdgcn_readfirstlane(tid >> 6);
  for (int tok = bid * 4 + wid; tok < NTOK; tok += nblk * 4) {
    const float4 lg = *(const float4*)(p.logits + (long)tok * 256 + lane * 4);
    const float4 rbv = *(const float4*)(p.router_bias + lane * 4);
    float sg[4] = {sigmoidf(lg.x), sigmoidf(lg.y), sigmoidf(lg.z), sigmoidf(lg.w)};
    float sl[4] = {sg[0] + rbv.x, sg[1] + rbv.y, sg[2] + rbv.z, sg[3] + rbv.w};
    float t1 = fmaxf(sl[0], sl[1]), t2 = fminf(sl[0], sl[1]);
#pragma unroll
    for (int j = 2; j < 4; ++j) {
      const float v = sl[j];
      t2 = fmaxf(t2, fminf(t1, v));
      t1 = fmaxf(t1, v);
    }
#pragma unroll
    for (int o = 1; o < 8; o <<= 1) {
      const float a1 = __shfl_xor(t1, o), a2 = __shfl_xor(t2, o);
      const float n1 = fmaxf(t1, a1);
      const float n2 = fmaxf(fminf(t1, a1), fmaxf(t2, a2));
      t1 = n1; t2 = n2;
    }
    const float gscore = t1 + t2;
    const int grp = lane >> 3;
    int rank = 0;
#pragma unroll
    for (int g2 = 0; g2 < 8; ++g2) {
      const float og = __shfl(gscore, g2 * 8);
      rank += (og > gscore || (og == gscore && g2 < grp)) ? 1 : 0;
    }
    const bool gsel = rank < 4;
    float cv[4];
#pragma unroll
    for (int j = 0; j < 4; ++j) cv[j] = gsel ? sl[j] : -1e30f;
    int my_e = -1; float my_s = 0.f; float ssum = 0.f;
    for (int r = 0; r < 8; ++r) {
      float bv = cv[0]; int bj = 0;
#pragma unroll
      for (int j = 1; j < 4; ++j) if (cv[j] > bv) { bv = cv[j]; bj = j; }
      int be = lane * 4 + bj;
      float bs = bj == 0 ? sg[0] : (bj == 1 ? sg[1] : (bj == 2 ? sg[2] : sg[3]));
#pragma unroll
      for (int o = 32; o; o >>= 1) {
        const float ov = __shfl_xor(bv, o);
        const int oe = __shfl_xor(be, o);
        const float os = __shfl_xor(bs, o);
        if (ov > bv || (ov == bv && oe < be)) { bv = ov; be = oe; bs = os; }
      }
      if ((be >> 2) == lane) {
        const int j = be & 3;
        if (j == 0) cv[0] = -3e30f; else if (j == 1) cv[1] = -3e30f; else if (j == 2) cv[2] = -3e30f; else cv[3] = -3e30f;
      }
      if (lane == r) { my_e = be; my_s = bs; }
      ssum += bs;
    }
    if (lane < 8) {
      const float w = my_s / ssum * 2.5f;
      const int rk = atomicAdd(p.counts + my_e, 1);
      p.eidx[tok * 8 + lane] = my_e;
      p.ewt[tok * 8 + lane] = w;
      p.erank[tok * 8 + lane] = rk;
    }
  }
}
DI void phase13(const Params& p, char* smem, int bid) {
  if (bid != 0) return;
  const int tid = TIDX();
  int* s_cnt = (int*)smem;
  const int cnt = p.counts[tid];
  s_cnt[tid] = cnt;
  __syncthreads();
  int run = 0, nt = 0;
  for (int e = 0; e < tid; ++e) { const int c = s_cnt[e]; run += c; nt += (c + 127) >> 7; }
  p.offs[tid] = run;
  for (int m = 0; m * 128 < cnt; ++m) {
    p.tile_e[nt] = tid;
    p.tile_r0[nt] = run + m * 128;
    p.tile_nr[nt] = (cnt - m * 128) > 128 ? 128 : (cnt - m * 128);
    ++nt;
  }
  if (tid == 255) {
    p.offs[256] = run + cnt;
    for (int m = 0; m < 128; ++m) {
      p.tile_e[nt] = 256;
      p.tile_r0[nt] = 131072 + m * 128;
      p.tile_nr[nt] = 128;
      ++nt;
    }
    p.ntiles[0] = nt;
  }
}
DI void phase14(const Params& p, int bid, int nblk) {
  for (int i = bid * 256 + TIDX(); i < NSLOT; i += nblk * 256) {
    if (i < 131072) {
      const int e = p.eidx[i];
      const int slot = p.offs[e] + p.erank[i];
      p.slot_tok[slot] = i >> 3;
      p.slot_wt[slot] = p.ewt[i];
      p.tok_slot[i] = slot;
    } else {
      p.slot_tok[i] = i - 131072;
      p.slot_wt[i] = 1.f;
    }
  }
}

struct AGather {
  const u16* h; const int* slot_tok; int r0, nr;
  DI const u16* operator()(int r) const { return r < nr ? h + (long)slot_tok[r0 + r] * 1024 : nullptr; }
};
struct BGateUp {
  const float* wg; long udiff; long ldb; int n0;
  DI const float* operator()(int c4) const {
    const int wn = c4 >> 6, ntl = (c4 >> 5) & 1, j = c4 & 31;
    return wg + (long)ntl * udiff + n0 + wn * 32 + j;
  }
};
struct EpiH {
  u16* H; int r0, nr, n0;
  DI void operator()(f32x16 (&acc)[2][2], int wm, int wn, int lane) const {
#pragma unroll
    for (int mt = 0; mt < 2; ++mt)
#pragma unroll
      for (int i = 0; i < 16; ++i) {
        const int r = wm * 64 + mt * 32 + (i & 3) + 8 * (i >> 2) + 4 * (lane >> 5);
        if (r < nr) {
          const float g = acc[mt][0][i], u = acc[mt][1][i];
          H[(long)(r0 + r) * 256 + n0 + wn * 32 + (lane & 31)] = f2bf(siluf(g) * u);
        }
      }
  }
};
DI void phase15(const Params& p, char* smem, int bid, int nblk) {
  const int ntl = p.ntiles[0];
  for (int item = bid; item < ntl * 4; item += nblk) {
    const int ti = item >> 2, nt_ = item & 3;
    const int e = p.tile_e[ti], r0 = p.tile_r0[ti], nr = p.tile_nr[ti];
    AGather af{p.h, p.slot_tok, r0, nr};
    const float* wg = e < 256 ? p.w_eg + (long)e * 1024 * 256 : p.w_sg;
    const float* wu = e < 256 ? p.w_eu + (long)e * 1024 * 256 : p.w_su;
    BGateUp bf{wg, (long)(wu - wg), 256, nt_ * 64};
    EpiH ef{p.H, r0, nr, nt_ * 64};
    gemm_tile(smem, 16, 64, af, bf, ef);
  }
}
struct EpiYexp {
  u16* Y; const float* slot_wt; int r0, nr, n0;
  DI void operator()(f32x16 (&acc)[2][2], int wm, int wn, int lane) const {
    EPI_FOR {
      const int r = EPI_R;
      if (r < nr) Y[(long)(r0 + r) * 1024 + n0 + EPI_C] = f2bf(acc[mt][nt][i] * slot_wt[r0 + r]);
    }
  }
};
DI void phase16(const Params& p, char* smem, int bid, int nblk) {
  const int ntl = p.ntiles[0];
  for (int item = bid; item < ntl * 8; item += nblk) {
    const int ti = item >> 3, nt_ = item & 7;
    const int e = p.tile_e[ti], r0 = p.tile_r0[ti], nr = p.tile_nr[ti];
    ARows af{p.H + (long)r0 * 256, 256, nr};
    const float* wd = e < 256 ? p.w_ed + (long)e * 256 * 1024 : p.w_sd;
    BMat bf{wd + nt_ * 128, 1024, 128};
    EpiYexp ef{p.Y, p.slot_wt, r0, nr, nt_ * 128};
    gemm_tile(smem, 4, 64, af, bf, ef);
  }
}
DI void phase17(const Params& p, int bid, int nblk) {
  const int tid = TIDX(), lane = tid & 63, wid = __builtin_amdgcn_readfirstlane(tid >> 6);
  for (int row = bid * 4 + wid; row < NTOK; row += nblk * 4) {
    const int b = row >> 13;
    const float* modb = p.mod + b * 6144;
    int slots[9];
#pragma unroll
    for (int k = 0; k < 8; ++k) slots[k] = p.tok_slot[row * 8 + k];
    slots[8] = 131072 + row;
    float yv[16];
#pragma unroll
    for (int j = 0; j < 16; ++j) yv[j] = 0.f;
#pragma unroll
    for (int k = 0; k < 9; ++k) {
#pragma unroll
      for (int i = 0; i < 4; ++i) {
        const uint2 u = *(const uint2*)(p.Y + (long)slots[k] * 1024 + i * 256 + lane * 4);
        yv[i * 4 + 0] += lo16(u.x); yv[i * 4 + 1] += hi16(u.x); yv[i * 4 + 2] += lo16(u.y); yv[i * 4 + 3] += hi16(u.y);
      }
    }
    float ss = 0.f;
#pragma unroll
    for (int j = 0; j < 16; ++j) ss += yv[j] * yv[j];
    ss = wave_sum(ss);
    const float r = rsqrtf(ss * (1.f / 1024.f) + 1e-6f);
#pragma unroll
    for (int i = 0; i < 4; ++i) {
      const int col = i * 256 + lane * 4;
      const float4 xx = *(const float4*)(p.x1 + (long)row * 1024 + col);
      float o[4] = {xx.x, xx.y, xx.z, xx.w};
#pragma unroll
      for (int j = 0; j < 4; ++j) o[j] += modb[5120 + col + j] * (yv[i * 4 + j] * r * p.g_post_ffn[col + j]);
      *(float4*)(p.out + (long)row * 1024 + col) = make_float4(o[0], o[1], o[2], o[3]);
    }
  }
}

__global__ void __launch_bounds__(256, 2) mega(Params p) {
  cg::grid_group grid = cg::this_grid();
  __shared__ __attribute__((aligned(16))) char smem[LDS_BYTES];
  const int bid = blockIdx.x, nblk = gridDim.x;
#if !defined(ONLY) || ONLY==0
  if (p.phase_lo <= 0 && 0 < p.phase_hi) {
    phase0(p, bid, nblk);
#if (REPEAT_MASK >> 0) & 1
    grid.sync();
    phase0(p, bid, nblk);
#endif
    if (0 + 1 < p.phase_hi) grid.sync();
  }
#endif
#if !defined(ONLY) || ONLY==1
  if (p.phase_lo <= 1 && 1 < p.phase_hi) {
    phase1(p, smem, bid, nblk);
#if (REPEAT_MASK >> 1) & 1
    grid.sync();
    phase1(p, smem, bid, nblk);
#endif
    if (1 + 1 < p.phase_hi) grid.sync();
  }
#endif
#if !defined(ONLY) || ONLY==2
  if (p.phase_lo <= 2 && 2 < p.phase_hi) {
    phase2(p, smem, bid, nblk);
#if (REPEAT_MASK >> 2) & 1
    grid.sync();
    phase2(p, smem, bid, nblk);
#endif
    if (2 + 1 < p.phase_hi) grid.sync();
  }
#endif
#if !defined(ONLY) || ONLY==3
  if (p.phase_lo <= 3 && 3 < p.phase_hi) {
    phase3(p, smem, bid, nblk);
#if (REPEAT_MASK >> 3) & 1
    grid.sync();
    phase3(p, smem, bid, nblk);
#endif
    if (3 + 1 < p.phase_hi) grid.sync();
  }
#endif
#if !defined(ONLY) || ONLY==4
  if (p.phase_lo <= 4 && 4 < p.phase_hi) {
    phase4(p, smem, bid, nblk);
#if (REPEAT_MASK >> 4) & 1
    grid.sync();
    phase4(p, smem, bid, nblk);
#endif
    if (4 + 1 < p.phase_hi) grid.sync();
  }
#endif
#if !defined(ONLY) || ONLY==5
  if (p.phase_lo <= 5 && 5 < p.phase_hi) {
    phase5(p, smem, bid, nblk);
#if (REPEAT_MASK >> 5) & 1
    grid.sync();
    phase5(p, smem, bid, nblk);
#endif
    if (5 + 1 < p.phase_hi) grid.sync();
  }
#endif
#if !defined(ONLY) || ONLY==6
  if (p.phase_lo <= 6 && 6 < p.phase_hi) {
    phase6(p, smem, bid, nblk);
#if (REPEAT_MASK >> 6) & 1
    grid.sync();
    phase6(p, smem, bid, nblk);
#endif
    if (6 + 1 < p.phase_hi) grid.sync();
  }
#endif
#if !defined(ONLY) || ONLY==7
  if (p.phase_lo <= 7 && 7 < p.phase_hi) {
    phase7(p, smem, bid, nblk);
#if (REPEAT_MASK >> 7) & 1
    grid.sync();
    phase7(p, smem, bid, nblk);
#endif
    if (7 + 1 < p.phase_hi) grid.sync();
  }
#endif
#if !defined(ONLY) || ONLY==8
  if (p.phase_lo <= 8 && 8 < p.phase_hi) {
    phase8(p, smem, bid, nblk);
#if (REPEAT_MASK >> 8) & 1
    grid.sync();
    phase8(p, smem, bid, nblk);
#endif
    if (8 + 1 < p.phase_hi) grid.sync();
  }
#endif
#if !defined(ONLY) || ONLY==9
  if (p.phase_lo <= 9 && 9 < p.phase_hi) {
    phase9(p, smem, bid, nblk);
#if (REPEAT_MASK >> 9) & 1
    grid.sync();
    phase9(p, smem, bid, nblk);
#endif
    if (9 + 1 < p.phase_hi) grid.sync();
  }
#endif
#if !defined(ONLY) || ONLY==10
  if (p.phase_lo <= 10 && 10 < p.phase_hi) {
    phase10(p, bid, nblk);
#if (REPEAT_MASK >> 10) & 1
    grid.sync();
    phase10(p, bid, nblk);
#endif
    if (10 + 1 < p.phase_hi) grid.sync();
  }
#endif
#if !defined(ONLY) || ONLY==11
  if (p.phase_lo <= 11 && 11 < p.phase_hi) {
    phase11(p, smem, bid, nblk);
#if (REPEAT_MASK >> 11) & 1
    grid.sync();
    phase11(p, smem, bid, nblk);
#endif
    if (11 + 1 < p.phase_hi) grid.sync();
  }
#endif
#if !defined(ONLY) || ONLY==12
  if (p.phase_lo <= 12 && 12 < p.phase_hi) {
    phase12(p, bid, nblk);
#if (REPEAT_MASK >> 12) & 1
    grid.sync();
    phase12(p, bid, nblk);
#endif
    if (12 + 1 < p.phase_hi) grid.sync();
  }
#endif
#if !defined(ONLY) || ONLY==13
  if (p.phase_lo <= 13 && 13 < p.phase_hi) {
    phase13(p, smem, bid);
#if (REPEAT_MASK >> 13) & 1
    grid.sync();
    phase13(p, smem, bid);
#endif
    if (13 + 1 < p.phase_hi) grid.sync();
  }
#endif
#if !defined(ONLY) || ONLY==14
  if (p.phase_lo <= 14 && 14 < p.phase_hi) {
    phase14(p, bid, nblk);
#if (REPEAT_MASK >> 14) & 1
    grid.sync();
    phase14(p, bid, nblk);
#endif
    if (14 + 1 < p.phase_hi) grid.sync();
  }
#endif
#if !defined(ONLY) || ONLY==15
  if (p.phase_lo <= 15 && 15 < p.phase_hi) {
    phase15(p, smem, bid, nblk);
#if (REPEAT_MASK >> 15) & 1
    grid.sync();
    phase15(p, smem, bid, nblk);
#endif
    if (15 + 1 < p.phase_hi) grid.sync();
  }
#endif
#if !defined(ONLY) || ONLY==16
  if (p.phase_lo <= 16 && 16 < p.phase_hi) {
    phase16(p, smem, bid, nblk);
#if (REPEAT_MASK >> 16) & 1
    grid.sync();
    phase16(p, smem, bid, nblk);
#endif
    if (16 + 1 < p.phase_hi) grid.sync();
  }
#endif
#if !defined(ONLY) || ONLY==17
  if (p.phase_lo <= 17 && 17 < p.phase_hi) {
    phase17(p, bid, nblk);
#if (REPEAT_MASK >> 17) & 1
    grid.sync();
    phase17(p, bid, nblk);
#endif
    if (17 + 1 < p.phase_hi) grid.sync();
  }
#endif
}

extern "C" void kernel_launch(void* const* d_in, const int* in_sizes, int n_in, void* d_out, int out_size, void* d_ws, size_t ws_size,
                              hipStream_t stream) {
  static int grid_blocks = 0;
  if (!grid_blocks) {
    int dev = 0, cus = 0, per_cu = 0;
    (void)hipGetDevice(&dev);
    (void)hipDeviceGetAttribute(&cus, hipDeviceAttributeMultiprocessorCount, dev);
    (void)hipOccupancyMaxActiveBlocksPerMultiprocessor(&per_cu, mega, 256, 0);
    if (per_cu > 2) per_cu = 2;
    if (per_cu < 1) per_cu = 1;
    grid_blocks = cus * per_cu;
  }
  Params p{};
  const float* const* in = (const float* const*)d_in;
  p.x = in[0]; p.c = in[1]; p.w_ada = in[2]; p.b_ada = in[3]; p.g_pre_mix = in[4]; p.g_post_mix = in[5]; p.g_pre_ffn = in[6]; p.g_post_ffn = in[7];
  p.w_in = in[8]; p.rel_bias = in[9]; p.cmp_pe = in[10]; p.cmp_w1 = in[11]; p.cmp_b1 = in[12]; p.cmp_w2 = in[13]; p.dsa_kv_norm = in[14];
  p.dsa_w_uk = in[15]; p.dsa_w_uv = in[16]; p.w_bn = in[17]; p.w_bd = in[18]; p.w_out = in[19]; p.router_w = in[20]; p.router_bias = in[21];
  p.w_eg = in[22]; p.w_eu = in[23]; p.w_ed = in[24]; p.w_sg = in[25]; p.w_su = in[26]; p.w_sd = in[27];
  p.out = (float*)d_out;
  char* ws = (char*)d_ws;
  size_t off = 0;
  auto alloc = [&](size_t bytes) { char* r = ws + off; off += (bytes + 255) & ~(size_t)255; return r; };
  p.modp = (float*)alloc(16 * 2 * 6144 * 4);
  p.mod = (float*)alloc(2 * 6144 * 4);
  p.pe_part = (float*)alloc(16 * 256 * 4);
  p.w_ukT = (float*)alloc(8 * 64 * 128 * 4);
  p.counts = (int*)alloc(256 * 4);
  p.offs = (int*)alloc(257 * 4);
  p.tile_e = (int*)alloc(1536 * 4);
  p.tile_r0 = (int*)alloc(1536 * 4);
  p.tile_nr = (int*)alloc(1536 * 4);
  p.ntiles = (int*)alloc(4);
  p.h = (u16*)alloc((size_t)NTOK * 1024 * 2);
  p.proj = (u16*)alloc((size_t)NTOK * LDP * 2);
  p.widx = (float*)alloc((size_t)NTOK * 8 * 4);
  p.zc = (u16*)alloc((size_t)2 * 2048 * 128 * 2);
  p.kc = (u16*)alloc((size_t)4 * 512 * 64 * 2);
  p.vcT = (u16*)alloc((size_t)4 * 512 * 64 * 2);
  p.vts = (u16*)alloc((size_t)4 * 64 * T * 2);
  p.vtw = (u16*)alloc((size_t)4 * 64 * T * 2);
  p.qlat = (u16*)alloc((size_t)NTOK * 1024 * 2);
  p.ckv = (u16*)alloc((size_t)NTOK * 128 * 2);
  p.selk = (int*)alloc((size_t)NTOK * 256 * 4);
  p.onsa = (u16*)alloc((size_t)NTOK * 512 * 2);
  p.olat = (u16*)alloc((size_t)NTOK * 1024 * 2);
  p.odsa = (u16*)alloc((size_t)NTOK * 512 * 2);
  p.y = p.qlat;
  p.z = p.olat;
  p.eidx = (int*)alloc((size_t)NTOK * 8 * 4);
  p.ewt = (float*)alloc((size_t)NTOK * 8 * 4);
  p.erank = (int*)alloc((size_t)NTOK * 8 * 4);
  p.slot_tok = (int*)alloc((size_t)NSLOT * 4);
  p.slot_wt = (float*)alloc((size_t)NSLOT * 4);
  p.tok_slot = (int*)alloc((size_t)NTOK * 8 * 4);
  char* big = alloc((size_t)2 * T * T * 4);
  p.scores = (float*)big;
  {
    size_t o2 = 0;
    auto sub = [&](size_t bytes) { char* r = big + o2; o2 += (bytes + 255) & ~(size_t)255; return r; };
    p.H = (u16*)sub((size_t)NSLOT * 256 * 2);
    p.Y = (u16*)sub((size_t)NSLOT * 1024 * 2);
    p.x1 = (float*)sub((size_t)NTOK * 1024 * 4);
    p.logits = (float*)sub((size_t)NTOK * 256 * 4);
  }
  if (off > ws_size) fprintf(stderr, "workspace too small: need %zu have %zu\n", off, ws_size);
  p.phase_lo = 0;
  p.phase_hi = 18;
  void* args[] = {&p};
  hipError_t e = hipLaunchCooperativeKernel((void*)mega, dim3(grid_blocks), dim3(256), args, 0, stream);
  if (e != hipSuccess) fprintf(stderr, "coop launch failed: %s (grid %d)\n", hipGetErrorString(e), grid_blocks);
}
```

```cpp
#include <hip/hip_runtime.h>
#include <hip/hip_cooperative_groups.h>
#include <cstdio>
namespace cg = cooperative_groups;

#define DI __device__ __forceinline__
typedef unsigned short u16;
typedef unsigned long long u64;
using bf16x8 = __attribute__((ext_vector_type(8))) short;
using f32x16 = __attribute__((ext_vector_type(16))) float;

constexpr int T = 8192;
constexpr int NTOK = 16384;
constexpr int LDP = 4576;
constexpr int C_QN = 0, C_KV = 512, C_GN = 1280, C_QD = 1304, C_CKV = 1816, C_QI = 1944, C_KI = 2456, C_WI = 2520, C_GM = 2528;
constexpr int NSLOT = 131072 + 16384;
constexpr int LDS_BYTES = 73728 + 64;
#ifndef REPEAT_MASK
#define REPEAT_MASK 0
#endif

__device__ const unsigned char BUCKET[128] = {
  0, 1, 2, 3, 4, 5, 6, 7, 8, 9, 10, 11, 12, 13, 14, 15, 16, 16, 16, 17, 17, 18, 18, 18, 19, 19, 19, 20, 20, 20, 20, 21,
  21, 21, 21, 22, 22, 22, 22, 22, 23, 23, 23, 23, 23, 23, 24, 24, 24, 24, 24, 24, 25, 25, 25, 25, 25, 25, 25, 26, 26, 26, 26, 26,
  26, 26, 26, 27, 27, 27, 27, 27, 27, 27, 27, 27, 27, 28, 28, 28, 28, 28, 28, 28, 28, 28, 28, 29, 29, 29, 29, 29, 29, 29, 29, 29,
  29, 29, 29, 30, 30, 30, 30, 30, 30, 30, 30, 30, 30, 30, 30, 30, 30, 31, 31, 31, 31, 31, 31, 31, 31, 31, 31, 31, 31, 31, 31, 31};

struct Params {
  const float *x, *c, *w_ada, *b_ada, *g_pre_mix, *g_post_mix, *g_pre_ffn, *g_post_ffn, *w_in, *rel_bias;
  const float *cmp_pe, *cmp_w1, *cmp_b1, *cmp_w2, *dsa_kv_norm, *dsa_w_uk, *dsa_w_uv, *w_bn, *w_bd, *w_out;
  const float *router_w, *router_bias, *w_eg, *w_eu, *w_ed, *w_sg, *w_su, *w_sd;
  float* out;
  float* modp;
  float* mod;
  float* pe_part;
  float* w_ukT;
  u16 *w_inT, *w_bnT, *w_bdT, *w_outT, *routerT;
  u16* h;
  u16* proj;
  float* widx;
  u16* zc;
  u16* kc;
  u16* vcT;
  u16* vts;
  u16* vtw;
  u16* qlat;
  u16* ckv;
  float* scores;
  int* selk;
  u16* onsa;
  u16* olat;
  u16* odsa;
  u16* y;
  u16* z;
  float* x1;
  float* logits;
  int* eidx;
  float* ewt;
  int* erank;
  int* counts;
  int* offs;
  int* tile_e;
  int* tile_r0;
  int* tile_nr;
  int* ntiles;
  int* slot_tok;
  float* slot_wt;
  int* tok_slot;
  u16* H;
  u16* Y;
  unsigned* bar;
  int phase_lo, phase_hi;
};

DI float bf2f(u16 v) { return __uint_as_float(((unsigned)v) << 16); }
typedef __bf16 bf16x2_t __attribute__((ext_vector_type(2)));
typedef float f32x2_t __attribute__((ext_vector_type(2)));
DI unsigned pack2(float a, float b) { f32x2_t v = {a, b}; return __builtin_bit_cast(unsigned, __builtin_convertvector(v, bf16x2_t)); }
DI u16 f2bf(float x) { return (u16)(pack2(x, x) & 0xffffu); }
DI float lo16(unsigned u) { return __uint_as_float(u << 16); }
DI float hi16(unsigned u) { return __uint_as_float(u & 0xffff0000u); }
DI float wave_sum(float v) { for (int o = 32; o; o >>= 1) v += __shfl_xor(v, o); return v; }
DI float wave_max(float v) { for (int o = 32; o; o >>= 1) v = fmaxf(v, __shfl_xor(v, o)); return v; }
DI float rdlane(float v, int l) { return __int_as_float(__builtin_amdgcn_readlane(__float_as_int(v), l)); }
DI int rdlane_i(int v, int l) { return __builtin_amdgcn_readlane(v, l); }
DI int TIDX() { int t = threadIdx.x; asm volatile("" : "+v"(t)); return t; }
DI void cbar(const void* p) { asm volatile("" ::"v"(p) : "memory"); }
DI void wave_sync() { asm volatile("s_waitcnt lgkmcnt(0)" ::: "memory"); __builtin_amdgcn_wave_barrier(); }
DI float sigmoidf(float x) { return 1.f / (1.f + __expf(-x)); }
DI float siluf(float x) { return x / (1.f + __expf(-x)); }
DI float gelu_tanh(float x) { float u = 0.7978845608028654f * (x + 0.044715f * x * x * x); float e = __expf(2.f * u); float th = 1.f - 2.f / (e + 1.f); return 0.5f * x * (1.f + th); }


#define XB_TMO      128
#define XB_XCNT(j)  (256  + 64 * (j))
#define XB_XSUB(j)  (1280 + 64 * (j))
#define XB_XGEN(j)  (2304 + 64 * (j))
#define XB_TOP      3328
#define XB_TOPGEN   3392
#define XCD_BAR_WORDS 3456
#define XB_SPIN_CAP (1u << 22)
#define LAS __attribute__((address_space(3)))
DI unsigned xb_ld(unsigned* p) { return __hip_atomic_load(p, __ATOMIC_RELAXED, __HIP_MEMORY_SCOPE_AGENT); }
DI unsigned xb_add(unsigned* p, unsigned v) { return __hip_atomic_fetch_add(p, v, __ATOMIC_RELAXED, __HIP_MEMORY_SCOPE_AGENT); }
DI unsigned xb_xcc_id() { return (unsigned)__builtin_amdgcn_s_getreg((3 << 11) | 20) & 0xFu; }
#define XB_SPIN(cond, bar) do { unsigned _sp = 0; while (cond) { __builtin_amdgcn_s_sleep(1); \
    if ((++_sp & 255u) == 0u) { if (xb_ld(&(bar)[XB_TMO])) break; if (_sp > XB_SPIN_CAP) { atomicAdd(&(bar)[XB_TMO], 1u); break; } } } } while (0)
struct XcdBarrier { unsigned* bar; unsigned x; volatile LAS unsigned* st; };
DI XcdBarrier xcd_barrier_post(unsigned* bar, volatile LAS unsigned* st) {
  XcdBarrier b; b.bar = bar; b.x = xb_xcc_id(); b.st = st;
  if (threadIdx.x == 0) (void)xb_add(&bar[XB_XCNT(b.x)], 1u);
  return b;
}
DI void xcd_barrier_complete(unsigned* bar, unsigned x, unsigned& nloc, unsigned& nx) {
  const unsigned G = gridDim.x * gridDim.y * gridDim.z;
  unsigned sum, cnt, mine, sp = 0u;
  for (;;) {
    sum = 0u; cnt = 0u; mine = 0u;
#pragma unroll
    for (unsigned j = 0; j < 16; ++j) { const unsigned c = xb_ld(&bar[XB_XCNT(j)]); sum += c; cnt += (c > 0u) ? 1u : 0u; mine = (j == x) ? c : mine; }
    if (sum == G) break;
    __builtin_amdgcn_s_sleep(1);
    if ((++sp & 255u) == 0u) { if (xb_ld(&bar[XB_TMO])) break; if (sp > XB_SPIN_CAP) { atomicAdd(&bar[XB_TMO], 1u); break; } }
  }
  nloc = mine > 0u ? mine : 1u; nx = cnt > 0u ? cnt : 1u;
}
DI void xcd_barrier(const XcdBarrier& b) {
  asm volatile("s_waitcnt vmcnt(0)" ::: "memory");
  __syncthreads();
  if (threadIdx.x == 0) {
    unsigned* bar = b.bar;
    __builtin_amdgcn_s_waitcnt(0);
    unsigned nloc = b.st[0], nx = b.st[1];
    if (nloc == 0u) { xcd_barrier_complete(bar, b.x, nloc, nx); b.st[0] = nloc; b.st[1] = nx; }
    const unsigned old = xb_add(&bar[XB_XSUB(b.x)], 1u);
    const unsigned gen = old / nloc;
    if (old + 1u == (gen + 1u) * nloc) {
      __builtin_amdgcn_fence(__ATOMIC_RELEASE, "agent");
      asm volatile("s_waitcnt vmcnt(0)" ::: "memory");
      const unsigned og = xb_add(&bar[XB_TOP], 1u);
      const unsigned tg = og / nx;
      if (og + 1u == (tg + 1u) * nx) xb_add(&bar[XB_TOPGEN], 1u);
      else XB_SPIN(xb_ld(&bar[XB_TOPGEN]) == tg, bar);
      __builtin_amdgcn_fence(__ATOMIC_ACQUIRE, "agent");
      xb_add(&bar[XB_XGEN(b.x)], 1u);
      asm volatile("s_waitcnt vmcnt(0)" ::: "memory");
    } else {
      XB_SPIN(xb_ld(&bar[XB_XGEN(b.x)]) == gen, bar);
      __builtin_amdgcn_fence(__ATOMIC_ACQUIRE, "agent");
      asm volatile("s_waitcnt vmcnt(0)" ::: "memory");
    }
  }
  __syncthreads();
}

template <bool SWAP = true, bool SINGLE = false, bool BT16 = false, class AF, class BF, class EF>
DI void gemm_tile(char* smem, int nk, long a_kstep, const AF& af, const BF& bf, const EF& ef) {
  asm volatile("" ::: "memory");
  u16* As = (u16*)smem;
  const int tid = TIDX(), lane = tid & 63, wid = __builtin_amdgcn_readfirstlane(tid >> 6), wm = wid >> 1, wn = wid & 1;
  const int arow = tid >> 1, ahalf = tid & 1;
  const u16* ap = af(arow) + ahalf * 32;
  const int bkq = lane & 7, bnq = wid * 8 + (lane >> 3);
  const long ldb = bf.ldb;
  const float* bp = nullptr;
  const u16* bp16 = nullptr;
  if constexpr (BT16) bp16 = bf.row(arow) + ahalf * 32;
  else bp = bf(bnq * 4) + (long)(bkq * 4) * ldb;
  uint4 sa0_0, sa0_1, sa0_2, sa0_3, sa1_0, sa1_1, sa1_2, sa1_3;
  float4 sb0_0, sb0_1, sb0_2, sb0_3, sb0_4, sb0_5, sb0_6, sb0_7, sb1_0, sb1_1, sb1_2, sb1_3, sb1_4, sb1_5, sb1_6, sb1_7;
  uint4 tb0_0, tb0_1, tb0_2, tb0_3, tb1_0, tb1_1, tb1_2, tb1_3;
  f32x16 acc[2][2];
#pragma unroll
  for (int a = 0; a < 2; ++a)
#pragma unroll
    for (int b = 0; b < 2; ++b)
#pragma unroll
      for (int i = 0; i < 16; ++i) acc[a][b][i] = 0.f;

#define GEMM_LOAD(S, KT)                                                                  \
  {                                                                                       \
    const uint4* pa_ = (const uint4*)(ap + (long)(KT) * a_kstep);                         \
    sa##S##_0 = pa_[0]; sa##S##_1 = pa_[1]; sa##S##_2 = pa_[2]; sa##S##_3 = pa_[3];       \
    if constexpr (BT16) {                                                                 \
      const uint4* pt_ = (const uint4*)(bp16 + (long)(KT) * 64);                          \
      tb##S##_0 = pt_[0]; tb##S##_1 = pt_[1]; tb##S##_2 = pt_[2]; tb##S##_3 = pt_[3];     \
    } else {                                                                              \
      const float* pb_ = bp + (long)(KT) * 64 * ldb;                                      \
      sb##S##_0 = *(const float4*)(pb_);                                                  \
      sb##S##_1 = *(const float4*)(pb_ + ldb);                                            \
      sb##S##_2 = *(const float4*)(pb_ + 2 * ldb);                                        \
      sb##S##_3 = *(const float4*)(pb_ + 3 * ldb);                                        \
      sb##S##_4 = *(const float4*)(pb_ + 32 * ldb);                                       \
      sb##S##_5 = *(const float4*)(pb_ + 33 * ldb);                                       \
      sb##S##_6 = *(const float4*)(pb_ + 34 * ldb);                                       \
      sb##S##_7 = *(const float4*)(pb_ + 35 * ldb);                                       \
    }                                                                                     \
  }
#define GEMM_BW(V0, V1, V2, V3, C, I, QOFF)                                               \
  {                                                                                       \
    uint2 w_;                                                                             \
    w_.x = pack2(V0.C, V1.C);                                                             \
    w_.y = pack2(V2.C, V3.C);                                                             \
    *(uint2*)&Bs_[(bnq * 4 + (I)) * 72 + (QOFF) + bkq * 4] = w_;                          \
  }
#define GEMM_STORE(S, BUF)                                                                \
  {                                                                                       \
    u16* As_ = As + (BUF) * (2 * 128 * 72);                                               \
    u16* Bs_ = As_ + 128 * 72;                                                            \
    uint4* da_ = (uint4*)&As_[arow * 72 + ahalf * 32];                                    \
    da_[0] = sa##S##_0; da_[1] = sa##S##_1; da_[2] = sa##S##_2; da_[3] = sa##S##_3;       \
    if constexpr (BT16) {                                                                 \
      uint4* db_ = (uint4*)&Bs_[arow * 72 + ahalf * 32];                                  \
      db_[0] = tb##S##_0; db_[1] = tb##S##_1; db_[2] = tb##S##_2; db_[3] = tb##S##_3;     \
    } else {                                                                              \
      GEMM_BW(sb##S##_0, sb##S##_1, sb##S##_2, sb##S##_3, x, 0, 0)                        \
      GEMM_BW(sb##S##_0, sb##S##_1, sb##S##_2, sb##S##_3, y, 1, 0)                        \
      GEMM_BW(sb##S##_0, sb##S##_1, sb##S##_2, sb##S##_3, z, 2, 0)                        \
      GEMM_BW(sb##S##_0, sb##S##_1, sb##S##_2, sb##S##_3, w, 3, 0)                        \
      GEMM_BW(sb##S##_4, sb##S##_5, sb##S##_6, sb##S##_7, x, 0, 32)                       \
      GEMM_BW(sb##S##_4, sb##S##_5, sb##S##_6, sb##S##_7, y, 1, 32)                       \
      GEMM_BW(sb##S##_4, sb##S##_5, sb##S##_6, sb##S##_7, z, 2, 32)                       \
      GEMM_BW(sb##S##_4, sb##S##_5, sb##S##_6, sb##S##_7, w, 3, 32)                       \
    }                                                                                     \
  }
#define GEMM_COMPUTE(BUF)                                                                 \
  {                                                                                       \
    const u16* Ac = As + (BUF) * (2 * 128 * 72);                                          \
    const u16* Bc = Ac + 128 * 72;                                                        \
    _Pragma("unroll") for (int ks = 0; ks < 4; ++ks) {                                    \
      bf16x8 a[2], b[2];                                                                  \
      _Pragma("unroll") for (int mt = 0; mt < 2; ++mt) a[mt] = *(const bf16x8*)&Ac[(wm * 64 + mt * 32 + (lane & 31)) * 72 + ks * 16 + (lane >> 5) * 8]; \
      _Pragma("unroll") for (int nt = 0; nt < 2; ++nt) b[nt] = *(const bf16x8*)&Bc[(wn * 64 + nt * 32 + (lane & 31)) * 72 + ks * 16 + (lane >> 5) * 8]; \
      _Pragma("unroll") for (int mt = 0; mt < 2; ++mt)                                    \
      _Pragma("unroll") for (int nt = 0; nt < 2; ++nt)                                    \
        acc[mt][nt] = SWAP ? __builtin_amdgcn_mfma_f32_32x32x16_bf16(b[nt], a[mt], acc[mt][nt], 0, 0, 0) \
                           : __builtin_amdgcn_mfma_f32_32x32x16_bf16(a[mt], b[nt], acc[mt][nt], 0, 0, 0); \
    }                                                                                     \
  }
  GEMM_LOAD(0, 0)
  __syncthreads();
  if (SINGLE) {
    GEMM_STORE(0, 0)
    __syncthreads();
    GEMM_COMPUTE(0)
  } else {
    GEMM_LOAD(1, 1)
    GEMM_STORE(0, 0)
    __syncthreads();
    const int last = nk - 1;
    for (int kt = 0; kt < nk; kt += 2) {
      const int k2 = kt + 2 < last ? kt + 2 : last, k3 = kt + 3 < last ? kt + 3 : last;
      GEMM_LOAD(0, k2)
      asm volatile("" ::: "memory");
      GEMM_COMPUTE(0)
      asm volatile("" ::: "memory");
      GEMM_STORE(1, 1)
      __syncthreads();
      GEMM_LOAD(1, k3)
      asm volatile("" ::: "memory");
      GEMM_COMPUTE(1)
      asm volatile("" ::: "memory");
      GEMM_STORE(0, 0)
      __syncthreads();
    }
  }
#undef GEMM_LOAD
#undef GEMM_STORE
#undef GEMM_BW
#undef GEMM_COMPUTE
  ef(acc, wm, wn, lane);
}

#define EPI_FOR                                                   \
  _Pragma("unroll") for (int mt = 0; mt < 2; ++mt)                \
  _Pragma("unroll") for (int nt = 0; nt < 2; ++nt)                \
  _Pragma("unroll") for (int i = 0; i < 16; ++i)
#define EPI_R (wm * 64 + mt * 32 + (i & 3) + 8 * (i >> 2) + 4 * (lane >> 5))
#define EPI_C (wn * 64 + nt * 32 + (lane & 31))
#define SW_FOR                                                    \
  _Pragma("unroll") for (int mt = 0; mt < 2; ++mt)                \
  _Pragma("unroll") for (int nt = 0; nt < 2; ++nt)                \
  _Pragma("unroll") for (int q4 = 0; q4 < 4; ++q4)
#define SW_R (wm * 64 + mt * 32 + (lane & 31))
#define SW_C0 (wn * 64 + nt * 32 + 8 * q4 + 4 * (lane >> 5))
#define SW_V(j) acc[mt][nt][4 * q4 + (j)]
DI uint2 pack4(float a, float b, float c, float d) { uint2 w; w.x = pack2(a, b); w.y = pack2(c, d); return w; }

struct ARows { const u16* base; long ld; int nrows; DI const u16* operator()(int r) const { return base + (long)(r < nrows ? r : 0) * ld; } };
struct BMat { const float* base; long ldb; int ncols; DI const float* operator()(int c4) const { return base + (c4 < ncols ? c4 : 0); } DI const u16* row(int) const { return nullptr; } };
struct BMatT { const u16* base; long ldb; DI const float* operator()(int) const { return nullptr; } DI const u16* row(int n) const { return base + (long)n * ldb; } };

DI void phase0(const Params& p, char* smem, int bid, int nblk) {
  const int tid = TIDX();
  for (int item = bid; item < 384 + 256 + 16 + 1 + 1728; item += nblk) {
    if (item < 384) {
      const int cc = item % 24, kc = item / 24;
      const int col = cc * 256 + tid;
      float a0 = 0.f, a1 = 0.f;
      for (int k = kc * 64; k < kc * 64 + 64; ++k) {
        const float w = p.w_ada[(long)k * 6144 + col];
        a0 += siluf(p.c[k]) * w;
        a1 += siluf(p.c[1024 + k]) * w;
      }
      p.modp[(kc * 2 + 0) * 6144 + col] = a0;
      p.modp[(kc * 2 + 1) * 6144 + col] = a1;
    } else if (item < 640) {
      const int idx = (item - 384) * 256 + tid;
      const int c = idx & 127, d = (idx >> 7) & 63, h = idx >> 13;
      p.w_ukT[idx] = p.dsa_w_uk[c * 512 + h * 64 + d];
    } else if (item < 656) {
      const int part = item - 640;
      const int slot = tid >> 7, kk = tid & 127;
      float a = 0.f;
      for (int ld = part * 128; ld < part * 128 + 128; ++ld) a += p.cmp_pe[slot * 2048 + ld] * p.cmp_w1[((long)slot * 2048 + ld) * 128 + kk];
      p.pe_part[part * 256 + tid] = a;
    } else if (item == 656) {
      p.counts[tid] = 0;
    } else {
      int it = item - 657;
      const float* W; u16* WT; int K, N, ntn;
      if (it < 1152) { W = p.w_in; WT = p.w_inT; K = 1024; N = LDP; ntn = 72; }
      else if (it < 1280) { it -= 1152; W = p.w_bn; WT = p.w_bnT; K = 512; N = 1024; ntn = 16; }
      else if (it < 1408) { it -= 1280; W = p.w_bd; WT = p.w_bdT; K = 512; N = 1024; ntn = 16; }
      else if (it < 1664) { it -= 1408; W = p.w_out; WT = p.w_outT; K = 1024; N = 1024; ntn = 16; }
      else { it -= 1664; W = p.router_w; WT = p.routerT; K = 1024; N = 256; ntn = 4; }
      const int k0 = (it / ntn) * 64, n0 = (it % ntn) * 64;
      u16* tl = (u16*)smem;
      __syncthreads();
      const int kr = tid >> 4, nq = tid & 15;
#pragma unroll
      for (int ps = 0; ps < 4; ++ps) {
        const int k = kr + 16 * ps, n = n0 + nq * 4;
        float4 v = make_float4(0.f, 0.f, 0.f, 0.f);
        if (n < N) v = *(const float4*)(W + (long)(k0 + k) * N + n);
        tl[(nq * 4 + 0) * 72 + k] = f2bf(v.x);
        tl[(nq * 4 + 1) * 72 + k] = f2bf(v.y);
        tl[(nq * 4 + 2) * 72 + k] = f2bf(v.z);
        tl[(nq * 4 + 3) * 72 + k] = f2bf(v.w);
      }
      __syncthreads();
      const int nr = tid >> 2, piece = tid & 3;
      const uint4 a = *(const uint4*)(tl + nr * 72 + piece * 16);
      const uint4 b = *(const uint4*)(tl + nr * 72 + piece * 16 + 8);
      uint4* dst = (uint4*)(WT + (long)(n0 + nr) * K + k0 + piece * 16);
      dst[0] = a; dst[1] = b;
    }
  }
}

DI void phase1(const Params& p, char* smem, int bid, int nblk) {
  const int tid = TIDX(), lane = tid & 63, wid = __builtin_amdgcn_readfirstlane(tid >> 6);
  float* modl = (float*)smem;
  for (int idx = tid; idx < 4096; idx += 256) {
    const int b = idx >> 11, n = idx & 2047;
    float v = p.b_ada[n];
    for (int kc = 0; kc < 16; ++kc) v += p.modp[(kc * 2 + b) * 6144 + n];
    modl[idx] = v;
  }
  if (bid < 48) {
    const int idx = bid * 256 + tid;
    const int b = idx / 6144, n = idx % 6144;
    float v = p.b_ada[n];
    for (int kc = 0; kc < 16; ++kc) v += p.modp[(kc * 2 + b) * 6144 + n];
    p.mod[idx] = v;
  }
  __syncthreads();
  for (int row = bid * 4 + wid; row < NTOK; row += nblk * 4) {
    const int b = row >> 13;
    const float* xr = p.x + (long)row * 1024;
    float4 v[4];
    float ss = 0.f;
#pragma unroll
    for (int i = 0; i < 4; ++i) {
      v[i] = *(const float4*)(xr + i * 256 + lane * 4);
      ss += v[i].x * v[i].x + v[i].y * v[i].y + v[i].z * v[i].z + v[i].w * v[i].w;
    }
    ss = wave_sum(ss);
    const float r = rsqrtf(ss * (1.f / 1024.f) + 1e-6f);
#pragma unroll
    for (int i = 0; i < 4; ++i) {
      const int col = i * 256 + lane * 4;
      const float4 g = *(const float4*)(p.g_pre_mix + col);
      const float* sh = modl + b * 2048 + col;
      const float* sc = modl + b * 2048 + 1024 + col;
      const float o0 = v[i].x * r * g.x * (1.f + sc[0]) + sh[0];
      const float o1 = v[i].y * r * g.y * (1.f + sc[1]) + sh[1];
      const float o2 = v[i].z * r * g.z * (1.f + sc[2]) + sh[2];
      const float o3 = v[i].w * r * g.w * (1.f + sc[3]) + sh[3];
      uint2 w;
      w.x = pack2(o0, o1);
      w.y = pack2(o2, o3);
      *(uint2*)(p.h + (long)row * 1024 + col) = w;
    }
  }
}

struct EpiProj {
  u16* proj; float* widx; int m0, n0;
  DI void operator()(f32x16 (&acc)[2][2], int wm, int wn, int lane) const {
    SW_FOR {
      const int r = m0 + SW_R, c = n0 + SW_C0;
      if (c < LDP) {
        float v[4] = {SW_V(0), SW_V(1), SW_V(2), SW_V(3)};
        if (c < C_KV) { for (int j = 0; j < 4; ++j) v[j] *= 0.125f; }
        else if (c < C_GN) {}
        else if (c < C_QD) { for (int j = 0; j < 4; ++j) v[j] = sigmoidf(v[j]); }
        else if (c < C_QI) {}
        else if (c < C_KI) { for (int j = 0; j < 4; ++j) v[j] *= 0.125f; }
        else if (c < C_WI) {}
        else if (c < C_GM) {
          for (int j = 0; j < 4; ++j) v[j] *= 0.35355339059327373f;
          *(float4*)(widx + (long)r * 8 + (c - C_WI)) = make_float4(v[0], v[1], v[2], v[3]);
        } else { for (int j = 0; j < 4; ++j) v[j] = sigmoidf(v[j]); }
        *(uint2*)(proj + (long)r * LDP + c) = pack4(v[0], v[1], v[2], v[3]);
      }
    }
  }
};
struct EpiProjVT {
  u16* vt; int m0;
  DI void operator()(f32x16 (&acc)[2][2], int wm, int wn, int lane) const {
#pragma unroll
    for (int mt = 0; mt < 2; ++mt)
#pragma unroll
      for (int nt = 0; nt < 2; ++nt) {
        const int cc = EPI_C;
#pragma unroll
        for (int q4 = 0; q4 < 4; ++q4) {
          const int r = m0 + wm * 64 + mt * 32 + 8 * q4 + 4 * (lane >> 5);
          const int b = r >> 13, t = r & 8191;
          uint2 w;
          w.x = pack2(acc[mt][nt][q4 * 4 + 0], acc[mt][nt][q4 * 4 + 1]);
          w.y = pack2(acc[mt][nt][q4 * 4 + 2], acc[mt][nt][q4 * 4 + 3]);
          *(uint2*)(vt + ((long)(b * 128 + cc)) * T + t) = w;
        }
      }
  }
};
DI void phase2(const Params& p, char* smem, int bid, int nblk) {
  for (int item = bid; item < 128 * 36; item += nblk) {
    const int mt_ = item / 36, nt_ = item % 36;
    ARows af{p.h + (long)mt_ * 128 * 1024, 1024, 128};
    BMatT bf{p.w_inT + (long)nt_ * 128 * 1024, 1024};
    if (nt_ == 7 || nt_ == 9) {
      EpiProjVT ef{nt_ == 7 ? p.vts : p.vtw, mt_ * 128};
      gemm_tile<false, false, true>(smem, 16, 64, af, bf, ef);
    } else {
      EpiProj ef{p.proj, p.widx, mt_ * 128, nt_ * 128};
      gemm_tile<true, false, true>(smem, 16, 64, af, bf, ef);
    }
  }
}

struct ACmp {
  const u16* proj; int slot, m0;
  DI const u16* operator()(int r) const {
    const int R = m0 + r, bg = R >> 9, n = R & 511, b = bg >> 1, g = bg & 1;
    const int nc = n >= 511 ? 510 : n;
    return proj + ((long)b * T + 16 * nc) * LDP + C_KV + slot * 128 + g * 64;
  }
};
struct EpiCmp1 {
  u16* zc; const float* b1; const float* pe_part; int slot, m0;
  DI void operator()(f32x16 (&acc)[2][2], int wm, int wn, int lane) const {
#pragma unroll
    for (int nt = 0; nt < 2; ++nt)
#pragma unroll
      for (int q4 = 0; q4 < 4; ++q4) {
        const int c = SW_C0;
        float4 bias = *(const float4*)(b1 + slot * 128 + c);
        for (int q = 0; q < 16; ++q) {
          const float4 t = *(const float4*)(pe_part + q * 256 + slot * 128 + c);
          bias.x += t.x; bias.y += t.y; bias.z += t.z; bias.w += t.w;
        }
#pragma unroll
        for (int mt = 0; mt < 2; ++mt) {
          const int R = m0 + SW_R;
          *(uint2*)(zc + ((long)slot * 2048 + R) * 128 + c) =
              pack4(gelu_tanh(SW_V(0) + bias.x), gelu_tanh(SW_V(1) + bias.y), gelu_tanh(SW_V(2) + bias.z), gelu_tanh(SW_V(3) + bias.w));
        }
      }
  }
};
struct EpiQlat {
  u16* qlat; int h, m0;
  DI void operator()(f32x16 (&acc)[2][2], int wm, int wn, int lane) const {
    SW_FOR {
      const int r = m0 + SW_R, c = SW_C0;
      *(uint2*)(qlat + ((long)r * 8 + h) * 128 + c) = pack4(SW_V(0) * 0.125f, SW_V(1) * 0.125f, SW_V(2) * 0.125f, SW_V(3) * 0.125f);
    }
  }
};
DI void phase3(const Params& p, char* smem, int bid, int nblk) {
  const int tid = TIDX(), lane = tid & 63, wid = __builtin_amdgcn_readfirstlane(tid >> 6);
  for (int item = bid; item < 32 + 1024 + 512; item += nblk) {
    if (item < 32) {
      const int slot = item >> 4, mt_ = item & 15;
      ACmp af{p.proj, slot, mt_ * 128};
      BMat bf{p.cmp_w1 + (long)slot * 2048 * 128, 128, 128};
      EpiCmp1 ef{p.zc, p.cmp_b1, p.pe_part, slot, mt_ * 128};
      gemm_tile(smem, 32, LDP, af, bf, ef);
    } else if (item < 1056) {
      const int it = item - 32, h = it & 7, mt_ = it >> 3;
      ARows af{p.proj + (long)mt_ * 128 * LDP + C_QD + h * 64, LDP, 128};
      BMat bf{p.w_ukT + h * 64 * 128, 128, 128};
      EpiQlat ef{p.qlat, h, mt_ * 128};
      gemm_tile<true, true>(smem, 1, 64, af, bf, ef);
    } else {
      const int it = item - 1056;
      for (int q = 0; q < 8; ++q) {
        const int row = it * 32 + wid * 8 + q;
        const unsigned u = *(const unsigned*)(p.proj + (long)row * LDP + C_CKV + lane * 2);
        const float a = lo16(u), b = hi16(u);
        const float ss = wave_sum(a * a + b * b);
        const float r = rsqrtf(ss * (1.f / 128.f) + 1e-6f);
        *(unsigned*)(p.ckv + (long)row * 128 + lane * 2) = pack2(a * r * p.dsa_kv_norm[lane * 2], b * r * p.dsa_kv_norm[lane * 2 + 1]);
      }
    }
  }
}

struct EpiCmp2 {
  u16* dst; int m0;
  DI void operator()(f32x16 (&acc)[2][2], int wm, int wn, int lane) const {
    SW_FOR {
      const int R = m0 + SW_R, c = SW_C0;
      if (c < 64) *(uint2*)(dst + (long)R * 64 + c) = pack4(SW_V(0), SW_V(1), SW_V(2), SW_V(3));
    }
  }
};
struct EpiCmp2T {
  u16* dst; int m0;
  DI void operator()(f32x16 (&acc)[2][2], int wm, int wn, int lane) const {
#pragma unroll
    for (int mt = 0; mt < 2; ++mt)
#pragma unroll
      for (int nt = 0; nt < 2; ++nt) {
        const int c = EPI_C;
        if (c < 64) {
#pragma unroll
          for (int q4 = 0; q4 < 4; ++q4) {
            const int R = m0 + wm * 64 + mt * 32 + 8 * q4 + 4 * (lane >> 5);
            const int bg = R >> 9, n = R & 511;
            *(uint2*)(dst + ((long)(bg * 64 + c)) * 512 + n) =
                pack4(acc[mt][nt][q4 * 4 + 0], acc[mt][nt][q4 * 4 + 1], acc[mt][nt][q4 * 4 + 2], acc[mt][nt][q4 * 4 + 3]);
          }
        }
      }
  }
};
DI void indexer_item(const Params& p, char* smem, int item) {
  const int tid = TIDX(), lane = tid & 63, wid = __builtin_amdgcn_readfirstlane(tid >> 6);
  int b = 0, rem = item;
  if (rem >= 2080) { b = 1; rem -= 2080; }
  int qt = (int)((sqrtf(8.f * rem + 1.f) - 1.f) * 0.5f);
  while ((qt + 1) * (qt + 2) / 2 <= rem) ++qt;
  while (qt * (qt + 1) / 2 > rem) --qt;
  const int kt = rem - qt * (qt + 1) / 2;
  const int t0 = qt * 128 + (wid >> 1) * 64, s0 = kt * 128 + (wid & 1) * 64;
  if (s0 > t0 + 63) return;
  float* wl = (float*)smem + wid * 512;
  const float* wsrc = p.widx + ((long)b * T + t0) * 8;
#pragma unroll
  for (int i = 0; i < 8; ++i) wl[i * 64 + lane] = wsrc[i * 64 + lane];
  wave_sync();
  const u16* projb = p.proj + (long)b * T * LDP;
  const int r31 = lane & 31, hf = lane >> 5;
  bf16x8 bfr[2][4];
#pragma unroll
  for (int nt = 0; nt < 2; ++nt)
#pragma unroll
    for (int ks = 0; ks < 4; ++ks) bfr[nt][ks] = *(const bf16x8*)(projb + (long)(s0 + nt * 32 + r31) * LDP + C_KI + ks * 16 + hf * 8);
  f32x16 sum[2][2];
#pragma unroll
  for (int a = 0; a < 2; ++a)
#pragma unroll
    for (int c = 0; c < 2; ++c)
#pragma unroll
      for (int i = 0; i < 16; ++i) sum[a][c][i] = 0.f;
  for (int h = 0; h < 8; ++h) {
    bf16x8 afr[2][4];
#pragma unroll
    for (int mt = 0; mt < 2; ++mt)
#pragma unroll
      for (int ks = 0; ks < 4; ++ks) afr[mt][ks] = *(const bf16x8*)(projb + (long)(t0 + mt * 32 + r31) * LDP + C_QI + h * 64 + ks * 16 + hf * 8);
#pragma unroll
    for (int mt = 0; mt < 2; ++mt)
#pragma unroll
      for (int nt = 0; nt < 2; ++nt) {
        f32x16 acc;
#pragma unroll
        for (int i = 0; i < 16; ++i) acc[i] = 0.f;
#pragma unroll
        for (int ks = 0; ks < 4; ++ks) acc = __builtin_amdgcn_mfma_f32_32x32x16_bf16(afr[mt][ks], bfr[nt][ks], acc, 0, 0, 0);
#pragma unroll
        for (int i = 0; i < 16; ++i) {
          const int row = mt * 32 + (i & 3) + 8 * (i >> 2) + 4 * hf;
          sum[mt][nt][i] += wl[row * 8 + h] * fmaxf(acc[i], 0.f);
        }
      }
  }
#pragma unroll
  for (int mt = 0; mt < 2; ++mt)
#pragma unroll
    for (int nt = 0; nt < 2; ++nt)
#pragma unroll
      for (int i = 0; i < 16; ++i) {
        const int row = mt * 32 + (i & 3) + 8 * (i >> 2) + 4 * hf;
        p.scores[((long)b * T + t0 + row) * T + s0 + nt * 32 + r31] = sum[mt][nt][i];
      }
}
DI void phase4(const Params& p, char* smem, int bid, int nblk) {
  for (int item = bid; item < 32 + 4160; item += nblk) {
    __syncthreads();
    if (item < 32) {
      const int slot = item >> 4, mt_ = item & 15;
      ARows af{p.zc + ((long)slot * 2048 + mt_ * 128) * 128, 128, 128};
      BMat bf{p.cmp_w2 + slot * 128 * 64, 64, 64};
      if (slot) { EpiCmp2T ef{p.vcT, mt_ * 128}; gemm_tile<false>(smem, 2, 64, af, bf, ef); }
      else { EpiCmp2 ef{p.kc, mt_ * 128}; gemm_tile(smem, 2, 64, af, bf, ef); }
    } else {
      indexer_item(p, smem, item - 32);
    }
  }
}

using f32x4 = __attribute__((ext_vector_type(4))) float;
#define MFMA16(a, b, c) __builtin_amdgcn_mfma_f32_16x16x32_bf16((a), (b), (c), 0, 0, 0)
#define MFMA32(a, b, c) __builtin_amdgcn_mfma_f32_32x32x16_bf16((a), (b), (c), 0, 0, 0)

constexpr int NSA_STAGE_BYTES = 64 * 72 * 2 + 64 * 68 * 2;
DI void dense_scores(f32x16 (&acc)[2], const u16* Ks, const bf16x8 (&qf)[4], int lane) {
  const int r = lane & 31, hf = lane >> 5;
#pragma unroll
  for (int tile = 0; tile < 2; ++tile) {
    const u16* kp = Ks + (32 * tile + r) * 72 + 8 * hf;
    f32x16 c;
#pragma unroll
    for (int i = 0; i < 16; ++i) c[i] = 0.f;
#pragma unroll
    for (int ks = 0; ks < 4; ++ks) c = MFMA32(*(const bf16x8*)(kp + 16 * ks), qf[ks], c);
    acc[tile] = c;
  }
}
DI void dense_pv(const f32x16 (&acc)[2], const u16* Vs, int lane, f32x16 (&o)[2]) {
  const int r = lane & 31, hf = lane >> 5;
#pragma unroll
  for (int tile = 0; tile < 2; ++tile)
#pragma unroll
    for (int s = 0; s < 2; ++s) {
      uint4 w;
      w.x = pack2(acc[tile][8 * s + 0], acc[tile][8 * s + 1]);
      w.y = pack2(acc[tile][8 * s + 2], acc[tile][8 * s + 3]);
      w.z = pack2(acc[tile][8 * s + 4], acc[tile][8 * s + 5]);
      w.w = pack2(acc[tile][8 * s + 6], acc[tile][8 * s + 7]);
      const bf16x8 pb = __builtin_bit_cast(bf16x8, w);
#pragma unroll
      for (int dt = 0; dt < 2; ++dt) {
        const u16* vp = Vs + (32 * dt + r) * 68 + 32 * tile + 16 * s + 4 * hf;
        const uint2 lo = *(const uint2*)vp;
        const uint2 hi = *(const uint2*)(vp + 8);
        uint4 a;
        a.x = lo.x; a.y = lo.y; a.z = hi.x; a.w = hi.y;
        o[dt] = MFMA32(__builtin_bit_cast(bf16x8, a), pb, o[dt]);
      }
    }
}
constexpr float LOG2E = 1.4426950408889634f;
template <int DSTEP>
DI float dense_mask(f32x16 (&acc)[2], bool active, int lo_c, int hi_c, int dist0_c, int dmin_u, const float* btab_h, int lane) {
  const int hf = lane >> 5;
  const bool colfull = !active || (lo_c <= 0 && hi_c >= 63);
  float mx = -INFINITY;
  if (dmin_u >= 128 && __ballot(colfull) == ~0ull) {
    const float be = active ? btab_h[128] : -INFINITY;
#pragma unroll
    for (int tile = 0; tile < 2; ++tile)
#pragma unroll
      for (int i = 0; i < 16; ++i) {
        const float sv = fmaf(acc[tile][i], LOG2E, be);
        acc[tile][i] = sv;
        mx = fmaxf(mx, sv);
      }
  } else {
    const int lo2 = active ? lo_c : 1, hi2 = active ? hi_c : 0;
#pragma unroll
    for (int tile = 0; tile < 2; ++tile)
#pragma unroll
      for (int i = 0; i < 16; ++i) {
        const int kl = 32 * tile + (i & 3) + 8 * (i >> 2) + 4 * hf;
        int dc = dist0_c - DSTEP * kl;
        dc = dc < 0 ? 0 : (dc > 128 ? 128 : dc);
        const float bias = btab_h[dc];
        const float s2 = fmaf(acc[tile][i], LOG2E, bias);
        const float sv = (kl >= lo2 && kl <= hi2) ? s2 : -INFINITY;
        acc[tile][i] = sv;
        mx = fmaxf(mx, sv);
      }
  }
  return fmaxf(mx, __shfl_xor(mx, 32));
}
DI void dense_chunk(const u16* Ks, const u16* Vs, bool active, int lo_c, int hi_c, int dist0_c, int dmin_u, const bf16x8 (&qf)[4],
                    const float* btab_h, int lane, float& m, float& l, f32x16 (&o)[2]) {
  f32x16 acc[2];
  dense_scores(acc, Ks, qf, lane);
  const float mx = dense_mask<1>(acc, active, lo_c, hi_c, dist0_c, dmin_u, btab_h, lane);
  const float mn = fmaxf(m, mx);
  const float alpha = __builtin_amdgcn_exp2f(m - mn);
  float ls = 0.f;
#pragma unroll
  for (int tile = 0; tile < 2; ++tile)
#pragma unroll
    for (int i = 0; i < 16; ++i) {
      const float pv = __builtin_amdgcn_exp2f(acc[tile][i] - mn);
      acc[tile][i] = pv;
      ls += pv;
    }
  ls += __shfl_xor(ls, 32);
  l = l * alpha + ls;
  m = mn;
  o[0] *= alpha;
  o[1] *= alpha;
  dense_pv(acc, Vs, lane, o);
}

template <int KSG, int VSG, bool NEEDV, class Next, class Body>
DI void chunk_pipeline(char* stage, const u16* kg0, const u16* vg0, int first, int tid, const Next& next, const Body& body) {
  const int srow = tid >> 2, spiece = tid & 3;
  uint4 rk0, rk1, rv0, rv1;
  rv0 = rv1 = make_uint4(0, 0, 0, 0);
  int d = first;
#define NSA_GLOAD(D)                                                                      \
  {                                                                                       \
    const uint4* pk_ = (const uint4*)(kg0 + ((long)(D) * 64 + srow) * KSG + spiece * 16); \
    rk0 = pk_[0]; rk1 = pk_[1];                                                           \
    if (NEEDV) {                                                                          \
      const uint4* pv_ = (const uint4*)(vg0 + (long)srow * VSG + (D) * 64 + spiece * 16); \
      rv0 = pv_[0]; rv1 = pv_[1];                                                         \
    }                                                                                     \
  }
  if (d >= 0) NSA_GLOAD(d)
  int ph = 0;
  __syncthreads();
  while (d >= 0) {
    u16* Ks = (u16*)(stage + ph * NSA_STAGE_BYTES);
    u16* Vs = Ks + 64 * 72;
    *(uint4*)(Ks + srow * 72 + spiece * 16) = rk0;
    *(uint4*)(Ks + srow * 72 + spiece * 16 + 8) = rk1;
    if (NEEDV) {
      uint2* dv = (uint2*)(Vs + srow * 68 + spiece * 16);
      dv[0] = make_uint2(rv0.x, rv0.y); dv[1] = make_uint2(rv0.z, rv0.w);
      dv[2] = make_uint2(rv1.x, rv1.y); dv[3] = make_uint2(rv1.z, rv1.w);
    }
    const int dn = next(d);
    if (dn >= 0) NSA_GLOAD(dn)
    __syncthreads();
    body(d, Ks, Vs);
    ph ^= 1;
    d = dn;
  }
#undef NSA_GLOAD
}

DI void nsa_item(const Params& p, char* smem, int item) {
  const int tid = TIDX(), lane = tid & 63, wid = __builtin_amdgcn_readfirstlane(tid >> 6);
  const int chunk = item & 255, g = (item >> 8) & 1, b = item >> 9;
  const int bg = b * 2 + g;
  float* btab = (float*)smem;
  u64* wun = (u64*)(smem + 2304);
  float* imps = (float*)(smem + 4096) + wid * 1056;
  char* stage = smem + 21504;
  for (int idx = tid; idx < 4 * 129; idx += 256) {
    const int h = idx / 129, d = idx % 129;
    const int bk = d < 128 ? BUCKET[d] : 31;
    btab[h * 132 + d] = p.rel_bias[bk * 16 + g * 4 + h] * LOG2E;
  }
  __syncthreads();
  const int t0 = chunk * 32;
  const int tw = t0 + wid * 8;
  const int c = lane & 31, hf = lane >> 5, qi = c >> 2, hh = c & 3;
  const int t_c = tw + qi;
  const int cur = t0 >> 6;
  const long row = (long)b * T + t_c;
  const u16* prow = p.proj + row * LDP;
  const u16* projb = p.proj + (long)b * T * LDP;
  const float* btab_h = btab + hh * 132;
  bf16x8 qf[4];
#pragma unroll
  for (int ks = 0; ks < 4; ++ks) qf[ks] = *(const bf16x8*)(prow + C_QN + (g * 4 + hh) * 64 + ks * 16 + hf * 8);
  const u16* gptr = prow + C_GN + (g * 4 + hh) * 3;
  for (int k = lane; k < 1056; k += 64) imps[k] = 0.f;
  u16* orow = p.onsa + row * 512 + (g * 4 + hh) * 64 + 4 * hf;
  auto emit = [&](const f32x16 (&o)[2], float sc, bool first) {
#pragma unroll
    for (int dt = 0; dt < 2; ++dt)
#pragma unroll
      for (int q4 = 0; q4 < 4; ++q4) {
        uint2* dst = (uint2*)(orow + 32 * dt + 8 * q4);
        float v0 = o[dt][4 * q4 + 0] * sc, v1 = o[dt][4 * q4 + 1] * sc, v2 = o[dt][4 * q4 + 2] * sc, v3 = o[dt][4 * q4 + 3] * sc;
        if (!first) {
          const uint2 u = *dst;
          v0 += lo16(u.x); v1 += hi16(u.x); v2 += lo16(u.y); v3 += hi16(u.y);
        }
        uint2 w;
        w.x = pack2(v0, v1);
        w.y = pack2(v2, v3);
        *dst = w;
      }
  };
  const int ncv_c = (t_c >= 31) ? ((t_c - 31) >> 4) + 1 : 0;
  const int ncv_max = (t0 + 31 >= 31) ? ((t0 + 31 - 31) >> 4) + 1 : 0;
  const int nchunk_c = (ncv_max + 63) >> 6;
  {
    const u16* kcb = p.kc + (long)bg * 512 * 64;
    const u16* vcb = p.vcT + (long)bg * 64 * 512;
    float m = -1e30f, l = 0.f;
    auto next_c = [&](int d) { return d + 1 < nchunk_c ? d + 1 : -1; };
    chunk_pipeline<64, 512, false>(stage, kcb, vcb, 0, tid, next_c, [&](int i, const u16* Ks, const u16* Vs) {
      f32x16 acc[2];
      dense_scores(acc, Ks, qf, lane);
      const float mx = dense_mask<16>(acc, true, 0, ncv_c - 1 - i * 64, t_c - 31 - 1024 * i, tw - 31 - 1024 * i - 1008, btab_h, lane);
      const float mn = fmaxf(m, mx);
      float ls = 0.f;
#pragma unroll
      for (int tile = 0; tile < 2; ++tile)
#pragma unroll
        for (int q = 0; q < 16; ++q) ls += __builtin_amdgcn_exp2f(acc[tile][q] - mn);
      ls += __shfl_xor(ls, 32);
      l = l * __builtin_amdgcn_exp2f(m - mn) + ls;
      m = mn;
    });
    const float invl = 1.f / fmaxf(l, 1e-30f);
    f32x16 oc[2];
#pragma unroll
    for (int i = 0; i < 16; ++i) { oc[0][i] = 0.f; oc[1][i] = 0.f; }
    chunk_pipeline<64, 512, true>(stage, kcb, vcb, 0, tid, next_c, [&](int i, const u16* Ks, const u16* Vs) {
      f32x16 acc[2];
      dense_scores(acc, Ks, qf, lane);
      (void)dense_mask<16>(acc, true, 0, ncv_c - 1 - i * 64, t_c - 31 - 1024 * i, tw - 31 - 1024 * i - 1008, btab_h, lane);
      float part[2][4], spill[2][4];
#pragma unroll
      for (int tile = 0; tile < 2; ++tile) {
#pragma unroll
        for (int q = 0; q < 16; ++q) acc[tile][q] = __builtin_amdgcn_exp2f(acc[tile][q] - m) * invl;
#pragma unroll
        for (int q4 = 0; q4 < 4; ++q4) {
          float pa = acc[tile][4 * q4] + acc[tile][4 * q4 + 1] + acc[tile][4 * q4 + 2] + 0.5f * acc[tile][4 * q4 + 3];
          float sp = 0.5f * acc[tile][4 * q4 + 3];
          pa += __shfl_xor(pa, 1); pa += __shfl_xor(pa, 2);
          sp += __shfl_xor(sp, 1); sp += __shfl_xor(sp, 2);
          part[tile][q4] = pa; spill[tile][q4] = sp;
        }
      }
      if (hh == 0) {
#pragma unroll
        for (int tile = 0; tile < 2; ++tile)
#pragma unroll
          for (int q4 = 0; q4 < 4; ++q4) imps[qi * 132 + 16 * i + 8 * tile + 2 * q4 + hf] += part[tile][q4];
      }
      wave_sync();
      if (hh == 0) {
#pragma unroll
        for (int tile = 0; tile < 2; ++tile)
#pragma unroll
          for (int q4 = 0; q4 < 4; ++q4) imps[qi * 132 + 16 * i + 8 * tile + 2 * q4 + hf + 1] += spill[tile][q4];
      }
      wave_sync();
      dense_pv(acc, Vs, lane, oc);
    });
    emit(oc, bf2f(gptr[0]), true);
  }
  wave_sync();
  u64 my0 = 0, my1 = 0, wu0 = 0, wu1 = 0;
  for (int q = 0; q < 8; ++q) {
    u64 mask0, mask1;
    if (cur <= 15) {
      mask0 = (2ull << cur) - 1ull;
      mask1 = 0ull;
    } else {
      const float imp_lo = imps[q * 132 + lane], imp_hi = imps[q * 132 + lane + 64];
      const int jl = lane, jh = lane + 64;
      float c0 = (jl >= 1 && jl <= cur - 2) ? imp_lo : -1.f;
      float c1 = (jh <= cur - 2) ? imp_hi : -1.f;
      bool sel_lo = (jl == 0) || (jl == cur) || (jl == cur - 1);
      bool sel_hi = (jh == cur) || (jh == cur - 1);
      for (int r = 0; r < 13; ++r) {
        float bv; int bj;
        if (c0 >= c1) { bv = c0; bj = jl; } else { bv = c1; bj = jh; }
#pragma unroll
        for (int o = 32; o; o >>= 1) {
          const float ov = __shfl_xor(bv, o);
          const int oj = __shfl_xor(bj, o);
          if (ov > bv || (ov == bv && oj < bj)) { bv = ov; bj = oj; }
        }
        if (bj == jl) { sel_lo = true; c0 = -1.f; }
        if (bj == jh) { sel_hi = true; c1 = -1.f; }
      }
      mask0 = __ballot(sel_lo);
      mask1 = __ballot(sel_hi);
    }
    if (qi == q) { my0 = mask0; my1 = mask1; }
    wu0 |= mask0; wu1 |= mask1;
  }
  if (lane == 0) { wun[wid * 2] = wu0; wun[wid * 2 + 1] = wu1; }
  __syncthreads();
  u64 bu0 = wun[0] | wun[2] | wun[4] | wun[6], bu1 = wun[1] | wun[3] | wun[5] | wun[7];
  bu0 = ((u64)(unsigned)__builtin_amdgcn_readfirstlane((int)(bu0 >> 32)) << 32) | (unsigned)__builtin_amdgcn_readfirstlane((int)bu0);
  bu1 = ((u64)(unsigned)__builtin_amdgcn_readfirstlane((int)(bu1 >> 32)) << 32) | (unsigned)__builtin_amdgcn_readfirstlane((int)bu1);
  {
    float m = -1e30f, l = 0.f;
    f32x16 o[2];
#pragma unroll
    for (int i = 0; i < 16; ++i) { o[0][i] = 0.f; o[1][i] = 0.f; }
    const int kcol = C_KV + 2 * 128 + g * 64;
    auto next_s = [&](int j) {
      ++j;
      if (j < 64) {
        const u64 mm = bu0 & (~0ull << j);
        if (mm) return (int)__builtin_ctzll(mm);
        j = 64;
      }
      if (j >= 128) return -1;
      const u64 mm = bu1 & (~0ull << (j - 64));
      return mm ? 64 + (int)__builtin_ctzll(mm) : -1;
    };
    chunk_pipeline<LDP, T, true>(stage, projb + kcol, p.vts + (long)bg * 64 * T, 0, tid, next_s, [&](int j, const u16* Ks, const u16* Vs) {
      const bool bit = ((j < 64 ? (my0 >> j) : (my1 >> (j - 64))) & 1ull) != 0;
      if (__ballot(bit) != 0ull) {
        const int pos0 = 64 * j;
        dense_chunk(Ks, Vs, bit, 0, t_c - pos0, t_c - pos0, tw - pos0 - 63, qf, btab_h, lane, m, l, o);
      }
    });
    emit(o, bf2f(gptr[1]) / fmaxf(l, 1e-30f), false);
  }
  {
    float m = -1e30f, l = 0.f;
    f32x16 o[2];
#pragma unroll
    for (int i = 0; i < 16; ++i) { o[0][i] = 0.f; o[1][i] = 0.f; }
    const int kcol = C_KV + 4 * 128 + g * 64;
    const int wlo_c = t_c - 511 < 0 ? 0 : t_c - 511;
    const int wlo_min = t0 - 511 < 0 ? 0 : t0 - 511;
    auto next_w = [&](int j) { return j + 1 <= cur ? j + 1 : -1; };
    chunk_pipeline<LDP, T, true>(stage, projb + kcol, p.vtw + (long)bg * 64 * T, wlo_min >> 6, tid, next_w, [&](int jw, const u16* Ks, const u16* Vs) {
      const int pos0 = 64 * jw;
      const int lo_c = wlo_c - pos0 < 0 ? 0 : wlo_c - pos0;
      dense_chunk(Ks, Vs, true, lo_c, t_c - pos0, t_c - pos0, tw - pos0 - 63, qf, btab_h, lane, m, l, o);
    });
    emit(o, bf2f(gptr[2]) / fmaxf(l, 1e-30f), false);
  }
}

DI unsigned f2ord(float v) { const unsigned u = __float_as_uint(v); return (u & 0x80000000u) ? ~u : (u | 0x80000000u); }

DI void topk_row(const Params& p, int b, int t, int lane) {
  const long row = (long)b * T + t;
  int* dst = p.selk + row * 256;
  if (t < 256) {
#pragma unroll
    for (int i = 0; i < 4; ++i) { const int s = i * 64 + lane; dst[s] = (s <= t) ? s : -1; }
    return;
  }
  const float* srow = p.scores + row * T;
  const int ngrp = (t >> 10) + 1;
  unsigned u[128];
  int ln = lane;
  asm volatile("" : "+v"(ln));
#pragma unroll
  for (int gq = 0; gq < 8; ++gq) {
    if (gq < ngrp) {
#pragma unroll
      for (int j = 0; j < 16; ++j) {
        const int s = (gq * 16 + j) * 64 + ln;
        const float v = srow[s < t ? s : t];
        u[gq * 16 + j] = (s <= t) ? f2ord(v) : 0u;
      }
    } else {
#pragma unroll
      for (int j = 0; j < 16; ++j) u[gq * 16 + j] = 0u;
    }
  }
  unsigned thr = 0u;
  for (int bit = 31; bit >= 0; --bit) {
    const unsigned cand = thr | (1u << bit);
    int cnt = 0;
#pragma unroll
    for (int gq = 0; gq < 8; ++gq) {
      if (gq < ngrp) {
#pragma unroll
        for (int j = 0; j < 16; ++j) cnt += __popcll(__ballot(u[gq * 16 + j] >= cand));
      }
    }
    if (cnt >= 256) thr = cand;
    if (cnt == 256) break;
  }
  int ngt = 0;
#pragma unroll
  for (int gq = 0; gq < 8; ++gq) {
    if (gq < ngrp) {
#pragma unroll
      for (int j = 0; j < 16; ++j) ngt += __popcll(__ballot(u[gq * 16 + j] > thr));
    }
  }
  int base_gt = 0, base_eq = 0;
  const int need_eq = 256 - ngt;
  int ln2 = lane;
  asm volatile("" : "+v"(ln2));
#pragma unroll
  for (int gq = 0; gq < 8; ++gq) {
    if (gq < ngrp) {
#pragma unroll
      for (int j = 0; j < 16; ++j) {
        const int s = (gq * 16 + j) * 64 + ln2;
        const unsigned uv = u[gq * 16 + j];
        const bool gt = uv > thr, eq = uv == thr;
        const u64 mg = __ballot(gt), me = __ballot(eq);
        const int pg = __builtin_amdgcn_mbcnt_hi((unsigned)(mg >> 32), __builtin_amdgcn_mbcnt_lo((unsigned)mg, 0));
        const int pe = __builtin_amdgcn_mbcnt_hi((unsigned)(me >> 32), __builtin_amdgcn_mbcnt_lo((unsigned)me, 0));
        if (gt) dst[base_gt + pg] = s;
        if (eq && (base_eq + pe) < need_eq) dst[ngt + base_eq + pe] = s;
        base_gt += __popcll(mg);
        base_eq += __popcll(me);
      }
    }
  }
}

DI void phase5(const Params& p, char* smem, int bid, int nblk) {
  for (int item = bid; item < 1024; item += nblk) {
    __syncthreads();
    const int it = 1023 - item;
    const int chunk = it >> 2, bgi = it & 3;
    nsa_item(p, smem, (bgi << 8) | chunk);
  }
  {
    const int tid = TIDX(), lane = tid & 63, wid = __builtin_amdgcn_readfirstlane(tid >> 6);
    for (int item = bid; item < 2048; item += nblk) {
      const int it = 2047 - item;
      const int b = it & 1, tb = it >> 1;
#pragma unroll 1
      for (int q = 0; q < 2; ++q) {
        asm volatile("" ::: "memory");
        topk_row(p, b, tb * 8 + wid * 2 + q, lane);
      }
    }
  }
}

DI void dsa_query(const Params& p, const float* btab, int b, int t, int lane) {
  const long row = (long)b * T + t;
  const int lg = lane >> 4, r16 = lane & 15, hh = lane & 7;
  bf16x8 qf[4];
#pragma unroll
  for (int ks = 0; ks < 4; ++ks) {
    bf16x8 z = {0, 0, 0, 0, 0, 0, 0, 0};
    if (r16 < 8) z = *(const bf16x8*)(p.qlat + (row * 8 + r16) * 128 + ks * 32 + lg * 8);
    qf[ks] = z;
  }
  const u16* ckvb = p.ckv + (long)b * T * 128;
  const int nvalid = (t + 1) < 256 ? (t + 1) : 256;
  float m = -1e30f, l = 0.f, o0[8], o1[8];
#pragma unroll
  for (int h = 0; h < 8; ++h) { o0[h] = 0.f; o1[h] = 0.f; }
  for (int i = 0; i * 64 < nvalid; ++i) {
    const int nval = (nvalid - i * 64) > 64 ? 64 : (nvalid - i * 64);
    int kidx = p.selk[row * 256 + i * 64 + lane];
    if (lane >= nval || kidx < 0 || kidx > t) kidx = t;
    f32x4 acc[4];
#pragma unroll
    for (int rt = 0; rt < 4; ++rt) {
      const int kk = __shfl(kidx, 16 * rt + r16);
      const u16* kp = ckvb + (long)kk * 128 + 8 * lg;
      f32x4 c = {0.f, 0.f, 0.f, 0.f};
#pragma unroll
      for (int ks = 0; ks < 4; ++ks) c = MFMA16(*(const bf16x8*)(kp + 32 * ks), qf[ks], c);
      acc[rt] = c;
    }
    float mx = -1e30f;
#pragma unroll
    for (int rt = 0; rt < 4; ++rt)
#pragma unroll
      for (int r = 0; r < 4; ++r) {
        const int pl = 16 * rt + 4 * lg + r;
        const int kk = __shfl(kidx, pl);
        int dc = t - kk;
        dc = dc < 0 ? 0 : (dc > 128 ? 128 : dc);
        const float sv = (pl < nval) ? acc[rt][r] + btab[hh * 132 + dc] : -1e30f;
        acc[rt][r] = sv;
        mx = fmaxf(mx, sv);
      }
    mx = fmaxf(mx, __shfl_xor(mx, 16));
    mx = fmaxf(mx, __shfl_xor(mx, 32));
    const float mn = fmaxf(m, mx);
    const float alpha = __expf(m - mn);
    float ls = 0.f;
#pragma unroll
    for (int rt = 0; rt < 4; ++rt)
#pragma unroll
      for (int r = 0; r < 4; ++r) {
        const float pv = acc[rt][r] > -1e29f ? __expf(acc[rt][r] - mn) : 0.f;
        acc[rt][r] = pv;
        ls += pv;
      }
    ls += __shfl_xor(ls, 16);
    ls += __shfl_xor(ls, 32);
    l = l * alpha + ls;
    m = mn;
#pragma unroll
    for (int h = 0; h < 8; ++h) { const float a = rdlane(alpha, h); o0[h] *= a; o1[h] *= a; }
#pragma unroll
    for (int rt = 0; rt < 4; ++rt) {
      asm volatile("" ::: "memory");
#pragma unroll
      for (int g2 = 0; g2 < 4; ++g2)
#pragma unroll
        for (int r = 0; r < 4; ++r) {
          const int pl = 16 * rt + 4 * g2 + r;
          const int kL = rdlane_i(kidx, pl);
          const unsigned u = *(const unsigned*)(ckvb + (long)kL * 128 + lane * 2);
          const float v0 = lo16(u), v1 = hi16(u);
#pragma unroll
          for (int h = 0; h < 8; ++h) {
            const float pw = rdlane(acc[rt][r], 16 * g2 + h);
            o0[h] += pw * v0;
            o1[h] += pw * v1;
          }
        }
    }
  }
  const float invl = 1.f / fmaxf(l, 1e-30f);
#pragma unroll
  for (int h = 0; h < 8; ++h) {
    const float iv = rdlane(invl, h);
    *(unsigned*)(p.olat + row * 1024 + h * 128 + lane * 2) = pack2(o0[h] * iv, o1[h] * iv);
  }
}
DI void phase6(const Params& p, char* smem, int bid, int nblk) {
  const int tid = TIDX(), lane = tid & 63, wid = __builtin_amdgcn_readfirstlane(tid >> 6);
  float* btab = (float*)smem;
  for (int idx = tid; idx < 8 * 129; idx += 256) {
    const int h = idx / 129, d = idx % 129;
    const int bk = d < 128 ? BUCKET[d] : 31;
    btab[h * 132 + d] = p.rel_bias[bk * 16 + 8 + h];
  }
  __syncthreads();
  for (int item = bid; item < 2048; item += nblk) {
    const int it = 2047 - item;
    const int b = it & 1, tb = it >> 1;
    for (int q = 0; q < 2; ++q) dsa_query(p, btab, b, tb * 8 + wid * 2 + q, lane);
  }
}

struct EpiOdsa {
  u16* odsa; int h, m0;
  DI void operator()(f32x16 (&acc)[2][2], int wm, int wn, int lane) const {
    SW_FOR {
      const int r = m0 + SW_R, c = SW_C0;
      if (c < 64) *(uint2*)(odsa + (long)r * 512 + h * 64 + c) = pack4(SW_V(0), SW_V(1), SW_V(2), SW_V(3));
    }
  }
};
DI void phase7(const Params& p, char* smem, int bid, int nblk) {
  for (int item = bid; item < 1024; item += nblk) {
    const int h = item & 7, mt_ = item >> 3;
    ARows af{p.olat + (long)mt_ * 128 * 1024 + h * 128, 1024, 128};
    BMat bf{p.dsa_w_uv + h * 64, 512, 64};
    EpiOdsa ef{p.odsa, h, mt_ * 128};
    gemm_tile(smem, 2, 64, af, bf, ef);
  }
}

struct EpiY {
  u16* y; const u16* proj; int m0, n0, second;
  DI void operator()(f32x16 (&acc)[2][2], int wm, int wn, int lane) const {
    SW_FOR {
      const int r = m0 + SW_R, c = n0 + SW_C0;
      const uint2 gu = *(const uint2*)(proj + (long)r * LDP + C_GM + second * 1024 + c);
      float v0 = lo16(gu.x) * SW_V(0), v1 = hi16(gu.x) * SW_V(1), v2 = lo16(gu.y) * SW_V(2), v3 = hi16(gu.y) * SW_V(3);
      uint2* dst = (uint2*)(y + (long)r * 1024 + c);
      if (second) {
        const uint2 yu = *dst;
        v0 += lo16(yu.x); v1 += hi16(yu.x); v2 += lo16(yu.y); v3 += hi16(yu.y);
      }
      *dst = pack4(v0, v1, v2, v3);
    }
  }
};
DI void phase8(const Params& p, char* smem, int bid, int nblk) {
  for (int item = bid; item < 1024; item += nblk) {
    const int nt_ = item & 7, mt_ = item >> 3;
    {
      ARows af{p.onsa + (long)mt_ * 128 * 512, 512, 128};
      BMatT bf{p.w_bnT + (long)nt_ * 128 * 512, 512};
      EpiY ef{p.y, p.proj, mt_ * 128, nt_ * 128, 0};
      gemm_tile<true, false, true>(smem, 8, 64, af, bf, ef);
    }
    {
      ARows af{p.odsa + (long)mt_ * 128 * 512, 512, 128};
      BMatT bf{p.w_bdT + (long)nt_ * 128 * 512, 512};
      EpiY ef{p.y, p.proj, mt_ * 128, nt_ * 128, 1};
      gemm_tile<true, false, true>(smem, 8, 64, af, bf, ef);
    }
  }
}
struct EpiStoreBf {
  u16* dst; long ld; int m0, n0;
  DI void operator()(f32x16 (&acc)[2][2], int wm, int wn, int lane) const {
    SW_FOR { *(uint2*)(dst + (long)(m0 + SW_R) * ld + n0 + SW_C0) = pack4(SW_V(0), SW_V(1), SW_V(2), SW_V(3)); }
  }
};
DI void phase9(const Params& p, char* smem, int bid, int nblk) {
  for (int item = bid; item < 1024; item += nblk) {
    const int nt_ = item & 7, mt_ = item >> 3;
    ARows af{p.y + (long)mt_ * 128 * 1024, 1024, 128};
    BMatT bf{p.w_outT + (long)nt_ * 128 * 1024, 1024};
    EpiStoreBf ef{p.z, 1024, mt_ * 128, nt_ * 128};
    gemm_tile<true, false, true>(smem, 16, 64, af, bf, ef);
  }
}

DI void phase10(const Params& p, int bid, int nblk) {
  const int tid = TIDX(), lane = tid & 63, wid = __builtin_amdgcn_readfirstlane(tid >> 6);
  for (int row = bid * 4 + wid; row < NTOK; row += nblk * 4) {
    const int b = row >> 13;
    const float* modb = p.mod + b * 6144;
    float zv[16], xv[16];
    float ss = 0.f;
#pragma unroll
    for (int i = 0; i < 4; ++i) {
      const int col = i * 256 + lane * 4;
      const uint2 u = *(const uint2*)(p.z + (long)row * 1024 + col);
      zv[i * 4 + 0] = lo16(u.x); zv[i * 4 + 1] = hi16(u.x); zv[i * 4 + 2] = lo16(u.y); zv[i * 4 + 3] = hi16(u.y);
      const float4 xx = *(const float4*)(p.x + (long)row * 1024 + col);
      xv[i * 4 + 0] = xx.x; xv[i * 4 + 1] = xx.y; xv[i * 4 + 2] = xx.z; xv[i * 4 + 3] = xx.w;
#pragma unroll
      for (int j = 0; j < 4; ++j) ss += zv[i * 4 + j] * zv[i * 4 + j];
    }
    ss = wave_sum(ss);
    const float r = rsqrtf(ss * (1.f / 1024.f) + 1e-6f);
    float ss2 = 0.f;
#pragma unroll
    for (int i = 0; i < 4; ++i)
#pragma unroll
      for (int j = 0; j < 4; ++j) {
        const int col = i * 256 + lane * 4 + j;
        const float v = xv[i * 4 + j] + modb[2048 + col] * (zv[i * 4 + j] * r * p.g_post_mix[col]);
        xv[i * 4 + j] = v;
        ss2 += v * v;
      }
    ss2 = wave_sum(ss2);
    const float r2 = rsqrtf(ss2 * (1.f / 1024.f) + 1e-6f);
#pragma unroll
    for (int i = 0; i < 4; ++i) {
      const int col = i * 256 + lane * 4;
      *(float4*)(p.x1 + (long)row * 1024 + col) = make_float4(xv[i * 4], xv[i * 4 + 1], xv[i * 4 + 2], xv[i * 4 + 3]);
      float hv[4];
#pragma unroll
      for (int j = 0; j < 4; ++j) hv[j] = xv[i * 4 + j] * r2 * p.g_pre_ffn[col + j] * (1.f + modb[4096 + col + j]) + modb[3072 + col + j];
      uint2 w;
      w.x = pack2(hv[0], hv[1]);
      w.y = pack2(hv[2], hv[3]);
      *(uint2*)(p.h + (long)row * 1024 + col) = w;
    }
  }
}

struct EpiStoreF32 {
  float* dst; long ld; int m0, n0;
  DI void operator()(f32x16 (&acc)[2][2], int wm, int wn, int lane) const {
    SW_FOR { *(float4*)(dst + (long)(m0 + SW_R) * ld + n0 + SW_C0) = make_float4(SW_V(0), SW_V(1), SW_V(2), SW_V(3)); }
  }
};
DI void phase11(const Params& p, char* smem, int bid, int nblk) {
  for (int item = bid; item < 256; item += nblk) {
    const int nt_ = item & 1, mt_ = item >> 1;
    ARows af{p.h + (long)mt_ * 128 * 1024, 1024, 128};
    BMatT bf{p.routerT + (long)nt_ * 128 * 1024, 1024};
    EpiStoreF32 ef{p.logits, 256, mt_ * 128, nt_ * 128};
    gemm_tile<true, false, true>(smem, 16, 64, af, bf, ef);
  }
}
DI void phase12(const Params& p, int bid, int nblk) {
  const int tid = TIDX(), lane = tid & 63, wid = __builtin_amdgcn_readfirstlane(tid >> 6);
  for (int tok = bid * 4 + wid; tok < NTOK; tok += nblk * 4) {
    const float4 lg = *(const float4*)(p.logits + (long)tok * 256 + lane * 4);
    const float4 rbv = *(const float4*)(p.router_bias + lane * 4);
    float sg[4] = {sigmoidf(lg.x), sigmoidf(lg.y), sigmoidf(lg.z), sigmoidf(lg.w)};
    float sl[4] = {sg[0] + rbv.x, sg[1] + rbv.y, sg[2] + rbv.z, sg[3] + rbv.w};
    float t1 = fmaxf(sl[0], sl[1]), t2 = fminf(sl[0], sl[1]);
#pragma unroll
    for (int j = 2; j < 4; ++j) {
      const float v = sl[j];
      t2 = fmaxf(t2, fminf(t1, v));
      t1 = fmaxf(t1, v);
    }
#pragma unroll
    for (int o = 1; o < 8; o <<= 1) {
      const float a1 = __shfl_xor(t1, o), a2 = __shfl_xor(t2, o);
      const float n1 = fmaxf(t1, a1);
      const float n2 = fmaxf(fminf(t1, a1), fmaxf(t2, a2));
      t1 = n1; t2 = n2;
    }
    const float gscore = t1 + t2;
    const int grp = lane >> 3;
    int rank = 0;
#pragma unroll
    for (int g2 = 0; g2 < 8; ++g2) {
      const float og = __shfl(gscore, g2 * 8);
      rank += (og > gscore || (og == gscore && g2 < grp)) ? 1 : 0;
    }
    const bool gsel = rank < 4;
    float cv[4];
#pragma unroll
    for (int j = 0; j < 4; ++j) cv[j] = gsel ? sl[j] : -1e30f;
    int my_e = -1; float my_s = 0.f; float ssum = 0.f;
    for (int r = 0; r < 8; ++r) {
      float bv = cv[0]; int bj = 0;
#pragma unroll
      for (int j = 1; j < 4; ++j) if (cv[j] > bv) { bv = cv[j]; bj = j; }
      int be = lane * 4 + bj;
      float bs = bj == 0 ? sg[0] : (bj == 1 ? sg[1] : (bj == 2 ? sg[2] : sg[3]));
#pragma unroll
      for (int o = 32; o; o >>= 1) {
        const float ov = __shfl_xor(bv, o);
        const int oe = __shfl_xor(be, o);
        const float os = __shfl_xor(bs, o);
        if (ov > bv || (ov == bv && oe < be)) { bv = ov; be = oe; bs = os; }
      }
      if ((be >> 2) == lane) {
        const int j = be & 3;
        if (j == 0) cv[0] = -3e30f; else if (j == 1) cv[1] = -3e30f; else if (j == 2) cv[2] = -3e30f; else cv[3] = -3e30f;
      }
      if (lane == r) { my_e = be; my_s = bs; }
      ssum += bs;
    }
    if (lane < 8) {
      const float w = my_s / ssum * 2.5f;
      const int rk = atomicAdd(p.counts + my_e, 1);
      p.eidx[tok * 8 + lane] = my_e;
      p.ewt[tok * 8 + lane] = w;
      p.erank[tok * 8 + lane] = rk;
    }
  }
}
DI void phase13(const Params& p, char* smem, int bid) {
  if (bid != 0) return;
  const int tid = TIDX();
  int* s_cnt = (int*)smem;
  const int cnt = p.counts[tid];
  s_cnt[tid] = cnt;
  __syncthreads();
  int run = 0, nt = 0;
  for (int e = 0; e < tid; ++e) { const int c = s_cnt[e]; run += c; nt += (c + 127) >> 7; }
  p.offs[tid] = run;
  for (int m = 0; m * 128 < cnt; ++m) {
    p.tile_e[nt] = tid;
    p.tile_r0[nt] = run + m * 128;
    p.tile_nr[nt] = (cnt - m * 128) > 128 ? 128 : (cnt - m * 128);
    ++nt;
  }
  if (tid == 255) {
    p.offs[256] = run + cnt;
    for (int m = 0; m < 128; ++m) {
      p.tile_e[nt] = 256;
      p.tile_r0[nt] = 131072 + m * 128;
      p.tile_nr[nt] = 128;
      ++nt;
    }
    p.ntiles[0] = nt;
  }
}
DI void phase14(const Params& p, int bid, int nblk) {
  for (int i = bid * 256 + TIDX(); i < NSLOT; i += nblk * 256) {
    if (i < 131072) {
      const int e = p.eidx[i];
      const int slot = p.offs[e] + p.erank[i];
      p.slot_tok[slot] = i >> 3;
      p.slot_wt[slot] = p.ewt[i];
      p.tok_slot[i] = slot;
    } else {
      p.slot_tok[i] = i - 131072;
      p.slot_wt[i] = 1.f;
    }
  }
}

struct AGather {
  const u16* h; const int* slot_tok; int r0, nr;
  DI const u16* operator()(int r) const { return h + (long)slot_tok[r0 + (r < nr ? r : 0)] * 1024; }
};
struct BGateUp {
  const float* wg; long udiff; long ldb; int n0;
  DI const float* operator()(int c4) const {
    const int wn = c4 >> 6, ntl = (c4 >> 5) & 1, j = c4 & 31;
    return wg + (long)ntl * udiff + n0 + wn * 32 + j;
  }
  DI const u16* row(int) const { return nullptr; }
};
struct EpiH {
  u16* H; int r0, nr, n0;
  DI void operator()(f32x16 (&acc)[2][2], int wm, int wn, int lane) const {
#pragma unroll
    for (int mt = 0; mt < 2; ++mt) {
      const int r = wm * 64 + mt * 32 + (lane & 31);
      if (r < nr) {
#pragma unroll
        for (int q4 = 0; q4 < 4; ++q4) {
          float v[4];
#pragma unroll
          for (int j = 0; j < 4; ++j) v[j] = siluf(acc[mt][0][4 * q4 + j]) * acc[mt][1][4 * q4 + j];
          *(uint2*)(H + (long)(r0 + r) * 256 + n0 + wn * 32 + 8 * q4 + 4 * (lane >> 5)) = pack4(v[0], v[1], v[2], v[3]);
        }
      }
    }
  }
};
DI void phase15(const Params& p, char* smem, int bid, int nblk) {
  const int ntl = p.ntiles[0];
  const int nq = (ntl + 3) >> 2;
  const int nitems = ((4 * nq + 7) >> 3) * 32;
  for (int item = bid; item < nitems; item += nblk) {
    const int s = item >> 3, m4 = s & 3, u = (s >> 2) * 8 + (item & 7);
    const int ti = (u >> 2) * 4 + m4, nt_ = u & 3;
    if (ti >= ntl) continue;
    const int e = p.tile_e[ti], r0 = p.tile_r0[ti], nr = p.tile_nr[ti];
    AGather af{p.h, p.slot_tok, r0, nr};
    const float* wg = e < 256 ? p.w_eg + (long)e * 1024 * 256 : p.w_sg;
    const float* wu = e < 256 ? p.w_eu + (long)e * 1024 * 256 : p.w_su;
    BGateUp bf{wg, (long)(wu - wg), 256, nt_ * 64};
    EpiH ef{p.H, r0, nr, nt_ * 64};
    gemm_tile(smem, 16, 64, af, bf, ef);
  }
}
struct EpiYexp {
  u16* Y; const float* slot_wt; int r0, nr, n0;
  DI void operator()(f32x16 (&acc)[2][2], int wm, int wn, int lane) const {
#pragma unroll
    for (int mt = 0; mt < 2; ++mt) {
      const int r = wm * 64 + mt * 32 + (lane & 31);
      if (r < nr) {
        const float w = slot_wt[r0 + r];
#pragma unroll
        for (int nt = 0; nt < 2; ++nt)
#pragma unroll
          for (int q4 = 0; q4 < 4; ++q4)
            *(uint2*)(Y + (long)(r0 + r) * 1024 + n0 + SW_C0) = pack4(SW_V(0) * w, SW_V(1) * w, SW_V(2) * w, SW_V(3) * w);
      }
    }
  }
};
DI void phase16(const Params& p, char* smem, int bid, int nblk) {
  const int ntl = p.ntiles[0];
  const int nq = (ntl + 3) >> 2;
  for (int item = bid; item < nq * 32; item += nblk) {
    const int ti = (item >> 5) * 4 + ((item >> 3) & 3), nt_ = item & 7;
    if (ti >= ntl) continue;
    const int e = p.tile_e[ti], r0 = p.tile_r0[ti], nr = p.tile_nr[ti];
    ARows af{p.H + (long)r0 * 256, 256, nr};
    const float* wd = e < 256 ? p.w_ed + (long)e * 256 * 1024 : p.w_sd;
    BMat bf{wd + nt_ * 128, 1024, 128};
    EpiYexp ef{p.Y, p.slot_wt, r0, nr, nt_ * 128};
    gemm_tile(smem, 4, 64, af, bf, ef);
  }
}
DI void phase17(const Params& p, int bid, int nblk) {
  const int tid = TIDX(), lane = tid & 63, wid = __builtin_amdgcn_readfirstlane(tid >> 6);
  for (int row = bid * 4 + wid; row < NTOK; row += nblk * 4) {
    const int b = row >> 13;
    const float* modb = p.mod + b * 6144;
    int slots[9];
#pragma unroll
    for (int k = 0; k < 8; ++k) slots[k] = p.tok_slot[row * 8 + k];
    slots[8] = 131072 + row;
    float yv[16];
#pragma unroll
    for (int j = 0; j < 16; ++j) yv[j] = 0.f;
#pragma unroll
    for (int k = 0; k < 9; ++k) {
#pragma unroll
      for (int i = 0; i < 4; ++i) {
        const uint2 u = *(const uint2*)(p.Y + (long)slots[k] * 1024 + i * 256 + lane * 4);
        yv[i * 4 + 0] += lo16(u.x); yv[i * 4 + 1] += hi16(u.x); yv[i * 4 + 2] += lo16(u.y); yv[i * 4 + 3] += hi16(u.y);
      }
    }
    float ss = 0.f;
#pragma unroll
    for (int j = 0; j < 16; ++j) ss += yv[j] * yv[j];
    ss = wave_sum(ss);
    const float r = rsqrtf(ss * (1.f / 1024.f) + 1e-6f);
#pragma unroll
    for (int i = 0; i < 4; ++i) {
      const int col = i * 256 + lane * 4;
      const float4 xx = *(const float4*)(p.x1 + (long)row * 1024 + col);
      float o[4] = {xx.x, xx.y, xx.z, xx.w};
#pragma unroll
      for (int j = 0; j < 4; ++j) o[j] += modb[5120 + col + j] * (yv[i * 4 + j] * r * p.g_post_ffn[col + j]);
      *(float4*)(p.out + (long)row * 1024 + col) = make_float4(o[0], o[1], o[2], o[3]);
    }
  }
}

__global__ void __launch_bounds__(256, 2) mega(Params p) {
  cg::grid_group grid = cg::this_grid();
  __shared__ __attribute__((aligned(16))) char smem[LDS_BYTES];
  const int bid = blockIdx.x, nblk = gridDim.x;
  if (p.phase_hi == 12345) grid.sync();
  if (threadIdx.x < 4) ((unsigned*)(smem + 73728))[threadIdx.x] = 0u;
  __syncthreads();
  const XcdBarrier xb = xcd_barrier_post(p.bar, (volatile LAS unsigned*)(smem + 73728));
#if !defined(ONLY) || ONLY==0
  if (p.phase_lo <= 0 && 0 < p.phase_hi) {
    phase0(p, smem, bid, nblk);
#if (REPEAT_MASK >> 0) & 1
    xcd_barrier(xb);
    phase0(p, smem, bid, nblk);
#endif
    if (0 + 1 < p.phase_hi) xcd_barrier(xb);
  }
#endif
#if !defined(ONLY) || ONLY==1
  if (p.phase_lo <= 1 && 1 < p.phase_hi) {
    phase1(p, smem, bid, nblk);
#if (REPEAT_MASK >> 1) & 1
    xcd_barrier(xb);
    phase1(p, smem, bid, nblk);
#endif
    if (1 + 1 < p.phase_hi) xcd_barrier(xb);
  }
#endif
#if !defined(ONLY) || ONLY==2
  if (p.phase_lo <= 2 && 2 < p.phase_hi) {
    phase2(p, smem, bid, nblk);
#if (REPEAT_MASK >> 2) & 1
    xcd_barrier(xb);
    phase2(p, smem, bid, nblk);
#endif
    if (2 + 1 < p.phase_hi) xcd_barrier(xb);
  }
#endif
#if !defined(ONLY) || ONLY==3
  if (p.phase_lo <= 3 && 3 < p.phase_hi) {
    phase3(p, smem, bid, nblk);
#if (REPEAT_MASK >> 3) & 1
    xcd_barrier(xb);
    phase3(p, smem, bid, nblk);
#endif
    if (3 + 1 < p.phase_hi) xcd_barrier(xb);
  }
#endif
#if !defined(ONLY) || ONLY==4
  if (p.phase_lo <= 4 && 4 < p.phase_hi) {
    phase4(p, smem, bid, nblk);
#if (REPEAT_MASK >> 4) & 1
    xcd_barrier(xb);
    phase4(p, smem, bid, nblk);
#endif
    if (4 + 1 < p.phase_hi) xcd_barrier(xb);
  }
#endif
#if !defined(ONLY) || ONLY==5
  if (p.phase_lo <= 5 && 5 < p.phase_hi) {
    phase5(p, smem, bid, nblk);
#if (REPEAT_MASK >> 5) & 1
    xcd_barrier(xb);
    phase5(p, smem, bid, nblk);
#endif
    if (5 + 1 < p.phase_hi) xcd_barrier(xb);
  }
#endif
#if !defined(ONLY) || ONLY==6
  if (p.phase_lo <= 6 && 6 < p.phase_hi) {
    phase6(p, smem, bid, nblk);
#if (REPEAT_MASK >> 6) & 1
    xcd_barrier(xb);
    phase6(p, smem, bid, nblk);
#endif
    if (6 + 1 < p.phase_hi) xcd_barrier(xb);
  }
#endif
#if !defined(ONLY) || ONLY==7
  if (p.phase_lo <= 7 && 7 < p.phase_hi) {
    phase7(p, smem, bid, nblk);
#if (REPEAT_MASK >> 7) & 1
    xcd_barrier(xb);
    phase7(p, smem, bid, nblk);
#endif
    if (7 + 1 < p.phase_hi) xcd_barrier(xb);
  }
#endif
#if !defined(ONLY) || ONLY==8
  if (p.phase_lo <= 8 && 8 < p.phase_hi) {
    phase8(p, smem, bid, nblk);
#if (REPEAT_MASK >> 8) & 1
    xcd_barrier(xb);
    phase8(p, smem, bid, nblk);
#endif
    if (8 + 1 < p.phase_hi) xcd_barrier(xb);
  }
#endif
#if !defined(ONLY) || ONLY==9
  if (p.phase_lo <= 9 && 9 < p.phase_hi) {
    phase9(p, smem, bid, nblk);
#if (REPEAT_MASK >> 9) & 1
    xcd_barrier(xb);
    phase9(p, smem, bid, nblk);
#endif
    if (9 + 1 < p.phase_hi) xcd_barrier(xb);
  }
#endif
#if !defined(ONLY) || ONLY==10
  if (p.phase_lo <= 10 && 10 < p.phase_hi) {
    phase10(p, bid, nblk);
#if (REPEAT_MASK >> 10) & 1
    xcd_barrier(xb);
    phase10(p, bid, nblk);
#endif
    if (10 + 1 < p.phase_hi) xcd_barrier(xb);
  }
#endif
#if !defined(ONLY) || ONLY==11
  if (p.phase_lo <= 11 && 11 < p.phase_hi) {
    phase11(p, smem, bid, nblk);
#if (REPEAT_MASK >> 11) & 1
    xcd_barrier(xb);
    phase11(p, smem, bid, nblk);
#endif
    if (11 + 1 < p.phase_hi) xcd_barrier(xb);
  }
#endif
#if !defined(ONLY) || ONLY==12
  if (p.phase_lo <= 12 && 12 < p.phase_hi) {
    phase12(p, bid, nblk);
#if (REPEAT_MASK >> 12) & 1
    xcd_barrier(xb);
    phase12(p, bid, nblk);
#endif
    if (12 + 1 < p.phase_hi) xcd_barrier(xb);
  }
#endif
#if !defined(ONLY) || ONLY==13
  if (p.phase_lo <= 13 && 13 < p.phase_hi) {
    phase13(p, smem, bid);
#if (REPEAT_MASK >> 13) & 1
    xcd_barrier(xb);
    phase13(p, smem, bid);
#endif
    if (13 + 1 < p.phase_hi) xcd_barrier(xb);
  }
#endif
#if !defined(ONLY) || ONLY==14
  if (p.phase_lo <= 14 && 14 < p.phase_hi) {
    phase14(p, bid, nblk);
#if (REPEAT_MASK >> 14) & 1
    xcd_barrier(xb);
    phase14(p, bid, nblk);
#endif
    if (14 + 1 < p.phase_hi) xcd_barrier(xb);
  }
#endif
#if !defined(ONLY) || ONLY==15
  if (p.phase_lo <= 15 && 15 < p.phase_hi) {
    phase15(p, smem, bid, nblk);
#if (REPEAT_MASK >> 15) & 1
    xcd_barrier(xb);
    phase15(p, smem, bid, nblk);
#endif
    if (15 + 1 < p.phase_hi) xcd_barrier(xb);
  }
#endif
#if !defined(ONLY) || ONLY==16
  if (p.phase_lo <= 16 && 16 < p.phase_hi) {
    phase16(p, smem, bid, nblk);
#if (REPEAT_MASK >> 16) & 1
    xcd_barrier(xb);
    phase16(p, smem, bid, nblk);
#endif
    if (16 + 1 < p.phase_hi) xcd_barrier(xb);
  }
#endif
#if !defined(ONLY) || ONLY==17
  if (p.phase_lo <= 17 && 17 < p.phase_hi) {
    phase17(p, bid, nblk);
#if (REPEAT_MASK >> 17) & 1
    xcd_barrier(xb);
    phase17(p, bid, nblk);
#endif
    if (17 + 1 < p.phase_hi) xcd_barrier(xb);
  }
#endif
}

extern "C" void kernel_launch(void* const* d_in, const int* in_sizes, int n_in, void* d_out, int out_size, void* d_ws, size_t ws_size,
                              hipStream_t stream) {
  static int grid_blocks = 0;
  if (!grid_blocks) {
    int dev = 0, cus = 0, per_cu = 0;
    (void)hipGetDevice(&dev);
    (void)hipDeviceGetAttribute(&cus, hipDeviceAttributeMultiprocessorCount, dev);
    (void)hipOccupancyMaxActiveBlocksPerMultiprocessor(&per_cu, mega, 256, 0);
    if (per_cu > 2) per_cu = 2;
    if (per_cu < 1) per_cu = 1;
    grid_blocks = cus * per_cu;
  }
  Params p{};
  const float* const* in = (const float* const*)d_in;
  p.x = in[0]; p.c = in[1]; p.w_ada = in[2]; p.b_ada = in[3]; p.g_pre_mix = in[4]; p.g_post_mix = in[5]; p.g_pre_ffn = in[6]; p.g_post_ffn = in[7];
  p.w_in = in[8]; p.rel_bias = in[9]; p.cmp_pe = in[10]; p.cmp_w1 = in[11]; p.cmp_b1 = in[12]; p.cmp_w2 = in[13]; p.dsa_kv_norm = in[14];
  p.dsa_w_uk = in[15]; p.dsa_w_uv = in[16]; p.w_bn = in[17]; p.w_bd = in[18]; p.w_out = in[19]; p.router_w = in[20]; p.router_bias = in[21];
  p.w_eg = in[22]; p.w_eu = in[23]; p.w_ed = in[24]; p.w_sg = in[25]; p.w_su = in[26]; p.w_sd = in[27];
  p.out = (float*)d_out;
  char* ws = (char*)d_ws;
  size_t off = 0;
  auto alloc = [&](size_t bytes) { char* r = ws + off; off += (bytes + 255) & ~(size_t)255; return r; };
  p.bar = (unsigned*)alloc(XCD_BAR_WORDS * 4);
  p.modp = (float*)alloc(16 * 2 * 6144 * 4);
  p.mod = (float*)alloc(2 * 6144 * 4);
  p.pe_part = (float*)alloc(16 * 256 * 4);
  p.w_ukT = (float*)alloc(8 * 64 * 128 * 4);
  p.w_inT = (u16*)alloc((size_t)4608 * 1024 * 2);
  p.w_bnT = (u16*)alloc((size_t)1024 * 512 * 2);
  p.w_bdT = (u16*)alloc((size_t)1024 * 512 * 2);
  p.w_outT = (u16*)alloc((size_t)1024 * 1024 * 2);
  p.routerT = (u16*)alloc((size_t)256 * 1024 * 2);
  p.counts = (int*)alloc(256 * 4);
  p.offs = (int*)alloc(257 * 4);
  p.tile_e = (int*)alloc(1536 * 4);
  p.tile_r0 = (int*)alloc(1536 * 4);
  p.tile_nr = (int*)alloc(1536 * 4);
  p.ntiles = (int*)alloc(4);
  p.h = (u16*)alloc((size_t)NTOK * 1024 * 2);
  p.proj = (u16*)alloc((size_t)NTOK * LDP * 2);
  p.widx = (float*)alloc((size_t)NTOK * 8 * 4);
  p.zc = (u16*)alloc((size_t)2 * 2048 * 128 * 2);
  p.kc = (u16*)alloc((size_t)4 * 512 * 64 * 2);
  p.vcT = (u16*)alloc((size_t)4 * 512 * 64 * 2);
  p.vts = (u16*)alloc((size_t)4 * 64 * T * 2);
  p.vtw = (u16*)alloc((size_t)4 * 64 * T * 2);
  p.qlat = (u16*)alloc((size_t)NTOK * 1024 * 2);
  p.ckv = (u16*)alloc((size_t)NTOK * 128 * 2);
  p.selk = (int*)alloc((size_t)NTOK * 256 * 4);
  p.onsa = (u16*)alloc((size_t)NTOK * 512 * 2);
  p.olat = (u16*)alloc((size_t)NTOK * 1024 * 2);
  p.odsa = (u16*)alloc((size_t)NTOK * 512 * 2);
  p.y = p.qlat;
  p.z = p.olat;
  p.eidx = (int*)alloc((size_t)NTOK * 8 * 4);
  p.ewt = (float*)alloc((size_t)NTOK * 8 * 4);
  p.erank = (int*)alloc((size_t)NTOK * 8 * 4);
  p.slot_tok = (int*)alloc((size_t)NSLOT * 4);
  p.slot_wt = (float*)alloc((size_t)NSLOT * 4);
  p.tok_slot = (int*)alloc((size_t)NTOK * 8 * 4);
  char* big = alloc((size_t)2 * T * T * 4);
  p.scores = (float*)big;
  {
    size_t o2 = 0;
    auto sub = [&](size_t bytes) { char* r = big + o2; o2 += (bytes + 255) & ~(size_t)255; return r; };
    p.H = (u16*)sub((size_t)NSLOT * 256 * 2);
    p.Y = (u16*)sub((size_t)NSLOT * 1024 * 2);
    p.x1 = (float*)sub((size_t)NTOK * 1024 * 4);
    p.logits = (float*)sub((size_t)NTOK * 256 * 4);
  }
  if (off > ws_size) fprintf(stderr, "workspace too small: need %zu have %zu\n", off, ws_size);
  p.phase_lo = 0;
  p.phase_hi = 18;
  (void)hipMemsetAsync(p.bar, 0, XCD_BAR_WORDS * 4, stream);
  void* args[] = {&p};
  hipError_t e = hipLaunchCooperativeKernel((void*)mega, dim3(grid_blocks), dim3(256), args, 0, stream);
  if (e != hipSuccess) fprintf(stderr, "coop launch failed: %s (grid %d)\n", hipGetErrorString(e), grid_blocks);
}
```

```cpp
#include <hip/hip_runtime.h>
#include <hip/hip_cooperative_groups.h>
#include <cstdio>
namespace cg = cooperative_groups;

#define DI __device__ __forceinline__
typedef unsigned short u16;
typedef unsigned long long u64;
using bf16x8 = __attribute__((ext_vector_type(8))) short;
using f32x16 = __attribute__((ext_vector_type(16))) float;

constexpr int T = 8192;
constexpr int NTOK = 16384;
constexpr int LDP = 4576;
constexpr int C_QN = 0, C_KV = 512, C_GN = 1280, C_QD = 1304, C_CKV = 1816, C_QI = 1944, C_KI = 2456, C_WI = 2520, C_GM = 2528;
constexpr int NSLOT = 131072 + 16384;
constexpr int LDS_BYTES = 73728 + 64;
#ifndef REPEAT_MASK
#define REPEAT_MASK 0
#endif

__device__ const unsigned char BUCKET[128] = {
  0, 1, 2, 3, 4, 5, 6, 7, 8, 9, 10, 11, 12, 13, 14, 15, 16, 16, 16, 17, 17, 18, 18, 18, 19, 19, 19, 20, 20, 20, 20, 21,
  21, 21, 21, 22, 22, 22, 22, 22, 23, 23, 23, 23, 23, 23, 24, 24, 24, 24, 24, 24, 25, 25, 25, 25, 25, 25, 25, 26, 26, 26, 26, 26,
  26, 26, 26, 27, 27, 27, 27, 27, 27, 27, 27, 27, 27, 28, 28, 28, 28, 28, 28, 28, 28, 28, 28, 29, 29, 29, 29, 29, 29, 29, 29, 29,
  29, 29, 29, 30, 30, 30, 30, 30, 30, 30, 30, 30, 30, 30, 30, 30, 30, 31, 31, 31, 31, 31, 31, 31, 31, 31, 31, 31, 31, 31, 31, 31};

struct Params {
  const float *x, *c, *w_ada, *b_ada, *g_pre_mix, *g_post_mix, *g_pre_ffn, *g_post_ffn, *w_in, *rel_bias;
  const float *cmp_pe, *cmp_w1, *cmp_b1, *cmp_w2, *dsa_kv_norm, *dsa_w_uk, *dsa_w_uv, *w_bn, *w_bd, *w_out;
  const float *router_w, *router_bias, *w_eg, *w_eu, *w_ed, *w_sg, *w_su, *w_sd;
  float* out;
  float* modp;
  float* mod;
  float* pe_part;
  float* w_ukT;
  u16 *w_inT, *w_bnT, *w_bdT, *w_outT, *routerT;
  u16* h;
  u16* proj;
  float* widx;
  u16* zc;
  u16* kc;
  u16* vcT;
  u16* vts;
  u16* vtw;
  u16* qlat;
  u16* ckv;
  float* scores;
  int* selk;
  u16* onsa;
  u16* olat;
  u16* odsa;
  u16* y;
  u16* z;
  float* x1;
  float* logits;
  int* eidx;
  float* ewt;
  int* erank;
  int* counts;
  int* offs;
  int* tile_e;
  int* tile_r0;
  int* tile_nr;
  int* ntiles;
  int *tile2_e, *tile2_r0, *tile2_nr;
  int* slot_tok;
  float* slot_wt;
  int* tok_slot;
  u16* H;
  u16* Y;
  unsigned* bar;
  int phase_lo, phase_hi;
};

DI float bf2f(u16 v) { return __uint_as_float(((unsigned)v) << 16); }
typedef __bf16 bf16x2_t __attribute__((ext_vector_type(2)));
typedef float f32x2_t __attribute__((ext_vector_type(2)));
DI unsigned pack2(float a, float b) { f32x2_t v = {a, b}; return __builtin_bit_cast(unsigned, __builtin_convertvector(v, bf16x2_t)); }
DI u16 f2bf(float x) { return (u16)(pack2(x, x) & 0xffffu); }
DI float lo16(unsigned u) { return __uint_as_float(u << 16); }
DI float hi16(unsigned u) { return __uint_as_float(u & 0xffff0000u); }
DI float wave_sum(float v) { for (int o = 32; o; o >>= 1) v += __shfl_xor(v, o); return v; }
DI float wave_max(float v) { for (int o = 32; o; o >>= 1) v = fmaxf(v, __shfl_xor(v, o)); return v; }
#define DPP_QP1 0xB1
#define DPP_QP2 0x4E
#define DPP_RHM 0x141
#define DPP_RM  0x140
#define DPP_B15 0x142
#define DPP_B31 0x143
DI int wave_sum_i(int x) {
  x += __builtin_amdgcn_update_dpp(0, x, DPP_QP1, 0xF, 0xF, true);
  x += __builtin_amdgcn_update_dpp(0, x, DPP_QP2, 0xF, 0xF, true);
  x += __builtin_amdgcn_update_dpp(0, x, DPP_RHM, 0xF, 0xF, true);
  x += __builtin_amdgcn_update_dpp(0, x, DPP_RM, 0xF, 0xF, true);
  x += __builtin_amdgcn_update_dpp(0, x, DPP_B15, 0xA, 0xF, true);
  x += __builtin_amdgcn_update_dpp(0, x, DPP_B31, 0xC, 0xF, true);
  return __builtin_amdgcn_readlane(x, 63);
}
DI void wave_argmax(float& v, int& idx) {
#define AM_STEP(CTRL, RM)                                                                                                   \
  {                                                                                                                         \
    const float ov_ = __int_as_float(__builtin_amdgcn_update_dpp(__float_as_int(v), __float_as_int(v), CTRL, RM, 0xF, false)); \
    const int oi_ = __builtin_amdgcn_update_dpp(idx, idx, CTRL, RM, 0xF, false);                                            \
    const bool tk_ = ov_ > v || (ov_ == v && oi_ < idx);                                                                    \
    v = tk_ ? ov_ : v;                                                                                                      \
    idx = tk_ ? oi_ : idx;                                                                                                  \
  }
  AM_STEP(DPP_QP1, 0xF) AM_STEP(DPP_QP2, 0xF) AM_STEP(DPP_RHM, 0xF) AM_STEP(DPP_RM, 0xF) AM_STEP(DPP_B15, 0xA) AM_STEP(DPP_B31, 0xC)
#undef AM_STEP
  v = __int_as_float(__builtin_amdgcn_readlane(__float_as_int(v), 63));
  idx = __builtin_amdgcn_readlane(idx, 63);
}
DI float rdlane(float v, int l) { return __int_as_float(__builtin_amdgcn_readlane(__float_as_int(v), l)); }
DI int rdlane_i(int v, int l) { return __builtin_amdgcn_readlane(v, l); }
DI int TIDX() { int t = threadIdx.x; asm volatile("" : "+v"(t)); return t; }
DI void cbar(const void* p) { asm volatile("" ::"v"(p) : "memory"); }
DI void wave_sync() { asm volatile("s_waitcnt lgkmcnt(0)" ::: "memory"); __builtin_amdgcn_wave_barrier(); }
DI float sigmoidf(float x) { return 1.f / (1.f + __expf(-x)); }
DI float siluf(float x) { return x / (1.f + __expf(-x)); }
DI float gelu_tanh(float x) { float u = 0.7978845608028654f * (x + 0.044715f * x * x * x); float e = __expf(2.f * u); float th = 1.f - 2.f / (e + 1.f); return 0.5f * x * (1.f + th); }


#define XB_TMO      128
#define XB_XCNT(j)  (256  + 64 * (j))
#define XB_XSUB(j)  (1280 + 64 * (j))
#define XB_XGEN(j)  (2304 + 64 * (j))
#define XB_TOP      3328
#define XB_TOPGEN   3392
#define XCD_BAR_WORDS 3456
#define XB_SPIN_CAP (1u << 22)
#define LAS __attribute__((address_space(3)))
DI unsigned xb_ld(unsigned* p) { return __hip_atomic_load(p, __ATOMIC_RELAXED, __HIP_MEMORY_SCOPE_AGENT); }
DI unsigned xb_add(unsigned* p, unsigned v) { return __hip_atomic_fetch_add(p, v, __ATOMIC_RELAXED, __HIP_MEMORY_SCOPE_AGENT); }
DI unsigned xb_xcc_id() { return (unsigned)__builtin_amdgcn_s_getreg((3 << 11) | 20) & 0xFu; }
#define XB_SPIN(cond, bar) do { unsigned _sp = 0; while (cond) { __builtin_amdgcn_s_sleep(1); \
    if ((++_sp & 255u) == 0u) { if (xb_ld(&(bar)[XB_TMO])) break; if (_sp > XB_SPIN_CAP) { atomicAdd(&(bar)[XB_TMO], 1u); break; } } } } while (0)
struct XcdBarrier { unsigned* bar; unsigned x; volatile LAS unsigned* st; };
DI XcdBarrier xcd_barrier_post(unsigned* bar, volatile LAS unsigned* st) {
  XcdBarrier b; b.bar = bar; b.x = xb_xcc_id(); b.st = st;
  if (threadIdx.x == 0) (void)xb_add(&bar[XB_XCNT(b.x)], 1u);
  return b;
}
DI void xcd_barrier_complete(unsigned* bar, unsigned x, unsigned& nloc, unsigned& nx) {
  const unsigned G = gridDim.x * gridDim.y * gridDim.z;
  unsigned sum, cnt, mine, sp = 0u;
  for (;;) {
    sum = 0u; cnt = 0u; mine = 0u;
#pragma unroll
    for (unsigned j = 0; j < 16; ++j) { const unsigned c = xb_ld(&bar[XB_XCNT(j)]); sum += c; cnt += (c > 0u) ? 1u : 0u; mine = (j == x) ? c : mine; }
    if (sum == G) break;
    __builtin_amdgcn_s_sleep(1);
    if ((++sp & 255u) == 0u) { if (xb_ld(&bar[XB_TMO])) break; if (sp > XB_SPIN_CAP) { atomicAdd(&bar[XB_TMO], 1u); break; } }
  }
  nloc = mine > 0u ? mine : 1u; nx = cnt > 0u ? cnt : 1u;
}
DI void xcd_barrier(const XcdBarrier& b) {
  asm volatile("s_waitcnt vmcnt(0)" ::: "memory");
  __syncthreads();
  if (threadIdx.x == 0) {
    unsigned* bar = b.bar;
    __builtin_amdgcn_s_waitcnt(0);
    unsigned nloc = b.st[0], nx = b.st[1];
    if (nloc == 0u) { xcd_barrier_complete(bar, b.x, nloc, nx); b.st[0] = nloc; b.st[1] = nx; }
    const unsigned old = xb_add(&bar[XB_XSUB(b.x)], 1u);
    const unsigned gen = old / nloc;
    if (old + 1u == (gen + 1u) * nloc) {
      __builtin_amdgcn_fence(__ATOMIC_RELEASE, "agent");
      asm volatile("s_waitcnt vmcnt(0)" ::: "memory");
      const unsigned og = xb_add(&bar[XB_TOP], 1u);
      const unsigned tg = og / nx;
      if (og + 1u == (tg + 1u) * nx) xb_add(&bar[XB_TOPGEN], 1u);
      else XB_SPIN(xb_ld(&bar[XB_TOPGEN]) == tg, bar);
      __builtin_amdgcn_fence(__ATOMIC_ACQUIRE, "agent");
      xb_add(&bar[XB_XGEN(b.x)], 1u);
      asm volatile("s_waitcnt vmcnt(0)" ::: "memory");
    } else {
      XB_SPIN(xb_ld(&bar[XB_XGEN(b.x)]) == gen, bar);
      __builtin_amdgcn_fence(__ATOMIC_ACQUIRE, "agent");
      asm volatile("s_waitcnt vmcnt(0)" ::: "memory");
    }
  }
  __syncthreads();
}

template <bool SWAP = true, bool SINGLE = false, bool BT16 = false, class AF, class BF, class EF>
DI void gemm_tile(char* smem, int nk, long a_kstep, const AF& af, const BF& bf, const EF& ef) {
  asm volatile("" ::: "memory");
  u16* As = (u16*)smem;
  const int tid = TIDX(), lane = tid & 63, wid = __builtin_amdgcn_readfirstlane(tid >> 6), wm = wid >> 1, wn = wid & 1;
  const int arow = tid >> 1, ahalf = tid & 1;
  const u16* ap = af(arow) + ahalf * 32;
  const int bkq = lane & 7, bnq = wid * 8 + (lane >> 3);
  const long ldb = bf.ldb;
  const float* bp = nullptr;
  const u16* bp16 = nullptr;
  if constexpr (BT16) bp16 = bf.row(arow) + ahalf * 32;
  else bp = bf(bnq * 4) + (long)(bkq * 4) * ldb;
  uint4 sa0_0, sa0_1, sa0_2, sa0_3, sa1_0, sa1_1, sa1_2, sa1_3;
  float4 sb0_0, sb0_1, sb0_2, sb0_3, sb0_4, sb0_5, sb0_6, sb0_7, sb1_0, sb1_1, sb1_2, sb1_3, sb1_4, sb1_5, sb1_6, sb1_7;
  uint4 tb0_0, tb0_1, tb0_2, tb0_3, tb1_0, tb1_1, tb1_2, tb1_3;
  f32x16 acc[2][2];
#pragma unroll
  for (int a = 0; a < 2; ++a)
#pragma unroll
    for (int b = 0; b < 2; ++b)
#pragma unroll
      for (int i = 0; i < 16; ++i) acc[a][b][i] = 0.f;

#define GEMM_LOAD(S, KT)                                                                  \
  {                                                                                       \
    const uint4* pa_ = (const uint4*)(ap + (long)(KT) * a_kstep);                         \
    sa##S##_0 = pa_[0]; sa##S##_1 = pa_[1]; sa##S##_2 = pa_[2]; sa##S##_3 = pa_[3];       \
    if constexpr (BT16) {                                                                 \
      const uint4* pt_ = (const uint4*)(bp16 + (long)(KT) * 64);                          \
      tb##S##_0 = pt_[0]; tb##S##_1 = pt_[1]; tb##S##_2 = pt_[2]; tb##S##_3 = pt_[3];     \
    } else {                                                                              \
      const float* pb_ = bp + (long)(KT) * 64 * ldb;                                      \
      sb##S##_0 = *(const float4*)(pb_);                                                  \
      sb##S##_1 = *(const float4*)(pb_ + ldb);                                            \
      sb##S##_2 = *(const float4*)(pb_ + 2 * ldb);                                        \
      sb##S##_3 = *(const float4*)(pb_ + 3 * ldb);                                        \
      sb##S##_4 = *(const float4*)(pb_ + 32 * ldb);                                       \
      sb##S##_5 = *(const float4*)(pb_ + 33 * ldb);                                       \
      sb##S##_6 = *(const float4*)(pb_ + 34 * ldb);                                       \
      sb##S##_7 = *(const float4*)(pb_ + 35 * ldb);                                       \
    }                                                                                     \
  }
#define GEMM_BW(V0, V1, V2, V3, C, I, QOFF)                                               \
  {                                                                                       \
    uint2 w_;                                                                             \
    w_.x = pack2(V0.C, V1.C);                                                             \
    w_.y = pack2(V2.C, V3.C);                                                             \
    *(uint2*)&Bs_[(bnq * 4 + (I)) * 72 + (QOFF) + bkq * 4] = w_;                          \
  }
#define GEMM_STORE(S, BUF)                                                                \
  {                                                                                       \
    u16* As_ = As + (BUF) * (2 * 128 * 72);                                               \
    u16* Bs_ = As_ + 128 * 72;                                                            \
    uint4* da_ = (uint4*)&As_[arow * 72 + ahalf * 32];                                    \
    da_[0] = sa##S##_0; da_[1] = sa##S##_1; da_[2] = sa##S##_2; da_[3] = sa##S##_3;       \
    if constexpr (BT16) {                                                                 \
      uint4* db_ = (uint4*)&Bs_[arow * 72 + ahalf * 32];                                  \
      db_[0] = tb##S##_0; db_[1] = tb##S##_1; db_[2] = tb##S##_2; db_[3] = tb##S##_3;     \
    } else {                                                                              \
      GEMM_BW(sb##S##_0, sb##S##_1, sb##S##_2, sb##S##_3, x, 0, 0)                        \
      GEMM_BW(sb##S##_0, sb##S##_1, sb##S##_2, sb##S##_3, y, 1, 0)                        \
      GEMM_BW(sb##S##_0, sb##S##_1, sb##S##_2, sb##S##_3, z, 2, 0)                        \
      GEMM_BW(sb##S##_0, sb##S##_1, sb##S##_2, sb##S##_3, w, 3, 0)                        \
      GEMM_BW(sb##S##_4, sb##S##_5, sb##S##_6, sb##S##_7, x, 0, 32)                       \
      GEMM_BW(sb##S##_4, sb##S##_5, sb##S##_6, sb##S##_7, y, 1, 32)                       \
      GEMM_BW(sb##S##_4, sb##S##_5, sb##S##_6, sb##S##_7, z, 2, 32)                       \
      GEMM_BW(sb##S##_4, sb##S##_5, sb##S##_6, sb##S##_7, w, 3, 32)                       \
    }                                                                                     \
  }
#define GEMM_COMPUTE(BUF)                                                                 \
  {                                                                                       \
    const u16* Ac = As + (BUF) * (2 * 128 * 72);                                          \
    const u16* Bc = Ac + 128 * 72;                                                        \
    _Pragma("unroll") for (int ks = 0; ks < 4; ++ks) {                                    \
      bf16x8 a[2], b[2];                                                                  \
      _Pragma("unroll") for (int mt = 0; mt < 2; ++mt) a[mt] = *(const bf16x8*)&Ac[(wm * 64 + mt * 32 + (lane & 31)) * 72 + ks * 16 + (lane >> 5) * 8]; \
      _Pragma("unroll") for (int nt = 0; nt < 2; ++nt) b[nt] = *(const bf16x8*)&Bc[(wn * 64 + nt * 32 + (lane & 31)) * 72 + ks * 16 + (lane >> 5) * 8]; \
      _Pragma("unroll") for (int mt = 0; mt < 2; ++mt)                                    \
      _Pragma("unroll") for (int nt = 0; nt < 2; ++nt)                                    \
        acc[mt][nt] = SWAP ? __builtin_amdgcn_mfma_f32_32x32x16_bf16(b[nt], a[mt], acc[mt][nt], 0, 0, 0) \
                           : __builtin_amdgcn_mfma_f32_32x32x16_bf16(a[mt], b[nt], acc[mt][nt], 0, 0, 0); \
    }                                                                                     \
  }
  GEMM_LOAD(0, 0)
  __syncthreads();
  if (SINGLE) {
    GEMM_STORE(0, 0)
    __syncthreads();
    GEMM_COMPUTE(0)
  } else {
    GEMM_LOAD(1, 1)
    GEMM_STORE(0, 0)
    __syncthreads();
    const int last = nk - 1;
    for (int kt = 0; kt < nk; kt += 2) {
      const int k2 = kt + 2 < last ? kt + 2 : last, k3 = kt + 3 < last ? kt + 3 : last;
      GEMM_LOAD(0, k2)
      asm volatile("" ::: "memory");
      GEMM_COMPUTE(0)
      asm volatile("" ::: "memory");
      GEMM_STORE(1, 1)
      __syncthreads();
      GEMM_LOAD(1, k3)
      asm volatile("" ::: "memory");
      GEMM_COMPUTE(1)
      asm volatile("" ::: "memory");
      GEMM_STORE(0, 0)
      __syncthreads();
    }
  }
#undef GEMM_LOAD
#undef GEMM_STORE
#undef GEMM_BW
#undef GEMM_COMPUTE
  ef(acc, wm, wn, lane);
}

template <bool BT16, class AF, class BF, class EF>
DI void gemm_tile256(char* smem, int nk, const AF& af, const BF& bf, const EF& ef) {
  asm volatile("" ::: "memory");
  u16* As = (u16*)smem;
  u16* Bs = As + 256 * 72;
  const int tid = TIDX(), lane = tid & 63, wid = __builtin_amdgcn_readfirstlane(tid >> 6), wm = wid >> 1, wn = wid & 1;
  const int piece = tid & 7, rbase = tid >> 3;
  const u16* abase = af(0);
  int ao0, ao1, ao2, ao3, ao4, ao5, ao6, ao7;
  ao0 = (int)(af(rbase) - abase) + piece * 8;        ao1 = (int)(af(rbase + 32) - abase) + piece * 8;
  ao2 = (int)(af(rbase + 64) - abase) + piece * 8;   ao3 = (int)(af(rbase + 96) - abase) + piece * 8;
  ao4 = (int)(af(rbase + 128) - abase) + piece * 8;  ao5 = (int)(af(rbase + 160) - abase) + piece * 8;
  ao6 = (int)(af(rbase + 192) - abase) + piece * 8;  ao7 = (int)(af(rbase + 224) - abase) + piece * 8;
  const u16* bp16 = nullptr; long bstride = 0;
  const float* bp = nullptr; long ldb = 0;
  const int bkq = lane & 7, bnq = wid * 8 + (lane >> 3);
  if constexpr (BT16) { bp16 = bf.row(rbase) + piece * 8; bstride = bf.ldb * 32; }
  else { ldb = bf.ldb; bp = bf(bnq * 4) + (long)(bkq * 4) * ldb; }
  uint4 ra0, ra1, ra2, ra3, ra4, ra5, ra6, ra7, rb0, rb1, rb2, rb3;
  float4 fb0, fb1, fb2, fb3, fb4, fb5, fb6, fb7;
  f32x16 acc[4][2];
#pragma unroll
  for (int a = 0; a < 4; ++a)
#pragma unroll
    for (int b = 0; b < 2; ++b)
#pragma unroll
      for (int i = 0; i < 16; ++i) acc[a][b][i] = 0.f;
#define G256_LOAD(KT)                                                   \
  {                                                                     \
    const u16* pa_ = abase + (long)(KT) * 64;                           \
    ra0 = *(const uint4*)(pa_ + ao0); ra1 = *(const uint4*)(pa_ + ao1); \
    ra2 = *(const uint4*)(pa_ + ao2); ra3 = *(const uint4*)(pa_ + ao3); \
    ra4 = *(const uint4*)(pa_ + ao4); ra5 = *(const uint4*)(pa_ + ao5); \
    ra6 = *(const uint4*)(pa_ + ao6); ra7 = *(const uint4*)(pa_ + ao7); \
    if constexpr (BT16) {                                               \
      const u16* pb_ = bp16 + (long)(KT) * 64;                          \
      rb0 = *(const uint4*)(pb_);                                       \
      rb1 = *(const uint4*)(pb_ + bstride);                             \
      rb2 = *(const uint4*)(pb_ + 2 * bstride);                         \
      rb3 = *(const uint4*)(pb_ + 3 * bstride);                         \
    } else {                                                            \
      const float* pf_ = bp + (long)(KT) * 64 * ldb;                    \
      fb0 = *(const float4*)(pf_);            fb1 = *(const float4*)(pf_ + ldb);      \
      fb2 = *(const float4*)(pf_ + 2 * ldb);  fb3 = *(const float4*)(pf_ + 3 * ldb);  \
      fb4 = *(const float4*)(pf_ + 32 * ldb); fb5 = *(const float4*)(pf_ + 33 * ldb); \
      fb6 = *(const float4*)(pf_ + 34 * ldb); fb7 = *(const float4*)(pf_ + 35 * ldb); \
    }                                                                   \
  }
#define G256_BW(V0, V1, V2, V3, C, I, QOFF)                             \
  {                                                                     \
    uint2 w_;                                                           \
    w_.x = pack2(V0.C, V1.C);                                           \
    w_.y = pack2(V2.C, V3.C);                                           \
    *(uint2*)&Bs[(bnq * 4 + (I)) * 72 + (QOFF) + bkq * 4] = w_;         \
  }
  G256_LOAD(0)
  const int last = nk - 1;
  for (int kt = 0; kt < nk; ++kt) {
    __syncthreads();
    {
      u16* da = As + rbase * 72 + piece * 8;
      *(uint4*)(da) = ra0;            *(uint4*)(da + 32 * 72) = ra1;  *(uint4*)(da + 64 * 72) = ra2;  *(uint4*)(da + 96 * 72) = ra3;
      *(uint4*)(da + 128 * 72) = ra4; *(uint4*)(da + 160 * 72) = ra5; *(uint4*)(da + 192 * 72) = ra6; *(uint4*)(da + 224 * 72) = ra7;
      if constexpr (BT16) {
        u16* db = Bs + rbase * 72 + piece * 8;
        *(uint4*)(db) = rb0; *(uint4*)(db + 32 * 72) = rb1; *(uint4*)(db + 64 * 72) = rb2; *(uint4*)(db + 96 * 72) = rb3;
      } else {
        G256_BW(fb0, fb1, fb2, fb3, x, 0, 0)  G256_BW(fb0, fb1, fb2, fb3, y, 1, 0)
        G256_BW(fb0, fb1, fb2, fb3, z, 2, 0)  G256_BW(fb0, fb1, fb2, fb3, w, 3, 0)
        G256_BW(fb4, fb5, fb6, fb7, x, 0, 32) G256_BW(fb4, fb5, fb6, fb7, y, 1, 32)
        G256_BW(fb4, fb5, fb6, fb7, z, 2, 32) G256_BW(fb4, fb5, fb6, fb7, w, 3, 32)
      }
    }
    __syncthreads();
    const int kn = kt + 1 < last ? kt + 1 : last;
    G256_LOAD(kn)
    asm volatile("" ::: "memory");
#pragma unroll
    for (int ks = 0; ks < 4; ++ks) {
      bf16x8 a[4], b[2];
#pragma unroll
      for (int mt = 0; mt < 4; ++mt) a[mt] = *(const bf16x8*)&As[(wm * 128 + mt * 32 + (lane & 31)) * 72 + ks * 16 + (lane >> 5) * 8];
#pragma unroll
      for (int nt = 0; nt < 2; ++nt) b[nt] = *(const bf16x8*)&Bs[(wn * 64 + nt * 32 + (lane & 31)) * 72 + ks * 16 + (lane >> 5) * 8];
#pragma unroll
      for (int mt = 0; mt < 4; ++mt)
#pragma unroll
        for (int nt = 0; nt < 2; ++nt) acc[mt][nt] = __builtin_amdgcn_mfma_f32_32x32x16_bf16(b[nt], a[mt], acc[mt][nt], 0, 0, 0);
    }
    asm volatile("" ::: "memory");
  }
#undef G256_LOAD
#undef G256_BW
  ef(acc, wm, wn, lane);
}

#define EPI_FOR                                                   \
  _Pragma("unroll") for (int mt = 0; mt < 2; ++mt)                \
  _Pragma("unroll") for (int nt = 0; nt < 2; ++nt)                \
  _Pragma("unroll") for (int i = 0; i < 16; ++i)
#define EPI_R (wm * 64 + mt * 32 + (i & 3) + 8 * (i >> 2) + 4 * (lane >> 5))
#define EPI_C (wn * 64 + nt * 32 + (lane & 31))
#define SW_FOR                                                    \
  _Pragma("unroll") for (int mt = 0; mt < MT; ++mt)               \
  _Pragma("unroll") for (int nt = 0; nt < 2; ++nt)                \
  _Pragma("unroll") for (int q4 = 0; q4 < 4; ++q4)
#define SW_R (wm * (32 * MT) + mt * 32 + (lane & 31))
#define SW_C0 (wn * 64 + nt * 32 + 8 * q4 + 4 * (lane >> 5))
#define SW_V(j) acc[mt][nt][4 * q4 + (j)]
DI uint2 pack4(float a, float b, float c, float d) { uint2 w; w.x = pack2(a, b); w.y = pack2(c, d); return w; }

struct ARows { const u16* base; long ld; int nrows; DI const u16* operator()(int r) const { return base + (long)(r < nrows ? r : 0) * ld; } };
struct BMat { const float* base; long ldb; int ncols; DI const float* operator()(int c4) const { return base + (c4 < ncols ? c4 : 0); } DI const u16* row(int) const { return nullptr; } };
struct BMatT { const u16* base; long ldb; DI const float* operator()(int) const { return nullptr; } DI const u16* row(int n) const { return base + (long)n * ldb; } };

DI void phase0(const Params& p, char* smem, int bid, int nblk) {
  const int tid = TIDX();
  for (int item = bid; item < 384 + 256 + 16 + 1 + 1728; item += nblk) {
    if (item < 384) {
      const int cc = item % 24, kc = item / 24;
      const int col = cc * 256 + tid;
      float a0 = 0.f, a1 = 0.f;
      for (int k = kc * 64; k < kc * 64 + 64; ++k) {
        const float w = p.w_ada[(long)k * 6144 + col];
        a0 += siluf(p.c[k]) * w;
        a1 += siluf(p.c[1024 + k]) * w;
      }
      p.modp[(kc * 2 + 0) * 6144 + col] = a0;
      p.modp[(kc * 2 + 1) * 6144 + col] = a1;
    } else if (item < 640) {
      const int idx = (item - 384) * 256 + tid;
      const int c = idx & 127, d = (idx >> 7) & 63, h = idx >> 13;
      p.w_ukT[idx] = p.dsa_w_uk[c * 512 + h * 64 + d];
    } else if (item < 656) {
      const int part = item - 640;
      const int slot = tid >> 7, kk = tid & 127;
      float a = 0.f;
      for (int ld = part * 128; ld < part * 128 + 128; ++ld) a += p.cmp_pe[slot * 2048 + ld] * p.cmp_w1[((long)slot * 2048 + ld) * 128 + kk];
      p.pe_part[part * 256 + tid] = a;
    } else if (item == 656) {
      p.counts[tid] = 0;
    } else {
      int it = item - 657;
      const float* W; u16* WT; int K, N, ntn;
      if (it < 1152) { W = p.w_in; WT = p.w_inT; K = 1024; N = LDP; ntn = 72; }
      else if (it < 1280) { it -= 1152; W = p.w_bn; WT = p.w_bnT; K = 512; N = 1024; ntn = 16; }
      else if (it < 1408) { it -= 1280; W = p.w_bd; WT = p.w_bdT; K = 512; N = 1024; ntn = 16; }
      else if (it < 1664) { it -= 1408; W = p.w_out; WT = p.w_outT; K = 1024; N = 1024; ntn = 16; }
      else { it -= 1664; W = p.router_w; WT = p.routerT; K = 1024; N = 256; ntn = 4; }
      const int k0 = (it / ntn) * 64, n0 = (it % ntn) * 64;
      u16* tl = (u16*)smem;
      __syncthreads();
      const int kr = tid >> 4, nq = tid & 15;
#pragma unroll
      for (int ps = 0; ps < 4; ++ps) {
        const int k = kr + 16 * ps, n = n0 + nq * 4;
        float4 v = make_float4(0.f, 0.f, 0.f, 0.f);
        if (n < N) v = *(const float4*)(W + (long)(k0 + k) * N + n);
        tl[(nq * 4 + 0) * 72 + k] = f2bf(v.x);
        tl[(nq * 4 + 1) * 72 + k] = f2bf(v.y);
        tl[(nq * 4 + 2) * 72 + k] = f2bf(v.z);
        tl[(nq * 4 + 3) * 72 + k] = f2bf(v.w);
      }
      __syncthreads();
      const int nr = tid >> 2, piece = tid & 3;
      const uint4 a = *(const uint4*)(tl + nr * 72 + piece * 16);
      const uint4 b = *(const uint4*)(tl + nr * 72 + piece * 16 + 8);
      uint4* dst = (uint4*)(WT + (long)(n0 + nr) * K + k0 + piece * 16);
      dst[0] = a; dst[1] = b;
    }
  }
}

DI void phase1(const Params& p, char* smem, int bid, int nblk) {
  const int tid = TIDX(), lane = tid & 63, wid = __builtin_amdgcn_readfirstlane(tid >> 6);
  float* modl = (float*)smem;
  for (int idx = tid; idx < 4096; idx += 256) {
    const int b = idx >> 11, n = idx & 2047;
    float v = p.b_ada[n];
    for (int kc = 0; kc < 16; ++kc) v += p.modp[(kc * 2 + b) * 6144 + n];
    modl[idx] = v;
  }
  if (bid < 48) {
    const int idx = bid * 256 + tid;
    const int b = idx / 6144, n = idx % 6144;
    float v = p.b_ada[n];
    for (int kc = 0; kc < 16; ++kc) v += p.modp[(kc * 2 + b) * 6144 + n];
    p.mod[idx] = v;
  }
  __syncthreads();
  for (int row = bid * 4 + wid; row < NTOK; row += nblk * 4) {
    const int b = row >> 13;
    const float* xr = p.x + (long)row * 1024;
    float4 v[4];
    float ss = 0.f;
#pragma unroll
    for (int i = 0; i < 4; ++i) {
      v[i] = *(const float4*)(xr + i * 256 + lane * 4);
      ss += v[i].x * v[i].x + v[i].y * v[i].y + v[i].z * v[i].z + v[i].w * v[i].w;
    }
    ss = wave_sum(ss);
    const float r = rsqrtf(ss * (1.f / 1024.f) + 1e-6f);
#pragma unroll
    for (int i = 0; i < 4; ++i) {
      const int col = i * 256 + lane * 4;
      const float4 g = *(const float4*)(p.g_pre_mix + col);
      const float* sh = modl + b * 2048 + col;
      const float* sc = modl + b * 2048 + 1024 + col;
      const float o0 = v[i].x * r * g.x * (1.f + sc[0]) + sh[0];
      const float o1 = v[i].y * r * g.y * (1.f + sc[1]) + sh[1];
      const float o2 = v[i].z * r * g.z * (1.f + sc[2]) + sh[2];
      const float o3 = v[i].w * r * g.w * (1.f + sc[3]) + sh[3];
      uint2 w;
      w.x = pack2(o0, o1);
      w.y = pack2(o2, o3);
      *(uint2*)(p.h + (long)row * 1024 + col) = w;
    }
  }
}

struct EpiProj {
  u16* proj; float* widx; int m0, n0;
  template <int MT> DI void operator()(f32x16 (&acc)[MT][2], int wm, int wn, int lane) const {
    SW_FOR {
      const int r = m0 + SW_R, c = n0 + SW_C0;
      if (c < LDP) {
        float v[4] = {SW_V(0), SW_V(1), SW_V(2), SW_V(3)};
        if (c < C_KV) { for (int j = 0; j < 4; ++j) v[j] *= 0.125f; }
        else if (c < C_GN) {}
        else if (c < C_QD) { for (int j = 0; j < 4; ++j) v[j] = sigmoidf(v[j]); }
        else if (c < C_QI) {}
        else if (c < C_KI) { for (int j = 0; j < 4; ++j) v[j] *= 0.125f; }
        else if (c < C_WI) {}
        else if (c < C_GM) {
          for (int j = 0; j < 4; ++j) v[j] *= 0.35355339059327373f;
          *(float4*)(widx + (long)r * 8 + (c - C_WI)) = make_float4(v[0], v[1], v[2], v[3]);
        } else { for (int j = 0; j < 4; ++j) v[j] = sigmoidf(v[j]); }
        *(uint2*)(proj + (long)r * LDP + c) = pack4(v[0], v[1], v[2], v[3]);
      }
    }
  }
};
struct EpiProjVT {
  u16* vt; int m0;
  DI void operator()(f32x16 (&acc)[2][2], int wm, int wn, int lane) const {
#pragma unroll
    for (int mt = 0; mt < 2; ++mt)
#pragma unroll
      for (int nt = 0; nt < 2; ++nt) {
        const int cc = EPI_C;
#pragma unroll
        for (int q4 = 0; q4 < 4; ++q4) {
          const int r = m0 + wm * 64 + mt * 32 + 8 * q4 + 4 * (lane >> 5);
          const int b = r >> 13, t = r & 8191;
          uint2 w;
          w.x = pack2(acc[mt][nt][q4 * 4 + 0], acc[mt][nt][q4 * 4 + 1]);
          w.y = pack2(acc[mt][nt][q4 * 4 + 2], acc[mt][nt][q4 * 4 + 3]);
          *(uint2*)(vt + ((long)(b * 128 + cc)) * T + t) = w;
        }
      }
  }
};
DI void phase2(const Params& p, char* smem, int bid, int nblk) {
  for (int item = bid; item < 64 * 34 + 256; item += nblk) {
    if (item < 64 * 34) {
      const int mt_ = item / 34, q = item % 34;
      const int nt_ = q < 7 ? q : (q < 8 ? q + 1 : q + 2);
      ARows af{p.h + (long)mt_ * 256 * 1024, 1024, 256};
      BMatT bf{p.w_inT + (long)nt_ * 128 * 1024, 1024};
      EpiProj ef{p.proj, p.widx, mt_ * 256, nt_ * 128};
      gemm_tile256<true>(smem, 16, af, bf, ef);
    } else {
      const int it = item - 64 * 34, mt_ = it >> 1, nt_ = (it & 1) ? 9 : 7;
      ARows af{p.h + (long)mt_ * 128 * 1024, 1024, 128};
      BMatT bf{p.w_inT + (long)nt_ * 128 * 1024, 1024};
      EpiProjVT ef{nt_ == 7 ? p.vts : p.vtw, mt_ * 128};
      gemm_tile<false, false, true>(smem, 16, 64, af, bf, ef);
    }
  }
}

struct ACmp {
  const u16* proj; int slot, m0;
  DI const u16* operator()(int r) const {
    const int R = m0 + r, bg = R >> 9, n = R & 511, b = bg >> 1, g = bg & 1;
    const int nc = n >= 511 ? 510 : n;
    return proj + ((long)b * T + 16 * nc) * LDP + C_KV + slot * 128 + g * 64;
  }
};
struct EpiCmp1 {
  u16* zc; const float* b1; const float* pe_part; int slot, m0;
  DI void operator()(f32x16 (&acc)[2][2], int wm, int wn, int lane) const {
    constexpr int MT = 2;
#pragma unroll
    for (int nt = 0; nt < 2; ++nt)
#pragma unroll
      for (int q4 = 0; q4 < 4; ++q4) {
        const int c = SW_C0;
        float4 bias = *(const float4*)(b1 + slot * 128 + c);
        for (int q = 0; q < 16; ++q) {
          const float4 t = *(const float4*)(pe_part + q * 256 + slot * 128 + c);
          bias.x += t.x; bias.y += t.y; bias.z += t.z; bias.w += t.w;
        }
#pragma unroll
        for (int mt = 0; mt < 2; ++mt) {
          const int R = m0 + SW_R;
          *(uint2*)(zc + ((long)slot * 2048 + R) * 128 + c) =
              pack4(gelu_tanh(SW_V(0) + bias.x), gelu_tanh(SW_V(1) + bias.y), gelu_tanh(SW_V(2) + bias.z), gelu_tanh(SW_V(3) + bias.w));
        }
      }
  }
};
struct EpiQlat {
  u16* qlat; int h, m0;
  DI void operator()(f32x16 (&acc)[2][2], int wm, int wn, int lane) const {
    constexpr int MT = 2;
    SW_FOR {
      const int r = m0 + SW_R, c = SW_C0;
      *(uint2*)(qlat + ((long)r * 8 + h) * 128 + c) = pack4(SW_V(0) * 0.125f, SW_V(1) * 0.125f, SW_V(2) * 0.125f, SW_V(3) * 0.125f);
    }
  }
};
DI void indexer_item(const Params& p, char* smem, int item);
DI void phase3(const Params& p, char* smem, int bid, int nblk) {
  const int tid = TIDX(), lane = tid & 63, wid = __builtin_amdgcn_readfirstlane(tid >> 6);
  if (bid < 32) {
    const int slot = bid >> 4, mt_ = bid & 15;
    ACmp af{p.proj, slot, mt_ * 128};
    BMat bf{p.cmp_w1 + (long)slot * 2048 * 128, 128, 128};
    EpiCmp1 ef{p.zc, p.cmp_b1, p.pe_part, slot, mt_ * 128};
    gemm_tile(smem, 32, LDP, af, bf, ef);
    return;
  }
  for (int item = bid - 32; item < 4160 + 1024 + 512; item += nblk - 32) {
    __syncthreads();
    if (item < 4160) {
      indexer_item(p, smem, item);
    } else if (item < 4160 + 1024) {
      const int it = item - 4160, h = it & 7, mt_ = it >> 3;
      ARows af{p.proj + (long)mt_ * 128 * LDP + C_QD + h * 64, LDP, 128};
      BMat bf{p.w_ukT + h * 64 * 128, 128, 128};
      EpiQlat ef{p.qlat, h, mt_ * 128};
      gemm_tile<true, true>(smem, 1, 64, af, bf, ef);
    } else {
      const int it = item - 4160 - 1024;
      for (int q = 0; q < 8; ++q) {
        const int row = it * 32 + wid * 8 + q;
        const unsigned u = *(const unsigned*)(p.proj + (long)row * LDP + C_CKV + lane * 2);
        const float a = lo16(u), b = hi16(u);
        const float ss = wave_sum(a * a + b * b);
        const float r = rsqrtf(ss * (1.f / 128.f) + 1e-6f);
        *(unsigned*)(p.ckv + (long)row * 128 + lane * 2) = pack2(a * r * p.dsa_kv_norm[lane * 2], b * r * p.dsa_kv_norm[lane * 2 + 1]);
      }
    }
  }
}

struct EpiCmp2 {
  u16* dst; int m0;
  DI void operator()(f32x16 (&acc)[2][2], int wm, int wn, int lane) const {
    constexpr int MT = 2;
    SW_FOR {
      const int R = m0 + SW_R, c = SW_C0;
      if (c < 64) *(uint2*)(dst + (long)R * 64 + c) = pack4(SW_V(0), SW_V(1), SW_V(2), SW_V(3));
    }
  }
};
struct EpiCmp2T {
  u16* dst; int m0;
  DI void operator()(f32x16 (&acc)[2][2], int wm, int wn, int lane) const {
#pragma unroll
    for (int mt = 0; mt < 2; ++mt)
#pragma unroll
      for (int nt = 0; nt < 2; ++nt) {
        const int c = EPI_C;
        if (c < 64) {
#pragma unroll
          for (int q4 = 0; q4 < 4; ++q4) {
            const int R = m0 + wm * 64 + mt * 32 + 8 * q4 + 4 * (lane >> 5);
            const int bg = R >> 9, n = R & 511;
            *(uint2*)(dst + ((long)(bg * 64 + c)) * 512 + n) =
                pack4(acc[mt][nt][q4 * 4 + 0], acc[mt][nt][q4 * 4 + 1], acc[mt][nt][q4 * 4 + 2], acc[mt][nt][q4 * 4 + 3]);
          }
        }
      }
  }
};
DI void indexer_item(const Params& p, char* smem, int item) {
  const int tid = TIDX(), lane = tid & 63, wid = __builtin_amdgcn_readfirstlane(tid >> 6);
  int b = 0, rem = item;
  if (rem >= 2080) { b = 1; rem -= 2080; }
  int qt = (int)((sqrtf(8.f * rem + 1.f) - 1.f) * 0.5f);
  while ((qt + 1) * (qt + 2) / 2 <= rem) ++qt;
  while (qt * (qt + 1) / 2 > rem) --qt;
  const int kt = rem - qt * (qt + 1) / 2;
  const int t0 = qt * 128 + (wid >> 1) * 64, s0 = kt * 128 + (wid & 1) * 64;
  if (s0 > t0 + 63) return;
  float* wl = (float*)smem + wid * 512;
  const float* wsrc = p.widx + ((long)b * T + t0) * 8;
#pragma unroll
  for (int i = 0; i < 8; ++i) wl[i * 64 + lane] = wsrc[i * 64 + lane];
  wave_sync();
  const u16* projb = p.proj + (long)b * T * LDP;
  const int r31 = lane & 31, hf = lane >> 5;
  bf16x8 bfr[2][4];
#pragma unroll
  for (int nt = 0; nt < 2; ++nt)
#pragma unroll
    for (int ks = 0; ks < 4; ++ks) bfr[nt][ks] = *(const bf16x8*)(projb + (long)(s0 + nt * 32 + r31) * LDP + C_KI + ks * 16 + hf * 8);
  f32x16 sum[2][2];
#pragma unroll
  for (int a = 0; a < 2; ++a)
#pragma unroll
    for (int c = 0; c < 2; ++c)
#pragma unroll
      for (int i = 0; i < 16; ++i) sum[a][c][i] = 0.f;
  const u16* qbase = projb + (long)(t0 + r31) * LDP + C_QI + hf * 8;
  bf16x8 af0[4], af1[4];
#define IDX_LOADQ(DST, STEP)                                                                            \
  _Pragma("unroll") for (int ks = 0; ks < 4; ++ks) DST[ks] = *(const bf16x8*)(qbase + (long)((STEP) & 1) * 32 * LDP + ((STEP) >> 1) * 64 + ks * 16);
#define IDX_STEP(SRC, MT, H)                                                                            \
  {                                                                                                     \
    const float w_ = wl[((MT) * 32 + r31) * 8 + (H)];                                                   \
    _Pragma("unroll") for (int nt = 0; nt < 2; ++nt) {                                                  \
      f32x16 acc;                                                                                       \
      _Pragma("unroll") for (int i = 0; i < 16; ++i) acc[i] = 0.f;                                      \
      _Pragma("unroll") for (int ks = 0; ks < 4; ++ks) acc = __builtin_amdgcn_mfma_f32_32x32x16_bf16(bfr[nt][ks], SRC[ks], acc, 0, 0, 0); \
      _Pragma("unroll") for (int i = 0; i < 16; ++i) sum[MT][nt][i] += w_ * fmaxf(acc[i], 0.f);        \
    }                                                                                                   \
  }
  IDX_LOADQ(af0, 0)
#pragma unroll 1
  for (int h = 0; h < 8; ++h) {
    IDX_LOADQ(af1, 2 * h + 1)
    asm volatile("" ::: "memory");
    IDX_STEP(af0, 0, h)
    asm volatile("" ::: "memory");
    { const int sn = 2 * h + 2 < 15 ? 2 * h + 2 : 15; IDX_LOADQ(af0, sn) }
    asm volatile("" ::: "memory");
    IDX_STEP(af1, 1, h)
    asm volatile("" ::: "memory");
  }
#undef IDX_LOADQ
#undef IDX_STEP
#pragma unroll
  for (int mt = 0; mt < 2; ++mt)
#pragma unroll
    for (int nt = 0; nt < 2; ++nt)
#pragma unroll
      for (int q4 = 0; q4 < 4; ++q4)
        *(float4*)(p.scores + ((long)b * T + t0 + mt * 32 + r31) * T + s0 + nt * 32 + 8 * q4 + 4 * hf) =
            make_float4(sum[mt][nt][4 * q4], sum[mt][nt][4 * q4 + 1], sum[mt][nt][4 * q4 + 2], sum[mt][nt][4 * q4 + 3]);
}
DI void topk_row(const Params& p, int b, int t, int lane);
DI void phase4(const Params& p, char* smem, int bid, int nblk) {
  if (bid < 32) {
    const int slot = bid >> 4, mt_ = bid & 15;
    ARows af{p.zc + ((long)slot * 2048 + mt_ * 128) * 128, 128, 128};
    BMat bf{p.cmp_w2 + slot * 128 * 64, 64, 64};
    if (slot) { EpiCmp2T ef{p.vcT, mt_ * 128}; gemm_tile<false>(smem, 2, 64, af, bf, ef); }
    else { EpiCmp2 ef{p.kc, mt_ * 128}; gemm_tile(smem, 2, 64, af, bf, ef); }
  }
  const int tid = TIDX(), lane = tid & 63, wid = __builtin_amdgcn_readfirstlane(tid >> 6);
  for (int item = bid; item < 2048; item += nblk) {
    const int it = item < 1024 ? 2047 - item : item - 1024;
    const int b = it & 1, tb = it >> 1;
#pragma unroll 1
    for (int q = 0; q < 2; ++q) {
      asm volatile("" ::: "memory");
      topk_row(p, b, tb * 8 + wid * 2 + q, lane);
    }
  }
}

using f32x4 = __attribute__((ext_vector_type(4))) float;
#define MFMA16(a, b, c) __builtin_amdgcn_mfma_f32_16x16x32_bf16((a), (b), (c), 0, 0, 0)
#define MFMA32(a, b, c) __builtin_amdgcn_mfma_f32_32x32x16_bf16((a), (b), (c), 0, 0, 0)

constexpr int NSA_STAGE_BYTES = 64 * 72 * 2 + 64 * 68 * 2;
DI void dense_scores(f32x16 (&acc)[2], const u16* Ks, const bf16x8 (&qf)[4], int lane) {
  const int r = lane & 31, hf = lane >> 5;
#pragma unroll
  for (int tile = 0; tile < 2; ++tile) {
    const u16* kp = Ks + (32 * tile + r) * 72 + 8 * hf;
    f32x16 c;
#pragma unroll
    for (int i = 0; i < 16; ++i) c[i] = 0.f;
#pragma unroll
    for (int ks = 0; ks < 4; ++ks) c = MFMA32(*(const bf16x8*)(kp + 16 * ks), qf[ks], c);
    acc[tile] = c;
  }
}
DI void dense_pv(const f32x16 (&acc)[2], const u16* Vs, int lane, f32x16 (&o)[2]) {
  const int r = lane & 31, hf = lane >> 5;
#pragma unroll
  for (int tile = 0; tile < 2; ++tile)
#pragma unroll
    for (int s = 0; s < 2; ++s) {
      uint4 w;
      w.x = pack2(acc[tile][8 * s + 0], acc[tile][8 * s + 1]);
      w.y = pack2(acc[tile][8 * s + 2], acc[tile][8 * s + 3]);
      w.z = pack2(acc[tile][8 * s + 4], acc[tile][8 * s + 5]);
      w.w = pack2(acc[tile][8 * s + 6], acc[tile][8 * s + 7]);
      const bf16x8 pb = __builtin_bit_cast(bf16x8, w);
#pragma unroll
      for (int dt = 0; dt < 2; ++dt) {
        const u16* vp = Vs + (32 * dt + r) * 68 + 32 * tile + 16 * s + 4 * hf;
        const uint2 lo = *(const uint2*)vp;
        const uint2 hi = *(const uint2*)(vp + 8);
        uint4 a;
        a.x = lo.x; a.y = lo.y; a.z = hi.x; a.w = hi.y;
        o[dt] = MFMA32(__builtin_bit_cast(bf16x8, a), pb, o[dt]);
      }
    }
}
constexpr float LOG2E = 1.4426950408889634f;
template <int DSTEP>
DI float dense_mask(f32x16 (&acc)[2], bool active, int lo_c, int hi_c, int dist0_c, int dmin_u, const float* btab_h, int lane) {
  const int hf = lane >> 5;
  const bool colfull = !active || (lo_c <= 0 && hi_c >= 63);
  float mx = -INFINITY;
  if (dmin_u >= 128 && __ballot(colfull) == ~0ull) {
    const float be = active ? btab_h[128] : -INFINITY;
#pragma unroll
    for (int tile = 0; tile < 2; ++tile)
#pragma unroll
      for (int i = 0; i < 16; ++i) {
        const float sv = fmaf(acc[tile][i], LOG2E, be);
        acc[tile][i] = sv;
        mx = fmaxf(mx, sv);
      }
  } else {
    const int lo2 = active ? lo_c : 1, hi2 = active ? hi_c : 0;
#pragma unroll
    for (int tile = 0; tile < 2; ++tile)
#pragma unroll
      for (int i = 0; i < 16; ++i) {
        const int kl = 32 * tile + (i & 3) + 8 * (i >> 2) + 4 * hf;
        int dc = dist0_c - DSTEP * kl;
        dc = dc < 0 ? 0 : (dc > 128 ? 128 : dc);
        const float bias = btab_h[dc];
        const float s2 = fmaf(acc[tile][i], LOG2E, bias);
        const float sv = (kl >= lo2 && kl <= hi2) ? s2 : -INFINITY;
        acc[tile][i] = sv;
        mx = fmaxf(mx, sv);
      }
  }
  return fmaxf(mx, __shfl_xor(mx, 32));
}
DI void dense_chunk(const u16* Ks, const u16* Vs, bool active, int lo_c, int hi_c, int dist0_c, int dmin_u, const bf16x8 (&qf)[4],
                    const float* btab_h, int lane, float& m, float& l, f32x16 (&o)[2]) {
  f32x16 acc[2];
  dense_scores(acc, Ks, qf, lane);
  const float mx = dense_mask<1>(acc, active, lo_c, hi_c, dist0_c, dmin_u, btab_h, lane);
  const float mn = fmaxf(m, mx);
  const float alpha = __builtin_amdgcn_exp2f(m - mn);
  float ls = 0.f;
#pragma unroll
  for (int tile = 0; tile < 2; ++tile)
#pragma unroll
    for (int i = 0; i < 16; ++i) {
      const float pv = __builtin_amdgcn_exp2f(acc[tile][i] - mn);
      acc[tile][i] = pv;
      ls += pv;
    }
  ls += __shfl_xor(ls, 32);
  l = l * alpha + ls;
  m = mn;
  o[0] *= alpha;
  o[1] *= alpha;
  dense_pv(acc, Vs, lane, o);
}

template <int KSG, int VSG, bool NEEDV, class Next, class Body>
DI void chunk_pipeline(char* stage, const u16* kg0, const u16* vg0, int first, int tid, const Next& next, const Body& body) {
  const int srow = tid >> 2, spiece = tid & 3;
  uint4 rk0, rk1, rv0, rv1;
  rv0 = rv1 = make_uint4(0, 0, 0, 0);
  int d = first;
#define NSA_GLOAD(D)                                                                      \
  {                                                                                       \
    const uint4* pk_ = (const uint4*)(kg0 + ((long)(D) * 64 + srow) * KSG + spiece * 16); \
    rk0 = pk_[0]; rk1 = pk_[1];                                                           \
    if (NEEDV) {                                                                          \
      const uint4* pv_ = (const uint4*)(vg0 + (long)srow * VSG + (D) * 64 + spiece * 16); \
      rv0 = pv_[0]; rv1 = pv_[1];                                                         \
    }                                                                                     \
  }
  if (d >= 0) NSA_GLOAD(d)
  int ph = 0;
  __syncthreads();
  while (d >= 0) {
    u16* Ks = (u16*)(stage + ph * NSA_STAGE_BYTES);
    u16* Vs = Ks + 64 * 72;
    *(uint4*)(Ks + srow * 72 + spiece * 16) = rk0;
    *(uint4*)(Ks + srow * 72 + spiece * 16 + 8) = rk1;
    if (NEEDV) {
      uint2* dv = (uint2*)(Vs + srow * 68 + spiece * 16);
      dv[0] = make_uint2(rv0.x, rv0.y); dv[1] = make_uint2(rv0.z, rv0.w);
      dv[2] = make_uint2(rv1.x, rv1.y); dv[3] = make_uint2(rv1.z, rv1.w);
    }
    const int dn = next(d);
    if (dn >= 0) NSA_GLOAD(dn)
    __syncthreads();
    body(d, Ks, Vs);
    ph ^= 1;
    d = dn;
  }
#undef NSA_GLOAD
}

DI void nsa_item(const Params& p, char* smem, int item) {
  const int tid = TIDX(), lane = tid & 63, wid = __builtin_amdgcn_readfirstlane(tid >> 6);
  const int chunk = item & 255, g = (item >> 8) & 1, b = item >> 9;
  const int bg = b * 2 + g;
  float* btab = (float*)smem;
  u64* wun = (u64*)(smem + 2304);
  float* imps = (float*)(smem + 4096) + wid * 1056;
  char* stage = smem + 21504;
  for (int idx = tid; idx < 4 * 129; idx += 256) {
    const int h = idx / 129, d = idx % 129;
    const int bk = d < 128 ? BUCKET[d] : 31;
    btab[h * 132 + d] = p.rel_bias[bk * 16 + g * 4 + h] * LOG2E;
  }
  __syncthreads();
  const int t0 = chunk * 32;
  const int tw = t0 + wid * 8;
  const int c = lane & 31, hf = lane >> 5, qi = c >> 2, hh = c & 3;
  const int t_c = tw + qi;
  const int cur = t0 >> 6;
  const long row = (long)b * T + t_c;
  const u16* prow = p.proj + row * LDP;
  const u16* projb = p.proj + (long)b * T * LDP;
  const float* btab_h = btab + hh * 132;
  bf16x8 qf[4];
#pragma unroll
  for (int ks = 0; ks < 4; ++ks) qf[ks] = *(const bf16x8*)(prow + C_QN + (g * 4 + hh) * 64 + ks * 16 + hf * 8);
  const u16* gptr = prow + C_GN + (g * 4 + hh) * 3;
  for (int k = lane; k < 1056; k += 64) imps[k] = 0.f;
  u16* orow = p.onsa + row * 512 + (g * 4 + hh) * 64 + 4 * hf;
  auto emit = [&](const f32x16 (&o)[2], float sc, bool first) {
#pragma unroll
    for (int dt = 0; dt < 2; ++dt)
#pragma unroll
      for (int q4 = 0; q4 < 4; ++q4) {
        uint2* dst = (uint2*)(orow + 32 * dt + 8 * q4);
        float v0 = o[dt][4 * q4 + 0] * sc, v1 = o[dt][4 * q4 + 1] * sc, v2 = o[dt][4 * q4 + 2] * sc, v3 = o[dt][4 * q4 + 3] * sc;
        if (!first) {
          const uint2 u = *dst;
          v0 += lo16(u.x); v1 += hi16(u.x); v2 += lo16(u.y); v3 += hi16(u.y);
        }
        uint2 w;
        w.x = pack2(v0, v1);
        w.y = pack2(v2, v3);
        *dst = w;
      }
  };
  const int ncv_c = (t_c >= 31) ? ((t_c - 31) >> 4) + 1 : 0;
  const int ncv_max = (t0 + 31 >= 31) ? ((t0 + 31 - 31) >> 4) + 1 : 0;
  const int nchunk_c = (ncv_max + 63) >> 6;
  {
    const u16* kcb = p.kc + (long)bg * 512 * 64;
    const u16* vcb = p.vcT + (long)bg * 64 * 512;
    float m = -1e30f, l = 0.f;
    auto next_c = [&](int d) { return d + 1 < nchunk_c ? d + 1 : -1; };
    chunk_pipeline<64, 512, false>(stage, kcb, vcb, 0, tid, next_c, [&](int i, const u16* Ks, const u16* Vs) {
      f32x16 acc[2];
      dense_scores(acc, Ks, qf, lane);
      const float mx = dense_mask<16>(acc, true, 0, ncv_c - 1 - i * 64, t_c - 31 - 1024 * i, tw - 31 - 1024 * i - 1008, btab_h, lane);
      const float mn = fmaxf(m, mx);
      float ls = 0.f;
#pragma unroll
      for (int tile = 0; tile < 2; ++tile)
#pragma unroll
        for (int q = 0; q < 16; ++q) ls += __builtin_amdgcn_exp2f(acc[tile][q] - mn);
      ls += __shfl_xor(ls, 32);
      l = l * __builtin_amdgcn_exp2f(m - mn) + ls;
      m = mn;
    });
    const float invl = 1.f / fmaxf(l, 1e-30f);
    f32x16 oc[2];
#pragma unroll
    for (int i = 0; i < 16; ++i) { oc[0][i] = 0.f; oc[1][i] = 0.f; }
    chunk_pipeline<64, 512, true>(stage, kcb, vcb, 0, tid, next_c, [&](int i, const u16* Ks, const u16* Vs) {
      f32x16 acc[2];
      dense_scores(acc, Ks, qf, lane);
      (void)dense_mask<16>(acc, true, 0, ncv_c - 1 - i * 64, t_c - 31 - 1024 * i, tw - 31 - 1024 * i - 1008, btab_h, lane);
      float part[2][4], spill[2][4];
#pragma unroll
      for (int tile = 0; tile < 2; ++tile) {
#pragma unroll
        for (int q = 0; q < 16; ++q) acc[tile][q] = __builtin_amdgcn_exp2f(acc[tile][q] - m) * invl;
#pragma unroll
        for (int q4 = 0; q4 < 4; ++q4) {
          float pa = acc[tile][4 * q4] + acc[tile][4 * q4 + 1] + acc[tile][4 * q4 + 2] + 0.5f * acc[tile][4 * q4 + 3];
          float sp = 0.5f * acc[tile][4 * q4 + 3];
          pa += __shfl_xor(pa, 1); pa += __shfl_xor(pa, 2);
          sp += __shfl_xor(sp, 1); sp += __shfl_xor(sp, 2);
          part[tile][q4] = pa; spill[tile][q4] = sp;
        }
      }
      if (hh == 0) {
#pragma unroll
        for (int tile = 0; tile < 2; ++tile)
#pragma unroll
          for (int q4 = 0; q4 < 4; ++q4) imps[qi * 132 + 16 * i + 8 * tile + 2 * q4 + hf] += part[tile][q4];
      }
      wave_sync();
      if (hh == 0) {
#pragma unroll
        for (int tile = 0; tile < 2; ++tile)
#pragma unroll
          for (int q4 = 0; q4 < 4; ++q4) imps[qi * 132 + 16 * i + 8 * tile + 2 * q4 + hf + 1] += spill[tile][q4];
      }
      wave_sync();
      dense_pv(acc, Vs, lane, oc);
    });
    emit(oc, bf2f(gptr[0]), true);
  }
  wave_sync();
  u64 my0 = 0, my1 = 0, wu0 = 0, wu1 = 0;
  for (int q = 0; q < 8; ++q) {
    u64 mask0, mask1;
    if (cur <= 15) {
      mask0 = (2ull << cur) - 1ull;
      mask1 = 0ull;
    } else {
      const float imp_lo = imps[q * 132 + lane], imp_hi = imps[q * 132 + lane + 64];
      const int jl = lane, jh = lane + 64;
      float c0 = (jl >= 1 && jl <= cur - 2) ? imp_lo : -1.f;
      float c1 = (jh <= cur - 2) ? imp_hi : -1.f;
      bool sel_lo = (jl == 0) || (jl == cur) || (jl == cur - 1);
      bool sel_hi = (jh == cur) || (jh == cur - 1);
      for (int r = 0; r < 13; ++r) {
        float bv; int bj;
        if (c0 >= c1) { bv = c0; bj = jl; } else { bv = c1; bj = jh; }
        wave_argmax(bv, bj);
        if (bj == jl) { sel_lo = true; c0 = -1.f; }
        if (bj == jh) { sel_hi = true; c1 = -1.f; }
      }
      mask0 = __ballot(sel_lo);
      mask1 = __ballot(sel_hi);
    }
    if (qi == q) { my0 = mask0; my1 = mask1; }
    wu0 |= mask0; wu1 |= mask1;
  }
  if (lane == 0) { wun[wid * 2] = wu0; wun[wid * 2 + 1] = wu1; }
  __syncthreads();
  u64 bu0 = wun[0] | wun[2] | wun[4] | wun[6], bu1 = wun[1] | wun[3] | wun[5] | wun[7];
  bu0 = ((u64)(unsigned)__builtin_amdgcn_readfirstlane((int)(bu0 >> 32)) << 32) | (unsigned)__builtin_amdgcn_readfirstlane((int)bu0);
  bu1 = ((u64)(unsigned)__builtin_amdgcn_readfirstlane((int)(bu1 >> 32)) << 32) | (unsigned)__builtin_amdgcn_readfirstlane((int)bu1);
  {
    float m = -1e30f, l = 0.f;
    f32x16 o[2];
#pragma unroll
    for (int i = 0; i < 16; ++i) { o[0][i] = 0.f; o[1][i] = 0.f; }
    const int kcol = C_KV + 2 * 128 + g * 64;
    auto next_s = [&](int j) {
      ++j;
      if (j < 64) {
        const u64 mm = bu0 & (~0ull << j);
        if (mm) return (int)__builtin_ctzll(mm);
        j = 64;
      }
      if (j >= 128) return -1;
      const u64 mm = bu1 & (~0ull << (j - 64));
      return mm ? 64 + (int)__builtin_ctzll(mm) : -1;
    };
    chunk_pipeline<LDP, T, true>(stage, projb + kcol, p.vts + (long)bg * 64 * T, 0, tid, next_s, [&](int j, const u16* Ks, const u16* Vs) {
      const bool bit = ((j < 64 ? (my0 >> j) : (my1 >> (j - 64))) & 1ull) != 0;
      if (__ballot(bit) != 0ull) {
        const int pos0 = 64 * j;
        dense_chunk(Ks, Vs, bit, 0, t_c - pos0, t_c - pos0, tw - pos0 - 63, qf, btab_h, lane, m, l, o);
      }
    });
    emit(o, bf2f(gptr[1]) / fmaxf(l, 1e-30f), false);
  }
  {
    float m = -1e30f, l = 0.f;
    f32x16 o[2];
#pragma unroll
    for (int i = 0; i < 16; ++i) { o[0][i] = 0.f; o[1][i] = 0.f; }
    const int kcol = C_KV + 4 * 128 + g * 64;
    const int wlo_c = t_c - 511 < 0 ? 0 : t_c - 511;
    const int wlo_min = t0 - 511 < 0 ? 0 : t0 - 511;
    auto next_w = [&](int j) { return j + 1 <= cur ? j + 1 : -1; };
    chunk_pipeline<LDP, T, true>(stage, projb + kcol, p.vtw + (long)bg * 64 * T, wlo_min >> 6, tid, next_w, [&](int jw, const u16* Ks, const u16* Vs) {
      const int pos0 = 64 * jw;
      const int lo_c = wlo_c - pos0 < 0 ? 0 : wlo_c - pos0;
      dense_chunk(Ks, Vs, true, lo_c, t_c - pos0, t_c - pos0, tw - pos0 - 63, qf, btab_h, lane, m, l, o);
    });
    emit(o, bf2f(gptr[2]) / fmaxf(l, 1e-30f), false);
  }
}

DI unsigned f2ord(float v) { const unsigned u = __float_as_uint(v); return (u & 0x80000000u) ? ~u : (u | 0x80000000u); }

DI void topk_row(const Params& p, int b, int t, int lane) {
  const long row = (long)b * T + t;
  int* dst = p.selk + row * 256;
  if (t < 256) {
#pragma unroll
    for (int i = 0; i < 4; ++i) { const int s = i * 64 + lane; dst[s] = (s <= t) ? s : -1; }
    return;
  }
  const float* srow = p.scores + row * T;
  const int ngrp = (t >> 10) + 1;
  unsigned u[128];
  int ln = lane;
  asm volatile("" : "+v"(ln));
#pragma unroll
  for (int gq = 0; gq < 8; ++gq) {
    if (gq < ngrp) {
#pragma unroll
      for (int j = 0; j < 16; ++j) {
        const int s = (gq * 16 + j) * 64 + ln;
        const float v = srow[s < t ? s : t];
        u[gq * 16 + j] = (s <= t) ? f2ord(v) : 0u;
      }
    } else {
#pragma unroll
      for (int j = 0; j < 16; ++j) u[gq * 16 + j] = 0u;
    }
  }
  unsigned thr = 0u;
  for (int bit = 31; bit >= 0; --bit) {
    const unsigned cand = thr | (1u << bit);
    int cl = 0;
#pragma unroll
    for (int gq = 0; gq < 8; ++gq) {
      if (gq < ngrp) {
#pragma unroll
        for (int j = 0; j < 16; ++j) cl += (u[gq * 16 + j] >= cand) ? 1 : 0;
      }
    }
    const int cnt = wave_sum_i(cl);
    if (cnt >= 256) thr = cand;
    if (cnt == 256) break;
  }
  int ngt = 0;
#pragma unroll
  for (int gq = 0; gq < 8; ++gq) {
    if (gq < ngrp) {
#pragma unroll
      for (int j = 0; j < 16; ++j) ngt += __popcll(__ballot(u[gq * 16 + j] > thr));
    }
  }
  int base_gt = 0, base_eq = 0;
  const int need_eq = 256 - ngt;
  int ln2 = lane;
  asm volatile("" : "+v"(ln2));
#pragma unroll
  for (int gq = 0; gq < 8; ++gq) {
    if (gq < ngrp) {
#pragma unroll
      for (int j = 0; j < 16; ++j) {
        const int s = (gq * 16 + j) * 64 + ln2;
        const unsigned uv = u[gq * 16 + j];
        const bool gt = uv > thr, eq = uv == thr;
        const u64 mg = __ballot(gt), me = __ballot(eq);
        const int pg = __builtin_amdgcn_mbcnt_hi((unsigned)(mg >> 32), __builtin_amdgcn_mbcnt_lo((unsigned)mg, 0));
        const int pe = __builtin_amdgcn_mbcnt_hi((unsigned)(me >> 32), __builtin_amdgcn_mbcnt_lo((unsigned)me, 0));
        if (gt) dst[base_gt + pg] = s;
        if (eq && (base_eq + pe) < need_eq) dst[ngt + base_eq + pe] = s;
        base_gt += __popcll(mg);
        base_eq += __popcll(me);
      }
    }
  }
}

DI void phase6(const Params& p, char* smem, int bid, int nblk);
DI void phase5(const Params& p, char* smem, int bid, int nblk) {
  for (int item = bid; item < 1024; item += nblk) {
    __syncthreads();
    const int it = item < 512 ? 1023 - item : item - 512;
    const int chunk = it >> 2, bgi = it & 3;
    nsa_item(p, smem, (bgi << 8) | chunk);
  }
  __syncthreads();
  phase6(p, smem, bid, nblk);
}

DI void tr_read2(unsigned a0, unsigned a1, uint2& r0, uint2& r1) {
  asm volatile("ds_read_b64_tr_b16 %0, %2\n\tds_read_b64_tr_b16 %1, %3\n\ts_waitcnt lgkmcnt(0)" : "=&v"(r0), "=&v"(r1) : "v"(a0), "v"(a1) : "memory");
}
DI void dsa_query(const Params& p, u16* Cs, const float* btab, int b, int t, int lane) {
  const long row = (long)b * T + t;
  const int lg = lane >> 4, r16 = lane & 15, hh = lane & 7;
  bf16x8 qf[4];
#pragma unroll
  for (int ks = 0; ks < 4; ++ks) {
    bf16x8 z = {0, 0, 0, 0, 0, 0, 0, 0};
    if (r16 < 8) z = *(const bf16x8*)(p.qlat + (row * 8 + r16) * 128 + ks * 32 + lg * 8);
    qf[ks] = z;
  }
  const u16* ckvb = p.ckv + (long)b * T * 128;
  const int nvalid = (t + 1) < 256 ? (t + 1) : 256;
  float m = -1e30f, l = 0.f;
  f32x4 o[8];
#pragma unroll
  for (int ct = 0; ct < 8; ++ct) o[ct] = (f32x4){0.f, 0.f, 0.f, 0.f};
  const unsigned cs_base = (unsigned)(size_t)Cs;
  for (int ch = 0; ch * 32 < nvalid; ++ch) {
    const int nval = (nvalid - ch * 32) > 32 ? 32 : (nvalid - ch * 32);
    int kidx = p.selk[row * 256 + ch * 32 + (lane & 31)];
    if ((lane & 31) >= nval || kidx < 0 || kidx > t) kidx = t;
    wave_sync();
#pragma unroll
    for (int i = 0; i < 8; ++i) {
      const int r = 4 * i + lg;
      const int kr = __shfl(kidx, r);
      const uint4 v = *(const uint4*)(ckvb + (long)kr * 128 + r16 * 8);
      *(uint4*)(Cs + r * 144 + r16 * 8) = v;
    }
    wave_sync();
    f32x4 acc[2];
#pragma unroll
    for (int rt = 0; rt < 2; ++rt) {
      const u16* kp = Cs + (16 * rt + r16) * 144 + 8 * lg;
      f32x4 c = {0.f, 0.f, 0.f, 0.f};
#pragma unroll
      for (int ks = 0; ks < 4; ++ks) c = MFMA16(*(const bf16x8*)(kp + 32 * ks), qf[ks], c);
      acc[rt] = c;
    }
    float mx = -INFINITY;
#pragma unroll
    for (int rt = 0; rt < 2; ++rt)
#pragma unroll
      for (int r = 0; r < 4; ++r) {
        const int pl = 16 * rt + 4 * lg + r;
        const int kk = __shfl(kidx, pl);
        int dc = t - kk;
        dc = dc < 0 ? 0 : (dc > 128 ? 128 : dc);
        const float sv = (pl < nval) ? fmaf(acc[rt][r], LOG2E, btab[hh * 132 + dc]) : -INFINITY;
        acc[rt][r] = sv;
        mx = fmaxf(mx, sv);
      }
    mx = fmaxf(mx, __shfl_xor(mx, 16));
    mx = fmaxf(mx, __shfl_xor(mx, 32));
    const float mn = fmaxf(m, mx);
    const float alpha = __builtin_amdgcn_exp2f(m - mn);
    float ls = 0.f;
#pragma unroll
    for (int rt = 0; rt < 2; ++rt)
#pragma unroll
      for (int r = 0; r < 4; ++r) {
        const float pv = __builtin_amdgcn_exp2f(acc[rt][r] - mn);
        acc[rt][r] = pv;
        ls += pv;
      }
    ls += __shfl_xor(ls, 16);
    ls += __shfl_xor(ls, 32);
    l = l * alpha + ls;
    m = mn;
    uint4 pw;
    pw.x = pack2(acc[0][0], acc[0][1]);
    pw.y = pack2(acc[0][2], acc[0][3]);
    pw.z = pack2(acc[1][0], acc[1][1]);
    pw.w = pack2(acc[1][2], acc[1][3]);
    const bf16x8 pb = __builtin_bit_cast(bf16x8, pw);
    const unsigned a_lo = cs_base + (unsigned)(((4 * lg + (r16 >> 2)) * 144 + 4 * (r16 & 3)) * 2);
    const unsigned a_hi = a_lo + 16 * 144 * 2;
#pragma unroll
    for (int ct = 0; ct < 8; ++ct) {
      uint2 lo, hi;
      tr_read2(a_lo + ct * 32, a_hi + ct * 32, lo, hi);
      uint4 aw;
      aw.x = lo.x; aw.y = lo.y; aw.z = hi.x; aw.w = hi.y;
      o[ct] = o[ct] * alpha;
      o[ct] = MFMA16(__builtin_bit_cast(bf16x8, aw), pb, o[ct]);
    }
  }
  const float invl = 1.f / fmaxf(l, 1e-30f);
  if (r16 < 8) {
#pragma unroll
    for (int ct = 0; ct < 8; ++ct)
      *(uint2*)(p.olat + row * 1024 + r16 * 128 + 16 * ct + 4 * lg) = pack4(o[ct][0] * invl, o[ct][1] * invl, o[ct][2] * invl, o[ct][3] * invl);
  }
}
DI void phase6(const Params& p, char* smem, int bid, int nblk) {
  const int tid = TIDX(), lane = tid & 63, wid = __builtin_amdgcn_readfirstlane(tid >> 6);
  float* btab = (float*)smem;
  u16* Cs = (u16*)(smem + 8192) + wid * (32 * 144);
  for (int idx = tid; idx < 8 * 129; idx += 256) {
    const int h = idx / 129, d = idx % 129;
    const int bk = d < 128 ? BUCKET[d] : 31;
    btab[h * 132 + d] = p.rel_bias[bk * 16 + 8 + h] * LOG2E;
  }
  __syncthreads();
  for (int item = bid; item < 2048; item += nblk) {
    const int it = item < 1024 ? 2047 - item : item - 1024;
    const int b = it & 1, tb = it >> 1;
    for (int q = 0; q < 2; ++q) dsa_query(p, Cs, btab, b, tb * 8 + wid * 2 + q, lane);
  }
}

struct EpiOdsa {
  u16* odsa; int h, m0;
  DI void operator()(f32x16 (&acc)[2][2], int wm, int wn, int lane) const {
    constexpr int MT = 2;
    SW_FOR {
      const int r = m0 + SW_R, c = SW_C0;
      if (c < 64) *(uint2*)(odsa + (long)r * 512 + h * 64 + c) = pack4(SW_V(0), SW_V(1), SW_V(2), SW_V(3));
    }
  }
};
DI void phase7(const Params& p, char* smem, int bid, int nblk) {
  for (int item = bid; item < 1024; item += nblk) {
    const int h = item & 7, mt_ = item >> 3;
    ARows af{p.olat + (long)mt_ * 128 * 1024 + h * 128, 1024, 128};
    BMat bf{p.dsa_w_uv + h * 64, 512, 64};
    EpiOdsa ef{p.odsa, h, mt_ * 128};
    gemm_tile(smem, 2, 64, af, bf, ef);
  }
}

struct EpiY {
  u16* y; const u16* proj; int m0, n0, second;
  template <int MT> DI void operator()(f32x16 (&acc)[MT][2], int wm, int wn, int lane) const {
    SW_FOR {
      const int r = m0 + SW_R, c = n0 + SW_C0;
      const uint2 gu = *(const uint2*)(proj + (long)r * LDP + C_GM + second * 1024 + c);
      float v0 = lo16(gu.x) * SW_V(0), v1 = hi16(gu.x) * SW_V(1), v2 = lo16(gu.y) * SW_V(2), v3 = hi16(gu.y) * SW_V(3);
      uint2* dst = (uint2*)(y + (long)r * 1024 + c);
      if (second) {
        const uint2 yu = *dst;
        v0 += lo16(yu.x); v1 += hi16(yu.x); v2 += lo16(yu.y); v3 += hi16(yu.y);
      }
      *dst = pack4(v0, v1, v2, v3);
    }
  }
};
DI void phase8(const Params& p, char* smem, int bid, int nblk) {
  for (int item = bid; item < 512; item += nblk) {
    const int nt_ = item & 7, mt_ = item >> 3;
    {
      ARows af{p.onsa + (long)mt_ * 256 * 512, 512, 256};
      BMatT bf{p.w_bnT + (long)nt_ * 128 * 512, 512};
      EpiY ef{p.y, p.proj, mt_ * 256, nt_ * 128, 0};
      gemm_tile256<true>(smem, 8, af, bf, ef);
    }
    {
      ARows af{p.odsa + (long)mt_ * 256 * 512, 512, 256};
      BMatT bf{p.w_bdT + (long)nt_ * 128 * 512, 512};
      EpiY ef{p.y, p.proj, mt_ * 256, nt_ * 128, 1};
      gemm_tile256<true>(smem, 8, af, bf, ef);
    }
  }
}
struct EpiStoreBf {
  u16* dst; long ld; int m0, n0;
  template <int MT> DI void operator()(f32x16 (&acc)[MT][2], int wm, int wn, int lane) const {
    SW_FOR { *(uint2*)(dst + (long)(m0 + SW_R) * ld + n0 + SW_C0) = pack4(SW_V(0), SW_V(1), SW_V(2), SW_V(3)); }
  }
};
DI void phase9(const Params& p, char* smem, int bid, int nblk) {
  for (int item = bid; item < 512; item += nblk) {
    const int nt_ = item & 7, mt_ = item >> 3;
    ARows af{p.y + (long)mt_ * 256 * 1024, 1024, 256};
    BMatT bf{p.w_outT + (long)nt_ * 128 * 1024, 1024};
    EpiStoreBf ef{p.z, 1024, mt_ * 256, nt_ * 128};
    gemm_tile256<true>(smem, 16, af, bf, ef);
  }
}

DI void phase10(const Params& p, int bid, int nblk) {
  const int tid = TIDX(), lane = tid & 63, wid = __builtin_amdgcn_readfirstlane(tid >> 6);
  for (int row = bid * 4 + wid; row < NTOK; row += nblk * 4) {
    const int b = row >> 13;
    const float* modb = p.mod + b * 6144;
    float zv[16], xv[16];
    float ss = 0.f;
#pragma unroll
    for (int i = 0; i < 4; ++i) {
      const int col = i * 256 + lane * 4;
      const uint2 u = *(const uint2*)(p.z + (long)row * 1024 + col);
      zv[i * 4 + 0] = lo16(u.x); zv[i * 4 + 1] = hi16(u.x); zv[i * 4 + 2] = lo16(u.y); zv[i * 4 + 3] = hi16(u.y);
      const float4 xx = *(const float4*)(p.x + (long)row * 1024 + col);
      xv[i * 4 + 0] = xx.x; xv[i * 4 + 1] = xx.y; xv[i * 4 + 2] = xx.z; xv[i * 4 + 3] = xx.w;
#pragma unroll
      for (int j = 0; j < 4; ++j) ss += zv[i * 4 + j] * zv[i * 4 + j];
    }
    ss = wave_sum(ss);
    const float r = rsqrtf(ss * (1.f / 1024.f) + 1e-6f);
    float ss2 = 0.f;
#pragma unroll
    for (int i = 0; i < 4; ++i)
#pragma unroll
      for (int j = 0; j < 4; ++j) {
        const int col = i * 256 + lane * 4 + j;
        const float v = xv[i * 4 + j] + modb[2048 + col] * (zv[i * 4 + j] * r * p.g_post_mix[col]);
        xv[i * 4 + j] = v;
        ss2 += v * v;
      }
    ss2 = wave_sum(ss2);
    const float r2 = rsqrtf(ss2 * (1.f / 1024.f) + 1e-6f);
#pragma unroll
    for (int i = 0; i < 4; ++i) {
      const int col = i * 256 + lane * 4;
      *(float4*)(p.x1 + (long)row * 1024 + col) = make_float4(xv[i * 4], xv[i * 4 + 1], xv[i * 4 + 2], xv[i * 4 + 3]);
      float hv[4];
#pragma unroll
      for (int j = 0; j < 4; ++j) hv[j] = xv[i * 4 + j] * r2 * p.g_pre_ffn[col + j] * (1.f + modb[4096 + col + j]) + modb[3072 + col + j];
      uint2 w;
      w.x = pack2(hv[0], hv[1]);
      w.y = pack2(hv[2], hv[3]);
      *(uint2*)(p.h + (long)row * 1024 + col) = w;
    }
  }
}

struct EpiStoreF32 {
  float* dst; long ld; int m0, n0;
  DI void operator()(f32x16 (&acc)[2][2], int wm, int wn, int lane) const {
    constexpr int MT = 2;
    SW_FOR { *(float4*)(dst + (long)(m0 + SW_R) * ld + n0 + SW_C0) = make_float4(SW_V(0), SW_V(1), SW_V(2), SW_V(3)); }
  }
};
DI void phase11(const Params& p, char* smem, int bid, int nblk) {
  for (int item = bid; item < 256; item += nblk) {
    const int nt_ = item & 1, mt_ = item >> 1;
    ARows af{p.h + (long)mt_ * 128 * 1024, 1024, 128};
    BMatT bf{p.routerT + (long)nt_ * 128 * 1024, 1024};
    EpiStoreF32 ef{p.logits, 256, mt_ * 128, nt_ * 128};
    gemm_tile<true, false, true>(smem, 16, 64, af, bf, ef);
  }
}
DI void phase12(const Params& p, int bid, int nblk) {
  const int tid = TIDX(), lane = tid & 63, wid = __builtin_amdgcn_readfirstlane(tid >> 6);
  for (int tok = bid * 4 + wid; tok < NTOK; tok += nblk * 4) {
    const float4 lg = *(const float4*)(p.logits + (long)tok * 256 + lane * 4);
    const float4 rbv = *(const float4*)(p.router_bias + lane * 4);
    float sg[4] = {sigmoidf(lg.x), sigmoidf(lg.y), sigmoidf(lg.z), sigmoidf(lg.w)};
    float sl[4] = {sg[0] + rbv.x, sg[1] + rbv.y, sg[2] + rbv.z, sg[3] + rbv.w};
    float t1 = fmaxf(sl[0], sl[1]), t2 = fminf(sl[0], sl[1]);
#pragma unroll
    for (int j = 2; j < 4; ++j) {
      const float v = sl[j];
      t2 = fmaxf(t2, fminf(t1, v));
      t1 = fmaxf(t1, v);
    }
#define R_MERGE(CTRL)                                                                                                            \
    {                                                                                                                            \
      const float a1 = __int_as_float(__builtin_amdgcn_update_dpp(0, __float_as_int(t1), CTRL, 0xF, 0xF, true));                 \
      const float a2 = __int_as_float(__builtin_amdgcn_update_dpp(0, __float_as_int(t2), CTRL, 0xF, 0xF, true));                 \
      const float n1 = fmaxf(t1, a1);                                                                                            \
      const float n2 = fmaxf(fminf(t1, a1), fmaxf(t2, a2));                                                                      \
      t1 = n1; t2 = n2;                                                                                                          \
    }
    R_MERGE(DPP_QP1) R_MERGE(DPP_QP2) R_MERGE(DPP_RHM)
#undef R_MERGE
    const float gscore = t1 + t2;
    const int grp = lane >> 3;
    int rank = 0;
#pragma unroll
    for (int g2 = 0; g2 < 8; ++g2) {
      const float og = rdlane(gscore, g2 * 8);
      rank += (og > gscore || (og == gscore && g2 < grp)) ? 1 : 0;
    }
    const bool gsel = rank < 4;
    float cv[4];
#pragma unroll
    for (int j = 0; j < 4; ++j) cv[j] = gsel ? sl[j] : -1e30f;
    int my_e = -1; float my_s = 0.f; float ssum = 0.f;
    for (int r = 0; r < 8; ++r) {
      float bv = cv[0]; int bj = 0;
#pragma unroll
      for (int j = 1; j < 4; ++j) if (cv[j] > bv) { bv = cv[j]; bj = j; }
      int be = lane * 4 + bj;
      wave_argmax(bv, be);
      const int wl_ = be >> 2, wj = be & 3;
      const float s0 = rdlane(sg[0], wl_), s1 = rdlane(sg[1], wl_), s2 = rdlane(sg[2], wl_), s3 = rdlane(sg[3], wl_);
      const float bs = wj == 0 ? s0 : (wj == 1 ? s1 : (wj == 2 ? s2 : s3));
      if (wl_ == lane) {
        if (wj == 0) cv[0] = -3e30f; else if (wj == 1) cv[1] = -3e30f; else if (wj == 2) cv[2] = -3e30f; else cv[3] = -3e30f;
      }
      if (lane == r) { my_e = be; my_s = bs; }
      ssum += bs;
    }
    if (lane < 8) {
      const float w = my_s / ssum * 2.5f;
      const int rk = atomicAdd(p.counts + my_e, 1);
      p.eidx[tok * 8 + lane] = my_e;
      p.ewt[tok * 8 + lane] = w;
      p.erank[tok * 8 + lane] = rk;
    }
  }
}
DI void phase14(const Params& p, char* smem, int bid, int nblk) {
  const int tid = TIDX();
  int* s_cnt = (int*)smem;
  int* s_off = s_cnt + 256;
  const int cnt = p.counts[tid];
  s_cnt[tid] = cnt;
  __syncthreads();
  int run = 0, nt = 0, nt2 = 0;
  for (int e = 0; e < tid; ++e) { const int c = s_cnt[e]; run += c; nt += (c + 127) >> 7; nt2 += (c + 255) >> 8; }
  s_off[tid] = run;
  __syncthreads();
  if (bid == 0) {
    p.offs[tid] = run;
    for (int m = 0; m * 256 < cnt; ++m) {
      p.tile2_e[nt2] = tid;
      p.tile2_r0[nt2] = run + m * 256;
      p.tile2_nr[nt2] = (cnt - m * 256) > 256 ? 256 : (cnt - m * 256);
      ++nt2;
    }
    for (int m = 0; m * 128 < cnt; ++m) {
      p.tile_e[nt] = tid;
      p.tile_r0[nt] = run + m * 128;
      p.tile_nr[nt] = (cnt - m * 128) > 128 ? 128 : (cnt - m * 128);
      ++nt;
    }
    if (tid == 255) {
      p.offs[256] = run + cnt;
      for (int m = 0; m < 128; ++m) {
        p.tile_e[nt] = 256;
        p.tile_r0[nt] = 131072 + m * 128;
        p.tile_nr[nt] = 128;
        ++nt;
      }
      p.ntiles[0] = nt;
      for (int m = 0; m < 64; ++m) {
        p.tile2_e[nt2] = 256;
        p.tile2_r0[nt2] = 131072 + m * 256;
        p.tile2_nr[nt2] = 256;
        ++nt2;
      }
      p.ntiles[1] = nt2;
    }
  }
  for (int i = bid * 256 + tid; i < NSLOT; i += nblk * 256) {
    if (i < 131072) {
      const int e = p.eidx[i];
      const int slot = s_off[e] + p.erank[i];
      p.slot_tok[slot] = i >> 3;
      p.slot_wt[slot] = p.ewt[i];
      p.tok_slot[i] = slot;
    } else {
      p.slot_tok[i] = i - 131072;
      p.slot_wt[i] = 1.f;
    }
  }
}

struct AGather {
  const u16* h; const int* slot_tok; int r0, nr;
  DI const u16* operator()(int r) const { return h + (long)slot_tok[r0 + (r < nr ? r : 0)] * 1024; }
};
struct BGateUp {
  const float* wg; long udiff; long ldb; int n0;
  DI const float* operator()(int c4) const {
    const int wn = c4 >> 6, ntl = (c4 >> 5) & 1, j = c4 & 31;
    return wg + (long)ntl * udiff + n0 + wn * 32 + j;
  }
  DI const u16* row(int) const { return nullptr; }
};
struct EpiH {
  u16* H; int r0, nr, n0;
  template <int MT> DI void operator()(f32x16 (&acc)[MT][2], int wm, int wn, int lane) const {
#pragma unroll
    for (int mt = 0; mt < MT; ++mt) {
      const int r = SW_R;
      if (r < nr) {
#pragma unroll
        for (int q4 = 0; q4 < 4; ++q4) {
          float v[4];
#pragma unroll
          for (int j = 0; j < 4; ++j) v[j] = siluf(acc[mt][0][4 * q4 + j]) * acc[mt][1][4 * q4 + j];
          *(uint2*)(H + (long)(r0 + r) * 256 + n0 + wn * 32 + 8 * q4 + 4 * (lane >> 5)) = pack4(v[0], v[1], v[2], v[3]);
        }
      }
    }
  }
};
DI void phase15(const Params& p, char* smem, int bid, int nblk) {
  const int ntl = p.ntiles[1];
  for (int item = bid; item < ntl * 4; item += nblk) {
    const int ti = item >> 2, nt_ = item & 3;
    const int e = p.tile2_e[ti], r0 = p.tile2_r0[ti], nr = p.tile2_nr[ti];
    AGather af{p.h, p.slot_tok, r0, nr};
    const float* wg = e < 256 ? p.w_eg + (long)e * 1024 * 256 : p.w_sg;
    const float* wu = e < 256 ? p.w_eu + (long)e * 1024 * 256 : p.w_su;
    BGateUp bf{wg, (long)(wu - wg), 256, nt_ * 64};
    EpiH ef{p.H, r0, nr, nt_ * 64};
    gemm_tile256<false>(smem, 16, af, bf, ef);
  }
}
struct EpiYexp {
  u16* Y; const float* slot_wt; int r0, nr, n0;
  template <int MT> DI void operator()(f32x16 (&acc)[MT][2], int wm, int wn, int lane) const {
#pragma unroll
    for (int mt = 0; mt < MT; ++mt) {
      const int r = SW_R;
      if (r < nr) {
        const float w = slot_wt[r0 + r];
#pragma unroll
        for (int nt = 0; nt < 2; ++nt)
#pragma unroll
          for (int q4 = 0; q4 < 4; ++q4)
            *(uint2*)(Y + (long)(r0 + r) * 1024 + n0 + SW_C0) = pack4(SW_V(0) * w, SW_V(1) * w, SW_V(2) * w, SW_V(3) * w);
      }
    }
  }
};
DI void phase16(const Params& p, char* smem, int bid, int nblk) {
  const int ntl = p.ntiles[1];
  for (int item = bid; item < ntl * 8; item += nblk) {
    const int ti = item >> 3, nt_ = item & 7;
    const int e = p.tile2_e[ti], r0 = p.tile2_r0[ti], nr = p.tile2_nr[ti];
    ARows af{p.H + (long)r0 * 256, 256, nr};
    const float* wd = e < 256 ? p.w_ed + (long)e * 256 * 1024 : p.w_sd;
    BMat bf{wd + nt_ * 128, 1024, 128};
    EpiYexp ef{p.Y, p.slot_wt, r0, nr, nt_ * 128};
    gemm_tile256<false>(smem, 4, af, bf, ef);
  }
}
DI void phase17(const Params& p, int bid, int nblk) {
  const int tid = TIDX(), lane = tid & 63, wid = __builtin_amdgcn_readfirstlane(tid >> 6);
  for (int row = bid * 4 + wid; row < NTOK; row += nblk * 4) {
    const int b = row >> 13;
    const float* modb = p.mod + b * 6144;
    int slots[9];
#pragma unroll
    for (int k = 0; k < 8; ++k) slots[k] = p.tok_slot[row * 8 + k];
    slots[8] = 131072 + row;
    float yv[16];
#pragma unroll
    for (int j = 0; j < 16; ++j) yv[j] = 0.f;
#pragma unroll
    for (int k = 0; k < 9; ++k) {
#pragma unroll
      for (int i = 0; i < 4; ++i) {
        const uint2 u = *(const uint2*)(p.Y + (long)slots[k] * 1024 + i * 256 + lane * 4);
        yv[i * 4 + 0] += lo16(u.x); yv[i * 4 + 1] += hi16(u.x); yv[i * 4 + 2] += lo16(u.y); yv[i * 4 + 3] += hi16(u.y);
      }
    }
    float ss = 0.f;
#pragma unroll
    for (int j = 0; j < 16; ++j) ss += yv[j] * yv[j];
    ss = wave_sum(ss);
    const float r = rsqrtf(ss * (1.f / 1024.f) + 1e-6f);
#pragma unroll
    for (int i = 0; i < 4; ++i) {
      const int col = i * 256 + lane * 4;
      const float4 xx = *(const float4*)(p.x1 + (long)row * 1024 + col);
      float o[4] = {xx.x, xx.y, xx.z, xx.w};
#pragma unroll
      for (int j = 0; j < 4; ++j) o[j] += modb[5120 + col + j] * (yv[i * 4 + j] * r * p.g_post_ffn[col + j]);
      *(float4*)(p.out + (long)row * 1024 + col) = make_float4(o[0], o[1], o[2], o[3]);
    }
  }
}

__global__ void __launch_bounds__(256, 2) mega(Params p) {
  cg::grid_group grid = cg::this_grid();
  __shared__ __attribute__((aligned(16))) char smem[LDS_BYTES];
  const int bid = blockIdx.x, nblk = gridDim.x;
  if (p.phase_hi == 12345) grid.sync();
  if (threadIdx.x < 4) ((unsigned*)(smem + 73728))[threadIdx.x] = 0u;
  __syncthreads();
  const XcdBarrier xb = xcd_barrier_post(p.bar, (volatile LAS unsigned*)(smem + 73728));
#if !defined(ONLY) || ONLY==0
  if (p.phase_lo <= 0 && 0 < p.phase_hi) {
    phase0(p, smem, bid, nblk);
#if (REPEAT_MASK >> 0) & 1
    xcd_barrier(xb);
    phase0(p, smem, bid, nblk);
#endif
    if (0 + 1 < p.phase_hi) xcd_barrier(xb);
  }
#endif
#if !defined(ONLY) || ONLY==1
  if (p.phase_lo <= 1 && 1 < p.phase_hi) {
    phase1(p, smem, bid, nblk);
#if (REPEAT_MASK >> 1) & 1
    xcd_barrier(xb);
    phase1(p, smem, bid, nblk);
#endif
    if (1 + 1 < p.phase_hi) xcd_barrier(xb);
  }
#endif
#if !defined(ONLY) || ONLY==2
  if (p.phase_lo <= 2 && 2 < p.phase_hi) {
    phase2(p, smem, bid, nblk);
#if (REPEAT_MASK >> 2) & 1
    xcd_barrier(xb);
    phase2(p, smem, bid, nblk);
#endif
    if (2 + 1 < p.phase_hi) xcd_barrier(xb);
  }
#endif
#if !defined(ONLY) || ONLY==3
  if (p.phase_lo <= 3 && 3 < p.phase_hi) {
    phase3(p, smem, bid, nblk);
#if (REPEAT_MASK >> 3) & 1
    xcd_barrier(xb);
    phase3(p, smem, bid, nblk);
#endif
    if (3 + 1 < p.phase_hi) xcd_barrier(xb);
  }
#endif
#if !defined(ONLY) || ONLY==4
  if (p.phase_lo <= 4 && 4 < p.phase_hi) {
    phase4(p, smem, bid, nblk);
#if (REPEAT_MASK >> 4) & 1
    xcd_barrier(xb);
    phase4(p, smem, bid, nblk);
#endif
    if (4 + 1 < p.phase_hi) xcd_barrier(xb);
  }
#endif
#if !defined(ONLY) || ONLY==5
  if (p.phase_lo <= 5 && 5 < p.phase_hi) {
    phase5(p, smem, bid, nblk);
#if (REPEAT_MASK >> 5) & 1
    xcd_barrier(xb);
    phase5(p, smem, bid, nblk);
#endif
    if (5 + 1 < p.phase_hi) xcd_barrier(xb);
  }
#endif
#if !defined(ONLY) || ONLY==7
  if (p.phase_lo <= 7 && 7 < p.phase_hi) {
    phase7(p, smem, bid, nblk);
#if (REPEAT_MASK >> 7) & 1
    xcd_barrier(xb);
    phase7(p, smem, bid, nblk);
#endif
    if (7 + 1 < p.phase_hi) xcd_barrier(xb);
  }
#endif
#if !defined(ONLY) || ONLY==8
  if (p.phase_lo <= 8 && 8 < p.phase_hi) {
    phase8(p, smem, bid, nblk);
#if (REPEAT_MASK >> 8) & 1
    xcd_barrier(xb);
    phase8(p, smem, bid, nblk);
#endif
    if (8 + 1 < p.phase_hi) xcd_barrier(xb);
  }
#endif
#if !defined(ONLY) || ONLY==9
  if (p.phase_lo <= 9 && 9 < p.phase_hi) {
    phase9(p, smem, bid, nblk);
#if (REPEAT_MASK >> 9) & 1
    xcd_barrier(xb);
    phase9(p, smem, bid, nblk);
#endif
    if (9 + 1 < p.phase_hi) xcd_barrier(xb);
  }
#endif
#if !defined(ONLY) || ONLY==10
  if (p.phase_lo <= 10 && 10 < p.phase_hi) {
    phase10(p, bid, nblk);
#if (REPEAT_MASK >> 10) & 1
    xcd_barrier(xb);
    phase10(p, bid, nblk);
#endif
    if (10 + 1 < p.phase_hi) xcd_barrier(xb);
  }
#endif
#if !defined(ONLY) || ONLY==11
  if (p.phase_lo <= 11 && 11 < p.phase_hi) {
    phase11(p, smem, bid, nblk);
#if (REPEAT_MASK >> 11) & 1
    xcd_barrier(xb);
    phase11(p, smem, bid, nblk);
#endif
    if (11 + 1 < p.phase_hi) xcd_barrier(xb);
  }
#endif
#if !defined(ONLY) || ONLY==12
  if (p.phase_lo <= 12 && 12 < p.phase_hi) {
    phase12(p, bid, nblk);
#if (REPEAT_MASK >> 12) & 1
    xcd_barrier(xb);
    phase12(p, bid, nblk);
#endif
    if (12 + 1 < p.phase_hi) xcd_barrier(xb);
  }
#endif
#if !defined(ONLY) || ONLY==14
  if (p.phase_lo <= 14 && 14 < p.phase_hi) {
    phase14(p, smem, bid, nblk);
#if (REPEAT_MASK >> 14) & 1
    xcd_barrier(xb);
    phase14(p, smem, bid, nblk);
#endif
    if (14 + 1 < p.phase_hi) xcd_barrier(xb);
  }
#endif
#if !defined(ONLY) || ONLY==15
  if (p.phase_lo <= 15 && 15 < p.phase_hi) {
    phase15(p, smem, bid, nblk);
#if (REPEAT_MASK >> 15) & 1
    xcd_barrier(xb);
    phase15(p, smem, bid, nblk);
#endif
    if (15 + 1 < p.phase_hi) xcd_barrier(xb);
  }
#endif
#if !defined(ONLY) || ONLY==16
  if (p.phase_lo <= 16 && 16 < p.phase_hi) {
    phase16(p, smem, bid, nblk);
#if (REPEAT_MASK >> 16) & 1
    xcd_barrier(xb);
    phase16(p, smem, bid, nblk);
#endif
    if (16 + 1 < p.phase_hi) xcd_barrier(xb);
  }
#endif
#if !defined(ONLY) || ONLY==17
  if (p.phase_lo <= 17 && 17 < p.phase_hi) {
    phase17(p, bid, nblk);
#if (REPEAT_MASK >> 17) & 1
    xcd_barrier(xb);
    phase17(p, bid, nblk);
#endif
    if (17 + 1 < p.phase_hi) xcd_barrier(xb);
  }
#endif
}

extern "C" void kernel_launch(void* const* d_in, const int* in_sizes, int n_in, void* d_out, int out_size, void* d_ws, size_t ws_size,
                              hipStream_t stream) {
  static int grid_blocks = 0;
  if (!grid_blocks) {
    int dev = 0, cus = 0, per_cu = 0;
    (void)hipGetDevice(&dev);
    (void)hipDeviceGetAttribute(&cus, hipDeviceAttributeMultiprocessorCount, dev);
    (void)hipOccupancyMaxActiveBlocksPerMultiprocessor(&per_cu, mega, 256, 0);
    if (per_cu > 2) per_cu = 2;
    if (per_cu < 1) per_cu = 1;
    grid_blocks = cus * per_cu;
  }
  Params p{};
  const float* const* in = (const float* const*)d_in;
  p.x = in[0]; p.c = in[1]; p.w_ada = in[2]; p.b_ada = in[3]; p.g_pre_mix = in[4]; p.g_post_mix = in[5]; p.g_pre_ffn = in[6]; p.g_post_ffn = in[7];
  p.w_in = in[8]; p.rel_bias = in[9]; p.cmp_pe = in[10]; p.cmp_w1 = in[11]; p.cmp_b1 = in[12]; p.cmp_w2 = in[13]; p.dsa_kv_norm = in[14];
  p.dsa_w_uk = in[15]; p.dsa_w_uv = in[16]; p.w_bn = in[17]; p.w_bd = in[18]; p.w_out = in[19]; p.router_w = in[20]; p.router_bias = in[21];
  p.w_eg = in[22]; p.w_eu = in[23]; p.w_ed = in[24]; p.w_sg = in[25]; p.w_su = in[26]; p.w_sd = in[27];
  p.out = (float*)d_out;
  char* ws = (char*)d_ws;
  size_t off = 0;
  auto alloc = [&](size_t bytes) { char* r = ws + off; off += (bytes + 255) & ~(size_t)255; return r; };
  p.bar = (unsigned*)alloc(XCD_BAR_WORDS * 4);
  p.modp = (float*)alloc(16 * 2 * 6144 * 4);
  p.mod = (float*)alloc(2 * 6144 * 4);
  p.pe_part = (float*)alloc(16 * 256 * 4);
  p.w_ukT = (float*)alloc(8 * 64 * 128 * 4);
  p.w_inT = (u16*)alloc((size_t)4608 * 1024 * 2);
  p.w_bnT = (u16*)alloc((size_t)1024 * 512 * 2);
  p.w_bdT = (u16*)alloc((size_t)1024 * 512 * 2);
  p.w_outT = (u16*)alloc((size_t)1024 * 1024 * 2);
  p.routerT = (u16*)alloc((size_t)256 * 1024 * 2);
  p.counts = (int*)alloc(256 * 4);
  p.offs = (int*)alloc(257 * 4);
  p.tile_e = (int*)alloc(1536 * 4);
  p.tile_r0 = (int*)alloc(1536 * 4);
  p.tile_nr = (int*)alloc(1536 * 4);
  p.ntiles = (int*)alloc(8);
  p.tile2_e = (int*)alloc(1024 * 4);
  p.tile2_r0 = (int*)alloc(1024 * 4);
  p.tile2_nr = (int*)alloc(1024 * 4);
  p.h = (u16*)alloc((size_t)NTOK * 1024 * 2);
  p.proj = (u16*)alloc((size_t)NTOK * LDP * 2);
  p.widx = (float*)alloc((size_t)NTOK * 8 * 4);
  p.zc = (u16*)alloc((size_t)2 * 2048 * 128 * 2);
  p.kc = (u16*)alloc((size_t)4 * 512 * 64 * 2);
  p.vcT = (u16*)alloc((size_t)4 * 512 * 64 * 2);
  p.vts = (u16*)alloc((size_t)4 * 64 * T * 2);
  p.vtw = (u16*)alloc((size_t)4 * 64 * T * 2);
  p.qlat = (u16*)alloc((size_t)NTOK * 1024 * 2);
  p.ckv = (u16*)alloc((size_t)NTOK * 128 * 2);
  p.selk = (int*)alloc((size_t)NTOK * 256 * 4);
  p.onsa = (u16*)alloc((size_t)NTOK * 512 * 2);
  p.olat = (u16*)alloc((size_t)NTOK * 1024 * 2);
  p.odsa = (u16*)alloc((size_t)NTOK * 512 * 2);
  p.y = p.qlat;
  p.z = p.olat;
  p.eidx = (int*)alloc((size_t)NTOK * 8 * 4);
  p.ewt = (float*)alloc((size_t)NTOK * 8 * 4);
  p.erank = (int*)alloc((size_t)NTOK * 8 * 4);
  p.slot_tok = (int*)alloc((size_t)NSLOT * 4);
  p.slot_wt = (float*)alloc((size_t)NSLOT * 4);
  p.tok_slot = (int*)alloc((size_t)NTOK * 8 * 4);
  char* big = alloc((size_t)2 * T * T * 4);
  p.scores = (float*)big;
  {
    size_t o2 = 0;
    auto sub = [&](size_t bytes) { char* r = big + o2; o2 += (bytes + 255) & ~(size_t)255; return r; };
    p.H = (u16*)sub((size_t)NSLOT * 256 * 2);
    p.Y = (u16*)sub((size_t)NSLOT * 1024 * 2);
    p.x1 = (float*)sub((size_t)NTOK * 1024 * 4);
    p.logits = (float*)sub((size_t)NTOK * 256 * 4);
  }
  if (off > ws_size) fprintf(stderr, "workspace too small: need %zu have %zu\n", off, ws_size);
  p.phase_lo = 0;
  p.phase_hi = 18;
  (void)hipMemsetAsync(p.bar, 0, XCD_BAR_WORDS * 4, stream);
  void* args[] = {&p};
  hipError_t e = hipLaunchCooperativeKernel((void*)mega, dim3(grid_blocks), dim3(256), args, 0, stream);
  if (e != hipSuccess) fprintf(stderr, "coop launch failed: %s (grid %d)\n", hipGetErrorString(e), grid_blocks);
}
```

```cpp
#include <hip/hip_runtime.h>
#include <hip/hip_cooperative_groups.h>
#include <cstdio>
namespace cg = cooperative_groups;

#define DI __device__ __forceinline__
typedef unsigned short u16;
typedef unsigned long long u64;
using bf16x8 = __attribute__((ext_vector_type(8))) short;
using f32x16 = __attribute__((ext_vector_type(16))) float;

constexpr int T = 8192;
constexpr int NTOK = 16384;
constexpr int LDP = 4576;
constexpr int C_QN = 0, C_KV = 512, C_GN = 1280, C_QD = 1304, C_CKV = 1816, C_QI = 1944, C_KI = 2456, C_WI = 2520, C_GM = 2528;
constexpr int NSLOT = 131072 + 16384;
constexpr int LDS_BYTES = 73728 + 64;
#ifndef REPEAT_MASK
#define REPEAT_MASK 0
#endif

__device__ const unsigned char BUCKET[128] = {
  0, 1, 2, 3, 4, 5, 6, 7, 8, 9, 10, 11, 12, 13, 14, 15, 16, 16, 16, 17, 17, 18, 18, 18, 19, 19, 19, 20, 20, 20, 20, 21,
  21, 21, 21, 22, 22, 22, 22, 22, 23, 23, 23, 23, 23, 23, 24, 24, 24, 24, 24, 24, 25, 25, 25, 25, 25, 25, 25, 26, 26, 26, 26, 26,
  26, 26, 26, 27, 27, 27, 27, 27, 27, 27, 27, 27, 27, 28, 28, 28, 28, 28, 28, 28, 28, 28, 28, 29, 29, 29, 29, 29, 29, 29, 29, 29,
  29, 29, 29, 30, 30, 30, 30, 30, 30, 30, 30, 30, 30, 30, 30, 30, 30, 31, 31, 31, 31, 31, 31, 31, 31, 31, 31, 31, 31, 31, 31, 31};

struct Params {
  const float *x, *c, *w_ada, *b_ada, *g_pre_mix, *g_post_mix, *g_pre_ffn, *g_post_ffn, *w_in, *rel_bias;
  const float *cmp_pe, *cmp_w1, *cmp_b1, *cmp_w2, *dsa_kv_norm, *dsa_w_uk, *dsa_w_uv, *w_bn, *w_bd, *w_out;
  const float *router_w, *router_bias, *w_eg, *w_eu, *w_ed, *w_sg, *w_su, *w_sd;
  float* out;
  float* modp;
  float* mod;
  float* pe_part;
  float* w_ukT;
  u16 *w_inT, *w_bnT, *w_bdT, *w_outT, *routerT;
  u16* h;
  u16* proj;
  float* widx;
  u16* zc;
  u16* kc;
  u16* vcT;
  u16* vts;
  u16* vtw;
  u16* qlat;
  u16* ckv;
  float* scores;
  int* selk;
  u16* onsa;
  u16* olat;
  u16* odsa;
  u16* y;
  u16* z;
  float* x1;
  float* logits;
  int* eidx;
  float* ewt;
  int* erank;
  int* counts;
  int* offs;
  int* tile_e;
  int* tile_r0;
  int* tile_nr;
  int* ntiles;
  int *tile2_e, *tile2_r0, *tile2_nr;
  int* slot_tok;
  float* slot_wt;
  int* tok_slot;
  u16* H;
  u16* Y;
  unsigned* bar;
  int phase_lo, phase_hi;
};

DI float bf2f(u16 v) { return __uint_as_float(((unsigned)v) << 16); }
typedef __bf16 bf16x2_t __attribute__((ext_vector_type(2)));
typedef float f32x2_t __attribute__((ext_vector_type(2)));
DI unsigned pack2(float a, float b) { f32x2_t v = {a, b}; return __builtin_bit_cast(unsigned, __builtin_convertvector(v, bf16x2_t)); }
DI u16 f2bf(float x) { return (u16)(pack2(x, x) & 0xffffu); }
DI float lo16(unsigned u) { return __uint_as_float(u << 16); }
DI float hi16(unsigned u) { return __uint_as_float(u & 0xffff0000u); }
DI float wave_sum(float v) { for (int o = 32; o; o >>= 1) v += __shfl_xor(v, o); return v; }
DI float wave_max(float v) { for (int o = 32; o; o >>= 1) v = fmaxf(v, __shfl_xor(v, o)); return v; }
#define DPP_QP1 0xB1
#define DPP_QP2 0x4E
#define DPP_RHM 0x141
#define DPP_RM  0x140
#define DPP_B15 0x142
#define DPP_B31 0x143
DI int wave_sum_i(int x) {
  x += __builtin_amdgcn_update_dpp(0, x, DPP_QP1, 0xF, 0xF, true);
  x += __builtin_amdgcn_update_dpp(0, x, DPP_QP2, 0xF, 0xF, true);
  x += __builtin_amdgcn_update_dpp(0, x, DPP_RHM, 0xF, 0xF, true);
  x += __builtin_amdgcn_update_dpp(0, x, DPP_RM, 0xF, 0xF, true);
  x += __builtin_amdgcn_update_dpp(0, x, DPP_B15, 0xA, 0xF, true);
  x += __builtin_amdgcn_update_dpp(0, x, DPP_B31, 0xC, 0xF, true);
  return __builtin_amdgcn_readlane(x, 63);
}
#define DPP_SELF(x, CTRL, RM) ((unsigned)__builtin_amdgcn_update_dpp((int)(x), (int)(x), CTRL, RM, 0xF, false))
DI unsigned wave_max_u(unsigned x) {
  x = max(x, DPP_SELF(x, DPP_QP1, 0xF)); x = max(x, DPP_SELF(x, DPP_QP2, 0xF)); x = max(x, DPP_SELF(x, DPP_RHM, 0xF));
  x = max(x, DPP_SELF(x, DPP_RM, 0xF)); x = max(x, DPP_SELF(x, DPP_B15, 0xA)); x = max(x, DPP_SELF(x, DPP_B31, 0xC));
  return (unsigned)__builtin_amdgcn_readlane((int)x, 63);
}
DI unsigned wave_min_u(unsigned x) {
  x = min(x, DPP_SELF(x, DPP_QP1, 0xF)); x = min(x, DPP_SELF(x, DPP_QP2, 0xF)); x = min(x, DPP_SELF(x, DPP_RHM, 0xF));
  x = min(x, DPP_SELF(x, DPP_RM, 0xF)); x = min(x, DPP_SELF(x, DPP_B15, 0xA)); x = min(x, DPP_SELF(x, DPP_B31, 0xC));
  return (unsigned)__builtin_amdgcn_readlane((int)x, 63);
}
DI void wave_argmax(float& v, int& idx) {
#define AM_STEP(CTRL, RM)                                                                                                   \
  {                                                                                                                         \
    const float ov_ = __int_as_float(__builtin_amdgcn_update_dpp(__float_as_int(v), __float_as_int(v), CTRL, RM, 0xF, false)); \
    const int oi_ = __builtin_amdgcn_update_dpp(idx, idx, CTRL, RM, 0xF, false);                                            \
    const bool tk_ = ov_ > v || (ov_ == v && oi_ < idx);                                                                    \
    v = tk_ ? ov_ : v;                                                                                                      \
    idx = tk_ ? oi_ : idx;                                                                                                  \
  }
  AM_STEP(DPP_QP1, 0xF) AM_STEP(DPP_QP2, 0xF) AM_STEP(DPP_RHM, 0xF) AM_STEP(DPP_RM, 0xF) AM_STEP(DPP_B15, 0xA) AM_STEP(DPP_B31, 0xC)
#undef AM_STEP
  v = __int_as_float(__builtin_amdgcn_readlane(__float_as_int(v), 63));
  idx = __builtin_amdgcn_readlane(idx, 63);
}
DI float rdlane(float v, int l) { return __int_as_float(__builtin_amdgcn_readlane(__float_as_int(v), l)); }
DI int rdlane_i(int v, int l) { return __builtin_amdgcn_readlane(v, l); }
DI int TIDX() { int t = threadIdx.x; asm volatile("" : "+v"(t)); return t; }
DI void cbar(const void* p) { asm volatile("" ::"v"(p) : "memory"); }
DI void wave_sync() { asm volatile("s_waitcnt lgkmcnt(0)" ::: "memory"); __builtin_amdgcn_wave_barrier(); }
DI float sigmoidf(float x) { return 1.f / (1.f + __expf(-x)); }
DI float siluf(float x) { return x / (1.f + __expf(-x)); }
DI float gelu_tanh(float x) { float u = 0.7978845608028654f * (x + 0.044715f * x * x * x); float e = __expf(2.f * u); float th = 1.f - 2.f / (e + 1.f); return 0.5f * x * (1.f + th); }


#define XB_TMO      128
#define XB_XCNT(j)  (256  + 64 * (j))
#define XB_XSUB(j)  (1280 + 64 * (j))
#define XB_XGEN(j)  (2304 + 64 * (j))
#define XB_TOP      3328
#define XB_TOPGEN   3392
#define XCD_BAR_WORDS 3456
#define XB_SPIN_CAP (1u << 22)
#define LAS __attribute__((address_space(3)))
DI unsigned xb_ld(unsigned* p) { return __hip_atomic_load(p, __ATOMIC_RELAXED, __HIP_MEMORY_SCOPE_AGENT); }
DI unsigned xb_add(unsigned* p, unsigned v) { return __hip_atomic_fetch_add(p, v, __ATOMIC_RELAXED, __HIP_MEMORY_SCOPE_AGENT); }
DI unsigned xb_xcc_id() { return (unsigned)__builtin_amdgcn_s_getreg((3 << 11) | 20) & 0xFu; }
#define XB_SPIN(cond, bar) do { unsigned _sp = 0; while (cond) { __builtin_amdgcn_s_sleep(1); \
    if ((++_sp & 255u) == 0u) { if (xb_ld(&(bar)[XB_TMO])) break; if (_sp > XB_SPIN_CAP) { atomicAdd(&(bar)[XB_TMO], 1u); break; } } } } while (0)
struct XcdBarrier { unsigned* bar; unsigned x; volatile LAS unsigned* st; };
DI XcdBarrier xcd_barrier_post(unsigned* bar, volatile LAS unsigned* st) {
  XcdBarrier b; b.bar = bar; b.x = xb_xcc_id(); b.st = st;
  if (threadIdx.x == 0) (void)xb_add(&bar[XB_XCNT(b.x)], 1u);
  return b;
}
DI void xcd_barrier_complete(unsigned* bar, unsigned x, unsigned& nloc, unsigned& nx) {
  const unsigned G = gridDim.x * gridDim.y * gridDim.z;
  unsigned sum, cnt, mine, sp = 0u;
  for (;;) {
    sum = 0u; cnt = 0u; mine = 0u;
#pragma unroll
    for (unsigned j = 0; j < 16; ++j) { const unsigned c = xb_ld(&bar[XB_XCNT(j)]); sum += c; cnt += (c > 0u) ? 1u : 0u; mine = (j == x) ? c : mine; }
    if (sum == G) break;
    __builtin_amdgcn_s_sleep(1);
    if ((++sp & 255u) == 0u) { if (xb_ld(&bar[XB_TMO])) break; if (sp > XB_SPIN_CAP) { atomicAdd(&bar[XB_TMO], 1u); break; } }
  }
  nloc = mine > 0u ? mine : 1u; nx = cnt > 0u ? cnt : 1u;
}
DI void xcd_barrier(const XcdBarrier& b) {
  asm volatile("s_waitcnt vmcnt(0)" ::: "memory");
  __syncthreads();
  if (threadIdx.x == 0) {
    unsigned* bar = b.bar;
    __builtin_amdgcn_s_waitcnt(0);
    unsigned nloc = b.st[0], nx = b.st[1];
    if (nloc == 0u) { xcd_barrier_complete(bar, b.x, nloc, nx); b.st[0] = nloc; b.st[1] = nx; }
    const unsigned old = xb_add(&bar[XB_XSUB(b.x)], 1u);
    const unsigned gen = old / nloc;
    if (old + 1u == (gen + 1u) * nloc) {
      __builtin_amdgcn_fence(__ATOMIC_RELEASE, "agent");
      asm volatile("s_waitcnt vmcnt(0)" ::: "memory");
      const unsigned og = xb_add(&bar[XB_TOP], 1u);
      const unsigned tg = og / nx;
      if (og + 1u == (tg + 1u) * nx) xb_add(&bar[XB_TOPGEN], 1u);
      else XB_SPIN(xb_ld(&bar[XB_TOPGEN]) == tg, bar);
      __builtin_amdgcn_fence(__ATOMIC_ACQUIRE, "agent");
      xb_add(&bar[XB_XGEN(b.x)], 1u);
      asm volatile("s_waitcnt vmcnt(0)" ::: "memory");
    } else {
      XB_SPIN(xb_ld(&bar[XB_XGEN(b.x)]) == gen, bar);
      __builtin_amdgcn_fence(__ATOMIC_ACQUIRE, "agent");
      asm volatile("s_waitcnt vmcnt(0)" ::: "memory");
    }
  }
  __syncthreads();
}

template <bool SWAP = true, bool SINGLE = false, bool BT16 = false, class AF, class BF, class EF>
DI void gemm_tile(char* smem, int nk, long a_kstep, const AF& af, const BF& bf, const EF& ef) {
  asm volatile("" ::: "memory");
  u16* As = (u16*)smem;
  const int tid = TIDX(), lane = tid & 63, wid = __builtin_amdgcn_readfirstlane(tid >> 6), wm = wid >> 1, wn = wid & 1;
  const int arow = tid >> 1, ahalf = tid & 1;
  const u16* ap = af(arow) + ahalf * 32;
  const int bkq = lane & 7, bnq = wid * 8 + (lane >> 3);
  const long ldb = bf.ldb;
  const float* bp = nullptr;
  const u16* bp16 = nullptr;
  if constexpr (BT16) bp16 = bf.row(arow) + ahalf * 32;
  else bp = bf(bnq * 4) + (long)(bkq * 4) * ldb;
  uint4 sa0_0, sa0_1, sa0_2, sa0_3, sa1_0, sa1_1, sa1_2, sa1_3;
  float4 sb0_0, sb0_1, sb0_2, sb0_3, sb0_4, sb0_5, sb0_6, sb0_7, sb1_0, sb1_1, sb1_2, sb1_3, sb1_4, sb1_5, sb1_6, sb1_7;
  uint4 tb0_0, tb0_1, tb0_2, tb0_3, tb1_0, tb1_1, tb1_2, tb1_3;
  f32x16 acc[2][2];
#pragma unroll
  for (int a = 0; a < 2; ++a)
#pragma unroll
    for (int b = 0; b < 2; ++b)
#pragma unroll
      for (int i = 0; i < 16; ++i) acc[a][b][i] = 0.f;

#define GEMM_LOAD(S, KT)                                                                  \
  {                                                                                       \
    const uint4* pa_ = (const uint4*)(ap + (long)(KT) * a_kstep);                         \
    sa##S##_0 = pa_[0]; sa##S##_1 = pa_[1]; sa##S##_2 = pa_[2]; sa##S##_3 = pa_[3];       \
    if constexpr (BT16) {                                                                 \
      const uint4* pt_ = (const uint4*)(bp16 + (long)(KT) * 64);                          \
      tb##S##_0 = pt_[0]; tb##S##_1 = pt_[1]; tb##S##_2 = pt_[2]; tb##S##_3 = pt_[3];     \
    } else {                                                                              \
      const float* pb_ = bp + (long)(KT) * 64 * ldb;                                      \
      sb##S##_0 = *(const float4*)(pb_);                                                  \
      sb##S##_1 = *(const float4*)(pb_ + ldb);                                            \
      sb##S##_2 = *(const float4*)(pb_ + 2 * ldb);                                        \
      sb##S##_3 = *(const float4*)(pb_ + 3 * ldb);                                        \
      sb##S##_4 = *(const float4*)(pb_ + 32 * ldb);                                       \
      sb##S##_5 = *(const float4*)(pb_ + 33 * ldb);                                       \
      sb##S##_6 = *(const float4*)(pb_ + 34 * ldb);                                       \
      sb##S##_7 = *(const float4*)(pb_ + 35 * ldb);                                       \
    }                                                                                     \
  }
#define GEMM_BW(V0, V1, V2, V3, C, I, QOFF)                                               \
  {                                                                                       \
    uint2 w_;                                                                             \
    w_.x = pack2(V0.C, V1.C);                                                             \
    w_.y = pack2(V2.C, V3.C);                                                             \
    *(uint2*)&Bs_[(bnq * 4 + (I)) * 72 + (QOFF) + bkq * 4] = w_;                          \
  }
#define GEMM_STORE(S, BUF)                                                                \
  {                                                                                       \
    u16* As_ = As + (BUF) * (2 * 128 * 72);                                               \
    u16* Bs_ = As_ + 128 * 72;                                                            \
    uint4* da_ = (uint4*)&As_[arow * 72 + ahalf * 32];                                    \
    da_[0] = sa##S##_0; da_[1] = sa##S##_1; da_[2] = sa##S##_2; da_[3] = sa##S##_3;       \
    if constexpr (BT16) {                                                                 \
      uint4* db_ = (uint4*)&Bs_[arow * 72 + ahalf * 32];                                  \
      db_[0] = tb##S##_0; db_[1] = tb##S##_1; db_[2] = tb##S##_2; db_[3] = tb##S##_3;     \
    } else {                                                                              \
      GEMM_BW(sb##S##_0, sb##S##_1, sb##S##_2, sb##S##_3, x, 0, 0)                        \
      GEMM_BW(sb##S##_0, sb##S##_1, sb##S##_2, sb##S##_3, y, 1, 0)                        \
      GEMM_BW(sb##S##_0, sb##S##_1, sb##S##_2, sb##S##_3, z, 2, 0)                        \
      GEMM_BW(sb##S##_0, sb##S##_1, sb##S##_2, sb##S##_3, w, 3, 0)                        \
      GEMM_BW(sb##S##_4, sb##S##_5, sb##S##_6, sb##S##_7, x, 0, 32)                       \
      GEMM_BW(sb##S##_4, sb##S##_5, sb##S##_6, sb##S##_7, y, 1, 32)                       \
      GEMM_BW(sb##S##_4, sb##S##_5, sb##S##_6, sb##S##_7, z, 2, 32)                       \
      GEMM_BW(sb##S##_4, sb##S##_5, sb##S##_6, sb##S##_7, w, 3, 32)                       \
    }                                                                                     \
  }
#define GEMM_COMPUTE(BUF)                                                                 \
  {                                                                                       \
    const u16* Ac = As + (BUF) * (2 * 128 * 72);                                          \
    const u16* Bc = Ac + 128 * 72;                                                        \
    _Pragma("unroll") for (int ks = 0; ks < 4; ++ks) {                                    \
      bf16x8 a[2], b[2];                                                                  \
      _Pragma("unroll") for (int mt = 0; mt < 2; ++mt) a[mt] = *(const bf16x8*)&Ac[(wm * 64 + mt * 32 + (lane & 31)) * 72 + ks * 16 + (lane >> 5) * 8]; \
      _Pragma("unroll") for (int nt = 0; nt < 2; ++nt) b[nt] = *(const bf16x8*)&Bc[(wn * 64 + nt * 32 + (lane & 31)) * 72 + ks * 16 + (lane >> 5) * 8]; \
      _Pragma("unroll") for (int mt = 0; mt < 2; ++mt)                                    \
      _Pragma("unroll") for (int nt = 0; nt < 2; ++nt)                                    \
        acc[mt][nt] = SWAP ? __builtin_amdgcn_mfma_f32_32x32x16_bf16(b[nt], a[mt], acc[mt][nt], 0, 0, 0) \
                           : __builtin_amdgcn_mfma_f32_32x32x16_bf16(a[mt], b[nt], acc[mt][nt], 0, 0, 0); \
    }                                                                                     \
  }
  GEMM_LOAD(0, 0)
  __syncthreads();
  if (SINGLE) {
    GEMM_STORE(0, 0)
    __syncthreads();
    GEMM_COMPUTE(0)
  } else {
    GEMM_LOAD(1, 1)
    GEMM_STORE(0, 0)
    __syncthreads();
    const int last = nk - 1;
    for (int kt = 0; kt < nk; kt += 2) {
      const int k2 = kt + 2 < last ? kt + 2 : last, k3 = kt + 3 < last ? kt + 3 : last;
      GEMM_LOAD(0, k2)
      asm volatile("" ::: "memory");
      GEMM_COMPUTE(0)
      asm volatile("" ::: "memory");
      GEMM_STORE(1, 1)
      __syncthreads();
      GEMM_LOAD(1, k3)
      asm volatile("" ::: "memory");
      GEMM_COMPUTE(1)
      asm volatile("" ::: "memory");
      GEMM_STORE(0, 0)
      __syncthreads();
    }
  }
#undef GEMM_LOAD
#undef GEMM_STORE
#undef GEMM_BW
#undef GEMM_COMPUTE
  ef(acc, wm, wn, lane);
}

template <bool BT16, class AF, class BF, class EF>
DI void gemm_tile256(char* smem, int nk, const AF& af, const BF& bf, const EF& ef) {
  asm volatile("" ::: "memory");
  u16* As = (u16*)smem;
  u16* Bs = As + 256 * 72;
  const int tid = TIDX(), lane = tid & 63, wid = __builtin_amdgcn_readfirstlane(tid >> 6), wm = wid >> 1, wn = wid & 1;
  const int piece = tid & 7, rbase = tid >> 3;
  const u16* abase = af(0);
  int ao0, ao1, ao2, ao3, ao4, ao5, ao6, ao7;
  ao0 = (int)(af(rbase) - abase) + piece * 8;        ao1 = (int)(af(rbase + 32) - abase) + piece * 8;
  ao2 = (int)(af(rbase + 64) - abase) + piece * 8;   ao3 = (int)(af(rbase + 96) - abase) + piece * 8;
  ao4 = (int)(af(rbase + 128) - abase) + piece * 8;  ao5 = (int)(af(rbase + 160) - abase) + piece * 8;
  ao6 = (int)(af(rbase + 192) - abase) + piece * 8;  ao7 = (int)(af(rbase + 224) - abase) + piece * 8;
  const u16* bp16 = nullptr; long bstride = 0;
  const float* bp = nullptr; long ldb = 0;
  const int bkq = lane & 7, bnq = wid * 8 + (lane >> 3);
  if constexpr (BT16) { bp16 = bf.row(rbase) + piece * 8; bstride = bf.ldb * 32; }
  else { ldb = bf.ldb; bp = bf(bnq * 4) + (long)(bkq * 4) * ldb; }
  uint4 ra0, ra1, ra2, ra3, ra4, ra5, ra6, ra7, rb0, rb1, rb2, rb3;
  float4 fb0, fb1, fb2, fb3, fb4, fb5, fb6, fb7;
  f32x16 acc[4][2];
#pragma unroll
  for (int a = 0; a < 4; ++a)
#pragma unroll
    for (int b = 0; b < 2; ++b)
#pragma unroll
      for (int i = 0; i < 16; ++i) acc[a][b][i] = 0.f;
#define G256_LOAD(KT)                                                   \
  {                                                                     \
    const u16* pa_ = abase + (long)(KT) * 64;                           \
    ra0 = *(const uint4*)(pa_ + ao0); ra1 = *(const uint4*)(pa_ + ao1); \
    ra2 = *(const uint4*)(pa_ + ao2); ra3 = *(const uint4*)(pa_ + ao3); \
    ra4 = *(const uint4*)(pa_ + ao4); ra5 = *(const uint4*)(pa_ + ao5); \
    ra6 = *(const uint4*)(pa_ + ao6); ra7 = *(const uint4*)(pa_ + ao7); \
    if constexpr (BT16) {                                               \
      const u16* pb_ = bp16 + (long)(KT) * 64;                          \
      rb0 = *(const uint4*)(pb_);                                       \
      rb1 = *(const uint4*)(pb_ + bstride);                             \
      rb2 = *(const uint4*)(pb_ + 2 * bstride);                         \
      rb3 = *(const uint4*)(pb_ + 3 * bstride);                         \
    } else {                                                            \
      const float* pf_ = bp + (long)(KT) * 64 * ldb;                    \
      fb0 = *(const float4*)(pf_);            fb1 = *(const float4*)(pf_ + ldb);      \
      fb2 = *(const float4*)(pf_ + 2 * ldb);  fb3 = *(const float4*)(pf_ + 3 * ldb);  \
      fb4 = *(const float4*)(pf_ + 32 * ldb); fb5 = *(const float4*)(pf_ + 33 * ldb); \
      fb6 = *(const float4*)(pf_ + 34 * ldb); fb7 = *(const float4*)(pf_ + 35 * ldb); \
    }                                                                   \
  }
#define G256_BW(V0, V1, V2, V3, C, I, QOFF)                             \
  {                                                                     \
    uint2 w_;                                                           \
    w_.x = pack2(V0.C, V1.C);                                           \
    w_.y = pack2(V2.C, V3.C);                                           \
    *(uint2*)&Bs[(bnq * 4 + (I)) * 72 + (QOFF) + bkq * 4] = w_;         \
  }
  G256_LOAD(0)
  const int last = nk - 1;
  for (int kt = 0; kt < nk; ++kt) {
    __syncthreads();
    {
      u16* da = As + rbase * 72 + piece * 8;
      *(uint4*)(da) = ra0;            *(uint4*)(da + 32 * 72) = ra1;  *(uint4*)(da + 64 * 72) = ra2;  *(uint4*)(da + 96 * 72) = ra3;
      *(uint4*)(da + 128 * 72) = ra4; *(uint4*)(da + 160 * 72) = ra5; *(uint4*)(da + 192 * 72) = ra6; *(uint4*)(da + 224 * 72) = ra7;
      if constexpr (BT16) {
        u16* db = Bs + rbase * 72 + piece * 8;
        *(uint4*)(db) = rb0; *(uint4*)(db + 32 * 72) = rb1; *(uint4*)(db + 64 * 72) = rb2; *(uint4*)(db + 96 * 72) = rb3;
      } else {
        G256_BW(fb0, fb1, fb2, fb3, x, 0, 0)  G256_BW(fb0, fb1, fb2, fb3, y, 1, 0)
        G256_BW(fb0, fb1, fb2, fb3, z, 2, 0)  G256_BW(fb0, fb1, fb2, fb3, w, 3, 0)
        G256_BW(fb4, fb5, fb6, fb7, x, 0, 32) G256_BW(fb4, fb5, fb6, fb7, y, 1, 32)
        G256_BW(fb4, fb5, fb6, fb7, z, 2, 32) G256_BW(fb4, fb5, fb6, fb7, w, 3, 32)
      }
    }
    __syncthreads();
    const int kn = kt + 1 < last ? kt + 1 : last;
    G256_LOAD(kn)
    asm volatile("" ::: "memory");
#pragma unroll
    for (int ks = 0; ks < 4; ++ks) {
      bf16x8 a[4], b[2];
#pragma unroll
      for (int mt = 0; mt < 4; ++mt) a[mt] = *(const bf16x8*)&As[(wm * 128 + mt * 32 + (lane & 31)) * 72 + ks * 16 + (lane >> 5) * 8];
#pragma unroll
      for (int nt = 0; nt < 2; ++nt) b[nt] = *(const bf16x8*)&Bs[(wn * 64 + nt * 32 + (lane & 31)) * 72 + ks * 16 + (lane >> 5) * 8];
#pragma unroll
      for (int mt = 0; mt < 4; ++mt)
#pragma unroll
        for (int nt = 0; nt < 2; ++nt) acc[mt][nt] = __builtin_amdgcn_mfma_f32_32x32x16_bf16(b[nt], a[mt], acc[mt][nt], 0, 0, 0);
    }
    asm volatile("" ::: "memory");
  }
#undef G256_LOAD
#undef G256_BW
  ef(acc, wm, wn, lane);
}

#define EPI_FOR                                                   \
  _Pragma("unroll") for (int mt = 0; mt < 2; ++mt)                \
  _Pragma("unroll") for (int nt = 0; nt < 2; ++nt)                \
  _Pragma("unroll") for (int i = 0; i < 16; ++i)
#define EPI_R (wm * 64 + mt * 32 + (i & 3) + 8 * (i >> 2) + 4 * (lane >> 5))
#define EPI_C (wn * 64 + nt * 32 + (lane & 31))
#define SW_FOR                                                    \
  _Pragma("unroll") for (int mt = 0; mt < MT; ++mt)               \
  _Pragma("unroll") for (int nt = 0; nt < 2; ++nt)                \
  _Pragma("unroll") for (int q4 = 0; q4 < 4; ++q4)
#define SW_R (wm * (32 * MT) + mt * 32 + (lane & 31))
#define SW_C0 (wn * 64 + nt * 32 + 8 * q4 + 4 * (lane >> 5))
#define SW_V(j) acc[mt][nt][4 * q4 + (j)]
DI uint2 pack4(float a, float b, float c, float d) { uint2 w; w.x = pack2(a, b); w.y = pack2(c, d); return w; }

struct ARows { const u16* base; long ld; int nrows; DI const u16* operator()(int r) const { return base + (long)(r < nrows ? r : 0) * ld; } };
struct BMat { const float* base; long ldb; int ncols; DI const float* operator()(int c4) const { return base + (c4 < ncols ? c4 : 0); } DI const u16* row(int) const { return nullptr; } };
struct BMatT { const u16* base; long ldb; DI const float* operator()(int) const { return nullptr; } DI const u16* row(int n) const { return base + (long)n * ldb; } };

DI void phase0(const Params& p, char* smem, int bid, int nblk) {
  const int tid = TIDX();
  for (int item = bid; item < 384 + 256 + 16 + 1 + 1728; item += nblk) {
    if (item < 384) {
      const int cc = item % 24, kc = item / 24;
      const int col = cc * 256 + tid;
      float a0 = 0.f, a1 = 0.f;
#pragma unroll 1
      for (int half = 0; half < 2; ++half) {
        const int k0 = kc * 64 + half * 32;
        float w[32];
#pragma unroll
        for (int j = 0; j < 32; ++j) w[j] = p.w_ada[(long)(k0 + j) * 6144 + col];
#pragma unroll
        for (int j = 0; j < 32; ++j) {
          a0 += siluf(p.c[k0 + j]) * w[j];
          a1 += siluf(p.c[1024 + k0 + j]) * w[j];
        }
      }
      p.modp[(kc * 2 + 0) * 6144 + col] = a0;
      p.modp[(kc * 2 + 1) * 6144 + col] = a1;
    } else if (item < 640) {
      const int idx = (item - 384) * 256 + tid;
      const int c = idx & 127, d = (idx >> 7) & 63, h = idx >> 13;
      p.w_ukT[idx] = p.dsa_w_uk[c * 512 + h * 64 + d];
    } else if (item < 656) {
      const int part = item - 640;
      const int slot = tid >> 7, kk = tid & 127;
      float a = 0.f;
      for (int ld = part * 128; ld < part * 128 + 128; ++ld) a += p.cmp_pe[slot * 2048 + ld] * p.cmp_w1[((long)slot * 2048 + ld) * 128 + kk];
      p.pe_part[part * 256 + tid] = a;
    } else if (item == 656) {
      p.counts[tid] = 0;
    } else {
      int it = item - 657;
      const float* W; u16* WT; int K, N, ntn;
      if (it < 1152) { W = p.w_in; WT = p.w_inT; K = 1024; N = LDP; ntn = 72; }
      else if (it < 1280) { it -= 1152; W = p.w_bn; WT = p.w_bnT; K = 512; N = 1024; ntn = 16; }
      else if (it < 1408) { it -= 1280; W = p.w_bd; WT = p.w_bdT; K = 512; N = 1024; ntn = 16; }
      else if (it < 1664) { it -= 1408; W = p.w_out; WT = p.w_outT; K = 1024; N = 1024; ntn = 16; }
      else { it -= 1664; W = p.router_w; WT = p.routerT; K = 1024; N = 256; ntn = 4; }
      const int k0 = (it / ntn) * 64, n0 = (it % ntn) * 64;
      u16* tl = (u16*)smem;
      __syncthreads();
      const int kr = tid >> 4, nq = tid & 15;
#pragma unroll
      for (int ps = 0; ps < 4; ++ps) {
        const int k = kr + 16 * ps, n = n0 + nq * 4;
        float4 v = make_float4(0.f, 0.f, 0.f, 0.f);
        if (n < N) v = *(const float4*)(W + (long)(k0 + k) * N + n);
        tl[(nq * 4 + 0) * 72 + k] = f2bf(v.x);
        tl[(nq * 4 + 1) * 72 + k] = f2bf(v.y);
        tl[(nq * 4 + 2) * 72 + k] = f2bf(v.z);
        tl[(nq * 4 + 3) * 72 + k] = f2bf(v.w);
      }
      __syncthreads();
      const int nr = tid >> 2, piece = tid & 3;
      const uint4 a = *(const uint4*)(tl + nr * 72 + piece * 16);
      const uint4 b = *(const uint4*)(tl + nr * 72 + piece * 16 + 8);
      uint4* dst = (uint4*)(WT + (long)(n0 + nr) * K + k0 + piece * 16);
      dst[0] = a; dst[1] = b;
    }
  }
}

DI void phase1(const Params& p, char* smem, int bid, int nblk) {
  const int tid = TIDX(), lane = tid & 63, wid = __builtin_amdgcn_readfirstlane(tid >> 6);
  float* modl = (float*)smem;
  for (int idx = tid; idx < 4096; idx += 256) {
    const int b = idx >> 11, n = idx & 2047;
    float v = p.b_ada[n];
    for (int kc = 0; kc < 16; ++kc) v += p.modp[(kc * 2 + b) * 6144 + n];
    modl[idx] = v;
  }
  if (bid < 48) {
    const int idx = bid * 256 + tid;
    const int b = idx / 6144, n = idx % 6144;
    float v = p.b_ada[n];
    for (int kc = 0; kc < 16; ++kc) v += p.modp[(kc * 2 + b) * 6144 + n];
    p.mod[idx] = v;
  }
  __syncthreads();
  for (int row = bid * 4 + wid; row < NTOK; row += nblk * 4) {
    const int b = row >> 13;
    const float* xr = p.x + (long)row * 1024;
    float4 v[4];
    float ss = 0.f;
#pragma unroll
    for (int i = 0; i < 4; ++i) {
      v[i] = *(const float4*)(xr + i * 256 + lane * 4);
      ss += v[i].x * v[i].x + v[i].y * v[i].y + v[i].z * v[i].z + v[i].w * v[i].w;
    }
    ss = wave_sum(ss);
    const float r = rsqrtf(ss * (1.f / 1024.f) + 1e-6f);
#pragma unroll
    for (int i = 0; i < 4; ++i) {
      const int col = i * 256 + lane * 4;
      const float4 g = *(const float4*)(p.g_pre_mix + col);
      const float* sh = modl + b * 2048 + col;
      const float* sc = modl + b * 2048 + 1024 + col;
      const float o0 = v[i].x * r * g.x * (1.f + sc[0]) + sh[0];
      const float o1 = v[i].y * r * g.y * (1.f + sc[1]) + sh[1];
      const float o2 = v[i].z * r * g.z * (1.f + sc[2]) + sh[2];
      const float o3 = v[i].w * r * g.w * (1.f + sc[3]) + sh[3];
      uint2 w;
      w.x = pack2(o0, o1);
      w.y = pack2(o2, o3);
      *(uint2*)(p.h + (long)row * 1024 + col) = w;
    }
  }
}

struct EpiProj {
  u16* proj; float* widx; int m0, n0;
  template <int MT> DI void operator()(f32x16 (&acc)[MT][2], int wm, int wn, int lane) const {
    SW_FOR {
      const int r = m0 + SW_R, c = n0 + SW_C0;
      if (c < LDP) {
        float v[4] = {SW_V(0), SW_V(1), SW_V(2), SW_V(3)};
        if (c < C_KV) { for (int j = 0; j < 4; ++j) v[j] *= 0.125f; }
        else if (c < C_GN) {}
        else if (c < C_QD) { for (int j = 0; j < 4; ++j) v[j] = sigmoidf(v[j]); }
        else if (c < C_QI) {}
        else if (c < C_KI) { for (int j = 0; j < 4; ++j) v[j] *= 0.125f; }
        else if (c < C_WI) {}
        else if (c < C_GM) {
          for (int j = 0; j < 4; ++j) v[j] *= 0.35355339059327373f;
          *(float4*)(widx + (long)r * 8 + (c - C_WI)) = make_float4(v[0], v[1], v[2], v[3]);
        } else { for (int j = 0; j < 4; ++j) v[j] = sigmoidf(v[j]); }
        *(uint2*)(proj + (long)r * LDP + c) = pack4(v[0], v[1], v[2], v[3]);
      }
    }
  }
};
struct EpiProjVT {
  u16* vt; int m0;
  DI void operator()(f32x16 (&acc)[2][2], int wm, int wn, int lane) const {
#pragma unroll
    for (int mt = 0; mt < 2; ++mt)
#pragma unroll
      for (int nt = 0; nt < 2; ++nt) {
        const int cc = EPI_C;
#pragma unroll
        for (int q4 = 0; q4 < 4; ++q4) {
          const int r = m0 + wm * 64 + mt * 32 + 8 * q4 + 4 * (lane >> 5);
          const int b = r >> 13, t = r & 8191;
          uint2 w;
          w.x = pack2(acc[mt][nt][q4 * 4 + 0], acc[mt][nt][q4 * 4 + 1]);
          w.y = pack2(acc[mt][nt][q4 * 4 + 2], acc[mt][nt][q4 * 4 + 3]);
          *(uint2*)(vt + ((long)(b * 128 + cc)) * T + t) = w;
        }
      }
  }
};
DI void phase2(const Params& p, char* smem, int bid, int nblk) {
  for (int item = bid; item < 64 * 34 + 256; item += nblk) {
    if (item < 64 * 34) {
      const int mt_ = item / 34, q = item % 34;
      const int nt_ = q < 7 ? q : (q < 8 ? q + 1 : q + 2);
      ARows af{p.h + (long)mt_ * 256 * 1024, 1024, 256};
      BMatT bf{p.w_inT + (long)nt_ * 128 * 1024, 1024};
      EpiProj ef{p.proj, p.widx, mt_ * 256, nt_ * 128};
      gemm_tile256<true>(smem, 16, af, bf, ef);
    } else {
      const int it = item - 64 * 34, mt_ = it >> 1, nt_ = (it & 1) ? 9 : 7;
      ARows af{p.h + (long)mt_ * 128 * 1024, 1024, 128};
      BMatT bf{p.w_inT + (long)nt_ * 128 * 1024, 1024};
      EpiProjVT ef{nt_ == 7 ? p.vts : p.vtw, mt_ * 128};
      gemm_tile<false, false, true>(smem, 16, 64, af, bf, ef);
    }
  }
}

struct ACmp {
  const u16* proj; int slot, m0;
  DI const u16* operator()(int r) const {
    const int R = m0 + r, bg = R >> 9, n = R & 511, b = bg >> 1, g = bg & 1;
    const int nc = n >= 511 ? 510 : n;
    return proj + ((long)b * T + 16 * nc) * LDP + C_KV + slot * 128 + g * 64;
  }
};
struct EpiCmp1 {
  u16* zc; const float* b1; const float* pe_part; int slot, m0;
  DI void operator()(f32x16 (&acc)[2][2], int wm, int wn, int lane) const {
    constexpr int MT = 2;
#pragma unroll
    for (int nt = 0; nt < 2; ++nt)
#pragma unroll
      for (int q4 = 0; q4 < 4; ++q4) {
        const int c = SW_C0;
        float4 bias = *(const float4*)(b1 + slot * 128 + c);
        for (int q = 0; q < 16; ++q) {
          const float4 t = *(const float4*)(pe_part + q * 256 + slot * 128 + c);
          bias.x += t.x; bias.y += t.y; bias.z += t.z; bias.w += t.w;
        }
#pragma unroll
        for (int mt = 0; mt < 2; ++mt) {
          const int R = m0 + SW_R;
          *(uint2*)(zc + ((long)slot * 2048 + R) * 128 + c) =
              pack4(gelu_tanh(SW_V(0) + bias.x), gelu_tanh(SW_V(1) + bias.y), gelu_tanh(SW_V(2) + bias.z), gelu_tanh(SW_V(3) + bias.w));
        }
      }
  }
};
struct EpiQlat {
  u16* qlat; int h, m0;
  DI void operator()(f32x16 (&acc)[2][2], int wm, int wn, int lane) const {
    constexpr int MT = 2;
    SW_FOR {
      const int r = m0 + SW_R, c = SW_C0;
      *(uint2*)(qlat + ((long)r * 8 + h) * 128 + c) = pack4(SW_V(0) * 0.125f, SW_V(1) * 0.125f, SW_V(2) * 0.125f, SW_V(3) * 0.125f);
    }
  }
};
DI void indexer_item(const Params& p, char* smem, int item);
DI void phase3(const Params& p, char* smem, int bid, int nblk) {
  const int tid = TIDX(), lane = tid & 63, wid = __builtin_amdgcn_readfirstlane(tid >> 6);
  if (bid < 32) {
    const int slot = bid >> 4, mt_ = bid & 15;
    ACmp af{p.proj, slot, mt_ * 128};
    BMat bf{p.cmp_w1 + (long)slot * 2048 * 128, 128, 128};
    EpiCmp1 ef{p.zc, p.cmp_b1, p.pe_part, slot, mt_ * 128};
    gemm_tile(smem, 32, LDP, af, bf, ef);
    return;
  }
  for (int item = bid - 32; item < 4160 + 1024 + 512; item += nblk - 32) {
    __syncthreads();
    if (item < 4160) {
      indexer_item(p, smem, item);
    } else if (item < 4160 + 1024) {
      const int it = item - 4160, h = it & 7, mt_ = it >> 3;
      ARows af{p.proj + (long)mt_ * 128 * LDP + C_QD + h * 64, LDP, 128};
      BMat bf{p.w_ukT + h * 64 * 128, 128, 128};
      EpiQlat ef{p.qlat, h, mt_ * 128};
      gemm_tile<true, true>(smem, 1, 64, af, bf, ef);
    } else {
      const int it = item - 4160 - 1024;
      for (int q = 0; q < 8; ++q) {
        const int row = it * 32 + wid * 8 + q;
        const unsigned u = *(const unsigned*)(p.proj + (long)row * LDP + C_CKV + lane * 2);
        const float a = lo16(u), b = hi16(u);
        const float ss = wave_sum(a * a + b * b);
        const float r = rsqrtf(ss * (1.f / 128.f) + 1e-6f);
        *(unsigned*)(p.ckv + (long)row * 128 + lane * 2) = pack2(a * r * p.dsa_kv_norm[lane * 2], b * r * p.dsa_kv_norm[lane * 2 + 1]);
      }
    }
  }
}

struct EpiCmp2 {
  u16* dst; int m0;
  DI void operator()(f32x16 (&acc)[2][2], int wm, int wn, int lane) const {
    constexpr int MT = 2;
    SW_FOR {
      const int R = m0 + SW_R, c = SW_C0;
      if (c < 64) *(uint2*)(dst + (long)R * 64 + c) = pack4(SW_V(0), SW_V(1), SW_V(2), SW_V(3));
    }
  }
};
struct EpiCmp2T {
  u16* dst; int m0;
  DI void operator()(f32x16 (&acc)[2][2], int wm, int wn, int lane) const {
#pragma unroll
    for (int mt = 0; mt < 2; ++mt)
#pragma unroll
      for (int nt = 0; nt < 2; ++nt) {
        const int c = EPI_C;
        if (c < 64) {
#pragma unroll
          for (int q4 = 0; q4 < 4; ++q4) {
            const int R = m0 + wm * 64 + mt * 32 + 8 * q4 + 4 * (lane >> 5);
            const int bg = R >> 9, n = R & 511;
            *(uint2*)(dst + ((long)(bg * 64 + c)) * 512 + n) =
                pack4(acc[mt][nt][q4 * 4 + 0], acc[mt][nt][q4 * 4 + 1], acc[mt][nt][q4 * 4 + 2], acc[mt][nt][q4 * 4 + 3]);
          }
        }
      }
  }
};
DI void indexer_item(const Params& p, char* smem, int item) {
  const int tid = TIDX(), lane = tid & 63, wid = __builtin_amdgcn_readfirstlane(tid >> 6);
  int b = 0, rem = item;
  if (rem >= 2080) { b = 1; rem -= 2080; }
  int qt = (int)((sqrtf(8.f * rem + 1.f) - 1.f) * 0.5f);
  while ((qt + 1) * (qt + 2) / 2 <= rem) ++qt;
  while (qt * (qt + 1) / 2 > rem) --qt;
  const int kt = rem - qt * (qt + 1) / 2;
  const int t0 = qt * 128 + (wid >> 1) * 64, s0 = kt * 128 + (wid & 1) * 64;
  if (s0 > t0 + 63) return;
  float* wl = (float*)smem + wid * 512;
  const float* wsrc = p.widx + ((long)b * T + t0) * 8;
#pragma unroll
  for (int i = 0; i < 8; ++i) wl[i * 64 + lane] = wsrc[i * 64 + lane];
  wave_sync();
  const u16* projb = p.proj + (long)b * T * LDP;
  const int r31 = lane & 31, hf = lane >> 5;
  u16* Kt = (u16*)(smem + 8192) + wid * (64 * 72);
  {
    const int piece = lane & 7, rb = lane >> 3;
#pragma unroll
    for (int i = 0; i < 8; ++i) {
      const uint4 v = *(const uint4*)(projb + (long)(s0 + rb + 8 * i) * LDP + C_KI + piece * 8);
      *(uint4*)(Kt + (rb + 8 * i) * 72 + piece * 8) = v;
    }
  }
  wave_sync();
  const u16* kfrag = Kt + r31 * 72 + hf * 8;
  f32x16 sum[2][2];
#pragma unroll
  for (int a = 0; a < 2; ++a)
#pragma unroll
    for (int c = 0; c < 2; ++c)
#pragma unroll
      for (int i = 0; i < 16; ++i) sum[a][c][i] = 0.f;
  const u16* qbase = projb + (long)(t0 + r31) * LDP + C_QI + hf * 8;
  bf16x8 af0[4], af1[4], af2[4], af3[4];
#define IDX_LOADQ(DST, STEP)                                                                            \
  {                                                                                                     \
    const int st_ = (STEP) < 15 ? (STEP) : 15;                                                          \
    _Pragma("unroll") for (int ks = 0; ks < 4; ++ks) DST[ks] = *(const bf16x8*)(qbase + (long)(st_ & 1) * 32 * LDP + (st_ >> 1) * 64 + ks * 16); \
  }
#define IDX_STEP(SRC, MT, H)                                                                            \
  {                                                                                                     \
    const float w_ = wl[((MT) * 32 + r31) * 8 + (H)];                                                   \
    _Pragma("unroll") for (int nt = 0; nt < 2; ++nt) {                                                  \
      f32x16 acc;                                                                                       \
      _Pragma("unroll") for (int i = 0; i < 16; ++i) acc[i] = 0.f;                                      \
      _Pragma("unroll") for (int ks = 0; ks < 4; ++ks) acc = __builtin_amdgcn_mfma_f32_32x32x16_bf16(*(const bf16x8*)(kfrag + nt * 32 * 72 + ks * 16), SRC[ks], acc, 0, 0, 0); \
      _Pragma("unroll") for (int i = 0; i < 16; ++i) sum[MT][nt][i] += w_ * fmaxf(acc[i], 0.f);        \
    }                                                                                                   \
  }
  IDX_LOADQ(af0, 0) IDX_LOADQ(af1, 1) IDX_LOADQ(af2, 2)
#pragma unroll 1
  for (int s4 = 0; s4 < 16; s4 += 4) {
    IDX_LOADQ(af3, s4 + 3)
    asm volatile("" ::: "memory");
    IDX_STEP(af0, 0, s4 >> 1)
    asm volatile("" ::: "memory");
    IDX_LOADQ(af0, s4 + 4)
    asm volatile("" ::: "memory");
    IDX_STEP(af1, 1, s4 >> 1)
    asm volatile("" ::: "memory");
    IDX_LOADQ(af1, s4 + 5)
    asm volatile("" ::: "memory");
    IDX_STEP(af2, 0, (s4 >> 1) + 1)
    asm volatile("" ::: "memory");
    IDX_LOADQ(af2, s4 + 6)
    asm volatile("" ::: "memory");
    IDX_STEP(af3, 1, (s4 >> 1) + 1)
    asm volatile("" ::: "memory");
  }
#undef IDX_LOADQ
#undef IDX_STEP
#pragma unroll
  for (int mt = 0; mt < 2; ++mt)
#pragma unroll
    for (int nt = 0; nt < 2; ++nt)
#pragma unroll
      for (int q4 = 0; q4 < 4; ++q4)
        *(float4*)(p.scores + ((long)b * T + t0 + mt * 32 + r31) * T + s0 + nt * 32 + 8 * q4 + 4 * hf) =
            make_float4(sum[mt][nt][4 * q4], sum[mt][nt][4 * q4 + 1], sum[mt][nt][4 * q4 + 2], sum[mt][nt][4 * q4 + 3]);
}
DI void topk_row(const Params& p, int b, int t, int lane);
DI void phase4(const Params& p, char* smem, int bid, int nblk) {
  if (bid < 32) {
    const int slot = bid >> 4, mt_ = bid & 15;
    ARows af{p.zc + ((long)slot * 2048 + mt_ * 128) * 128, 128, 128};
    BMat bf{p.cmp_w2 + slot * 128 * 64, 64, 64};
    if (slot) { EpiCmp2T ef{p.vcT, mt_ * 128}; gemm_tile<false>(smem, 2, 64, af, bf, ef); }
    else { EpiCmp2 ef{p.kc, mt_ * 128}; gemm_tile(smem, 2, 64, af, bf, ef); }
  }
  const int tid = TIDX(), lane = tid & 63, wid = __builtin_amdgcn_readfirstlane(tid >> 6);
  for (int item = bid; item < 2048; item += nblk) {
    const int it = item < 1024 ? 2047 - item : item - 1024;
    const int b = it & 1, tb = it >> 1;
#pragma unroll 1
    for (int q = 0; q < 2; ++q) {
      asm volatile("" ::: "memory");
      topk_row(p, b, tb * 8 + wid * 2 + q, lane);
    }
  }
}

using f32x4 = __attribute__((ext_vector_type(4))) float;
#define MFMA16(a, b, c) __builtin_amdgcn_mfma_f32_16x16x32_bf16((a), (b), (c), 0, 0, 0)
#define MFMA32(a, b, c) __builtin_amdgcn_mfma_f32_32x32x16_bf16((a), (b), (c), 0, 0, 0)

constexpr int NSA_STAGE_BYTES = 64 * 72 * 2 + 64 * 68 * 2;
DI void dense_scores(f32x16 (&acc)[2], const u16* Ks, const bf16x8 (&qf)[4], int lane) {
  const int r = lane & 31, hf = lane >> 5;
#pragma unroll
  for (int tile = 0; tile < 2; ++tile) {
    const u16* kp = Ks + (32 * tile + r) * 72 + 8 * hf;
    f32x16 c;
#pragma unroll
    for (int i = 0; i < 16; ++i) c[i] = 0.f;
#pragma unroll
    for (int ks = 0; ks < 4; ++ks) c = MFMA32(*(const bf16x8*)(kp + 16 * ks), qf[ks], c);
    acc[tile] = c;
  }
}
DI void dense_pv(const f32x16 (&acc)[2], const u16* Vs, int lane, f32x16 (&o)[2]) {
  const int r = lane & 31, hf = lane >> 5;
#pragma unroll
  for (int tile = 0; tile < 2; ++tile)
#pragma unroll
    for (int s = 0; s < 2; ++s) {
      uint4 w;
      w.x = pack2(acc[tile][8 * s + 0], acc[tile][8 * s + 1]);
      w.y = pack2(acc[tile][8 * s + 2], acc[tile][8 * s + 3]);
      w.z = pack2(acc[tile][8 * s + 4], acc[tile][8 * s + 5]);
      w.w = pack2(acc[tile][8 * s + 6], acc[tile][8 * s + 7]);
      const bf16x8 pb = __builtin_bit_cast(bf16x8, w);
#pragma unroll
      for (int dt = 0; dt < 2; ++dt) {
        const u16* vp = Vs + (32 * dt + r) * 68 + 32 * tile + 16 * s + 4 * hf;
        const uint2 lo = *(const uint2*)vp;
        const uint2 hi = *(const uint2*)(vp + 8);
        uint4 a;
        a.x = lo.x; a.y = lo.y; a.z = hi.x; a.w = hi.y;
        o[dt] = MFMA32(__builtin_bit_cast(bf16x8, a), pb, o[dt]);
      }
    }
}
constexpr float LOG2E = 1.4426950408889634f;
template <int DSTEP>
DI float dense_mask(f32x16 (&acc)[2], bool active, int lo_c, int hi_c, int dist0_c, int dmin_u, const float* btab_h, int lane) {
  const int hf = lane >> 5;
  const bool colfull = !active || (lo_c <= 0 && hi_c >= 63);
  float mx = -INFINITY;
  if (dmin_u >= 128 && __ballot(colfull) == ~0ull) {
    const float be = active ? btab_h[128] : -INFINITY;
#pragma unroll
    for (int tile = 0; tile < 2; ++tile)
#pragma unroll
      for (int i = 0; i < 16; ++i) {
        const float sv = fmaf(acc[tile][i], LOG2E, be);
        acc[tile][i] = sv;
        mx = fmaxf(mx, sv);
      }
  } else {
    const int lo2 = active ? lo_c : 1, hi2 = active ? hi_c : 0;
#pragma unroll
    for (int tile = 0; tile < 2; ++tile)
#pragma unroll
      for (int i = 0; i < 16; ++i) {
        const int kl = 32 * tile + (i & 3) + 8 * (i >> 2) + 4 * hf;
        int dc = dist0_c - DSTEP * kl;
        dc = dc < 0 ? 0 : (dc > 128 ? 128 : dc);
        const float bias = btab_h[dc];
        const float s2 = fmaf(acc[tile][i], LOG2E, bias);
        const float sv = (kl >= lo2 && kl <= hi2) ? s2 : -INFINITY;
        acc[tile][i] = sv;
        mx = fmaxf(mx, sv);
      }
  }
  return fmaxf(mx, __shfl_xor(mx, 32));
}
DI void dense_chunk(const u16* Ks, const u16* Vs, bool active, int lo_c, int hi_c, int dist0_c, int dmin_u, const bf16x8 (&qf)[4],
                    const float* btab_h, int lane, float& m, float& l, f32x16 (&o)[2]) {
  f32x16 acc[2];
  dense_scores(acc, Ks, qf, lane);
  const float mx = dense_mask<1>(acc, active, lo_c, hi_c, dist0_c, dmin_u, btab_h, lane);
  const float mn = fmaxf(m, mx);
  const float alpha = __builtin_amdgcn_exp2f(m - mn);
  float ls = 0.f;
#pragma unroll
  for (int tile = 0; tile < 2; ++tile)
#pragma unroll
    for (int i = 0; i < 16; ++i) {
      const float pv = __builtin_amdgcn_exp2f(acc[tile][i] - mn);
      acc[tile][i] = pv;
      ls += pv;
    }
  ls += __shfl_xor(ls, 32);
  l = l * alpha + ls;
  m = mn;
  o[0] *= alpha;
  o[1] *= alpha;
  dense_pv(acc, Vs, lane, o);
}

template <int KSG, int VSG, bool NEEDV, class Next, class Body>
DI void chunk_pipeline(char* stage, const u16* kg0, const u16* vg0, int first, int tid, const Next& next, const Body& body) {
  const int srow = tid >> 2, spiece = tid & 3;
  uint4 rk0, rk1, rv0, rv1;
  rv0 = rv1 = make_uint4(0, 0, 0, 0);
  int d = first;
#define NSA_GLOAD(D)                                                                      \
  {                                                                                       \
    const uint4* pk_ = (const uint4*)(kg0 + ((long)(D) * 64 + srow) * KSG + spiece * 16); \
    rk0 = pk_[0]; rk1 = pk_[1];                                                           \
    if (NEEDV) {                                                                          \
      const uint4* pv_ = (const uint4*)(vg0 + (long)srow * VSG + (D) * 64 + spiece * 16); \
      rv0 = pv_[0]; rv1 = pv_[1];                                                         \
    }                                                                                     \
  }
  if (d >= 0) NSA_GLOAD(d)
  int ph = 0;
  __syncthreads();
  while (d >= 0) {
    u16* Ks = (u16*)(stage + ph * NSA_STAGE_BYTES);
    u16* Vs = Ks + 64 * 72;
    *(uint4*)(Ks + srow * 72 + spiece * 16) = rk0;
    *(uint4*)(Ks + srow * 72 + spiece * 16 + 8) = rk1;
    if (NEEDV) {
      uint2* dv = (uint2*)(Vs + srow * 68 + spiece * 16);
      dv[0] = make_uint2(rv0.x, rv0.y); dv[1] = make_uint2(rv0.z, rv0.w);
      dv[2] = make_uint2(rv1.x, rv1.y); dv[3] = make_uint2(rv1.z, rv1.w);
    }
    const int dn = next(d);
    if (dn >= 0) NSA_GLOAD(dn)
    __syncthreads();
    body(d, Ks, Vs);
    ph ^= 1;
    d = dn;
  }
#undef NSA_GLOAD
}

DI void nsa_item(const Params& p, char* smem, int item) {
  const int tid = TIDX(), lane = tid & 63, wid = __builtin_amdgcn_readfirstlane(tid >> 6);
  const int chunk = item & 255, g = (item >> 8) & 1, b = item >> 9;
  const int bg = b * 2 + g;
  float* btab = (float*)smem;
  u64* wun = (u64*)(smem + 2304);
  float* imps = (float*)(smem + 4096) + wid * 1056;
  char* stage = smem + 21504;
  for (int idx = tid; idx < 4 * 129; idx += 256) {
    const int h = idx / 129, d = idx % 129;
    const int bk = d < 128 ? BUCKET[d] : 31;
    btab[h * 132 + d] = p.rel_bias[bk * 16 + g * 4 + h] * LOG2E;
  }
  __syncthreads();
  const int t0 = chunk * 32;
  const int tw = t0 + wid * 8;
  const int c = lane & 31, hf = lane >> 5, qi = c >> 2, hh = c & 3;
  const int t_c = tw + qi;
  const int cur = t0 >> 6;
  const long row = (long)b * T + t_c;
  const u16* prow = p.proj + row * LDP;
  const u16* projb = p.proj + (long)b * T * LDP;
  const float* btab_h = btab + hh * 132;
  bf16x8 qf[4];
#pragma unroll
  for (int ks = 0; ks < 4; ++ks) qf[ks] = *(const bf16x8*)(prow + C_QN + (g * 4 + hh) * 64 + ks * 16 + hf * 8);
  const u16* gptr = prow + C_GN + (g * 4 + hh) * 3;
  for (int k = lane; k < 1056; k += 64) imps[k] = 0.f;
  u16* orow = p.onsa + row * 512 + (g * 4 + hh) * 64 + 4 * hf;
  auto emit = [&](const f32x16 (&o)[2], float sc, bool first) {
#pragma unroll
    for (int dt = 0; dt < 2; ++dt)
#pragma unroll
      for (int q4 = 0; q4 < 4; ++q4) {
        uint2* dst = (uint2*)(orow + 32 * dt + 8 * q4);
        float v0 = o[dt][4 * q4 + 0] * sc, v1 = o[dt][4 * q4 + 1] * sc, v2 = o[dt][4 * q4 + 2] * sc, v3 = o[dt][4 * q4 + 3] * sc;
        if (!first) {
          const uint2 u = *dst;
          v0 += lo16(u.x); v1 += hi16(u.x); v2 += lo16(u.y); v3 += hi16(u.y);
        }
        uint2 w;
        w.x = pack2(v0, v1);
        w.y = pack2(v2, v3);
        *dst = w;
      }
  };
  const int ncv_c = (t_c >= 31) ? ((t_c - 31) >> 4) + 1 : 0;
  const int ncv_max = (t0 + 31 >= 31) ? ((t0 + 31 - 31) >> 4) + 1 : 0;
  const int nchunk_c = (ncv_max + 63) >> 6;
  {
    const u16* kcb = p.kc + (long)bg * 512 * 64;
    const u16* vcb = p.vcT + (long)bg * 64 * 512;
    float m = -1e30f, l = 0.f;
    auto next_c = [&](int d) { return d + 1 < nchunk_c ? d + 1 : -1; };
    chunk_pipeline<64, 512, false>(stage, kcb, vcb, 0, tid, next_c, [&](int i, const u16* Ks, const u16* Vs) {
      f32x16 acc[2];
      dense_scores(acc, Ks, qf, lane);
      const float mx = dense_mask<16>(acc, true, 0, ncv_c - 1 - i * 64, t_c - 31 - 1024 * i, tw - 31 - 1024 * i - 1008, btab_h, lane);
      const float mn = fmaxf(m, mx);
      float ls = 0.f;
#pragma unroll
      for (int tile = 0; tile < 2; ++tile)
#pragma unroll
        for (int q = 0; q < 16; ++q) ls += __builtin_amdgcn_exp2f(acc[tile][q] - mn);
      ls += __shfl_xor(ls, 32);
      l = l * __builtin_amdgcn_exp2f(m - mn) + ls;
      m = mn;
    });
    const float invl = 1.f / fmaxf(l, 1e-30f);
    f32x16 oc[2];
#pragma unroll
    for (int i = 0; i < 16; ++i) { oc[0][i] = 0.f; oc[1][i] = 0.f; }
    chunk_pipeline<64, 512, true>(stage, kcb, vcb, 0, tid, next_c, [&](int i, const u16* Ks, const u16* Vs) {
      f32x16 acc[2];
      dense_scores(acc, Ks, qf, lane);
      (void)dense_mask<16>(acc, true, 0, ncv_c - 1 - i * 64, t_c - 31 - 1024 * i, tw - 31 - 1024 * i - 1008, btab_h, lane);
      float part[2][4], spill[2][4];
#pragma unroll
      for (int tile = 0; tile < 2; ++tile) {
#pragma unroll
        for (int q = 0; q < 16; ++q) acc[tile][q] = __builtin_amdgcn_exp2f(acc[tile][q] - m) * invl;
#pragma unroll
        for (int q4 = 0; q4 < 4; ++q4) {
          float pa = acc[tile][4 * q4] + acc[tile][4 * q4 + 1] + acc[tile][4 * q4 + 2] + 0.5f * acc[tile][4 * q4 + 3];
          float sp = 0.5f * acc[tile][4 * q4 + 3];
          pa += __shfl_xor(pa, 1); pa += __shfl_xor(pa, 2);
          sp += __shfl_xor(sp, 1); sp += __shfl_xor(sp, 2);
          part[tile][q4] = pa; spill[tile][q4] = sp;
        }
      }
      if (hh == 0) {
#pragma unroll
        for (int tile = 0; tile < 2; ++tile)
#pragma unroll
          for (int q4 = 0; q4 < 4; ++q4) imps[qi * 132 + 16 * i + 8 * tile + 2 * q4 + hf] += part[tile][q4];
      }
      wave_sync();
      if (hh == 0) {
#pragma unroll
        for (int tile = 0; tile < 2; ++tile)
#pragma unroll
          for (int q4 = 0; q4 < 4; ++q4) imps[qi * 132 + 16 * i + 8 * tile + 2 * q4 + hf + 1] += spill[tile][q4];
      }
      wave_sync();
      dense_pv(acc, Vs, lane, oc);
    });
    emit(oc, bf2f(gptr[0]), true);
  }
  wave_sync();
  u64 my0 = 0, my1 = 0, wu0 = 0, wu1 = 0;
  for (int q = 0; q < 8; ++q) {
    u64 mask0, mask1;
    if (cur <= 15) {
      mask0 = (2ull << cur) - 1ull;
      mask1 = 0ull;
    } else {
      const float imp_lo = imps[q * 132 + lane], imp_hi = imps[q * 132 + lane + 64];
      const int jl = lane, jh = lane + 64;
      float c0 = (jl >= 1 && jl <= cur - 2) ? imp_lo : -1.f;
      float c1 = (jh <= cur - 2) ? imp_hi : -1.f;
      bool sel_lo = (jl == 0) || (jl == cur) || (jl == cur - 1);
      bool sel_hi = (jh == cur) || (jh == cur - 1);
      for (int r = 0; r < 13; ++r) {
        float bv; int bj;
        if (c0 >= c1) { bv = c0; bj = jl; } else { bv = c1; bj = jh; }
        wave_argmax(bv, bj);
        if (bj == jl) { sel_lo = true; c0 = -1.f; }
        if (bj == jh) { sel_hi = true; c1 = -1.f; }
      }
      mask0 = __ballot(sel_lo);
      mask1 = __ballot(sel_hi);
    }
    if (qi == q) { my0 = mask0; my1 = mask1; }
    wu0 |= mask0; wu1 |= mask1;
  }
  if (lane == 0) { wun[wid * 2] = wu0; wun[wid * 2 + 1] = wu1; }
  __syncthreads();
  u64 bu0 = wun[0] | wun[2] | wun[4] | wun[6], bu1 = wun[1] | wun[3] | wun[5] | wun[7];
  bu0 = ((u64)(unsigned)__builtin_amdgcn_readfirstlane((int)(bu0 >> 32)) << 32) | (unsigned)__builtin_amdgcn_readfirstlane((int)bu0);
  bu1 = ((u64)(unsigned)__builtin_amdgcn_readfirstlane((int)(bu1 >> 32)) << 32) | (unsigned)__builtin_amdgcn_readfirstlane((int)bu1);
  {
    float m = -1e30f, l = 0.f;
    f32x16 o[2];
#pragma unroll
    for (int i = 0; i < 16; ++i) { o[0][i] = 0.f; o[1][i] = 0.f; }
    const int kcol = C_KV + 2 * 128 + g * 64;
    auto next_s = [&](int j) {
      ++j;
      if (j < 64) {
        const u64 mm = bu0 & (~0ull << j);
        if (mm) return (int)__builtin_ctzll(mm);
        j = 64;
      }
      if (j >= 128) return -1;
      const u64 mm = bu1 & (~0ull << (j - 64));
      return mm ? 64 + (int)__builtin_ctzll(mm) : -1;
    };
    chunk_pipeline<LDP, T, true>(stage, projb + kcol, p.vts + (long)bg * 64 * T, 0, tid, next_s, [&](int j, const u16* Ks, const u16* Vs) {
      const bool bit = ((j < 64 ? (my0 >> j) : (my1 >> (j - 64))) & 1ull) != 0;
      if (__ballot(bit) != 0ull) {
        const int pos0 = 64 * j;
        dense_chunk(Ks, Vs, bit, 0, t_c - pos0, t_c - pos0, tw - pos0 - 63, qf, btab_h, lane, m, l, o);
      }
    });
    emit(o, bf2f(gptr[1]) / fmaxf(l, 1e-30f), false);
  }
  {
    float m = -1e30f, l = 0.f;
    f32x16 o[2];
#pragma unroll
    for (int i = 0; i < 16; ++i) { o[0][i] = 0.f; o[1][i] = 0.f; }
    const int kcol = C_KV + 4 * 128 + g * 64;
    const int wlo_c = t_c - 511 < 0 ? 0 : t_c - 511;
    const int wlo_min = t0 - 511 < 0 ? 0 : t0 - 511;
    auto next_w = [&](int j) { return j + 1 <= cur ? j + 1 : -1; };
    chunk_pipeline<LDP, T, true>(stage, projb + kcol, p.vtw + (long)bg * 64 * T, wlo_min >> 6, tid, next_w, [&](int jw, const u16* Ks, const u16* Vs) {
      const int pos0 = 64 * jw;
      const int lo_c = wlo_c - pos0 < 0 ? 0 : wlo_c - pos0;
      dense_chunk(Ks, Vs, true, lo_c, t_c - pos0, t_c - pos0, tw - pos0 - 63, qf, btab_h, lane, m, l, o);
    });
    emit(o, bf2f(gptr[2]) / fmaxf(l, 1e-30f), false);
  }
}

DI unsigned f2ord(float v) { const unsigned u = __float_as_uint(v); return (u & 0x80000000u) ? ~u : (u | 0x80000000u); }

DI void topk_row(const Params& p, int b, int t, int lane) {
  const long row = (long)b * T + t;
  int* dst = p.selk + row * 256;
  if (t < 256) {
#pragma unroll
    for (int i = 0; i < 4; ++i) { const int s = i * 64 + lane; dst[s] = (s <= t) ? s : -1; }
    return;
  }
  const float* srow = p.scores + row * T;
  const int ngrp = (t >> 10) + 1;
  unsigned u[128];
  int ln = lane;
  asm volatile("" : "+v"(ln));
#pragma unroll
  for (int gq = 0; gq < 8; ++gq) {
    if (gq < ngrp) {
#pragma unroll
      for (int j = 0; j < 16; ++j) {
        const int s = (gq * 16 + j) * 64 + ln;
        u[gq * 16 + j] = __float_as_uint(srow[s < t ? s : t]);
      }
    } else {
#pragma unroll
      for (int j = 0; j < 16; ++j) u[gq * 16 + j] = 0u;
    }
  }
  asm volatile("" ::: "memory");
#pragma unroll
  for (int gq = 0; gq < 8; ++gq) {
    if (gq < ngrp) {
#pragma unroll
      for (int j = 0; j < 16; ++j) {
        const int s = (gq * 16 + j) * 64 + ln;
        u[gq * 16 + j] = (s <= t) ? (f2ord(__uint_as_float(u[gq * 16 + j])) >> 1) : 0u;
      }
    }
  }
  const int nlane = 16 * ngrp;
  unsigned m0 = 0u, m1 = 0u, m2 = 0u, m3 = 0u;
#pragma unroll
  for (int gq = 0; gq < 8; ++gq) {
    if (gq < ngrp) {
#pragma unroll
      for (int j = 0; j < 16; j += 4) {
        m0 = max(m0, u[gq * 16 + j]); m1 = max(m1, u[gq * 16 + j + 1]); m2 = max(m2, u[gq * 16 + j + 2]); m3 = max(m3, u[gq * 16 + j + 3]);
      }
    }
  }
  unsigned lo = wave_min_u(min(min(m0, m1), min(m2, m3)));
  unsigned hi = wave_max_u(max(max(m0, m1), max(m2, m3))) + 1u;
#define TOPK_COUNT_GE(PIV, OUT)                                                         \
  {                                                                                     \
    unsigned below_ = 0;     \
    _Pragma("unroll") for (int gq = 0; gq < 8; ++gq) {                                  \
      if (gq < ngrp) {                                                                  \
        _Pragma("unroll") for (int j = 0; j < 16; ++j) below_ += (u[gq * 16 + j] - (PIV)) >> 31; \
      }                                                                                 \
    }                                                                                   \
    OUT = wave_sum_i(nlane - (int)below_);                                              \
  }
  int c_lo, c_hi = 0;
  TOPK_COUNT_GE(lo, c_lo)
  int iter = 0;
  while (c_lo != 256 && hi - lo > 1u) {
    const unsigned span = hi - lo;
    unsigned step;
    if ((++iter & 3) == 0) step = span >> 1;
    else step = (unsigned)((float)span * ((float)(c_lo - 256) / (float)(c_lo - c_hi)));
    step = step < 1u ? 1u : (step > span - 1u ? span - 1u : step);
    const unsigned piv = lo + step;
    int c;
    TOPK_COUNT_GE(piv, c)
    if (c >= 256) { lo = piv; c_lo = c; } else { hi = piv; c_hi = c; }
  }
#undef TOPK_COUNT_GE
  const unsigned thr = lo;
  int ngt = 0;
#pragma unroll
  for (int gq = 0; gq < 8; ++gq) {
    if (gq < ngrp) {
#pragma unroll
      for (int j = 0; j < 16; ++j) ngt += __popcll(__ballot(u[gq * 16 + j] > thr));
    }
  }
  int base_gt = 0, base_eq = 0;
  const int need_eq = 256 - ngt;
  int ln2 = lane;
  asm volatile("" : "+v"(ln2));
#pragma unroll
  for (int gq = 0; gq < 8; ++gq) {
    if (gq < ngrp) {
#pragma unroll
      for (int j = 0; j < 16; ++j) {
        const int s = (gq * 16 + j) * 64 + ln2;
        const unsigned uv = u[gq * 16 + j];
        const bool gt = uv > thr, eq = uv == thr;
        const u64 mg = __ballot(gt), me = __ballot(eq);
        const int pg = __builtin_amdgcn_mbcnt_hi((unsigned)(mg >> 32), __builtin_amdgcn_mbcnt_lo((unsigned)mg, 0));
        const int pe = __builtin_amdgcn_mbcnt_hi((unsigned)(me >> 32), __builtin_amdgcn_mbcnt_lo((unsigned)me, 0));
        if (gt) dst[base_gt + pg] = s;
        if (eq && (base_eq + pe) < need_eq) dst[ngt + base_eq + pe] = s;
        base_gt += __popcll(mg);
        base_eq += __popcll(me);
      }
    }
  }
}

DI void phase6(const Params& p, char* smem, int bid, int nblk);
DI void phase5(const Params& p, char* smem, int bid, int nblk) {
  for (int item = bid; item < 1024; item += nblk) {
    __syncthreads();
    const int it = item < 512 ? 1023 - item : item - 512;
    const int chunk = it >> 2, bgi = it & 3;
    nsa_item(p, smem, (bgi << 8) | chunk);
  }
  __syncthreads();
  phase6(p, smem, bid, nblk);
}

DI void tr_read2(unsigned a0, unsigned a1, uint2& r0, uint2& r1) {
  asm volatile("ds_read_b64_tr_b16 %0, %2\n\tds_read_b64_tr_b16 %1, %3\n\ts_waitcnt lgkmcnt(0)" : "=&v"(r0), "=&v"(r1) : "v"(a0), "v"(a1) : "memory");
}
DI void tr_read4(unsigned a0, unsigned a1, unsigned a2, unsigned a3, uint2& r0, uint2& r1, uint2& r2, uint2& r3) {
  asm volatile("ds_read_b64_tr_b16 %0, %4\n\tds_read_b64_tr_b16 %1, %5\n\tds_read_b64_tr_b16 %2, %6\n\tds_read_b64_tr_b16 %3, %7\n\ts_waitcnt lgkmcnt(0)"
               : "=&v"(r0), "=&v"(r1), "=&v"(r2), "=&v"(r3) : "v"(a0), "v"(a1), "v"(a2), "v"(a3) : "memory");
}
DI void dsa_query(const Params& p, u16* Cs, const float* btab, int b, int t, int lane) {
  const long row = (long)b * T + t;
  const int lg = lane >> 4, r16 = lane & 15, hh = lane & 7;
  bf16x8 qf[4];
#pragma unroll
  for (int ks = 0; ks < 4; ++ks) {
    bf16x8 z = {0, 0, 0, 0, 0, 0, 0, 0};
    if (r16 < 8) z = *(const bf16x8*)(p.qlat + (row * 8 + r16) * 128 + ks * 32 + lg * 8);
    qf[ks] = z;
  }
  const u16* ckvb = p.ckv + (long)b * T * 128;
  const int nvalid = (t + 1) < 256 ? (t + 1) : 256;
  float m = -1e30f, l = 0.f;
  f32x4 o[8];
#pragma unroll
  for (int ct = 0; ct < 8; ++ct) o[ct] = (f32x4){0.f, 0.f, 0.f, 0.f};
  const unsigned cs_base = (unsigned)(size_t)Cs;
  const int nch = (nvalid + 31) >> 5;
  uint4 gv0, gv1, gv2, gv3, gv4, gv5, gv6, gv7;
  int kidx_n;
#define DSA_G1(V, I) { const int kr_ = __shfl(kidx_n, 4 * (I) + lg); V = *(const uint4*)(ckvb + (long)kr_ * 128 + r16 * 8); }
#define DSA_GATHER(CH)                                                            \
  {                                                                               \
    const int nv_ = (nvalid - (CH) * 32) > 32 ? 32 : (nvalid - (CH) * 32);        \
    kidx_n = p.selk[row * 256 + (CH) * 32 + (lane & 31)];                         \
    if ((lane & 31) >= nv_ || kidx_n < 0 || kidx_n > t) kidx_n = t;               \
    DSA_G1(gv0, 0) DSA_G1(gv1, 1) DSA_G1(gv2, 2) DSA_G1(gv3, 3) DSA_G1(gv4, 4) DSA_G1(gv5, 5) DSA_G1(gv6, 6) DSA_G1(gv7, 7) \
  }
  DSA_GATHER(0)
  for (int ch = 0; ch < nch; ++ch) {
    const int nval = (nvalid - ch * 32) > 32 ? 32 : (nvalid - ch * 32);
    const int kidx = kidx_n;
    wave_sync();
    {
      u16* d_ = Cs + lg * 144 + r16 * 8;
      *(uint4*)(d_) = gv0;            *(uint4*)(d_ + 4 * 144) = gv1;  *(uint4*)(d_ + 8 * 144) = gv2;  *(uint4*)(d_ + 12 * 144) = gv3;
      *(uint4*)(d_ + 16 * 144) = gv4; *(uint4*)(d_ + 20 * 144) = gv5; *(uint4*)(d_ + 24 * 144) = gv6; *(uint4*)(d_ + 28 * 144) = gv7;
    }
    { const int chn = ch + 1 < nch ? ch + 1 : nch - 1; DSA_GATHER(chn) }
    wave_sync();
    f32x4 acc[2];
#pragma unroll
    for (int rt = 0; rt < 2; ++rt) {
      const u16* kp = Cs + (16 * rt + r16) * 144 + 8 * lg;
      f32x4 c = {0.f, 0.f, 0.f, 0.f};
#pragma unroll
      for (int ks = 0; ks < 4; ++ks) c = MFMA16(*(const bf16x8*)(kp + 32 * ks), qf[ks], c);
      acc[rt] = c;
    }
    float mx = -INFINITY;
#pragma unroll
    for (int rt = 0; rt < 2; ++rt)
#pragma unroll
      for (int r = 0; r < 4; ++r) {
        const int pl = 16 * rt + 4 * lg + r;
        const int kk = __shfl(kidx, pl);
        int dc = t - kk;
        dc = dc < 0 ? 0 : (dc > 128 ? 128 : dc);
        const float sv = (pl < nval) ? fmaf(acc[rt][r], LOG2E, btab[hh * 132 + dc]) : -INFINITY;
        acc[rt][r] = sv;
        mx = fmaxf(mx, sv);
      }
    mx = fmaxf(mx, __shfl_xor(mx, 16));
    mx = fmaxf(mx, __shfl_xor(mx, 32));
    const float mn = fmaxf(m, mx);
    const float alpha = __builtin_amdgcn_exp2f(m - mn);
    float ls = 0.f;
#pragma unroll
    for (int rt = 0; rt < 2; ++rt)
#pragma unroll
      for (int r = 0; r < 4; ++r) {
        const float pv = __builtin_amdgcn_exp2f(acc[rt][r] - mn);
        acc[rt][r] = pv;
        ls += pv;
      }
    ls += __shfl_xor(ls, 16);
    ls += __shfl_xor(ls, 32);
    l = l * alpha + ls;
    m = mn;
    uint4 pw;
    pw.x = pack2(acc[0][0], acc[0][1]);
    pw.y = pack2(acc[0][2], acc[0][3]);
    pw.z = pack2(acc[1][0], acc[1][1]);
    pw.w = pack2(acc[1][2], acc[1][3]);
    const bf16x8 pb = __builtin_bit_cast(bf16x8, pw);
    const unsigned a_lo = cs_base + (unsigned)(((4 * lg + (r16 >> 2)) * 144 + 4 * (r16 & 3)) * 2);
    const unsigned a_hi = a_lo + 16 * 144 * 2;
#pragma unroll
    for (int ct = 0; ct < 8; ct += 2) {
      uint2 lo0, hi0, lo1, hi1;
      tr_read4(a_lo + ct * 32, a_hi + ct * 32, a_lo + ct * 32 + 32, a_hi + ct * 32 + 32, lo0, hi0, lo1, hi1);
      uint4 aw0, aw1;
      aw0.x = lo0.x; aw0.y = lo0.y; aw0.z = hi0.x; aw0.w = hi0.y;
      aw1.x = lo1.x; aw1.y = lo1.y; aw1.z = hi1.x; aw1.w = hi1.y;
      o[ct] = o[ct] * alpha;
      o[ct + 1] = o[ct + 1] * alpha;
      o[ct] = MFMA16(__builtin_bit_cast(bf16x8, aw0), pb, o[ct]);
      o[ct + 1] = MFMA16(__builtin_bit_cast(bf16x8, aw1), pb, o[ct + 1]);
    }
  }
#undef DSA_GATHER
#undef DSA_G1
  const float invl = 1.f / fmaxf(l, 1e-30f);
  if (r16 < 8) {
#pragma unroll
    for (int ct = 0; ct < 8; ++ct)
      *(uint2*)(p.olat + row * 1024 + r16 * 128 + 16 * ct + 4 * lg) = pack4(o[ct][0] * invl, o[ct][1] * invl, o[ct][2] * invl, o[ct][3] * invl);
  }
}
DI void phase6(const Params& p, char* smem, int bid, int nblk) {
  const int tid = TIDX(), lane = tid & 63, wid = __builtin_amdgcn_readfirstlane(tid >> 6);
  float* btab = (float*)smem;
  u16* Cs = (u16*)(smem + 8192) + wid * (32 * 144);
  for (int idx = tid; idx < 8 * 129; idx += 256) {
    const int h = idx / 129, d = idx % 129;
    const int bk = d < 128 ? BUCKET[d] : 31;
    btab[h * 132 + d] = p.rel_bias[bk * 16 + 8 + h] * LOG2E;
  }
  __syncthreads();
  for (int item = bid; item < 2048; item += nblk) {
    const int it = item < 1024 ? 2047 - item : item - 1024;
    const int b = it & 1, tb = it >> 1;
    for (int q = 0; q < 2; ++q) dsa_query(p, Cs, btab, b, tb * 8 + wid * 2 + q, lane);
  }
}

struct EpiOdsa {
  u16* odsa; int h, m0;
  DI void operator()(f32x16 (&acc)[2][2], int wm, int wn, int lane) const {
    constexpr int MT = 2;
    SW_FOR {
      const int r = m0 + SW_R, c = SW_C0;
      if (c < 64) *(uint2*)(odsa + (long)r * 512 + h * 64 + c) = pack4(SW_V(0), SW_V(1), SW_V(2), SW_V(3));
    }
  }
};
DI void phase7(const Params& p, char* smem, int bid, int nblk) {
  for (int item = bid; item < 1024; item += nblk) {
    const int h = item & 7, mt_ = item >> 3;
    ARows af{p.olat + (long)mt_ * 128 * 1024 + h * 128, 1024, 128};
    BMat bf{p.dsa_w_uv + h * 64, 512, 64};
    EpiOdsa ef{p.odsa, h, mt_ * 128};
    gemm_tile(smem, 2, 64, af, bf, ef);
  }
}

struct EpiY {
  u16* y; const u16* proj; int m0, n0, second;
  template <int MT> DI void operator()(f32x16 (&acc)[MT][2], int wm, int wn, int lane) const {
    SW_FOR {
      const int r = m0 + SW_R, c = n0 + SW_C0;
      const uint2 gu = *(const uint2*)(proj + (long)r * LDP + C_GM + second * 1024 + c);
      float v0 = lo16(gu.x) * SW_V(0), v1 = hi16(gu.x) * SW_V(1), v2 = lo16(gu.y) * SW_V(2), v3 = hi16(gu.y) * SW_V(3);
      uint2* dst = (uint2*)(y + (long)r * 1024 + c);
      if (second) {
        const uint2 yu = *dst;
        v0 += lo16(yu.x); v1 += hi16(yu.x); v2 += lo16(yu.y); v3 += hi16(yu.y);
      }
      *dst = pack4(v0, v1, v2, v3);
    }
  }
};
DI void phase8(const Params& p, char* smem, int bid, int nblk) {
  for (int item = bid; item < 512; item += nblk) {
    const int nt_ = item & 7, mt_ = item >> 3;
    {
      ARows af{p.onsa + (long)mt_ * 256 * 512, 512, 256};
      BMatT bf{p.w_bnT + (long)nt_ * 128 * 512, 512};
      EpiY ef{p.y, p.proj, mt_ * 256, nt_ * 128, 0};
      gemm_tile256<true>(smem, 8, af, bf, ef);
    }
    {
      ARows af{p.odsa + (long)mt_ * 256 * 512, 512, 256};
      BMatT bf{p.w_bdT + (long)nt_ * 128 * 512, 512};
      EpiY ef{p.y, p.proj, mt_ * 256, nt_ * 128, 1};
      gemm_tile256<true>(smem, 8, af, bf, ef);
    }
  }
}
struct EpiStoreBf {
  u16* dst; long ld; int m0, n0;
  template <int MT> DI void operator()(f32x16 (&acc)[MT][2], int wm, int wn, int lane) const {
    SW_FOR { *(uint2*)(dst + (long)(m0 + SW_R) * ld + n0 + SW_C0) = pack4(SW_V(0), SW_V(1), SW_V(2), SW_V(3)); }
  }
};
DI void phase9(const Params& p, char* smem, int bid, int nblk) {
  for (int item = bid; item < 512; item += nblk) {
    const int nt_ = item & 7, mt_ = item >> 3;
    ARows af{p.y + (long)mt_ * 256 * 1024, 1024, 256};
    BMatT bf{p.w_outT + (long)nt_ * 128 * 1024, 1024};
    EpiStoreBf ef{p.z, 1024, mt_ * 256, nt_ * 128};
    gemm_tile256<true>(smem, 16, af, bf, ef);
  }
}

DI void phase10(const Params& p, int bid, int nblk) {
  const int tid = TIDX(), lane = tid & 63, wid = __builtin_amdgcn_readfirstlane(tid >> 6);
  for (int row = bid * 4 + wid; row < NTOK; row += nblk * 4) {
    const int b = row >> 13;
    const float* modb = p.mod + b * 6144;
    float zv[16], xv[16];
    float ss = 0.f;
#pragma unroll
    for (int i = 0; i < 4; ++i) {
      const int col = i * 256 + lane * 4;
      const uint2 u = *(const uint2*)(p.z + (long)row * 1024 + col);
      zv[i * 4 + 0] = lo16(u.x); zv[i * 4 + 1] = hi16(u.x); zv[i * 4 + 2] = lo16(u.y); zv[i * 4 + 3] = hi16(u.y);
      const float4 xx = *(const float4*)(p.x + (long)row * 1024 + col);
      xv[i * 4 + 0] = xx.x; xv[i * 4 + 1] = xx.y; xv[i * 4 + 2] = xx.z; xv[i * 4 + 3] = xx.w;
#pragma unroll
      for (int j = 0; j < 4; ++j) ss += zv[i * 4 + j] * zv[i * 4 + j];
    }
    ss = wave_sum(ss);
    const float r = rsqrtf(ss * (1.f / 1024.f) + 1e-6f);
    float ss2 = 0.f;
#pragma unroll
    for (int i = 0; i < 4; ++i)
#pragma unroll
      for (int j = 0; j < 4; ++j) {
        const int col = i * 256 + lane * 4 + j;
        const float v = xv[i * 4 + j] + modb[2048 + col] * (zv[i * 4 + j] * r * p.g_post_mix[col]);
        xv[i * 4 + j] = v;
        ss2 += v * v;
      }
    ss2 = wave_sum(ss2);
    const float r2 = rsqrtf(ss2 * (1.f / 1024.f) + 1e-6f);
#pragma unroll
    for (int i = 0; i < 4; ++i) {
      const int col = i * 256 + lane * 4;
      *(float4*)(p.x1 + (long)row * 1024 + col) = make_float4(xv[i * 4], xv[i * 4 + 1], xv[i * 4 + 2], xv[i * 4 + 3]);
      float hv[4];
#pragma unroll
      for (int j = 0; j < 4; ++j) hv[j] = xv[i * 4 + j] * r2 * p.g_pre_ffn[col + j] * (1.f + modb[4096 + col + j]) + modb[3072 + col + j];
      uint2 w;
      w.x = pack2(hv[0], hv[1]);
      w.y = pack2(hv[2], hv[3]);
      *(uint2*)(p.h + (long)row * 1024 + col) = w;
    }
  }
}

struct EpiStoreF32 {
  float* dst; long ld; int m0, n0;
  DI void operator()(f32x16 (&acc)[2][2], int wm, int wn, int lane) const {
    constexpr int MT = 2;
    SW_FOR { *(float4*)(dst + (long)(m0 + SW_R) * ld + n0 + SW_C0) = make_float4(SW_V(0), SW_V(1), SW_V(2), SW_V(3)); }
  }
};
DI void phase11(const Params& p, char* smem, int bid, int nblk) {
  for (int item = bid; item < 256; item += nblk) {
    const int nt_ = item & 1, mt_ = item >> 1;
    ARows af{p.h + (long)mt_ * 128 * 1024, 1024, 128};
    BMatT bf{p.routerT + (long)nt_ * 128 * 1024, 1024};
    EpiStoreF32 ef{p.logits, 256, mt_ * 128, nt_ * 128};
    gemm_tile<true, false, true>(smem, 16, 64, af, bf, ef);
  }
}
DI void phase12(const Params& p, int bid, int nblk) {
  const int tid = TIDX(), lane = tid & 63, wid = __builtin_amdgcn_readfirstlane(tid >> 6);
  for (int tok = bid * 4 + wid; tok < NTOK; tok += nblk * 4) {
    const float4 lg = *(const float4*)(p.logits + (long)tok * 256 + lane * 4);
    const float4 rbv = *(const float4*)(p.router_bias + lane * 4);
    float sg[4] = {sigmoidf(lg.x), sigmoidf(lg.y), sigmoidf(lg.z), sigmoidf(lg.w)};
    float sl[4] = {sg[0] + rbv.x, sg[1] + rbv.y, sg[2] + rbv.z, sg[3] + rbv.w};
    float t1 = fmaxf(sl[0], sl[1]), t2 = fminf(sl[0], sl[1]);
#pragma unroll
    for (int j = 2; j < 4; ++j) {
      const float v = sl[j];
      t2 = fmaxf(t2, fminf(t1, v));
      t1 = fmaxf(t1, v);
    }
#define R_MERGE(CTRL)                                                                                                            \
    {                                                                                                                            \
      const float a1 = __int_as_float(__builtin_amdgcn_update_dpp(0, __float_as_int(t1), CTRL, 0xF, 0xF, true));                 \
      const float a2 = __int_as_float(__builtin_amdgcn_update_dpp(0, __float_as_int(t2), CTRL, 0xF, 0xF, true));                 \
      const float n1 = fmaxf(t1, a1);                                                                                            \
      const float n2 = fmaxf(fminf(t1, a1), fmaxf(t2, a2));                                                                      \
      t1 = n1; t2 = n2;                                                                                                          \
    }
    R_MERGE(DPP_QP1) R_MERGE(DPP_QP2) R_MERGE(DPP_RHM)
#undef R_MERGE
    const float gscore = t1 + t2;
    const int grp = lane >> 3;
    int rank = 0;
#pragma unroll
    for (int g2 = 0; g2 < 8; ++g2) {
      const float og = rdlane(gscore, g2 * 8);
      rank += (og > gscore || (og == gscore && g2 < grp)) ? 1 : 0;
    }
    const bool gsel = rank < 4;
    float cv[4];
#pragma unroll
    for (int j = 0; j < 4; ++j) cv[j] = gsel ? sl[j] : -1e30f;
    int my_e = -1; float my_s = 0.f; float ssum = 0.f;
    for (int r = 0; r < 8; ++r) {
      float bv = cv[0]; int bj = 0;
#pragma unroll
      for (int j = 1; j < 4; ++j) if (cv[j] > bv) { bv = cv[j]; bj = j; }
      int be = lane * 4 + bj;
      wave_argmax(bv, be);
      const int wl_ = be >> 2, wj = be & 3;
      const float s0 = rdlane(sg[0], wl_), s1 = rdlane(sg[1], wl_), s2 = rdlane(sg[2], wl_), s3 = rdlane(sg[3], wl_);
      const float bs = wj == 0 ? s0 : (wj == 1 ? s1 : (wj == 2 ? s2 : s3));
      if (wl_ == lane) {
        if (wj == 0) cv[0] = -3e30f; else if (wj == 1) cv[1] = -3e30f; else if (wj == 2) cv[2] = -3e30f; else cv[3] = -3e30f;
      }
      if (lane == r) { my_e = be; my_s = bs; }
      ssum += bs;
    }
    if (lane < 8) {
      const float w = my_s / ssum * 2.5f;
      const int rk = atomicAdd(p.counts + my_e, 1);
      p.eidx[tok * 8 + lane] = my_e;
      p.ewt[tok * 8 + lane] = w;
      p.erank[tok * 8 + lane] = rk;
    }
  }
}
DI void phase14(const Params& p, char* smem, int bid, int nblk) {
  const int tid = TIDX();
  int* s_cnt = (int*)smem;
  int* s_off = s_cnt + 256;
  const int cnt = p.counts[tid];
  s_cnt[tid] = cnt;
  __syncthreads();
  int run = 0, nt = 0, nt2 = 0;
  for (int e = 0; e < tid; ++e) { const int c = s_cnt[e]; run += c; nt += (c + 127) >> 7; nt2 += (c + 255) >> 8; }
  s_off[tid] = run;
  __syncthreads();
  if (bid == 0) {
    p.offs[tid] = run;
    for (int m = 0; m * 256 < cnt; ++m) {
      p.tile2_e[nt2] = tid;
      p.tile2_r0[nt2] = run + m * 256;
      p.tile2_nr[nt2] = (cnt - m * 256) > 256 ? 256 : (cnt - m * 256);
      ++nt2;
    }
    for (int m = 0; m * 128 < cnt; ++m) {
      p.tile_e[nt] = tid;
      p.tile_r0[nt] = run + m * 128;
      p.tile_nr[nt] = (cnt - m * 128) > 128 ? 128 : (cnt - m * 128);
      ++nt;
    }
    if (tid == 255) {
      p.offs[256] = run + cnt;
      for (int m = 0; m < 128; ++m) {
        p.tile_e[nt] = 256;
        p.tile_r0[nt] = 131072 + m * 128;
        p.tile_nr[nt] = 128;
        ++nt;
      }
      p.ntiles[0] = nt;
      for (int m = 0; m < 64; ++m) {
        p.tile2_e[nt2] = 256;
        p.tile2_r0[nt2] = 131072 + m * 256;
        p.tile2_nr[nt2] = 256;
        ++nt2;
      }
      p.ntiles[1] = nt2;
    }
  }
  for (int i = bid * 256 + tid; i < NSLOT; i += nblk * 256) {
    if (i < 131072) {
      const int e = p.eidx[i];
      const int slot = s_off[e] + p.erank[i];
      p.slot_tok[slot] = i >> 3;
      p.slot_wt[slot] = p.ewt[i];
      p.tok_slot[i] = slot;
    } else {
      p.slot_tok[i] = i - 131072;
      p.slot_wt[i] = 1.f;
    }
  }
}

struct AGather {
  const u16* h; const int* slot_tok; int r0, nr;
  DI const u16* operator()(int r) const { return h + (long)slot_tok[r0 + (r < nr ? r : 0)] * 1024; }
};
struct BGateUp {
  const float* wg; long udiff; long ldb; int n0;
  DI const float* operator()(int c4) const {
    const int wn = c4 >> 6, ntl = (c4 >> 5) & 1, j = c4 & 31;
    return wg + (long)ntl * udiff + n0 + wn * 32 + j;
  }
  DI const u16* row(int) const { return nullptr; }
};
struct EpiH {
  u16* H; int r0, nr, n0;
  template <int MT> DI void operator()(f32x16 (&acc)[MT][2], int wm, int wn, int lane) const {
#pragma unroll
    for (int mt = 0; mt < MT; ++mt) {
      const int r = SW_R;
      if (r < nr) {
#pragma unroll
        for (int q4 = 0; q4 < 4; ++q4) {
          float v[4];
#pragma unroll
          for (int j = 0; j < 4; ++j) v[j] = siluf(acc[mt][0][4 * q4 + j]) * acc[mt][1][4 * q4 + j];
          *(uint2*)(H + (long)(r0 + r) * 256 + n0 + wn * 32 + 8 * q4 + 4 * (lane >> 5)) = pack4(v[0], v[1], v[2], v[3]);
        }
      }
    }
  }
};
DI void phase15(const Params& p, char* smem, int bid, int nblk) {
  const int ntl = p.ntiles[1];
  for (int item = bid; item < ntl * 4; item += nblk) {
    const int ti = item >> 2, nt_ = item & 3;
    const int e = p.tile2_e[ti], r0 = p.tile2_r0[ti], nr = p.tile2_nr[ti];
    AGather af{p.h, p.slot_tok, r0, nr};
    const float* wg = e < 256 ? p.w_eg + (long)e * 1024 * 256 : p.w_sg;
    const float* wu = e < 256 ? p.w_eu + (long)e * 1024 * 256 : p.w_su;
    BGateUp bf{wg, (long)(wu - wg), 256, nt_ * 64};
    EpiH ef{p.H, r0, nr, nt_ * 64};
    gemm_tile256<false>(smem, 16, af, bf, ef);
  }
}
struct EpiYexp {
  u16* Y; const float* slot_wt; int r0, nr, n0;
  template <int MT> DI void operator()(f32x16 (&acc)[MT][2], int wm, int wn, int lane) const {
#pragma unroll
    for (int mt = 0; mt < MT; ++mt) {
      const int r = SW_R;
      if (r < nr) {
        const float w = slot_wt[r0 + r];
#pragma unroll
        for (int nt = 0; nt < 2; ++nt)
#pragma unroll
          for (int q4 = 0; q4 < 4; ++q4)
            *(uint2*)(Y + (long)(r0 + r) * 1024 + n0 + SW_C0) = pack4(SW_V(0) * w, SW_V(1) * w, SW_V(2) * w, SW_V(3) * w);
      }
    }
  }
};
DI void phase16(const Params& p, char* smem, int bid, int nblk) {
  const int ntl = p.ntiles[1];
  for (int item = bid; item < ntl * 8; item += nblk) {
    const int ti = item >> 3, nt_ = item & 7;
    const int e = p.tile2_e[ti], r0 = p.tile2_r0[ti], nr = p.tile2_nr[ti];
    ARows af{p.H + (long)r0 * 256, 256, nr};
    const float* wd = e < 256 ? p.w_ed + (long)e * 256 * 1024 : p.w_sd;
    BMat bf{wd + nt_ * 128, 1024, 128};
    EpiYexp ef{p.Y, p.slot_wt, r0, nr, nt_ * 128};
    gemm_tile256<false>(smem, 4, af, bf, ef);
  }
}
DI void phase17(const Params& p, int bid, int nblk) {
  const int tid = TIDX(), lane = tid & 63, wid = __builtin_amdgcn_readfirstlane(tid >> 6);
  for (int row = bid * 4 + wid; row < NTOK; row += nblk * 4) {
    const int b = row >> 13;
    const float* modb = p.mod + b * 6144;
    int slots[9];
#pragma unroll
    for (int k = 0; k < 8; ++k) slots[k] = p.tok_slot[row * 8 + k];
    slots[8] = 131072 + row;
    float yv[16];
#pragma unroll
    for (int j = 0; j < 16; ++j) yv[j] = 0.f;
#pragma unroll
    for (int k = 0; k < 9; ++k) {
#pragma unroll
      for (int i = 0; i < 4; ++i) {
        const uint2 u = *(const uint2*)(p.Y + (long)slots[k] * 1024 + i * 256 + lane * 4);
        yv[i * 4 + 0] += lo16(u.x); yv[i * 4 + 1] += hi16(u.x); yv[i * 4 + 2] += lo16(u.y); yv[i * 4 + 3] += hi16(u.y);
      }
    }
    float ss = 0.f;
#pragma unroll
    for (int j = 0; j < 16; ++j) ss += yv[j] * yv[j];
    ss = wave_sum(ss);
    const float r = rsqrtf(ss * (1.f / 1024.f) + 1e-6f);
#pragma unroll
    for (int i = 0; i < 4; ++i) {
      const int col = i * 256 + lane * 4;
      const float4 xx = *(const float4*)(p.x1 + (long)row * 1024 + col);
      float o[4] = {xx.x, xx.y, xx.z, xx.w};
#pragma unroll
      for (int j = 0; j < 4; ++j) o[j] += modb[5120 + col + j] * (yv[i * 4 + j] * r * p.g_post_ffn[col + j]);
      *(float4*)(p.out + (long)row * 1024 + col) = make_float4(o[0], o[1], o[2], o[3]);
    }
  }
}

__global__ void __launch_bounds__(256, 2) mega(Params p) {
  cg::grid_group grid = cg::this_grid();
  __shared__ __attribute__((aligned(16))) char smem[LDS_BYTES];
  const int bid = blockIdx.x, nblk = gridDim.x;
  if (p.phase_hi == 12345) grid.sync();
  if (threadIdx.x < 4) ((unsigned*)(smem + 73728))[threadIdx.x] = 0u;
  __syncthreads();
  const XcdBarrier xb = xcd_barrier_post(p.bar, (volatile LAS unsigned*)(smem + 73728));
#if !defined(ONLY) || ONLY==0
  if (p.phase_lo <= 0 && 0 < p.phase_hi) {
    phase0(p, smem, bid, nblk);
#if (REPEAT_MASK >> 0) & 1
    xcd_barrier(xb);
    phase0(p, smem, bid, nblk);
#endif
    if (0 + 1 < p.phase_hi) xcd_barrier(xb);
  }
#endif
#if !defined(ONLY) || ONLY==1
  if (p.phase_lo <= 1 && 1 < p.phase_hi) {
    phase1(p, smem, bid, nblk);
#if (REPEAT_MASK >> 1) & 1
    xcd_barrier(xb);
    phase1(p, smem, bid, nblk);
#endif
    if (1 + 1 < p.phase_hi) xcd_barrier(xb);
  }
#endif
#if !defined(ONLY) || ONLY==2
  if (p.phase_lo <= 2 && 2 < p.phase_hi) {
    phase2(p, smem, bid, nblk);
#if (REPEAT_MASK >> 2) & 1
    xcd_barrier(xb);
    phase2(p, smem, bid, nblk);
#endif
    if (2 + 1 < p.phase_hi) xcd_barrier(xb);
  }
#endif
#if !defined(ONLY) || ONLY==3
  if (p.phase_lo <= 3 && 3 < p.phase_hi) {
    phase3(p, smem, bid, nblk);
#if (REPEAT_MASK >> 3) & 1
    xcd_barrier(xb);
    phase3(p, smem, bid, nblk);
#endif
    if (3 + 1 < p.phase_hi) xcd_barrier(xb);
  }
#endif
#if !defined(ONLY) || ONLY==4
  if (p.phase_lo <= 4 && 4 < p.phase_hi) {
    phase4(p, smem, bid, nblk);
#if (REPEAT_MASK >> 4) & 1
    xcd_barrier(xb);
    phase4(p, smem, bid, nblk);
#endif
    if (4 + 1 < p.phase_hi) xcd_barrier(xb);
  }
#endif
#if !defined(ONLY) || ONLY==5
  if (p.phase_lo <= 5 && 5 < p.phase_hi) {
    phase5(p, smem, bid, nblk);
#if (REPEAT_MASK >> 5) & 1
    xcd_barrier(xb);
    phase5(p, smem, bid, nblk);
#endif
    if (5 + 1 < p.phase_hi) xcd_barrier(xb);
  }
#endif
#if !defined(ONLY) || ONLY==7
  if (p.phase_lo <= 7 && 7 < p.phase_hi) {
    phase7(p, smem, bid, nblk);
#if (REPEAT_MASK >> 7) & 1
    xcd_barrier(xb);
    phase7(p, smem, bid, nblk);
#endif
    if (7 + 1 < p.phase_hi) xcd_barrier(xb);
  }
#endif
#if !defined(ONLY) || ONLY==8
  if (p.phase_lo <= 8 && 8 < p.phase_hi) {
    phase8(p, smem, bid, nblk);
#if (REPEAT_MASK >> 8) & 1
    xcd_barrier(xb);
    phase8(p, smem, bid, nblk);
#endif
    if (8 + 1 < p.phase_hi) xcd_barrier(xb);
  }
#endif
#if !defined(ONLY) || ONLY==9
  if (p.phase_lo <= 9 && 9 < p.phase_hi) {
    phase9(p, smem, bid, nblk);
#if (REPEAT_MASK >> 9) & 1
    xcd_barrier(xb);
    phase9(p, smem, bid, nblk);
#endif
    if (9 + 1 < p.phase_hi) xcd_barrier(xb);
  }
#endif
#if !defined(ONLY) || ONLY==10
  if (p.phase_lo <= 10 && 10 < p.phase_hi) {
    phase10(p, bid, nblk);
#if (REPEAT_MASK >> 10) & 1
    xcd_barrier(xb);
    phase10(p, bid, nblk);
#endif
    if (10 + 1 < p.phase_hi) xcd_barrier(xb);
  }
#endif
#if !defined(ONLY) || ONLY==11
  if (p.phase_lo <= 11 && 11 < p.phase_hi) {
    phase11(p, smem, bid, nblk);
#if (REPEAT_MASK >> 11) & 1
    xcd_barrier(xb);
    phase11(p, smem, bid, nblk);
#endif
    if (11 + 1 < p.phase_hi) xcd_barrier(xb);
  }
#endif
#if !defined(ONLY) || ONLY==12
  if (p.phase_lo <= 12 && 12 < p.phase_hi) {
    phase12(p, bid, nblk);
#if (REPEAT_MASK >> 12) & 1
    xcd_barrier(xb);
    phase12(p, bid, nblk);
#endif
    if (12 + 1 < p.phase_hi) xcd_barrier(xb);
  }
#endif
#if !defined(ONLY) || ONLY==14
  if (p.phase_lo <= 14 && 14 < p.phase_hi) {
    phase14(p, smem, bid, nblk);
#if (REPEAT_MASK >> 14) & 1
    xcd_barrier(xb);
    phase14(p, smem, bid, nblk);
#endif
    if (14 + 1 < p.phase_hi) xcd_barrier(xb);
  }
#endif
#if !defined(ONLY) || ONLY==15
  if (p.phase_lo <= 15 && 15 < p.phase_hi) {
    phase15(p, smem, bid, nblk);
#if (REPEAT_MASK >> 15) & 1
    xcd_barrier(xb);
    phase15(p, smem, bid, nblk);
#endif
    if (15 + 1 < p.phase_hi) xcd_barrier(xb);
  }
#endif
#if !defined(ONLY) || ONLY==16
  if (p.phase_lo <= 16 && 16 < p.phase_hi) {
    phase16(p, smem, bid, nblk);
#if (REPEAT_MASK >> 16) & 1
    xcd_barrier(xb);
    phase16(p, smem, bid, nblk);
#endif
    if (16 + 1 < p.phase_hi) xcd_barrier(xb);
  }
#endif
#if !defined(ONLY) || ONLY==17
  if (p.phase_lo <= 17 && 17 < p.phase_hi) {
    phase17(p, bid, nblk);
#if (REPEAT_MASK >> 17) & 1
    xcd_barrier(xb);
    phase17(p, bid, nblk);
#endif
    if (17 + 1 < p.phase_hi) xcd_barrier(xb);
  }
#endif
}

extern "C" void kernel_launch(void* const* d_in, const int* in_sizes, int n_in, void* d_out, int out_size, void* d_ws, size_t ws_size,
                              hipStream_t stream) {
  static int grid_blocks = 0;
  if (!grid_blocks) {
    int dev = 0, cus = 0, per_cu = 0;
    (void)hipGetDevice(&dev);
    (void)hipDeviceGetAttribute(&cus, hipDeviceAttributeMultiprocessorCount, dev);
    (void)hipOccupancyMaxActiveBlocksPerMultiprocessor(&per_cu, mega, 256, 0);
    if (per_cu > 2) per_cu = 2;
    if (per_cu < 1) per_cu = 1;
    grid_blocks = cus * per_cu;
  }
  Params p{};
  const float* const* in = (const float* const*)d_in;
  p.x = in[0]; p.c = in[1]; p.w_ada = in[2]; p.b_ada = in[3]; p.g_pre_mix = in[4]; p.g_post_mix = in[5]; p.g_pre_ffn = in[6]; p.g_post_ffn = in[7];
  p.w_in = in[8]; p.rel_bias = in[9]; p.cmp_pe = in[10]; p.cmp_w1 = in[11]; p.cmp_b1 = in[12]; p.cmp_w2 = in[13]; p.dsa_kv_norm = in[14];
  p.dsa_w_uk = in[15]; p.dsa_w_uv = in[16]; p.w_bn = in[17]; p.w_bd = in[18]; p.w_out = in[19]; p.router_w = in[20]; p.router_bias = in[21];
  p.w_eg = in[22]; p.w_eu = in[23]; p.w_ed = in[24]; p.w_sg = in[25]; p.w_su = in[26]; p.w_sd = in[27];
  p.out = (float*)d_out;
  char* ws = (char*)d_ws;
  size_t off = 0;
  auto alloc = [&](size_t bytes) { char* r = ws + off; off += (bytes + 255) & ~(size_t)255; return r; };
  p.bar = (unsigned*)alloc(XCD_BAR_WORDS * 4);
  p.modp = (float*)alloc(16 * 2 * 6144 * 4);
  p.mod = (float*)alloc(2 * 6144 * 4);
  p.pe_part = (float*)alloc(16 * 256 * 4);
  p.w_ukT = (float*)alloc(8 * 64 * 128 * 4);
  p.w_inT = (u16*)alloc((size_t)4608 * 1024 * 2);
  p.w_bnT = (u16*)alloc((size_t)1024 * 512 * 2);
  p.w_bdT = (u16*)alloc((size_t)1024 * 512 * 2);
  p.w_outT = (u16*)alloc((size_t)1024 * 1024 * 2);
  p.routerT = (u16*)alloc((size_t)256 * 1024 * 2);
  p.counts = (int*)alloc(256 * 4);
  p.offs = (int*)alloc(257 * 4);
  p.tile_e = (int*)alloc(1536 * 4);
  p.tile_r0 = (int*)alloc(1536 * 4);
  p.tile_nr = (int*)alloc(1536 * 4);
  p.ntiles = (int*)alloc(8);
  p.tile2_e = (int*)alloc(1024 * 4);
  p.tile2_r0 = (int*)alloc(1024 * 4);
  p.tile2_nr = (int*)alloc(1024 * 4);
  p.h = (u16*)alloc((size_t)NTOK * 1024 * 2);
  p.proj = (u16*)alloc((size_t)NTOK * LDP * 2);
  p.widx = (float*)alloc((size_t)NTOK * 8 * 4);
  p.zc = (u16*)alloc((size_t)2 * 2048 * 128 * 2);
  p.kc = (u16*)alloc((size_t)4 * 512 * 64 * 2);
  p.vcT = (u16*)alloc((size_t)4 * 512 * 64 * 2);
  p.vts = (u16*)alloc((size_t)4 * 64 * T * 2);
  p.vtw = (u16*)alloc((size_t)4 * 64 * T * 2);
  p.qlat = (u16*)alloc((size_t)NTOK * 1024 * 2);
  p.ckv = (u16*)alloc((size_t)NTOK * 128 * 2);
  p.selk = (int*)alloc((size_t)NTOK * 256 * 4);
  p.onsa = (u16*)alloc((size_t)NTOK * 512 * 2);
  p.olat = (u16*)alloc((size_t)NTOK * 1024 * 2);
  p.odsa = (u16*)alloc((size_t)NTOK * 512 * 2);
  p.y = p.qlat;
  p.z = p.olat;
  p.eidx = (int*)alloc((size_t)NTOK * 8 * 4);
  p.ewt = (float*)alloc((size_t)NTOK * 8 * 4);
  p.erank = (int*)alloc((size_t)NTOK * 8 * 4);
  p.slot_tok = (int*)alloc((size_t)NSLOT * 4);
  p.slot_wt = (float*)alloc((size_t)NSLOT * 4);
  p.tok_slot = (int*)alloc((size_t)NTOK * 8 * 4);
  char* big = alloc((size_t)2 * T * T * 4);
  p.scores = (float*)big;
  {
    size_t o2 = 0;
    auto sub = [&](size_t bytes) { char* r = big + o2; o2 += (bytes + 255) & ~(size_t)255; return r; };
    p.H = (u16*)sub((size_t)NSLOT * 256 * 2);
    p.Y = (u16*)sub((size_t)NSLOT * 1024 * 2);
    p.x1 = (float*)sub((size_t)NTOK * 1024 * 4);
    p.logits = (float*)sub((size_t)NTOK * 256 * 4);
  }
  if (off > ws_size) fprintf(stderr, "workspace too small: need %zu have %zu\n", off, ws_size);
  p.phase_lo = 0;
  p.phase_hi = 18;
  (void)hipMemsetAsync(p.bar, 0, XCD_BAR_WORDS * 4, stream);
  void* args[] = {&p};
  hipError_t e = hipLaunchCooperativeKernel((void*)mega, dim3(grid_blocks), dim3(256), args, 0, stream);
  if (e != hipSuccess) fprintf(stderr, "coop launch failed: %s (grid %d)\n", hipGetErrorString(e), grid_blocks);
}
```

```cpp
#include <hip/hip_runtime.h>
#include <hip/hip_cooperative_groups.h>
#include <cstdio>
namespace cg = cooperative_groups;

#define DI __device__ __forceinline__
typedef unsigned short u16;
typedef unsigned long long u64;
using bf16x8 = __attribute__((ext_vector_type(8))) short;
using f32x16 = __attribute__((ext_vector_type(16))) float;

constexpr int T = 8192;
constexpr int NTOK = 16384;
constexpr int LDP = 4576;
constexpr int C_QN = 0, C_KV = 512, C_GN = 1280, C_QD = 1304, C_CKV = 1816, C_QI = 1944, C_KI = 2456, C_WI = 2520, C_GM = 2528;
constexpr int NSLOT = 131072 + 16384;
constexpr int LDS_BYTES = 73728 + 64;
#ifndef REPEAT_MASK
#define REPEAT_MASK 0
#endif

__device__ const unsigned char BUCKET[128] = {
  0, 1, 2, 3, 4, 5, 6, 7, 8, 9, 10, 11, 12, 13, 14, 15, 16, 16, 16, 17, 17, 18, 18, 18, 19, 19, 19, 20, 20, 20, 20, 21,
  21, 21, 21, 22, 22, 22, 22, 22, 23, 23, 23, 23, 23, 23, 24, 24, 24, 24, 24, 24, 25, 25, 25, 25, 25, 25, 25, 26, 26, 26, 26, 26,
  26, 26, 26, 27, 27, 27, 27, 27, 27, 27, 27, 27, 27, 28, 28, 28, 28, 28, 28, 28, 28, 28, 28, 29, 29, 29, 29, 29, 29, 29, 29, 29,
  29, 29, 29, 30, 30, 30, 30, 30, 30, 30, 30, 30, 30, 30, 30, 30, 30, 31, 31, 31, 31, 31, 31, 31, 31, 31, 31, 31, 31, 31, 31, 31};

struct Params {
  const float *x, *c, *w_ada, *b_ada, *g_pre_mix, *g_post_mix, *g_pre_ffn, *g_post_ffn, *w_in, *rel_bias;
  const float *cmp_pe, *cmp_w1, *cmp_b1, *cmp_w2, *dsa_kv_norm, *dsa_w_uk, *dsa_w_uv, *w_bn, *w_bd, *w_out;
  const float *router_w, *router_bias, *w_eg, *w_eu, *w_ed, *w_sg, *w_su, *w_sd;
  float* out;
  float* modp;
  float* mod;
  float* pe_part;
  float* w_ukT;
  u16 *w_inT, *w_bnT, *w_bdT, *w_outT, *routerT;
  u16* h;
  u16* proj;
  float* widx;
  u16* zc;
  u16* kc;
  u16* vcT;
  u16* vts;
  u16* vtw;
  u16* qlat;
  u16* ckv;
  float* scores;
  int* selk;
  u16* onsa;
  u16* olat;
  u16* odsa;
  u16* y;
  u16* z;
  float* x1;
  float* logits;
  int* eidx;
  float* ewt;
  int* erank;
  int* counts;
  int* offs;
  int* tile_e;
  int* tile_r0;
  int* tile_nr;
  int* ntiles;
  int *tile2_e, *tile2_r0, *tile2_nr;
  int* slot_tok;
  float* slot_wt;
  int* tok_slot;
  u16* H;
  u16* Y;
  unsigned* bar;
  int phase_lo, phase_hi;
};

DI float bf2f(u16 v) { return __uint_as_float(((unsigned)v) << 16); }
typedef __bf16 bf16x2_t __attribute__((ext_vector_type(2)));
typedef float f32x2_t __attribute__((ext_vector_type(2)));
DI unsigned pack2(float a, float b) { f32x2_t v = {a, b}; return __builtin_bit_cast(unsigned, __builtin_convertvector(v, bf16x2_t)); }
DI u16 f2bf(float x) { return (u16)(pack2(x, x) & 0xffffu); }
DI float lo16(unsigned u) { return __uint_as_float(u << 16); }
DI float hi16(unsigned u) { return __uint_as_float(u & 0xffff0000u); }
DI float wave_sum(float v) { for (int o = 32; o; o >>= 1) v += __shfl_xor(v, o); return v; }
DI float wave_max(float v) { for (int o = 32; o; o >>= 1) v = fmaxf(v, __shfl_xor(v, o)); return v; }
#define DPP_QP1 0xB1
#define DPP_QP2 0x4E
#define DPP_RHM 0x141
#define DPP_RM  0x140
#define DPP_B15 0x142
#define DPP_B31 0x143
DI int wave_sum_i(int x) {
  x += __builtin_amdgcn_update_dpp(0, x, DPP_QP1, 0xF, 0xF, true);
  x += __builtin_amdgcn_update_dpp(0, x, DPP_QP2, 0xF, 0xF, true);
  x += __builtin_amdgcn_update_dpp(0, x, DPP_RHM, 0xF, 0xF, true);
  x += __builtin_amdgcn_update_dpp(0, x, DPP_RM, 0xF, 0xF, true);
  x += __builtin_amdgcn_update_dpp(0, x, DPP_B15, 0xA, 0xF, true);
  x += __builtin_amdgcn_update_dpp(0, x, DPP_B31, 0xC, 0xF, true);
  return __builtin_amdgcn_readlane(x, 63);
}
#define DPP_SELF(x, CTRL, RM) ((unsigned)__builtin_amdgcn_update_dpp((int)(x), (int)(x), CTRL, RM, 0xF, false))
DI unsigned wave_max_u(unsigned x) {
  x = max(x, DPP_SELF(x, DPP_QP1, 0xF)); x = max(x, DPP_SELF(x, DPP_QP2, 0xF)); x = max(x, DPP_SELF(x, DPP_RHM, 0xF));
  x = max(x, DPP_SELF(x, DPP_RM, 0xF)); x = max(x, DPP_SELF(x, DPP_B15, 0xA)); x = max(x, DPP_SELF(x, DPP_B31, 0xC));
  return (unsigned)__builtin_amdgcn_readlane((int)x, 63);
}
DI unsigned wave_min_u(unsigned x) {
  x = min(x, DPP_SELF(x, DPP_QP1, 0xF)); x = min(x, DPP_SELF(x, DPP_QP2, 0xF)); x = min(x, DPP_SELF(x, DPP_RHM, 0xF));
  x = min(x, DPP_SELF(x, DPP_RM, 0xF)); x = min(x, DPP_SELF(x, DPP_B15, 0xA)); x = min(x, DPP_SELF(x, DPP_B31, 0xC));
  return (unsigned)__builtin_amdgcn_readlane((int)x, 63);
}
DI void wave_argmax(float& v, int& idx) {
#define AM_STEP(CTRL, RM)                                                                                                   \
  {                                                                                                                         \
    const float ov_ = __int_as_float(__builtin_amdgcn_update_dpp(__float_as_int(v), __float_as_int(v), CTRL, RM, 0xF, false)); \
    const int oi_ = __builtin_amdgcn_update_dpp(idx, idx, CTRL, RM, 0xF, false);                                            \
    const bool tk_ = ov_ > v || (ov_ == v && oi_ < idx);                                                                    \
    v = tk_ ? ov_ : v;                                                                                                      \
    idx = tk_ ? oi_ : idx;                                                                                                  \
  }
  AM_STEP(DPP_QP1, 0xF) AM_STEP(DPP_QP2, 0xF) AM_STEP(DPP_RHM, 0xF) AM_STEP(DPP_RM, 0xF) AM_STEP(DPP_B15, 0xA) AM_STEP(DPP_B31, 0xC)
#undef AM_STEP
  v = __int_as_float(__builtin_amdgcn_readlane(__float_as_int(v), 63));
  idx = __builtin_amdgcn_readlane(idx, 63);
}
DI float rdlane(float v, int l) { return __int_as_float(__builtin_amdgcn_readlane(__float_as_int(v), l)); }
DI int rdlane_i(int v, int l) { return __builtin_amdgcn_readlane(v, l); }
DI int TIDX() { int t = threadIdx.x; asm volatile("" : "+v"(t)); return t; }
DI void cbar(const void* p) { asm volatile("" ::"v"(p) : "memory"); }
DI void wave_sync() { asm volatile("s_waitcnt lgkmcnt(0)" ::: "memory"); __builtin_amdgcn_wave_barrier(); }
DI float sigmoidf(float x) { return 1.f / (1.f + __expf(-x)); }
DI float siluf(float x) { return x / (1.f + __expf(-x)); }
DI float gelu_tanh(float x) { float u = 0.7978845608028654f * (x + 0.044715f * x * x * x); float e = __expf(2.f * u); float th = 1.f - 2.f / (e + 1.f); return 0.5f * x * (1.f + th); }


#define XB_TMO      128
#define XB_XCNT(j)  (256  + 64 * (j))
#define XB_XSUB(j)  (1280 + 64 * (j))
#define XB_XGEN(j)  (2304 + 64 * (j))
#define XB_TOP      3328
#define XB_TOPGEN   3392
#define XCD_BAR_WORDS 3456
#define XB_SPIN_CAP (1u << 22)
#define LAS __attribute__((address_space(3)))
DI unsigned xb_ld(unsigned* p) { return __hip_atomic_load(p, __ATOMIC_RELAXED, __HIP_MEMORY_SCOPE_AGENT); }
DI unsigned xb_add(unsigned* p, unsigned v) { return __hip_atomic_fetch_add(p, v, __ATOMIC_RELAXED, __HIP_MEMORY_SCOPE_AGENT); }
DI unsigned xb_xcc_id() { return (unsigned)__builtin_amdgcn_s_getreg((3 << 11) | 20) & 0xFu; }
#define XB_SPIN(cond, bar) do { unsigned _sp = 0; while (cond) { __builtin_amdgcn_s_sleep(1); \
    if ((++_sp & 255u) == 0u) { if (xb_ld(&(bar)[XB_TMO])) break; if (_sp > XB_SPIN_CAP) { atomicAdd(&(bar)[XB_TMO], 1u); break; } } } } while (0)
struct XcdBarrier { unsigned* bar; unsigned x; volatile LAS unsigned* st; };
DI XcdBarrier xcd_barrier_post(unsigned* bar, volatile LAS unsigned* st) {
  XcdBarrier b; b.bar = bar; b.x = xb_xcc_id(); b.st = st;
  if (threadIdx.x == 0) (void)xb_add(&bar[XB_XCNT(b.x)], 1u);
  return b;
}
DI void xcd_barrier_complete(unsigned* bar, unsigned x, unsigned& nloc, unsigned& nx) {
  const unsigned G = gridDim.x * gridDim.y * gridDim.z;
  unsigned sum, cnt, mine, sp = 0u;
  for (;;) {
    sum = 0u; cnt = 0u; mine = 0u;
#pragma unroll
    for (unsigned j = 0; j < 16; ++j) { const unsigned c = xb_ld(&bar[XB_XCNT(j)]); sum += c; cnt += (c > 0u) ? 1u : 0u; mine = (j == x) ? c : mine; }
    if (sum == G) break;
    __builtin_amdgcn_s_sleep(1);
    if ((++sp & 255u) == 0u) { if (xb_ld(&bar[XB_TMO])) break; if (sp > XB_SPIN_CAP) { atomicAdd(&bar[XB_TMO], 1u); break; } }
  }
  nloc = mine > 0u ? mine : 1u; nx = cnt > 0u ? cnt : 1u;
}
DI void xcd_barrier(const XcdBarrier& b) {
  asm volatile("s_waitcnt vmcnt(0)" ::: "memory");
  __syncthreads();
  if (threadIdx.x == 0) {
    unsigned* bar = b.bar;
    __builtin_amdgcn_s_waitcnt(0);
    unsigned nloc = b.st[0], nx = b.st[1];
    if (nloc == 0u) { xcd_barrier_complete(bar, b.x, nloc, nx); b.st[0] = nloc; b.st[1] = nx; }
    const unsigned old = xb_add(&bar[XB_XSUB(b.x)], 1u);
    const unsigned gen = old / nloc;
    if (old + 1u == (gen + 1u) * nloc) {
      __builtin_amdgcn_fence(__ATOMIC_RELEASE, "agent");
      asm volatile("s_waitcnt vmcnt(0)" ::: "memory");
      const unsigned og = xb_add(&bar[XB_TOP], 1u);
      const unsigned tg = og / nx;
      if (og + 1u == (tg + 1u) * nx) xb_add(&bar[XB_TOPGEN], 1u);
      else XB_SPIN(xb_ld(&bar[XB_TOPGEN]) == tg, bar);
      __builtin_amdgcn_fence(__ATOMIC_ACQUIRE, "agent");
      xb_add(&bar[XB_XGEN(b.x)], 1u);
      asm volatile("s_waitcnt vmcnt(0)" ::: "memory");
    } else {
      XB_SPIN(xb_ld(&bar[XB_XGEN(b.x)]) == gen, bar);
      __builtin_amdgcn_fence(__ATOMIC_ACQUIRE, "agent");
      asm volatile("s_waitcnt vmcnt(0)" ::: "memory");
    }
  }
  __syncthreads();
}

template <bool SWAP = true, bool SINGLE = false, bool BT16 = false, class AF, class BF, class EF>
DI void gemm_tile(char* smem, int nk, long a_kstep, const AF& af, const BF& bf, const EF& ef) {
  asm volatile("" ::: "memory");
  u16* As = (u16*)smem;
  const int tid = TIDX(), lane = tid & 63, wid = __builtin_amdgcn_readfirstlane(tid >> 6), wm = wid >> 1, wn = wid & 1;
  const int arow = tid >> 1, ahalf = tid & 1;
  const u16* ap = af(arow) + ahalf * 32;
  const int bkq = lane & 7, bnq = wid * 8 + (lane >> 3);
  const long ldb = bf.ldb;
  const float* bp = nullptr;
  const u16* bp16 = nullptr;
  if constexpr (BT16) bp16 = bf.row(arow) + ahalf * 32;
  else bp = bf(bnq * 4) + (long)(bkq * 4) * ldb;
  uint4 sa0_0, sa0_1, sa0_2, sa0_3, sa1_0, sa1_1, sa1_2, sa1_3;
  float4 sb0_0, sb0_1, sb0_2, sb0_3, sb0_4, sb0_5, sb0_6, sb0_7, sb1_0, sb1_1, sb1_2, sb1_3, sb1_4, sb1_5, sb1_6, sb1_7;
  uint4 tb0_0, tb0_1, tb0_2, tb0_3, tb1_0, tb1_1, tb1_2, tb1_3;
  f32x16 acc[2][2];
#pragma unroll
  for (int a = 0; a < 2; ++a)
#pragma unroll
    for (int b = 0; b < 2; ++b)
#pragma unroll
      for (int i = 0; i < 16; ++i) acc[a][b][i] = 0.f;

#define GEMM_LOAD(S, KT)                                                                  \
  {                                                                                       \
    const uint4* pa_ = (const uint4*)(ap + (long)(KT) * a_kstep);                         \
    sa##S##_0 = pa_[0]; sa##S##_1 = pa_[1]; sa##S##_2 = pa_[2]; sa##S##_3 = pa_[3];       \
    if constexpr (BT16) {                                                                 \
      const uint4* pt_ = (const uint4*)(bp16 + (long)(KT) * 64);                          \
      tb##S##_0 = pt_[0]; tb##S##_1 = pt_[1]; tb##S##_2 = pt_[2]; tb##S##_3 = pt_[3];     \
    } else {                                                                              \
      const float* pb_ = bp + (long)(KT) * 64 * ldb;                                      \
      sb##S##_0 = *(const float4*)(pb_);                                                  \
      sb##S##_1 = *(const float4*)(pb_ + ldb);                                            \
      sb##S##_2 = *(const float4*)(pb_ + 2 * ldb);                                        \
      sb##S##_3 = *(const float4*)(pb_ + 3 * ldb);                                        \
      sb##S##_4 = *(const float4*)(pb_ + 32 * ldb);                                       \
      sb##S##_5 = *(const float4*)(pb_ + 33 * ldb);                                       \
      sb##S##_6 = *(const float4*)(pb_ + 34 * ldb);                                       \
      sb##S##_7 = *(const float4*)(pb_ + 35 * ldb);                                       \
    }                                                                                     \
  }
#define GEMM_BW(V0, V1, V2, V3, C, I, QOFF)                                               \
  {                                                                                       \
    uint2 w_;                                                                             \
    w_.x = pack2(V0.C, V1.C);                                                             \
    w_.y = pack2(V2.C, V3.C);                                                             \
    *(uint2*)&Bs_[(bnq * 4 + (I)) * 72 + (QOFF) + bkq * 4] = w_;                          \
  }
#define GEMM_STORE(S, BUF)                                                                \
  {                                                                                       \
    u16* As_ = As + (BUF) * (2 * 128 * 72);                                               \
    u16* Bs_ = As_ + 128 * 72;                                                            \
    uint4* da_ = (uint4*)&As_[arow * 72 + ahalf * 32];                                    \
    da_[0] = sa##S##_0; da_[1] = sa##S##_1; da_[2] = sa##S##_2; da_[3] = sa##S##_3;       \
    if constexpr (BT16) {                                                                 \
      uint4* db_ = (uint4*)&Bs_[arow * 72 + ahalf * 32];                                  \
      db_[0] = tb##S##_0; db_[1] = tb##S##_1; db_[2] = tb##S##_2; db_[3] = tb##S##_3;     \
    } else {                                                                              \
      GEMM_BW(sb##S##_0, sb##S##_1, sb##S##_2, sb##S##_3, x, 0, 0)                        \
      GEMM_BW(sb##S##_0, sb##S##_1, sb##S##_2, sb##S##_3, y, 1, 0)                        \
      GEMM_BW(sb##S##_0, sb##S##_1, sb##S##_2, sb##S##_3, z, 2, 0)                        \
      GEMM_BW(sb##S##_0, sb##S##_1, sb##S##_2, sb##S##_3, w, 3, 0)                        \
      GEMM_BW(sb##S##_4, sb##S##_5, sb##S##_6, sb##S##_7, x, 0, 32)                       \
      GEMM_BW(sb##S##_4, sb##S##_5, sb##S##_6, sb##S##_7, y, 1, 32)                       \
      GEMM_BW(sb##S##_4, sb##S##_5, sb##S##_6, sb##S##_7, z, 2, 32)                       \
      GEMM_BW(sb##S##_4, sb##S##_5, sb##S##_6, sb##S##_7, w, 3, 32)                       \
    }                                                                                     \
  }
#define GEMM_COMPUTE(BUF)                                                                 \
  {                                                                                       \
    const u16* Ac = As + (BUF) * (2 * 128 * 72);                                          \
    const u16* Bc = Ac + 128 * 72;                                                        \
    _Pragma("unroll") for (int ks = 0; ks < 4; ++ks) {                                    \
      bf16x8 a[2], b[2];                                                                  \
      _Pragma("unroll") for (int mt = 0; mt < 2; ++mt) a[mt] = *(const bf16x8*)&Ac[(wm * 64 + mt * 32 + (lane & 31)) * 72 + ks * 16 + (lane >> 5) * 8]; \
      _Pragma("unroll") for (int nt = 0; nt < 2; ++nt) b[nt] = *(const bf16x8*)&Bc[(wn * 64 + nt * 32 + (lane & 31)) * 72 + ks * 16 + (lane >> 5) * 8]; \
      _Pragma("unroll") for (int mt = 0; mt < 2; ++mt)                                    \
      _Pragma("unroll") for (int nt = 0; nt < 2; ++nt)                                    \
        acc[mt][nt] = SWAP ? __builtin_amdgcn_mfma_f32_32x32x16_bf16(b[nt], a[mt], acc[mt][nt], 0, 0, 0) \
                           : __builtin_amdgcn_mfma_f32_32x32x16_bf16(a[mt], b[nt], acc[mt][nt], 0, 0, 0); \
    }                                                                                     \
  }
  GEMM_LOAD(0, 0)
  __syncthreads();
  if (SINGLE) {
    GEMM_STORE(0, 0)
    __syncthreads();
    GEMM_COMPUTE(0)
  } else {
    GEMM_LOAD(1, 1)
    GEMM_STORE(0, 0)
    __syncthreads();
    const int last = nk - 1;
    for (int kt = 0; kt < nk; kt += 2) {
      const int k2 = kt + 2 < last ? kt + 2 : last, k3 = kt + 3 < last ? kt + 3 : last;
      GEMM_LOAD(0, k2)
      asm volatile("" ::: "memory");
      GEMM_COMPUTE(0)
      asm volatile("" ::: "memory");
      GEMM_STORE(1, 1)
      __syncthreads();
      GEMM_LOAD(1, k3)
      asm volatile("" ::: "memory");
      GEMM_COMPUTE(1)
      asm volatile("" ::: "memory");
      GEMM_STORE(0, 0)
      __syncthreads();
    }
  }
#undef GEMM_LOAD
#undef GEMM_STORE
#undef GEMM_BW
#undef GEMM_COMPUTE
  ef(acc, wm, wn, lane);
}

template <bool BT16, class AF, class BF, class EF>
DI void gemm_tile256(char* smem, int nk, const AF& af, const BF& bf, const EF& ef) {
  asm volatile("" ::: "memory");
  u16* As = (u16*)smem;
  u16* Bs = As + 256 * 72;
  const int tid = TIDX(), lane = tid & 63, wid = __builtin_amdgcn_readfirstlane(tid >> 6), wm = wid >> 1, wn = wid & 1;
  const int piece = tid & 7, rbase = tid >> 3;
  const u16* abase = af(0);
  int ao0, ao1, ao2, ao3, ao4, ao5, ao6, ao7;
  ao0 = (int)(af(rbase) - abase) + piece * 8;        ao1 = (int)(af(rbase + 32) - abase) + piece * 8;
  ao2 = (int)(af(rbase + 64) - abase) + piece * 8;   ao3 = (int)(af(rbase + 96) - abase) + piece * 8;
  ao4 = (int)(af(rbase + 128) - abase) + piece * 8;  ao5 = (int)(af(rbase + 160) - abase) + piece * 8;
  ao6 = (int)(af(rbase + 192) - abase) + piece * 8;  ao7 = (int)(af(rbase + 224) - abase) + piece * 8;
  const u16* bp16 = nullptr; long bstride = 0;
  const float* bp = nullptr; long ldb = 0;
  const int bkq = lane & 7, bnq = wid * 8 + (lane >> 3);
  if constexpr (BT16) { bp16 = bf.row(rbase) + piece * 8; bstride = bf.ldb * 32; }
  else { ldb = bf.ldb; bp = bf(bnq * 4) + (long)(bkq * 4) * ldb; }
  uint4 ra0, ra1, ra2, ra3, ra4, ra5, ra6, ra7, rb0, rb1, rb2, rb3;
  float4 fb0, fb1, fb2, fb3, fb4, fb5, fb6, fb7;
  f32x16 acc[4][2];
#pragma unroll
  for (int a = 0; a < 4; ++a)
#pragma unroll
    for (int b = 0; b < 2; ++b)
#pragma unroll
      for (int i = 0; i < 16; ++i) acc[a][b][i] = 0.f;
#define G256_LOAD(KT)                                                   \
  {                                                                     \
    const u16* pa_ = abase + (long)(KT) * 64;                           \
    ra0 = *(const uint4*)(pa_ + ao0); ra1 = *(const uint4*)(pa_ + ao1); \
    ra2 = *(const uint4*)(pa_ + ao2); ra3 = *(const uint4*)(pa_ + ao3); \
    ra4 = *(const uint4*)(pa_ + ao4); ra5 = *(const uint4*)(pa_ + ao5); \
    ra6 = *(const uint4*)(pa_ + ao6); ra7 = *(const uint4*)(pa_ + ao7); \
    if constexpr (BT16) {                                               \
      const u16* pb_ = bp16 + (long)(KT) * 64;                          \
      rb0 = *(const uint4*)(pb_);                                       \
      rb1 = *(const uint4*)(pb_ + bstride);                             \
      rb2 = *(const uint4*)(pb_ + 2 * bstride);                         \
      rb3 = *(const uint4*)(pb_ + 3 * bstride);                         \
    } else {                                                            \
      const float* pf_ = bp + (long)(KT) * 64 * ldb;                    \
      fb0 = *(const float4*)(pf_);            fb1 = *(const float4*)(pf_ + ldb);      \
      fb2 = *(const float4*)(pf_ + 2 * ldb);  fb3 = *(const float4*)(pf_ + 3 * ldb);  \
      fb4 = *(const float4*)(pf_ + 32 * ldb); fb5 = *(const float4*)(pf_ + 33 * ldb); \
      fb6 = *(const float4*)(pf_ + 34 * ldb); fb7 = *(const float4*)(pf_ + 35 * ldb); \
    }                                                                   \
  }
#define G256_BW(V0, V1, V2, V3, C, I, QOFF)                             \
  {                                                                     \
    uint2 w_;                                                           \
    w_.x = pack2(V0.C, V1.C);                                           \
    w_.y = pack2(V2.C, V3.C);                                           \
    *(uint2*)&Bs[(bnq * 4 + (I)) * 72 + (QOFF) + bkq * 4] = w_;         \
  }
  G256_LOAD(0)
  const int last = nk - 1;
  for (int kt = 0; kt < nk; ++kt) {
    __syncthreads();
    {
      u16* da = As + rbase * 72 + piece * 8;
      *(uint4*)(da) = ra0;            *(uint4*)(da + 32 * 72) = ra1;  *(uint4*)(da + 64 * 72) = ra2;  *(uint4*)(da + 96 * 72) = ra3;
      *(uint4*)(da + 128 * 72) = ra4; *(uint4*)(da + 160 * 72) = ra5; *(uint4*)(da + 192 * 72) = ra6; *(uint4*)(da + 224 * 72) = ra7;
      if constexpr (BT16) {
        u16* db = Bs + rbase * 72 + piece * 8;
        *(uint4*)(db) = rb0; *(uint4*)(db + 32 * 72) = rb1; *(uint4*)(db + 64 * 72) = rb2; *(uint4*)(db + 96 * 72) = rb3;
      } else {
        G256_BW(fb0, fb1, fb2, fb3, x, 0, 0)  G256_BW(fb0, fb1, fb2, fb3, y, 1, 0)
        G256_BW(fb0, fb1, fb2, fb3, z, 2, 0)  G256_BW(fb0, fb1, fb2, fb3, w, 3, 0)
        G256_BW(fb4, fb5, fb6, fb7, x, 0, 32) G256_BW(fb4, fb5, fb6, fb7, y, 1, 32)
        G256_BW(fb4, fb5, fb6, fb7, z, 2, 32) G256_BW(fb4, fb5, fb6, fb7, w, 3, 32)
      }
    }
    __syncthreads();
    const int kn = kt + 1 < last ? kt + 1 : last;
    G256_LOAD(kn)
    asm volatile("" ::: "memory");
#pragma unroll
    for (int ks = 0; ks < 4; ++ks) {
      bf16x8 a[4], b[2];
#pragma unroll
      for (int mt = 0; mt < 4; ++mt) a[mt] = *(const bf16x8*)&As[(wm * 128 + mt * 32 + (lane & 31)) * 72 + ks * 16 + (lane >> 5) * 8];
#pragma unroll
      for (int nt = 0; nt < 2; ++nt) b[nt] = *(const bf16x8*)&Bs[(wn * 64 + nt * 32 + (lane & 31)) * 72 + ks * 16 + (lane >> 5) * 8];
#pragma unroll
      for (int mt = 0; mt < 4; ++mt)
#pragma unroll
        for (int nt = 0; nt < 2; ++nt) acc[mt][nt] = __builtin_amdgcn_mfma_f32_32x32x16_bf16(b[nt], a[mt], acc[mt][nt], 0, 0, 0);
    }
    asm volatile("" ::: "memory");
  }
#undef G256_LOAD
#undef G256_BW
  ef(acc, wm, wn, lane);
}

#define EPI_FOR                                                   \
  _Pragma("unroll") for (int mt = 0; mt < 2; ++mt)                \
  _Pragma("unroll") for (int nt = 0; nt < 2; ++nt)                \
  _Pragma("unroll") for (int i = 0; i < 16; ++i)
#define EPI_R (wm * 64 + mt * 32 + (i & 3) + 8 * (i >> 2) + 4 * (lane >> 5))
#define EPI_C (wn * 64 + nt * 32 + (lane & 31))
#define SW_FOR                                                    \
  _Pragma("unroll") for (int mt = 0; mt < MT; ++mt)               \
  _Pragma("unroll") for (int nt = 0; nt < 2; ++nt)                \
  _Pragma("unroll") for (int q4 = 0; q4 < 4; ++q4)
#define SW_R (wm * (32 * MT) + mt * 32 + (lane & 31))
#define SW_C0 (wn * 64 + nt * 32 + 8 * q4 + 4 * (lane >> 5))
#define SW_V(j) acc[mt][nt][4 * q4 + (j)]
DI uint2 pack4(float a, float b, float c, float d) { uint2 w; w.x = pack2(a, b); w.y = pack2(c, d); return w; }

struct ARows { const u16* base; long ld; int nrows; DI const u16* operator()(int r) const { return base + (long)(r < nrows ? r : 0) * ld; } };
struct BMat { const float* base; long ldb; int ncols; DI const float* operator()(int c4) const { return base + (c4 < ncols ? c4 : 0); } DI const u16* row(int) const { return nullptr; } };
struct BMatT { const u16* base; long ldb; DI const float* operator()(int) const { return nullptr; } DI const u16* row(int n) const { return base + (long)n * ldb; } };

DI void phase0(const Params& p, char* smem, int bid, int nblk) {
  const int tid = TIDX();
  for (int item = bid; item < 384 + 256 + 16 + 1 + 1728; item += nblk) {
    if (item < 384) {
      const int cc = item % 24, kc = item / 24;
      const int col = cc * 256 + tid;
      float a0 = 0.f, a1 = 0.f;
#pragma unroll 1
      for (int half = 0; half < 2; ++half) {
        const int k0 = kc * 64 + half * 32;
        float w[32];
#pragma unroll
        for (int j = 0; j < 32; ++j) w[j] = p.w_ada[(long)(k0 + j) * 6144 + col];
#pragma unroll
        for (int j = 0; j < 32; ++j) {
          a0 += siluf(p.c[k0 + j]) * w[j];
          a1 += siluf(p.c[1024 + k0 + j]) * w[j];
        }
      }
      p.modp[(kc * 2 + 0) * 6144 + col] = a0;
      p.modp[(kc * 2 + 1) * 6144 + col] = a1;
    } else if (item < 640) {
      const int idx = (item - 384) * 256 + tid;
      const int c = idx & 127, d = (idx >> 7) & 63, h = idx >> 13;
      p.w_ukT[idx] = p.dsa_w_uk[c * 512 + h * 64 + d];
    } else if (item < 656) {
      const int part = item - 640;
      const int slot = tid >> 7, kk = tid & 127;
      float a = 0.f;
      for (int ld = part * 128; ld < part * 128 + 128; ++ld) a += p.cmp_pe[slot * 2048 + ld] * p.cmp_w1[((long)slot * 2048 + ld) * 128 + kk];
      p.pe_part[part * 256 + tid] = a;
    } else if (item == 656) {
      p.counts[tid] = 0;
    } else {
      int it = item - 657;
      const float* W; u16* WT; int K, N, ntn;
      if (it < 1152) { W = p.w_in; WT = p.w_inT; K = 1024; N = LDP; ntn = 72; }
      else if (it < 1280) { it -= 1152; W = p.w_bn; WT = p.w_bnT; K = 512; N = 1024; ntn = 16; }
      else if (it < 1408) { it -= 1280; W = p.w_bd; WT = p.w_bdT; K = 512; N = 1024; ntn = 16; }
      else if (it < 1664) { it -= 1408; W = p.w_out; WT = p.w_outT; K = 1024; N = 1024; ntn = 16; }
      else { it -= 1664; W = p.router_w; WT = p.routerT; K = 1024; N = 256; ntn = 4; }
      const int k0 = (it / ntn) * 64, n0 = (it % ntn) * 64;
      u16* tl = (u16*)smem;
      __syncthreads();
      const int kr = tid >> 4, nq = tid & 15;
#pragma unroll
      for (int ps = 0; ps < 4; ++ps) {
        const int k = kr + 16 * ps, n = n0 + nq * 4;
        float4 v = make_float4(0.f, 0.f, 0.f, 0.f);
        if (n < N) v = *(const float4*)(W + (long)(k0 + k) * N + n);
        tl[(nq * 4 + 0) * 72 + k] = f2bf(v.x);
        tl[(nq * 4 + 1) * 72 + k] = f2bf(v.y);
        tl[(nq * 4 + 2) * 72 + k] = f2bf(v.z);
        tl[(nq * 4 + 3) * 72 + k] = f2bf(v.w);
      }
      __syncthreads();
      const int nr = tid >> 2, piece = tid & 3;
      const uint4 a = *(const uint4*)(tl + nr * 72 + piece * 16);
      const uint4 b = *(const uint4*)(tl + nr * 72 + piece * 16 + 8);
      uint4* dst = (uint4*)(WT + (long)(n0 + nr) * K + k0 + piece * 16);
      dst[0] = a; dst[1] = b;
    }
  }
}

DI void phase1(const Params& p, char* smem, int bid, int nblk) {
  const int tid = TIDX(), lane = tid & 63, wid = __builtin_amdgcn_readfirstlane(tid >> 6);
  float* modl = (float*)smem;
  for (int idx = tid; idx < 4096; idx += 256) {
    const int b = idx >> 11, n = idx & 2047;
    float v = p.b_ada[n];
    for (int kc = 0; kc < 16; ++kc) v += p.modp[(kc * 2 + b) * 6144 + n];
    modl[idx] = v;
  }
  if (bid < 48) {
    const int idx = bid * 256 + tid;
    const int b = idx / 6144, n = idx % 6144;
    float v = p.b_ada[n];
    for (int kc = 0; kc < 16; ++kc) v += p.modp[(kc * 2 + b) * 6144 + n];
    p.mod[idx] = v;
  }
  __syncthreads();
  for (int row = bid * 4 + wid; row < NTOK; row += nblk * 4) {
    const int b = row >> 13;
    const float* xr = p.x + (long)row * 1024;
    float4 v[4];
    float ss = 0.f;
#pragma unroll
    for (int i = 0; i < 4; ++i) {
      v[i] = *(const float4*)(xr + i * 256 + lane * 4);
      ss += v[i].x * v[i].x + v[i].y * v[i].y + v[i].z * v[i].z + v[i].w * v[i].w;
    }
    ss = wave_sum(ss);
    const float r = rsqrtf(ss * (1.f / 1024.f) + 1e-6f);
#pragma unroll
    for (int i = 0; i < 4; ++i) {
      const int col = i * 256 + lane * 4;
      const float4 g = *(const float4*)(p.g_pre_mix + col);
      const float* sh = modl + b * 2048 + col;
      const float* sc = modl + b * 2048 + 1024 + col;
      const float o0 = v[i].x * r * g.x * (1.f + sc[0]) + sh[0];
      const float o1 = v[i].y * r * g.y * (1.f + sc[1]) + sh[1];
      const float o2 = v[i].z * r * g.z * (1.f + sc[2]) + sh[2];
      const float o3 = v[i].w * r * g.w * (1.f + sc[3]) + sh[3];
      uint2 w;
      w.x = pack2(o0, o1);
      w.y = pack2(o2, o3);
      *(uint2*)(p.h + (long)row * 1024 + col) = w;
    }
  }
}

struct EpiProj {
  u16* proj; float* widx; int m0, n0;
  template <int MT> DI void operator()(f32x16 (&acc)[MT][2], int wm, int wn, int lane) const {
    SW_FOR {
      const int r = m0 + SW_R, c = n0 + SW_C0;
      if (c < LDP) {
        float v[4] = {SW_V(0), SW_V(1), SW_V(2), SW_V(3)};
        if (c < C_KV) { for (int j = 0; j < 4; ++j) v[j] *= 0.125f; }
        else if (c < C_GN) {}
        else if (c < C_QD) { for (int j = 0; j < 4; ++j) v[j] = sigmoidf(v[j]); }
        else if (c < C_QI) {}
        else if (c < C_KI) { for (int j = 0; j < 4; ++j) v[j] *= 0.125f; }
        else if (c < C_WI) {}
        else if (c < C_GM) {
          for (int j = 0; j < 4; ++j) v[j] *= 0.35355339059327373f;
          *(float4*)(widx + (long)r * 8 + (c - C_WI)) = make_float4(v[0], v[1], v[2], v[3]);
        } else { for (int j = 0; j < 4; ++j) v[j] = sigmoidf(v[j]); }
        *(uint2*)(proj + (long)r * LDP + c) = pack4(v[0], v[1], v[2], v[3]);
      }
    }
  }
};
struct EpiProjVT {
  u16* vt; int m0;
  DI void operator()(f32x16 (&acc)[2][2], int wm, int wn, int lane) const {
#pragma unroll
    for (int mt = 0; mt < 2; ++mt)
#pragma unroll
      for (int nt = 0; nt < 2; ++nt) {
        const int cc = EPI_C;
#pragma unroll
        for (int q4 = 0; q4 < 4; ++q4) {
          const int r = m0 + wm * 64 + mt * 32 + 8 * q4 + 4 * (lane >> 5);
          const int b = r >> 13, t = r & 8191;
          uint2 w;
          w.x = pack2(acc[mt][nt][q4 * 4 + 0], acc[mt][nt][q4 * 4 + 1]);
          w.y = pack2(acc[mt][nt][q4 * 4 + 2], acc[mt][nt][q4 * 4 + 3]);
          *(uint2*)(vt + ((long)(b * 128 + cc)) * T + t) = w;
        }
      }
  }
};
DI void phase2(const Params& p, char* smem, int bid, int nblk) {
  for (int item = bid; item < 64 * 34 + 256; item += nblk) {
    if (item < 64 * 34) {
      const int mt_ = item / 34, q = item % 34;
      const int nt_ = q < 7 ? q : (q < 8 ? q + 1 : q + 2);
      ARows af{p.h + (long)mt_ * 256 * 1024, 1024, 256};
      BMatT bf{p.w_inT + (long)nt_ * 128 * 1024, 1024};
      EpiProj ef{p.proj, p.widx, mt_ * 256, nt_ * 128};
      gemm_tile256<true>(smem, 16, af, bf, ef);
    } else {
      const int it = item - 64 * 34, mt_ = it >> 1, nt_ = (it & 1) ? 9 : 7;
      ARows af{p.h + (long)mt_ * 128 * 1024, 1024, 128};
      BMatT bf{p.w_inT + (long)nt_ * 128 * 1024, 1024};
      EpiProjVT ef{nt_ == 7 ? p.vts : p.vtw, mt_ * 128};
      gemm_tile<false, false, true>(smem, 16, 64, af, bf, ef);
    }
  }
}

struct ACmp {
  const u16* proj; int slot, m0;
  DI const u16* operator()(int r) const {
    const int R = m0 + r, bg = R >> 9, n = R & 511, b = bg >> 1, g = bg & 1;
    const int nc = n >= 511 ? 510 : n;
    return proj + ((long)b * T + 16 * nc) * LDP + C_KV + slot * 128 + g * 64;
  }
};
struct EpiCmp1 {
  u16* zc; const float* b1; const float* pe_part; int slot, m0;
  DI void operator()(f32x16 (&acc)[2][2], int wm, int wn, int lane) const {
    constexpr int MT = 2;
#pragma unroll
    for (int nt = 0; nt < 2; ++nt)
#pragma unroll
      for (int q4 = 0; q4 < 4; ++q4) {
        const int c = SW_C0;
        float4 bias = *(const float4*)(b1 + slot * 128 + c);
        for (int q = 0; q < 16; ++q) {
          const float4 t = *(const float4*)(pe_part + q * 256 + slot * 128 + c);
          bias.x += t.x; bias.y += t.y; bias.z += t.z; bias.w += t.w;
        }
#pragma unroll
        for (int mt = 0; mt < 2; ++mt) {
          const int R = m0 + SW_R;
          *(uint2*)(zc + ((long)slot * 2048 + R) * 128 + c) =
              pack4(gelu_tanh(SW_V(0) + bias.x), gelu_tanh(SW_V(1) + bias.y), gelu_tanh(SW_V(2) + bias.z), gelu_tanh(SW_V(3) + bias.w));
        }
      }
  }
};
struct EpiQlat {
  u16* qlat; int h, m0;
  DI void operator()(f32x16 (&acc)[2][2], int wm, int wn, int lane) const {
    constexpr int MT = 2;
    SW_FOR {
      const int r = m0 + SW_R, c = SW_C0;
      *(uint2*)(qlat + ((long)r * 8 + h) * 128 + c) = pack4(SW_V(0) * 0.125f, SW_V(1) * 0.125f, SW_V(2) * 0.125f, SW_V(3) * 0.125f);
    }
  }
};
DI void indexer_item(const Params& p, char* smem, int item);
DI void phase3(const Params& p, char* smem, int bid, int nblk) {
  const int tid = TIDX(), lane = tid & 63, wid = __builtin_amdgcn_readfirstlane(tid >> 6);
  if (bid < 32) {
    const int slot = bid >> 4, mt_ = bid & 15;
    ACmp af{p.proj, slot, mt_ * 128};
    BMat bf{p.cmp_w1 + (long)slot * 2048 * 128, 128, 128};
    EpiCmp1 ef{p.zc, p.cmp_b1, p.pe_part, slot, mt_ * 128};
    gemm_tile(smem, 32, LDP, af, bf, ef);
    return;
  }
  for (int item = bid - 32; item < 4160 + 1024 + 512; item += nblk - 32) {
    __syncthreads();
    if (item < 4160) {
      indexer_item(p, smem, item);
    } else if (item < 4160 + 1024) {
      const int it = item - 4160, h = it & 7, mt_ = it >> 3;
      ARows af{p.proj + (long)mt_ * 128 * LDP + C_QD + h * 64, LDP, 128};
      BMat bf{p.w_ukT + h * 64 * 128, 128, 128};
      EpiQlat ef{p.qlat, h, mt_ * 128};
      gemm_tile<true, true>(smem, 1, 64, af, bf, ef);
    } else {
      const int it = item - 4160 - 1024;
      for (int q = 0; q < 8; ++q) {
        const int row = it * 32 + wid * 8 + q;
        const unsigned u = *(const unsigned*)(p.proj + (long)row * LDP + C_CKV + lane * 2);
        const float a = lo16(u), b = hi16(u);
        const float ss = wave_sum(a * a + b * b);
        const float r = rsqrtf(ss * (1.f / 128.f) + 1e-6f);
        *(unsigned*)(p.ckv + (long)row * 128 + lane * 2) = pack2(a * r * p.dsa_kv_norm[lane * 2], b * r * p.dsa_kv_norm[lane * 2 + 1]);
      }
    }
  }
}

struct EpiCmp2 {
  u16* dst; int m0;
  DI void operator()(f32x16 (&acc)[2][2], int wm, int wn, int lane) const {
    constexpr int MT = 2;
    SW_FOR {
      const int R = m0 + SW_R, c = SW_C0;
      if (c < 64) *(uint2*)(dst + (long)R * 64 + c) = pack4(SW_V(0), SW_V(1), SW_V(2), SW_V(3));
    }
  }
};
struct EpiCmp2T {
  u16* dst; int m0;
  DI void operator()(f32x16 (&acc)[2][2], int wm, int wn, int lane) const {
#pragma unroll
    for (int mt = 0; mt < 2; ++mt)
#pragma unroll
      for (int nt = 0; nt < 2; ++nt) {
        const int c = EPI_C;
        if (c < 64) {
#pragma unroll
          for (int q4 = 0; q4 < 4; ++q4) {
            const int R = m0 + wm * 64 + mt * 32 + 8 * q4 + 4 * (lane >> 5);
            const int bg = R >> 9, n = R & 511;
            *(uint2*)(dst + ((long)(bg * 64 + c)) * 512 + n) =
                pack4(acc[mt][nt][q4 * 4 + 0], acc[mt][nt][q4 * 4 + 1], acc[mt][nt][q4 * 4 + 2], acc[mt][nt][q4 * 4 + 3]);
          }
        }
      }
  }
};
DI void indexer_item(const Params& p, char* smem, int item) {
  const int tid = TIDX(), lane = tid & 63, wid = __builtin_amdgcn_readfirstlane(tid >> 6);
  int b = 0, rem = item;
  if (rem >= 2080) { b = 1; rem -= 2080; }
  int qt = (int)((sqrtf(8.f * rem + 1.f) - 1.f) * 0.5f);
  while ((qt + 1) * (qt + 2) / 2 <= rem) ++qt;
  while (qt * (qt + 1) / 2 > rem) --qt;
  const int kt = rem - qt * (qt + 1) / 2;
  const int t0 = qt * 128 + (wid >> 1) * 64, s0 = kt * 128 + (wid & 1) * 64;
  if (s0 > t0 + 63) return;
  float* wl = (float*)smem + wid * 512;
  const float* wsrc = p.widx + ((long)b * T + t0) * 8;
#pragma unroll
  for (int i = 0; i < 8; ++i) wl[i * 64 + lane] = wsrc[i * 64 + lane];
  wave_sync();
  const u16* projb = p.proj + (long)b * T * LDP;
  const int r31 = lane & 31, hf = lane >> 5;
  u16* Kt = (u16*)(smem + 8192) + wid * (64 * 72);
  {
    const int piece = lane & 7, rb = lane >> 3;
#pragma unroll
    for (int i = 0; i < 8; ++i) {
      const uint4 v = *(const uint4*)(projb + (long)(s0 + rb + 8 * i) * LDP + C_KI + piece * 8);
      *(uint4*)(Kt + (rb + 8 * i) * 72 + piece * 8) = v;
    }
  }
  wave_sync();
  const u16* kfrag = Kt + r31 * 72 + hf * 8;
  f32x16 sum[2][2];
#pragma unroll
  for (int a = 0; a < 2; ++a)
#pragma unroll
    for (int c = 0; c < 2; ++c)
#pragma unroll
      for (int i = 0; i < 16; ++i) sum[a][c][i] = 0.f;
  const u16* qbase = projb + (long)(t0 + r31) * LDP + C_QI + hf * 8;
  bf16x8 af0[4], af1[4], af2[4], af3[4];
#define IDX_LOADQ(DST, STEP)                                                                            \
  {                                                                                                     \
    const int st_ = (STEP) < 15 ? (STEP) : 15;                                                          \
    _Pragma("unroll") for (int ks = 0; ks < 4; ++ks) DST[ks] = *(const bf16x8*)(qbase + (long)(st_ & 1) * 32 * LDP + (st_ >> 1) * 64 + ks * 16); \
  }
#define IDX_STEP(SRC, MT, H)                                                                            \
  {                                                                                                     \
    const float w_ = wl[((MT) * 32 + r31) * 8 + (H)];                                                   \
    _Pragma("unroll") for (int nt = 0; nt < 2; ++nt) {                                                  \
      f32x16 acc;                                                                                       \
      _Pragma("unroll") for (int i = 0; i < 16; ++i) acc[i] = 0.f;                                      \
      _Pragma("unroll") for (int ks = 0; ks < 4; ++ks) acc = __builtin_amdgcn_mfma_f32_32x32x16_bf16(*(const bf16x8*)(kfrag + nt * 32 * 72 + ks * 16), SRC[ks], acc, 0, 0, 0); \
      _Pragma("unroll") for (int i = 0; i < 16; ++i) sum[MT][nt][i] += w_ * fmaxf(acc[i], 0.f);        \
    }                                                                                                   \
  }
  IDX_LOADQ(af0, 0) IDX_LOADQ(af1, 1) IDX_LOADQ(af2, 2)
#pragma unroll 1
  for (int s4 = 0; s4 < 16; s4 += 4) {
    IDX_LOADQ(af3, s4 + 3)
    asm volatile("" ::: "memory");
    IDX_STEP(af0, 0, s4 >> 1)
    asm volatile("" ::: "memory");
    IDX_LOADQ(af0, s4 + 4)
    asm volatile("" ::: "memory");
    IDX_STEP(af1, 1, s4 >> 1)
    asm volatile("" ::: "memory");
    IDX_LOADQ(af1, s4 + 5)
    asm volatile("" ::: "memory");
    IDX_STEP(af2, 0, (s4 >> 1) + 1)
    asm volatile("" ::: "memory");
    IDX_LOADQ(af2, s4 + 6)
    asm volatile("" ::: "memory");
    IDX_STEP(af3, 1, (s4 >> 1) + 1)
    asm volatile("" ::: "memory");
  }
#undef IDX_LOADQ
#undef IDX_STEP
#pragma unroll
  for (int mt = 0; mt < 2; ++mt)
#pragma unroll
    for (int nt = 0; nt < 2; ++nt)
#pragma unroll
      for (int q4 = 0; q4 < 4; ++q4)
      {
        typedef _Float16 h4_t __attribute__((ext_vector_type(4)));
        typedef float f4_t __attribute__((ext_vector_type(4)));
        const f4_t v4 = {sum[mt][nt][4 * q4], sum[mt][nt][4 * q4 + 1], sum[mt][nt][4 * q4 + 2], sum[mt][nt][4 * q4 + 3]};
        *(h4_t*)((u16*)p.scores + ((long)b * T + t0 + mt * 32 + r31) * T + s0 + nt * 32 + 8 * q4 + 4 * hf) = __builtin_convertvector(v4, h4_t);
      }
}
DI void topk_row(const Params& p, int b, int t, int lane);
DI void phase4(const Params& p, char* smem, int bid, int nblk) {
  if (bid < 32) {
    const int slot = bid >> 4, mt_ = bid & 15;
    ARows af{p.zc + ((long)slot * 2048 + mt_ * 128) * 128, 128, 128};
    BMat bf{p.cmp_w2 + slot * 128 * 64, 64, 64};
    if (slot) { EpiCmp2T ef{p.vcT, mt_ * 128}; gemm_tile<false>(smem, 2, 64, af, bf, ef); }
    else { EpiCmp2 ef{p.kc, mt_ * 128}; gemm_tile(smem, 2, 64, af, bf, ef); }
  }
  const int tid = TIDX(), lane = tid & 63, wid = __builtin_amdgcn_readfirstlane(tid >> 6);
  for (int item = bid; item < 2048; item += nblk) {
    const int it = item < 1024 ? 2047 - item : item - 1024;
    const int b = it & 1, tb = it >> 1;
#pragma unroll 1
    for (int q = 0; q < 2; ++q) {
      asm volatile("" ::: "memory");
      topk_row(p, b, tb * 8 + wid * 2 + q, lane);
    }
  }
}

using f32x4 = __attribute__((ext_vector_type(4))) float;
#define MFMA16(a, b, c) __builtin_amdgcn_mfma_f32_16x16x32_bf16((a), (b), (c), 0, 0, 0)
#define MFMA32(a, b, c) __builtin_amdgcn_mfma_f32_32x32x16_bf16((a), (b), (c), 0, 0, 0)

constexpr int NSA_STAGE_BYTES = 64 * 72 * 2 + 64 * 68 * 2;
DI void dense_scores(f32x16 (&acc)[2], const u16* Ks, const bf16x8 (&qf)[4], int lane) {
  const int r = lane & 31, hf = lane >> 5;
  bf16x8 kf[2][4];
#pragma unroll
  for (int tile = 0; tile < 2; ++tile)
#pragma unroll
    for (int ks = 0; ks < 4; ++ks) kf[tile][ks] = *(const bf16x8*)(Ks + (32 * tile + r) * 72 + 8 * hf + 16 * ks);
  asm volatile("" ::: "memory");
#pragma unroll
  for (int tile = 0; tile < 2; ++tile) {
    f32x16 c;
#pragma unroll
    for (int i = 0; i < 16; ++i) c[i] = 0.f;
#pragma unroll
    for (int ks = 0; ks < 4; ++ks) c = MFMA32(kf[tile][ks], qf[ks], c);
    acc[tile] = c;
  }
}
DI void dense_pv(const f32x16 (&acc)[2], const u16* Vs, int lane, f32x16 (&o)[2]) {
  const int r = lane & 31, hf = lane >> 5;
  uint2 vlo[2][2][2], vhi[2][2][2];
#pragma unroll
  for (int tile = 0; tile < 2; ++tile)
#pragma unroll
    for (int s = 0; s < 2; ++s)
#pragma unroll
      for (int dt = 0; dt < 2; ++dt) {
        const u16* vp = Vs + (32 * dt + r) * 68 + 32 * tile + 16 * s + 4 * hf;
        vlo[tile][s][dt] = *(const uint2*)vp;
        vhi[tile][s][dt] = *(const uint2*)(vp + 8);
      }
  asm volatile("" ::: "memory");
#pragma unroll
  for (int tile = 0; tile < 2; ++tile)
#pragma unroll
    for (int s = 0; s < 2; ++s) {
      uint4 w;
      w.x = pack2(acc[tile][8 * s + 0], acc[tile][8 * s + 1]);
      w.y = pack2(acc[tile][8 * s + 2], acc[tile][8 * s + 3]);
      w.z = pack2(acc[tile][8 * s + 4], acc[tile][8 * s + 5]);
      w.w = pack2(acc[tile][8 * s + 6], acc[tile][8 * s + 7]);
      const bf16x8 pb = __builtin_bit_cast(bf16x8, w);
#pragma unroll
      for (int dt = 0; dt < 2; ++dt) {
        uint4 a;
        a.x = vlo[tile][s][dt].x; a.y = vlo[tile][s][dt].y; a.z = vhi[tile][s][dt].x; a.w = vhi[tile][s][dt].y;
        o[dt] = MFMA32(__builtin_bit_cast(bf16x8, a), pb, o[dt]);
      }
    }
}
constexpr float LOG2E = 1.4426950408889634f;
template <int DSTEP>
DI float dense_mask(f32x16 (&acc)[2], bool active, int lo_c, int hi_c, int dist0_c, int dmin_u, const float* btab_h, int lane) {
  const int hf = lane >> 5;
  const bool colfull = !active || (lo_c <= 0 && hi_c >= 63);
  float mx = -INFINITY;
  if (dmin_u >= 128 && __ballot(colfull) == ~0ull) {
    const float be = active ? btab_h[128] : -INFINITY;
#pragma unroll
    for (int tile = 0; tile < 2; ++tile)
#pragma unroll
      for (int i = 0; i < 16; ++i) {
        const float sv = fmaf(acc[tile][i], LOG2E, be);
        acc[tile][i] = sv;
        mx = fmaxf(mx, sv);
      }
  } else {
    const int lo2 = active ? lo_c : 1, hi2 = active ? hi_c : 0;
#pragma unroll
    for (int tile = 0; tile < 2; ++tile)
#pragma unroll
      for (int i = 0; i < 16; ++i) {
        const int kl = 32 * tile + (i & 3) + 8 * (i >> 2) + 4 * hf;
        int dc = dist0_c - DSTEP * kl;
        dc = dc < 0 ? 0 : (dc > 128 ? 128 : dc);
        const float bias = btab_h[dc];
        const float s2 = fmaf(acc[tile][i], LOG2E, bias);
        const float sv = (kl >= lo2 && kl <= hi2) ? s2 : -INFINITY;
        acc[tile][i] = sv;
        mx = fmaxf(mx, sv);
      }
  }
  return fmaxf(mx, __shfl_xor(mx, 32));
}
DI void dense_chunk(const u16* Ks, const u16* Vs, bool active, int lo_c, int hi_c, int dist0_c, int dmin_u, const bf16x8 (&qf)[4],
                    const float* btab_h, int lane, float& m, float& l, f32x16 (&o)[2]) {
  f32x16 acc[2];
  dense_scores(acc, Ks, qf, lane);
  const float mx = dense_mask<1>(acc, active, lo_c, hi_c, dist0_c, dmin_u, btab_h, lane);
  const float mn = fmaxf(m, mx);
  const float alpha = __builtin_amdgcn_exp2f(m - mn);
  float ls = 0.f;
#pragma unroll
  for (int tile = 0; tile < 2; ++tile)
#pragma unroll
    for (int i = 0; i < 16; ++i) {
      const float pv = __builtin_amdgcn_exp2f(acc[tile][i] - mn);
      acc[tile][i] = pv;
      ls += pv;
    }
  ls += __shfl_xor(ls, 32);
  l = l * alpha + ls;
  m = mn;
  o[0] *= alpha;
  o[1] *= alpha;
  dense_pv(acc, Vs, lane, o);
}

template <int KSG, int VSG, bool NEEDV, class Next, class Body>
DI void chunk_pipeline(char* stage, const u16* kg0, const u16* vg0, int first, int tid, const Next& next, const Body& body) {
  const int srow = tid >> 2, spiece = tid & 3;
  uint4 rk0, rk1, rv0, rv1;
  rv0 = rv1 = make_uint4(0, 0, 0, 0);
  int d = first;
#define NSA_GLOAD(D)                                                                      \
  {                                                                                       \
    const uint4* pk_ = (const uint4*)(kg0 + ((long)(D) * 64 + srow) * KSG + spiece * 16); \
    rk0 = pk_[0]; rk1 = pk_[1];                                                           \
    if (NEEDV) {                                                                          \
      const uint4* pv_ = (const uint4*)(vg0 + (long)srow * VSG + (D) * 64 + spiece * 16); \
      rv0 = pv_[0]; rv1 = pv_[1];                                                         \
    }                                                                                     \
  }
  if (d >= 0) NSA_GLOAD(d)
  int ph = 0;
  __syncthreads();
  while (d >= 0) {
    u16* Ks = (u16*)(stage + ph * NSA_STAGE_BYTES);
    u16* Vs = Ks + 64 * 72;
    *(uint4*)(Ks + srow * 72 + spiece * 16) = rk0;
    *(uint4*)(Ks + srow * 72 + spiece * 16 + 8) = rk1;
    if (NEEDV) {
      uint2* dv = (uint2*)(Vs + srow * 68 + spiece * 16);
      dv[0] = make_uint2(rv0.x, rv0.y); dv[1] = make_uint2(rv0.z, rv0.w);
      dv[2] = make_uint2(rv1.x, rv1.y); dv[3] = make_uint2(rv1.z, rv1.w);
    }
    const int dn = next(d);
    if (dn >= 0) NSA_GLOAD(dn)
    __syncthreads();
    body(d, Ks, Vs);
    ph ^= 1;
    d = dn;
  }
#undef NSA_GLOAD
}

DI void nsa_item(const Params& p, char* smem, int item) {
  const int tid = TIDX(), lane = tid & 63, wid = __builtin_amdgcn_readfirstlane(tid >> 6);
  const int chunk = item & 255, g = (item >> 8) & 1, b = item >> 9;
  const int bg = b * 2 + g;
  float* btab = (float*)smem;
  u64* wun = (u64*)(smem + 2304);
  float* imps = (float*)(smem + 4096) + wid * 1056;
  char* stage = smem + 21504;
  for (int idx = tid; idx < 4 * 129; idx += 256) {
    const int h = idx / 129, d = idx % 129;
    const int bk = d < 128 ? BUCKET[d] : 31;
    btab[h * 132 + d] = p.rel_bias[bk * 16 + g * 4 + h] * LOG2E;
  }
  __syncthreads();
  const int t0 = chunk * 32;
  const int tw = t0 + wid * 8;
  const int c = lane & 31, hf = lane >> 5, qi = c >> 2, hh = c & 3;
  const int t_c = tw + qi;
  const int cur = t0 >> 6;
  const long row = (long)b * T + t_c;
  const u16* prow = p.proj + row * LDP;
  const u16* projb = p.proj + (long)b * T * LDP;
  const float* btab_h = btab + hh * 132;
  bf16x8 qf[4];
#pragma unroll
  for (int ks = 0; ks < 4; ++ks) qf[ks] = *(const bf16x8*)(prow + C_QN + (g * 4 + hh) * 64 + ks * 16 + hf * 8);
  const u16* gptr = prow + C_GN + (g * 4 + hh) * 3;
  for (int k = lane; k < 1056; k += 64) imps[k] = 0.f;
  u16* orow = p.onsa + row * 512 + (g * 4 + hh) * 64 + 4 * hf;
  auto emit = [&](const f32x16 (&o)[2], float sc, bool first) {
#pragma unroll
    for (int dt = 0; dt < 2; ++dt)
#pragma unroll
      for (int q4 = 0; q4 < 4; ++q4) {
        uint2* dst = (uint2*)(orow + 32 * dt + 8 * q4);
        float v0 = o[dt][4 * q4 + 0] * sc, v1 = o[dt][4 * q4 + 1] * sc, v2 = o[dt][4 * q4 + 2] * sc, v3 = o[dt][4 * q4 + 3] * sc;
        if (!first) {
          const uint2 u = *dst;
          v0 += lo16(u.x); v1 += hi16(u.x); v2 += lo16(u.y); v3 += hi16(u.y);
        }
        uint2 w;
        w.x = pack2(v0, v1);
        w.y = pack2(v2, v3);
        *dst = w;
      }
  };
  const int ncv_c = (t_c >= 31) ? ((t_c - 31) >> 4) + 1 : 0;
  const int ncv_max = (t0 + 31 >= 31) ? ((t0 + 31 - 31) >> 4) + 1 : 0;
  const int nchunk_c = (ncv_max + 63) >> 6;
  {
    const u16* kcb = p.kc + (long)bg * 512 * 64;
    const u16* vcb = p.vcT + (long)bg * 64 * 512;
    float m = -1e30f, l = 0.f;
    auto next_c = [&](int d) { return d + 1 < nchunk_c ? d + 1 : -1; };
    chunk_pipeline<64, 512, false>(stage, kcb, vcb, 0, tid, next_c, [&](int i, const u16* Ks, const u16* Vs) {
      f32x16 acc[2];
      dense_scores(acc, Ks, qf, lane);
      const float mx = dense_mask<16>(acc, true, 0, ncv_c - 1 - i * 64, t_c - 31 - 1024 * i, tw - 31 - 1024 * i - 1008, btab_h, lane);
      const float mn = fmaxf(m, mx);
      float ls = 0.f;
#pragma unroll
      for (int tile = 0; tile < 2; ++tile)
#pragma unroll
        for (int q = 0; q < 16; ++q) ls += __builtin_amdgcn_exp2f(acc[tile][q] - mn);
      ls += __shfl_xor(ls, 32);
      l = l * __builtin_amdgcn_exp2f(m - mn) + ls;
      m = mn;
    });
    const float invl = 1.f / fmaxf(l, 1e-30f);
    f32x16 oc[2];
#pragma unroll
    for (int i = 0; i < 16; ++i) { oc[0][i] = 0.f; oc[1][i] = 0.f; }
    chunk_pipeline<64, 512, true>(stage, kcb, vcb, 0, tid, next_c, [&](int i, const u16* Ks, const u16* Vs) {
      f32x16 acc[2];
      dense_scores(acc, Ks, qf, lane);
      (void)dense_mask<16>(acc, true, 0, ncv_c - 1 - i * 64, t_c - 31 - 1024 * i, tw - 31 - 1024 * i - 1008, btab_h, lane);
      float part[2][4], spill[2][4];
#pragma unroll
      for (int tile = 0; tile < 2; ++tile) {
#pragma unroll
        for (int q = 0; q < 16; ++q) acc[tile][q] = __builtin_amdgcn_exp2f(acc[tile][q] - m) * invl;
#pragma unroll
        for (int q4 = 0; q4 < 4; ++q4) {
          float pa = acc[tile][4 * q4] + acc[tile][4 * q4 + 1] + acc[tile][4 * q4 + 2] + 0.5f * acc[tile][4 * q4 + 3];
          float sp = 0.5f * acc[tile][4 * q4 + 3];
          pa += __shfl_xor(pa, 1); pa += __shfl_xor(pa, 2);
          sp += __shfl_xor(sp, 1); sp += __shfl_xor(sp, 2);
          part[tile][q4] = pa; spill[tile][q4] = sp;
        }
      }
      if (hh == 0) {
#pragma unroll
        for (int tile = 0; tile < 2; ++tile)
#pragma unroll
          for (int q4 = 0; q4 < 4; ++q4) imps[qi * 132 + 16 * i + 8 * tile + 2 * q4 + hf] += part[tile][q4];
      }
      wave_sync();
      if (hh == 0) {
#pragma unroll
        for (int tile = 0; tile < 2; ++tile)
#pragma unroll
          for (int q4 = 0; q4 < 4; ++q4) imps[qi * 132 + 16 * i + 8 * tile + 2 * q4 + hf + 1] += spill[tile][q4];
      }
      wave_sync();
      dense_pv(acc, Vs, lane, oc);
    });
    emit(oc, bf2f(gptr[0]), true);
  }
  wave_sync();
  u64 my0 = 0, my1 = 0, wu0 = 0, wu1 = 0;
  for (int q = 0; q < 8; ++q) {
    u64 mask0, mask1;
    if (cur <= 15) {
      mask0 = (2ull << cur) - 1ull;
      mask1 = 0ull;
    } else {
      const float imp_lo = imps[q * 132 + lane], imp_hi = imps[q * 132 + lane + 64];
      const int jl = lane, jh = lane + 64;
      float c0 = (jl >= 1 && jl <= cur - 2) ? imp_lo : -1.f;
      float c1 = (jh <= cur - 2) ? imp_hi : -1.f;
      bool sel_lo = (jl == 0) || (jl == cur) || (jl == cur - 1);
      bool sel_hi = (jh == cur) || (jh == cur - 1);
      for (int r = 0; r < 13; ++r) {
        float bv; int bj;
        if (c0 >= c1) { bv = c0; bj = jl; } else { bv = c1; bj = jh; }
        wave_argmax(bv, bj);
        if (bj == jl) { sel_lo = true; c0 = -1.f; }
        if (bj == jh) { sel_hi = true; c1 = -1.f; }
      }
      mask0 = __ballot(sel_lo);
      mask1 = __ballot(sel_hi);
    }
    if (qi == q) { my0 = mask0; my1 = mask1; }
    wu0 |= mask0; wu1 |= mask1;
  }
  if (lane == 0) { wun[wid * 2] = wu0; wun[wid * 2 + 1] = wu1; }
  __syncthreads();
  u64 bu0 = wun[0] | wun[2] | wun[4] | wun[6], bu1 = wun[1] | wun[3] | wun[5] | wun[7];
  bu0 = ((u64)(unsigned)__builtin_amdgcn_readfirstlane((int)(bu0 >> 32)) << 32) | (unsigned)__builtin_amdgcn_readfirstlane((int)bu0);
  bu1 = ((u64)(unsigned)__builtin_amdgcn_readfirstlane((int)(bu1 >> 32)) << 32) | (unsigned)__builtin_amdgcn_readfirstlane((int)bu1);
  {
    float m = -1e30f, l = 0.f;
    f32x16 o[2];
#pragma unroll
    for (int i = 0; i < 16; ++i) { o[0][i] = 0.f; o[1][i] = 0.f; }
    const int kcol = C_KV + 2 * 128 + g * 64;
    auto next_s = [&](int j) {
      ++j;
      if (j < 64) {
        const u64 mm = bu0 & (~0ull << j);
        if (mm) return (int)__builtin_ctzll(mm);
        j = 64;
      }
      if (j >= 128) return -1;
      const u64 mm = bu1 & (~0ull << (j - 64));
      return mm ? 64 + (int)__builtin_ctzll(mm) : -1;
    };
    chunk_pipeline<LDP, T, true>(stage, projb + kcol, p.vts + (long)bg * 64 * T, 0, tid, next_s, [&](int j, const u16* Ks, const u16* Vs) {
      const bool bit = ((j < 64 ? (my0 >> j) : (my1 >> (j - 64))) & 1ull) != 0;
      if (__ballot(bit) != 0ull) {
        const int pos0 = 64 * j;
        dense_chunk(Ks, Vs, bit, 0, t_c - pos0, t_c - pos0, tw - pos0 - 63, qf, btab_h, lane, m, l, o);
      }
    });
    emit(o, bf2f(gptr[1]) / fmaxf(l, 1e-30f), false);
  }
  {
    float m = -1e30f, l = 0.f;
    f32x16 o[2];
#pragma unroll
    for (int i = 0; i < 16; ++i) { o[0][i] = 0.f; o[1][i] = 0.f; }
    const int kcol = C_KV + 4 * 128 + g * 64;
    const int wlo_c = t_c - 511 < 0 ? 0 : t_c - 511;
    const int wlo_min = t0 - 511 < 0 ? 0 : t0 - 511;
    auto next_w = [&](int j) { return j + 1 <= cur ? j + 1 : -1; };
    chunk_pipeline<LDP, T, true>(stage, projb + kcol, p.vtw + (long)bg * 64 * T, wlo_min >> 6, tid, next_w, [&](int jw, const u16* Ks, const u16* Vs) {
      const int pos0 = 64 * jw;
      const int lo_c = wlo_c - pos0 < 0 ? 0 : wlo_c - pos0;
      dense_chunk(Ks, Vs, true, lo_c, t_c - pos0, t_c - pos0, tw - pos0 - 63, qf, btab_h, lane, m, l, o);
    });
    emit(o, bf2f(gptr[2]) / fmaxf(l, 1e-30f), false);
  }
}

DI unsigned f2ord(float v) { const unsigned u = __float_as_uint(v); return (u & 0x80000000u) ? ~u : (u | 0x80000000u); }

DI void topk_row(const Params& p, int b, int t, int lane) {
  const long row = (long)b * T + t;
  int* dst = p.selk + row * 256;
  if (t < 256) {
#pragma unroll
    for (int i = 0; i < 4; ++i) { const int s = i * 64 + lane; dst[s] = (s <= t) ? s : -1; }
    return;
  }
  const u16* srow = (const u16*)p.scores + row * T;
  const int ngrp = (t >> 10) + 1;
  unsigned u[128];
  int ln = lane;
  asm volatile("" : "+v"(ln));
#pragma unroll
  for (int gq = 0; gq < 8; ++gq) {
    if (gq < ngrp) {
#pragma unroll
      for (int j = 0; j < 16; ++j) {
        const int s = (gq * 16 + j) * 64 + ln;
        u[gq * 16 + j] = srow[s < t ? s : t];
      }
    } else {
#pragma unroll
      for (int j = 0; j < 16; ++j) u[gq * 16 + j] = 0u;
    }
  }
  asm volatile("" ::: "memory");
#pragma unroll
  for (int gq = 0; gq < 8; ++gq) {
    if (gq < ngrp) {
#pragma unroll
      for (int j = 0; j < 16; ++j) {
        const int s = (gq * 16 + j) * 64 + ln;
        { const unsigned h_ = u[gq * 16 + j]; u[gq * 16 + j] = (s <= t) ? ((h_ & 0x8000u) ? (~h_ & 0xFFFFu) : (h_ | 0x8000u)) : 0u; }
      }
    }
  }
  const int nlane = 16 * ngrp;
  unsigned m0 = 0u, m1 = 0u, m2 = 0u, m3 = 0u;
#pragma unroll
  for (int gq = 0; gq < 8; ++gq) {
    if (gq < ngrp) {
#pragma unroll
      for (int j = 0; j < 16; j += 4) {
        m0 = max(m0, u[gq * 16 + j]); m1 = max(m1, u[gq * 16 + j + 1]); m2 = max(m2, u[gq * 16 + j + 2]); m3 = max(m3, u[gq * 16 + j + 3]);
      }
    }
  }
  unsigned lo = wave_min_u(min(min(m0, m1), min(m2, m3)));
  unsigned hi = wave_max_u(max(max(m0, m1), max(m2, m3))) + 1u;
#define TOPK_COUNT_GE(PIV, OUT)                                                         \
  {                                                                                     \
    unsigned below_ = 0;     \
    _Pragma("unroll") for (int gq = 0; gq < 8; ++gq) {                                  \
      if (gq < ngrp) {                                                                  \
        _Pragma("unroll") for (int j = 0; j < 16; ++j) below_ += (u[gq * 16 + j] - (PIV)) >> 31; \
      }                                                                                 \
    }                                                                                   \
    OUT = wave_sum_i(nlane - (int)below_);                                              \
  }
  int c_lo, c_hi = 0;
  TOPK_COUNT_GE(lo, c_lo)
  int iter = 0;
  while (c_lo != 256 && hi - lo > 1u) {
    const unsigned span = hi - lo;
    unsigned step;
    if ((++iter & 3) == 0) step = span >> 1;
    else step = (unsigned)((float)span * ((float)(c_lo - 256) / (float)(c_lo - c_hi)));
    step = step < 1u ? 1u : (step > span - 1u ? span - 1u : step);
    const unsigned piv = lo + step;
    int c;
    TOPK_COUNT_GE(piv, c)
    if (c >= 256) { lo = piv; c_lo = c; } else { hi = piv; c_hi = c; }
  }
#undef TOPK_COUNT_GE
  const unsigned thr = lo;
  int ngt = 0;
#pragma unroll
  for (int gq = 0; gq < 8; ++gq) {
    if (gq < ngrp) {
#pragma unroll
      for (int j = 0; j < 16; ++j) ngt += __popcll(__ballot(u[gq * 16 + j] > thr));
    }
  }
  int base_gt = 0, base_eq = 0;
  const int need_eq = 256 - ngt;
  int ln2 = lane;
  asm volatile("" : "+v"(ln2));
#pragma unroll
  for (int gq = 0; gq < 8; ++gq) {
    if (gq < ngrp) {
#pragma unroll
      for (int j = 0; j < 16; ++j) {
        const int s = (gq * 16 + j) * 64 + ln2;
        const unsigned uv = u[gq * 16 + j];
        const bool gt = uv > thr, eq = uv == thr;
        const u64 mg = __ballot(gt), me = __ballot(eq);
        const int pg = __builtin_amdgcn_mbcnt_hi((unsigned)(mg >> 32), __builtin_amdgcn_mbcnt_lo((unsigned)mg, 0));
        const int pe = __builtin_amdgcn_mbcnt_hi((unsigned)(me >> 32), __builtin_amdgcn_mbcnt_lo((unsigned)me, 0));
        if (gt) dst[base_gt + pg] = s;
        if (eq && (base_eq + pe) < need_eq) dst[ngt + base_eq + pe] = s;
        base_gt += __popcll(mg);
        base_eq += __popcll(me);
      }
    }
  }
}

DI void phase6(const Params& p, char* smem, int bid, int nblk);
DI void phase5(const Params& p, char* smem, int bid, int nblk) {
  for (int item = bid; item < 1024; item += nblk) {
    __syncthreads();
    const int it = item < 512 ? 1023 - item : item - 512;
    const int chunk = it >> 2, bgi = it & 3;
    nsa_item(p, smem, (bgi << 8) | chunk);
  }
  __syncthreads();
  phase6(p, smem, bid, nblk);
}

DI void tr_read2(unsigned a0, unsigned a1, uint2& r0, uint2& r1) {
  asm volatile("ds_read_b64_tr_b16 %0, %2\n\tds_read_b64_tr_b16 %1, %3\n\ts_waitcnt lgkmcnt(0)" : "=&v"(r0), "=&v"(r1) : "v"(a0), "v"(a1) : "memory");
}
DI void tr_read4(unsigned a0, unsigned a1, unsigned a2, unsigned a3, uint2& r0, uint2& r1, uint2& r2, uint2& r3) {
  asm volatile("ds_read_b64_tr_b16 %0, %4\n\tds_read_b64_tr_b16 %1, %5\n\tds_read_b64_tr_b16 %2, %6\n\tds_read_b64_tr_b16 %3, %7\n\ts_waitcnt lgkmcnt(0)"
               : "=&v"(r0), "=&v"(r1), "=&v"(r2), "=&v"(r3) : "v"(a0), "v"(a1), "v"(a2), "v"(a3) : "memory");
}
DI void dsa_query(const Params& p, u16* Cs, const float* btab, int b, int t, int lane) {
  const long row = (long)b * T + t;
  const int lg = lane >> 4, r16 = lane & 15, hh = lane & 7;
  bf16x8 qf[4];
#pragma unroll
  for (int ks = 0; ks < 4; ++ks) {
    bf16x8 z = {0, 0, 0, 0, 0, 0, 0, 0};
    if (r16 < 8) z = *(const bf16x8*)(p.qlat + (row * 8 + r16) * 128 + ks * 32 + lg * 8);
    qf[ks] = z;
  }
  const u16* ckvb = p.ckv + (long)b * T * 128;
  const int nvalid = (t + 1) < 256 ? (t + 1) : 256;
  float m = -1e30f, l = 0.f;
  f32x4 o[8];
#pragma unroll
  for (int ct = 0; ct < 8; ++ct) o[ct] = (f32x4){0.f, 0.f, 0.f, 0.f};
  const unsigned cs_base = (unsigned)(size_t)Cs;
  const int nch = (nvalid + 31) >> 5;
  uint4 gv0, gv1, gv2, gv3, gv4, gv5, gv6, gv7;
  int kidx_n;
#define DSA_G1(V, I) { const int kr_ = __shfl(kidx_n, 4 * (I) + lg); V = *(const uint4*)(ckvb + (long)kr_ * 128 + r16 * 8); }
#define DSA_GATHER(CH)                                                            \
  {                                                                               \
    const int nv_ = (nvalid - (CH) * 32) > 32 ? 32 : (nvalid - (CH) * 32);        \
    kidx_n = p.selk[row * 256 + (CH) * 32 + (lane & 31)];                         \
    if ((lane & 31) >= nv_ || kidx_n < 0 || kidx_n > t) kidx_n = t;               \
    DSA_G1(gv0, 0) DSA_G1(gv1, 1) DSA_G1(gv2, 2) DSA_G1(gv3, 3) DSA_G1(gv4, 4) DSA_G1(gv5, 5) DSA_G1(gv6, 6) DSA_G1(gv7, 7) \
  }
  DSA_GATHER(0)
  for (int ch = 0; ch < nch; ++ch) {
    const int nval = (nvalid - ch * 32) > 32 ? 32 : (nvalid - ch * 32);
    const int kidx = kidx_n;
    wave_sync();
    {
      u16* d_ = Cs + lg * 144 + r16 * 8;
      *(uint4*)(d_) = gv0;            *(uint4*)(d_ + 4 * 144) = gv1;  *(uint4*)(d_ + 8 * 144) = gv2;  *(uint4*)(d_ + 12 * 144) = gv3;
      *(uint4*)(d_ + 16 * 144) = gv4; *(uint4*)(d_ + 20 * 144) = gv5; *(uint4*)(d_ + 24 * 144) = gv6; *(uint4*)(d_ + 28 * 144) = gv7;
    }
    { const int chn = ch + 1 < nch ? ch + 1 : nch - 1; DSA_GATHER(chn) }
    wave_sync();
    f32x4 acc[2];
#pragma unroll
    for (int rt = 0; rt < 2; ++rt) {
      const u16* kp = Cs + (16 * rt + r16) * 144 + 8 * lg;
      f32x4 c = {0.f, 0.f, 0.f, 0.f};
#pragma unroll
      for (int ks = 0; ks < 4; ++ks) c = MFMA16(*(const bf16x8*)(kp + 32 * ks), qf[ks], c);
      acc[rt] = c;
    }
    float mx = -INFINITY;
#pragma unroll
    for (int rt = 0; rt < 2; ++rt)
#pragma unroll
      for (int r = 0; r < 4; ++r) {
        const int pl = 16 * rt + 4 * lg + r;
        const int kk = __shfl(kidx, pl);
        int dc = t - kk;
        dc = dc < 0 ? 0 : (dc > 128 ? 128 : dc);
        const float sv = (pl < nval) ? fmaf(acc[rt][r], LOG2E, btab[hh * 132 + dc]) : -INFINITY;
        acc[rt][r] = sv;
        mx = fmaxf(mx, sv);
      }
    mx = fmaxf(mx, __shfl_xor(mx, 16));
    mx = fmaxf(mx, __shfl_xor(mx, 32));
    const float mn = fmaxf(m, mx);
    const float alpha = __builtin_amdgcn_exp2f(m - mn);
    float ls = 0.f;
#pragma unroll
    for (int rt = 0; rt < 2; ++rt)
#pragma unroll
      for (int r = 0; r < 4; ++r) {
        const float pv = __builtin_amdgcn_exp2f(acc[rt][r] - mn);
        acc[rt][r] = pv;
        ls += pv;
      }
    ls += __shfl_xor(ls, 16);
    ls += __shfl_xor(ls, 32);
    l = l * alpha + ls;
    m = mn;
    uint4 pw;
    pw.x = pack2(acc[0][0], acc[0][1]);
    pw.y = pack2(acc[0][2], acc[0][3]);
    pw.z = pack2(acc[1][0], acc[1][1]);
    pw.w = pack2(acc[1][2], acc[1][3]);
    const bf16x8 pb = __builtin_bit_cast(bf16x8, pw);
    const unsigned a_lo = cs_base + (unsigned)(((4 * lg + (r16 >> 2)) * 144 + 4 * (r16 & 3)) * 2);
    const unsigned a_hi = a_lo + 16 * 144 * 2;
#pragma unroll
    for (int ct = 0; ct < 8; ct += 2) {
      uint2 lo0, hi0, lo1, hi1;
      tr_read4(a_lo + ct * 32, a_hi + ct * 32, a_lo + ct * 32 + 32, a_hi + ct * 32 + 32, lo0, hi0, lo1, hi1);
      uint4 aw0, aw1;
      aw0.x = lo0.x; aw0.y = lo0.y; aw0.z = hi0.x; aw0.w = hi0.y;
      aw1.x = lo1.x; aw1.y = lo1.y; aw1.z = hi1.x; aw1.w = hi1.y;
      o[ct] = o[ct] * alpha;
      o[ct + 1] = o[ct + 1] * alpha;
      o[ct] = MFMA16(__builtin_bit_cast(bf16x8, aw0), pb, o[ct]);
      o[ct + 1] = MFMA16(__builtin_bit_cast(bf16x8, aw1), pb, o[ct + 1]);
    }
  }
#undef DSA_GATHER
#undef DSA_G1
  const float invl = 1.f / fmaxf(l, 1e-30f);
  if (r16 < 8) {
#pragma unroll
    for (int ct = 0; ct < 8; ++ct)
      *(uint2*)(p.olat + row * 1024 + r16 * 128 + 16 * ct + 4 * lg) = pack4(o[ct][0] * invl, o[ct][1] * invl, o[ct][2] * invl, o[ct][3] * invl);
  }
}
DI void phase6(const Params& p, char* smem, int bid, int nblk) {
  const int tid = TIDX(), lane = tid & 63, wid = __builtin_amdgcn_readfirstlane(tid >> 6);
  float* btab = (float*)smem;
  u16* Cs = (u16*)(smem + 8192) + wid * (32 * 144);
  for (int idx = tid; idx < 8 * 129; idx += 256) {
    const int h = idx / 129, d = idx % 129;
    const int bk = d < 128 ? BUCKET[d] : 31;
    btab[h * 132 + d] = p.rel_bias[bk * 16 + 8 + h] * LOG2E;
  }
  __syncthreads();
  for (int item = bid; item < 2048; item += nblk) {
    const int it = item < 1024 ? 2047 - item : item - 1024;
    const int b = it & 1, tb = it >> 1;
    for (int q = 0; q < 2; ++q) dsa_query(p, Cs, btab, b, tb * 8 + wid * 2 + q, lane);
  }
}

struct EpiOdsa {
  u16* odsa; int h, m0;
  DI void operator()(f32x16 (&acc)[2][2], int wm, int wn, int lane) const {
    constexpr int MT = 2;
    SW_FOR {
      const int r = m0 + SW_R, c = SW_C0;
      if (c < 64) *(uint2*)(odsa + (long)r * 512 + h * 64 + c) = pack4(SW_V(0), SW_V(1), SW_V(2), SW_V(3));
    }
  }
};
DI void phase7(const Params& p, char* smem, int bid, int nblk) {
  for (int item = bid; item < 1024; item += nblk) {
    const int h = item & 7, mt_ = item >> 3;
    ARows af{p.olat + (long)mt_ * 128 * 1024 + h * 128, 1024, 128};
    BMat bf{p.dsa_w_uv + h * 64, 512, 64};
    EpiOdsa ef{p.odsa, h, mt_ * 128};
    gemm_tile(smem, 2, 64, af, bf, ef);
  }
}

struct EpiY {
  u16* y; const u16* proj; int m0, n0, second;
  template <int MT> DI void operator()(f32x16 (&acc)[MT][2], int wm, int wn, int lane) const {
    SW_FOR {
      const int r = m0 + SW_R, c = n0 + SW_C0;
      const uint2 gu = *(const uint2*)(proj + (long)r * LDP + C_GM + second * 1024 + c);
      float v0 = lo16(gu.x) * SW_V(0), v1 = hi16(gu.x) * SW_V(1), v2 = lo16(gu.y) * SW_V(2), v3 = hi16(gu.y) * SW_V(3);
      uint2* dst = (uint2*)(y + (long)r * 1024 + c);
      if (second) {
        const uint2 yu = *dst;
        v0 += lo16(yu.x); v1 += hi16(yu.x); v2 += lo16(yu.y); v3 += hi16(yu.y);
      }
      *dst = pack4(v0, v1, v2, v3);
    }
  }
};
DI void phase8(const Params& p, char* smem, int bid, int nblk) {
  for (int item = bid; item < 512; item += nblk) {
    const int nt_ = item & 7, mt_ = item >> 3;
    {
      ARows af{p.onsa + (long)mt_ * 256 * 512, 512, 256};
      BMatT bf{p.w_bnT + (long)nt_ * 128 * 512, 512};
      EpiY ef{p.y, p.proj, mt_ * 256, nt_ * 128, 0};
      gemm_tile256<true>(smem, 8, af, bf, ef);
    }
    {
      ARows af{p.odsa + (long)mt_ * 256 * 512, 512, 256};
      BMatT bf{p.w_bdT + (long)nt_ * 128 * 512, 512};
      EpiY ef{p.y, p.proj, mt_ * 256, nt_ * 128, 1};
      gemm_tile256<true>(smem, 8, af, bf, ef);
    }
  }
}
struct EpiStoreBf {
  u16* dst; long ld; int m0, n0;
  template <int MT> DI void operator()(f32x16 (&acc)[MT][2], int wm, int wn, int lane) const {
    SW_FOR { *(uint2*)(dst + (long)(m0 + SW_R) * ld + n0 + SW_C0) = pack4(SW_V(0), SW_V(1), SW_V(2), SW_V(3)); }
  }
};
DI void phase9(const Params& p, char* smem, int bid, int nblk) {
  for (int item = bid; item < 512; item += nblk) {
    const int nt_ = item & 7, mt_ = item >> 3;
    ARows af{p.y + (long)mt_ * 256 * 1024, 1024, 256};
    BMatT bf{p.w_outT + (long)nt_ * 128 * 1024, 1024};
    EpiStoreBf ef{p.z, 1024, mt_ * 256, nt_ * 128};
    gemm_tile256<true>(smem, 16, af, bf, ef);
  }
}

DI void phase10(const Params& p, int bid, int nblk) {
  const int tid = TIDX(), lane = tid & 63, wid = __builtin_amdgcn_readfirstlane(tid >> 6);
  for (int row = bid * 4 + wid; row < NTOK; row += nblk * 4) {
    const int b = row >> 13;
    const float* modb = p.mod + b * 6144;
    float zv[16], xv[16];
    float ss = 0.f;
#pragma unroll
    for (int i = 0; i < 4; ++i) {
      const int col = i * 256 + lane * 4;
      const uint2 u = *(const uint2*)(p.z + (long)row * 1024 + col);
      zv[i * 4 + 0] = lo16(u.x); zv[i * 4 + 1] = hi16(u.x); zv[i * 4 + 2] = lo16(u.y); zv[i * 4 + 3] = hi16(u.y);
      const float4 xx = *(const float4*)(p.x + (long)row * 1024 + col);
      xv[i * 4 + 0] = xx.x; xv[i * 4 + 1] = xx.y; xv[i * 4 + 2] = xx.z; xv[i * 4 + 3] = xx.w;
#pragma unroll
      for (int j = 0; j < 4; ++j) ss += zv[i * 4 + j] * zv[i * 4 + j];
    }
    ss = wave_sum(ss);
    const float r = rsqrtf(ss * (1.f / 1024.f) + 1e-6f);
    float ss2 = 0.f;
#pragma unroll
    for (int i = 0; i < 4; ++i)
#pragma unroll
      for (int j = 0; j < 4; ++j) {
        const int col = i * 256 + lane * 4 + j;
        const float v = xv[i * 4 + j] + modb[2048 + col] * (zv[i * 4 + j] * r * p.g_post_mix[col]);
        xv[i * 4 + j] = v;
        ss2 += v * v;
      }
    ss2 = wave_sum(ss2);
    const float r2 = rsqrtf(ss2 * (1.f / 1024.f) + 1e-6f);
#pragma unroll
    for (int i = 0; i < 4; ++i) {
      const int col = i * 256 + lane * 4;
      *(float4*)(p.x1 + (long)row * 1024 + col) = make_float4(xv[i * 4], xv[i * 4 + 1], xv[i * 4 + 2], xv[i * 4 + 3]);
      float hv[4];
#pragma unroll
      for (int j = 0; j < 4; ++j) hv[j] = xv[i * 4 + j] * r2 * p.g_pre_ffn[col + j] * (1.f + modb[4096 + col + j]) + modb[3072 + col + j];
      uint2 w;
      w.x = pack2(hv[0], hv[1]);
      w.y = pack2(hv[2], hv[3]);
      *(uint2*)(p.h + (long)row * 1024 + col) = w;
    }
  }
}

struct EpiStoreF32 {
  float* dst; long ld; int m0, n0;
  DI void operator()(f32x16 (&acc)[2][2], int wm, int wn, int lane) const {
    constexpr int MT = 2;
    SW_FOR { *(float4*)(dst + (long)(m0 + SW_R) * ld + n0 + SW_C0) = make_float4(SW_V(0), SW_V(1), SW_V(2), SW_V(3)); }
  }
};
DI void phase11(const Params& p, char* smem, int bid, int nblk) {
  for (int item = bid; item < 256; item += nblk) {
    const int nt_ = item & 1, mt_ = item >> 1;
    ARows af{p.h + (long)mt_ * 128 * 1024, 1024, 128};
    BMatT bf{p.routerT + (long)nt_ * 128 * 1024, 1024};
    EpiStoreF32 ef{p.logits, 256, mt_ * 128, nt_ * 128};
    gemm_tile<true, false, true>(smem, 16, 64, af, bf, ef);
  }
}
DI void phase12(const Params& p, int bid, int nblk) {
  const int tid = TIDX(), lane = tid & 63, wid = __builtin_amdgcn_readfirstlane(tid >> 6);
  for (int tok = bid * 4 + wid; tok < NTOK; tok += nblk * 4) {
    const float4 lg = *(const float4*)(p.logits + (long)tok * 256 + lane * 4);
    const float4 rbv = *(const float4*)(p.router_bias + lane * 4);
    float sg[4] = {sigmoidf(lg.x), sigmoidf(lg.y), sigmoidf(lg.z), sigmoidf(lg.w)};
    float sl[4] = {sg[0] + rbv.x, sg[1] + rbv.y, sg[2] + rbv.z, sg[3] + rbv.w};
    float t1 = fmaxf(sl[0], sl[1]), t2 = fminf(sl[0], sl[1]);
#pragma unroll
    for (int j = 2; j < 4; ++j) {
      const float v = sl[j];
      t2 = fmaxf(t2, fminf(t1, v));
      t1 = fmaxf(t1, v);
    }
#define R_MERGE(CTRL)                                                                                                            \
    {                                                                                                                            \
      const float a1 = __int_as_float(__builtin_amdgcn_update_dpp(0, __float_as_int(t1), CTRL, 0xF, 0xF, true));                 \
      const float a2 = __int_as_float(__builtin_amdgcn_update_dpp(0, __float_as_int(t2), CTRL, 0xF, 0xF, true));                 \
      const float n1 = fmaxf(t1, a1);                                                                                            \
      const float n2 = fmaxf(fminf(t1, a1), fmaxf(t2, a2));                                                                      \
      t1 = n1; t2 = n2;                                                                                                          \
    }
    R_MERGE(DPP_QP1) R_MERGE(DPP_QP2) R_MERGE(DPP_RHM)
#undef R_MERGE
    const float gscore = t1 + t2;
    const int grp = lane >> 3;
    int rank = 0;
#pragma unroll
    for (int g2 = 0; g2 < 8; ++g2) {
      const float og = rdlane(gscore, g2 * 8);
      rank += (og > gscore || (og == gscore && g2 < grp)) ? 1 : 0;
    }
    const bool gsel = rank < 4;
    float cv[4];
#pragma unroll
    for (int j = 0; j < 4; ++j) cv[j] = gsel ? sl[j] : -1e30f;
    int my_e = -1; float my_s = 0.f; float ssum = 0.f;
    for (int r = 0; r < 8; ++r) {
      float bv = cv[0]; int bj = 0;
#pragma unroll
      for (int j = 1; j < 4; ++j) if (cv[j] > bv) { bv = cv[j]; bj = j; }
      int be = lane * 4 + bj;
      wave_argmax(bv, be);
      const int wl_ = be >> 2, wj = be & 3;
      const float s0 = rdlane(sg[0], wl_), s1 = rdlane(sg[1], wl_), s2 = rdlane(sg[2], wl_), s3 = rdlane(sg[3], wl_);
      const float bs = wj == 0 ? s0 : (wj == 1 ? s1 : (wj == 2 ? s2 : s3));
      if (wl_ == lane) {
        if (wj == 0) cv[0] = -3e30f; else if (wj == 1) cv[1] = -3e30f; else if (wj == 2) cv[2] = -3e30f; else cv[3] = -3e30f;
      }
      if (lane == r) { my_e = be; my_s = bs; }
      ssum += bs;
    }
    if (lane < 8) {
      const float w = my_s / ssum * 2.5f;
      const int rk = atomicAdd(p.counts + my_e, 1);
      p.eidx[tok * 8 + lane] = my_e;
      p.ewt[tok * 8 + lane] = w;
      p.erank[tok * 8 + lane] = rk;
    }
  }
}
DI void phase14(const Params& p, char* smem, int bid, int nblk) {
  const int tid = TIDX();
  int* s_cnt = (int*)smem;
  int* s_off = s_cnt + 256;
  const int cnt = p.counts[tid];
  s_cnt[tid] = cnt;
  __syncthreads();
  int run = 0, nt = 0, nt2 = 0;
  for (int e = 0; e < tid; ++e) { const int c = s_cnt[e]; run += c; nt += (c + 127) >> 7; nt2 += (c + 255) >> 8; }
  s_off[tid] = run;
  __syncthreads();
  if (bid == 0) {
    p.offs[tid] = run;
    for (int m = 0; m * 256 < cnt; ++m) {
      p.tile2_e[nt2] = tid;
      p.tile2_r0[nt2] = run + m * 256;
      p.tile2_nr[nt2] = (cnt - m * 256) > 256 ? 256 : (cnt - m * 256);
      ++nt2;
    }
    for (int m = 0; m * 128 < cnt; ++m) {
      p.tile_e[nt] = tid;
      p.tile_r0[nt] = run + m * 128;
      p.tile_nr[nt] = (cnt - m * 128) > 128 ? 128 : (cnt - m * 128);
      ++nt;
    }
    if (tid == 255) {
      p.offs[256] = run + cnt;
      for (int m = 0; m < 128; ++m) {
        p.tile_e[nt] = 256;
        p.tile_r0[nt] = 131072 + m * 128;
        p.tile_nr[nt] = 128;
        ++nt;
      }
      p.ntiles[0] = nt;
      for (int m = 0; m < 64; ++m) {
        p.tile2_e[nt2] = 256;
        p.tile2_r0[nt2] = 131072 + m * 256;
        p.tile2_nr[nt2] = 256;
        ++nt2;
      }
      p.ntiles[1] = nt2;
    }
  }
  for (int i = bid * 256 + tid; i < NSLOT; i += nblk * 256) {
    if (i < 131072) {
      const int e = p.eidx[i];
      const int slot = s_off[e] + p.erank[i];
      p.slot_tok[slot] = i >> 3;
      p.slot_wt[slot] = p.ewt[i];
      p.tok_slot[i] = slot;
    } else {
      p.slot_tok[i] = i - 131072;
      p.slot_wt[i] = 1.f;
    }
  }
}

struct AGather {
  const u16* h; const int* slot_tok; int r0, nr;
  DI const u16* operator()(int r) const { return h + (long)slot_tok[r0 + (r < nr ? r : 0)] * 1024; }
};
struct BGateUp {
  const float* wg; long udiff; long ldb; int n0;
  DI const float* operator()(int c4) const {
    const int wn = c4 >> 6, ntl = (c4 >> 5) & 1, j = c4 & 31;
    return wg + (long)ntl * udiff + n0 + wn * 32 + j;
  }
  DI const u16* row(int) const { return nullptr; }
};
struct EpiH {
  u16* H; int r0, nr, n0;
  template <int MT> DI void operator()(f32x16 (&acc)[MT][2], int wm, int wn, int lane) const {
#pragma unroll
    for (int mt = 0; mt < MT; ++mt) {
      const int r = SW_R;
      if (r < nr) {
#pragma unroll
        for (int q4 = 0; q4 < 4; ++q4) {
          float v[4];
#pragma unroll
          for (int j = 0; j < 4; ++j) v[j] = siluf(acc[mt][0][4 * q4 + j]) * acc[mt][1][4 * q4 + j];
          *(uint2*)(H + (long)(r0 + r) * 256 + n0 + wn * 32 + 8 * q4 + 4 * (lane >> 5)) = pack4(v[0], v[1], v[2], v[3]);
        }
      }
    }
  }
};
DI void phase15(const Params& p, char* smem, int bid, int nblk) {
  const int ntl = p.ntiles[1];
  for (int item = bid; item < ntl * 4; item += nblk) {
    const int ti = item >> 2, nt_ = item & 3;
    const int e = p.tile2_e[ti], r0 = p.tile2_r0[ti], nr = p.tile2_nr[ti];
    AGather af{p.h, p.slot_tok, r0, nr};
    const float* wg = e < 256 ? p.w_eg + (long)e * 1024 * 256 : p.w_sg;
    const float* wu = e < 256 ? p.w_eu + (long)e * 1024 * 256 : p.w_su;
    BGateUp bf{wg, (long)(wu - wg), 256, nt_ * 64};
    EpiH ef{p.H, r0, nr, nt_ * 64};
    gemm_tile256<false>(smem, 16, af, bf, ef);
  }
}
struct EpiYexp {
  u16* Y; const float* slot_wt; int r0, nr, n0;
  template <int MT> DI void operator()(f32x16 (&acc)[MT][2], int wm, int wn, int lane) const {
#pragma unroll
    for (int mt = 0; mt < MT; ++mt) {
      const int r = SW_R;
      if (r < nr) {
        const float w = slot_wt[r0 + r];
#pragma unroll
        for (int nt = 0; nt < 2; ++nt)
#pragma unroll
          for (int q4 = 0; q4 < 4; ++q4)
            *(uint2*)(Y + (long)(r0 + r) * 1024 + n0 + SW_C0) = pack4(SW_V(0) * w, SW_V(1) * w, SW_V(2) * w, SW_V(3) * w);
      }
    }
  }
};
DI void phase16(const Params& p, char* smem, int bid, int nblk) {
  const int ntl = p.ntiles[1];
  for (int item = bid; item < ntl * 8; item += nblk) {
    const int ti = item >> 3, nt_ = item & 7;
    const int e = p.tile2_e[ti], r0 = p.tile2_r0[ti], nr = p.tile2_nr[ti];
    ARows af{p.H + (long)r0 * 256, 256, nr};
    const float* wd = e < 256 ? p.w_ed + (long)e * 256 * 1024 : p.w_sd;
    BMat bf{wd + nt_ * 128, 1024, 128};
    EpiYexp ef{p.Y, p.slot_wt, r0, nr, nt_ * 128};
    gemm_tile256<false>(smem, 4, af, bf, ef);
  }
}
DI void phase17(const Params& p, int bid, int nblk) {
  const int tid = TIDX(), lane = tid & 63, wid = __builtin_amdgcn_readfirstlane(tid >> 6);
  for (int row = bid * 4 + wid; row < NTOK; row += nblk * 4) {
    const int b = row >> 13;
    const float* modb = p.mod + b * 6144;
    int slots[9];
#pragma unroll
    for (int k = 0; k < 8; ++k) slots[k] = p.tok_slot[row * 8 + k];
    slots[8] = 131072 + row;
    float yv[16];
#pragma unroll
    for (int j = 0; j < 16; ++j) yv[j] = 0.f;
#pragma unroll
    for (int k = 0; k < 9; ++k) {
#pragma unroll
      for (int i = 0; i < 4; ++i) {
        const uint2 u = *(const uint2*)(p.Y + (long)slots[k] * 1024 + i * 256 + lane * 4);
        yv[i * 4 + 0] += lo16(u.x); yv[i * 4 + 1] += hi16(u.x); yv[i * 4 + 2] += lo16(u.y); yv[i * 4 + 3] += hi16(u.y);
      }
    }
    float ss = 0.f;
#pragma unroll
    for (int j = 0; j < 16; ++j) ss += yv[j] * yv[j];
    ss = wave_sum(ss);
    const float r = rsqrtf(ss * (1.f / 1024.f) + 1e-6f);
#pragma unroll
    for (int i = 0; i < 4; ++i) {
      const int col = i * 256 + lane * 4;
      const float4 xx = *(const float4*)(p.x1 + (long)row * 1024 + col);
      float o[4] = {xx.x, xx.y, xx.z, xx.w};
#pragma unroll
      for (int j = 0; j < 4; ++j) o[j] += modb[5120 + col + j] * (yv[i * 4 + j] * r * p.g_post_ffn[col + j]);
      *(float4*)(p.out + (long)row * 1024 + col) = make_float4(o[0], o[1], o[2], o[3]);
    }
  }
}

__global__ void __launch_bounds__(256, 2) mega(Params p) {
  cg::grid_group grid = cg::this_grid();
  __shared__ __attribute__((aligned(16))) char smem[LDS_BYTES];
  const int bid = blockIdx.x, nblk = gridDim.x;
  if (p.phase_hi == 12345) grid.sync();
  if (threadIdx.x < 4) ((unsigned*)(smem + 73728))[threadIdx.x] = 0u;
  __syncthreads();
  const XcdBarrier xb = xcd_barrier_post(p.bar, (volatile LAS unsigned*)(smem + 73728));
#if !defined(ONLY) || ONLY==0
  if (p.phase_lo <= 0 && 0 < p.phase_hi) {
    phase0(p, smem, bid, nblk);
#if (REPEAT_MASK >> 0) & 1
    xcd_barrier(xb);
    phase0(p, smem, bid, nblk);
#endif
    if (0 + 1 < p.phase_hi) xcd_barrier(xb);
  }
#endif
#if !defined(ONLY) || ONLY==1
  if (p.phase_lo <= 1 && 1 < p.phase_hi) {
    phase1(p, smem, bid, nblk);
#if (REPEAT_MASK >> 1) & 1
    xcd_barrier(xb);
    phase1(p, smem, bid, nblk);
#endif
    if (1 + 1 < p.phase_hi) xcd_barrier(xb);
  }
#endif
#if !defined(ONLY) || ONLY==2
  if (p.phase_lo <= 2 && 2 < p.phase_hi) {
    phase2(p, smem, bid, nblk);
#if (REPEAT_MASK >> 2) & 1
    xcd_barrier(xb);
    phase2(p, smem, bid, nblk);
#endif
    if (2 + 1 < p.phase_hi) xcd_barrier(xb);
  }
#endif
#if !defined(ONLY) || ONLY==3
  if (p.phase_lo <= 3 && 3 < p.phase_hi) {
    phase3(p, smem, bid, nblk);
#if (REPEAT_MASK >> 3) & 1
    xcd_barrier(xb);
    phase3(p, smem, bid, nblk);
#endif
    if (3 + 1 < p.phase_hi) xcd_barrier(xb);
  }
#endif
#if !defined(ONLY) || ONLY==4
  if (p.phase_lo <= 4 && 4 < p.phase_hi) {
    phase4(p, smem, bid, nblk);
#if (REPEAT_MASK >> 4) & 1
    xcd_barrier(xb);
    phase4(p, smem, bid, nblk);
#endif
    if (4 + 1 < p.phase_hi) xcd_barrier(xb);
  }
#endif
#if !defined(ONLY) || ONLY==5
  if (p.phase_lo <= 5 && 5 < p.phase_hi) {
    phase5(p, smem, bid, nblk);
#if (REPEAT_MASK >> 5) & 1
    xcd_barrier(xb);
    phase5(p, smem, bid, nblk);
#endif
    if (5 + 1 < p.phase_hi) xcd_barrier(xb);
  }
#endif
#if !defined(ONLY) || ONLY==7
  if (p.phase_lo <= 7 && 7 < p.phase_hi) {
    phase7(p, smem, bid, nblk);
#if (REPEAT_MASK >> 7) & 1
    xcd_barrier(xb);
    phase7(p, smem, bid, nblk);
#endif
    if (7 + 1 < p.phase_hi) xcd_barrier(xb);
  }
#endif
#if !defined(ONLY) || ONLY==8
  if (p.phase_lo <= 8 && 8 < p.phase_hi) {
    phase8(p, smem, bid, nblk);
#if (REPEAT_MASK >> 8) & 1
    xcd_barrier(xb);
    phase8(p, smem, bid, nblk);
#endif
    if (8 + 1 < p.phase_hi) xcd_barrier(xb);
  }
#endif
#if !defined(ONLY) || ONLY==9
  if (p.phase_lo <= 9 && 9 < p.phase_hi) {
    phase9(p, smem, bid, nblk);
#if (REPEAT_MASK >> 9) & 1
    xcd_barrier(xb);
    phase9(p, smem, bid, nblk);
#endif
    if (9 + 1 < p.phase_hi) xcd_barrier(xb);
  }
#endif
#if !defined(ONLY) || ONLY==10
  if (p.phase_lo <= 10 && 10 < p.phase_hi) {
    phase10(p, bid, nblk);
#if (REPEAT_MASK >> 10) & 1
    xcd_barrier(xb);
    phase10(p, bid, nblk);
#endif
    if (10 + 1 < p.phase_hi) xcd_barrier(xb);
  }
#endif
#if !defined(ONLY) || ONLY==11
  if (p.phase_lo <= 11 && 11 < p.phase_hi) {
    phase11(p, smem, bid, nblk);
#if (REPEAT_MASK >> 11) & 1
    xcd_barrier(xb);
    phase11(p, smem, bid, nblk);
#endif
    if (11 + 1 < p.phase_hi) xcd_barrier(xb);
  }
#endif
#if !defined(ONLY) || ONLY==12
  if (p.phase_lo <= 12 && 12 < p.phase_hi) {
    phase12(p, bid, nblk);
#if (REPEAT_MASK >> 12) & 1
    xcd_barrier(xb);
    phase12(p, bid, nblk);
#endif
    if (12 + 1 < p.phase_hi) xcd_barrier(xb);
  }
#endif
#if !defined(ONLY) || ONLY==14
  if (p.phase_lo <= 14 && 14 < p.phase_hi) {
    phase14(p, smem, bid, nblk);
#if (REPEAT_MASK >> 14) & 1
    xcd_barrier(xb);
    phase14(p, smem, bid, nblk);
#endif
    if (14 + 1 < p.phase_hi) xcd_barrier(xb);
  }
#endif
#if !defined(ONLY) || ONLY==15
  if (p.phase_lo <= 15 && 15 < p.phase_hi) {
    phase15(p, smem, bid, nblk);
#if (REPEAT_MASK >> 15) & 1
    xcd_barrier(xb);
    phase15(p, smem, bid, nblk);
#endif
    if (15 + 1 < p.phase_hi) xcd_barrier(xb);
  }
#endif
#if !defined(ONLY) || ONLY==16
  if (p.phase_lo <= 16 && 16 < p.phase_hi) {
    phase16(p, smem, bid, nblk);
#if (REPEAT_MASK >> 16) & 1
    xcd_barrier(xb);
    phase16(p, smem, bid, nblk);
#endif
    if (16 + 1 < p.phase_hi) xcd_barrier(xb);
  }
#endif
#if !defined(ONLY) || ONLY==17
  if (p.phase_lo <= 17 && 17 < p.phase_hi) {
    phase17(p, bid, nblk);
#if (REPEAT_MASK >> 17) & 1
    xcd_barrier(xb);
    phase17(p, bid, nblk);
#endif
    if (17 + 1 < p.phase_hi) xcd_barrier(xb);
  }
#endif
}

extern "C" void kernel_launch(void* const* d_in, const int* in_sizes, int n_in, void* d_out, int out_size, void* d_ws, size_t ws_size,
                              hipStream_t stream) {
  static int grid_blocks = 0;
  if (!grid_blocks) {
    int dev = 0, cus = 0, per_cu = 0;
    (void)hipGetDevice(&dev);
    (void)hipDeviceGetAttribute(&cus, hipDeviceAttributeMultiprocessorCount, dev);
    (void)hipOccupancyMaxActiveBlocksPerMultiprocessor(&per_cu, mega, 256, 0);
    if (per_cu > 2) per_cu = 2;
    if (per_cu < 1) per_cu = 1;
    grid_blocks = cus * per_cu;
  }
  Params p{};
  const float* const* in = (const float* const*)d_in;
  p.x = in[0]; p.c = in[1]; p.w_ada = in[2]; p.b_ada = in[3]; p.g_pre_mix = in[4]; p.g_post_mix = in[5]; p.g_pre_ffn = in[6]; p.g_post_ffn = in[7];
  p.w_in = in[8]; p.rel_bias = in[9]; p.cmp_pe = in[10]; p.cmp_w1 = in[11]; p.cmp_b1 = in[12]; p.cmp_w2 = in[13]; p.dsa_kv_norm = in[14];
  p.dsa_w_uk = in[15]; p.dsa_w_uv = in[16]; p.w_bn = in[17]; p.w_bd = in[18]; p.w_out = in[19]; p.router_w = in[20]; p.router_bias = in[21];
  p.w_eg = in[22]; p.w_eu = in[23]; p.w_ed = in[24]; p.w_sg = in[25]; p.w_su = in[26]; p.w_sd = in[27];
  p.out = (float*)d_out;
  char* ws = (char*)d_ws;
  size_t off = 0;
  auto alloc = [&](size_t bytes) { char* r = ws + off; off += (bytes + 255) & ~(size_t)255; return r; };
  p.bar = (unsigned*)alloc(XCD_BAR_WORDS * 4);
  p.modp = (float*)alloc(16 * 2 * 6144 * 4);
  p.mod = (float*)alloc(2 * 6144 * 4);
  p.pe_part = (float*)alloc(16 * 256 * 4);
  p.w_ukT = (float*)alloc(8 * 64 * 128 * 4);
  p.w_inT = (u16*)alloc((size_t)4608 * 1024 * 2);
  p.w_bnT = (u16*)alloc((size_t)1024 * 512 * 2);
  p.w_bdT = (u16*)alloc((size_t)1024 * 512 * 2);
  p.w_outT = (u16*)alloc((size_t)1024 * 1024 * 2);
  p.routerT = (u16*)alloc((size_t)256 * 1024 * 2);
  p.counts = (int*)alloc(256 * 4);
  p.offs = (int*)alloc(257 * 4);
  p.tile_e = (int*)alloc(1536 * 4);
  p.tile_r0 = (int*)alloc(1536 * 4);
  p.tile_nr = (int*)alloc(1536 * 4);
  p.ntiles = (int*)alloc(8);
  p.tile2_e = (int*)alloc(1024 * 4);
  p.tile2_r0 = (int*)alloc(1024 * 4);
  p.tile2_nr = (int*)alloc(1024 * 4);
  p.h = (u16*)alloc((size_t)NTOK * 1024 * 2);
  p.proj = (u16*)alloc((size_t)NTOK * LDP * 2);
  p.widx = (float*)alloc((size_t)NTOK * 8 * 4);
  p.zc = (u16*)alloc((size_t)2 * 2048 * 128 * 2);
  p.kc = (u16*)alloc((size_t)4 * 512 * 64 * 2);
  p.vcT = (u16*)alloc((size_t)4 * 512 * 64 * 2);
  p.vts = (u16*)alloc((size_t)4 * 64 * T * 2);
  p.vtw = (u16*)alloc((size_t)4 * 64 * T * 2);
  p.qlat = (u16*)alloc((size_t)NTOK * 1024 * 2);
  p.ckv = (u16*)alloc((size_t)NTOK * 128 * 2);
  p.selk = (int*)alloc((size_t)NTOK * 256 * 4);
  p.onsa = (u16*)alloc((size_t)NTOK * 512 * 2);
  p.olat = (u16*)alloc((size_t)NTOK * 1024 * 2);
  p.odsa = (u16*)alloc((size_t)NTOK * 512 * 2);
  p.y = p.qlat;
  p.z = p.olat;
  p.eidx = (int*)alloc((size_t)NTOK * 8 * 4);
  p.ewt = (float*)alloc((size_t)NTOK * 8 * 4);
  p.erank = (int*)alloc((size_t)NTOK * 8 * 4);
  p.slot_tok = (int*)alloc((size_t)NSLOT * 4);
  p.slot_wt = (float*)alloc((size_t)NSLOT * 4);
  p.tok_slot = (int*)alloc((size_t)NTOK * 8 * 4);
  char* big = alloc((size_t)2 * T * T * 4);
  p.scores = (float*)big;
  {
    size_t o2 = 0;
    auto sub = [&](size_t bytes) { char* r = big + o2; o2 += (bytes + 255) & ~(size_t)255; return r; };
    p.H = (u16*)sub((size_t)NSLOT * 256 * 2);
    p.Y = (u16*)sub((size_t)NSLOT * 1024 * 2);
    p.x1 = (float*)sub((size_t)NTOK * 1024 * 4);
    p.logits = (float*)sub((size_t)NTOK * 256 * 4);
  }
  if (off > ws_size) fprintf(stderr, "workspace too small: need %zu have %zu\n", off, ws_size);
  p.phase_lo = 0;
  p.phase_hi = 18;
  (void)hipMemsetAsync(p.bar, 0, XCD_BAR_WORDS * 4, stream);
  void* args[] = {&p};
  hipError_t e = hipLaunchCooperativeKernel((void*)mega, dim3(grid_blocks), dim3(256), args, 0, stream);
  if (e != hipSuccess) fprintf(stderr, "coop launch failed: %s (grid %d)\n", hipGetErrorString(e), grid_blocks);
}
```

```cpp
#include <hip/hip_runtime.h>
#include <hip/hip_cooperative_groups.h>
#include <cstdio>
namespace cg = cooperative_groups;

#define DI __device__ __forceinline__
typedef unsigned short u16;
typedef unsigned long long u64;
using bf16x8 = __attribute__((ext_vector_type(8))) short;
using f32x16 = __attribute__((ext_vector_type(16))) float;

constexpr int T = 8192;
constexpr int NTOK = 16384;
constexpr int LDP = 4576;
constexpr int C_QN = 0, C_KV = 512, C_GN = 1280, C_QD = 1304, C_CKV = 1816, C_QI = 1944, C_KI = 2456, C_WI = 2520, C_GM = 2528;
constexpr int NSLOT = 131072 + 16384;
constexpr int HALF_LDS = 73728;
constexpr int LDS_BYTES = 2 * HALF_LDS + 128;
__shared__ __attribute__((aligned(16))) char g_smem[LDS_BYTES];
#ifndef REPEAT_MASK
#define REPEAT_MASK 0
#endif

__device__ const unsigned char BUCKET[128] = {
  0, 1, 2, 3, 4, 5, 6, 7, 8, 9, 10, 11, 12, 13, 14, 15, 16, 16, 16, 17, 17, 18, 18, 18, 19, 19, 19, 20, 20, 20, 20, 21,
  21, 21, 21, 22, 22, 22, 22, 22, 23, 23, 23, 23, 23, 23, 24, 24, 24, 24, 24, 24, 25, 25, 25, 25, 25, 25, 25, 26, 26, 26, 26, 26,
  26, 26, 26, 27, 27, 27, 27, 27, 27, 27, 27, 27, 27, 28, 28, 28, 28, 28, 28, 28, 28, 28, 28, 29, 29, 29, 29, 29, 29, 29, 29, 29,
  29, 29, 29, 30, 30, 30, 30, 30, 30, 30, 30, 30, 30, 30, 30, 30, 30, 31, 31, 31, 31, 31, 31, 31, 31, 31, 31, 31, 31, 31, 31, 31};

struct Params {
  const float *x, *c, *w_ada, *b_ada, *g_pre_mix, *g_post_mix, *g_pre_ffn, *g_post_ffn, *w_in, *rel_bias;
  const float *cmp_pe, *cmp_w1, *cmp_b1, *cmp_w2, *dsa_kv_norm, *dsa_w_uk, *dsa_w_uv, *w_bn, *w_bd, *w_out;
  const float *router_w, *router_bias, *w_eg, *w_eu, *w_ed, *w_sg, *w_su, *w_sd;
  float* out;
  float* modp;
  float* mod;
  float* pe_part;
  float* w_ukT;
  u16 *w_inT, *w_bnT, *w_bdT, *w_outT, *routerT;
  u16* h;
  u16* proj;
  float* widx;
  u16* zc;
  u16* kc;
  u16* vcT;
  u16* vts;
  u16* vtw;
  u16* qlat;
  u16* ckv;
  float* scores;
  int* selk;
  u16* onsa;
  u16* olat;
  u16* odsa;
  u16* y;
  u16* z;
  float* x1;
  float* logits;
  int* eidx;
  float* ewt;
  int* erank;
  int* counts;
  int* offs;
  int* tile_e;
  int* tile_r0;
  int* tile_nr;
  int* ntiles;
  int *tile2_e, *tile2_r0, *tile2_nr;
  int* slot_tok;
  float* slot_wt;
  int* tok_slot;
  u16* H;
  u16* Y;
  unsigned* bar;
  int phase_lo, phase_hi;
};

DI float bf2f(u16 v) { return __uint_as_float(((unsigned)v) << 16); }
typedef __bf16 bf16x2_t __attribute__((ext_vector_type(2)));
typedef float f32x2_t __attribute__((ext_vector_type(2)));
DI unsigned pack2(float a, float b) { f32x2_t v = {a, b}; return __builtin_bit_cast(unsigned, __builtin_convertvector(v, bf16x2_t)); }
DI u16 f2bf(float x) { return (u16)(pack2(x, x) & 0xffffu); }
DI float lo16(unsigned u) { return __uint_as_float(u << 16); }
DI float hi16(unsigned u) { return __uint_as_float(u & 0xffff0000u); }
DI float wave_sum(float v) { for (int o = 32; o; o >>= 1) v += __shfl_xor(v, o); return v; }
DI float wave_max(float v) { for (int o = 32; o; o >>= 1) v = fmaxf(v, __shfl_xor(v, o)); return v; }
#define DPP_QP1 0xB1
#define DPP_QP2 0x4E
#define DPP_RHM 0x141
#define DPP_RM  0x140
#define DPP_B15 0x142
#define DPP_B31 0x143
DI int wave_sum_i(int x) {
  x += __builtin_amdgcn_update_dpp(0, x, DPP_QP1, 0xF, 0xF, true);
  x += __builtin_amdgcn_update_dpp(0, x, DPP_QP2, 0xF, 0xF, true);
  x += __builtin_amdgcn_update_dpp(0, x, DPP_RHM, 0xF, 0xF, true);
  x += __builtin_amdgcn_update_dpp(0, x, DPP_RM, 0xF, 0xF, true);
  x += __builtin_amdgcn_update_dpp(0, x, DPP_B15, 0xA, 0xF, true);
  x += __builtin_amdgcn_update_dpp(0, x, DPP_B31, 0xC, 0xF, true);
  return __builtin_amdgcn_readlane(x, 63);
}
#define DPP_SELF(x, CTRL, RM) ((unsigned)__builtin_amdgcn_update_dpp((int)(x), (int)(x), CTRL, RM, 0xF, false))
DI unsigned wave_max_u(unsigned x) {
  x = max(x, DPP_SELF(x, DPP_QP1, 0xF)); x = max(x, DPP_SELF(x, DPP_QP2, 0xF)); x = max(x, DPP_SELF(x, DPP_RHM, 0xF));
  x = max(x, DPP_SELF(x, DPP_RM, 0xF)); x = max(x, DPP_SELF(x, DPP_B15, 0xA)); x = max(x, DPP_SELF(x, DPP_B31, 0xC));
  return (unsigned)__builtin_amdgcn_readlane((int)x, 63);
}
DI unsigned wave_min_u(unsigned x) {
  x = min(x, DPP_SELF(x, DPP_QP1, 0xF)); x = min(x, DPP_SELF(x, DPP_QP2, 0xF)); x = min(x, DPP_SELF(x, DPP_RHM, 0xF));
  x = min(x, DPP_SELF(x, DPP_RM, 0xF)); x = min(x, DPP_SELF(x, DPP_B15, 0xA)); x = min(x, DPP_SELF(x, DPP_B31, 0xC));
  return (unsigned)__builtin_amdgcn_readlane((int)x, 63);
}
DI void wave_argmax(float& v, int& idx) {
#define AM_STEP(CTRL, RM)                                                                                                   \
  {                                                                                                                         \
    const float ov_ = __int_as_float(__builtin_amdgcn_update_dpp(__float_as_int(v), __float_as_int(v), CTRL, RM, 0xF, false)); \
    const int oi_ = __builtin_amdgcn_update_dpp(idx, idx, CTRL, RM, 0xF, false);                                            \
    const bool tk_ = ov_ > v || (ov_ == v && oi_ < idx);                                                                    \
    v = tk_ ? ov_ : v;                                                                                                      \
    idx = tk_ ? oi_ : idx;                                                                                                  \
  }
  AM_STEP(DPP_QP1, 0xF) AM_STEP(DPP_QP2, 0xF) AM_STEP(DPP_RHM, 0xF) AM_STEP(DPP_RM, 0xF) AM_STEP(DPP_B15, 0xA) AM_STEP(DPP_B31, 0xC)
#undef AM_STEP
  v = __int_as_float(__builtin_amdgcn_readlane(__float_as_int(v), 63));
  idx = __builtin_amdgcn_readlane(idx, 63);
}
DI float rdlane(float v, int l) { return __int_as_float(__builtin_amdgcn_readlane(__float_as_int(v), l)); }
DI int rdlane_i(int v, int l) { return __builtin_amdgcn_readlane(v, l); }
DI int TIDX() { int t = threadIdx.x & 255; asm volatile("" : "+v"(t)); return t; }
DI int TIDX8() { int t = threadIdx.x; asm volatile("" : "+v"(t)); return t; }
DI void hb_sync() {
  asm volatile("s_waitcnt vmcnt(0) lgkmcnt(0)" ::: "memory");
  const int vb = __builtin_amdgcn_readfirstlane((int)(threadIdx.x >> 8));
  volatile __attribute__((address_space(3))) unsigned* cnt = (volatile __attribute__((address_space(3))) unsigned*)(g_smem + 2 * HALF_LDS + 64) + vb * 8;
  if ((threadIdx.x & 63) == 0) {
    const unsigned old = __hip_atomic_fetch_add((__attribute__((address_space(3))) unsigned*)cnt, 1u, __ATOMIC_RELAXED, __HIP_MEMORY_SCOPE_WORKGROUP);
    const unsigned target = (old & ~3u) + 4u;
    while ((int)(*cnt - target) < 0) __builtin_amdgcn_s_sleep(0);
  }
  asm volatile("s_waitcnt lgkmcnt(0)" ::: "memory");
  __builtin_amdgcn_wave_barrier();
}
DI void cbar(const void* p) { asm volatile("" ::"v"(p) : "memory"); }
DI void wave_sync() { asm volatile("s_waitcnt lgkmcnt(0)" ::: "memory"); __builtin_amdgcn_wave_barrier(); }
DI float sigmoidf(float x) { return 1.f / (1.f + __expf(-x)); }
DI float siluf(float x) { return x / (1.f + __expf(-x)); }
DI float gelu_tanh(float x) { float u = 0.7978845608028654f * (x + 0.044715f * x * x * x); float e = __expf(2.f * u); float th = 1.f - 2.f / (e + 1.f); return 0.5f * x * (1.f + th); }


#define XB_TMO      128
#define XB_XCNT(j)  (256  + 64 * (j))
#define XB_XSUB(j)  (1280 + 64 * (j))
#define XB_XGEN(j)  (2304 + 64 * (j))
#define XB_TOP      3328
#define XB_TOPGEN   3392
#define XCD_BAR_WORDS 3456
#define XB_SPIN_CAP (1u << 22)
#define LAS __attribute__((address_space(3)))
DI unsigned xb_ld(unsigned* p) { return __hip_atomic_load(p, __ATOMIC_RELAXED, __HIP_MEMORY_SCOPE_AGENT); }
DI unsigned xb_add(unsigned* p, unsigned v) { return __hip_atomic_fetch_add(p, v, __ATOMIC_RELAXED, __HIP_MEMORY_SCOPE_AGENT); }
DI unsigned xb_xcc_id() { return (unsigned)__builtin_amdgcn_s_getreg((3 << 11) | 20) & 0xFu; }
#define XB_SPIN(cond, bar) do { unsigned _sp = 0; while (cond) { __builtin_amdgcn_s_sleep(1); \
    if ((++_sp & 255u) == 0u) { if (xb_ld(&(bar)[XB_TMO])) break; if (_sp > XB_SPIN_CAP) { atomicAdd(&(bar)[XB_TMO], 1u); break; } } } } while (0)
struct XcdBarrier { unsigned* bar; unsigned x; volatile LAS unsigned* st; };
DI XcdBarrier xcd_barrier_post(unsigned* bar, volatile LAS unsigned* st) {
  XcdBarrier b; b.bar = bar; b.x = xb_xcc_id(); b.st = st;
  if (threadIdx.x == 0) (void)xb_add(&bar[XB_XCNT(b.x)], 1u);
  return b;
}
DI void xcd_barrier_complete(unsigned* bar, unsigned x, unsigned& nloc, unsigned& nx) {
  const unsigned G = gridDim.x * gridDim.y * gridDim.z;
  unsigned sum, cnt, mine, sp = 0u;
  for (;;) {
    sum = 0u; cnt = 0u; mine = 0u;
#pragma unroll
    for (unsigned j = 0; j < 16; ++j) { const unsigned c = xb_ld(&bar[XB_XCNT(j)]); sum += c; cnt += (c > 0u) ? 1u : 0u; mine = (j == x) ? c : mine; }
    if (sum == G) break;
    __builtin_amdgcn_s_sleep(1);
    if ((++sp & 255u) == 0u) { if (xb_ld(&bar[XB_TMO])) break; if (sp > XB_SPIN_CAP) { atomicAdd(&bar[XB_TMO], 1u); break; } }
  }
  nloc = mine > 0u ? mine : 1u; nx = cnt > 0u ? cnt : 1u;
}
DI void xcd_barrier(const XcdBarrier& b) {
  asm volatile("s_waitcnt vmcnt(0)" ::: "memory");
  __syncthreads();
  if (threadIdx.x == 0) {
    unsigned* bar = b.bar;
    __builtin_amdgcn_s_waitcnt(0);
    unsigned nloc = b.st[0], nx = b.st[1];
    if (nloc == 0u) { xcd_barrier_complete(bar, b.x, nloc, nx); b.st[0] = nloc; b.st[1] = nx; }
    const unsigned old = xb_add(&bar[XB_XSUB(b.x)], 1u);
    const unsigned gen = old / nloc;
    if (old + 1u == (gen + 1u) * nloc) {
      __builtin_amdgcn_fence(__ATOMIC_RELEASE, "agent");
      asm volatile("s_waitcnt vmcnt(0)" ::: "memory");
      const unsigned og = xb_add(&bar[XB_TOP], 1u);
      const unsigned tg = og / nx;
      if (og + 1u == (tg + 1u) * nx) xb_add(&bar[XB_TOPGEN], 1u);
      else XB_SPIN(xb_ld(&bar[XB_TOPGEN]) == tg, bar);
      __builtin_amdgcn_fence(__ATOMIC_ACQUIRE, "agent");
      xb_add(&bar[XB_XGEN(b.x)], 1u);
      asm volatile("s_waitcnt vmcnt(0)" ::: "memory");
    } else {
      XB_SPIN(xb_ld(&bar[XB_XGEN(b.x)]) == gen, bar);
      __builtin_amdgcn_fence(__ATOMIC_ACQUIRE, "agent");
      asm volatile("s_waitcnt vmcnt(0)" ::: "memory");
    }
  }
  __syncthreads();
}

template <bool SWAP = true, bool SINGLE = false, bool BT16 = false, class AF, class BF, class EF>
DI void gemm_tile(char* smem, int nk, long a_kstep, const AF& af, const BF& bf, const EF& ef) {
  asm volatile("" ::: "memory");
  u16* As = (u16*)smem;
  const int tid = TIDX(), lane = tid & 63, wid = __builtin_amdgcn_readfirstlane(tid >> 6), wm = wid >> 1, wn = wid & 1;
  const int arow = tid >> 1, ahalf = tid & 1;
  const u16* ap = af(arow) + ahalf * 32;
  const int bkq = lane & 7, bnq = wid * 8 + (lane >> 3);
  const long ldb = bf.ldb;
  const float* bp = nullptr;
  const u16* bp16 = nullptr;
  if constexpr (BT16) bp16 = bf.row(arow) + ahalf * 32;
  else bp = bf(bnq * 4) + (long)(bkq * 4) * ldb;
  uint4 sa0_0, sa0_1, sa0_2, sa0_3, sa1_0, sa1_1, sa1_2, sa1_3;
  float4 sb0_0, sb0_1, sb0_2, sb0_3, sb0_4, sb0_5, sb0_6, sb0_7, sb1_0, sb1_1, sb1_2, sb1_3, sb1_4, sb1_5, sb1_6, sb1_7;
  uint4 tb0_0, tb0_1, tb0_2, tb0_3, tb1_0, tb1_1, tb1_2, tb1_3;
  f32x16 acc[2][2];
#pragma unroll
  for (int a = 0; a < 2; ++a)
#pragma unroll
    for (int b = 0; b < 2; ++b)
#pragma unroll
      for (int i = 0; i < 16; ++i) acc[a][b][i] = 0.f;

#define GEMM_LOAD(S, KT)                                                                  \
  {                                                                                       \
    const uint4* pa_ = (const uint4*)(ap + (long)(KT) * a_kstep);                         \
    sa##S##_0 = pa_[0]; sa##S##_1 = pa_[1]; sa##S##_2 = pa_[2]; sa##S##_3 = pa_[3];       \
    if constexpr (BT16) {                                                                 \
      const uint4* pt_ = (const uint4*)(bp16 + (long)(KT) * 64);                          \
      tb##S##_0 = pt_[0]; tb##S##_1 = pt_[1]; tb##S##_2 = pt_[2]; tb##S##_3 = pt_[3];     \
    } else {                                                                              \
      const float* pb_ = bp + (long)(KT) * 64 * ldb;                                      \
      sb##S##_0 = *(const float4*)(pb_);                                                  \
      sb##S##_1 = *(const float4*)(pb_ + ldb);                                            \
      sb##S##_2 = *(const float4*)(pb_ + 2 * ldb);                                        \
      sb##S##_3 = *(const float4*)(pb_ + 3 * ldb);                                        \
      sb##S##_4 = *(const float4*)(pb_ + 32 * ldb);                                       \
      sb##S##_5 = *(const float4*)(pb_ + 33 * ldb);                                       \
      sb##S##_6 = *(const float4*)(pb_ + 34 * ldb);                                       \
      sb##S##_7 = *(const float4*)(pb_ + 35 * ldb);                                       \
    }                                                                                     \
  }
#define GEMM_BW(V0, V1, V2, V3, C, I, QOFF)                                               \
  {                                                                                       \
    uint2 w_;                                                                             \
    w_.x = pack2(V0.C, V1.C);                                                             \
    w_.y = pack2(V2.C, V3.C);                                                             \
    *(uint2*)&Bs_[(bnq * 4 + (I)) * 72 + (QOFF) + bkq * 4] = w_;                          \
  }
#define GEMM_STORE(S, BUF)                                                                \
  {                                                                                       \
    u16* As_ = As + (BUF) * (2 * 128 * 72);                                               \
    u16* Bs_ = As_ + 128 * 72;                                                            \
    uint4* da_ = (uint4*)&As_[arow * 72 + ahalf * 32];                                    \
    da_[0] = sa##S##_0; da_[1] = sa##S##_1; da_[2] = sa##S##_2; da_[3] = sa##S##_3;       \
    if constexpr (BT16) {                                                                 \
      uint4* db_ = (uint4*)&Bs_[arow * 72 + ahalf * 32];                                  \
      db_[0] = tb##S##_0; db_[1] = tb##S##_1; db_[2] = tb##S##_2; db_[3] = tb##S##_3;     \
    } else {                                                                              \
      GEMM_BW(sb##S##_0, sb##S##_1, sb##S##_2, sb##S##_3, x, 0, 0)                        \
      GEMM_BW(sb##S##_0, sb##S##_1, sb##S##_2, sb##S##_3, y, 1, 0)                        \
      GEMM_BW(sb##S##_0, sb##S##_1, sb##S##_2, sb##S##_3, z, 2, 0)                        \
      GEMM_BW(sb##S##_0, sb##S##_1, sb##S##_2, sb##S##_3, w, 3, 0)                        \
      GEMM_BW(sb##S##_4, sb##S##_5, sb##S##_6, sb##S##_7, x, 0, 32)                       \
      GEMM_BW(sb##S##_4, sb##S##_5, sb##S##_6, sb##S##_7, y, 1, 32)                       \
      GEMM_BW(sb##S##_4, sb##S##_5, sb##S##_6, sb##S##_7, z, 2, 32)                       \
      GEMM_BW(sb##S##_4, sb##S##_5, sb##S##_6, sb##S##_7, w, 3, 32)                       \
    }                                                                                     \
  }
#define GEMM_COMPUTE(BUF)                                                                 \
  {                                                                                       \
    const u16* Ac = As + (BUF) * (2 * 128 * 72);                                          \
    const u16* Bc = Ac + 128 * 72;                                                        \
    _Pragma("unroll") for (int ks = 0; ks < 4; ++ks) {                                    \
      bf16x8 a[2], b[2];                                                                  \
      _Pragma("unroll") for (int mt = 0; mt < 2; ++mt) a[mt] = *(const bf16x8*)&Ac[(wm * 64 + mt * 32 + (lane & 31)) * 72 + ks * 16 + (lane >> 5) * 8]; \
      _Pragma("unroll") for (int nt = 0; nt < 2; ++nt) b[nt] = *(const bf16x8*)&Bc[(wn * 64 + nt * 32 + (lane & 31)) * 72 + ks * 16 + (lane >> 5) * 8]; \
      _Pragma("unroll") for (int mt = 0; mt < 2; ++mt)                                    \
      _Pragma("unroll") for (int nt = 0; nt < 2; ++nt)                                    \
        acc[mt][nt] = SWAP ? __builtin_amdgcn_mfma_f32_32x32x16_bf16(b[nt], a[mt], acc[mt][nt], 0, 0, 0) \
                           : __builtin_amdgcn_mfma_f32_32x32x16_bf16(a[mt], b[nt], acc[mt][nt], 0, 0, 0); \
    }                                                                                     \
  }
  GEMM_LOAD(0, 0)
  hb_sync();
  if (SINGLE) {
    GEMM_STORE(0, 0)
    hb_sync();
    GEMM_COMPUTE(0)
  } else {
    GEMM_LOAD(1, 1)
    GEMM_STORE(0, 0)
    hb_sync();
    const int last = nk - 1;
    for (int kt = 0; kt < nk; kt += 2) {
      const int k2 = kt + 2 < last ? kt + 2 : last, k3 = kt + 3 < last ? kt + 3 : last;
      GEMM_LOAD(0, k2)
      asm volatile("" ::: "memory");
      GEMM_COMPUTE(0)
      asm volatile("" ::: "memory");
      GEMM_STORE(1, 1)
      hb_sync();
      GEMM_LOAD(1, k3)
      asm volatile("" ::: "memory");
      GEMM_COMPUTE(1)
      asm volatile("" ::: "memory");
      GEMM_STORE(0, 0)
      hb_sync();
    }
  }
#undef GEMM_LOAD
#undef GEMM_STORE
#undef GEMM_BW
#undef GEMM_COMPUTE
  ef(acc, wm, wn, lane);
}

template <bool BT16, class AF, class BF, class EF>
DI void gemm_tile256(char* smem, int nk, const AF& af, const BF& bf, const EF& ef) {
  asm volatile("" ::: "memory");
  u16* As = (u16*)smem;
  u16* Bs = As + 256 * 72;
  const int tid = TIDX(), lane = tid & 63, wid = __builtin_amdgcn_readfirstlane(tid >> 6), wm = wid >> 1, wn = wid & 1;
  const int piece = tid & 7, rbase = tid >> 3;
  const u16* abase = af(0);
  int ao0, ao1, ao2, ao3, ao4, ao5, ao6, ao7;
  ao0 = (int)(af(rbase) - abase) + piece * 8;        ao1 = (int)(af(rbase + 32) - abase) + piece * 8;
  ao2 = (int)(af(rbase + 64) - abase) + piece * 8;   ao3 = (int)(af(rbase + 96) - abase) + piece * 8;
  ao4 = (int)(af(rbase + 128) - abase) + piece * 8;  ao5 = (int)(af(rbase + 160) - abase) + piece * 8;
  ao6 = (int)(af(rbase + 192) - abase) + piece * 8;  ao7 = (int)(af(rbase + 224) - abase) + piece * 8;
  const u16* bp16 = nullptr; long bstride = 0;
  const float* bp = nullptr; long ldb = 0;
  const int bkq = lane & 7, bnq = wid * 8 + (lane >> 3);
  if constexpr (BT16) { bp16 = bf.row(rbase) + piece * 8; bstride = bf.ldb * 32; }
  else { ldb = bf.ldb; bp = bf(bnq * 4) + (long)(bkq * 4) * ldb; }
  uint4 ra0, ra1, ra2, ra3, ra4, ra5, ra6, ra7, rb0, rb1, rb2, rb3;
  float4 fb0, fb1, fb2, fb3, fb4, fb5, fb6, fb7;
  f32x16 acc[4][2];
#pragma unroll
  for (int a = 0; a < 4; ++a)
#pragma unroll
    for (int b = 0; b < 2; ++b)
#pragma unroll
      for (int i = 0; i < 16; ++i) acc[a][b][i] = 0.f;
#define G256_LOAD(KT)                                                   \
  {                                                                     \
    const u16* pa_ = abase + (long)(KT) * 64;                           \
    ra0 = *(const uint4*)(pa_ + ao0); ra1 = *(const uint4*)(pa_ + ao1); \
    ra2 = *(const uint4*)(pa_ + ao2); ra3 = *(const uint4*)(pa_ + ao3); \
    ra4 = *(const uint4*)(pa_ + ao4); ra5 = *(const uint4*)(pa_ + ao5); \
    ra6 = *(const uint4*)(pa_ + ao6); ra7 = *(const uint4*)(pa_ + ao7); \
    if constexpr (BT16) {                                               \
      const u16* pb_ = bp16 + (long)(KT) * 64;                          \
      rb0 = *(const uint4*)(pb_);                                       \
      rb1 = *(const uint4*)(pb_ + bstride);                             \
      rb2 = *(const uint4*)(pb_ + 2 * bstride);                         \
      rb3 = *(const uint4*)(pb_ + 3 * bstride);                         \
    } else {                                                            \
      const float* pf_ = bp + (long)(KT) * 64 * ldb;                    \
      fb0 = *(const float4*)(pf_);            fb1 = *(const float4*)(pf_ + ldb);      \
      fb2 = *(const float4*)(pf_ + 2 * ldb);  fb3 = *(const float4*)(pf_ + 3 * ldb);  \
      fb4 = *(const float4*)(pf_ + 32 * ldb); fb5 = *(const float4*)(pf_ + 33 * ldb); \
      fb6 = *(const float4*)(pf_ + 34 * ldb); fb7 = *(const float4*)(pf_ + 35 * ldb); \
    }                                                                   \
  }
#define G256_BW(V0, V1, V2, V3, C, I, QOFF)                             \
  {                                                                     \
    uint2 w_;                                                           \
    w_.x = pack2(V0.C, V1.C);                                           \
    w_.y = pack2(V2.C, V3.C);                                           \
    *(uint2*)&Bs[(bnq * 4 + (I)) * 72 + (QOFF) + bkq * 4] = w_;         \
  }
  G256_LOAD(0)
  const int last = nk - 1;
  for (int kt = 0; kt < nk; ++kt) {
    hb_sync();
    {
      u16* da = As + rbase * 72 + piece * 8;
      *(uint4*)(da) = ra0;            *(uint4*)(da + 32 * 72) = ra1;  *(uint4*)(da + 64 * 72) = ra2;  *(uint4*)(da + 96 * 72) = ra3;
      *(uint4*)(da + 128 * 72) = ra4; *(uint4*)(da + 160 * 72) = ra5; *(uint4*)(da + 192 * 72) = ra6; *(uint4*)(da + 224 * 72) = ra7;
      if constexpr (BT16) {
        u16* db = Bs + rbase * 72 + piece * 8;
        *(uint4*)(db) = rb0; *(uint4*)(db + 32 * 72) = rb1; *(uint4*)(db + 64 * 72) = rb2; *(uint4*)(db + 96 * 72) = rb3;
      } else {
        G256_BW(fb0, fb1, fb2, fb3, x, 0, 0)  G256_BW(fb0, fb1, fb2, fb3, y, 1, 0)
        G256_BW(fb0, fb1, fb2, fb3, z, 2, 0)  G256_BW(fb0, fb1, fb2, fb3, w, 3, 0)
        G256_BW(fb4, fb5, fb6, fb7, x, 0, 32) G256_BW(fb4, fb5, fb6, fb7, y, 1, 32)
        G256_BW(fb4, fb5, fb6, fb7, z, 2, 32) G256_BW(fb4, fb5, fb6, fb7, w, 3, 32)
      }
    }
    hb_sync();
    const int kn = kt + 1 < last ? kt + 1 : last;
    G256_LOAD(kn)
    asm volatile("" ::: "memory");
#pragma unroll
    for (int ks = 0; ks < 4; ++ks) {
      bf16x8 a[4], b[2];
#pragma unroll
      for (int mt = 0; mt < 4; ++mt) a[mt] = *(const bf16x8*)&As[(wm * 128 + mt * 32 + (lane & 31)) * 72 + ks * 16 + (lane >> 5) * 8];
#pragma unroll
      for (int nt = 0; nt < 2; ++nt) b[nt] = *(const bf16x8*)&Bs[(wn * 64 + nt * 32 + (lane & 31)) * 72 + ks * 16 + (lane >> 5) * 8];
#pragma unroll
      for (int mt = 0; mt < 4; ++mt)
#pragma unroll
        for (int nt = 0; nt < 2; ++nt) acc[mt][nt] = __builtin_amdgcn_mfma_f32_32x32x16_bf16(b[nt], a[mt], acc[mt][nt], 0, 0, 0);
    }
    asm volatile("" ::: "memory");
  }
#undef G256_LOAD
#undef G256_BW
  ef(acc, wm, wn, lane);
}

template <bool BT16, class AF, class BF, class EF>
DI void gemm8w(int nk, const AF& af, const BF& bf, const EF& ef) {
  asm volatile("" ::: "memory");
  u16* S0 = (u16*)g_smem;
  int tid = threadIdx.x; asm volatile("" : "+v"(tid));
  const int lane = tid & 63, wid = __builtin_amdgcn_readfirstlane(tid >> 6), wm = wid >> 2, wn = wid & 3;
  const int piece = tid & 7, rbase = tid >> 3;
  const u16* abase = af.origin();
  const int ao0 = af.off(rbase) + piece * 8, ao1 = af.off(rbase + 64) + piece * 8, ao2 = af.off(rbase + 128) + piece * 8, ao3 = af.off(rbase + 192) + piece * 8;
  const u16 *bq0 = nullptr, *bq1 = nullptr, *bq2 = nullptr, *bq3 = nullptr;
  const float* bp = nullptr; long ldb = 0;
  const int bkq = lane & 7, bnq = wid * 8 + (lane >> 3);
  if constexpr (BT16) { bq0 = bf.row(rbase) + piece * 8; bq1 = bf.row(rbase + 64) + piece * 8; bq2 = bf.row(rbase + 128) + piece * 8; bq3 = bf.row(rbase + 192) + piece * 8; }
  else { ldb = bf.ldb; bp = bf(bnq * 4) + (long)(bkq * 4) * ldb; }
  uint4 ra0, ra1, ra2, ra3, rb0, rb1, rb2, rb3;
  float4 fb0, fb1, fb2, fb3, fb4, fb5, fb6, fb7;
  f32x16 acc[4][2];
#pragma unroll
  for (int a = 0; a < 4; ++a)
#pragma unroll
    for (int b = 0; b < 2; ++b)
#pragma unroll
      for (int i = 0; i < 16; ++i) acc[a][b][i] = 0.f;
#define G8_LOAD(KT)                                                     \
  {                                                                     \
    const u16* pa_ = abase + (long)(KT) * 64;                           \
    ra0 = *(const uint4*)(pa_ + ao0); ra1 = *(const uint4*)(pa_ + ao1); \
    ra2 = *(const uint4*)(pa_ + ao2); ra3 = *(const uint4*)(pa_ + ao3); \
    if constexpr (BT16) {                                               \
      rb0 = *(const uint4*)(bq0 + (long)(KT) * 64); rb1 = *(const uint4*)(bq1 + (long)(KT) * 64); \
      rb2 = *(const uint4*)(bq2 + (long)(KT) * 64); rb3 = *(const uint4*)(bq3 + (long)(KT) * 64); \
    } else {                                                            \
      const float* pf_ = bp + (long)(KT) * 64 * ldb;                    \
      fb0 = *(const float4*)(pf_);            fb1 = *(const float4*)(pf_ + ldb);      \
      fb2 = *(const float4*)(pf_ + 2 * ldb);  fb3 = *(const float4*)(pf_ + 3 * ldb);  \
      fb4 = *(const float4*)(pf_ + 32 * ldb); fb5 = *(const float4*)(pf_ + 33 * ldb); \
      fb6 = *(const float4*)(pf_ + 34 * ldb); fb7 = *(const float4*)(pf_ + 35 * ldb); \
    }                                                                   \
  }
#define G8_BW(V0, V1, V2, V3, C, I, QOFF)                               \
  {                                                                     \
    uint2 w_;                                                           \
    w_.x = pack2(V0.C, V1.C);                                           \
    w_.y = pack2(V2.C, V3.C);                                           \
    *(uint2*)&Bs_[(bnq * 4 + (I)) * 72 + (QOFF) + bkq * 4] = w_;        \
  }
#define G8_STORE(BUF)                                                   \
  {                                                                     \
    u16* As_ = S0 + (BUF) * (512 * 72);                                 \
    u16* Bs_ = As_ + 256 * 72;                                          \
    u16* da = As_ + rbase * 72 + piece * 8;                             \
    *(uint4*)(da) = ra0; *(uint4*)(da + 64 * 72) = ra1; *(uint4*)(da + 128 * 72) = ra2; *(uint4*)(da + 192 * 72) = ra3; \
    if constexpr (BT16) {                                               \
      u16* db = Bs_ + rbase * 72 + piece * 8;                           \
      *(uint4*)(db) = rb0; *(uint4*)(db + 64 * 72) = rb1; *(uint4*)(db + 128 * 72) = rb2; *(uint4*)(db + 192 * 72) = rb3; \
    } else {                                                            \
      G8_BW(fb0, fb1, fb2, fb3, x, 0, 0)  G8_BW(fb0, fb1, fb2, fb3, y, 1, 0)   \
      G8_BW(fb0, fb1, fb2, fb3, z, 2, 0)  G8_BW(fb0, fb1, fb2, fb3, w, 3, 0)   \
      G8_BW(fb4, fb5, fb6, fb7, x, 0, 32) G8_BW(fb4, fb5, fb6, fb7, y, 1, 32)  \
      G8_BW(fb4, fb5, fb6, fb7, z, 2, 32) G8_BW(fb4, fb5, fb6, fb7, w, 3, 32)  \
    }                                                                   \
  }
  G8_LOAD(0)
  __syncthreads();
  G8_STORE(0)
  __syncthreads();
  const int last = nk - 1;
  for (int kt = 0; kt < nk; ++kt) {
    const int kn = kt + 1 < last ? kt + 1 : last;
    G8_LOAD(kn)
    asm volatile("" ::: "memory");
    {
      const u16* Ac = S0 + (kt & 1) * (512 * 72);
      const u16* Bc = Ac + 256 * 72;
#pragma unroll
      for (int ks = 0; ks < 4; ++ks) {
        bf16x8 a[4], b[2];
#pragma unroll
        for (int mt = 0; mt < 4; ++mt) a[mt] = *(const bf16x8*)&Ac[(wm * 128 + mt * 32 + (lane & 31)) * 72 + ks * 16 + (lane >> 5) * 8];
#pragma unroll
        for (int nt = 0; nt < 2; ++nt) b[nt] = *(const bf16x8*)&Bc[(wn * 64 + nt * 32 + (lane & 31)) * 72 + ks * 16 + (lane >> 5) * 8];
#pragma unroll
        for (int mt = 0; mt < 4; ++mt)
#pragma unroll
          for (int nt = 0; nt < 2; ++nt) acc[mt][nt] = __builtin_amdgcn_mfma_f32_32x32x16_bf16(b[nt], a[mt], acc[mt][nt], 0, 0, 0);
      }
    }
    asm volatile("" ::: "memory");
    if (kt + 1 < nk) {
      G8_STORE((kt + 1) & 1)
      __syncthreads();
    }
  }
#undef G8_LOAD
#undef G8_BW
#undef G8_STORE
  ef(acc, wm, wn, lane);
}

#define EPI_FOR                                                   \
  _Pragma("unroll") for (int mt = 0; mt < 2; ++mt)                \
  _Pragma("unroll") for (int nt = 0; nt < 2; ++nt)                \
  _Pragma("unroll") for (int i = 0; i < 16; ++i)
#define EPI_R (wm * 64 + mt * 32 + (i & 3) + 8 * (i >> 2) + 4 * (lane >> 5))
#define EPI_C (wn * 64 + nt * 32 + (lane & 31))
#define SW_FOR                                                    \
  _Pragma("unroll") for (int mt = 0; mt < MT; ++mt)               \
  _Pragma("unroll") for (int nt = 0; nt < 2; ++nt)                \
  _Pragma("unroll") for (int q4 = 0; q4 < 4; ++q4)
#define SW_R (wm * (32 * MT) + mt * 32 + (lane & 31))
#define SW_C0 (wn * 64 + nt * 32 + 8 * q4 + 4 * (lane >> 5))
#define SW_V(j) acc[mt][nt][4 * q4 + (j)]
DI uint2 pack4(float a, float b, float c, float d) { uint2 w; w.x = pack2(a, b); w.y = pack2(c, d); return w; }

struct ARows { const u16* base; long ld; int nrows; DI const u16* operator()(int r) const { return base + (long)(r < nrows ? r : 0) * ld; }
  DI const u16* origin() const { return base; } DI int off(int r) const { return (r < nrows ? r : 0) * (int)ld; } };
struct BMat { const float* base; long ldb; int ncols; DI const float* operator()(int c4) const { return base + (c4 < ncols ? c4 : 0); } DI const u16* row(int) const { return nullptr; } };
struct BMatT { const u16* base; long ldb; DI const float* operator()(int) const { return nullptr; } DI const u16* row(int n) const { return base + (long)n * ldb; } };

DI void phase0(const Params& p, char* smem, int bid, int nblk) {
  const int tid = TIDX();
  for (int item = bid; item < 384 + 256 + 16 + 1 + 1728; item += nblk) {
    if (item < 384) {
      const int cc = item % 24, kc = item / 24;
      const int col = cc * 256 + tid;
      float a0 = 0.f, a1 = 0.f;
#pragma unroll 1
      for (int half = 0; half < 2; ++half) {
        const int k0 = kc * 64 + half * 32;
        float w[32];
#pragma unroll
        for (int j = 0; j < 32; ++j) w[j] = p.w_ada[(long)(k0 + j) * 6144 + col];
#pragma unroll
        for (int j = 0; j < 32; ++j) {
          a0 += siluf(p.c[k0 + j]) * w[j];
          a1 += siluf(p.c[1024 + k0 + j]) * w[j];
        }
      }
      p.modp[(kc * 2 + 0) * 6144 + col] = a0;
      p.modp[(kc * 2 + 1) * 6144 + col] = a1;
    } else if (item < 640) {
      const int idx = (item - 384) * 256 + tid;
      const int c = idx & 127, d = (idx >> 7) & 63, h = idx >> 13;
      p.w_ukT[idx] = p.dsa_w_uk[c * 512 + h * 64 + d];
    } else if (item < 656) {
      const int part = item - 640;
      const int slot = tid >> 7, kk = tid & 127;
      float a = 0.f;
      for (int ld = part * 128; ld < part * 128 + 128; ++ld) a += p.cmp_pe[slot * 2048 + ld] * p.cmp_w1[((long)slot * 2048 + ld) * 128 + kk];
      p.pe_part[part * 256 + tid] = a;
    } else if (item == 656) {
      p.counts[tid] = 0;
    } else {
      int it = item - 657;
      const float* W; u16* WT; int K, N, ntn;
      if (it < 1152) { W = p.w_in; WT = p.w_inT; K = 1024; N = LDP; ntn = 72; }
      else if (it < 1280) { it -= 1152; W = p.w_bn; WT = p.w_bnT; K = 512; N = 1024; ntn = 16; }
      else if (it < 1408) { it -= 1280; W = p.w_bd; WT = p.w_bdT; K = 512; N = 1024; ntn = 16; }
      else if (it < 1664) { it -= 1408; W = p.w_out; WT = p.w_outT; K = 1024; N = 1024; ntn = 16; }
      else { it -= 1664; W = p.router_w; WT = p.routerT; K = 1024; N = 256; ntn = 4; }
      const int k0 = (it / ntn) * 64, n0 = (it % ntn) * 64;
      u16* tl = (u16*)smem;
      hb_sync();
      const int kr = tid >> 4, nq = tid & 15;
#pragma unroll
      for (int ps = 0; ps < 4; ++ps) {
        const int k = kr + 16 * ps, n = n0 + nq * 4;
        float4 v = make_float4(0.f, 0.f, 0.f, 0.f);
        if (n < N) v = *(const float4*)(W + (long)(k0 + k) * N + n);
        tl[(nq * 4 + 0) * 72 + k] = f2bf(v.x);
        tl[(nq * 4 + 1) * 72 + k] = f2bf(v.y);
        tl[(nq * 4 + 2) * 72 + k] = f2bf(v.z);
        tl[(nq * 4 + 3) * 72 + k] = f2bf(v.w);
      }
      hb_sync();
      const int nr = tid >> 2, piece = tid & 3;
      const uint4 a = *(const uint4*)(tl + nr * 72 + piece * 16);
      const uint4 b = *(const uint4*)(tl + nr * 72 + piece * 16 + 8);
      uint4* dst = (uint4*)(WT + (long)(n0 + nr) * K + k0 + piece * 16);
      dst[0] = a; dst[1] = b;
    }
  }
}

DI void phase1(const Params& p, char* smem, int bid, int nblk) {
  const int tid = TIDX(), lane = tid & 63, wid = __builtin_amdgcn_readfirstlane(tid >> 6);
  float* modl = (float*)smem;
  for (int idx = tid; idx < 4096; idx += 256) {
    const int b = idx >> 11, n = idx & 2047;
    float v = p.b_ada[n];
    for (int kc = 0; kc < 16; ++kc) v += p.modp[(kc * 2 + b) * 6144 + n];
    modl[idx] = v;
  }
  if (bid < 48) {
    const int idx = bid * 256 + tid;
    const int b = idx / 6144, n = idx % 6144;
    float v = p.b_ada[n];
    for (int kc = 0; kc < 16; ++kc) v += p.modp[(kc * 2 + b) * 6144 + n];
    p.mod[idx] = v;
  }
  hb_sync();
  for (int row = bid * 4 + wid; row < NTOK; row += nblk * 4) {
    const int b = row >> 13;
    const float* xr = p.x + (long)row * 1024;
    float4 v[4];
    float ss = 0.f;
#pragma unroll
    for (int i = 0; i < 4; ++i) {
      v[i] = *(const float4*)(xr + i * 256 + lane * 4);
      ss += v[i].x * v[i].x + v[i].y * v[i].y + v[i].z * v[i].z + v[i].w * v[i].w;
    }
    ss = wave_sum(ss);
    const float r = rsqrtf(ss * (1.f / 1024.f) + 1e-6f);
#pragma unroll
    for (int i = 0; i < 4; ++i) {
      const int col = i * 256 + lane * 4;
      const float4 g = *(const float4*)(p.g_pre_mix + col);
      const float* sh = modl + b * 2048 + col;
      const float* sc = modl + b * 2048 + 1024 + col;
      const float o0 = v[i].x * r * g.x * (1.f + sc[0]) + sh[0];
      const float o1 = v[i].y * r * g.y * (1.f + sc[1]) + sh[1];
      const float o2 = v[i].z * r * g.z * (1.f + sc[2]) + sh[2];
      const float o3 = v[i].w * r * g.w * (1.f + sc[3]) + sh[3];
      uint2 w;
      w.x = pack2(o0, o1);
      w.y = pack2(o2, o3);
      *(uint2*)(p.h + (long)row * 1024 + col) = w;
    }
  }
}

struct EpiProj {
  u16* proj; float* widx; int m0, n0;
  template <int MT> DI void operator()(f32x16 (&acc)[MT][2], int wm, int wn, int lane) const {
    SW_FOR {
      const int r = m0 + SW_R, c = n0 + SW_C0;
      if (c < LDP) {
        float v[4] = {SW_V(0), SW_V(1), SW_V(2), SW_V(3)};
        if (c < C_KV) { for (int j = 0; j < 4; ++j) v[j] *= 0.125f; }
        else if (c < C_GN) {}
        else if (c < C_QD) { for (int j = 0; j < 4; ++j) v[j] = sigmoidf(v[j]); }
        else if (c < C_QI) {}
        else if (c < C_KI) { for (int j = 0; j < 4; ++j) v[j] *= 0.125f; }
        else if (c < C_WI) {}
        else if (c < C_GM) {
          for (int j = 0; j < 4; ++j) v[j] *= 0.35355339059327373f;
          *(float4*)(widx + (long)r * 8 + (c - C_WI)) = make_float4(v[0], v[1], v[2], v[3]);
        } else { for (int j = 0; j < 4; ++j) v[j] = sigmoidf(v[j]); }
        *(uint2*)(proj + (long)r * LDP + c) = pack4(v[0], v[1], v[2], v[3]);
      }
    }
  }
};
struct EpiProjVT {
  u16* vt; int m0;
  DI void operator()(f32x16 (&acc)[2][2], int wm, int wn, int lane) const {
#pragma unroll
    for (int mt = 0; mt < 2; ++mt)
#pragma unroll
      for (int nt = 0; nt < 2; ++nt) {
        const int cc = EPI_C;
#pragma unroll
        for (int q4 = 0; q4 < 4; ++q4) {
          const int r = m0 + wm * 64 + mt * 32 + 8 * q4 + 4 * (lane >> 5);
          const int b = r >> 13, t = r & 8191;
          uint2 w;
          w.x = pack2(acc[mt][nt][q4 * 4 + 0], acc[mt][nt][q4 * 4 + 1]);
          w.y = pack2(acc[mt][nt][q4 * 4 + 2], acc[mt][nt][q4 * 4 + 3]);
          *(uint2*)(vt + ((long)(b * 128 + cc)) * T + t) = w;
        }
      }
  }
};
DI int proj_group(int q) { return q < 7 ? q : (q < 8 ? q + 1 : q + 2); }
struct BMatT2 { const u16* base; long ldb; int ra, rb; DI const u16* row(int n) const { return base + (long)((n < 128 ? ra : rb) + (n & 127)) * ldb; } };
struct EpiProj8 {
  u16* proj; float* widx; int m0, n0a, n0b;
  template <int MT> DI void operator()(f32x16 (&acc)[MT][2], int wm, int wn, int lane) const {
    EpiProj e{proj, widx, m0, wn < 2 ? n0a : n0b};
    e.template operator()<MT>(acc, wm, wn & 1, lane);
  }
};
DI void phase2_8w(const Params& p, int wg, int nwg) {
  for (int item = wg; item < 1024; item += nwg) {
    const int mt_ = item >> 4, v = item & 15;
    const int ga = proj_group(2 * v), gb = proj_group(2 * v + 1);
    ARows af{p.h + (long)mt_ * 256 * 1024, 1024, 256};
    BMatT2 bf{p.w_inT, 1024, ga * 128, gb * 128};
    EpiProj8 ef{p.proj, p.widx, mt_ * 256, ga * 128, gb * 128};
    gemm8w<true>(16, af, bf, ef);
  }
}
DI void phase2(const Params& p, char* smem, int bid, int nblk) {
  for (int item = bid; item < 128 + 256; item += nblk) {
    if (item < 128) {
      const int mt_ = item >> 1, nt_ = proj_group(32 + (item & 1));
      ARows af{p.h + (long)mt_ * 256 * 1024, 1024, 256};
      BMatT bf{p.w_inT + (long)nt_ * 128 * 1024, 1024};
      EpiProj ef{p.proj, p.widx, mt_ * 256, nt_ * 128};
      gemm_tile256<true>(smem, 16, af, bf, ef);
    } else {
      const int it = item - 128, mt_ = it >> 1, nt_ = (it & 1) ? 9 : 7;
      ARows af{p.h + (long)mt_ * 128 * 1024, 1024, 128};
      BMatT bf{p.w_inT + (long)nt_ * 128 * 1024, 1024};
      EpiProjVT ef{nt_ == 7 ? p.vts : p.vtw, mt_ * 128};
      gemm_tile<false, false, true>(smem, 16, 64, af, bf, ef);
    }
  }
}

struct ACmp {
  const u16* proj; int slot, m0;
  DI const u16* operator()(int r) const {
    const int R = m0 + r, bg = R >> 9, n = R & 511, b = bg >> 1, g = bg & 1;
    const int nc = n >= 511 ? 510 : n;
    return proj + ((long)b * T + 16 * nc) * LDP + C_KV + slot * 128 + g * 64;
  }
};
struct EpiCmp1 {
  u16* zc; const float* b1; const float* pe_part; int slot, m0;
  DI void operator()(f32x16 (&acc)[2][2], int wm, int wn, int lane) const {
    constexpr int MT = 2;
#pragma unroll
    for (int nt = 0; nt < 2; ++nt)
#pragma unroll
      for (int q4 = 0; q4 < 4; ++q4) {
        const int c = SW_C0;
        float4 bias = *(const float4*)(b1 + slot * 128 + c);
        for (int q = 0; q < 16; ++q) {
          const float4 t = *(const float4*)(pe_part + q * 256 + slot * 128 + c);
          bias.x += t.x; bias.y += t.y; bias.z += t.z; bias.w += t.w;
        }
#pragma unroll
        for (int mt = 0; mt < 2; ++mt) {
          const int R = m0 + SW_R;
          *(uint2*)(zc + ((long)slot * 2048 + R) * 128 + c) =
              pack4(gelu_tanh(SW_V(0) + bias.x), gelu_tanh(SW_V(1) + bias.y), gelu_tanh(SW_V(2) + bias.z), gelu_tanh(SW_V(3) + bias.w));
        }
      }
  }
};
struct EpiQlat {
  u16* qlat; int h, m0;
  DI void operator()(f32x16 (&acc)[2][2], int wm, int wn, int lane) const {
    constexpr int MT = 2;
    SW_FOR {
      const int r = m0 + SW_R, c = SW_C0;
      *(uint2*)(qlat + ((long)r * 8 + h) * 128 + c) = pack4(SW_V(0) * 0.125f, SW_V(1) * 0.125f, SW_V(2) * 0.125f, SW_V(3) * 0.125f);
    }
  }
};
DI void indexer_item(const Params& p, char* smem, int item);
DI void phase3(const Params& p, char* smem, int bid, int nblk) {
  const int tid = TIDX(), lane = tid & 63, wid = __builtin_amdgcn_readfirstlane(tid >> 6);
  if (bid < 32) {
    const int slot = bid >> 4, mt_ = bid & 15;
    ACmp af{p.proj, slot, mt_ * 128};
    BMat bf{p.cmp_w1 + (long)slot * 2048 * 128, 128, 128};
    EpiCmp1 ef{p.zc, p.cmp_b1, p.pe_part, slot, mt_ * 128};
    gemm_tile(smem, 32, LDP, af, bf, ef);
    return;
  }
  for (int item = bid - 32; item < 4160 + 1024 + 512; item += nblk - 32) {
    hb_sync();
    if (item < 4160) {
      indexer_item(p, smem, item);
    } else if (item < 4160 + 1024) {
      const int it = item - 4160, h = it & 7, mt_ = it >> 3;
      ARows af{p.proj + (long)mt_ * 128 * LDP + C_QD + h * 64, LDP, 128};
      BMat bf{p.w_ukT + h * 64 * 128, 128, 128};
      EpiQlat ef{p.qlat, h, mt_ * 128};
      gemm_tile<true, true>(smem, 1, 64, af, bf, ef);
    } else {
      const int it = item - 4160 - 1024;
      for (int q = 0; q < 8; ++q) {
        const int row = it * 32 + wid * 8 + q;
        const unsigned u = *(const unsigned*)(p.proj + (long)row * LDP + C_CKV + lane * 2);
        const float a = lo16(u), b = hi16(u);
        const float ss = wave_sum(a * a + b * b);
        const float r = rsqrtf(ss * (1.f / 128.f) + 1e-6f);
        *(unsigned*)(p.ckv + (long)row * 128 + lane * 2) = pack2(a * r * p.dsa_kv_norm[lane * 2], b * r * p.dsa_kv_norm[lane * 2 + 1]);
      }
    }
  }
}

struct EpiCmp2 {
  u16* dst; int m0;
  DI void operator()(f32x16 (&acc)[2][2], int wm, int wn, int lane) const {
    constexpr int MT = 2;
    SW_FOR {
      const int R = m0 + SW_R, c = SW_C0;
      if (c < 64) *(uint2*)(dst + (long)R * 64 + c) = pack4(SW_V(0), SW_V(1), SW_V(2), SW_V(3));
    }
  }
};
struct EpiCmp2T {
  u16* dst; int m0;
  DI void operator()(f32x16 (&acc)[2][2], int wm, int wn, int lane) const {
#pragma unroll
    for (int mt = 0; mt < 2; ++mt)
#pragma unroll
      for (int nt = 0; nt < 2; ++nt) {
        const int c = EPI_C;
        if (c < 64) {
#pragma unroll
          for (int q4 = 0; q4 < 4; ++q4) {
            const int R = m0 + wm * 64 + mt * 32 + 8 * q4 + 4 * (lane >> 5);
            const int bg = R >> 9, n = R & 511;
            *(uint2*)(dst + ((long)(bg * 64 + c)) * 512 + n) =
                pack4(acc[mt][nt][q4 * 4 + 0], acc[mt][nt][q4 * 4 + 1], acc[mt][nt][q4 * 4 + 2], acc[mt][nt][q4 * 4 + 3]);
          }
        }
      }
  }
};
DI void indexer_item(const Params& p, char* smem, int item) {
  const int tid = TIDX(), lane = tid & 63, wid = __builtin_amdgcn_readfirstlane(tid >> 6);
  int b = 0, rem = item;
  if (rem >= 2080) { b = 1; rem -= 2080; }
  int qt = (int)((sqrtf(8.f * rem + 1.f) - 1.f) * 0.5f);
  while ((qt + 1) * (qt + 2) / 2 <= rem) ++qt;
  while (qt * (qt + 1) / 2 > rem) --qt;
  const int kt = rem - qt * (qt + 1) / 2;
  const int t0 = qt * 128 + (wid >> 1) * 64, s0 = kt * 128 + (wid & 1) * 64;
  if (s0 > t0 + 63) return;
  float* wl = (float*)smem + wid * 512;
  const float* wsrc = p.widx + ((long)b * T + t0) * 8;
#pragma unroll
  for (int i = 0; i < 8; ++i) wl[i * 64 + lane] = wsrc[i * 64 + lane];
  wave_sync();
  const u16* projb = p.proj + (long)b * T * LDP;
  const int r31 = lane & 31, hf = lane >> 5;
  u16* Kt = (u16*)(smem + 8192) + wid * (64 * 72);
  {
    const int piece = lane & 7, rb = lane >> 3;
#pragma unroll
    for (int i = 0; i < 8; ++i) {
      const uint4 v = *(const uint4*)(projb + (long)(s0 + rb + 8 * i) * LDP + C_KI + piece * 8);
      *(uint4*)(Kt + (rb + 8 * i) * 72 + piece * 8) = v;
    }
  }
  wave_sync();
  const u16* kfrag = Kt + r31 * 72 + hf * 8;
  f32x16 sum[2][2];
#pragma unroll
  for (int a = 0; a < 2; ++a)
#pragma unroll
    for (int c = 0; c < 2; ++c)
#pragma unroll
      for (int i = 0; i < 16; ++i) sum[a][c][i] = 0.f;
  const u16* qbase = projb + (long)(t0 + r31) * LDP + C_QI + hf * 8;
  bf16x8 af0[4], af1[4], af2[4], af3[4];
#define IDX_LOADQ(DST, STEP)                                                                            \
  {                                                                                                     \
    const int st_ = (STEP) < 15 ? (STEP) : 15;                                                          \
    _Pragma("unroll") for (int ks = 0; ks < 4; ++ks) DST[ks] = *(const bf16x8*)(qbase + (long)(st_ & 1) * 32 * LDP + (st_ >> 1) * 64 + ks * 16); \
  }
#define IDX_STEP(SRC, MT, H)                                                                            \
  {                                                                                                     \
    const float w_ = wl[((MT) * 32 + r31) * 8 + (H)];                                                   \
    _Pragma("unroll") for (int nt = 0; nt < 2; ++nt) {                                                  \
      f32x16 acc;                                                                                       \
      _Pragma("unroll") for (int i = 0; i < 16; ++i) acc[i] = 0.f;                                      \
      _Pragma("unroll") for (int ks = 0; ks < 4; ++ks) acc = __builtin_amdgcn_mfma_f32_32x32x16_bf16(*(const bf16x8*)(kfrag + nt * 32 * 72 + ks * 16), SRC[ks], acc, 0, 0, 0); \
      _Pragma("unroll") for (int i = 0; i < 16; ++i) sum[MT][nt][i] += w_ * fmaxf(acc[i], 0.f);        \
    }                                                                                                   \
  }
  IDX_LOADQ(af0, 0) IDX_LOADQ(af1, 1) IDX_LOADQ(af2, 2)
#pragma unroll 1
  for (int s4 = 0; s4 < 16; s4 += 4) {
    IDX_LOADQ(af3, s4 + 3)
    asm volatile("" ::: "memory");
    IDX_STEP(af0, 0, s4 >> 1)
    asm volatile("" ::: "memory");
    IDX_LOADQ(af0, s4 + 4)
    asm volatile("" ::: "memory");
    IDX_STEP(af1, 1, s4 >> 1)
    asm volatile("" ::: "memory");
    IDX_LOADQ(af1, s4 + 5)
    asm volatile("" ::: "memory");
    IDX_STEP(af2, 0, (s4 >> 1) + 1)
    asm volatile("" ::: "memory");
    IDX_LOADQ(af2, s4 + 6)
    asm volatile("" ::: "memory");
    IDX_STEP(af3, 1, (s4 >> 1) + 1)
    asm volatile("" ::: "memory");
  }
#undef IDX_LOADQ
#undef IDX_STEP
#pragma unroll
  for (int mt = 0; mt < 2; ++mt)
#pragma unroll
    for (int nt = 0; nt < 2; ++nt)
#pragma unroll
      for (int q4 = 0; q4 < 4; ++q4)
      {
        typedef _Float16 h4_t __attribute__((ext_vector_type(4)));
        typedef float f4_t __attribute__((ext_vector_type(4)));
        const f4_t v4 = {sum[mt][nt][4 * q4], sum[mt][nt][4 * q4 + 1], sum[mt][nt][4 * q4 + 2], sum[mt][nt][4 * q4 + 3]};
        *(h4_t*)((u16*)p.scores + ((long)b * T + t0 + mt * 32 + r31) * T + s0 + nt * 32 + 8 * q4 + 4 * hf) = __builtin_convertvector(v4, h4_t);
      }
}
DI void topk_row(const Params& p, int b, int t, int lane);
DI void phase4(const Params& p, char* smem, int bid, int nblk) {
  if (bid < 32) {
    const int slot = bid >> 4, mt_ = bid & 15;
    ARows af{p.zc + ((long)slot * 2048 + mt_ * 128) * 128, 128, 128};
    BMat bf{p.cmp_w2 + slot * 128 * 64, 64, 64};
    if (slot) { EpiCmp2T ef{p.vcT, mt_ * 128}; gemm_tile<false>(smem, 2, 64, af, bf, ef); }
    else { EpiCmp2 ef{p.kc, mt_ * 128}; gemm_tile(smem, 2, 64, af, bf, ef); }
  }
  const int tid = TIDX(), lane = tid & 63, wid = __builtin_amdgcn_readfirstlane(tid >> 6);
  for (int item = bid; item < 2048; item += nblk) {
    const int it = item < 1024 ? 2047 - item : item - 1024;
    const int b = it & 1, tb = it >> 1;
#pragma unroll 1
    for (int q = 0; q < 2; ++q) {
      asm volatile("" ::: "memory");
      topk_row(p, b, tb * 8 + wid * 2 + q, lane);
    }
  }
}

using f32x4 = __attribute__((ext_vector_type(4))) float;
#define MFMA16(a, b, c) __builtin_amdgcn_mfma_f32_16x16x32_bf16((a), (b), (c), 0, 0, 0)
#define MFMA32(a, b, c) __builtin_amdgcn_mfma_f32_32x32x16_bf16((a), (b), (c), 0, 0, 0)

constexpr int NSA_STAGE_BYTES = 64 * 72 * 2 + 64 * 68 * 2;
DI void dense_scores(f32x16 (&acc)[2], const u16* Ks, const bf16x8 (&qf)[4], int lane) {
  const int r = lane & 31, hf = lane >> 5;
  bf16x8 kf[2][4];
#pragma unroll
  for (int tile = 0; tile < 2; ++tile)
#pragma unroll
    for (int ks = 0; ks < 4; ++ks) kf[tile][ks] = *(const bf16x8*)(Ks + (32 * tile + r) * 72 + 8 * hf + 16 * ks);
  asm volatile("" ::: "memory");
#pragma unroll
  for (int tile = 0; tile < 2; ++tile) {
    f32x16 c;
#pragma unroll
    for (int i = 0; i < 16; ++i) c[i] = 0.f;
#pragma unroll
    for (int ks = 0; ks < 4; ++ks) c = MFMA32(kf[tile][ks], qf[ks], c);
    acc[tile] = c;
  }
}
DI void dense_pv(const f32x16 (&acc)[2], const u16* Vs, int lane, f32x16 (&o)[2]) {
  const int r = lane & 31, hf = lane >> 5;
  uint2 vlo[2][2][2], vhi[2][2][2];
#pragma unroll
  for (int tile = 0; tile < 2; ++tile)
#pragma unroll
    for (int s = 0; s < 2; ++s)
#pragma unroll
      for (int dt = 0; dt < 2; ++dt) {
        const u16* vp = Vs + (32 * dt + r) * 68 + 32 * tile + 16 * s + 4 * hf;
        vlo[tile][s][dt] = *(const uint2*)vp;
        vhi[tile][s][dt] = *(const uint2*)(vp + 8);
      }
  asm volatile("" ::: "memory");
#pragma unroll
  for (int tile = 0; tile < 2; ++tile)
#pragma unroll
    for (int s = 0; s < 2; ++s) {
      uint4 w;
      w.x = pack2(acc[tile][8 * s + 0], acc[tile][8 * s + 1]);
      w.y = pack2(acc[tile][8 * s + 2], acc[tile][8 * s + 3]);
      w.z = pack2(acc[tile][8 * s + 4], acc[tile][8 * s + 5]);
      w.w = pack2(acc[tile][8 * s + 6], acc[tile][8 * s + 7]);
      const bf16x8 pb = __builtin_bit_cast(bf16x8, w);
#pragma unroll
      for (int dt = 0; dt < 2; ++dt) {
        uint4 a;
        a.x = vlo[tile][s][dt].x; a.y = vlo[tile][s][dt].y; a.z = vhi[tile][s][dt].x; a.w = vhi[tile][s][dt].y;
        o[dt] = MFMA32(__builtin_bit_cast(bf16x8, a), pb, o[dt]);
      }
    }
}
constexpr float LOG2E = 1.4426950408889634f;
template <int DSTEP>
DI float dense_mask(f32x16 (&acc)[2], bool active, int lo_c, int hi_c, int dist0_c, int dmin_u, const float* btab_h, int lane) {
  const int hf = lane >> 5;
  const bool colfull = !active || (lo_c <= 0 && hi_c >= 63);
  float mx = -INFINITY;
  if (dmin_u >= 128 && __ballot(colfull) == ~0ull) {
    const float be = active ? btab_h[128] : -INFINITY;
#pragma unroll
    for (int tile = 0; tile < 2; ++tile)
#pragma unroll
      for (int i = 0; i < 16; ++i) {
        const float sv = fmaf(acc[tile][i], LOG2E, be);
        acc[tile][i] = sv;
        mx = fmaxf(mx, sv);
      }
  } else {
    const int lo2 = active ? lo_c : 1, hi2 = active ? hi_c : 0;
#pragma unroll
    for (int tile = 0; tile < 2; ++tile)
#pragma unroll
      for (int i = 0; i < 16; ++i) {
        const int kl = 32 * tile + (i & 3) + 8 * (i >> 2) + 4 * hf;
        int dc = dist0_c - DSTEP * kl;
        dc = dc < 0 ? 0 : (dc > 128 ? 128 : dc);
        const float bias = btab_h[dc];
        const float s2 = fmaf(acc[tile][i], LOG2E, bias);
        const float sv = (kl >= lo2 && kl <= hi2) ? s2 : -INFINITY;
        acc[tile][i] = sv;
        mx = fmaxf(mx, sv);
      }
  }
  return fmaxf(mx, __shfl_xor(mx, 32));
}
DI void dense_chunk(const u16* Ks, const u16* Vs, bool active, int lo_c, int hi_c, int dist0_c, int dmin_u, const bf16x8 (&qf)[4],
                    const float* btab_h, int lane, float& m, float& l, f32x16 (&o)[2]) {
  f32x16 acc[2];
  dense_scores(acc, Ks, qf, lane);
  const float mx = dense_mask<1>(acc, active, lo_c, hi_c, dist0_c, dmin_u, btab_h, lane);
  const float mn = fmaxf(m, mx);
  const float alpha = __builtin_amdgcn_exp2f(m - mn);
  float ls = 0.f;
#pragma unroll
  for (int tile = 0; tile < 2; ++tile)
#pragma unroll
    for (int i = 0; i < 16; ++i) {
      const float pv = __builtin_amdgcn_exp2f(acc[tile][i] - mn);
      acc[tile][i] = pv;
      ls += pv;
    }
  ls += __shfl_xor(ls, 32);
  l = l * alpha + ls;
  m = mn;
  o[0] *= alpha;
  o[1] *= alpha;
  dense_pv(acc, Vs, lane, o);
}

template <int KSG, int VSG, bool NEEDV, class Next, class Body>
DI void chunk_pipeline(char* stage, const u16* kg0, const u16* vg0, int first, int tid, const Next& next, const Body& body) {
  const int srow = tid >> 3, spiece = tid & 7;
  uint4 rk0, rv0;
  rv0 = make_uint4(0, 0, 0, 0);
  int d = first;
#define NSA_GLOAD(D)                                                                      \
  {                                                                                       \
    rk0 = *(const uint4*)(kg0 + ((long)(D) * 64 + srow) * KSG + spiece * 8);              \
    if (NEEDV) rv0 = *(const uint4*)(vg0 + (long)srow * VSG + (D) * 64 + spiece * 8);     \
  }
  if (d >= 0) NSA_GLOAD(d)
  int ph = 0;
  __syncthreads();
  while (d >= 0) {
    u16* Ks = (u16*)(stage + ph * NSA_STAGE_BYTES);
    u16* Vs = Ks + 64 * 72;
    *(uint4*)(Ks + srow * 72 + spiece * 8) = rk0;
    if (NEEDV) {
      uint2* dv = (uint2*)(Vs + srow * 68 + spiece * 8);
      dv[0] = make_uint2(rv0.x, rv0.y); dv[1] = make_uint2(rv0.z, rv0.w);
    }
    const int dn = next(d);
    if (dn >= 0) NSA_GLOAD(dn)
    __syncthreads();
    body(d, Ks, Vs);
    ph ^= 1;
    d = dn;
  }
#undef NSA_GLOAD
}

DI void nsa_item(const Params& p, char* smem, int item) {
  const int tid = TIDX8(), lane = tid & 63, wid = __builtin_amdgcn_readfirstlane(tid >> 6);
  const int chunk = item & 127, g = (item >> 7) & 1, b = item >> 8;
  const int bg = b * 2 + g;
  float* btab = (float*)smem;
  u64* wun = (u64*)(smem + 2304);
  float* imps = (float*)(smem + 4096) + wid * 1056;
  char* stage = smem + 37888;
  for (int idx = tid; idx < 4 * 129; idx += 512) {
    const int h = idx / 129, d = idx % 129;
    const int bk = d < 128 ? BUCKET[d] : 31;
    btab[h * 132 + d] = p.rel_bias[bk * 16 + g * 4 + h] * LOG2E;
  }
  __syncthreads();
  const int t0 = chunk * 64;
  const int tw = t0 + wid * 8;
  const int c = lane & 31, hf = lane >> 5, qi = c >> 2, hh = c & 3;
  const int t_c = tw + qi;
  const int cur = t0 >> 6;
  const long row = (long)b * T + t_c;
  const u16* prow = p.proj + row * LDP;
  const u16* projb = p.proj + (long)b * T * LDP;
  const float* btab_h = btab + hh * 132;
  bf16x8 qf[4];
#pragma unroll
  for (int ks = 0; ks < 4; ++ks) qf[ks] = *(const bf16x8*)(prow + C_QN + (g * 4 + hh) * 64 + ks * 16 + hf * 8);
  const u16* gptr = prow + C_GN + (g * 4 + hh) * 3;
  for (int k = lane; k < 1056; k += 64) imps[k] = 0.f;
  u16* orow = p.onsa + row * 512 + (g * 4 + hh) * 64 + 4 * hf;
  auto emit = [&](const f32x16 (&o)[2], float sc, bool first) {
#pragma unroll
    for (int dt = 0; dt < 2; ++dt)
#pragma unroll
      for (int q4 = 0; q4 < 4; ++q4) {
        uint2* dst = (uint2*)(orow + 32 * dt + 8 * q4);
        float v0 = o[dt][4 * q4 + 0] * sc, v1 = o[dt][4 * q4 + 1] * sc, v2 = o[dt][4 * q4 + 2] * sc, v3 = o[dt][4 * q4 + 3] * sc;
        if (!first) {
          const uint2 u = *dst;
          v0 += lo16(u.x); v1 += hi16(u.x); v2 += lo16(u.y); v3 += hi16(u.y);
        }
        uint2 w;
        w.x = pack2(v0, v1);
        w.y = pack2(v2, v3);
        *dst = w;
      }
  };
  const int ncv_c = (t_c >= 31) ? ((t_c - 31) >> 4) + 1 : 0;
  const int ncv_max = ((t0 + 63 - 31) >> 4) + 1;
  const int nchunk_c = (ncv_max + 63) >> 6;
  {
    const u16* kcb = p.kc + (long)bg * 512 * 64;
    const u16* vcb = p.vcT + (long)bg * 64 * 512;
    float m = -1e30f, l = 0.f;
    auto next_c = [&](int d) { return d + 1 < nchunk_c ? d + 1 : -1; };
    chunk_pipeline<64, 512, false>(stage, kcb, vcb, 0, tid, next_c, [&](int i, const u16* Ks, const u16* Vs) {
      f32x16 acc[2];
      dense_scores(acc, Ks, qf, lane);
      const float mx = dense_mask<16>(acc, true, 0, ncv_c - 1 - i * 64, t_c - 31 - 1024 * i, tw - 31 - 1024 * i - 1008, btab_h, lane);
      const float mn = fmaxf(m, mx);
      float ls = 0.f;
#pragma unroll
      for (int tile = 0; tile < 2; ++tile)
#pragma unroll
        for (int q = 0; q < 16; ++q) ls += __builtin_amdgcn_exp2f(acc[tile][q] - mn);
      ls += __shfl_xor(ls, 32);
      l = l * __builtin_amdgcn_exp2f(m - mn) + ls;
      m = mn;
    });
    const float invl = 1.f / fmaxf(l, 1e-30f);
    f32x16 oc[2];
#pragma unroll
    for (int i = 0; i < 16; ++i) { oc[0][i] = 0.f; oc[1][i] = 0.f; }
    chunk_pipeline<64, 512, true>(stage, kcb, vcb, 0, tid, next_c, [&](int i, const u16* Ks, const u16* Vs) {
      f32x16 acc[2];
      dense_scores(acc, Ks, qf, lane);
      (void)dense_mask<16>(acc, true, 0, ncv_c - 1 - i * 64, t_c - 31 - 1024 * i, tw - 31 - 1024 * i - 1008, btab_h, lane);
      float part[2][4], spill[2][4];
#pragma unroll
      for (int tile = 0; tile < 2; ++tile) {
#pragma unroll
        for (int q = 0; q < 16; ++q) acc[tile][q] = __builtin_amdgcn_exp2f(acc[tile][q] - m) * invl;
#pragma unroll
        for (int q4 = 0; q4 < 4; ++q4) {
          float pa = acc[tile][4 * q4] + acc[tile][4 * q4 + 1] + acc[tile][4 * q4 + 2] + 0.5f * acc[tile][4 * q4 + 3];
          float sp = 0.5f * acc[tile][4 * q4 + 3];
          pa += __shfl_xor(pa, 1); pa += __shfl_xor(pa, 2);
          sp += __shfl_xor(sp, 1); sp += __shfl_xor(sp, 2);
          part[tile][q4] = pa; spill[tile][q4] = sp;
        }
      }
      if (hh == 0) {
#pragma unroll
        for (int tile = 0; tile < 2; ++tile)
#pragma unroll
          for (int q4 = 0; q4 < 4; ++q4) imps[qi * 132 + 16 * i + 8 * tile + 2 * q4 + hf] += part[tile][q4];
      }
      wave_sync();
      if (hh == 0) {
#pragma unroll
        for (int tile = 0; tile < 2; ++tile)
#pragma unroll
          for (int q4 = 0; q4 < 4; ++q4) imps[qi * 132 + 16 * i + 8 * tile + 2 * q4 + hf + 1] += spill[tile][q4];
      }
      wave_sync();
      dense_pv(acc, Vs, lane, oc);
    });
    emit(oc, bf2f(gptr[0]), true);
  }
  wave_sync();
  u64 my0 = 0, my1 = 0, wu0 = 0, wu1 = 0;
  for (int q = 0; q < 8; ++q) {
    u64 mask0, mask1;
    if (cur <= 15) {
      mask0 = (2ull << cur) - 1ull;
      mask1 = 0ull;
    } else {
      const float imp_lo = imps[q * 132 + lane], imp_hi = imps[q * 132 + lane + 64];
      const int jl = lane, jh = lane + 64;
      float c0 = (jl >= 1 && jl <= cur - 2) ? imp_lo : -1.f;
      float c1 = (jh <= cur - 2) ? imp_hi : -1.f;
      bool sel_lo = (jl == 0) || (jl == cur) || (jl == cur - 1);
      bool sel_hi = (jh == cur) || (jh == cur - 1);
      for (int r = 0; r < 13; ++r) {
        float bv; int bj;
        if (c0 >= c1) { bv = c0; bj = jl; } else { bv = c1; bj = jh; }
        wave_argmax(bv, bj);
        if (bj == jl) { sel_lo = true; c0 = -1.f; }
        if (bj == jh) { sel_hi = true; c1 = -1.f; }
      }
      mask0 = __ballot(sel_lo);
      mask1 = __ballot(sel_hi);
    }
    if (qi == q) { my0 = mask0; my1 = mask1; }
    wu0 |= mask0; wu1 |= mask1;
  }
  if (lane == 0) { wun[wid * 2] = wu0; wun[wid * 2 + 1] = wu1; }
  __syncthreads();
  u64 bu0 = wun[0] | wun[2] | wun[4] | wun[6] | wun[8] | wun[10] | wun[12] | wun[14];
  u64 bu1 = wun[1] | wun[3] | wun[5] | wun[7] | wun[9] | wun[11] | wun[13] | wun[15];
  bu0 = ((u64)(unsigned)__builtin_amdgcn_readfirstlane((int)(bu0 >> 32)) << 32) | (unsigned)__builtin_amdgcn_readfirstlane((int)bu0);
  bu1 = ((u64)(unsigned)__builtin_amdgcn_readfirstlane((int)(bu1 >> 32)) << 32) | (unsigned)__builtin_amdgcn_readfirstlane((int)bu1);
  {
    float m = -1e30f, l = 0.f;
    f32x16 o[2];
#pragma unroll
    for (int i = 0; i < 16; ++i) { o[0][i] = 0.f; o[1][i] = 0.f; }
    const int kcol = C_KV + 2 * 128 + g * 64;
    auto next_s = [&](int j) {
      ++j;
      if (j < 64) {
        const u64 mm = bu0 & (~0ull << j);
        if (mm) return (int)__builtin_ctzll(mm);
        j = 64;
      }
      if (j >= 128) return -1;
      const u64 mm = bu1 & (~0ull << (j - 64));
      return mm ? 64 + (int)__builtin_ctzll(mm) : -1;
    };
    chunk_pipeline<LDP, T, true>(stage, projb + kcol, p.vts + (long)bg * 64 * T, 0, tid, next_s, [&](int j, const u16* Ks, const u16* Vs) {
      const bool bit = ((j < 64 ? (my0 >> j) : (my1 >> (j - 64))) & 1ull) != 0;
      if (__ballot(bit) != 0ull) {
        const int pos0 = 64 * j;
        dense_chunk(Ks, Vs, bit, 0, t_c - pos0, t_c - pos0, tw - pos0 - 63, qf, btab_h, lane, m, l, o);
      }
    });
    emit(o, bf2f(gptr[1]) / fmaxf(l, 1e-30f), false);
  }
  {
    float m = -1e30f, l = 0.f;
    f32x16 o[2];
#pragma unroll
    for (int i = 0; i < 16; ++i) { o[0][i] = 0.f; o[1][i] = 0.f; }
    const int kcol = C_KV + 4 * 128 + g * 64;
    const int wlo_c = t_c - 511 < 0 ? 0 : t_c - 511;
    const int wlo_min = t0 - 511 < 0 ? 0 : t0 - 511;
    auto next_w = [&](int j) { return j + 1 <= cur ? j + 1 : -1; };
    chunk_pipeline<LDP, T, true>(stage, projb + kcol, p.vtw + (long)bg * 64 * T, wlo_min >> 6, tid, next_w, [&](int jw, const u16* Ks, const u16* Vs) {
      const int pos0 = 64 * jw;
      const int lo_c = wlo_c - pos0 < 0 ? 0 : wlo_c - pos0;
      dense_chunk(Ks, Vs, true, lo_c, t_c - pos0, t_c - pos0, tw - pos0 - 63, qf, btab_h, lane, m, l, o);
    });
    emit(o, bf2f(gptr[2]) / fmaxf(l, 1e-30f), false);
  }
}

DI unsigned f2ord(float v) { const unsigned u = __float_as_uint(v); return (u & 0x80000000u) ? ~u : (u | 0x80000000u); }

DI void topk_row(const Params& p, int b, int t, int lane) {
  const long row = (long)b * T + t;
  int* dst = p.selk + row * 256;
  if (t < 256) {
#pragma unroll
    for (int i = 0; i < 4; ++i) { const int s = i * 64 + lane; dst[s] = (s <= t) ? s : -1; }
    return;
  }
  const u16* srow = (const u16*)p.scores + row * T;
  const int ngrp = (t >> 10) + 1;
  unsigned u[128];
  int ln = lane;
  asm volatile("" : "+v"(ln));
#pragma unroll
  for (int gq = 0; gq < 8; ++gq) {
    if (gq < ngrp) {
#pragma unroll
      for (int j = 0; j < 16; ++j) {
        const int s = (gq * 16 + j) * 64 + ln;
        u[gq * 16 + j] = srow[s < t ? s : t];
      }
    } else {
#pragma unroll
      for (int j = 0; j < 16; ++j) u[gq * 16 + j] = 0u;
    }
  }
  asm volatile("" ::: "memory");
#pragma unroll
  for (int gq = 0; gq < 8; ++gq) {
    if (gq < ngrp) {
#pragma unroll
      for (int j = 0; j < 16; ++j) {
        const int s = (gq * 16 + j) * 64 + ln;
        { const unsigned h_ = u[gq * 16 + j]; u[gq * 16 + j] = (s <= t) ? ((h_ & 0x8000u) ? (~h_ & 0xFFFFu) : (h_ | 0x8000u)) : 0u; }
      }
    }
  }
  const int nlane = 16 * ngrp;
  unsigned m0 = 0u, m1 = 0u, m2 = 0u, m3 = 0u;
#pragma unroll
  for (int gq = 0; gq < 8; ++gq) {
    if (gq < ngrp) {
#pragma unroll
      for (int j = 0; j < 16; j += 4) {
        m0 = max(m0, u[gq * 16 + j]); m1 = max(m1, u[gq * 16 + j + 1]); m2 = max(m2, u[gq * 16 + j + 2]); m3 = max(m3, u[gq * 16 + j + 3]);
      }
    }
  }
  unsigned lo = wave_min_u(min(min(m0, m1), min(m2, m3)));
  unsigned hi = wave_max_u(max(max(m0, m1), max(m2, m3))) + 1u;
#define TOPK_COUNT_GE(PIV, OUT)                                                         \
  {                                                                                     \
    unsigned below_ = 0;     \
    _Pragma("unroll") for (int gq = 0; gq < 8; ++gq) {                                  \
      if (gq < ngrp) {                                                                  \
        _Pragma("unroll") for (int j = 0; j < 16; ++j) below_ += (u[gq * 16 + j] - (PIV)) >> 31; \
      }                                                                                 \
    }                                                                                   \
    OUT = wave_sum_i(nlane - (int)below_);                                              \
  }
  int c_lo, c_hi = 0;
  TOPK_COUNT_GE(lo, c_lo)
  int iter = 0;
  while (c_lo != 256 && hi - lo > 1u) {
    const unsigned span = hi - lo;
    unsigned step;
    if ((++iter & 3) == 0) step = span >> 1;
    else step = (unsigned)((float)span * ((float)(c_lo - 256) / (float)(c_lo - c_hi)));
    step = step < 1u ? 1u : (step > span - 1u ? span - 1u : step);
    const unsigned piv = lo + step;
    int c;
    TOPK_COUNT_GE(piv, c)
    if (c >= 256) { lo = piv; c_lo = c; } else { hi = piv; c_hi = c; }
  }
#undef TOPK_COUNT_GE
  const unsigned thr = lo;
  int ngt = 0;
#pragma unroll
  for (int gq = 0; gq < 8; ++gq) {
    if (gq < ngrp) {
#pragma unroll
      for (int j = 0; j < 16; ++j) ngt += __popcll(__ballot(u[gq * 16 + j] > thr));
    }
  }
  int base_gt = 0, base_eq = 0;
  const int need_eq = 256 - ngt;
  int ln2 = lane;
  asm volatile("" : "+v"(ln2));
#pragma unroll
  for (int gq = 0; gq < 8; ++gq) {
    if (gq < ngrp) {
#pragma unroll
      for (int j = 0; j < 16; ++j) {
        const int s = (gq * 16 + j) * 64 + ln2;
        const unsigned uv = u[gq * 16 + j];
        const bool gt = uv > thr, eq = uv == thr;
        const u64 mg = __ballot(gt), me = __ballot(eq);
        const int pg = __builtin_amdgcn_mbcnt_hi((unsigned)(mg >> 32), __builtin_amdgcn_mbcnt_lo((unsigned)mg, 0));
        const int pe = __builtin_amdgcn_mbcnt_hi((unsigned)(me >> 32), __builtin_amdgcn_mbcnt_lo((unsigned)me, 0));
        if (gt) dst[base_gt + pg] = s;
        if (eq && (base_eq + pe) < need_eq) dst[ngt + base_eq + pe] = s;
        base_gt += __popcll(mg);
        base_eq += __popcll(me);
      }
    }
  }
}

DI void phase6(const Params& p, char* smem, int bid, int nblk);
DI void phase5_nsa8(const Params& p) {
  for (int item = blockIdx.x; item < 512; item += gridDim.x) {
    __syncthreads();
    const int it = item < 256 ? 511 - item : item - 256;
    const int chunk = it >> 2, bgi = it & 3;
    nsa_item(p, g_smem, (bgi << 7) | chunk);
  }
  __syncthreads();
}
DI void phase5(const Params& p, char* smem, int bid, int nblk) {
  hb_sync();
  phase6(p, smem, bid, nblk);
}

DI void tr_read2(unsigned a0, unsigned a1, uint2& r0, uint2& r1) {
  asm volatile("ds_read_b64_tr_b16 %0, %2\n\tds_read_b64_tr_b16 %1, %3\n\ts_waitcnt lgkmcnt(0)" : "=&v"(r0), "=&v"(r1) : "v"(a0), "v"(a1) : "memory");
}
DI void tr_read4(unsigned a0, unsigned a1, unsigned a2, unsigned a3, uint2& r0, uint2& r1, uint2& r2, uint2& r3) {
  asm volatile("ds_read_b64_tr_b16 %0, %4\n\tds_read_b64_tr_b16 %1, %5\n\tds_read_b64_tr_b16 %2, %6\n\tds_read_b64_tr_b16 %3, %7\n\ts_waitcnt lgkmcnt(0)"
               : "=&v"(r0), "=&v"(r1), "=&v"(r2), "=&v"(r3) : "v"(a0), "v"(a1), "v"(a2), "v"(a3) : "memory");
}
DI void dsa_query(const Params& p, u16* Cs, const float* btab, int b, int t, int lane) {
  const long row = (long)b * T + t;
  const int lg = lane >> 4, r16 = lane & 15, hh = lane & 7;
  bf16x8 qf[4];
#pragma unroll
  for (int ks = 0; ks < 4; ++ks) {
    bf16x8 z = {0, 0, 0, 0, 0, 0, 0, 0};
    if (r16 < 8) z = *(const bf16x8*)(p.qlat + (row * 8 + r16) * 128 + ks * 32 + lg * 8);
    qf[ks] = z;
  }
  const u16* ckvb = p.ckv + (long)b * T * 128;
  const int nvalid = (t + 1) < 256 ? (t + 1) : 256;
  float m = -1e30f, l = 0.f;
  f32x4 o[8];
#pragma unroll
  for (int ct = 0; ct < 8; ++ct) o[ct] = (f32x4){0.f, 0.f, 0.f, 0.f};
  const unsigned cs_base = (unsigned)(size_t)Cs;
  const int nch = (nvalid + 31) >> 5;
  uint4 gv0, gv1, gv2, gv3, gv4, gv5, gv6, gv7;
  int kidx_n;
#define DSA_G1(V, I) { const int kr_ = __shfl(kidx_n, 4 * (I) + lg); V = *(const uint4*)(ckvb + (long)kr_ * 128 + r16 * 8); }
#define DSA_GATHER(CH)                                                            \
  {                                                                               \
    const int nv_ = (nvalid - (CH) * 32) > 32 ? 32 : (nvalid - (CH) * 32);        \
    kidx_n = p.selk[row * 256 + (CH) * 32 + (lane & 31)];                         \
    if ((lane & 31) >= nv_ || kidx_n < 0 || kidx_n > t) kidx_n = t;               \
    DSA_G1(gv0, 0) DSA_G1(gv1, 1) DSA_G1(gv2, 2) DSA_G1(gv3, 3) DSA_G1(gv4, 4) DSA_G1(gv5, 5) DSA_G1(gv6, 6) DSA_G1(gv7, 7) \
  }
  DSA_GATHER(0)
  for (int ch = 0; ch < nch; ++ch) {
    const int nval = (nvalid - ch * 32) > 32 ? 32 : (nvalid - ch * 32);
    const int kidx = kidx_n;
    wave_sync();
    {
      u16* d_ = Cs + lg * 144 + r16 * 8;
      *(uint4*)(d_) = gv0;            *(uint4*)(d_ + 4 * 144) = gv1;  *(uint4*)(d_ + 8 * 144) = gv2;  *(uint4*)(d_ + 12 * 144) = gv3;
      *(uint4*)(d_ + 16 * 144) = gv4; *(uint4*)(d_ + 20 * 144) = gv5; *(uint4*)(d_ + 24 * 144) = gv6; *(uint4*)(d_ + 28 * 144) = gv7;
    }
    { const int chn = ch + 1 < nch ? ch + 1 : nch - 1; DSA_GATHER(chn) }
    wave_sync();
    f32x4 acc[2];
#pragma unroll
    for (int rt = 0; rt < 2; ++rt) {
      const u16* kp = Cs + (16 * rt + r16) * 144 + 8 * lg;
      f32x4 c = {0.f, 0.f, 0.f, 0.f};
#pragma unroll
      for (int ks = 0; ks < 4; ++ks) c = MFMA16(*(const bf16x8*)(kp + 32 * ks), qf[ks], c);
      acc[rt] = c;
    }
    float mx = -INFINITY;
#pragma unroll
    for (int rt = 0; rt < 2; ++rt)
#pragma unroll
      for (int r = 0; r < 4; ++r) {
        const int pl = 16 * rt + 4 * lg + r;
        const int kk = __shfl(kidx, pl);
        int dc = t - kk;
        dc = dc < 0 ? 0 : (dc > 128 ? 128 : dc);
        const float sv = (pl < nval) ? fmaf(acc[rt][r], LOG2E, btab[hh * 132 + dc]) : -INFINITY;
        acc[rt][r] = sv;
        mx = fmaxf(mx, sv);
      }
    mx = fmaxf(mx, __shfl_xor(mx, 16));
    mx = fmaxf(mx, __shfl_xor(mx, 32));
    const float mn = fmaxf(m, mx);
    const float alpha = __builtin_amdgcn_exp2f(m - mn);
    float ls = 0.f;
#pragma unroll
    for (int rt = 0; rt < 2; ++rt)
#pragma unroll
      for (int r = 0; r < 4; ++r) {
        const float pv = __builtin_amdgcn_exp2f(acc[rt][r] - mn);
        acc[rt][r] = pv;
        ls += pv;
      }
    ls += __shfl_xor(ls, 16);
    ls += __shfl_xor(ls, 32);
    l = l * alpha + ls;
    m = mn;
    uint4 pw;
    pw.x = pack2(acc[0][0], acc[0][1]);
    pw.y = pack2(acc[0][2], acc[0][3]);
    pw.z = pack2(acc[1][0], acc[1][1]);
    pw.w = pack2(acc[1][2], acc[1][3]);
    const bf16x8 pb = __builtin_bit_cast(bf16x8, pw);
    const unsigned a_lo = cs_base + (unsigned)(((4 * lg + (r16 >> 2)) * 144 + 4 * (r16 & 3)) * 2);
    const unsigned a_hi = a_lo + 16 * 144 * 2;
#pragma unroll
    for (int ct = 0; ct < 8; ct += 2) {
      uint2 lo0, hi0, lo1, hi1;
      tr_read4(a_lo + ct * 32, a_hi + ct * 32, a_lo + ct * 32 + 32, a_hi + ct * 32 + 32, lo0, hi0, lo1, hi1);
      uint4 aw0, aw1;
      aw0.x = lo0.x; aw0.y = lo0.y; aw0.z = hi0.x; aw0.w = hi0.y;
      aw1.x = lo1.x; aw1.y = lo1.y; aw1.z = hi1.x; aw1.w = hi1.y;
      o[ct] = o[ct] * alpha;
      o[ct + 1] = o[ct + 1] * alpha;
      o[ct] = MFMA16(__builtin_bit_cast(bf16x8, aw0), pb, o[ct]);
      o[ct + 1] = MFMA16(__builtin_bit_cast(bf16x8, aw1), pb, o[ct + 1]);
    }
  }
#undef DSA_GATHER
#undef DSA_G1
  const float invl = 1.f / fmaxf(l, 1e-30f);
  if (r16 < 8) {
#pragma unroll
    for (int ct = 0; ct < 8; ++ct)
      *(uint2*)(p.olat + row * 1024 + r16 * 128 + 16 * ct + 4 * lg) = pack4(o[ct][0] * invl, o[ct][1] * invl, o[ct][2] * invl, o[ct][3] * invl);
  }
}
DI void phase6(const Params& p, char* smem, int bid, int nblk) {
  const int tid = TIDX(), lane = tid & 63, wid = __builtin_amdgcn_readfirstlane(tid >> 6);
  float* btab = (float*)smem;
  u16* Cs = (u16*)(smem + 8192) + wid * (32 * 144);
  for (int idx = tid; idx < 8 * 129; idx += 256) {
    const int h = idx / 129, d = idx % 129;
    const int bk = d < 128 ? BUCKET[d] : 31;
    btab[h * 132 + d] = p.rel_bias[bk * 16 + 8 + h] * LOG2E;
  }
  hb_sync();
  for (int item = bid; item < 2048; item += nblk) {
    const int it = item < 1024 ? 2047 - item : item - 1024;
    const int b = it & 1, tb = it >> 1;
    for (int q = 0; q < 2; ++q) dsa_query(p, Cs, btab, b, tb * 8 + wid * 2 + q, lane);
  }
}

struct EpiOdsa {
  u16* odsa; int h, m0;
  DI void operator()(f32x16 (&acc)[2][2], int wm, int wn, int lane) const {
    constexpr int MT = 2;
    SW_FOR {
      const int r = m0 + SW_R, c = SW_C0;
      if (c < 64) *(uint2*)(odsa + (long)r * 512 + h * 64 + c) = pack4(SW_V(0), SW_V(1), SW_V(2), SW_V(3));
    }
  }
};
DI void phase7(const Params& p, char* smem, int bid, int nblk) {
  for (int item = bid; item < 1024; item += nblk) {
    const int h = item & 7, mt_ = item >> 3;
    ARows af{p.olat + (long)mt_ * 128 * 1024 + h * 128, 1024, 128};
    BMat bf{p.dsa_w_uv + h * 64, 512, 64};
    EpiOdsa ef{p.odsa, h, mt_ * 128};
    gemm_tile(smem, 2, 64, af, bf, ef);
  }
}

struct EpiY {
  u16* y; const u16* proj; int m0, n0, second;
  template <int MT> DI void operator()(f32x16 (&acc)[MT][2], int wm, int wn, int lane) const {
    SW_FOR {
      const int r = m0 + SW_R, c = n0 + SW_C0;
      const uint2 gu = *(const uint2*)(proj + (long)r * LDP + C_GM + second * 1024 + c);
      float v0 = lo16(gu.x) * SW_V(0), v1 = hi16(gu.x) * SW_V(1), v2 = lo16(gu.y) * SW_V(2), v3 = hi16(gu.y) * SW_V(3);
      uint2* dst = (uint2*)(y + (long)r * 1024 + c);
      if (second) {
        const uint2 yu = *dst;
        v0 += lo16(yu.x); v1 += hi16(yu.x); v2 += lo16(yu.y); v3 += hi16(yu.y);
      }
      *dst = pack4(v0, v1, v2, v3);
    }
  }
};
DI void phase8_8w(const Params& p, int wg, int nwg) {
  for (int item = wg; item < 256; item += nwg) {
    const int nt_ = item & 3, mt_ = item >> 2;
    {
      ARows af{p.onsa + (long)mt_ * 256 * 512, 512, 256};
      BMatT bf{p.w_bnT + (long)nt_ * 256 * 512, 512};
      EpiY ef{p.y, p.proj, mt_ * 256, nt_ * 256, 0};
      gemm8w<true>(8, af, bf, ef);
    }
    {
      ARows af{p.odsa + (long)mt_ * 256 * 512, 512, 256};
      BMatT bf{p.w_bdT + (long)nt_ * 256 * 512, 512};
      EpiY ef{p.y, p.proj, mt_ * 256, nt_ * 256, 1};
      gemm8w<true>(8, af, bf, ef);
    }
  }
}
struct EpiStoreBf {
  u16* dst; long ld; int m0, n0;
  template <int MT> DI void operator()(f32x16 (&acc)[MT][2], int wm, int wn, int lane) const {
    SW_FOR { *(uint2*)(dst + (long)(m0 + SW_R) * ld + n0 + SW_C0) = pack4(SW_V(0), SW_V(1), SW_V(2), SW_V(3)); }
  }
};
DI void phase9_8w(const Params& p, int wg, int nwg) {
  for (int item = wg; item < 256; item += nwg) {
    const int nt_ = item & 3, mt_ = item >> 2;
    ARows af{p.y + (long)mt_ * 256 * 1024, 1024, 256};
    BMatT bf{p.w_outT + (long)nt_ * 256 * 1024, 1024};
    EpiStoreBf ef{p.z, 1024, mt_ * 256, nt_ * 256};
    gemm8w<true>(16, af, bf, ef);
  }
}

DI void phase10(const Params& p, int bid, int nblk) {
  const int tid = TIDX(), lane = tid & 63, wid = __builtin_amdgcn_readfirstlane(tid >> 6);
  for (int row = bid * 4 + wid; row < NTOK; row += nblk * 4) {
    const int b = row >> 13;
    const float* modb = p.mod + b * 6144;
    float zv[16], xv[16];
    float ss = 0.f;
#pragma unroll
    for (int i = 0; i < 4; ++i) {
      const int col = i * 256 + lane * 4;
      const uint2 u = *(const uint2*)(p.z + (long)row * 1024 + col);
      zv[i * 4 + 0] = lo16(u.x); zv[i * 4 + 1] = hi16(u.x); zv[i * 4 + 2] = lo16(u.y); zv[i * 4 + 3] = hi16(u.y);
      const float4 xx = *(const float4*)(p.x + (long)row * 1024 + col);
      xv[i * 4 + 0] = xx.x; xv[i * 4 + 1] = xx.y; xv[i * 4 + 2] = xx.z; xv[i * 4 + 3] = xx.w;
#pragma unroll
      for (int j = 0; j < 4; ++j) ss += zv[i * 4 + j] * zv[i * 4 + j];
    }
    ss = wave_sum(ss);
    const float r = rsqrtf(ss * (1.f / 1024.f) + 1e-6f);
    float ss2 = 0.f;
#pragma unroll
    for (int i = 0; i < 4; ++i)
#pragma unroll
      for (int j = 0; j < 4; ++j) {
        const int col = i * 256 + lane * 4 + j;
        const float v = xv[i * 4 + j] + modb[2048 + col] * (zv[i * 4 + j] * r * p.g_post_mix[col]);
        xv[i * 4 + j] = v;
        ss2 += v * v;
      }
    ss2 = wave_sum(ss2);
    const float r2 = rsqrtf(ss2 * (1.f / 1024.f) + 1e-6f);
#pragma unroll
    for (int i = 0; i < 4; ++i) {
      const int col = i * 256 + lane * 4;
      *(float4*)(p.x1 + (long)row * 1024 + col) = make_float4(xv[i * 4], xv[i * 4 + 1], xv[i * 4 + 2], xv[i * 4 + 3]);
      float hv[4];
#pragma unroll
      for (int j = 0; j < 4; ++j) hv[j] = xv[i * 4 + j] * r2 * p.g_pre_ffn[col + j] * (1.f + modb[4096 + col + j]) + modb[3072 + col + j];
      uint2 w;
      w.x = pack2(hv[0], hv[1]);
      w.y = pack2(hv[2], hv[3]);
      *(uint2*)(p.h + (long)row * 1024 + col) = w;
    }
  }
}

struct EpiStoreF32 {
  float* dst; long ld; int m0, n0;
  DI void operator()(f32x16 (&acc)[2][2], int wm, int wn, int lane) const {
    constexpr int MT = 2;
    SW_FOR { *(float4*)(dst + (long)(m0 + SW_R) * ld + n0 + SW_C0) = make_float4(SW_V(0), SW_V(1), SW_V(2), SW_V(3)); }
  }
};
DI void phase11(const Params& p, char* smem, int bid, int nblk) {
  for (int item = bid; item < 256; item += nblk) {
    const int nt_ = item & 1, mt_ = item >> 1;
    ARows af{p.h + (long)mt_ * 128 * 1024, 1024, 128};
    BMatT bf{p.routerT + (long)nt_ * 128 * 1024, 1024};
    EpiStoreF32 ef{p.logits, 256, mt_ * 128, nt_ * 128};
    gemm_tile<true, false, true>(smem, 16, 64, af, bf, ef);
  }
}
DI void phase12(const Params& p, int bid, int nblk) {
  const int tid = TIDX(), lane = tid & 63, wid = __builtin_amdgcn_readfirstlane(tid >> 6);
  for (int tok = bid * 4 + wid; tok < NTOK; tok += nblk * 4) {
    const float4 lg = *(const float4*)(p.logits + (long)tok * 256 + lane * 4);
    const float4 rbv = *(const float4*)(p.router_bias + lane * 4);
    float sg[4] = {sigmoidf(lg.x), sigmoidf(lg.y), sigmoidf(lg.z), sigmoidf(lg.w)};
    float sl[4] = {sg[0] + rbv.x, sg[1] + rbv.y, sg[2] + rbv.z, sg[3] + rbv.w};
    float t1 = fmaxf(sl[0], sl[1]), t2 = fminf(sl[0], sl[1]);
#pragma unroll
    for (int j = 2; j < 4; ++j) {
      const float v = sl[j];
      t2 = fmaxf(t2, fminf(t1, v));
      t1 = fmaxf(t1, v);
    }
#define R_MERGE(CTRL)                                                                                                            \
    {                                                                                                                            \
      const float a1 = __int_as_float(__builtin_amdgcn_update_dpp(0, __float_as_int(t1), CTRL, 0xF, 0xF, true));                 \
      const float a2 = __int_as_float(__builtin_amdgcn_update_dpp(0, __float_as_int(t2), CTRL, 0xF, 0xF, true));                 \
      const float n1 = fmaxf(t1, a1);                                                                                            \
      const float n2 = fmaxf(fminf(t1, a1), fmaxf(t2, a2));                                                                      \
      t1 = n1; t2 = n2;                                                                                                          \
    }
    R_MERGE(DPP_QP1) R_MERGE(DPP_QP2) R_MERGE(DPP_RHM)
#undef R_MERGE
    const float gscore = t1 + t2;
    const int grp = lane >> 3;
    int rank = 0;
#pragma unroll
    for (int g2 = 0; g2 < 8; ++g2) {
      const float og = rdlane(gscore, g2 * 8);
      rank += (og > gscore || (og == gscore && g2 < grp)) ? 1 : 0;
    }
    const bool gsel = rank < 4;
    float cv[4];
#pragma unroll
    for (int j = 0; j < 4; ++j) cv[j] = gsel ? sl[j] : -1e30f;
    int my_e = -1; float my_s = 0.f; float ssum = 0.f;
    for (int r = 0; r < 8; ++r) {
      float bv = cv[0]; int bj = 0;
#pragma unroll
      for (int j = 1; j < 4; ++j) if (cv[j] > bv) { bv = cv[j]; bj = j; }
      int be = lane * 4 + bj;
      wave_argmax(bv, be);
      const int wl_ = be >> 2, wj = be & 3;
      const float s0 = rdlane(sg[0], wl_), s1 = rdlane(sg[1], wl_), s2 = rdlane(sg[2], wl_), s3 = rdlane(sg[3], wl_);
      const float bs = wj == 0 ? s0 : (wj == 1 ? s1 : (wj == 2 ? s2 : s3));
      if (wl_ == lane) {
        if (wj == 0) cv[0] = -3e30f; else if (wj == 1) cv[1] = -3e30f; else if (wj == 2) cv[2] = -3e30f; else cv[3] = -3e30f;
      }
      if (lane == r) { my_e = be; my_s = bs; }
      ssum += bs;
    }
    if (lane < 8) {
      const float w = my_s / ssum * 2.5f;
      const int rk = atomicAdd(p.counts + my_e, 1);
      p.eidx[tok * 8 + lane] = my_e;
      p.ewt[tok * 8 + lane] = w;
      p.erank[tok * 8 + lane] = rk;
    }
  }
}
DI void phase14(const Params& p, char* smem, int bid, int nblk) {
  const int tid = TIDX();
  int* s_cnt = (int*)smem;
  int* s_off = s_cnt + 256;
  const int cnt = p.counts[tid];
  s_cnt[tid] = cnt;
  hb_sync();
  int run = 0, nt = 0, nt2 = 0;
  for (int e = 0; e < tid; ++e) { const int c = s_cnt[e]; run += c; nt += (c + 127) >> 7; nt2 += (c + 255) >> 8; }
  s_off[tid] = run;
  hb_sync();
  if (bid == 0) {
    p.offs[tid] = run;
    for (int m = 0; m * 256 < cnt; ++m) {
      p.tile2_e[nt2] = tid;
      p.tile2_r0[nt2] = run + m * 256;
      p.tile2_nr[nt2] = (cnt - m * 256) > 256 ? 256 : (cnt - m * 256);
      ++nt2;
    }
    for (int m = 0; m * 128 < cnt; ++m) {
      p.tile_e[nt] = tid;
      p.tile_r0[nt] = run + m * 128;
      p.tile_nr[nt] = (cnt - m * 128) > 128 ? 128 : (cnt - m * 128);
      ++nt;
    }
    if (tid == 255) {
      p.offs[256] = run + cnt;
      for (int m = 0; m < 128; ++m) {
        p.tile_e[nt] = 256;
        p.tile_r0[nt] = 131072 + m * 128;
        p.tile_nr[nt] = 128;
        ++nt;
      }
      p.ntiles[0] = nt;
      for (int m = 0; m < 64; ++m) {
        p.tile2_e[nt2] = 256;
        p.tile2_r0[nt2] = 131072 + m * 256;
        p.tile2_nr[nt2] = 256;
        ++nt2;
      }
      p.ntiles[1] = nt2;
    }
  }
  for (int i = bid * 256 + tid; i < NSLOT; i += nblk * 256) {
    if (i < 131072) {
      const int e = p.eidx[i];
      const int slot = s_off[e] + p.erank[i];
      p.slot_tok[slot] = i >> 3;
      p.slot_wt[slot] = p.ewt[i];
      p.tok_slot[i] = slot;
    } else {
      p.slot_tok[i] = i - 131072;
      p.slot_wt[i] = 1.f;
    }
  }
}

struct AGather {
  const u16* h; const int* slot_tok; int r0, nr;
  DI const u16* operator()(int r) const { return h + (long)slot_tok[r0 + (r < nr ? r : 0)] * 1024; }
  DI const u16* origin() const { return h; } DI int off(int r) const { return slot_tok[r0 + (r < nr ? r : 0)] * 1024; }
};
struct BGateUp {
  const float* wg; long udiff; long ldb; int n0;
  DI const float* operator()(int c4) const {
    const int wn = c4 >> 6, ntl = (c4 >> 5) & 1, j = c4 & 31;
    return wg + (long)ntl * udiff + n0 + wn * 32 + j;
  }
  DI const u16* row(int) const { return nullptr; }
};
struct EpiH {
  u16* H; int r0, nr, n0;
  template <int MT> DI void operator()(f32x16 (&acc)[MT][2], int wm, int wn, int lane) const {
#pragma unroll
    for (int mt = 0; mt < MT; ++mt) {
      const int r = SW_R;
      if (r < nr) {
#pragma unroll
        for (int q4 = 0; q4 < 4; ++q4) {
          float v[4];
#pragma unroll
          for (int j = 0; j < 4; ++j) v[j] = siluf(acc[mt][0][4 * q4 + j]) * acc[mt][1][4 * q4 + j];
          *(uint2*)(H + (long)(r0 + r) * 256 + n0 + wn * 32 + 8 * q4 + 4 * (lane >> 5)) = pack4(v[0], v[1], v[2], v[3]);
        }
      }
    }
  }
};
struct BGateUp8 {
  const float* wg; long udiff; long ldb; int n0;
  DI const float* operator()(int c4) const {
    const int wn = c4 >> 6, ntl = (c4 >> 5) & 1, j = c4 & 31;
    return wg + (long)ntl * udiff + n0 + wn * 32 + j;
  }
};
DI void phase15_8w(const Params& p, int wg, int nwg) {
  const int ntl = p.ntiles[1];
  for (int item = wg; item < ntl * 2; item += nwg) {
    const int ti = item >> 1, nt_ = item & 1;
    const int e = p.tile2_e[ti], r0 = p.tile2_r0[ti], nr = p.tile2_nr[ti];
    AGather af{p.h, p.slot_tok, r0, nr};
    const float* wgp = e < 256 ? p.w_eg + (long)e * 1024 * 256 : p.w_sg;
    const float* wup = e < 256 ? p.w_eu + (long)e * 1024 * 256 : p.w_su;
    BGateUp8 bf{wgp, (long)(wup - wgp), 256, nt_ * 128};
    EpiH ef{p.H, r0, nr, nt_ * 128};
    gemm8w<false>(16, af, bf, ef);
  }
}
struct EpiYexp {
  u16* Y; const float* slot_wt; int r0, nr, n0;
  template <int MT> DI void operator()(f32x16 (&acc)[MT][2], int wm, int wn, int lane) const {
#pragma unroll
    for (int mt = 0; mt < MT; ++mt) {
      const int r = SW_R;
      if (r < nr) {
        const float w = slot_wt[r0 + r];
#pragma unroll
        for (int nt = 0; nt < 2; ++nt)
#pragma unroll
          for (int q4 = 0; q4 < 4; ++q4)
            *(uint2*)(Y + (long)(r0 + r) * 1024 + n0 + SW_C0) = pack4(SW_V(0) * w, SW_V(1) * w, SW_V(2) * w, SW_V(3) * w);
      }
    }
  }
};
DI void phase16_8w(const Params& p, int wg, int nwg) {
  const int ntl = p.ntiles[1];
  for (int item = wg; item < ntl * 4; item += nwg) {
    const int ti = item >> 2, nt_ = item & 3;
    const int e = p.tile2_e[ti], r0 = p.tile2_r0[ti], nr = p.tile2_nr[ti];
    ARows af{p.H + (long)r0 * 256, 256, nr};
    const float* wd = e < 256 ? p.w_ed + (long)e * 256 * 1024 : p.w_sd;
    BMat bf{wd + nt_ * 256, 1024, 256};
    EpiYexp ef{p.Y, p.slot_wt, r0, nr, nt_ * 256};
    gemm8w<false>(4, af, bf, ef);
  }
}
DI void phase17(const Params& p, int bid, int nblk) {
  const int tid = TIDX(), lane = tid & 63, wid = __builtin_amdgcn_readfirstlane(tid >> 6);
  for (int row = bid * 4 + wid; row < NTOK; row += nblk * 4) {
    const int b = row >> 13;
    const float* modb = p.mod + b * 6144;
    int slots[9];
#pragma unroll
    for (int k = 0; k < 8; ++k) slots[k] = p.tok_slot[row * 8 + k];
    slots[8] = 131072 + row;
    float yv[16];
#pragma unroll
    for (int j = 0; j < 16; ++j) yv[j] = 0.f;
#pragma unroll
    for (int k = 0; k < 9; ++k) {
#pragma unroll
      for (int i = 0; i < 4; ++i) {
        const uint2 u = *(const uint2*)(p.Y + (long)slots[k] * 1024 + i * 256 + lane * 4);
        yv[i * 4 + 0] += lo16(u.x); yv[i * 4 + 1] += hi16(u.x); yv[i * 4 + 2] += lo16(u.y); yv[i * 4 + 3] += hi16(u.y);
      }
    }
    float ss = 0.f;
#pragma unroll
    for (int j = 0; j < 16; ++j) ss += yv[j] * yv[j];
    ss = wave_sum(ss);
    const float r = rsqrtf(ss * (1.f / 1024.f) + 1e-6f);
#pragma unroll
    for (int i = 0; i < 4; ++i) {
      const int col = i * 256 + lane * 4;
      const float4 xx = *(const float4*)(p.x1 + (long)row * 1024 + col);
      float o[4] = {xx.x, xx.y, xx.z, xx.w};
#pragma unroll
      for (int j = 0; j < 4; ++j) o[j] += modb[5120 + col + j] * (yv[i * 4 + j] * r * p.g_post_ffn[col + j]);
      *(float4*)(p.out + (long)row * 1024 + col) = make_float4(o[0], o[1], o[2], o[3]);
    }
  }
}

__global__ void __launch_bounds__(512, 2) mega(Params p) {
  cg::grid_group grid = cg::this_grid();
  const int vb = __builtin_amdgcn_readfirstlane((int)(threadIdx.x >> 8));
  char* smem = g_smem + vb * HALF_LDS;
  const int bid = blockIdx.x * 2 + vb, nblk = gridDim.x * 2;
  if (p.phase_hi == 12345) grid.sync();
  if (threadIdx.x < 32) ((unsigned*)(g_smem + 2 * HALF_LDS))[threadIdx.x] = 0u;
  __syncthreads();
  const XcdBarrier xb = xcd_barrier_post(p.bar, (volatile LAS unsigned*)(g_smem + 2 * HALF_LDS));
#if !defined(ONLY) || ONLY==0
  if (p.phase_lo <= 0 && 0 < p.phase_hi) {
    phase0(p, smem, bid, nblk);
#if (REPEAT_MASK >> 0) & 1
    xcd_barrier(xb);
    phase0(p, smem, bid, nblk);
#endif
    if (0 + 1 < p.phase_hi) xcd_barrier(xb);
  }
#endif
#if !defined(ONLY) || ONLY==1
  if (p.phase_lo <= 1 && 1 < p.phase_hi) {
    phase1(p, smem, bid, nblk);
#if (REPEAT_MASK >> 1) & 1
    xcd_barrier(xb);
    phase1(p, smem, bid, nblk);
#endif
    if (1 + 1 < p.phase_hi) xcd_barrier(xb);
  }
#endif
#if !defined(ONLY) || ONLY==2
  if (p.phase_lo <= 2 && 2 < p.phase_hi) {
    phase2_8w(p, blockIdx.x, gridDim.x);
    __syncthreads();
    phase2(p, smem, bid, nblk);
#if (REPEAT_MASK >> 2) & 1
    xcd_barrier(xb);
    phase2(p, smem, bid, nblk);
#endif
    if (2 + 1 < p.phase_hi) xcd_barrier(xb);
  }
#endif
#if !defined(ONLY) || ONLY==3
  if (p.phase_lo <= 3 && 3 < p.phase_hi) {
    phase3(p, smem, bid, nblk);
#if (REPEAT_MASK >> 3) & 1
    xcd_barrier(xb);
    phase3(p, smem, bid, nblk);
#endif
    if (3 + 1 < p.phase_hi) xcd_barrier(xb);
  }
#endif
#if !defined(ONLY) || ONLY==4
  if (p.phase_lo <= 4 && 4 < p.phase_hi) {
    phase4(p, smem, bid, nblk);
#if (REPEAT_MASK >> 4) & 1
    xcd_barrier(xb);
    phase4(p, smem, bid, nblk);
#endif
    if (4 + 1 < p.phase_hi) xcd_barrier(xb);
  }
#endif
#if !defined(ONLY) || ONLY==5
  if (p.phase_lo <= 5 && 5 < p.phase_hi) {
    phase5_nsa8(p);
    phase5(p, smem, bid, nblk);
#if (REPEAT_MASK >> 5) & 1
    xcd_barrier(xb);
    phase5(p, smem, bid, nblk);
#endif
    if (5 + 1 < p.phase_hi) xcd_barrier(xb);
  }
#endif
#if !defined(ONLY) || ONLY==7
  if (p.phase_lo <= 7 && 7 < p.phase_hi) {
    phase7(p, smem, bid, nblk);
#if (REPEAT_MASK >> 7) & 1
    xcd_barrier(xb);
    phase7(p, smem, bid, nblk);
#endif
    if (7 + 1 < p.phase_hi) xcd_barrier(xb);
  }
#endif
#if !defined(ONLY) || ONLY==8
  if (p.phase_lo <= 8 && 8 < p.phase_hi) {
    phase8_8w(p, blockIdx.x, gridDim.x);
#if (REPEAT_MASK >> 8) & 1
    xcd_barrier(xb);
    phase8_8w(p, blockIdx.x, gridDim.x);
#endif
    if (8 + 1 < p.phase_hi) xcd_barrier(xb);
  }
#endif
#if !defined(ONLY) || ONLY==9
  if (p.phase_lo <= 9 && 9 < p.phase_hi) {
    phase9_8w(p, blockIdx.x, gridDim.x);
#if (REPEAT_MASK >> 9) & 1
    xcd_barrier(xb);
    phase9_8w(p, blockIdx.x, gridDim.x);
#endif
    if (9 + 1 < p.phase_hi) xcd_barrier(xb);
  }
#endif
#if !defined(ONLY) || ONLY==10
  if (p.phase_lo <= 10 && 10 < p.phase_hi) {
    phase10(p, bid, nblk);
#if (REPEAT_MASK >> 10) & 1
    xcd_barrier(xb);
    phase10(p, bid, nblk);
#endif
    if (10 + 1 < p.phase_hi) xcd_barrier(xb);
  }
#endif
#if !defined(ONLY) || ONLY==11
  if (p.phase_lo <= 11 && 11 < p.phase_hi) {
    phase11(p, smem, bid, nblk);
#if (REPEAT_MASK >> 11) & 1
    xcd_barrier(xb);
    phase11(p, smem, bid, nblk);
#endif
    if (11 + 1 < p.phase_hi) xcd_barrier(xb);
  }
#endif
#if !defined(ONLY) || ONLY==12
  if (p.phase_lo <= 12 && 12 < p.phase_hi) {
    phase12(p, bid, nblk);
#if (REPEAT_MASK >> 12) & 1
    xcd_barrier(xb);
    phase12(p, bid, nblk);
#endif
    if (12 + 1 < p.phase_hi) xcd_barrier(xb);
  }
#endif
#if !defined(ONLY) || ONLY==14
  if (p.phase_lo <= 14 && 14 < p.phase_hi) {
    phase14(p, smem, bid, nblk);
#if (REPEAT_MASK >> 14) & 1
    xcd_barrier(xb);
    phase14(p, smem, bid, nblk);
#endif
    if (14 + 1 < p.phase_hi) xcd_barrier(xb);
  }
#endif
#if !defined(ONLY) || ONLY==15
  if (p.phase_lo <= 15 && 15 < p.phase_hi) {
    phase15_8w(p, blockIdx.x, gridDim.x);
#if (REPEAT_MASK >> 15) & 1
    xcd_barrier(xb);
    phase15_8w(p, blockIdx.x, gridDim.x);
#endif
    if (15 + 1 < p.phase_hi) xcd_barrier(xb);
  }
#endif
#if !defined(ONLY) || ONLY==16
  if (p.phase_lo <= 16 && 16 < p.phase_hi) {
    phase16_8w(p, blockIdx.x, gridDim.x);
#if (REPEAT_MASK >> 16) & 1
    xcd_barrier(xb);
    phase16_8w(p, blockIdx.x, gridDim.x);
#endif
    if (16 + 1 < p.phase_hi) xcd_barrier(xb);
  }
#endif
#if !defined(ONLY) || ONLY==17
  if (p.phase_lo <= 17 && 17 < p.phase_hi) {
    phase17(p, bid, nblk);
#if (REPEAT_MASK >> 17) & 1
    xcd_barrier(xb);
    phase17(p, bid, nblk);
#endif
    if (17 + 1 < p.phase_hi) xcd_barrier(xb);
  }
#endif
}

extern "C" void kernel_launch(void* const* d_in, const int* in_sizes, int n_in, void* d_out, int out_size, void* d_ws, size_t ws_size,
                              hipStream_t stream) {
  static int grid_blocks = 0;
  if (!grid_blocks) {
    int dev = 0, cus = 0, per_cu = 0;
    (void)hipGetDevice(&dev);
    (void)hipDeviceGetAttribute(&cus, hipDeviceAttributeMultiprocessorCount, dev);
    (void)hipOccupancyMaxActiveBlocksPerMultiprocessor(&per_cu, mega, 512, 0);
    if (per_cu > 1) per_cu = 1;
    if (per_cu < 1) per_cu = 1;
    grid_blocks = cus * per_cu;
  }
  Params p{};
  const float* const* in = (const float* const*)d_in;
  p.x = in[0]; p.c = in[1]; p.w_ada = in[2]; p.b_ada = in[3]; p.g_pre_mix = in[4]; p.g_post_mix = in[5]; p.g_pre_ffn = in[6]; p.g_post_ffn = in[7];
  p.w_in = in[8]; p.rel_bias = in[9]; p.cmp_pe = in[10]; p.cmp_w1 = in[11]; p.cmp_b1 = in[12]; p.cmp_w2 = in[13]; p.dsa_kv_norm = in[14];
  p.dsa_w_uk = in[15]; p.dsa_w_uv = in[16]; p.w_bn = in[17]; p.w_bd = in[18]; p.w_out = in[19]; p.router_w = in[20]; p.router_bias = in[21];
  p.w_eg = in[22]; p.w_eu = in[23]; p.w_ed = in[24]; p.w_sg = in[25]; p.w_su = in[26]; p.w_sd = in[27];
  p.out = (float*)d_out;
  char* ws = (char*)d_ws;
  size_t off = 0;
  auto alloc = [&](size_t bytes) { char* r = ws + off; off += (bytes + 255) & ~(size_t)255; return r; };
  p.bar = (unsigned*)alloc(XCD_BAR_WORDS * 4);
  p.modp = (float*)alloc(16 * 2 * 6144 * 4);
  p.mod = (float*)alloc(2 * 6144 * 4);
  p.pe_part = (float*)alloc(16 * 256 * 4);
  p.w_ukT = (float*)alloc(8 * 64 * 128 * 4);
  p.w_inT = (u16*)alloc((size_t)4608 * 1024 * 2);
  p.w_bnT = (u16*)alloc((size_t)1024 * 512 * 2);
  p.w_bdT = (u16*)alloc((size_t)1024 * 512 * 2);
  p.w_outT = (u16*)alloc((size_t)1024 * 1024 * 2);
  p.routerT = (u16*)alloc((size_t)256 * 1024 * 2);
  p.counts = (int*)alloc(256 * 4);
  p.offs = (int*)alloc(257 * 4);
  p.tile_e = (int*)alloc(1536 * 4);
  p.tile_r0 = (int*)alloc(1536 * 4);
  p.tile_nr = (int*)alloc(1536 * 4);
  p.ntiles = (int*)alloc(8);
  p.tile2_e = (int*)alloc(1024 * 4);
  p.tile2_r0 = (int*)alloc(1024 * 4);
  p.tile2_nr = (int*)alloc(1024 * 4);
  p.h = (u16*)alloc((size_t)NTOK * 1024 * 2);
  p.proj = (u16*)alloc((size_t)NTOK * LDP * 2);
  p.widx = (float*)alloc((size_t)NTOK * 8 * 4);
  p.zc = (u16*)alloc((size_t)2 * 2048 * 128 * 2);
  p.kc = (u16*)alloc((size_t)4 * 512 * 64 * 2);
  p.vcT = (u16*)alloc((size_t)4 * 512 * 64 * 2);
  p.vts = (u16*)alloc((size_t)4 * 64 * T * 2);
  p.vtw = (u16*)alloc((size_t)4 * 64 * T * 2);
  p.qlat = (u16*)alloc((size_t)NTOK * 1024 * 2);
  p.ckv = (u16*)alloc((size_t)NTOK * 128 * 2);
  p.selk = (int*)alloc((size_t)NTOK * 256 * 4);
  p.onsa = (u16*)alloc((size_t)NTOK * 512 * 2);
  p.olat = (u16*)alloc((size_t)NTOK * 1024 * 2);
  p.odsa = (u16*)alloc((size_t)NTOK * 512 * 2);
  p.y = p.qlat;
  p.z = p.olat;
  p.eidx = (int*)alloc((size_t)NTOK * 8 * 4);
  p.ewt = (float*)alloc((size_t)NTOK * 8 * 4);
  p.erank = (int*)alloc((size_t)NTOK * 8 * 4);
  p.slot_tok = (int*)alloc((size_t)NSLOT * 4);
  p.slot_wt = (float*)alloc((size_t)NSLOT * 4);
  p.tok_slot = (int*)alloc((size_t)NTOK * 8 * 4);
  char* big = alloc((size_t)2 * T * T * 4);
  p.scores = (float*)big;
  {
    size_t o2 = 0;
    auto sub = [&](size_t bytes) { char* r = big + o2; o2 += (bytes + 255) & ~(size_t)255; return r; };
    p.H = (u16*)sub((size_t)NSLOT * 256 * 2);
    p.Y = (u16*)sub((size_t)NSLOT * 1024 * 2);
    p.x1 = (float*)sub((size_t)NTOK * 1024 * 4);
    p.logits = (float*)sub((size_t)NTOK * 256 * 4);
  }
  if (off > ws_size) fprintf(stderr, "workspace too small: need %zu have %zu\n", off, ws_size);
  p.phase_lo = 0;
  p.phase_hi = 18;
  (void)hipMemsetAsync(p.bar, 0, XCD_BAR_WORDS * 4, stream);
  void* args[] = {&p};
  hipError_t e = hipLaunchCooperativeKernel((void*)mega, dim3(grid_blocks), dim3(512), args, 0, stream);
  if (e != hipSuccess) fprintf(stderr, "coop launch failed: %s (grid %d)\n", hipGetErrorString(e), grid_blocks);
}
```

```cpp
#include <hip/hip_runtime.h>
#include <hip/hip_cooperative_groups.h>
#include <cstdio>
namespace cg = cooperative_groups;

#define DI __device__ __forceinline__
typedef unsigned short u16;
typedef unsigned long long u64;
using bf16x8 = __attribute__((ext_vector_type(8))) short;
using f32x16 = __attribute__((ext_vector_type(16))) float;
using f32x4 = __attribute__((ext_vector_type(4))) float;

constexpr int T = 8192;
constexpr int NTOK = 16384;
constexpr int LDP = 4576;
constexpr int C_QN = 0, C_KV = 512, C_GN = 1280, C_QD = 1304, C_CKV = 1816, C_QI = 1944, C_KI = 2456, C_WI = 2520, C_GM = 2528;
constexpr int NSLOT = 131072 + 16384;
constexpr int HALF_LDS = 73728;
constexpr int LDS_BYTES = 2 * HALF_LDS + 128;
__shared__ __attribute__((aligned(16))) char g_smem[LDS_BYTES];
#ifndef REPEAT_MASK
#define REPEAT_MASK 0
#endif

__device__ const unsigned char BUCKET[128] = {
  0, 1, 2, 3, 4, 5, 6, 7, 8, 9, 10, 11, 12, 13, 14, 15, 16, 16, 16, 17, 17, 18, 18, 18, 19, 19, 19, 20, 20, 20, 20, 21,
  21, 21, 21, 22, 22, 22, 22, 22, 23, 23, 23, 23, 23, 23, 24, 24, 24, 24, 24, 24, 25, 25, 25, 25, 25, 25, 25, 26, 26, 26, 26, 26,
  26, 26, 26, 27, 27, 27, 27, 27, 27, 27, 27, 27, 27, 28, 28, 28, 28, 28, 28, 28, 28, 28, 28, 29, 29, 29, 29, 29, 29, 29, 29, 29,
  29, 29, 29, 30, 30, 30, 30, 30, 30, 30, 30, 30, 30, 30, 30, 30, 30, 31, 31, 31, 31, 31, 31, 31, 31, 31, 31, 31, 31, 31, 31, 31};

struct Params {
  const float *x, *c, *w_ada, *b_ada, *g_pre_mix, *g_post_mix, *g_pre_ffn, *g_post_ffn, *w_in, *rel_bias;
  const float *cmp_pe, *cmp_w1, *cmp_b1, *cmp_w2, *dsa_kv_norm, *dsa_w_uk, *dsa_w_uv, *w_bn, *w_bd, *w_out;
  const float *router_w, *router_bias, *w_eg, *w_eu, *w_ed, *w_sg, *w_su, *w_sd;
  float* out;
  float* modp;
  float* mod;
  float* pe_part;
  float* w_ukT;
  u16 *w_inT, *w_bnT, *w_bdT, *w_outT, *routerT;
  u16* h;
  u16* proj;
  float* widx;
  u16* zc;
  u16* kc;
  u16* vcT;
  u16* vts;
  u16* vtw;
  u16* qlat;
  u16* ckv;
  float* scores;
  int* selk;
  u16* onsa;
  u16* olat;
  u16* odsa;
  u16* y;
  u16* z;
  float* x1;
  float* logits;
  int* eidx;
  float* ewt;
  int* erank;
  int* counts;
  int* offs;
  int* tile_e;
  int* tile_r0;
  int* tile_nr;
  int* ntiles;
  int *tile2_e, *tile2_r0, *tile2_nr;
  int* slot_tok;
  float* slot_wt;
  int* tok_slot;
  u16* H;
  u16* Y;
  unsigned* bar;
  int phase_lo, phase_hi;
};

DI float bf2f(u16 v) { return __uint_as_float(((unsigned)v) << 16); }
typedef __bf16 bf16x2_t __attribute__((ext_vector_type(2)));
typedef float f32x2_t __attribute__((ext_vector_type(2)));
DI unsigned pack2(float a, float b) { f32x2_t v = {a, b}; return __builtin_bit_cast(unsigned, __builtin_convertvector(v, bf16x2_t)); }
DI u16 f2bf(float x) { return (u16)(pack2(x, x) & 0xffffu); }
DI float lo16(unsigned u) { return __uint_as_float(u << 16); }
DI float hi16(unsigned u) { return __uint_as_float(u & 0xffff0000u); }
DI float wave_sum(float v) { for (int o = 32; o; o >>= 1) v += __shfl_xor(v, o); return v; }
DI float wave_max(float v) { for (int o = 32; o; o >>= 1) v = fmaxf(v, __shfl_xor(v, o)); return v; }
#define DPP_QP1 0xB1
#define DPP_QP2 0x4E
#define DPP_RHM 0x141
#define DPP_RM  0x140
#define DPP_B15 0x142
#define DPP_B31 0x143
DI int wave_sum_i(int x) {
  x += __builtin_amdgcn_update_dpp(0, x, DPP_QP1, 0xF, 0xF, true);
  x += __builtin_amdgcn_update_dpp(0, x, DPP_QP2, 0xF, 0xF, true);
  x += __builtin_amdgcn_update_dpp(0, x, DPP_RHM, 0xF, 0xF, true);
  x += __builtin_amdgcn_update_dpp(0, x, DPP_RM, 0xF, 0xF, true);
  x += __builtin_amdgcn_update_dpp(0, x, DPP_B15, 0xA, 0xF, true);
  x += __builtin_amdgcn_update_dpp(0, x, DPP_B31, 0xC, 0xF, true);
  return __builtin_amdgcn_readlane(x, 63);
}
#define DPP_SELF(x, CTRL, RM) ((unsigned)__builtin_amdgcn_update_dpp((int)(x), (int)(x), CTRL, RM, 0xF, false))
DI unsigned wave_max_u(unsigned x) {
  x = max(x, DPP_SELF(x, DPP_QP1, 0xF)); x = max(x, DPP_SELF(x, DPP_QP2, 0xF)); x = max(x, DPP_SELF(x, DPP_RHM, 0xF));
  x = max(x, DPP_SELF(x, DPP_RM, 0xF)); x = max(x, DPP_SELF(x, DPP_B15, 0xA)); x = max(x, DPP_SELF(x, DPP_B31, 0xC));
  return (unsigned)__builtin_amdgcn_readlane((int)x, 63);
}
DI unsigned wave_min_u(unsigned x) {
  x = min(x, DPP_SELF(x, DPP_QP1, 0xF)); x = min(x, DPP_SELF(x, DPP_QP2, 0xF)); x = min(x, DPP_SELF(x, DPP_RHM, 0xF));
  x = min(x, DPP_SELF(x, DPP_RM, 0xF)); x = min(x, DPP_SELF(x, DPP_B15, 0xA)); x = min(x, DPP_SELF(x, DPP_B31, 0xC));
  return (unsigned)__builtin_amdgcn_readlane((int)x, 63);
}
DI void wave_argmax(float& v, int& idx) {
#define AM_STEP(CTRL, RM)                                                                                                   \
  {                                                                                                                         \
    const float ov_ = __int_as_float(__builtin_amdgcn_update_dpp(__float_as_int(v), __float_as_int(v), CTRL, RM, 0xF, false)); \
    const int oi_ = __builtin_amdgcn_update_dpp(idx, idx, CTRL, RM, 0xF, false);                                            \
    const bool tk_ = ov_ > v || (ov_ == v && oi_ < idx);                                                                    \
    v = tk_ ? ov_ : v;                                                                                                      \
    idx = tk_ ? oi_ : idx;                                                                                                  \
  }
  AM_STEP(DPP_QP1, 0xF) AM_STEP(DPP_QP2, 0xF) AM_STEP(DPP_RHM, 0xF) AM_STEP(DPP_RM, 0xF) AM_STEP(DPP_B15, 0xA) AM_STEP(DPP_B31, 0xC)
#undef AM_STEP
  v = __int_as_float(__builtin_amdgcn_readlane(__float_as_int(v), 63));
  idx = __builtin_amdgcn_readlane(idx, 63);
}
DI float rdlane(float v, int l) { return __int_as_float(__builtin_amdgcn_readlane(__float_as_int(v), l)); }
DI int rdlane_i(int v, int l) { return __builtin_amdgcn_readlane(v, l); }
DI int TIDX() { int t = threadIdx.x & 255; asm volatile("" : "+v"(t)); return t; }
DI int TIDX8() { int t = threadIdx.x; asm volatile("" : "+v"(t)); return t; }
DI void hb_sync() {
  asm volatile("s_waitcnt vmcnt(0) lgkmcnt(0)" ::: "memory");
  const int vb = __builtin_amdgcn_readfirstlane((int)(threadIdx.x >> 8));
  volatile __attribute__((address_space(3))) unsigned* cnt = (volatile __attribute__((address_space(3))) unsigned*)(g_smem + 2 * HALF_LDS + 64) + vb * 8;
  if ((threadIdx.x & 63) == 0) {
    const unsigned old = __hip_atomic_fetch_add((__attribute__((address_space(3))) unsigned*)cnt, 1u, __ATOMIC_RELAXED, __HIP_MEMORY_SCOPE_WORKGROUP);
    const unsigned target = (old & ~3u) + 4u;
    while ((int)(*cnt - target) < 0) __builtin_amdgcn_s_sleep(0);
  }
  asm volatile("s_waitcnt lgkmcnt(0)" ::: "memory");
  __builtin_amdgcn_wave_barrier();
}
DI void cbar(const void* p) { asm volatile("" ::"v"(p) : "memory"); }
DI void wave_sync() { asm volatile("s_waitcnt lgkmcnt(0)" ::: "memory"); __builtin_amdgcn_wave_barrier(); }
DI float sigmoidf(float x) { return 1.f / (1.f + __expf(-x)); }
DI float siluf(float x) { return x / (1.f + __expf(-x)); }
DI float gelu_tanh(float x) { float u = 0.7978845608028654f * (x + 0.044715f * x * x * x); float e = __expf(2.f * u); float th = 1.f - 2.f / (e + 1.f); return 0.5f * x * (1.f + th); }


#define XB_TMO      128
#define XB_XCNT(j)  (256  + 64 * (j))
#define XB_XSUB(j)  (1280 + 64 * (j))
#define XB_XGEN(j)  (2304 + 64 * (j))
#define XB_TOP      3328
#define XB_TOPGEN   3392
#define XCD_BAR_WORDS 3456
#define XB_SPIN_CAP (1u << 22)
#define LAS __attribute__((address_space(3)))
DI unsigned xb_ld(unsigned* p) { return __hip_atomic_load(p, __ATOMIC_RELAXED, __HIP_MEMORY_SCOPE_AGENT); }
DI unsigned xb_add(unsigned* p, unsigned v) { return __hip_atomic_fetch_add(p, v, __ATOMIC_RELAXED, __HIP_MEMORY_SCOPE_AGENT); }
DI unsigned xb_xcc_id() { return (unsigned)__builtin_amdgcn_s_getreg((3 << 11) | 20) & 0xFu; }
#define XB_SPIN(cond, bar) do { unsigned _sp = 0; while (cond) { __builtin_amdgcn_s_sleep(1); \
    if ((++_sp & 255u) == 0u) { if (xb_ld(&(bar)[XB_TMO])) break; if (_sp > XB_SPIN_CAP) { atomicAdd(&(bar)[XB_TMO], 1u); break; } } } } while (0)
struct XcdBarrier { unsigned* bar; unsigned x; volatile LAS unsigned* st; };
DI XcdBarrier xcd_barrier_post(unsigned* bar, volatile LAS unsigned* st) {
  XcdBarrier b; b.bar = bar; b.x = xb_xcc_id(); b.st = st;
  if (threadIdx.x == 0) (void)xb_add(&bar[XB_XCNT(b.x)], 1u);
  return b;
}
DI void xcd_barrier_complete(unsigned* bar, unsigned x, unsigned& nloc, unsigned& nx) {
  const unsigned G = gridDim.x * gridDim.y * gridDim.z;
  unsigned sum, cnt, mine, sp = 0u;
  for (;;) {
    sum = 0u; cnt = 0u; mine = 0u;
#pragma unroll
    for (unsigned j = 0; j < 16; ++j) { const unsigned c = xb_ld(&bar[XB_XCNT(j)]); sum += c; cnt += (c > 0u) ? 1u : 0u; mine = (j == x) ? c : mine; }
    if (sum == G) break;
    __builtin_amdgcn_s_sleep(1);
    if ((++sp & 255u) == 0u) { if (xb_ld(&bar[XB_TMO])) break; if (sp > XB_SPIN_CAP) { atomicAdd(&bar[XB_TMO], 1u); break; } }
  }
  nloc = mine > 0u ? mine : 1u; nx = cnt > 0u ? cnt : 1u;
}
DI void xcd_barrier(const XcdBarrier& b) {
  asm volatile("s_waitcnt vmcnt(0)" ::: "memory");
  __syncthreads();
  if (threadIdx.x == 0) {
    unsigned* bar = b.bar;
    __builtin_amdgcn_s_waitcnt(0);
    unsigned nloc = b.st[0], nx = b.st[1];
    if (nloc == 0u) { xcd_barrier_complete(bar, b.x, nloc, nx); b.st[0] = nloc; b.st[1] = nx; }
    const unsigned old = xb_add(&bar[XB_XSUB(b.x)], 1u);
    const unsigned gen = old / nloc;
    if (old + 1u == (gen + 1u) * nloc) {
      __builtin_amdgcn_fence(__ATOMIC_RELEASE, "agent");
      asm volatile("s_waitcnt vmcnt(0)" ::: "memory");
      const unsigned og = xb_add(&bar[XB_TOP], 1u);
      const unsigned tg = og / nx;
      if (og + 1u == (tg + 1u) * nx) xb_add(&bar[XB_TOPGEN], 1u);
      else XB_SPIN(xb_ld(&bar[XB_TOPGEN]) == tg, bar);
      __builtin_amdgcn_fence(__ATOMIC_ACQUIRE, "agent");
      xb_add(&bar[XB_XGEN(b.x)], 1u);
      asm volatile("s_waitcnt vmcnt(0)" ::: "memory");
    } else {
      XB_SPIN(xb_ld(&bar[XB_XGEN(b.x)]) == gen, bar);
      __builtin_amdgcn_fence(__ATOMIC_ACQUIRE, "agent");
      asm volatile("s_waitcnt vmcnt(0)" ::: "memory");
    }
  }
  __syncthreads();
}

template <bool SWAP = true, bool SINGLE = false, bool BT16 = false, class AF, class BF, class EF>
DI void gemm_tile(char* smem, int nk, long a_kstep, const AF& af, const BF& bf, const EF& ef) {
  asm volatile("" ::: "memory");
  u16* As = (u16*)smem;
  const int tid = TIDX(), lane = tid & 63, wid = __builtin_amdgcn_readfirstlane(tid >> 6), wm = wid >> 1, wn = wid & 1;
  const int arow = tid >> 1, ahalf = tid & 1;
  const u16* ap = af(arow) + ahalf * 32;
  const int bkq = lane & 7, bnq = wid * 8 + (lane >> 3);
  const long ldb = bf.ldb;
  const float* bp = nullptr;
  const u16* bp16 = nullptr;
  if constexpr (BT16) bp16 = bf.row(arow) + ahalf * 32;
  else bp = bf(bnq * 4) + (long)(bkq * 4) * ldb;
  uint4 sa0_0, sa0_1, sa0_2, sa0_3, sa1_0, sa1_1, sa1_2, sa1_3;
  float4 sb0_0, sb0_1, sb0_2, sb0_3, sb0_4, sb0_5, sb0_6, sb0_7, sb1_0, sb1_1, sb1_2, sb1_3, sb1_4, sb1_5, sb1_6, sb1_7;
  uint4 tb0_0, tb0_1, tb0_2, tb0_3, tb1_0, tb1_1, tb1_2, tb1_3;
  f32x16 acc[2][2];
#pragma unroll
  for (int a = 0; a < 2; ++a)
#pragma unroll
    for (int b = 0; b < 2; ++b)
#pragma unroll
      for (int i = 0; i < 16; ++i) acc[a][b][i] = 0.f;

#define GEMM_LOAD(S, KT)                                                                  \
  {                                                                                       \
    const uint4* pa_ = (const uint4*)(ap + (long)(KT) * a_kstep);                         \
    sa##S##_0 = pa_[0]; sa##S##_1 = pa_[1]; sa##S##_2 = pa_[2]; sa##S##_3 = pa_[3];       \
    if constexpr (BT16) {                                                                 \
      const uint4* pt_ = (const uint4*)(bp16 + (long)(KT) * 64);                          \
      tb##S##_0 = pt_[0]; tb##S##_1 = pt_[1]; tb##S##_2 = pt_[2]; tb##S##_3 = pt_[3];     \
    } else {                                                                              \
      const float* pb_ = bp + (long)(KT) * 64 * ldb;                                      \
      sb##S##_0 = *(const float4*)(pb_);                                                  \
      sb##S##_1 = *(const float4*)(pb_ + ldb);                                            \
      sb##S##_2 = *(const float4*)(pb_ + 2 * ldb);                                        \
      sb##S##_3 = *(const float4*)(pb_ + 3 * ldb);                                        \
      sb##S##_4 = *(const float4*)(pb_ + 32 * ldb);                                       \
      sb##S##_5 = *(const float4*)(pb_ + 33 * ldb);                                       \
      sb##S##_6 = *(const float4*)(pb_ + 34 * ldb);                                       \
      sb##S##_7 = *(const float4*)(pb_ + 35 * ldb);                                       \
    }                                                                                     \
  }
#define GEMM_BW(V0, V1, V2, V3, C, I, QOFF)                                               \
  {                                                                                       \
    uint2 w_;                                                                             \
    w_.x = pack2(V0.C, V1.C);                                                             \
    w_.y = pack2(V2.C, V3.C);                                                             \
    *(uint2*)&Bs_[(bnq * 4 + (I)) * 72 + (QOFF) + bkq * 4] = w_;                          \
  }
#define GEMM_STORE(S, BUF)                                                                \
  {                                                                                       \
    u16* As_ = As + (BUF) * (2 * 128 * 72);                                               \
    u16* Bs_ = As_ + 128 * 72;                                                            \
    uint4* da_ = (uint4*)&As_[arow * 72 + ahalf * 32];                                    \
    da_[0] = sa##S##_0; da_[1] = sa##S##_1; da_[2] = sa##S##_2; da_[3] = sa##S##_3;       \
    if constexpr (BT16) {                                                                 \
      uint4* db_ = (uint4*)&Bs_[arow * 72 + ahalf * 32];                                  \
      db_[0] = tb##S##_0; db_[1] = tb##S##_1; db_[2] = tb##S##_2; db_[3] = tb##S##_3;     \
    } else {                                                                              \
      GEMM_BW(sb##S##_0, sb##S##_1, sb##S##_2, sb##S##_3, x, 0, 0)                        \
      GEMM_BW(sb##S##_0, sb##S##_1, sb##S##_2, sb##S##_3, y, 1, 0)                        \
      GEMM_BW(sb##S##_0, sb##S##_1, sb##S##_2, sb##S##_3, z, 2, 0)                        \
      GEMM_BW(sb##S##_0, sb##S##_1, sb##S##_2, sb##S##_3, w, 3, 0)                        \
      GEMM_BW(sb##S##_4, sb##S##_5, sb##S##_6, sb##S##_7, x, 0, 32)                       \
      GEMM_BW(sb##S##_4, sb##S##_5, sb##S##_6, sb##S##_7, y, 1, 32)                       \
      GEMM_BW(sb##S##_4, sb##S##_5, sb##S##_6, sb##S##_7, z, 2, 32)                       \
      GEMM_BW(sb##S##_4, sb##S##_5, sb##S##_6, sb##S##_7, w, 3, 32)                       \
    }                                                                                     \
  }
#define GEMM_COMPUTE(BUF)                                                                 \
  {                                                                                       \
    const u16* Ac = As + (BUF) * (2 * 128 * 72);                                          \
    const u16* Bc = Ac + 128 * 72;                                                        \
    _Pragma("unroll") for (int ks = 0; ks < 4; ++ks) {                                    \
      bf16x8 a[2], b[2];                                                                  \
      _Pragma("unroll") for (int mt = 0; mt < 2; ++mt) a[mt] = *(const bf16x8*)&Ac[(wm * 64 + mt * 32 + (lane & 31)) * 72 + ks * 16 + (lane >> 5) * 8]; \
      _Pragma("unroll") for (int nt = 0; nt < 2; ++nt) b[nt] = *(const bf16x8*)&Bc[(wn * 64 + nt * 32 + (lane & 31)) * 72 + ks * 16 + (lane >> 5) * 8]; \
      _Pragma("unroll") for (int mt = 0; mt < 2; ++mt)                                    \
      _Pragma("unroll") for (int nt = 0; nt < 2; ++nt)                                    \
        acc[mt][nt] = SWAP ? __builtin_amdgcn_mfma_f32_32x32x16_bf16(b[nt], a[mt], acc[mt][nt], 0, 0, 0) \
                           : __builtin_amdgcn_mfma_f32_32x32x16_bf16(a[mt], b[nt], acc[mt][nt], 0, 0, 0); \
    }                                                                                     \
  }
  GEMM_LOAD(0, 0)
  hb_sync();
  if (SINGLE) {
    GEMM_STORE(0, 0)
    hb_sync();
    GEMM_COMPUTE(0)
  } else {
    GEMM_LOAD(1, 1)
    GEMM_STORE(0, 0)
    hb_sync();
    const int last = nk - 1;
    for (int kt = 0; kt < nk; kt += 2) {
      const int k2 = kt + 2 < last ? kt + 2 : last, k3 = kt + 3 < last ? kt + 3 : last;
      GEMM_LOAD(0, k2)
      asm volatile("" ::: "memory");
      GEMM_COMPUTE(0)
      asm volatile("" ::: "memory");
      GEMM_STORE(1, 1)
      hb_sync();
      GEMM_LOAD(1, k3)
      asm volatile("" ::: "memory");
      GEMM_COMPUTE(1)
      asm volatile("" ::: "memory");
      GEMM_STORE(0, 0)
      hb_sync();
    }
  }
#undef GEMM_LOAD
#undef GEMM_STORE
#undef GEMM_BW
#undef GEMM_COMPUTE
  ef(acc, wm, wn, lane);
}

template <bool BT16, class AF, class BF, class EF>
DI void gemm_tile256(char* smem, int nk, const AF& af, const BF& bf, const EF& ef) {
  asm volatile("" ::: "memory");
  u16* As = (u16*)smem;
  u16* Bs = As + 256 * 72;
  const int tid = TIDX(), lane = tid & 63, wid = __builtin_amdgcn_readfirstlane(tid >> 6), wm = wid >> 1, wn = wid & 1;
  const int piece = tid & 7, rbase = tid >> 3;
  const u16* abase = af(0);
  int ao0, ao1, ao2, ao3, ao4, ao5, ao6, ao7;
  ao0 = (int)(af(rbase) - abase) + piece * 8;        ao1 = (int)(af(rbase + 32) - abase) + piece * 8;
  ao2 = (int)(af(rbase + 64) - abase) + piece * 8;   ao3 = (int)(af(rbase + 96) - abase) + piece * 8;
  ao4 = (int)(af(rbase + 128) - abase) + piece * 8;  ao5 = (int)(af(rbase + 160) - abase) + piece * 8;
  ao6 = (int)(af(rbase + 192) - abase) + piece * 8;  ao7 = (int)(af(rbase + 224) - abase) + piece * 8;
  const u16* bp16 = nullptr; long bstride = 0;
  const float* bp = nullptr; long ldb = 0;
  const int bkq = lane & 7, bnq = wid * 8 + (lane >> 3);
  if constexpr (BT16) { bp16 = bf.row(rbase) + piece * 8; bstride = bf.ldb * 32; }
  else { ldb = bf.ldb; bp = bf(bnq * 4) + (long)(bkq * 4) * ldb; }
  uint4 ra0, ra1, ra2, ra3, ra4, ra5, ra6, ra7, rb0, rb1, rb2, rb3;
  float4 fb0, fb1, fb2, fb3, fb4, fb5, fb6, fb7;
  f32x16 acc[4][2];
#pragma unroll
  for (int a = 0; a < 4; ++a)
#pragma unroll
    for (int b = 0; b < 2; ++b)
#pragma unroll
      for (int i = 0; i < 16; ++i) acc[a][b][i] = 0.f;
#define G256_LOAD(KT)                                                   \
  {                                                                     \
    const u16* pa_ = abase + (long)(KT) * 64;                           \
    ra0 = *(const uint4*)(pa_ + ao0); ra1 = *(const uint4*)(pa_ + ao1); \
    ra2 = *(const uint4*)(pa_ + ao2); ra3 = *(const uint4*)(pa_ + ao3); \
    ra4 = *(const uint4*)(pa_ + ao4); ra5 = *(const uint4*)(pa_ + ao5); \
    ra6 = *(const uint4*)(pa_ + ao6); ra7 = *(const uint4*)(pa_ + ao7); \
    if constexpr (BT16) {                                               \
      const u16* pb_ = bp16 + (long)(KT) * 64;                          \
      rb0 = *(const uint4*)(pb_);                                       \
      rb1 = *(const uint4*)(pb_ + bstride);                             \
      rb2 = *(const uint4*)(pb_ + 2 * bstride);                         \
      rb3 = *(const uint4*)(pb_ + 3 * bstride);                         \
    } else {                                                            \
      const float* pf_ = bp + (long)(KT) * 64 * ldb;                    \
      fb0 = *(const float4*)(pf_);            fb1 = *(const float4*)(pf_ + ldb);      \
      fb2 = *(const float4*)(pf_ + 2 * ldb);  fb3 = *(const float4*)(pf_ + 3 * ldb);  \
      fb4 = *(const float4*)(pf_ + 32 * ldb); fb5 = *(const float4*)(pf_ + 33 * ldb); \
      fb6 = *(const float4*)(pf_ + 34 * ldb); fb7 = *(const float4*)(pf_ + 35 * ldb); \
    }                                                                   \
  }
#define G256_BW(V0, V1, V2, V3, C, I, QOFF)                             \
  {                                                                     \
    uint2 w_;                                                           \
    w_.x = pack2(V0.C, V1.C);                                           \
    w_.y = pack2(V2.C, V3.C);                                           \
    *(uint2*)&Bs[(bnq * 4 + (I)) * 72 + (QOFF) + bkq * 4] = w_;         \
  }
  G256_LOAD(0)
  const int last = nk - 1;
  for (int kt = 0; kt < nk; ++kt) {
    hb_sync();
    {
      u16* da = As + rbase * 72 + piece * 8;
      *(uint4*)(da) = ra0;            *(uint4*)(da + 32 * 72) = ra1;  *(uint4*)(da + 64 * 72) = ra2;  *(uint4*)(da + 96 * 72) = ra3;
      *(uint4*)(da + 128 * 72) = ra4; *(uint4*)(da + 160 * 72) = ra5; *(uint4*)(da + 192 * 72) = ra6; *(uint4*)(da + 224 * 72) = ra7;
      if constexpr (BT16) {
        u16* db = Bs + rbase * 72 + piece * 8;
        *(uint4*)(db) = rb0; *(uint4*)(db + 32 * 72) = rb1; *(uint4*)(db + 64 * 72) = rb2; *(uint4*)(db + 96 * 72) = rb3;
      } else {
        G256_BW(fb0, fb1, fb2, fb3, x, 0, 0)  G256_BW(fb0, fb1, fb2, fb3, y, 1, 0)
        G256_BW(fb0, fb1, fb2, fb3, z, 2, 0)  G256_BW(fb0, fb1, fb2, fb3, w, 3, 0)
        G256_BW(fb4, fb5, fb6, fb7, x, 0, 32) G256_BW(fb4, fb5, fb6, fb7, y, 1, 32)
        G256_BW(fb4, fb5, fb6, fb7, z, 2, 32) G256_BW(fb4, fb5, fb6, fb7, w, 3, 32)
      }
    }
    hb_sync();
    const int kn = kt + 1 < last ? kt + 1 : last;
    G256_LOAD(kn)
    asm volatile("" ::: "memory");
#pragma unroll
    for (int ks = 0; ks < 4; ++ks) {
      bf16x8 a[4], b[2];
#pragma unroll
      for (int mt = 0; mt < 4; ++mt) a[mt] = *(const bf16x8*)&As[(wm * 128 + mt * 32 + (lane & 31)) * 72 + ks * 16 + (lane >> 5) * 8];
#pragma unroll
      for (int nt = 0; nt < 2; ++nt) b[nt] = *(const bf16x8*)&Bs[(wn * 64 + nt * 32 + (lane & 31)) * 72 + ks * 16 + (lane >> 5) * 8];
#pragma unroll
      for (int mt = 0; mt < 4; ++mt)
#pragma unroll
        for (int nt = 0; nt < 2; ++nt) acc[mt][nt] = __builtin_amdgcn_mfma_f32_32x32x16_bf16(b[nt], a[mt], acc[mt][nt], 0, 0, 0);
    }
    asm volatile("" ::: "memory");
  }
#undef G256_LOAD
#undef G256_BW
  ef(acc, wm, wn, lane);
}

template <bool BT16, class AF, class BF, class EF>
DI void gemm8w(int nk, const AF& af, const BF& bf, const EF& ef) {
  asm volatile("" ::: "memory");
  u16* S0 = (u16*)g_smem;
  int tid = threadIdx.x; asm volatile("" : "+v"(tid));
  const int lane = tid & 63, wid = __builtin_amdgcn_readfirstlane(tid >> 6), wm = wid >> 2, wn = wid & 3;
  const int piece = tid & 7, rbase = tid >> 3;
  const u16* abase = af.origin();
  const int ao0 = af.off(rbase) + piece * 8, ao1 = af.off(rbase + 64) + piece * 8, ao2 = af.off(rbase + 128) + piece * 8, ao3 = af.off(rbase + 192) + piece * 8;
  const u16 *bq0 = nullptr, *bq1 = nullptr, *bq2 = nullptr, *bq3 = nullptr;
  const float* bp = nullptr; long ldb = 0;
  const int bkq = lane & 7, bnq = wid * 8 + (lane >> 3);
  if constexpr (BT16) { bq0 = bf.row(rbase) + piece * 8; bq1 = bf.row(rbase + 64) + piece * 8; bq2 = bf.row(rbase + 128) + piece * 8; bq3 = bf.row(rbase + 192) + piece * 8; }
  else { ldb = bf.ldb; bp = bf(bnq * 4) + (long)(bkq * 4) * ldb; }
  uint4 ra0, ra1, ra2, ra3, rb0, rb1, rb2, rb3;
  float4 fb0, fb1, fb2, fb3, fb4, fb5, fb6, fb7;
  f32x16 acc[4][2];
#pragma unroll
  for (int a = 0; a < 4; ++a)
#pragma unroll
    for (int b = 0; b < 2; ++b)
#pragma unroll
      for (int i = 0; i < 16; ++i) acc[a][b][i] = 0.f;
#define G8_LOAD(KT)                                                     \
  {                                                                     \
    const u16* pa_ = abase + (long)(KT) * 64;                           \
    ra0 = *(const uint4*)(pa_ + ao0); ra1 = *(const uint4*)(pa_ + ao1); \
    ra2 = *(const uint4*)(pa_ + ao2); ra3 = *(const uint4*)(pa_ + ao3); \
    if constexpr (BT16) {                                               \
      rb0 = *(const uint4*)(bq0 + (long)(KT) * 64); rb1 = *(const uint4*)(bq1 + (long)(KT) * 64); \
      rb2 = *(const uint4*)(bq2 + (long)(KT) * 64); rb3 = *(const uint4*)(bq3 + (long)(KT) * 64); \
    } else {                                                            \
      const float* pf_ = bp + (long)(KT) * 64 * ldb;                    \
      fb0 = *(const float4*)(pf_);            fb1 = *(const float4*)(pf_ + ldb);      \
      fb2 = *(const float4*)(pf_ + 2 * ldb);  fb3 = *(const float4*)(pf_ + 3 * ldb);  \
      fb4 = *(const float4*)(pf_ + 32 * ldb); fb5 = *(const float4*)(pf_ + 33 * ldb); \
      fb6 = *(const float4*)(pf_ + 34 * ldb); fb7 = *(const float4*)(pf_ + 35 * ldb); \
    }                                                                   \
  }
#define G8_BW(V0, V1, V2, V3, C, I, QOFF)                               \
  {                                                                     \
    uint2 w_;                                                           \
    w_.x = pack2(V0.C, V1.C);                                           \
    w_.y = pack2(V2.C, V3.C);                                           \
    *(uint2*)&Bs_[(bnq * 4 + (I)) * 72 + (QOFF) + bkq * 4] = w_;        \
  }
#define G8_STORE(BUF)                                                   \
  {                                                                     \
    u16* As_ = S0 + (BUF) * (512 * 72);                                 \
    u16* Bs_ = As_ + 256 * 72;                                          \
    u16* da = As_ + rbase * 72 + piece * 8;                             \
    *(uint4*)(da) = ra0; *(uint4*)(da + 64 * 72) = ra1; *(uint4*)(da + 128 * 72) = ra2; *(uint4*)(da + 192 * 72) = ra3; \
    if constexpr (BT16) {                                               \
      u16* db = Bs_ + rbase * 72 + piece * 8;                           \
      *(uint4*)(db) = rb0; *(uint4*)(db + 64 * 72) = rb1; *(uint4*)(db + 128 * 72) = rb2; *(uint4*)(db + 192 * 72) = rb3; \
    } else {                                                            \
      G8_BW(fb0, fb1, fb2, fb3, x, 0, 0)  G8_BW(fb0, fb1, fb2, fb3, y, 1, 0)   \
      G8_BW(fb0, fb1, fb2, fb3, z, 2, 0)  G8_BW(fb0, fb1, fb2, fb3, w, 3, 0)   \
      G8_BW(fb4, fb5, fb6, fb7, x, 0, 32) G8_BW(fb4, fb5, fb6, fb7, y, 1, 32)  \
      G8_BW(fb4, fb5, fb6, fb7, z, 2, 32) G8_BW(fb4, fb5, fb6, fb7, w, 3, 32)  \
    }                                                                   \
  }
  G8_LOAD(0)
  __syncthreads();
  G8_STORE(0)
  __syncthreads();
  const int last = nk - 1;
  for (int kt = 0; kt < nk; ++kt) {
    const int kn = kt + 1 < last ? kt + 1 : last;
    G8_LOAD(kn)
    asm volatile("" ::: "memory");
    {
      const u16* Ac = S0 + (kt & 1) * (512 * 72);
      const u16* Bc = Ac + 256 * 72;
#pragma unroll
      for (int ks = 0; ks < 4; ++ks) {
        bf16x8 a[4], b[2];
#pragma unroll
        for (int mt = 0; mt < 4; ++mt) a[mt] = *(const bf16x8*)&Ac[(wm * 128 + mt * 32 + (lane & 31)) * 72 + ks * 16 + (lane >> 5) * 8];
#pragma unroll
        for (int nt = 0; nt < 2; ++nt) b[nt] = *(const bf16x8*)&Bc[(wn * 64 + nt * 32 + (lane & 31)) * 72 + ks * 16 + (lane >> 5) * 8];
#pragma unroll
        for (int mt = 0; mt < 4; ++mt)
#pragma unroll
          for (int nt = 0; nt < 2; ++nt) acc[mt][nt] = __builtin_amdgcn_mfma_f32_32x32x16_bf16(b[nt], a[mt], acc[mt][nt], 0, 0, 0);
      }
    }
    asm volatile("" ::: "memory");
    if (kt + 1 < nk) {
      G8_STORE((kt + 1) & 1)
      __syncthreads();
    }
  }
#undef G8_LOAD
#undef G8_BW
#undef G8_STORE
  ef(acc, wm, wn, lane);
}

DI void st_stage_rc(int b, int& R, int& C) {
  const int st = b >> 10, sb = b & 1023, swz = sb ^ (((sb >> 9) & 1) << 5);
  R = (st >> 1) * 16 + (swz >> 6); C = (st & 1) * 32 + ((swz & 63) >> 1);
}
template <class PF, class QF, class EF>
DI void gemm8p(int nt, const PF& pf, const QF& qf, const EF& ef) {
  asm volatile("" ::: "memory");
  constexpr int HTB = 128 * 64 * 2;
  int tid = threadIdx.x; asm volatile("" : "+v"(tid));
  const int lane = tid & 63, wid = __builtin_amdgcn_readfirstlane(tid >> 6), wr = wid >> 2, wc = wid & 3, fr = lane & 15, fq = lane >> 4;
  int r0, c0, r1, c1;
  st_stage_rc(tid * 16, r0, c0);
  st_stage_rc(tid * 16 + 8192, r1, c1);
  const u16* pbase = pf.origin();
  const u16* qbase = qf.origin();
  const unsigned po00 = (unsigned)(pf.off(r0) + c0) * 2u, po01 = (unsigned)(pf.off(r1) + c1) * 2u;
  const unsigned po10 = (unsigned)(pf.off(128 + r0) + c0) * 2u, po11 = (unsigned)(pf.off(128 + r1) + c1) * 2u;
  const unsigned qo00 = (unsigned)(qf.off(r0) + c0) * 2u, qo01 = (unsigned)(qf.off(r1) + c1) * 2u;
  const unsigned qo10 = (unsigned)(qf.off(128 + r0) + c0) * 2u, qo11 = (unsigned)(qf.off(128 + r1) + c1) * 2u;
  const unsigned sdst = (unsigned)__builtin_amdgcn_readfirstlane((int)((unsigned)(size_t)g_smem + (unsigned)(tid & ~63) * 16u));
  const int laneoff = (fr * 64 + fq * 16) ^ ((fr >> 3) << 5);
  const char* rdP = g_smem + wr * 8192 + laneoff;
  const char* rdQ = g_smem + 4 * HTB + wc * 4096 + laneoff;
#define G8P_ST(SLOT, BASE, O0, O1, KT)                                                                                     \
  {                                                                                                                        \
    const char* g_ = (const char*)(BASE) + (long)(KT) * 128;                                                               \
    __builtin_amdgcn_global_load_lds((const unsigned*)(g_ + (O0)), (LAS unsigned*)(size_t)(sdst + (SLOT) * HTB), 16, 0, 0);          \
    __builtin_amdgcn_global_load_lds((const unsigned*)(g_ + (O1)), (LAS unsigned*)(size_t)(sdst + (SLOT) * HTB + 8192), 16, 0, 0);   \
  }
#define G8P_STP(b, h, KT) { if ((h) == 0) G8P_ST((b) * 2, pbase, po00, po01, KT) else G8P_ST((b) * 2 + 1, pbase, po10, po11, KT) }
#define G8P_STQ(b, h, KT) { if ((h) == 0) G8P_ST(4 + (b) * 2, qbase, qo00, qo01, KT) else G8P_ST(4 + (b) * 2 + 1, qbase, qo10, qo11, KT) }
#define G8P_LDP(b, h)                                                                                                      \
  _Pragma("unroll") for (int m = 0; m < 4; ++m) _Pragma("unroll") for (int k = 0; k < 2; ++k)                              \
    Pt[m][k] = *(const bf16x8*)(rdP + ((b) * 2 + (h)) * HTB + m * 2048 + k * 1024);
#define G8P_LDQ(dst, b, h)                                                                                                 \
  _Pragma("unroll") for (int n = 0; n < 2; ++n) _Pragma("unroll") for (int k = 0; k < 2; ++k)                              \
    dst[n][k] = *(const bf16x8*)(rdQ + ((b) * 2 + (h)) * HTB + n * 2048 + k * 1024);
#define G8P_MMA(ai, bj, QT)                                                                                                \
  {                                                                                                                        \
    __builtin_amdgcn_s_setprio(1);                                                                                         \
    _Pragma("unroll") for (int m = 0; m < 4; ++m) _Pragma("unroll") for (int n = 0; n < 2; ++n)                            \
      _Pragma("unroll") for (int k = 0; k < 2; ++k)                                                                        \
        acc[ai][bj][m][n] = __builtin_amdgcn_mfma_f32_16x16x32_bf16(Pt[m][k], QT[n][k], acc[ai][bj][m][n], 0, 0, 0);       \
    __builtin_amdgcn_s_setprio(0);                                                                                         \
  }
#define G8P_WV(n) asm volatile("s_waitcnt vmcnt(" #n ")" ::: "memory")
#define G8P_WL(n) asm volatile("s_waitcnt lgkmcnt(" #n ")" ::: "memory")
#define G8P_BAR __builtin_amdgcn_s_barrier()
#define G8P_SCHED __builtin_amdgcn_sched_barrier(0)
  f32x4 acc[2][2][4][2];
#pragma unroll
  for (int a = 0; a < 2; ++a)
#pragma unroll
    for (int b = 0; b < 2; ++b)
#pragma unroll
      for (int m = 0; m < 4; ++m)
#pragma unroll
        for (int n = 0; n < 2; ++n) acc[a][b][m][n] = (f32x4){0.f, 0.f, 0.f, 0.f};
  bf16x8 Pt[4][2], Q0[2][2], Q1[2][2];
  __syncthreads();
  G8P_STQ(0, 0, 0) G8P_STP(0, 0, 0) G8P_STQ(0, 1, 0) G8P_STP(0, 1, 0)
  if (wr == 1) G8P_BAR;
  G8P_WV(4); G8P_BAR;
  G8P_STQ(1, 0, 1) G8P_STP(1, 0, 1) G8P_STQ(1, 1, 1)
  G8P_WV(6); G8P_BAR;
  for (int t = 0; t < nt - 2; t += 2) {
    G8P_LDQ(Q0, 0, 0) G8P_SCHED; G8P_LDP(0, 0) G8P_STP(1, 1, t + 1)
    G8P_WL(8); G8P_BAR; G8P_WL(0); G8P_MMA(0, 0, Q0) G8P_BAR; G8P_SCHED;
    G8P_LDQ(Q1, 0, 1) G8P_STQ(0, 0, t + 2)
    G8P_BAR; G8P_WL(0); G8P_MMA(0, 1, Q1) G8P_BAR;
    G8P_LDP(0, 1) G8P_STP(0, 0, t + 2)
    G8P_BAR; G8P_WL(0); G8P_MMA(1, 0, Q0) G8P_BAR; G8P_SCHED;
    G8P_STQ(0, 1, t + 2)
    G8P_WV(6); G8P_BAR; G8P_MMA(1, 1, Q1) G8P_BAR;
    G8P_LDQ(Q0, 1, 0) G8P_SCHED; G8P_LDP(1, 0) G8P_STP(0, 1, t + 2)
    G8P_WL(8); G8P_BAR; G8P_WL(0); G8P_MMA(0, 0, Q0) G8P_BAR; G8P_SCHED;
    G8P_LDQ(Q1, 1, 1) G8P_STQ(1, 0, t + 3)
    G8P_BAR; G8P_WL(0); G8P_MMA(0, 1, Q1) G8P_BAR;
    G8P_LDP(1, 1) G8P_STP(1, 0, t + 3)
    G8P_BAR; G8P_WL(0); G8P_MMA(1, 0, Q0) G8P_BAR; G8P_SCHED;
    G8P_STQ(1, 1, t + 3)
    G8P_WV(6); G8P_BAR; G8P_MMA(1, 1, Q1) G8P_BAR;
  }
  {
    G8P_LDQ(Q0, 0, 0) G8P_LDP(0, 0) G8P_STP(1, 1, nt - 1)
    G8P_BAR; G8P_WL(0); G8P_MMA(0, 0, Q0) G8P_BAR;
    G8P_LDQ(Q1, 0, 1) G8P_BAR; G8P_WL(0); G8P_MMA(0, 1, Q1) G8P_BAR;
    G8P_LDP(0, 1) G8P_WV(4); G8P_BAR; G8P_WL(0); G8P_MMA(1, 0, Q0) G8P_MMA(1, 1, Q1) G8P_BAR;
  }
  {
    G8P_LDQ(Q0, 1, 0) G8P_LDP(1, 0) G8P_WV(2); G8P_BAR; G8P_WL(0); G8P_MMA(0, 0, Q0) G8P_BAR;
    G8P_LDQ(Q1, 1, 1) G8P_WV(0); G8P_BAR; G8P_WL(0); G8P_MMA(0, 1, Q1) G8P_BAR;
    G8P_LDP(1, 1) G8P_BAR; G8P_WL(0); G8P_MMA(1, 0, Q0) G8P_MMA(1, 1, Q1) G8P_BAR;
  }
  if (wr == 0) G8P_BAR;
#undef G8P_ST
#undef G8P_STP
#undef G8P_STQ
#undef G8P_LDP
#undef G8P_LDQ
#undef G8P_MMA
#undef G8P_WV
#undef G8P_WL
#undef G8P_BAR
#undef G8P_SCHED
#pragma unroll
  for (int ai = 0; ai < 2; ++ai)
#pragma unroll
    for (int bj = 0; bj < 2; ++bj)
#pragma unroll
      for (int m = 0; m < 4; ++m)
#pragma unroll
        for (int n = 0; n < 2; ++n)
          ef(bj * 128 + wc * 32 + n * 16 + fr, ai * 128 + wr * 64 + m * 16 + fq * 4, acc[ai][bj][m][n][0], acc[ai][bj][m][n][1], acc[ai][bj][m][n][2], acc[ai][bj][m][n][3]);
}

#define EPI_FOR                                                   \
  _Pragma("unroll") for (int mt = 0; mt < 2; ++mt)                \
  _Pragma("unroll") for (int nt = 0; nt < 2; ++nt)                \
  _Pragma("unroll") for (int i = 0; i < 16; ++i)
#define EPI_R (wm * 64 + mt * 32 + (i & 3) + 8 * (i >> 2) + 4 * (lane >> 5))
#define EPI_C (wn * 64 + nt * 32 + (lane & 31))
#define SW_FOR                                                    \
  _Pragma("unroll") for (int mt = 0; mt < MT; ++mt)               \
  _Pragma("unroll") for (int nt = 0; nt < 2; ++nt)                \
  _Pragma("unroll") for (int q4 = 0; q4 < 4; ++q4)
#define SW_R (wm * (32 * MT) + mt * 32 + (lane & 31))
#define SW_C0 (wn * 64 + nt * 32 + 8 * q4 + 4 * (lane >> 5))
#define SW_V(j) acc[mt][nt][4 * q4 + (j)]
DI uint2 pack4(float a, float b, float c, float d) { uint2 w; w.x = pack2(a, b); w.y = pack2(c, d); return w; }

struct ARows { const u16* base; long ld; int nrows; DI const u16* operator()(int r) const { return base + (long)(r < nrows ? r : 0) * ld; }
  DI const u16* origin() const { return base; } DI int off(int r) const { return (r < nrows ? r : 0) * (int)ld; } };
struct BMat { const float* base; long ldb; int ncols; DI const float* operator()(int c4) const { return base + (c4 < ncols ? c4 : 0); } DI const u16* row(int) const { return nullptr; } };
struct BMatT { const u16* base; long ldb; DI const float* operator()(int) const { return nullptr; } DI const u16* row(int n) const { return base + (long)n * ldb; } };

DI void phase0(const Params& p, char* smem, int bid, int nblk) {
  const int tid = TIDX();
  for (int item = bid; item < 384 + 256 + 16 + 1 + 1728; item += nblk) {
    if (item < 384) {
      const int cc = item % 24, kc = item / 24;
      const int col = cc * 256 + tid;
      float a0 = 0.f, a1 = 0.f;
#pragma unroll 1
      for (int half = 0; half < 2; ++half) {
        const int k0 = kc * 64 + half * 32;
        float w[32];
#pragma unroll
        for (int j = 0; j < 32; ++j) w[j] = p.w_ada[(long)(k0 + j) * 6144 + col];
#pragma unroll
        for (int j = 0; j < 32; ++j) {
          a0 += siluf(p.c[k0 + j]) * w[j];
          a1 += siluf(p.c[1024 + k0 + j]) * w[j];
        }
      }
      p.modp[(kc * 2 + 0) * 6144 + col] = a0;
      p.modp[(kc * 2 + 1) * 6144 + col] = a1;
    } else if (item < 640) {
      const int idx = (item - 384) * 256 + tid;
      const int c = idx & 127, d = (idx >> 7) & 63, h = idx >> 13;
      p.w_ukT[idx] = p.dsa_w_uk[c * 512 + h * 64 + d];
    } else if (item < 656) {
      const int part = item - 640;
      const int slot = tid >> 7, kk = tid & 127;
      float a = 0.f;
      for (int ld = part * 128; ld < part * 128 + 128; ++ld) a += p.cmp_pe[slot * 2048 + ld] * p.cmp_w1[((long)slot * 2048 + ld) * 128 + kk];
      p.pe_part[part * 256 + tid] = a;
    } else if (item == 656) {
      p.counts[tid] = 0;
    } else {
      int it = item - 657;
      const float* W; u16* WT; int K, N, ntn;
      if (it < 1152) { W = p.w_in; WT = p.w_inT; K = 1024; N = LDP; ntn = 72; }
      else if (it < 1280) { it -= 1152; W = p.w_bn; WT = p.w_bnT; K = 512; N = 1024; ntn = 16; }
      else if (it < 1408) { it -= 1280; W = p.w_bd; WT = p.w_bdT; K = 512; N = 1024; ntn = 16; }
      else if (it < 1664) { it -= 1408; W = p.w_out; WT = p.w_outT; K = 1024; N = 1024; ntn = 16; }
      else { it -= 1664; W = p.router_w; WT = p.routerT; K = 1024; N = 256; ntn = 4; }
      const int k0 = (it / ntn) * 64, n0 = (it % ntn) * 64;
      u16* tl = (u16*)smem;
      hb_sync();
      const int kr = tid >> 4, nq = tid & 15;
#pragma unroll
      for (int ps = 0; ps < 4; ++ps) {
        const int k = kr + 16 * ps, n = n0 + nq * 4;
        float4 v = make_float4(0.f, 0.f, 0.f, 0.f);
        if (n < N) v = *(const float4*)(W + (long)(k0 + k) * N + n);
        tl[(nq * 4 + 0) * 72 + k] = f2bf(v.x);
        tl[(nq * 4 + 1) * 72 + k] = f2bf(v.y);
        tl[(nq * 4 + 2) * 72 + k] = f2bf(v.z);
        tl[(nq * 4 + 3) * 72 + k] = f2bf(v.w);
      }
      hb_sync();
      const int nr = tid >> 2, piece = tid & 3;
      const uint4 a = *(const uint4*)(tl + nr * 72 + piece * 16);
      const uint4 b = *(const uint4*)(tl + nr * 72 + piece * 16 + 8);
      uint4* dst = (uint4*)(WT + (long)(n0 + nr) * K + k0 + piece * 16);
      dst[0] = a; dst[1] = b;
    }
  }
}

DI void phase1(const Params& p, char* smem, int bid, int nblk) {
  const int tid = TIDX(), lane = tid & 63, wid = __builtin_amdgcn_readfirstlane(tid >> 6);
  float* modl = (float*)smem;
  for (int idx = tid; idx < 4096; idx += 256) {
    const int b = idx >> 11, n = idx & 2047;
    float v = p.b_ada[n];
    for (int kc = 0; kc < 16; ++kc) v += p.modp[(kc * 2 + b) * 6144 + n];
    modl[idx] = v;
  }
  if (bid < 48) {
    const int idx = bid * 256 + tid;
    const int b = idx / 6144, n = idx % 6144;
    float v = p.b_ada[n];
    for (int kc = 0; kc < 16; ++kc) v += p.modp[(kc * 2 + b) * 6144 + n];
    p.mod[idx] = v;
  }
  hb_sync();
  for (int row = bid * 4 + wid; row < NTOK; row += nblk * 4) {
    const int b = row >> 13;
    const float* xr = p.x + (long)row * 1024;
    float4 v[4];
    float ss = 0.f;
#pragma unroll
    for (int i = 0; i < 4; ++i) {
      v[i] = *(const float4*)(xr + i * 256 + lane * 4);
      ss += v[i].x * v[i].x + v[i].y * v[i].y + v[i].z * v[i].z + v[i].w * v[i].w;
    }
    ss = wave_sum(ss);
    const float r = rsqrtf(ss * (1.f / 1024.f) + 1e-6f);
#pragma unroll
    for (int i = 0; i < 4; ++i) {
      const int col = i * 256 + lane * 4;
      const float4 g = *(const float4*)(p.g_pre_mix + col);
      const float* sh = modl + b * 2048 + col;
      const float* sc = modl + b * 2048 + 1024 + col;
      const float o0 = v[i].x * r * g.x * (1.f + sc[0]) + sh[0];
      const float o1 = v[i].y * r * g.y * (1.f + sc[1]) + sh[1];
      const float o2 = v[i].z * r * g.z * (1.f + sc[2]) + sh[2];
      const float o3 = v[i].w * r * g.w * (1.f + sc[3]) + sh[3];
      uint2 w;
      w.x = pack2(o0, o1);
      w.y = pack2(o2, o3);
      *(uint2*)(p.h + (long)row * 1024 + col) = w;
    }
  }
}

struct EpiProj {
  u16* proj; float* widx; int m0, n0;
  template <int MT> DI void operator()(f32x16 (&acc)[MT][2], int wm, int wn, int lane) const {
    SW_FOR {
      const int r = m0 + SW_R, c = n0 + SW_C0;
      if (c < LDP) {
        float v[4] = {SW_V(0), SW_V(1), SW_V(2), SW_V(3)};
        if (c < C_KV) { for (int j = 0; j < 4; ++j) v[j] *= 0.125f; }
        else if (c < C_GN) {}
        else if (c < C_QD) { for (int j = 0; j < 4; ++j) v[j] = sigmoidf(v[j]); }
        else if (c < C_QI) {}
        else if (c < C_KI) { for (int j = 0; j < 4; ++j) v[j] *= 0.125f; }
        else if (c < C_WI) {}
        else if (c < C_GM) {
          for (int j = 0; j < 4; ++j) v[j] *= 0.35355339059327373f;
          *(float4*)(widx + (long)r * 8 + (c - C_WI)) = make_float4(v[0], v[1], v[2], v[3]);
        } else { for (int j = 0; j < 4; ++j) v[j] = sigmoidf(v[j]); }
        *(uint2*)(proj + (long)r * LDP + c) = pack4(v[0], v[1], v[2], v[3]);
      }
    }
  }
};
struct EpiProjVT {
  u16* vt; int m0;
  DI void operator()(f32x16 (&acc)[2][2], int wm, int wn, int lane) const {
#pragma unroll
    for (int mt = 0; mt < 2; ++mt)
#pragma unroll
      for (int nt = 0; nt < 2; ++nt) {
        const int cc = EPI_C;
#pragma unroll
        for (int q4 = 0; q4 < 4; ++q4) {
          const int r = m0 + wm * 64 + mt * 32 + 8 * q4 + 4 * (lane >> 5);
          const int b = r >> 13, t = r & 8191;
          uint2 w;
          w.x = pack2(acc[mt][nt][q4 * 4 + 0], acc[mt][nt][q4 * 4 + 1]);
          w.y = pack2(acc[mt][nt][q4 * 4 + 2], acc[mt][nt][q4 * 4 + 3]);
          *(uint2*)(vt + ((long)(b * 128 + cc)) * T + t) = w;
        }
      }
  }
};
DI int proj_group(int q) { return q < 7 ? q : (q < 8 ? q + 1 : q + 2); }
DI void proj_store4(u16* proj, float* widx, long r, int c, float v0, float v1, float v2, float v3) {
  if (c < LDP) {
    float v[4] = {v0, v1, v2, v3};
    if (c < C_KV) { for (int j = 0; j < 4; ++j) v[j] *= 0.125f; }
    else if (c < C_GN) {}
    else if (c < C_QD) { for (int j = 0; j < 4; ++j) v[j] = sigmoidf(v[j]); }
    else if (c < C_QI) {}
    else if (c < C_KI) { for (int j = 0; j < 4; ++j) v[j] *= 0.125f; }
    else if (c < C_WI) {}
    else if (c < C_GM) {
      for (int j = 0; j < 4; ++j) v[j] *= 0.35355339059327373f;
      *(float4*)(widx + r * 8 + (c - C_WI)) = make_float4(v[0], v[1], v[2], v[3]);
    } else { for (int j = 0; j < 4; ++j) v[j] = sigmoidf(v[j]); }
    *(uint2*)(proj + r * LDP + c) = pack4(v[0], v[1], v[2], v[3]);
  }
}
struct WRows2 { const u16* base; int ra, rb; DI const u16* origin() const { return base; } DI int off(int r) const { return ((r < 128 ? ra : rb) + (r & 127)) * 1024; } };
struct Epi8Proj {
  u16* proj; float* widx; int m0, n0a, n0b;
  DI void operator()(int q, int c, float v0, float v1, float v2, float v3) const {
    proj_store4(proj, widx, m0 + q, (c < 128 ? n0a : n0b) + (c & 127), v0, v1, v2, v3);
  }
};
struct Epi8ProjVT {
  u16* vts; u16* vtw; int m0;
  DI void operator()(int q, int c, float v0, float v1, float v2, float v3) const {
    const int r = m0 + c, b = r >> 13, t = r & 8191;
    u16* vt = q < 128 ? vts : vtw;
    *(uint2*)(vt + ((long)(b * 128 + (q & 127))) * T + t) = pack4(v0, v1, v2, v3);
  }
};
DI void phase2_8w(const Params& p, int wg, int nwg) {
  for (int i = wg; i < 1280; i += nwg) {
    const int x_ = i & 7, s_ = (i >> 3) & 31, blk = (i >> 8) * 8 + x_;
    if (blk >= 36) continue;
    const int nb = blk % 9, mb = blk / 9;
    const int mt_ = mb * 16 + (s_ >> 1), v = 2 * nb + (s_ & 1);
    ARows tf{p.h + (long)mt_ * 256 * 1024, 1024, 256};
    if (v < 17) {
      const int ga = proj_group(2 * v), gb = proj_group(2 * v + 1);
      WRows2 wf{p.w_inT, ga * 128, gb * 128};
      Epi8Proj ef{p.proj, p.widx, mt_ * 256, ga * 128, gb * 128};
      gemm8p(16, wf, tf, ef);
    } else {
      WRows2 wf{p.w_inT, 7 * 128, 9 * 128};
      Epi8ProjVT ef{p.vts, p.vtw, mt_ * 256};
      gemm8p(16, tf, wf, ef);
    }
  }
}
DI void phase2(const Params& p, char* smem, int bid, int nblk) {}

struct ACmp {
  const u16* proj; int slot, m0;
  DI const u16* operator()(int r) const {
    const int R = m0 + r, bg = R >> 9, n = R & 511, b = bg >> 1, g = bg & 1;
    const int nc = n >= 511 ? 510 : n;
    return proj + ((long)b * T + 16 * nc) * LDP + C_KV + slot * 128 + g * 64;
  }
};
struct EpiCmp1 {
  u16* zc; const float* b1; const float* pe_part; int slot, m0;
  DI void operator()(f32x16 (&acc)[2][2], int wm, int wn, int lane) const {
    constexpr int MT = 2;
#pragma unroll
    for (int nt = 0; nt < 2; ++nt)
#pragma unroll
      for (int q4 = 0; q4 < 4; ++q4) {
        const int c = SW_C0;
        float4 bias = *(const float4*)(b1 + slot * 128 + c);
        for (int q = 0; q < 16; ++q) {
          const float4 t = *(const float4*)(pe_part + q * 256 + slot * 128 + c);
          bias.x += t.x; bias.y += t.y; bias.z += t.z; bias.w += t.w;
        }
#pragma unroll
        for (int mt = 0; mt < 2; ++mt) {
          const int R = m0 + SW_R;
          *(uint2*)(zc + ((long)slot * 2048 + R) * 128 + c) =
              pack4(gelu_tanh(SW_V(0) + bias.x), gelu_tanh(SW_V(1) + bias.y), gelu_tanh(SW_V(2) + bias.z), gelu_tanh(SW_V(3) + bias.w));
        }
      }
  }
};
struct EpiQlat {
  u16* qlat; int h, m0;
  DI void operator()(f32x16 (&acc)[2][2], int wm, int wn, int lane) const {
    constexpr int MT = 2;
    SW_FOR {
      const int r = m0 + SW_R, c = SW_C0;
      *(uint2*)(qlat + ((long)r * 8 + h) * 128 + c) = pack4(SW_V(0) * 0.125f, SW_V(1) * 0.125f, SW_V(2) * 0.125f, SW_V(3) * 0.125f);
    }
  }
};
DI void indexer_item(const Params& p, char* smem, int item);
DI void phase3(const Params& p, char* smem, int bid, int nblk) {
  const int tid = TIDX(), lane = tid & 63, wid = __builtin_amdgcn_readfirstlane(tid >> 6);
  if (bid < 32) {
    const int slot = bid >> 4, mt_ = bid & 15;
    ACmp af{p.proj, slot, mt_ * 128};
    BMat bf{p.cmp_w1 + (long)slot * 2048 * 128, 128, 128};
    EpiCmp1 ef{p.zc, p.cmp_b1, p.pe_part, slot, mt_ * 128};
    gemm_tile(smem, 32, LDP, af, bf, ef);
    return;
  }
  for (int item = bid - 32; item < 4160 + 1024 + 512; item += nblk - 32) {
    hb_sync();
    if (item < 4160) {
      indexer_item(p, smem, item);
    } else if (item < 4160 + 1024) {
      const int it = item - 4160, h = it & 7, mt_ = it >> 3;
      ARows af{p.proj + (long)mt_ * 128 * LDP + C_QD + h * 64, LDP, 128};
      BMat bf{p.w_ukT + h * 64 * 128, 128, 128};
      EpiQlat ef{p.qlat, h, mt_ * 128};
      gemm_tile<true, true>(smem, 1, 64, af, bf, ef);
    } else {
      const int it = item - 4160 - 1024;
      for (int q = 0; q < 8; ++q) {
        const int row = it * 32 + wid * 8 + q;
        const unsigned u = *(const unsigned*)(p.proj + (long)row * LDP + C_CKV + lane * 2);
        const float a = lo16(u), b = hi16(u);
        const float ss = wave_sum(a * a + b * b);
        const float r = rsqrtf(ss * (1.f / 128.f) + 1e-6f);
        *(unsigned*)(p.ckv + (long)row * 128 + lane * 2) = pack2(a * r * p.dsa_kv_norm[lane * 2], b * r * p.dsa_kv_norm[lane * 2 + 1]);
      }
    }
  }
}

struct EpiCmp2 {
  u16* dst; int m0;
  DI void operator()(f32x16 (&acc)[2][2], int wm, int wn, int lane) const {
    constexpr int MT = 2;
    SW_FOR {
      const int R = m0 + SW_R, c = SW_C0;
      if (c < 64) *(uint2*)(dst + (long)R * 64 + c) = pack4(SW_V(0), SW_V(1), SW_V(2), SW_V(3));
    }
  }
};
struct EpiCmp2T {
  u16* dst; int m0;
  DI void operator()(f32x16 (&acc)[2][2], int wm, int wn, int lane) const {
#pragma unroll
    for (int mt = 0; mt < 2; ++mt)
#pragma unroll
      for (int nt = 0; nt < 2; ++nt) {
        const int c = EPI_C;
        if (c < 64) {
#pragma unroll
          for (int q4 = 0; q4 < 4; ++q4) {
            const int R = m0 + wm * 64 + mt * 32 + 8 * q4 + 4 * (lane >> 5);
            const int bg = R >> 9, n = R & 511;
            *(uint2*)(dst + ((long)(bg * 64 + c)) * 512 + n) =
                pack4(acc[mt][nt][q4 * 4 + 0], acc[mt][nt][q4 * 4 + 1], acc[mt][nt][q4 * 4 + 2], acc[mt][nt][q4 * 4 + 3]);
          }
        }
      }
  }
};
DI void indexer_item(const Params& p, char* smem, int item) {
  const int tid = TIDX(), lane = tid & 63, wid = __builtin_amdgcn_readfirstlane(tid >> 6);
  int b = 0, rem = item;
  if (rem >= 2080) { b = 1; rem -= 2080; }
  int qt = (int)((sqrtf(8.f * rem + 1.f) - 1.f) * 0.5f);
  while ((qt + 1) * (qt + 2) / 2 <= rem) ++qt;
  while (qt * (qt + 1) / 2 > rem) --qt;
  const int kt = rem - qt * (qt + 1) / 2;
  const int t0 = qt * 128 + (wid >> 1) * 64, s0 = kt * 128 + (wid & 1) * 64;
  if (s0 > t0 + 63) return;
  float* wl = (float*)smem + wid * 512;
  const float* wsrc = p.widx + ((long)b * T + t0) * 8;
#pragma unroll
  for (int i = 0; i < 8; ++i) wl[i * 64 + lane] = wsrc[i * 64 + lane];
  wave_sync();
  const u16* projb = p.proj + (long)b * T * LDP;
  const int r31 = lane & 31, hf = lane >> 5;
  u16* Kt = (u16*)(smem + 8192) + wid * (64 * 72);
  {
    const int piece = lane & 7, rb = lane >> 3;
#pragma unroll
    for (int i = 0; i < 8; ++i) {
      const uint4 v = *(const uint4*)(projb + (long)(s0 + rb + 8 * i) * LDP + C_KI + piece * 8);
      *(uint4*)(Kt + (rb + 8 * i) * 72 + piece * 8) = v;
    }
  }
  wave_sync();
  const u16* kfrag = Kt + r31 * 72 + hf * 8;
  f32x16 sum[2][2];
#pragma unroll
  for (int a = 0; a < 2; ++a)
#pragma unroll
    for (int c = 0; c < 2; ++c)
#pragma unroll
      for (int i = 0; i < 16; ++i) sum[a][c][i] = 0.f;
  const u16* qbase = projb + (long)(t0 + r31) * LDP + C_QI + hf * 8;
  bf16x8 af0[4], af1[4], af2[4], af3[4];
#define IDX_LOADQ(DST, STEP)                                                                            \
  {                                                                                                     \
    const int st_ = (STEP) < 15 ? (STEP) : 15;                                                          \
    _Pragma("unroll") for (int ks = 0; ks < 4; ++ks) DST[ks] = *(const bf16x8*)(qbase + (long)(st_ & 1) * 32 * LDP + (st_ >> 1) * 64 + ks * 16); \
  }
#define IDX_STEP(SRC, MT, H)                                                                            \
  {                                                                                                     \
    const float w_ = wl[((MT) * 32 + r31) * 8 + (H)];                                                   \
    _Pragma("unroll") for (int nt = 0; nt < 2; ++nt) {                                                  \
      f32x16 acc;                                                                                       \
      _Pragma("unroll") for (int i = 0; i < 16; ++i) acc[i] = 0.f;                                      \
      _Pragma("unroll") for (int ks = 0; ks < 4; ++ks) acc = __builtin_amdgcn_mfma_f32_32x32x16_bf16(*(const bf16x8*)(kfrag + nt * 32 * 72 + ks * 16), SRC[ks], acc, 0, 0, 0); \
      _Pragma("unroll") for (int i = 0; i < 16; ++i) sum[MT][nt][i] += w_ * fmaxf(acc[i], 0.f);        \
    }                                                                                                   \
  }
  IDX_LOADQ(af0, 0) IDX_LOADQ(af1, 1) IDX_LOADQ(af2, 2)
#pragma unroll 1
  for (int s4 = 0; s4 < 16; s4 += 4) {
    IDX_LOADQ(af3, s4 + 3)
    asm volatile("" ::: "memory");
    IDX_STEP(af0, 0, s4 >> 1)
    asm volatile("" ::: "memory");
    IDX_LOADQ(af0, s4 + 4)
    asm volatile("" ::: "memory");
    IDX_STEP(af1, 1, s4 >> 1)
    asm volatile("" ::: "memory");
    IDX_LOADQ(af1, s4 + 5)
    asm volatile("" ::: "memory");
    IDX_STEP(af2, 0, (s4 >> 1) + 1)
    asm volatile("" ::: "memory");
    IDX_LOADQ(af2, s4 + 6)
    asm volatile("" ::: "memory");
    IDX_STEP(af3, 1, (s4 >> 1) + 1)
    asm volatile("" ::: "memory");
  }
#undef IDX_LOADQ
#undef IDX_STEP
#pragma unroll
  for (int mt = 0; mt < 2; ++mt)
#pragma unroll
    for (int nt = 0; nt < 2; ++nt)
#pragma unroll
      for (int q4 = 0; q4 < 4; ++q4)
      {
        typedef _Float16 h4_t __attribute__((ext_vector_type(4)));
        typedef float f4_t __attribute__((ext_vector_type(4)));
        const f4_t v4 = {sum[mt][nt][4 * q4], sum[mt][nt][4 * q4 + 1], sum[mt][nt][4 * q4 + 2], sum[mt][nt][4 * q4 + 3]};
        *(h4_t*)((u16*)p.scores + ((long)b * T + t0 + mt * 32 + r31) * T + s0 + nt * 32 + 8 * q4 + 4 * hf) = __builtin_convertvector(v4, h4_t);
      }
}
DI void topk_row(const Params& p, int b, int t, int lane);
DI void phase4(const Params& p, char* smem, int bid, int nblk) {
  if (bid < 32) {
    const int slot = bid >> 4, mt_ = bid & 15;
    ARows af{p.zc + ((long)slot * 2048 + mt_ * 128) * 128, 128, 128};
    BMat bf{p.cmp_w2 + slot * 128 * 64, 64, 64};
    if (slot) { EpiCmp2T ef{p.vcT, mt_ * 128}; gemm_tile<false>(smem, 2, 64, af, bf, ef); }
    else { EpiCmp2 ef{p.kc, mt_ * 128}; gemm_tile(smem, 2, 64, af, bf, ef); }
  }
  const int tid = TIDX(), lane = tid & 63, wid = __builtin_amdgcn_readfirstlane(tid >> 6);
  for (int item = bid; item < 2048; item += nblk) {
    const int it = item < 1024 ? 2047 - item : item - 1024;
    const int b = it & 1, tb = it >> 1;
#pragma unroll 1
    for (int q = 0; q < 2; ++q) {
      asm volatile("" ::: "memory");
      topk_row(p, b, tb * 8 + wid * 2 + q, lane);
    }
  }
}

#define MFMA16(a, b, c) __builtin_amdgcn_mfma_f32_16x16x32_bf16((a), (b), (c), 0, 0, 0)
#define MFMA32(a, b, c) __builtin_amdgcn_mfma_f32_32x32x16_bf16((a), (b), (c), 0, 0, 0)

constexpr int NSA_STAGE_BYTES = 64 * 72 * 2 + 64 * 68 * 2;
DI void dense_scores(f32x16 (&acc)[2], const u16* Ks, const bf16x8 (&qf)[4], int lane) {
  const int r = lane & 31, hf = lane >> 5;
  bf16x8 kf[2][4];
#pragma unroll
  for (int tile = 0; tile < 2; ++tile)
#pragma unroll
    for (int ks = 0; ks < 4; ++ks) kf[tile][ks] = *(const bf16x8*)(Ks + (32 * tile + r) * 72 + 8 * hf + 16 * ks);
  asm volatile("" ::: "memory");
#pragma unroll
  for (int tile = 0; tile < 2; ++tile) {
    f32x16 c;
#pragma unroll
    for (int i = 0; i < 16; ++i) c[i] = 0.f;
#pragma unroll
    for (int ks = 0; ks < 4; ++ks) c = MFMA32(kf[tile][ks], qf[ks], c);
    acc[tile] = c;
  }
}
DI void dense_pv(const f32x16 (&acc)[2], const u16* Vs, int lane, f32x16 (&o)[2]) {
  const int r = lane & 31, hf = lane >> 5;
  uint2 vlo[2][2][2], vhi[2][2][2];
#pragma unroll
  for (int tile = 0; tile < 2; ++tile)
#pragma unroll
    for (int s = 0; s < 2; ++s)
#pragma unroll
      for (int dt = 0; dt < 2; ++dt) {
        const u16* vp = Vs + (32 * dt + r) * 68 + 32 * tile + 16 * s + 4 * hf;
        vlo[tile][s][dt] = *(const uint2*)vp;
        vhi[tile][s][dt] = *(const uint2*)(vp + 8);
      }
  asm volatile("" ::: "memory");
#pragma unroll
  for (int tile = 0; tile < 2; ++tile)
#pragma unroll
    for (int s = 0; s < 2; ++s) {
      uint4 w;
      w.x = pack2(acc[tile][8 * s + 0], acc[tile][8 * s + 1]);
      w.y = pack2(acc[tile][8 * s + 2], acc[tile][8 * s + 3]);
      w.z = pack2(acc[tile][8 * s + 4], acc[tile][8 * s + 5]);
      w.w = pack2(acc[tile][8 * s + 6], acc[tile][8 * s + 7]);
      const bf16x8 pb = __builtin_bit_cast(bf16x8, w);
#pragma unroll
      for (int dt = 0; dt < 2; ++dt) {
        uint4 a;
        a.x = vlo[tile][s][dt].x; a.y = vlo[tile][s][dt].y; a.z = vhi[tile][s][dt].x; a.w = vhi[tile][s][dt].y;
        o[dt] = MFMA32(__builtin_bit_cast(bf16x8, a), pb, o[dt]);
      }
    }
}
constexpr float LOG2E = 1.4426950408889634f;
template <int DSTEP>
DI float dense_mask(f32x16 (&acc)[2], bool active, int lo_c, int hi_c, int dist0_c, int dmin_u, const float* btab_h, int lane) {
  const int hf = lane >> 5;
  const bool colfull = !active || (lo_c <= 0 && hi_c >= 63);
  float mx = -INFINITY;
  if (dmin_u >= 128 && __ballot(colfull) == ~0ull) {
    const float be = active ? btab_h[128] : -INFINITY;
#pragma unroll
    for (int tile = 0; tile < 2; ++tile)
#pragma unroll
      for (int i = 0; i < 16; ++i) {
        const float sv = fmaf(acc[tile][i], LOG2E, be);
        acc[tile][i] = sv;
        mx = fmaxf(mx, sv);
      }
  } else {
    const int lo2 = active ? lo_c : 1, hi2 = active ? hi_c : 0;
#pragma unroll
    for (int tile = 0; tile < 2; ++tile)
#pragma unroll
      for (int i = 0; i < 16; ++i) {
        const int kl = 32 * tile + (i & 3) + 8 * (i >> 2) + 4 * hf;
        int dc = dist0_c - DSTEP * kl;
        dc = dc < 0 ? 0 : (dc > 128 ? 128 : dc);
        const float bias = btab_h[dc];
        const float s2 = fmaf(acc[tile][i], LOG2E, bias);
        const float sv = (kl >= lo2 && kl <= hi2) ? s2 : -INFINITY;
        acc[tile][i] = sv;
        mx = fmaxf(mx, sv);
      }
  }
  return fmaxf(mx, __shfl_xor(mx, 32));
}
DI void dense_chunk(const u16* Ks, const u16* Vs, bool active, int lo_c, int hi_c, int dist0_c, int dmin_u, const bf16x8 (&qf)[4],
                    const float* btab_h, int lane, float& m, float& l, f32x16 (&o)[2]) {
  f32x16 acc[2];
  dense_scores(acc, Ks, qf, lane);
  const float mx = dense_mask<1>(acc, active, lo_c, hi_c, dist0_c, dmin_u, btab_h, lane);
  const float mn = fmaxf(m, mx);
  const float alpha = __builtin_amdgcn_exp2f(m - mn);
  float ls = 0.f;
#pragma unroll
  for (int tile = 0; tile < 2; ++tile)
#pragma unroll
    for (int i = 0; i < 16; ++i) {
      const float pv = __builtin_amdgcn_exp2f(acc[tile][i] - mn);
      acc[tile][i] = pv;
      ls += pv;
    }
  ls += __shfl_xor(ls, 32);
  l = l * alpha + ls;
  m = mn;
  o[0] *= alpha;
  o[1] *= alpha;
  dense_pv(acc, Vs, lane, o);
}

template <int KSG, int VSG, bool NEEDV, class Next, class Body>
DI void chunk_pipeline(char* stage, const u16* kg0, const u16* vg0, int first, int tid, const Next& next, const Body& body) {
  const int srow = tid >> 3, spiece = tid & 7;
  uint4 rk0, rv0;
  rv0 = make_uint4(0, 0, 0, 0);
  int d = first;
#define NSA_GLOAD(D)                                                                      \
  {                                                                                       \
    rk0 = *(const uint4*)(kg0 + ((long)(D) * 64 + srow) * KSG + spiece * 8);              \
    if (NEEDV) rv0 = *(const uint4*)(vg0 + (long)srow * VSG + (D) * 64 + spiece * 8);     \
  }
  if (d >= 0) NSA_GLOAD(d)
  int ph = 0;
  __syncthreads();
  while (d >= 0) {
    u16* Ks = (u16*)(stage + ph * NSA_STAGE_BYTES);
    u16* Vs = Ks + 64 * 72;
    *(uint4*)(Ks + srow * 72 + spiece * 8) = rk0;
    if (NEEDV) {
      uint2* dv = (uint2*)(Vs + srow * 68 + spiece * 8);
      dv[0] = make_uint2(rv0.x, rv0.y); dv[1] = make_uint2(rv0.z, rv0.w);
    }
    const int dn = next(d);
    if (dn >= 0) NSA_GLOAD(dn)
    __syncthreads();
    body(d, Ks, Vs);
    ph ^= 1;
    d = dn;
  }
#undef NSA_GLOAD
}

DI void nsa_item(const Params& p, char* smem, int item) {
  const int tid = TIDX8(), lane = tid & 63, wid = __builtin_amdgcn_readfirstlane(tid >> 6);
  const int chunk = item & 127, g = (item >> 7) & 1, b = item >> 8;
  const int bg = b * 2 + g;
  float* btab = (float*)smem;
  u64* wun = (u64*)(smem + 2304);
  float* imps = (float*)(smem + 4096) + wid * 1056;
  char* stage = smem + 37888;
  for (int idx = tid; idx < 4 * 129; idx += 512) {
    const int h = idx / 129, d = idx % 129;
    const int bk = d < 128 ? BUCKET[d] : 31;
    btab[h * 132 + d] = p.rel_bias[bk * 16 + g * 4 + h] * LOG2E;
  }
  __syncthreads();
  const int t0 = chunk * 64;
  const int tw = t0 + wid * 8;
  const int c = lane & 31, hf = lane >> 5, qi = c >> 2, hh = c & 3;
  const int t_c = tw + qi;
  const int cur = t0 >> 6;
  const long row = (long)b * T + t_c;
  const u16* prow = p.proj + row * LDP;
  const u16* projb = p.proj + (long)b * T * LDP;
  const float* btab_h = btab + hh * 132;
  bf16x8 qf[4];
#pragma unroll
  for (int ks = 0; ks < 4; ++ks) qf[ks] = *(const bf16x8*)(prow + C_QN + (g * 4 + hh) * 64 + ks * 16 + hf * 8);
  const u16* gptr = prow + C_GN + (g * 4 + hh) * 3;
  for (int k = lane; k < 1056; k += 64) imps[k] = 0.f;
  u16* orow = p.onsa + row * 512 + (g * 4 + hh) * 64 + 4 * hf;
  auto emit = [&](const f32x16 (&o)[2], float sc, bool first) {
#pragma unroll
    for (int dt = 0; dt < 2; ++dt)
#pragma unroll
      for (int q4 = 0; q4 < 4; ++q4) {
        uint2* dst = (uint2*)(orow + 32 * dt + 8 * q4);
        float v0 = o[dt][4 * q4 + 0] * sc, v1 = o[dt][4 * q4 + 1] * sc, v2 = o[dt][4 * q4 + 2] * sc, v3 = o[dt][4 * q4 + 3] * sc;
        if (!first) {
          const uint2 u = *dst;
          v0 += lo16(u.x); v1 += hi16(u.x); v2 += lo16(u.y); v3 += hi16(u.y);
        }
        uint2 w;
        w.x = pack2(v0, v1);
        w.y = pack2(v2, v3);
        *dst = w;
      }
  };
  const int ncv_c = (t_c >= 31) ? ((t_c - 31) >> 4) + 1 : 0;
  const int ncv_max = ((t0 + 63 - 31) >> 4) + 1;
  const int nchunk_c = (ncv_max + 63) >> 6;
  {
    const u16* kcb = p.kc + (long)bg * 512 * 64;
    const u16* vcb = p.vcT + (long)bg * 64 * 512;
    float m = -1e30f, l = 0.f;
    auto next_c = [&](int d) { return d + 1 < nchunk_c ? d + 1 : -1; };
    chunk_pipeline<64, 512, false>(stage, kcb, vcb, 0, tid, next_c, [&](int i, const u16* Ks, const u16* Vs) {
      f32x16 acc[2];
      dense_scores(acc, Ks, qf, lane);
      const float mx = dense_mask<16>(acc, true, 0, ncv_c - 1 - i * 64, t_c - 31 - 1024 * i, tw - 31 - 1024 * i - 1008, btab_h, lane);
      const float mn = fmaxf(m, mx);
      float ls = 0.f;
#pragma unroll
      for (int tile = 0; tile < 2; ++tile)
#pragma unroll
        for (int q = 0; q < 16; ++q) ls += __builtin_amdgcn_exp2f(acc[tile][q] - mn);
      ls += __shfl_xor(ls, 32);
      l = l * __builtin_amdgcn_exp2f(m - mn) + ls;
      m = mn;
    });
    const float invl = 1.f / fmaxf(l, 1e-30f);
    f32x16 oc[2];
#pragma unroll
    for (int i = 0; i < 16; ++i) { oc[0][i] = 0.f; oc[1][i] = 0.f; }
    chunk_pipeline<64, 512, true>(stage, kcb, vcb, 0, tid, next_c, [&](int i, const u16* Ks, const u16* Vs) {
      f32x16 acc[2];
      dense_scores(acc, Ks, qf, lane);
      (void)dense_mask<16>(acc, true, 0, ncv_c - 1 - i * 64, t_c - 31 - 1024 * i, tw - 31 - 1024 * i - 1008, btab_h, lane);
      float part[2][4], spill[2][4];
#pragma unroll
      for (int tile = 0; tile < 2; ++tile) {
#pragma unroll
        for (int q = 0; q < 16; ++q) acc[tile][q] = __builtin_amdgcn_exp2f(acc[tile][q] - m) * invl;
#pragma unroll
        for (int q4 = 0; q4 < 4; ++q4) {
          float pa = acc[tile][4 * q4] + acc[tile][4 * q4 + 1] + acc[tile][4 * q4 + 2] + 0.5f * acc[tile][4 * q4 + 3];
          float sp = 0.5f * acc[tile][4 * q4 + 3];
          pa += __shfl_xor(pa, 1); pa += __shfl_xor(pa, 2);
          sp += __shfl_xor(sp, 1); sp += __shfl_xor(sp, 2);
          part[tile][q4] = pa; spill[tile][q4] = sp;
        }
      }
      if (hh == 0) {
#pragma unroll
        for (int tile = 0; tile < 2; ++tile)
#pragma unroll
          for (int q4 = 0; q4 < 4; ++q4) imps[qi * 132 + 16 * i + 8 * tile + 2 * q4 + hf] += part[tile][q4];
      }
      wave_sync();
      if (hh == 0) {
#pragma unroll
        for (int tile = 0; tile < 2; ++tile)
#pragma unroll
          for (int q4 = 0; q4 < 4; ++q4) imps[qi * 132 + 16 * i + 8 * tile + 2 * q4 + hf + 1] += spill[tile][q4];
      }
      wave_sync();
      dense_pv(acc, Vs, lane, oc);
    });
    emit(oc, bf2f(gptr[0]), true);
  }
  wave_sync();
  u64 my0 = 0, my1 = 0, wu0 = 0, wu1 = 0;
  for (int q = 0; q < 8; ++q) {
    u64 mask0, mask1;
    if (cur <= 15) {
      mask0 = (2ull << cur) - 1ull;
      mask1 = 0ull;
    } else {
      const float imp_lo = imps[q * 132 + lane], imp_hi = imps[q * 132 + lane + 64];
      const int jl = lane, jh = lane + 64;
      float c0 = (jl >= 1 && jl <= cur - 2) ? imp_lo : -1.f;
      float c1 = (jh <= cur - 2) ? imp_hi : -1.f;
      bool sel_lo = (jl == 0) || (jl == cur) || (jl == cur - 1);
      bool sel_hi = (jh == cur) || (jh == cur - 1);
      for (int r = 0; r < 13; ++r) {
        float bv; int bj;
        if (c0 >= c1) { bv = c0; bj = jl; } else { bv = c1; bj = jh; }
        wave_argmax(bv, bj);
        if (bj == jl) { sel_lo = true; c0 = -1.f; }
        if (bj == jh) { sel_hi = true; c1 = -1.f; }
      }
      mask0 = __ballot(sel_lo);
      mask1 = __ballot(sel_hi);
    }
    if (qi == q) { my0 = mask0; my1 = mask1; }
    wu0 |= mask0; wu1 |= mask1;
  }
  if (lane == 0) { wun[wid * 2] = wu0; wun[wid * 2 + 1] = wu1; }
  __syncthreads();
  u64 bu0 = wun[0] | wun[2] | wun[4] | wun[6] | wun[8] | wun[10] | wun[12] | wun[14];
  u64 bu1 = wun[1] | wun[3] | wun[5] | wun[7] | wun[9] | wun[11] | wun[13] | wun[15];
  bu0 = ((u64)(unsigned)__builtin_amdgcn_readfirstlane((int)(bu0 >> 32)) << 32) | (unsigned)__builtin_amdgcn_readfirstlane((int)bu0);
  bu1 = ((u64)(unsigned)__builtin_amdgcn_readfirstlane((int)(bu1 >> 32)) << 32) | (unsigned)__builtin_amdgcn_readfirstlane((int)bu1);
  {
    float m = -1e30f, l = 0.f;
    f32x16 o[2];
#pragma unroll
    for (int i = 0; i < 16; ++i) { o[0][i] = 0.f; o[1][i] = 0.f; }
    const int kcol = C_KV + 2 * 128 + g * 64;
    auto next_s = [&](int j) {
      ++j;
      if (j < 64) {
        const u64 mm = bu0 & (~0ull << j);
        if (mm) return (int)__builtin_ctzll(mm);
        j = 64;
      }
      if (j >= 128) return -1;
      const u64 mm = bu1 & (~0ull << (j - 64));
      return mm ? 64 + (int)__builtin_ctzll(mm) : -1;
    };
    chunk_pipeline<LDP, T, true>(stage, projb + kcol, p.vts + (long)bg * 64 * T, 0, tid, next_s, [&](int j, const u16* Ks, const u16* Vs) {
      const bool bit = ((j < 64 ? (my0 >> j) : (my1 >> (j - 64))) & 1ull) != 0;
      if (__ballot(bit) != 0ull) {
        const int pos0 = 64 * j;
        dense_chunk(Ks, Vs, bit, 0, t_c - pos0, t_c - pos0, tw - pos0 - 63, qf, btab_h, lane, m, l, o);
      }
    });
    emit(o, bf2f(gptr[1]) / fmaxf(l, 1e-30f), false);
  }
  {
    float m = -1e30f, l = 0.f;
    f32x16 o[2];
#pragma unroll
    for (int i = 0; i < 16; ++i) { o[0][i] = 0.f; o[1][i] = 0.f; }
    const int kcol = C_KV + 4 * 128 + g * 64;
    const int wlo_c = t_c - 511 < 0 ? 0 : t_c - 511;
    const int wlo_min = t0 - 511 < 0 ? 0 : t0 - 511;
    auto next_w = [&](int j) { return j + 1 <= cur ? j + 1 : -1; };
    chunk_pipeline<LDP, T, true>(stage, projb + kcol, p.vtw + (long)bg * 64 * T, wlo_min >> 6, tid, next_w, [&](int jw, const u16* Ks, const u16* Vs) {
      const int pos0 = 64 * jw;
      const int lo_c = wlo_c - pos0 < 0 ? 0 : wlo_c - pos0;
      dense_chunk(Ks, Vs, true, lo_c, t_c - pos0, t_c - pos0, tw - pos0 - 63, qf, btab_h, lane, m, l, o);
    });
    emit(o, bf2f(gptr[2]) / fmaxf(l, 1e-30f), false);
  }
}

DI unsigned f2ord(float v) { const unsigned u = __float_as_uint(v); return (u & 0x80000000u) ? ~u : (u | 0x80000000u); }

DI void topk_row(const Params& p, int b, int t, int lane) {
  const long row = (long)b * T + t;
  int* dst = p.selk + row * 256;
  if (t < 256) {
#pragma unroll
    for (int i = 0; i < 4; ++i) { const int s = i * 64 + lane; dst[s] = (s <= t) ? s : -1; }
    return;
  }
  const u16* srow = (const u16*)p.scores + row * T;
  const int ngrp = (t >> 10) + 1;
  unsigned u[128];
  int ln = lane;
  asm volatile("" : "+v"(ln));
#pragma unroll
  for (int gq = 0; gq < 8; ++gq) {
    if (gq < ngrp) {
#pragma unroll
      for (int j = 0; j < 16; ++j) {
        const int s = (gq * 16 + j) * 64 + ln;
        u[gq * 16 + j] = srow[s < t ? s : t];
      }
    } else {
#pragma unroll
      for (int j = 0; j < 16; ++j) u[gq * 16 + j] = 0u;
    }
  }
  asm volatile("" ::: "memory");
#pragma unroll
  for (int gq = 0; gq < 8; ++gq) {
    if (gq < ngrp) {
#pragma unroll
      for (int j = 0; j < 16; ++j) {
        const int s = (gq * 16 + j) * 64 + ln;
        { const unsigned h_ = u[gq * 16 + j]; u[gq * 16 + j] = (s <= t) ? ((h_ & 0x8000u) ? (~h_ & 0xFFFFu) : (h_ | 0x8000u)) : 0u; }
      }
    }
  }
  const int nlane = 16 * ngrp;
  unsigned m0 = 0u, m1 = 0u, m2 = 0u, m3 = 0u;
#pragma unroll
  for (int gq = 0; gq < 8; ++gq) {
    if (gq < ngrp) {
#pragma unroll
      for (int j = 0; j < 16; j += 4) {
        m0 = max(m0, u[gq * 16 + j]); m1 = max(m1, u[gq * 16 + j + 1]); m2 = max(m2, u[gq * 16 + j + 2]); m3 = max(m3, u[gq * 16 + j + 3]);
      }
    }
  }
  unsigned lo = wave_min_u(min(min(m0, m1), min(m2, m3)));
  unsigned hi = wave_max_u(max(max(m0, m1), max(m2, m3))) + 1u;
#define TOPK_COUNT_GE(PIV, OUT)                                                         \
  {                                                                                     \
    unsigned below_ = 0;     \
    _Pragma("unroll") for (int gq = 0; gq < 8; ++gq) {                                  \
      if (gq < ngrp) {                                                                  \
        _Pragma("unroll") for (int j = 0; j < 16; ++j) below_ += (u[gq * 16 + j] - (PIV)) >> 31; \
      }                                                                                 \
    }                                                                                   \
    OUT = wave_sum_i(nlane - (int)below_);                                              \
  }
  int c_lo, c_hi = 0;
  TOPK_COUNT_GE(lo, c_lo)
  int iter = 0;
  while (c_lo != 256 && hi - lo > 1u) {
    const unsigned span = hi - lo;
    unsigned step;
    if ((++iter & 3) == 0) step = span >> 1;
    else step = (unsigned)((float)span * ((float)(c_lo - 256) / (float)(c_lo - c_hi)));
    step = step < 1u ? 1u : (step > span - 1u ? span - 1u : step);
    const unsigned piv = lo + step;
    int c;
    TOPK_COUNT_GE(piv, c)
    if (c >= 256) { lo = piv; c_lo = c; } else { hi = piv; c_hi = c; }
  }
#undef TOPK_COUNT_GE
  const unsigned thr = lo;
  int ngt = 0;
#pragma unroll
  for (int gq = 0; gq < 8; ++gq) {
    if (gq < ngrp) {
#pragma unroll
      for (int j = 0; j < 16; ++j) ngt += __popcll(__ballot(u[gq * 16 + j] > thr));
    }
  }
  int base_gt = 0, base_eq = 0;
  const int need_eq = 256 - ngt;
  int ln2 = lane;
  asm volatile("" : "+v"(ln2));
#pragma unroll
  for (int gq = 0; gq < 8; ++gq) {
    if (gq < ngrp) {
#pragma unroll
      for (int j = 0; j < 16; ++j) {
        const int s = (gq * 16 + j) * 64 + ln2;
        const unsigned uv = u[gq * 16 + j];
        const bool gt = uv > thr, eq = uv == thr;
        const u64 mg = __ballot(gt), me = __ballot(eq);
        const int pg = __builtin_amdgcn_mbcnt_hi((unsigned)(mg >> 32), __builtin_amdgcn_mbcnt_lo((unsigned)mg, 0));
        const int pe = __builtin_amdgcn_mbcnt_hi((unsigned)(me >> 32), __builtin_amdgcn_mbcnt_lo((unsigned)me, 0));
        if (gt) dst[base_gt + pg] = s;
        if (eq && (base_eq + pe) < need_eq) dst[ngt + base_eq + pe] = s;
        base_gt += __popcll(mg);
        base_eq += __popcll(me);
      }
    }
  }
}

DI void phase6(const Params& p, char* smem, int bid, int nblk);
DI void phase5_nsa8(const Params& p) {
  for (int item = blockIdx.x; item < 512; item += gridDim.x) {
    __syncthreads();
    const int it = item < 256 ? 511 - item : item - 256;
    const int chunk = it >> 2, bgi = it & 3;
    nsa_item(p, g_smem, (bgi << 7) | chunk);
  }
  __syncthreads();
}
DI void phase5(const Params& p, char* smem, int bid, int nblk) {
  hb_sync();
  phase6(p, smem, bid, nblk);
}

DI void tr_read2(unsigned a0, unsigned a1, uint2& r0, uint2& r1) {
  asm volatile("ds_read_b64_tr_b16 %0, %2\n\tds_read_b64_tr_b16 %1, %3\n\ts_waitcnt lgkmcnt(0)" : "=&v"(r0), "=&v"(r1) : "v"(a0), "v"(a1) : "memory");
}
DI void tr_read4(unsigned a0, unsigned a1, unsigned a2, unsigned a3, uint2& r0, uint2& r1, uint2& r2, uint2& r3) {
  asm volatile("ds_read_b64_tr_b16 %0, %4\n\tds_read_b64_tr_b16 %1, %5\n\tds_read_b64_tr_b16 %2, %6\n\tds_read_b64_tr_b16 %3, %7\n\ts_waitcnt lgkmcnt(0)"
               : "=&v"(r0), "=&v"(r1), "=&v"(r2), "=&v"(r3) : "v"(a0), "v"(a1), "v"(a2), "v"(a3) : "memory");
}
DI void dsa_query(const Params& p, u16* Cs, const float* btab, int b, int t, int lane) {
  const long row = (long)b * T + t;
  const int lg = lane >> 4, r16 = lane & 15, hh = lane & 7;
  bf16x8 qf[4];
#pragma unroll
  for (int ks = 0; ks < 4; ++ks) {
    bf16x8 z = {0, 0, 0, 0, 0, 0, 0, 0};
    if (r16 < 8) z = *(const bf16x8*)(p.qlat + (row * 8 + r16) * 128 + ks * 32 + lg * 8);
    qf[ks] = z;
  }
  const u16* ckvb = p.ckv + (long)b * T * 128;
  const int nvalid = (t + 1) < 256 ? (t + 1) : 256;
  float m = -1e30f, l = 0.f;
  f32x4 o[8];
#pragma unroll
  for (int ct = 0; ct < 8; ++ct) o[ct] = (f32x4){0.f, 0.f, 0.f, 0.f};
  const unsigned cs_base = (unsigned)(size_t)Cs;
  const int nch = (nvalid + 31) >> 5;
  uint4 gv0, gv1, gv2, gv3, gv4, gv5, gv6, gv7;
  int kidx_n;
#define DSA_G1(V, I) { const int kr_ = __shfl(kidx_n, 4 * (I) + lg); V = *(const uint4*)(ckvb + (long)kr_ * 128 + r16 * 8); }
#define DSA_GATHER(CH)                                                            \
  {                                                                               \
    const int nv_ = (nvalid - (CH) * 32) > 32 ? 32 : (nvalid - (CH) * 32);        \
    kidx_n = p.selk[row * 256 + (CH) * 32 + (lane & 31)];                         \
    if ((lane & 31) >= nv_ || kidx_n < 0 || kidx_n > t) kidx_n = t;               \
    DSA_G1(gv0, 0) DSA_G1(gv1, 1) DSA_G1(gv2, 2) DSA_G1(gv3, 3) DSA_G1(gv4, 4) DSA_G1(gv5, 5) DSA_G1(gv6, 6) DSA_G1(gv7, 7) \
  }
  DSA_GATHER(0)
  for (int ch = 0; ch < nch; ++ch) {
    const int nval = (nvalid - ch * 32) > 32 ? 32 : (nvalid - ch * 32);
    const int kidx = kidx_n;
    wave_sync();
    {
      u16* d_ = Cs + lg * 144 + r16 * 8;
      *(uint4*)(d_) = gv0;            *(uint4*)(d_ + 4 * 144) = gv1;  *(uint4*)(d_ + 8 * 144) = gv2;  *(uint4*)(d_ + 12 * 144) = gv3;
      *(uint4*)(d_ + 16 * 144) = gv4; *(uint4*)(d_ + 20 * 144) = gv5; *(uint4*)(d_ + 24 * 144) = gv6; *(uint4*)(d_ + 28 * 144) = gv7;
    }
    { const int chn = ch + 1 < nch ? ch + 1 : nch - 1; DSA_GATHER(chn) }
    wave_sync();
    f32x4 acc[2];
#pragma unroll
    for (int rt = 0; rt < 2; ++rt) {
      const u16* kp = Cs + (16 * rt + r16) * 144 + 8 * lg;
      f32x4 c = {0.f, 0.f, 0.f, 0.f};
#pragma unroll
      for (int ks = 0; ks < 4; ++ks) c = MFMA16(*(const bf16x8*)(kp + 32 * ks), qf[ks], c);
      acc[rt] = c;
    }
    float mx = -INFINITY;
#pragma unroll
    for (int rt = 0; rt < 2; ++rt)
#pragma unroll
      for (int r = 0; r < 4; ++r) {
        const int pl = 16 * rt + 4 * lg + r;
        const int kk = __shfl(kidx, pl);
        int dc = t - kk;
        dc = dc < 0 ? 0 : (dc > 128 ? 128 : dc);
        const float sv = (pl < nval) ? fmaf(acc[rt][r], LOG2E, btab[hh * 132 + dc]) : -INFINITY;
        acc[rt][r] = sv;
        mx = fmaxf(mx, sv);
      }
    mx = fmaxf(mx, __shfl_xor(mx, 16));
    mx = fmaxf(mx, __shfl_xor(mx, 32));
    const float mn = fmaxf(m, mx);
    const float alpha = __builtin_amdgcn_exp2f(m - mn);
    float ls = 0.f;
#pragma unroll
    for (int rt = 0; rt < 2; ++rt)
#pragma unroll
      for (int r = 0; r < 4; ++r) {
        const float pv = __builtin_amdgcn_exp2f(acc[rt][r] - mn);
        acc[rt][r] = pv;
        ls += pv;
      }
    ls += __shfl_xor(ls, 16);
    ls += __shfl_xor(ls, 32);
    l = l * alpha + ls;
    m = mn;
    uint4 pw;
    pw.x = pack2(acc[0][0], acc[0][1]);
    pw.y = pack2(acc[0][2], acc[0][3]);
    pw.z = pack2(acc[1][0], acc[1][1]);
    pw.w = pack2(acc[1][2], acc[1][3]);
    const bf16x8 pb = __builtin_bit_cast(bf16x8, pw);
    const unsigned a_lo = cs_base + (unsigned)(((4 * lg + (r16 >> 2)) * 144 + 4 * (r16 & 3)) * 2);
    const unsigned a_hi = a_lo + 16 * 144 * 2;
#pragma unroll
    for (int ct = 0; ct < 8; ct += 2) {
      uint2 lo0, hi0, lo1, hi1;
      tr_read4(a_lo + ct * 32, a_hi + ct * 32, a_lo + ct * 32 + 32, a_hi + ct * 32 + 32, lo0, hi0, lo1, hi1);
      uint4 aw0, aw1;
      aw0.x = lo0.x; aw0.y = lo0.y; aw0.z = hi0.x; aw0.w = hi0.y;
      aw1.x = lo1.x; aw1.y = lo1.y; aw1.z = hi1.x; aw1.w = hi1.y;
      o[ct] = o[ct] * alpha;
      o[ct + 1] = o[ct + 1] * alpha;
      o[ct] = MFMA16(__builtin_bit_cast(bf16x8, aw0), pb, o[ct]);
      o[ct + 1] = MFMA16(__builtin_bit_cast(bf16x8, aw1), pb, o[ct + 1]);
    }
  }
#undef DSA_GATHER
#undef DSA_G1
  const float invl = 1.f / fmaxf(l, 1e-30f);
  if (r16 < 8) {
#pragma unroll
    for (int ct = 0; ct < 8; ++ct)
      *(uint2*)(p.olat + row * 1024 + r16 * 128 + 16 * ct + 4 * lg) = pack4(o[ct][0] * invl, o[ct][1] * invl, o[ct][2] * invl, o[ct][3] * invl);
  }
}
DI void phase6(const Params& p, char* smem, int bid, int nblk) {
  const int tid = TIDX(), lane = tid & 63, wid = __builtin_amdgcn_readfirstlane(tid >> 6);
  float* btab = (float*)smem;
  u16* Cs = (u16*)(smem + 8192) + wid * (32 * 144);
  for (int idx = tid; idx < 8 * 129; idx += 256) {
    const int h = idx / 129, d = idx % 129;
    const int bk = d < 128 ? BUCKET[d] : 31;
    btab[h * 132 + d] = p.rel_bias[bk * 16 + 8 + h] * LOG2E;
  }
  hb_sync();
  for (int item = bid; item < 2048; item += nblk) {
    const int it = item < 1024 ? 2047 - item : item - 1024;
    const int b = it & 1, tb = it >> 1;
    for (int q = 0; q < 2; ++q) dsa_query(p, Cs, btab, b, tb * 8 + wid * 2 + q, lane);
  }
}

struct EpiOdsa {
  u16* odsa; int h, m0;
  DI void operator()(f32x16 (&acc)[2][2], int wm, int wn, int lane) const {
    constexpr int MT = 2;
    SW_FOR {
      const int r = m0 + SW_R, c = SW_C0;
      if (c < 64) *(uint2*)(odsa + (long)r * 512 + h * 64 + c) = pack4(SW_V(0), SW_V(1), SW_V(2), SW_V(3));
    }
  }
};
DI void phase7(const Params& p, char* smem, int bid, int nblk) {
  for (int item = bid; item < 1024; item += nblk) {
    const int h = item & 7, mt_ = item >> 3;
    ARows af{p.olat + (long)mt_ * 128 * 1024 + h * 128, 1024, 128};
    BMat bf{p.dsa_w_uv + h * 64, 512, 64};
    EpiOdsa ef{p.odsa, h, mt_ * 128};
    gemm_tile(smem, 2, 64, af, bf, ef);
  }
}

struct EpiY {
  u16* y; const u16* proj; int m0, n0, second;
  template <int MT> DI void operator()(f32x16 (&acc)[MT][2], int wm, int wn, int lane) const {
    SW_FOR {
      const int r = m0 + SW_R, c = n0 + SW_C0;
      const uint2 gu = *(const uint2*)(proj + (long)r * LDP + C_GM + second * 1024 + c);
      float v0 = lo16(gu.x) * SW_V(0), v1 = hi16(gu.x) * SW_V(1), v2 = lo16(gu.y) * SW_V(2), v3 = hi16(gu.y) * SW_V(3);
      uint2* dst = (uint2*)(y + (long)r * 1024 + c);
      if (second) {
        const uint2 yu = *dst;
        v0 += lo16(yu.x); v1 += hi16(yu.x); v2 += lo16(yu.y); v3 += hi16(yu.y);
      }
      *dst = pack4(v0, v1, v2, v3);
    }
  }
};
struct Epi8Y {
  u16* y; const u16* proj; int m0, n0, second;
  DI void operator()(int q, int c, float v0, float v1, float v2, float v3) const {
    const long r = m0 + q; const int cc = n0 + c;
    const uint2 gu = *(const uint2*)(proj + r * LDP + C_GM + second * 1024 + cc);
    v0 *= lo16(gu.x); v1 *= hi16(gu.x); v2 *= lo16(gu.y); v3 *= hi16(gu.y);
    uint2* dst = (uint2*)(y + r * 1024 + cc);
    if (second) {
      const uint2 yu = *dst;
      v0 += lo16(yu.x); v1 += hi16(yu.x); v2 += lo16(yu.y); v3 += hi16(yu.y);
    }
    *dst = pack4(v0, v1, v2, v3);
  }
};
DI void phase8_8w(const Params& p, int wg, int nwg) {
  for (int item = wg; item < 256; item += nwg) {
    const int x_ = item & 7, s_ = item >> 3, nt_ = s_ & 3, mt_ = x_ * 8 + (s_ >> 2);
    {
      ARows wf{p.w_bnT + (long)nt_ * 256 * 512, 512, 256};
      ARows xf{p.onsa + (long)mt_ * 256 * 512, 512, 256};
      Epi8Y ef{p.y, p.proj, mt_ * 256, nt_ * 256, 0};
      gemm8p(8, wf, xf, ef);
    }
    {
      ARows wf{p.w_bdT + (long)nt_ * 256 * 512, 512, 256};
      ARows xf{p.odsa + (long)mt_ * 256 * 512, 512, 256};
      Epi8Y ef{p.y, p.proj, mt_ * 256, nt_ * 256, 1};
      gemm8p(8, wf, xf, ef);
    }
  }
}
struct EpiStoreBf {
  u16* dst; long ld; int m0, n0;
  template <int MT> DI void operator()(f32x16 (&acc)[MT][2], int wm, int wn, int lane) const {
    SW_FOR { *(uint2*)(dst + (long)(m0 + SW_R) * ld + n0 + SW_C0) = pack4(SW_V(0), SW_V(1), SW_V(2), SW_V(3)); }
  }
};
struct Epi8StoreBf {
  u16* dst; long ld; int m0, n0;
  DI void operator()(int q, int c, float v0, float v1, float v2, float v3) const { *(uint2*)(dst + (long)(m0 + q) * ld + n0 + c) = pack4(v0, v1, v2, v3); }
};
DI void phase9_8w(const Params& p, int wg, int nwg) {
  for (int item = wg; item < 256; item += nwg) {
    const int x_ = item & 7, s_ = item >> 3, nt_ = s_ & 3, mt_ = x_ * 8 + (s_ >> 2);
    ARows wf{p.w_outT + (long)nt_ * 256 * 1024, 1024, 256};
    ARows xf{p.y + (long)mt_ * 256 * 1024, 1024, 256};
    Epi8StoreBf ef{p.z, 1024, mt_ * 256, nt_ * 256};
    gemm8p(16, wf, xf, ef);
  }
}

DI void phase10(const Params& p, int bid, int nblk) {
  const int tid = TIDX(), lane = tid & 63, wid = __builtin_amdgcn_readfirstlane(tid >> 6);
  for (int row = bid * 4 + wid; row < NTOK; row += nblk * 4) {
    const int b = row >> 13;
    const float* modb = p.mod + b * 6144;
    float zv[16], xv[16];
    float ss = 0.f;
#pragma unroll
    for (int i = 0; i < 4; ++i) {
      const int col = i * 256 + lane * 4;
      const uint2 u = *(const uint2*)(p.z + (long)row * 1024 + col);
      zv[i * 4 + 0] = lo16(u.x); zv[i * 4 + 1] = hi16(u.x); zv[i * 4 + 2] = lo16(u.y); zv[i * 4 + 3] = hi16(u.y);
      const float4 xx = *(const float4*)(p.x + (long)row * 1024 + col);
      xv[i * 4 + 0] = xx.x; xv[i * 4 + 1] = xx.y; xv[i * 4 + 2] = xx.z; xv[i * 4 + 3] = xx.w;
#pragma unroll
      for (int j = 0; j < 4; ++j) ss += zv[i * 4 + j] * zv[i * 4 + j];
    }
    ss = wave_sum(ss);
    const float r = rsqrtf(ss * (1.f / 1024.f) + 1e-6f);
    float ss2 = 0.f;
#pragma unroll
    for (int i = 0; i < 4; ++i)
#pragma unroll
      for (int j = 0; j < 4; ++j) {
        const int col = i * 256 + lane * 4 + j;
        const float v = xv[i * 4 + j] + modb[2048 + col] * (zv[i * 4 + j] * r * p.g_post_mix[col]);
        xv[i * 4 + j] = v;
        ss2 += v * v;
      }
    ss2 = wave_sum(ss2);
    const float r2 = rsqrtf(ss2 * (1.f / 1024.f) + 1e-6f);
#pragma unroll
    for (int i = 0; i < 4; ++i) {
      const int col = i * 256 + lane * 4;
      *(float4*)(p.x1 + (long)row * 1024 + col) = make_float4(xv[i * 4], xv[i * 4 + 1], xv[i * 4 + 2], xv[i * 4 + 3]);
      float hv[4];
#pragma unroll
      for (int j = 0; j < 4; ++j) hv[j] = xv[i * 4 + j] * r2 * p.g_pre_ffn[col + j] * (1.f + modb[4096 + col + j]) + modb[3072 + col + j];
      uint2 w;
      w.x = pack2(hv[0], hv[1]);
      w.y = pack2(hv[2], hv[3]);
      *(uint2*)(p.h + (long)row * 1024 + col) = w;
    }
  }
}

struct EpiStoreF32 {
  float* dst; long ld; int m0, n0;
  DI void operator()(f32x16 (&acc)[2][2], int wm, int wn, int lane) const {
    constexpr int MT = 2;
    SW_FOR { *(float4*)(dst + (long)(m0 + SW_R) * ld + n0 + SW_C0) = make_float4(SW_V(0), SW_V(1), SW_V(2), SW_V(3)); }
  }
};
DI void phase11(const Params& p, char* smem, int bid, int nblk) {
  for (int item = bid; item < 256; item += nblk) {
    const int nt_ = item & 1, mt_ = item >> 1;
    ARows af{p.h + (long)mt_ * 128 * 1024, 1024, 128};
    BMatT bf{p.routerT + (long)nt_ * 128 * 1024, 1024};
    EpiStoreF32 ef{p.logits, 256, mt_ * 128, nt_ * 128};
    gemm_tile<true, false, true>(smem, 16, 64, af, bf, ef);
  }
}
DI void phase12(const Params& p, int bid, int nblk) {
  const int tid = TIDX(), lane = tid & 63, wid = __builtin_amdgcn_readfirstlane(tid >> 6);
  for (int tok = bid * 4 + wid; tok < NTOK; tok += nblk * 4) {
    const float4 lg = *(const float4*)(p.logits + (long)tok * 256 + lane * 4);
    const float4 rbv = *(const float4*)(p.router_bias + lane * 4);
    float sg[4] = {sigmoidf(lg.x), sigmoidf(lg.y), sigmoidf(lg.z), sigmoidf(lg.w)};
    float sl[4] = {sg[0] + rbv.x, sg[1] + rbv.y, sg[2] + rbv.z, sg[3] + rbv.w};
    float t1 = fmaxf(sl[0], sl[1]), t2 = fminf(sl[0], sl[1]);
#pragma unroll
    for (int j = 2; j < 4; ++j) {
      const float v = sl[j];
      t2 = fmaxf(t2, fminf(t1, v));
      t1 = fmaxf(t1, v);
    }
#define R_MERGE(CTRL)                                                                                                            \
    {                                                                                                                            \
      const float a1 = __int_as_float(__builtin_amdgcn_update_dpp(0, __float_as_int(t1), CTRL, 0xF, 0xF, true));                 \
      const float a2 = __int_as_float(__builtin_amdgcn_update_dpp(0, __float_as_int(t2), CTRL, 0xF, 0xF, true));                 \
      const float n1 = fmaxf(t1, a1);                                                                                            \
      const float n2 = fmaxf(fminf(t1, a1), fmaxf(t2, a2));                                                                      \
      t1 = n1; t2 = n2;                                                                                                          \
    }
    R_MERGE(DPP_QP1) R_MERGE(DPP_QP2) R_MERGE(DPP_RHM)
#undef R_MERGE
    const float gscore = t1 + t2;
    const int grp = lane >> 3;
    int rank = 0;
#pragma unroll
    for (int g2 = 0; g2 < 8; ++g2) {
      const float og = rdlane(gscore, g2 * 8);
      rank += (og > gscore || (og == gscore && g2 < grp)) ? 1 : 0;
    }
    const bool gsel = rank < 4;
    float cv[4];
#pragma unroll
    for (int j = 0; j < 4; ++j) cv[j] = gsel ? sl[j] : -1e30f;
    int my_e = -1; float my_s = 0.f; float ssum = 0.f;
    for (int r = 0; r < 8; ++r) {
      float bv = cv[0]; int bj = 0;
#pragma unroll
      for (int j = 1; j < 4; ++j) if (cv[j] > bv) { bv = cv[j]; bj = j; }
      int be = lane * 4 + bj;
      wave_argmax(bv, be);
      const int wl_ = be >> 2, wj = be & 3;
      const float s0 = rdlane(sg[0], wl_), s1 = rdlane(sg[1], wl_), s2 = rdlane(sg[2], wl_), s3 = rdlane(sg[3], wl_);
      const float bs = wj == 0 ? s0 : (wj == 1 ? s1 : (wj == 2 ? s2 : s3));
      if (wl_ == lane) {
        if (wj == 0) cv[0] = -3e30f; else if (wj == 1) cv[1] = -3e30f; else if (wj == 2) cv[2] = -3e30f; else cv[3] = -3e30f;
      }
      if (lane == r) { my_e = be; my_s = bs; }
      ssum += bs;
    }
    if (lane < 8) {
      const float w = my_s / ssum * 2.5f;
      const int rk = atomicAdd(p.counts + my_e, 1);
      p.eidx[tok * 8 + lane] = my_e;
      p.ewt[tok * 8 + lane] = w;
      p.erank[tok * 8 + lane] = rk;
    }
  }
}
DI void phase14(const Params& p, char* smem, int bid, int nblk) {
  const int tid = TIDX();
  int* s_cnt = (int*)smem;
  int* s_off = s_cnt + 256;
  const int cnt = p.counts[tid];
  s_cnt[tid] = cnt;
  hb_sync();
  int run = 0, nt = 0, nt2 = 0;
  for (int e = 0; e < tid; ++e) { const int c = s_cnt[e]; run += c; nt += (c + 127) >> 7; nt2 += (c + 255) >> 8; }
  s_off[tid] = run;
  hb_sync();
  if (bid == 0) {
    p.offs[tid] = run;
    for (int m = 0; m * 256 < cnt; ++m) {
      p.tile2_e[nt2] = tid;
      p.tile2_r0[nt2] = run + m * 256;
      p.tile2_nr[nt2] = (cnt - m * 256) > 256 ? 256 : (cnt - m * 256);
      ++nt2;
    }
    for (int m = 0; m * 128 < cnt; ++m) {
      p.tile_e[nt] = tid;
      p.tile_r0[nt] = run + m * 128;
      p.tile_nr[nt] = (cnt - m * 128) > 128 ? 128 : (cnt - m * 128);
      ++nt;
    }
    if (tid == 255) {
      p.offs[256] = run + cnt;
      for (int m = 0; m < 128; ++m) {
        p.tile_e[nt] = 256;
        p.tile_r0[nt] = 131072 + m * 128;
        p.tile_nr[nt] = 128;
        ++nt;
      }
      p.ntiles[0] = nt;
      for (int m = 0; m < 64; ++m) {
        p.tile2_e[nt2] = 256;
        p.tile2_r0[nt2] = 131072 + m * 256;
        p.tile2_nr[nt2] = 256;
        ++nt2;
      }
      p.ntiles[1] = nt2;
    }
  }
  for (int i = bid * 256 + tid; i < NSLOT; i += nblk * 256) {
    if (i < 131072) {
      const int e = p.eidx[i];
      const int slot = s_off[e] + p.erank[i];
      p.slot_tok[slot] = i >> 3;
      p.slot_wt[slot] = p.ewt[i];
      p.tok_slot[i] = slot;
    } else {
      p.slot_tok[i] = i - 131072;
      p.slot_wt[i] = 1.f;
    }
  }
}

struct AGather {
  const u16* h; const int* slot_tok; int r0, nr;
  DI const u16* operator()(int r) const { return h + (long)slot_tok[r0 + (r < nr ? r : 0)] * 1024; }
  DI const u16* origin() const { return h; } DI int off(int r) const { return slot_tok[r0 + (r < nr ? r : 0)] * 1024; }
};
struct BGateUp {
  const float* wg; long udiff; long ldb; int n0;
  DI const float* operator()(int c4) const {
    const int wn = c4 >> 6, ntl = (c4 >> 5) & 1, j = c4 & 31;
    return wg + (long)ntl * udiff + n0 + wn * 32 + j;
  }
  DI const u16* row(int) const { return nullptr; }
};
struct EpiH {
  u16* H; int r0, nr, n0;
  template <int MT> DI void operator()(f32x16 (&acc)[MT][2], int wm, int wn, int lane) const {
#pragma unroll
    for (int mt = 0; mt < MT; ++mt) {
      const int r = SW_R;
      if (r < nr) {
#pragma unroll
        for (int q4 = 0; q4 < 4; ++q4) {
          float v[4];
#pragma unroll
          for (int j = 0; j < 4; ++j) v[j] = siluf(acc[mt][0][4 * q4 + j]) * acc[mt][1][4 * q4 + j];
          *(uint2*)(H + (long)(r0 + r) * 256 + n0 + wn * 32 + 8 * q4 + 4 * (lane >> 5)) = pack4(v[0], v[1], v[2], v[3]);
        }
      }
    }
  }
};
struct BGateUp8 {
  const float* wg; long udiff; long ldb; int n0;
  DI const float* operator()(int c4) const {
    const int wn = c4 >> 6, ntl = (c4 >> 5) & 1, j = c4 & 31;
    return wg + (long)ntl * udiff + n0 + wn * 32 + j;
  }
};
DI void phase15_8w(const Params& p, int wg, int nwg) {
  const int ntl = p.ntiles[1];
  for (int item = wg; item < ntl * 2; item += nwg) {
    const int ti = item >> 1, nt_ = item & 1;
    const int e = p.tile2_e[ti], r0 = p.tile2_r0[ti], nr = p.tile2_nr[ti];
    AGather af{p.h, p.slot_tok, r0, nr};
    const float* wgp = e < 256 ? p.w_eg + (long)e * 1024 * 256 : p.w_sg;
    const float* wup = e < 256 ? p.w_eu + (long)e * 1024 * 256 : p.w_su;
    BGateUp8 bf{wgp, (long)(wup - wgp), 256, nt_ * 128};
    EpiH ef{p.H, r0, nr, nt_ * 128};
    gemm8w<false>(16, af, bf, ef);
  }
}
struct EpiYexp {
  u16* Y; const float* slot_wt; int r0, nr, n0;
  template <int MT> DI void operator()(f32x16 (&acc)[MT][2], int wm, int wn, int lane) const {
#pragma unroll
    for (int mt = 0; mt < MT; ++mt) {
      const int r = SW_R;
      if (r < nr) {
        const float w = slot_wt[r0 + r];
#pragma unroll
        for (int nt = 0; nt < 2; ++nt)
#pragma unroll
          for (int q4 = 0; q4 < 4; ++q4)
            *(uint2*)(Y + (long)(r0 + r) * 1024 + n0 + SW_C0) = pack4(SW_V(0) * w, SW_V(1) * w, SW_V(2) * w, SW_V(3) * w);
      }
    }
  }
};
DI void phase16_8w(const Params& p, int wg, int nwg) {
  const int ntl = p.ntiles[1];
  for (int item = wg; item < ntl * 4; item += nwg) {
    const int ti = item >> 2, nt_ = item & 3;
    const int e = p.tile2_e[ti], r0 = p.tile2_r0[ti], nr = p.tile2_nr[ti];
    ARows af{p.H + (long)r0 * 256, 256, nr};
    const float* wd = e < 256 ? p.w_ed + (long)e * 256 * 1024 : p.w_sd;
    BMat bf{wd + nt_ * 256, 1024, 256};
    EpiYexp ef{p.Y, p.slot_wt, r0, nr, nt_ * 256};
    gemm8w<false>(4, af, bf, ef);
  }
}
DI void phase17(const Params& p, int bid, int nblk) {
  const int tid = TIDX(), lane = tid & 63, wid = __builtin_amdgcn_readfirstlane(tid >> 6);
  for (int row = bid * 4 + wid; row < NTOK; row += nblk * 4) {
    const int b = row >> 13;
    const float* modb = p.mod + b * 6144;
    int slots[9];
#pragma unroll
    for (int k = 0; k < 8; ++k) slots[k] = p.tok_slot[row * 8 + k];
    slots[8] = 131072 + row;
    float yv[16];
#pragma unroll
    for (int j = 0; j < 16; ++j) yv[j] = 0.f;
#pragma unroll
    for (int k = 0; k < 9; ++k) {
#pragma unroll
      for (int i = 0; i < 4; ++i) {
        const uint2 u = *(const uint2*)(p.Y + (long)slots[k] * 1024 + i * 256 + lane * 4);
        yv[i * 4 + 0] += lo16(u.x); yv[i * 4 + 1] += hi16(u.x); yv[i * 4 + 2] += lo16(u.y); yv[i * 4 + 3] += hi16(u.y);
      }
    }
    float ss = 0.f;
#pragma unroll
    for (int j = 0; j < 16; ++j) ss += yv[j] * yv[j];
    ss = wave_sum(ss);
    const float r = rsqrtf(ss * (1.f / 1024.f) + 1e-6f);
#pragma unroll
    for (int i = 0; i < 4; ++i) {
      const int col = i * 256 + lane * 4;
      const float4 xx = *(const float4*)(p.x1 + (long)row * 1024 + col);
      float o[4] = {xx.x, xx.y, xx.z, xx.w};
#pragma unroll
      for (int j = 0; j < 4; ++j) o[j] += modb[5120 + col + j] * (yv[i * 4 + j] * r * p.g_post_ffn[col + j]);
      *(float4*)(p.out + (long)row * 1024 + col) = make_float4(o[0], o[1], o[2], o[3]);
    }
  }
}

__global__ void __launch_bounds__(512, 2) mega(Params p) {
  cg::grid_group grid = cg::this_grid();
  const int vb = __builtin_amdgcn_readfirstlane((int)(threadIdx.x >> 8));
  char* smem = g_smem + vb * HALF_LDS;
  const int bid = blockIdx.x * 2 + vb, nblk = gridDim.x * 2;
  if (p.phase_hi == 12345) grid.sync();
  if (threadIdx.x < 32) ((unsigned*)(g_smem + 2 * HALF_LDS))[threadIdx.x] = 0u;
  __syncthreads();
  const XcdBarrier xb = xcd_barrier_post(p.bar, (volatile LAS unsigned*)(g_smem + 2 * HALF_LDS));
#if !defined(ONLY) || ONLY==0
  if (p.phase_lo <= 0 && 0 < p.phase_hi) {
    phase0(p, smem, bid, nblk);
#if (REPEAT_MASK >> 0) & 1
    xcd_barrier(xb);
    phase0(p, smem, bid, nblk);
#endif
    if (0 + 1 < p.phase_hi) xcd_barrier(xb);
  }
#endif
#if !defined(ONLY) || ONLY==1
  if (p.phase_lo <= 1 && 1 < p.phase_hi) {
    phase1(p, smem, bid, nblk);
#if (REPEAT_MASK >> 1) & 1
    xcd_barrier(xb);
    phase1(p, smem, bid, nblk);
#endif
    if (1 + 1 < p.phase_hi) xcd_barrier(xb);
  }
#endif
#if !defined(ONLY) || ONLY==2
  if (p.phase_lo <= 2 && 2 < p.phase_hi) {
    phase2_8w(p, blockIdx.x, gridDim.x);
    __syncthreads();
    phase2(p, smem, bid, nblk);
#if (REPEAT_MASK >> 2) & 1
    xcd_barrier(xb);
    phase2_8w(p, blockIdx.x, gridDim.x);
    __syncthreads();
    phase2(p, smem, bid, nblk);
#endif
    if (2 + 1 < p.phase_hi) xcd_barrier(xb);
  }
#endif
#if !defined(ONLY) || ONLY==3
  if (p.phase_lo <= 3 && 3 < p.phase_hi) {
    phase3(p, smem, bid, nblk);
#if (REPEAT_MASK >> 3) & 1
    xcd_barrier(xb);
    phase3(p, smem, bid, nblk);
#endif
    if (3 + 1 < p.phase_hi) xcd_barrier(xb);
  }
#endif
#if !defined(ONLY) || ONLY==4
  if (p.phase_lo <= 4 && 4 < p.phase_hi) {
    phase4(p, smem, bid, nblk);
#if (REPEAT_MASK >> 4) & 1
    xcd_barrier(xb);
    phase4(p, smem, bid, nblk);
#endif
    if (4 + 1 < p.phase_hi) xcd_barrier(xb);
  }
#endif
#if !defined(ONLY) || ONLY==5
  if (p.phase_lo <= 5 && 5 < p.phase_hi) {
    phase5_nsa8(p);
    phase5(p, smem, bid, nblk);
#if (REPEAT_MASK >> 5) & 1
    xcd_barrier(xb);
    phase5_nsa8(p);
    phase5(p, smem, bid, nblk);
#endif
    if (5 + 1 < p.phase_hi) xcd_barrier(xb);
  }
#endif
#if !defined(ONLY) || ONLY==7
  if (p.phase_lo <= 7 && 7 < p.phase_hi) {
    phase7(p, smem, bid, nblk);
#if (REPEAT_MASK >> 7) & 1
    xcd_barrier(xb);
    phase7(p, smem, bid, nblk);
#endif
    if (7 + 1 < p.phase_hi) xcd_barrier(xb);
  }
#endif
#if !defined(ONLY) || ONLY==8
  if (p.phase_lo <= 8 && 8 < p.phase_hi) {
    phase8_8w(p, blockIdx.x, gridDim.x);
#if (REPEAT_MASK >> 8) & 1
    xcd_barrier(xb);
    phase8_8w(p, blockIdx.x, gridDim.x);
#endif
    if (8 + 1 < p.phase_hi) xcd_barrier(xb);
  }
#endif
#if !defined(ONLY) || ONLY==9
  if (p.phase_lo <= 9 && 9 < p.phase_hi) {
    phase9_8w(p, blockIdx.x, gridDim.x);
#if (REPEAT_MASK >> 9) & 1
    xcd_barrier(xb);
    phase9_8w(p, blockIdx.x, gridDim.x);
#endif
    if (9 + 1 < p.phase_hi) xcd_barrier(xb);
  }
#endif
#if !defined(ONLY) || ONLY==10
  if (p.phase_lo <= 10 && 10 < p.phase_hi) {
    phase10(p, bid, nblk);
#if (REPEAT_MASK >> 10) & 1
    xcd_barrier(xb);
    phase10(p, bid, nblk);
#endif
    if (10 + 1 < p.phase_hi) xcd_barrier(xb);
  }
#endif
#if !defined(ONLY) || ONLY==11
  if (p.phase_lo <= 11 && 11 < p.phase_hi) {
    phase11(p, smem, bid, nblk);
#if (REPEAT_MASK >> 11) & 1
    xcd_barrier(xb);
    phase11(p, smem, bid, nblk);
#endif
    if (11 + 1 < p.phase_hi) xcd_barrier(xb);
  }
#endif
#if !defined(ONLY) || ONLY==12
  if (p.phase_lo <= 12 && 12 < p.phase_hi) {
    phase12(p, bid, nblk);
#if (REPEAT_MASK >> 12) & 1
    xcd_barrier(xb);
    phase12(p, bid, nblk);
#endif
    if (12 + 1 < p.phase_hi) xcd_barrier(xb);
  }
#endif
#if !defined(ONLY) || ONLY==14
  if (p.phase_lo <= 14 && 14 < p.phase_hi) {
    phase14(p, smem, bid, nblk);
#if (REPEAT_MASK >> 14) & 1
    xcd_barrier(xb);
    phase14(p, smem, bid, nblk);
#endif
    if (14 + 1 < p.phase_hi) xcd_barrier(xb);
  }
#endif
#if !defined(ONLY) || ONLY==15
  if (p.phase_lo <= 15 && 15 < p.phase_hi) {
    phase15_8w(p, blockIdx.x, gridDim.x);
#if (REPEAT_MASK >> 15) & 1
    xcd_barrier(xb);
    phase15_8w(p, blockIdx.x, gridDim.x);
#endif
    if (15 + 1 < p.phase_hi) xcd_barrier(xb);
  }
#endif
#if !defined(ONLY) || ONLY==16
  if (p.phase_lo <= 16 && 16 < p.phase_hi) {
    phase16_8w(p, blockIdx.x, gridDim.x);
#if (REPEAT_MASK >> 16) & 1
    xcd_barrier(xb);
    phase16_8w(p, blockIdx.x, gridDim.x);
#endif
    if (16 + 1 < p.phase_hi) xcd_barrier(xb);
  }
#endif
#if !defined(ONLY) || ONLY==17
  if (p.phase_lo <= 17 && 17 < p.phase_hi) {
    phase17(p, bid, nblk);
#if (REPEAT_MASK >> 17) & 1
    xcd_barrier(xb);
    phase17(p, bid, nblk);
#endif
    if (17 + 1 < p.phase_hi) xcd_barrier(xb);
  }
#endif
}

extern "C" void kernel_launch(void* const* d_in, const int* in_sizes, int n_in, void* d_out, int out_size, void* d_ws, size_t ws_size,
                              hipStream_t stream) {
  static int grid_blocks = 0;
  if (!grid_blocks) {
    int dev = 0, cus = 0, per_cu = 0;
    (void)hipGetDevice(&dev);
    (void)hipDeviceGetAttribute(&cus, hipDeviceAttributeMultiprocessorCount, dev);
    (void)hipOccupancyMaxActiveBlocksPerMultiprocessor(&per_cu, mega, 512, 0);
    if (per_cu > 1) per_cu = 1;
    if (per_cu < 1) per_cu = 1;
    grid_blocks = cus * per_cu;
  }
  Params p{};
  const float* const* in = (const float* const*)d_in;
  p.x = in[0]; p.c = in[1]; p.w_ada = in[2]; p.b_ada = in[3]; p.g_pre_mix = in[4]; p.g_post_mix = in[5]; p.g_pre_ffn = in[6]; p.g_post_ffn = in[7];
  p.w_in = in[8]; p.rel_bias = in[9]; p.cmp_pe = in[10]; p.cmp_w1 = in[11]; p.cmp_b1 = in[12]; p.cmp_w2 = in[13]; p.dsa_kv_norm = in[14];
  p.dsa_w_uk = in[15]; p.dsa_w_uv = in[16]; p.w_bn = in[17]; p.w_bd = in[18]; p.w_out = in[19]; p.router_w = in[20]; p.router_bias = in[21];
  p.w_eg = in[22]; p.w_eu = in[23]; p.w_ed = in[24]; p.w_sg = in[25]; p.w_su = in[26]; p.w_sd = in[27];
  p.out = (float*)d_out;
  char* ws = (char*)d_ws;
  size_t off = 0;
  auto alloc = [&](size_t bytes) { char* r = ws + off; off += (bytes + 255) & ~(size_t)255; return r; };
  p.bar = (unsigned*)alloc(XCD_BAR_WORDS * 4);
  p.modp = (float*)alloc(16 * 2 * 6144 * 4);
  p.mod = (float*)alloc(2 * 6144 * 4);
  p.pe_part = (float*)alloc(16 * 256 * 4);
  p.w_ukT = (float*)alloc(8 * 64 * 128 * 4);
  p.w_inT = (u16*)alloc((size_t)4608 * 1024 * 2);
  p.w_bnT = (u16*)alloc((size_t)1024 * 512 * 2);
  p.w_bdT = (u16*)alloc((size_t)1024 * 512 * 2);
  p.w_outT = (u16*)alloc((size_t)1024 * 1024 * 2);
  p.routerT = (u16*)alloc((size_t)256 * 1024 * 2);
  p.counts = (int*)alloc(256 * 4);
  p.offs = (int*)alloc(257 * 4);
  p.tile_e = (int*)alloc(1536 * 4);
  p.tile_r0 = (int*)alloc(1536 * 4);
  p.tile_nr = (int*)alloc(1536 * 4);
  p.ntiles = (int*)alloc(8);
  p.tile2_e = (int*)alloc(1024 * 4);
  p.tile2_r0 = (int*)alloc(1024 * 4);
  p.tile2_nr = (int*)alloc(1024 * 4);
  p.h = (u16*)alloc((size_t)NTOK * 1024 * 2);
  p.proj = (u16*)alloc((size_t)NTOK * LDP * 2);
  p.widx = (float*)alloc((size_t)NTOK * 8 * 4);
  p.zc = (u16*)alloc((size_t)2 * 2048 * 128 * 2);
  p.kc = (u16*)alloc((size_t)4 * 512 * 64 * 2);
  p.vcT = (u16*)alloc((size_t)4 * 512 * 64 * 2);
  p.vts = (u16*)alloc((size_t)4 * 64 * T * 2);
  p.vtw = (u16*)alloc((size_t)4 * 64 * T * 2);
  p.qlat = (u16*)alloc((size_t)NTOK * 1024 * 2);
  p.ckv = (u16*)alloc((size_t)NTOK * 128 * 2);
  p.selk = (int*)alloc((size_t)NTOK * 256 * 4);
  p.onsa = (u16*)alloc((size_t)NTOK * 512 * 2);
  p.olat = (u16*)alloc((size_t)NTOK * 1024 * 2);
  p.odsa = (u16*)alloc((size_t)NTOK * 512 * 2);
  p.y = p.qlat;
  p.z = p.olat;
  p.eidx = (int*)alloc((size_t)NTOK * 8 * 4);
  p.ewt = (float*)alloc((size_t)NTOK * 8 * 4);
  p.erank = (int*)alloc((size_t)NTOK * 8 * 4);
  p.slot_tok = (int*)alloc((size_t)NSLOT * 4);
  p.slot_wt = (float*)alloc((size_t)NSLOT * 4);
  p.tok_slot = (int*)alloc((size_t)NTOK * 8 * 4);
  char* big = alloc((size_t)2 * T * T * 4);
  p.scores = (float*)big;
  {
    size_t o2 = 0;
    auto sub = [&](size_t bytes) { char* r = big + o2; o2 += (bytes + 255) & ~(size_t)255; return r; };
    p.H = (u16*)sub((size_t)NSLOT * 256 * 2);
    p.Y = (u16*)sub((size_t)NSLOT * 1024 * 2);
    p.x1 = (float*)sub((size_t)NTOK * 1024 * 4);
    p.logits = (float*)sub((size_t)NTOK * 256 * 4);
  }
  if (off > ws_size) fprintf(stderr, "workspace too small: need %zu have %zu\n", off, ws_size);
  p.phase_lo = 0;
  p.phase_hi = 18;
  (void)hipMemsetAsync(p.bar, 0, XCD_BAR_WORDS * 4, stream);
  void* args[] = {&p};
  hipError_t e = hipLaunchCooperativeKernel((void*)mega, dim3(grid_blocks), dim3(512), args, 0, stream);
  if (e != hipSuccess) fprintf(stderr, "coop launch failed: %s (grid %d)\n", hipGetErrorString(e), grid_blocks);
}
```

```cpp
#include <hip/hip_runtime.h>
#include <hip/hip_cooperative_groups.h>
#include <cstdio>
namespace cg = cooperative_groups;

#define DI __device__ __forceinline__
typedef unsigned short u16;
typedef unsigned long long u64;
using bf16x8 = __attribute__((ext_vector_type(8))) short;
using f32x16 = __attribute__((ext_vector_type(16))) float;
using f32x4 = __attribute__((ext_vector_type(4))) float;

constexpr int T = 8192;
constexpr int NTOK = 16384;
constexpr int LDP = 4576;
constexpr int C_QN = 0, C_KV = 512, C_GN = 1280, C_QD = 1304, C_CKV = 1816, C_QI = 1944, C_KI = 2456, C_WI = 2520, C_GM = 2528;
constexpr int NSLOT = 131072 + 16384;
constexpr int HALF_LDS = 73728;
constexpr int LDS_BYTES = 2 * HALF_LDS + 128;
__shared__ __attribute__((aligned(16))) char g_smem[LDS_BYTES];
#ifndef REPEAT_MASK
#define REPEAT_MASK 0
#endif

__device__ const unsigned char BUCKET[128] = {
  0, 1, 2, 3, 4, 5, 6, 7, 8, 9, 10, 11, 12, 13, 14, 15, 16, 16, 16, 17, 17, 18, 18, 18, 19, 19, 19, 20, 20, 20, 20, 21,
  21, 21, 21, 22, 22, 22, 22, 22, 23, 23, 23, 23, 23, 23, 24, 24, 24, 24, 24, 24, 25, 25, 25, 25, 25, 25, 25, 26, 26, 26, 26, 26,
  26, 26, 26, 27, 27, 27, 27, 27, 27, 27, 27, 27, 27, 28, 28, 28, 28, 28, 28, 28, 28, 28, 28, 29, 29, 29, 29, 29, 29, 29, 29, 29,
  29, 29, 29, 30, 30, 30, 30, 30, 30, 30, 30, 30, 30, 30, 30, 30, 30, 31, 31, 31, 31, 31, 31, 31, 31, 31, 31, 31, 31, 31, 31, 31};

struct Params {
  const float *x, *c, *w_ada, *b_ada, *g_pre_mix, *g_post_mix, *g_pre_ffn, *g_post_ffn, *w_in, *rel_bias;
  const float *cmp_pe, *cmp_w1, *cmp_b1, *cmp_w2, *dsa_kv_norm, *dsa_w_uk, *dsa_w_uv, *w_bn, *w_bd, *w_out;
  const float *router_w, *router_bias, *w_eg, *w_eu, *w_ed, *w_sg, *w_su, *w_sd;
  float* out;
  float* modp;
  float* mod;
  float* pe_part;
  float* w_ukT;
  u16 *w_inT, *w_bnT, *w_bdT, *w_outT, *routerT;
  u16* h;
  u16* proj;
  float* widx;
  u16* zc;
  u16* kc;
  u16* vcT;
  u16* vts;
  u16* vtw;
  u16* qlat;
  u16* ckv;
  float* scores;
  int* selk;
  u16* onsa;
  u16* olat;
  u16* odsa;
  u16* y;
  u16* z;
  float* x1;
  float* logits;
  int* eidx;
  float* ewt;
  int* erank;
  int* counts;
  int* offs;
  int* tile_e;
  int* tile_r0;
  int* tile_nr;
  int* ntiles;
  int *tile2_e, *tile2_r0, *tile2_nr;
  int* slot_tok;
  float* slot_wt;
  int* tok_slot;
  u16* H;
  u16* Y;
  unsigned* bar;
  int phase_lo, phase_hi;
};

DI float bf2f(u16 v) { return __uint_as_float(((unsigned)v) << 16); }
typedef __bf16 bf16x2_t __attribute__((ext_vector_type(2)));
typedef float f32x2_t __attribute__((ext_vector_type(2)));
DI unsigned pack2(float a, float b) { f32x2_t v = {a, b}; return __builtin_bit_cast(unsigned, __builtin_convertvector(v, bf16x2_t)); }
DI u16 f2bf(float x) { return (u16)(pack2(x, x) & 0xffffu); }
DI float lo16(unsigned u) { return __uint_as_float(u << 16); }
DI float hi16(unsigned u) { return __uint_as_float(u & 0xffff0000u); }
DI float wave_sum(float v) { for (int o = 32; o; o >>= 1) v += __shfl_xor(v, o); return v; }
DI float wave_max(float v) { for (int o = 32; o; o >>= 1) v = fmaxf(v, __shfl_xor(v, o)); return v; }
#define DPP_QP1 0xB1
#define DPP_QP2 0x4E
#define DPP_RHM 0x141
#define DPP_RM  0x140
#define DPP_B15 0x142
#define DPP_B31 0x143
DI int wave_sum_i(int x) {
  x += __builtin_amdgcn_update_dpp(0, x, DPP_QP1, 0xF, 0xF, true);
  x += __builtin_amdgcn_update_dpp(0, x, DPP_QP2, 0xF, 0xF, true);
  x += __builtin_amdgcn_update_dpp(0, x, DPP_RHM, 0xF, 0xF, true);
  x += __builtin_amdgcn_update_dpp(0, x, DPP_RM, 0xF, 0xF, true);
  x += __builtin_amdgcn_update_dpp(0, x, DPP_B15, 0xA, 0xF, true);
  x += __builtin_amdgcn_update_dpp(0, x, DPP_B31, 0xC, 0xF, true);
  return __builtin_amdgcn_readlane(x, 63);
}
#define DPP_SELF(x, CTRL, RM) ((unsigned)__builtin_amdgcn_update_dpp((int)(x), (int)(x), CTRL, RM, 0xF, false))
DI unsigned wave_max_u(unsigned x) {
  x = max(x, DPP_SELF(x, DPP_QP1, 0xF)); x = max(x, DPP_SELF(x, DPP_QP2, 0xF)); x = max(x, DPP_SELF(x, DPP_RHM, 0xF));
  x = max(x, DPP_SELF(x, DPP_RM, 0xF)); x = max(x, DPP_SELF(x, DPP_B15, 0xA)); x = max(x, DPP_SELF(x, DPP_B31, 0xC));
  return (unsigned)__builtin_amdgcn_readlane((int)x, 63);
}
DI unsigned wave_min_u(unsigned x) {
  x = min(x, DPP_SELF(x, DPP_QP1, 0xF)); x = min(x, DPP_SELF(x, DPP_QP2, 0xF)); x = min(x, DPP_SELF(x, DPP_RHM, 0xF));
  x = min(x, DPP_SELF(x, DPP_RM, 0xF)); x = min(x, DPP_SELF(x, DPP_B15, 0xA)); x = min(x, DPP_SELF(x, DPP_B31, 0xC));
  return (unsigned)__builtin_amdgcn_readlane((int)x, 63);
}
DI void wave_argmax(float& v, int& idx) {
#define AM_STEP(CTRL, RM)                                                                                                   \
  {                                                                                                                         \
    const float ov_ = __int_as_float(__builtin_amdgcn_update_dpp(__float_as_int(v), __float_as_int(v), CTRL, RM, 0xF, false)); \
    const int oi_ = __builtin_amdgcn_update_dpp(idx, idx, CTRL, RM, 0xF, false);                                            \
    const bool tk_ = ov_ > v || (ov_ == v && oi_ < idx);                                                                    \
    v = tk_ ? ov_ : v;                                                                                                      \
    idx = tk_ ? oi_ : idx;                                                                                                  \
  }
  AM_STEP(DPP_QP1, 0xF) AM_STEP(DPP_QP2, 0xF) AM_STEP(DPP_RHM, 0xF) AM_STEP(DPP_RM, 0xF) AM_STEP(DPP_B15, 0xA) AM_STEP(DPP_B31, 0xC)
#undef AM_STEP
  v = __int_as_float(__builtin_amdgcn_readlane(__float_as_int(v), 63));
  idx = __builtin_amdgcn_readlane(idx, 63);
}
DI float rdlane(float v, int l) { return __int_as_float(__builtin_amdgcn_readlane(__float_as_int(v), l)); }
DI int rdlane_i(int v, int l) { return __builtin_amdgcn_readlane(v, l); }
DI int TIDX() { int t = threadIdx.x & 255; asm volatile("" : "+v"(t)); return t; }
DI int TIDX8() { int t = threadIdx.x; asm volatile("" : "+v"(t)); return t; }
DI void hb_sync() {
  asm volatile("s_waitcnt vmcnt(0) lgkmcnt(0)" ::: "memory");
  const int vb = __builtin_amdgcn_readfirstlane((int)(threadIdx.x >> 8));
  volatile __attribute__((address_space(3))) unsigned* cnt = (volatile __attribute__((address_space(3))) unsigned*)(g_smem + 2 * HALF_LDS + 64) + vb * 8;
  if ((threadIdx.x & 63) == 0) {
    const unsigned old = __hip_atomic_fetch_add((__attribute__((address_space(3))) unsigned*)cnt, 1u, __ATOMIC_RELAXED, __HIP_MEMORY_SCOPE_WORKGROUP);
    const unsigned target = (old & ~3u) + 4u;
    while ((int)(*cnt - target) < 0) __builtin_amdgcn_s_sleep(0);
  }
  asm volatile("s_waitcnt lgkmcnt(0)" ::: "memory");
  __builtin_amdgcn_wave_barrier();
}
DI void cbar(const void* p) { asm volatile("" ::"v"(p) : "memory"); }
DI void wave_sync() { asm volatile("s_waitcnt lgkmcnt(0)" ::: "memory"); __builtin_amdgcn_wave_barrier(); }
DI float sigmoidf(float x) { return 1.f / (1.f + __expf(-x)); }
DI float siluf(float x) { return x / (1.f + __expf(-x)); }
DI float gelu_tanh(float x) { float u = 0.7978845608028654f * (x + 0.044715f * x * x * x); float e = __expf(2.f * u); float th = 1.f - 2.f / (e + 1.f); return 0.5f * x * (1.f + th); }


#define XB_TMO      128
#define XB_XCNT(j)  (256  + 64 * (j))
#define XB_XSUB(j)  (1280 + 64 * (j))
#define XB_XGEN(j)  (2304 + 64 * (j))
#define XB_TOP      3328
#define XB_TOPGEN   3392
#define XCD_BAR_WORDS 3456
#define XB_SPIN_CAP (1u << 22)
#define LAS __attribute__((address_space(3)))
DI unsigned xb_ld(unsigned* p) { return __hip_atomic_load(p, __ATOMIC_RELAXED, __HIP_MEMORY_SCOPE_AGENT); }
DI unsigned xb_add(unsigned* p, unsigned v) { return __hip_atomic_fetch_add(p, v, __ATOMIC_RELAXED, __HIP_MEMORY_SCOPE_AGENT); }
DI unsigned xb_xcc_id() { return (unsigned)__builtin_amdgcn_s_getreg((3 << 11) | 20) & 0xFu; }
#define XB_SPIN(cond, bar) do { unsigned _sp = 0; while (cond) { __builtin_amdgcn_s_sleep(1); \
    if ((++_sp & 255u) == 0u) { if (xb_ld(&(bar)[XB_TMO])) break; if (_sp > XB_SPIN_CAP) { atomicAdd(&(bar)[XB_TMO], 1u); break; } } } } while (0)
struct XcdBarrier { unsigned* bar; unsigned x; volatile LAS unsigned* st; };
DI XcdBarrier xcd_barrier_post(unsigned* bar, volatile LAS unsigned* st) {
  XcdBarrier b; b.bar = bar; b.x = xb_xcc_id(); b.st = st;
  if (threadIdx.x == 0) (void)xb_add(&bar[XB_XCNT(b.x)], 1u);
  return b;
}
DI void xcd_barrier_complete(unsigned* bar, unsigned x, unsigned& nloc, unsigned& nx) {
  const unsigned G = gridDim.x * gridDim.y * gridDim.z;
  unsigned sum, cnt, mine, sp = 0u;
  for (;;) {
    sum = 0u; cnt = 0u; mine = 0u;
#pragma unroll
    for (unsigned j = 0; j < 16; ++j) { const unsigned c = xb_ld(&bar[XB_XCNT(j)]); sum += c; cnt += (c > 0u) ? 1u : 0u; mine = (j == x) ? c : mine; }
    if (sum == G) break;
    __builtin_amdgcn_s_sleep(1);
    if ((++sp & 255u) == 0u) { if (xb_ld(&bar[XB_TMO])) break; if (sp > XB_SPIN_CAP) { atomicAdd(&bar[XB_TMO], 1u); break; } }
  }
  nloc = mine > 0u ? mine : 1u; nx = cnt > 0u ? cnt : 1u;
}
DI void xcd_barrier(const XcdBarrier& b) {
  asm volatile("s_waitcnt vmcnt(0)" ::: "memory");
  __syncthreads();
  if (threadIdx.x == 0) {
    unsigned* bar = b.bar;
    __builtin_amdgcn_s_waitcnt(0);
    unsigned nloc = b.st[0], nx = b.st[1];
    if (nloc == 0u) { xcd_barrier_complete(bar, b.x, nloc, nx); b.st[0] = nloc; b.st[1] = nx; }
    const unsigned old = xb_add(&bar[XB_XSUB(b.x)], 1u);
    const unsigned gen = old / nloc;
    if (old + 1u == (gen + 1u) * nloc) {
      __builtin_amdgcn_fence(__ATOMIC_RELEASE, "agent");
      asm volatile("s_waitcnt vmcnt(0)" ::: "memory");
      const unsigned og = xb_add(&bar[XB_TOP], 1u);
      const unsigned tg = og / nx;
      if (og + 1u == (tg + 1u) * nx) xb_add(&bar[XB_TOPGEN], 1u);
      else XB_SPIN(xb_ld(&bar[XB_TOPGEN]) == tg, bar);
      __builtin_amdgcn_fence(__ATOMIC_ACQUIRE, "agent");
      xb_add(&bar[XB_XGEN(b.x)], 1u);
      asm volatile("s_waitcnt vmcnt(0)" ::: "memory");
    } else {
      XB_SPIN(xb_ld(&bar[XB_XGEN(b.x)]) == gen, bar);
      __builtin_amdgcn_fence(__ATOMIC_ACQUIRE, "agent");
      asm volatile("s_waitcnt vmcnt(0)" ::: "memory");
    }
  }
  __syncthreads();
}

template <bool SWAP = true, bool SINGLE = false, bool BT16 = false, class AF, class BF, class EF>
DI void gemm_tile(char* smem, int nk, long a_kstep, const AF& af, const BF& bf, const EF& ef) {
  asm volatile("" ::: "memory");
  u16* As = (u16*)smem;
  const int tid = TIDX(), lane = tid & 63, wid = __builtin_amdgcn_readfirstlane(tid >> 6), wm = wid >> 1, wn = wid & 1;
  const int arow = tid >> 1, ahalf = tid & 1;
  const u16* ap = af(arow) + ahalf * 32;
  const int bkq = lane & 7, bnq = wid * 8 + (lane >> 3);
  const long ldb = bf.ldb;
  const float* bp = nullptr;
  const u16* bp16 = nullptr;
  if constexpr (BT16) bp16 = bf.row(arow) + ahalf * 32;
  else bp = bf(bnq * 4) + (long)(bkq * 4) * ldb;
  uint4 sa0_0, sa0_1, sa0_2, sa0_3, sa1_0, sa1_1, sa1_2, sa1_3;
  float4 sb0_0, sb0_1, sb0_2, sb0_3, sb0_4, sb0_5, sb0_6, sb0_7, sb1_0, sb1_1, sb1_2, sb1_3, sb1_4, sb1_5, sb1_6, sb1_7;
  uint4 tb0_0, tb0_1, tb0_2, tb0_3, tb1_0, tb1_1, tb1_2, tb1_3;
  f32x16 acc[2][2];
#pragma unroll
  for (int a = 0; a < 2; ++a)
#pragma unroll
    for (int b = 0; b < 2; ++b)
#pragma unroll
      for (int i = 0; i < 16; ++i) acc[a][b][i] = 0.f;

#define GEMM_LOAD(S, KT)                                                                  \
  {                                                                                       \
    const uint4* pa_ = (const uint4*)(ap + (long)(KT) * a_kstep);                         \
    sa##S##_0 = pa_[0]; sa##S##_1 = pa_[1]; sa##S##_2 = pa_[2]; sa##S##_3 = pa_[3];       \
    if constexpr (BT16) {                                                                 \
      const uint4* pt_ = (const uint4*)(bp16 + (long)(KT) * 64);                          \
      tb##S##_0 = pt_[0]; tb##S##_1 = pt_[1]; tb##S##_2 = pt_[2]; tb##S##_3 = pt_[3];     \
    } else {                                                                              \
      const float* pb_ = bp + (long)(KT) * 64 * ldb;                                      \
      sb##S##_0 = *(const float4*)(pb_);                                                  \
      sb##S##_1 = *(const float4*)(pb_ + ldb);                                            \
      sb##S##_2 = *(const float4*)(pb_ + 2 * ldb);                                        \
      sb##S##_3 = *(const float4*)(pb_ + 3 * ldb);                                        \
      sb##S##_4 = *(const float4*)(pb_ + 32 * ldb);                                       \
      sb##S##_5 = *(const float4*)(pb_ + 33 * ldb);                                       \
      sb##S##_6 = *(const float4*)(pb_ + 34 * ldb);                                       \
      sb##S##_7 = *(const float4*)(pb_ + 35 * ldb);                                       \
    }                                                                                     \
  }
#define GEMM_BW(V0, V1, V2, V3, C, I, QOFF)                                               \
  {                                                                                       \
    uint2 w_;                                                                             \
    w_.x = pack2(V0.C, V1.C);                                                             \
    w_.y = pack2(V2.C, V3.C);                                                             \
    *(uint2*)&Bs_[(bnq * 4 + (I)) * 72 + (QOFF) + bkq * 4] = w_;                          \
  }
#define GEMM_STORE(S, BUF)                                                                \
  {                                                                                       \
    u16* As_ = As + (BUF) * (2 * 128 * 72);                                               \
    u16* Bs_ = As_ + 128 * 72;                                                            \
    uint4* da_ = (uint4*)&As_[arow * 72 + ahalf * 32];                                    \
    da_[0] = sa##S##_0; da_[1] = sa##S##_1; da_[2] = sa##S##_2; da_[3] = sa##S##_3;       \
    if constexpr (BT16) {                                                                 \
      uint4* db_ = (uint4*)&Bs_[arow * 72 + ahalf * 32];                                  \
      db_[0] = tb##S##_0; db_[1] = tb##S##_1; db_[2] = tb##S##_2; db_[3] = tb##S##_3;     \
    } else {                                                                              \
      GEMM_BW(sb##S##_0, sb##S##_1, sb##S##_2, sb##S##_3, x, 0, 0)                        \
      GEMM_BW(sb##S##_0, sb##S##_1, sb##S##_2, sb##S##_3, y, 1, 0)                        \
      GEMM_BW(sb##S##_0, sb##S##_1, sb##S##_2, sb##S##_3, z, 2, 0)                        \
      GEMM_BW(sb##S##_0, sb##S##_1, sb##S##_2, sb##S##_3, w, 3, 0)                        \
      GEMM_BW(sb##S##_4, sb##S##_5, sb##S##_6, sb##S##_7, x, 0, 32)                       \
      GEMM_BW(sb##S##_4, sb##S##_5, sb##S##_6, sb##S##_7, y, 1, 32)                       \
      GEMM_BW(sb##S##_4, sb##S##_5, sb##S##_6, sb##S##_7, z, 2, 32)                       \
      GEMM_BW(sb##S##_4, sb##S##_5, sb##S##_6, sb##S##_7, w, 3, 32)                       \
    }                                                                                     \
  }
#define GEMM_COMPUTE(BUF)                                                                 \
  {                                                                                       \
    const u16* Ac = As + (BUF) * (2 * 128 * 72);                                          \
    const u16* Bc = Ac + 128 * 72;                                                        \
    _Pragma("unroll") for (int ks = 0; ks < 4; ++ks) {                                    \
      bf16x8 a[2], b[2];                                                                  \
      _Pragma("unroll") for (int mt = 0; mt < 2; ++mt) a[mt] = *(const bf16x8*)&Ac[(wm * 64 + mt * 32 + (lane & 31)) * 72 + ks * 16 + (lane >> 5) * 8]; \
      _Pragma("unroll") for (int nt = 0; nt < 2; ++nt) b[nt] = *(const bf16x8*)&Bc[(wn * 64 + nt * 32 + (lane & 31)) * 72 + ks * 16 + (lane >> 5) * 8]; \
      _Pragma("unroll") for (int mt = 0; mt < 2; ++mt)                                    \
      _Pragma("unroll") for (int nt = 0; nt < 2; ++nt)                                    \
        acc[mt][nt] = SWAP ? __builtin_amdgcn_mfma_f32_32x32x16_bf16(b[nt], a[mt], acc[mt][nt], 0, 0, 0) \
                           : __builtin_amdgcn_mfma_f32_32x32x16_bf16(a[mt], b[nt], acc[mt][nt], 0, 0, 0); \
    }                                                                                     \
  }
  GEMM_LOAD(0, 0)
  hb_sync();
  if (SINGLE) {
    GEMM_STORE(0, 0)
    hb_sync();
    GEMM_COMPUTE(0)
  } else {
    GEMM_LOAD(1, 1)
    GEMM_STORE(0, 0)
    hb_sync();
    const int last = nk - 1;
    for (int kt = 0; kt < nk; kt += 2) {
      const int k2 = kt + 2 < last ? kt + 2 : last, k3 = kt + 3 < last ? kt + 3 : last;
      GEMM_LOAD(0, k2)
      asm volatile("" ::: "memory");
      GEMM_COMPUTE(0)
      asm volatile("" ::: "memory");
      GEMM_STORE(1, 1)
      hb_sync();
      GEMM_LOAD(1, k3)
      asm volatile("" ::: "memory");
      GEMM_COMPUTE(1)
      asm volatile("" ::: "memory");
      GEMM_STORE(0, 0)
      hb_sync();
    }
  }
#undef GEMM_LOAD
#undef GEMM_STORE
#undef GEMM_BW
#undef GEMM_COMPUTE
  ef(acc, wm, wn, lane);
}

template <bool BT16, class AF, class BF, class EF>
DI void gemm_tile256(char* smem, int nk, const AF& af, const BF& bf, const EF& ef) {
  asm volatile("" ::: "memory");
  u16* As = (u16*)smem;
  u16* Bs = As + 256 * 72;
  const int tid = TIDX(), lane = tid & 63, wid = __builtin_amdgcn_readfirstlane(tid >> 6), wm = wid >> 1, wn = wid & 1;
  const int piece = tid & 7, rbase = tid >> 3;
  const u16* abase = af(0);
  int ao0, ao1, ao2, ao3, ao4, ao5, ao6, ao7;
  ao0 = (int)(af(rbase) - abase) + piece * 8;        ao1 = (int)(af(rbase + 32) - abase) + piece * 8;
  ao2 = (int)(af(rbase + 64) - abase) + piece * 8;   ao3 = (int)(af(rbase + 96) - abase) + piece * 8;
  ao4 = (int)(af(rbase + 128) - abase) + piece * 8;  ao5 = (int)(af(rbase + 160) - abase) + piece * 8;
  ao6 = (int)(af(rbase + 192) - abase) + piece * 8;  ao7 = (int)(af(rbase + 224) - abase) + piece * 8;
  const u16* bp16 = nullptr; long bstride = 0;
  const float* bp = nullptr; long ldb = 0;
  const int bkq = lane & 7, bnq = wid * 8 + (lane >> 3);
  if constexpr (BT16) { bp16 = bf.row(rbase) + piece * 8; bstride = bf.ldb * 32; }
  else { ldb = bf.ldb; bp = bf(bnq * 4) + (long)(bkq * 4) * ldb; }
  uint4 ra0, ra1, ra2, ra3, ra4, ra5, ra6, ra7, rb0, rb1, rb2, rb3;
  float4 fb0, fb1, fb2, fb3, fb4, fb5, fb6, fb7;
  f32x16 acc[4][2];
#pragma unroll
  for (int a = 0; a < 4; ++a)
#pragma unroll
    for (int b = 0; b < 2; ++b)
#pragma unroll
      for (int i = 0; i < 16; ++i) acc[a][b][i] = 0.f;
#define G256_LOAD(KT)                                                   \
  {                                                                     \
    const u16* pa_ = abase + (long)(KT) * 64;                           \
    ra0 = *(const uint4*)(pa_ + ao0); ra1 = *(const uint4*)(pa_ + ao1); \
    ra2 = *(const uint4*)(pa_ + ao2); ra3 = *(const uint4*)(pa_ + ao3); \
    ra4 = *(const uint4*)(pa_ + ao4); ra5 = *(const uint4*)(pa_ + ao5); \
    ra6 = *(const uint4*)(pa_ + ao6); ra7 = *(const uint4*)(pa_ + ao7); \
    if constexpr (BT16) {                                               \
      const u16* pb_ = bp16 + (long)(KT) * 64;                          \
      rb0 = *(const uint4*)(pb_);                                       \
      rb1 = *(const uint4*)(pb_ + bstride);                             \
      rb2 = *(const uint4*)(pb_ + 2 * bstride);                         \
      rb3 = *(const uint4*)(pb_ + 3 * bstride);                         \
    } else {                                                            \
      const float* pf_ = bp + (long)(KT) * 64 * ldb;                    \
      fb0 = *(const float4*)(pf_);            fb1 = *(const float4*)(pf_ + ldb);      \
      fb2 = *(const float4*)(pf_ + 2 * ldb);  fb3 = *(const float4*)(pf_ + 3 * ldb);  \
      fb4 = *(const float4*)(pf_ + 32 * ldb); fb5 = *(const float4*)(pf_ + 33 * ldb); \
      fb6 = *(const float4*)(pf_ + 34 * ldb); fb7 = *(const float4*)(pf_ + 35 * ldb); \
    }                                                                   \
  }
#define G256_BW(V0, V1, V2, V3, C, I, QOFF)                             \
  {                                                                     \
    uint2 w_;                                                           \
    w_.x = pack2(V0.C, V1.C);                                           \
    w_.y = pack2(V2.C, V3.C);                                           \
    *(uint2*)&Bs[(bnq * 4 + (I)) * 72 + (QOFF) + bkq * 4] = w_;         \
  }
  G256_LOAD(0)
  const int last = nk - 1;
  for (int kt = 0; kt < nk; ++kt) {
    hb_sync();
    {
      u16* da = As + rbase * 72 + piece * 8;
      *(uint4*)(da) = ra0;            *(uint4*)(da + 32 * 72) = ra1;  *(uint4*)(da + 64 * 72) = ra2;  *(uint4*)(da + 96 * 72) = ra3;
      *(uint4*)(da + 128 * 72) = ra4; *(uint4*)(da + 160 * 72) = ra5; *(uint4*)(da + 192 * 72) = ra6; *(uint4*)(da + 224 * 72) = ra7;
      if constexpr (BT16) {
        u16* db = Bs + rbase * 72 + piece * 8;
        *(uint4*)(db) = rb0; *(uint4*)(db + 32 * 72) = rb1; *(uint4*)(db + 64 * 72) = rb2; *(uint4*)(db + 96 * 72) = rb3;
      } else {
        G256_BW(fb0, fb1, fb2, fb3, x, 0, 0)  G256_BW(fb0, fb1, fb2, fb3, y, 1, 0)
        G256_BW(fb0, fb1, fb2, fb3, z, 2, 0)  G256_BW(fb0, fb1, fb2, fb3, w, 3, 0)
        G256_BW(fb4, fb5, fb6, fb7, x, 0, 32) G256_BW(fb4, fb5, fb6, fb7, y, 1, 32)
        G256_BW(fb4, fb5, fb6, fb7, z, 2, 32) G256_BW(fb4, fb5, fb6, fb7, w, 3, 32)
      }
    }
    hb_sync();
    const int kn = kt + 1 < last ? kt + 1 : last;
    G256_LOAD(kn)
    asm volatile("" ::: "memory");
#pragma unroll
    for (int ks = 0; ks < 4; ++ks) {
      bf16x8 a[4], b[2];
#pragma unroll
      for (int mt = 0; mt < 4; ++mt) a[mt] = *(const bf16x8*)&As[(wm * 128 + mt * 32 + (lane & 31)) * 72 + ks * 16 + (lane >> 5) * 8];
#pragma unroll
      for (int nt = 0; nt < 2; ++nt) b[nt] = *(const bf16x8*)&Bs[(wn * 64 + nt * 32 + (lane & 31)) * 72 + ks * 16 + (lane >> 5) * 8];
#pragma unroll
      for (int mt = 0; mt < 4; ++mt)
#pragma unroll
        for (int nt = 0; nt < 2; ++nt) acc[mt][nt] = __builtin_amdgcn_mfma_f32_32x32x16_bf16(b[nt], a[mt], acc[mt][nt], 0, 0, 0);
    }
    asm volatile("" ::: "memory");
  }
#undef G256_LOAD
#undef G256_BW
  ef(acc, wm, wn, lane);
}

template <bool BT16, class AF, class BF, class EF>
DI void gemm8w(int nk, const AF& af, const BF& bf, const EF& ef) {
  asm volatile("" ::: "memory");
  u16* S0 = (u16*)g_smem;
  int tid = threadIdx.x; asm volatile("" : "+v"(tid));
  const int lane = tid & 63, wid = __builtin_amdgcn_readfirstlane(tid >> 6), wm = wid >> 2, wn = wid & 3;
  const int piece = tid & 7, rbase = tid >> 3;
  const u16* abase = af.origin();
  const int ao0 = af.off(rbase) + piece * 8, ao1 = af.off(rbase + 64) + piece * 8, ao2 = af.off(rbase + 128) + piece * 8, ao3 = af.off(rbase + 192) + piece * 8;
  const u16 *bq0 = nullptr, *bq1 = nullptr, *bq2 = nullptr, *bq3 = nullptr;
  const float* bp = nullptr; long ldb = 0;
  const int bkq = lane & 7, bnq = wid * 8 + (lane >> 3);
  if constexpr (BT16) { bq0 = bf.row(rbase) + piece * 8; bq1 = bf.row(rbase + 64) + piece * 8; bq2 = bf.row(rbase + 128) + piece * 8; bq3 = bf.row(rbase + 192) + piece * 8; }
  else { ldb = bf.ldb; bp = bf(bnq * 4) + (long)(bkq * 4) * ldb; }
  uint4 ra0, ra1, ra2, ra3, rb0, rb1, rb2, rb3;
  float4 fb0, fb1, fb2, fb3, fb4, fb5, fb6, fb7;
  f32x16 acc[4][2];
#pragma unroll
  for (int a = 0; a < 4; ++a)
#pragma unroll
    for (int b = 0; b < 2; ++b)
#pragma unroll
      for (int i = 0; i < 16; ++i) acc[a][b][i] = 0.f;
#define G8_LOAD(KT)                                                     \
  {                                                                     \
    const u16* pa_ = abase + (long)(KT) * 64;                           \
    ra0 = *(const uint4*)(pa_ + ao0); ra1 = *(const uint4*)(pa_ + ao1); \
    ra2 = *(const uint4*)(pa_ + ao2); ra3 = *(const uint4*)(pa_ + ao3); \
    if constexpr (BT16) {                                               \
      rb0 = *(const uint4*)(bq0 + (long)(KT) * 64); rb1 = *(const uint4*)(bq1 + (long)(KT) * 64); \
      rb2 = *(const uint4*)(bq2 + (long)(KT) * 64); rb3 = *(const uint4*)(bq3 + (long)(KT) * 64); \
    } else {                                                            \
      const float* pf_ = bp + (long)(KT) * 64 * ldb;                    \
      fb0 = *(const float4*)(pf_);            fb1 = *(const float4*)(pf_ + ldb);      \
      fb2 = *(const float4*)(pf_ + 2 * ldb);  fb3 = *(const float4*)(pf_ + 3 * ldb);  \
      fb4 = *(const float4*)(pf_ + 32 * ldb); fb5 = *(const float4*)(pf_ + 33 * ldb); \
      fb6 = *(const float4*)(pf_ + 34 * ldb); fb7 = *(const float4*)(pf_ + 35 * ldb); \
    }                                                                   \
  }
#define G8_BW(V0, V1, V2, V3, C, I, QOFF)                               \
  {                                                                     \
    uint2 w_;                                                           \
    w_.x = pack2(V0.C, V1.C);                                           \
    w_.y = pack2(V2.C, V3.C);                                           \
    *(uint2*)&Bs_[(bnq * 4 + (I)) * 72 + (QOFF) + bkq * 4] = w_;        \
  }
#define G8_STORE(BUF)                                                   \
  {                                                                     \
    u16* As_ = S0 + (BUF) * (512 * 72);                                 \
    u16* Bs_ = As_ + 256 * 72;                                          \
    u16* da = As_ + rbase * 72 + piece * 8;                             \
    *(uint4*)(da) = ra0; *(uint4*)(da + 64 * 72) = ra1; *(uint4*)(da + 128 * 72) = ra2; *(uint4*)(da + 192 * 72) = ra3; \
    if constexpr (BT16) {                                               \
      u16* db = Bs_ + rbase * 72 + piece * 8;                           \
      *(uint4*)(db) = rb0; *(uint4*)(db + 64 * 72) = rb1; *(uint4*)(db + 128 * 72) = rb2; *(uint4*)(db + 192 * 72) = rb3; \
    } else {                                                            \
      G8_BW(fb0, fb1, fb2, fb3, x, 0, 0)  G8_BW(fb0, fb1, fb2, fb3, y, 1, 0)   \
      G8_BW(fb0, fb1, fb2, fb3, z, 2, 0)  G8_BW(fb0, fb1, fb2, fb3, w, 3, 0)   \
      G8_BW(fb4, fb5, fb6, fb7, x, 0, 32) G8_BW(fb4, fb5, fb6, fb7, y, 1, 32)  \
      G8_BW(fb4, fb5, fb6, fb7, z, 2, 32) G8_BW(fb4, fb5, fb6, fb7, w, 3, 32)  \
    }                                                                   \
  }
  G8_LOAD(0)
  __syncthreads();
  G8_STORE(0)
  __syncthreads();
  const int last = nk - 1;
  for (int kt = 0; kt < nk; ++kt) {
    const int kn = kt + 1 < last ? kt + 1 : last;
    G8_LOAD(kn)
    asm volatile("" ::: "memory");
    {
      const u16* Ac = S0 + (kt & 1) * (512 * 72);
      const u16* Bc = Ac + 256 * 72;
#pragma unroll
      for (int ks = 0; ks < 4; ++ks) {
        bf16x8 a[4], b[2];
#pragma unroll
        for (int mt = 0; mt < 4; ++mt) a[mt] = *(const bf16x8*)&Ac[(wm * 128 + mt * 32 + (lane & 31)) * 72 + ks * 16 + (lane >> 5) * 8];
#pragma unroll
        for (int nt = 0; nt < 2; ++nt) b[nt] = *(const bf16x8*)&Bc[(wn * 64 + nt * 32 + (lane & 31)) * 72 + ks * 16 + (lane >> 5) * 8];
#pragma unroll
        for (int mt = 0; mt < 4; ++mt)
#pragma unroll
          for (int nt = 0; nt < 2; ++nt) acc[mt][nt] = __builtin_amdgcn_mfma_f32_32x32x16_bf16(b[nt], a[mt], acc[mt][nt], 0, 0, 0);
      }
    }
    asm volatile("" ::: "memory");
    if (kt + 1 < nk) {
      G8_STORE((kt + 1) & 1)
      __syncthreads();
    }
  }
#undef G8_LOAD
#undef G8_BW
#undef G8_STORE
  ef(acc, wm, wn, lane);
}

DI void st_stage_rc(int b, int& R, int& C) {
  const int st = b >> 10, sb = b & 1023, swz = sb ^ (((sb >> 9) & 1) << 5);
  R = (st >> 1) * 16 + (swz >> 6); C = (st & 1) * 32 + ((swz & 63) >> 1);
}
template <class PF, class QF, class EF>
DI void gemm8p(int nt, const PF& pf, const QF& qf, const EF& ef) {
  asm volatile("" ::: "memory");
  constexpr int HTB = 128 * 64 * 2;
  int tid = threadIdx.x; asm volatile("" : "+v"(tid));
  const int lane = tid & 63, wid = __builtin_amdgcn_readfirstlane(tid >> 6), wr = wid >> 2, wc = wid & 3, fr = lane & 15, fq = lane >> 4;
  int r0, c0, r1, c1;
  st_stage_rc(tid * 16, r0, c0);
  st_stage_rc(tid * 16 + 8192, r1, c1);
  const u16* pbase = pf.origin();
  const u16* qbase = qf.origin();
  const unsigned po00 = (unsigned)(pf.off(r0) + c0) * 2u, po01 = (unsigned)(pf.off(r1) + c1) * 2u;
  const unsigned po10 = (unsigned)(pf.off(128 + r0) + c0) * 2u, po11 = (unsigned)(pf.off(128 + r1) + c1) * 2u;
  const unsigned qo00 = (unsigned)(qf.off(r0) + c0) * 2u, qo01 = (unsigned)(qf.off(r1) + c1) * 2u;
  const unsigned qo10 = (unsigned)(qf.off(128 + r0) + c0) * 2u, qo11 = (unsigned)(qf.off(128 + r1) + c1) * 2u;
  const unsigned sdst = (unsigned)__builtin_amdgcn_readfirstlane((int)((unsigned)(size_t)g_smem + (unsigned)(tid & ~63) * 16u));
  const int laneoff = (fr * 64 + fq * 16) ^ ((fr >> 3) << 5);
  const char* rdP = g_smem + wr * 8192 + laneoff;
  const char* rdQ = g_smem + 4 * HTB + wc * 4096 + laneoff;
#define G8P_ST(SLOT, BASE, O0, O1, KT)                                                                                     \
  {                                                                                                                        \
    const char* g_ = (const char*)(BASE) + (long)(KT) * 128;                                                               \
    __builtin_amdgcn_global_load_lds((const unsigned*)(g_ + (O0)), (LAS unsigned*)(size_t)(sdst + (SLOT) * HTB), 16, 0, 0);          \
    __builtin_amdgcn_global_load_lds((const unsigned*)(g_ + (O1)), (LAS unsigned*)(size_t)(sdst + (SLOT) * HTB + 8192), 16, 0, 0);   \
  }
#define G8P_STP(b, h, KT) { if ((h) == 0) G8P_ST((b) * 2, pbase, po00, po01, KT) else G8P_ST((b) * 2 + 1, pbase, po10, po11, KT) }
#define G8P_STQ(b, h, KT) { if ((h) == 0) G8P_ST(4 + (b) * 2, qbase, qo00, qo01, KT) else G8P_ST(4 + (b) * 2 + 1, qbase, qo10, qo11, KT) }
#define G8P_LDP(b, h)                                                                                                      \
  _Pragma("unroll") for (int m = 0; m < 4; ++m) _Pragma("unroll") for (int k = 0; k < 2; ++k)                              \
    Pt[m][k] = *(const bf16x8*)(rdP + ((b) * 2 + (h)) * HTB + m * 2048 + k * 1024);
#define G8P_LDQ(dst, b, h)                                                                                                 \
  _Pragma("unroll") for (int n = 0; n < 2; ++n) _Pragma("unroll") for (int k = 0; k < 2; ++k)                              \
    dst[n][k] = *(const bf16x8*)(rdQ + ((b) * 2 + (h)) * HTB + n * 2048 + k * 1024);
#define G8P_MMA(ai, bj, QT)                                                                                                \
  {                                                                                                                        \
    __builtin_amdgcn_s_setprio(1);                                                                                         \
    _Pragma("unroll") for (int m = 0; m < 4; ++m) _Pragma("unroll") for (int n = 0; n < 2; ++n)                            \
      _Pragma("unroll") for (int k = 0; k < 2; ++k)                                                                        \
        acc[ai][bj][m][n] = __builtin_amdgcn_mfma_f32_16x16x32_bf16(Pt[m][k], QT[n][k], acc[ai][bj][m][n], 0, 0, 0);       \
    __builtin_amdgcn_s_setprio(0);                                                                                         \
  }
#define G8P_WV(n) asm volatile("s_waitcnt vmcnt(" #n ")" ::: "memory")
#define G8P_WL(n) asm volatile("s_waitcnt lgkmcnt(" #n ")" ::: "memory")
#define G8P_BAR __builtin_amdgcn_s_barrier()
#define G8P_SCHED __builtin_amdgcn_sched_barrier(0)
  f32x4 acc[2][2][4][2];
#pragma unroll
  for (int a = 0; a < 2; ++a)
#pragma unroll
    for (int b = 0; b < 2; ++b)
#pragma unroll
      for (int m = 0; m < 4; ++m)
#pragma unroll
        for (int n = 0; n < 2; ++n) acc[a][b][m][n] = (f32x4){0.f, 0.f, 0.f, 0.f};
  bf16x8 Pt[4][2], Q0[2][2], Q1[2][2];
  __syncthreads();
  G8P_STQ(0, 0, 0) G8P_STP(0, 0, 0) G8P_STQ(0, 1, 0) G8P_STP(0, 1, 0)
  if (wr == 1) G8P_BAR;
  G8P_WV(4); G8P_BAR;
  G8P_STQ(1, 0, 1) G8P_STP(1, 0, 1) G8P_STQ(1, 1, 1)
  G8P_WV(6); G8P_BAR;
  for (int t = 0; t < nt - 2; t += 2) {
    G8P_LDQ(Q0, 0, 0) G8P_SCHED; G8P_LDP(0, 0) G8P_STP(1, 1, t + 1)
    G8P_WL(8); G8P_BAR; G8P_WL(0); G8P_MMA(0, 0, Q0) G8P_BAR; G8P_SCHED;
    G8P_LDQ(Q1, 0, 1) G8P_STQ(0, 0, t + 2)
    G8P_BAR; G8P_WL(0); G8P_MMA(0, 1, Q1) G8P_BAR;
    G8P_LDP(0, 1) G8P_STP(0, 0, t + 2)
    G8P_BAR; G8P_WL(0); G8P_MMA(1, 0, Q0) G8P_BAR; G8P_SCHED;
    G8P_STQ(0, 1, t + 2)
    G8P_WV(6); G8P_BAR; G8P_MMA(1, 1, Q1) G8P_BAR;
    G8P_LDQ(Q0, 1, 0) G8P_SCHED; G8P_LDP(1, 0) G8P_STP(0, 1, t + 2)
    G8P_WL(8); G8P_BAR; G8P_WL(0); G8P_MMA(0, 0, Q0) G8P_BAR; G8P_SCHED;
    G8P_LDQ(Q1, 1, 1) G8P_STQ(1, 0, t + 3)
    G8P_BAR; G8P_WL(0); G8P_MMA(0, 1, Q1) G8P_BAR;
    G8P_LDP(1, 1) G8P_STP(1, 0, t + 3)
    G8P_BAR; G8P_WL(0); G8P_MMA(1, 0, Q0) G8P_BAR; G8P_SCHED;
    G8P_STQ(1, 1, t + 3)
    G8P_WV(6); G8P_BAR; G8P_MMA(1, 1, Q1) G8P_BAR;
  }
  {
    G8P_LDQ(Q0, 0, 0) G8P_LDP(0, 0) G8P_STP(1, 1, nt - 1)
    G8P_BAR; G8P_WL(0); G8P_MMA(0, 0, Q0) G8P_BAR;
    G8P_LDQ(Q1, 0, 1) G8P_BAR; G8P_WL(0); G8P_MMA(0, 1, Q1) G8P_BAR;
    G8P_LDP(0, 1) G8P_WV(4); G8P_BAR; G8P_WL(0); G8P_MMA(1, 0, Q0) G8P_MMA(1, 1, Q1) G8P_BAR;
  }
  {
    G8P_LDQ(Q0, 1, 0) G8P_LDP(1, 0) G8P_WV(2); G8P_BAR; G8P_WL(0); G8P_MMA(0, 0, Q0) G8P_BAR;
    G8P_LDQ(Q1, 1, 1) G8P_WV(0); G8P_BAR; G8P_WL(0); G8P_MMA(0, 1, Q1) G8P_BAR;
    G8P_LDP(1, 1) G8P_BAR; G8P_WL(0); G8P_MMA(1, 0, Q0) G8P_MMA(1, 1, Q1) G8P_BAR;
  }
  if (wr == 0) G8P_BAR;
#undef G8P_ST
#undef G8P_STP
#undef G8P_STQ
#undef G8P_LDP
#undef G8P_LDQ
#undef G8P_MMA
#undef G8P_WV
#undef G8P_WL
#undef G8P_BAR
#undef G8P_SCHED
#pragma unroll
  for (int ai = 0; ai < 2; ++ai)
#pragma unroll
    for (int bj = 0; bj < 2; ++bj)
#pragma unroll
      for (int m = 0; m < 4; ++m)
#pragma unroll
        for (int n = 0; n < 2; ++n)
          ef(bj * 128 + wc * 32 + n * 16 + fr, ai * 128 + wr * 64 + m * 16 + fq * 4, acc[ai][bj][m][n][0], acc[ai][bj][m][n][1], acc[ai][bj][m][n][2], acc[ai][bj][m][n][3]);
}

#define EPI_FOR                                                   \
  _Pragma("unroll") for (int mt = 0; mt < 2; ++mt)                \
  _Pragma("unroll") for (int nt = 0; nt < 2; ++nt)                \
  _Pragma("unroll") for (int i = 0; i < 16; ++i)
#define EPI_R (wm * 64 + mt * 32 + (i & 3) + 8 * (i >> 2) + 4 * (lane >> 5))
#define EPI_C (wn * 64 + nt * 32 + (lane & 31))
#define SW_FOR                                                    \
  _Pragma("unroll") for (int mt = 0; mt < MT; ++mt)               \
  _Pragma("unroll") for (int nt = 0; nt < 2; ++nt)                \
  _Pragma("unroll") for (int q4 = 0; q4 < 4; ++q4)
#define SW_R (wm * (32 * MT) + mt * 32 + (lane & 31))
#define SW_C0 (wn * 64 + nt * 32 + 8 * q4 + 4 * (lane >> 5))
#define SW_V(j) acc[mt][nt][4 * q4 + (j)]
DI uint2 pack4(float a, float b, float c, float d) { uint2 w; w.x = pack2(a, b); w.y = pack2(c, d); return w; }

struct ARows { const u16* base; long ld; int nrows; DI const u16* operator()(int r) const { return base + (long)(r < nrows ? r : 0) * ld; }
  DI const u16* origin() const { return base; } DI int off(int r) const { return (r < nrows ? r : 0) * (int)ld; } };
struct BMat { const float* base; long ldb; int ncols; DI const float* operator()(int c4) const { return base + (c4 < ncols ? c4 : 0); } DI const u16* row(int) const { return nullptr; } };
struct BMatT { const u16* base; long ldb; DI const float* operator()(int) const { return nullptr; } DI const u16* row(int n) const { return base + (long)n * ldb; } };

DI void phase0(const Params& p, char* smem, int bid, int nblk) {
  const int tid = TIDX();
  for (int item = bid; item < 384 + 256 + 16 + 1 + 1728; item += nblk) {
    if (item < 384) {
      const int cc = item % 24, kc = item / 24;
      const int col = cc * 256 + tid;
      float a0 = 0.f, a1 = 0.f;
#pragma unroll 1
      for (int half = 0; half < 2; ++half) {
        const int k0 = kc * 64 + half * 32;
        float w[32];
#pragma unroll
        for (int j = 0; j < 32; ++j) w[j] = p.w_ada[(long)(k0 + j) * 6144 + col];
#pragma unroll
        for (int j = 0; j < 32; ++j) {
          a0 += siluf(p.c[k0 + j]) * w[j];
          a1 += siluf(p.c[1024 + k0 + j]) * w[j];
        }
      }
      p.modp[(kc * 2 + 0) * 6144 + col] = a0;
      p.modp[(kc * 2 + 1) * 6144 + col] = a1;
    } else if (item < 640) {
      const int idx = (item - 384) * 256 + tid;
      const int c = idx & 127, d = (idx >> 7) & 63, h = idx >> 13;
      p.w_ukT[idx] = p.dsa_w_uk[c * 512 + h * 64 + d];
    } else if (item < 656) {
      const int part = item - 640;
      const int slot = tid >> 7, kk = tid & 127;
      float a = 0.f;
      for (int ld = part * 128; ld < part * 128 + 128; ++ld) a += p.cmp_pe[slot * 2048 + ld] * p.cmp_w1[((long)slot * 2048 + ld) * 128 + kk];
      p.pe_part[part * 256 + tid] = a;
    } else if (item == 656) {
      p.counts[tid] = 0;
    } else {
      int it = item - 657;
      const float* W; u16* WT; int K, N, ntn;
      if (it < 1152) { W = p.w_in; WT = p.w_inT; K = 1024; N = LDP; ntn = 72; }
      else if (it < 1280) { it -= 1152; W = p.w_bn; WT = p.w_bnT; K = 512; N = 1024; ntn = 16; }
      else if (it < 1408) { it -= 1280; W = p.w_bd; WT = p.w_bdT; K = 512; N = 1024; ntn = 16; }
      else if (it < 1664) { it -= 1408; W = p.w_out; WT = p.w_outT; K = 1024; N = 1024; ntn = 16; }
      else { it -= 1664; W = p.router_w; WT = p.routerT; K = 1024; N = 256; ntn = 4; }
      const int k0 = (it / ntn) * 64, n0 = (it % ntn) * 64;
      u16* tl = (u16*)smem;
      hb_sync();
      const int kr = tid >> 4, nq = tid & 15;
#pragma unroll
      for (int ps = 0; ps < 4; ++ps) {
        const int k = kr + 16 * ps, n = n0 + nq * 4;
        float4 v = make_float4(0.f, 0.f, 0.f, 0.f);
        if (n < N) v = *(const float4*)(W + (long)(k0 + k) * N + n);
        tl[(nq * 4 + 0) * 72 + k] = f2bf(v.x);
        tl[(nq * 4 + 1) * 72 + k] = f2bf(v.y);
        tl[(nq * 4 + 2) * 72 + k] = f2bf(v.z);
        tl[(nq * 4 + 3) * 72 + k] = f2bf(v.w);
      }
      hb_sync();
      const int nr = tid >> 2, piece = tid & 3;
      const uint4 a = *(const uint4*)(tl + nr * 72 + piece * 16);
      const uint4 b = *(const uint4*)(tl + nr * 72 + piece * 16 + 8);
      uint4* dst = (uint4*)(WT + (long)(n0 + nr) * K + k0 + piece * 16);
      dst[0] = a; dst[1] = b;
    }
  }
}

DI void phase1(const Params& p, char* smem, int bid, int nblk) {
  const int tid = TIDX(), lane = tid & 63, wid = __builtin_amdgcn_readfirstlane(tid >> 6);
  float* modl = (float*)smem;
  const int b = bid & 1;
#pragma unroll
  for (int i0 = 0; i0 < 8; i0 += 4) {
    float v[4];
#pragma unroll
    for (int ii = 0; ii < 4; ++ii) v[ii] = p.b_ada[tid + 256 * (i0 + ii)];
#pragma unroll
    for (int kc = 0; kc < 16; ++kc)
#pragma unroll
      for (int ii = 0; ii < 4; ++ii) v[ii] += p.modp[(kc * 2 + b) * 6144 + tid + 256 * (i0 + ii)];
#pragma unroll
    for (int ii = 0; ii < 4; ++ii) modl[tid + 256 * (i0 + ii)] = v[ii];
  }
  if (bid < 48) {
    const int idx = bid * 256 + tid;
    const int bb = idx / 6144, n = idx % 6144;
    float v = p.b_ada[n];
#pragma unroll
    for (int kc = 0; kc < 16; ++kc) v += p.modp[(kc * 2 + bb) * 6144 + n];
    p.mod[idx] = v;
  }
  hb_sync();
  float cm[16], ca[16];
#pragma unroll
  for (int i = 0; i < 4; ++i) {
    const int col = i * 256 + lane * 4;
    const float4 g = *(const float4*)(p.g_pre_mix + col);
    const float4 sh = *(const float4*)(modl + col), sc = *(const float4*)(modl + 1024 + col);
    cm[i * 4 + 0] = g.x * (1.f + sc.x); cm[i * 4 + 1] = g.y * (1.f + sc.y); cm[i * 4 + 2] = g.z * (1.f + sc.z); cm[i * 4 + 3] = g.w * (1.f + sc.w);
    ca[i * 4 + 0] = sh.x; ca[i * 4 + 1] = sh.y; ca[i * 4 + 2] = sh.z; ca[i * 4 + 3] = sh.w;
  }
  const int stride = (nblk >> 1) * 4;
  for (int t0 = (bid >> 1) * 4 + wid; t0 < T; t0 += 4 * stride) {
    float4 v[4][4];
#pragma unroll
    for (int k = 0; k < 4; ++k) {
      const int t = t0 + k * stride < T ? t0 + k * stride : T - 1;
      const float* xr = p.x + ((long)b * T + t) * 1024;
#pragma unroll
      for (int i = 0; i < 4; ++i) v[k][i] = *(const float4*)(xr + i * 256 + lane * 4);
    }
#pragma unroll
    for (int k = 0; k < 4; ++k) {
      float ss = 0.f;
#pragma unroll
      for (int i = 0; i < 4; ++i) ss += v[k][i].x * v[k][i].x + v[k][i].y * v[k][i].y + v[k][i].z * v[k][i].z + v[k][i].w * v[k][i].w;
      ss = wave_sum(ss);
      const float r = rsqrtf(ss * (1.f / 1024.f) + 1e-6f);
      if (t0 + k * stride < T) {
        u16* hr = p.h + ((long)b * T + t0 + k * stride) * 1024;
#pragma unroll
        for (int i = 0; i < 4; ++i) {
          const float o0 = v[k][i].x * r * cm[i * 4 + 0] + ca[i * 4 + 0];
          const float o1 = v[k][i].y * r * cm[i * 4 + 1] + ca[i * 4 + 1];
          const float o2 = v[k][i].z * r * cm[i * 4 + 2] + ca[i * 4 + 2];
          const float o3 = v[k][i].w * r * cm[i * 4 + 3] + ca[i * 4 + 3];
          *(uint2*)(hr + i * 256 + lane * 4) = pack4(o0, o1, o2, o3);
        }
      }
    }
  }
}

struct EpiProj {
  u16* proj; float* widx; int m0, n0;
  template <int MT> DI void operator()(f32x16 (&acc)[MT][2], int wm, int wn, int lane) const {
    SW_FOR {
      const int r = m0 + SW_R, c = n0 + SW_C0;
      if (c < LDP) {
        float v[4] = {SW_V(0), SW_V(1), SW_V(2), SW_V(3)};
        if (c < C_KV) { for (int j = 0; j < 4; ++j) v[j] *= 0.125f; }
        else if (c < C_GN) {}
        else if (c < C_QD) { for (int j = 0; j < 4; ++j) v[j] = sigmoidf(v[j]); }
        else if (c < C_QI) {}
        else if (c < C_KI) { for (int j = 0; j < 4; ++j) v[j] *= 0.125f; }
        else if (c < C_WI) {}
        else if (c < C_GM) {
          for (int j = 0; j < 4; ++j) v[j] *= 0.35355339059327373f;
          *(float4*)(widx + (long)r * 8 + (c - C_WI)) = make_float4(v[0], v[1], v[2], v[3]);
        } else { for (int j = 0; j < 4; ++j) v[j] = sigmoidf(v[j]); }
        *(uint2*)(proj + (long)r * LDP + c) = pack4(v[0], v[1], v[2], v[3]);
      }
    }
  }
};
struct EpiProjVT {
  u16* vt; int m0;
  DI void operator()(f32x16 (&acc)[2][2], int wm, int wn, int lane) const {
#pragma unroll
    for (int mt = 0; mt < 2; ++mt)
#pragma unroll
      for (int nt = 0; nt < 2; ++nt) {
        const int cc = EPI_C;
#pragma unroll
        for (int q4 = 0; q4 < 4; ++q4) {
          const int r = m0 + wm * 64 + mt * 32 + 8 * q4 + 4 * (lane >> 5);
          const int b = r >> 13, t = r & 8191;
          uint2 w;
          w.x = pack2(acc[mt][nt][q4 * 4 + 0], acc[mt][nt][q4 * 4 + 1]);
          w.y = pack2(acc[mt][nt][q4 * 4 + 2], acc[mt][nt][q4 * 4 + 3]);
          *(uint2*)(vt + ((long)(b * 128 + cc)) * T + t) = w;
        }
      }
  }
};
DI int proj_group(int q) { return q < 7 ? q : (q < 8 ? q + 1 : q + 2); }
DI void proj_store4(u16* proj, float* widx, long r, int c, float v0, float v1, float v2, float v3) {
  if (c < LDP) {
    float v[4] = {v0, v1, v2, v3};
    if (c < C_KV) { for (int j = 0; j < 4; ++j) v[j] *= 0.125f; }
    else if (c < C_GN) {}
    else if (c < C_QD) { for (int j = 0; j < 4; ++j) v[j] = sigmoidf(v[j]); }
    else if (c < C_QI) {}
    else if (c < C_KI) { for (int j = 0; j < 4; ++j) v[j] *= 0.125f; }
    else if (c < C_WI) {}
    else if (c < C_GM) {
      for (int j = 0; j < 4; ++j) v[j] *= 0.35355339059327373f;
      *(float4*)(widx + r * 8 + (c - C_WI)) = make_float4(v[0], v[1], v[2], v[3]);
    } else { for (int j = 0; j < 4; ++j) v[j] = sigmoidf(v[j]); }
    *(uint2*)(proj + r * LDP + c) = pack4(v[0], v[1], v[2], v[3]);
  }
}
struct WRows2 { const u16* base; int ra, rb; DI const u16* origin() const { return base; } DI int off(int r) const { return ((r < 128 ? ra : rb) + (r & 127)) * 1024; } };
struct Epi8Proj {
  u16* proj; float* widx; int m0, n0a, n0b;
  DI void operator()(int q, int c, float v0, float v1, float v2, float v3) const {
    proj_store4(proj, widx, m0 + q, (c < 128 ? n0a : n0b) + (c & 127), v0, v1, v2, v3);
  }
};
struct Epi8ProjVT {
  u16* vts; u16* vtw; int m0;
  DI void operator()(int q, int c, float v0, float v1, float v2, float v3) const {
    const int r = m0 + c, b = r >> 13, t = r & 8191;
    u16* vt = q < 128 ? vts : vtw;
    *(uint2*)(vt + ((long)(b * 128 + (q & 127))) * T + t) = pack4(v0, v1, v2, v3);
  }
};
DI void phase2_8w(const Params& p, int wg, int nwg) {
  for (int i = wg; i < 1280; i += nwg) {
    const int x_ = i & 7, s_ = (i >> 3) & 31, blk = (i >> 8) * 8 + x_;
    if (blk >= 36) continue;
    const int nb = blk % 9, mb = blk / 9;
    const int mt_ = mb * 16 + (s_ >> 1), v = 2 * nb + (s_ & 1);
    ARows tf{p.h + (long)mt_ * 256 * 1024, 1024, 256};
    if (v < 17) {
      const int ga = proj_group(2 * v), gb = proj_group(2 * v + 1);
      WRows2 wf{p.w_inT, ga * 128, gb * 128};
      Epi8Proj ef{p.proj, p.widx, mt_ * 256, ga * 128, gb * 128};
      gemm8p(16, wf, tf, ef);
    } else {
      WRows2 wf{p.w_inT, 7 * 128, 9 * 128};
      Epi8ProjVT ef{p.vts, p.vtw, mt_ * 256};
      gemm8p(16, tf, wf, ef);
    }
  }
}
DI void phase2(const Params& p, char* smem, int bid, int nblk) {}

struct ACmp {
  const u16* proj; int slot, m0;
  DI const u16* operator()(int r) const {
    const int R = m0 + r, bg = R >> 9, n = R & 511, b = bg >> 1, g = bg & 1;
    const int nc = n >= 511 ? 510 : n;
    return proj + ((long)b * T + 16 * nc) * LDP + C_KV + slot * 128 + g * 64;
  }
};
struct EpiCmp1 {
  u16* zc; const float* b1; const float* pe_part; int slot, m0;
  DI void operator()(f32x16 (&acc)[2][2], int wm, int wn, int lane) const {
    constexpr int MT = 2;
#pragma unroll
    for (int nt = 0; nt < 2; ++nt)
#pragma unroll
      for (int q4 = 0; q4 < 4; ++q4) {
        const int c = SW_C0;
        float4 bias = *(const float4*)(b1 + slot * 128 + c);
        for (int q = 0; q < 16; ++q) {
          const float4 t = *(const float4*)(pe_part + q * 256 + slot * 128 + c);
          bias.x += t.x; bias.y += t.y; bias.z += t.z; bias.w += t.w;
        }
#pragma unroll
        for (int mt = 0; mt < 2; ++mt) {
          const int R = m0 + SW_R;
          *(uint2*)(zc + ((long)slot * 2048 + R) * 128 + c) =
              pack4(gelu_tanh(SW_V(0) + bias.x), gelu_tanh(SW_V(1) + bias.y), gelu_tanh(SW_V(2) + bias.z), gelu_tanh(SW_V(3) + bias.w));
        }
      }
  }
};
struct EpiQlat {
  u16* qlat; int h, m0;
  DI void operator()(f32x16 (&acc)[2][2], int wm, int wn, int lane) const {
    constexpr int MT = 2;
    SW_FOR {
      const int r = m0 + SW_R, c = SW_C0;
      *(uint2*)(qlat + ((long)r * 8 + h) * 128 + c) = pack4(SW_V(0) * 0.125f, SW_V(1) * 0.125f, SW_V(2) * 0.125f, SW_V(3) * 0.125f);
    }
  }
};
DI void indexer_item(const Params& p, char* smem, int item);
DI void phase3(const Params& p, char* smem, int bid, int nblk) {
  const int tid = TIDX(), lane = tid & 63, wid = __builtin_amdgcn_readfirstlane(tid >> 6);
  if (bid < 32) {
    const int slot = bid >> 4, mt_ = bid & 15;
    ACmp af{p.proj, slot, mt_ * 128};
    BMat bf{p.cmp_w1 + (long)slot * 2048 * 128, 128, 128};
    EpiCmp1 ef{p.zc, p.cmp_b1, p.pe_part, slot, mt_ * 128};
    gemm_tile(smem, 32, LDP, af, bf, ef);
    return;
  }
  for (int item = bid - 32; item < 4160 + 1024 + 512; item += nblk - 32) {
    hb_sync();
    if (item < 4160) {
      indexer_item(p, smem, item);
    } else if (item < 4160 + 1024) {
      const int it = item - 4160, h = it & 7, mt_ = it >> 3;
      ARows af{p.proj + (long)mt_ * 128 * LDP + C_QD + h * 64, LDP, 128};
      BMat bf{p.w_ukT + h * 64 * 128, 128, 128};
      EpiQlat ef{p.qlat, h, mt_ * 128};
      gemm_tile<true, true>(smem, 1, 64, af, bf, ef);
    } else {
      const int it = item - 4160 - 1024;
      for (int q = 0; q < 8; ++q) {
        const int row = it * 32 + wid * 8 + q;
        const unsigned u = *(const unsigned*)(p.proj + (long)row * LDP + C_CKV + lane * 2);
        const float a = lo16(u), b = hi16(u);
        const float ss = wave_sum(a * a + b * b);
        const float r = rsqrtf(ss * (1.f / 128.f) + 1e-6f);
        *(unsigned*)(p.ckv + (long)row * 128 + lane * 2) = pack2(a * r * p.dsa_kv_norm[lane * 2], b * r * p.dsa_kv_norm[lane * 2 + 1]);
      }
    }
  }
}

struct EpiCmp2 {
  u16* dst; int m0;
  DI void operator()(f32x16 (&acc)[2][2], int wm, int wn, int lane) const {
    constexpr int MT = 2;
    SW_FOR {
      const int R = m0 + SW_R, c = SW_C0;
      if (c < 64) *(uint2*)(dst + (long)R * 64 + c) = pack4(SW_V(0), SW_V(1), SW_V(2), SW_V(3));
    }
  }
};
struct EpiCmp2T {
  u16* dst; int m0;
  DI void operator()(f32x16 (&acc)[2][2], int wm, int wn, int lane) const {
#pragma unroll
    for (int mt = 0; mt < 2; ++mt)
#pragma unroll
      for (int nt = 0; nt < 2; ++nt) {
        const int c = EPI_C;
        if (c < 64) {
#pragma unroll
          for (int q4 = 0; q4 < 4; ++q4) {
            const int R = m0 + wm * 64 + mt * 32 + 8 * q4 + 4 * (lane >> 5);
            const int bg = R >> 9, n = R & 511;
            *(uint2*)(dst + ((long)(bg * 64 + c)) * 512 + n) =
                pack4(acc[mt][nt][q4 * 4 + 0], acc[mt][nt][q4 * 4 + 1], acc[mt][nt][q4 * 4 + 2], acc[mt][nt][q4 * 4 + 3]);
          }
        }
      }
  }
};
DI void indexer_item(const Params& p, char* smem, int item) {
  const int tid = TIDX(), lane = tid & 63, wid = __builtin_amdgcn_readfirstlane(tid >> 6);
  int b = 0, rem = item;
  if (rem >= 2080) { b = 1; rem -= 2080; }
  int qt = (int)((sqrtf(8.f * rem + 1.f) - 1.f) * 0.5f);
  while ((qt + 1) * (qt + 2) / 2 <= rem) ++qt;
  while (qt * (qt + 1) / 2 > rem) --qt;
  const int kt = rem - qt * (qt + 1) / 2;
  const int t0 = qt * 128 + (wid >> 1) * 64, s0 = kt * 128 + (wid & 1) * 64;
  if (s0 > t0 + 63) return;
  float* wl = (float*)smem + wid * 512;
  const float* wsrc = p.widx + ((long)b * T + t0) * 8;
#pragma unroll
  for (int i = 0; i < 8; ++i) wl[i * 64 + lane] = wsrc[i * 64 + lane];
  wave_sync();
  const u16* projb = p.proj + (long)b * T * LDP;
  const int r31 = lane & 31, hf = lane >> 5;
  u16* Kt = (u16*)(smem + 8192) + wid * (64 * 72);
  {
    const int piece = lane & 7, rb = lane >> 3;
#pragma unroll
    for (int i = 0; i < 8; ++i) {
      const uint4 v = *(const uint4*)(projb + (long)(s0 + rb + 8 * i) * LDP + C_KI + piece * 8);
      *(uint4*)(Kt + (rb + 8 * i) * 72 + piece * 8) = v;
    }
  }
  wave_sync();
  const u16* kfrag = Kt + r31 * 72 + hf * 8;
  f32x16 sum[2][2];
#pragma unroll
  for (int a = 0; a < 2; ++a)
#pragma unroll
    for (int c = 0; c < 2; ++c)
#pragma unroll
      for (int i = 0; i < 16; ++i) sum[a][c][i] = 0.f;
  const u16* qbase = projb + (long)(t0 + r31) * LDP + C_QI + hf * 8;
  bf16x8 af0[4], af1[4], af2[4], af3[4];
#define IDX_LOADQ(DST, STEP)                                                                            \
  {                                                                                                     \
    const int st_ = (STEP) < 15 ? (STEP) : 15;                                                          \
    _Pragma("unroll") for (int ks = 0; ks < 4; ++ks) DST[ks] = *(const bf16x8*)(qbase + (long)(st_ & 1) * 32 * LDP + (st_ >> 1) * 64 + ks * 16); \
  }
#define IDX_STEP(SRC, MT, H)                                                                            \
  {                                                                                                     \
    const float w_ = wl[((MT) * 32 + r31) * 8 + (H)];                                                   \
    _Pragma("unroll") for (int nt = 0; nt < 2; ++nt) {                                                  \
      f32x16 acc;                                                                                       \
      _Pragma("unroll") for (int i = 0; i < 16; ++i) acc[i] = 0.f;                                      \
      _Pragma("unroll") for (int ks = 0; ks < 4; ++ks) acc = __builtin_amdgcn_mfma_f32_32x32x16_bf16(*(const bf16x8*)(kfrag + nt * 32 * 72 + ks * 16), SRC[ks], acc, 0, 0, 0); \
      _Pragma("unroll") for (int i = 0; i < 16; ++i) sum[MT][nt][i] += w_ * fmaxf(acc[i], 0.f);        \
    }                                                                                                   \
  }
  IDX_LOADQ(af0, 0) IDX_LOADQ(af1, 1) IDX_LOADQ(af2, 2)
#pragma unroll 1
  for (int s4 = 0; s4 < 16; s4 += 4) {
    IDX_LOADQ(af3, s4 + 3)
    asm volatile("" ::: "memory");
    IDX_STEP(af0, 0, s4 >> 1)
    asm volatile("" ::: "memory");
    IDX_LOADQ(af0, s4 + 4)
    asm volatile("" ::: "memory");
    IDX_STEP(af1, 1, s4 >> 1)
    asm volatile("" ::: "memory");
    IDX_LOADQ(af1, s4 + 5)
    asm volatile("" ::: "memory");
    IDX_STEP(af2, 0, (s4 >> 1) + 1)
    asm volatile("" ::: "memory");
    IDX_LOADQ(af2, s4 + 6)
    asm volatile("" ::: "memory");
    IDX_STEP(af3, 1, (s4 >> 1) + 1)
    asm volatile("" ::: "memory");
  }
#undef IDX_LOADQ
#undef IDX_STEP
#pragma unroll
  for (int mt = 0; mt < 2; ++mt)
#pragma unroll
    for (int nt = 0; nt < 2; ++nt)
#pragma unroll
      for (int q4 = 0; q4 < 4; ++q4)
      {
        typedef _Float16 h4_t __attribute__((ext_vector_type(4)));
        typedef float f4_t __attribute__((ext_vector_type(4)));
        const f4_t v4 = {sum[mt][nt][4 * q4], sum[mt][nt][4 * q4 + 1], sum[mt][nt][4 * q4 + 2], sum[mt][nt][4 * q4 + 3]};
        *(h4_t*)((u16*)p.scores + ((long)b * T + t0 + mt * 32 + r31) * T + s0 + nt * 32 + 8 * q4 + 4 * hf) = __builtin_convertvector(v4, h4_t);
      }
}
DI void topk_row(const Params& p, int b, int t, int lane);
DI void phase4(const Params& p, char* smem, int bid, int nblk) {
  if (bid < 32) {
    const int slot = bid >> 4, mt_ = bid & 15;
    ARows af{p.zc + ((long)slot * 2048 + mt_ * 128) * 128, 128, 128};
    BMat bf{p.cmp_w2 + slot * 128 * 64, 64, 64};
    if (slot) { EpiCmp2T ef{p.vcT, mt_ * 128}; gemm_tile<false>(smem, 2, 64, af, bf, ef); }
    else { EpiCmp2 ef{p.kc, mt_ * 128}; gemm_tile(smem, 2, 64, af, bf, ef); }
  }
  const int tid = TIDX(), lane = tid & 63, wid = __builtin_amdgcn_readfirstlane(tid >> 6);
  for (int item = bid; item < 2048; item += nblk) {
    const int it = item < 1024 ? 2047 - item : item - 1024;
    const int b = it & 1, tb = it >> 1;
#pragma unroll 1
    for (int q = 0; q < 2; ++q) {
      asm volatile("" ::: "memory");
      topk_row(p, b, tb * 8 + wid * 2 + q, lane);
    }
  }
}

#define MFMA16(a, b, c) __builtin_amdgcn_mfma_f32_16x16x32_bf16((a), (b), (c), 0, 0, 0)
#define MFMA32(a, b, c) __builtin_amdgcn_mfma_f32_32x32x16_bf16((a), (b), (c), 0, 0, 0)

constexpr int NSA_STAGE_BYTES = 64 * 72 * 2 + 64 * 68 * 2;
DI void dense_scores(f32x16 (&acc)[2], const u16* Ks, const bf16x8 (&qf)[4], int lane) {
  const int r = lane & 31, hf = lane >> 5;
  bf16x8 kf[2][4];
#pragma unroll
  for (int tile = 0; tile < 2; ++tile)
#pragma unroll
    for (int ks = 0; ks < 4; ++ks) kf[tile][ks] = *(const bf16x8*)(Ks + (32 * tile + r) * 72 + 8 * hf + 16 * ks);
  asm volatile("" ::: "memory");
#pragma unroll
  for (int tile = 0; tile < 2; ++tile) {
    f32x16 c;
#pragma unroll
    for (int i = 0; i < 16; ++i) c[i] = 0.f;
#pragma unroll
    for (int ks = 0; ks < 4; ++ks) c = MFMA32(kf[tile][ks], qf[ks], c);
    acc[tile] = c;
  }
}
DI void dense_pv(const f32x16 (&acc)[2], const u16* Vs, int lane, f32x16 (&o)[2]) {
  const int r = lane & 31, hf = lane >> 5;
  uint2 vlo[2][2][2], vhi[2][2][2];
#pragma unroll
  for (int tile = 0; tile < 2; ++tile)
#pragma unroll
    for (int s = 0; s < 2; ++s)
#pragma unroll
      for (int dt = 0; dt < 2; ++dt) {
        const u16* vp = Vs + (32 * dt + r) * 68 + 32 * tile + 16 * s + 4 * hf;
        vlo[tile][s][dt] = *(const uint2*)vp;
        vhi[tile][s][dt] = *(const uint2*)(vp + 8);
      }
  asm volatile("" ::: "memory");
#pragma unroll
  for (int tile = 0; tile < 2; ++tile)
#pragma unroll
    for (int s = 0; s < 2; ++s) {
      uint4 w;
      w.x = pack2(acc[tile][8 * s + 0], acc[tile][8 * s + 1]);
      w.y = pack2(acc[tile][8 * s + 2], acc[tile][8 * s + 3]);
      w.z = pack2(acc[tile][8 * s + 4], acc[tile][8 * s + 5]);
      w.w = pack2(acc[tile][8 * s + 6], acc[tile][8 * s + 7]);
      const bf16x8 pb = __builtin_bit_cast(bf16x8, w);
#pragma unroll
      for (int dt = 0; dt < 2; ++dt) {
        uint4 a;
        a.x = vlo[tile][s][dt].x; a.y = vlo[tile][s][dt].y; a.z = vhi[tile][s][dt].x; a.w = vhi[tile][s][dt].y;
        o[dt] = MFMA32(__builtin_bit_cast(bf16x8, a), pb, o[dt]);
      }
    }
}
constexpr float LOG2E = 1.4426950408889634f;
template <int DSTEP>
DI float dense_mask(f32x16 (&acc)[2], bool active, int lo_c, int hi_c, int dist0_c, int dmin_u, const float* btab_h, int lane) {
  const int hf = lane >> 5;
  const bool colfull = !active || (lo_c <= 0 && hi_c >= 63);
  float mx = -INFINITY;
  if (dmin_u >= 128 && __ballot(colfull) == ~0ull) {
    const float be = active ? btab_h[128] : -INFINITY;
#pragma unroll
    for (int tile = 0; tile < 2; ++tile)
#pragma unroll
      for (int i = 0; i < 16; ++i) {
        const float sv = fmaf(acc[tile][i], LOG2E, be);
        acc[tile][i] = sv;
        mx = fmaxf(mx, sv);
      }
  } else {
    const int lo2 = active ? lo_c : 1, hi2 = active ? hi_c : 0;
#pragma unroll
    for (int tile = 0; tile < 2; ++tile)
#pragma unroll
      for (int i = 0; i < 16; ++i) {
        const int kl = 32 * tile + (i & 3) + 8 * (i >> 2) + 4 * hf;
        int dc = dist0_c - DSTEP * kl;
        dc = dc < 0 ? 0 : (dc > 128 ? 128 : dc);
        const float bias = btab_h[dc];
        const float s2 = fmaf(acc[tile][i], LOG2E, bias);
        const float sv = (kl >= lo2 && kl <= hi2) ? s2 : -INFINITY;
        acc[tile][i] = sv;
        mx = fmaxf(mx, sv);
      }
  }
  return fmaxf(mx, __shfl_xor(mx, 32));
}
DI void dense_chunk(const u16* Ks, const u16* Vs, bool active, int lo_c, int hi_c, int dist0_c, int dmin_u, const bf16x8 (&qf)[4],
                    const float* btab_h, int lane, float& m, float& l, f32x16 (&o)[2]) {
  f32x16 acc[2];
  dense_scores(acc, Ks, qf, lane);
  const float mx = dense_mask<1>(acc, active, lo_c, hi_c, dist0_c, dmin_u, btab_h, lane);
  const float mn = fmaxf(m, mx);
  const float alpha = __builtin_amdgcn_exp2f(m - mn);
  float ls = 0.f;
#pragma unroll
  for (int tile = 0; tile < 2; ++tile)
#pragma unroll
    for (int i = 0; i < 16; ++i) {
      const float pv = __builtin_amdgcn_exp2f(acc[tile][i] - mn);
      acc[tile][i] = pv;
      ls += pv;
    }
  ls += __shfl_xor(ls, 32);
  l = l * alpha + ls;
  m = mn;
  o[0] *= alpha;
  o[1] *= alpha;
  dense_pv(acc, Vs, lane, o);
}

template <int KSG, int VSG, bool NEEDV, class Next, class Body>
DI void chunk_pipeline(char* stage, const u16* kg0, const u16* vg0, int first, int tid, const Next& next, const Body& body) {
  const int srow = tid >> 3, spiece = tid & 7;
  uint4 rk0, rv0;
  rv0 = make_uint4(0, 0, 0, 0);
  int d = first;
#define NSA_GLOAD(D)                                                                      \
  {                                                                                       \
    rk0 = *(const uint4*)(kg0 + ((long)(D) * 64 + srow) * KSG + spiece * 8);              \
    if (NEEDV) rv0 = *(const uint4*)(vg0 + (long)srow * VSG + (D) * 64 + spiece * 8);     \
  }
  if (d >= 0) NSA_GLOAD(d)
  int ph = 0;
  __syncthreads();
  while (d >= 0) {
    u16* Ks = (u16*)(stage + ph * NSA_STAGE_BYTES);
    u16* Vs = Ks + 64 * 72;
    *(uint4*)(Ks + srow * 72 + spiece * 8) = rk0;
    if (NEEDV) {
      uint2* dv = (uint2*)(Vs + srow * 68 + spiece * 8);
      dv[0] = make_uint2(rv0.x, rv0.y); dv[1] = make_uint2(rv0.z, rv0.w);
    }
    const int dn = next(d);
    if (dn >= 0) NSA_GLOAD(dn)
    __syncthreads();
    body(d, Ks, Vs);
    ph ^= 1;
    d = dn;
  }
#undef NSA_GLOAD
}

DI void nsa_item(const Params& p, char* smem, int item) {
  const int tid = TIDX8(), lane = tid & 63, wid = __builtin_amdgcn_readfirstlane(tid >> 6);
  const int chunk = item & 127, g = (item >> 7) & 1, b = item >> 8;
  const int bg = b * 2 + g;
  float* btab = (float*)smem;
  u64* wun = (u64*)(smem + 2304);
  float* imps = (float*)(smem + 4096) + wid * 1056;
  char* stage = smem + 37888;
  for (int idx = tid; idx < 4 * 129; idx += 512) {
    const int h = idx / 129, d = idx % 129;
    const int bk = d < 128 ? BUCKET[d] : 31;
    btab[h * 132 + d] = p.rel_bias[bk * 16 + g * 4 + h] * LOG2E;
  }
  __syncthreads();
  const int t0 = chunk * 64;
  const int tw = t0 + wid * 8;
  const int c = lane & 31, hf = lane >> 5, qi = c >> 2, hh = c & 3;
  const int t_c = tw + qi;
  const int cur = t0 >> 6;
  const long row = (long)b * T + t_c;
  const u16* prow = p.proj + row * LDP;
  const u16* projb = p.proj + (long)b * T * LDP;
  const float* btab_h = btab + hh * 132;
  bf16x8 qf[4];
#pragma unroll
  for (int ks = 0; ks < 4; ++ks) qf[ks] = *(const bf16x8*)(prow + C_QN + (g * 4 + hh) * 64 + ks * 16 + hf * 8);
  const u16* gptr = prow + C_GN + (g * 4 + hh) * 3;
  for (int k = lane; k < 1056; k += 64) imps[k] = 0.f;
  u16* orow = p.onsa + row * 512 + (g * 4 + hh) * 64 + 4 * hf;
  auto emit = [&](const f32x16 (&o)[2], float sc, bool first) {
#pragma unroll
    for (int dt = 0; dt < 2; ++dt)
#pragma unroll
      for (int q4 = 0; q4 < 4; ++q4) {
        uint2* dst = (uint2*)(orow + 32 * dt + 8 * q4);
        float v0 = o[dt][4 * q4 + 0] * sc, v1 = o[dt][4 * q4 + 1] * sc, v2 = o[dt][4 * q4 + 2] * sc, v3 = o[dt][4 * q4 + 3] * sc;
        if (!first) {
          const uint2 u = *dst;
          v0 += lo16(u.x); v1 += hi16(u.x); v2 += lo16(u.y); v3 += hi16(u.y);
        }
        uint2 w;
        w.x = pack2(v0, v1);
        w.y = pack2(v2, v3);
        *dst = w;
      }
  };
  const int ncv_c = (t_c >= 31) ? ((t_c - 31) >> 4) + 1 : 0;
  const int ncv_max = ((t0 + 63 - 31) >> 4) + 1;
  const int nchunk_c = (ncv_max + 63) >> 6;
  {
    const u16* kcb = p.kc + (long)bg * 512 * 64;
    const u16* vcb = p.vcT + (long)bg * 64 * 512;
    float m = -1e30f, l = 0.f;
    auto next_c = [&](int d) { return d + 1 < nchunk_c ? d + 1 : -1; };
    chunk_pipeline<64, 512, false>(stage, kcb, vcb, 0, tid, next_c, [&](int i, const u16* Ks, const u16* Vs) {
      f32x16 acc[2];
      dense_scores(acc, Ks, qf, lane);
      const float mx = dense_mask<16>(acc, true, 0, ncv_c - 1 - i * 64, t_c - 31 - 1024 * i, tw - 31 - 1024 * i - 1008, btab_h, lane);
      const float mn = fmaxf(m, mx);
      float ls = 0.f;
#pragma unroll
      for (int tile = 0; tile < 2; ++tile)
#pragma unroll
        for (int q = 0; q < 16; ++q) ls += __builtin_amdgcn_exp2f(acc[tile][q] - mn);
      ls += __shfl_xor(ls, 32);
      l = l * __builtin_amdgcn_exp2f(m - mn) + ls;
      m = mn;
    });
    const float invl = 1.f / fmaxf(l, 1e-30f);
    f32x16 oc[2];
#pragma unroll
    for (int i = 0; i < 16; ++i) { oc[0][i] = 0.f; oc[1][i] = 0.f; }
    chunk_pipeline<64, 512, true>(stage, kcb, vcb, 0, tid, next_c, [&](int i, const u16* Ks, const u16* Vs) {
      f32x16 acc[2];
      dense_scores(acc, Ks, qf, lane);
      (void)dense_mask<16>(acc, true, 0, ncv_c - 1 - i * 64, t_c - 31 - 1024 * i, tw - 31 - 1024 * i - 1008, btab_h, lane);
      float part[2][4], spill[2][4];
#pragma unroll
      for (int tile = 0; tile < 2; ++tile) {
#pragma unroll
        for (int q = 0; q < 16; ++q) acc[tile][q] = __builtin_amdgcn_exp2f(acc[tile][q] - m) * invl;
#pragma unroll
        for (int q4 = 0; q4 < 4; ++q4) {
          float pa = acc[tile][4 * q4] + acc[tile][4 * q4 + 1] + acc[tile][4 * q4 + 2] + 0.5f * acc[tile][4 * q4 + 3];
          float sp = 0.5f * acc[tile][4 * q4 + 3];
          pa += __shfl_xor(pa, 1); pa += __shfl_xor(pa, 2);
          sp += __shfl_xor(sp, 1); sp += __shfl_xor(sp, 2);
          part[tile][q4] = pa; spill[tile][q4] = sp;
        }
      }
      if (hh == 0) {
#pragma unroll
        for (int tile = 0; tile < 2; ++tile)
#pragma unroll
          for (int q4 = 0; q4 < 4; ++q4) imps[qi * 132 + 16 * i + 8 * tile + 2 * q4 + hf] += part[tile][q4];
      }
      wave_sync();
      if (hh == 0) {
#pragma unroll
        for (int tile = 0; tile < 2; ++tile)
#pragma unroll
          for (int q4 = 0; q4 < 4; ++q4) imps[qi * 132 + 16 * i + 8 * tile + 2 * q4 + hf + 1] += spill[tile][q4];
      }
      wave_sync();
      dense_pv(acc, Vs, lane, oc);
    });
    emit(oc, bf2f(gptr[0]), true);
  }
  wave_sync();
  u64 my0 = 0, my1 = 0, wu0 = 0, wu1 = 0;
  for (int q = 0; q < 8; ++q) {
    u64 mask0, mask1;
    if (cur <= 15) {
      mask0 = (2ull << cur) - 1ull;
      mask1 = 0ull;
    } else {
      const float imp_lo = imps[q * 132 + lane], imp_hi = imps[q * 132 + lane + 64];
      const int jl = lane, jh = lane + 64;
      float c0 = (jl >= 1 && jl <= cur - 2) ? imp_lo : -1.f;
      float c1 = (jh <= cur - 2) ? imp_hi : -1.f;
      bool sel_lo = (jl == 0) || (jl == cur) || (jl == cur - 1);
      bool sel_hi = (jh == cur) || (jh == cur - 1);
      for (int r = 0; r < 13; ++r) {
        float bv; int bj;
        if (c0 >= c1) { bv = c0; bj = jl; } else { bv = c1; bj = jh; }
        wave_argmax(bv, bj);
        if (bj == jl) { sel_lo = true; c0 = -1.f; }
        if (bj == jh) { sel_hi = true; c1 = -1.f; }
      }
      mask0 = __ballot(sel_lo);
      mask1 = __ballot(sel_hi);
    }
    if (qi == q) { my0 = mask0; my1 = mask1; }
    wu0 |= mask0; wu1 |= mask1;
  }
  if (lane == 0) { wun[wid * 2] = wu0; wun[wid * 2 + 1] = wu1; }
  __syncthreads();
  u64 bu0 = wun[0] | wun[2] | wun[4] | wun[6] | wun[8] | wun[10] | wun[12] | wun[14];
  u64 bu1 = wun[1] | wun[3] | wun[5] | wun[7] | wun[9] | wun[11] | wun[13] | wun[15];
  bu0 = ((u64)(unsigned)__builtin_amdgcn_readfirstlane((int)(bu0 >> 32)) << 32) | (unsigned)__builtin_amdgcn_readfirstlane((int)bu0);
  bu1 = ((u64)(unsigned)__builtin_amdgcn_readfirstlane((int)(bu1 >> 32)) << 32) | (unsigned)__builtin_amdgcn_readfirstlane((int)bu1);
  {
    float m = -1e30f, l = 0.f;
    f32x16 o[2];
#pragma unroll
    for (int i = 0; i < 16; ++i) { o[0][i] = 0.f; o[1][i] = 0.f; }
    const int kcol = C_KV + 2 * 128 + g * 64;
    auto next_s = [&](int j) {
      ++j;
      if (j < 64) {
        const u64 mm = bu0 & (~0ull << j);
        if (mm) return (int)__builtin_ctzll(mm);
        j = 64;
      }
      if (j >= 128) return -1;
      const u64 mm = bu1 & (~0ull << (j - 64));
      return mm ? 64 + (int)__builtin_ctzll(mm) : -1;
    };
    chunk_pipeline<LDP, T, true>(stage, projb + kcol, p.vts + (long)bg * 64 * T, 0, tid, next_s, [&](int j, const u16* Ks, const u16* Vs) {
      const bool bit = ((j < 64 ? (my0 >> j) : (my1 >> (j - 64))) & 1ull) != 0;
      if (__ballot(bit) != 0ull) {
        const int pos0 = 64 * j;
        dense_chunk(Ks, Vs, bit, 0, t_c - pos0, t_c - pos0, tw - pos0 - 63, qf, btab_h, lane, m, l, o);
      }
    });
    emit(o, bf2f(gptr[1]) / fmaxf(l, 1e-30f), false);
  }
  {
    float m = -1e30f, l = 0.f;
    f32x16 o[2];
#pragma unroll
    for (int i = 0; i < 16; ++i) { o[0][i] = 0.f; o[1][i] = 0.f; }
    const int kcol = C_KV + 4 * 128 + g * 64;
    const int wlo_c = t_c - 511 < 0 ? 0 : t_c - 511;
    const int wlo_min = t0 - 511 < 0 ? 0 : t0 - 511;
    auto next_w = [&](int j) { return j + 1 <= cur ? j + 1 : -1; };
    chunk_pipeline<LDP, T, true>(stage, projb + kcol, p.vtw + (long)bg * 64 * T, wlo_min >> 6, tid, next_w, [&](int jw, const u16* Ks, const u16* Vs) {
      const int pos0 = 64 * jw;
      const int lo_c = wlo_c - pos0 < 0 ? 0 : wlo_c - pos0;
      dense_chunk(Ks, Vs, true, lo_c, t_c - pos0, t_c - pos0, tw - pos0 - 63, qf, btab_h, lane, m, l, o);
    });
    emit(o, bf2f(gptr[2]) / fmaxf(l, 1e-30f), false);
  }
}

DI unsigned f2ord(float v) { const unsigned u = __float_as_uint(v); return (u & 0x80000000u) ? ~u : (u | 0x80000000u); }

DI void topk_row(const Params& p, int b, int t, int lane) {
  const long row = (long)b * T + t;
  int* dst = p.selk + row * 256;
  if (t < 256) {
#pragma unroll
    for (int i = 0; i < 4; ++i) { const int s = i * 64 + lane; dst[s] = (s <= t) ? s : -1; }
    return;
  }
  const u16* srow = (const u16*)p.scores + row * T;
  const int ngrp = (t >> 10) + 1;
  unsigned u[128];
  int ln = lane;
  asm volatile("" : "+v"(ln));
#pragma unroll
  for (int gq = 0; gq < 8; ++gq) {
    if (gq < ngrp) {
#pragma unroll
      for (int j = 0; j < 16; ++j) {
        const int s = (gq * 16 + j) * 64 + ln;
        u[gq * 16 + j] = srow[s < t ? s : t];
      }
    } else {
#pragma unroll
      for (int j = 0; j < 16; ++j) u[gq * 16 + j] = 0u;
    }
  }
  asm volatile("" ::: "memory");
#pragma unroll
  for (int gq = 0; gq < 8; ++gq) {
    if (gq < ngrp) {
#pragma unroll
      for (int j = 0; j < 16; ++j) {
        const int s = (gq * 16 + j) * 64 + ln;
        { const unsigned h_ = u[gq * 16 + j]; u[gq * 16 + j] = (s <= t) ? ((h_ & 0x8000u) ? (~h_ & 0xFFFFu) : (h_ | 0x8000u)) : 0u; }
      }
    }
  }
  const int nlane = 16 * ngrp;
  unsigned m0 = 0u, m1 = 0u, m2 = 0u, m3 = 0u;
#pragma unroll
  for (int gq = 0; gq < 8; ++gq) {
    if (gq < ngrp) {
#pragma unroll
      for (int j = 0; j < 16; j += 4) {
        m0 = max(m0, u[gq * 16 + j]); m1 = max(m1, u[gq * 16 + j + 1]); m2 = max(m2, u[gq * 16 + j + 2]); m3 = max(m3, u[gq * 16 + j + 3]);
      }
    }
  }
  unsigned lo = wave_min_u(min(min(m0, m1), min(m2, m3)));
  unsigned hi = wave_max_u(max(max(m0, m1), max(m2, m3))) + 1u;
#define TOPK_COUNT_GE(PIV, OUT)                                                         \
  {                                                                                     \
    unsigned below_ = 0;     \
    _Pragma("unroll") for (int gq = 0; gq < 8; ++gq) {                                  \
      if (gq < ngrp) {                                                                  \
        _Pragma("unroll") for (int j = 0; j < 16; ++j) below_ += (u[gq * 16 + j] - (PIV)) >> 31; \
      }                                                                                 \
    }                                                                                   \
    OUT = wave_sum_i(nlane - (int)below_);                                              \
  }
  int c_lo, c_hi = 0;
  TOPK_COUNT_GE(lo, c_lo)
  int iter = 0;
  while (c_lo != 256 && hi - lo > 1u) {
    const unsigned span = hi - lo;
    unsigned step;
    if ((++iter & 3) == 0) step = span >> 1;
    else step = (unsigned)((float)span * ((float)(c_lo - 256) / (float)(c_lo - c_hi)));
    step = step < 1u ? 1u : (step > span - 1u ? span - 1u : step);
    const unsigned piv = lo + step;
    int c;
    TOPK_COUNT_GE(piv, c)
    if (c >= 256) { lo = piv; c_lo = c; } else { hi = piv; c_hi = c; }
  }
#undef TOPK_COUNT_GE
  const unsigned thr = lo;
  int ngt = 0;
#pragma unroll
  for (int gq = 0; gq < 8; ++gq) {
    if (gq < ngrp) {
#pragma unroll
      for (int j = 0; j < 16; ++j) ngt += __popcll(__ballot(u[gq * 16 + j] > thr));
    }
  }
  int base_gt = 0, base_eq = 0;
  const int need_eq = 256 - ngt;
  int ln2 = lane;
  asm volatile("" : "+v"(ln2));
#pragma unroll
  for (int gq = 0; gq < 8; ++gq) {
    if (gq < ngrp) {
#pragma unroll
      for (int j = 0; j < 16; ++j) {
        const int s = (gq * 16 + j) * 64 + ln2;
        const unsigned uv = u[gq * 16 + j];
        const bool gt = uv > thr, eq = uv == thr;
        const u64 mg = __ballot(gt), me = __ballot(eq);
        const int pg = __builtin_amdgcn_mbcnt_hi((unsigned)(mg >> 32), __builtin_amdgcn_mbcnt_lo((unsigned)mg, 0));
        const int pe = __builtin_amdgcn_mbcnt_hi((unsigned)(me >> 32), __builtin_amdgcn_mbcnt_lo((unsigned)me, 0));
        if (gt) dst[base_gt + pg] = s;
        if (eq && (base_eq + pe) < need_eq) dst[ngt + base_eq + pe] = s;
        base_gt += __popcll(mg);
        base_eq += __popcll(me);
      }
    }
  }
}

DI void phase6(const Params& p, char* smem, int bid, int nblk);
DI void phase5_nsa8(const Params& p) {
  for (int item = blockIdx.x; item < 512; item += gridDim.x) {
    __syncthreads();
    const int it = item < 256 ? 511 - item : item - 256;
    const int chunk = it >> 2, bgi = it & 3;
    nsa_item(p, g_smem, (bgi << 7) | chunk);
  }
  __syncthreads();
}
DI void phase5(const Params& p, char* smem, int bid, int nblk) {
  hb_sync();
  phase6(p, smem, bid, nblk);
}

DI void tr_read2(unsigned a0, unsigned a1, uint2& r0, uint2& r1) {
  asm volatile("ds_read_b64_tr_b16 %0, %2\n\tds_read_b64_tr_b16 %1, %3\n\ts_waitcnt lgkmcnt(0)" : "=&v"(r0), "=&v"(r1) : "v"(a0), "v"(a1) : "memory");
}
DI void tr_read4(unsigned a0, unsigned a1, unsigned a2, unsigned a3, uint2& r0, uint2& r1, uint2& r2, uint2& r3) {
  asm volatile("ds_read_b64_tr_b16 %0, %4\n\tds_read_b64_tr_b16 %1, %5\n\tds_read_b64_tr_b16 %2, %6\n\tds_read_b64_tr_b16 %3, %7\n\ts_waitcnt lgkmcnt(0)"
               : "=&v"(r0), "=&v"(r1), "=&v"(r2), "=&v"(r3) : "v"(a0), "v"(a1), "v"(a2), "v"(a3) : "memory");
}
DI void dsa_query(const Params& p, u16* Cs, const float* btab, int b, int t, int lane) {
  const long row = (long)b * T + t;
  const int lg = lane >> 4, r16 = lane & 15, hh = lane & 7;
  bf16x8 qf[4];
#pragma unroll
  for (int ks = 0; ks < 4; ++ks) {
    bf16x8 z = {0, 0, 0, 0, 0, 0, 0, 0};
    if (r16 < 8) z = *(const bf16x8*)(p.qlat + (row * 8 + r16) * 128 + ks * 32 + lg * 8);
    qf[ks] = z;
  }
  const u16* ckvb = p.ckv + (long)b * T * 128;
  const int nvalid = (t + 1) < 256 ? (t + 1) : 256;
  float m = -1e30f, l = 0.f;
  f32x4 o[8];
#pragma unroll
  for (int ct = 0; ct < 8; ++ct) o[ct] = (f32x4){0.f, 0.f, 0.f, 0.f};
  const unsigned cs_base = (unsigned)(size_t)Cs;
  const int nch = (nvalid + 31) >> 5;
  uint4 gv0, gv1, gv2, gv3, gv4, gv5, gv6, gv7;
  int kidx_n;
#define DSA_G1(V, I) { const int kr_ = __shfl(kidx_n, 4 * (I) + lg); V = *(const uint4*)(ckvb + (long)kr_ * 128 + r16 * 8); }
#define DSA_GATHER(CH)                                                            \
  {                                                                               \
    const int nv_ = (nvalid - (CH) * 32) > 32 ? 32 : (nvalid - (CH) * 32);        \
    kidx_n = p.selk[row * 256 + (CH) * 32 + (lane & 31)];                         \
    if ((lane & 31) >= nv_ || kidx_n < 0 || kidx_n > t) kidx_n = t;               \
    DSA_G1(gv0, 0) DSA_G1(gv1, 1) DSA_G1(gv2, 2) DSA_G1(gv3, 3) DSA_G1(gv4, 4) DSA_G1(gv5, 5) DSA_G1(gv6, 6) DSA_G1(gv7, 7) \
  }
  DSA_GATHER(0)
  for (int ch = 0; ch < nch; ++ch) {
    const int nval = (nvalid - ch * 32) > 32 ? 32 : (nvalid - ch * 32);
    const int kidx = kidx_n;
    wave_sync();
    {
      u16* d_ = Cs + lg * 144 + r16 * 8;
      *(uint4*)(d_) = gv0;            *(uint4*)(d_ + 4 * 144) = gv1;  *(uint4*)(d_ + 8 * 144) = gv2;  *(uint4*)(d_ + 12 * 144) = gv3;
      *(uint4*)(d_ + 16 * 144) = gv4; *(uint4*)(d_ + 20 * 144) = gv5; *(uint4*)(d_ + 24 * 144) = gv6; *(uint4*)(d_ + 28 * 144) = gv7;
    }
    { const int chn = ch + 1 < nch ? ch + 1 : nch - 1; DSA_GATHER(chn) }
    wave_sync();
    f32x4 acc[2];
#pragma unroll
    for (int rt = 0; rt < 2; ++rt) {
      const u16* kp = Cs + (16 * rt + r16) * 144 + 8 * lg;
      f32x4 c = {0.f, 0.f, 0.f, 0.f};
#pragma unroll
      for (int ks = 0; ks < 4; ++ks) c = MFMA16(*(const bf16x8*)(kp + 32 * ks), qf[ks], c);
      acc[rt] = c;
    }
    float mx = -INFINITY;
#pragma unroll
    for (int rt = 0; rt < 2; ++rt)
#pragma unroll
      for (int r = 0; r < 4; ++r) {
        const int pl = 16 * rt + 4 * lg + r;
        const int kk = __shfl(kidx, pl);
        int dc = t - kk;
        dc = dc < 0 ? 0 : (dc > 128 ? 128 : dc);
        const float sv = (pl < nval) ? fmaf(acc[rt][r], LOG2E, btab[hh * 132 + dc]) : -INFINITY;
        acc[rt][r] = sv;
        mx = fmaxf(mx, sv);
      }
    mx = fmaxf(mx, __shfl_xor(mx, 16));
    mx = fmaxf(mx, __shfl_xor(mx, 32));
    const float mn = fmaxf(m, mx);
    const float alpha = __builtin_amdgcn_exp2f(m - mn);
    float ls = 0.f;
#pragma unroll
    for (int rt = 0; rt < 2; ++rt)
#pragma unroll
      for (int r = 0; r < 4; ++r) {
        const float pv = __builtin_amdgcn_exp2f(acc[rt][r] - mn);
        acc[rt][r] = pv;
        ls += pv;
      }
    ls += __shfl_xor(ls, 16);
    ls += __shfl_xor(ls, 32);
    l = l * alpha + ls;
    m = mn;
    uint4 pw;
    pw.x = pack2(acc[0][0], acc[0][1]);
    pw.y = pack2(acc[0][2], acc[0][3]);
    pw.z = pack2(acc[1][0], acc[1][1]);
    pw.w = pack2(acc[1][2], acc[1][3]);
    const bf16x8 pb = __builtin_bit_cast(bf16x8, pw);
    const unsigned a_lo = cs_base + (unsigned)(((4 * lg + (r16 >> 2)) * 144 + 4 * (r16 & 3)) * 2);
    const unsigned a_hi = a_lo + 16 * 144 * 2;
#pragma unroll
    for (int ct = 0; ct < 8; ct += 2) {
      uint2 lo0, hi0, lo1, hi1;
      tr_read4(a_lo + ct * 32, a_hi + ct * 32, a_lo + ct * 32 + 32, a_hi + ct * 32 + 32, lo0, hi0, lo1, hi1);
      uint4 aw0, aw1;
      aw0.x = lo0.x; aw0.y = lo0.y; aw0.z = hi0.x; aw0.w = hi0.y;
      aw1.x = lo1.x; aw1.y = lo1.y; aw1.z = hi1.x; aw1.w = hi1.y;
      o[ct] = o[ct] * alpha;
      o[ct + 1] = o[ct + 1] * alpha;
      o[ct] = MFMA16(__builtin_bit_cast(bf16x8, aw0), pb, o[ct]);
      o[ct + 1] = MFMA16(__builtin_bit_cast(bf16x8, aw1), pb, o[ct + 1]);
    }
  }
#undef DSA_GATHER
#undef DSA_G1
  const float invl = 1.f / fmaxf(l, 1e-30f);
  if (r16 < 8) {
#pragma unroll
    for (int ct = 0; ct < 8; ++ct)
      *(uint2*)(p.olat + row * 1024 + r16 * 128 + 16 * ct + 4 * lg) = pack4(o[ct][0] * invl, o[ct][1] * invl, o[ct][2] * invl, o[ct][3] * invl);
  }
}
DI void phase6(const Params& p, char* smem, int bid, int nblk) {
  const int tid = TIDX(), lane = tid & 63, wid = __builtin_amdgcn_readfirstlane(tid >> 6);
  float* btab = (float*)smem;
  u16* Cs = (u16*)(smem + 8192) + wid * (32 * 144);
  for (int idx = tid; idx < 8 * 129; idx += 256) {
    const int h = idx / 129, d = idx % 129;
    const int bk = d < 128 ? BUCKET[d] : 31;
    btab[h * 132 + d] = p.rel_bias[bk * 16 + 8 + h] * LOG2E;
  }
  hb_sync();
  for (int item = bid; item < 2048; item += nblk) {
    const int it = item < 1024 ? 2047 - item : item - 1024;
    const int b = it & 1, tb = it >> 1;
    for (int q = 0; q < 2; ++q) dsa_query(p, Cs, btab, b, tb * 8 + wid * 2 + q, lane);
  }
}

struct EpiOdsa {
  u16* odsa; int h, m0;
  DI void operator()(f32x16 (&acc)[2][2], int wm, int wn, int lane) const {
    constexpr int MT = 2;
    SW_FOR {
      const int r = m0 + SW_R, c = SW_C0;
      if (c < 64) *(uint2*)(odsa + (long)r * 512 + h * 64 + c) = pack4(SW_V(0), SW_V(1), SW_V(2), SW_V(3));
    }
  }
};
DI void phase7(const Params& p, char* smem, int bid, int nblk) {
  for (int item = bid; item < 1024; item += nblk) {
    const int h = item & 7, mt_ = item >> 3;
    ARows af{p.olat + (long)mt_ * 128 * 1024 + h * 128, 1024, 128};
    BMat bf{p.dsa_w_uv + h * 64, 512, 64};
    EpiOdsa ef{p.odsa, h, mt_ * 128};
    gemm_tile(smem, 2, 64, af, bf, ef);
  }
}

struct EpiY {
  u16* y; const u16* proj; int m0, n0, second;
  template <int MT> DI void operator()(f32x16 (&acc)[MT][2], int wm, int wn, int lane) const {
    SW_FOR {
      const int r = m0 + SW_R, c = n0 + SW_C0;
      const uint2 gu = *(const uint2*)(proj + (long)r * LDP + C_GM + second * 1024 + c);
      float v0 = lo16(gu.x) * SW_V(0), v1 = hi16(gu.x) * SW_V(1), v2 = lo16(gu.y) * SW_V(2), v3 = hi16(gu.y) * SW_V(3);
      uint2* dst = (uint2*)(y + (long)r * 1024 + c);
      if (second) {
        const uint2 yu = *dst;
        v0 += lo16(yu.x); v1 += hi16(yu.x); v2 += lo16(yu.y); v3 += hi16(yu.y);
      }
      *dst = pack4(v0, v1, v2, v3);
    }
  }
};
struct Epi8Y {
  u16* y; const u16* proj; int m0, n0, second;
  DI void operator()(int q, int c, float v0, float v1, float v2, float v3) const {
    const long r = m0 + q; const int cc = n0 + c;
    const uint2 gu = *(const uint2*)(proj + r * LDP + C_GM + second * 1024 + cc);
    v0 *= lo16(gu.x); v1 *= hi16(gu.x); v2 *= lo16(gu.y); v3 *= hi16(gu.y);
    uint2* dst = (uint2*)(y + r * 1024 + cc);
    if (second) {
      const uint2 yu = *dst;
      v0 += lo16(yu.x); v1 += hi16(yu.x); v2 += lo16(yu.y); v3 += hi16(yu.y);
    }
    *dst = pack4(v0, v1, v2, v3);
  }
};
DI void phase8_8w(const Params& p, int wg, int nwg) {
  for (int item = wg; item < 256; item += nwg) {
    const int x_ = item & 7, s_ = item >> 3, nt_ = s_ & 3, mt_ = x_ * 8 + (s_ >> 2);
    {
      ARows wf{p.w_bnT + (long)nt_ * 256 * 512, 512, 256};
      ARows xf{p.onsa + (long)mt_ * 256 * 512, 512, 256};
      Epi8Y ef{p.y, p.proj, mt_ * 256, nt_ * 256, 0};
      gemm8p(8, wf, xf, ef);
    }
    {
      ARows wf{p.w_bdT + (long)nt_ * 256 * 512, 512, 256};
      ARows xf{p.odsa + (long)mt_ * 256 * 512, 512, 256};
      Epi8Y ef{p.y, p.proj, mt_ * 256, nt_ * 256, 1};
      gemm8p(8, wf, xf, ef);
    }
  }
}
struct EpiStoreBf {
  u16* dst; long ld; int m0, n0;
  template <int MT> DI void operator()(f32x16 (&acc)[MT][2], int wm, int wn, int lane) const {
    SW_FOR { *(uint2*)(dst + (long)(m0 + SW_R) * ld + n0 + SW_C0) = pack4(SW_V(0), SW_V(1), SW_V(2), SW_V(3)); }
  }
};
struct Epi8StoreBf {
  u16* dst; long ld; int m0, n0;
  DI void operator()(int q, int c, float v0, float v1, float v2, float v3) const { *(uint2*)(dst + (long)(m0 + q) * ld + n0 + c) = pack4(v0, v1, v2, v3); }
};
DI void phase9_8w(const Params& p, int wg, int nwg) {
  for (int item = wg; item < 256; item += nwg) {
    const int x_ = item & 7, s_ = item >> 3, nt_ = s_ & 3, mt_ = x_ * 8 + (s_ >> 2);
    ARows wf{p.w_outT + (long)nt_ * 256 * 1024, 1024, 256};
    ARows xf{p.y + (long)mt_ * 256 * 1024, 1024, 256};
    Epi8StoreBf ef{p.z, 1024, mt_ * 256, nt_ * 256};
    gemm8p(16, wf, xf, ef);
  }
}

DI void phase10(const Params& p, int bid, int nblk) {
  const int tid = TIDX(), lane = tid & 63, wid = __builtin_amdgcn_readfirstlane(tid >> 6);
  const int b = bid & 1;
  const float* modb = p.mod + b * 6144;
  float cz[16], cm[16], ca[16];
#pragma unroll
  for (int i = 0; i < 4; ++i) {
    const int col = i * 256 + lane * 4;
    const float4 gt = *(const float4*)(modb + 2048 + col), gp = *(const float4*)(p.g_post_mix + col);
    const float4 gf = *(const float4*)(p.g_pre_ffn + col), sc = *(const float4*)(modb + 4096 + col), sh = *(const float4*)(modb + 3072 + col);
    cz[i * 4 + 0] = gt.x * gp.x; cz[i * 4 + 1] = gt.y * gp.y; cz[i * 4 + 2] = gt.z * gp.z; cz[i * 4 + 3] = gt.w * gp.w;
    cm[i * 4 + 0] = gf.x * (1.f + sc.x); cm[i * 4 + 1] = gf.y * (1.f + sc.y); cm[i * 4 + 2] = gf.z * (1.f + sc.z); cm[i * 4 + 3] = gf.w * (1.f + sc.w);
    ca[i * 4 + 0] = sh.x; ca[i * 4 + 1] = sh.y; ca[i * 4 + 2] = sh.z; ca[i * 4 + 3] = sh.w;
  }
  const int stride = (nblk >> 1) * 4;
  for (int t0 = (bid >> 1) * 4 + wid; t0 < T; t0 += 2 * stride) {
    uint2 zu[2][4]; float4 xx[2][4];
#pragma unroll
    for (int k = 0; k < 2; ++k) {
      const int t = t0 + k * stride < T ? t0 + k * stride : T - 1;
      const long row = (long)b * T + t;
#pragma unroll
      for (int i = 0; i < 4; ++i) {
        zu[k][i] = *(const uint2*)(p.z + row * 1024 + i * 256 + lane * 4);
        xx[k][i] = *(const float4*)(p.x + row * 1024 + i * 256 + lane * 4);
      }
    }
#pragma unroll
    for (int k = 0; k < 2; ++k) {
      float zv[16], xv[16];
      float ss = 0.f;
#pragma unroll
      for (int i = 0; i < 4; ++i) {
        zv[i * 4 + 0] = lo16(zu[k][i].x); zv[i * 4 + 1] = hi16(zu[k][i].x); zv[i * 4 + 2] = lo16(zu[k][i].y); zv[i * 4 + 3] = hi16(zu[k][i].y);
        xv[i * 4 + 0] = xx[k][i].x; xv[i * 4 + 1] = xx[k][i].y; xv[i * 4 + 2] = xx[k][i].z; xv[i * 4 + 3] = xx[k][i].w;
#pragma unroll
        for (int j = 0; j < 4; ++j) ss += zv[i * 4 + j] * zv[i * 4 + j];
      }
      ss = wave_sum(ss);
      const float r = rsqrtf(ss * (1.f / 1024.f) + 1e-6f);
      float ss2 = 0.f;
#pragma unroll
      for (int j = 0; j < 16; ++j) {
        const float v = xv[j] + cz[j] * (zv[j] * r);
        xv[j] = v;
        ss2 += v * v;
      }
      ss2 = wave_sum(ss2);
      const float r2 = rsqrtf(ss2 * (1.f / 1024.f) + 1e-6f);
      if (t0 + k * stride < T) {
        const long row = (long)b * T + t0 + k * stride;
#pragma unroll
        for (int i = 0; i < 4; ++i) {
          const int col = i * 256 + lane * 4;
          *(float4*)(p.x1 + row * 1024 + col) = make_float4(xv[i * 4], xv[i * 4 + 1], xv[i * 4 + 2], xv[i * 4 + 3]);
          *(uint2*)(p.h + row * 1024 + col) = pack4(xv[i * 4] * r2 * cm[i * 4] + ca[i * 4], xv[i * 4 + 1] * r2 * cm[i * 4 + 1] + ca[i * 4 + 1],
                                                    xv[i * 4 + 2] * r2 * cm[i * 4 + 2] + ca[i * 4 + 2], xv[i * 4 + 3] * r2 * cm[i * 4 + 3] + ca[i * 4 + 3]);
        }
      }
    }
  }
}

struct EpiStoreF32 {
  float* dst; long ld; int m0, n0;
  DI void operator()(f32x16 (&acc)[2][2], int wm, int wn, int lane) const {
    constexpr int MT = 2;
    SW_FOR { *(float4*)(dst + (long)(m0 + SW_R) * ld + n0 + SW_C0) = make_float4(SW_V(0), SW_V(1), SW_V(2), SW_V(3)); }
  }
};
DI void phase11(const Params& p, char* smem, int bid, int nblk) {
  for (int item = bid; item < 256; item += nblk) {
    const int nt_ = item & 1, mt_ = item >> 1;
    ARows af{p.h + (long)mt_ * 128 * 1024, 1024, 128};
    BMatT bf{p.routerT + (long)nt_ * 128 * 1024, 1024};
    EpiStoreF32 ef{p.logits, 256, mt_ * 128, nt_ * 128};
    gemm_tile<true, false, true>(smem, 16, 64, af, bf, ef);
  }
}
DI void phase12(const Params& p, int bid, int nblk) {
  const int tid = TIDX(), lane = tid & 63, wid = __builtin_amdgcn_readfirstlane(tid >> 6);
  for (int tok = bid * 4 + wid; tok < NTOK; tok += nblk * 4) {
    const float4 lg = *(const float4*)(p.logits + (long)tok * 256 + lane * 4);
    const float4 rbv = *(const float4*)(p.router_bias + lane * 4);
    float sg[4] = {sigmoidf(lg.x), sigmoidf(lg.y), sigmoidf(lg.z), sigmoidf(lg.w)};
    float sl[4] = {sg[0] + rbv.x, sg[1] + rbv.y, sg[2] + rbv.z, sg[3] + rbv.w};
    float t1 = fmaxf(sl[0], sl[1]), t2 = fminf(sl[0], sl[1]);
#pragma unroll
    for (int j = 2; j < 4; ++j) {
      const float v = sl[j];
      t2 = fmaxf(t2, fminf(t1, v));
      t1 = fmaxf(t1, v);
    }
#define R_MERGE(CTRL)                                                                                                            \
    {                                                                                                                            \
      const float a1 = __int_as_float(__builtin_amdgcn_update_dpp(0, __float_as_int(t1), CTRL, 0xF, 0xF, true));                 \
      const float a2 = __int_as_float(__builtin_amdgcn_update_dpp(0, __float_as_int(t2), CTRL, 0xF, 0xF, true));                 \
      const float n1 = fmaxf(t1, a1);                                                                                            \
      const float n2 = fmaxf(fminf(t1, a1), fmaxf(t2, a2));                                                                      \
      t1 = n1; t2 = n2;                                                                                                          \
    }
    R_MERGE(DPP_QP1) R_MERGE(DPP_QP2) R_MERGE(DPP_RHM)
#undef R_MERGE
    const float gscore = t1 + t2;
    const int grp = lane >> 3;
    int rank = 0;
#pragma unroll
    for (int g2 = 0; g2 < 8; ++g2) {
      const float og = rdlane(gscore, g2 * 8);
      rank += (og > gscore || (og == gscore && g2 < grp)) ? 1 : 0;
    }
    const bool gsel = rank < 4;
    float cv[4];
#pragma unroll
    for (int j = 0; j < 4; ++j) cv[j] = gsel ? sl[j] : -1e30f;
    int my_e = -1; float my_s = 0.f; float ssum = 0.f;
    for (int r = 0; r < 8; ++r) {
      float bv = cv[0]; int bj = 0;
#pragma unroll
      for (int j = 1; j < 4; ++j) if (cv[j] > bv) { bv = cv[j]; bj = j; }
      int be = lane * 4 + bj;
      wave_argmax(bv, be);
      const int wl_ = be >> 2, wj = be & 3;
      const float s0 = rdlane(sg[0], wl_), s1 = rdlane(sg[1], wl_), s2 = rdlane(sg[2], wl_), s3 = rdlane(sg[3], wl_);
      const float bs = wj == 0 ? s0 : (wj == 1 ? s1 : (wj == 2 ? s2 : s3));
      if (wl_ == lane) {
        if (wj == 0) cv[0] = -3e30f; else if (wj == 1) cv[1] = -3e30f; else if (wj == 2) cv[2] = -3e30f; else cv[3] = -3e30f;
      }
      if (lane == r) { my_e = be; my_s = bs; }
      ssum += bs;
    }
    if (lane < 8) {
      const float w = my_s / ssum * 2.5f;
      const int rk = atomicAdd(p.counts + my_e, 1);
      p.eidx[tok * 8 + lane] = my_e;
      p.ewt[tok * 8 + lane] = w;
      p.erank[tok * 8 + lane] = rk;
    }
  }
}
DI void phase14(const Params& p, char* smem, int bid, int nblk) {
  const int tid = TIDX();
  int* s_cnt = (int*)smem;
  int* s_off = s_cnt + 256;
  const int cnt = p.counts[tid];
  s_cnt[tid] = cnt;
  hb_sync();
  int run = 0, nt = 0, nt2 = 0;
  for (int e = 0; e < tid; ++e) { const int c = s_cnt[e]; run += c; nt += (c + 127) >> 7; nt2 += (c + 255) >> 8; }
  s_off[tid] = run;
  hb_sync();
  if (bid == 0) {
    p.offs[tid] = run;
    for (int m = 0; m * 256 < cnt; ++m) {
      p.tile2_e[nt2] = tid;
      p.tile2_r0[nt2] = run + m * 256;
      p.tile2_nr[nt2] = (cnt - m * 256) > 256 ? 256 : (cnt - m * 256);
      ++nt2;
    }
    for (int m = 0; m * 128 < cnt; ++m) {
      p.tile_e[nt] = tid;
      p.tile_r0[nt] = run + m * 128;
      p.tile_nr[nt] = (cnt - m * 128) > 128 ? 128 : (cnt - m * 128);
      ++nt;
    }
    if (tid == 255) {
      p.offs[256] = run + cnt;
      for (int m = 0; m < 128; ++m) {
        p.tile_e[nt] = 256;
        p.tile_r0[nt] = 131072 + m * 128;
        p.tile_nr[nt] = 128;
        ++nt;
      }
      p.ntiles[0] = nt;
      for (int m = 0; m < 64; ++m) {
        p.tile2_e[nt2] = 256;
        p.tile2_r0[nt2] = 131072 + m * 256;
        p.tile2_nr[nt2] = 256;
        ++nt2;
      }
      p.ntiles[1] = nt2;
    }
  }
  for (int i = bid * 256 + tid; i < NSLOT; i += nblk * 256) {
    if (i < 131072) {
      const int e = p.eidx[i];
      const int slot = s_off[e] + p.erank[i];
      p.slot_tok[slot] = i >> 3;
      p.slot_wt[slot] = p.ewt[i];
      p.tok_slot[i] = slot;
    } else {
      p.slot_tok[i] = i - 131072;
      p.slot_wt[i] = 1.f;
    }
  }
}

struct AGather {
  const u16* h; const int* slot_tok; int r0, nr;
  DI const u16* operator()(int r) const { return h + (long)slot_tok[r0 + (r < nr ? r : 0)] * 1024; }
  DI const u16* origin() const { return h; } DI int off(int r) const { return slot_tok[r0 + (r < nr ? r : 0)] * 1024; }
};
struct BGateUp {
  const float* wg; long udiff; long ldb; int n0;
  DI const float* operator()(int c4) const {
    const int wn = c4 >> 6, ntl = (c4 >> 5) & 1, j = c4 & 31;
    return wg + (long)ntl * udiff + n0 + wn * 32 + j;
  }
  DI const u16* row(int) const { return nullptr; }
};
struct EpiH {
  u16* H; int r0, nr, n0;
  template <int MT> DI void operator()(f32x16 (&acc)[MT][2], int wm, int wn, int lane) const {
#pragma unroll
    for (int mt = 0; mt < MT; ++mt) {
      const int r = SW_R;
      if (r < nr) {
#pragma unroll
        for (int q4 = 0; q4 < 4; ++q4) {
          float v[4];
#pragma unroll
          for (int j = 0; j < 4; ++j) v[j] = siluf(acc[mt][0][4 * q4 + j]) * acc[mt][1][4 * q4 + j];
          *(uint2*)(H + (long)(r0 + r) * 256 + n0 + wn * 32 + 8 * q4 + 4 * (lane >> 5)) = pack4(v[0], v[1], v[2], v[3]);
        }
      }
    }
  }
};
struct BGateUp8 {
  const float* wg; long udiff; long ldb; int n0;
  DI const float* operator()(int c4) const {
    const int wn = c4 >> 6, ntl = (c4 >> 5) & 1, j = c4 & 31;
    return wg + (long)ntl * udiff + n0 + wn * 32 + j;
  }
};
DI void phase15_8w(const Params& p, int wg, int nwg) {
  const int ntl = p.ntiles[1];
  for (int item = wg; item < ntl * 2; item += nwg) {
    const int ti = item >> 1, nt_ = item & 1;
    const int e = p.tile2_e[ti], r0 = p.tile2_r0[ti], nr = p.tile2_nr[ti];
    AGather af{p.h, p.slot_tok, r0, nr};
    const float* wgp = e < 256 ? p.w_eg + (long)e * 1024 * 256 : p.w_sg;
    const float* wup = e < 256 ? p.w_eu + (long)e * 1024 * 256 : p.w_su;
    BGateUp8 bf{wgp, (long)(wup - wgp), 256, nt_ * 128};
    EpiH ef{p.H, r0, nr, nt_ * 128};
    gemm8w<false>(16, af, bf, ef);
  }
}
struct EpiYexp {
  u16* Y; const float* slot_wt; int r0, nr, n0;
  template <int MT> DI void operator()(f32x16 (&acc)[MT][2], int wm, int wn, int lane) const {
#pragma unroll
    for (int mt = 0; mt < MT; ++mt) {
      const int r = SW_R;
      if (r < nr) {
        const float w = slot_wt[r0 + r];
#pragma unroll
        for (int nt = 0; nt < 2; ++nt)
#pragma unroll
          for (int q4 = 0; q4 < 4; ++q4)
            *(uint2*)(Y + (long)(r0 + r) * 1024 + n0 + SW_C0) = pack4(SW_V(0) * w, SW_V(1) * w, SW_V(2) * w, SW_V(3) * w);
      }
    }
  }
};
DI void phase16_8w(const Params& p, int wg, int nwg) {
  const int ntl = p.ntiles[1];
  for (int item = wg; item < ntl * 4; item += nwg) {
    const int ti = item >> 2, nt_ = item & 3;
    const int e = p.tile2_e[ti], r0 = p.tile2_r0[ti], nr = p.tile2_nr[ti];
    ARows af{p.H + (long)r0 * 256, 256, nr};
    const float* wd = e < 256 ? p.w_ed + (long)e * 256 * 1024 : p.w_sd;
    BMat bf{wd + nt_ * 256, 1024, 256};
    EpiYexp ef{p.Y, p.slot_wt, r0, nr, nt_ * 256};
    gemm8w<false>(4, af, bf, ef);
  }
}
DI void phase17(const Params& p, int bid, int nblk) {
  const int tid = TIDX(), lane = tid & 63, wid = __builtin_amdgcn_readfirstlane(tid >> 6);
  const int b = bid & 1;
  const float* modb = p.mod + b * 6144;
  float cy[16];
#pragma unroll
  for (int i = 0; i < 4; ++i) {
    const int col = i * 256 + lane * 4;
    const float4 gt = *(const float4*)(modb + 5120 + col), gp = *(const float4*)(p.g_post_ffn + col);
    cy[i * 4 + 0] = gt.x * gp.x; cy[i * 4 + 1] = gt.y * gp.y; cy[i * 4 + 2] = gt.z * gp.z; cy[i * 4 + 3] = gt.w * gp.w;
  }
  const int stride = (nblk >> 1) * 4;
  for (int t0 = (bid >> 1) * 4 + wid; t0 < T; t0 += 2 * stride) {
    long rows[2];
    int slots[2][8];
#pragma unroll
    for (int k = 0; k < 2; ++k) {
      const int t = t0 + k * stride < T ? t0 + k * stride : T - 1;
      rows[k] = (long)b * T + t;
      const int4 s0 = *(const int4*)(p.tok_slot + rows[k] * 8), s1 = *(const int4*)(p.tok_slot + rows[k] * 8 + 4);
      slots[k][0] = s0.x; slots[k][1] = s0.y; slots[k][2] = s0.z; slots[k][3] = s0.w;
      slots[k][4] = s1.x; slots[k][5] = s1.y; slots[k][6] = s1.z; slots[k][7] = s1.w;
    }
    float4 xx[2][4];
#pragma unroll
    for (int k = 0; k < 2; ++k)
#pragma unroll
      for (int i = 0; i < 4; ++i) xx[k][i] = *(const float4*)(p.x1 + rows[k] * 1024 + i * 256 + lane * 4);
#pragma unroll
    for (int k = 0; k < 2; ++k) {
      float yv[16];
#pragma unroll
      for (int j = 0; j < 16; ++j) yv[j] = 0.f;
#pragma unroll
      for (int q = 0; q < 9; ++q) {
        const long sl = q < 8 ? (long)slots[k][q] : 131072 + rows[k];
#pragma unroll
        for (int i = 0; i < 4; ++i) {
          const uint2 u = *(const uint2*)(p.Y + sl * 1024 + i * 256 + lane * 4);
          yv[i * 4 + 0] += lo16(u.x); yv[i * 4 + 1] += hi16(u.x); yv[i * 4 + 2] += lo16(u.y); yv[i * 4 + 3] += hi16(u.y);
        }
      }
      float ss = 0.f;
#pragma unroll
      for (int j = 0; j < 16; ++j) ss += yv[j] * yv[j];
      ss = wave_sum(ss);
      const float r = rsqrtf(ss * (1.f / 1024.f) + 1e-6f);
      if (t0 + k * stride < T) {
#pragma unroll
        for (int i = 0; i < 4; ++i) {
          const int col = i * 256 + lane * 4;
          *(float4*)(p.out + rows[k] * 1024 + col) = make_float4(xx[k][i].x + cy[i * 4] * (yv[i * 4] * r), xx[k][i].y + cy[i * 4 + 1] * (yv[i * 4 + 1] * r),
                                                                 xx[k][i].z + cy[i * 4 + 2] * (yv[i * 4 + 2] * r), xx[k][i].w + cy[i * 4 + 3] * (yv[i * 4 + 3] * r));
        }
      }
    }
  }
}

__global__ void __launch_bounds__(512, 2) mega(Params p) {
  cg::grid_group grid = cg::this_grid();
  const int vb = __builtin_amdgcn_readfirstlane((int)(threadIdx.x >> 8));
  char* smem = g_smem + vb * HALF_LDS;
  const int bid = blockIdx.x * 2 + vb, nblk = gridDim.x * 2;
  if (p.phase_hi == 12345) grid.sync();
  if (threadIdx.x < 32) ((unsigned*)(g_smem + 2 * HALF_LDS))[threadIdx.x] = 0u;
  __syncthreads();
  const XcdBarrier xb = xcd_barrier_post(p.bar, (volatile LAS unsigned*)(g_smem + 2 * HALF_LDS));
#if !defined(ONLY) || ONLY==0
  if (p.phase_lo <= 0 && 0 < p.phase_hi) {
    phase0(p, smem, bid, nblk);
#if (REPEAT_MASK >> 0) & 1
    xcd_barrier(xb);
    phase0(p, smem, bid, nblk);
#endif
    if (0 + 1 < p.phase_hi) xcd_barrier(xb);
  }
#endif
#if !defined(ONLY) || ONLY==1
  if (p.phase_lo <= 1 && 1 < p.phase_hi) {
    phase1(p, smem, bid, nblk);
#if (REPEAT_MASK >> 1) & 1
    xcd_barrier(xb);
    phase1(p, smem, bid, nblk);
#endif
    if (1 + 1 < p.phase_hi) xcd_barrier(xb);
  }
#endif
#if !defined(ONLY) || ONLY==2
  if (p.phase_lo <= 2 && 2 < p.phase_hi) {
    phase2_8w(p, blockIdx.x, gridDim.x);
    __syncthreads();
    phase2(p, smem, bid, nblk);
#if (REPEAT_MASK >> 2) & 1
    xcd_barrier(xb);
    phase2_8w(p, blockIdx.x, gridDim.x);
    __syncthreads();
    phase2(p, smem, bid, nblk);
#endif
    if (2 + 1 < p.phase_hi) xcd_barrier(xb);
  }
#endif
#if !defined(ONLY) || ONLY==3
  if (p.phase_lo <= 3 && 3 < p.phase_hi) {
    phase3(p, smem, bid, nblk);
#if (REPEAT_MASK >> 3) & 1
    xcd_barrier(xb);
    phase3(p, smem, bid, nblk);
#endif
    if (3 + 1 < p.phase_hi) xcd_barrier(xb);
  }
#endif
#if !defined(ONLY) || ONLY==4
  if (p.phase_lo <= 4 && 4 < p.phase_hi) {
    phase4(p, smem, bid, nblk);
#if (REPEAT_MASK >> 4) & 1
    xcd_barrier(xb);
    phase4(p, smem, bid, nblk);
#endif
    if (4 + 1 < p.phase_hi) xcd_barrier(xb);
  }
#endif
#if !defined(ONLY) || ONLY==5
  if (p.phase_lo <= 5 && 5 < p.phase_hi) {
    phase5_nsa8(p);
    phase5(p, smem, bid, nblk);
#if (REPEAT_MASK >> 5) & 1
    xcd_barrier(xb);
    phase5_nsa8(p);
    phase5(p, smem, bid, nblk);
#endif
    if (5 + 1 < p.phase_hi) xcd_barrier(xb);
  }
#endif
#if !defined(ONLY) || ONLY==7
  if (p.phase_lo <= 7 && 7 < p.phase_hi) {
    phase7(p, smem, bid, nblk);
#if (REPEAT_MASK >> 7) & 1
    xcd_barrier(xb);
    phase7(p, smem, bid, nblk);
#endif
    if (7 + 1 < p.phase_hi) xcd_barrier(xb);
  }
#endif
#if !defined(ONLY) || ONLY==8
  if (p.phase_lo <= 8 && 8 < p.phase_hi) {
    phase8_8w(p, blockIdx.x, gridDim.x);
#if (REPEAT_MASK >> 8) & 1
    xcd_barrier(xb);
    phase8_8w(p, blockIdx.x, gridDim.x);
#endif
    if (8 + 1 < p.phase_hi) xcd_barrier(xb);
  }
#endif
#if !defined(ONLY) || ONLY==9
  if (p.phase_lo <= 9 && 9 < p.phase_hi) {
    phase9_8w(p, blockIdx.x, gridDim.x);
#if (REPEAT_MASK >> 9) & 1
    xcd_barrier(xb);
    phase9_8w(p, blockIdx.x, gridDim.x);
#endif
    if (9 + 1 < p.phase_hi) xcd_barrier(xb);
  }
#endif
#if !defined(ONLY) || ONLY==10
  if (p.phase_lo <= 10 && 10 < p.phase_hi) {
    phase10(p, bid, nblk);
#if (REPEAT_MASK >> 10) & 1
    xcd_barrier(xb);
    phase10(p, bid, nblk);
#endif
    if (10 + 1 < p.phase_hi) xcd_barrier(xb);
  }
#endif
#if !defined(ONLY) || ONLY==11
  if (p.phase_lo <= 11 && 11 < p.phase_hi) {
    phase11(p, smem, bid, nblk);
#if (REPEAT_MASK >> 11) & 1
    xcd_barrier(xb);
    phase11(p, smem, bid, nblk);
#endif
    if (11 + 1 < p.phase_hi) xcd_barrier(xb);
  }
#endif
#if !defined(ONLY) || ONLY==12
  if (p.phase_lo <= 12 && 12 < p.phase_hi) {
    phase12(p, bid, nblk);
#if (REPEAT_MASK >> 12) & 1
    xcd_barrier(xb);
    phase12(p, bid, nblk);
#endif
    if (12 + 1 < p.phase_hi) xcd_barrier(xb);
  }
#endif
#if !defined(ONLY) || ONLY==14
  if (p.phase_lo <= 14 && 14 < p.phase_hi) {
    phase14(p, smem, bid, nblk);
#if (REPEAT_MASK >> 14) & 1
    xcd_barrier(xb);
    phase14(p, smem, bid, nblk);
#endif
    if (14 + 1 < p.phase_hi) xcd_barrier(xb);
  }
#endif
#if !defined(ONLY) || ONLY==15
  if (p.phase_lo <= 15 && 15 < p.phase_hi) {
    phase15_8w(p, blockIdx.x, gridDim.x);
#if (REPEAT_MASK >> 15) & 1
    xcd_barrier(xb);
    phase15_8w(p, blockIdx.x, gridDim.x);
#endif
    if (15 + 1 < p.phase_hi) xcd_barrier(xb);
  }
#endif
#if !defined(ONLY) || ONLY==16
  if (p.phase_lo <= 16 && 16 < p.phase_hi) {
    phase16_8w(p, blockIdx.x, gridDim.x);
#if (REPEAT_MASK >> 16) & 1
    xcd_barrier(xb);
    phase16_8w(p, blockIdx.x, gridDim.x);
#endif
    if (16 + 1 < p.phase_hi) xcd_barrier(xb);
  }
#endif
#if !defined(ONLY) || ONLY==17
  if (p.phase_lo <= 17 && 17 < p.phase_hi) {
    phase17(p, bid, nblk);
#if (REPEAT_MASK >> 17) & 1
    xcd_barrier(xb);
    phase17(p, bid, nblk);
#endif
    if (17 + 1 < p.phase_hi) xcd_barrier(xb);
  }
#endif
}

extern "C" void kernel_launch(void* const* d_in, const int* in_sizes, int n_in, void* d_out, int out_size, void* d_ws, size_t ws_size,
                              hipStream_t stream) {
  static int grid_blocks = 0;
  if (!grid_blocks) {
    int dev = 0, cus = 0, per_cu = 0;
    (void)hipGetDevice(&dev);
    (void)hipDeviceGetAttribute(&cus, hipDeviceAttributeMultiprocessorCount, dev);
    (void)hipOccupancyMaxActiveBlocksPerMultiprocessor(&per_cu, mega, 512, 0);
    if (per_cu > 1) per_cu = 1;
    if (per_cu < 1) per_cu = 1;
    grid_blocks = cus * per_cu;
  }
  Params p{};
  const float* const* in = (const float* const*)d_in;
  p.x = in[0]; p.c = in[1]; p.w_ada = in[2]; p.b_ada = in[3]; p.g_pre_mix = in[4]; p.g_post_mix = in[5]; p.g_pre_ffn = in[6]; p.g_post_ffn = in[7];
  p.w_in = in[8]; p.rel_bias = in[9]; p.cmp_pe = in[10]; p.cmp_w1 = in[11]; p.cmp_b1 = in[12]; p.cmp_w2 = in[13]; p.dsa_kv_norm = in[14];
  p.dsa_w_uk = in[15]; p.dsa_w_uv = in[16]; p.w_bn = in[17]; p.w_bd = in[18]; p.w_out = in[19]; p.router_w = in[20]; p.router_bias = in[21];
  p.w_eg = in[22]; p.w_eu = in[23]; p.w_ed = in[24]; p.w_sg = in[25]; p.w_su = in[26]; p.w_sd = in[27];
  p.out = (float*)d_out;
  char* ws = (char*)d_ws;
  size_t off = 0;
  auto alloc = [&](size_t bytes) { char* r = ws + off; off += (bytes + 255) & ~(size_t)255; return r; };
  p.bar = (unsigned*)alloc(XCD_BAR_WORDS * 4);
  p.modp = (float*)alloc(16 * 2 * 6144 * 4);
  p.mod = (float*)alloc(2 * 6144 * 4);
  p.pe_part = (float*)alloc(16 * 256 * 4);
  p.w_ukT = (float*)alloc(8 * 64 * 128 * 4);
  p.w_inT = (u16*)alloc((size_t)4608 * 1024 * 2);
  p.w_bnT = (u16*)alloc((size_t)1024 * 512 * 2);
  p.w_bdT = (u16*)alloc((size_t)1024 * 512 * 2);
  p.w_outT = (u16*)alloc((size_t)1024 * 1024 * 2);
  p.routerT = (u16*)alloc((size_t)256 * 1024 * 2);
  p.counts = (int*)alloc(256 * 4);
  p.offs = (int*)alloc(257 * 4);
  p.tile_e = (int*)alloc(1536 * 4);
  p.tile_r0 = (int*)alloc(1536 * 4);
  p.tile_nr = (int*)alloc(1536 * 4);
  p.ntiles = (int*)alloc(8);
  p.tile2_e = (int*)alloc(1024 * 4);
  p.tile2_r0 = (int*)alloc(1024 * 4);
  p.tile2_nr = (int*)alloc(1024 * 4);
  p.h = (u16*)alloc((size_t)NTOK * 1024 * 2);
  p.proj = (u16*)alloc((size_t)NTOK * LDP * 2);
  p.widx = (float*)alloc((size_t)NTOK * 8 * 4);
  p.zc = (u16*)alloc((size_t)2 * 2048 * 128 * 2);
  p.kc = (u16*)alloc((size_t)4 * 512 * 64 * 2);
  p.vcT = (u16*)alloc((size_t)4 * 512 * 64 * 2);
  p.vts = (u16*)alloc((size_t)4 * 64 * T * 2);
  p.vtw = (u16*)alloc((size_t)4 * 64 * T * 2);
  p.qlat = (u16*)alloc((size_t)NTOK * 1024 * 2);
  p.ckv = (u16*)alloc((size_t)NTOK * 128 * 2);
  p.selk = (int*)alloc((size_t)NTOK * 256 * 4);
  p.onsa = (u16*)alloc((size_t)NTOK * 512 * 2);
  p.olat = (u16*)alloc((size_t)NTOK * 1024 * 2);
  p.odsa = (u16*)alloc((size_t)NTOK * 512 * 2);
  p.y = p.qlat;
  p.z = p.olat;
  p.eidx = (int*)alloc((size_t)NTOK * 8 * 4);
  p.ewt = (float*)alloc((size_t)NTOK * 8 * 4);
  p.erank = (int*)alloc((size_t)NTOK * 8 * 4);
  p.slot_tok = (int*)alloc((size_t)NSLOT * 4);
  p.slot_wt = (float*)alloc((size_t)NSLOT * 4);
  p.tok_slot = (int*)alloc((size_t)NTOK * 8 * 4);
  char* big = alloc((size_t)2 * T * T * 4);
  p.scores = (float*)big;
  {
    size_t o2 = 0;
    auto sub = [&](size_t bytes) { char* r = big + o2; o2 += (bytes + 255) & ~(size_t)255; return r; };
    p.H = (u16*)sub((size_t)NSLOT * 256 * 2);
    p.Y = (u16*)sub((size_t)NSLOT * 1024 * 2);
    p.x1 = (float*)sub((size_t)NTOK * 1024 * 4);
    p.logits = (float*)sub((size_t)NTOK * 256 * 4);
  }
  if (off > ws_size) fprintf(stderr, "workspace too small: need %zu have %zu\n", off, ws_size);
  p.phase_lo = 0;
  p.phase_hi = 18;
  (void)hipMemsetAsync(p.bar, 0, XCD_BAR_WORDS * 4, stream);
  void* args[] = {&p};
  hipError_t e = hipLaunchCooperativeKernel((void*)mega, dim3(grid_blocks), dim3(512), args, 0, stream);
  if (e != hipSuccess) fprintf(stderr, "coop launch failed: %s (grid %d)\n", hipGetErrorString(e), grid_blocks);
}
```

```cpp
#include <hip/hip_runtime.h>
#include <hip/hip_cooperative_groups.h>
#include <cstdio>
namespace cg = cooperative_groups;

#define DI __device__ __forceinline__
typedef unsigned short u16;
typedef unsigned long long u64;
using bf16x8 = __attribute__((ext_vector_type(8))) short;
using f32x16 = __attribute__((ext_vector_type(16))) float;
using f32x4 = __attribute__((ext_vector_type(4))) float;

constexpr int T = 8192;
constexpr int NTOK = 16384;
constexpr int LDP = 4576;
constexpr int C_QN = 0, C_KV = 512, C_GN = 1280, C_QD = 1304, C_CKV = 1816, C_QI = 1944, C_KI = 2456, C_WI = 2520, C_GM = 2528;
constexpr int NSLOT = 131072 + 16384;
constexpr int HALF_LDS = 73728;
constexpr int LDS_BYTES = 2 * HALF_LDS + 128;
__shared__ __attribute__((aligned(16))) char g_smem[LDS_BYTES];
#ifndef REPEAT_MASK
#define REPEAT_MASK 0
#endif

__device__ const unsigned char BUCKET[128] = {
  0, 1, 2, 3, 4, 5, 6, 7, 8, 9, 10, 11, 12, 13, 14, 15, 16, 16, 16, 17, 17, 18, 18, 18, 19, 19, 19, 20, 20, 20, 20, 21,
  21, 21, 21, 22, 22, 22, 22, 22, 23, 23, 23, 23, 23, 23, 24, 24, 24, 24, 24, 24, 25, 25, 25, 25, 25, 25, 25, 26, 26, 26, 26, 26,
  26, 26, 26, 27, 27, 27, 27, 27, 27, 27, 27, 27, 27, 28, 28, 28, 28, 28, 28, 28, 28, 28, 28, 29, 29, 29, 29, 29, 29, 29, 29, 29,
  29, 29, 29, 30, 30, 30, 30, 30, 30, 30, 30, 30, 30, 30, 30, 30, 30, 31, 31, 31, 31, 31, 31, 31, 31, 31, 31, 31, 31, 31, 31, 31};

struct Params {
  const float *x, *c, *w_ada, *b_ada, *g_pre_mix, *g_post_mix, *g_pre_ffn, *g_post_ffn, *w_in, *rel_bias;
  const float *cmp_pe, *cmp_w1, *cmp_b1, *cmp_w2, *dsa_kv_norm, *dsa_w_uk, *dsa_w_uv, *w_bn, *w_bd, *w_out;
  const float *router_w, *router_bias, *w_eg, *w_eu, *w_ed, *w_sg, *w_su, *w_sd;
  float* out;
  float* modp;
  float* mod;
  float* pe_part;
  float* w_ukT;
  u16 *w_inT, *w_bnT, *w_bdT, *w_outT, *routerT;
  u16* h;
  u16* proj;
  float* widx;
  u16* zc;
  u16* kc;
  u16* vcT;
  u16* vts;
  u16* vtw;
  u16* qlat;
  u16* ckv;
  float* scores;
  int* selk;
  u16* onsa;
  u16* olat;
  u16* odsa;
  u16* y;
  u16* z;
  float* x1;
  float* logits;
  int* eidx;
  float* ewt;
  int* erank;
  int* counts;
  int* offs;
  int* tile_e;
  int* tile_r0;
  int* tile_nr;
  int* ntiles;
  int *tile2_e, *tile2_r0, *tile2_nr;
  int* slot_tok;
  float* slot_wt;
  int* tok_slot;
  u16* H;
  u16* Y;
  unsigned* bar;
  int phase_lo, phase_hi;
};

DI float bf2f(u16 v) { return __uint_as_float(((unsigned)v) << 16); }
typedef __bf16 bf16x2_t __attribute__((ext_vector_type(2)));
typedef float f32x2_t __attribute__((ext_vector_type(2)));
DI unsigned pack2(float a, float b) { f32x2_t v = {a, b}; return __builtin_bit_cast(unsigned, __builtin_convertvector(v, bf16x2_t)); }
DI u16 f2bf(float x) { return (u16)(pack2(x, x) & 0xffffu); }
DI float lo16(unsigned u) { return __uint_as_float(u << 16); }
DI float hi16(unsigned u) { return __uint_as_float(u & 0xffff0000u); }
DI float wave_sum(float v) { for (int o = 32; o; o >>= 1) v += __shfl_xor(v, o); return v; }
DI float wave_max(float v) { for (int o = 32; o; o >>= 1) v = fmaxf(v, __shfl_xor(v, o)); return v; }
#define DPP_QP1 0xB1
#define DPP_QP2 0x4E
#define DPP_RHM 0x141
#define DPP_RM  0x140
#define DPP_B15 0x142
#define DPP_B31 0x143
DI int wave_sum_i(int x) {
  x += __builtin_amdgcn_update_dpp(0, x, DPP_QP1, 0xF, 0xF, true);
  x += __builtin_amdgcn_update_dpp(0, x, DPP_QP2, 0xF, 0xF, true);
  x += __builtin_amdgcn_update_dpp(0, x, DPP_RHM, 0xF, 0xF, true);
  x += __builtin_amdgcn_update_dpp(0, x, DPP_RM, 0xF, 0xF, true);
  x += __builtin_amdgcn_update_dpp(0, x, DPP_B15, 0xA, 0xF, true);
  x += __builtin_amdgcn_update_dpp(0, x, DPP_B31, 0xC, 0xF, true);
  return __builtin_amdgcn_readlane(x, 63);
}
#define DPP_SELF(x, CTRL, RM) ((unsigned)__builtin_amdgcn_update_dpp((int)(x), (int)(x), CTRL, RM, 0xF, false))
DI unsigned wave_max_u(unsigned x) {
  x = max(x, DPP_SELF(x, DPP_QP1, 0xF)); x = max(x, DPP_SELF(x, DPP_QP2, 0xF)); x = max(x, DPP_SELF(x, DPP_RHM, 0xF));
  x = max(x, DPP_SELF(x, DPP_RM, 0xF)); x = max(x, DPP_SELF(x, DPP_B15, 0xA)); x = max(x, DPP_SELF(x, DPP_B31, 0xC));
  return (unsigned)__builtin_amdgcn_readlane((int)x, 63);
}
DI unsigned wave_min_u(unsigned x) {
  x = min(x, DPP_SELF(x, DPP_QP1, 0xF)); x = min(x, DPP_SELF(x, DPP_QP2, 0xF)); x = min(x, DPP_SELF(x, DPP_RHM, 0xF));
  x = min(x, DPP_SELF(x, DPP_RM, 0xF)); x = min(x, DPP_SELF(x, DPP_B15, 0xA)); x = min(x, DPP_SELF(x, DPP_B31, 0xC));
  return (unsigned)__builtin_amdgcn_readlane((int)x, 63);
}
DI void wave_argmax(float& v, int& idx) {
#define AM_STEP(CTRL, RM)                                                                                                   \
  {                                                                                                                         \
    const float ov_ = __int_as_float(__builtin_amdgcn_update_dpp(__float_as_int(v), __float_as_int(v), CTRL, RM, 0xF, false)); \
    const int oi_ = __builtin_amdgcn_update_dpp(idx, idx, CTRL, RM, 0xF, false);                                            \
    const bool tk_ = ov_ > v || (ov_ == v && oi_ < idx);                                                                    \
    v = tk_ ? ov_ : v;                                                                                                      \
    idx = tk_ ? oi_ : idx;                                                                                                  \
  }
  AM_STEP(DPP_QP1, 0xF) AM_STEP(DPP_QP2, 0xF) AM_STEP(DPP_RHM, 0xF) AM_STEP(DPP_RM, 0xF) AM_STEP(DPP_B15, 0xA) AM_STEP(DPP_B31, 0xC)
#undef AM_STEP
  v = __int_as_float(__builtin_amdgcn_readlane(__float_as_int(v), 63));
  idx = __builtin_amdgcn_readlane(idx, 63);
}
DI float rdlane(float v, int l) { return __int_as_float(__builtin_amdgcn_readlane(__float_as_int(v), l)); }
DI int rdlane_i(int v, int l) { return __builtin_amdgcn_readlane(v, l); }
DI int TIDX() { int t = threadIdx.x & 255; asm volatile("" : "+v"(t)); return t; }
DI int TIDX8() { int t = threadIdx.x; asm volatile("" : "+v"(t)); return t; }
DI void hb_sync() {
  asm volatile("s_waitcnt vmcnt(0) lgkmcnt(0)" ::: "memory");
  const int vb = __builtin_amdgcn_readfirstlane((int)(threadIdx.x >> 8));
  volatile __attribute__((address_space(3))) unsigned* cnt = (volatile __attribute__((address_space(3))) unsigned*)(g_smem + 2 * HALF_LDS + 64) + vb * 8;
  if ((threadIdx.x & 63) == 0) {
    const unsigned old = __hip_atomic_fetch_add((__attribute__((address_space(3))) unsigned*)cnt, 1u, __ATOMIC_RELAXED, __HIP_MEMORY_SCOPE_WORKGROUP);
    const unsigned target = (old & ~3u) + 4u;
    while ((int)(*cnt - target) < 0) __builtin_amdgcn_s_sleep(0);
  }
  asm volatile("s_waitcnt lgkmcnt(0)" ::: "memory");
  __builtin_amdgcn_wave_barrier();
}
DI void cbar(const void* p) { asm volatile("" ::"v"(p) : "memory"); }
DI void wave_sync() { asm volatile("s_waitcnt lgkmcnt(0)" ::: "memory"); __builtin_amdgcn_wave_barrier(); }
DI float sigmoidf(float x) { return 1.f / (1.f + __expf(-x)); }
DI float siluf(float x) { return x / (1.f + __expf(-x)); }
DI float gelu_tanh(float x) { float u = 0.7978845608028654f * (x + 0.044715f * x * x * x); float e = __expf(2.f * u); float th = 1.f - 2.f / (e + 1.f); return 0.5f * x * (1.f + th); }


#define XB_TMO      128
#define XB_XCNT(j)  (256  + 64 * (j))
#define XB_XSUB(j)  (1280 + 64 * (j))
#define XB_XGEN(j)  (2304 + 64 * (j))
#define XB_TOP      3328
#define XB_TOPGEN   3392
#define XCD_BAR_WORDS 3456
#define XB_SPIN_CAP (1u << 22)
#define LAS __attribute__((address_space(3)))
DI unsigned xb_ld(unsigned* p) { return __hip_atomic_load(p, __ATOMIC_RELAXED, __HIP_MEMORY_SCOPE_AGENT); }
DI unsigned xb_add(unsigned* p, unsigned v) { return __hip_atomic_fetch_add(p, v, __ATOMIC_RELAXED, __HIP_MEMORY_SCOPE_AGENT); }
DI unsigned xb_xcc_id() { return (unsigned)__builtin_amdgcn_s_getreg((3 << 11) | 20) & 0xFu; }
#define XB_SPIN(cond, bar) do { unsigned _sp = 0; while (cond) { __builtin_amdgcn_s_sleep(1); \
    if ((++_sp & 255u) == 0u) { if (xb_ld(&(bar)[XB_TMO])) break; if (_sp > XB_SPIN_CAP) { atomicAdd(&(bar)[XB_TMO], 1u); break; } } } } while (0)
struct XcdBarrier { unsigned* bar; unsigned x; volatile LAS unsigned* st; };
DI XcdBarrier xcd_barrier_post(unsigned* bar, volatile LAS unsigned* st) {
  XcdBarrier b; b.bar = bar; b.x = xb_xcc_id(); b.st = st;
  if (threadIdx.x == 0) (void)xb_add(&bar[XB_XCNT(b.x)], 1u);
  return b;
}
DI void xcd_barrier_complete(unsigned* bar, unsigned x, unsigned& nloc, unsigned& nx) {
  const unsigned G = gridDim.x * gridDim.y * gridDim.z;
  unsigned sum, cnt, mine, sp = 0u;
  for (;;) {
    sum = 0u; cnt = 0u; mine = 0u;
#pragma unroll
    for (unsigned j = 0; j < 16; ++j) { const unsigned c = xb_ld(&bar[XB_XCNT(j)]); sum += c; cnt += (c > 0u) ? 1u : 0u; mine = (j == x) ? c : mine; }
    if (sum == G) break;
    __builtin_amdgcn_s_sleep(1);
    if ((++sp & 255u) == 0u) { if (xb_ld(&bar[XB_TMO])) break; if (sp > XB_SPIN_CAP) { atomicAdd(&bar[XB_TMO], 1u); break; } }
  }
  nloc = mine > 0u ? mine : 1u; nx = cnt > 0u ? cnt : 1u;
}
DI void xcd_barrier(const XcdBarrier& b) {
  asm volatile("s_waitcnt vmcnt(0)" ::: "memory");
  __syncthreads();
  if (threadIdx.x == 0) {
    unsigned* bar = b.bar;
    __builtin_amdgcn_s_waitcnt(0);
    unsigned nloc = b.st[0], nx = b.st[1];
    if (nloc == 0u) { xcd_barrier_complete(bar, b.x, nloc, nx); b.st[0] = nloc; b.st[1] = nx; }
    const unsigned old = xb_add(&bar[XB_XSUB(b.x)], 1u);
    const unsigned gen = old / nloc;
    if (old + 1u == (gen + 1u) * nloc) {
      __builtin_amdgcn_fence(__ATOMIC_RELEASE, "agent");
      asm volatile("s_waitcnt vmcnt(0)" ::: "memory");
      const unsigned og = xb_add(&bar[XB_TOP], 1u);
      const unsigned tg = og / nx;
      if (og + 1u == (tg + 1u) * nx) xb_add(&bar[XB_TOPGEN], 1u);
      else XB_SPIN(xb_ld(&bar[XB_TOPGEN]) == tg, bar);
      __builtin_amdgcn_fence(__ATOMIC_ACQUIRE, "agent");
      xb_add(&bar[XB_XGEN(b.x)], 1u);
      asm volatile("s_waitcnt vmcnt(0)" ::: "memory");
    } else {
      XB_SPIN(xb_ld(&bar[XB_XGEN(b.x)]) == gen, bar);
      __builtin_amdgcn_fence(__ATOMIC_ACQUIRE, "agent");
      asm volatile("s_waitcnt vmcnt(0)" ::: "memory");
    }
  }
  __syncthreads();
}

template <bool SWAP = true, bool SINGLE = false, bool BT16 = false, class AF, class BF, class EF>
DI void gemm_tile(char* smem, int nk, long a_kstep, const AF& af, const BF& bf, const EF& ef) {
  asm volatile("" ::: "memory");
  u16* As = (u16*)smem;
  const int tid = TIDX(), lane = tid & 63, wid = __builtin_amdgcn_readfirstlane(tid >> 6), wm = wid >> 1, wn = wid & 1;
  const int arow = tid >> 1, ahalf = tid & 1;
  const u16* ap = af(arow) + ahalf * 32;
  const int bkq = lane & 7, bnq = wid * 8 + (lane >> 3);
  const long ldb = bf.ldb;
  const float* bp = nullptr;
  const u16* bp16 = nullptr;
  if constexpr (BT16) bp16 = bf.row(arow) + ahalf * 32;
  else bp = bf(bnq * 4) + (long)(bkq * 4) * ldb;
  uint4 sa0_0, sa0_1, sa0_2, sa0_3, sa1_0, sa1_1, sa1_2, sa1_3;
  float4 sb0_0, sb0_1, sb0_2, sb0_3, sb0_4, sb0_5, sb0_6, sb0_7, sb1_0, sb1_1, sb1_2, sb1_3, sb1_4, sb1_5, sb1_6, sb1_7;
  uint4 tb0_0, tb0_1, tb0_2, tb0_3, tb1_0, tb1_1, tb1_2, tb1_3;
  f32x16 acc[2][2];
#pragma unroll
  for (int a = 0; a < 2; ++a)
#pragma unroll
    for (int b = 0; b < 2; ++b)
#pragma unroll
      for (int i = 0; i < 16; ++i) acc[a][b][i] = 0.f;

#define GEMM_LOAD(S, KT)                                                                  \
  {                                                                                       \
    const uint4* pa_ = (const uint4*)(ap + (long)(KT) * a_kstep);                         \
    sa##S##_0 = pa_[0]; sa##S##_1 = pa_[1]; sa##S##_2 = pa_[2]; sa##S##_3 = pa_[3];       \
    if constexpr (BT16) {                                                                 \
      const uint4* pt_ = (const uint4*)(bp16 + (long)(KT) * 64);                          \
      tb##S##_0 = pt_[0]; tb##S##_1 = pt_[1]; tb##S##_2 = pt_[2]; tb##S##_3 = pt_[3];     \
    } else {                                                                              \
      const float* pb_ = bp + (long)(KT) * 64 * ldb;                                      \
      sb##S##_0 = *(const float4*)(pb_);                                                  \
      sb##S##_1 = *(const float4*)(pb_ + ldb);                                            \
      sb##S##_2 = *(const float4*)(pb_ + 2 * ldb);                                        \
      sb##S##_3 = *(const float4*)(pb_ + 3 * ldb);                                        \
      sb##S##_4 = *(const float4*)(pb_ + 32 * ldb);                                       \
      sb##S##_5 = *(const float4*)(pb_ + 33 * ldb);                                       \
      sb##S##_6 = *(const float4*)(pb_ + 34 * ldb);                                       \
      sb##S##_7 = *(const float4*)(pb_ + 35 * ldb);                                       \
    }                                                                                     \
  }
#define GEMM_BW(V0, V1, V2, V3, C, I, QOFF)                                               \
  {                                                                                       \
    uint2 w_;                                                                             \
    w_.x = pack2(V0.C, V1.C);                                                             \
    w_.y = pack2(V2.C, V3.C);                                                             \
    *(uint2*)&Bs_[(bnq * 4 + (I)) * 72 + (QOFF) + bkq * 4] = w_;                          \
  }
#define GEMM_STORE(S, BUF)                                                                \
  {                                                                                       \
    u16* As_ = As + (BUF) * (2 * 128 * 72);                                               \
    u16* Bs_ = As_ + 128 * 72;                                                            \
    uint4* da_ = (uint4*)&As_[arow * 72 + ahalf * 32];                                    \
    da_[0] = sa##S##_0; da_[1] = sa##S##_1; da_[2] = sa##S##_2; da_[3] = sa##S##_3;       \
    if constexpr (BT16) {                                                                 \
      uint4* db_ = (uint4*)&Bs_[arow * 72 + ahalf * 32];                                  \
      db_[0] = tb##S##_0; db_[1] = tb##S##_1; db_[2] = tb##S##_2; db_[3] = tb##S##_3;     \
    } else {                                                                              \
      GEMM_BW(sb##S##_0, sb##S##_1, sb##S##_2, sb##S##_3, x, 0, 0)                        \
      GEMM_BW(sb##S##_0, sb##S##_1, sb##S##_2, sb##S##_3, y, 1, 0)                        \
      GEMM_BW(sb##S##_0, sb##S##_1, sb##S##_2, sb##S##_3, z, 2, 0)                        \
      GEMM_BW(sb##S##_0, sb##S##_1, sb##S##_2, sb##S##_3, w, 3, 0)                        \
      GEMM_BW(sb##S##_4, sb##S##_5, sb##S##_6, sb##S##_7, x, 0, 32)                       \
      GEMM_BW(sb##S##_4, sb##S##_5, sb##S##_6, sb##S##_7, y, 1, 32)                       \
      GEMM_BW(sb##S##_4, sb##S##_5, sb##S##_6, sb##S##_7, z, 2, 32)                       \
      GEMM_BW(sb##S##_4, sb##S##_5, sb##S##_6, sb##S##_7, w, 3, 32)                       \
    }                                                                                     \
  }
#define GEMM_COMPUTE(BUF)                                                                 \
  {                                                                                       \
    const u16* Ac = As + (BUF) * (2 * 128 * 72);                                          \
    const u16* Bc = Ac + 128 * 72;                                                        \
    _Pragma("unroll") for (int ks = 0; ks < 4; ++ks) {                                    \
      bf16x8 a[2], b[2];                                                                  \
      _Pragma("unroll") for (int mt = 0; mt < 2; ++mt) a[mt] = *(const bf16x8*)&Ac[(wm * 64 + mt * 32 + (lane & 31)) * 72 + ks * 16 + (lane >> 5) * 8]; \
      _Pragma("unroll") for (int nt = 0; nt < 2; ++nt) b[nt] = *(const bf16x8*)&Bc[(wn * 64 + nt * 32 + (lane & 31)) * 72 + ks * 16 + (lane >> 5) * 8]; \
      _Pragma("unroll") for (int mt = 0; mt < 2; ++mt)                                    \
      _Pragma("unroll") for (int nt = 0; nt < 2; ++nt)                                    \
        acc[mt][nt] = SWAP ? __builtin_amdgcn_mfma_f32_32x32x16_bf16(b[nt], a[mt], acc[mt][nt], 0, 0, 0) \
                           : __builtin_amdgcn_mfma_f32_32x32x16_bf16(a[mt], b[nt], acc[mt][nt], 0, 0, 0); \
    }                                                                                     \
  }
  GEMM_LOAD(0, 0)
  hb_sync();
  if (SINGLE) {
    GEMM_STORE(0, 0)
    hb_sync();
    GEMM_COMPUTE(0)
  } else {
    GEMM_LOAD(1, 1)
    GEMM_STORE(0, 0)
    hb_sync();
    const int last = nk - 1;
    for (int kt = 0; kt < nk; kt += 2) {
      const int k2 = kt + 2 < last ? kt + 2 : last, k3 = kt + 3 < last ? kt + 3 : last;
      GEMM_LOAD(0, k2)
      asm volatile("" ::: "memory");
      GEMM_COMPUTE(0)
      asm volatile("" ::: "memory");
      GEMM_STORE(1, 1)
      hb_sync();
      GEMM_LOAD(1, k3)
      asm volatile("" ::: "memory");
      GEMM_COMPUTE(1)
      asm volatile("" ::: "memory");
      GEMM_STORE(0, 0)
      hb_sync();
    }
  }
#undef GEMM_LOAD
#undef GEMM_STORE
#undef GEMM_BW
#undef GEMM_COMPUTE
  ef(acc, wm, wn, lane);
}

template <bool BT16, class AF, class BF, class EF>
DI void gemm_tile256(char* smem, int nk, const AF& af, const BF& bf, const EF& ef) {
  asm volatile("" ::: "memory");
  u16* As = (u16*)smem;
  u16* Bs = As + 256 * 72;
  const int tid = TIDX(), lane = tid & 63, wid = __builtin_amdgcn_readfirstlane(tid >> 6), wm = wid >> 1, wn = wid & 1;
  const int piece = tid & 7, rbase = tid >> 3;
  const u16* abase = af(0);
  int ao0, ao1, ao2, ao3, ao4, ao5, ao6, ao7;
  ao0 = (int)(af(rbase) - abase) + piece * 8;        ao1 = (int)(af(rbase + 32) - abase) + piece * 8;
  ao2 = (int)(af(rbase + 64) - abase) + piece * 8;   ao3 = (int)(af(rbase + 96) - abase) + piece * 8;
  ao4 = (int)(af(rbase + 128) - abase) + piece * 8;  ao5 = (int)(af(rbase + 160) - abase) + piece * 8;
  ao6 = (int)(af(rbase + 192) - abase) + piece * 8;  ao7 = (int)(af(rbase + 224) - abase) + piece * 8;
  const u16* bp16 = nullptr; long bstride = 0;
  const float* bp = nullptr; long ldb = 0;
  const int bkq = lane & 7, bnq = wid * 8 + (lane >> 3);
  if constexpr (BT16) { bp16 = bf.row(rbase) + piece * 8; bstride = bf.ldb * 32; }
  else { ldb = bf.ldb; bp = bf(bnq * 4) + (long)(bkq * 4) * ldb; }
  uint4 ra0, ra1, ra2, ra3, ra4, ra5, ra6, ra7, rb0, rb1, rb2, rb3;
  float4 fb0, fb1, fb2, fb3, fb4, fb5, fb6, fb7;
  f32x16 acc[4][2];
#pragma unroll
  for (int a = 0; a < 4; ++a)
#pragma unroll
    for (int b = 0; b < 2; ++b)
#pragma unroll
      for (int i = 0; i < 16; ++i) acc[a][b][i] = 0.f;
#define G256_LOAD(KT)                                                   \
  {                                                                     \
    const u16* pa_ = abase + (long)(KT) * 64;                           \
    ra0 = *(const uint4*)(pa_ + ao0); ra1 = *(const uint4*)(pa_ + ao1); \
    ra2 = *(const uint4*)(pa_ + ao2); ra3 = *(const uint4*)(pa_ + ao3); \
    ra4 = *(const uint4*)(pa_ + ao4); ra5 = *(const uint4*)(pa_ + ao5); \
    ra6 = *(const uint4*)(pa_ + ao6); ra7 = *(const uint4*)(pa_ + ao7); \
    if constexpr (BT16) {                                               \
      const u16* pb_ = bp16 + (long)(KT) * 64;                          \
      rb0 = *(const uint4*)(pb_);                                       \
      rb1 = *(const uint4*)(pb_ + bstride);                             \
      rb2 = *(const uint4*)(pb_ + 2 * bstride);                         \
      rb3 = *(const uint4*)(pb_ + 3 * bstride);                         \
    } else {                                                            \
      const float* pf_ = bp + (long)(KT) * 64 * ldb;                    \
      fb0 = *(const float4*)(pf_);            fb1 = *(const float4*)(pf_ + ldb);      \
      fb2 = *(const float4*)(pf_ + 2 * ldb);  fb3 = *(const float4*)(pf_ + 3 * ldb);  \
      fb4 = *(const float4*)(pf_ + 32 * ldb); fb5 = *(const float4*)(pf_ + 33 * ldb); \
      fb6 = *(const float4*)(pf_ + 34 * ldb); fb7 = *(const float4*)(pf_ + 35 * ldb); \
    }                                                                   \
  }
#define G256_BW(V0, V1, V2, V3, C, I, QOFF)                             \
  {                                                                     \
    uint2 w_;                                                           \
    w_.x = pack2(V0.C, V1.C);                                           \
    w_.y = pack2(V2.C, V3.C);                                           \
    *(uint2*)&Bs[(bnq * 4 + (I)) * 72 + (QOFF) + bkq * 4] = w_;         \
  }
  G256_LOAD(0)
  const int last = nk - 1;
  for (int kt = 0; kt < nk; ++kt) {
    hb_sync();
    {
      u16* da = As + rbase * 72 + piece * 8;
      *(uint4*)(da) = ra0;            *(uint4*)(da + 32 * 72) = ra1;  *(uint4*)(da + 64 * 72) = ra2;  *(uint4*)(da + 96 * 72) = ra3;
      *(uint4*)(da + 128 * 72) = ra4; *(uint4*)(da + 160 * 72) = ra5; *(uint4*)(da + 192 * 72) = ra6; *(uint4*)(da + 224 * 72) = ra7;
      if constexpr (BT16) {
        u16* db = Bs + rbase * 72 + piece * 8;
        *(uint4*)(db) = rb0; *(uint4*)(db + 32 * 72) = rb1; *(uint4*)(db + 64 * 72) = rb2; *(uint4*)(db + 96 * 72) = rb3;
      } else {
        G256_BW(fb0, fb1, fb2, fb3, x, 0, 0)  G256_BW(fb0, fb1, fb2, fb3, y, 1, 0)
        G256_BW(fb0, fb1, fb2, fb3, z, 2, 0)  G256_BW(fb0, fb1, fb2, fb3, w, 3, 0)
        G256_BW(fb4, fb5, fb6, fb7, x, 0, 32) G256_BW(fb4, fb5, fb6, fb7, y, 1, 32)
        G256_BW(fb4, fb5, fb6, fb7, z, 2, 32) G256_BW(fb4, fb5, fb6, fb7, w, 3, 32)
      }
    }
    hb_sync();
    const int kn = kt + 1 < last ? kt + 1 : last;
    G256_LOAD(kn)
    asm volatile("" ::: "memory");
#pragma unroll
    for (int ks = 0; ks < 4; ++ks) {
      bf16x8 a[4], b[2];
#pragma unroll
      for (int mt = 0; mt < 4; ++mt) a[mt] = *(const bf16x8*)&As[(wm * 128 + mt * 32 + (lane & 31)) * 72 + ks * 16 + (lane >> 5) * 8];
#pragma unroll
      for (int nt = 0; nt < 2; ++nt) b[nt] = *(const bf16x8*)&Bs[(wn * 64 + nt * 32 + (lane & 31)) * 72 + ks * 16 + (lane >> 5) * 8];
#pragma unroll
      for (int mt = 0; mt < 4; ++mt)
#pragma unroll
        for (int nt = 0; nt < 2; ++nt) acc[mt][nt] = __builtin_amdgcn_mfma_f32_32x32x16_bf16(b[nt], a[mt], acc[mt][nt], 0, 0, 0);
    }
    asm volatile("" ::: "memory");
  }
#undef G256_LOAD
#undef G256_BW
  ef(acc, wm, wn, lane);
}

template <bool BT16, class AF, class BF, class EF>
DI void gemm8w(int nk, const AF& af, const BF& bf, const EF& ef) {
  asm volatile("" ::: "memory");
  u16* S0 = (u16*)g_smem;
  int tid = threadIdx.x; asm volatile("" : "+v"(tid));
  const int lane = tid & 63, wid = __builtin_amdgcn_readfirstlane(tid >> 6), wm = wid >> 2, wn = wid & 3;
  const int piece = tid & 7, rbase = tid >> 3;
  const u16* abase = af.origin();
  const int ao0 = af.off(rbase) + piece * 8, ao1 = af.off(rbase + 64) + piece * 8, ao2 = af.off(rbase + 128) + piece * 8, ao3 = af.off(rbase + 192) + piece * 8;
  const u16 *bq0 = nullptr, *bq1 = nullptr, *bq2 = nullptr, *bq3 = nullptr;
  const float* bp = nullptr; long ldb = 0;
  const int bkq = lane & 7, bnq = wid * 8 + (lane >> 3);
  if constexpr (BT16) { bq0 = bf.row(rbase) + piece * 8; bq1 = bf.row(rbase + 64) + piece * 8; bq2 = bf.row(rbase + 128) + piece * 8; bq3 = bf.row(rbase + 192) + piece * 8; }
  else { ldb = bf.ldb; bp = bf(bnq * 4) + (long)(bkq * 4) * ldb; }
  uint4 ra0, ra1, ra2, ra3, rb0, rb1, rb2, rb3;
  float4 fb0, fb1, fb2, fb3, fb4, fb5, fb6, fb7;
  f32x16 acc[4][2];
#pragma unroll
  for (int a = 0; a < 4; ++a)
#pragma unroll
    for (int b = 0; b < 2; ++b)
#pragma unroll
      for (int i = 0; i < 16; ++i) acc[a][b][i] = 0.f;
#define G8_LOAD(KT)                                                     \
  {                                                                     \
    const u16* pa_ = abase + (long)(KT) * 64;                           \
    ra0 = *(const uint4*)(pa_ + ao0); ra1 = *(const uint4*)(pa_ + ao1); \
    ra2 = *(const uint4*)(pa_ + ao2); ra3 = *(const uint4*)(pa_ + ao3); \
    if constexpr (BT16) {                                               \
      rb0 = *(const uint4*)(bq0 + (long)(KT) * 64); rb1 = *(const uint4*)(bq1 + (long)(KT) * 64); \
      rb2 = *(const uint4*)(bq2 + (long)(KT) * 64); rb3 = *(const uint4*)(bq3 + (long)(KT) * 64); \
    } else {                                                            \
      const float* pf_ = bp + (long)(KT) * 64 * ldb;                    \
      fb0 = *(const float4*)(pf_);            fb1 = *(const float4*)(pf_ + ldb);      \
      fb2 = *(const float4*)(pf_ + 2 * ldb);  fb3 = *(const float4*)(pf_ + 3 * ldb);  \
      fb4 = *(const float4*)(pf_ + 32 * ldb); fb5 = *(const float4*)(pf_ + 33 * ldb); \
      fb6 = *(const float4*)(pf_ + 34 * ldb); fb7 = *(const float4*)(pf_ + 35 * ldb); \
    }                                                                   \
  }
#define G8_BW(V0, V1, V2, V3, C, I, QOFF)                               \
  {                                                                     \
    uint2 w_;                                                           \
    w_.x = pack2(V0.C, V1.C);                                           \
    w_.y = pack2(V2.C, V3.C);                                           \
    *(uint2*)&Bs_[(bnq * 4 + (I)) * 72 + (QOFF) + bkq * 4] = w_;        \
  }
#define G8_STORE(BUF)                                                   \
  {                                                                     \
    u16* As_ = S0 + (BUF) * (512 * 72);                                 \
    u16* Bs_ = As_ + 256 * 72;                                          \
    u16* da = As_ + rbase * 72 + piece * 8;                             \
    *(uint4*)(da) = ra0; *(uint4*)(da + 64 * 72) = ra1; *(uint4*)(da + 128 * 72) = ra2; *(uint4*)(da + 192 * 72) = ra3; \
    if constexpr (BT16) {                                               \
      u16* db = Bs_ + rbase * 72 + piece * 8;                           \
      *(uint4*)(db) = rb0; *(uint4*)(db + 64 * 72) = rb1; *(uint4*)(db + 128 * 72) = rb2; *(uint4*)(db + 192 * 72) = rb3; \
    } else {                                                            \
      G8_BW(fb0, fb1, fb2, fb3, x, 0, 0)  G8_BW(fb0, fb1, fb2, fb3, y, 1, 0)   \
      G8_BW(fb0, fb1, fb2, fb3, z, 2, 0)  G8_BW(fb0, fb1, fb2, fb3, w, 3, 0)   \
      G8_BW(fb4, fb5, fb6, fb7, x, 0, 32) G8_BW(fb4, fb5, fb6, fb7, y, 1, 32)  \
      G8_BW(fb4, fb5, fb6, fb7, z, 2, 32) G8_BW(fb4, fb5, fb6, fb7, w, 3, 32)  \
    }                                                                   \
  }
  G8_LOAD(0)
  __syncthreads();
  G8_STORE(0)
  __syncthreads();
  const int last = nk - 1;
  for (int kt = 0; kt < nk; ++kt) {
    const int kn = kt + 1 < last ? kt + 1 : last;
    G8_LOAD(kn)
    asm volatile("" ::: "memory");
    {
      const u16* Ac = S0 + (kt & 1) * (512 * 72);
      const u16* Bc = Ac + 256 * 72;
#pragma unroll
      for (int ks = 0; ks < 4; ++ks) {
        bf16x8 a[4], b[2];
#pragma unroll
        for (int mt = 0; mt < 4; ++mt) a[mt] = *(const bf16x8*)&Ac[(wm * 128 + mt * 32 + (lane & 31)) * 72 + ks * 16 + (lane >> 5) * 8];
#pragma unroll
        for (int nt = 0; nt < 2; ++nt) b[nt] = *(const bf16x8*)&Bc[(wn * 64 + nt * 32 + (lane & 31)) * 72 + ks * 16 + (lane >> 5) * 8];
#pragma unroll
        for (int mt = 0; mt < 4; ++mt)
#pragma unroll
          for (int nt = 0; nt < 2; ++nt) acc[mt][nt] = __builtin_amdgcn_mfma_f32_32x32x16_bf16(b[nt], a[mt], acc[mt][nt], 0, 0, 0);
      }
    }
    asm volatile("" ::: "memory");
    if (kt + 1 < nk) {
      G8_STORE((kt + 1) & 1)
      __syncthreads();
    }
  }
#undef G8_LOAD
#undef G8_BW
#undef G8_STORE
  ef(acc, wm, wn, lane);
}

DI void st_stage_rc(int b, int& R, int& C) {
  const int st = b >> 10, sb = b & 1023, swz = sb ^ (((sb >> 9) & 1) << 5);
  R = (st >> 1) * 16 + (swz >> 6); C = (st & 1) * 32 + ((swz & 63) >> 1);
}
template <class PF, class QF, class EF>
DI void gemm8p(int nt, const PF& pf, const QF& qf, const EF& ef) {
  asm volatile("" ::: "memory");
  constexpr int HTB = 128 * 64 * 2;
  int tid = threadIdx.x; asm volatile("" : "+v"(tid));
  const int lane = tid & 63, wid = __builtin_amdgcn_readfirstlane(tid >> 6), wr = wid >> 2, wc = wid & 3, fr = lane & 15, fq = lane >> 4;
  int r0, c0, r1, c1;
  st_stage_rc(tid * 16, r0, c0);
  st_stage_rc(tid * 16 + 8192, r1, c1);
  const u16* pbase = pf.origin();
  const u16* qbase = qf.origin();
  const unsigned po00 = (unsigned)(pf.off(r0) + c0) * 2u, po01 = (unsigned)(pf.off(r1) + c1) * 2u;
  const unsigned po10 = (unsigned)(pf.off(128 + r0) + c0) * 2u, po11 = (unsigned)(pf.off(128 + r1) + c1) * 2u;
  const unsigned qo00 = (unsigned)(qf.off(r0) + c0) * 2u, qo01 = (unsigned)(qf.off(r1) + c1) * 2u;
  const unsigned qo10 = (unsigned)(qf.off(128 + r0) + c0) * 2u, qo11 = (unsigned)(qf.off(128 + r1) + c1) * 2u;
  const unsigned sdst = (unsigned)__builtin_amdgcn_readfirstlane((int)((unsigned)(size_t)g_smem + (unsigned)(tid & ~63) * 16u));
  const int laneoff = (fr * 64 + fq * 16) ^ ((fr >> 3) << 5);
  const char* rdP = g_smem + wr * 8192 + laneoff;
  const char* rdQ = g_smem + 4 * HTB + wc * 4096 + laneoff;
#define G8P_ST(SLOT, BASE, O0, O1, KT)                                                                                     \
  {                                                                                                                        \
    const char* g_ = (const char*)(BASE) + (long)(KT) * 128;                                                               \
    __builtin_amdgcn_global_load_lds((const unsigned*)(g_ + (O0)), (LAS unsigned*)(size_t)(sdst + (SLOT) * HTB), 16, 0, 0);          \
    __builtin_amdgcn_global_load_lds((const unsigned*)(g_ + (O1)), (LAS unsigned*)(size_t)(sdst + (SLOT) * HTB + 8192), 16, 0, 0);   \
  }
#define G8P_STP(b, h, KT) { if ((h) == 0) G8P_ST((b) * 2, pbase, po00, po01, KT) else G8P_ST((b) * 2 + 1, pbase, po10, po11, KT) }
#define G8P_STQ(b, h, KT) { if ((h) == 0) G8P_ST(4 + (b) * 2, qbase, qo00, qo01, KT) else G8P_ST(4 + (b) * 2 + 1, qbase, qo10, qo11, KT) }
#define G8P_LDP(b, h)                                                                                                      \
  _Pragma("unroll") for (int m = 0; m < 4; ++m) _Pragma("unroll") for (int k = 0; k < 2; ++k)                              \
    Pt[m][k] = *(const bf16x8*)(rdP + ((b) * 2 + (h)) * HTB + m * 2048 + k * 1024);
#define G8P_LDQ(dst, b, h)                                                                                                 \
  _Pragma("unroll") for (int n = 0; n < 2; ++n) _Pragma("unroll") for (int k = 0; k < 2; ++k)                              \
    dst[n][k] = *(const bf16x8*)(rdQ + ((b) * 2 + (h)) * HTB + n * 2048 + k * 1024);
#define G8P_MMA(ai, bj, QT)                                                                                                \
  {                                                                                                                        \
    __builtin_amdgcn_s_setprio(1);                                                                                         \
    _Pragma("unroll") for (int m = 0; m < 4; ++m) _Pragma("unroll") for (int n = 0; n < 2; ++n)                            \
      _Pragma("unroll") for (int k = 0; k < 2; ++k)                                                                        \
        acc[ai][bj][m][n] = __builtin_amdgcn_mfma_f32_16x16x32_bf16(Pt[m][k], QT[n][k], acc[ai][bj][m][n], 0, 0, 0);       \
    __builtin_amdgcn_s_setprio(0);                                                                                         \
  }
#define G8P_WV(n) asm volatile("s_waitcnt vmcnt(" #n ")" ::: "memory")
#define G8P_WL(n) asm volatile("s_waitcnt lgkmcnt(" #n ")" ::: "memory")
#define G8P_BAR __builtin_amdgcn_s_barrier()
#define G8P_SCHED __builtin_amdgcn_sched_barrier(0)
  f32x4 acc[2][2][4][2];
#pragma unroll
  for (int a = 0; a < 2; ++a)
#pragma unroll
    for (int b = 0; b < 2; ++b)
#pragma unroll
      for (int m = 0; m < 4; ++m)
#pragma unroll
        for (int n = 0; n < 2; ++n) acc[a][b][m][n] = (f32x4){0.f, 0.f, 0.f, 0.f};
  bf16x8 Pt[4][2], Q0[2][2], Q1[2][2];
  __syncthreads();
  G8P_STQ(0, 0, 0) G8P_STP(0, 0, 0) G8P_STQ(0, 1, 0) G8P_STP(0, 1, 0)
  if (wr == 1) G8P_BAR;
  G8P_WV(4); G8P_BAR;
  G8P_STQ(1, 0, 1) G8P_STP(1, 0, 1) G8P_STQ(1, 1, 1)
  G8P_WV(6); G8P_BAR;
  for (int t = 0; t < nt - 2; t += 2) {
    G8P_LDQ(Q0, 0, 0) G8P_SCHED; G8P_LDP(0, 0) G8P_STP(1, 1, t + 1)
    G8P_WL(8); G8P_BAR; G8P_WL(0); G8P_MMA(0, 0, Q0) G8P_BAR; G8P_SCHED;
    G8P_LDQ(Q1, 0, 1) G8P_STQ(0, 0, t + 2)
    G8P_BAR; G8P_WL(0); G8P_MMA(0, 1, Q1) G8P_BAR;
    G8P_LDP(0, 1) G8P_STP(0, 0, t + 2)
    G8P_BAR; G8P_WL(0); G8P_MMA(1, 0, Q0) G8P_BAR; G8P_SCHED;
    G8P_STQ(0, 1, t + 2)
    G8P_WV(6); G8P_BAR; G8P_MMA(1, 1, Q1) G8P_BAR;
    G8P_LDQ(Q0, 1, 0) G8P_SCHED; G8P_LDP(1, 0) G8P_STP(0, 1, t + 2)
    G8P_WL(8); G8P_BAR; G8P_WL(0); G8P_MMA(0, 0, Q0) G8P_BAR; G8P_SCHED;
    G8P_LDQ(Q1, 1, 1) G8P_STQ(1, 0, t + 3)
    G8P_BAR; G8P_WL(0); G8P_MMA(0, 1, Q1) G8P_BAR;
    G8P_LDP(1, 1) G8P_STP(1, 0, t + 3)
    G8P_BAR; G8P_WL(0); G8P_MMA(1, 0, Q0) G8P_BAR; G8P_SCHED;
    G8P_STQ(1, 1, t + 3)
    G8P_WV(6); G8P_BAR; G8P_MMA(1, 1, Q1) G8P_BAR;
  }
  {
    G8P_LDQ(Q0, 0, 0) G8P_LDP(0, 0) G8P_STP(1, 1, nt - 1)
    G8P_BAR; G8P_WL(0); G8P_MMA(0, 0, Q0) G8P_BAR;
    G8P_LDQ(Q1, 0, 1) G8P_BAR; G8P_WL(0); G8P_MMA(0, 1, Q1) G8P_BAR;
    G8P_LDP(0, 1) G8P_WV(4); G8P_BAR; G8P_WL(0); G8P_MMA(1, 0, Q0) G8P_MMA(1, 1, Q1) G8P_BAR;
  }
  {
    G8P_LDQ(Q0, 1, 0) G8P_LDP(1, 0) G8P_WV(2); G8P_BAR; G8P_WL(0); G8P_MMA(0, 0, Q0) G8P_BAR;
    G8P_LDQ(Q1, 1, 1) G8P_WV(0); G8P_BAR; G8P_WL(0); G8P_MMA(0, 1, Q1) G8P_BAR;
    G8P_LDP(1, 1) G8P_BAR; G8P_WL(0); G8P_MMA(1, 0, Q0) G8P_MMA(1, 1, Q1) G8P_BAR;
  }
  if (wr == 0) G8P_BAR;
#undef G8P_ST
#undef G8P_STP
#undef G8P_STQ
#undef G8P_LDP
#undef G8P_LDQ
#undef G8P_MMA
#undef G8P_WV
#undef G8P_WL
#undef G8P_BAR
#undef G8P_SCHED
#pragma unroll
  for (int ai = 0; ai < 2; ++ai)
#pragma unroll
    for (int bj = 0; bj < 2; ++bj)
#pragma unroll
      for (int m = 0; m < 4; ++m)
#pragma unroll
        for (int n = 0; n < 2; ++n)
          ef(bj * 128 + wc * 32 + n * 16 + fr, ai * 128 + wr * 64 + m * 16 + fq * 4, acc[ai][bj][m][n][0], acc[ai][bj][m][n][1], acc[ai][bj][m][n][2], acc[ai][bj][m][n][3]);
}

#define EPI_FOR                                                   \
  _Pragma("unroll") for (int mt = 0; mt < 2; ++mt)                \
  _Pragma("unroll") for (int nt = 0; nt < 2; ++nt)                \
  _Pragma("unroll") for (int i = 0; i < 16; ++i)
#define EPI_R (wm * 64 + mt * 32 + (i & 3) + 8 * (i >> 2) + 4 * (lane >> 5))
#define EPI_C (wn * 64 + nt * 32 + (lane & 31))
#define SW_FOR                                                    \
  _Pragma("unroll") for (int mt = 0; mt < MT; ++mt)               \
  _Pragma("unroll") for (int nt = 0; nt < 2; ++nt)                \
  _Pragma("unroll") for (int q4 = 0; q4 < 4; ++q4)
#define SW_R (wm * (32 * MT) + mt * 32 + (lane & 31))
#define SW_C0 (wn * 64 + nt * 32 + 8 * q4 + 4 * (lane >> 5))
#define SW_V(j) acc[mt][nt][4 * q4 + (j)]
DI uint2 pack4(float a, float b, float c, float d) { uint2 w; w.x = pack2(a, b); w.y = pack2(c, d); return w; }

struct ARows { const u16* base; long ld; int nrows; DI const u16* operator()(int r) const { return base + (long)(r < nrows ? r : 0) * ld; }
  DI const u16* origin() const { return base; } DI int off(int r) const { return (r < nrows ? r : 0) * (int)ld; } };
struct BMat { const float* base; long ldb; int ncols; DI const float* operator()(int c4) const { return base + (c4 < ncols ? c4 : 0); } DI const u16* row(int) const { return nullptr; } };
struct BMatT { const u16* base; long ldb; DI const float* operator()(int) const { return nullptr; } DI const u16* row(int n) const { return base + (long)n * ldb; } };

DI void phase0(const Params& p, char* smem, int bid, int nblk) {
  const int tid = TIDX();
  for (int item = bid; item < 384 + 256 + 16 + 1 + 1728; item += nblk) {
    if (item < 384) {
      const int cc = item % 24, kc = item / 24;
      const int col = cc * 256 + tid;
      float a0 = 0.f, a1 = 0.f;
#pragma unroll 1
      for (int half = 0; half < 2; ++half) {
        const int k0 = kc * 64 + half * 32;
        float w[32];
#pragma unroll
        for (int j = 0; j < 32; ++j) w[j] = p.w_ada[(long)(k0 + j) * 6144 + col];
#pragma unroll
        for (int j = 0; j < 32; ++j) {
          a0 += siluf(p.c[k0 + j]) * w[j];
          a1 += siluf(p.c[1024 + k0 + j]) * w[j];
        }
      }
      p.modp[(kc * 2 + 0) * 6144 + col] = a0;
      p.modp[(kc * 2 + 1) * 6144 + col] = a1;
    } else if (item < 640) {
      const int idx = (item - 384) * 256 + tid;
      const int c = idx & 127, d = (idx >> 7) & 63, h = idx >> 13;
      p.w_ukT[idx] = p.dsa_w_uk[c * 512 + h * 64 + d];
    } else if (item < 656) {
      const int part = item - 640;
      const int slot = tid >> 7, kk = tid & 127;
      float a = 0.f;
      for (int ld = part * 128; ld < part * 128 + 128; ++ld) a += p.cmp_pe[slot * 2048 + ld] * p.cmp_w1[((long)slot * 2048 + ld) * 128 + kk];
      p.pe_part[part * 256 + tid] = a;
    } else if (item == 656) {
      p.counts[tid * 32] = 0;
    } else {
      int it = item - 657;
      const float* W; u16* WT; int K, N, ntn;
      if (it < 1152) { W = p.w_in; WT = p.w_inT; K = 1024; N = LDP; ntn = 72; }
      else if (it < 1280) { it -= 1152; W = p.w_bn; WT = p.w_bnT; K = 512; N = 1024; ntn = 16; }
      else if (it < 1408) { it -= 1280; W = p.w_bd; WT = p.w_bdT; K = 512; N = 1024; ntn = 16; }
      else if (it < 1664) { it -= 1408; W = p.w_out; WT = p.w_outT; K = 1024; N = 1024; ntn = 16; }
      else { it -= 1664; W = p.router_w; WT = p.routerT; K = 1024; N = 256; ntn = 4; }
      const int k0 = (it / ntn) * 64, n0 = (it % ntn) * 64;
      u16* tl = (u16*)smem;
      hb_sync();
      const int kr = tid >> 4, nq = tid & 15;
#pragma unroll
      for (int ps = 0; ps < 4; ++ps) {
        const int k = kr + 16 * ps, n = n0 + nq * 4;
        float4 v = make_float4(0.f, 0.f, 0.f, 0.f);
        if (n < N) v = *(const float4*)(W + (long)(k0 + k) * N + n);
        tl[(nq * 4 + 0) * 72 + k] = f2bf(v.x);
        tl[(nq * 4 + 1) * 72 + k] = f2bf(v.y);
        tl[(nq * 4 + 2) * 72 + k] = f2bf(v.z);
        tl[(nq * 4 + 3) * 72 + k] = f2bf(v.w);
      }
      hb_sync();
      const int nr = tid >> 2, piece = tid & 3;
      const uint4 a = *(const uint4*)(tl + nr * 72 + piece * 16);
      const uint4 b = *(const uint4*)(tl + nr * 72 + piece * 16 + 8);
      uint4* dst = (uint4*)(WT + (long)(n0 + nr) * K + k0 + piece * 16);
      dst[0] = a; dst[1] = b;
    }
  }
}

DI void phase1(const Params& p, char* smem, int bid, int nblk) {
  const int tid = TIDX(), lane = tid & 63, wid = __builtin_amdgcn_readfirstlane(tid >> 6);
  float* modl = (float*)smem;
  const int b = bid & 1;
#pragma unroll
  for (int i0 = 0; i0 < 8; i0 += 4) {
    float v[4];
#pragma unroll
    for (int ii = 0; ii < 4; ++ii) v[ii] = p.b_ada[tid + 256 * (i0 + ii)];
#pragma unroll
    for (int kc = 0; kc < 16; ++kc)
#pragma unroll
      for (int ii = 0; ii < 4; ++ii) v[ii] += p.modp[(kc * 2 + b) * 6144 + tid + 256 * (i0 + ii)];
#pragma unroll
    for (int ii = 0; ii < 4; ++ii) modl[tid + 256 * (i0 + ii)] = v[ii];
  }
  if (bid < 48) {
    const int idx = bid * 256 + tid;
    const int bb = idx / 6144, n = idx % 6144;
    float v = p.b_ada[n];
#pragma unroll
    for (int kc = 0; kc < 16; ++kc) v += p.modp[(kc * 2 + bb) * 6144 + n];
    p.mod[idx] = v;
  }
  hb_sync();
  float cm[16], ca[16];
#pragma unroll
  for (int i = 0; i < 4; ++i) {
    const int col = i * 256 + lane * 4;
    const float4 g = *(const float4*)(p.g_pre_mix + col);
    const float4 sh = *(const float4*)(modl + col), sc = *(const float4*)(modl + 1024 + col);
    cm[i * 4 + 0] = g.x * (1.f + sc.x); cm[i * 4 + 1] = g.y * (1.f + sc.y); cm[i * 4 + 2] = g.z * (1.f + sc.z); cm[i * 4 + 3] = g.w * (1.f + sc.w);
    ca[i * 4 + 0] = sh.x; ca[i * 4 + 1] = sh.y; ca[i * 4 + 2] = sh.z; ca[i * 4 + 3] = sh.w;
  }
  const int stride = (nblk >> 1) * 4;
  for (int t0 = (bid >> 1) * 4 + wid; t0 < T; t0 += 4 * stride) {
    float4 v[4][4];
#pragma unroll
    for (int k = 0; k < 4; ++k) {
      const int t = t0 + k * stride < T ? t0 + k * stride : T - 1;
      const float* xr = p.x + ((long)b * T + t) * 1024;
#pragma unroll
      for (int i = 0; i < 4; ++i) v[k][i] = *(const float4*)(xr + i * 256 + lane * 4);
    }
#pragma unroll
    for (int k = 0; k < 4; ++k) {
      float ss = 0.f;
#pragma unroll
      for (int i = 0; i < 4; ++i) ss += v[k][i].x * v[k][i].x + v[k][i].y * v[k][i].y + v[k][i].z * v[k][i].z + v[k][i].w * v[k][i].w;
      ss = wave_sum(ss);
      const float r = rsqrtf(ss * (1.f / 1024.f) + 1e-6f);
      if (t0 + k * stride < T) {
        u16* hr = p.h + ((long)b * T + t0 + k * stride) * 1024;
#pragma unroll
        for (int i = 0; i < 4; ++i) {
          const float o0 = v[k][i].x * r * cm[i * 4 + 0] + ca[i * 4 + 0];
          const float o1 = v[k][i].y * r * cm[i * 4 + 1] + ca[i * 4 + 1];
          const float o2 = v[k][i].z * r * cm[i * 4 + 2] + ca[i * 4 + 2];
          const float o3 = v[k][i].w * r * cm[i * 4 + 3] + ca[i * 4 + 3];
          *(uint2*)(hr + i * 256 + lane * 4) = pack4(o0, o1, o2, o3);
        }
      }
    }
  }
}

struct EpiProj {
  u16* proj; float* widx; int m0, n0;
  template <int MT> DI void operator()(f32x16 (&acc)[MT][2], int wm, int wn, int lane) const {
    SW_FOR {
      const int r = m0 + SW_R, c = n0 + SW_C0;
      if (c < LDP) {
        float v[4] = {SW_V(0), SW_V(1), SW_V(2), SW_V(3)};
        if (c < C_KV) { for (int j = 0; j < 4; ++j) v[j] *= 0.125f; }
        else if (c < C_GN) {}
        else if (c < C_QD) { for (int j = 0; j < 4; ++j) v[j] = sigmoidf(v[j]); }
        else if (c < C_QI) {}
        else if (c < C_KI) { for (int j = 0; j < 4; ++j) v[j] *= 0.125f; }
        else if (c < C_WI) {}
        else if (c < C_GM) {
          for (int j = 0; j < 4; ++j) v[j] *= 0.35355339059327373f;
          *(float4*)(widx + (long)r * 8 + (c - C_WI)) = make_float4(v[0], v[1], v[2], v[3]);
        } else { for (int j = 0; j < 4; ++j) v[j] = sigmoidf(v[j]); }
        *(uint2*)(proj + (long)r * LDP + c) = pack4(v[0], v[1], v[2], v[3]);
      }
    }
  }
};
struct EpiProjVT {
  u16* vt; int m0;
  DI void operator()(f32x16 (&acc)[2][2], int wm, int wn, int lane) const {
#pragma unroll
    for (int mt = 0; mt < 2; ++mt)
#pragma unroll
      for (int nt = 0; nt < 2; ++nt) {
        const int cc = EPI_C;
#pragma unroll
        for (int q4 = 0; q4 < 4; ++q4) {
          const int r = m0 + wm * 64 + mt * 32 + 8 * q4 + 4 * (lane >> 5);
          const int b = r >> 13, t = r & 8191;
          uint2 w;
          w.x = pack2(acc[mt][nt][q4 * 4 + 0], acc[mt][nt][q4 * 4 + 1]);
          w.y = pack2(acc[mt][nt][q4 * 4 + 2], acc[mt][nt][q4 * 4 + 3]);
          *(uint2*)(vt + ((long)(b * 128 + cc)) * T + t) = w;
        }
      }
  }
};
DI int proj_group(int q) { return q < 7 ? q : (q < 8 ? q + 1 : q + 2); }
DI void proj_store4(u16* proj, float* widx, long r, int c, float v0, float v1, float v2, float v3) {
  if (c < LDP) {
    float v[4] = {v0, v1, v2, v3};
    if (c < C_KV) { for (int j = 0; j < 4; ++j) v[j] *= 0.125f; }
    else if (c < C_GN) {}
    else if (c < C_QD) { for (int j = 0; j < 4; ++j) v[j] = sigmoidf(v[j]); }
    else if (c < C_QI) {}
    else if (c < C_KI) { for (int j = 0; j < 4; ++j) v[j] *= 0.125f; }
    else if (c < C_WI) {}
    else if (c < C_GM) {
      for (int j = 0; j < 4; ++j) v[j] *= 0.35355339059327373f;
      *(float4*)(widx + r * 8 + (c - C_WI)) = make_float4(v[0], v[1], v[2], v[3]);
    } else { for (int j = 0; j < 4; ++j) v[j] = sigmoidf(v[j]); }
    *(uint2*)(proj + r * LDP + c) = pack4(v[0], v[1], v[2], v[3]);
  }
}
struct WRows2 { const u16* base; int ra, rb; DI const u16* origin() const { return base; } DI int off(int r) const { return ((r < 128 ? ra : rb) + (r & 127)) * 1024; } };
struct Epi8Proj {
  u16* proj; float* widx; int m0, n0a, n0b;
  DI void operator()(int q, int c, float v0, float v1, float v2, float v3) const {
    proj_store4(proj, widx, m0 + q, (c < 128 ? n0a : n0b) + (c & 127), v0, v1, v2, v3);
  }
};
struct Epi8ProjVT {
  u16* vts; u16* vtw; int m0;
  DI void operator()(int q, int c, float v0, float v1, float v2, float v3) const {
    const int r = m0 + c, b = r >> 13, t = r & 8191;
    u16* vt = q < 128 ? vts : vtw;
    *(uint2*)(vt + ((long)(b * 128 + (q & 127))) * T + t) = pack4(v0, v1, v2, v3);
  }
};
DI void phase2_8w(const Params& p, int wg, int nwg) {
  for (int i = wg; i < 1280; i += nwg) {
    const int x_ = i & 7, s_ = (i >> 3) & 31, blk = (i >> 8) * 8 + x_;
    if (blk >= 36) continue;
    const int nb = blk % 9, mb = blk / 9;
    const int mt_ = mb * 16 + (s_ >> 1), v = 2 * nb + (s_ & 1);
    ARows tf{p.h + (long)mt_ * 256 * 1024, 1024, 256};
    if (v < 17) {
      const int ga = proj_group(2 * v), gb = proj_group(2 * v + 1);
      WRows2 wf{p.w_inT, ga * 128, gb * 128};
      Epi8Proj ef{p.proj, p.widx, mt_ * 256, ga * 128, gb * 128};
      gemm8p(16, wf, tf, ef);
    } else {
      WRows2 wf{p.w_inT, 7 * 128, 9 * 128};
      Epi8ProjVT ef{p.vts, p.vtw, mt_ * 256};
      gemm8p(16, tf, wf, ef);
    }
  }
}
DI void phase2(const Params& p, char* smem, int bid, int nblk) {}

struct ACmp {
  const u16* proj; int slot, m0;
  DI const u16* operator()(int r) const {
    const int R = m0 + r, bg = R >> 9, n = R & 511, b = bg >> 1, g = bg & 1;
    const int nc = n >= 511 ? 510 : n;
    return proj + ((long)b * T + 16 * nc) * LDP + C_KV + slot * 128 + g * 64;
  }
};
struct EpiCmp1 {
  u16* zc; const float* b1; const float* pe_part; int slot, m0;
  DI void operator()(f32x16 (&acc)[2][2], int wm, int wn, int lane) const {
    constexpr int MT = 2;
#pragma unroll
    for (int nt = 0; nt < 2; ++nt)
#pragma unroll
      for (int q4 = 0; q4 < 4; ++q4) {
        const int c = SW_C0;
        float4 bias = *(const float4*)(b1 + slot * 128 + c);
        for (int q = 0; q < 16; ++q) {
          const float4 t = *(const float4*)(pe_part + q * 256 + slot * 128 + c);
          bias.x += t.x; bias.y += t.y; bias.z += t.z; bias.w += t.w;
        }
#pragma unroll
        for (int mt = 0; mt < 2; ++mt) {
          const int R = m0 + SW_R;
          *(uint2*)(zc + ((long)slot * 2048 + R) * 128 + c) =
              pack4(gelu_tanh(SW_V(0) + bias.x), gelu_tanh(SW_V(1) + bias.y), gelu_tanh(SW_V(2) + bias.z), gelu_tanh(SW_V(3) + bias.w));
        }
      }
  }
};
struct EpiQlat {
  u16* qlat; int h, m0;
  DI void operator()(f32x16 (&acc)[2][2], int wm, int wn, int lane) const {
    constexpr int MT = 2;
    SW_FOR {
      const int r = m0 + SW_R, c = SW_C0;
      *(uint2*)(qlat + ((long)r * 8 + h) * 128 + c) = pack4(SW_V(0) * 0.125f, SW_V(1) * 0.125f, SW_V(2) * 0.125f, SW_V(3) * 0.125f);
    }
  }
};
DI void indexer_item(const Params& p, char* smem, int item);
DI void phase3(const Params& p, char* smem, int bid, int nblk) {
  const int tid = TIDX(), lane = tid & 63, wid = __builtin_amdgcn_readfirstlane(tid >> 6);
  if (bid < 32) {
    const int slot = bid >> 4, mt_ = bid & 15;
    ACmp af{p.proj, slot, mt_ * 128};
    BMat bf{p.cmp_w1 + (long)slot * 2048 * 128, 128, 128};
    EpiCmp1 ef{p.zc, p.cmp_b1, p.pe_part, slot, mt_ * 128};
    gemm_tile(smem, 32, LDP, af, bf, ef);
    return;
  }
  for (int item = bid - 32; item < 4160 + 1024 + 512; item += nblk - 32) {
    hb_sync();
    if (item < 4160) {
      indexer_item(p, smem, item);
    } else if (item < 4160 + 1024) {
      const int it = item - 4160, h = it & 7, mt_ = it >> 3;
      ARows af{p.proj + (long)mt_ * 128 * LDP + C_QD + h * 64, LDP, 128};
      BMat bf{p.w_ukT + h * 64 * 128, 128, 128};
      EpiQlat ef{p.qlat, h, mt_ * 128};
      gemm_tile<true, true>(smem, 1, 64, af, bf, ef);
    } else {
      const int it = item - 4160 - 1024;
      for (int q = 0; q < 8; ++q) {
        const int row = it * 32 + wid * 8 + q;
        const unsigned u = *(const unsigned*)(p.proj + (long)row * LDP + C_CKV + lane * 2);
        const float a = lo16(u), b = hi16(u);
        const float ss = wave_sum(a * a + b * b);
        const float r = rsqrtf(ss * (1.f / 128.f) + 1e-6f);
        *(unsigned*)(p.ckv + (long)row * 128 + lane * 2) = pack2(a * r * p.dsa_kv_norm[lane * 2], b * r * p.dsa_kv_norm[lane * 2 + 1]);
      }
    }
  }
}

struct EpiCmp2 {
  u16* dst; int m0;
  DI void operator()(f32x16 (&acc)[2][2], int wm, int wn, int lane) const {
    constexpr int MT = 2;
    SW_FOR {
      const int R = m0 + SW_R, c = SW_C0;
      if (c < 64) *(uint2*)(dst + (long)R * 64 + c) = pack4(SW_V(0), SW_V(1), SW_V(2), SW_V(3));
    }
  }
};
struct EpiCmp2T {
  u16* dst; int m0;
  DI void operator()(f32x16 (&acc)[2][2], int wm, int wn, int lane) const {
#pragma unroll
    for (int mt = 0; mt < 2; ++mt)
#pragma unroll
      for (int nt = 0; nt < 2; ++nt) {
        const int c = EPI_C;
        if (c < 64) {
#pragma unroll
          for (int q4 = 0; q4 < 4; ++q4) {
            const int R = m0 + wm * 64 + mt * 32 + 8 * q4 + 4 * (lane >> 5);
            const int bg = R >> 9, n = R & 511;
            *(uint2*)(dst + ((long)(bg * 64 + c)) * 512 + n) =
                pack4(acc[mt][nt][q4 * 4 + 0], acc[mt][nt][q4 * 4 + 1], acc[mt][nt][q4 * 4 + 2], acc[mt][nt][q4 * 4 + 3]);
          }
        }
      }
  }
};
DI void indexer_item(const Params& p, char* smem, int item) {
  const int tid = TIDX(), lane = tid & 63, wid = __builtin_amdgcn_readfirstlane(tid >> 6);
  int b = 0, rem = item;
  if (rem >= 2080) { b = 1; rem -= 2080; }
  int qt = (int)((sqrtf(8.f * rem + 1.f) - 1.f) * 0.5f);
  while ((qt + 1) * (qt + 2) / 2 <= rem) ++qt;
  while (qt * (qt + 1) / 2 > rem) --qt;
  const int kt = rem - qt * (qt + 1) / 2;
  const int t0 = qt * 128 + (wid >> 1) * 64, s0 = kt * 128 + (wid & 1) * 64;
  if (s0 > t0 + 63) return;
  float* wl = (float*)smem + wid * 512;
  const float* wsrc = p.widx + ((long)b * T + t0) * 8;
#pragma unroll
  for (int i = 0; i < 8; ++i) wl[i * 64 + lane] = wsrc[i * 64 + lane];
  wave_sync();
  const u16* projb = p.proj + (long)b * T * LDP;
  const int r31 = lane & 31, hf = lane >> 5;
  u16* Kt = (u16*)(smem + 8192) + wid * (64 * 72);
  {
    const int piece = lane & 7, rb = lane >> 3;
#pragma unroll
    for (int i = 0; i < 8; ++i) {
      const uint4 v = *(const uint4*)(projb + (long)(s0 + rb + 8 * i) * LDP + C_KI + piece * 8);
      *(uint4*)(Kt + (rb + 8 * i) * 72 + piece * 8) = v;
    }
  }
  wave_sync();
  const u16* kfrag = Kt + r31 * 72 + hf * 8;
  f32x16 sum[2][2];
#pragma unroll
  for (int a = 0; a < 2; ++a)
#pragma unroll
    for (int c = 0; c < 2; ++c)
#pragma unroll
      for (int i = 0; i < 16; ++i) sum[a][c][i] = 0.f;
  const u16* qbase = projb + (long)(t0 + r31) * LDP + C_QI + hf * 8;
  bf16x8 af0[4], af1[4], af2[4], af3[4];
#define IDX_LOADQ(DST, STEP)                                                                            \
  {                                                                                                     \
    const int st_ = (STEP) < 15 ? (STEP) : 15;                                                          \
    _Pragma("unroll") for (int ks = 0; ks < 4; ++ks) DST[ks] = *(const bf16x8*)(qbase + (long)(st_ & 1) * 32 * LDP + (st_ >> 1) * 64 + ks * 16); \
  }
#define IDX_STEP(SRC, MT, H)                                                                            \
  {                                                                                                     \
    const float w_ = wl[((MT) * 32 + r31) * 8 + (H)];                                                   \
    _Pragma("unroll") for (int nt = 0; nt < 2; ++nt) {                                                  \
      f32x16 acc;                                                                                       \
      _Pragma("unroll") for (int i = 0; i < 16; ++i) acc[i] = 0.f;                                      \
      _Pragma("unroll") for (int ks = 0; ks < 4; ++ks) acc = __builtin_amdgcn_mfma_f32_32x32x16_bf16(*(const bf16x8*)(kfrag + nt * 32 * 72 + ks * 16), SRC[ks], acc, 0, 0, 0); \
      _Pragma("unroll") for (int i = 0; i < 16; ++i) sum[MT][nt][i] += w_ * fmaxf(acc[i], 0.f);        \
    }                                                                                                   \
  }
  IDX_LOADQ(af0, 0) IDX_LOADQ(af1, 1) IDX_LOADQ(af2, 2)
#pragma unroll 1
  for (int s4 = 0; s4 < 16; s4 += 4) {
    IDX_LOADQ(af3, s4 + 3)
    asm volatile("" ::: "memory");
    IDX_STEP(af0, 0, s4 >> 1)
    asm volatile("" ::: "memory");
    IDX_LOADQ(af0, s4 + 4)
    asm volatile("" ::: "memory");
    IDX_STEP(af1, 1, s4 >> 1)
    asm volatile("" ::: "memory");
    IDX_LOADQ(af1, s4 + 5)
    asm volatile("" ::: "memory");
    IDX_STEP(af2, 0, (s4 >> 1) + 1)
    asm volatile("" ::: "memory");
    IDX_LOADQ(af2, s4 + 6)
    asm volatile("" ::: "memory");
    IDX_STEP(af3, 1, (s4 >> 1) + 1)
    asm volatile("" ::: "memory");
  }
#undef IDX_LOADQ
#undef IDX_STEP
#pragma unroll
  for (int mt = 0; mt < 2; ++mt)
#pragma unroll
    for (int nt = 0; nt < 2; ++nt)
#pragma unroll
      for (int q4 = 0; q4 < 4; ++q4)
      {
        typedef _Float16 h4_t __attribute__((ext_vector_type(4)));
        typedef float f4_t __attribute__((ext_vector_type(4)));
        const f4_t v4 = {sum[mt][nt][4 * q4], sum[mt][nt][4 * q4 + 1], sum[mt][nt][4 * q4 + 2], sum[mt][nt][4 * q4 + 3]};
        *(h4_t*)((u16*)p.scores + ((long)b * T + t0 + mt * 32 + r31) * T + s0 + nt * 32 + 8 * q4 + 4 * hf) = __builtin_convertvector(v4, h4_t);
      }
}
DI void topk_row(const Params& p, int b, int t, int lane);
DI void phase4(const Params& p, char* smem, int bid, int nblk) {
  if (bid < 32) {
    const int slot = bid >> 4, mt_ = bid & 15;
    ARows af{p.zc + ((long)slot * 2048 + mt_ * 128) * 128, 128, 128};
    BMat bf{p.cmp_w2 + slot * 128 * 64, 64, 64};
    if (slot) { EpiCmp2T ef{p.vcT, mt_ * 128}; gemm_tile<false>(smem, 2, 64, af, bf, ef); }
    else { EpiCmp2 ef{p.kc, mt_ * 128}; gemm_tile(smem, 2, 64, af, bf, ef); }
  }
  const int tid = TIDX(), lane = tid & 63, wid = __builtin_amdgcn_readfirstlane(tid >> 6);
  for (int item = bid; item < 2048; item += nblk) {
    const int it = item < 1024 ? 2047 - item : item - 1024;
    const int b = it & 1, tb = it >> 1;
#pragma unroll 1
    for (int q = 0; q < 2; ++q) {
      asm volatile("" ::: "memory");
      topk_row(p, b, tb * 8 + wid * 2 + q, lane);
    }
  }
}

#define MFMA16(a, b, c) __builtin_amdgcn_mfma_f32_16x16x32_bf16((a), (b), (c), 0, 0, 0)
#define MFMA32(a, b, c) __builtin_amdgcn_mfma_f32_32x32x16_bf16((a), (b), (c), 0, 0, 0)

constexpr int NSA_STAGE_BYTES = 64 * 72 * 2 + 64 * 68 * 2;
DI void dense_scores(f32x16 (&acc)[2], const u16* Ks, const bf16x8 (&qf)[4], int lane) {
  const int r = lane & 31, hf = lane >> 5;
  bf16x8 kf[2][4];
#pragma unroll
  for (int tile = 0; tile < 2; ++tile)
#pragma unroll
    for (int ks = 0; ks < 4; ++ks) kf[tile][ks] = *(const bf16x8*)(Ks + (32 * tile + r) * 72 + 8 * hf + 16 * ks);
  asm volatile("" ::: "memory");
#pragma unroll
  for (int tile = 0; tile < 2; ++tile) {
    f32x16 c;
#pragma unroll
    for (int i = 0; i < 16; ++i) c[i] = 0.f;
#pragma unroll
    for (int ks = 0; ks < 4; ++ks) c = MFMA32(kf[tile][ks], qf[ks], c);
    acc[tile] = c;
  }
}
DI void dense_pv(const f32x16 (&acc)[2], const u16* Vs, int lane, f32x16 (&o)[2]) {
  const int r = lane & 31, hf = lane >> 5;
  uint2 vlo[2][2][2], vhi[2][2][2];
#pragma unroll
  for (int tile = 0; tile < 2; ++tile)
#pragma unroll
    for (int s = 0; s < 2; ++s)
#pragma unroll
      for (int dt = 0; dt < 2; ++dt) {
        const u16* vp = Vs + (32 * dt + r) * 68 + 32 * tile + 16 * s + 4 * hf;
        vlo[tile][s][dt] = *(const uint2*)vp;
        vhi[tile][s][dt] = *(const uint2*)(vp + 8);
      }
  asm volatile("" ::: "memory");
#pragma unroll
  for (int tile = 0; tile < 2; ++tile)
#pragma unroll
    for (int s = 0; s < 2; ++s) {
      uint4 w;
      w.x = pack2(acc[tile][8 * s + 0], acc[tile][8 * s + 1]);
      w.y = pack2(acc[tile][8 * s + 2], acc[tile][8 * s + 3]);
      w.z = pack2(acc[tile][8 * s + 4], acc[tile][8 * s + 5]);
      w.w = pack2(acc[tile][8 * s + 6], acc[tile][8 * s + 7]);
      const bf16x8 pb = __builtin_bit_cast(bf16x8, w);
#pragma unroll
      for (int dt = 0; dt < 2; ++dt) {
        uint4 a;
        a.x = vlo[tile][s][dt].x; a.y = vlo[tile][s][dt].y; a.z = vhi[tile][s][dt].x; a.w = vhi[tile][s][dt].y;
        o[dt] = MFMA32(__builtin_bit_cast(bf16x8, a), pb, o[dt]);
      }
    }
}
constexpr float LOG2E = 1.4426950408889634f;
template <int DSTEP>
DI float dense_mask(f32x16 (&acc)[2], bool active, int lo_c, int hi_c, int dist0_c, int dmin_u, const float* btab_h, int lane) {
  const int hf = lane >> 5;
  const bool colfull = !active || (lo_c <= 0 && hi_c >= 63);
  float mx = -INFINITY;
  if (dmin_u >= 128 && __ballot(colfull) == ~0ull) {
    const float be = active ? btab_h[128] : -INFINITY;
#pragma unroll
    for (int tile = 0; tile < 2; ++tile)
#pragma unroll
      for (int i = 0; i < 16; ++i) {
        const float sv = fmaf(acc[tile][i], LOG2E, be);
        acc[tile][i] = sv;
        mx = fmaxf(mx, sv);
      }
  } else {
    const int lo2 = active ? lo_c : 1, hi2 = active ? hi_c : 0;
#pragma unroll
    for (int tile = 0; tile < 2; ++tile)
#pragma unroll
      for (int i = 0; i < 16; ++i) {
        const int kl = 32 * tile + (i & 3) + 8 * (i >> 2) + 4 * hf;
        int dc = dist0_c - DSTEP * kl;
        dc = dc < 0 ? 0 : (dc > 128 ? 128 : dc);
        const float bias = btab_h[dc];
        const float s2 = fmaf(acc[tile][i], LOG2E, bias);
        const float sv = (kl >= lo2 && kl <= hi2) ? s2 : -INFINITY;
        acc[tile][i] = sv;
        mx = fmaxf(mx, sv);
      }
  }
  return fmaxf(mx, __shfl_xor(mx, 32));
}
DI void dense_chunk(const u16* Ks, const u16* Vs, bool active, int lo_c, int hi_c, int dist0_c, int dmin_u, const bf16x8 (&qf)[4],
                    const float* btab_h, int lane, float& m, float& l, f32x16 (&o)[2]) {
  f32x16 acc[2];
  dense_scores(acc, Ks, qf, lane);
  const float mx = dense_mask<1>(acc, active, lo_c, hi_c, dist0_c, dmin_u, btab_h, lane);
  const float mn = fmaxf(m, mx);
  const float alpha = __builtin_amdgcn_exp2f(m - mn);
  float ls = 0.f;
#pragma unroll
  for (int tile = 0; tile < 2; ++tile)
#pragma unroll
    for (int i = 0; i < 16; ++i) {
      const float pv = __builtin_amdgcn_exp2f(acc[tile][i] - mn);
      acc[tile][i] = pv;
      ls += pv;
    }
  ls += __shfl_xor(ls, 32);
  l = l * alpha + ls;
  m = mn;
  o[0] *= alpha;
  o[1] *= alpha;
  dense_pv(acc, Vs, lane, o);
}

template <int KSG, int VSG, bool NEEDV, class Next, class Body>
DI void chunk_pipeline(char* stage, const u16* kg0, const u16* vg0, int first, int tid, const Next& next, const Body& body) {
  const int srow = tid >> 3, spiece = tid & 7;
  uint4 rk0, rv0;
  rv0 = make_uint4(0, 0, 0, 0);
  int d = first;
#define NSA_GLOAD(D)                                                                      \
  {                                                                                       \
    rk0 = *(const uint4*)(kg0 + ((long)(D) * 64 + srow) * KSG + spiece * 8);              \
    if (NEEDV) rv0 = *(const uint4*)(vg0 + (long)srow * VSG + (D) * 64 + spiece * 8);     \
  }
  if (d >= 0) NSA_GLOAD(d)
  int ph = 0;
  __syncthreads();
  while (d >= 0) {
    u16* Ks = (u16*)(stage + ph * NSA_STAGE_BYTES);
    u16* Vs = Ks + 64 * 72;
    *(uint4*)(Ks + srow * 72 + spiece * 8) = rk0;
    if (NEEDV) {
      uint2* dv = (uint2*)(Vs + srow * 68 + spiece * 8);
      dv[0] = make_uint2(rv0.x, rv0.y); dv[1] = make_uint2(rv0.z, rv0.w);
    }
    const int dn = next(d);
    if (dn >= 0) NSA_GLOAD(dn)
    __syncthreads();
    body(d, Ks, Vs);
    ph ^= 1;
    d = dn;
  }
#undef NSA_GLOAD
}

DI void nsa_item(const Params& p, char* smem, int item) {
  const int tid = TIDX8(), lane = tid & 63, wid = __builtin_amdgcn_readfirstlane(tid >> 6);
  const int chunk = item & 127, g = (item >> 7) & 1, b = item >> 8;
  const int bg = b * 2 + g;
  float* btab = (float*)smem;
  u64* wun = (u64*)(smem + 2304);
  float* imps = (float*)(smem + 4096) + wid * 1056;
  char* stage = smem + 37888;
  for (int idx = tid; idx < 4 * 129; idx += 512) {
    const int h = idx / 129, d = idx % 129;
    const int bk = d < 128 ? BUCKET[d] : 31;
    btab[h * 132 + d] = p.rel_bias[bk * 16 + g * 4 + h] * LOG2E;
  }
  __syncthreads();
  const int t0 = chunk * 64;
  const int tw = t0 + wid * 8;
  const int c = lane & 31, hf = lane >> 5, qi = c >> 2, hh = c & 3;
  const int t_c = tw + qi;
  const int cur = t0 >> 6;
  const long row = (long)b * T + t_c;
  const u16* prow = p.proj + row * LDP;
  const u16* projb = p.proj + (long)b * T * LDP;
  const float* btab_h = btab + hh * 132;
  bf16x8 qf[4];
#pragma unroll
  for (int ks = 0; ks < 4; ++ks) qf[ks] = *(const bf16x8*)(prow + C_QN + (g * 4 + hh) * 64 + ks * 16 + hf * 8);
  const u16* gptr = prow + C_GN + (g * 4 + hh) * 3;
  for (int k = lane; k < 1056; k += 64) imps[k] = 0.f;
  u16* orow = p.onsa + row * 512 + (g * 4 + hh) * 64 + 4 * hf;
  auto emit = [&](const f32x16 (&o)[2], float sc, bool first) {
#pragma unroll
    for (int dt = 0; dt < 2; ++dt)
#pragma unroll
      for (int q4 = 0; q4 < 4; ++q4) {
        uint2* dst = (uint2*)(orow + 32 * dt + 8 * q4);
        float v0 = o[dt][4 * q4 + 0] * sc, v1 = o[dt][4 * q4 + 1] * sc, v2 = o[dt][4 * q4 + 2] * sc, v3 = o[dt][4 * q4 + 3] * sc;
        if (!first) {
          const uint2 u = *dst;
          v0 += lo16(u.x); v1 += hi16(u.x); v2 += lo16(u.y); v3 += hi16(u.y);
        }
        uint2 w;
        w.x = pack2(v0, v1);
        w.y = pack2(v2, v3);
        *dst = w;
      }
  };
  const int ncv_c = (t_c >= 31) ? ((t_c - 31) >> 4) + 1 : 0;
  const int ncv_max = ((t0 + 63 - 31) >> 4) + 1;
  const int nchunk_c = (ncv_max + 63) >> 6;
  {
    const u16* kcb = p.kc + (long)bg * 512 * 64;
    const u16* vcb = p.vcT + (long)bg * 64 * 512;
    float m = -1e30f, l = 0.f;
    auto next_c = [&](int d) { return d + 1 < nchunk_c ? d + 1 : -1; };
    chunk_pipeline<64, 512, false>(stage, kcb, vcb, 0, tid, next_c, [&](int i, const u16* Ks, const u16* Vs) {
      f32x16 acc[2];
      dense_scores(acc, Ks, qf, lane);
      const float mx = dense_mask<16>(acc, true, 0, ncv_c - 1 - i * 64, t_c - 31 - 1024 * i, tw - 31 - 1024 * i - 1008, btab_h, lane);
      const float mn = fmaxf(m, mx);
      float ls = 0.f;
#pragma unroll
      for (int tile = 0; tile < 2; ++tile)
#pragma unroll
        for (int q = 0; q < 16; ++q) ls += __builtin_amdgcn_exp2f(acc[tile][q] - mn);
      ls += __shfl_xor(ls, 32);
      l = l * __builtin_amdgcn_exp2f(m - mn) + ls;
      m = mn;
    });
    const float invl = 1.f / fmaxf(l, 1e-30f);
    f32x16 oc[2];
#pragma unroll
    for (int i = 0; i < 16; ++i) { oc[0][i] = 0.f; oc[1][i] = 0.f; }
    chunk_pipeline<64, 512, true>(stage, kcb, vcb, 0, tid, next_c, [&](int i, const u16* Ks, const u16* Vs) {
      f32x16 acc[2];
      dense_scores(acc, Ks, qf, lane);
      (void)dense_mask<16>(acc, true, 0, ncv_c - 1 - i * 64, t_c - 31 - 1024 * i, tw - 31 - 1024 * i - 1008, btab_h, lane);
      float part[2][4], spill[2][4];
#pragma unroll
      for (int tile = 0; tile < 2; ++tile) {
#pragma unroll
        for (int q = 0; q < 16; ++q) acc[tile][q] = __builtin_amdgcn_exp2f(acc[tile][q] - m) * invl;
#pragma unroll
        for (int q4 = 0; q4 < 4; ++q4) {
          float pa = acc[tile][4 * q4] + acc[tile][4 * q4 + 1] + acc[tile][4 * q4 + 2] + 0.5f * acc[tile][4 * q4 + 3];
          float sp = 0.5f * acc[tile][4 * q4 + 3];
          pa += __shfl_xor(pa, 1); pa += __shfl_xor(pa, 2);
          sp += __shfl_xor(sp, 1); sp += __shfl_xor(sp, 2);
          part[tile][q4] = pa; spill[tile][q4] = sp;
        }
      }
      if (hh == 0) {
#pragma unroll
        for (int tile = 0; tile < 2; ++tile)
#pragma unroll
          for (int q4 = 0; q4 < 4; ++q4) imps[qi * 132 + 16 * i + 8 * tile + 2 * q4 + hf] += part[tile][q4];
      }
      wave_sync();
      if (hh == 0) {
#pragma unroll
        for (int tile = 0; tile < 2; ++tile)
#pragma unroll
          for (int q4 = 0; q4 < 4; ++q4) imps[qi * 132 + 16 * i + 8 * tile + 2 * q4 + hf + 1] += spill[tile][q4];
      }
      wave_sync();
      dense_pv(acc, Vs, lane, oc);
    });
    emit(oc, bf2f(gptr[0]), true);
  }
  wave_sync();
  u64 my0 = 0, my1 = 0, wu0 = 0, wu1 = 0;
  for (int q = 0; q < 8; ++q) {
    u64 mask0, mask1;
    if (cur <= 15) {
      mask0 = (2ull << cur) - 1ull;
      mask1 = 0ull;
    } else {
      const float imp_lo = imps[q * 132 + lane], imp_hi = imps[q * 132 + lane + 64];
      const int jl = lane, jh = lane + 64;
      float c0 = (jl >= 1 && jl <= cur - 2) ? imp_lo : -1.f;
      float c1 = (jh <= cur - 2) ? imp_hi : -1.f;
      bool sel_lo = (jl == 0) || (jl == cur) || (jl == cur - 1);
      bool sel_hi = (jh == cur) || (jh == cur - 1);
      for (int r = 0; r < 13; ++r) {
        float bv; int bj;
        if (c0 >= c1) { bv = c0; bj = jl; } else { bv = c1; bj = jh; }
        wave_argmax(bv, bj);
        if (bj == jl) { sel_lo = true; c0 = -1.f; }
        if (bj == jh) { sel_hi = true; c1 = -1.f; }
      }
      mask0 = __ballot(sel_lo);
      mask1 = __ballot(sel_hi);
    }
    if (qi == q) { my0 = mask0; my1 = mask1; }
    wu0 |= mask0; wu1 |= mask1;
  }
  if (lane == 0) { wun[wid * 2] = wu0; wun[wid * 2 + 1] = wu1; }
  __syncthreads();
  u64 bu0 = wun[0] | wun[2] | wun[4] | wun[6] | wun[8] | wun[10] | wun[12] | wun[14];
  u64 bu1 = wun[1] | wun[3] | wun[5] | wun[7] | wun[9] | wun[11] | wun[13] | wun[15];
  bu0 = ((u64)(unsigned)__builtin_amdgcn_readfirstlane((int)(bu0 >> 32)) << 32) | (unsigned)__builtin_amdgcn_readfirstlane((int)bu0);
  bu1 = ((u64)(unsigned)__builtin_amdgcn_readfirstlane((int)(bu1 >> 32)) << 32) | (unsigned)__builtin_amdgcn_readfirstlane((int)bu1);
  {
    float m = -1e30f, l = 0.f;
    f32x16 o[2];
#pragma unroll
    for (int i = 0; i < 16; ++i) { o[0][i] = 0.f; o[1][i] = 0.f; }
    const int kcol = C_KV + 2 * 128 + g * 64;
    auto next_s = [&](int j) {
      ++j;
      if (j < 64) {
        const u64 mm = bu0 & (~0ull << j);
        if (mm) return (int)__builtin_ctzll(mm);
        j = 64;
      }
      if (j >= 128) return -1;
      const u64 mm = bu1 & (~0ull << (j - 64));
      return mm ? 64 + (int)__builtin_ctzll(mm) : -1;
    };
    chunk_pipeline<LDP, T, true>(stage, projb + kcol, p.vts + (long)bg * 64 * T, 0, tid, next_s, [&](int j, const u16* Ks, const u16* Vs) {
      const bool bit = ((j < 64 ? (my0 >> j) : (my1 >> (j - 64))) & 1ull) != 0;
      if (__ballot(bit) != 0ull) {
        const int pos0 = 64 * j;
        dense_chunk(Ks, Vs, bit, 0, t_c - pos0, t_c - pos0, tw - pos0 - 63, qf, btab_h, lane, m, l, o);
      }
    });
    emit(o, bf2f(gptr[1]) / fmaxf(l, 1e-30f), false);
  }
  {
    float m = -1e30f, l = 0.f;
    f32x16 o[2];
#pragma unroll
    for (int i = 0; i < 16; ++i) { o[0][i] = 0.f; o[1][i] = 0.f; }
    const int kcol = C_KV + 4 * 128 + g * 64;
    const int wlo_c = t_c - 511 < 0 ? 0 : t_c - 511;
    const int wlo_min = t0 - 511 < 0 ? 0 : t0 - 511;
    auto next_w = [&](int j) { return j + 1 <= cur ? j + 1 : -1; };
    chunk_pipeline<LDP, T, true>(stage, projb + kcol, p.vtw + (long)bg * 64 * T, wlo_min >> 6, tid, next_w, [&](int jw, const u16* Ks, const u16* Vs) {
      const int pos0 = 64 * jw;
      const int lo_c = wlo_c - pos0 < 0 ? 0 : wlo_c - pos0;
      dense_chunk(Ks, Vs, true, lo_c, t_c - pos0, t_c - pos0, tw - pos0 - 63, qf, btab_h, lane, m, l, o);
    });
    emit(o, bf2f(gptr[2]) / fmaxf(l, 1e-30f), false);
  }
}

DI unsigned f2ord(float v) { const unsigned u = __float_as_uint(v); return (u & 0x80000000u) ? ~u : (u | 0x80000000u); }

DI void topk_row(const Params& p, int b, int t, int lane) {
  const long row = (long)b * T + t;
  int* dst = p.selk + row * 256;
  if (t < 256) {
#pragma unroll
    for (int i = 0; i < 4; ++i) { const int s = i * 64 + lane; dst[s] = (s <= t) ? s : -1; }
    return;
  }
  const u16* srow = (const u16*)p.scores + row * T;
  const int ngrp = (t >> 10) + 1;
  unsigned u[128];
  int ln = lane;
  asm volatile("" : "+v"(ln));
#pragma unroll
  for (int gq = 0; gq < 8; ++gq) {
    if (gq < ngrp) {
#pragma unroll
      for (int j = 0; j < 16; ++j) {
        const int s = (gq * 16 + j) * 64 + ln;
        u[gq * 16 + j] = srow[s < t ? s : t];
      }
    } else {
#pragma unroll
      for (int j = 0; j < 16; ++j) u[gq * 16 + j] = 0u;
    }
  }
  asm volatile("" ::: "memory");
#pragma unroll
  for (int gq = 0; gq < 8; ++gq) {
    if (gq < ngrp) {
#pragma unroll
      for (int j = 0; j < 16; ++j) {
        const int s = (gq * 16 + j) * 64 + ln;
        { const unsigned h_ = u[gq * 16 + j]; u[gq * 16 + j] = (s <= t) ? ((h_ & 0x8000u) ? (~h_ & 0xFFFFu) : (h_ | 0x8000u)) : 0u; }
      }
    }
  }
  const int nlane = 16 * ngrp;
  unsigned m0 = 0u, m1 = 0u, m2 = 0u, m3 = 0u;
#pragma unroll
  for (int gq = 0; gq < 8; ++gq) {
    if (gq < ngrp) {
#pragma unroll
      for (int j = 0; j < 16; j += 4) {
        m0 = max(m0, u[gq * 16 + j]); m1 = max(m1, u[gq * 16 + j + 1]); m2 = max(m2, u[gq * 16 + j + 2]); m3 = max(m3, u[gq * 16 + j + 3]);
      }
    }
  }
  unsigned lo = wave_min_u(min(min(m0, m1), min(m2, m3)));
  unsigned hi = wave_max_u(max(max(m0, m1), max(m2, m3))) + 1u;
#define TOPK_COUNT_GE(PIV, OUT)                                                         \
  {                                                                                     \
    unsigned below_ = 0;     \
    _Pragma("unroll") for (int gq = 0; gq < 8; ++gq) {                                  \
      if (gq < ngrp) {                                                                  \
        _Pragma("unroll") for (int j = 0; j < 16; ++j) below_ += (u[gq * 16 + j] - (PIV)) >> 31; \
      }                                                                                 \
    }                                                                                   \
    OUT = wave_sum_i(nlane - (int)below_);                                              \
  }
  int c_lo, c_hi = 0;
  TOPK_COUNT_GE(lo, c_lo)
  int iter = 0;
  while (c_lo != 256 && hi - lo > 1u) {
    const unsigned span = hi - lo;
    unsigned step;
    if ((++iter & 3) == 0) step = span >> 1;
    else step = (unsigned)((float)span * ((float)(c_lo - 256) / (float)(c_lo - c_hi)));
    step = step < 1u ? 1u : (step > span - 1u ? span - 1u : step);
    const unsigned piv = lo + step;
    int c;
    TOPK_COUNT_GE(piv, c)
    if (c >= 256) { lo = piv; c_lo = c; } else { hi = piv; c_hi = c; }
  }
#undef TOPK_COUNT_GE
  const unsigned thr = lo;
  int ngt = 0;
#pragma unroll
  for (int gq = 0; gq < 8; ++gq) {
    if (gq < ngrp) {
#pragma unroll
      for (int j = 0; j < 16; ++j) ngt += __popcll(__ballot(u[gq * 16 + j] > thr));
    }
  }
  int base_gt = 0, base_eq = 0;
  const int need_eq = 256 - ngt;
  int ln2 = lane;
  asm volatile("" : "+v"(ln2));
#pragma unroll
  for (int gq = 0; gq < 8; ++gq) {
    if (gq < ngrp) {
#pragma unroll
      for (int j = 0; j < 16; ++j) {
        const int s = (gq * 16 + j) * 64 + ln2;
        const unsigned uv = u[gq * 16 + j];
        const bool gt = uv > thr, eq = uv == thr;
        const u64 mg = __ballot(gt), me = __ballot(eq);
        const int pg = __builtin_amdgcn_mbcnt_hi((unsigned)(mg >> 32), __builtin_amdgcn_mbcnt_lo((unsigned)mg, 0));
        const int pe = __builtin_amdgcn_mbcnt_hi((unsigned)(me >> 32), __builtin_amdgcn_mbcnt_lo((unsigned)me, 0));
        if (gt) dst[base_gt + pg] = s;
        if (eq && (base_eq + pe) < need_eq) dst[ngt + base_eq + pe] = s;
        base_gt += __popcll(mg);
        base_eq += __popcll(me);
      }
    }
  }
}

DI void phase6(const Params& p, char* smem, int bid, int nblk);
DI void phase5_nsa8(const Params& p) {
  for (int item = blockIdx.x; item < 512; item += gridDim.x) {
    __syncthreads();
    const int it = item < 256 ? 511 - item : item - 256;
    const int chunk = it >> 2, bgi = it & 3;
    nsa_item(p, g_smem, (bgi << 7) | chunk);
  }
  __syncthreads();
}
DI void phase5(const Params& p, char* smem, int bid, int nblk) {
  hb_sync();
  phase6(p, smem, bid, nblk);
}

DI void tr_read2(unsigned a0, unsigned a1, uint2& r0, uint2& r1) {
  asm volatile("ds_read_b64_tr_b16 %0, %2\n\tds_read_b64_tr_b16 %1, %3\n\ts_waitcnt lgkmcnt(0)" : "=&v"(r0), "=&v"(r1) : "v"(a0), "v"(a1) : "memory");
}
DI void tr_read4(unsigned a0, unsigned a1, unsigned a2, unsigned a3, uint2& r0, uint2& r1, uint2& r2, uint2& r3) {
  asm volatile("ds_read_b64_tr_b16 %0, %4\n\tds_read_b64_tr_b16 %1, %5\n\tds_read_b64_tr_b16 %2, %6\n\tds_read_b64_tr_b16 %3, %7\n\ts_waitcnt lgkmcnt(0)"
               : "=&v"(r0), "=&v"(r1), "=&v"(r2), "=&v"(r3) : "v"(a0), "v"(a1), "v"(a2), "v"(a3) : "memory");
}
DI void dsa_query(const Params& p, u16* Cs, const float* btab, int b, int t, int lane) {
  const long row = (long)b * T + t;
  const int lg = lane >> 4, r16 = lane & 15, hh = lane & 7;
  bf16x8 qf[4];
#pragma unroll
  for (int ks = 0; ks < 4; ++ks) {
    bf16x8 z = {0, 0, 0, 0, 0, 0, 0, 0};
    if (r16 < 8) z = *(const bf16x8*)(p.qlat + (row * 8 + r16) * 128 + ks * 32 + lg * 8);
    qf[ks] = z;
  }
  const u16* ckvb = p.ckv + (long)b * T * 128;
  const int nvalid = (t + 1) < 256 ? (t + 1) : 256;
  float m = -1e30f, l = 0.f;
  f32x4 o[8];
#pragma unroll
  for (int ct = 0; ct < 8; ++ct) o[ct] = (f32x4){0.f, 0.f, 0.f, 0.f};
  const unsigned cs_base = (unsigned)(size_t)Cs;
  const int nch = (nvalid + 31) >> 5;
  uint4 gv0, gv1, gv2, gv3, gv4, gv5, gv6, gv7;
  int kidx_n;
#define DSA_G1(V, I) { const int kr_ = __shfl(kidx_n, 4 * (I) + lg); V = *(const uint4*)(ckvb + (long)kr_ * 128 + r16 * 8); }
#define DSA_GATHER(CH)                                                            \
  {                                                                               \
    const int nv_ = (nvalid - (CH) * 32) > 32 ? 32 : (nvalid - (CH) * 32);        \
    kidx_n = p.selk[row * 256 + (CH) * 32 + (lane & 31)];                         \
    if ((lane & 31) >= nv_ || kidx_n < 0 || kidx_n > t) kidx_n = t;               \
    DSA_G1(gv0, 0) DSA_G1(gv1, 1) DSA_G1(gv2, 2) DSA_G1(gv3, 3) DSA_G1(gv4, 4) DSA_G1(gv5, 5) DSA_G1(gv6, 6) DSA_G1(gv7, 7) \
  }
  DSA_GATHER(0)
  for (int ch = 0; ch < nch; ++ch) {
    const int nval = (nvalid - ch * 32) > 32 ? 32 : (nvalid - ch * 32);
    const int kidx = kidx_n;
    wave_sync();
    {
      u16* d_ = Cs + lg * 144 + r16 * 8;
      *(uint4*)(d_) = gv0;            *(uint4*)(d_ + 4 * 144) = gv1;  *(uint4*)(d_ + 8 * 144) = gv2;  *(uint4*)(d_ + 12 * 144) = gv3;
      *(uint4*)(d_ + 16 * 144) = gv4; *(uint4*)(d_ + 20 * 144) = gv5; *(uint4*)(d_ + 24 * 144) = gv6; *(uint4*)(d_ + 28 * 144) = gv7;
    }
    { const int chn = ch + 1 < nch ? ch + 1 : nch - 1; DSA_GATHER(chn) }
    wave_sync();
    f32x4 acc[2];
#pragma unroll
    for (int rt = 0; rt < 2; ++rt) {
      const u16* kp = Cs + (16 * rt + r16) * 144 + 8 * lg;
      f32x4 c = {0.f, 0.f, 0.f, 0.f};
#pragma unroll
      for (int ks = 0; ks < 4; ++ks) c = MFMA16(*(const bf16x8*)(kp + 32 * ks), qf[ks], c);
      acc[rt] = c;
    }
    float mx = -INFINITY;
#pragma unroll
    for (int rt = 0; rt < 2; ++rt)
#pragma unroll
      for (int r = 0; r < 4; ++r) {
        const int pl = 16 * rt + 4 * lg + r;
        const int kk = __shfl(kidx, pl);
        int dc = t - kk;
        dc = dc < 0 ? 0 : (dc > 128 ? 128 : dc);
        const float sv = (pl < nval) ? fmaf(acc[rt][r], LOG2E, btab[hh * 132 + dc]) : -INFINITY;
        acc[rt][r] = sv;
        mx = fmaxf(mx, sv);
      }
    mx = fmaxf(mx, __shfl_xor(mx, 16));
    mx = fmaxf(mx, __shfl_xor(mx, 32));
    const float mn = fmaxf(m, mx);
    const float alpha = __builtin_amdgcn_exp2f(m - mn);
    float ls = 0.f;
#pragma unroll
    for (int rt = 0; rt < 2; ++rt)
#pragma unroll
      for (int r = 0; r < 4; ++r) {
        const float pv = __builtin_amdgcn_exp2f(acc[rt][r] - mn);
        acc[rt][r] = pv;
        ls += pv;
      }
    ls += __shfl_xor(ls, 16);
    ls += __shfl_xor(ls, 32);
    l = l * alpha + ls;
    m = mn;
    uint4 pw;
    pw.x = pack2(acc[0][0], acc[0][1]);
    pw.y = pack2(acc[0][2], acc[0][3]);
    pw.z = pack2(acc[1][0], acc[1][1]);
    pw.w = pack2(acc[1][2], acc[1][3]);
    const bf16x8 pb = __builtin_bit_cast(bf16x8, pw);
    const unsigned a_lo = cs_base + (unsigned)(((4 * lg + (r16 >> 2)) * 144 + 4 * (r16 & 3)) * 2);
    const unsigned a_hi = a_lo + 16 * 144 * 2;
#pragma unroll
    for (int ct = 0; ct < 8; ct += 2) {
      uint2 lo0, hi0, lo1, hi1;
      tr_read4(a_lo + ct * 32, a_hi + ct * 32, a_lo + ct * 32 + 32, a_hi + ct * 32 + 32, lo0, hi0, lo1, hi1);
      uint4 aw0, aw1;
      aw0.x = lo0.x; aw0.y = lo0.y; aw0.z = hi0.x; aw0.w = hi0.y;
      aw1.x = lo1.x; aw1.y = lo1.y; aw1.z = hi1.x; aw1.w = hi1.y;
      o[ct] = o[ct] * alpha;
      o[ct + 1] = o[ct + 1] * alpha;
      o[ct] = MFMA16(__builtin_bit_cast(bf16x8, aw0), pb, o[ct]);
      o[ct + 1] = MFMA16(__builtin_bit_cast(bf16x8, aw1), pb, o[ct + 1]);
    }
  }
#undef DSA_GATHER
#undef DSA_G1
  const float invl = 1.f / fmaxf(l, 1e-30f);
  if (r16 < 8) {
#pragma unroll
    for (int ct = 0; ct < 8; ++ct)
      *(uint2*)(p.olat + row * 1024 + r16 * 128 + 16 * ct + 4 * lg) = pack4(o[ct][0] * invl, o[ct][1] * invl, o[ct][2] * invl, o[ct][3] * invl);
  }
}
DI void phase6(const Params& p, char* smem, int bid, int nblk) {
  const int tid = TIDX(), lane = tid & 63, wid = __builtin_amdgcn_readfirstlane(tid >> 6);
  float* btab = (float*)smem;
  u16* Cs = (u16*)(smem + 8192) + wid * (32 * 144);
  for (int idx = tid; idx < 8 * 129; idx += 256) {
    const int h = idx / 129, d = idx % 129;
    const int bk = d < 128 ? BUCKET[d] : 31;
    btab[h * 132 + d] = p.rel_bias[bk * 16 + 8 + h] * LOG2E;
  }
  hb_sync();
  for (int item = bid; item < 2048; item += nblk) {
    const int it = item < 1024 ? 2047 - item : item - 1024;
    const int b = it & 1, tb = it >> 1;
    for (int q = 0; q < 2; ++q) dsa_query(p, Cs, btab, b, tb * 8 + wid * 2 + q, lane);
  }
}

struct EpiOdsa {
  u16* odsa; int h, m0;
  DI void operator()(f32x16 (&acc)[2][2], int wm, int wn, int lane) const {
    constexpr int MT = 2;
    SW_FOR {
      const int r = m0 + SW_R, c = SW_C0;
      if (c < 64) *(uint2*)(odsa + (long)r * 512 + h * 64 + c) = pack4(SW_V(0), SW_V(1), SW_V(2), SW_V(3));
    }
  }
};
DI void phase7(const Params& p, char* smem, int bid, int nblk) {
  for (int item = bid; item < 1024; item += nblk) {
    const int h = item & 7, mt_ = item >> 3;
    ARows af{p.olat + (long)mt_ * 128 * 1024 + h * 128, 1024, 128};
    BMat bf{p.dsa_w_uv + h * 64, 512, 64};
    EpiOdsa ef{p.odsa, h, mt_ * 128};
    gemm_tile(smem, 2, 64, af, bf, ef);
  }
}

struct EpiY {
  u16* y; const u16* proj; int m0, n0, second;
  template <int MT> DI void operator()(f32x16 (&acc)[MT][2], int wm, int wn, int lane) const {
    SW_FOR {
      const int r = m0 + SW_R, c = n0 + SW_C0;
      const uint2 gu = *(const uint2*)(proj + (long)r * LDP + C_GM + second * 1024 + c);
      float v0 = lo16(gu.x) * SW_V(0), v1 = hi16(gu.x) * SW_V(1), v2 = lo16(gu.y) * SW_V(2), v3 = hi16(gu.y) * SW_V(3);
      uint2* dst = (uint2*)(y + (long)r * 1024 + c);
      if (second) {
        const uint2 yu = *dst;
        v0 += lo16(yu.x); v1 += hi16(yu.x); v2 += lo16(yu.y); v3 += hi16(yu.y);
      }
      *dst = pack4(v0, v1, v2, v3);
    }
  }
};
struct Epi8Y {
  u16* y; const u16* proj; int m0, n0, second;
  DI void operator()(int q, int c, float v0, float v1, float v2, float v3) const {
    const long r = m0 + q; const int cc = n0 + c;
    const uint2 gu = *(const uint2*)(proj + r * LDP + C_GM + second * 1024 + cc);
    v0 *= lo16(gu.x); v1 *= hi16(gu.x); v2 *= lo16(gu.y); v3 *= hi16(gu.y);
    uint2* dst = (uint2*)(y + r * 1024 + cc);
    if (second) {
      const uint2 yu = *dst;
      v0 += lo16(yu.x); v1 += hi16(yu.x); v2 += lo16(yu.y); v3 += hi16(yu.y);
    }
    *dst = pack4(v0, v1, v2, v3);
  }
};
DI void phase8_8w(const Params& p, int wg, int nwg) {
  for (int item = wg; item < 256; item += nwg) {
    const int x_ = item & 7, s_ = item >> 3, nt_ = s_ & 3, mt_ = x_ * 8 + (s_ >> 2);
    {
      ARows wf{p.w_bnT + (long)nt_ * 256 * 512, 512, 256};
      ARows xf{p.onsa + (long)mt_ * 256 * 512, 512, 256};
      Epi8Y ef{p.y, p.proj, mt_ * 256, nt_ * 256, 0};
      gemm8p(8, wf, xf, ef);
    }
    {
      ARows wf{p.w_bdT + (long)nt_ * 256 * 512, 512, 256};
      ARows xf{p.odsa + (long)mt_ * 256 * 512, 512, 256};
      Epi8Y ef{p.y, p.proj, mt_ * 256, nt_ * 256, 1};
      gemm8p(8, wf, xf, ef);
    }
  }
}
struct EpiStoreBf {
  u16* dst; long ld; int m0, n0;
  template <int MT> DI void operator()(f32x16 (&acc)[MT][2], int wm, int wn, int lane) const {
    SW_FOR { *(uint2*)(dst + (long)(m0 + SW_R) * ld + n0 + SW_C0) = pack4(SW_V(0), SW_V(1), SW_V(2), SW_V(3)); }
  }
};
struct Epi8StoreBf {
  u16* dst; long ld; int m0, n0;
  DI void operator()(int q, int c, float v0, float v1, float v2, float v3) const { *(uint2*)(dst + (long)(m0 + q) * ld + n0 + c) = pack4(v0, v1, v2, v3); }
};
DI void phase9_8w(const Params& p, int wg, int nwg) {
  for (int item = wg; item < 256; item += nwg) {
    const int x_ = item & 7, s_ = item >> 3, nt_ = s_ & 3, mt_ = x_ * 8 + (s_ >> 2);
    ARows wf{p.w_outT + (long)nt_ * 256 * 1024, 1024, 256};
    ARows xf{p.y + (long)mt_ * 256 * 1024, 1024, 256};
    Epi8StoreBf ef{p.z, 1024, mt_ * 256, nt_ * 256};
    gemm8p(16, wf, xf, ef);
  }
}

DI void phase10(const Params& p, int bid, int nblk) {
  const int tid = TIDX(), lane = tid & 63, wid = __builtin_amdgcn_readfirstlane(tid >> 6);
  const int b = bid & 1;
  const float* modb = p.mod + b * 6144;
  float cz[16], cm[16], ca[16];
#pragma unroll
  for (int i = 0; i < 4; ++i) {
    const int col = i * 256 + lane * 4;
    const float4 gt = *(const float4*)(modb + 2048 + col), gp = *(const float4*)(p.g_post_mix + col);
    const float4 gf = *(const float4*)(p.g_pre_ffn + col), sc = *(const float4*)(modb + 4096 + col), sh = *(const float4*)(modb + 3072 + col);
    cz[i * 4 + 0] = gt.x * gp.x; cz[i * 4 + 1] = gt.y * gp.y; cz[i * 4 + 2] = gt.z * gp.z; cz[i * 4 + 3] = gt.w * gp.w;
    cm[i * 4 + 0] = gf.x * (1.f + sc.x); cm[i * 4 + 1] = gf.y * (1.f + sc.y); cm[i * 4 + 2] = gf.z * (1.f + sc.z); cm[i * 4 + 3] = gf.w * (1.f + sc.w);
    ca[i * 4 + 0] = sh.x; ca[i * 4 + 1] = sh.y; ca[i * 4 + 2] = sh.z; ca[i * 4 + 3] = sh.w;
  }
  const int stride = (nblk >> 1) * 4;
  for (int t0 = (bid >> 1) * 4 + wid; t0 < T; t0 += 2 * stride) {
    uint2 zu[2][4]; float4 xx[2][4];
#pragma unroll
    for (int k = 0; k < 2; ++k) {
      const int t = t0 + k * stride < T ? t0 + k * stride : T - 1;
      const long row = (long)b * T + t;
#pragma unroll
      for (int i = 0; i < 4; ++i) {
        zu[k][i] = *(const uint2*)(p.z + row * 1024 + i * 256 + lane * 4);
        xx[k][i] = *(const float4*)(p.x + row * 1024 + i * 256 + lane * 4);
      }
    }
#pragma unroll
    for (int k = 0; k < 2; ++k) {
      float zv[16], xv[16];
      float ss = 0.f;
#pragma unroll
      for (int i = 0; i < 4; ++i) {
        zv[i * 4 + 0] = lo16(zu[k][i].x); zv[i * 4 + 1] = hi16(zu[k][i].x); zv[i * 4 + 2] = lo16(zu[k][i].y); zv[i * 4 + 3] = hi16(zu[k][i].y);
        xv[i * 4 + 0] = xx[k][i].x; xv[i * 4 + 1] = xx[k][i].y; xv[i * 4 + 2] = xx[k][i].z; xv[i * 4 + 3] = xx[k][i].w;
#pragma unroll
        for (int j = 0; j < 4; ++j) ss += zv[i * 4 + j] * zv[i * 4 + j];
      }
      ss = wave_sum(ss);
      const float r = rsqrtf(ss * (1.f / 1024.f) + 1e-6f);
      float ss2 = 0.f;
#pragma unroll
      for (int j = 0; j < 16; ++j) {
        const float v = xv[j] + cz[j] * (zv[j] * r);
        xv[j] = v;
        ss2 += v * v;
      }
      ss2 = wave_sum(ss2);
      const float r2 = rsqrtf(ss2 * (1.f / 1024.f) + 1e-6f);
      if (t0 + k * stride < T) {
        const long row = (long)b * T + t0 + k * stride;
#pragma unroll
        for (int i = 0; i < 4; ++i) {
          const int col = i * 256 + lane * 4;
          *(float4*)(p.x1 + row * 1024 + col) = make_float4(xv[i * 4], xv[i * 4 + 1], xv[i * 4 + 2], xv[i * 4 + 3]);
          *(uint2*)(p.h + row * 1024 + col) = pack4(xv[i * 4] * r2 * cm[i * 4] + ca[i * 4], xv[i * 4 + 1] * r2 * cm[i * 4 + 1] + ca[i * 4 + 1],
                                                    xv[i * 4 + 2] * r2 * cm[i * 4 + 2] + ca[i * 4 + 2], xv[i * 4 + 3] * r2 * cm[i * 4 + 3] + ca[i * 4 + 3]);
        }
      }
    }
  }
}

struct EpiStoreF32 {
  float* dst; long ld; int m0, n0;
  DI void operator()(f32x16 (&acc)[2][2], int wm, int wn, int lane) const {
    constexpr int MT = 2;
    SW_FOR { *(float4*)(dst + (long)(m0 + SW_R) * ld + n0 + SW_C0) = make_float4(SW_V(0), SW_V(1), SW_V(2), SW_V(3)); }
  }
};
DI void phase11(const Params& p, char* smem, int bid, int nblk) {
  for (int item = bid; item < 256; item += nblk) {
    const int nt_ = item & 1, mt_ = item >> 1;
    ARows af{p.h + (long)mt_ * 128 * 1024, 1024, 128};
    BMatT bf{p.routerT + (long)nt_ * 128 * 1024, 1024};
    EpiStoreF32 ef{p.logits, 256, mt_ * 128, nt_ * 128};
    gemm_tile<true, false, true>(smem, 16, 64, af, bf, ef);
  }
}
DI void phase12(const Params& p, int bid, int nblk) {
  const int tid = TIDX(), lane = tid & 63, wid = __builtin_amdgcn_readfirstlane(tid >> 6);
  for (int tok = bid * 4 + wid; tok < NTOK; tok += nblk * 4) {
    const float4 lg = *(const float4*)(p.logits + (long)tok * 256 + lane * 4);
    const float4 rbv = *(const float4*)(p.router_bias + lane * 4);
    float sg[4] = {sigmoidf(lg.x), sigmoidf(lg.y), sigmoidf(lg.z), sigmoidf(lg.w)};
    float sl[4] = {sg[0] + rbv.x, sg[1] + rbv.y, sg[2] + rbv.z, sg[3] + rbv.w};
    float t1 = fmaxf(sl[0], sl[1]), t2 = fminf(sl[0], sl[1]);
#pragma unroll
    for (int j = 2; j < 4; ++j) {
      const float v = sl[j];
      t2 = fmaxf(t2, fminf(t1, v));
      t1 = fmaxf(t1, v);
    }
#define R_MERGE(CTRL)                                                                                                            \
    {                                                                                                                            \
      const float a1 = __int_as_float(__builtin_amdgcn_update_dpp(0, __float_as_int(t1), CTRL, 0xF, 0xF, true));                 \
      const float a2 = __int_as_float(__builtin_amdgcn_update_dpp(0, __float_as_int(t2), CTRL, 0xF, 0xF, true));                 \
      const float n1 = fmaxf(t1, a1);                                                                                            \
      const float n2 = fmaxf(fminf(t1, a1), fmaxf(t2, a2));                                                                      \
      t1 = n1; t2 = n2;                                                                                                          \
    }
    R_MERGE(DPP_QP1) R_MERGE(DPP_QP2) R_MERGE(DPP_RHM)
#undef R_MERGE
    const float gscore = t1 + t2;
    const int grp = lane >> 3;
    int rank = 0;
#pragma unroll
    for (int g2 = 0; g2 < 8; ++g2) {
      const float og = rdlane(gscore, g2 * 8);
      rank += (og > gscore || (og == gscore && g2 < grp)) ? 1 : 0;
    }
    const bool gsel = rank < 4;
    float cv[4];
#pragma unroll
    for (int j = 0; j < 4; ++j) cv[j] = gsel ? sl[j] : -1e30f;
    int my_e = -1; float my_s = 0.f; float ssum = 0.f;
    for (int r = 0; r < 8; ++r) {
      float bv = cv[0]; int bj = 0;
#pragma unroll
      for (int j = 1; j < 4; ++j) if (cv[j] > bv) { bv = cv[j]; bj = j; }
      int be = lane * 4 + bj;
      wave_argmax(bv, be);
      const int wl_ = be >> 2, wj = be & 3;
      const float s0 = rdlane(sg[0], wl_), s1 = rdlane(sg[1], wl_), s2 = rdlane(sg[2], wl_), s3 = rdlane(sg[3], wl_);
      const float bs = wj == 0 ? s0 : (wj == 1 ? s1 : (wj == 2 ? s2 : s3));
      if (wl_ == lane) {
        if (wj == 0) cv[0] = -3e30f; else if (wj == 1) cv[1] = -3e30f; else if (wj == 2) cv[2] = -3e30f; else cv[3] = -3e30f;
      }
      if (lane == r) { my_e = be; my_s = bs; }
      ssum += bs;
    }
    if (lane < 8) {
      const float w = my_s / ssum * 2.5f;
      const int rk = atomicAdd(p.counts + my_e * 32, 1);
      p.eidx[tok * 8 + lane] = my_e;
      p.ewt[tok * 8 + lane] = w;
      p.erank[tok * 8 + lane] = rk;
    }
  }
}
DI void phase14(const Params& p, char* smem, int bid, int nblk) {
  const int tid = TIDX();
  int* s_cnt = (int*)smem;
  int* s_off = s_cnt + 256;
  const int cnt = p.counts[tid * 32];
  s_cnt[tid] = cnt;
  hb_sync();
  int run = 0, nt = 0, nt2 = 0;
  for (int e = 0; e < tid; ++e) { const int c = s_cnt[e]; run += c; nt += (c + 127) >> 7; nt2 += (c + 255) >> 8; }
  s_off[tid] = run;
  hb_sync();
  if (bid == 0) {
    p.offs[tid] = run;
    for (int m = 0; m * 256 < cnt; ++m) {
      p.tile2_e[nt2] = tid;
      p.tile2_r0[nt2] = run + m * 256;
      p.tile2_nr[nt2] = (cnt - m * 256) > 256 ? 256 : (cnt - m * 256);
      ++nt2;
    }
    for (int m = 0; m * 128 < cnt; ++m) {
      p.tile_e[nt] = tid;
      p.tile_r0[nt] = run + m * 128;
      p.tile_nr[nt] = (cnt - m * 128) > 128 ? 128 : (cnt - m * 128);
      ++nt;
    }
    if (tid == 255) {
      p.offs[256] = run + cnt;
      for (int m = 0; m < 128; ++m) {
        p.tile_e[nt] = 256;
        p.tile_r0[nt] = 131072 + m * 128;
        p.tile_nr[nt] = 128;
        ++nt;
      }
      p.ntiles[0] = nt;
      for (int m = 0; m < 64; ++m) {
        p.tile2_e[nt2] = 256;
        p.tile2_r0[nt2] = 131072 + m * 256;
        p.tile2_nr[nt2] = 256;
        ++nt2;
      }
      p.ntiles[1] = nt2;
    }
  }
  for (int i = bid * 256 + tid; i < NSLOT; i += nblk * 256) {
    if (i < 131072) {
      const int e = p.eidx[i];
      const int slot = s_off[e] + p.erank[i];
      p.slot_tok[slot] = i >> 3;
      p.slot_wt[slot] = p.ewt[i];
      p.tok_slot[i] = slot;
    } else {
      p.slot_tok[i] = i - 131072;
      p.slot_wt[i] = 1.f;
    }
  }
}

struct AGather {
  const u16* h; const int* slot_tok; int r0, nr;
  DI const u16* operator()(int r) const { return h + (long)slot_tok[r0 + (r < nr ? r : 0)] * 1024; }
  DI const u16* origin() const { return h; } DI int off(int r) const { return slot_tok[r0 + (r < nr ? r : 0)] * 1024; }
};
struct BGateUp {
  const float* wg; long udiff; long ldb; int n0;
  DI const float* operator()(int c4) const {
    const int wn = c4 >> 6, ntl = (c4 >> 5) & 1, j = c4 & 31;
    return wg + (long)ntl * udiff + n0 + wn * 32 + j;
  }
  DI const u16* row(int) const { return nullptr; }
};
struct EpiH {
  u16* H; int r0, nr, n0;
  template <int MT> DI void operator()(f32x16 (&acc)[MT][2], int wm, int wn, int lane) const {
#pragma unroll
    for (int mt = 0; mt < MT; ++mt) {
      const int r = SW_R;
      if (r < nr) {
#pragma unroll
        for (int q4 = 0; q4 < 4; ++q4) {
          float v[4];
#pragma unroll
          for (int j = 0; j < 4; ++j) v[j] = siluf(acc[mt][0][4 * q4 + j]) * acc[mt][1][4 * q4 + j];
          *(uint2*)(H + (long)(r0 + r) * 256 + n0 + wn * 32 + 8 * q4 + 4 * (lane >> 5)) = pack4(v[0], v[1], v[2], v[3]);
        }
      }
    }
  }
};
struct BGateUp8 {
  const float* wg; long udiff; long ldb; int n0;
  DI const float* operator()(int c4) const {
    const int wn = c4 >> 6, ntl = (c4 >> 5) & 1, j = c4 & 31;
    return wg + (long)ntl * udiff + n0 + wn * 32 + j;
  }
};
DI void phase15_8w(const Params& p, int wg, int nwg) {
  const int ntl = p.ntiles[1];
  const int nit = ntl * 2, nrounds = (nit + 255) >> 8;
  for (int i = wg; i < nrounds * 256; i += nwg) {
    const int item = ((((i >> 8) << 3) + (i & 7)) << 5) + ((i >> 3) & 31);
    if (item >= nit) continue;
    const int ti = item >> 1, nt_ = item & 1;
    const int e = p.tile2_e[ti], r0 = p.tile2_r0[ti], nr = p.tile2_nr[ti];
    AGather af{p.h, p.slot_tok, r0, nr};
    const float* wgp = e < 256 ? p.w_eg + (long)e * 1024 * 256 : p.w_sg;
    const float* wup = e < 256 ? p.w_eu + (long)e * 1024 * 256 : p.w_su;
    BGateUp8 bf{wgp, (long)(wup - wgp), 256, nt_ * 128};
    EpiH ef{p.H, r0, nr, nt_ * 128};
    gemm8w<false>(16, af, bf, ef);
  }
}
struct EpiYexp {
  u16* Y; const float* slot_wt; int r0, nr, n0;
  template <int MT> DI void operator()(f32x16 (&acc)[MT][2], int wm, int wn, int lane) const {
#pragma unroll
    for (int mt = 0; mt < MT; ++mt) {
      const int r = SW_R;
      if (r < nr) {
        const float w = slot_wt[r0 + r];
#pragma unroll
        for (int nt = 0; nt < 2; ++nt)
#pragma unroll
          for (int q4 = 0; q4 < 4; ++q4)
            *(uint2*)(Y + (long)(r0 + r) * 1024 + n0 + SW_C0) = pack4(SW_V(0) * w, SW_V(1) * w, SW_V(2) * w, SW_V(3) * w);
      }
    }
  }
};
DI void phase16_8w(const Params& p, int wg, int nwg) {
  const int ntl = p.ntiles[1];
  const int nit = ntl * 4, nrounds = (nit + 255) >> 8;
  for (int i = wg; i < nrounds * 256; i += nwg) {
    const int item = ((((i >> 8) << 3) + (i & 7)) << 5) + ((i >> 3) & 31);
    if (item >= nit) continue;
    const int ti = item >> 2, nt_ = item & 3;
    const int e = p.tile2_e[ti], r0 = p.tile2_r0[ti], nr = p.tile2_nr[ti];
    ARows af{p.H + (long)r0 * 256, 256, nr};
    const float* wd = e < 256 ? p.w_ed + (long)e * 256 * 1024 : p.w_sd;
    BMat bf{wd + nt_ * 256, 1024, 256};
    EpiYexp ef{p.Y, p.slot_wt, r0, nr, nt_ * 256};
    gemm8w<false>(4, af, bf, ef);
  }
}
DI void phase17(const Params& p, int bid, int nblk) {
  const int tid = TIDX(), lane = tid & 63, wid = __builtin_amdgcn_readfirstlane(tid >> 6);
  const int b = bid & 1;
  const float* modb = p.mod + b * 6144;
  float cy[16];
#pragma unroll
  for (int i = 0; i < 4; ++i) {
    const int col = i * 256 + lane * 4;
    const float4 gt = *(const float4*)(modb + 5120 + col), gp = *(const float4*)(p.g_post_ffn + col);
    cy[i * 4 + 0] = gt.x * gp.x; cy[i * 4 + 1] = gt.y * gp.y; cy[i * 4 + 2] = gt.z * gp.z; cy[i * 4 + 3] = gt.w * gp.w;
  }
  const int stride = (nblk >> 1) * 4;
  for (int t0 = (bid >> 1) * 4 + wid; t0 < T; t0 += 2 * stride) {
    long rows[2];
    int slots[2][8];
#pragma unroll
    for (int k = 0; k < 2; ++k) {
      const int t = t0 + k * stride < T ? t0 + k * stride : T - 1;
      rows[k] = (long)b * T + t;
      const int4 s0 = *(const int4*)(p.tok_slot + rows[k] * 8), s1 = *(const int4*)(p.tok_slot + rows[k] * 8 + 4);
      slots[k][0] = s0.x; slots[k][1] = s0.y; slots[k][2] = s0.z; slots[k][3] = s0.w;
      slots[k][4] = s1.x; slots[k][5] = s1.y; slots[k][6] = s1.z; slots[k][7] = s1.w;
    }
    float4 xx[2][4];
#pragma unroll
    for (int k = 0; k < 2; ++k)
#pragma unroll
      for (int i = 0; i < 4; ++i) xx[k][i] = *(const float4*)(p.x1 + rows[k] * 1024 + i * 256 + lane * 4);
#pragma unroll
    for (int k = 0; k < 2; ++k) {
      float yv[16];
#pragma unroll
      for (int j = 0; j < 16; ++j) yv[j] = 0.f;
#pragma unroll
      for (int q = 0; q < 9; ++q) {
        const long sl = q < 8 ? (long)slots[k][q] : 131072 + rows[k];
#pragma unroll
        for (int i = 0; i < 4; ++i) {
          const uint2 u = *(const uint2*)(p.Y + sl * 1024 + i * 256 + lane * 4);
          yv[i * 4 + 0] += lo16(u.x); yv[i * 4 + 1] += hi16(u.x); yv[i * 4 + 2] += lo16(u.y); yv[i * 4 + 3] += hi16(u.y);
        }
      }
      float ss = 0.f;
#pragma unroll
      for (int j = 0; j < 16; ++j) ss += yv[j] * yv[j];
      ss = wave_sum(ss);
      const float r = rsqrtf(ss * (1.f / 1024.f) + 1e-6f);
      if (t0 + k * stride < T) {
#pragma unroll
        for (int i = 0; i < 4; ++i) {
          const int col = i * 256 + lane * 4;
          *(float4*)(p.out + rows[k] * 1024 + col) = make_float4(xx[k][i].x + cy[i * 4] * (yv[i * 4] * r), xx[k][i].y + cy[i * 4 + 1] * (yv[i * 4 + 1] * r),
                                                                 xx[k][i].z + cy[i * 4 + 2] * (yv[i * 4 + 2] * r), xx[k][i].w + cy[i * 4 + 3] * (yv[i * 4 + 3] * r));
        }
      }
    }
  }
}

__global__ void __launch_bounds__(512, 2) mega(Params p) {
  cg::grid_group grid = cg::this_grid();
  const int vb = __builtin_amdgcn_readfirstlane((int)(threadIdx.x >> 8));
  char* smem = g_smem + vb * HALF_LDS;
  const int bid = blockIdx.x * 2 + vb, nblk = gridDim.x * 2;
  if (p.phase_hi == 12345) grid.sync();
  if (threadIdx.x < 32) ((unsigned*)(g_smem + 2 * HALF_LDS))[threadIdx.x] = 0u;
  __syncthreads();
  const XcdBarrier xb = xcd_barrier_post(p.bar, (volatile LAS unsigned*)(g_smem + 2 * HALF_LDS));
#if !defined(ONLY) || ONLY==0
  if (p.phase_lo <= 0 && 0 < p.phase_hi) {
    phase0(p, smem, bid, nblk);
#if (REPEAT_MASK >> 0) & 1
    xcd_barrier(xb);
    phase0(p, smem, bid, nblk);
#endif
    if (0 + 1 < p.phase_hi) xcd_barrier(xb);
  }
#endif
#if !defined(ONLY) || ONLY==1
  if (p.phase_lo <= 1 && 1 < p.phase_hi) {
    phase1(p, smem, bid, nblk);
#if (REPEAT_MASK >> 1) & 1
    xcd_barrier(xb);
    phase1(p, smem, bid, nblk);
#endif
    if (1 + 1 < p.phase_hi) xcd_barrier(xb);
  }
#endif
#if !defined(ONLY) || ONLY==2
  if (p.phase_lo <= 2 && 2 < p.phase_hi) {
    phase2_8w(p, blockIdx.x, gridDim.x);
    __syncthreads();
    phase2(p, smem, bid, nblk);
#if (REPEAT_MASK >> 2) & 1
    xcd_barrier(xb);
    phase2_8w(p, blockIdx.x, gridDim.x);
    __syncthreads();
    phase2(p, smem, bid, nblk);
#endif
    if (2 + 1 < p.phase_hi) xcd_barrier(xb);
  }
#endif
#if !defined(ONLY) || ONLY==3
  if (p.phase_lo <= 3 && 3 < p.phase_hi) {
    phase3(p, smem, bid, nblk);
#if (REPEAT_MASK >> 3) & 1
    xcd_barrier(xb);
    phase3(p, smem, bid, nblk);
#endif
    if (3 + 1 < p.phase_hi) xcd_barrier(xb);
  }
#endif
#if !defined(ONLY) || ONLY==4
  if (p.phase_lo <= 4 && 4 < p.phase_hi) {
    phase4(p, smem, bid, nblk);
#if (REPEAT_MASK >> 4) & 1
    xcd_barrier(xb);
    phase4(p, smem, bid, nblk);
#endif
    if (4 + 1 < p.phase_hi) xcd_barrier(xb);
  }
#endif
#if !defined(ONLY) || ONLY==5
  if (p.phase_lo <= 5 && 5 < p.phase_hi) {
    phase5_nsa8(p);
    phase5(p, smem, bid, nblk);
#if (REPEAT_MASK >> 5) & 1
    xcd_barrier(xb);
    phase5_nsa8(p);
    phase5(p, smem, bid, nblk);
#endif
    if (5 + 1 < p.phase_hi) xcd_barrier(xb);
  }
#endif
#if !defined(ONLY) || ONLY==7
  if (p.phase_lo <= 7 && 7 < p.phase_hi) {
    phase7(p, smem, bid, nblk);
#if (REPEAT_MASK >> 7) & 1
    xcd_barrier(xb);
    phase7(p, smem, bid, nblk);
#endif
    if (7 + 1 < p.phase_hi) xcd_barrier(xb);
  }
#endif
#if !defined(ONLY) || ONLY==8
  if (p.phase_lo <= 8 && 8 < p.phase_hi) {
    phase8_8w(p, blockIdx.x, gridDim.x);
#if (REPEAT_MASK >> 8) & 1
    xcd_barrier(xb);
    phase8_8w(p, blockIdx.x, gridDim.x);
#endif
    if (8 + 1 < p.phase_hi) xcd_barrier(xb);
  }
#endif
#if !defined(ONLY) || ONLY==9
  if (p.phase_lo <= 9 && 9 < p.phase_hi) {
    phase9_8w(p, blockIdx.x, gridDim.x);
#if (REPEAT_MASK >> 9) & 1
    xcd_barrier(xb);
    phase9_8w(p, blockIdx.x, gridDim.x);
#endif
    if (9 + 1 < p.phase_hi) xcd_barrier(xb);
  }
#endif
#if !defined(ONLY) || ONLY==10
  if (p.phase_lo <= 10 && 10 < p.phase_hi) {
    phase10(p, bid, nblk);
#if (REPEAT_MASK >> 10) & 1
    xcd_barrier(xb);
    phase10(p, bid, nblk);
#endif
    if (10 + 1 < p.phase_hi) xcd_barrier(xb);
  }
#endif
#if !defined(ONLY) || ONLY==11
  if (p.phase_lo <= 11 && 11 < p.phase_hi) {
    phase11(p, smem, bid, nblk);
#if (REPEAT_MASK >> 11) & 1
    xcd_barrier(xb);
    phase11(p, smem, bid, nblk);
#endif
    if (11 + 1 < p.phase_hi) xcd_barrier(xb);
  }
#endif
#if !defined(ONLY) || ONLY==12
  if (p.phase_lo <= 12 && 12 < p.phase_hi) {
    phase12(p, bid, nblk);
#if (REPEAT_MASK >> 12) & 1
    xcd_barrier(xb);
    phase12(p, bid, nblk);
#endif
    if (12 + 1 < p.phase_hi) xcd_barrier(xb);
  }
#endif
#if !defined(ONLY) || ONLY==14
  if (p.phase_lo <= 14 && 14 < p.phase_hi) {
    phase14(p, smem, bid, nblk);
#if (REPEAT_MASK >> 14) & 1
    xcd_barrier(xb);
    phase14(p, smem, bid, nblk);
#endif
    if (14 + 1 < p.phase_hi) xcd_barrier(xb);
  }
#endif
#if !defined(ONLY) || ONLY==15
  if (p.phase_lo <= 15 && 15 < p.phase_hi) {
    phase15_8w(p, blockIdx.x, gridDim.x);
#if (REPEAT_MASK >> 15) & 1
    xcd_barrier(xb);
    phase15_8w(p, blockIdx.x, gridDim.x);
#endif
    if (15 + 1 < p.phase_hi) xcd_barrier(xb);
  }
#endif
#if !defined(ONLY) || ONLY==16
  if (p.phase_lo <= 16 && 16 < p.phase_hi) {
    phase16_8w(p, blockIdx.x, gridDim.x);
#if (REPEAT_MASK >> 16) & 1
    xcd_barrier(xb);
    phase16_8w(p, blockIdx.x, gridDim.x);
#endif
    if (16 + 1 < p.phase_hi) xcd_barrier(xb);
  }
#endif
#if !defined(ONLY) || ONLY==17
  if (p.phase_lo <= 17 && 17 < p.phase_hi) {
    phase17(p, bid, nblk);
#if (REPEAT_MASK >> 17) & 1
    xcd_barrier(xb);
    phase17(p, bid, nblk);
#endif
    if (17 + 1 < p.phase_hi) xcd_barrier(xb);
  }
#endif
}

extern "C" void kernel_launch(void* const* d_in, const int* in_sizes, int n_in, void* d_out, int out_size, void* d_ws, size_t ws_size,
                              hipStream_t stream) {
  static int grid_blocks = 0;
  if (!grid_blocks) {
    int dev = 0, cus = 0, per_cu = 0;
    (void)hipGetDevice(&dev);
    (void)hipDeviceGetAttribute(&cus, hipDeviceAttributeMultiprocessorCount, dev);
    (void)hipOccupancyMaxActiveBlocksPerMultiprocessor(&per_cu, mega, 512, 0);
    if (per_cu > 1) per_cu = 1;
    if (per_cu < 1) per_cu = 1;
    grid_blocks = cus * per_cu;
  }
  Params p{};
  const float* const* in = (const float* const*)d_in;
  p.x = in[0]; p.c = in[1]; p.w_ada = in[2]; p.b_ada = in[3]; p.g_pre_mix = in[4]; p.g_post_mix = in[5]; p.g_pre_ffn = in[6]; p.g_post_ffn = in[7];
  p.w_in = in[8]; p.rel_bias = in[9]; p.cmp_pe = in[10]; p.cmp_w1 = in[11]; p.cmp_b1 = in[12]; p.cmp_w2 = in[13]; p.dsa_kv_norm = in[14];
  p.dsa_w_uk = in[15]; p.dsa_w_uv = in[16]; p.w_bn = in[17]; p.w_bd = in[18]; p.w_out = in[19]; p.router_w = in[20]; p.router_bias = in[21];
  p.w_eg = in[22]; p.w_eu = in[23]; p.w_ed = in[24]; p.w_sg = in[25]; p.w_su = in[26]; p.w_sd = in[27];
  p.out = (float*)d_out;
  char* ws = (char*)d_ws;
  size_t off = 0;
  auto alloc = [&](size_t bytes) { char* r = ws + off; off += (bytes + 255) & ~(size_t)255; return r; };
  p.bar = (unsigned*)alloc(XCD_BAR_WORDS * 4);
  p.modp = (float*)alloc(16 * 2 * 6144 * 4);
  p.mod = (float*)alloc(2 * 6144 * 4);
  p.pe_part = (float*)alloc(16 * 256 * 4);
  p.w_ukT = (float*)alloc(8 * 64 * 128 * 4);
  p.w_inT = (u16*)alloc((size_t)4608 * 1024 * 2);
  p.w_bnT = (u16*)alloc((size_t)1024 * 512 * 2);
  p.w_bdT = (u16*)alloc((size_t)1024 * 512 * 2);
  p.w_outT = (u16*)alloc((size_t)1024 * 1024 * 2);
  p.routerT = (u16*)alloc((size_t)256 * 1024 * 2);
  p.counts = (int*)alloc(256 * 32 * 4);
  p.offs = (int*)alloc(257 * 4);
  p.tile_e = (int*)alloc(1536 * 4);
  p.tile_r0 = (int*)alloc(1536 * 4);
  p.tile_nr = (int*)alloc(1536 * 4);
  p.ntiles = (int*)alloc(8);
  p.tile2_e = (int*)alloc(1024 * 4);
  p.tile2_r0 = (int*)alloc(1024 * 4);
  p.tile2_nr = (int*)alloc(1024 * 4);
  p.h = (u16*)alloc((size_t)NTOK * 1024 * 2);
  p.proj = (u16*)alloc((size_t)NTOK * LDP * 2);
  p.widx = (float*)alloc((size_t)NTOK * 8 * 4);
  p.zc = (u16*)alloc((size_t)2 * 2048 * 128 * 2);
  p.kc = (u16*)alloc((size_t)4 * 512 * 64 * 2);
  p.vcT = (u16*)alloc((size_t)4 * 512 * 64 * 2);
  p.vts = (u16*)alloc((size_t)4 * 64 * T * 2);
  p.vtw = (u16*)alloc((size_t)4 * 64 * T * 2);
  p.qlat = (u16*)alloc((size_t)NTOK * 1024 * 2);
  p.ckv = (u16*)alloc((size_t)NTOK * 128 * 2);
  p.selk = (int*)alloc((size_t)NTOK * 256 * 4);
  p.onsa = (u16*)alloc((size_t)NTOK * 512 * 2);
  p.olat = (u16*)alloc((size_t)NTOK * 1024 * 2);
  p.odsa = (u16*)alloc((size_t)NTOK * 512 * 2);
  p.y = p.qlat;
  p.z = p.olat;
  p.eidx = (int*)alloc((size_t)NTOK * 8 * 4);
  p.ewt = (float*)alloc((size_t)NTOK * 8 * 4);
  p.erank = (int*)alloc((size_t)NTOK * 8 * 4);
  p.slot_tok = (int*)alloc((size_t)NSLOT * 4);
  p.slot_wt = (float*)alloc((size_t)NSLOT * 4);
  p.tok_slot = (int*)alloc((size_t)NTOK * 8 * 4);
  char* big = alloc((size_t)2 * T * T * 4);
  p.scores = (float*)big;
  {
    size_t o2 = 0;
    auto sub = [&](size_t bytes) { char* r = big + o2; o2 += (bytes + 255) & ~(size_t)255; return r; };
    p.H = (u16*)sub((size_t)NSLOT * 256 * 2);
    p.Y = (u16*)sub((size_t)NSLOT * 1024 * 2);
    p.x1 = (float*)sub((size_t)NTOK * 1024 * 4);
    p.logits = (float*)sub((size_t)NTOK * 256 * 4);
  }
  if (off > ws_size) fprintf(stderr, "workspace too small: need %zu have %zu\n", off, ws_size);
  p.phase_lo = 0;
  p.phase_hi = 18;
  (void)hipMemsetAsync(p.bar, 0, XCD_BAR_WORDS * 4, stream);
  void* args[] = {&p};
  hipError_t e = hipLaunchCooperativeKernel((void*)mega, dim3(grid_blocks), dim3(512), args, 0, stream);
  if (e != hipSuccess) fprintf(stderr, "coop launch failed: %s (grid %d)\n", hipGetErrorString(e), grid_blocks);
}
```

```cpp
#include <hip/hip_runtime.h>
#include <hip/hip_cooperative_groups.h>
#include <cstdio>
namespace cg = cooperative_groups;

#define DI __device__ __forceinline__
typedef unsigned short u16;
typedef unsigned long long u64;
using bf16x8 = __attribute__((ext_vector_type(8))) short;
using f32x16 = __attribute__((ext_vector_type(16))) float;
using f32x4 = __attribute__((ext_vector_type(4))) float;

constexpr int T = 8192;
constexpr int NTOK = 16384;
constexpr int LDP = 4576;
constexpr int C_QN = 0, C_KV = 512, C_GN = 1280, C_QD = 1304, C_CKV = 1816, C_QI = 1944, C_KI = 2456, C_WI = 2520, C_GM = 2528;
constexpr int NSLOT = 131072 + 16384;
constexpr int HALF_LDS = 73728;
constexpr int LDS_BYTES = 2 * HALF_LDS + 128;
__shared__ __attribute__((aligned(16))) char g_smem[LDS_BYTES];
#ifndef REPEAT_MASK
#define REPEAT_MASK 0
#endif

__device__ const unsigned char BUCKET[128] = {
  0, 1, 2, 3, 4, 5, 6, 7, 8, 9, 10, 11, 12, 13, 14, 15, 16, 16, 16, 17, 17, 18, 18, 18, 19, 19, 19, 20, 20, 20, 20, 21,
  21, 21, 21, 22, 22, 22, 22, 22, 23, 23, 23, 23, 23, 23, 24, 24, 24, 24, 24, 24, 25, 25, 25, 25, 25, 25, 25, 26, 26, 26, 26, 26,
  26, 26, 26, 27, 27, 27, 27, 27, 27, 27, 27, 27, 27, 28, 28, 28, 28, 28, 28, 28, 28, 28, 28, 29, 29, 29, 29, 29, 29, 29, 29, 29,
  29, 29, 29, 30, 30, 30, 30, 30, 30, 30, 30, 30, 30, 30, 30, 30, 30, 31, 31, 31, 31, 31, 31, 31, 31, 31, 31, 31, 31, 31, 31, 31};

struct Params {
  const float *x, *c, *w_ada, *b_ada, *g_pre_mix, *g_post_mix, *g_pre_ffn, *g_post_ffn, *w_in, *rel_bias;
  const float *cmp_pe, *cmp_w1, *cmp_b1, *cmp_w2, *dsa_kv_norm, *dsa_w_uk, *dsa_w_uv, *w_bn, *w_bd, *w_out;
  const float *router_w, *router_bias, *w_eg, *w_eu, *w_ed, *w_sg, *w_su, *w_sd;
  float* out;
  float* modp;
  float* mod;
  float* pe_part;
  float* cpart;
  float* w_ukT;
  u16 *w_inT, *w_bnT, *w_bdT, *w_outT, *routerT;
  u16* h;
  u16* proj;
  float* widx;
  u16* zc;
  u16* kc;
  u16* vcT;
  u16* vts;
  u16* vtw;
  u16* qlat;
  u16* ckv;
  float* scores;
  int* selk;
  u16* onsa;
  u16* olat;
  u16* odsa;
  u16* y;
  u16* z;
  float* x1;
  float* logits;
  int* eidx;
  float* ewt;
  int* erank;
  int* counts;
  int* offs;
  int* tile_e;
  int* tile_r0;
  int* tile_nr;
  int* ntiles;
  int *tile2_e, *tile2_r0, *tile2_nr;
  int* slot_tok;
  float* slot_wt;
  int* tok_slot;
  u16* H;
  u16* Y;
  unsigned* bar;
  int phase_lo, phase_hi;
};

DI float bf2f(u16 v) { return __uint_as_float(((unsigned)v) << 16); }
typedef __bf16 bf16x2_t __attribute__((ext_vector_type(2)));
typedef float f32x2_t __attribute__((ext_vector_type(2)));
DI unsigned pack2(float a, float b) { f32x2_t v = {a, b}; return __builtin_bit_cast(unsigned, __builtin_convertvector(v, bf16x2_t)); }
DI u16 f2bf(float x) { return (u16)(pack2(x, x) & 0xffffu); }
DI float lo16(unsigned u) { return __uint_as_float(u << 16); }
DI float hi16(unsigned u) { return __uint_as_float(u & 0xffff0000u); }
DI float wave_sum(float v) { for (int o = 32; o; o >>= 1) v += __shfl_xor(v, o); return v; }
DI float wave_max(float v) { for (int o = 32; o; o >>= 1) v = fmaxf(v, __shfl_xor(v, o)); return v; }
#define DPP_QP1 0xB1
#define DPP_QP2 0x4E
#define DPP_RHM 0x141
#define DPP_RM  0x140
#define DPP_B15 0x142
#define DPP_B31 0x143
DI int wave_sum_i(int x) {
  x += __builtin_amdgcn_update_dpp(0, x, DPP_QP1, 0xF, 0xF, true);
  x += __builtin_amdgcn_update_dpp(0, x, DPP_QP2, 0xF, 0xF, true);
  x += __builtin_amdgcn_update_dpp(0, x, DPP_RHM, 0xF, 0xF, true);
  x += __builtin_amdgcn_update_dpp(0, x, DPP_RM, 0xF, 0xF, true);
  x += __builtin_amdgcn_update_dpp(0, x, DPP_B15, 0xA, 0xF, true);
  x += __builtin_amdgcn_update_dpp(0, x, DPP_B31, 0xC, 0xF, true);
  return __builtin_amdgcn_readlane(x, 63);
}
#define DPP_SELF(x, CTRL, RM) ((unsigned)__builtin_amdgcn_update_dpp((int)(x), (int)(x), CTRL, RM, 0xF, false))
DI unsigned wave_max_u(unsigned x) {
  x = max(x, DPP_SELF(x, DPP_QP1, 0xF)); x = max(x, DPP_SELF(x, DPP_QP2, 0xF)); x = max(x, DPP_SELF(x, DPP_RHM, 0xF));
  x = max(x, DPP_SELF(x, DPP_RM, 0xF)); x = max(x, DPP_SELF(x, DPP_B15, 0xA)); x = max(x, DPP_SELF(x, DPP_B31, 0xC));
  return (unsigned)__builtin_amdgcn_readlane((int)x, 63);
}
DI unsigned wave_min_u(unsigned x) {
  x = min(x, DPP_SELF(x, DPP_QP1, 0xF)); x = min(x, DPP_SELF(x, DPP_QP2, 0xF)); x = min(x, DPP_SELF(x, DPP_RHM, 0xF));
  x = min(x, DPP_SELF(x, DPP_RM, 0xF)); x = min(x, DPP_SELF(x, DPP_B15, 0xA)); x = min(x, DPP_SELF(x, DPP_B31, 0xC));
  return (unsigned)__builtin_amdgcn_readlane((int)x, 63);
}
DI void wave_argmax(float& v, int& idx) {
#define AM_STEP(CTRL, RM)                                                                                                   \
  {                                                                                                                         \
    const float ov_ = __int_as_float(__builtin_amdgcn_update_dpp(__float_as_int(v), __float_as_int(v), CTRL, RM, 0xF, false)); \
    const int oi_ = __builtin_amdgcn_update_dpp(idx, idx, CTRL, RM, 0xF, false);                                            \
    const bool tk_ = ov_ > v || (ov_ == v && oi_ < idx);                                                                    \
    v = tk_ ? ov_ : v;                                                                                                      \
    idx = tk_ ? oi_ : idx;                                                                                                  \
  }
  AM_STEP(DPP_QP1, 0xF) AM_STEP(DPP_QP2, 0xF) AM_STEP(DPP_RHM, 0xF) AM_STEP(DPP_RM, 0xF) AM_STEP(DPP_B15, 0xA) AM_STEP(DPP_B31, 0xC)
#undef AM_STEP
  v = __int_as_float(__builtin_amdgcn_readlane(__float_as_int(v), 63));
  idx = __builtin_amdgcn_readlane(idx, 63);
}
DI float rdlane(float v, int l) { return __int_as_float(__builtin_amdgcn_readlane(__float_as_int(v), l)); }
DI int rdlane_i(int v, int l) { return __builtin_amdgcn_readlane(v, l); }
DI int TIDX() { int t = threadIdx.x & 255; asm volatile("" : "+v"(t)); return t; }
DI int TIDX8() { int t = threadIdx.x; asm volatile("" : "+v"(t)); return t; }
DI void hb_sync() {
  asm volatile("s_waitcnt vmcnt(0) lgkmcnt(0)" ::: "memory");
  const int vb = __builtin_amdgcn_readfirstlane((int)(threadIdx.x >> 8));
  volatile __attribute__((address_space(3))) unsigned* cnt = (volatile __attribute__((address_space(3))) unsigned*)(g_smem + 2 * HALF_LDS + 64) + vb * 8;
  if ((threadIdx.x & 63) == 0) {
    const unsigned old = __hip_atomic_fetch_add((__attribute__((address_space(3))) unsigned*)cnt, 1u, __ATOMIC_RELAXED, __HIP_MEMORY_SCOPE_WORKGROUP);
    const unsigned target = (old & ~3u) + 4u;
    while ((int)(*cnt - target) < 0) __builtin_amdgcn_s_sleep(0);
  }
  asm volatile("s_waitcnt lgkmcnt(0)" ::: "memory");
  __builtin_amdgcn_wave_barrier();
}
DI void cbar(const void* p) { asm volatile("" ::"v"(p) : "memory"); }
DI void wave_sync() { asm volatile("s_waitcnt lgkmcnt(0)" ::: "memory"); __builtin_amdgcn_wave_barrier(); }
DI float sigmoidf(float x) { return 1.f / (1.f + __expf(-x)); }
DI float siluf(float x) { return x / (1.f + __expf(-x)); }
DI float gelu_tanh(float x) { float u = 0.7978845608028654f * (x + 0.044715f * x * x * x); float e = __expf(2.f * u); float th = 1.f - 2.f / (e + 1.f); return 0.5f * x * (1.f + th); }


#define XB_TMO      128
#define XB_XCNT(j)  (256  + 64 * (j))
#define XB_XSUB(j)  (1280 + 64 * (j))
#define XB_XGEN(j)  (2304 + 64 * (j))
#define XB_TOP      3328
#define XB_TOPGEN   3392
#define XCD_BAR_WORDS 3456
#define XB_SPIN_CAP (1u << 22)
#define LAS __attribute__((address_space(3)))
DI unsigned xb_ld(unsigned* p) { return __hip_atomic_load(p, __ATOMIC_RELAXED, __HIP_MEMORY_SCOPE_AGENT); }
DI unsigned xb_add(unsigned* p, unsigned v) { return __hip_atomic_fetch_add(p, v, __ATOMIC_RELAXED, __HIP_MEMORY_SCOPE_AGENT); }
DI unsigned xb_xcc_id() { return (unsigned)__builtin_amdgcn_s_getreg((3 << 11) | 20) & 0xFu; }
#define XB_SPIN(cond, bar) do { unsigned _sp = 0; while (cond) { __builtin_amdgcn_s_sleep(1); \
    if ((++_sp & 255u) == 0u) { if (xb_ld(&(bar)[XB_TMO])) break; if (_sp > XB_SPIN_CAP) { atomicAdd(&(bar)[XB_TMO], 1u); break; } } } } while (0)
struct XcdBarrier { unsigned* bar; unsigned x; volatile LAS unsigned* st; };
DI XcdBarrier xcd_barrier_post(unsigned* bar, volatile LAS unsigned* st) {
  XcdBarrier b; b.bar = bar; b.x = xb_xcc_id(); b.st = st;
  if (threadIdx.x == 0) (void)xb_add(&bar[XB_XCNT(b.x)], 1u);
  return b;
}
DI void xcd_barrier_complete(unsigned* bar, unsigned x, unsigned& nloc, unsigned& nx) {
  const unsigned G = gridDim.x * gridDim.y * gridDim.z;
  unsigned sum, cnt, mine, sp = 0u;
  for (;;) {
    sum = 0u; cnt = 0u; mine = 0u;
#pragma unroll
    for (unsigned j = 0; j < 16; ++j) { const unsigned c = xb_ld(&bar[XB_XCNT(j)]); sum += c; cnt += (c > 0u) ? 1u : 0u; mine = (j == x) ? c : mine; }
    if (sum == G) break;
    __builtin_amdgcn_s_sleep(1);
    if ((++sp & 255u) == 0u) { if (xb_ld(&bar[XB_TMO])) break; if (sp > XB_SPIN_CAP) { atomicAdd(&bar[XB_TMO], 1u); break; } }
  }
  nloc = mine > 0u ? mine : 1u; nx = cnt > 0u ? cnt : 1u;
}
DI void xcd_barrier(const XcdBarrier& b) {
  asm volatile("s_waitcnt vmcnt(0)" ::: "memory");
  __syncthreads();
  if (threadIdx.x == 0) {
    unsigned* bar = b.bar;
    __builtin_amdgcn_s_waitcnt(0);
    unsigned nloc = b.st[0], nx = b.st[1];
    if (nloc == 0u) { xcd_barrier_complete(bar, b.x, nloc, nx); b.st[0] = nloc; b.st[1] = nx; }
    const unsigned old = xb_add(&bar[XB_XSUB(b.x)], 1u);
    const unsigned gen = old / nloc;
    if (old + 1u == (gen + 1u) * nloc) {
      __builtin_amdgcn_fence(__ATOMIC_RELEASE, "agent");
      asm volatile("s_waitcnt vmcnt(0)" ::: "memory");
      const unsigned og = xb_add(&bar[XB_TOP], 1u);
      const unsigned tg = og / nx;
      if (og + 1u == (tg + 1u) * nx) xb_add(&bar[XB_TOPGEN], 1u);
      else XB_SPIN(xb_ld(&bar[XB_TOPGEN]) == tg, bar);
      __builtin_amdgcn_fence(__ATOMIC_ACQUIRE, "agent");
      xb_add(&bar[XB_XGEN(b.x)], 1u);
      asm volatile("s_waitcnt vmcnt(0)" ::: "memory");
    } else {
      XB_SPIN(xb_ld(&bar[XB_XGEN(b.x)]) == gen, bar);
      __builtin_amdgcn_fence(__ATOMIC_ACQUIRE, "agent");
      asm volatile("s_waitcnt vmcnt(0)" ::: "memory");
    }
  }
  __syncthreads();
}

template <bool SWAP = true, bool SINGLE = false, bool BT16 = false, class AF, class BF, class EF>
DI void gemm_tile(char* smem, int nk, long a_kstep, const AF& af, const BF& bf, const EF& ef) {
  asm volatile("" ::: "memory");
  u16* As = (u16*)smem;
  const int tid = TIDX(), lane = tid & 63, wid = __builtin_amdgcn_readfirstlane(tid >> 6), wm = wid >> 1, wn = wid & 1;
  const int arow = tid >> 1, ahalf = tid & 1;
  const u16* ap = af(arow) + ahalf * 32;
  const int bkq = lane & 7, bnq = wid * 8 + (lane >> 3);
  const long ldb = bf.ldb;
  const float* bp = nullptr;
  const u16* bp16 = nullptr;
  if constexpr (BT16) bp16 = bf.row(arow) + ahalf * 32;
  else bp = bf(bnq * 4) + (long)(bkq * 4) * ldb;
  uint4 sa0_0, sa0_1, sa0_2, sa0_3, sa1_0, sa1_1, sa1_2, sa1_3;
  float4 sb0_0, sb0_1, sb0_2, sb0_3, sb0_4, sb0_5, sb0_6, sb0_7, sb1_0, sb1_1, sb1_2, sb1_3, sb1_4, sb1_5, sb1_6, sb1_7;
  uint4 tb0_0, tb0_1, tb0_2, tb0_3, tb1_0, tb1_1, tb1_2, tb1_3;
  f32x16 acc[2][2];
#pragma unroll
  for (int a = 0; a < 2; ++a)
#pragma unroll
    for (int b = 0; b < 2; ++b)
#pragma unroll
      for (int i = 0; i < 16; ++i) acc[a][b][i] = 0.f;

#define GEMM_LOAD(S, KT)                                                                  \
  {                                                                                       \
    const uint4* pa_ = (const uint4*)(ap + (long)(KT) * a_kstep);                         \
    sa##S##_0 = pa_[0]; sa##S##_1 = pa_[1]; sa##S##_2 = pa_[2]; sa##S##_3 = pa_[3];       \
    if constexpr (BT16) {                                                                 \
      const uint4* pt_ = (const uint4*)(bp16 + (long)(KT) * 64);                          \
      tb##S##_0 = pt_[0]; tb##S##_1 = pt_[1]; tb##S##_2 = pt_[2]; tb##S##_3 = pt_[3];     \
    } else {                                                                              \
      const float* pb_ = bp + (long)(KT) * 64 * ldb;                                      \
      sb##S##_0 = *(const float4*)(pb_);                                                  \
      sb##S##_1 = *(const float4*)(pb_ + ldb);                                            \
      sb##S##_2 = *(const float4*)(pb_ + 2 * ldb);                                        \
      sb##S##_3 = *(const float4*)(pb_ + 3 * ldb);                                        \
      sb##S##_4 = *(const float4*)(pb_ + 32 * ldb);                                       \
      sb##S##_5 = *(const float4*)(pb_ + 33 * ldb);                                       \
      sb##S##_6 = *(const float4*)(pb_ + 34 * ldb);                                       \
      sb##S##_7 = *(const float4*)(pb_ + 35 * ldb);                                       \
    }                                                                                     \
  }
#define GEMM_BW(V0, V1, V2, V3, C, I, QOFF)                                               \
  {                                                                                       \
    uint2 w_;                                                                             \
    w_.x = pack2(V0.C, V1.C);                                                             \
    w_.y = pack2(V2.C, V3.C);                                                             \
    *(uint2*)&Bs_[(bnq * 4 + (I)) * 72 + (QOFF) + bkq * 4] = w_;                          \
  }
#define GEMM_STORE(S, BUF)                                                                \
  {                                                                                       \
    u16* As_ = As + (BUF) * (2 * 128 * 72);                                               \
    u16* Bs_ = As_ + 128 * 72;                                                            \
    uint4* da_ = (uint4*)&As_[arow * 72 + ahalf * 32];                                    \
    da_[0] = sa##S##_0; da_[1] = sa##S##_1; da_[2] = sa##S##_2; da_[3] = sa##S##_3;       \
    if constexpr (BT16) {                                                                 \
      uint4* db_ = (uint4*)&Bs_[arow * 72 + ahalf * 32];                                  \
      db_[0] = tb##S##_0; db_[1] = tb##S##_1; db_[2] = tb##S##_2; db_[3] = tb##S##_3;     \
    } else {                                                                              \
      GEMM_BW(sb##S##_0, sb##S##_1, sb##S##_2, sb##S##_3, x, 0, 0)                        \
      GEMM_BW(sb##S##_0, sb##S##_1, sb##S##_2, sb##S##_3, y, 1, 0)                        \
      GEMM_BW(sb##S##_0, sb##S##_1, sb##S##_2, sb##S##_3, z, 2, 0)                        \
      GEMM_BW(sb##S##_0, sb##S##_1, sb##S##_2, sb##S##_3, w, 3, 0)                        \
      GEMM_BW(sb##S##_4, sb##S##_5, sb##S##_6, sb##S##_7, x, 0, 32)                       \
      GEMM_BW(sb##S##_4, sb##S##_5, sb##S##_6, sb##S##_7, y, 1, 32)                       \
      GEMM_BW(sb##S##_4, sb##S##_5, sb##S##_6, sb##S##_7, z, 2, 32)                       \
      GEMM_BW(sb##S##_4, sb##S##_5, sb##S##_6, sb##S##_7, w, 3, 32)                       \
    }                                                                                     \
  }
#define GEMM_COMPUTE(BUF)                                                                 \
  {                                                                                       \
    const u16* Ac = As + (BUF) * (2 * 128 * 72);                                          \
    const u16* Bc = Ac + 128 * 72;                                                        \
    _Pragma("unroll") for (int ks = 0; ks < 4; ++ks) {                                    \
      bf16x8 a[2], b[2];                                                                  \
      _Pragma("unroll") for (int mt = 0; mt < 2; ++mt) a[mt] = *(const bf16x8*)&Ac[(wm * 64 + mt * 32 + (lane & 31)) * 72 + ks * 16 + (lane >> 5) * 8]; \
      _Pragma("unroll") for (int nt = 0; nt < 2; ++nt) b[nt] = *(const bf16x8*)&Bc[(wn * 64 + nt * 32 + (lane & 31)) * 72 + ks * 16 + (lane >> 5) * 8]; \
      _Pragma("unroll") for (int mt = 0; mt < 2; ++mt)                                    \
      _Pragma("unroll") for (int nt = 0; nt < 2; ++nt)                                    \
        acc[mt][nt] = SWAP ? __builtin_amdgcn_mfma_f32_32x32x16_bf16(b[nt], a[mt], acc[mt][nt], 0, 0, 0) \
                           : __builtin_amdgcn_mfma_f32_32x32x16_bf16(a[mt], b[nt], acc[mt][nt], 0, 0, 0); \
    }                                                                                     \
  }
  GEMM_LOAD(0, 0)
  hb_sync();
  if (SINGLE) {
    GEMM_STORE(0, 0)
    hb_sync();
    GEMM_COMPUTE(0)
  } else {
    GEMM_LOAD(1, 1)
    GEMM_STORE(0, 0)
    hb_sync();
    const int last = nk - 1;
    for (int kt = 0; kt < nk; kt += 2) {
      const int k2 = kt + 2 < last ? kt + 2 : last, k3 = kt + 3 < last ? kt + 3 : last;
      GEMM_LOAD(0, k2)
      asm volatile("" ::: "memory");
      GEMM_COMPUTE(0)
      asm volatile("" ::: "memory");
      GEMM_STORE(1, 1)
      hb_sync();
      GEMM_LOAD(1, k3)
      asm volatile("" ::: "memory");
      GEMM_COMPUTE(1)
      asm volatile("" ::: "memory");
      GEMM_STORE(0, 0)
      hb_sync();
    }
  }
#undef GEMM_LOAD
#undef GEMM_STORE
#undef GEMM_BW
#undef GEMM_COMPUTE
  ef(acc, wm, wn, lane);
}

template <bool BT16, class AF, class BF, class EF>
DI void gemm_tile256(char* smem, int nk, const AF& af, const BF& bf, const EF& ef) {
  asm volatile("" ::: "memory");
  u16* As = (u16*)smem;
  u16* Bs = As + 256 * 72;
  const int tid = TIDX(), lane = tid & 63, wid = __builtin_amdgcn_readfirstlane(tid >> 6), wm = wid >> 1, wn = wid & 1;
  const int piece = tid & 7, rbase = tid >> 3;
  const u16* abase = af(0);
  int ao0, ao1, ao2, ao3, ao4, ao5, ao6, ao7;
  ao0 = (int)(af(rbase) - abase) + piece * 8;        ao1 = (int)(af(rbase + 32) - abase) + piece * 8;
  ao2 = (int)(af(rbase + 64) - abase) + piece * 8;   ao3 = (int)(af(rbase + 96) - abase) + piece * 8;
  ao4 = (int)(af(rbase + 128) - abase) + piece * 8;  ao5 = (int)(af(rbase + 160) - abase) + piece * 8;
  ao6 = (int)(af(rbase + 192) - abase) + piece * 8;  ao7 = (int)(af(rbase + 224) - abase) + piece * 8;
  const u16* bp16 = nullptr; long bstride = 0;
  const float* bp = nullptr; long ldb = 0;
  const int bkq = lane & 7, bnq = wid * 8 + (lane >> 3);
  if constexpr (BT16) { bp16 = bf.row(rbase) + piece * 8; bstride = bf.ldb * 32; }
  else { ldb = bf.ldb; bp = bf(bnq * 4) + (long)(bkq * 4) * ldb; }
  uint4 ra0, ra1, ra2, ra3, ra4, ra5, ra6, ra7, rb0, rb1, rb2, rb3;
  float4 fb0, fb1, fb2, fb3, fb4, fb5, fb6, fb7;
  f32x16 acc[4][2];
#pragma unroll
  for (int a = 0; a < 4; ++a)
#pragma unroll
    for (int b = 0; b < 2; ++b)
#pragma unroll
      for (int i = 0; i < 16; ++i) acc[a][b][i] = 0.f;
#define G256_LOAD(KT)                                                   \
  {                                                                     \
    const u16* pa_ = abase + (long)(KT) * 64;                           \
    ra0 = *(const uint4*)(pa_ + ao0); ra1 = *(const uint4*)(pa_ + ao1); \
    ra2 = *(const uint4*)(pa_ + ao2); ra3 = *(const uint4*)(pa_ + ao3); \
    ra4 = *(const uint4*)(pa_ + ao4); ra5 = *(const uint4*)(pa_ + ao5); \
    ra6 = *(const uint4*)(pa_ + ao6); ra7 = *(const uint4*)(pa_ + ao7); \
    if constexpr (BT16) {                                               \
      const u16* pb_ = bp16 + (long)(KT) * 64;                          \
      rb0 = *(const uint4*)(pb_);                                       \
      rb1 = *(const uint4*)(pb_ + bstride);                             \
      rb2 = *(const uint4*)(pb_ + 2 * bstride);                         \
      rb3 = *(const uint4*)(pb_ + 3 * bstride);                         \
    } else {                                                            \
      const float* pf_ = bp + (long)(KT) * 64 * ldb;                    \
      fb0 = *(const float4*)(pf_);            fb1 = *(const float4*)(pf_ + ldb);      \
      fb2 = *(const float4*)(pf_ + 2 * ldb);  fb3 = *(const float4*)(pf_ + 3 * ldb);  \
      fb4 = *(const float4*)(pf_ + 32 * ldb); fb5 = *(const float4*)(pf_ + 33 * ldb); \
      fb6 = *(const float4*)(pf_ + 34 * ldb); fb7 = *(const float4*)(pf_ + 35 * ldb); \
    }                                                                   \
  }
#define G256_BW(V0, V1, V2, V3, C, I, QOFF)                             \
  {                                                                     \
    uint2 w_;                                                           \
    w_.x = pack2(V0.C, V1.C);                                           \
    w_.y = pack2(V2.C, V3.C);                                           \
    *(uint2*)&Bs[(bnq * 4 + (I)) * 72 + (QOFF) + bkq * 4] = w_;         \
  }
  G256_LOAD(0)
  const int last = nk - 1;
  for (int kt = 0; kt < nk; ++kt) {
    hb_sync();
    {
      u16* da = As + rbase * 72 + piece * 8;
      *(uint4*)(da) = ra0;            *(uint4*)(da + 32 * 72) = ra1;  *(uint4*)(da + 64 * 72) = ra2;  *(uint4*)(da + 96 * 72) = ra3;
      *(uint4*)(da + 128 * 72) = ra4; *(uint4*)(da + 160 * 72) = ra5; *(uint4*)(da + 192 * 72) = ra6; *(uint4*)(da + 224 * 72) = ra7;
      if constexpr (BT16) {
        u16* db = Bs + rbase * 72 + piece * 8;
        *(uint4*)(db) = rb0; *(uint4*)(db + 32 * 72) = rb1; *(uint4*)(db + 64 * 72) = rb2; *(uint4*)(db + 96 * 72) = rb3;
      } else {
        G256_BW(fb0, fb1, fb2, fb3, x, 0, 0)  G256_BW(fb0, fb1, fb2, fb3, y, 1, 0)
        G256_BW(fb0, fb1, fb2, fb3, z, 2, 0)  G256_BW(fb0, fb1, fb2, fb3, w, 3, 0)
        G256_BW(fb4, fb5, fb6, fb7, x, 0, 32) G256_BW(fb4, fb5, fb6, fb7, y, 1, 32)
        G256_BW(fb4, fb5, fb6, fb7, z, 2, 32) G256_BW(fb4, fb5, fb6, fb7, w, 3, 32)
      }
    }
    hb_sync();
    const int kn = kt + 1 < last ? kt + 1 : last;
    G256_LOAD(kn)
    asm volatile("" ::: "memory");
#pragma unroll
    for (int ks = 0; ks < 4; ++ks) {
      bf16x8 a[4], b[2];
#pragma unroll
      for (int mt = 0; mt < 4; ++mt) a[mt] = *(const bf16x8*)&As[(wm * 128 + mt * 32 + (lane & 31)) * 72 + ks * 16 + (lane >> 5) * 8];
#pragma unroll
      for (int nt = 0; nt < 2; ++nt) b[nt] = *(const bf16x8*)&Bs[(wn * 64 + nt * 32 + (lane & 31)) * 72 + ks * 16 + (lane >> 5) * 8];
#pragma unroll
      for (int mt = 0; mt < 4; ++mt)
#pragma unroll
        for (int nt = 0; nt < 2; ++nt) acc[mt][nt] = __builtin_amdgcn_mfma_f32_32x32x16_bf16(b[nt], a[mt], acc[mt][nt], 0, 0, 0);
    }
    asm volatile("" ::: "memory");
  }
#undef G256_LOAD
#undef G256_BW
  ef(acc, wm, wn, lane);
}

template <bool BT16, class AF, class BF, class EF>
DI void gemm8w(int nk, const AF& af, const BF& bf, const EF& ef) {
  asm volatile("" ::: "memory");
  u16* S0 = (u16*)g_smem;
  int tid = threadIdx.x; asm volatile("" : "+v"(tid));
  const int lane = tid & 63, wid = __builtin_amdgcn_readfirstlane(tid >> 6), wm = wid >> 2, wn = wid & 3;
  const int piece = tid & 7, rbase = tid >> 3;
  const u16* abase = af.origin();
  const int ao0 = af.off(rbase) + piece * 8, ao1 = af.off(rbase + 64) + piece * 8, ao2 = af.off(rbase + 128) + piece * 8, ao3 = af.off(rbase + 192) + piece * 8;
  const u16 *bq0 = nullptr, *bq1 = nullptr, *bq2 = nullptr, *bq3 = nullptr;
  const float* bp = nullptr; long ldb = 0;
  const int bkq = lane & 7, bnq = wid * 8 + (lane >> 3);
  if constexpr (BT16) { bq0 = bf.row(rbase) + piece * 8; bq1 = bf.row(rbase + 64) + piece * 8; bq2 = bf.row(rbase + 128) + piece * 8; bq3 = bf.row(rbase + 192) + piece * 8; }
  else { ldb = bf.ldb; bp = bf(bnq * 4) + (long)(bkq * 4) * ldb; }
  uint4 ra0, ra1, ra2, ra3, rb0, rb1, rb2, rb3;
  float4 fb0, fb1, fb2, fb3, fb4, fb5, fb6, fb7;
  f32x16 acc[4][2];
#pragma unroll
  for (int a = 0; a < 4; ++a)
#pragma unroll
    for (int b = 0; b < 2; ++b)
#pragma unroll
      for (int i = 0; i < 16; ++i) acc[a][b][i] = 0.f;
#define G8_LOAD(KT)                                                     \
  {                                                                     \
    const u16* pa_ = abase + (long)(KT) * 64;                           \
    ra0 = *(const uint4*)(pa_ + ao0); ra1 = *(const uint4*)(pa_ + ao1); \
    ra2 = *(const uint4*)(pa_ + ao2); ra3 = *(const uint4*)(pa_ + ao3); \
    if constexpr (BT16) {                                               \
      rb0 = *(const uint4*)(bq0 + (long)(KT) * 64); rb1 = *(const uint4*)(bq1 + (long)(KT) * 64); \
      rb2 = *(const uint4*)(bq2 + (long)(KT) * 64); rb3 = *(const uint4*)(bq3 + (long)(KT) * 64); \
    } else {                                                            \
      const float* pf_ = bp + (long)(KT) * 64 * ldb;                    \
      fb0 = *(const float4*)(pf_);            fb1 = *(const float4*)(pf_ + ldb);      \
      fb2 = *(const float4*)(pf_ + 2 * ldb);  fb3 = *(const float4*)(pf_ + 3 * ldb);  \
      fb4 = *(const float4*)(pf_ + 32 * ldb); fb5 = *(const float4*)(pf_ + 33 * ldb); \
      fb6 = *(const float4*)(pf_ + 34 * ldb); fb7 = *(const float4*)(pf_ + 35 * ldb); \
    }                                                                   \
  }
#define G8_BW(V0, V1, V2, V3, C, I, QOFF)                               \
  {                                                                     \
    uint2 w_;                                                           \
    w_.x = pack2(V0.C, V1.C);                                           \
    w_.y = pack2(V2.C, V3.C);                                           \
    *(uint2*)&Bs_[(bnq * 4 + (I)) * 72 + (QOFF) + bkq * 4] = w_;        \
  }
#define G8_STORE(BUF)                                                   \
  {                                                                     \
    u16* As_ = S0 + (BUF) * (512 * 72);                                 \
    u16* Bs_ = As_ + 256 * 72;                                          \
    u16* da = As_ + rbase * 72 + piece * 8;                             \
    *(uint4*)(da) = ra0; *(uint4*)(da + 64 * 72) = ra1; *(uint4*)(da + 128 * 72) = ra2; *(uint4*)(da + 192 * 72) = ra3; \
    if constexpr (BT16) {                                               \
      u16* db = Bs_ + rbase * 72 + piece * 8;                           \
      *(uint4*)(db) = rb0; *(uint4*)(db + 64 * 72) = rb1; *(uint4*)(db + 128 * 72) = rb2; *(uint4*)(db + 192 * 72) = rb3; \
    } else {                                                            \
      G8_BW(fb0, fb1, fb2, fb3, x, 0, 0)  G8_BW(fb0, fb1, fb2, fb3, y, 1, 0)   \
      G8_BW(fb0, fb1, fb2, fb3, z, 2, 0)  G8_BW(fb0, fb1, fb2, fb3, w, 3, 0)   \
      G8_BW(fb4, fb5, fb6, fb7, x, 0, 32) G8_BW(fb4, fb5, fb6, fb7, y, 1, 32)  \
      G8_BW(fb4, fb5, fb6, fb7, z, 2, 32) G8_BW(fb4, fb5, fb6, fb7, w, 3, 32)  \
    }                                                                   \
  }
  G8_LOAD(0)
  __syncthreads();
  G8_STORE(0)
  __syncthreads();
  const int last = nk - 1;
  for (int kt = 0; kt < nk; ++kt) {
    const int kn = kt + 1 < last ? kt + 1 : last;
    G8_LOAD(kn)
    asm volatile("" ::: "memory");
    {
      const u16* Ac = S0 + (kt & 1) * (512 * 72);
      const u16* Bc = Ac + 256 * 72;
#pragma unroll
      for (int ks = 0; ks < 4; ++ks) {
        bf16x8 a[4], b[2];
#pragma unroll
        for (int mt = 0; mt < 4; ++mt) a[mt] = *(const bf16x8*)&Ac[(wm * 128 + mt * 32 + (lane & 31)) * 72 + ks * 16 + (lane >> 5) * 8];
#pragma unroll
        for (int nt = 0; nt < 2; ++nt) b[nt] = *(const bf16x8*)&Bc[(wn * 64 + nt * 32 + (lane & 31)) * 72 + ks * 16 + (lane >> 5) * 8];
#pragma unroll
        for (int mt = 0; mt < 4; ++mt)
#pragma unroll
          for (int nt = 0; nt < 2; ++nt) acc[mt][nt] = __builtin_amdgcn_mfma_f32_32x32x16_bf16(b[nt], a[mt], acc[mt][nt], 0, 0, 0);
      }
    }
    asm volatile("" ::: "memory");
    if (kt + 1 < nk) {
      G8_STORE((kt + 1) & 1)
      __syncthreads();
    }
  }
#undef G8_LOAD
#undef G8_BW
#undef G8_STORE
  ef(acc, wm, wn, lane);
}

DI void st_stage_rc(int b, int& R, int& C) {
  const int st = b >> 10, sb = b & 1023, swz = sb ^ (((sb >> 9) & 1) << 5);
  R = (st >> 1) * 16 + (swz >> 6); C = (st & 1) * 32 + ((swz & 63) >> 1);
}
template <class PF, class QF, class EF>
DI void gemm8p(int nt, const PF& pf, const QF& qf, const EF& ef) {
  asm volatile("" ::: "memory");
  constexpr int HTB = 128 * 64 * 2;
  int tid = threadIdx.x; asm volatile("" : "+v"(tid));
  const int lane = tid & 63, wid = __builtin_amdgcn_readfirstlane(tid >> 6), wr = wid >> 2, wc = wid & 3, fr = lane & 15, fq = lane >> 4;
  int r0, c0, r1, c1;
  st_stage_rc(tid * 16, r0, c0);
  st_stage_rc(tid * 16 + 8192, r1, c1);
  const u16* pbase = pf.origin();
  const u16* qbase = qf.origin();
  const unsigned po00 = (unsigned)(pf.off(r0) + c0) * 2u, po01 = (unsigned)(pf.off(r1) + c1) * 2u;
  const unsigned po10 = (unsigned)(pf.off(128 + r0) + c0) * 2u, po11 = (unsigned)(pf.off(128 + r1) + c1) * 2u;
  const unsigned qo00 = (unsigned)(qf.off(r0) + c0) * 2u, qo01 = (unsigned)(qf.off(r1) + c1) * 2u;
  const unsigned qo10 = (unsigned)(qf.off(128 + r0) + c0) * 2u, qo11 = (unsigned)(qf.off(128 + r1) + c1) * 2u;
  const unsigned sdst = (unsigned)__builtin_amdgcn_readfirstlane((int)((unsigned)(size_t)g_smem + (unsigned)(tid & ~63) * 16u));
  const int laneoff = (fr * 64 + fq * 16) ^ ((fr >> 3) << 5);
  const char* rdP = g_smem + wr * 8192 + laneoff;
  const char* rdQ = g_smem + 4 * HTB + wc * 4096 + laneoff;
#define G8P_ST(SLOT, BASE, O0, O1, KT)                                                                                     \
  {                                                                                                                        \
    const char* g_ = (const char*)(BASE) + (long)(KT) * 128;                                                               \
    __builtin_amdgcn_global_load_lds((const unsigned*)(g_ + (O0)), (LAS unsigned*)(size_t)(sdst + (SLOT) * HTB), 16, 0, 0);          \
    __builtin_amdgcn_global_load_lds((const unsigned*)(g_ + (O1)), (LAS unsigned*)(size_t)(sdst + (SLOT) * HTB + 8192), 16, 0, 0);   \
  }
#define G8P_STP(b, h, KT) { if ((h) == 0) G8P_ST((b) * 2, pbase, po00, po01, KT) else G8P_ST((b) * 2 + 1, pbase, po10, po11, KT) }
#define G8P_STQ(b, h, KT) { if ((h) == 0) G8P_ST(4 + (b) * 2, qbase, qo00, qo01, KT) else G8P_ST(4 + (b) * 2 + 1, qbase, qo10, qo11, KT) }
#define G8P_LDP(b, h)                                                                                                      \
  _Pragma("unroll") for (int m = 0; m < 4; ++m) _Pragma("unroll") for (int k = 0; k < 2; ++k)                              \
    Pt[m][k] = *(const bf16x8*)(rdP + ((b) * 2 + (h)) * HTB + m * 2048 + k * 1024);
#define G8P_LDQ(dst, b, h)                                                                                                 \
  _Pragma("unroll") for (int n = 0; n < 2; ++n) _Pragma("unroll") for (int k = 0; k < 2; ++k)                              \
    dst[n][k] = *(const bf16x8*)(rdQ + ((b) * 2 + (h)) * HTB + n * 2048 + k * 1024);
#define G8P_MMA(ai, bj, QT)                                                                                                \
  {                                                                                                                        \
    __builtin_amdgcn_s_setprio(1);                                                                                         \
    _Pragma("unroll") for (int m = 0; m < 4; ++m) _Pragma("unroll") for (int n = 0; n < 2; ++n)                            \
      _Pragma("unroll") for (int k = 0; k < 2; ++k)                                                                        \
        acc[ai][bj][m][n] = __builtin_amdgcn_mfma_f32_16x16x32_bf16(Pt[m][k], QT[n][k], acc[ai][bj][m][n], 0, 0, 0);       \
    __builtin_amdgcn_s_setprio(0);                                                                                         \
  }
#define G8P_WV(n) asm volatile("s_waitcnt vmcnt(" #n ")" ::: "memory")
#define G8P_WL(n) asm volatile("s_waitcnt lgkmcnt(" #n ")" ::: "memory")
#define G8P_BAR __builtin_amdgcn_s_barrier()
#define G8P_SCHED __builtin_amdgcn_sched_barrier(0)
  f32x4 acc[2][2][4][2];
#pragma unroll
  for (int a = 0; a < 2; ++a)
#pragma unroll
    for (int b = 0; b < 2; ++b)
#pragma unroll
      for (int m = 0; m < 4; ++m)
#pragma unroll
        for (int n = 0; n < 2; ++n) acc[a][b][m][n] = (f32x4){0.f, 0.f, 0.f, 0.f};
  bf16x8 Pt[4][2], Q0[2][2], Q1[2][2];
  __syncthreads();
  G8P_STQ(0, 0, 0) G8P_STP(0, 0, 0) G8P_STQ(0, 1, 0) G8P_STP(0, 1, 0)
  if (wr == 1) G8P_BAR;
  G8P_WV(4); G8P_BAR;
  G8P_STQ(1, 0, 1) G8P_STP(1, 0, 1) G8P_STQ(1, 1, 1)
  G8P_WV(6); G8P_BAR;
  for (int t = 0; t < nt - 2; t += 2) {
    G8P_LDQ(Q0, 0, 0) G8P_SCHED; G8P_LDP(0, 0) G8P_STP(1, 1, t + 1)
    G8P_WL(8); G8P_BAR; G8P_WL(0); G8P_MMA(0, 0, Q0) G8P_BAR; G8P_SCHED;
    G8P_LDQ(Q1, 0, 1) G8P_STQ(0, 0, t + 2)
    G8P_BAR; G8P_WL(0); G8P_MMA(0, 1, Q1) G8P_BAR;
    G8P_LDP(0, 1) G8P_STP(0, 0, t + 2)
    G8P_BAR; G8P_WL(0); G8P_MMA(1, 0, Q0) G8P_BAR; G8P_SCHED;
    G8P_STQ(0, 1, t + 2)
    G8P_WV(6); G8P_BAR; G8P_MMA(1, 1, Q1) G8P_BAR;
    G8P_LDQ(Q0, 1, 0) G8P_SCHED; G8P_LDP(1, 0) G8P_STP(0, 1, t + 2)
    G8P_WL(8); G8P_BAR; G8P_WL(0); G8P_MMA(0, 0, Q0) G8P_BAR; G8P_SCHED;
    G8P_LDQ(Q1, 1, 1) G8P_STQ(1, 0, t + 3)
    G8P_BAR; G8P_WL(0); G8P_MMA(0, 1, Q1) G8P_BAR;
    G8P_LDP(1, 1) G8P_STP(1, 0, t + 3)
    G8P_BAR; G8P_WL(0); G8P_MMA(1, 0, Q0) G8P_BAR; G8P_SCHED;
    G8P_STQ(1, 1, t + 3)
    G8P_WV(6); G8P_BAR; G8P_MMA(1, 1, Q1) G8P_BAR;
  }
  {
    G8P_LDQ(Q0, 0, 0) G8P_LDP(0, 0) G8P_STP(1, 1, nt - 1)
    G8P_BAR; G8P_WL(0); G8P_MMA(0, 0, Q0) G8P_BAR;
    G8P_LDQ(Q1, 0, 1) G8P_BAR; G8P_WL(0); G8P_MMA(0, 1, Q1) G8P_BAR;
    G8P_LDP(0, 1) G8P_WV(4); G8P_BAR; G8P_WL(0); G8P_MMA(1, 0, Q0) G8P_MMA(1, 1, Q1) G8P_BAR;
  }
  {
    G8P_LDQ(Q0, 1, 0) G8P_LDP(1, 0) G8P_WV(2); G8P_BAR; G8P_WL(0); G8P_MMA(0, 0, Q0) G8P_BAR;
    G8P_LDQ(Q1, 1, 1) G8P_WV(0); G8P_BAR; G8P_WL(0); G8P_MMA(0, 1, Q1) G8P_BAR;
    G8P_LDP(1, 1) G8P_BAR; G8P_WL(0); G8P_MMA(1, 0, Q0) G8P_MMA(1, 1, Q1) G8P_BAR;
  }
  if (wr == 0) G8P_BAR;
#undef G8P_ST
#undef G8P_STP
#undef G8P_STQ
#undef G8P_LDP
#undef G8P_LDQ
#undef G8P_MMA
#undef G8P_WV
#undef G8P_WL
#undef G8P_BAR
#undef G8P_SCHED
#pragma unroll
  for (int ai = 0; ai < 2; ++ai)
#pragma unroll
    for (int bj = 0; bj < 2; ++bj)
#pragma unroll
      for (int m = 0; m < 4; ++m)
#pragma unroll
        for (int n = 0; n < 2; ++n)
          ef(bj * 128 + wc * 32 + n * 16 + fr, ai * 128 + wr * 64 + m * 16 + fq * 4, acc[ai][bj][m][n][0], acc[ai][bj][m][n][1], acc[ai][bj][m][n][2], acc[ai][bj][m][n][3]);
}

#define EPI_FOR                                                   \
  _Pragma("unroll") for (int mt = 0; mt < 2; ++mt)                \
  _Pragma("unroll") for (int nt = 0; nt < 2; ++nt)                \
  _Pragma("unroll") for (int i = 0; i < 16; ++i)
#define EPI_R (wm * 64 + mt * 32 + (i & 3) + 8 * (i >> 2) + 4 * (lane >> 5))
#define EPI_C (wn * 64 + nt * 32 + (lane & 31))
#define SW_FOR                                                    \
  _Pragma("unroll") for (int mt = 0; mt < MT; ++mt)               \
  _Pragma("unroll") for (int nt = 0; nt < 2; ++nt)                \
  _Pragma("unroll") for (int q4 = 0; q4 < 4; ++q4)
#define SW_R (wm * (32 * MT) + mt * 32 + (lane & 31))
#define SW_C0 (wn * 64 + nt * 32 + 8 * q4 + 4 * (lane >> 5))
#define SW_V(j) acc[mt][nt][4 * q4 + (j)]
DI uint2 pack4(float a, float b, float c, float d) { uint2 w; w.x = pack2(a, b); w.y = pack2(c, d); return w; }

struct ARows { const u16* base; long ld; int nrows; DI const u16* operator()(int r) const { return base + (long)(r < nrows ? r : 0) * ld; }
  DI const u16* origin() const { return base; } DI int off(int r) const { return (r < nrows ? r : 0) * (int)ld; } };
struct BMat { const float* base; long ldb; int ncols; DI const float* operator()(int c4) const { return base + (c4 < ncols ? c4 : 0); } DI const u16* row(int) const { return nullptr; } };
struct BMatT { const u16* base; long ldb; DI const float* operator()(int) const { return nullptr; } DI const u16* row(int n) const { return base + (long)n * ldb; } };

DI void phase0(const Params& p, char* smem, int bid, int nblk) {
  const int tid = TIDX();
  for (int item = bid; item < 384 + 256 + 16 + 1 + 1728; item += nblk) {
    if (item < 384) {
      const int cc = item % 24, kc = item / 24;
      const int col = cc * 256 + tid;
      float a0 = 0.f, a1 = 0.f;
#pragma unroll 1
      for (int half = 0; half < 2; ++half) {
        const int k0 = kc * 64 + half * 32;
        float w[32];
#pragma unroll
        for (int j = 0; j < 32; ++j) w[j] = p.w_ada[(long)(k0 + j) * 6144 + col];
#pragma unroll
        for (int j = 0; j < 32; ++j) {
          a0 += siluf(p.c[k0 + j]) * w[j];
          a1 += siluf(p.c[1024 + k0 + j]) * w[j];
        }
      }
      p.modp[(kc * 2 + 0) * 6144 + col] = a0;
      p.modp[(kc * 2 + 1) * 6144 + col] = a1;
    } else if (item < 640) {
      const int idx = (item - 384) * 256 + tid;
      const int c = idx & 127, d = (idx >> 7) & 63, h = idx >> 13;
      p.w_ukT[idx] = p.dsa_w_uk[c * 512 + h * 64 + d];
    } else if (item < 656) {
      const int part = item - 640;
      const int slot = tid >> 7, kk = tid & 127;
      float a = 0.f;
      for (int ld = part * 128; ld < part * 128 + 128; ++ld) a += p.cmp_pe[slot * 2048 + ld] * p.cmp_w1[((long)slot * 2048 + ld) * 128 + kk];
      p.pe_part[part * 256 + tid] = a;
    } else if (item == 656) {
      p.counts[tid * 32] = 0;
    } else {
      int it = item - 657;
      const float* W; u16* WT; int K, N, ntn;
      if (it < 1152) { W = p.w_in; WT = p.w_inT; K = 1024; N = LDP; ntn = 72; }
      else if (it < 1280) { it -= 1152; W = p.w_bn; WT = p.w_bnT; K = 512; N = 1024; ntn = 16; }
      else if (it < 1408) { it -= 1280; W = p.w_bd; WT = p.w_bdT; K = 512; N = 1024; ntn = 16; }
      else if (it < 1664) { it -= 1408; W = p.w_out; WT = p.w_outT; K = 1024; N = 1024; ntn = 16; }
      else { it -= 1664; W = p.router_w; WT = p.routerT; K = 1024; N = 256; ntn = 4; }
      const int k0 = (it / ntn) * 64, n0 = (it % ntn) * 64;
      u16* tl = (u16*)smem;
      hb_sync();
      const int kr = tid >> 4, nq = tid & 15;
#pragma unroll
      for (int ps = 0; ps < 4; ++ps) {
        const int k = kr + 16 * ps, n = n0 + nq * 4;
        float4 v = make_float4(0.f, 0.f, 0.f, 0.f);
        if (n < N) v = *(const float4*)(W + (long)(k0 + k) * N + n);
        tl[(nq * 4 + 0) * 72 + k] = f2bf(v.x);
        tl[(nq * 4 + 1) * 72 + k] = f2bf(v.y);
        tl[(nq * 4 + 2) * 72 + k] = f2bf(v.z);
        tl[(nq * 4 + 3) * 72 + k] = f2bf(v.w);
      }
      hb_sync();
      const int nr = tid >> 2, piece = tid & 3;
      const uint4 a = *(const uint4*)(tl + nr * 72 + piece * 16);
      const uint4 b = *(const uint4*)(tl + nr * 72 + piece * 16 + 8);
      uint4* dst = (uint4*)(WT + (long)(n0 + nr) * K + k0 + piece * 16);
      dst[0] = a; dst[1] = b;
    }
  }
}

DI void phase1(const Params& p, char* smem, int bid, int nblk) {
  const int tid = TIDX(), lane = tid & 63, wid = __builtin_amdgcn_readfirstlane(tid >> 6);
  float* modl = (float*)smem;
  const int b = bid & 1;
#pragma unroll
  for (int i0 = 0; i0 < 8; i0 += 4) {
    float v[4];
#pragma unroll
    for (int ii = 0; ii < 4; ++ii) v[ii] = p.b_ada[tid + 256 * (i0 + ii)];
#pragma unroll
    for (int kc = 0; kc < 16; ++kc)
#pragma unroll
      for (int ii = 0; ii < 4; ++ii) v[ii] += p.modp[(kc * 2 + b) * 6144 + tid + 256 * (i0 + ii)];
#pragma unroll
    for (int ii = 0; ii < 4; ++ii) modl[tid + 256 * (i0 + ii)] = v[ii];
  }
  if (bid < 48) {
    const int idx = bid * 256 + tid;
    const int bb = idx / 6144, n = idx % 6144;
    float v = p.b_ada[n];
#pragma unroll
    for (int kc = 0; kc < 16; ++kc) v += p.modp[(kc * 2 + bb) * 6144 + n];
    p.mod[idx] = v;
  }
  hb_sync();
  float cm[16], ca[16];
#pragma unroll
  for (int i = 0; i < 4; ++i) {
    const int col = i * 256 + lane * 4;
    const float4 g = *(const float4*)(p.g_pre_mix + col);
    const float4 sh = *(const float4*)(modl + col), sc = *(const float4*)(modl + 1024 + col);
    cm[i * 4 + 0] = g.x * (1.f + sc.x); cm[i * 4 + 1] = g.y * (1.f + sc.y); cm[i * 4 + 2] = g.z * (1.f + sc.z); cm[i * 4 + 3] = g.w * (1.f + sc.w);
    ca[i * 4 + 0] = sh.x; ca[i * 4 + 1] = sh.y; ca[i * 4 + 2] = sh.z; ca[i * 4 + 3] = sh.w;
  }
  const int stride = (nblk >> 1) * 4;
  for (int t0 = (bid >> 1) * 4 + wid; t0 < T; t0 += 4 * stride) {
    float4 v[4][4];
#pragma unroll
    for (int k = 0; k < 4; ++k) {
      const int t = t0 + k * stride < T ? t0 + k * stride : T - 1;
      const float* xr = p.x + ((long)b * T + t) * 1024;
#pragma unroll
      for (int i = 0; i < 4; ++i) v[k][i] = *(const float4*)(xr + i * 256 + lane * 4);
    }
#pragma unroll
    for (int k = 0; k < 4; ++k) {
      float ss = 0.f;
#pragma unroll
      for (int i = 0; i < 4; ++i) ss += v[k][i].x * v[k][i].x + v[k][i].y * v[k][i].y + v[k][i].z * v[k][i].z + v[k][i].w * v[k][i].w;
      ss = wave_sum(ss);
      const float r = rsqrtf(ss * (1.f / 1024.f) + 1e-6f);
      if (t0 + k * stride < T) {
        u16* hr = p.h + ((long)b * T + t0 + k * stride) * 1024;
#pragma unroll
        for (int i = 0; i < 4; ++i) {
          const float o0 = v[k][i].x * r * cm[i * 4 + 0] + ca[i * 4 + 0];
          const float o1 = v[k][i].y * r * cm[i * 4 + 1] + ca[i * 4 + 1];
          const float o2 = v[k][i].z * r * cm[i * 4 + 2] + ca[i * 4 + 2];
          const float o3 = v[k][i].w * r * cm[i * 4 + 3] + ca[i * 4 + 3];
          *(uint2*)(hr + i * 256 + lane * 4) = pack4(o0, o1, o2, o3);
        }
      }
    }
  }
}

struct EpiProj {
  u16* proj; float* widx; int m0, n0;
  template <int MT> DI void operator()(f32x16 (&acc)[MT][2], int wm, int wn, int lane) const {
    SW_FOR {
      const int r = m0 + SW_R, c = n0 + SW_C0;
      if (c < LDP) {
        float v[4] = {SW_V(0), SW_V(1), SW_V(2), SW_V(3)};
        if (c < C_KV) { for (int j = 0; j < 4; ++j) v[j] *= 0.125f; }
        else if (c < C_GN) {}
        else if (c < C_QD) { for (int j = 0; j < 4; ++j) v[j] = sigmoidf(v[j]); }
        else if (c < C_QI) {}
        else if (c < C_KI) { for (int j = 0; j < 4; ++j) v[j] *= 0.125f; }
        else if (c < C_WI) {}
        else if (c < C_GM) {
          for (int j = 0; j < 4; ++j) v[j] *= 0.35355339059327373f;
          *(float4*)(widx + (long)r * 8 + (c - C_WI)) = make_float4(v[0], v[1], v[2], v[3]);
        } else { for (int j = 0; j < 4; ++j) v[j] = sigmoidf(v[j]); }
        *(uint2*)(proj + (long)r * LDP + c) = pack4(v[0], v[1], v[2], v[3]);
      }
    }
  }
};
struct EpiProjVT {
  u16* vt; int m0;
  DI void operator()(f32x16 (&acc)[2][2], int wm, int wn, int lane) const {
#pragma unroll
    for (int mt = 0; mt < 2; ++mt)
#pragma unroll
      for (int nt = 0; nt < 2; ++nt) {
        const int cc = EPI_C;
#pragma unroll
        for (int q4 = 0; q4 < 4; ++q4) {
          const int r = m0 + wm * 64 + mt * 32 + 8 * q4 + 4 * (lane >> 5);
          const int b = r >> 13, t = r & 8191;
          uint2 w;
          w.x = pack2(acc[mt][nt][q4 * 4 + 0], acc[mt][nt][q4 * 4 + 1]);
          w.y = pack2(acc[mt][nt][q4 * 4 + 2], acc[mt][nt][q4 * 4 + 3]);
          *(uint2*)(vt + ((long)(b * 128 + cc)) * T + t) = w;
        }
      }
  }
};
DI int proj_group(int q) { return q < 7 ? q : (q < 8 ? q + 1 : q + 2); }
DI void proj_store4(u16* proj, float* widx, long r, int c, float v0, float v1, float v2, float v3) {
  if (c < LDP) {
    float v[4] = {v0, v1, v2, v3};
    if (c < C_KV) { for (int j = 0; j < 4; ++j) v[j] *= 0.125f; }
    else if (c < C_GN) {}
    else if (c < C_QD) { for (int j = 0; j < 4; ++j) v[j] = sigmoidf(v[j]); }
    else if (c < C_QI) {}
    else if (c < C_KI) { for (int j = 0; j < 4; ++j) v[j] *= 0.125f; }
    else if (c < C_WI) {}
    else if (c < C_GM) {
      for (int j = 0; j < 4; ++j) v[j] *= 0.35355339059327373f;
      *(float4*)(widx + r * 8 + (c - C_WI)) = make_float4(v[0], v[1], v[2], v[3]);
    } else { for (int j = 0; j < 4; ++j) v[j] = sigmoidf(v[j]); }
    *(uint2*)(proj + r * LDP + c) = pack4(v[0], v[1], v[2], v[3]);
  }
}
struct WRows2 { const u16* base; int ra, rb; DI const u16* origin() const { return base; } DI int off(int r) const { return ((r < 128 ? ra : rb) + (r & 127)) * 1024; } };
struct Epi8Proj {
  u16* proj; float* widx; int m0, n0a, n0b;
  DI void operator()(int q, int c, float v0, float v1, float v2, float v3) const {
    proj_store4(proj, widx, m0 + q, (c < 128 ? n0a : n0b) + (c & 127), v0, v1, v2, v3);
  }
};
struct Epi8ProjVT {
  u16* vts; u16* vtw; int m0;
  DI void operator()(int q, int c, float v0, float v1, float v2, float v3) const {
    const int r = m0 + c, b = r >> 13, t = r & 8191;
    u16* vt = q < 128 ? vts : vtw;
    *(uint2*)(vt + ((long)(b * 128 + (q & 127))) * T + t) = pack4(v0, v1, v2, v3);
  }
};
DI void phase2_8w(const Params& p, int wg, int nwg) {
  for (int i = wg; i < 1280; i += nwg) {
    const int x_ = i & 7, s_ = (i >> 3) & 31, blk = (i >> 8) * 8 + x_;
    if (blk >= 36) continue;
    const int nb = blk % 9, mb = blk / 9;
    const int mt_ = mb * 16 + (s_ >> 1), v = 2 * nb + (s_ & 1);
    ARows tf{p.h + (long)mt_ * 256 * 1024, 1024, 256};
    if (v < 17) {
      const int ga = proj_group(2 * v), gb = proj_group(2 * v + 1);
      WRows2 wf{p.w_inT, ga * 128, gb * 128};
      Epi8Proj ef{p.proj, p.widx, mt_ * 256, ga * 128, gb * 128};
      gemm8p(16, wf, tf, ef);
    } else {
      WRows2 wf{p.w_inT, 7 * 128, 9 * 128};
      Epi8ProjVT ef{p.vts, p.vtw, mt_ * 256};
      gemm8p(16, tf, wf, ef);
    }
  }
}
DI void phase2(const Params& p, char* smem, int bid, int nblk) {}

struct ACmp {
  const u16* proj; int slot, m0, kt0;
  DI const u16* operator()(int r) const {
    const int R = m0 + r, bg = R >> 9, n = R & 511, b = bg >> 1, g = bg & 1;
    const int nc = n >= 511 ? 510 : n;
    return proj + ((long)b * T + 16 * nc + kt0) * LDP + C_KV + slot * 128 + g * 64;
  }
};
struct EpiPartF32 {
  float* dst; int m0;
  DI void operator()(f32x16 (&acc)[2][2], int wm, int wn, int lane) const {
    constexpr int MT = 2;
    SW_FOR { *(float4*)(dst + (long)(m0 + SW_R) * 128 + SW_C0) = make_float4(SW_V(0), SW_V(1), SW_V(2), SW_V(3)); }
  }
};
struct EpiCmp1 {
  u16* zc; const float* b1; const float* pe_part; int slot, m0;
  DI void operator()(f32x16 (&acc)[2][2], int wm, int wn, int lane) const {
    constexpr int MT = 2;
#pragma unroll
    for (int nt = 0; nt < 2; ++nt)
#pragma unroll
      for (int q4 = 0; q4 < 4; ++q4) {
        const int c = SW_C0;
        float4 bias = *(const float4*)(b1 + slot * 128 + c);
        for (int q = 0; q < 16; ++q) {
          const float4 t = *(const float4*)(pe_part + q * 256 + slot * 128 + c);
          bias.x += t.x; bias.y += t.y; bias.z += t.z; bias.w += t.w;
        }
#pragma unroll
        for (int mt = 0; mt < 2; ++mt) {
          const int R = m0 + SW_R;
          *(uint2*)(zc + ((long)slot * 2048 + R) * 128 + c) =
              pack4(gelu_tanh(SW_V(0) + bias.x), gelu_tanh(SW_V(1) + bias.y), gelu_tanh(SW_V(2) + bias.z), gelu_tanh(SW_V(3) + bias.w));
        }
      }
  }
};
struct EpiQlat {
  u16* qlat; int h, m0;
  DI void operator()(f32x16 (&acc)[2][2], int wm, int wn, int lane) const {
    constexpr int MT = 2;
    SW_FOR {
      const int r = m0 + SW_R, c = SW_C0;
      *(uint2*)(qlat + ((long)r * 8 + h) * 128 + c) = pack4(SW_V(0) * 0.125f, SW_V(1) * 0.125f, SW_V(2) * 0.125f, SW_V(3) * 0.125f);
    }
  }
};
constexpr int IDX_QLD = 520;
constexpr int IDX_NITEMS = 1152;
DI void indexer_item2(const Params& p, char* smem, int b, int tq, int c) {
  const int tid = TIDX(), lane = tid & 63, wid = __builtin_amdgcn_readfirstlane(tid >> 6);
  u16* Qs = (u16*)smem;
  float* wl = (float*)(smem + 64 * IDX_QLD * 2);
  const u16* projb = p.proj + (long)b * T * LDP;
  const int t0 = tq * 64;
  {
    uint4 q[16];
#pragma unroll
    for (int i = 0; i < 16; ++i) q[i] = *(const uint4*)(projb + (long)(t0 + i * 4 + wid) * LDP + C_QI + lane * 8);
    const float2 wv = *(const float2*)(p.widx + ((long)b * T + t0) * 8 + tid * 2);
#pragma unroll
    for (int i = 0; i < 16; ++i) *(uint4*)(Qs + (i * 4 + wid) * IDX_QLD + lane * 8) = q[i];
    *(float2*)(wl + tid * 2) = wv;
  }
  hb_sync();
  const int r31 = lane & 31, hf = lane >> 5;
  const int kt_lo = c * 16, kt_hi = (kt_lo + 16 < tq + 1) ? kt_lo + 16 : tq + 1;
  const u16* qfrag = Qs + r31 * IDX_QLD + hf * 8;
  const float* wq = wl + r31 * 8;
  const u16* kbase = projb + (long)r31 * LDP + C_KI + hf * 8;
  bf16x8 kn[2][4];
#define IDX2_LOADK(KT)                                                                                   \
  {                                                                                                      \
    const int kk_ = (KT) < kt_hi ? (KT) : kt_hi - 1;                                                     \
    _Pragma("unroll") for (int nt = 0; nt < 2; ++nt)                                                     \
      _Pragma("unroll") for (int ks = 0; ks < 4; ++ks) kn[nt][ks] = *(const bf16x8*)(kbase + (long)(kk_ * 64 + nt * 32) * LDP + ks * 16); \
  }
  IDX2_LOADK(kt_lo + wid)
#pragma unroll 1
  for (int kt = kt_lo + wid; kt < kt_hi; kt += 4) {
    bf16x8 kf[2][4];
#pragma unroll
    for (int nt = 0; nt < 2; ++nt)
#pragma unroll
      for (int ks = 0; ks < 4; ++ks) kf[nt][ks] = kn[nt][ks];
    IDX2_LOADK(kt + 4)
    asm volatile("" ::: "memory");
    f32x16 sum[2][2];
#pragma unroll
    for (int a = 0; a < 2; ++a)
#pragma unroll
      for (int d = 0; d < 2; ++d)
#pragma unroll
        for (int i = 0; i < 16; ++i) sum[a][d][i] = 0.f;
#define IDX2_LOADQ(DST, MT, H)                                                                          \
  {                                                                                                      \
    const int h_ = (H) < 7 ? (H) : 7;                                                                    \
    _Pragma("unroll") for (int ks = 0; ks < 4; ++ks) DST[ks] = *(const bf16x8*)(qfrag + (MT) * 32 * IDX_QLD + h_ * 64 + ks * 16); \
  }
#define IDX2_CHAIN(ACC, SRC, NT)                                                                         \
  {                                                                                                      \
    _Pragma("unroll") for (int i = 0; i < 16; ++i) ACC[i] = 0.f;                                         \
    _Pragma("unroll") for (int ks = 0; ks < 4; ++ks) ACC = __builtin_amdgcn_mfma_f32_32x32x16_bf16(kf[NT][ks], SRC[ks], ACC, 0, 0, 0); \
  }
#define IDX2_ACCUM(ACC, MT, NT, W)                                                                       \
  {                                                                                                      \
    _Pragma("unroll") for (int i = 0; i < 16; ++i) {                                                     \
      const int rb_ = __float_as_int(ACC[i]);                                                            \
      sum[MT][NT][i] += (W) * __int_as_float(rb_ > 0 ? rb_ : 0);                                         \
    }                                                                                                    \
  }
#define IDX2_SGB4 \
  __builtin_amdgcn_sched_group_barrier(0x008, 1, 0); __builtin_amdgcn_sched_group_barrier(0x002, 6, 0); \
  __builtin_amdgcn_sched_group_barrier(0x008, 1, 0); __builtin_amdgcn_sched_group_barrier(0x002, 6, 0); \
  __builtin_amdgcn_sched_group_barrier(0x008, 1, 0); __builtin_amdgcn_sched_group_barrier(0x002, 6, 0); \
  __builtin_amdgcn_sched_group_barrier(0x008, 1, 0); __builtin_amdgcn_sched_group_barrier(0x002, 6, 0);
    bf16x8 sa[4], sb[4];
    f32x16 accA, accB;
    IDX2_LOADQ(sa, 0, 0)
    IDX2_LOADQ(sb, 1, 0)
    float w0 = wq[0], w1 = wq[256];
    IDX2_CHAIN(accA, sa, 0)
#pragma unroll 1
    for (int h = 0; h < 8; ++h) {
      const int hn = h < 7 ? h + 1 : 7;
      IDX2_CHAIN(accB, sa, 1)
      IDX2_ACCUM(accA, 0, 0, w0)
      IDX2_LOADQ(sa, 0, h + 1)
      IDX2_CHAIN(accA, sb, 0)
      IDX2_ACCUM(accB, 0, 1, w0)
      IDX2_CHAIN(accB, sb, 1)
      IDX2_ACCUM(accA, 1, 0, w1)
      IDX2_LOADQ(sb, 1, h + 1)
      const float w0n = wq[hn], w1n = wq[256 + hn];
      IDX2_CHAIN(accA, sa, 0)
      IDX2_ACCUM(accB, 1, 1, w1)
      w0 = w0n; w1 = w1n;
      IDX2_SGB4
      IDX2_SGB4
      __builtin_amdgcn_sched_group_barrier(0x100, 5, 0);
      IDX2_SGB4
      IDX2_SGB4
      __builtin_amdgcn_sched_group_barrier(0x100, 5, 0);
    }
#undef IDX2_LOADQ
#undef IDX2_CHAIN
#undef IDX2_ACCUM
#undef IDX2_SGB4
    const int s0 = kt * 64;
#pragma unroll
    for (int mt = 0; mt < 2; ++mt)
#pragma unroll
      for (int nt = 0; nt < 2; ++nt)
#pragma unroll
        for (int q4 = 0; q4 < 4; ++q4) {
          typedef _Float16 h4_t __attribute__((ext_vector_type(4)));
          typedef float f4_t __attribute__((ext_vector_type(4)));
          const f4_t v4 = {sum[mt][nt][4 * q4], sum[mt][nt][4 * q4 + 1], sum[mt][nt][4 * q4 + 2], sum[mt][nt][4 * q4 + 3]};
          *(h4_t*)((u16*)p.scores + ((long)b * T + t0 + mt * 32 + r31) * T + s0 + nt * 32 + 8 * q4 + 4 * hf) = __builtin_convertvector(v4, h4_t);
        }
  }
#undef IDX2_LOADK
}
DI void phase3(const Params& p, char* smem, int bid, int nblk) {
  const int tid = TIDX(), lane = tid & 63, wid = __builtin_amdgcn_readfirstlane(tid >> 6);
  if (bid < 128) {
    const int kq = bid & 3, tile = bid >> 2, slot = tile >> 4, mt_ = tile & 15;
    ACmp af{p.proj, slot, mt_ * 128, kq * 8};
    BMat bf{p.cmp_w1 + ((long)slot * 2048 + kq * 512) * 128, 128, 128};
    EpiPartF32 ef{p.cpart + ((long)kq * 4096 + slot * 2048) * 128, mt_ * 128};
    gemm_tile(smem, 8, LDP, af, bf, ef);
  }
  int* qslot = (int*)(smem + 64 * IDX_QLD * 2 + 2048);
  unsigned* qctr = p.bar + XCD_BAR_WORDS;
  hb_sync();
  if (tid == 0) *qslot = (int)atomicAdd(qctr, 1u);
  for (;;) {
    hb_sync();
    const int i = __builtin_amdgcn_readfirstlane(*qslot);
    if (i >= IDX_NITEMS + 1024 + 512) break;
    int nxt = 0;
    if (tid == 0) nxt = (int)atomicAdd(qctr, 1u);
    if (i < IDX_NITEMS) {
      const int b = i & 1;
      int j = i >> 1, c = 0;
      while (j >= 128 - 16 * c) { j -= 128 - 16 * c; ++c; }
      indexer_item2(p, smem, b, 127 - j, c);
    } else if (i < IDX_NITEMS + 1024) {
      const int it = i - IDX_NITEMS, h = it & 7, mt_ = it >> 3;
      ARows af{p.proj + (long)mt_ * 128 * LDP + C_QD + h * 64, LDP, 128};
      BMat bf{p.w_ukT + h * 64 * 128, 128, 128};
      EpiQlat ef{p.qlat, h, mt_ * 128};
      gemm_tile<true, true>(smem, 1, 64, af, bf, ef);
    } else {
      const int it = i - IDX_NITEMS - 1024;
      const float n0 = p.dsa_kv_norm[lane * 2], n1 = p.dsa_kv_norm[lane * 2 + 1];
      unsigned u[8];
#pragma unroll
      for (int q = 0; q < 8; ++q) u[q] = *(const unsigned*)(p.proj + (long)(it * 32 + wid * 8 + q) * LDP + C_CKV + lane * 2);
#pragma unroll
      for (int q = 0; q < 8; ++q) {
        const float a = lo16(u[q]), b = hi16(u[q]);
        const float ss = wave_sum(a * a + b * b);
        const float r = rsqrtf(ss * (1.f / 128.f) + 1e-6f);
        *(unsigned*)(p.ckv + (long)(it * 32 + wid * 8 + q) * 128 + lane * 2) = pack2(a * r * n0, b * r * n1);
      }
    }
    hb_sync();
    if (tid == 0) *qslot = nxt;
  }
}

struct EpiCmp2 {
  u16* dst; int m0;
  DI void operator()(f32x16 (&acc)[2][2], int wm, int wn, int lane) const {
    constexpr int MT = 2;
    SW_FOR {
      const int R = m0 + SW_R, c = SW_C0;
      if (c < 64) *(uint2*)(dst + (long)R * 64 + c) = pack4(SW_V(0), SW_V(1), SW_V(2), SW_V(3));
    }
  }
};
struct EpiCmp2T {
  u16* dst; int m0;
  DI void operator()(f32x16 (&acc)[2][2], int wm, int wn, int lane) const {
#pragma unroll
    for (int mt = 0; mt < 2; ++mt)
#pragma unroll
      for (int nt = 0; nt < 2; ++nt) {
        const int c = EPI_C;
        if (c < 64) {
#pragma unroll
          for (int q4 = 0; q4 < 4; ++q4) {
            const int R = m0 + wm * 64 + mt * 32 + 8 * q4 + 4 * (lane >> 5);
            const int bg = R >> 9, n = R & 511;
            *(uint2*)(dst + ((long)(bg * 64 + c)) * 512 + n) =
                pack4(acc[mt][nt][q4 * 4 + 0], acc[mt][nt][q4 * 4 + 1], acc[mt][nt][q4 * 4 + 2], acc[mt][nt][q4 * 4 + 3]);
          }
        }
      }
  }
};
DI void indexer_item(const Params& p, char* smem, int item) {
  const int tid = TIDX(), lane = tid & 63, wid = __builtin_amdgcn_readfirstlane(tid >> 6);
  int b = 0, rem = item;
  if (rem >= 2080) { b = 1; rem -= 2080; }
  int qt = (int)((sqrtf(8.f * rem + 1.f) - 1.f) * 0.5f);
  while ((qt + 1) * (qt + 2) / 2 <= rem) ++qt;
  while (qt * (qt + 1) / 2 > rem) --qt;
  const int kt = rem - qt * (qt + 1) / 2;
  const int t0 = qt * 128 + (wid >> 1) * 64, s0 = kt * 128 + (wid & 1) * 64;
  if (s0 > t0 + 63) return;
  float* wl = (float*)smem + wid * 512;
  const float* wsrc = p.widx + ((long)b * T + t0) * 8;
#pragma unroll
  for (int i = 0; i < 8; ++i) wl[i * 64 + lane] = wsrc[i * 64 + lane];
  wave_sync();
  const u16* projb = p.proj + (long)b * T * LDP;
  const int r31 = lane & 31, hf = lane >> 5;
  u16* Kt = (u16*)(smem + 8192) + wid * (64 * 72);
  {
    const int piece = lane & 7, rb = lane >> 3;
#pragma unroll
    for (int i = 0; i < 8; ++i) {
      const uint4 v = *(const uint4*)(projb + (long)(s0 + rb + 8 * i) * LDP + C_KI + piece * 8);
      *(uint4*)(Kt + (rb + 8 * i) * 72 + piece * 8) = v;
    }
  }
  wave_sync();
  const u16* kfrag = Kt + r31 * 72 + hf * 8;
  f32x16 sum[2][2];
#pragma unroll
  for (int a = 0; a < 2; ++a)
#pragma unroll
    for (int c = 0; c < 2; ++c)
#pragma unroll
      for (int i = 0; i < 16; ++i) sum[a][c][i] = 0.f;
  const u16* qbase = projb + (long)(t0 + r31) * LDP + C_QI + hf * 8;
  bf16x8 af0[4], af1[4], af2[4], af3[4];
#define IDX_LOADQ(DST, STEP)                                                                            \
  {                                                                                                     \
    const int st_ = (STEP) < 15 ? (STEP) : 15;                                                          \
    _Pragma("unroll") for (int ks = 0; ks < 4; ++ks) DST[ks] = *(const bf16x8*)(qbase + (long)(st_ & 1) * 32 * LDP + (st_ >> 1) * 64 + ks * 16); \
  }
#define IDX_STEP(SRC, MT, H)                                                                            \
  {                                                                                                     \
    const float w_ = wl[((MT) * 32 + r31) * 8 + (H)];                                                   \
    _Pragma("unroll") for (int nt = 0; nt < 2; ++nt) {                                                  \
      f32x16 acc;                                                                                       \
      _Pragma("unroll") for (int i = 0; i < 16; ++i) acc[i] = 0.f;                                      \
      _Pragma("unroll") for (int ks = 0; ks < 4; ++ks) acc = __builtin_amdgcn_mfma_f32_32x32x16_bf16(*(const bf16x8*)(kfrag + nt * 32 * 72 + ks * 16), SRC[ks], acc, 0, 0, 0); \
      _Pragma("unroll") for (int i = 0; i < 16; ++i) sum[MT][nt][i] += w_ * fmaxf(acc[i], 0.f);        \
    }                                                                                                   \
  }
  IDX_LOADQ(af0, 0) IDX_LOADQ(af1, 1) IDX_LOADQ(af2, 2)
#pragma unroll 1
  for (int s4 = 0; s4 < 16; s4 += 4) {
    IDX_LOADQ(af3, s4 + 3)
    asm volatile("" ::: "memory");
    IDX_STEP(af0, 0, s4 >> 1)
    asm volatile("" ::: "memory");
    IDX_LOADQ(af0, s4 + 4)
    asm volatile("" ::: "memory");
    IDX_STEP(af1, 1, s4 >> 1)
    asm volatile("" ::: "memory");
    IDX_LOADQ(af1, s4 + 5)
    asm volatile("" ::: "memory");
    IDX_STEP(af2, 0, (s4 >> 1) + 1)
    asm volatile("" ::: "memory");
    IDX_LOADQ(af2, s4 + 6)
    asm volatile("" ::: "memory");
    IDX_STEP(af3, 1, (s4 >> 1) + 1)
    asm volatile("" ::: "memory");
  }
#undef IDX_LOADQ
#undef IDX_STEP
#pragma unroll
  for (int mt = 0; mt < 2; ++mt)
#pragma unroll
    for (int nt = 0; nt < 2; ++nt)
#pragma unroll
      for (int q4 = 0; q4 < 4; ++q4)
      {
        typedef _Float16 h4_t __attribute__((ext_vector_type(4)));
        typedef float f4_t __attribute__((ext_vector_type(4)));
        const f4_t v4 = {sum[mt][nt][4 * q4], sum[mt][nt][4 * q4 + 1], sum[mt][nt][4 * q4 + 2], sum[mt][nt][4 * q4 + 3]};
        *(h4_t*)((u16*)p.scores + ((long)b * T + t0 + mt * 32 + r31) * T + s0 + nt * 32 + 8 * q4 + 4 * hf) = __builtin_convertvector(v4, h4_t);
      }
}
DI void topk_row(const Params& p, int b, int t, int lane);
DI void phase4(const Params& p, char* smem, int bid, int nblk) {
  if (bid < 32) {
    const int slot = bid >> 4, mt_ = bid & 15;
    {
      const int tid = TIDX(), c = (tid & 31) * 4;
      float4 bias = *(const float4*)(p.cmp_b1 + slot * 128 + c);
      for (int q = 0; q < 16; ++q) {
        const float4 t = *(const float4*)(p.pe_part + q * 256 + slot * 128 + c);
        bias.x += t.x; bias.y += t.y; bias.z += t.z; bias.w += t.w;
      }
#pragma unroll 4
      for (int i = 0; i < 16; ++i) {
        const long R = (long)slot * 2048 + mt_ * 128 + (tid >> 5) + 8 * i;
        float4 v = *(const float4*)(p.cpart + R * 128 + c);
#pragma unroll
        for (int kq = 1; kq < 4; ++kq) {
          const float4 t = *(const float4*)(p.cpart + ((long)kq * 4096 + R) * 128 + c);
          v.x += t.x; v.y += t.y; v.z += t.z; v.w += t.w;
        }
        *(uint2*)(p.zc + R * 128 + c) = pack4(gelu_tanh(v.x + bias.x), gelu_tanh(v.y + bias.y), gelu_tanh(v.z + bias.z), gelu_tanh(v.w + bias.w));
      }
      hb_sync();
    }
    ARows af{p.zc + ((long)slot * 2048 + mt_ * 128) * 128, 128, 128};
    BMat bf{p.cmp_w2 + slot * 128 * 64, 64, 64};
    if (slot) { EpiCmp2T ef{p.vcT, mt_ * 128}; gemm_tile<false>(smem, 2, 64, af, bf, ef); }
    else { EpiCmp2 ef{p.kc, mt_ * 128}; gemm_tile(smem, 2, 64, af, bf, ef); }
  }
  const int tid = TIDX(), lane = tid & 63, wid = __builtin_amdgcn_readfirstlane(tid >> 6);
  for (int item = bid; item < 2048; item += nblk) {
    const int it = item < 1024 ? 2047 - item : item - 1024;
    const int b = it & 1, tb = it >> 1;
#pragma unroll 1
    for (int q = 0; q < 2; ++q) {
      asm volatile("" ::: "memory");
      topk_row(p, b, tb * 8 + wid * 2 + q, lane);
    }
  }
}

#define MFMA16(a, b, c) __builtin_amdgcn_mfma_f32_16x16x32_bf16((a), (b), (c), 0, 0, 0)
#define MFMA32(a, b, c) __builtin_amdgcn_mfma_f32_32x32x16_bf16((a), (b), (c), 0, 0, 0)

constexpr int NSA_STAGE_BYTES = 64 * 72 * 2 + 64 * 68 * 2;
DI void dense_scores(f32x16 (&acc)[2], const u16* Ks, const bf16x8 (&qf)[4], int lane) {
  const int r = lane & 31, hf = lane >> 5;
  bf16x8 kf[2][4];
#pragma unroll
  for (int tile = 0; tile < 2; ++tile)
#pragma unroll
    for (int ks = 0; ks < 4; ++ks) kf[tile][ks] = *(const bf16x8*)(Ks + (32 * tile + r) * 72 + 8 * hf + 16 * ks);
  asm volatile("" ::: "memory");
#pragma unroll
  for (int tile = 0; tile < 2; ++tile) {
    f32x16 c;
#pragma unroll
    for (int i = 0; i < 16; ++i) c[i] = 0.f;
#pragma unroll
    for (int ks = 0; ks < 4; ++ks) c = MFMA32(kf[tile][ks], qf[ks], c);
    acc[tile] = c;
  }
}
DI void dense_pv(const f32x16 (&acc)[2], const u16* Vs, int lane, f32x16 (&o)[2]) {
  const int r = lane & 31, hf = lane >> 5;
  uint2 vlo[2][2][2], vhi[2][2][2];
#pragma unroll
  for (int tile = 0; tile < 2; ++tile)
#pragma unroll
    for (int s = 0; s < 2; ++s)
#pragma unroll
      for (int dt = 0; dt < 2; ++dt) {
        const u16* vp = Vs + (32 * dt + r) * 68 + 32 * tile + 16 * s + 4 * hf;
        vlo[tile][s][dt] = *(const uint2*)vp;
        vhi[tile][s][dt] = *(const uint2*)(vp + 8);
      }
  asm volatile("" ::: "memory");
#pragma unroll
  for (int tile = 0; tile < 2; ++tile)
#pragma unroll
    for (int s = 0; s < 2; ++s) {
      uint4 w;
      w.x = pack2(acc[tile][8 * s + 0], acc[tile][8 * s + 1]);
      w.y = pack2(acc[tile][8 * s + 2], acc[tile][8 * s + 3]);
      w.z = pack2(acc[tile][8 * s + 4], acc[tile][8 * s + 5]);
      w.w = pack2(acc[tile][8 * s + 6], acc[tile][8 * s + 7]);
      const bf16x8 pb = __builtin_bit_cast(bf16x8, w);
#pragma unroll
      for (int dt = 0; dt < 2; ++dt) {
        uint4 a;
        a.x = vlo[tile][s][dt].x; a.y = vlo[tile][s][dt].y; a.z = vhi[tile][s][dt].x; a.w = vhi[tile][s][dt].y;
        o[dt] = MFMA32(__builtin_bit_cast(bf16x8, a), pb, o[dt]);
      }
    }
}
constexpr float LOG2E = 1.4426950408889634f;
template <int DSTEP>
DI float dense_mask(f32x16 (&acc)[2], bool active, int lo_c, int hi_c, int dist0_c, int dmin_u, const float* btab_h, int lane) {
  const int hf = lane >> 5;
  const bool colfull = !active || (lo_c <= 0 && hi_c >= 63);
  float mx = -INFINITY;
  if (dmin_u >= 128 && __ballot(colfull) == ~0ull) {
    const float be = active ? btab_h[128] : -INFINITY;
#pragma unroll
    for (int tile = 0; tile < 2; ++tile)
#pragma unroll
      for (int i = 0; i < 16; ++i) {
        const float sv = fmaf(acc[tile][i], LOG2E, be);
        acc[tile][i] = sv;
        mx = fmaxf(mx, sv);
      }
  } else {
    const int lo2 = active ? lo_c : 1, hi2 = active ? hi_c : 0;
#pragma unroll
    for (int tile = 0; tile < 2; ++tile)
#pragma unroll
      for (int i = 0; i < 16; ++i) {
        const int kl = 32 * tile + (i & 3) + 8 * (i >> 2) + 4 * hf;
        int dc = dist0_c - DSTEP * kl;
        dc = dc < 0 ? 0 : (dc > 128 ? 128 : dc);
        const float bias = btab_h[dc];
        const float s2 = fmaf(acc[tile][i], LOG2E, bias);
        const float sv = (kl >= lo2 && kl <= hi2) ? s2 : -INFINITY;
        acc[tile][i] = sv;
        mx = fmaxf(mx, sv);
      }
  }
  return fmaxf(mx, __shfl_xor(mx, 32));
}
DI void dense_chunk(const u16* Ks, const u16* Vs, bool active, int lo_c, int hi_c, int dist0_c, int dmin_u, const bf16x8 (&qf)[4],
                    const float* btab_h, int lane, float& m, float& l, f32x16 (&o)[2]) {
  f32x16 acc[2];
  dense_scores(acc, Ks, qf, lane);
  const float mx = dense_mask<1>(acc, active, lo_c, hi_c, dist0_c, dmin_u, btab_h, lane);
  const float mn = fmaxf(m, mx);
  const float alpha = __builtin_amdgcn_exp2f(m - mn);
  float ls = 0.f;
#pragma unroll
  for (int tile = 0; tile < 2; ++tile)
#pragma unroll
    for (int i = 0; i < 16; ++i) {
      const float pv = __builtin_amdgcn_exp2f(acc[tile][i] - mn);
      acc[tile][i] = pv;
      ls += pv;
    }
  ls += __shfl_xor(ls, 32);
  l = l * alpha + ls;
  m = mn;
  o[0] *= alpha;
  o[1] *= alpha;
  dense_pv(acc, Vs, lane, o);
}

template <int KSG, int VSG, bool NEEDV, class Next, class Body>
DI void chunk_pipeline(char* stage, const u16* kg0, const u16* vg0, int first, int tid, const Next& next, const Body& body) {
  const int srow = tid >> 3, spiece = tid & 7;
  uint4 rk0, rv0;
  rv0 = make_uint4(0, 0, 0, 0);
  int d = first;
#define NSA_GLOAD(D)                                                                      \
  {                                                                                       \
    rk0 = *(const uint4*)(kg0 + ((long)(D) * 64 + srow) * KSG + spiece * 8);              \
    if (NEEDV) rv0 = *(const uint4*)(vg0 + (long)srow * VSG + (D) * 64 + spiece * 8);     \
  }
  if (d >= 0) NSA_GLOAD(d)
  int ph = 0;
  __syncthreads();
  while (d >= 0) {
    u16* Ks = (u16*)(stage + ph * NSA_STAGE_BYTES);
    u16* Vs = Ks + 64 * 72;
    *(uint4*)(Ks + srow * 72 + spiece * 8) = rk0;
    if (NEEDV) {
      uint2* dv = (uint2*)(Vs + srow * 68 + spiece * 8);
      dv[0] = make_uint2(rv0.x, rv0.y); dv[1] = make_uint2(rv0.z, rv0.w);
    }
    const int dn = next(d);
    if (dn >= 0) NSA_GLOAD(dn)
    __syncthreads();
    body(d, Ks, Vs);
    ph ^= 1;
    d = dn;
  }
#undef NSA_GLOAD
}

DI void nsa_item(const Params& p, char* smem, int item) {
  const int tid = TIDX8(), lane = tid & 63, wid = __builtin_amdgcn_readfirstlane(tid >> 6);
  const int chunk = item & 127, g = (item >> 7) & 1, b = item >> 8;
  const int bg = b * 2 + g;
  float* btab = (float*)smem;
  u64* wun = (u64*)(smem + 2304);
  float* imps = (float*)(smem + 4096) + wid * 1056;
  char* stage = smem + 37888;
  for (int idx = tid; idx < 4 * 129; idx += 512) {
    const int h = idx / 129, d = idx % 129;
    const int bk = d < 128 ? BUCKET[d] : 31;
    btab[h * 132 + d] = p.rel_bias[bk * 16 + g * 4 + h] * LOG2E;
  }
  __syncthreads();
  const int t0 = chunk * 64;
  const int tw = t0 + wid * 8;
  const int c = lane & 31, hf = lane >> 5, qi = c >> 2, hh = c & 3;
  const int t_c = tw + qi;
  const int cur = t0 >> 6;
  const long row = (long)b * T + t_c;
  const u16* prow = p.proj + row * LDP;
  const u16* projb = p.proj + (long)b * T * LDP;
  const float* btab_h = btab + hh * 132;
  bf16x8 qf[4];
#pragma unroll
  for (int ks = 0; ks < 4; ++ks) qf[ks] = *(const bf16x8*)(prow + C_QN + (g * 4 + hh) * 64 + ks * 16 + hf * 8);
  const u16* gptr = prow + C_GN + (g * 4 + hh) * 3;
  for (int k = lane; k < 1056; k += 64) imps[k] = 0.f;
  u16* orow = p.onsa + row * 512 + (g * 4 + hh) * 64 + 4 * hf;
  auto emit = [&](const f32x16 (&o)[2], float sc, bool first) {
#pragma unroll
    for (int dt = 0; dt < 2; ++dt)
#pragma unroll
      for (int q4 = 0; q4 < 4; ++q4) {
        uint2* dst = (uint2*)(orow + 32 * dt + 8 * q4);
        float v0 = o[dt][4 * q4 + 0] * sc, v1 = o[dt][4 * q4 + 1] * sc, v2 = o[dt][4 * q4 + 2] * sc, v3 = o[dt][4 * q4 + 3] * sc;
        if (!first) {
          const uint2 u = *dst;
          v0 += lo16(u.x); v1 += hi16(u.x); v2 += lo16(u.y); v3 += hi16(u.y);
        }
        uint2 w;
        w.x = pack2(v0, v1);
        w.y = pack2(v2, v3);
        *dst = w;
      }
  };
  const int ncv_c = (t_c >= 31) ? ((t_c - 31) >> 4) + 1 : 0;
  const int ncv_max = ((t0 + 63 - 31) >> 4) + 1;
  const int nchunk_c = (ncv_max + 63) >> 6;
  {
    const u16* kcb = p.kc + (long)bg * 512 * 64;
    const u16* vcb = p.vcT + (long)bg * 64 * 512;
    float m = -1e30f, l = 0.f;
    auto next_c = [&](int d) { return d + 1 < nchunk_c ? d + 1 : -1; };
    chunk_pipeline<64, 512, false>(stage, kcb, vcb, 0, tid, next_c, [&](int i, const u16* Ks, const u16* Vs) {
      f32x16 acc[2];
      dense_scores(acc, Ks, qf, lane);
      const float mx = dense_mask<16>(acc, true, 0, ncv_c - 1 - i * 64, t_c - 31 - 1024 * i, tw - 31 - 1024 * i - 1008, btab_h, lane);
      const float mn = fmaxf(m, mx);
      float ls = 0.f;
#pragma unroll
      for (int tile = 0; tile < 2; ++tile)
#pragma unroll
        for (int q = 0; q < 16; ++q) ls += __builtin_amdgcn_exp2f(acc[tile][q] - mn);
      ls += __shfl_xor(ls, 32);
      l = l * __builtin_amdgcn_exp2f(m - mn) + ls;
      m = mn;
    });
    const float invl = 1.f / fmaxf(l, 1e-30f);
    f32x16 oc[2];
#pragma unroll
    for (int i = 0; i < 16; ++i) { oc[0][i] = 0.f; oc[1][i] = 0.f; }
    chunk_pipeline<64, 512, true>(stage, kcb, vcb, 0, tid, next_c, [&](int i, const u16* Ks, const u16* Vs) {
      f32x16 acc[2];
      dense_scores(acc, Ks, qf, lane);
      (void)dense_mask<16>(acc, true, 0, ncv_c - 1 - i * 64, t_c - 31 - 1024 * i, tw - 31 - 1024 * i - 1008, btab_h, lane);
      float part[2][4], spill[2][4];
#pragma unroll
      for (int tile = 0; tile < 2; ++tile) {
#pragma unroll
        for (int q = 0; q < 16; ++q) acc[tile][q] = __builtin_amdgcn_exp2f(acc[tile][q] - m) * invl;
#pragma unroll
        for (int q4 = 0; q4 < 4; ++q4) {
          float pa = acc[tile][4 * q4] + acc[tile][4 * q4 + 1] + acc[tile][4 * q4 + 2] + 0.5f * acc[tile][4 * q4 + 3];
          float sp = 0.5f * acc[tile][4 * q4 + 3];
          pa += __shfl_xor(pa, 1); pa += __shfl_xor(pa, 2);
          sp += __shfl_xor(sp, 1); sp += __shfl_xor(sp, 2);
          part[tile][q4] = pa; spill[tile][q4] = sp;
        }
      }
      if (hh == 0) {
#pragma unroll
        for (int tile = 0; tile < 2; ++tile)
#pragma unroll
          for (int q4 = 0; q4 < 4; ++q4) imps[qi * 132 + 16 * i + 8 * tile + 2 * q4 + hf] += part[tile][q4];
      }
      wave_sync();
      if (hh == 0) {
#pragma unroll
        for (int tile = 0; tile < 2; ++tile)
#pragma unroll
          for (int q4 = 0; q4 < 4; ++q4) imps[qi * 132 + 16 * i + 8 * tile + 2 * q4 + hf + 1] += spill[tile][q4];
      }
      wave_sync();
      dense_pv(acc, Vs, lane, oc);
    });
    emit(oc, bf2f(gptr[0]), true);
  }
  wave_sync();
  u64 my0 = 0, my1 = 0, wu0 = 0, wu1 = 0;
  for (int q = 0; q < 8; ++q) {
    u64 mask0, mask1;
    if (cur <= 15) {
      mask0 = (2ull << cur) - 1ull;
      mask1 = 0ull;
    } else {
      const float imp_lo = imps[q * 132 + lane], imp_hi = imps[q * 132 + lane + 64];
      const int jl = lane, jh = lane + 64;
      float c0 = (jl >= 1 && jl <= cur - 2) ? imp_lo : -1.f;
      float c1 = (jh <= cur - 2) ? imp_hi : -1.f;
      bool sel_lo = (jl == 0) || (jl == cur) || (jl == cur - 1);
      bool sel_hi = (jh == cur) || (jh == cur - 1);
      for (int r = 0; r < 13; ++r) {
        float bv; int bj;
        if (c0 >= c1) { bv = c0; bj = jl; } else { bv = c1; bj = jh; }
        wave_argmax(bv, bj);
        if (bj == jl) { sel_lo = true; c0 = -1.f; }
        if (bj == jh) { sel_hi = true; c1 = -1.f; }
      }
      mask0 = __ballot(sel_lo);
      mask1 = __ballot(sel_hi);
    }
    if (qi == q) { my0 = mask0; my1 = mask1; }
    wu0 |= mask0; wu1 |= mask1;
  }
  if (lane == 0) { wun[wid * 2] = wu0; wun[wid * 2 + 1] = wu1; }
  __syncthreads();
  u64 bu0 = wun[0] | wun[2] | wun[4] | wun[6] | wun[8] | wun[10] | wun[12] | wun[14];
  u64 bu1 = wun[1] | wun[3] | wun[5] | wun[7] | wun[9] | wun[11] | wun[13] | wun[15];
  bu0 = ((u64)(unsigned)__builtin_amdgcn_readfirstlane((int)(bu0 >> 32)) << 32) | (unsigned)__builtin_amdgcn_readfirstlane((int)bu0);
  bu1 = ((u64)(unsigned)__builtin_amdgcn_readfirstlane((int)(bu1 >> 32)) << 32) | (unsigned)__builtin_amdgcn_readfirstlane((int)bu1);
  {
    float m = -1e30f, l = 0.f;
    f32x16 o[2];
#pragma unroll
    for (int i = 0; i < 16; ++i) { o[0][i] = 0.f; o[1][i] = 0.f; }
    const int kcol = C_KV + 2 * 128 + g * 64;
    auto next_s = [&](int j) {
      ++j;
      if (j < 64) {
        const u64 mm = bu0 & (~0ull << j);
        if (mm) return (int)__builtin_ctzll(mm);
        j = 64;
      }
      if (j >= 128) return -1;
      const u64 mm = bu1 & (~0ull << (j - 64));
      return mm ? 64 + (int)__builtin_ctzll(mm) : -1;
    };
    chunk_pipeline<LDP, T, true>(stage, projb + kcol, p.vts + (long)bg * 64 * T, 0, tid, next_s, [&](int j, const u16* Ks, const u16* Vs) {
      const bool bit = ((j < 64 ? (my0 >> j) : (my1 >> (j - 64))) & 1ull) != 0;
      if (__ballot(bit) != 0ull) {
        const int pos0 = 64 * j;
        dense_chunk(Ks, Vs, bit, 0, t_c - pos0, t_c - pos0, tw - pos0 - 63, qf, btab_h, lane, m, l, o);
      }
    });
    emit(o, bf2f(gptr[1]) / fmaxf(l, 1e-30f), false);
  }
  {
    float m = -1e30f, l = 0.f;
    f32x16 o[2];
#pragma unroll
    for (int i = 0; i < 16; ++i) { o[0][i] = 0.f; o[1][i] = 0.f; }
    const int kcol = C_KV + 4 * 128 + g * 64;
    const int wlo_c = t_c - 511 < 0 ? 0 : t_c - 511;
    const int wlo_min = t0 - 511 < 0 ? 0 : t0 - 511;
    auto next_w = [&](int j) { return j + 1 <= cur ? j + 1 : -1; };
    chunk_pipeline<LDP, T, true>(stage, projb + kcol, p.vtw + (long)bg * 64 * T, wlo_min >> 6, tid, next_w, [&](int jw, const u16* Ks, const u16* Vs) {
      const int pos0 = 64 * jw;
      const int lo_c = wlo_c - pos0 < 0 ? 0 : wlo_c - pos0;
      dense_chunk(Ks, Vs, true, lo_c, t_c - pos0, t_c - pos0, tw - pos0 - 63, qf, btab_h, lane, m, l, o);
    });
    emit(o, bf2f(gptr[2]) / fmaxf(l, 1e-30f), false);
  }
}

DI unsigned f2ord(float v) { const unsigned u = __float_as_uint(v); return (u & 0x80000000u) ? ~u : (u | 0x80000000u); }

DI void topk_row(const Params& p, int b, int t, int lane) {
  const long row = (long)b * T + t;
  int* dst = p.selk + row * 256;
  if (t < 256) {
#pragma unroll
    for (int i = 0; i < 4; ++i) { const int s = i * 64 + lane; dst[s] = (s <= t) ? s : -1; }
    return;
  }
  const u16* srow = (const u16*)p.scores + row * T;
  const int ngrp = (t >> 10) + 1;
  unsigned u[128];
  int ln = lane;
  asm volatile("" : "+v"(ln));
#pragma unroll
  for (int gq = 0; gq < 8; ++gq) {
    if (gq < ngrp) {
#pragma unroll
      for (int j = 0; j < 16; ++j) {
        const int s = (gq * 16 + j) * 64 + ln;
        u[gq * 16 + j] = srow[s < t ? s : t];
      }
    } else {
#pragma unroll
      for (int j = 0; j < 16; ++j) u[gq * 16 + j] = 0u;
    }
  }
  asm volatile("" ::: "memory");
#pragma unroll
  for (int gq = 0; gq < 8; ++gq) {
    if (gq < ngrp) {
#pragma unroll
      for (int j = 0; j < 16; ++j) {
        const int s = (gq * 16 + j) * 64 + ln;
        { const unsigned h_ = u[gq * 16 + j]; u[gq * 16 + j] = (s <= t) ? ((h_ & 0x8000u) ? (~h_ & 0xFFFFu) : (h_ | 0x8000u)) : 0u; }
      }
    }
  }
  const int nlane = 16 * ngrp;
  unsigned m0 = 0u, m1 = 0u, m2 = 0u, m3 = 0u;
#pragma unroll
  for (int gq = 0; gq < 8; ++gq) {
    if (gq < ngrp) {
#pragma unroll
      for (int j = 0; j < 16; j += 4) {
        m0 = max(m0, u[gq * 16 + j]); m1 = max(m1, u[gq * 16 + j + 1]); m2 = max(m2, u[gq * 16 + j + 2]); m3 = max(m3, u[gq * 16 + j + 3]);
      }
    }
  }
  unsigned lo = wave_min_u(min(min(m0, m1), min(m2, m3)));
  unsigned hi = wave_max_u(max(max(m0, m1), max(m2, m3))) + 1u;
#define TOPK_COUNT_GE(PIV, OUT)                                                         \
  {                                                                                     \
    unsigned below_ = 0;     \
    _Pragma("unroll") for (int gq = 0; gq < 8; ++gq) {                                  \
      if (gq < ngrp) {                                                                  \
        _Pragma("unroll") for (int j = 0; j < 16; ++j) below_ += (u[gq * 16 + j] - (PIV)) >> 31; \
      }                                                                                 \
    }                                                                                   \
    OUT = wave_sum_i(nlane - (int)below_);                                              \
  }
  int c_lo, c_hi = 0;
  TOPK_COUNT_GE(lo, c_lo)
  int iter = 0;
  while (c_lo != 256 && hi - lo > 1u) {
    const unsigned span = hi - lo;
    unsigned step;
    if ((++iter & 3) == 0) step = span >> 1;
    else step = (unsigned)((float)span * ((float)(c_lo - 256) / (float)(c_lo - c_hi)));
    step = step < 1u ? 1u : (step > span - 1u ? span - 1u : step);
    const unsigned piv = lo + step;
    int c;
    TOPK_COUNT_GE(piv, c)
    if (c >= 256) { lo = piv; c_lo = c; } else { hi = piv; c_hi = c; }
  }
#undef TOPK_COUNT_GE
  const unsigned thr = lo;
  int ngt = 0;
#pragma unroll
  for (int gq = 0; gq < 8; ++gq) {
    if (gq < ngrp) {
#pragma unroll
      for (int j = 0; j < 16; ++j) ngt += __popcll(__ballot(u[gq * 16 + j] > thr));
    }
  }
  int base_gt = 0, base_eq = 0;
  const int need_eq = 256 - ngt;
  int ln2 = lane;
  asm volatile("" : "+v"(ln2));
#pragma unroll
  for (int gq = 0; gq < 8; ++gq) {
    if (gq < ngrp) {
#pragma unroll
      for (int j = 0; j < 16; ++j) {
        const int s = (gq * 16 + j) * 64 + ln2;
        const unsigned uv = u[gq * 16 + j];
        const bool gt = uv > thr, eq = uv == thr;
        const u64 mg = __ballot(gt), me = __ballot(eq);
        const int pg = __builtin_amdgcn_mbcnt_hi((unsigned)(mg >> 32), __builtin_amdgcn_mbcnt_lo((unsigned)mg, 0));
        const int pe = __builtin_amdgcn_mbcnt_hi((unsigned)(me >> 32), __builtin_amdgcn_mbcnt_lo((unsigned)me, 0));
        if (gt) dst[base_gt + pg] = s;
        if (eq && (base_eq + pe) < need_eq) dst[ngt + base_eq + pe] = s;
        base_gt += __popcll(mg);
        base_eq += __popcll(me);
      }
    }
  }
}

DI void phase6(const Params& p, char* smem, int bid, int nblk);
DI void phase5_nsa8(const Params& p) {
  for (int item = blockIdx.x; item < 512; item += gridDim.x) {
    __syncthreads();
    const int it = item < 256 ? 511 - item : item - 256;
    const int chunk = it >> 2, bgi = it & 3;
    nsa_item(p, g_smem, (bgi << 7) | chunk);
  }
  __syncthreads();
}
DI void phase5(const Params& p, char* smem, int bid, int nblk) {
  hb_sync();
  phase6(p, smem, bid, nblk);
}

DI void tr_read2(unsigned a0, unsigned a1, uint2& r0, uint2& r1) {
  asm volatile("ds_read_b64_tr_b16 %0, %2\n\tds_read_b64_tr_b16 %1, %3\n\ts_waitcnt lgkmcnt(0)" : "=&v"(r0), "=&v"(r1) : "v"(a0), "v"(a1) : "memory");
}
DI void tr_read4(unsigned a0, unsigned a1, unsigned a2, unsigned a3, uint2& r0, uint2& r1, uint2& r2, uint2& r3) {
  asm volatile("ds_read_b64_tr_b16 %0, %4\n\tds_read_b64_tr_b16 %1, %5\n\tds_read_b64_tr_b16 %2, %6\n\tds_read_b64_tr_b16 %3, %7\n\ts_waitcnt lgkmcnt(0)"
               : "=&v"(r0), "=&v"(r1), "=&v"(r2), "=&v"(r3) : "v"(a0), "v"(a1), "v"(a2), "v"(a3) : "memory");
}
DI void dsa_query(const Params& p, u16* Cs, const float* btab, int b, int t, int lane) {
  const long row = (long)b * T + t;
  const int lg = lane >> 4, r16 = lane & 15, hh = lane & 7;
  bf16x8 qf[4];
#pragma unroll
  for (int ks = 0; ks < 4; ++ks) {
    bf16x8 z = {0, 0, 0, 0, 0, 0, 0, 0};
    if (r16 < 8) z = *(const bf16x8*)(p.qlat + (row * 8 + r16) * 128 + ks * 32 + lg * 8);
    qf[ks] = z;
  }
  const u16* ckvb = p.ckv + (long)b * T * 128;
  const int nvalid = (t + 1) < 256 ? (t + 1) : 256;
  float m = -1e30f, l = 0.f;
  f32x4 o[8];
#pragma unroll
  for (int ct = 0; ct < 8; ++ct) o[ct] = (f32x4){0.f, 0.f, 0.f, 0.f};
  const unsigned cs_base = (unsigned)(size_t)Cs;
  const int nch = (nvalid + 31) >> 5;
  uint4 gv0, gv1, gv2, gv3, gv4, gv5, gv6, gv7;
  int kidx_n;
#define DSA_G1(V, I) { const int kr_ = __shfl(kidx_n, 4 * (I) + lg); V = *(const uint4*)(ckvb + (long)kr_ * 128 + r16 * 8); }
#define DSA_GATHER(CH)                                                            \
  {                                                                               \
    const int nv_ = (nvalid - (CH) * 32) > 32 ? 32 : (nvalid - (CH) * 32);        \
    kidx_n = p.selk[row * 256 + (CH) * 32 + (lane & 31)];                         \
    if ((lane & 31) >= nv_ || kidx_n < 0 || kidx_n > t) kidx_n = t;               \
    DSA_G1(gv0, 0) DSA_G1(gv1, 1) DSA_G1(gv2, 2) DSA_G1(gv3, 3) DSA_G1(gv4, 4) DSA_G1(gv5, 5) DSA_G1(gv6, 6) DSA_G1(gv7, 7) \
  }
  DSA_GATHER(0)
  for (int ch = 0; ch < nch; ++ch) {
    const int nval = (nvalid - ch * 32) > 32 ? 32 : (nvalid - ch * 32);
    const int kidx = kidx_n;
    wave_sync();
    {
      u16* d_ = Cs + lg * 144 + r16 * 8;
      *(uint4*)(d_) = gv0;            *(uint4*)(d_ + 4 * 144) = gv1;  *(uint4*)(d_ + 8 * 144) = gv2;  *(uint4*)(d_ + 12 * 144) = gv3;
      *(uint4*)(d_ + 16 * 144) = gv4; *(uint4*)(d_ + 20 * 144) = gv5; *(uint4*)(d_ + 24 * 144) = gv6; *(uint4*)(d_ + 28 * 144) = gv7;
    }
    { const int chn = ch + 1 < nch ? ch + 1 : nch - 1; DSA_GATHER(chn) }
    wave_sync();
    f32x4 acc[2];
#pragma unroll
    for (int rt = 0; rt < 2; ++rt) {
      const u16* kp = Cs + (16 * rt + r16) * 144 + 8 * lg;
      f32x4 c = {0.f, 0.f, 0.f, 0.f};
#pragma unroll
      for (int ks = 0; ks < 4; ++ks) c = MFMA16(*(const bf16x8*)(kp + 32 * ks), qf[ks], c);
      acc[rt] = c;
    }
    float mx = -INFINITY;
#pragma unroll
    for (int rt = 0; rt < 2; ++rt)
#pragma unroll
      for (int r = 0; r < 4; ++r) {
        const int pl = 16 * rt + 4 * lg + r;
        const int kk = __shfl(kidx, pl);
        int dc = t - kk;
        dc = dc < 0 ? 0 : (dc > 128 ? 128 : dc);
        const float sv = (pl < nval) ? fmaf(acc[rt][r], LOG2E, btab[hh * 132 + dc]) : -INFINITY;
        acc[rt][r] = sv;
        mx = fmaxf(mx, sv);
      }
    mx = fmaxf(mx, __shfl_xor(mx, 16));
    mx = fmaxf(mx, __shfl_xor(mx, 32));
    const float mn = fmaxf(m, mx);
    const float alpha = __builtin_amdgcn_exp2f(m - mn);
    float ls = 0.f;
#pragma unroll
    for (int rt = 0; rt < 2; ++rt)
#pragma unroll
      for (int r = 0; r < 4; ++r) {
        const float pv = __builtin_amdgcn_exp2f(acc[rt][r] - mn);
        acc[rt][r] = pv;
        ls += pv;
      }
    ls += __shfl_xor(ls, 16);
    ls += __shfl_xor(ls, 32);
    l = l * alpha + ls;
    m = mn;
    uint4 pw;
    pw.x = pack2(acc[0][0], acc[0][1]);
    pw.y = pack2(acc[0][2], acc[0][3]);
    pw.z = pack2(acc[1][0], acc[1][1]);
    pw.w = pack2(acc[1][2], acc[1][3]);
    const bf16x8 pb = __builtin_bit_cast(bf16x8, pw);
    const unsigned a_lo = cs_base + (unsigned)(((4 * lg + (r16 >> 2)) * 144 + 4 * (r16 & 3)) * 2);
    const unsigned a_hi = a_lo + 16 * 144 * 2;
#pragma unroll
    for (int ct = 0; ct < 8; ct += 2) {
      uint2 lo0, hi0, lo1, hi1;
      tr_read4(a_lo + ct * 32, a_hi + ct * 32, a_lo + ct * 32 + 32, a_hi + ct * 32 + 32, lo0, hi0, lo1, hi1);
      uint4 aw0, aw1;
      aw0.x = lo0.x; aw0.y = lo0.y; aw0.z = hi0.x; aw0.w = hi0.y;
      aw1.x = lo1.x; aw1.y = lo1.y; aw1.z = hi1.x; aw1.w = hi1.y;
      o[ct] = o[ct] * alpha;
      o[ct + 1] = o[ct + 1] * alpha;
      o[ct] = MFMA16(__builtin_bit_cast(bf16x8, aw0), pb, o[ct]);
      o[ct + 1] = MFMA16(__builtin_bit_cast(bf16x8, aw1), pb, o[ct + 1]);
    }
  }
#undef DSA_GATHER
#undef DSA_G1
  const float invl = 1.f / fmaxf(l, 1e-30f);
  if (r16 < 8) {
#pragma unroll
    for (int ct = 0; ct < 8; ++ct)
      *(uint2*)(p.olat + row * 1024 + r16 * 128 + 16 * ct + 4 * lg) = pack4(o[ct][0] * invl, o[ct][1] * invl, o[ct][2] * invl, o[ct][3] * invl);
  }
}
DI void phase6(const Params& p, char* smem, int bid, int nblk) {
  const int tid = TIDX(), lane = tid & 63, wid = __builtin_amdgcn_readfirstlane(tid >> 6);
  float* btab = (float*)smem;
  u16* Cs = (u16*)(smem + 8192) + wid * (32 * 144);
  for (int idx = tid; idx < 8 * 129; idx += 256) {
    const int h = idx / 129, d = idx % 129;
    const int bk = d < 128 ? BUCKET[d] : 31;
    btab[h * 132 + d] = p.rel_bias[bk * 16 + 8 + h] * LOG2E;
  }
  hb_sync();
  for (int item = bid; item < 2048; item += nblk) {
    const int it = item < 1024 ? 2047 - item : item - 1024;
    const int b = it & 1, tb = it >> 1;
    for (int q = 0; q < 2; ++q) dsa_query(p, Cs, btab, b, tb * 8 + wid * 2 + q, lane);
  }
}

struct EpiOdsa {
  u16* odsa; int h, m0;
  DI void operator()(f32x16 (&acc)[2][2], int wm, int wn, int lane) const {
    constexpr int MT = 2;
    SW_FOR {
      const int r = m0 + SW_R, c = SW_C0;
      if (c < 64) *(uint2*)(odsa + (long)r * 512 + h * 64 + c) = pack4(SW_V(0), SW_V(1), SW_V(2), SW_V(3));
    }
  }
};
DI void phase7(const Params& p, char* smem, int bid, int nblk) {
  for (int item = bid; item < 1024; item += nblk) {
    const int h = item & 7, mt_ = item >> 3;
    ARows af{p.olat + (long)mt_ * 128 * 1024 + h * 128, 1024, 128};
    BMat bf{p.dsa_w_uv + h * 64, 512, 64};
    EpiOdsa ef{p.odsa, h, mt_ * 128};
    gemm_tile(smem, 2, 64, af, bf, ef);
  }
}

struct EpiY {
  u16* y; const u16* proj; int m0, n0, second;
  template <int MT> DI void operator()(f32x16 (&acc)[MT][2], int wm, int wn, int lane) const {
    SW_FOR {
      const int r = m0 + SW_R, c = n0 + SW_C0;
      const uint2 gu = *(const uint2*)(proj + (long)r * LDP + C_GM + second * 1024 + c);
      float v0 = lo16(gu.x) * SW_V(0), v1 = hi16(gu.x) * SW_V(1), v2 = lo16(gu.y) * SW_V(2), v3 = hi16(gu.y) * SW_V(3);
      uint2* dst = (uint2*)(y + (long)r * 1024 + c);
      if (second) {
        const uint2 yu = *dst;
        v0 += lo16(yu.x); v1 += hi16(yu.x); v2 += lo16(yu.y); v3 += hi16(yu.y);
      }
      *dst = pack4(v0, v1, v2, v3);
    }
  }
};
struct Epi8Y {
  u16* y; const u16* proj; int m0, n0, second;
  DI void operator()(int q, int c, float v0, float v1, float v2, float v3) const {
    const long r = m0 + q; const int cc = n0 + c;
    const uint2 gu = *(const uint2*)(proj + r * LDP + C_GM + second * 1024 + cc);
    v0 *= lo16(gu.x); v1 *= hi16(gu.x); v2 *= lo16(gu.y); v3 *= hi16(gu.y);
    uint2* dst = (uint2*)(y + r * 1024 + cc);
    if (second) {
      const uint2 yu = *dst;
      v0 += lo16(yu.x); v1 += hi16(yu.x); v2 += lo16(yu.y); v3 += hi16(yu.y);
    }
    *dst = pack4(v0, v1, v2, v3);
  }
};
DI void phase8_8w(const Params& p, int wg, int nwg) {
  for (int item = wg; item < 256; item += nwg) {
    const int x_ = item & 7, s_ = item >> 3, nt_ = s_ & 3, mt_ = x_ * 8 + (s_ >> 2);
    {
      ARows wf{p.w_bnT + (long)nt_ * 256 * 512, 512, 256};
      ARows xf{p.onsa + (long)mt_ * 256 * 512, 512, 256};
      Epi8Y ef{p.y, p.proj, mt_ * 256, nt_ * 256, 0};
      gemm8p(8, wf, xf, ef);
    }
    {
      ARows wf{p.w_bdT + (long)nt_ * 256 * 512, 512, 256};
      ARows xf{p.odsa + (long)mt_ * 256 * 512, 512, 256};
      Epi8Y ef{p.y, p.proj, mt_ * 256, nt_ * 256, 1};
      gemm8p(8, wf, xf, ef);
    }
  }
}
struct EpiStoreBf {
  u16* dst; long ld; int m0, n0;
  template <int MT> DI void operator()(f32x16 (&acc)[MT][2], int wm, int wn, int lane) const {
    SW_FOR { *(uint2*)(dst + (long)(m0 + SW_R) * ld + n0 + SW_C0) = pack4(SW_V(0), SW_V(1), SW_V(2), SW_V(3)); }
  }
};
struct Epi8StoreBf {
  u16* dst; long ld; int m0, n0;
  DI void operator()(int q, int c, float v0, float v1, float v2, float v3) const { *(uint2*)(dst + (long)(m0 + q) * ld + n0 + c) = pack4(v0, v1, v2, v3); }
};
DI void phase9_8w(const Params& p, int wg, int nwg) {
  for (int item = wg; item < 256; item += nwg) {
    const int x_ = item & 7, s_ = item >> 3, nt_ = s_ & 3, mt_ = x_ * 8 + (s_ >> 2);
    ARows wf{p.w_outT + (long)nt_ * 256 * 1024, 1024, 256};
    ARows xf{p.y + (long)mt_ * 256 * 1024, 1024, 256};
    Epi8StoreBf ef{p.z, 1024, mt_ * 256, nt_ * 256};
    gemm8p(16, wf, xf, ef);
  }
}

DI void phase10(const Params& p, int bid, int nblk) {
  const int tid = TIDX(), lane = tid & 63, wid = __builtin_amdgcn_readfirstlane(tid >> 6);
  const int b = bid & 1;
  const float* modb = p.mod + b * 6144;
  float cz[16], cm[16], ca[16];
#pragma unroll
  for (int i = 0; i < 4; ++i) {
    const int col = i * 256 + lane * 4;
    const float4 gt = *(const float4*)(modb + 2048 + col), gp = *(const float4*)(p.g_post_mix + col);
    const float4 gf = *(const float4*)(p.g_pre_ffn + col), sc = *(const float4*)(modb + 4096 + col), sh = *(const float4*)(modb + 3072 + col);
    cz[i * 4 + 0] = gt.x * gp.x; cz[i * 4 + 1] = gt.y * gp.y; cz[i * 4 + 2] = gt.z * gp.z; cz[i * 4 + 3] = gt.w * gp.w;
    cm[i * 4 + 0] = gf.x * (1.f + sc.x); cm[i * 4 + 1] = gf.y * (1.f + sc.y); cm[i * 4 + 2] = gf.z * (1.f + sc.z); cm[i * 4 + 3] = gf.w * (1.f + sc.w);
    ca[i * 4 + 0] = sh.x; ca[i * 4 + 1] = sh.y; ca[i * 4 + 2] = sh.z; ca[i * 4 + 3] = sh.w;
  }
  const int stride = (nblk >> 1) * 4;
  for (int t0 = (bid >> 1) * 4 + wid; t0 < T; t0 += 2 * stride) {
    uint2 zu[2][4]; float4 xx[2][4];
#pragma unroll
    for (int k = 0; k < 2; ++k) {
      const int t = t0 + k * stride < T ? t0 + k * stride : T - 1;
      const long row = (long)b * T + t;
#pragma unroll
      for (int i = 0; i < 4; ++i) {
        zu[k][i] = *(const uint2*)(p.z + row * 1024 + i * 256 + lane * 4);
        xx[k][i] = *(const float4*)(p.x + row * 1024 + i * 256 + lane * 4);
      }
    }
#pragma unroll
    for (int k = 0; k < 2; ++k) {
      float zv[16], xv[16];
      float ss = 0.f;
#pragma unroll
      for (int i = 0; i < 4; ++i) {
        zv[i * 4 + 0] = lo16(zu[k][i].x); zv[i * 4 + 1] = hi16(zu[k][i].x); zv[i * 4 + 2] = lo16(zu[k][i].y); zv[i * 4 + 3] = hi16(zu[k][i].y);
        xv[i * 4 + 0] = xx[k][i].x; xv[i * 4 + 1] = xx[k][i].y; xv[i * 4 + 2] = xx[k][i].z; xv[i * 4 + 3] = xx[k][i].w;
#pragma unroll
        for (int j = 0; j < 4; ++j) ss += zv[i * 4 + j] * zv[i * 4 + j];
      }
      ss = wave_sum(ss);
      const float r = rsqrtf(ss * (1.f / 1024.f) + 1e-6f);
      float ss2 = 0.f;
#pragma unroll
      for (int j = 0; j < 16; ++j) {
        const float v = xv[j] + cz[j] * (zv[j] * r);
        xv[j] = v;
        ss2 += v * v;
      }
      ss2 = wave_sum(ss2);
      const float r2 = rsqrtf(ss2 * (1.f / 1024.f) + 1e-6f);
      if (t0 + k * stride < T) {
        const long row = (long)b * T + t0 + k * stride;
#pragma unroll
        for (int i = 0; i < 4; ++i) {
          const int col = i * 256 + lane * 4;
          *(float4*)(p.x1 + row * 1024 + col) = make_float4(xv[i * 4], xv[i * 4 + 1], xv[i * 4 + 2], xv[i * 4 + 3]);
          *(uint2*)(p.h + row * 1024 + col) = pack4(xv[i * 4] * r2 * cm[i * 4] + ca[i * 4], xv[i * 4 + 1] * r2 * cm[i * 4 + 1] + ca[i * 4 + 1],
                                                    xv[i * 4 + 2] * r2 * cm[i * 4 + 2] + ca[i * 4 + 2], xv[i * 4 + 3] * r2 * cm[i * 4 + 3] + ca[i * 4 + 3]);
        }
      }
    }
  }
}

struct EpiStoreF32 {
  float* dst; long ld; int m0, n0;
  DI void operator()(f32x16 (&acc)[2][2], int wm, int wn, int lane) const {
    constexpr int MT = 2;
    SW_FOR { *(float4*)(dst + (long)(m0 + SW_R) * ld + n0 + SW_C0) = make_float4(SW_V(0), SW_V(1), SW_V(2), SW_V(3)); }
  }
};
DI void phase11(const Params& p, char* smem, int bid, int nblk) {
  for (int item = bid; item < 256; item += nblk) {
    const int nt_ = item & 1, mt_ = item >> 1;
    ARows af{p.h + (long)mt_ * 128 * 1024, 1024, 128};
    BMatT bf{p.routerT + (long)nt_ * 128 * 1024, 1024};
    EpiStoreF32 ef{p.logits, 256, mt_ * 128, nt_ * 128};
    gemm_tile<true, false, true>(smem, 16, 64, af, bf, ef);
  }
}
DI void phase12(const Params& p, int bid, int nblk) {
  const int tid = TIDX(), lane = tid & 63, wid = __builtin_amdgcn_readfirstlane(tid >> 6);
  for (int tok = bid * 4 + wid; tok < NTOK; tok += nblk * 4) {
    const float4 lg = *(const float4*)(p.logits + (long)tok * 256 + lane * 4);
    const float4 rbv = *(const float4*)(p.router_bias + lane * 4);
    float sg[4] = {sigmoidf(lg.x), sigmoidf(lg.y), sigmoidf(lg.z), sigmoidf(lg.w)};
    float sl[4] = {sg[0] + rbv.x, sg[1] + rbv.y, sg[2] + rbv.z, sg[3] + rbv.w};
    float t1 = fmaxf(sl[0], sl[1]), t2 = fminf(sl[0], sl[1]);
#pragma unroll
    for (int j = 2; j < 4; ++j) {
      const float v = sl[j];
      t2 = fmaxf(t2, fminf(t1, v));
      t1 = fmaxf(t1, v);
    }
#define R_MERGE(CTRL)                                                                                                            \
    {                                                                                                                            \
      const float a1 = __int_as_float(__builtin_amdgcn_update_dpp(0, __float_as_int(t1), CTRL, 0xF, 0xF, true));                 \
      const float a2 = __int_as_float(__builtin_amdgcn_update_dpp(0, __float_as_int(t2), CTRL, 0xF, 0xF, true));                 \
      const float n1 = fmaxf(t1, a1);                                                                                            \
      const float n2 = fmaxf(fminf(t1, a1), fmaxf(t2, a2));                                                                      \
      t1 = n1; t2 = n2;                                                                                                          \
    }
    R_MERGE(DPP_QP1) R_MERGE(DPP_QP2) R_MERGE(DPP_RHM)
#undef R_MERGE
    const float gscore = t1 + t2;
    const int grp = lane >> 3;
    int rank = 0;
#pragma unroll
    for (int g2 = 0; g2 < 8; ++g2) {
      const float og = rdlane(gscore, g2 * 8);
      rank += (og > gscore || (og == gscore && g2 < grp)) ? 1 : 0;
    }
    const bool gsel = rank < 4;
    float cv[4];
#pragma unroll
    for (int j = 0; j < 4; ++j) cv[j] = gsel ? sl[j] : -1e30f;
    int my_e = -1; float my_s = 0.f; float ssum = 0.f;
    for (int r = 0; r < 8; ++r) {
      float bv = cv[0]; int bj = 0;
#pragma unroll
      for (int j = 1; j < 4; ++j) if (cv[j] > bv) { bv = cv[j]; bj = j; }
      int be = lane * 4 + bj;
      wave_argmax(bv, be);
      const int wl_ = be >> 2, wj = be & 3;
      const float s0 = rdlane(sg[0], wl_), s1 = rdlane(sg[1], wl_), s2 = rdlane(sg[2], wl_), s3 = rdlane(sg[3], wl_);
      const float bs = wj == 0 ? s0 : (wj == 1 ? s1 : (wj == 2 ? s2 : s3));
      if (wl_ == lane) {
        if (wj == 0) cv[0] = -3e30f; else if (wj == 1) cv[1] = -3e30f; else if (wj == 2) cv[2] = -3e30f; else cv[3] = -3e30f;
      }
      if (lane == r) { my_e = be; my_s = bs; }
      ssum += bs;
    }
    if (lane < 8) {
      const float w = my_s / ssum * 2.5f;
      const int rk = atomicAdd(p.counts + my_e * 32, 1);
      p.eidx[tok * 8 + lane] = my_e;
      p.ewt[tok * 8 + lane] = w;
      p.erank[tok * 8 + lane] = rk;
    }
  }
}
DI void phase14(const Params& p, char* smem, int bid, int nblk) {
  const int tid = TIDX();
  int* s_cnt = (int*)smem;
  int* s_off = s_cnt + 256;
  const int cnt = p.counts[tid * 32];
  s_cnt[tid] = cnt;
  hb_sync();
  int run = 0, nt = 0, nt2 = 0;
  for (int e = 0; e < tid; ++e) { const int c = s_cnt[e]; run += c; nt += (c + 127) >> 7; nt2 += (c + 255) >> 8; }
  s_off[tid] = run;
  hb_sync();
  if (bid == 0) {
    p.offs[tid] = run;
    for (int m = 0; m * 256 < cnt; ++m) {
      p.tile2_e[nt2] = tid;
      p.tile2_r0[nt2] = run + m * 256;
      p.tile2_nr[nt2] = (cnt - m * 256) > 256 ? 256 : (cnt - m * 256);
      ++nt2;
    }
    for (int m = 0; m * 128 < cnt; ++m) {
      p.tile_e[nt] = tid;
      p.tile_r0[nt] = run + m * 128;
      p.tile_nr[nt] = (cnt - m * 128) > 128 ? 128 : (cnt - m * 128);
      ++nt;
    }
    if (tid == 255) {
      p.offs[256] = run + cnt;
      for (int m = 0; m < 128; ++m) {
        p.tile_e[nt] = 256;
        p.tile_r0[nt] = 131072 + m * 128;
        p.tile_nr[nt] = 128;
        ++nt;
      }
      p.ntiles[0] = nt;
      for (int m = 0; m < 64; ++m) {
        p.tile2_e[nt2] = 256;
        p.tile2_r0[nt2] = 131072 + m * 256;
        p.tile2_nr[nt2] = 256;
        ++nt2;
      }
      p.ntiles[1] = nt2;
    }
  }
  for (int i = bid * 256 + tid; i < NSLOT; i += nblk * 256) {
    if (i < 131072) {
      const int e = p.eidx[i];
      const int slot = s_off[e] + p.erank[i];
      p.slot_tok[slot] = i >> 3;
      p.slot_wt[slot] = p.ewt[i];
      p.tok_slot[i] = slot;
    } else {
      p.slot_tok[i] = i - 131072;
      p.slot_wt[i] = 1.f;
    }
  }
}

struct AGather {
  const u16* h; const int* slot_tok; int r0, nr;
  DI const u16* operator()(int r) const { return h + (long)slot_tok[r0 + (r < nr ? r : 0)] * 1024; }
  DI const u16* origin() const { return h; } DI int off(int r) const { return slot_tok[r0 + (r < nr ? r : 0)] * 1024; }
};
struct BGateUp {
  const float* wg; long udiff; long ldb; int n0;
  DI const float* operator()(int c4) const {
    const int wn = c4 >> 6, ntl = (c4 >> 5) & 1, j = c4 & 31;
    return wg + (long)ntl * udiff + n0 + wn * 32 + j;
  }
  DI const u16* row(int) const { return nullptr; }
};
struct EpiH {
  u16* H; int r0, nr, n0;
  template <int MT> DI void operator()(f32x16 (&acc)[MT][2], int wm, int wn, int lane) const {
#pragma unroll
    for (int mt = 0; mt < MT; ++mt) {
      const int r = SW_R;
      if (r < nr) {
#pragma unroll
        for (int q4 = 0; q4 < 4; ++q4) {
          float v[4];
#pragma unroll
          for (int j = 0; j < 4; ++j) v[j] = siluf(acc[mt][0][4 * q4 + j]) * acc[mt][1][4 * q4 + j];
          *(uint2*)(H + (long)(r0 + r) * 256 + n0 + wn * 32 + 8 * q4 + 4 * (lane >> 5)) = pack4(v[0], v[1], v[2], v[3]);
        }
      }
    }
  }
};
struct BGateUp8 {
  const float* wg; long udiff; long ldb; int n0;
  DI const float* operator()(int c4) const {
    const int wn = c4 >> 6, ntl = (c4 >> 5) & 1, j = c4 & 31;
    return wg + (long)ntl * udiff + n0 + wn * 32 + j;
  }
};
DI void phase15_8w(const Params& p, int wg, int nwg) {
  const int ntl = p.ntiles[1];
  const int nit = ntl * 2, nrounds = (nit + 255) >> 8;
  for (int i = wg; i < nrounds * 256; i += nwg) {
    const int item = ((((i >> 8) << 3) + (i & 7)) << 5) + ((i >> 3) & 31);
    if (item >= nit) continue;
    const int ti = item >> 1, nt_ = item & 1;
    const int e = p.tile2_e[ti], r0 = p.tile2_r0[ti], nr = p.tile2_nr[ti];
    AGather af{p.h, p.slot_tok, r0, nr};
    const float* wgp = e < 256 ? p.w_eg + (long)e * 1024 * 256 : p.w_sg;
    const float* wup = e < 256 ? p.w_eu + (long)e * 1024 * 256 : p.w_su;
    BGateUp8 bf{wgp, (long)(wup - wgp), 256, nt_ * 128};
    EpiH ef{p.H, r0, nr, nt_ * 128};
    gemm8w<false>(16, af, bf, ef);
  }
}
struct EpiYexp {
  u16* Y; const float* slot_wt; int r0, nr, n0;
  template <int MT> DI void operator()(f32x16 (&acc)[MT][2], int wm, int wn, int lane) const {
#pragma unroll
    for (int mt = 0; mt < MT; ++mt) {
      const int r = SW_R;
      if (r < nr) {
        const float w = slot_wt[r0 + r];
#pragma unroll
        for (int nt = 0; nt < 2; ++nt)
#pragma unroll
          for (int q4 = 0; q4 < 4; ++q4)
            *(uint2*)(Y + (long)(r0 + r) * 1024 + n0 + SW_C0) = pack4(SW_V(0) * w, SW_V(1) * w, SW_V(2) * w, SW_V(3) * w);
      }
    }
  }
};
DI void phase16_8w(const Params& p, int wg, int nwg) {
  const int ntl = p.ntiles[1];
  const int nit = ntl * 4, nrounds = (nit + 255) >> 8;
  for (int i = wg; i < nrounds * 256; i += nwg) {
    const int item = ((((i >> 8) << 3) + (i & 7)) << 5) + ((i >> 3) & 31);
    if (item >= nit) continue;
    const int ti = item >> 2, nt_ = item & 3;
    const int e = p.tile2_e[ti], r0 = p.tile2_r0[ti], nr = p.tile2_nr[ti];
    ARows af{p.H + (long)r0 * 256, 256, nr};
    const float* wd = e < 256 ? p.w_ed + (long)e * 256 * 1024 : p.w_sd;
    BMat bf{wd + nt_ * 256, 1024, 256};
    EpiYexp ef{p.Y, p.slot_wt, r0, nr, nt_ * 256};
    gemm8w<false>(4, af, bf, ef);
  }
}
DI void phase17(const Params& p, int bid, int nblk) {
  const int tid = TIDX(), lane = tid & 63, wid = __builtin_amdgcn_readfirstlane(tid >> 6);
  const int b = bid & 1;
  const float* modb = p.mod + b * 6144;
  float cy[16];
#pragma unroll
  for (int i = 0; i < 4; ++i) {
    const int col = i * 256 + lane * 4;
    const float4 gt = *(const float4*)(modb + 5120 + col), gp = *(const float4*)(p.g_post_ffn + col);
    cy[i * 4 + 0] = gt.x * gp.x; cy[i * 4 + 1] = gt.y * gp.y; cy[i * 4 + 2] = gt.z * gp.z; cy[i * 4 + 3] = gt.w * gp.w;
  }
  const int stride = (nblk >> 1) * 4;
  for (int t0 = (bid >> 1) * 4 + wid; t0 < T; t0 += 2 * stride) {
    long rows[2];
    int slots[2][8];
#pragma unroll
    for (int k = 0; k < 2; ++k) {
      const int t = t0 + k * stride < T ? t0 + k * stride : T - 1;
      rows[k] = (long)b * T + t;
      const int4 s0 = *(const int4*)(p.tok_slot + rows[k] * 8), s1 = *(const int4*)(p.tok_slot + rows[k] * 8 + 4);
      slots[k][0] = s0.x; slots[k][1] = s0.y; slots[k][2] = s0.z; slots[k][3] = s0.w;
      slots[k][4] = s1.x; slots[k][5] = s1.y; slots[k][6] = s1.z; slots[k][7] = s1.w;
    }
    float4 xx[2][4];
#pragma unroll
    for (int k = 0; k < 2; ++k)
#pragma unroll
      for (int i = 0; i < 4; ++i) xx[k][i] = *(const float4*)(p.x1 + rows[k] * 1024 + i * 256 + lane * 4);
#pragma unroll
    for (int k = 0; k < 2; ++k) {
      float yv[16];
#pragma unroll
      for (int j = 0; j < 16; ++j) yv[j] = 0.f;
#pragma unroll
      for (int q = 0; q < 9; ++q) {
        const long sl = q < 8 ? (long)slots[k][q] : 131072 + rows[k];
#pragma unroll
        for (int i = 0; i < 4; ++i) {
          const uint2 u = *(const uint2*)(p.Y + sl * 1024 + i * 256 + lane * 4);
          yv[i * 4 + 0] += lo16(u.x); yv[i * 4 + 1] += hi16(u.x); yv[i * 4 + 2] += lo16(u.y); yv[i * 4 + 3] += hi16(u.y);
        }
      }
      float ss = 0.f;
#pragma unroll
      for (int j = 0; j < 16; ++j) ss += yv[j] * yv[j];
      ss = wave_sum(ss);
      const float r = rsqrtf(ss * (1.f / 1024.f) + 1e-6f);
      if (t0 + k * stride < T) {
#pragma unroll
        for (int i = 0; i < 4; ++i) {
          const int col = i * 256 + lane * 4;
          *(float4*)(p.out + rows[k] * 1024 + col) = make_float4(xx[k][i].x + cy[i * 4] * (yv[i * 4] * r), xx[k][i].y + cy[i * 4 + 1] * (yv[i * 4 + 1] * r),
                                                                 xx[k][i].z + cy[i * 4 + 2] * (yv[i * 4 + 2] * r), xx[k][i].w + cy[i * 4 + 3] * (yv[i * 4 + 3] * r));
        }
      }
    }
  }
}

__global__ void __launch_bounds__(512, 2) mega(Params p) {
  cg::grid_group grid = cg::this_grid();
  const int vb = __builtin_amdgcn_readfirstlane((int)(threadIdx.x >> 8));
  char* smem = g_smem + vb * HALF_LDS;
  const int bid = blockIdx.x * 2 + vb, nblk = gridDim.x * 2;
  if (p.phase_hi == 12345) grid.sync();
  if (threadIdx.x < 32) ((unsigned*)(g_smem + 2 * HALF_LDS))[threadIdx.x] = 0u;
  __syncthreads();
  const XcdBarrier xb = xcd_barrier_post(p.bar, (volatile LAS unsigned*)(g_smem + 2 * HALF_LDS));
#if !defined(ONLY) || ONLY==0
  if (p.phase_lo <= 0 && 0 < p.phase_hi) {
    phase0(p, smem, bid, nblk);
#if (REPEAT_MASK >> 0) & 1
    xcd_barrier(xb);
    phase0(p, smem, bid, nblk);
#endif
    if (0 + 1 < p.phase_hi) xcd_barrier(xb);
  }
#endif
#if !defined(ONLY) || ONLY==1
  if (p.phase_lo <= 1 && 1 < p.phase_hi) {
    phase1(p, smem, bid, nblk);
#if (REPEAT_MASK >> 1) & 1
    xcd_barrier(xb);
    phase1(p, smem, bid, nblk);
#endif
    if (1 + 1 < p.phase_hi) xcd_barrier(xb);
  }
#endif
#if !defined(ONLY) || ONLY==2
  if (p.phase_lo <= 2 && 2 < p.phase_hi) {
    phase2_8w(p, blockIdx.x, gridDim.x);
    __syncthreads();
    phase2(p, smem, bid, nblk);
#if (REPEAT_MASK >> 2) & 1
    xcd_barrier(xb);
    phase2_8w(p, blockIdx.x, gridDim.x);
    __syncthreads();
    phase2(p, smem, bid, nblk);
#endif
    if (2 + 1 < p.phase_hi) xcd_barrier(xb);
  }
#endif
#if !defined(ONLY) || ONLY==3
  if (p.phase_lo <= 3 && 3 < p.phase_hi) {
    phase3(p, smem, bid, nblk);
#if (REPEAT_MASK >> 3) & 1
    xcd_barrier(xb);
    phase3(p, smem, bid, nblk);
#endif
    if (3 + 1 < p.phase_hi) xcd_barrier(xb);
  }
#endif
#if !defined(ONLY) || ONLY==4
  if (p.phase_lo <= 4 && 4 < p.phase_hi) {
    phase4(p, smem, bid, nblk);
#if (REPEAT_MASK >> 4) & 1
    xcd_barrier(xb);
    phase4(p, smem, bid, nblk);
#endif
    if (4 + 1 < p.phase_hi) xcd_barrier(xb);
  }
#endif
#if !defined(ONLY) || ONLY==5
  if (p.phase_lo <= 5 && 5 < p.phase_hi) {
    phase5_nsa8(p);
    phase5(p, smem, bid, nblk);
#if (REPEAT_MASK >> 5) & 1
    xcd_barrier(xb);
    phase5_nsa8(p);
    phase5(p, smem, bid, nblk);
#endif
    if (5 + 1 < p.phase_hi) xcd_barrier(xb);
  }
#endif
#if !defined(ONLY) || ONLY==7
  if (p.phase_lo <= 7 && 7 < p.phase_hi) {
    phase7(p, smem, bid, nblk);
#if (REPEAT_MASK >> 7) & 1
    xcd_barrier(xb);
    phase7(p, smem, bid, nblk);
#endif
    if (7 + 1 < p.phase_hi) xcd_barrier(xb);
  }
#endif
#if !defined(ONLY) || ONLY==8
  if (p.phase_lo <= 8 && 8 < p.phase_hi) {
    phase8_8w(p, blockIdx.x, gridDim.x);
#if (REPEAT_MASK >> 8) & 1
    xcd_barrier(xb);
    phase8_8w(p, blockIdx.x, gridDim.x);
#endif
    if (8 + 1 < p.phase_hi) xcd_barrier(xb);
  }
#endif
#if !defined(ONLY) || ONLY==9
  if (p.phase_lo <= 9 && 9 < p.phase_hi) {
    phase9_8w(p, blockIdx.x, gridDim.x);
#if (REPEAT_MASK >> 9) & 1
    xcd_barrier(xb);
    phase9_8w(p, blockIdx.x, gridDim.x);
#endif
    if (9 + 1 < p.phase_hi) xcd_barrier(xb);
  }
#endif
#if !defined(ONLY) || ONLY==10
  if (p.phase_lo <= 10 && 10 < p.phase_hi) {
    phase10(p, bid, nblk);
#if (REPEAT_MASK >> 10) & 1
    xcd_barrier(xb);
    phase10(p, bid, nblk);
#endif
    if (10 + 1 < p.phase_hi) xcd_barrier(xb);
  }
#endif
#if !defined(ONLY) || ONLY==11
  if (p.phase_lo <= 11 && 11 < p.phase_hi) {
    phase11(p, smem, bid, nblk);
#if (REPEAT_MASK >> 11) & 1
    xcd_barrier(xb);
    phase11(p, smem, bid, nblk);
#endif
    if (11 + 1 < p.phase_hi) xcd_barrier(xb);
  }
#endif
#if !defined(ONLY) || ONLY==12
  if (p.phase_lo <= 12 && 12 < p.phase_hi) {
    phase12(p, bid, nblk);
#if (REPEAT_MASK >> 12) & 1
    xcd_barrier(xb);
    phase12(p, bid, nblk);
#endif
    if (12 + 1 < p.phase_hi) xcd_barrier(xb);
  }
#endif
#if !defined(ONLY) || ONLY==14
  if (p.phase_lo <= 14 && 14 < p.phase_hi) {
    phase14(p, smem, bid, nblk);
#if (REPEAT_MASK >> 14) & 1
    xcd_barrier(xb);
    phase14(p, smem, bid, nblk);
#endif
    if (14 + 1 < p.phase_hi) xcd_barrier(xb);
  }
#endif
#if !defined(ONLY) || ONLY==15
  if (p.phase_lo <= 15 && 15 < p.phase_hi) {
    phase15_8w(p, blockIdx.x, gridDim.x);
#if (REPEAT_MASK >> 15) & 1
    xcd_barrier(xb);
    phase15_8w(p, blockIdx.x, gridDim.x);
#endif
    if (15 + 1 < p.phase_hi) xcd_barrier(xb);
  }
#endif
#if !defined(ONLY) || ONLY==16
  if (p.phase_lo <= 16 && 16 < p.phase_hi) {
    phase16_8w(p, blockIdx.x, gridDim.x);
#if (REPEAT_MASK >> 16) & 1
    xcd_barrier(xb);
    phase16_8w(p, blockIdx.x, gridDim.x);
#endif
    if (16 + 1 < p.phase_hi) xcd_barrier(xb);
  }
#endif
#if !defined(ONLY) || ONLY==17
  if (p.phase_lo <= 17 && 17 < p.phase_hi) {
    phase17(p, bid, nblk);
#if (REPEAT_MASK >> 17) & 1
    xcd_barrier(xb);
    phase17(p, bid, nblk);
#endif
    if (17 + 1 < p.phase_hi) xcd_barrier(xb);
  }
#endif
}

extern "C" void kernel_launch(void* const* d_in, const int* in_sizes, int n_in, void* d_out, int out_size, void* d_ws, size_t ws_size,
                              hipStream_t stream) {
  static int grid_blocks = 0;
  if (!grid_blocks) {
    int dev = 0, cus = 0, per_cu = 0;
    (void)hipGetDevice(&dev);
    (void)hipDeviceGetAttribute(&cus, hipDeviceAttributeMultiprocessorCount, dev);
    (void)hipOccupancyMaxActiveBlocksPerMultiprocessor(&per_cu, mega, 512, 0);
    if (per_cu > 1) per_cu = 1;
    if (per_cu < 1) per_cu = 1;
    grid_blocks = cus * per_cu;
  }
  Params p{};
  const float* const* in = (const float* const*)d_in;
  p.x = in[0]; p.c = in[1]; p.w_ada = in[2]; p.b_ada = in[3]; p.g_pre_mix = in[4]; p.g_post_mix = in[5]; p.g_pre_ffn = in[6]; p.g_post_ffn = in[7];
  p.w_in = in[8]; p.rel_bias = in[9]; p.cmp_pe = in[10]; p.cmp_w1 = in[11]; p.cmp_b1 = in[12]; p.cmp_w2 = in[13]; p.dsa_kv_norm = in[14];
  p.dsa_w_uk = in[15]; p.dsa_w_uv = in[16]; p.w_bn = in[17]; p.w_bd = in[18]; p.w_out = in[19]; p.router_w = in[20]; p.router_bias = in[21];
  p.w_eg = in[22]; p.w_eu = in[23]; p.w_ed = in[24]; p.w_sg = in[25]; p.w_su = in[26]; p.w_sd = in[27];
  p.out = (float*)d_out;
  char* ws = (char*)d_ws;
  size_t off = 0;
  auto alloc = [&](size_t bytes) { char* r = ws + off; off += (bytes + 255) & ~(size_t)255; return r; };
  p.bar = (unsigned*)alloc((XCD_BAR_WORDS + 64) * 4);
  p.modp = (float*)alloc(16 * 2 * 6144 * 4);
  p.mod = (float*)alloc(2 * 6144 * 4);
  p.pe_part = (float*)alloc(16 * 256 * 4);
  p.cpart = (float*)alloc((size_t)4 * 4096 * 128 * 4);
  p.w_ukT = (float*)alloc(8 * 64 * 128 * 4);
  p.w_inT = (u16*)alloc((size_t)4608 * 1024 * 2);
  p.w_bnT = (u16*)alloc((size_t)1024 * 512 * 2);
  p.w_bdT = (u16*)alloc((size_t)1024 * 512 * 2);
  p.w_outT = (u16*)alloc((size_t)1024 * 1024 * 2);
  p.routerT = (u16*)alloc((size_t)256 * 1024 * 2);
  p.counts = (int*)alloc(256 * 32 * 4);
  p.offs = (int*)alloc(257 * 4);
  p.tile_e = (int*)alloc(1536 * 4);
  p.tile_r0 = (int*)alloc(1536 * 4);
  p.tile_nr = (int*)alloc(1536 * 4);
  p.ntiles = (int*)alloc(8);
  p.tile2_e = (int*)alloc(1024 * 4);
  p.tile2_r0 = (int*)alloc(1024 * 4);
  p.tile2_nr = (int*)alloc(1024 * 4);
  p.h = (u16*)alloc((size_t)NTOK * 1024 * 2);
  p.proj = (u16*)alloc((size_t)NTOK * LDP * 2);
  p.widx = (float*)alloc((size_t)NTOK * 8 * 4);
  p.zc = (u16*)alloc((size_t)2 * 2048 * 128 * 2);
  p.kc = (u16*)alloc((size_t)4 * 512 * 64 * 2);
  p.vcT = (u16*)alloc((size_t)4 * 512 * 64 * 2);
  p.vts = (u16*)alloc((size_t)4 * 64 * T * 2);
  p.vtw = (u16*)alloc((size_t)4 * 64 * T * 2);
  p.qlat = (u16*)alloc((size_t)NTOK * 1024 * 2);
  p.ckv = (u16*)alloc((size_t)NTOK * 128 * 2);
  p.selk = (int*)alloc((size_t)NTOK * 256 * 4);
  p.onsa = (u16*)alloc((size_t)NTOK * 512 * 2);
  p.olat = (u16*)alloc((size_t)NTOK * 1024 * 2);
  p.odsa = (u16*)alloc((size_t)NTOK * 512 * 2);
  p.y = p.qlat;
  p.z = p.olat;
  p.eidx = (int*)alloc((size_t)NTOK * 8 * 4);
  p.ewt = (float*)alloc((size_t)NTOK * 8 * 4);
  p.erank = (int*)alloc((size_t)NTOK * 8 * 4);
  p.slot_tok = (int*)alloc((size_t)NSLOT * 4);
  p.slot_wt = (float*)alloc((size_t)NSLOT * 4);
  p.tok_slot = (int*)alloc((size_t)NTOK * 8 * 4);
  char* big = alloc((size_t)2 * T * T * 4);
  p.scores = (float*)big;
  {
    size_t o2 = 0;
    auto sub = [&](size_t bytes) { char* r = big + o2; o2 += (bytes + 255) & ~(size_t)255; return r; };
    p.H = (u16*)sub((size_t)NSLOT * 256 * 2);
    p.Y = (u16*)sub((size_t)NSLOT * 1024 * 2);
    p.x1 = (float*)sub((size_t)NTOK * 1024 * 4);
    p.logits = (float*)sub((size_t)NTOK * 256 * 4);
  }
  if (off > ws_size) fprintf(stderr, "workspace too small: need %zu have %zu\n", off, ws_size);
  p.phase_lo = 0;
  p.phase_hi = 18;
  (void)hipMemsetAsync(p.bar, 0, (XCD_BAR_WORDS + 64) * 4, stream);
  void* args[] = {&p};
  hipError_t e = hipLaunchCooperativeKernel((void*)mega, dim3(grid_blocks), dim3(512), args, 0, stream);
  if (e != hipSuccess) fprintf(stderr, "coop launch failed: %s (grid %d)\n", hipGetErrorString(e), grid_blocks);
}
```

```cpp
#include <hip/hip_runtime.h>
#include <hip/hip_cooperative_groups.h>
#include <cstdio>
namespace cg = cooperative_groups;

#define DI __device__ __forceinline__
typedef unsigned short u16;
typedef unsigned long long u64;
using bf16x8 = __attribute__((ext_vector_type(8))) short;
using f32x16 = __attribute__((ext_vector_type(16))) float;
using f32x4 = __attribute__((ext_vector_type(4))) float;

constexpr int T = 8192;
constexpr int NTOK = 16384;
constexpr int LDP = 4576;
constexpr int C_QN = 0, C_KV = 512, C_GN = 1280, C_QD = 1304, C_CKV = 1816, C_QI = 1944, C_KI = 2456, C_WI = 2520, C_GM = 2528;
constexpr int NSLOT = 131072 + 16384;
constexpr int HALF_LDS = 73728;
constexpr int LDS_BYTES = 2 * HALF_LDS + 128;
__shared__ __attribute__((aligned(16))) char g_smem[LDS_BYTES];
#ifndef REPEAT_MASK
#define REPEAT_MASK 0
#endif

__device__ const unsigned char BUCKET[128] = {
  0, 1, 2, 3, 4, 5, 6, 7, 8, 9, 10, 11, 12, 13, 14, 15, 16, 16, 16, 17, 17, 18, 18, 18, 19, 19, 19, 20, 20, 20, 20, 21,
  21, 21, 21, 22, 22, 22, 22, 22, 23, 23, 23, 23, 23, 23, 24, 24, 24, 24, 24, 24, 25, 25, 25, 25, 25, 25, 25, 26, 26, 26, 26, 26,
  26, 26, 26, 27, 27, 27, 27, 27, 27, 27, 27, 27, 27, 28, 28, 28, 28, 28, 28, 28, 28, 28, 28, 29, 29, 29, 29, 29, 29, 29, 29, 29,
  29, 29, 29, 30, 30, 30, 30, 30, 30, 30, 30, 30, 30, 30, 30, 30, 30, 31, 31, 31, 31, 31, 31, 31, 31, 31, 31, 31, 31, 31, 31, 31};

struct Params {
  const float *x, *c, *w_ada, *b_ada, *g_pre_mix, *g_post_mix, *g_pre_ffn, *g_post_ffn, *w_in, *rel_bias;
  const float *cmp_pe, *cmp_w1, *cmp_b1, *cmp_w2, *dsa_kv_norm, *dsa_w_uk, *dsa_w_uv, *w_bn, *w_bd, *w_out;
  const float *router_w, *router_bias, *w_eg, *w_eu, *w_ed, *w_sg, *w_su, *w_sd;
  float* out;
  float* modp;
  float* mod;
  float* pe_part;
  float* cpart;
  float* w_ukT;
  u16 *w_inT, *w_bnT, *w_bdT, *w_outT, *routerT;
  u16* h;
  u16* proj;
  float* widx;
  u16* zc;
  u16* kc;
  u16* vcT;
  u16* vts;
  u16* vtw;
  u16* qlat;
  u16* ckv;
  float* scores;
  int* selk;
  u16* onsa;
  u16* olat;
  u16* odsa;
  u16* y;
  u16* z;
  float* x1;
  float* logits;
  int* eidx;
  float* ewt;
  int* erank;
  int* counts;
  int* offs;
  int* tile_e;
  int* tile_r0;
  int* tile_nr;
  int* ntiles;
  int *tile2_e, *tile2_r0, *tile2_nr;
  int* slot_tok;
  float* slot_wt;
  int* tok_slot;
  u16* H;
  u16* Y;
  unsigned* bar;
  int phase_lo, phase_hi;
};

DI float bf2f(u16 v) { return __uint_as_float(((unsigned)v) << 16); }
typedef __bf16 bf16x2_t __attribute__((ext_vector_type(2)));
typedef float f32x2_t __attribute__((ext_vector_type(2)));
DI unsigned pack2(float a, float b) { f32x2_t v = {a, b}; return __builtin_bit_cast(unsigned, __builtin_convertvector(v, bf16x2_t)); }
DI u16 f2bf(float x) { return (u16)(pack2(x, x) & 0xffffu); }
DI float lo16(unsigned u) { return __uint_as_float(u << 16); }
DI float hi16(unsigned u) { return __uint_as_float(u & 0xffff0000u); }
DI float wave_sum(float v) { for (int o = 32; o; o >>= 1) v += __shfl_xor(v, o); return v; }
DI float wave_max(float v) { for (int o = 32; o; o >>= 1) v = fmaxf(v, __shfl_xor(v, o)); return v; }
#define DPP_QP1 0xB1
#define DPP_QP2 0x4E
#define DPP_RHM 0x141
#define DPP_RM  0x140
#define DPP_B15 0x142
#define DPP_B31 0x143
DI int wave_sum_i(int x) {
  x += __builtin_amdgcn_update_dpp(0, x, DPP_QP1, 0xF, 0xF, true);
  x += __builtin_amdgcn_update_dpp(0, x, DPP_QP2, 0xF, 0xF, true);
  x += __builtin_amdgcn_update_dpp(0, x, DPP_RHM, 0xF, 0xF, true);
  x += __builtin_amdgcn_update_dpp(0, x, DPP_RM, 0xF, 0xF, true);
  x += __builtin_amdgcn_update_dpp(0, x, DPP_B15, 0xA, 0xF, true);
  x += __builtin_amdgcn_update_dpp(0, x, DPP_B31, 0xC, 0xF, true);
  return __builtin_amdgcn_readlane(x, 63);
}
#define DPP_SELF(x, CTRL, RM) ((unsigned)__builtin_amdgcn_update_dpp((int)(x), (int)(x), CTRL, RM, 0xF, false))
DI unsigned wave_max_u(unsigned x) {
  x = max(x, DPP_SELF(x, DPP_QP1, 0xF)); x = max(x, DPP_SELF(x, DPP_QP2, 0xF)); x = max(x, DPP_SELF(x, DPP_RHM, 0xF));
  x = max(x, DPP_SELF(x, DPP_RM, 0xF)); x = max(x, DPP_SELF(x, DPP_B15, 0xA)); x = max(x, DPP_SELF(x, DPP_B31, 0xC));
  return (unsigned)__builtin_amdgcn_readlane((int)x, 63);
}
DI unsigned wave_min_u(unsigned x) {
  x = min(x, DPP_SELF(x, DPP_QP1, 0xF)); x = min(x, DPP_SELF(x, DPP_QP2, 0xF)); x = min(x, DPP_SELF(x, DPP_RHM, 0xF));
  x = min(x, DPP_SELF(x, DPP_RM, 0xF)); x = min(x, DPP_SELF(x, DPP_B15, 0xA)); x = min(x, DPP_SELF(x, DPP_B31, 0xC));
  return (unsigned)__builtin_amdgcn_readlane((int)x, 63);
}
DI void wave_argmax(float& v, int& idx) {
#define AM_STEP(CTRL, RM)                                                                                                   \
  {                                                                                                                         \
    const float ov_ = __int_as_float(__builtin_amdgcn_update_dpp(__float_as_int(v), __float_as_int(v), CTRL, RM, 0xF, false)); \
    const int oi_ = __builtin_amdgcn_update_dpp(idx, idx, CTRL, RM, 0xF, false);                                            \
    const bool tk_ = ov_ > v || (ov_ == v && oi_ < idx);                                                                    \
    v = tk_ ? ov_ : v;                                                                                                      \
    idx = tk_ ? oi_ : idx;                                                                                                  \
  }
  AM_STEP(DPP_QP1, 0xF) AM_STEP(DPP_QP2, 0xF) AM_STEP(DPP_RHM, 0xF) AM_STEP(DPP_RM, 0xF) AM_STEP(DPP_B15, 0xA) AM_STEP(DPP_B31, 0xC)
#undef AM_STEP
  v = __int_as_float(__builtin_amdgcn_readlane(__float_as_int(v), 63));
  idx = __builtin_amdgcn_readlane(idx, 63);
}
DI float rdlane(float v, int l) { return __int_as_float(__builtin_amdgcn_readlane(__float_as_int(v), l)); }
DI int rdlane_i(int v, int l) { return __builtin_amdgcn_readlane(v, l); }
DI int TIDX() { int t = threadIdx.x & 255; asm volatile("" : "+v"(t)); return t; }
DI int TIDX8() { int t = threadIdx.x; asm volatile("" : "+v"(t)); return t; }
DI void hb_sync() {
  asm volatile("s_waitcnt vmcnt(0) lgkmcnt(0)" ::: "memory");
  const int vb = __builtin_amdgcn_readfirstlane((int)(threadIdx.x >> 8));
  volatile __attribute__((address_space(3))) unsigned* cnt = (volatile __attribute__((address_space(3))) unsigned*)(g_smem + 2 * HALF_LDS + 64) + vb * 8;
  if ((threadIdx.x & 63) == 0) {
    const unsigned old = __hip_atomic_fetch_add((__attribute__((address_space(3))) unsigned*)cnt, 1u, __ATOMIC_RELAXED, __HIP_MEMORY_SCOPE_WORKGROUP);
    const unsigned target = (old & ~3u) + 4u;
    while ((int)(*cnt - target) < 0) __builtin_amdgcn_s_sleep(0);
  }
  asm volatile("s_waitcnt lgkmcnt(0)" ::: "memory");
  __builtin_amdgcn_wave_barrier();
}
DI void cbar(const void* p) { asm volatile("" ::"v"(p) : "memory"); }
DI void wave_sync() { asm volatile("s_waitcnt lgkmcnt(0)" ::: "memory"); __builtin_amdgcn_wave_barrier(); }
DI float sigmoidf(float x) { return 1.f / (1.f + __expf(-x)); }
DI float siluf(float x) { return x / (1.f + __expf(-x)); }
DI float gelu_tanh(float x) { float u = 0.7978845608028654f * (x + 0.044715f * x * x * x); float e = __expf(2.f * u); float th = 1.f - 2.f / (e + 1.f); return 0.5f * x * (1.f + th); }


#define XB_TMO      128
#define XB_XCNT(j)  (256  + 64 * (j))
#define XB_XSUB(j)  (1280 + 64 * (j))
#define XB_XGEN(j)  (2304 + 64 * (j))
#define XB_TOP      3328
#define XB_TOPGEN   3392
#define XCD_BAR_WORDS 3456
#define XB_SPIN_CAP (1u << 22)
#define LAS __attribute__((address_space(3)))
DI unsigned xb_ld(unsigned* p) { return __hip_atomic_load(p, __ATOMIC_RELAXED, __HIP_MEMORY_SCOPE_AGENT); }
DI unsigned xb_add(unsigned* p, unsigned v) { return __hip_atomic_fetch_add(p, v, __ATOMIC_RELAXED, __HIP_MEMORY_SCOPE_AGENT); }
DI unsigned xb_xcc_id() { return (unsigned)__builtin_amdgcn_s_getreg((3 << 11) | 20) & 0xFu; }
#define XB_SPIN(cond, bar) do { unsigned _sp = 0; while (cond) { __builtin_amdgcn_s_sleep(1); \
    if ((++_sp & 255u) == 0u) { if (xb_ld(&(bar)[XB_TMO])) break; if (_sp > XB_SPIN_CAP) { atomicAdd(&(bar)[XB_TMO], 1u); break; } } } } while (0)
struct XcdBarrier { unsigned* bar; unsigned x; volatile LAS unsigned* st; };
DI XcdBarrier xcd_barrier_post(unsigned* bar, volatile LAS unsigned* st) {
  XcdBarrier b; b.bar = bar; b.x = xb_xcc_id(); b.st = st;
  if (threadIdx.x == 0) (void)xb_add(&bar[XB_XCNT(b.x)], 1u);
  return b;
}
DI void xcd_barrier_complete(unsigned* bar, unsigned x, unsigned& nloc, unsigned& nx) {
  const unsigned G = gridDim.x * gridDim.y * gridDim.z;
  unsigned sum, cnt, mine, sp = 0u;
  for (;;) {
    sum = 0u; cnt = 0u; mine = 0u;
#pragma unroll
    for (unsigned j = 0; j < 16; ++j) { const unsigned c = xb_ld(&bar[XB_XCNT(j)]); sum += c; cnt += (c > 0u) ? 1u : 0u; mine = (j == x) ? c : mine; }
    if (sum == G) break;
    __builtin_amdgcn_s_sleep(1);
    if ((++sp & 255u) == 0u) { if (xb_ld(&bar[XB_TMO])) break; if (sp > XB_SPIN_CAP) { atomicAdd(&bar[XB_TMO], 1u); break; } }
  }
  nloc = mine > 0u ? mine : 1u; nx = cnt > 0u ? cnt : 1u;
}
DI void xcd_barrier(const XcdBarrier& b) {
  asm volatile("s_waitcnt vmcnt(0)" ::: "memory");
  __syncthreads();
  if (threadIdx.x == 0) {
    unsigned* bar = b.bar;
    __builtin_amdgcn_s_waitcnt(0);
    unsigned nloc = b.st[0], nx = b.st[1];
    if (nloc == 0u) { xcd_barrier_complete(bar, b.x, nloc, nx); b.st[0] = nloc; b.st[1] = nx; }
    const unsigned old = xb_add(&bar[XB_XSUB(b.x)], 1u);
    const unsigned gen = old / nloc;
    if (old + 1u == (gen + 1u) * nloc) {
      __builtin_amdgcn_fence(__ATOMIC_RELEASE, "agent");
      asm volatile("s_waitcnt vmcnt(0)" ::: "memory");
      const unsigned og = xb_add(&bar[XB_TOP], 1u);
      const unsigned tg = og / nx;
      if (og + 1u == (tg + 1u) * nx) xb_add(&bar[XB_TOPGEN], 1u);
      else XB_SPIN(xb_ld(&bar[XB_TOPGEN]) == tg, bar);
      __builtin_amdgcn_fence(__ATOMIC_ACQUIRE, "agent");
      xb_add(&bar[XB_XGEN(b.x)], 1u);
      asm volatile("s_waitcnt vmcnt(0)" ::: "memory");
    } else {
      XB_SPIN(xb_ld(&bar[XB_XGEN(b.x)]) == gen, bar);
      __builtin_amdgcn_fence(__ATOMIC_ACQUIRE, "agent");
      asm volatile("s_waitcnt vmcnt(0)" ::: "memory");
    }
  }
  __syncthreads();
}

template <bool SWAP = true, bool SINGLE = false, bool BT16 = false, class AF, class BF, class EF>
DI void gemm_tile(char* smem, int nk, long a_kstep, const AF& af, const BF& bf, const EF& ef) {
  asm volatile("" ::: "memory");
  u16* As = (u16*)smem;
  const int tid = TIDX(), lane = tid & 63, wid = __builtin_amdgcn_readfirstlane(tid >> 6), wm = wid >> 1, wn = wid & 1;
  const int arow = tid >> 1, ahalf = tid & 1;
  const u16* ap = af(arow) + ahalf * 32;
  const int bkq = lane & 7, bnq = wid * 8 + (lane >> 3);
  const long ldb = bf.ldb;
  const float* bp = nullptr;
  const u16* bp16 = nullptr;
  if constexpr (BT16) bp16 = bf.row(arow) + ahalf * 32;
  else bp = bf(bnq * 4) + (long)(bkq * 4) * ldb;
  uint4 sa0_0, sa0_1, sa0_2, sa0_3, sa1_0, sa1_1, sa1_2, sa1_3;
  float4 sb0_0, sb0_1, sb0_2, sb0_3, sb0_4, sb0_5, sb0_6, sb0_7, sb1_0, sb1_1, sb1_2, sb1_3, sb1_4, sb1_5, sb1_6, sb1_7;
  uint4 tb0_0, tb0_1, tb0_2, tb0_3, tb1_0, tb1_1, tb1_2, tb1_3;
  f32x16 acc[2][2];
#pragma unroll
  for (int a = 0; a < 2; ++a)
#pragma unroll
    for (int b = 0; b < 2; ++b)
#pragma unroll
      for (int i = 0; i < 16; ++i) acc[a][b][i] = 0.f;

#define GEMM_LOAD(S, KT)                                                                  \
  {                                                                                       \
    const uint4* pa_ = (const uint4*)(ap + (long)(KT) * a_kstep);                         \
    sa##S##_0 = pa_[0]; sa##S##_1 = pa_[1]; sa##S##_2 = pa_[2]; sa##S##_3 = pa_[3];       \
    if constexpr (BT16) {                                                                 \
      const uint4* pt_ = (const uint4*)(bp16 + (long)(KT) * 64);                          \
      tb##S##_0 = pt_[0]; tb##S##_1 = pt_[1]; tb##S##_2 = pt_[2]; tb##S##_3 = pt_[3];     \
    } else {                                                                              \
      const float* pb_ = bp + (long)(KT) * 64 * ldb;                                      \
      sb##S##_0 = *(const float4*)(pb_);                                                  \
      sb##S##_1 = *(const float4*)(pb_ + ldb);                                            \
      sb##S##_2 = *(const float4*)(pb_ + 2 * ldb);                                        \
      sb##S##_3 = *(const float4*)(pb_ + 3 * ldb);                                        \
      sb##S##_4 = *(const float4*)(pb_ + 32 * ldb);                                       \
      sb##S##_5 = *(const float4*)(pb_ + 33 * ldb);                                       \
      sb##S##_6 = *(const float4*)(pb_ + 34 * ldb);                                       \
      sb##S##_7 = *(const float4*)(pb_ + 35 * ldb);                                       \
    }                                                                                     \
  }
#define GEMM_BW(V0, V1, V2, V3, C, I, QOFF)                                               \
  {                                                                                       \
    uint2 w_;                                                                             \
    w_.x = pack2(V0.C, V1.C);                                                             \
    w_.y = pack2(V2.C, V3.C);                                                             \
    *(uint2*)&Bs_[(bnq * 4 + (I)) * 72 + (QOFF) + bkq * 4] = w_;                          \
  }
#define GEMM_STORE(S, BUF)                                                                \
  {                                                                                       \
    u16* As_ = As + (BUF) * (2 * 128 * 72);                                               \
    u16* Bs_ = As_ + 128 * 72;                                                            \
    uint4* da_ = (uint4*)&As_[arow * 72 + ahalf * 32];                                    \
    da_[0] = sa##S##_0; da_[1] = sa##S##_1; da_[2] = sa##S##_2; da_[3] = sa##S##_3;       \
    if constexpr (BT16) {                                                                 \
      uint4* db_ = (uint4*)&Bs_[arow * 72 + ahalf * 32];                                  \
      db_[0] = tb##S##_0; db_[1] = tb##S##_1; db_[2] = tb##S##_2; db_[3] = tb##S##_3;     \
    } else {                                                                              \
      GEMM_BW(sb##S##_0, sb##S##_1, sb##S##_2, sb##S##_3, x, 0, 0)                        \
      GEMM_BW(sb##S##_0, sb##S##_1, sb##S##_2, sb##S##_3, y, 1, 0)                        \
      GEMM_BW(sb##S##_0, sb##S##_1, sb##S##_2, sb##S##_3, z, 2, 0)                        \
      GEMM_BW(sb##S##_0, sb##S##_1, sb##S##_2, sb##S##_3, w, 3, 0)                        \
      GEMM_BW(sb##S##_4, sb##S##_5, sb##S##_6, sb##S##_7, x, 0, 32)                       \
      GEMM_BW(sb##S##_4, sb##S##_5, sb##S##_6, sb##S##_7, y, 1, 32)                       \
      GEMM_BW(sb##S##_4, sb##S##_5, sb##S##_6, sb##S##_7, z, 2, 32)                       \
      GEMM_BW(sb##S##_4, sb##S##_5, sb##S##_6, sb##S##_7, w, 3, 32)                       \
    }                                                                                     \
  }
#define GEMM_COMPUTE(BUF)                                                                 \
  {                                                                                       \
    const u16* Ac = As + (BUF) * (2 * 128 * 72);                                          \
    const u16* Bc = Ac + 128 * 72;                                                        \
    _Pragma("unroll") for (int ks = 0; ks < 4; ++ks) {                                    \
      bf16x8 a[2], b[2];                                                                  \
      _Pragma("unroll") for (int mt = 0; mt < 2; ++mt) a[mt] = *(const bf16x8*)&Ac[(wm * 64 + mt * 32 + (lane & 31)) * 72 + ks * 16 + (lane >> 5) * 8]; \
      _Pragma("unroll") for (int nt = 0; nt < 2; ++nt) b[nt] = *(const bf16x8*)&Bc[(wn * 64 + nt * 32 + (lane & 31)) * 72 + ks * 16 + (lane >> 5) * 8]; \
      _Pragma("unroll") for (int mt = 0; mt < 2; ++mt)                                    \
      _Pragma("unroll") for (int nt = 0; nt < 2; ++nt)                                    \
        acc[mt][nt] = SWAP ? __builtin_amdgcn_mfma_f32_32x32x16_bf16(b[nt], a[mt], acc[mt][nt], 0, 0, 0) \
                           : __builtin_amdgcn_mfma_f32_32x32x16_bf16(a[mt], b[nt], acc[mt][nt], 0, 0, 0); \
    }                                                                                     \
  }
  GEMM_LOAD(0, 0)
  hb_sync();
  if (SINGLE) {
    GEMM_STORE(0, 0)
    hb_sync();
    GEMM_COMPUTE(0)
  } else {
    GEMM_LOAD(1, 1)
    GEMM_STORE(0, 0)
    hb_sync();
    const int last = nk - 1;
    for (int kt = 0; kt < nk; kt += 2) {
      const int k2 = kt + 2 < last ? kt + 2 : last, k3 = kt + 3 < last ? kt + 3 : last;
      GEMM_LOAD(0, k2)
      asm volatile("" ::: "memory");
      GEMM_COMPUTE(0)
      asm volatile("" ::: "memory");
      GEMM_STORE(1, 1)
      hb_sync();
      GEMM_LOAD(1, k3)
      asm volatile("" ::: "memory");
      GEMM_COMPUTE(1)
      asm volatile("" ::: "memory");
      GEMM_STORE(0, 0)
      hb_sync();
    }
  }
#undef GEMM_LOAD
#undef GEMM_STORE
#undef GEMM_BW
#undef GEMM_COMPUTE
  ef(acc, wm, wn, lane);
}

template <bool BT16, class AF, class BF, class EF>
DI void gemm_tile256(char* smem, int nk, const AF& af, const BF& bf, const EF& ef) {
  asm volatile("" ::: "memory");
  u16* As = (u16*)smem;
  u16* Bs = As + 256 * 72;
  const int tid = TIDX(), lane = tid & 63, wid = __builtin_amdgcn_readfirstlane(tid >> 6), wm = wid >> 1, wn = wid & 1;
  const int piece = tid & 7, rbase = tid >> 3;
  const u16* abase = af(0);
  int ao0, ao1, ao2, ao3, ao4, ao5, ao6, ao7;
  ao0 = (int)(af(rbase) - abase) + piece * 8;        ao1 = (int)(af(rbase + 32) - abase) + piece * 8;
  ao2 = (int)(af(rbase + 64) - abase) + piece * 8;   ao3 = (int)(af(rbase + 96) - abase) + piece * 8;
  ao4 = (int)(af(rbase + 128) - abase) + piece * 8;  ao5 = (int)(af(rbase + 160) - abase) + piece * 8;
  ao6 = (int)(af(rbase + 192) - abase) + piece * 8;  ao7 = (int)(af(rbase + 224) - abase) + piece * 8;
  const u16* bp16 = nullptr; long bstride = 0;
  const float* bp = nullptr; long ldb = 0;
  const int bkq = lane & 7, bnq = wid * 8 + (lane >> 3);
  if constexpr (BT16) { bp16 = bf.row(rbase) + piece * 8; bstride = bf.ldb * 32; }
  else { ldb = bf.ldb; bp = bf(bnq * 4) + (long)(bkq * 4) * ldb; }
  uint4 ra0, ra1, ra2, ra3, ra4, ra5, ra6, ra7, rb0, rb1, rb2, rb3;
  float4 fb0, fb1, fb2, fb3, fb4, fb5, fb6, fb7;
  f32x16 acc[4][2];
#pragma unroll
  for (int a = 0; a < 4; ++a)
#pragma unroll
    for (int b = 0; b < 2; ++b)
#pragma unroll
      for (int i = 0; i < 16; ++i) acc[a][b][i] = 0.f;
#define G256_LOAD(KT)                                                   \
  {                                                                     \
    const u16* pa_ = abase + (long)(KT) * 64;                           \
    ra0 = *(const uint4*)(pa_ + ao0); ra1 = *(const uint4*)(pa_ + ao1); \
    ra2 = *(const uint4*)(pa_ + ao2); ra3 = *(const uint4*)(pa_ + ao3); \
    ra4 = *(const uint4*)(pa_ + ao4); ra5 = *(const uint4*)(pa_ + ao5); \
    ra6 = *(const uint4*)(pa_ + ao6); ra7 = *(const uint4*)(pa_ + ao7); \
    if constexpr (BT16) {                                               \
      const u16* pb_ = bp16 + (long)(KT) * 64;                          \
      rb0 = *(const uint4*)(pb_);                                       \
      rb1 = *(const uint4*)(pb_ + bstride);                             \
      rb2 = *(const uint4*)(pb_ + 2 * bstride);                         \
      rb3 = *(const uint4*)(pb_ + 3 * bstride);                         \
    } else {                                                            \
      const float* pf_ = bp + (long)(KT) * 64 * ldb;                    \
      fb0 = *(const float4*)(pf_);            fb1 = *(const float4*)(pf_ + ldb);      \
      fb2 = *(const float4*)(pf_ + 2 * ldb);  fb3 = *(const float4*)(pf_ + 3 * ldb);  \
      fb4 = *(const float4*)(pf_ + 32 * ldb); fb5 = *(const float4*)(pf_ + 33 * ldb); \
      fb6 = *(const float4*)(pf_ + 34 * ldb); fb7 = *(const float4*)(pf_ + 35 * ldb); \
    }                                                                   \
  }
#define G256_BW(V0, V1, V2, V3, C, I, QOFF)                             \
  {                                                                     \
    uint2 w_;                                                           \
    w_.x = pack2(V0.C, V1.C);                                           \
    w_.y = pack2(V2.C, V3.C);                                           \
    *(uint2*)&Bs[(bnq * 4 + (I)) * 72 + (QOFF) + bkq * 4] = w_;         \
  }
  G256_LOAD(0)
  const int last = nk - 1;
  for (int kt = 0; kt < nk; ++kt) {
    hb_sync();
    {
      u16* da = As + rbase * 72 + piece * 8;
      *(uint4*)(da) = ra0;            *(uint4*)(da + 32 * 72) = ra1;  *(uint4*)(da + 64 * 72) = ra2;  *(uint4*)(da + 96 * 72) = ra3;
      *(uint4*)(da + 128 * 72) = ra4; *(uint4*)(da + 160 * 72) = ra5; *(uint4*)(da + 192 * 72) = ra6; *(uint4*)(da + 224 * 72) = ra7;
      if constexpr (BT16) {
        u16* db = Bs + rbase * 72 + piece * 8;
        *(uint4*)(db) = rb0; *(uint4*)(db + 32 * 72) = rb1; *(uint4*)(db + 64 * 72) = rb2; *(uint4*)(db + 96 * 72) = rb3;
      } else {
        G256_BW(fb0, fb1, fb2, fb3, x, 0, 0)  G256_BW(fb0, fb1, fb2, fb3, y, 1, 0)
        G256_BW(fb0, fb1, fb2, fb3, z, 2, 0)  G256_BW(fb0, fb1, fb2, fb3, w, 3, 0)
        G256_BW(fb4, fb5, fb6, fb7, x, 0, 32) G256_BW(fb4, fb5, fb6, fb7, y, 1, 32)
        G256_BW(fb4, fb5, fb6, fb7, z, 2, 32) G256_BW(fb4, fb5, fb6, fb7, w, 3, 32)
      }
    }
    hb_sync();
    const int kn = kt + 1 < last ? kt + 1 : last;
    G256_LOAD(kn)
    asm volatile("" ::: "memory");
#pragma unroll
    for (int ks = 0; ks < 4; ++ks) {
      bf16x8 a[4], b[2];
#pragma unroll
      for (int mt = 0; mt < 4; ++mt) a[mt] = *(const bf16x8*)&As[(wm * 128 + mt * 32 + (lane & 31)) * 72 + ks * 16 + (lane >> 5) * 8];
#pragma unroll
      for (int nt = 0; nt < 2; ++nt) b[nt] = *(const bf16x8*)&Bs[(wn * 64 + nt * 32 + (lane & 31)) * 72 + ks * 16 + (lane >> 5) * 8];
#pragma unroll
      for (int mt = 0; mt < 4; ++mt)
#pragma unroll
        for (int nt = 0; nt < 2; ++nt) acc[mt][nt] = __builtin_amdgcn_mfma_f32_32x32x16_bf16(b[nt], a[mt], acc[mt][nt], 0, 0, 0);
    }
    asm volatile("" ::: "memory");
  }
#undef G256_LOAD
#undef G256_BW
  ef(acc, wm, wn, lane);
}

template <bool BT16, class AF, class BF, class EF>
DI void gemm8w(int nk, const AF& af, const BF& bf, const EF& ef) {
  asm volatile("" ::: "memory");
  u16* S0 = (u16*)g_smem;
  int tid = threadIdx.x; asm volatile("" : "+v"(tid));
  const int lane = tid & 63, wid = __builtin_amdgcn_readfirstlane(tid >> 6), wm = wid >> 2, wn = wid & 3;
  const int piece = tid & 7, rbase = tid >> 3;
  const u16* abase = af.origin();
  const int ao0 = af.off(rbase) + piece * 8, ao1 = af.off(rbase + 64) + piece * 8, ao2 = af.off(rbase + 128) + piece * 8, ao3 = af.off(rbase + 192) + piece * 8;
  const u16 *bq0 = nullptr, *bq1 = nullptr, *bq2 = nullptr, *bq3 = nullptr;
  const float* bp = nullptr; long ldb = 0;
  const int bkq = lane & 7, bnq = wid * 8 + (lane >> 3);
  if constexpr (BT16) { bq0 = bf.row(rbase) + piece * 8; bq1 = bf.row(rbase + 64) + piece * 8; bq2 = bf.row(rbase + 128) + piece * 8; bq3 = bf.row(rbase + 192) + piece * 8; }
  else { ldb = bf.ldb; bp = bf(bnq * 4) + (long)(bkq * 4) * ldb; }
  uint4 ra0, ra1, ra2, ra3, rb0, rb1, rb2, rb3;
  float4 fb0, fb1, fb2, fb3, fb4, fb5, fb6, fb7;
  f32x16 acc[4][2];
#pragma unroll
  for (int a = 0; a < 4; ++a)
#pragma unroll
    for (int b = 0; b < 2; ++b)
#pragma unroll
      for (int i = 0; i < 16; ++i) acc[a][b][i] = 0.f;
#define G8_LOAD(KT)                                                     \
  {                                                                     \
    const u16* pa_ = abase + (long)(KT) * 64;                           \
    ra0 = *(const uint4*)(pa_ + ao0); ra1 = *(const uint4*)(pa_ + ao1); \
    ra2 = *(const uint4*)(pa_ + ao2); ra3 = *(const uint4*)(pa_ + ao3); \
    if constexpr (BT16) {                                               \
      rb0 = *(const uint4*)(bq0 + (long)(KT) * 64); rb1 = *(const uint4*)(bq1 + (long)(KT) * 64); \
      rb2 = *(const uint4*)(bq2 + (long)(KT) * 64); rb3 = *(const uint4*)(bq3 + (long)(KT) * 64); \
    } else {                                                            \
      const float* pf_ = bp + (long)(KT) * 64 * ldb;                    \
      fb0 = *(const float4*)(pf_);            fb1 = *(const float4*)(pf_ + ldb);      \
      fb2 = *(const float4*)(pf_ + 2 * ldb);  fb3 = *(const float4*)(pf_ + 3 * ldb);  \
      fb4 = *(const float4*)(pf_ + 32 * ldb); fb5 = *(const float4*)(pf_ + 33 * ldb); \
      fb6 = *(const float4*)(pf_ + 34 * ldb); fb7 = *(const float4*)(pf_ + 35 * ldb); \
    }                                                                   \
  }
#define G8_BW(V0, V1, V2, V3, C, I, QOFF)                               \
  {                                                                     \
    uint2 w_;                                                           \
    w_.x = pack2(V0.C, V1.C);                                           \
    w_.y = pack2(V2.C, V3.C);                                           \
    *(uint2*)&Bs_[(bnq * 4 + (I)) * 72 + (QOFF) + bkq * 4] = w_;        \
  }
#define G8_STORE(BUF)                                                   \
  {                                                                     \
    u16* As_ = S0 + (BUF) * (512 * 72);                                 \
    u16* Bs_ = As_ + 256 * 72;                                          \
    u16* da = As_ + rbase * 72 + piece * 8;                             \
    *(uint4*)(da) = ra0; *(uint4*)(da + 64 * 72) = ra1; *(uint4*)(da + 128 * 72) = ra2; *(uint4*)(da + 192 * 72) = ra3; \
    if constexpr (BT16) {                                               \
      u16* db = Bs_ + rbase * 72 + piece * 8;                           \
      *(uint4*)(db) = rb0; *(uint4*)(db + 64 * 72) = rb1; *(uint4*)(db + 128 * 72) = rb2; *(uint4*)(db + 192 * 72) = rb3; \
    } else {                                                            \
      G8_BW(fb0, fb1, fb2, fb3, x, 0, 0)  G8_BW(fb0, fb1, fb2, fb3, y, 1, 0)   \
      G8_BW(fb0, fb1, fb2, fb3, z, 2, 0)  G8_BW(fb0, fb1, fb2, fb3, w, 3, 0)   \
      G8_BW(fb4, fb5, fb6, fb7, x, 0, 32) G8_BW(fb4, fb5, fb6, fb7, y, 1, 32)  \
      G8_BW(fb4, fb5, fb6, fb7, z, 2, 32) G8_BW(fb4, fb5, fb6, fb7, w, 3, 32)  \
    }                                                                   \
  }
  G8_LOAD(0)
  __syncthreads();
  G8_STORE(0)
  __syncthreads();
  const int last = nk - 1;
  for (int kt = 0; kt < nk; ++kt) {
    const int kn = kt + 1 < last ? kt + 1 : last;
    G8_LOAD(kn)
    asm volatile("" ::: "memory");
    {
      const u16* Ac = S0 + (kt & 1) * (512 * 72);
      const u16* Bc = Ac + 256 * 72;
#pragma unroll
      for (int ks = 0; ks < 4; ++ks) {
        bf16x8 a[4], b[2];
#pragma unroll
        for (int mt = 0; mt < 4; ++mt) a[mt] = *(const bf16x8*)&Ac[(wm * 128 + mt * 32 + (lane & 31)) * 72 + ks * 16 + (lane >> 5) * 8];
#pragma unroll
        for (int nt = 0; nt < 2; ++nt) b[nt] = *(const bf16x8*)&Bc[(wn * 64 + nt * 32 + (lane & 31)) * 72 + ks * 16 + (lane >> 5) * 8];
#pragma unroll
        for (int mt = 0; mt < 4; ++mt)
#pragma unroll
          for (int nt = 0; nt < 2; ++nt) acc[mt][nt] = __builtin_amdgcn_mfma_f32_32x32x16_bf16(b[nt], a[mt], acc[mt][nt], 0, 0, 0);
      }
    }
    asm volatile("" ::: "memory");
    if (kt + 1 < nk) {
      G8_STORE((kt + 1) & 1)
      __syncthreads();
    }
  }
#undef G8_LOAD
#undef G8_BW
#undef G8_STORE
  ef(acc, wm, wn, lane);
}

DI void st_stage_rc(int b, int& R, int& C) {
  const int st = b >> 10, sb = b & 1023, swz = sb ^ (((sb >> 9) & 1) << 5);
  R = (st >> 1) * 16 + (swz >> 6); C = (st & 1) * 32 + ((swz & 63) >> 1);
}
template <class PF, class QF, class EF>
DI void gemm8p(int nt, const PF& pf, const QF& qf, const EF& ef) {
  asm volatile("" ::: "memory");
  constexpr int HTB = 128 * 64 * 2;
  int tid = threadIdx.x; asm volatile("" : "+v"(tid));
  const int lane = tid & 63, wid = __builtin_amdgcn_readfirstlane(tid >> 6), wr = wid >> 2, wc = wid & 3, fr = lane & 15, fq = lane >> 4;
  int r0, c0, r1, c1;
  st_stage_rc(tid * 16, r0, c0);
  st_stage_rc(tid * 16 + 8192, r1, c1);
  const u16* pbase = pf.origin();
  const u16* qbase = qf.origin();
  const unsigned po00 = (unsigned)(pf.off(r0) + c0) * 2u, po01 = (unsigned)(pf.off(r1) + c1) * 2u;
  const unsigned po10 = (unsigned)(pf.off(128 + r0) + c0) * 2u, po11 = (unsigned)(pf.off(128 + r1) + c1) * 2u;
  const unsigned qo00 = (unsigned)(qf.off(r0) + c0) * 2u, qo01 = (unsigned)(qf.off(r1) + c1) * 2u;
  const unsigned qo10 = (unsigned)(qf.off(128 + r0) + c0) * 2u, qo11 = (unsigned)(qf.off(128 + r1) + c1) * 2u;
  const unsigned sdst = (unsigned)__builtin_amdgcn_readfirstlane((int)((unsigned)(size_t)g_smem + (unsigned)(tid & ~63) * 16u));
  const int laneoff = (fr * 64 + fq * 16) ^ ((fr >> 3) << 5);
  const char* rdP = g_smem + wr * 8192 + laneoff;
  const char* rdQ = g_smem + 4 * HTB + wc * 4096 + laneoff;
#define G8P_ST(SLOT, BASE, O0, O1, KT)                                                                                     \
  {                                                                                                                        \
    const char* g_ = (const char*)(BASE) + (long)(KT) * 128;                                                               \
    __builtin_amdgcn_global_load_lds((const unsigned*)(g_ + (O0)), (LAS unsigned*)(size_t)(sdst + (SLOT) * HTB), 16, 0, 0);          \
    __builtin_amdgcn_global_load_lds((const unsigned*)(g_ + (O1)), (LAS unsigned*)(size_t)(sdst + (SLOT) * HTB + 8192), 16, 0, 0);   \
  }
#define G8P_STP(b, h, KT) { if ((h) == 0) G8P_ST((b) * 2, pbase, po00, po01, KT) else G8P_ST((b) * 2 + 1, pbase, po10, po11, KT) }
#define G8P_STQ(b, h, KT) { if ((h) == 0) G8P_ST(4 + (b) * 2, qbase, qo00, qo01, KT) else G8P_ST(4 + (b) * 2 + 1, qbase, qo10, qo11, KT) }
#define G8P_LDP(b, h)                                                                                                      \
  _Pragma("unroll") for (int m = 0; m < 4; ++m) _Pragma("unroll") for (int k = 0; k < 2; ++k)                              \
    Pt[m][k] = *(const bf16x8*)(rdP + ((b) * 2 + (h)) * HTB + m * 2048 + k * 1024);
#define G8P_LDQ(dst, b, h)                                                                                                 \
  _Pragma("unroll") for (int n = 0; n < 2; ++n) _Pragma("unroll") for (int k = 0; k < 2; ++k)                              \
    dst[n][k] = *(const bf16x8*)(rdQ + ((b) * 2 + (h)) * HTB + n * 2048 + k * 1024);
#define G8P_MMA(ai, bj, QT)                                                                                                \
  {                                                                                                                        \
    __builtin_amdgcn_s_setprio(1);                                                                                         \
    _Pragma("unroll") for (int m = 0; m < 4; ++m) _Pragma("unroll") for (int n = 0; n < 2; ++n)                            \
      _Pragma("unroll") for (int k = 0; k < 2; ++k)                                                                        \
        acc[ai][bj][m][n] = __builtin_amdgcn_mfma_f32_16x16x32_bf16(Pt[m][k], QT[n][k], acc[ai][bj][m][n], 0, 0, 0);       \
    __builtin_amdgcn_s_setprio(0);                                                                                         \
  }
#define G8P_WV(n) asm volatile("s_waitcnt vmcnt(" #n ")" ::: "memory")
#define G8P_WL(n) asm volatile("s_waitcnt lgkmcnt(" #n ")" ::: "memory")
#define G8P_BAR __builtin_amdgcn_s_barrier()
#define G8P_SCHED __builtin_amdgcn_sched_barrier(0)
  f32x4 acc[2][2][4][2];
#pragma unroll
  for (int a = 0; a < 2; ++a)
#pragma unroll
    for (int b = 0; b < 2; ++b)
#pragma unroll
      for (int m = 0; m < 4; ++m)
#pragma unroll
        for (int n = 0; n < 2; ++n) acc[a][b][m][n] = (f32x4){0.f, 0.f, 0.f, 0.f};
  bf16x8 Pt[4][2], Q0[2][2], Q1[2][2];
  __syncthreads();
  G8P_STQ(0, 0, 0) G8P_STP(0, 0, 0) G8P_STQ(0, 1, 0) G8P_STP(0, 1, 0)
  if (wr == 1) G8P_BAR;
  G8P_WV(4); G8P_BAR;
  G8P_STQ(1, 0, 1) G8P_STP(1, 0, 1) G8P_STQ(1, 1, 1)
  G8P_WV(6); G8P_BAR;
  for (int t = 0; t < nt - 2; t += 2) {
    G8P_LDQ(Q0, 0, 0) G8P_SCHED; G8P_LDP(0, 0) G8P_STP(1, 1, t + 1)
    G8P_WL(8); G8P_BAR; G8P_WL(0); G8P_MMA(0, 0, Q0) G8P_BAR; G8P_SCHED;
    G8P_LDQ(Q1, 0, 1) G8P_STQ(0, 0, t + 2)
    G8P_BAR; G8P_WL(0); G8P_MMA(0, 1, Q1) G8P_BAR;
    G8P_LDP(0, 1) G8P_STP(0, 0, t + 2)
    G8P_BAR; G8P_WL(0); G8P_MMA(1, 0, Q0) G8P_BAR; G8P_SCHED;
    G8P_STQ(0, 1, t + 2)
    G8P_WV(6); G8P_BAR; G8P_MMA(1, 1, Q1) G8P_BAR;
    G8P_LDQ(Q0, 1, 0) G8P_SCHED; G8P_LDP(1, 0) G8P_STP(0, 1, t + 2)
    G8P_WL(8); G8P_BAR; G8P_WL(0); G8P_MMA(0, 0, Q0) G8P_BAR; G8P_SCHED;
    G8P_LDQ(Q1, 1, 1) G8P_STQ(1, 0, t + 3)
    G8P_BAR; G8P_WL(0); G8P_MMA(0, 1, Q1) G8P_BAR;
    G8P_LDP(1, 1) G8P_STP(1, 0, t + 3)
    G8P_BAR; G8P_WL(0); G8P_MMA(1, 0, Q0) G8P_BAR; G8P_SCHED;
    G8P_STQ(1, 1, t + 3)
    G8P_WV(6); G8P_BAR; G8P_MMA(1, 1, Q1) G8P_BAR;
  }
  {
    G8P_LDQ(Q0, 0, 0) G8P_LDP(0, 0) G8P_STP(1, 1, nt - 1)
    G8P_BAR; G8P_WL(0); G8P_MMA(0, 0, Q0) G8P_BAR;
    G8P_LDQ(Q1, 0, 1) G8P_BAR; G8P_WL(0); G8P_MMA(0, 1, Q1) G8P_BAR;
    G8P_LDP(0, 1) G8P_WV(4); G8P_BAR; G8P_WL(0); G8P_MMA(1, 0, Q0) G8P_MMA(1, 1, Q1) G8P_BAR;
  }
  {
    G8P_LDQ(Q0, 1, 0) G8P_LDP(1, 0) G8P_WV(2); G8P_BAR; G8P_WL(0); G8P_MMA(0, 0, Q0) G8P_BAR;
    G8P_LDQ(Q1, 1, 1) G8P_WV(0); G8P_BAR; G8P_WL(0); G8P_MMA(0, 1, Q1) G8P_BAR;
    G8P_LDP(1, 1) G8P_BAR; G8P_WL(0); G8P_MMA(1, 0, Q0) G8P_MMA(1, 1, Q1) G8P_BAR;
  }
  if (wr == 0) G8P_BAR;
#undef G8P_ST
#undef G8P_STP
#undef G8P_STQ
#undef G8P_LDP
#undef G8P_LDQ
#undef G8P_MMA
#undef G8P_WV
#undef G8P_WL
#undef G8P_BAR
#undef G8P_SCHED
#pragma unroll
  for (int ai = 0; ai < 2; ++ai)
#pragma unroll
    for (int bj = 0; bj < 2; ++bj)
#pragma unroll
      for (int m = 0; m < 4; ++m)
#pragma unroll
        for (int n = 0; n < 2; ++n)
          ef(bj * 128 + wc * 32 + n * 16 + fr, ai * 128 + wr * 64 + m * 16 + fq * 4, acc[ai][bj][m][n][0], acc[ai][bj][m][n][1], acc[ai][bj][m][n][2], acc[ai][bj][m][n][3]);
}

#define EPI_FOR                                                   \
  _Pragma("unroll") for (int mt = 0; mt < 2; ++mt)                \
  _Pragma("unroll") for (int nt = 0; nt < 2; ++nt)                \
  _Pragma("unroll") for (int i = 0; i < 16; ++i)
#define EPI_R (wm * 64 + mt * 32 + (i & 3) + 8 * (i >> 2) + 4 * (lane >> 5))
#define EPI_C (wn * 64 + nt * 32 + (lane & 31))
#define SW_FOR                                                    \
  _Pragma("unroll") for (int mt = 0; mt < MT; ++mt)               \
  _Pragma("unroll") for (int nt = 0; nt < 2; ++nt)                \
  _Pragma("unroll") for (int q4 = 0; q4 < 4; ++q4)
#define SW_R (wm * (32 * MT) + mt * 32 + (lane & 31))
#define SW_C0 (wn * 64 + nt * 32 + 8 * q4 + 4 * (lane >> 5))
#define SW_V(j) acc[mt][nt][4 * q4 + (j)]
DI uint2 pack4(float a, float b, float c, float d) { uint2 w; w.x = pack2(a, b); w.y = pack2(c, d); return w; }

struct ARows { const u16* base; long ld; int nrows; DI const u16* operator()(int r) const { return base + (long)(r < nrows ? r : 0) * ld; }
  DI const u16* origin() const { return base; } DI int off(int r) const { return (r < nrows ? r : 0) * (int)ld; } };
struct BMat { const float* base; long ldb; int ncols; DI const float* operator()(int c4) const { return base + (c4 < ncols ? c4 : 0); } DI const u16* row(int) const { return nullptr; } };
struct BMatT { const u16* base; long ldb; DI const float* operator()(int) const { return nullptr; } DI const u16* row(int n) const { return base + (long)n * ldb; } };

DI void phase0(const Params& p, char* smem, int bid, int nblk) {
  const int tid = TIDX();
  for (int item = bid; item < 384 + 256 + 16 + 1 + 432; item += nblk) {
    if (item < 384) {
      const int cc = item % 24, kc = item / 24;
      const int col = cc * 256 + tid;
      float a0 = 0.f, a1 = 0.f;
#pragma unroll 1
      for (int half = 0; half < 2; ++half) {
        const int k0 = kc * 64 + half * 32;
        float w[32];
#pragma unroll
        for (int j = 0; j < 32; ++j) w[j] = p.w_ada[(long)(k0 + j) * 6144 + col];
#pragma unroll
        for (int j = 0; j < 32; ++j) {
          a0 += siluf(p.c[k0 + j]) * w[j];
          a1 += siluf(p.c[1024 + k0 + j]) * w[j];
        }
      }
      p.modp[(kc * 2 + 0) * 6144 + col] = a0;
      p.modp[(kc * 2 + 1) * 6144 + col] = a1;
    } else if (item < 640) {
      const int idx = (item - 384) * 256 + tid;
      const int c = idx & 127, d = (idx >> 7) & 63, h = idx >> 13;
      p.w_ukT[idx] = p.dsa_w_uk[c * 512 + h * 64 + d];
    } else if (item < 656) {
      const int part = item - 640;
      const int slot = tid >> 7, kk = tid & 127;
      float a = 0.f;
      for (int ld = part * 128; ld < part * 128 + 128; ++ld) a += p.cmp_pe[slot * 2048 + ld] * p.cmp_w1[((long)slot * 2048 + ld) * 128 + kk];
      p.pe_part[part * 256 + tid] = a;
    } else if (item == 656) {
      p.counts[tid * 32] = 0;
    } else {
      int it = item - 657;
      const float* W; u16* WT; int K, N, ntn;
      if (it < 288) { W = p.w_in; WT = p.w_inT; K = 1024; N = LDP; ntn = 18; }
      else if (it < 320) { it -= 288; W = p.w_bn; WT = p.w_bnT; K = 512; N = 1024; ntn = 4; }
      else if (it < 352) { it -= 320; W = p.w_bd; WT = p.w_bdT; K = 512; N = 1024; ntn = 4; }
      else if (it < 416) { it -= 352; W = p.w_out; WT = p.w_outT; K = 1024; N = 1024; ntn = 4; }
      else { it -= 416; W = p.router_w; WT = p.routerT; K = 1024; N = 256; ntn = 1; }
      const int k0 = (it / ntn) * 64 + (tid >> 6) * 16, n = (it % ntn) * 256 + (tid & 63) * 4;
      float4 v[16];
#pragma unroll
      for (int ps = 0; ps < 16; ++ps) {
        v[ps] = make_float4(0.f, 0.f, 0.f, 0.f);
        if (n < N) v[ps] = *(const float4*)(W + (long)(k0 + ps) * N + n);
      }
#define TR_ROW(J, C)                                                                                                         \
      {                                                                                                                      \
        uint4 a_, b_;                                                                                                        \
        a_.x = pack2(v[0].C, v[1].C); a_.y = pack2(v[2].C, v[3].C); a_.z = pack2(v[4].C, v[5].C); a_.w = pack2(v[6].C, v[7].C);          \
        b_.x = pack2(v[8].C, v[9].C); b_.y = pack2(v[10].C, v[11].C); b_.z = pack2(v[12].C, v[13].C); b_.w = pack2(v[14].C, v[15].C);    \
        uint4* dst_ = (uint4*)(WT + (long)(n + (J)) * K + k0);                                                               \
        dst_[0] = a_; dst_[1] = b_;                                                                                          \
      }
      TR_ROW(0, x) TR_ROW(1, y) TR_ROW(2, z) TR_ROW(3, w)
#undef TR_ROW
    }
  }
}

DI void phase1(const Params& p, char* smem, int bid, int nblk) {
  const int tid = TIDX(), lane = tid & 63, wid = __builtin_amdgcn_readfirstlane(tid >> 6);
  float* modl = (float*)smem;
  const int b = bid & 1;
#pragma unroll
  for (int i0 = 0; i0 < 8; i0 += 4) {
    float v[4];
#pragma unroll
    for (int ii = 0; ii < 4; ++ii) v[ii] = p.b_ada[tid + 256 * (i0 + ii)];
#pragma unroll
    for (int kc = 0; kc < 16; ++kc)
#pragma unroll
      for (int ii = 0; ii < 4; ++ii) v[ii] += p.modp[(kc * 2 + b) * 6144 + tid + 256 * (i0 + ii)];
#pragma unroll
    for (int ii = 0; ii < 4; ++ii) modl[tid + 256 * (i0 + ii)] = v[ii];
  }
  if (bid < 48) {
    const int idx = bid * 256 + tid;
    const int bb = idx / 6144, n = idx % 6144;
    float v = p.b_ada[n];
#pragma unroll
    for (int kc = 0; kc < 16; ++kc) v += p.modp[(kc * 2 + bb) * 6144 + n];
    p.mod[idx] = v;
  }
  hb_sync();
  float cm[16], ca[16];
#pragma unroll
  for (int i = 0; i < 4; ++i) {
    const int col = i * 256 + lane * 4;
    const float4 g = *(const float4*)(p.g_pre_mix + col);
    const float4 sh = *(const float4*)(modl + col), sc = *(const float4*)(modl + 1024 + col);
    cm[i * 4 + 0] = g.x * (1.f + sc.x); cm[i * 4 + 1] = g.y * (1.f + sc.y); cm[i * 4 + 2] = g.z * (1.f + sc.z); cm[i * 4 + 3] = g.w * (1.f + sc.w);
    ca[i * 4 + 0] = sh.x; ca[i * 4 + 1] = sh.y; ca[i * 4 + 2] = sh.z; ca[i * 4 + 3] = sh.w;
  }
  const int stride = (nblk >> 1) * 4;
  for (int t0 = (bid >> 1) * 4 + wid; t0 < T; t0 += 4 * stride) {
    float4 v[4][4];
#pragma unroll
    for (int k = 0; k < 4; ++k) {
      const int t = t0 + k * stride < T ? t0 + k * stride : T - 1;
      const float* xr = p.x + ((long)b * T + t) * 1024;
#pragma unroll
      for (int i = 0; i < 4; ++i) v[k][i] = *(const float4*)(xr + i * 256 + lane * 4);
    }
#pragma unroll
    for (int k = 0; k < 4; ++k) {
      float ss = 0.f;
#pragma unroll
      for (int i = 0; i < 4; ++i) ss += v[k][i].x * v[k][i].x + v[k][i].y * v[k][i].y + v[k][i].z * v[k][i].z + v[k][i].w * v[k][i].w;
      ss = wave_sum(ss);
      const float r = rsqrtf(ss * (1.f / 1024.f) + 1e-6f);
      if (t0 + k * stride < T) {
        u16* hr = p.h + ((long)b * T + t0 + k * stride) * 1024;
#pragma unroll
        for (int i = 0; i < 4; ++i) {
          const float o0 = v[k][i].x * r * cm[i * 4 + 0] + ca[i * 4 + 0];
          const float o1 = v[k][i].y * r * cm[i * 4 + 1] + ca[i * 4 + 1];
          const float o2 = v[k][i].z * r * cm[i * 4 + 2] + ca[i * 4 + 2];
          const float o3 = v[k][i].w * r * cm[i * 4 + 3] + ca[i * 4 + 3];
          *(uint2*)(hr + i * 256 + lane * 4) = pack4(o0, o1, o2, o3);
        }
      }
    }
  }
}

struct EpiProj {
  u16* proj; float* widx; int m0, n0;
  template <int MT> DI void operator()(f32x16 (&acc)[MT][2], int wm, int wn, int lane) const {
    SW_FOR {
      const int r = m0 + SW_R, c = n0 + SW_C0;
      if (c < LDP) {
        float v[4] = {SW_V(0), SW_V(1), SW_V(2), SW_V(3)};
        if (c < C_KV) { for (int j = 0; j < 4; ++j) v[j] *= 0.125f; }
        else if (c < C_GN) {}
        else if (c < C_QD) { for (int j = 0; j < 4; ++j) v[j] = sigmoidf(v[j]); }
        else if (c < C_QI) {}
        else if (c < C_KI) { for (int j = 0; j < 4; ++j) v[j] *= 0.125f; }
        else if (c < C_WI) {}
        else if (c < C_GM) {
          for (int j = 0; j < 4; ++j) v[j] *= 0.35355339059327373f;
          *(float4*)(widx + (long)r * 8 + (c - C_WI)) = make_float4(v[0], v[1], v[2], v[3]);
        } else { for (int j = 0; j < 4; ++j) v[j] = sigmoidf(v[j]); }
        *(uint2*)(proj + (long)r * LDP + c) = pack4(v[0], v[1], v[2], v[3]);
      }
    }
  }
};
struct EpiProjVT {
  u16* vt; int m0;
  DI void operator()(f32x16 (&acc)[2][2], int wm, int wn, int lane) const {
#pragma unroll
    for (int mt = 0; mt < 2; ++mt)
#pragma unroll
      for (int nt = 0; nt < 2; ++nt) {
        const int cc = EPI_C;
#pragma unroll
        for (int q4 = 0; q4 < 4; ++q4) {
          const int r = m0 + wm * 64 + mt * 32 + 8 * q4 + 4 * (lane >> 5);
          const int b = r >> 13, t = r & 8191;
          uint2 w;
          w.x = pack2(acc[mt][nt][q4 * 4 + 0], acc[mt][nt][q4 * 4 + 1]);
          w.y = pack2(acc[mt][nt][q4 * 4 + 2], acc[mt][nt][q4 * 4 + 3]);
          *(uint2*)(vt + ((long)(b * 128 + cc)) * T + t) = w;
        }
      }
  }
};
DI int proj_group(int q) { return q < 7 ? q : (q < 8 ? q + 1 : q + 2); }
DI void proj_store4(u16* proj, float* widx, long r, int c, float v0, float v1, float v2, float v3) {
  if (c < LDP) {
    float v[4] = {v0, v1, v2, v3};
    if (c < C_KV) { for (int j = 0; j < 4; ++j) v[j] *= 0.125f; }
    else if (c < C_GN) {}
    else if (c < C_QD) { for (int j = 0; j < 4; ++j) v[j] = sigmoidf(v[j]); }
    else if (c < C_QI) {}
    else if (c < C_KI) { for (int j = 0; j < 4; ++j) v[j] *= 0.125f; }
    else if (c < C_WI) {}
    else if (c < C_GM) {
      for (int j = 0; j < 4; ++j) v[j] *= 0.35355339059327373f;
      *(float4*)(widx + r * 8 + (c - C_WI)) = make_float4(v[0], v[1], v[2], v[3]);
    } else { for (int j = 0; j < 4; ++j) v[j] = sigmoidf(v[j]); }
    *(uint2*)(proj + r * LDP + c) = pack4(v[0], v[1], v[2], v[3]);
  }
}
struct WRows2 { const u16* base; int ra, rb; DI const u16* origin() const { return base; } DI int off(int r) const { return ((r < 128 ? ra : rb) + (r & 127)) * 1024; } };
struct Epi8Proj {
  u16* proj; float* widx; int m0, n0a, n0b;
  DI void operator()(int q, int c, float v0, float v1, float v2, float v3) const {
    proj_store4(proj, widx, m0 + q, (c < 128 ? n0a : n0b) + (c & 127), v0, v1, v2, v3);
  }
};
struct Epi8ProjVT {
  u16* vts; u16* vtw; int m0;
  DI void operator()(int q, int c, float v0, float v1, float v2, float v3) const {
    const int r = m0 + c, b = r >> 13, t = r & 8191;
    u16* vt = q < 128 ? vts : vtw;
    *(uint2*)(vt + ((long)(b * 128 + (q & 127))) * T + t) = pack4(v0, v1, v2, v3);
  }
};
DI void phase2_8w(const Params& p, int wg, int nwg) {
  for (int i = wg; i < 1280; i += nwg) {
    const int x_ = i & 7, s_ = (i >> 3) & 31, blk = (i >> 8) * 8 + x_;
    if (blk >= 36) continue;
    const int nb = blk % 9, mb = blk / 9;
    const int mt_ = mb * 16 + (s_ >> 1), v = 2 * nb + (s_ & 1);
    ARows tf{p.h + (long)mt_ * 256 * 1024, 1024, 256};
    if (v < 17) {
      const int ga = proj_group(2 * v), gb = proj_group(2 * v + 1);
      WRows2 wf{p.w_inT, ga * 128, gb * 128};
      Epi8Proj ef{p.proj, p.widx, mt_ * 256, ga * 128, gb * 128};
      gemm8p(16, wf, tf, ef);
    } else {
      WRows2 wf{p.w_inT, 7 * 128, 9 * 128};
      Epi8ProjVT ef{p.vts, p.vtw, mt_ * 256};
      gemm8p(16, tf, wf, ef);
    }
  }
}
DI void phase2(const Params& p, char* smem, int bid, int nblk) {}

struct ACmp {
  const u16* proj; int slot, m0, kt0;
  DI const u16* operator()(int r) const {
    const int R = m0 + r, bg = R >> 9, n = R & 511, b = bg >> 1, g = bg & 1;
    const int nc = n >= 511 ? 510 : n;
    return proj + ((long)b * T + 16 * nc + kt0) * LDP + C_KV + slot * 128 + g * 64;
  }
};
struct EpiPartF32 {
  float* dst; int m0;
  DI void operator()(f32x16 (&acc)[2][2], int wm, int wn, int lane) const {
    constexpr int MT = 2;
    SW_FOR { *(float4*)(dst + (long)(m0 + SW_R) * 128 + SW_C0) = make_float4(SW_V(0), SW_V(1), SW_V(2), SW_V(3)); }
  }
};
struct EpiCmp1 {
  u16* zc; const float* b1; const float* pe_part; int slot, m0;
  DI void operator()(f32x16 (&acc)[2][2], int wm, int wn, int lane) const {
    constexpr int MT = 2;
#pragma unroll
    for (int nt = 0; nt < 2; ++nt)
#pragma unroll
      for (int q4 = 0; q4 < 4; ++q4) {
        const int c = SW_C0;
        float4 bias = *(const float4*)(b1 + slot * 128 + c);
        for (int q = 0; q < 16; ++q) {
          const float4 t = *(const float4*)(pe_part + q * 256 + slot * 128 + c);
          bias.x += t.x; bias.y += t.y; bias.z += t.z; bias.w += t.w;
        }
#pragma unroll
        for (int mt = 0; mt < 2; ++mt) {
          const int R = m0 + SW_R;
          *(uint2*)(zc + ((long)slot * 2048 + R) * 128 + c) =
              pack4(gelu_tanh(SW_V(0) + bias.x), gelu_tanh(SW_V(1) + bias.y), gelu_tanh(SW_V(2) + bias.z), gelu_tanh(SW_V(3) + bias.w));
        }
      }
  }
};
struct EpiQlat {
  u16* qlat; int h, m0;
  DI void operator()(f32x16 (&acc)[2][2], int wm, int wn, int lane) const {
    constexpr int MT = 2;
    SW_FOR {
      const int r = m0 + SW_R, c = SW_C0;
      *(uint2*)(qlat + ((long)r * 8 + h) * 128 + c) = pack4(SW_V(0) * 0.125f, SW_V(1) * 0.125f, SW_V(2) * 0.125f, SW_V(3) * 0.125f);
    }
  }
};
constexpr int IDX_QLD = 520;
constexpr int IDX_NITEMS = 1152;
DI void indexer_item2(const Params& p, char* smem, int b, int tq, int c) {
  const int tid = TIDX(), lane = tid & 63, wid = __builtin_amdgcn_readfirstlane(tid >> 6);
  u16* Qs = (u16*)smem;
  float* wl = (float*)(smem + 64 * IDX_QLD * 2);
  const u16* projb = p.proj + (long)b * T * LDP;
  const int t0 = tq * 64;
  {
    uint4 q[16];
#pragma unroll
    for (int i = 0; i < 16; ++i) q[i] = *(const uint4*)(projb + (long)(t0 + i * 4 + wid) * LDP + C_QI + lane * 8);
    const float2 wv = *(const float2*)(p.widx + ((long)b * T + t0) * 8 + tid * 2);
#pragma unroll
    for (int i = 0; i < 16; ++i) *(uint4*)(Qs + (i * 4 + wid) * IDX_QLD + lane * 8) = q[i];
    *(float2*)(wl + tid * 2) = wv;
  }
  hb_sync();
  const int r31 = lane & 31, hf = lane >> 5;
  const int kt_lo = c * 16, kt_hi = (kt_lo + 16 < tq + 1) ? kt_lo + 16 : tq + 1;
  const u16* qfrag = Qs + r31 * IDX_QLD + hf * 8;
  const float* wq = wl + r31 * 8;
  const u16* kbase = projb + (long)r31 * LDP + C_KI + hf * 8;
  bf16x8 kn[2][4];
#define IDX2_LOADK(KT)                                                                                   \
  {                                                                                                      \
    const int kk_ = (KT) < kt_hi ? (KT) : kt_hi - 1;                                                     \
    _Pragma("unroll") for (int nt = 0; nt < 2; ++nt)                                                     \
      _Pragma("unroll") for (int ks = 0; ks < 4; ++ks) kn[nt][ks] = *(const bf16x8*)(kbase + (long)(kk_ * 64 + nt * 32) * LDP + ks * 16); \
  }
  IDX2_LOADK(kt_lo + wid)
#pragma unroll 1
  for (int kt = kt_lo + wid; kt < kt_hi; kt += 4) {
    bf16x8 kf[2][4];
#pragma unroll
    for (int nt = 0; nt < 2; ++nt)
#pragma unroll
      for (int ks = 0; ks < 4; ++ks) kf[nt][ks] = kn[nt][ks];
    IDX2_LOADK(kt + 4)
    asm volatile("" ::: "memory");
    f32x16 sum[2][2];
#pragma unroll
    for (int a = 0; a < 2; ++a)
#pragma unroll
      for (int d = 0; d < 2; ++d)
#pragma unroll
        for (int i = 0; i < 16; ++i) sum[a][d][i] = 0.f;
#define IDX2_LOADQ(DST, MT, H)                                                                          \
  {                                                                                                      \
    const int h_ = (H) < 7 ? (H) : 7;                                                                    \
    _Pragma("unroll") for (int ks = 0; ks < 4; ++ks) DST[ks] = *(const bf16x8*)(qfrag + (MT) * 32 * IDX_QLD + h_ * 64 + ks * 16); \
  }
#define IDX2_CHAIN(ACC, SRC, NT)                                                                         \
  {                                                                                                      \
    _Pragma("unroll") for (int i = 0; i < 16; ++i) ACC[i] = 0.f;                                         \
    _Pragma("unroll") for (int ks = 0; ks < 4; ++ks) ACC = __builtin_amdgcn_mfma_f32_32x32x16_bf16(kf[NT][ks], SRC[ks], ACC, 0, 0, 0); \
  }
#define IDX2_ACCUM(ACC, MT, NT, W)                                                                       \
  {                                                                                                      \
    _Pragma("unroll") for (int i = 0; i < 16; ++i) {                                                     \
      const int rb_ = __float_as_int(ACC[i]);                                                            \
      sum[MT][NT][i] += (W) * __int_as_float(rb_ > 0 ? rb_ : 0);                                         \
    }                                                                                                    \
  }
#define IDX2_SGB4 \
  __builtin_amdgcn_sched_group_barrier(0x008, 1, 0); __builtin_amdgcn_sched_group_barrier(0x002, 6, 0); \
  __builtin_amdgcn_sched_group_barrier(0x008, 1, 0); __builtin_amdgcn_sched_group_barrier(0x002, 6, 0); \
  __builtin_amdgcn_sched_group_barrier(0x008, 1, 0); __builtin_amdgcn_sched_group_barrier(0x002, 6, 0); \
  __builtin_amdgcn_sched_group_barrier(0x008, 1, 0); __builtin_amdgcn_sched_group_barrier(0x002, 6, 0);
    bf16x8 sa[4], sb[4];
    f32x16 accA, accB;
    IDX2_LOADQ(sa, 0, 0)
    IDX2_LOADQ(sb, 1, 0)
    float w0 = wq[0], w1 = wq[256];
    IDX2_CHAIN(accA, sa, 0)
#pragma unroll 1
    for (int h = 0; h < 8; ++h) {
      const int hn = h < 7 ? h + 1 : 7;
      IDX2_CHAIN(accB, sa, 1)
      IDX2_ACCUM(accA, 0, 0, w0)
      IDX2_LOADQ(sa, 0, h + 1)
      IDX2_CHAIN(accA, sb, 0)
      IDX2_ACCUM(accB, 0, 1, w0)
      IDX2_CHAIN(accB, sb, 1)
      IDX2_ACCUM(accA, 1, 0, w1)
      IDX2_LOADQ(sb, 1, h + 1)
      const float w0n = wq[hn], w1n = wq[256 + hn];
      IDX2_CHAIN(accA, sa, 0)
      IDX2_ACCUM(accB, 1, 1, w1)
      w0 = w0n; w1 = w1n;
      IDX2_SGB4
      IDX2_SGB4
      __builtin_amdgcn_sched_group_barrier(0x100, 5, 0);
      IDX2_SGB4
      IDX2_SGB4
      __builtin_amdgcn_sched_group_barrier(0x100, 5, 0);
    }
#undef IDX2_LOADQ
#undef IDX2_CHAIN
#undef IDX2_ACCUM
#undef IDX2_SGB4
    const int s0 = kt * 64;
#pragma unroll
    for (int mt = 0; mt < 2; ++mt)
#pragma unroll
      for (int nt = 0; nt < 2; ++nt)
#pragma unroll
        for (int q4 = 0; q4 < 4; ++q4) {
          typedef _Float16 h4_t __attribute__((ext_vector_type(4)));
          typedef float f4_t __attribute__((ext_vector_type(4)));
          const f4_t v4 = {sum[mt][nt][4 * q4], sum[mt][nt][4 * q4 + 1], sum[mt][nt][4 * q4 + 2], sum[mt][nt][4 * q4 + 3]};
          *(h4_t*)((u16*)p.scores + ((long)b * T + t0 + mt * 32 + r31) * T + s0 + nt * 32 + 8 * q4 + 4 * hf) = __builtin_convertvector(v4, h4_t);
        }
  }
#undef IDX2_LOADK
}
DI void phase3(const Params& p, char* smem, int bid, int nblk) {
  const int tid = TIDX(), lane = tid & 63, wid = __builtin_amdgcn_readfirstlane(tid >> 6);
  if (bid < 128) {
    const int kq = bid & 3, tile = bid >> 2, slot = tile >> 4, mt_ = tile & 15;
    ACmp af{p.proj, slot, mt_ * 128, kq * 8};
    BMat bf{p.cmp_w1 + ((long)slot * 2048 + kq * 512) * 128, 128, 128};
    EpiPartF32 ef{p.cpart + ((long)kq * 4096 + slot * 2048) * 128, mt_ * 128};
    gemm_tile(smem, 8, LDP, af, bf, ef);
  }
  int* qslot = (int*)(smem + 64 * IDX_QLD * 2 + 2048);
  unsigned* qctr = p.bar + XCD_BAR_WORDS;
  hb_sync();
  if (tid == 0) *qslot = (int)atomicAdd(qctr, 1u);
  for (;;) {
    hb_sync();
    const int i = __builtin_amdgcn_readfirstlane(*qslot);
    if (i >= IDX_NITEMS + 1024 + 512) break;
    int nxt = 0;
    if (tid == 0) nxt = (int)atomicAdd(qctr, 1u);
    if (i < IDX_NITEMS) {
      const int b = i & 1;
      int j = i >> 1, c = 0;
      while (j >= 128 - 16 * c) { j -= 128 - 16 * c; ++c; }
      indexer_item2(p, smem, b, 127 - j, c);
    } else if (i < IDX_NITEMS + 1024) {
      const int it = i - IDX_NITEMS, h = it & 7, mt_ = it >> 3;
      ARows af{p.proj + (long)mt_ * 128 * LDP + C_QD + h * 64, LDP, 128};
      BMat bf{p.w_ukT + h * 64 * 128, 128, 128};
      EpiQlat ef{p.qlat, h, mt_ * 128};
      gemm_tile<true, true>(smem, 1, 64, af, bf, ef);
    } else {
      const int it = i - IDX_NITEMS - 1024;
      const float n0 = p.dsa_kv_norm[lane * 2], n1 = p.dsa_kv_norm[lane * 2 + 1];
      unsigned u[8];
#pragma unroll
      for (int q = 0; q < 8; ++q) u[q] = *(const unsigned*)(p.proj + (long)(it * 32 + wid * 8 + q) * LDP + C_CKV + lane * 2);
#pragma unroll
      for (int q = 0; q < 8; ++q) {
        const float a = lo16(u[q]), b = hi16(u[q]);
        const float ss = wave_sum(a * a + b * b);
        const float r = rsqrtf(ss * (1.f / 128.f) + 1e-6f);
        *(unsigned*)(p.ckv + (long)(it * 32 + wid * 8 + q) * 128 + lane * 2) = pack2(a * r * n0, b * r * n1);
      }
    }
    hb_sync();
    if (tid == 0) *qslot = nxt;
  }
}

struct EpiCmp2 {
  u16* dst; int m0;
  DI void operator()(f32x16 (&acc)[2][2], int wm, int wn, int lane) const {
    constexpr int MT = 2;
    SW_FOR {
      const int R = m0 + SW_R, c = SW_C0;
      if (c < 64) *(uint2*)(dst + (long)R * 64 + c) = pack4(SW_V(0), SW_V(1), SW_V(2), SW_V(3));
    }
  }
};
struct EpiCmp2T {
  u16* dst; int m0;
  DI void operator()(f32x16 (&acc)[2][2], int wm, int wn, int lane) const {
#pragma unroll
    for (int mt = 0; mt < 2; ++mt)
#pragma unroll
      for (int nt = 0; nt < 2; ++nt) {
        const int c = EPI_C;
        if (c < 64) {
#pragma unroll
          for (int q4 = 0; q4 < 4; ++q4) {
            const int R = m0 + wm * 64 + mt * 32 + 8 * q4 + 4 * (lane >> 5);
            const int bg = R >> 9, n = R & 511;
            *(uint2*)(dst + ((long)(bg * 64 + c)) * 512 + n) =
                pack4(acc[mt][nt][q4 * 4 + 0], acc[mt][nt][q4 * 4 + 1], acc[mt][nt][q4 * 4 + 2], acc[mt][nt][q4 * 4 + 3]);
          }
        }
      }
  }
};
DI void indexer_item(const Params& p, char* smem, int item) {
  const int tid = TIDX(), lane = tid & 63, wid = __builtin_amdgcn_readfirstlane(tid >> 6);
  int b = 0, rem = item;
  if (rem >= 2080) { b = 1; rem -= 2080; }
  int qt = (int)((sqrtf(8.f * rem + 1.f) - 1.f) * 0.5f);
  while ((qt + 1) * (qt + 2) / 2 <= rem) ++qt;
  while (qt * (qt + 1) / 2 > rem) --qt;
  const int kt = rem - qt * (qt + 1) / 2;
  const int t0 = qt * 128 + (wid >> 1) * 64, s0 = kt * 128 + (wid & 1) * 64;
  if (s0 > t0 + 63) return;
  float* wl = (float*)smem + wid * 512;
  const float* wsrc = p.widx + ((long)b * T + t0) * 8;
#pragma unroll
  for (int i = 0; i < 8; ++i) wl[i * 64 + lane] = wsrc[i * 64 + lane];
  wave_sync();
  const u16* projb = p.proj + (long)b * T * LDP;
  const int r31 = lane & 31, hf = lane >> 5;
  u16* Kt = (u16*)(smem + 8192) + wid * (64 * 72);
  {
    const int piece = lane & 7, rb = lane >> 3;
#pragma unroll
    for (int i = 0; i < 8; ++i) {
      const uint4 v = *(const uint4*)(projb + (long)(s0 + rb + 8 * i) * LDP + C_KI + piece * 8);
      *(uint4*)(Kt + (rb + 8 * i) * 72 + piece * 8) = v;
    }
  }
  wave_sync();
  const u16* kfrag = Kt + r31 * 72 + hf * 8;
  f32x16 sum[2][2];
#pragma unroll
  for (int a = 0; a < 2; ++a)
#pragma unroll
    for (int c = 0; c < 2; ++c)
#pragma unroll
      for (int i = 0; i < 16; ++i) sum[a][c][i] = 0.f;
  const u16* qbase = projb + (long)(t0 + r31) * LDP + C_QI + hf * 8;
  bf16x8 af0[4], af1[4], af2[4], af3[4];
#define IDX_LOADQ(DST, STEP)                                                                            \
  {                                                                                                     \
    const int st_ = (STEP) < 15 ? (STEP) : 15;                                                          \
    _Pragma("unroll") for (int ks = 0; ks < 4; ++ks) DST[ks] = *(const bf16x8*)(qbase + (long)(st_ & 1) * 32 * LDP + (st_ >> 1) * 64 + ks * 16); \
  }
#define IDX_STEP(SRC, MT, H)                                                                            \
  {                                                                                                     \
    const float w_ = wl[((MT) * 32 + r31) * 8 + (H)];                                                   \
    _Pragma("unroll") for (int nt = 0; nt < 2; ++nt) {                                                  \
      f32x16 acc;                                                                                       \
      _Pragma("unroll") for (int i = 0; i < 16; ++i) acc[i] = 0.f;                                      \
      _Pragma("unroll") for (int ks = 0; ks < 4; ++ks) acc = __builtin_amdgcn_mfma_f32_32x32x16_bf16(*(const bf16x8*)(kfrag + nt * 32 * 72 + ks * 16), SRC[ks], acc, 0, 0, 0); \
      _Pragma("unroll") for (int i = 0; i < 16; ++i) sum[MT][nt][i] += w_ * fmaxf(acc[i], 0.f);        \
    }                                                                                                   \
  }
  IDX_LOADQ(af0, 0) IDX_LOADQ(af1, 1) IDX_LOADQ(af2, 2)
#pragma unroll 1
  for (int s4 = 0; s4 < 16; s4 += 4) {
    IDX_LOADQ(af3, s4 + 3)
    asm volatile("" ::: "memory");
    IDX_STEP(af0, 0, s4 >> 1)
    asm volatile("" ::: "memory");
    IDX_LOADQ(af0, s4 + 4)
    asm volatile("" ::: "memory");
    IDX_STEP(af1, 1, s4 >> 1)
    asm volatile("" ::: "memory");
    IDX_LOADQ(af1, s4 + 5)
    asm volatile("" ::: "memory");
    IDX_STEP(af2, 0, (s4 >> 1) + 1)
    asm volatile("" ::: "memory");
    IDX_LOADQ(af2, s4 + 6)
    asm volatile("" ::: "memory");
    IDX_STEP(af3, 1, (s4 >> 1) + 1)
    asm volatile("" ::: "memory");
  }
#undef IDX_LOADQ
#undef IDX_STEP
#pragma unroll
  for (int mt = 0; mt < 2; ++mt)
#pragma unroll
    for (int nt = 0; nt < 2; ++nt)
#pragma unroll
      for (int q4 = 0; q4 < 4; ++q4)
      {
        typedef _Float16 h4_t __attribute__((ext_vector_type(4)));
        typedef float f4_t __attribute__((ext_vector_type(4)));
        const f4_t v4 = {sum[mt][nt][4 * q4], sum[mt][nt][4 * q4 + 1], sum[mt][nt][4 * q4 + 2], sum[mt][nt][4 * q4 + 3]};
        *(h4_t*)((u16*)p.scores + ((long)b * T + t0 + mt * 32 + r31) * T + s0 + nt * 32 + 8 * q4 + 4 * hf) = __builtin_convertvector(v4, h4_t);
      }
}
DI void topk_row(const Params& p, int b, int t, int lane);
DI void phase4(const Params& p, char* smem, int bid, int nblk) {
  if (bid < 32) {
    const int slot = bid >> 4, mt_ = bid & 15;
    {
      const int tid = TIDX(), c = (tid & 31) * 4;
      float4 bias = *(const float4*)(p.cmp_b1 + slot * 128 + c);
      for (int q = 0; q < 16; ++q) {
        const float4 t = *(const float4*)(p.pe_part + q * 256 + slot * 128 + c);
        bias.x += t.x; bias.y += t.y; bias.z += t.z; bias.w += t.w;
      }
#pragma unroll 4
      for (int i = 0; i < 16; ++i) {
        const long R = (long)slot * 2048 + mt_ * 128 + (tid >> 5) + 8 * i;
        float4 v = *(const float4*)(p.cpart + R * 128 + c);
#pragma unroll
        for (int kq = 1; kq < 4; ++kq) {
          const float4 t = *(const float4*)(p.cpart + ((long)kq * 4096 + R) * 128 + c);
          v.x += t.x; v.y += t.y; v.z += t.z; v.w += t.w;
        }
        *(uint2*)(p.zc + R * 128 + c) = pack4(gelu_tanh(v.x + bias.x), gelu_tanh(v.y + bias.y), gelu_tanh(v.z + bias.z), gelu_tanh(v.w + bias.w));
      }
      hb_sync();
    }
    ARows af{p.zc + ((long)slot * 2048 + mt_ * 128) * 128, 128, 128};
    BMat bf{p.cmp_w2 + slot * 128 * 64, 64, 64};
    if (slot) { EpiCmp2T ef{p.vcT, mt_ * 128}; gemm_tile<false>(smem, 2, 64, af, bf, ef); }
    else { EpiCmp2 ef{p.kc, mt_ * 128}; gemm_tile(smem, 2, 64, af, bf, ef); }
  }
  const int tid = TIDX(), lane = tid & 63, wid = __builtin_amdgcn_readfirstlane(tid >> 6);
  for (int item = bid; item < 2048; item += nblk) {
    const int it = item < 1024 ? 2047 - item : item - 1024;
    const int b = it & 1, tb = it >> 1;
#pragma unroll 1
    for (int q = 0; q < 2; ++q) {
      asm volatile("" ::: "memory");
      topk_row(p, b, tb * 8 + wid * 2 + q, lane);
    }
  }
}

#define MFMA16(a, b, c) __builtin_amdgcn_mfma_f32_16x16x32_bf16((a), (b), (c), 0, 0, 0)
#define MFMA32(a, b, c) __builtin_amdgcn_mfma_f32_32x32x16_bf16((a), (b), (c), 0, 0, 0)

constexpr int NSA_STAGE_BYTES = 64 * 72 * 2 + 64 * 68 * 2;
DI void dense_scores(f32x16 (&acc)[2], const u16* Ks, const bf16x8 (&qf)[4], int lane) {
  const int r = lane & 31, hf = lane >> 5;
  bf16x8 kf[2][4];
#pragma unroll
  for (int tile = 0; tile < 2; ++tile)
#pragma unroll
    for (int ks = 0; ks < 4; ++ks) kf[tile][ks] = *(const bf16x8*)(Ks + (32 * tile + r) * 72 + 8 * hf + 16 * ks);
  asm volatile("" ::: "memory");
#pragma unroll
  for (int tile = 0; tile < 2; ++tile) {
    f32x16 c;
#pragma unroll
    for (int i = 0; i < 16; ++i) c[i] = 0.f;
#pragma unroll
    for (int ks = 0; ks < 4; ++ks) c = MFMA32(kf[tile][ks], qf[ks], c);
    acc[tile] = c;
  }
}
DI void dense_pv(const f32x16 (&acc)[2], const u16* Vs, int lane, f32x16 (&o)[2]) {
  const int r = lane & 31, hf = lane >> 5;
  uint2 vlo[2][2][2], vhi[2][2][2];
#pragma unroll
  for (int tile = 0; tile < 2; ++tile)
#pragma unroll
    for (int s = 0; s < 2; ++s)
#pragma unroll
      for (int dt = 0; dt < 2; ++dt) {
        const u16* vp = Vs + (32 * dt + r) * 68 + 32 * tile + 16 * s + 4 * hf;
        vlo[tile][s][dt] = *(const uint2*)vp;
        vhi[tile][s][dt] = *(const uint2*)(vp + 8);
      }
  asm volatile("" ::: "memory");
#pragma unroll
  for (int tile = 0; tile < 2; ++tile)
#pragma unroll
    for (int s = 0; s < 2; ++s) {
      uint4 w;
      w.x = pack2(acc[tile][8 * s + 0], acc[tile][8 * s + 1]);
      w.y = pack2(acc[tile][8 * s + 2], acc[tile][8 * s + 3]);
      w.z = pack2(acc[tile][8 * s + 4], acc[tile][8 * s + 5]);
      w.w = pack2(acc[tile][8 * s + 6], acc[tile][8 * s + 7]);
      const bf16x8 pb = __builtin_bit_cast(bf16x8, w);
#pragma unroll
      for (int dt = 0; dt < 2; ++dt) {
        uint4 a;
        a.x = vlo[tile][s][dt].x; a.y = vlo[tile][s][dt].y; a.z = vhi[tile][s][dt].x; a.w = vhi[tile][s][dt].y;
        o[dt] = MFMA32(__builtin_bit_cast(bf16x8, a), pb, o[dt]);
      }
    }
}
constexpr float LOG2E = 1.4426950408889634f;
template <int DSTEP>
DI float dense_mask(f32x16 (&acc)[2], bool active, int lo_c, int hi_c, int dist0_c, int dmin_u, const float* btab_h, int lane) {
  const int hf = lane >> 5;
  const bool colfull = !active || (lo_c <= 0 && hi_c >= 63);
  float mx = -INFINITY;
  if (dmin_u >= 128 && __ballot(colfull) == ~0ull) {
    const float be = active ? btab_h[128] : -INFINITY;
#pragma unroll
    for (int tile = 0; tile < 2; ++tile)
#pragma unroll
      for (int i = 0; i < 16; ++i) {
        const float sv = fmaf(acc[tile][i], LOG2E, be);
        acc[tile][i] = sv;
        mx = fmaxf(mx, sv);
      }
  } else {
    const int lo2 = active ? lo_c : 1, hi2 = active ? hi_c : 0;
#pragma unroll
    for (int tile = 0; tile < 2; ++tile)
#pragma unroll
      for (int i = 0; i < 16; ++i) {
        const int kl = 32 * tile + (i & 3) + 8 * (i >> 2) + 4 * hf;
        int dc = dist0_c - DSTEP * kl;
        dc = dc < 0 ? 0 : (dc > 128 ? 128 : dc);
        const float bias = btab_h[dc];
        const float s2 = fmaf(acc[tile][i], LOG2E, bias);
        const float sv = (kl >= lo2 && kl <= hi2) ? s2 : -INFINITY;
        acc[tile][i] = sv;
        mx = fmaxf(mx, sv);
      }
  }
  return fmaxf(mx, __shfl_xor(mx, 32));
}
DI void dense_chunk(const u16* Ks, const u16* Vs, bool active, int lo_c, int hi_c, int dist0_c, int dmin_u, const bf16x8 (&qf)[4],
                    const float* btab_h, int lane, float& m, float& l, f32x16 (&o)[2]) {
  f32x16 acc[2];
  dense_scores(acc, Ks, qf, lane);
  const float mx = dense_mask<1>(acc, active, lo_c, hi_c, dist0_c, dmin_u, btab_h, lane);
  const float mn = fmaxf(m, mx);
  const float alpha = __builtin_amdgcn_exp2f(m - mn);
  float ls = 0.f;
#pragma unroll
  for (int tile = 0; tile < 2; ++tile)
#pragma unroll
    for (int i = 0; i < 16; ++i) {
      const float pv = __builtin_amdgcn_exp2f(acc[tile][i] - mn);
      acc[tile][i] = pv;
      ls += pv;
    }
  ls += __shfl_xor(ls, 32);
  l = l * alpha + ls;
  m = mn;
  o[0] *= alpha;
  o[1] *= alpha;
  dense_pv(acc, Vs, lane, o);
}

template <int KSG, int VSG, bool NEEDV, class Next, class Body>
DI void chunk_pipeline(char* stage, const u16* kg0, const u16* vg0, int first, int tid, const Next& next, const Body& body) {
  const int srow = tid >> 3, spiece = tid & 7;
  uint4 rk0, rv0;
  rv0 = make_uint4(0, 0, 0, 0);
  int d = first;
#define NSA_GLOAD(D)                                                                      \
  {                                                                                       \
    rk0 = *(const uint4*)(kg0 + ((long)(D) * 64 + srow) * KSG + spiece * 8);              \
    if (NEEDV) rv0 = *(const uint4*)(vg0 + (long)srow * VSG + (D) * 64 + spiece * 8);     \
  }
  if (d >= 0) NSA_GLOAD(d)
  int ph = 0;
  __syncthreads();
  while (d >= 0) {
    u16* Ks = (u16*)(stage + ph * NSA_STAGE_BYTES);
    u16* Vs = Ks + 64 * 72;
    *(uint4*)(Ks + srow * 72 + spiece * 8) = rk0;
    if (NEEDV) {
      uint2* dv = (uint2*)(Vs + srow * 68 + spiece * 8);
      dv[0] = make_uint2(rv0.x, rv0.y); dv[1] = make_uint2(rv0.z, rv0.w);
    }
    const int dn = next(d);
    if (dn >= 0) NSA_GLOAD(dn)
    __syncthreads();
    body(d, Ks, Vs);
    ph ^= 1;
    d = dn;
  }
#undef NSA_GLOAD
}

DI void nsa_item(const Params& p, char* smem, int item) {
  const int tid = TIDX8(), lane = tid & 63, wid = __builtin_amdgcn_readfirstlane(tid >> 6);
  const int chunk = item & 127, g = (item >> 7) & 1, b = item >> 8;
  const int bg = b * 2 + g;
  float* btab = (float*)smem;
  u64* wun = (u64*)(smem + 2304);
  float* imps = (float*)(smem + 4096) + wid * 1056;
  char* stage = smem + 37888;
  for (int idx = tid; idx < 4 * 129; idx += 512) {
    const int h = idx / 129, d = idx % 129;
    const int bk = d < 128 ? BUCKET[d] : 31;
    btab[h * 132 + d] = p.rel_bias[bk * 16 + g * 4 + h] * LOG2E;
  }
  __syncthreads();
  const int t0 = chunk * 64;
  const int tw = t0 + wid * 8;
  const int c = lane & 31, hf = lane >> 5, qi = c >> 2, hh = c & 3;
  const int t_c = tw + qi;
  const int cur = t0 >> 6;
  const long row = (long)b * T + t_c;
  const u16* prow = p.proj + row * LDP;
  const u16* projb = p.proj + (long)b * T * LDP;
  const float* btab_h = btab + hh * 132;
  bf16x8 qf[4];
#pragma unroll
  for (int ks = 0; ks < 4; ++ks) qf[ks] = *(const bf16x8*)(prow + C_QN + (g * 4 + hh) * 64 + ks * 16 + hf * 8);
  const u16* gptr = prow + C_GN + (g * 4 + hh) * 3;
  for (int k = lane; k < 1056; k += 64) imps[k] = 0.f;
  u16* orow = p.onsa + row * 512 + (g * 4 + hh) * 64 + 4 * hf;
  auto emit = [&](const f32x16 (&o)[2], float sc, bool first) {
#pragma unroll
    for (int dt = 0; dt < 2; ++dt)
#pragma unroll
      for (int q4 = 0; q4 < 4; ++q4) {
        uint2* dst = (uint2*)(orow + 32 * dt + 8 * q4);
        float v0 = o[dt][4 * q4 + 0] * sc, v1 = o[dt][4 * q4 + 1] * sc, v2 = o[dt][4 * q4 + 2] * sc, v3 = o[dt][4 * q4 + 3] * sc;
        if (!first) {
          const uint2 u = *dst;
          v0 += lo16(u.x); v1 += hi16(u.x); v2 += lo16(u.y); v3 += hi16(u.y);
        }
        uint2 w;
        w.x = pack2(v0, v1);
        w.y = pack2(v2, v3);
        *dst = w;
      }
  };
  const int ncv_c = (t_c >= 31) ? ((t_c - 31) >> 4) + 1 : 0;
  const int ncv_max = ((t0 + 63 - 31) >> 4) + 1;
  const int nchunk_c = (ncv_max + 63) >> 6;
  {
    const u16* kcb = p.kc + (long)bg * 512 * 64;
    const u16* vcb = p.vcT + (long)bg * 64 * 512;
    float m = -1e30f, l = 0.f;
    auto next_c = [&](int d) { return d + 1 < nchunk_c ? d + 1 : -1; };
    chunk_pipeline<64, 512, false>(stage, kcb, vcb, 0, tid, next_c, [&](int i, const u16* Ks, const u16* Vs) {
      f32x16 acc[2];
      dense_scores(acc, Ks, qf, lane);
      const float mx = dense_mask<16>(acc, true, 0, ncv_c - 1 - i * 64, t_c - 31 - 1024 * i, tw - 31 - 1024 * i - 1008, btab_h, lane);
      const float mn = fmaxf(m, mx);
      float ls = 0.f;
#pragma unroll
      for (int tile = 0; tile < 2; ++tile)
#pragma unroll
        for (int q = 0; q < 16; ++q) ls += __builtin_amdgcn_exp2f(acc[tile][q] - mn);
      ls += __shfl_xor(ls, 32);
      l = l * __builtin_amdgcn_exp2f(m - mn) + ls;
      m = mn;
    });
    const float invl = 1.f / fmaxf(l, 1e-30f);
    f32x16 oc[2];
#pragma unroll
    for (int i = 0; i < 16; ++i) { oc[0][i] = 0.f; oc[1][i] = 0.f; }
    chunk_pipeline<64, 512, true>(stage, kcb, vcb, 0, tid, next_c, [&](int i, const u16* Ks, const u16* Vs) {
      f32x16 acc[2];
      dense_scores(acc, Ks, qf, lane);
      (void)dense_mask<16>(acc, true, 0, ncv_c - 1 - i * 64, t_c - 31 - 1024 * i, tw - 31 - 1024 * i - 1008, btab_h, lane);
      float part[2][4], spill[2][4];
#pragma unroll
      for (int tile = 0; tile < 2; ++tile) {
#pragma unroll
        for (int q = 0; q < 16; ++q) acc[tile][q] = __builtin_amdgcn_exp2f(acc[tile][q] - m) * invl;
#pragma unroll
        for (int q4 = 0; q4 < 4; ++q4) {
          float pa = acc[tile][4 * q4] + acc[tile][4 * q4 + 1] + acc[tile][4 * q4 + 2] + 0.5f * acc[tile][4 * q4 + 3];
          float sp = 0.5f * acc[tile][4 * q4 + 3];
          pa += __shfl_xor(pa, 1); pa += __shfl_xor(pa, 2);
          sp += __shfl_xor(sp, 1); sp += __shfl_xor(sp, 2);
          part[tile][q4] = pa; spill[tile][q4] = sp;
        }
      }
      if (hh == 0) {
#pragma unroll
        for (int tile = 0; tile < 2; ++tile)
#pragma unroll
          for (int q4 = 0; q4 < 4; ++q4) imps[qi * 132 + 16 * i + 8 * tile + 2 * q4 + hf] += part[tile][q4];
      }
      wave_sync();
      if (hh == 0) {
#pragma unroll
        for (int tile = 0; tile < 2; ++tile)
#pragma unroll
          for (int q4 = 0; q4 < 4; ++q4) imps[qi * 132 + 16 * i + 8 * tile + 2 * q4 + hf + 1] += spill[tile][q4];
      }
      wave_sync();
      dense_pv(acc, Vs, lane, oc);
    });
    emit(oc, bf2f(gptr[0]), true);
  }
  wave_sync();
  u64 my0 = 0, my1 = 0, wu0 = 0, wu1 = 0;
  for (int q = 0; q < 8; ++q) {
    u64 mask0, mask1;
    if (cur <= 15) {
      mask0 = (2ull << cur) - 1ull;
      mask1 = 0ull;
    } else {
      const float imp_lo = imps[q * 132 + lane], imp_hi = imps[q * 132 + lane + 64];
      const int jl = lane, jh = lane + 64;
      float c0 = (jl >= 1 && jl <= cur - 2) ? imp_lo : -1.f;
      float c1 = (jh <= cur - 2) ? imp_hi : -1.f;
      bool sel_lo = (jl == 0) || (jl == cur) || (jl == cur - 1);
      bool sel_hi = (jh == cur) || (jh == cur - 1);
      for (int r = 0; r < 13; ++r) {
        float bv; int bj;
        if (c0 >= c1) { bv = c0; bj = jl; } else { bv = c1; bj = jh; }
        wave_argmax(bv, bj);
        if (bj == jl) { sel_lo = true; c0 = -1.f; }
        if (bj == jh) { sel_hi = true; c1 = -1.f; }
      }
      mask0 = __ballot(sel_lo);
      mask1 = __ballot(sel_hi);
    }
    if (qi == q) { my0 = mask0; my1 = mask1; }
    wu0 |= mask0; wu1 |= mask1;
  }
  if (lane == 0) { wun[wid * 2] = wu0; wun[wid * 2 + 1] = wu1; }
  __syncthreads();
  u64 bu0 = wun[0] | wun[2] | wun[4] | wun[6] | wun[8] | wun[10] | wun[12] | wun[14];
  u64 bu1 = wun[1] | wun[3] | wun[5] | wun[7] | wun[9] | wun[11] | wun[13] | wun[15];
  bu0 = ((u64)(unsigned)__builtin_amdgcn_readfirstlane((int)(bu0 >> 32)) << 32) | (unsigned)__builtin_amdgcn_readfirstlane((int)bu0);
  bu1 = ((u64)(unsigned)__builtin_amdgcn_readfirstlane((int)(bu1 >> 32)) << 32) | (unsigned)__builtin_amdgcn_readfirstlane((int)bu1);
  {
    float m = -1e30f, l = 0.f;
    f32x16 o[2];
#pragma unroll
    for (int i = 0; i < 16; ++i) { o[0][i] = 0.f; o[1][i] = 0.f; }
    const int kcol = C_KV + 2 * 128 + g * 64;
    auto next_s = [&](int j) {
      ++j;
      if (j < 64) {
        const u64 mm = bu0 & (~0ull << j);
        if (mm) return (int)__builtin_ctzll(mm);
        j = 64;
      }
      if (j >= 128) return -1;
      const u64 mm = bu1 & (~0ull << (j - 64));
      return mm ? 64 + (int)__builtin_ctzll(mm) : -1;
    };
    chunk_pipeline<LDP, T, true>(stage, projb + kcol, p.vts + (long)bg * 64 * T, 0, tid, next_s, [&](int j, const u16* Ks, const u16* Vs) {
      const bool bit = ((j < 64 ? (my0 >> j) : (my1 >> (j - 64))) & 1ull) != 0;
      if (__ballot(bit) != 0ull) {
        const int pos0 = 64 * j;
        dense_chunk(Ks, Vs, bit, 0, t_c - pos0, t_c - pos0, tw - pos0 - 63, qf, btab_h, lane, m, l, o);
      }
    });
    emit(o, bf2f(gptr[1]) / fmaxf(l, 1e-30f), false);
  }
  {
    float m = -1e30f, l = 0.f;
    f32x16 o[2];
#pragma unroll
    for (int i = 0; i < 16; ++i) { o[0][i] = 0.f; o[1][i] = 0.f; }
    const int kcol = C_KV + 4 * 128 + g * 64;
    const int wlo_c = t_c - 511 < 0 ? 0 : t_c - 511;
    const int wlo_min = t0 - 511 < 0 ? 0 : t0 - 511;
    auto next_w = [&](int j) { return j + 1 <= cur ? j + 1 : -1; };
    chunk_pipeline<LDP, T, true>(stage, projb + kcol, p.vtw + (long)bg * 64 * T, wlo_min >> 6, tid, next_w, [&](int jw, const u16* Ks, const u16* Vs) {
      const int pos0 = 64 * jw;
      const int lo_c = wlo_c - pos0 < 0 ? 0 : wlo_c - pos0;
      dense_chunk(Ks, Vs, true, lo_c, t_c - pos0, t_c - pos0, tw - pos0 - 63, qf, btab_h, lane, m, l, o);
    });
    emit(o, bf2f(gptr[2]) / fmaxf(l, 1e-30f), false);
  }
}

DI unsigned f2ord(float v) { const unsigned u = __float_as_uint(v); return (u & 0x80000000u) ? ~u : (u | 0x80000000u); }

DI void topk_row(const Params& p, int b, int t, int lane) {
  const long row = (long)b * T + t;
  int* dst = p.selk + row * 256;
  if (t < 256) {
#pragma unroll
    for (int i = 0; i < 4; ++i) { const int s = i * 64 + lane; dst[s] = (s <= t) ? s : -1; }
    return;
  }
  const u16* srow = (const u16*)p.scores + row * T;
  const int ngrp = (t >> 10) + 1;
  unsigned u[128];
  int ln = lane;
  asm volatile("" : "+v"(ln));
#pragma unroll
  for (int gq = 0; gq < 8; ++gq) {
    if (gq < ngrp) {
#pragma unroll
      for (int j = 0; j < 16; ++j) {
        const int s = (gq * 16 + j) * 64 + ln;
        u[gq * 16 + j] = srow[s < t ? s : t];
      }
    } else {
#pragma unroll
      for (int j = 0; j < 16; ++j) u[gq * 16 + j] = 0u;
    }
  }
  asm volatile("" ::: "memory");
#pragma unroll
  for (int gq = 0; gq < 8; ++gq) {
    if (gq < ngrp) {
#pragma unroll
      for (int j = 0; j < 16; ++j) {
        const int s = (gq * 16 + j) * 64 + ln;
        { const unsigned h_ = u[gq * 16 + j]; u[gq * 16 + j] = (s <= t) ? ((h_ & 0x8000u) ? (~h_ & 0xFFFFu) : (h_ | 0x8000u)) : 0u; }
      }
    }
  }
  const int nlane = 16 * ngrp;
  unsigned m0 = 0u, m1 = 0u, m2 = 0u, m3 = 0u;
#pragma unroll
  for (int gq = 0; gq < 8; ++gq) {
    if (gq < ngrp) {
#pragma unroll
      for (int j = 0; j < 16; j += 4) {
        m0 = max(m0, u[gq * 16 + j]); m1 = max(m1, u[gq * 16 + j + 1]); m2 = max(m2, u[gq * 16 + j + 2]); m3 = max(m3, u[gq * 16 + j + 3]);
      }
    }
  }
  unsigned lo = wave_min_u(min(min(m0, m1), min(m2, m3)));
  unsigned hi = wave_max_u(max(max(m0, m1), max(m2, m3))) + 1u;
#define TOPK_COUNT_GE(PIV, OUT)                                                         \
  {                                                                                     \
    unsigned below_ = 0;     \
    _Pragma("unroll") for (int gq = 0; gq < 8; ++gq) {                                  \
      if (gq < ngrp) {                                                                  \
        _Pragma("unroll") for (int j = 0; j < 16; ++j) below_ += (u[gq * 16 + j] - (PIV)) >> 31; \
      }                                                                                 \
    }                                                                                   \
    OUT = wave_sum_i(nlane - (int)below_);                                              \
  }
  int c_lo, c_hi = 0;
  TOPK_COUNT_GE(lo, c_lo)
  int iter = 0;
  while (c_lo != 256 && hi - lo > 1u) {
    const unsigned span = hi - lo;
    unsigned step;
    if ((++iter & 3) == 0) step = span >> 1;
    else step = (unsigned)((float)span * ((float)(c_lo - 256) / (float)(c_lo - c_hi)));
    step = step < 1u ? 1u : (step > span - 1u ? span - 1u : step);
    const unsigned piv = lo + step;
    int c;
    TOPK_COUNT_GE(piv, c)
    if (c >= 256) { lo = piv; c_lo = c; } else { hi = piv; c_hi = c; }
  }
#undef TOPK_COUNT_GE
  const unsigned thr = lo;
  int ngt = 0;
#pragma unroll
  for (int gq = 0; gq < 8; ++gq) {
    if (gq < ngrp) {
#pragma unroll
      for (int j = 0; j < 16; ++j) ngt += __popcll(__ballot(u[gq * 16 + j] > thr));
    }
  }
  int base_gt = 0, base_eq = 0;
  const int need_eq = 256 - ngt;
  int ln2 = lane;
  asm volatile("" : "+v"(ln2));
#pragma unroll
  for (int gq = 0; gq < 8; ++gq) {
    if (gq < ngrp) {
#pragma unroll
      for (int j = 0; j < 16; ++j) {
        const int s = (gq * 16 + j) * 64 + ln2;
        const unsigned uv = u[gq * 16 + j];
        const bool gt = uv > thr, eq = uv == thr;
        const u64 mg = __ballot(gt), me = __ballot(eq);
        const int pg = __builtin_amdgcn_mbcnt_hi((unsigned)(mg >> 32), __builtin_amdgcn_mbcnt_lo((unsigned)mg, 0));
        const int pe = __builtin_amdgcn_mbcnt_hi((unsigned)(me >> 32), __builtin_amdgcn_mbcnt_lo((unsigned)me, 0));
        if (gt) dst[base_gt + pg] = s;
        if (eq && (base_eq + pe) < need_eq) dst[ngt + base_eq + pe] = s;
        base_gt += __popcll(mg);
        base_eq += __popcll(me);
      }
    }
  }
}

DI void phase6(const Params& p, char* smem, int bid, int nblk);
DI void phase5_nsa8(const Params& p) {
  for (int item = blockIdx.x; item < 512; item += gridDim.x) {
    __syncthreads();
    const int it = item < 256 ? 511 - item : item - 256;
    const int chunk = it >> 2, bgi = it & 3;
    nsa_item(p, g_smem, (bgi << 7) | chunk);
  }
  __syncthreads();
}
DI void phase5(const Params& p, char* smem, int bid, int nblk) {
  hb_sync();
  phase6(p, smem, bid, nblk);
}

DI void tr_read2(unsigned a0, unsigned a1, uint2& r0, uint2& r1) {
  asm volatile("ds_read_b64_tr_b16 %0, %2\n\tds_read_b64_tr_b16 %1, %3\n\ts_waitcnt lgkmcnt(0)" : "=&v"(r0), "=&v"(r1) : "v"(a0), "v"(a1) : "memory");
}
DI void tr_read4(unsigned a0, unsigned a1, unsigned a2, unsigned a3, uint2& r0, uint2& r1, uint2& r2, uint2& r3) {
  asm volatile("ds_read_b64_tr_b16 %0, %4\n\tds_read_b64_tr_b16 %1, %5\n\tds_read_b64_tr_b16 %2, %6\n\tds_read_b64_tr_b16 %3, %7\n\ts_waitcnt lgkmcnt(0)"
               : "=&v"(r0), "=&v"(r1), "=&v"(r2), "=&v"(r3) : "v"(a0), "v"(a1), "v"(a2), "v"(a3) : "memory");
}
DI void dsa_query(const Params& p, u16* Cs, const float* btab, int b, int t, int lane) {
  const long row = (long)b * T + t;
  const int lg = lane >> 4, r16 = lane & 15, hh = lane & 7;
  bf16x8 qf[4];
#pragma unroll
  for (int ks = 0; ks < 4; ++ks) {
    bf16x8 z = {0, 0, 0, 0, 0, 0, 0, 0};
    if (r16 < 8) z = *(const bf16x8*)(p.qlat + (row * 8 + r16) * 128 + ks * 32 + lg * 8);
    qf[ks] = z;
  }
  const u16* ckvb = p.ckv + (long)b * T * 128;
  const int nvalid = (t + 1) < 256 ? (t + 1) : 256;
  float m = -1e30f, l = 0.f;
  f32x4 o[8];
#pragma unroll
  for (int ct = 0; ct < 8; ++ct) o[ct] = (f32x4){0.f, 0.f, 0.f, 0.f};
  const unsigned cs_base = (unsigned)(size_t)Cs;
  const int nch = (nvalid + 31) >> 5;
  uint4 gv0, gv1, gv2, gv3, gv4, gv5, gv6, gv7;
  int kidx_n;
#define DSA_G1(V, I) { const int kr_ = __shfl(kidx_n, 4 * (I) + lg); V = *(const uint4*)(ckvb + (long)kr_ * 128 + r16 * 8); }
#define DSA_GATHER(CH)                                                            \
  {                                                                               \
    const int nv_ = (nvalid - (CH) * 32) > 32 ? 32 : (nvalid - (CH) * 32);        \
    kidx_n = p.selk[row * 256 + (CH) * 32 + (lane & 31)];                         \
    if ((lane & 31) >= nv_ || kidx_n < 0 || kidx_n > t) kidx_n = t;               \
    DSA_G1(gv0, 0) DSA_G1(gv1, 1) DSA_G1(gv2, 2) DSA_G1(gv3, 3) DSA_G1(gv4, 4) DSA_G1(gv5, 5) DSA_G1(gv6, 6) DSA_G1(gv7, 7) \
  }
  DSA_GATHER(0)
  for (int ch = 0; ch < nch; ++ch) {
    const int nval = (nvalid - ch * 32) > 32 ? 32 : (nvalid - ch * 32);
    const int kidx = kidx_n;
    wave_sync();
    {
      u16* d_ = Cs + lg * 144 + r16 * 8;
      *(uint4*)(d_) = gv0;            *(uint4*)(d_ + 4 * 144) = gv1;  *(uint4*)(d_ + 8 * 144) = gv2;  *(uint4*)(d_ + 12 * 144) = gv3;
      *(uint4*)(d_ + 16 * 144) = gv4; *(uint4*)(d_ + 20 * 144) = gv5; *(uint4*)(d_ + 24 * 144) = gv6; *(uint4*)(d_ + 28 * 144) = gv7;
    }
    { const int chn = ch + 1 < nch ? ch + 1 : nch - 1; DSA_GATHER(chn) }
    wave_sync();
    f32x4 acc[2];
#pragma unroll
    for (int rt = 0; rt < 2; ++rt) {
      const u16* kp = Cs + (16 * rt + r16) * 144 + 8 * lg;
      f32x4 c = {0.f, 0.f, 0.f, 0.f};
#pragma unroll
      for (int ks = 0; ks < 4; ++ks) c = MFMA16(*(const bf16x8*)(kp + 32 * ks), qf[ks], c);
      acc[rt] = c;
    }
    float mx = -INFINITY;
#pragma unroll
    for (int rt = 0; rt < 2; ++rt)
#pragma unroll
      for (int r = 0; r < 4; ++r) {
        const int pl = 16 * rt + 4 * lg + r;
        const int kk = __shfl(kidx, pl);
        int dc = t - kk;
        dc = dc < 0 ? 0 : (dc > 128 ? 128 : dc);
        const float sv = (pl < nval) ? fmaf(acc[rt][r], LOG2E, btab[hh * 132 + dc]) : -INFINITY;
        acc[rt][r] = sv;
        mx = fmaxf(mx, sv);
      }
    mx = fmaxf(mx, __shfl_xor(mx, 16));
    mx = fmaxf(mx, __shfl_xor(mx, 32));
    const float mn = fmaxf(m, mx);
    const float alpha = __builtin_amdgcn_exp2f(m - mn);
    float ls = 0.f;
#pragma unroll
    for (int rt = 0; rt < 2; ++rt)
#pragma unroll
      for (int r = 0; r < 4; ++r) {
        const float pv = __builtin_amdgcn_exp2f(acc[rt][r] - mn);
        acc[rt][r] = pv;
        ls += pv;
      }
    ls += __shfl_xor(ls, 16);
    ls += __shfl_xor(ls, 32);
    l = l * alpha + ls;
    m = mn;
    uint4 pw;
    pw.x = pack2(acc[0][0], acc[0][1]);
    pw.y = pack2(acc[0][2], acc[0][3]);
    pw.z = pack2(acc[1][0], acc[1][1]);
    pw.w = pack2(acc[1][2], acc[1][3]);
    const bf16x8 pb = __builtin_bit_cast(bf16x8, pw);
    const unsigned a_lo = cs_base + (unsigned)(((4 * lg + (r16 >> 2)) * 144 + 4 * (r16 & 3)) * 2);
    const unsigned a_hi = a_lo + 16 * 144 * 2;
#pragma unroll
    for (int ct = 0; ct < 8; ct += 2) {
      uint2 lo0, hi0, lo1, hi1;
      tr_read4(a_lo + ct * 32, a_hi + ct * 32, a_lo + ct * 32 + 32, a_hi + ct * 32 + 32, lo0, hi0, lo1, hi1);
      uint4 aw0, aw1;
      aw0.x = lo0.x; aw0.y = lo0.y; aw0.z = hi0.x; aw0.w = hi0.y;
      aw1.x = lo1.x; aw1.y = lo1.y; aw1.z = hi1.x; aw1.w = hi1.y;
      o[ct] = o[ct] * alpha;
      o[ct + 1] = o[ct + 1] * alpha;
      o[ct] = MFMA16(__builtin_bit_cast(bf16x8, aw0), pb, o[ct]);
      o[ct + 1] = MFMA16(__builtin_bit_cast(bf16x8, aw1), pb, o[ct + 1]);
    }
  }
#undef DSA_GATHER
#undef DSA_G1
  const float invl = 1.f / fmaxf(l, 1e-30f);
  if (r16 < 8) {
#pragma unroll
    for (int ct = 0; ct < 8; ++ct)
      *(uint2*)(p.olat + row * 1024 + r16 * 128 + 16 * ct + 4 * lg) = pack4(o[ct][0] * invl, o[ct][1] * invl, o[ct][2] * invl, o[ct][3] * invl);
  }
}
DI void phase6(const Params& p, char* smem, int bid, int nblk) {
  const int tid = TIDX(), lane = tid & 63, wid = __builtin_amdgcn_readfirstlane(tid >> 6);
  float* btab = (float*)smem;
  u16* Cs = (u16*)(smem + 8192) + wid * (32 * 144);
  for (int idx = tid; idx < 8 * 129; idx += 256) {
    const int h = idx / 129, d = idx % 129;
    const int bk = d < 128 ? BUCKET[d] : 31;
    btab[h * 132 + d] = p.rel_bias[bk * 16 + 8 + h] * LOG2E;
  }
  hb_sync();
  for (int item = bid; item < 2048; item += nblk) {
    const int it = item < 1024 ? 2047 - item : item - 1024;
    const int b = it & 1, tb = it >> 1;
    for (int q = 0; q < 2; ++q) dsa_query(p, Cs, btab, b, tb * 8 + wid * 2 + q, lane);
  }
}

struct EpiOdsa {
  u16* odsa; int h, m0;
  DI void operator()(f32x16 (&acc)[2][2], int wm, int wn, int lane) const {
    constexpr int MT = 2;
    SW_FOR {
      const int r = m0 + SW_R, c = SW_C0;
      if (c < 64) *(uint2*)(odsa + (long)r * 512 + h * 64 + c) = pack4(SW_V(0), SW_V(1), SW_V(2), SW_V(3));
    }
  }
};
DI void phase7(const Params& p, char* smem, int bid, int nblk) {
  for (int item = bid; item < 1024; item += nblk) {
    const int h = item & 7, mt_ = item >> 3;
    ARows af{p.olat + (long)mt_ * 128 * 1024 + h * 128, 1024, 128};
    BMat bf{p.dsa_w_uv + h * 64, 512, 64};
    EpiOdsa ef{p.odsa, h, mt_ * 128};
    gemm_tile(smem, 2, 64, af, bf, ef);
  }
}

struct EpiY {
  u16* y; const u16* proj; int m0, n0, second;
  template <int MT> DI void operator()(f32x16 (&acc)[MT][2], int wm, int wn, int lane) const {
    SW_FOR {
      const int r = m0 + SW_R, c = n0 + SW_C0;
      const uint2 gu = *(const uint2*)(proj + (long)r * LDP + C_GM + second * 1024 + c);
      float v0 = lo16(gu.x) * SW_V(0), v1 = hi16(gu.x) * SW_V(1), v2 = lo16(gu.y) * SW_V(2), v3 = hi16(gu.y) * SW_V(3);
      uint2* dst = (uint2*)(y + (long)r * 1024 + c);
      if (second) {
        const uint2 yu = *dst;
        v0 += lo16(yu.x); v1 += hi16(yu.x); v2 += lo16(yu.y); v3 += hi16(yu.y);
      }
      *dst = pack4(v0, v1, v2, v3);
    }
  }
};
struct Epi8Y {
  u16* y; const u16* proj; int m0, n0, second;
  DI void operator()(int q, int c, float v0, float v1, float v2, float v3) const {
    const long r = m0 + q; const int cc = n0 + c;
    const uint2 gu = *(const uint2*)(proj + r * LDP + C_GM + second * 1024 + cc);
    v0 *= lo16(gu.x); v1 *= hi16(gu.x); v2 *= lo16(gu.y); v3 *= hi16(gu.y);
    uint2* dst = (uint2*)(y + r * 1024 + cc);
    if (second) {
      const uint2 yu = *dst;
      v0 += lo16(yu.x); v1 += hi16(yu.x); v2 += lo16(yu.y); v3 += hi16(yu.y);
    }
    *dst = pack4(v0, v1, v2, v3);
  }
};
DI void phase8_8w(const Params& p, int wg, int nwg) {
  for (int item = wg; item < 256; item += nwg) {
    const int x_ = item & 7, s_ = item >> 3, nt_ = s_ & 3, mt_ = x_ * 8 + (s_ >> 2);
    {
      ARows wf{p.w_bnT + (long)nt_ * 256 * 512, 512, 256};
      ARows xf{p.onsa + (long)mt_ * 256 * 512, 512, 256};
      Epi8Y ef{p.y, p.proj, mt_ * 256, nt_ * 256, 0};
      gemm8p(8, wf, xf, ef);
    }
    {
      ARows wf{p.w_bdT + (long)nt_ * 256 * 512, 512, 256};
      ARows xf{p.odsa + (long)mt_ * 256 * 512, 512, 256};
      Epi8Y ef{p.y, p.proj, mt_ * 256, nt_ * 256, 1};
      gemm8p(8, wf, xf, ef);
    }
  }
}
struct EpiStoreBf {
  u16* dst; long ld; int m0, n0;
  template <int MT> DI void operator()(f32x16 (&acc)[MT][2], int wm, int wn, int lane) const {
    SW_FOR { *(uint2*)(dst + (long)(m0 + SW_R) * ld + n0 + SW_C0) = pack4(SW_V(0), SW_V(1), SW_V(2), SW_V(3)); }
  }
};
struct Epi8StoreBf {
  u16* dst; long ld; int m0, n0;
  DI void operator()(int q, int c, float v0, float v1, float v2, float v3) const { *(uint2*)(dst + (long)(m0 + q) * ld + n0 + c) = pack4(v0, v1, v2, v3); }
};
DI void phase9_8w(const Params& p, int wg, int nwg) {
  for (int item = wg; item < 256; item += nwg) {
    const int x_ = item & 7, s_ = item >> 3, nt_ = s_ & 3, mt_ = x_ * 8 + (s_ >> 2);
    ARows wf{p.w_outT + (long)nt_ * 256 * 1024, 1024, 256};
    ARows xf{p.y + (long)mt_ * 256 * 1024, 1024, 256};
    Epi8StoreBf ef{p.z, 1024, mt_ * 256, nt_ * 256};
    gemm8p(16, wf, xf, ef);
  }
}

DI void phase10(const Params& p, int bid, int nblk) {
  const int tid = TIDX(), lane = tid & 63, wid = __builtin_amdgcn_readfirstlane(tid >> 6);
  const int b = bid & 1;
  const float* modb = p.mod + b * 6144;
  float cz[16], cm[16], ca[16];
#pragma unroll
  for (int i = 0; i < 4; ++i) {
    const int col = i * 256 + lane * 4;
    const float4 gt = *(const float4*)(modb + 2048 + col), gp = *(const float4*)(p.g_post_mix + col);
    const float4 gf = *(const float4*)(p.g_pre_ffn + col), sc = *(const float4*)(modb + 4096 + col), sh = *(const float4*)(modb + 3072 + col);
    cz[i * 4 + 0] = gt.x * gp.x; cz[i * 4 + 1] = gt.y * gp.y; cz[i * 4 + 2] = gt.z * gp.z; cz[i * 4 + 3] = gt.w * gp.w;
    cm[i * 4 + 0] = gf.x * (1.f + sc.x); cm[i * 4 + 1] = gf.y * (1.f + sc.y); cm[i * 4 + 2] = gf.z * (1.f + sc.z); cm[i * 4 + 3] = gf.w * (1.f + sc.w);
    ca[i * 4 + 0] = sh.x; ca[i * 4 + 1] = sh.y; ca[i * 4 + 2] = sh.z; ca[i * 4 + 3] = sh.w;
  }
  const int stride = (nblk >> 1) * 4;
  for (int t0 = (bid >> 1) * 4 + wid; t0 < T; t0 += 2 * stride) {
    uint2 zu[2][4]; float4 xx[2][4];
#pragma unroll
    for (int k = 0; k < 2; ++k) {
      const int t = t0 + k * stride < T ? t0 + k * stride : T - 1;
      const long row = (long)b * T + t;
#pragma unroll
      for (int i = 0; i < 4; ++i) {
        zu[k][i] = *(const uint2*)(p.z + row * 1024 + i * 256 + lane * 4);
        xx[k][i] = *(const float4*)(p.x + row * 1024 + i * 256 + lane * 4);
      }
    }
#pragma unroll
    for (int k = 0; k < 2; ++k) {
      float zv[16], xv[16];
      float ss = 0.f;
#pragma unroll
      for (int i = 0; i < 4; ++i) {
        zv[i * 4 + 0] = lo16(zu[k][i].x); zv[i * 4 + 1] = hi16(zu[k][i].x); zv[i * 4 + 2] = lo16(zu[k][i].y); zv[i * 4 + 3] = hi16(zu[k][i].y);
        xv[i * 4 + 0] = xx[k][i].x; xv[i * 4 + 1] = xx[k][i].y; xv[i * 4 + 2] = xx[k][i].z; xv[i * 4 + 3] = xx[k][i].w;
#pragma unroll
        for (int j = 0; j < 4; ++j) ss += zv[i * 4 + j] * zv[i * 4 + j];
      }
      ss = wave_sum(ss);
      const float r = rsqrtf(ss * (1.f / 1024.f) + 1e-6f);
      float ss2 = 0.f;
#pragma unroll
      for (int j = 0; j < 16; ++j) {
        const float v = xv[j] + cz[j] * (zv[j] * r);
        xv[j] = v;
        ss2 += v * v;
      }
      ss2 = wave_sum(ss2);
      const float r2 = rsqrtf(ss2 * (1.f / 1024.f) + 1e-6f);
      if (t0 + k * stride < T) {
        const long row = (long)b * T + t0 + k * stride;
#pragma unroll
        for (int i = 0; i < 4; ++i) {
          const int col = i * 256 + lane * 4;
          *(float4*)(p.x1 + row * 1024 + col) = make_float4(xv[i * 4], xv[i * 4 + 1], xv[i * 4 + 2], xv[i * 4 + 3]);
          *(uint2*)(p.h + row * 1024 + col) = pack4(xv[i * 4] * r2 * cm[i * 4] + ca[i * 4], xv[i * 4 + 1] * r2 * cm[i * 4 + 1] + ca[i * 4 + 1],
                                                    xv[i * 4 + 2] * r2 * cm[i * 4 + 2] + ca[i * 4 + 2], xv[i * 4 + 3] * r2 * cm[i * 4 + 3] + ca[i * 4 + 3]);
        }
      }
    }
  }
}

struct EpiStoreF32 {
  float* dst; long ld; int m0, n0;
  DI void operator()(f32x16 (&acc)[2][2], int wm, int wn, int lane) const {
    constexpr int MT = 2;
    SW_FOR { *(float4*)(dst + (long)(m0 + SW_R) * ld + n0 + SW_C0) = make_float4(SW_V(0), SW_V(1), SW_V(2), SW_V(3)); }
  }
};
DI void phase11(const Params& p, char* smem, int bid, int nblk) {
  for (int item = bid; item < 256; item += nblk) {
    const int nt_ = item & 1, mt_ = item >> 1;
    ARows af{p.h + (long)mt_ * 128 * 1024, 1024, 128};
    BMatT bf{p.routerT + (long)nt_ * 128 * 1024, 1024};
    EpiStoreF32 ef{p.logits, 256, mt_ * 128, nt_ * 128};
    gemm_tile<true, false, true>(smem, 16, 64, af, bf, ef);
  }
}
DI void phase12(const Params& p, int bid, int nblk) {
  const int tid = TIDX(), lane = tid & 63, wid = __builtin_amdgcn_readfirstlane(tid >> 6);
  for (int tok = bid * 4 + wid; tok < NTOK; tok += nblk * 4) {
    const float4 lg = *(const float4*)(p.logits + (long)tok * 256 + lane * 4);
    const float4 rbv = *(const float4*)(p.router_bias + lane * 4);
    float sg[4] = {sigmoidf(lg.x), sigmoidf(lg.y), sigmoidf(lg.z), sigmoidf(lg.w)};
    float sl[4] = {sg[0] + rbv.x, sg[1] + rbv.y, sg[2] + rbv.z, sg[3] + rbv.w};
    float t1 = fmaxf(sl[0], sl[1]), t2 = fminf(sl[0], sl[1]);
#pragma unroll
    for (int j = 2; j < 4; ++j) {
      const float v = sl[j];
      t2 = fmaxf(t2, fminf(t1, v));
      t1 = fmaxf(t1, v);
    }
#define R_MERGE(CTRL)                                                                                                            \
    {                                                                                                                            \
      const float a1 = __int_as_float(__builtin_amdgcn_update_dpp(0, __float_as_int(t1), CTRL, 0xF, 0xF, true));                 \
      const float a2 = __int_as_float(__builtin_amdgcn_update_dpp(0, __float_as_int(t2), CTRL, 0xF, 0xF, true));                 \
      const float n1 = fmaxf(t1, a1);                                                                                            \
      const float n2 = fmaxf(fminf(t1, a1), fmaxf(t2, a2));                                                                      \
      t1 = n1; t2 = n2;                                                                                                          \
    }
    R_MERGE(DPP_QP1) R_MERGE(DPP_QP2) R_MERGE(DPP_RHM)
#undef R_MERGE
    const float gscore = t1 + t2;
    const int grp = lane >> 3;
    int rank = 0;
#pragma unroll
    for (int g2 = 0; g2 < 8; ++g2) {
      const float og = rdlane(gscore, g2 * 8);
      rank += (og > gscore || (og == gscore && g2 < grp)) ? 1 : 0;
    }
    const bool gsel = rank < 4;
    float cv[4];
#pragma unroll
    for (int j = 0; j < 4; ++j) cv[j] = gsel ? sl[j] : -1e30f;
    int my_e = -1; float my_s = 0.f; float ssum = 0.f;
    for (int r = 0; r < 8; ++r) {
      float bv = cv[0]; int bj = 0;
#pragma unroll
      for (int j = 1; j < 4; ++j) if (cv[j] > bv) { bv = cv[j]; bj = j; }
      int be = lane * 4 + bj;
      wave_argmax(bv, be);
      const int wl_ = be >> 2, wj = be & 3;
      const float s0 = rdlane(sg[0], wl_), s1 = rdlane(sg[1], wl_), s2 = rdlane(sg[2], wl_), s3 = rdlane(sg[3], wl_);
      const float bs = wj == 0 ? s0 : (wj == 1 ? s1 : (wj == 2 ? s2 : s3));
      if (wl_ == lane) {
        if (wj == 0) cv[0] = -3e30f; else if (wj == 1) cv[1] = -3e30f; else if (wj == 2) cv[2] = -3e30f; else cv[3] = -3e30f;
      }
      if (lane == r) { my_e = be; my_s = bs; }
      ssum += bs;
    }
    if (lane < 8) {
      const float w = my_s / ssum * 2.5f;
      const int rk = atomicAdd(p.counts + my_e * 32, 1);
      p.eidx[tok * 8 + lane] = my_e;
      p.ewt[tok * 8 + lane] = w;
      p.erank[tok * 8 + lane] = rk;
    }
  }
}
DI void phase14(const Params& p, char* smem, int bid, int nblk) {
  const int tid = TIDX();
  int* s_cnt = (int*)smem;
  int* s_off = s_cnt + 256;
  const int cnt = p.counts[tid * 32];
  s_cnt[tid] = cnt;
  hb_sync();
  int run = 0, nt = 0, nt2 = 0;
  for (int e = 0; e < tid; ++e) { const int c = s_cnt[e]; run += c; nt += (c + 127) >> 7; nt2 += (c + 255) >> 8; }
  s_off[tid] = run;
  hb_sync();
  if (bid == 0) {
    p.offs[tid] = run;
    for (int m = 0; m * 256 < cnt; ++m) {
      p.tile2_e[nt2] = tid;
      p.tile2_r0[nt2] = run + m * 256;
      p.tile2_nr[nt2] = (cnt - m * 256) > 256 ? 256 : (cnt - m * 256);
      ++nt2;
    }
    for (int m = 0; m * 128 < cnt; ++m) {
      p.tile_e[nt] = tid;
      p.tile_r0[nt] = run + m * 128;
      p.tile_nr[nt] = (cnt - m * 128) > 128 ? 128 : (cnt - m * 128);
      ++nt;
    }
    if (tid == 255) {
      p.offs[256] = run + cnt;
      for (int m = 0; m < 128; ++m) {
        p.tile_e[nt] = 256;
        p.tile_r0[nt] = 131072 + m * 128;
        p.tile_nr[nt] = 128;
        ++nt;
      }
      p.ntiles[0] = nt;
      for (int m = 0; m < 64; ++m) {
        p.tile2_e[nt2] = 256;
        p.tile2_r0[nt2] = 131072 + m * 256;
        p.tile2_nr[nt2] = 256;
        ++nt2;
      }
      p.ntiles[1] = nt2;
    }
  }
  for (int i = bid * 256 + tid; i < NSLOT; i += nblk * 256) {
    if (i < 131072) {
      const int e = p.eidx[i];
      const int slot = s_off[e] + p.erank[i];
      p.slot_tok[slot] = i >> 3;
      p.slot_wt[slot] = p.ewt[i];
      p.tok_slot[i] = slot;
    } else {
      p.slot_tok[i] = i - 131072;
      p.slot_wt[i] = 1.f;
    }
  }
}

struct AGather {
  const u16* h; const int* slot_tok; int r0, nr;
  DI const u16* operator()(int r) const { return h + (long)slot_tok[r0 + (r < nr ? r : 0)] * 1024; }
  DI const u16* origin() const { return h; } DI int off(int r) const { return slot_tok[r0 + (r < nr ? r : 0)] * 1024; }
};
struct BGateUp {
  const float* wg; long udiff; long ldb; int n0;
  DI const float* operator()(int c4) const {
    const int wn = c4 >> 6, ntl = (c4 >> 5) & 1, j = c4 & 31;
    return wg + (long)ntl * udiff + n0 + wn * 32 + j;
  }
  DI const u16* row(int) const { return nullptr; }
};
struct EpiH {
  u16* H; int r0, nr, n0;
  template <int MT> DI void operator()(f32x16 (&acc)[MT][2], int wm, int wn, int lane) const {
#pragma unroll
    for (int mt = 0; mt < MT; ++mt) {
      const int r = SW_R;
      if (r < nr) {
#pragma unroll
        for (int q4 = 0; q4 < 4; ++q4) {
          float v[4];
#pragma unroll
          for (int j = 0; j < 4; ++j) v[j] = siluf(acc[mt][0][4 * q4 + j]) * acc[mt][1][4 * q4 + j];
          *(uint2*)(H + (long)(r0 + r) * 256 + n0 + wn * 32 + 8 * q4 + 4 * (lane >> 5)) = pack4(v[0], v[1], v[2], v[3]);
        }
      }
    }
  }
};
struct BGateUp8 {
  const float* wg; long udiff; long ldb; int n0;
  DI const float* operator()(int c4) const {
    const int wn = c4 >> 6, ntl = (c4 >> 5) & 1, j = c4 & 31;
    return wg + (long)ntl * udiff + n0 + wn * 32 + j;
  }
};
DI void phase15_8w(const Params& p, int wg, int nwg) {
  const int ntl = p.ntiles[1];
  const int nit = ntl * 2, nrounds = (nit + 255) >> 8;
  for (int i = wg; i < nrounds * 256; i += nwg) {
    const int item = ((((i >> 8) << 3) + (i & 7)) << 5) + ((i >> 3) & 31);
    if (item >= nit) continue;
    const int ti = item >> 1, nt_ = item & 1;
    const int e = p.tile2_e[ti], r0 = p.tile2_r0[ti], nr = p.tile2_nr[ti];
    AGather af{p.h, p.slot_tok, r0, nr};
    const float* wgp = e < 256 ? p.w_eg + (long)e * 1024 * 256 : p.w_sg;
    const float* wup = e < 256 ? p.w_eu + (long)e * 1024 * 256 : p.w_su;
    BGateUp8 bf{wgp, (long)(wup - wgp), 256, nt_ * 128};
    EpiH ef{p.H, r0, nr, nt_ * 128};
    gemm8w<false>(16, af, bf, ef);
  }
}
struct EpiYexp {
  u16* Y; const float* slot_wt; int r0, nr, n0;
  template <int MT> DI void operator()(f32x16 (&acc)[MT][2], int wm, int wn, int lane) const {
#pragma unroll
    for (int mt = 0; mt < MT; ++mt) {
      const int r = SW_R;
      if (r < nr) {
        const float w = slot_wt[r0 + r];
#pragma unroll
        for (int nt = 0; nt < 2; ++nt)
#pragma unroll
          for (int q4 = 0; q4 < 4; ++q4)
            *(uint2*)(Y + (long)(r0 + r) * 1024 + n0 + SW_C0) = pack4(SW_V(0) * w, SW_V(1) * w, SW_V(2) * w, SW_V(3) * w);
      }
    }
  }
};
DI void phase16_8w(const Params& p, int wg, int nwg) {
  const int ntl = p.ntiles[1];
  const int nit = ntl * 4, nrounds = (nit + 255) >> 8;
  for (int i = wg; i < nrounds * 256; i += nwg) {
    const int item = ((((i >> 8) << 3) + (i & 7)) << 5) + ((i >> 3) & 31);
    if (item >= nit) continue;
    const int ti = item >> 2, nt_ = item & 3;
    const int e = p.tile2_e[ti], r0 = p.tile2_r0[ti], nr = p.tile2_nr[ti];
    ARows af{p.H + (long)r0 * 256, 256, nr};
    const float* wd = e < 256 ? p.w_ed + (long)e * 256 * 1024 : p.w_sd;
    BMat bf{wd + nt_ * 256, 1024, 256};
    EpiYexp ef{p.Y, p.slot_wt, r0, nr, nt_ * 256};
    gemm8w<false>(4, af, bf, ef);
  }
}
DI void phase17(const Params& p, int bid, int nblk) {
  const int tid = TIDX(), lane = tid & 63, wid = __builtin_amdgcn_readfirstlane(tid >> 6);
  const int b = bid & 1;
  const float* modb = p.mod + b * 6144;
  float cy[16];
#pragma unroll
  for (int i = 0; i < 4; ++i) {
    const int col = i * 256 + lane * 4;
    const float4 gt = *(const float4*)(modb + 5120 + col), gp = *(const float4*)(p.g_post_ffn + col);
    cy[i * 4 + 0] = gt.x * gp.x; cy[i * 4 + 1] = gt.y * gp.y; cy[i * 4 + 2] = gt.z * gp.z; cy[i * 4 + 3] = gt.w * gp.w;
  }
  const int stride = (nblk >> 1) * 4;
  for (int t0 = (bid >> 1) * 4 + wid; t0 < T; t0 += 2 * stride) {
    long rows[2];
    int slots[2][8];
#pragma unroll
    for (int k = 0; k < 2; ++k) {
      const int t = t0 + k * stride < T ? t0 + k * stride : T - 1;
      rows[k] = (long)b * T + t;
      const int4 s0 = *(const int4*)(p.tok_slot + rows[k] * 8), s1 = *(const int4*)(p.tok_slot + rows[k] * 8 + 4);
      slots[k][0] = s0.x; slots[k][1] = s0.y; slots[k][2] = s0.z; slots[k][3] = s0.w;
      slots[k][4] = s1.x; slots[k][5] = s1.y; slots[k][6] = s1.z; slots[k][7] = s1.w;
    }
    float4 xx[2][4];
#pragma unroll
    for (int k = 0; k < 2; ++k)
#pragma unroll
      for (int i = 0; i < 4; ++i) xx[k][i] = *(const float4*)(p.x1 + rows[k] * 1024 + i * 256 + lane * 4);
#pragma unroll
    for (int k = 0; k < 2; ++k) {
      float yv[16];
#pragma unroll
      for (int j = 0; j < 16; ++j) yv[j] = 0.f;
#pragma unroll
      for (int q = 0; q < 9; ++q) {
        const long sl = q < 8 ? (long)slots[k][q] : 131072 + rows[k];
#pragma unroll
        for (int i = 0; i < 4; ++i) {
          const uint2 u = *(const uint2*)(p.Y + sl * 1024 + i * 256 + lane * 4);
          yv[i * 4 + 0] += lo16(u.x); yv[i * 4 + 1] += hi16(u.x); yv[i * 4 + 2] += lo16(u.y); yv[i * 4 + 3] += hi16(u.y);
        }
      }
      float ss = 0.f;
#pragma unroll
      for (int j = 0; j < 16; ++j) ss += yv[j] * yv[j];
      ss = wave_sum(ss);
      const float r = rsqrtf(ss * (1.f / 1024.f) + 1e-6f);
      if (t0 + k * stride < T) {
#pragma unroll
        for (int i = 0; i < 4; ++i) {
          const int col = i * 256 + lane * 4;
          *(float4*)(p.out + rows[k] * 1024 + col) = make_float4(xx[k][i].x + cy[i * 4] * (yv[i * 4] * r), xx[k][i].y + cy[i * 4 + 1] * (yv[i * 4 + 1] * r),
                                                                 xx[k][i].z + cy[i * 4 + 2] * (yv[i * 4 + 2] * r), xx[k][i].w + cy[i * 4 + 3] * (yv[i * 4 + 3] * r));
        }
      }
    }
  }
}

__global__ void __launch_bounds__(512, 2) mega(Params p) {
  cg::grid_group grid = cg::this_grid();
  const int vb = __builtin_amdgcn_readfirstlane((int)(threadIdx.x >> 8));
  char* smem = g_smem + vb * HALF_LDS;
  const int bid = blockIdx.x * 2 + vb, nblk = gridDim.x * 2;
  if (p.phase_hi == 12345) grid.sync();
  if (threadIdx.x < 32) ((unsigned*)(g_smem + 2 * HALF_LDS))[threadIdx.x] = 0u;
  __syncthreads();
  const XcdBarrier xb = xcd_barrier_post(p.bar, (volatile LAS unsigned*)(g_smem + 2 * HALF_LDS));
#if !defined(ONLY) || ONLY==0
  if (p.phase_lo <= 0 && 0 < p.phase_hi) {
    phase0(p, smem, bid, nblk);
#if (REPEAT_MASK >> 0) & 1
    xcd_barrier(xb);
    phase0(p, smem, bid, nblk);
#endif
    if (0 + 1 < p.phase_hi) xcd_barrier(xb);
  }
#endif
#if !defined(ONLY) || ONLY==1
  if (p.phase_lo <= 1 && 1 < p.phase_hi) {
    phase1(p, smem, bid, nblk);
#if (REPEAT_MASK >> 1) & 1
    xcd_barrier(xb);
    phase1(p, smem, bid, nblk);
#endif
    if (1 + 1 < p.phase_hi) xcd_barrier(xb);
  }
#endif
#if !defined(ONLY) || ONLY==2
  if (p.phase_lo <= 2 && 2 < p.phase_hi) {
    phase2_8w(p, blockIdx.x, gridDim.x);
    __syncthreads();
    phase2(p, smem, bid, nblk);
#if (REPEAT_MASK >> 2) & 1
    xcd_barrier(xb);
    phase2_8w(p, blockIdx.x, gridDim.x);
    __syncthreads();
    phase2(p, smem, bid, nblk);
#endif
    if (2 + 1 < p.phase_hi) xcd_barrier(xb);
  }
#endif
#if !defined(ONLY) || ONLY==3
  if (p.phase_lo <= 3 && 3 < p.phase_hi) {
    phase3(p, smem, bid, nblk);
#if (REPEAT_MASK >> 3) & 1
    xcd_barrier(xb);
    phase3(p, smem, bid, nblk);
#endif
    if (3 + 1 < p.phase_hi) xcd_barrier(xb);
  }
#endif
#if !defined(ONLY) || ONLY==4
  if (p.phase_lo <= 4 && 4 < p.phase_hi) {
    phase4(p, smem, bid, nblk);
#if (REPEAT_MASK >> 4) & 1
    xcd_barrier(xb);
    phase4(p, smem, bid, nblk);
#endif
    if (4 + 1 < p.phase_hi) xcd_barrier(xb);
  }
#endif
#if !defined(ONLY) || ONLY==5
  if (p.phase_lo <= 5 && 5 < p.phase_hi) {
    phase5_nsa8(p);
    phase5(p, smem, bid, nblk);
#if (REPEAT_MASK >> 5) & 1
    xcd_barrier(xb);
    phase5_nsa8(p);
    phase5(p, smem, bid, nblk);
#endif
    if (5 + 1 < p.phase_hi) xcd_barrier(xb);
  }
#endif
#if !defined(ONLY) || ONLY==7
  if (p.phase_lo <= 7 && 7 < p.phase_hi) {
    phase7(p, smem, bid, nblk);
#if (REPEAT_MASK >> 7) & 1
    xcd_barrier(xb);
    phase7(p, smem, bid, nblk);
#endif
    if (7 + 1 < p.phase_hi) xcd_barrier(xb);
  }
#endif
#if !defined(ONLY) || ONLY==8
  if (p.phase_lo <= 8 && 8 < p.phase_hi) {
    phase8_8w(p, blockIdx.x, gridDim.x);
#if (REPEAT_MASK >> 8) & 1
    xcd_barrier(xb);
    phase8_8w(p, blockIdx.x, gridDim.x);
#endif
    if (8 + 1 < p.phase_hi) xcd_barrier(xb);
  }
#endif
#if !defined(ONLY) || ONLY==9
  if (p.phase_lo <= 9 && 9 < p.phase_hi) {
    phase9_8w(p, blockIdx.x, gridDim.x);
#if (REPEAT_MASK >> 9) & 1
    xcd_barrier(xb);
    phase9_8w(p, blockIdx.x, gridDim.x);
#endif
    if (9 + 1 < p.phase_hi) xcd_barrier(xb);
  }
#endif
#if !defined(ONLY) || ONLY==10
  if (p.phase_lo <= 10 && 10 < p.phase_hi) {
    phase10(p, bid, nblk);
#if (REPEAT_MASK >> 10) & 1
    xcd_barrier(xb);
    phase10(p, bid, nblk);
#endif
    if (10 + 1 < p.phase_hi) xcd_barrier(xb);
  }
#endif
#if !defined(ONLY) || ONLY==11
  if (p.phase_lo <= 11 && 11 < p.phase_hi) {
    phase11(p, smem, bid, nblk);
#if (REPEAT_MASK >> 11) & 1
    xcd_barrier(xb);
    phase11(p, smem, bid, nblk);
#endif
    if (11 + 1 < p.phase_hi) xcd_barrier(xb);
  }
#endif
#if !defined(ONLY) || ONLY==12
  if (p.phase_lo <= 12 && 12 < p.phase_hi) {
    phase12(p, bid, nblk);
#if (REPEAT_MASK >> 12) & 1
    xcd_barrier(xb);
    phase12(p, bid, nblk);
#endif
    if (12 + 1 < p.phase_hi) xcd_barrier(xb);
  }
#endif
#if !defined(ONLY) || ONLY==14
  if (p.phase_lo <= 14 && 14 < p.phase_hi) {
    phase14(p, smem, bid, nblk);
#if (REPEAT_MASK >> 14) & 1
    xcd_barrier(xb);
    phase14(p, smem, bid, nblk);
#endif
    if (14 + 1 < p.phase_hi) xcd_barrier(xb);
  }
#endif
#if !defined(ONLY) || ONLY==15
  if (p.phase_lo <= 15 && 15 < p.phase_hi) {
    phase15_8w(p, blockIdx.x, gridDim.x);
#if (REPEAT_MASK >> 15) & 1
    xcd_barrier(xb);
    phase15_8w(p, blockIdx.x, gridDim.x);
#endif
    if (15 + 1 < p.phase_hi) xcd_barrier(xb);
  }
#endif
#if !defined(ONLY) || ONLY==16
  if (p.phase_lo <= 16 && 16 < p.phase_hi) {
    phase16_8w(p, blockIdx.x, gridDim.x);
#if (REPEAT_MASK >> 16) & 1
    xcd_barrier(xb);
    phase16_8w(p, blockIdx.x, gridDim.x);
#endif
    if (16 + 1 < p.phase_hi) xcd_barrier(xb);
  }
#endif
#if !defined(ONLY) || ONLY==17
  if (p.phase_lo <= 17 && 17 < p.phase_hi) {
    phase17(p, bid, nblk);
#if (REPEAT_MASK >> 17) & 1
    xcd_barrier(xb);
    phase17(p, bid, nblk);
#endif
    if (17 + 1 < p.phase_hi) xcd_barrier(xb);
  }
#endif
}

extern "C" void kernel_launch(void* const* d_in, const int* in_sizes, int n_in, void* d_out, int out_size, void* d_ws, size_t ws_size,
                              hipStream_t stream) {
  static int grid_blocks = 0;
  if (!grid_blocks) {
    int dev = 0, cus = 0, per_cu = 0;
    (void)hipGetDevice(&dev);
    (void)hipDeviceGetAttribute(&cus, hipDeviceAttributeMultiprocessorCount, dev);
    (void)hipOccupancyMaxActiveBlocksPerMultiprocessor(&per_cu, mega, 512, 0);
    if (per_cu > 1) per_cu = 1;
    if (per_cu < 1) per_cu = 1;
    grid_blocks = cus * per_cu;
  }
  Params p{};
  const float* const* in = (const float* const*)d_in;
  p.x = in[0]; p.c = in[1]; p.w_ada = in[2]; p.b_ada = in[3]; p.g_pre_mix = in[4]; p.g_post_mix = in[5]; p.g_pre_ffn = in[6]; p.g_post_ffn = in[7];
  p.w_in = in[8]; p.rel_bias = in[9]; p.cmp_pe = in[10]; p.cmp_w1 = in[11]; p.cmp_b1 = in[12]; p.cmp_w2 = in[13]; p.dsa_kv_norm = in[14];
  p.dsa_w_uk = in[15]; p.dsa_w_uv = in[16]; p.w_bn = in[17]; p.w_bd = in[18]; p.w_out = in[19]; p.router_w = in[20]; p.router_bias = in[21];
  p.w_eg = in[22]; p.w_eu = in[23]; p.w_ed = in[24]; p.w_sg = in[25]; p.w_su = in[26]; p.w_sd = in[27];
  p.out = (float*)d_out;
  char* ws = (char*)d_ws;
  size_t off = 0;
  auto alloc = [&](size_t bytes) { char* r = ws + off; off += (bytes + 255) & ~(size_t)255; return r; };
  p.bar = (unsigned*)alloc((XCD_BAR_WORDS + 64) * 4);
  p.modp = (float*)alloc(16 * 2 * 6144 * 4);
  p.mod = (float*)alloc(2 * 6144 * 4);
  p.pe_part = (float*)alloc(16 * 256 * 4);
  p.cpart = (float*)alloc((size_t)4 * 4096 * 128 * 4);
  p.w_ukT = (float*)alloc(8 * 64 * 128 * 4);
  p.w_inT = (u16*)alloc((size_t)4608 * 1024 * 2);
  p.w_bnT = (u16*)alloc((size_t)1024 * 512 * 2);
  p.w_bdT = (u16*)alloc((size_t)1024 * 512 * 2);
  p.w_outT = (u16*)alloc((size_t)1024 * 1024 * 2);
  p.routerT = (u16*)alloc((size_t)256 * 1024 * 2);
  p.counts = (int*)alloc(256 * 32 * 4);
  p.offs = (int*)alloc(257 * 4);
  p.tile_e = (int*)alloc(1536 * 4);
  p.tile_r0 = (int*)alloc(1536 * 4);
  p.tile_nr = (int*)alloc(1536 * 4);
  p.ntiles = (int*)alloc(8);
  p.tile2_e = (int*)alloc(1024 * 4);
  p.tile2_r0 = (int*)alloc(1024 * 4);
  p.tile2_nr = (int*)alloc(1024 * 4);
  p.h = (u16*)alloc((size_t)NTOK * 1024 * 2);
  p.proj = (u16*)alloc((size_t)NTOK * LDP * 2);
  p.widx = (float*)alloc((size_t)NTOK * 8 * 4);
  p.zc = (u16*)alloc((size_t)2 * 2048 * 128 * 2);
  p.kc = (u16*)alloc((size_t)4 * 512 * 64 * 2);
  p.vcT = (u16*)alloc((size_t)4 * 512 * 64 * 2);
  p.vts = (u16*)alloc((size_t)4 * 64 * T * 2);
  p.vtw = (u16*)alloc((size_t)4 * 64 * T * 2);
  p.qlat = (u16*)alloc((size_t)NTOK * 1024 * 2);
  p.ckv = (u16*)alloc((size_t)NTOK * 128 * 2);
  p.selk = (int*)alloc((size_t)NTOK * 256 * 4);
  p.onsa = (u16*)alloc((size_t)NTOK * 512 * 2);
  p.olat = (u16*)alloc((size_t)NTOK * 1024 * 2);
  p.odsa = (u16*)alloc((size_t)NTOK * 512 * 2);
  p.y = p.qlat;
  p.z = p.olat;
  p.eidx = (int*)alloc((size_t)NTOK * 8 * 4);
  p.ewt = (float*)alloc((size_t)NTOK * 8 * 4);
  p.erank = (int*)alloc((size_t)NTOK * 8 * 4);
  p.slot_tok = (int*)alloc((size_t)NSLOT * 4);
  p.slot_wt = (float*)alloc((size_t)NSLOT * 4);
  p.tok_slot = (int*)alloc((size_t)NTOK * 8 * 4);
  char* big = alloc((size_t)2 * T * T * 4);
  p.scores = (float*)big;
  {
    size_t o2 = 0;
    auto sub = [&](size_t bytes) { char* r = big + o2; o2 += (bytes + 255) & ~(size_t)255; return r; };
    p.H = (u16*)sub((size_t)NSLOT * 256 * 2);
    p.Y = (u16*)sub((size_t)NSLOT * 1024 * 2);
    p.x1 = (float*)sub((size_t)NTOK * 1024 * 4);
    p.logits = (float*)sub((size_t)NTOK * 256 * 4);
  }
  if (off > ws_size) fprintf(stderr, "workspace too small: need %zu have %zu\n", off, ws_size);
  p.phase_lo = 0;
  p.phase_hi = 18;
  (void)hipMemsetAsync(p.bar, 0, (XCD_BAR_WORDS + 64) * 4, stream);
  void* args[] = {&p};
  hipError_t e = hipLaunchCooperativeKernel((void*)mega, dim3(grid_blocks), dim3(512), args, 0, stream);
  if (e != hipSuccess) fprintf(stderr, "coop launch failed: %s (grid %d)\n", hipGetErrorString(e), grid_blocks);
}
```

```cpp
#include <hip/hip_runtime.h>
#include <hip/hip_cooperative_groups.h>
#include <cstdio>
namespace cg = cooperative_groups;

#define DI __device__ __forceinline__
typedef unsigned short u16;
typedef unsigned long long u64;
using bf16x8 = __attribute__((ext_vector_type(8))) short;
using f32x16 = __attribute__((ext_vector_type(16))) float;
using f32x4 = __attribute__((ext_vector_type(4))) float;

constexpr int T = 8192;
constexpr int NTOK = 16384;
constexpr int LDP = 4576;
constexpr int C_QN = 0, C_KV = 512, C_GN = 1280, C_QD = 1304, C_CKV = 1816, C_QI = 1944, C_KI = 2456, C_WI = 2520, C_GM = 2528;
constexpr int NSLOT = 131072 + 16384;
constexpr int HALF_LDS = 73728;
constexpr int LDS_BYTES = 2 * HALF_LDS + 128;
__shared__ __attribute__((aligned(16))) char g_smem[LDS_BYTES];
#ifndef REPEAT_MASK
#define REPEAT_MASK 0
#endif

__device__ const unsigned char BUCKET[128] = {
  0, 1, 2, 3, 4, 5, 6, 7, 8, 9, 10, 11, 12, 13, 14, 15, 16, 16, 16, 17, 17, 18, 18, 18, 19, 19, 19, 20, 20, 20, 20, 21,
  21, 21, 21, 22, 22, 22, 22, 22, 23, 23, 23, 23, 23, 23, 24, 24, 24, 24, 24, 24, 25, 25, 25, 25, 25, 25, 25, 26, 26, 26, 26, 26,
  26, 26, 26, 27, 27, 27, 27, 27, 27, 27, 27, 27, 27, 28, 28, 28, 28, 28, 28, 28, 28, 28, 28, 29, 29, 29, 29, 29, 29, 29, 29, 29,
  29, 29, 29, 30, 30, 30, 30, 30, 30, 30, 30, 30, 30, 30, 30, 30, 30, 31, 31, 31, 31, 31, 31, 31, 31, 31, 31, 31, 31, 31, 31, 31};

struct Params {
  const float *x, *c, *w_ada, *b_ada, *g_pre_mix, *g_post_mix, *g_pre_ffn, *g_post_ffn, *w_in, *rel_bias;
  const float *cmp_pe, *cmp_w1, *cmp_b1, *cmp_w2, *dsa_kv_norm, *dsa_w_uk, *dsa_w_uv, *w_bn, *w_bd, *w_out;
  const float *router_w, *router_bias, *w_eg, *w_eu, *w_ed, *w_sg, *w_su, *w_sd;
  float* out;
  float* modp;
  float* mod;
  float* pe_part;
  float* cpart;
  float* w_ukT;
  u16 *w_inT, *w_bnT, *w_bdT, *w_outT, *routerT;
  u16* h;
  u16* proj;
  float* widx;
  u16* zc;
  u16* kc;
  u16* vcT;
  u16* vts;
  u16* vtw;
  u16* qlat;
  u16* ckv;
  float* scores;
  int* selk;
  u16* onsa;
  u16* olat;
  u16* odsa;
  u16* y;
  u16* z;
  float* x1;
  float* logits;
  int* eidx;
  float* ewt;
  int* erank;
  int* counts;
  int* offs;
  int* tile_e;
  int* tile_r0;
  int* tile_nr;
  int* ntiles;
  int *tile2_e, *tile2_r0, *tile2_nr;
  int* slot_tok;
  float* slot_wt;
  int* tok_slot;
  u16* H;
  u16* Y;
  unsigned* bar;
  int phase_lo, phase_hi;
};

DI float bf2f(u16 v) { return __uint_as_float(((unsigned)v) << 16); }
typedef __bf16 bf16x2_t __attribute__((ext_vector_type(2)));
typedef float f32x2_t __attribute__((ext_vector_type(2)));
DI unsigned pack2(float a, float b) { f32x2_t v = {a, b}; return __builtin_bit_cast(unsigned, __builtin_convertvector(v, bf16x2_t)); }
DI u16 f2bf(float x) { return (u16)(pack2(x, x) & 0xffffu); }
DI float lo16(unsigned u) { return __uint_as_float(u << 16); }
DI float hi16(unsigned u) { return __uint_as_float(u & 0xffff0000u); }
DI float wave_sum_shfl(float v) { for (int o = 32; o; o >>= 1) v += __shfl_xor(v, o); return v; }
DI float wave_max(float v) { for (int o = 32; o; o >>= 1) v = fmaxf(v, __shfl_xor(v, o)); return v; }
#define DPP_QP1 0xB1
#define DPP_QP2 0x4E
#define DPP_RHM 0x141
#define DPP_RM  0x140
#define DPP_B15 0x142
#define DPP_B31 0x143
#define DPP_F0(x, CTRL, RM) __int_as_float(__builtin_amdgcn_update_dpp(0, __float_as_int(x), CTRL, RM, 0xF, true))
DI float wave_sum(float v) {
  v += DPP_F0(v, DPP_QP1, 0xF); v += DPP_F0(v, DPP_QP2, 0xF); v += DPP_F0(v, DPP_RHM, 0xF); v += DPP_F0(v, DPP_RM, 0xF);
  v += DPP_F0(v, DPP_B15, 0xA); v += DPP_F0(v, DPP_B31, 0xC);
  return __int_as_float(__builtin_amdgcn_readlane(__float_as_int(v), 63));
}
DI int wave_sum_i(int x) {
  x += __builtin_amdgcn_update_dpp(0, x, DPP_QP1, 0xF, 0xF, true);
  x += __builtin_amdgcn_update_dpp(0, x, DPP_QP2, 0xF, 0xF, true);
  x += __builtin_amdgcn_update_dpp(0, x, DPP_RHM, 0xF, 0xF, true);
  x += __builtin_amdgcn_update_dpp(0, x, DPP_RM, 0xF, 0xF, true);
  x += __builtin_amdgcn_update_dpp(0, x, DPP_B15, 0xA, 0xF, true);
  x += __builtin_amdgcn_update_dpp(0, x, DPP_B31, 0xC, 0xF, true);
  return __builtin_amdgcn_readlane(x, 63);
}
#define DPP_SELF(x, CTRL, RM) ((unsigned)__builtin_amdgcn_update_dpp((int)(x), (int)(x), CTRL, RM, 0xF, false))
DI unsigned wave_max_u(unsigned x) {
  x = max(x, DPP_SELF(x, DPP_QP1, 0xF)); x = max(x, DPP_SELF(x, DPP_QP2, 0xF)); x = max(x, DPP_SELF(x, DPP_RHM, 0xF));
  x = max(x, DPP_SELF(x, DPP_RM, 0xF)); x = max(x, DPP_SELF(x, DPP_B15, 0xA)); x = max(x, DPP_SELF(x, DPP_B31, 0xC));
  return (unsigned)__builtin_amdgcn_readlane((int)x, 63);
}
DI unsigned wave_min_u(unsigned x) {
  x = min(x, DPP_SELF(x, DPP_QP1, 0xF)); x = min(x, DPP_SELF(x, DPP_QP2, 0xF)); x = min(x, DPP_SELF(x, DPP_RHM, 0xF));
  x = min(x, DPP_SELF(x, DPP_RM, 0xF)); x = min(x, DPP_SELF(x, DPP_B15, 0xA)); x = min(x, DPP_SELF(x, DPP_B31, 0xC));
  return (unsigned)__builtin_amdgcn_readlane((int)x, 63);
}
DI void wave_argmax(float& v, int& idx) {
#define AM_STEP(CTRL, RM)                                                                                                   \
  {                                                                                                                         \
    const float ov_ = __int_as_float(__builtin_amdgcn_update_dpp(__float_as_int(v), __float_as_int(v), CTRL, RM, 0xF, false)); \
    const int oi_ = __builtin_amdgcn_update_dpp(idx, idx, CTRL, RM, 0xF, false);                                            \
    const bool tk_ = ov_ > v || (ov_ == v && oi_ < idx);                                                                    \
    v = tk_ ? ov_ : v;                                                                                                      \
    idx = tk_ ? oi_ : idx;                                                                                                  \
  }
  AM_STEP(DPP_QP1, 0xF) AM_STEP(DPP_QP2, 0xF) AM_STEP(DPP_RHM, 0xF) AM_STEP(DPP_RM, 0xF) AM_STEP(DPP_B15, 0xA) AM_STEP(DPP_B31, 0xC)
#undef AM_STEP
  v = __int_as_float(__builtin_amdgcn_readlane(__float_as_int(v), 63));
  idx = __builtin_amdgcn_readlane(idx, 63);
}
DI float rdlane(float v, int l) { return __int_as_float(__builtin_amdgcn_readlane(__float_as_int(v), l)); }
DI int rdlane_i(int v, int l) { return __builtin_amdgcn_readlane(v, l); }
DI float x32_sum(float v) { const auto r = __builtin_amdgcn_permlane32_swap(__float_as_uint(v), __float_as_uint(v), false, false); return __uint_as_float(r[0]) + __uint_as_float(r[1]); }
DI float x32_max(float v) { const auto r = __builtin_amdgcn_permlane32_swap(__float_as_uint(v), __float_as_uint(v), false, false); return fmaxf(__uint_as_float(r[0]), __uint_as_float(r[1])); }
DI float x16_sum(float v) { const auto r = __builtin_amdgcn_permlane16_swap(__float_as_uint(v), __float_as_uint(v), false, false); return __uint_as_float(r[0]) + __uint_as_float(r[1]); }
DI float x16_max(float v) { const auto r = __builtin_amdgcn_permlane16_swap(__float_as_uint(v), __float_as_uint(v), false, false); return fmaxf(__uint_as_float(r[0]), __uint_as_float(r[1])); }
DI int TIDX() { int t = threadIdx.x & 255; asm volatile("" : "+v"(t)); return t; }
DI int TIDX8() { int t = threadIdx.x; asm volatile("" : "+v"(t)); return t; }
DI void hb_sync() {
  asm volatile("s_waitcnt vmcnt(0) lgkmcnt(0)" ::: "memory");
  const int vb = __builtin_amdgcn_readfirstlane((int)(threadIdx.x >> 8));
  volatile __attribute__((address_space(3))) unsigned* cnt = (volatile __attribute__((address_space(3))) unsigned*)(g_smem + 2 * HALF_LDS + 64) + vb * 8;
  if ((threadIdx.x & 63) == 0) {
    const unsigned old = __hip_atomic_fetch_add((__attribute__((address_space(3))) unsigned*)cnt, 1u, __ATOMIC_RELAXED, __HIP_MEMORY_SCOPE_WORKGROUP);
    const unsigned target = (old & ~3u) + 4u;
    while ((int)(*cnt - target) < 0) __builtin_amdgcn_s_sleep(0);
  }
  asm volatile("s_waitcnt lgkmcnt(0)" ::: "memory");
  __builtin_amdgcn_wave_barrier();
}
DI void cbar(const void* p) { asm volatile("" ::"v"(p) : "memory"); }
DI void wave_sync() { asm volatile("s_waitcnt lgkmcnt(0)" ::: "memory"); __builtin_amdgcn_wave_barrier(); }
DI float sigmoidf(float x) { return 1.f / (1.f + __expf(-x)); }
DI float siluf(float x) { return x / (1.f + __expf(-x)); }
DI float gelu_tanh(float x) { float u = 0.7978845608028654f * (x + 0.044715f * x * x * x); float e = __expf(2.f * u); float th = 1.f - 2.f / (e + 1.f); return 0.5f * x * (1.f + th); }


#define XB_TMO      128
#define XB_XCNT(j)  (256  + 64 * (j))
#define XB_XSUB(j)  (1280 + 64 * (j))
#define XB_XGEN(j)  (2304 + 64 * (j))
#define XB_TOP      3328
#define XB_TOPGEN   3392
#define XCD_BAR_WORDS 3456
#define XB_SPIN_CAP (1u << 22)
#define LAS __attribute__((address_space(3)))
DI unsigned xb_ld(unsigned* p) { return __hip_atomic_load(p, __ATOMIC_RELAXED, __HIP_MEMORY_SCOPE_AGENT); }
DI unsigned xb_add(unsigned* p, unsigned v) { return __hip_atomic_fetch_add(p, v, __ATOMIC_RELAXED, __HIP_MEMORY_SCOPE_AGENT); }
DI unsigned xb_xcc_id() { return (unsigned)__builtin_amdgcn_s_getreg((3 << 11) | 20) & 0xFu; }
#define XB_SPIN(cond, bar) do { unsigned _sp = 0; while (cond) { __builtin_amdgcn_s_sleep(1); \
    if ((++_sp & 255u) == 0u) { if (xb_ld(&(bar)[XB_TMO])) break; if (_sp > XB_SPIN_CAP) { atomicAdd(&(bar)[XB_TMO], 1u); break; } } } } while (0)
struct XcdBarrier { unsigned* bar; unsigned x; volatile LAS unsigned* st; };
DI XcdBarrier xcd_barrier_post(unsigned* bar, volatile LAS unsigned* st) {
  XcdBarrier b; b.bar = bar; b.x = xb_xcc_id(); b.st = st;
  if (threadIdx.x == 0) (void)xb_add(&bar[XB_XCNT(b.x)], 1u);
  return b;
}
DI void xcd_barrier_complete(unsigned* bar, unsigned x, unsigned& nloc, unsigned& nx) {
  const unsigned G = gridDim.x * gridDim.y * gridDim.z;
  unsigned sum, cnt, mine, sp = 0u;
  for (;;) {
    sum = 0u; cnt = 0u; mine = 0u;
#pragma unroll
    for (unsigned j = 0; j < 16; ++j) { const unsigned c = xb_ld(&bar[XB_XCNT(j)]); sum += c; cnt += (c > 0u) ? 1u : 0u; mine = (j == x) ? c : mine; }
    if (sum == G) break;
    __builtin_amdgcn_s_sleep(1);
    if ((++sp & 255u) == 0u) { if (xb_ld(&bar[XB_TMO])) break; if (sp > XB_SPIN_CAP) { atomicAdd(&bar[XB_TMO], 1u); break; } }
  }
  nloc = mine > 0u ? mine : 1u; nx = cnt > 0u ? cnt : 1u;
}
DI void xcd_barrier(const XcdBarrier& b) {
  asm volatile("s_waitcnt vmcnt(0)" ::: "memory");
  __syncthreads();
  if (threadIdx.x == 0) {
    unsigned* bar = b.bar;
    __builtin_amdgcn_s_waitcnt(0);
    unsigned nloc = b.st[0], nx = b.st[1];
    if (nloc == 0u) { xcd_barrier_complete(bar, b.x, nloc, nx); b.st[0] = nloc; b.st[1] = nx; }
    const unsigned old = xb_add(&bar[XB_XSUB(b.x)], 1u);
    const unsigned gen = old / nloc;
    if (old + 1u == (gen + 1u) * nloc) {
      __builtin_amdgcn_fence(__ATOMIC_RELEASE, "agent");
      asm volatile("s_waitcnt vmcnt(0)" ::: "memory");
      const unsigned og = xb_add(&bar[XB_TOP], 1u);
      const unsigned tg = og / nx;
      if (og + 1u == (tg + 1u) * nx) xb_add(&bar[XB_TOPGEN], 1u);
      else XB_SPIN(xb_ld(&bar[XB_TOPGEN]) == tg, bar);
      __builtin_amdgcn_fence(__ATOMIC_ACQUIRE, "agent");
      xb_add(&bar[XB_XGEN(b.x)], 1u);
      asm volatile("s_waitcnt vmcnt(0)" ::: "memory");
    } else {
      XB_SPIN(xb_ld(&bar[XB_XGEN(b.x)]) == gen, bar);
      __builtin_amdgcn_fence(__ATOMIC_ACQUIRE, "agent");
      asm volatile("s_waitcnt vmcnt(0)" ::: "memory");
    }
  }
  __syncthreads();
}

template <bool SWAP = true, bool SINGLE = false, bool BT16 = false, class AF, class BF, class EF>
DI void gemm_tile(char* smem, int nk, long a_kstep, const AF& af, const BF& bf, const EF& ef) {
  asm volatile("" ::: "memory");
  u16* As = (u16*)smem;
  const int tid = TIDX(), lane = tid & 63, wid = __builtin_amdgcn_readfirstlane(tid >> 6), wm = wid >> 1, wn = wid & 1;
  const int arow = tid >> 1, ahalf = tid & 1;
  const u16* ap = af(arow) + ahalf * 32;
  const int bkq = lane & 7, bnq = wid * 8 + (lane >> 3);
  const long ldb = bf.ldb;
  const float* bp = nullptr;
  const u16* bp16 = nullptr;
  if constexpr (BT16) bp16 = bf.row(arow) + ahalf * 32;
  else bp = bf(bnq * 4) + (long)(bkq * 4) * ldb;
  uint4 sa0_0, sa0_1, sa0_2, sa0_3, sa1_0, sa1_1, sa1_2, sa1_3;
  float4 sb0_0, sb0_1, sb0_2, sb0_3, sb0_4, sb0_5, sb0_6, sb0_7, sb1_0, sb1_1, sb1_2, sb1_3, sb1_4, sb1_5, sb1_6, sb1_7;
  uint4 tb0_0, tb0_1, tb0_2, tb0_3, tb1_0, tb1_1, tb1_2, tb1_3;
  f32x16 acc[2][2];
#pragma unroll
  for (int a = 0; a < 2; ++a)
#pragma unroll
    for (int b = 0; b < 2; ++b)
#pragma unroll
      for (int i = 0; i < 16; ++i) acc[a][b][i] = 0.f;

#define GEMM_LOAD(S, KT)                                                                  \
  {                                                                                       \
    const uint4* pa_ = (const uint4*)(ap + (long)(KT) * a_kstep);                         \
    sa##S##_0 = pa_[0]; sa##S##_1 = pa_[1]; sa##S##_2 = pa_[2]; sa##S##_3 = pa_[3];       \
    if constexpr (BT16) {                                                                 \
      const uint4* pt_ = (const uint4*)(bp16 + (long)(KT) * 64);                          \
      tb##S##_0 = pt_[0]; tb##S##_1 = pt_[1]; tb##S##_2 = pt_[2]; tb##S##_3 = pt_[3];     \
    } else {                                                                              \
      const float* pb_ = bp + (long)(KT) * 64 * ldb;                                      \
      sb##S##_0 = *(const float4*)(pb_);                                                  \
      sb##S##_1 = *(const float4*)(pb_ + ldb);                                            \
      sb##S##_2 = *(const float4*)(pb_ + 2 * ldb);                                        \
      sb##S##_3 = *(const float4*)(pb_ + 3 * ldb);                                        \
      sb##S##_4 = *(const float4*)(pb_ + 32 * ldb);                                       \
      sb##S##_5 = *(const float4*)(pb_ + 33 * ldb);                                       \
      sb##S##_6 = *(const float4*)(pb_ + 34 * ldb);                                       \
      sb##S##_7 = *(const float4*)(pb_ + 35 * ldb);                                       \
    }                                                                                     \
  }
#define GEMM_BW(V0, V1, V2, V3, C, I, QOFF)                                               \
  {                                                                                       \
    uint2 w_;                                                                             \
    w_.x = pack2(V0.C, V1.C);                                                             \
    w_.y = pack2(V2.C, V3.C);                                                             \
    *(uint2*)&Bs_[(bnq * 4 + (I)) * 72 + (QOFF) + bkq * 4] = w_;                          \
  }
#define GEMM_STORE(S, BUF)                                                                \
  {                                                                                       \
    u16* As_ = As + (BUF) * (2 * 128 * 72);                                               \
    u16* Bs_ = As_ + 128 * 72;                                                            \
    uint4* da_ = (uint4*)&As_[arow * 72 + ahalf * 32];                                    \
    da_[0] = sa##S##_0; da_[1] = sa##S##_1; da_[2] = sa##S##_2; da_[3] = sa##S##_3;       \
    if constexpr (BT16) {                                                                 \
      uint4* db_ = (uint4*)&Bs_[arow * 72 + ahalf * 32];                                  \
      db_[0] = tb##S##_0; db_[1] = tb##S##_1; db_[2] = tb##S##_2; db_[3] = tb##S##_3;     \
    } else {                                                                              \
      GEMM_BW(sb##S##_0, sb##S##_1, sb##S##_2, sb##S##_3, x, 0, 0)                        \
      GEMM_BW(sb##S##_0, sb##S##_1, sb##S##_2, sb##S##_3, y, 1, 0)                        \
      GEMM_BW(sb##S##_0, sb##S##_1, sb##S##_2, sb##S##_3, z, 2, 0)                        \
      GEMM_BW(sb##S##_0, sb##S##_1, sb##S##_2, sb##S##_3, w, 3, 0)                        \
      GEMM_BW(sb##S##_4, sb##S##_5, sb##S##_6, sb##S##_7, x, 0, 32)                       \
      GEMM_BW(sb##S##_4, sb##S##_5, sb##S##_6, sb##S##_7, y, 1, 32)                       \
      GEMM_BW(sb##S##_4, sb##S##_5, sb##S##_6, sb##S##_7, z, 2, 32)                       \
      GEMM_BW(sb##S##_4, sb##S##_5, sb##S##_6, sb##S##_7, w, 3, 32)                       \
    }                                                                                     \
  }
#define GEMM_COMPUTE(BUF)                                                                 \
  {                                                                                       \
    const u16* Ac = As + (BUF) * (2 * 128 * 72);                                          \
    const u16* Bc = Ac + 128 * 72;                                                        \
    _Pragma("unroll") for (int ks = 0; ks < 4; ++ks) {                                    \
      bf16x8 a[2], b[2];                                                                  \
      _Pragma("unroll") for (int mt = 0; mt < 2; ++mt) a[mt] = *(const bf16x8*)&Ac[(wm * 64 + mt * 32 + (lane & 31)) * 72 + ks * 16 + (lane >> 5) * 8]; \
      _Pragma("unroll") for (int nt = 0; nt < 2; ++nt) b[nt] = *(const bf16x8*)&Bc[(wn * 64 + nt * 32 + (lane & 31)) * 72 + ks * 16 + (lane >> 5) * 8]; \
      _Pragma("unroll") for (int mt = 0; mt < 2; ++mt)                                    \
      _Pragma("unroll") for (int nt = 0; nt < 2; ++nt)                                    \
        acc[mt][nt] = SWAP ? __builtin_amdgcn_mfma_f32_32x32x16_bf16(b[nt], a[mt], acc[mt][nt], 0, 0, 0) \
                           : __builtin_amdgcn_mfma_f32_32x32x16_bf16(a[mt], b[nt], acc[mt][nt], 0, 0, 0); \
    }                                                                                     \
  }
  GEMM_LOAD(0, 0)
  hb_sync();
  if (SINGLE) {
    GEMM_STORE(0, 0)
    hb_sync();
    GEMM_COMPUTE(0)
  } else {
    GEMM_LOAD(1, 1)
    GEMM_STORE(0, 0)
    hb_sync();
    const int last = nk - 1;
    for (int kt = 0; kt < nk; kt += 2) {
      const int k2 = kt + 2 < last ? kt + 2 : last, k3 = kt + 3 < last ? kt + 3 : last;
      GEMM_LOAD(0, k2)
      asm volatile("" ::: "memory");
      GEMM_COMPUTE(0)
      asm volatile("" ::: "memory");
      GEMM_STORE(1, 1)
      hb_sync();
      GEMM_LOAD(1, k3)
      asm volatile("" ::: "memory");
      GEMM_COMPUTE(1)
      asm volatile("" ::: "memory");
      GEMM_STORE(0, 0)
      hb_sync();
    }
  }
#undef GEMM_LOAD
#undef GEMM_STORE
#undef GEMM_BW
#undef GEMM_COMPUTE
  ef(acc, wm, wn, lane);
}

template <bool BT16, class AF, class BF, class EF>
DI void gemm_tile256(char* smem, int nk, const AF& af, const BF& bf, const EF& ef) {
  asm volatile("" ::: "memory");
  u16* As = (u16*)smem;
  u16* Bs = As + 256 * 72;
  const int tid = TIDX(), lane = tid & 63, wid = __builtin_amdgcn_readfirstlane(tid >> 6), wm = wid >> 1, wn = wid & 1;
  const int piece = tid & 7, rbase = tid >> 3;
  const u16* abase = af(0);
  int ao0, ao1, ao2, ao3, ao4, ao5, ao6, ao7;
  ao0 = (int)(af(rbase) - abase) + piece * 8;        ao1 = (int)(af(rbase + 32) - abase) + piece * 8;
  ao2 = (int)(af(rbase + 64) - abase) + piece * 8;   ao3 = (int)(af(rbase + 96) - abase) + piece * 8;
  ao4 = (int)(af(rbase + 128) - abase) + piece * 8;  ao5 = (int)(af(rbase + 160) - abase) + piece * 8;
  ao6 = (int)(af(rbase + 192) - abase) + piece * 8;  ao7 = (int)(af(rbase + 224) - abase) + piece * 8;
  const u16* bp16 = nullptr; long bstride = 0;
  const float* bp = nullptr; long ldb = 0;
  const int bkq = lane & 7, bnq = wid * 8 + (lane >> 3);
  if constexpr (BT16) { bp16 = bf.row(rbase) + piece * 8; bstride = bf.ldb * 32; }
  else { ldb = bf.ldb; bp = bf(bnq * 4) + (long)(bkq * 4) * ldb; }
  uint4 ra0, ra1, ra2, ra3, ra4, ra5, ra6, ra7, rb0, rb1, rb2, rb3;
  float4 fb0, fb1, fb2, fb3, fb4, fb5, fb6, fb7;
  f32x16 acc[4][2];
#pragma unroll
  for (int a = 0; a < 4; ++a)
#pragma unroll
    for (int b = 0; b < 2; ++b)
#pragma unroll
      for (int i = 0; i < 16; ++i) acc[a][b][i] = 0.f;
#define G256_LOAD(KT)                                                   \
  {                                                                     \
    const u16* pa_ = abase + (long)(KT) * 64;                           \
    ra0 = *(const uint4*)(pa_ + ao0); ra1 = *(const uint4*)(pa_ + ao1); \
    ra2 = *(const uint4*)(pa_ + ao2); ra3 = *(const uint4*)(pa_ + ao3); \
    ra4 = *(const uint4*)(pa_ + ao4); ra5 = *(const uint4*)(pa_ + ao5); \
    ra6 = *(const uint4*)(pa_ + ao6); ra7 = *(const uint4*)(pa_ + ao7); \
    if constexpr (BT16) {                                               \
      const u16* pb_ = bp16 + (long)(KT) * 64;                          \
      rb0 = *(const uint4*)(pb_);                                       \
      rb1 = *(const uint4*)(pb_ + bstride);                             \
      rb2 = *(const uint4*)(pb_ + 2 * bstride);                         \
      rb3 = *(const uint4*)(pb_ + 3 * bstride);                         \
    } else {                                                            \
      const float* pf_ = bp + (long)(KT) * 64 * ldb;                    \
      fb0 = *(const float4*)(pf_);            fb1 = *(const float4*)(pf_ + ldb);      \
      fb2 = *(const float4*)(pf_ + 2 * ldb);  fb3 = *(const float4*)(pf_ + 3 * ldb);  \
      fb4 = *(const float4*)(pf_ + 32 * ldb); fb5 = *(const float4*)(pf_ + 33 * ldb); \
      fb6 = *(const float4*)(pf_ + 34 * ldb); fb7 = *(const float4*)(pf_ + 35 * ldb); \
    }                                                                   \
  }
#define G256_BW(V0, V1, V2, V3, C, I, QOFF)                             \
  {                                                                     \
    uint2 w_;                                                           \
    w_.x = pack2(V0.C, V1.C);                                           \
    w_.y = pack2(V2.C, V3.C);                                           \
    *(uint2*)&Bs[(bnq * 4 + (I)) * 72 + (QOFF) + bkq * 4] = w_;         \
  }
  G256_LOAD(0)
  const int last = nk - 1;
  for (int kt = 0; kt < nk; ++kt) {
    hb_sync();
    {
      u16* da = As + rbase * 72 + piece * 8;
      *(uint4*)(da) = ra0;            *(uint4*)(da + 32 * 72) = ra1;  *(uint4*)(da + 64 * 72) = ra2;  *(uint4*)(da + 96 * 72) = ra3;
      *(uint4*)(da + 128 * 72) = ra4; *(uint4*)(da + 160 * 72) = ra5; *(uint4*)(da + 192 * 72) = ra6; *(uint4*)(da + 224 * 72) = ra7;
      if constexpr (BT16) {
        u16* db = Bs + rbase * 72 + piece * 8;
        *(uint4*)(db) = rb0; *(uint4*)(db + 32 * 72) = rb1; *(uint4*)(db + 64 * 72) = rb2; *(uint4*)(db + 96 * 72) = rb3;
      } else {
        G256_BW(fb0, fb1, fb2, fb3, x, 0, 0)  G256_BW(fb0, fb1, fb2, fb3, y, 1, 0)
        G256_BW(fb0, fb1, fb2, fb3, z, 2, 0)  G256_BW(fb0, fb1, fb2, fb3, w, 3, 0)
        G256_BW(fb4, fb5, fb6, fb7, x, 0, 32) G256_BW(fb4, fb5, fb6, fb7, y, 1, 32)
        G256_BW(fb4, fb5, fb6, fb7, z, 2, 32) G256_BW(fb4, fb5, fb6, fb7, w, 3, 32)
      }
    }
    hb_sync();
    const int kn = kt + 1 < last ? kt + 1 : last;
    G256_LOAD(kn)
    asm volatile("" ::: "memory");
#pragma unroll
    for (int ks = 0; ks < 4; ++ks) {
      bf16x8 a[4], b[2];
#pragma unroll
      for (int mt = 0; mt < 4; ++mt) a[mt] = *(const bf16x8*)&As[(wm * 128 + mt * 32 + (lane & 31)) * 72 + ks * 16 + (lane >> 5) * 8];
#pragma unroll
      for (int nt = 0; nt < 2; ++nt) b[nt] = *(const bf16x8*)&Bs[(wn * 64 + nt * 32 + (lane & 31)) * 72 + ks * 16 + (lane >> 5) * 8];
#pragma unroll
      for (int mt = 0; mt < 4; ++mt)
#pragma unroll
        for (int nt = 0; nt < 2; ++nt) acc[mt][nt] = __builtin_amdgcn_mfma_f32_32x32x16_bf16(b[nt], a[mt], acc[mt][nt], 0, 0, 0);
    }
    asm volatile("" ::: "memory");
  }
#undef G256_LOAD
#undef G256_BW
  ef(acc, wm, wn, lane);
}

template <bool BT16, class AF, class BF, class EF>
DI void gemm8w(int nk, const AF& af, const BF& bf, const EF& ef) {
  asm volatile("" ::: "memory");
  u16* S0 = (u16*)g_smem;
  int tid = threadIdx.x; asm volatile("" : "+v"(tid));
  const int lane = tid & 63, wid = __builtin_amdgcn_readfirstlane(tid >> 6), wm = wid >> 2, wn = wid & 3;
  const int piece = tid & 7, rbase = tid >> 3;
  const u16* abase = af.origin();
  const int ao0 = af.off(rbase) + piece * 8, ao1 = af.off(rbase + 64) + piece * 8, ao2 = af.off(rbase + 128) + piece * 8, ao3 = af.off(rbase + 192) + piece * 8;
  const u16 *bq0 = nullptr, *bq1 = nullptr, *bq2 = nullptr, *bq3 = nullptr;
  const float* bp = nullptr; long ldb = 0;
  const int bkq = lane & 7, bnq = wid * 8 + (lane >> 3);
  if constexpr (BT16) { bq0 = bf.row(rbase) + piece * 8; bq1 = bf.row(rbase + 64) + piece * 8; bq2 = bf.row(rbase + 128) + piece * 8; bq3 = bf.row(rbase + 192) + piece * 8; }
  else { ldb = bf.ldb; bp = bf(bnq * 4) + (long)(bkq * 4) * ldb; }
  uint4 ra0, ra1, ra2, ra3, rb0, rb1, rb2, rb3;
  float4 fb0, fb1, fb2, fb3, fb4, fb5, fb6, fb7;
  f32x16 acc[4][2];
#pragma unroll
  for (int a = 0; a < 4; ++a)
#pragma unroll
    for (int b = 0; b < 2; ++b)
#pragma unroll
      for (int i = 0; i < 16; ++i) acc[a][b][i] = 0.f;
#define G8_LOAD(KT)                                                     \
  {                                                                     \
    const u16* pa_ = abase + (long)(KT) * 64;                           \
    ra0 = *(const uint4*)(pa_ + ao0); ra1 = *(const uint4*)(pa_ + ao1); \
    ra2 = *(const uint4*)(pa_ + ao2); ra3 = *(const uint4*)(pa_ + ao3); \
    if constexpr (BT16) {                                               \
      rb0 = *(const uint4*)(bq0 + (long)(KT) * 64); rb1 = *(const uint4*)(bq1 + (long)(KT) * 64); \
      rb2 = *(const uint4*)(bq2 + (long)(KT) * 64); rb3 = *(const uint4*)(bq3 + (long)(KT) * 64); \
    } else {                                                            \
      const float* pf_ = bp + (long)(KT) * 64 * ldb;                    \
      fb0 = *(const float4*)(pf_);            fb1 = *(const float4*)(pf_ + ldb);      \
      fb2 = *(const float4*)(pf_ + 2 * ldb);  fb3 = *(const float4*)(pf_ + 3 * ldb);  \
      fb4 = *(const float4*)(pf_ + 32 * ldb); fb5 = *(const float4*)(pf_ + 33 * ldb); \
      fb6 = *(const float4*)(pf_ + 34 * ldb); fb7 = *(const float4*)(pf_ + 35 * ldb); \
    }                                                                   \
  }
#define G8_BW(V0, V1, V2, V3, C, I, QOFF)                               \
  {                                                                     \
    uint2 w_;                                                           \
    w_.x = pack2(V0.C, V1.C);                                           \
    w_.y = pack2(V2.C, V3.C);                                           \
    *(uint2*)&Bs_[(bnq * 4 + (I)) * 72 + (QOFF) + bkq * 4] = w_;        \
  }
#define G8_STORE(BUF)                                                   \
  {                                                                     \
    u16* As_ = S0 + (BUF) * (512 * 72);                                 \
    u16* Bs_ = As_ + 256 * 72;                                          \
    u16* da = As_ + rbase * 72 + piece * 8;                             \
    *(uint4*)(da) = ra0; *(uint4*)(da + 64 * 72) = ra1; *(uint4*)(da + 128 * 72) = ra2; *(uint4*)(da + 192 * 72) = ra3; \
    if constexpr (BT16) {                                               \
      u16* db = Bs_ + rbase * 72 + piece * 8;                           \
      *(uint4*)(db) = rb0; *(uint4*)(db + 64 * 72) = rb1; *(uint4*)(db + 128 * 72) = rb2; *(uint4*)(db + 192 * 72) = rb3; \
    } else {                                                            \
      G8_BW(fb0, fb1, fb2, fb3, x, 0, 0)  G8_BW(fb0, fb1, fb2, fb3, y, 1, 0)   \
      G8_BW(fb0, fb1, fb2, fb3, z, 2, 0)  G8_BW(fb0, fb1, fb2, fb3, w, 3, 0)   \
      G8_BW(fb4, fb5, fb6, fb7, x, 0, 32) G8_BW(fb4, fb5, fb6, fb7, y, 1, 32)  \
      G8_BW(fb4, fb5, fb6, fb7, z, 2, 32) G8_BW(fb4, fb5, fb6, fb7, w, 3, 32)  \
    }                                                                   \
  }
  G8_LOAD(0)
  __syncthreads();
  G8_STORE(0)
  __syncthreads();
  const int last = nk - 1;
  for (int kt = 0; kt < nk; ++kt) {
    const int kn = kt + 1 < last ? kt + 1 : last;
    G8_LOAD(kn)
    asm volatile("" ::: "memory");
    {
      const u16* Ac = S0 + (kt & 1) * (512 * 72);
      const u16* Bc = Ac + 256 * 72;
#pragma unroll
      for (int ks = 0; ks < 4; ++ks) {
        bf16x8 a[4], b[2];
#pragma unroll
        for (int mt = 0; mt < 4; ++mt) a[mt] = *(const bf16x8*)&Ac[(wm * 128 + mt * 32 + (lane & 31)) * 72 + ks * 16 + (lane >> 5) * 8];
#pragma unroll
        for (int nt = 0; nt < 2; ++nt) b[nt] = *(const bf16x8*)&Bc[(wn * 64 + nt * 32 + (lane & 31)) * 72 + ks * 16 + (lane >> 5) * 8];
#pragma unroll
        for (int mt = 0; mt < 4; ++mt)
#pragma unroll
          for (int nt = 0; nt < 2; ++nt) acc[mt][nt] = __builtin_amdgcn_mfma_f32_32x32x16_bf16(b[nt], a[mt], acc[mt][nt], 0, 0, 0);
      }
    }
    asm volatile("" ::: "memory");
    if (kt + 1 < nk) {
      G8_STORE((kt + 1) & 1)
      __syncthreads();
    }
  }
#undef G8_LOAD
#undef G8_BW
#undef G8_STORE
  ef(acc, wm, wn, lane);
}

DI void st_stage_rc(int b, int& R, int& C) {
  const int st = b >> 10, sb = b & 1023, swz = sb ^ (((sb >> 9) & 1) << 5);
  R = (st >> 1) * 16 + (swz >> 6); C = (st & 1) * 32 + ((swz & 63) >> 1);
}
template <class PF, class QF, class EF>
DI void gemm8p(int nt, const PF& pf, const QF& qf, const EF& ef) {
  asm volatile("" ::: "memory");
  constexpr int HTB = 128 * 64 * 2;
  int tid = threadIdx.x; asm volatile("" : "+v"(tid));
  const int lane = tid & 63, wid = __builtin_amdgcn_readfirstlane(tid >> 6), wr = wid >> 2, wc = wid & 3, fr = lane & 15, fq = lane >> 4;
  int r0, c0, r1, c1;
  st_stage_rc(tid * 16, r0, c0);
  st_stage_rc(tid * 16 + 8192, r1, c1);
  const u16* pbase = pf.origin();
  const u16* qbase = qf.origin();
  const unsigned po00 = (unsigned)(pf.off(r0) + c0) * 2u, po01 = (unsigned)(pf.off(r1) + c1) * 2u;
  const unsigned po10 = (unsigned)(pf.off(128 + r0) + c0) * 2u, po11 = (unsigned)(pf.off(128 + r1) + c1) * 2u;
  const unsigned qo00 = (unsigned)(qf.off(r0) + c0) * 2u, qo01 = (unsigned)(qf.off(r1) + c1) * 2u;
  const unsigned qo10 = (unsigned)(qf.off(128 + r0) + c0) * 2u, qo11 = (unsigned)(qf.off(128 + r1) + c1) * 2u;
  const unsigned sdst = (unsigned)__builtin_amdgcn_readfirstlane((int)((unsigned)(size_t)g_smem + (unsigned)(tid & ~63) * 16u));
  const int laneoff = (fr * 64 + fq * 16) ^ ((fr >> 3) << 5);
  const char* rdP = g_smem + wr * 8192 + laneoff;
  const char* rdQ = g_smem + 4 * HTB + wc * 4096 + laneoff;
#define G8P_ST(SLOT, BASE, O0, O1, KT)                                                                                     \
  {                                                                                                                        \
    const char* g_ = (const char*)(BASE) + (long)(KT) * 128;                                                               \
    __builtin_amdgcn_global_load_lds((const unsigned*)(g_ + (O0)), (LAS unsigned*)(size_t)(sdst + (SLOT) * HTB), 16, 0, 0);          \
    __builtin_amdgcn_global_load_lds((const unsigned*)(g_ + (O1)), (LAS unsigned*)(size_t)(sdst + (SLOT) * HTB + 8192), 16, 0, 0);   \
  }
#define G8P_STP(b, h, KT) { if ((h) == 0) G8P_ST((b) * 2, pbase, po00, po01, KT) else G8P_ST((b) * 2 + 1, pbase, po10, po11, KT) }
#define G8P_STQ(b, h, KT) { if ((h) == 0) G8P_ST(4 + (b) * 2, qbase, qo00, qo01, KT) else G8P_ST(4 + (b) * 2 + 1, qbase, qo10, qo11, KT) }
#define G8P_LDP(b, h)                                                                                                      \
  _Pragma("unroll") for (int m = 0; m < 4; ++m) _Pragma("unroll") for (int k = 0; k < 2; ++k)                              \
    Pt[m][k] = *(const bf16x8*)(rdP + ((b) * 2 + (h)) * HTB + m * 2048 + k * 1024);
#define G8P_LDQ(dst, b, h)                                                                                                 \
  _Pragma("unroll") for (int n = 0; n < 2; ++n) _Pragma("unroll") for (int k = 0; k < 2; ++k)                              \
    dst[n][k] = *(const bf16x8*)(rdQ + ((b) * 2 + (h)) * HTB + n * 2048 + k * 1024);
#define G8P_MMA(ai, bj, QT)                                                                                                \
  {                                                                                                                        \
    __builtin_amdgcn_s_setprio(1);                                                                                         \
    _Pragma("unroll") for (int m = 0; m < 4; ++m) _Pragma("unroll") for (int n = 0; n < 2; ++n)                            \
      _Pragma("unroll") for (int k = 0; k < 2; ++k)                                                                        \
        acc[ai][bj][m][n] = __builtin_amdgcn_mfma_f32_16x16x32_bf16(Pt[m][k], QT[n][k], acc[ai][bj][m][n], 0, 0, 0);       \
    __builtin_amdgcn_s_setprio(0);                                                                                         \
  }
#define G8P_WV(n) asm volatile("s_waitcnt vmcnt(" #n ")" ::: "memory")
#define G8P_WL(n) asm volatile("s_waitcnt lgkmcnt(" #n ")" ::: "memory")
#define G8P_BAR __builtin_amdgcn_s_barrier()
#define G8P_SCHED __builtin_amdgcn_sched_barrier(0)
  f32x4 acc[2][2][4][2];
#pragma unroll
  for (int a = 0; a < 2; ++a)
#pragma unroll
    for (int b = 0; b < 2; ++b)
#pragma unroll
      for (int m = 0; m < 4; ++m)
#pragma unroll
        for (int n = 0; n < 2; ++n) acc[a][b][m][n] = (f32x4){0.f, 0.f, 0.f, 0.f};
  bf16x8 Pt[4][2], Q0[2][2], Q1[2][2];
  __syncthreads();
  G8P_STQ(0, 0, 0) G8P_STP(0, 0, 0) G8P_STQ(0, 1, 0) G8P_STP(0, 1, 0)
  if (wr == 1) G8P_BAR;
  G8P_WV(4); G8P_BAR;
  G8P_STQ(1, 0, 1) G8P_STP(1, 0, 1) G8P_STQ(1, 1, 1)
  G8P_WV(6); G8P_BAR;
  for (int t = 0; t < nt - 2; t += 2) {
    G8P_LDQ(Q0, 0, 0) G8P_SCHED; G8P_LDP(0, 0) G8P_STP(1, 1, t + 1)
    G8P_WL(8); G8P_BAR; G8P_WL(0); G8P_MMA(0, 0, Q0) G8P_BAR; G8P_SCHED;
    G8P_LDQ(Q1, 0, 1) G8P_STQ(0, 0, t + 2)
    G8P_BAR; G8P_WL(0); G8P_MMA(0, 1, Q1) G8P_BAR;
    G8P_LDP(0, 1) G8P_STP(0, 0, t + 2)
    G8P_BAR; G8P_WL(0); G8P_MMA(1, 0, Q0) G8P_BAR; G8P_SCHED;
    G8P_STQ(0, 1, t + 2)
    G8P_WV(6); G8P_BAR; G8P_MMA(1, 1, Q1) G8P_BAR;
    G8P_LDQ(Q0, 1, 0) G8P_SCHED; G8P_LDP(1, 0) G8P_STP(0, 1, t + 2)
    G8P_WL(8); G8P_BAR; G8P_WL(0); G8P_MMA(0, 0, Q0) G8P_BAR; G8P_SCHED;
    G8P_LDQ(Q1, 1, 1) G8P_STQ(1, 0, t + 3)
    G8P_BAR; G8P_WL(0); G8P_MMA(0, 1, Q1) G8P_BAR;
    G8P_LDP(1, 1) G8P_STP(1, 0, t + 3)
    G8P_BAR; G8P_WL(0); G8P_MMA(1, 0, Q0) G8P_BAR; G8P_SCHED;
    G8P_STQ(1, 1, t + 3)
    G8P_WV(6); G8P_BAR; G8P_MMA(1, 1, Q1) G8P_BAR;
  }
  {
    G8P_LDQ(Q0, 0, 0) G8P_LDP(0, 0) G8P_STP(1, 1, nt - 1)
    G8P_BAR; G8P_WL(0); G8P_MMA(0, 0, Q0) G8P_BAR;
    G8P_LDQ(Q1, 0, 1) G8P_BAR; G8P_WL(0); G8P_MMA(0, 1, Q1) G8P_BAR;
    G8P_LDP(0, 1) G8P_WV(4); G8P_BAR; G8P_WL(0); G8P_MMA(1, 0, Q0) G8P_MMA(1, 1, Q1) G8P_BAR;
  }
  {
    G8P_LDQ(Q0, 1, 0) G8P_LDP(1, 0) G8P_WV(2); G8P_BAR; G8P_WL(0); G8P_MMA(0, 0, Q0) G8P_BAR;
    G8P_LDQ(Q1, 1, 1) G8P_WV(0); G8P_BAR; G8P_WL(0); G8P_MMA(0, 1, Q1) G8P_BAR;
    G8P_LDP(1, 1) G8P_BAR; G8P_WL(0); G8P_MMA(1, 0, Q0) G8P_MMA(1, 1, Q1) G8P_BAR;
  }
  if (wr == 0) G8P_BAR;
#undef G8P_ST
#undef G8P_STP
#undef G8P_STQ
#undef G8P_LDP
#undef G8P_LDQ
#undef G8P_MMA
#undef G8P_WV
#undef G8P_WL
#undef G8P_BAR
#undef G8P_SCHED
#pragma unroll
  for (int ai = 0; ai < 2; ++ai)
#pragma unroll
    for (int bj = 0; bj < 2; ++bj)
#pragma unroll
      for (int m = 0; m < 4; ++m)
#pragma unroll
        for (int n = 0; n < 2; ++n)
          ef(bj * 128 + wc * 32 + n * 16 + fr, ai * 128 + wr * 64 + m * 16 + fq * 4, acc[ai][bj][m][n][0], acc[ai][bj][m][n][1], acc[ai][bj][m][n][2], acc[ai][bj][m][n][3]);
}

#define EPI_FOR                                                   \
  _Pragma("unroll") for (int mt = 0; mt < 2; ++mt)                \
  _Pragma("unroll") for (int nt = 0; nt < 2; ++nt)                \
  _Pragma("unroll") for (int i = 0; i < 16; ++i)
#define EPI_R (wm * 64 + mt * 32 + (i & 3) + 8 * (i >> 2) + 4 * (lane >> 5))
#define EPI_C (wn * 64 + nt * 32 + (lane & 31))
#define SW_FOR                                                    \
  _Pragma("unroll") for (int mt = 0; mt < MT; ++mt)               \
  _Pragma("unroll") for (int nt = 0; nt < 2; ++nt)                \
  _Pragma("unroll") for (int q4 = 0; q4 < 4; ++q4)
#define SW_R (wm * (32 * MT) + mt * 32 + (lane & 31))
#define SW_C0 (wn * 64 + nt * 32 + 8 * q4 + 4 * (lane >> 5))
#define SW_V(j) acc[mt][nt][4 * q4 + (j)]
DI uint2 pack4(float a, float b, float c, float d) { uint2 w; w.x = pack2(a, b); w.y = pack2(c, d); return w; }

struct ARows { const u16* base; long ld; int nrows; DI const u16* operator()(int r) const { return base + (long)(r < nrows ? r : 0) * ld; }
  DI const u16* origin() const { return base; } DI int off(int r) const { return (r < nrows ? r : 0) * (int)ld; } };
struct BMat { const float* base; long ldb; int ncols; DI const float* operator()(int c4) const { return base + (c4 < ncols ? c4 : 0); } DI const u16* row(int) const { return nullptr; } };
struct BMatT { const u16* base; long ldb; DI const float* operator()(int) const { return nullptr; } DI const u16* row(int n) const { return base + (long)n * ldb; } };

DI void phase0(const Params& p, char* smem, int bid, int nblk) {
  const int tid = TIDX();
  for (int item = bid; item < 384 + 256 + 16 + 1 + 432; item += nblk) {
    if (item < 384) {
      const int cc = item % 24, kc = item / 24;
      const int col = cc * 256 + tid;
      float a0 = 0.f, a1 = 0.f;
#pragma unroll 1
      for (int half = 0; half < 2; ++half) {
        const int k0 = kc * 64 + half * 32;
        float w[32];
#pragma unroll
        for (int j = 0; j < 32; ++j) w[j] = p.w_ada[(long)(k0 + j) * 6144 + col];
#pragma unroll
        for (int j = 0; j < 32; ++j) {
          a0 += siluf(p.c[k0 + j]) * w[j];
          a1 += siluf(p.c[1024 + k0 + j]) * w[j];
        }
      }
      p.modp[(kc * 2 + 0) * 6144 + col] = a0;
      p.modp[(kc * 2 + 1) * 6144 + col] = a1;
    } else if (item < 640) {
      const int idx = (item - 384) * 256 + tid;
      const int c = idx & 127, d = (idx >> 7) & 63, h = idx >> 13;
      p.w_ukT[idx] = p.dsa_w_uk[c * 512 + h * 64 + d];
    } else if (item < 656) {
      const int part = item - 640;
      const int slot = tid >> 7, kk = tid & 127;
      float a = 0.f;
      for (int ld = part * 128; ld < part * 128 + 128; ++ld) a += p.cmp_pe[slot * 2048 + ld] * p.cmp_w1[((long)slot * 2048 + ld) * 128 + kk];
      p.pe_part[part * 256 + tid] = a;
    } else if (item == 656) {
      p.counts[tid * 32] = 0;
    } else {
      int it = item - 657;
      const float* W; u16* WT; int K, N, ntn;
      if (it < 288) { W = p.w_in; WT = p.w_inT; K = 1024; N = LDP; ntn = 18; }
      else if (it < 320) { it -= 288; W = p.w_bn; WT = p.w_bnT; K = 512; N = 1024; ntn = 4; }
      else if (it < 352) { it -= 320; W = p.w_bd; WT = p.w_bdT; K = 512; N = 1024; ntn = 4; }
      else if (it < 416) { it -= 352; W = p.w_out; WT = p.w_outT; K = 1024; N = 1024; ntn = 4; }
      else { it -= 416; W = p.router_w; WT = p.routerT; K = 1024; N = 256; ntn = 1; }
      const int k0 = (it / ntn) * 64 + (tid >> 6) * 16, n = (it % ntn) * 256 + (tid & 63) * 4;
      float4 v[16];
#pragma unroll
      for (int ps = 0; ps < 16; ++ps) {
        v[ps] = make_float4(0.f, 0.f, 0.f, 0.f);
        if (n < N) v[ps] = *(const float4*)(W + (long)(k0 + ps) * N + n);
      }
#define TR_ROW(J, C)                                                                                                         \
      {                                                                                                                      \
        uint4 a_, b_;                                                                                                        \
        a_.x = pack2(v[0].C, v[1].C); a_.y = pack2(v[2].C, v[3].C); a_.z = pack2(v[4].C, v[5].C); a_.w = pack2(v[6].C, v[7].C);          \
        b_.x = pack2(v[8].C, v[9].C); b_.y = pack2(v[10].C, v[11].C); b_.z = pack2(v[12].C, v[13].C); b_.w = pack2(v[14].C, v[15].C);    \
        uint4* dst_ = (uint4*)(WT + (long)(n + (J)) * K + k0);                                                               \
        dst_[0] = a_; dst_[1] = b_;                                                                                          \
      }
      TR_ROW(0, x) TR_ROW(1, y) TR_ROW(2, z) TR_ROW(3, w)
#undef TR_ROW
    }
  }
}

DI void phase1(const Params& p, char* smem, int bid, int nblk) {
  const int tid = TIDX(), lane = tid & 63, wid = __builtin_amdgcn_readfirstlane(tid >> 6);
  float* modl = (float*)smem;
  const int b = bid & 1;
#pragma unroll
  for (int i0 = 0; i0 < 8; i0 += 4) {
    float v[4];
#pragma unroll
    for (int ii = 0; ii < 4; ++ii) v[ii] = p.b_ada[tid + 256 * (i0 + ii)];
#pragma unroll
    for (int kc = 0; kc < 16; ++kc)
#pragma unroll
      for (int ii = 0; ii < 4; ++ii) v[ii] += p.modp[(kc * 2 + b) * 6144 + tid + 256 * (i0 + ii)];
#pragma unroll
    for (int ii = 0; ii < 4; ++ii) modl[tid + 256 * (i0 + ii)] = v[ii];
  }
  if (bid < 48) {
    const int idx = bid * 256 + tid;
    const int bb = idx / 6144, n = idx % 6144;
    float v = p.b_ada[n];
#pragma unroll
    for (int kc = 0; kc < 16; ++kc) v += p.modp[(kc * 2 + bb) * 6144 + n];
    p.mod[idx] = v;
  }
  hb_sync();
  float cm[16], ca[16];
#pragma unroll
  for (int i = 0; i < 4; ++i) {
    const int col = i * 256 + lane * 4;
    const float4 g = *(const float4*)(p.g_pre_mix + col);
    const float4 sh = *(const float4*)(modl + col), sc = *(const float4*)(modl + 1024 + col);
    cm[i * 4 + 0] = g.x * (1.f + sc.x); cm[i * 4 + 1] = g.y * (1.f + sc.y); cm[i * 4 + 2] = g.z * (1.f + sc.z); cm[i * 4 + 3] = g.w * (1.f + sc.w);
    ca[i * 4 + 0] = sh.x; ca[i * 4 + 1] = sh.y; ca[i * 4 + 2] = sh.z; ca[i * 4 + 3] = sh.w;
  }
  const int stride = (nblk >> 1) * 4;
  for (int t0 = (bid >> 1) * 4 + wid; t0 < T; t0 += 4 * stride) {
    float4 v[4][4];
#pragma unroll
    for (int k = 0; k < 4; ++k) {
      const int t = t0 + k * stride < T ? t0 + k * stride : T - 1;
      const float* xr = p.x + ((long)b * T + t) * 1024;
#pragma unroll
      for (int i = 0; i < 4; ++i) v[k][i] = *(const float4*)(xr + i * 256 + lane * 4);
    }
#pragma unroll
    for (int k = 0; k < 4; ++k) {
      float ss = 0.f;
#pragma unroll
      for (int i = 0; i < 4; ++i) ss += v[k][i].x * v[k][i].x + v[k][i].y * v[k][i].y + v[k][i].z * v[k][i].z + v[k][i].w * v[k][i].w;
      ss = wave_sum(ss);
      const float r = rsqrtf(ss * (1.f / 1024.f) + 1e-6f);
      if (t0 + k * stride < T) {
        u16* hr = p.h + ((long)b * T + t0 + k * stride) * 1024;
#pragma unroll
        for (int i = 0; i < 4; ++i) {
          const float o0 = v[k][i].x * r * cm[i * 4 + 0] + ca[i * 4 + 0];
          const float o1 = v[k][i].y * r * cm[i * 4 + 1] + ca[i * 4 + 1];
          const float o2 = v[k][i].z * r * cm[i * 4 + 2] + ca[i * 4 + 2];
          const float o3 = v[k][i].w * r * cm[i * 4 + 3] + ca[i * 4 + 3];
          *(uint2*)(hr + i * 256 + lane * 4) = pack4(o0, o1, o2, o3);
        }
      }
    }
  }
}

struct EpiProj {
  u16* proj; float* widx; int m0, n0;
  template <int MT> DI void operator()(f32x16 (&acc)[MT][2], int wm, int wn, int lane) const {
    SW_FOR {
      const int r = m0 + SW_R, c = n0 + SW_C0;
      if (c < LDP) {
        float v[4] = {SW_V(0), SW_V(1), SW_V(2), SW_V(3)};
        if (c < C_KV) { for (int j = 0; j < 4; ++j) v[j] *= 0.125f; }
        else if (c < C_GN) {}
        else if (c < C_QD) { for (int j = 0; j < 4; ++j) v[j] = sigmoidf(v[j]); }
        else if (c < C_QI) {}
        else if (c < C_KI) { for (int j = 0; j < 4; ++j) v[j] *= 0.125f; }
        else if (c < C_WI) {}
        else if (c < C_GM) {
          for (int j = 0; j < 4; ++j) v[j] *= 0.35355339059327373f;
          *(float4*)(widx + (long)r * 8 + (c - C_WI)) = make_float4(v[0], v[1], v[2], v[3]);
        } else { for (int j = 0; j < 4; ++j) v[j] = sigmoidf(v[j]); }
        *(uint2*)(proj + (long)r * LDP + c) = pack4(v[0], v[1], v[2], v[3]);
      }
    }
  }
};
struct EpiProjVT {
  u16* vt; int m0;
  DI void operator()(f32x16 (&acc)[2][2], int wm, int wn, int lane) const {
#pragma unroll
    for (int mt = 0; mt < 2; ++mt)
#pragma unroll
      for (int nt = 0; nt < 2; ++nt) {
        const int cc = EPI_C;
#pragma unroll
        for (int q4 = 0; q4 < 4; ++q4) {
          const int r = m0 + wm * 64 + mt * 32 + 8 * q4 + 4 * (lane >> 5);
          const int b = r >> 13, t = r & 8191;
          uint2 w;
          w.x = pack2(acc[mt][nt][q4 * 4 + 0], acc[mt][nt][q4 * 4 + 1]);
          w.y = pack2(acc[mt][nt][q4 * 4 + 2], acc[mt][nt][q4 * 4 + 3]);
          *(uint2*)(vt + ((long)(b * 128 + cc)) * T + t) = w;
        }
      }
  }
};
DI int proj_group(int q) { return q < 7 ? q : (q < 8 ? q + 1 : q + 2); }
DI void proj_store4(u16* proj, float* widx, long r, int c, float v0, float v1, float v2, float v3) {
  if (c < LDP) {
    float v[4] = {v0, v1, v2, v3};
    if (c < C_KV) { for (int j = 0; j < 4; ++j) v[j] *= 0.125f; }
    else if (c < C_GN) {}
    else if (c < C_QD) { for (int j = 0; j < 4; ++j) v[j] = sigmoidf(v[j]); }
    else if (c < C_QI) {}
    else if (c < C_KI) { for (int j = 0; j < 4; ++j) v[j] *= 0.125f; }
    else if (c < C_WI) {}
    else if (c < C_GM) {
      for (int j = 0; j < 4; ++j) v[j] *= 0.35355339059327373f;
      *(float4*)(widx + r * 8 + (c - C_WI)) = make_float4(v[0], v[1], v[2], v[3]);
    } else { for (int j = 0; j < 4; ++j) v[j] = sigmoidf(v[j]); }
    *(uint2*)(proj + r * LDP + c) = pack4(v[0], v[1], v[2], v[3]);
  }
}
struct WRows2 { const u16* base; int ra, rb; DI const u16* origin() const { return base; } DI int off(int r) const { return ((r < 128 ? ra : rb) + (r & 127)) * 1024; } };
struct Epi8Proj {
  u16* proj; float* widx; int m0, n0a, n0b;
  DI void operator()(int q, int c, float v0, float v1, float v2, float v3) const {
    proj_store4(proj, widx, m0 + q, (c < 128 ? n0a : n0b) + (c & 127), v0, v1, v2, v3);
  }
};
struct Epi8ProjVT {
  u16* vts; u16* vtw; int m0;
  DI void operator()(int q, int c, float v0, float v1, float v2, float v3) const {
    const int r = m0 + c, b = r >> 13, t = r & 8191;
    u16* vt = q < 128 ? vts : vtw;
    *(uint2*)(vt + ((long)(b * 128 + (q & 127))) * T + t) = pack4(v0, v1, v2, v3);
  }
};
DI void phase2_8w(const Params& p, int wg, int nwg) {
  for (int i = wg; i < 1280; i += nwg) {
    const int x_ = i & 7, s_ = (i >> 3) & 31, blk = (i >> 8) * 8 + x_;
    if (blk >= 36) continue;
    const int nb = blk % 9, mb = blk / 9;
    const int mt_ = mb * 16 + (s_ >> 1), v = 2 * nb + (s_ & 1);
    ARows tf{p.h + (long)mt_ * 256 * 1024, 1024, 256};
    if (v < 17) {
      const int ga = proj_group(2 * v), gb = proj_group(2 * v + 1);
      WRows2 wf{p.w_inT, ga * 128, gb * 128};
      Epi8Proj ef{p.proj, p.widx, mt_ * 256, ga * 128, gb * 128};
      gemm8p(16, wf, tf, ef);
    } else {
      WRows2 wf{p.w_inT, 7 * 128, 9 * 128};
      Epi8ProjVT ef{p.vts, p.vtw, mt_ * 256};
      gemm8p(16, tf, wf, ef);
    }
  }
}
DI void phase2(const Params& p, char* smem, int bid, int nblk) {}

struct ACmp {
  const u16* proj; int slot, m0, kt0;
  DI const u16* operator()(int r) const {
    const int R = m0 + r, bg = R >> 9, n = R & 511, b = bg >> 1, g = bg & 1;
    const int nc = n >= 511 ? 510 : n;
    return proj + ((long)b * T + 16 * nc + kt0) * LDP + C_KV + slot * 128 + g * 64;
  }
};
struct EpiPartF32 {
  float* dst; int m0;
  DI void operator()(f32x16 (&acc)[2][2], int wm, int wn, int lane) const {
    constexpr int MT = 2;
    SW_FOR { *(float4*)(dst + (long)(m0 + SW_R) * 128 + SW_C0) = make_float4(SW_V(0), SW_V(1), SW_V(2), SW_V(3)); }
  }
};
struct EpiCmp1 {
  u16* zc; const float* b1; const float* pe_part; int slot, m0;
  DI void operator()(f32x16 (&acc)[2][2], int wm, int wn, int lane) const {
    constexpr int MT = 2;
#pragma unroll
    for (int nt = 0; nt < 2; ++nt)
#pragma unroll
      for (int q4 = 0; q4 < 4; ++q4) {
        const int c = SW_C0;
        float4 bias = *(const float4*)(b1 + slot * 128 + c);
        for (int q = 0; q < 16; ++q) {
          const float4 t = *(const float4*)(pe_part + q * 256 + slot * 128 + c);
          bias.x += t.x; bias.y += t.y; bias.z += t.z; bias.w += t.w;
        }
#pragma unroll
        for (int mt = 0; mt < 2; ++mt) {
          const int R = m0 + SW_R;
          *(uint2*)(zc + ((long)slot * 2048 + R) * 128 + c) =
              pack4(gelu_tanh(SW_V(0) + bias.x), gelu_tanh(SW_V(1) + bias.y), gelu_tanh(SW_V(2) + bias.z), gelu_tanh(SW_V(3) + bias.w));
        }
      }
  }
};
struct EpiQlat {
  u16* qlat; int h, m0;
  DI void operator()(f32x16 (&acc)[2][2], int wm, int wn, int lane) const {
    constexpr int MT = 2;
    SW_FOR {
      const int r = m0 + SW_R, c = SW_C0;
      *(uint2*)(qlat + ((long)r * 8 + h) * 128 + c) = pack4(SW_V(0) * 0.125f, SW_V(1) * 0.125f, SW_V(2) * 0.125f, SW_V(3) * 0.125f);
    }
  }
};
constexpr int IDX_QLD = 520;
constexpr int IDX_NITEMS = 1152;
DI void indexer_item2(const Params& p, char* smem, int b, int tq, int c) {
  const int tid = TIDX(), lane = tid & 63, wid = __builtin_amdgcn_readfirstlane(tid >> 6);
  u16* Qs = (u16*)smem;
  float* wl = (float*)(smem + 64 * IDX_QLD * 2);
  const u16* projb = p.proj + (long)b * T * LDP;
  const int t0 = tq * 64;
  {
    uint4 q[16];
#pragma unroll
    for (int i = 0; i < 16; ++i) q[i] = *(const uint4*)(projb + (long)(t0 + i * 4 + wid) * LDP + C_QI + lane * 8);
    const float2 wv = *(const float2*)(p.widx + ((long)b * T + t0) * 8 + tid * 2);
#pragma unroll
    for (int i = 0; i < 16; ++i) *(uint4*)(Qs + (i * 4 + wid) * IDX_QLD + lane * 8) = q[i];
    *(float2*)(wl + tid * 2) = wv;
  }
  hb_sync();
  const int r31 = lane & 31, hf = lane >> 5;
  const int kt_lo = c * 16, kt_hi = (kt_lo + 16 < tq + 1) ? kt_lo + 16 : tq + 1;
  const u16* qfrag = Qs + r31 * IDX_QLD + hf * 8;
  const float* wq = wl + r31 * 8;
  const u16* kbase = projb + (long)r31 * LDP + C_KI + hf * 8;
  bf16x8 kn[2][4];
#define IDX2_LOADK(KT)                                                                                   \
  {                                                                                                      \
    const int kk_ = (KT) < kt_hi ? (KT) : kt_hi - 1;                                                     \
    _Pragma("unroll") for (int nt = 0; nt < 2; ++nt)                                                     \
      _Pragma("unroll") for (int ks = 0; ks < 4; ++ks) kn[nt][ks] = *(const bf16x8*)(kbase + (long)(kk_ * 64 + nt * 32) * LDP + ks * 16); \
  }
  IDX2_LOADK(kt_lo + wid)
#pragma unroll 1
  for (int kt = kt_lo + wid; kt < kt_hi; kt += 4) {
    bf16x8 kf[2][4];
#pragma unroll
    for (int nt = 0; nt < 2; ++nt)
#pragma unroll
      for (int ks = 0; ks < 4; ++ks) kf[nt][ks] = kn[nt][ks];
    IDX2_LOADK(kt + 4)
    asm volatile("" ::: "memory");
    f32x16 sum[2][2];
#pragma unroll
    for (int a = 0; a < 2; ++a)
#pragma unroll
      for (int d = 0; d < 2; ++d)
#pragma unroll
        for (int i = 0; i < 16; ++i) sum[a][d][i] = 0.f;
#define IDX2_LOADQ(DST, MT, H)                                                                          \
  {                                                                                                      \
    const int h_ = (H) < 7 ? (H) : 7;                                                                    \
    _Pragma("unroll") for (int ks = 0; ks < 4; ++ks) DST[ks] = *(const bf16x8*)(qfrag + (MT) * 32 * IDX_QLD + h_ * 64 + ks * 16); \
  }
#define IDX2_CHAIN(ACC, SRC, NT)                                                                         \
  {                                                                                                      \
    _Pragma("unroll") for (int i = 0; i < 16; ++i) ACC[i] = 0.f;                                         \
    _Pragma("unroll") for (int ks = 0; ks < 4; ++ks) ACC = __builtin_amdgcn_mfma_f32_32x32x16_bf16(kf[NT][ks], SRC[ks], ACC, 0, 0, 0); \
  }
#define IDX2_ACCUM(ACC, MT, NT, W)                                                                       \
  {                                                                                                      \
    _Pragma("unroll") for (int i = 0; i < 16; ++i) {                                                     \
      const int rb_ = __float_as_int(ACC[i]);                                                            \
      sum[MT][NT][i] += (W) * __int_as_float(rb_ > 0 ? rb_ : 0);                                         \
    }                                                                                                    \
  }
#define IDX2_SGB4 \
  __builtin_amdgcn_sched_group_barrier(0x008, 1, 0); __builtin_amdgcn_sched_group_barrier(0x002, 6, 0); \
  __builtin_amdgcn_sched_group_barrier(0x008, 1, 0); __builtin_amdgcn_sched_group_barrier(0x002, 6, 0); \
  __builtin_amdgcn_sched_group_barrier(0x008, 1, 0); __builtin_amdgcn_sched_group_barrier(0x002, 6, 0); \
  __builtin_amdgcn_sched_group_barrier(0x008, 1, 0); __builtin_amdgcn_sched_group_barrier(0x002, 6, 0);
    bf16x8 sa[4], sb[4];
    f32x16 accA, accB;
    IDX2_LOADQ(sa, 0, 0)
    IDX2_LOADQ(sb, 1, 0)
    float w0 = wq[0], w1 = wq[256];
    IDX2_CHAIN(accA, sa, 0)
#pragma unroll 1
    for (int h = 0; h < 8; ++h) {
      const int hn = h < 7 ? h + 1 : 7;
      IDX2_CHAIN(accB, sa, 1)
      IDX2_ACCUM(accA, 0, 0, w0)
      IDX2_LOADQ(sa, 0, h + 1)
      IDX2_CHAIN(accA, sb, 0)
      IDX2_ACCUM(accB, 0, 1, w0)
      IDX2_CHAIN(accB, sb, 1)
      IDX2_ACCUM(accA, 1, 0, w1)
      IDX2_LOADQ(sb, 1, h + 1)
      const float w0n = wq[hn], w1n = wq[256 + hn];
      IDX2_CHAIN(accA, sa, 0)
      IDX2_ACCUM(accB, 1, 1, w1)
      w0 = w0n; w1 = w1n;
      IDX2_SGB4
      IDX2_SGB4
      __builtin_amdgcn_sched_group_barrier(0x100, 5, 0);
      IDX2_SGB4
      IDX2_SGB4
      __builtin_amdgcn_sched_group_barrier(0x100, 5, 0);
    }
#undef IDX2_LOADQ
#undef IDX2_CHAIN
#undef IDX2_ACCUM
#undef IDX2_SGB4
    const int s0 = kt * 64;
#pragma unroll
    for (int mt = 0; mt < 2; ++mt)
#pragma unroll
      for (int nt = 0; nt < 2; ++nt)
#pragma unroll
        for (int q4 = 0; q4 < 4; ++q4) {
          typedef _Float16 h4_t __attribute__((ext_vector_type(4)));
          typedef float f4_t __attribute__((ext_vector_type(4)));
          const f4_t v4 = {sum[mt][nt][4 * q4], sum[mt][nt][4 * q4 + 1], sum[mt][nt][4 * q4 + 2], sum[mt][nt][4 * q4 + 3]};
          *(h4_t*)((u16*)p.scores + ((long)b * T + t0 + mt * 32 + r31) * T + s0 + nt * 32 + 8 * q4 + 4 * hf) = __builtin_convertvector(v4, h4_t);
        }
  }
#undef IDX2_LOADK
}
DI void phase3(const Params& p, char* smem, int bid, int nblk) {
  const int tid = TIDX(), lane = tid & 63, wid = __builtin_amdgcn_readfirstlane(tid >> 6);
  if (bid < 128) {
    const int kq = bid & 3, tile = bid >> 2, slot = tile >> 4, mt_ = tile & 15;
    ACmp af{p.proj, slot, mt_ * 128, kq * 8};
    BMat bf{p.cmp_w1 + ((long)slot * 2048 + kq * 512) * 128, 128, 128};
    EpiPartF32 ef{p.cpart + ((long)kq * 4096 + slot * 2048) * 128, mt_ * 128};
    gemm_tile(smem, 8, LDP, af, bf, ef);
  }
  int* qslot = (int*)(smem + 64 * IDX_QLD * 2 + 2048);
  unsigned* qctr = p.bar + XCD_BAR_WORDS;
  hb_sync();
  if (tid == 0) *qslot = (int)atomicAdd(qctr, 1u);
  for (;;) {
    hb_sync();
    const int i = __builtin_amdgcn_readfirstlane(*qslot);
    if (i >= IDX_NITEMS + 1024 + 512) break;
    int nxt = 0;
    if (tid == 0) nxt = (int)atomicAdd(qctr, 1u);
    if (i < IDX_NITEMS) {
      const int b = i & 1;
      int j = i >> 1, c = 0;
      while (j >= 128 - 16 * c) { j -= 128 - 16 * c; ++c; }
      indexer_item2(p, smem, b, 127 - j, c);
    } else if (i < IDX_NITEMS + 1024) {
      const int it = i - IDX_NITEMS, h = it & 7, mt_ = it >> 3;
      ARows af{p.proj + (long)mt_ * 128 * LDP + C_QD + h * 64, LDP, 128};
      BMat bf{p.w_ukT + h * 64 * 128, 128, 128};
      EpiQlat ef{p.qlat, h, mt_ * 128};
      gemm_tile<true, true>(smem, 1, 64, af, bf, ef);
    } else {
      const int it = i - IDX_NITEMS - 1024;
      const float n0 = p.dsa_kv_norm[lane * 2], n1 = p.dsa_kv_norm[lane * 2 + 1];
      unsigned u[8];
#pragma unroll
      for (int q = 0; q < 8; ++q) u[q] = *(const unsigned*)(p.proj + (long)(it * 32 + wid * 8 + q) * LDP + C_CKV + lane * 2);
#pragma unroll
      for (int q = 0; q < 8; ++q) {
        const float a = lo16(u[q]), b = hi16(u[q]);
        const float ss = wave_sum(a * a + b * b);
        const float r = rsqrtf(ss * (1.f / 128.f) + 1e-6f);
        *(unsigned*)(p.ckv + (long)(it * 32 + wid * 8 + q) * 128 + lane * 2) = pack2(a * r * n0, b * r * n1);
      }
    }
    hb_sync();
    if (tid == 0) *qslot = nxt;
  }
}

struct EpiCmp2 {
  u16* dst; int m0;
  DI void operator()(f32x16 (&acc)[2][2], int wm, int wn, int lane) const {
    constexpr int MT = 2;
    SW_FOR {
      const int R = m0 + SW_R, c = SW_C0;
      if (c < 64) *(uint2*)(dst + (long)R * 64 + c) = pack4(SW_V(0), SW_V(1), SW_V(2), SW_V(3));
    }
  }
};
struct EpiCmp2T {
  u16* dst; int m0;
  DI void operator()(f32x16 (&acc)[2][2], int wm, int wn, int lane) const {
#pragma unroll
    for (int mt = 0; mt < 2; ++mt)
#pragma unroll
      for (int nt = 0; nt < 2; ++nt) {
        const int c = EPI_C;
        if (c < 64) {
#pragma unroll
          for (int q4 = 0; q4 < 4; ++q4) {
            const int R = m0 + wm * 64 + mt * 32 + 8 * q4 + 4 * (lane >> 5);
            const int bg = R >> 9, n = R & 511;
            *(uint2*)(dst + ((long)(bg * 64 + c)) * 512 + n) =
                pack4(acc[mt][nt][q4 * 4 + 0], acc[mt][nt][q4 * 4 + 1], acc[mt][nt][q4 * 4 + 2], acc[mt][nt][q4 * 4 + 3]);
          }
        }
      }
  }
};
DI void indexer_item(const Params& p, char* smem, int item) {
  const int tid = TIDX(), lane = tid & 63, wid = __builtin_amdgcn_readfirstlane(tid >> 6);
  int b = 0, rem = item;
  if (rem >= 2080) { b = 1; rem -= 2080; }
  int qt = (int)((sqrtf(8.f * rem + 1.f) - 1.f) * 0.5f);
  while ((qt + 1) * (qt + 2) / 2 <= rem) ++qt;
  while (qt * (qt + 1) / 2 > rem) --qt;
  const int kt = rem - qt * (qt + 1) / 2;
  const int t0 = qt * 128 + (wid >> 1) * 64, s0 = kt * 128 + (wid & 1) * 64;
  if (s0 > t0 + 63) return;
  float* wl = (float*)smem + wid * 512;
  const float* wsrc = p.widx + ((long)b * T + t0) * 8;
#pragma unroll
  for (int i = 0; i < 8; ++i) wl[i * 64 + lane] = wsrc[i * 64 + lane];
  wave_sync();
  const u16* projb = p.proj + (long)b * T * LDP;
  const int r31 = lane & 31, hf = lane >> 5;
  u16* Kt = (u16*)(smem + 8192) + wid * (64 * 72);
  {
    const int piece = lane & 7, rb = lane >> 3;
#pragma unroll
    for (int i = 0; i < 8; ++i) {
      const uint4 v = *(const uint4*)(projb + (long)(s0 + rb + 8 * i) * LDP + C_KI + piece * 8);
      *(uint4*)(Kt + (rb + 8 * i) * 72 + piece * 8) = v;
    }
  }
  wave_sync();
  const u16* kfrag = Kt + r31 * 72 + hf * 8;
  f32x16 sum[2][2];
#pragma unroll
  for (int a = 0; a < 2; ++a)
#pragma unroll
    for (int c = 0; c < 2; ++c)
#pragma unroll
      for (int i = 0; i < 16; ++i) sum[a][c][i] = 0.f;
  const u16* qbase = projb + (long)(t0 + r31) * LDP + C_QI + hf * 8;
  bf16x8 af0[4], af1[4], af2[4], af3[4];
#define IDX_LOADQ(DST, STEP)                                                                            \
  {                                                                                                     \
    const int st_ = (STEP) < 15 ? (STEP) : 15;                                                          \
    _Pragma("unroll") for (int ks = 0; ks < 4; ++ks) DST[ks] = *(const bf16x8*)(qbase + (long)(st_ & 1) * 32 * LDP + (st_ >> 1) * 64 + ks * 16); \
  }
#define IDX_STEP(SRC, MT, H)                                                                            \
  {                                                                                                     \
    const float w_ = wl[((MT) * 32 + r31) * 8 + (H)];                                                   \
    _Pragma("unroll") for (int nt = 0; nt < 2; ++nt) {                                                  \
      f32x16 acc;                                                                                       \
      _Pragma("unroll") for (int i = 0; i < 16; ++i) acc[i] = 0.f;                                      \
      _Pragma("unroll") for (int ks = 0; ks < 4; ++ks) acc = __builtin_amdgcn_mfma_f32_32x32x16_bf16(*(const bf16x8*)(kfrag + nt * 32 * 72 + ks * 16), SRC[ks], acc, 0, 0, 0); \
      _Pragma("unroll") for (int i = 0; i < 16; ++i) sum[MT][nt][i] += w_ * fmaxf(acc[i], 0.f);        \
    }                                                                                                   \
  }
  IDX_LOADQ(af0, 0) IDX_LOADQ(af1, 1) IDX_LOADQ(af2, 2)
#pragma unroll 1
  for (int s4 = 0; s4 < 16; s4 += 4) {
    IDX_LOADQ(af3, s4 + 3)
    asm volatile("" ::: "memory");
    IDX_STEP(af0, 0, s4 >> 1)
    asm volatile("" ::: "memory");
    IDX_LOADQ(af0, s4 + 4)
    asm volatile("" ::: "memory");
    IDX_STEP(af1, 1, s4 >> 1)
    asm volatile("" ::: "memory");
    IDX_LOADQ(af1, s4 + 5)
    asm volatile("" ::: "memory");
    IDX_STEP(af2, 0, (s4 >> 1) + 1)
    asm volatile("" ::: "memory");
    IDX_LOADQ(af2, s4 + 6)
    asm volatile("" ::: "memory");
    IDX_STEP(af3, 1, (s4 >> 1) + 1)
    asm volatile("" ::: "memory");
  }
#undef IDX_LOADQ
#undef IDX_STEP
#pragma unroll
  for (int mt = 0; mt < 2; ++mt)
#pragma unroll
    for (int nt = 0; nt < 2; ++nt)
#pragma unroll
      for (int q4 = 0; q4 < 4; ++q4)
      {
        typedef _Float16 h4_t __attribute__((ext_vector_type(4)));
        typedef float f4_t __attribute__((ext_vector_type(4)));
        const f4_t v4 = {sum[mt][nt][4 * q4], sum[mt][nt][4 * q4 + 1], sum[mt][nt][4 * q4 + 2], sum[mt][nt][4 * q4 + 3]};
        *(h4_t*)((u16*)p.scores + ((long)b * T + t0 + mt * 32 + r31) * T + s0 + nt * 32 + 8 * q4 + 4 * hf) = __builtin_convertvector(v4, h4_t);
      }
}
DI void topk_row(const Params& p, int b, int t, int lane);
DI void phase4(const Params& p, char* smem, int bid, int nblk) {
  if (bid < 32) {
    const int slot = bid >> 4, mt_ = bid & 15;
    {
      const int tid = TIDX(), c = (tid & 31) * 4;
      float4 bias = *(const float4*)(p.cmp_b1 + slot * 128 + c);
      for (int q = 0; q < 16; ++q) {
        const float4 t = *(const float4*)(p.pe_part + q * 256 + slot * 128 + c);
        bias.x += t.x; bias.y += t.y; bias.z += t.z; bias.w += t.w;
      }
#pragma unroll 4
      for (int i = 0; i < 16; ++i) {
        const long R = (long)slot * 2048 + mt_ * 128 + (tid >> 5) + 8 * i;
        float4 v = *(const float4*)(p.cpart + R * 128 + c);
#pragma unroll
        for (int kq = 1; kq < 4; ++kq) {
          const float4 t = *(const float4*)(p.cpart + ((long)kq * 4096 + R) * 128 + c);
          v.x += t.x; v.y += t.y; v.z += t.z; v.w += t.w;
        }
        *(uint2*)(p.zc + R * 128 + c) = pack4(gelu_tanh(v.x + bias.x), gelu_tanh(v.y + bias.y), gelu_tanh(v.z + bias.z), gelu_tanh(v.w + bias.w));
      }
      hb_sync();
    }
    ARows af{p.zc + ((long)slot * 2048 + mt_ * 128) * 128, 128, 128};
    BMat bf{p.cmp_w2 + slot * 128 * 64, 64, 64};
    if (slot) { EpiCmp2T ef{p.vcT, mt_ * 128}; gemm_tile<false>(smem, 2, 64, af, bf, ef); }
    else { EpiCmp2 ef{p.kc, mt_ * 128}; gemm_tile(smem, 2, 64, af, bf, ef); }
  }
  const int tid = TIDX(), lane = tid & 63, wid = __builtin_amdgcn_readfirstlane(tid >> 6);
  for (int item = bid; item < 2048; item += nblk) {
    const int it = item < 1024 ? 2047 - item : item - 1024;
    const int b = it & 1, tb = it >> 1;
#pragma unroll 1
    for (int q = 0; q < 2; ++q) {
      asm volatile("" ::: "memory");
      topk_row(p, b, tb * 8 + wid * 2 + q, lane);
    }
  }
}

#define MFMA16(a, b, c) __builtin_amdgcn_mfma_f32_16x16x32_bf16((a), (b), (c), 0, 0, 0)
#define MFMA32(a, b, c) __builtin_amdgcn_mfma_f32_32x32x16_bf16((a), (b), (c), 0, 0, 0)

constexpr int NSA_STAGE_BYTES = 64 * 72 * 2 + 64 * 68 * 2;
DI void dense_scores(f32x16 (&acc)[2], const u16* Ks, const bf16x8 (&qf)[4], int lane) {
  const int r = lane & 31, hf = lane >> 5;
  bf16x8 kf[2][4];
#pragma unroll
  for (int tile = 0; tile < 2; ++tile)
#pragma unroll
    for (int ks = 0; ks < 4; ++ks) kf[tile][ks] = *(const bf16x8*)(Ks + (32 * tile + r) * 72 + 8 * hf + 16 * ks);
  asm volatile("" ::: "memory");
#pragma unroll
  for (int tile = 0; tile < 2; ++tile) {
    f32x16 c;
#pragma unroll
    for (int i = 0; i < 16; ++i) c[i] = 0.f;
#pragma unroll
    for (int ks = 0; ks < 4; ++ks) c = MFMA32(kf[tile][ks], qf[ks], c);
    acc[tile] = c;
  }
}
DI void dense_pv(const f32x16 (&acc)[2], const u16* Vs, int lane, f32x16 (&o)[2]) {
  const int r = lane & 31, hf = lane >> 5;
  uint2 vlo[2][2][2], vhi[2][2][2];
#pragma unroll
  for (int tile = 0; tile < 2; ++tile)
#pragma unroll
    for (int s = 0; s < 2; ++s)
#pragma unroll
      for (int dt = 0; dt < 2; ++dt) {
        const u16* vp = Vs + (32 * dt + r) * 68 + 32 * tile + 16 * s + 4 * hf;
        vlo[tile][s][dt] = *(const uint2*)vp;
        vhi[tile][s][dt] = *(const uint2*)(vp + 8);
      }
  asm volatile("" ::: "memory");
#pragma unroll
  for (int tile = 0; tile < 2; ++tile)
#pragma unroll
    for (int s = 0; s < 2; ++s) {
      uint4 w;
      w.x = pack2(acc[tile][8 * s + 0], acc[tile][8 * s + 1]);
      w.y = pack2(acc[tile][8 * s + 2], acc[tile][8 * s + 3]);
      w.z = pack2(acc[tile][8 * s + 4], acc[tile][8 * s + 5]);
      w.w = pack2(acc[tile][8 * s + 6], acc[tile][8 * s + 7]);
      const bf16x8 pb = __builtin_bit_cast(bf16x8, w);
#pragma unroll
      for (int dt = 0; dt < 2; ++dt) {
        uint4 a;
        a.x = vlo[tile][s][dt].x; a.y = vlo[tile][s][dt].y; a.z = vhi[tile][s][dt].x; a.w = vhi[tile][s][dt].y;
        o[dt] = MFMA32(__builtin_bit_cast(bf16x8, a), pb, o[dt]);
      }
    }
}
constexpr float LOG2E = 1.4426950408889634f;
template <int DSTEP>
DI float dense_mask(f32x16 (&acc)[2], bool active, int lo_c, int hi_c, int dist0_c, int dmin_u, const float* btab_h, int lane) {
  const int hf = lane >> 5;
  const bool colfull = !active || (lo_c <= 0 && hi_c >= 63);
  float mx = -INFINITY;
  if (dmin_u >= 128 && __ballot(colfull) == ~0ull) {
    const float be = active ? btab_h[128] : -INFINITY;
#pragma unroll
    for (int tile = 0; tile < 2; ++tile)
#pragma unroll
      for (int i = 0; i < 16; ++i) {
        const float sv = fmaf(acc[tile][i], LOG2E, be);
        acc[tile][i] = sv;
        mx = fmaxf(mx, sv);
      }
  } else {
    const int lo2 = active ? lo_c : 1, hi2 = active ? hi_c : 0;
#pragma unroll
    for (int tile = 0; tile < 2; ++tile)
#pragma unroll
      for (int i = 0; i < 16; ++i) {
        const int kl = 32 * tile + (i & 3) + 8 * (i >> 2) + 4 * hf;
        int dc = dist0_c - DSTEP * kl;
        dc = dc < 0 ? 0 : (dc > 128 ? 128 : dc);
        const float bias = btab_h[dc];
        const float s2 = fmaf(acc[tile][i], LOG2E, bias);
        const float sv = (kl >= lo2 && kl <= hi2) ? s2 : -INFINITY;
        acc[tile][i] = sv;
        mx = fmaxf(mx, sv);
      }
  }
  return x32_max(mx);
}
DI void dense_chunk(const u16* Ks, const u16* Vs, bool active, int lo_c, int hi_c, int dist0_c, int dmin_u, const bf16x8 (&qf)[4],
                    const float* btab_h, int lane, float& m, float& l, f32x16 (&o)[2]) {
  f32x16 acc[2];
  dense_scores(acc, Ks, qf, lane);
  const float mx = dense_mask<1>(acc, active, lo_c, hi_c, dist0_c, dmin_u, btab_h, lane);
  const float mn = fmaxf(m, mx);
  const float alpha = __builtin_amdgcn_exp2f(m - mn);
  float ls = 0.f;
#pragma unroll
  for (int tile = 0; tile < 2; ++tile)
#pragma unroll
    for (int i = 0; i < 16; ++i) {
      const float pv = __builtin_amdgcn_exp2f(acc[tile][i] - mn);
      acc[tile][i] = pv;
      ls += pv;
    }
  ls = x32_sum(ls);
  l = l * alpha + ls;
  m = mn;
  o[0] *= alpha;
  o[1] *= alpha;
  dense_pv(acc, Vs, lane, o);
}

template <int KSG, int VSG, bool NEEDV, class Next, class Body>
DI void chunk_pipeline(char* stage, const u16* kg0, const u16* vg0, int first, int tid, const Next& next, const Body& body) {
  const int srow = tid >> 3, spiece = tid & 7;
  uint4 rk0, rv0;
  rv0 = make_uint4(0, 0, 0, 0);
  int d = first;
#define NSA_GLOAD(D)                                                                      \
  {                                                                                       \
    rk0 = *(const uint4*)(kg0 + ((long)(D) * 64 + srow) * KSG + spiece * 8);              \
    if (NEEDV) rv0 = *(const uint4*)(vg0 + (long)srow * VSG + (D) * 64 + spiece * 8);     \
  }
  if (d >= 0) NSA_GLOAD(d)
  int ph = 0;
  __syncthreads();
  while (d >= 0) {
    u16* Ks = (u16*)(stage + ph * NSA_STAGE_BYTES);
    u16* Vs = Ks + 64 * 72;
    *(uint4*)(Ks + srow * 72 + spiece * 8) = rk0;
    if (NEEDV) {
      uint2* dv = (uint2*)(Vs + srow * 68 + spiece * 8);
      dv[0] = make_uint2(rv0.x, rv0.y); dv[1] = make_uint2(rv0.z, rv0.w);
    }
    const int dn = next(d);
    if (dn >= 0) NSA_GLOAD(dn)
    __syncthreads();
    body(d, Ks, Vs);
    ph ^= 1;
    d = dn;
  }
#undef NSA_GLOAD
}

DI void nsa_item(const Params& p, char* smem, int item) {
  const int tid = TIDX8(), lane = tid & 63, wid = __builtin_amdgcn_readfirstlane(tid >> 6);
  const int chunk = item & 127, g = (item >> 7) & 1, b = item >> 8;
  const int bg = b * 2 + g;
  float* btab = (float*)smem;
  u64* wun = (u64*)(smem + 2304);
  float* imps = (float*)(smem + 4096) + wid * 1056;
  char* stage = smem + 37888;
  for (int idx = tid; idx < 4 * 129; idx += 512) {
    const int h = idx / 129, d = idx % 129;
    const int bk = d < 128 ? BUCKET[d] : 31;
    btab[h * 132 + d] = p.rel_bias[bk * 16 + g * 4 + h] * LOG2E;
  }
  __syncthreads();
  const int t0 = chunk * 64;
  const int tw = t0 + wid * 8;
  const int c = lane & 31, hf = lane >> 5, qi = c >> 2, hh = c & 3;
  const int t_c = tw + qi;
  const int cur = t0 >> 6;
  const long row = (long)b * T + t_c;
  const u16* prow = p.proj + row * LDP;
  const u16* projb = p.proj + (long)b * T * LDP;
  const float* btab_h = btab + hh * 132;
  bf16x8 qf[4];
#pragma unroll
  for (int ks = 0; ks < 4; ++ks) qf[ks] = *(const bf16x8*)(prow + C_QN + (g * 4 + hh) * 64 + ks * 16 + hf * 8);
  const u16* gptr = prow + C_GN + (g * 4 + hh) * 3;
  for (int k = lane; k < 1056; k += 64) imps[k] = 0.f;
  u16* orow = p.onsa + row * 512 + (g * 4 + hh) * 64 + 4 * hf;
  auto emit = [&](const f32x16 (&o)[2], float sc, bool first) {
#pragma unroll
    for (int dt = 0; dt < 2; ++dt)
#pragma unroll
      for (int q4 = 0; q4 < 4; ++q4) {
        uint2* dst = (uint2*)(orow + 32 * dt + 8 * q4);
        float v0 = o[dt][4 * q4 + 0] * sc, v1 = o[dt][4 * q4 + 1] * sc, v2 = o[dt][4 * q4 + 2] * sc, v3 = o[dt][4 * q4 + 3] * sc;
        if (!first) {
          const uint2 u = *dst;
          v0 += lo16(u.x); v1 += hi16(u.x); v2 += lo16(u.y); v3 += hi16(u.y);
        }
        uint2 w;
        w.x = pack2(v0, v1);
        w.y = pack2(v2, v3);
        *dst = w;
      }
  };
  const int ncv_c = (t_c >= 31) ? ((t_c - 31) >> 4) + 1 : 0;
  const int ncv_max = ((t0 + 63 - 31) >> 4) + 1;
  const int nchunk_c = (ncv_max + 63) >> 6;
  {
    const u16* kcb = p.kc + (long)bg * 512 * 64;
    const u16* vcb = p.vcT + (long)bg * 64 * 512;
    float m = -1e30f, l = 0.f;
    auto next_c = [&](int d) { return d + 1 < nchunk_c ? d + 1 : -1; };
    chunk_pipeline<64, 512, false>(stage, kcb, vcb, 0, tid, next_c, [&](int i, const u16* Ks, const u16* Vs) {
      f32x16 acc[2];
      dense_scores(acc, Ks, qf, lane);
      const float mx = dense_mask<16>(acc, true, 0, ncv_c - 1 - i * 64, t_c - 31 - 1024 * i, tw - 31 - 1024 * i - 1008, btab_h, lane);
      const float mn = fmaxf(m, mx);
      float ls = 0.f;
#pragma unroll
      for (int tile = 0; tile < 2; ++tile)
#pragma unroll
        for (int q = 0; q < 16; ++q) ls += __builtin_amdgcn_exp2f(acc[tile][q] - mn);
      ls = x32_sum(ls);
      l = l * __builtin_amdgcn_exp2f(m - mn) + ls;
      m = mn;
    });
    const float invl = 1.f / fmaxf(l, 1e-30f);
    f32x16 oc[2];
#pragma unroll
    for (int i = 0; i < 16; ++i) { oc[0][i] = 0.f; oc[1][i] = 0.f; }
    chunk_pipeline<64, 512, true>(stage, kcb, vcb, 0, tid, next_c, [&](int i, const u16* Ks, const u16* Vs) {
      f32x16 acc[2];
      dense_scores(acc, Ks, qf, lane);
      (void)dense_mask<16>(acc, true, 0, ncv_c - 1 - i * 64, t_c - 31 - 1024 * i, tw - 31 - 1024 * i - 1008, btab_h, lane);
      float part[2][4], spill[2][4];
#pragma unroll
      for (int tile = 0; tile < 2; ++tile) {
#pragma unroll
        for (int q = 0; q < 16; ++q) acc[tile][q] = __builtin_amdgcn_exp2f(acc[tile][q] - m) * invl;
#pragma unroll
        for (int q4 = 0; q4 < 4; ++q4) {
          float pa = acc[tile][4 * q4] + acc[tile][4 * q4 + 1] + acc[tile][4 * q4 + 2] + 0.5f * acc[tile][4 * q4 + 3];
          float sp = 0.5f * acc[tile][4 * q4 + 3];
          pa += DPP_F0(pa, DPP_QP1, 0xF); pa += DPP_F0(pa, DPP_QP2, 0xF);
          sp += DPP_F0(sp, DPP_QP1, 0xF); sp += DPP_F0(sp, DPP_QP2, 0xF);
          part[tile][q4] = pa; spill[tile][q4] = sp;
        }
      }
      if (hh == 0) {
#pragma unroll
        for (int tile = 0; tile < 2; ++tile)
#pragma unroll
          for (int q4 = 0; q4 < 4; ++q4) imps[qi * 132 + 16 * i + 8 * tile + 2 * q4 + hf] += part[tile][q4];
      }
      wave_sync();
      if (hh == 0) {
#pragma unroll
        for (int tile = 0; tile < 2; ++tile)
#pragma unroll
          for (int q4 = 0; q4 < 4; ++q4) imps[qi * 132 + 16 * i + 8 * tile + 2 * q4 + hf + 1] += spill[tile][q4];
      }
      wave_sync();
      dense_pv(acc, Vs, lane, oc);
    });
    emit(oc, bf2f(gptr[0]), true);
  }
  wave_sync();
  u64 my0 = 0, my1 = 0, wu0 = 0, wu1 = 0;
  for (int q = 0; q < 8; ++q) {
    u64 mask0, mask1;
    if (cur <= 15) {
      mask0 = (2ull << cur) - 1ull;
      mask1 = 0ull;
    } else {
      const float imp_lo = imps[q * 132 + lane], imp_hi = imps[q * 132 + lane + 64];
      const int jl = lane, jh = lane + 64;
      float c0 = (jl >= 1 && jl <= cur - 2) ? imp_lo : -1.f;
      float c1 = (jh <= cur - 2) ? imp_hi : -1.f;
      bool sel_lo = (jl == 0) || (jl == cur) || (jl == cur - 1);
      bool sel_hi = (jh == cur) || (jh == cur - 1);
      for (int r = 0; r < 13; ++r) {
        float bv; int bj;
        if (c0 >= c1) { bv = c0; bj = jl; } else { bv = c1; bj = jh; }
        wave_argmax(bv, bj);
        if (bj == jl) { sel_lo = true; c0 = -1.f; }
        if (bj == jh) { sel_hi = true; c1 = -1.f; }
      }
      mask0 = __ballot(sel_lo);
      mask1 = __ballot(sel_hi);
    }
    if (qi == q) { my0 = mask0; my1 = mask1; }
    wu0 |= mask0; wu1 |= mask1;
  }
  if (lane == 0) { wun[wid * 2] = wu0; wun[wid * 2 + 1] = wu1; }
  __syncthreads();
  u64 bu0 = wun[0] | wun[2] | wun[4] | wun[6] | wun[8] | wun[10] | wun[12] | wun[14];
  u64 bu1 = wun[1] | wun[3] | wun[5] | wun[7] | wun[9] | wun[11] | wun[13] | wun[15];
  bu0 = ((u64)(unsigned)__builtin_amdgcn_readfirstlane((int)(bu0 >> 32)) << 32) | (unsigned)__builtin_amdgcn_readfirstlane((int)bu0);
  bu1 = ((u64)(unsigned)__builtin_amdgcn_readfirstlane((int)(bu1 >> 32)) << 32) | (unsigned)__builtin_amdgcn_readfirstlane((int)bu1);
  {
    float m = -1e30f, l = 0.f;
    f32x16 o[2];
#pragma unroll
    for (int i = 0; i < 16; ++i) { o[0][i] = 0.f; o[1][i] = 0.f; }
    const int kcol = C_KV + 2 * 128 + g * 64;
    auto next_s = [&](int j) {
      ++j;
      if (j < 64) {
        const u64 mm = bu0 & (~0ull << j);
        if (mm) return (int)__builtin_ctzll(mm);
        j = 64;
      }
      if (j >= 128) return -1;
      const u64 mm = bu1 & (~0ull << (j - 64));
      return mm ? 64 + (int)__builtin_ctzll(mm) : -1;
    };
    chunk_pipeline<LDP, T, true>(stage, projb + kcol, p.vts + (long)bg * 64 * T, 0, tid, next_s, [&](int j, const u16* Ks, const u16* Vs) {
      const bool bit = ((j < 64 ? (my0 >> j) : (my1 >> (j - 64))) & 1ull) != 0;
      if (__ballot(bit) != 0ull) {
        const int pos0 = 64 * j;
        dense_chunk(Ks, Vs, bit, 0, t_c - pos0, t_c - pos0, tw - pos0 - 63, qf, btab_h, lane, m, l, o);
      }
    });
    emit(o, bf2f(gptr[1]) / fmaxf(l, 1e-30f), false);
  }
  {
    float m = -1e30f, l = 0.f;
    f32x16 o[2];
#pragma unroll
    for (int i = 0; i < 16; ++i) { o[0][i] = 0.f; o[1][i] = 0.f; }
    const int kcol = C_KV + 4 * 128 + g * 64;
    const int wlo_c = t_c - 511 < 0 ? 0 : t_c - 511;
    const int wlo_min = t0 - 511 < 0 ? 0 : t0 - 511;
    auto next_w = [&](int j) { return j + 1 <= cur ? j + 1 : -1; };
    chunk_pipeline<LDP, T, true>(stage, projb + kcol, p.vtw + (long)bg * 64 * T, wlo_min >> 6, tid, next_w, [&](int jw, const u16* Ks, const u16* Vs) {
      const int pos0 = 64 * jw;
      const int lo_c = wlo_c - pos0 < 0 ? 0 : wlo_c - pos0;
      dense_chunk(Ks, Vs, true, lo_c, t_c - pos0, t_c - pos0, tw - pos0 - 63, qf, btab_h, lane, m, l, o);
    });
    emit(o, bf2f(gptr[2]) / fmaxf(l, 1e-30f), false);
  }
}

DI unsigned f2ord(float v) { const unsigned u = __float_as_uint(v); return (u & 0x80000000u) ? ~u : (u | 0x80000000u); }

DI void topk_row(const Params& p, int b, int t, int lane) {
  const long row = (long)b * T + t;
  int* dst = p.selk + row * 256;
  if (t < 256) {
#pragma unroll
    for (int i = 0; i < 4; ++i) { const int s = i * 64 + lane; dst[s] = (s <= t) ? s : -1; }
    return;
  }
  const u16* srow = (const u16*)p.scores + row * T;
  const int ngrp = (t >> 10) + 1;
  unsigned u[128];
  int ln = lane;
  asm volatile("" : "+v"(ln));
#pragma unroll
  for (int gq = 0; gq < 8; ++gq) {
    if (gq < ngrp) {
#pragma unroll
      for (int j = 0; j < 16; ++j) {
        const int s = (gq * 16 + j) * 64 + ln;
        u[gq * 16 + j] = srow[s < t ? s : t];
      }
    } else {
#pragma unroll
      for (int j = 0; j < 16; ++j) u[gq * 16 + j] = 0u;
    }
  }
  asm volatile("" ::: "memory");
#pragma unroll
  for (int gq = 0; gq < 8; ++gq) {
    if (gq < ngrp) {
#pragma unroll
      for (int j = 0; j < 16; ++j) {
        const int s = (gq * 16 + j) * 64 + ln;
        { const unsigned h_ = u[gq * 16 + j]; u[gq * 16 + j] = (s <= t) ? ((h_ & 0x8000u) ? (~h_ & 0xFFFFu) : (h_ | 0x8000u)) : 0u; }
      }
    }
  }
  const int nlane = 16 * ngrp;
  unsigned m0 = 0u, m1 = 0u, m2 = 0u, m3 = 0u;
#pragma unroll
  for (int gq = 0; gq < 8; ++gq) {
    if (gq < ngrp) {
#pragma unroll
      for (int j = 0; j < 16; j += 4) {
        m0 = max(m0, u[gq * 16 + j]); m1 = max(m1, u[gq * 16 + j + 1]); m2 = max(m2, u[gq * 16 + j + 2]); m3 = max(m3, u[gq * 16 + j + 3]);
      }
    }
  }
  unsigned lo = wave_min_u(min(min(m0, m1), min(m2, m3)));
  unsigned hi = wave_max_u(max(max(m0, m1), max(m2, m3))) + 1u;
#define TOPK_COUNT_GE(PIV, OUT)                                                         \
  {                                                                                     \
    unsigned below_ = 0;     \
    _Pragma("unroll") for (int gq = 0; gq < 8; ++gq) {                                  \
      if (gq < ngrp) {                                                                  \
        _Pragma("unroll") for (int j = 0; j < 16; ++j) below_ += (u[gq * 16 + j] - (PIV)) >> 31; \
      }                                                                                 \
    }                                                                                   \
    OUT = wave_sum_i(nlane - (int)below_);                                              \
  }
  int c_lo, c_hi = 0;
  TOPK_COUNT_GE(lo, c_lo)
  int iter = 0;
  while (c_lo != 256 && hi - lo > 1u) {
    const unsigned span = hi - lo;
    unsigned step;
    if ((++iter & 3) == 0) step = span >> 1;
    else step = (unsigned)((float)span * ((float)(c_lo - 256) / (float)(c_lo - c_hi)));
    step = step < 1u ? 1u : (step > span - 1u ? span - 1u : step);
    const unsigned piv = lo + step;
    int c;
    TOPK_COUNT_GE(piv, c)
    if (c >= 256) { lo = piv; c_lo = c; } else { hi = piv; c_hi = c; }
  }
#undef TOPK_COUNT_GE
  const unsigned thr = lo;
  int ngt = 0;
#pragma unroll
  for (int gq = 0; gq < 8; ++gq) {
    if (gq < ngrp) {
#pragma unroll
      for (int j = 0; j < 16; ++j) ngt += __popcll(__ballot(u[gq * 16 + j] > thr));
    }
  }
  int base_gt = 0, base_eq = 0;
  const int need_eq = 256 - ngt;
  int ln2 = lane;
  asm volatile("" : "+v"(ln2));
#pragma unroll
  for (int gq = 0; gq < 8; ++gq) {
    if (gq < ngrp) {
#pragma unroll
      for (int j = 0; j < 16; ++j) {
        const int s = (gq * 16 + j) * 64 + ln2;
        const unsigned uv = u[gq * 16 + j];
        const bool gt = uv > thr, eq = uv == thr;
        const u64 mg = __ballot(gt), me = __ballot(eq);
        const int pg = __builtin_amdgcn_mbcnt_hi((unsigned)(mg >> 32), __builtin_amdgcn_mbcnt_lo((unsigned)mg, 0));
        const int pe = __builtin_amdgcn_mbcnt_hi((unsigned)(me >> 32), __builtin_amdgcn_mbcnt_lo((unsigned)me, 0));
        if (gt) dst[base_gt + pg] = s;
        if (eq && (base_eq + pe) < need_eq) dst[ngt + base_eq + pe] = s;
        base_gt += __popcll(mg);
        base_eq += __popcll(me);
      }
    }
  }
}

DI void phase6(const Params& p, char* smem, int bid, int nblk);
DI void phase5_nsa8(const Params& p) {
  for (int item = blockIdx.x; item < 512; item += gridDim.x) {
    __syncthreads();
    const int it = item < 256 ? 511 - item : item - 256;
    const int chunk = it >> 2, bgi = it & 3;
    nsa_item(p, g_smem, (bgi << 7) | chunk);
  }
  __syncthreads();
}
DI void phase5(const Params& p, char* smem, int bid, int nblk) {
  hb_sync();
  phase6(p, smem, bid, nblk);
}

DI void tr_read2(unsigned a0, unsigned a1, uint2& r0, uint2& r1) {
  asm volatile("ds_read_b64_tr_b16 %0, %2\n\tds_read_b64_tr_b16 %1, %3\n\ts_waitcnt lgkmcnt(0)" : "=&v"(r0), "=&v"(r1) : "v"(a0), "v"(a1) : "memory");
}
DI void tr_read4(unsigned a0, unsigned a1, unsigned a2, unsigned a3, uint2& r0, uint2& r1, uint2& r2, uint2& r3) {
  asm volatile("ds_read_b64_tr_b16 %0, %4\n\tds_read_b64_tr_b16 %1, %5\n\tds_read_b64_tr_b16 %2, %6\n\tds_read_b64_tr_b16 %3, %7\n\ts_waitcnt lgkmcnt(0)"
               : "=&v"(r0), "=&v"(r1), "=&v"(r2), "=&v"(r3) : "v"(a0), "v"(a1), "v"(a2), "v"(a3) : "memory");
}
DI void dsa_query(const Params& p, u16* Cs, const float* btab, int b, int t, int lane) {
  const long row = (long)b * T + t;
  const int lg = lane >> 4, r16 = lane & 15, hh = lane & 7;
  bf16x8 qf[4];
#pragma unroll
  for (int ks = 0; ks < 4; ++ks) {
    bf16x8 z = {0, 0, 0, 0, 0, 0, 0, 0};
    if (r16 < 8) z = *(const bf16x8*)(p.qlat + (row * 8 + r16) * 128 + ks * 32 + lg * 8);
    qf[ks] = z;
  }
  const u16* ckvb = p.ckv + (long)b * T * 128;
  const int nvalid = (t + 1) < 256 ? (t + 1) : 256;
  float m = -1e30f, l = 0.f;
  f32x4 o[8];
#pragma unroll
  for (int ct = 0; ct < 8; ++ct) o[ct] = (f32x4){0.f, 0.f, 0.f, 0.f};
  const unsigned cs_base = (unsigned)(size_t)Cs;
  const int nch = (nvalid + 31) >> 5;
  uint4 gv0, gv1, gv2, gv3, gv4, gv5, gv6, gv7;
  int kidx_n;
#define DSA_G1(V, I) { const int kr_ = __shfl(kidx_n, 4 * (I) + lg); V = *(const uint4*)(ckvb + (long)kr_ * 128 + r16 * 8); }
#define DSA_GATHER(CH)                                                            \
  {                                                                               \
    const int nv_ = (nvalid - (CH) * 32) > 32 ? 32 : (nvalid - (CH) * 32);        \
    kidx_n = p.selk[row * 256 + (CH) * 32 + (lane & 31)];                         \
    if ((lane & 31) >= nv_ || kidx_n < 0 || kidx_n > t) kidx_n = t;               \
    DSA_G1(gv0, 0) DSA_G1(gv1, 1) DSA_G1(gv2, 2) DSA_G1(gv3, 3) DSA_G1(gv4, 4) DSA_G1(gv5, 5) DSA_G1(gv6, 6) DSA_G1(gv7, 7) \
  }
  DSA_GATHER(0)
  for (int ch = 0; ch < nch; ++ch) {
    const int nval = (nvalid - ch * 32) > 32 ? 32 : (nvalid - ch * 32);
    const int kidx = kidx_n;
    wave_sync();
    {
      u16* d_ = Cs + lg * 144 + r16 * 8;
      *(uint4*)(d_) = gv0;            *(uint4*)(d_ + 4 * 144) = gv1;  *(uint4*)(d_ + 8 * 144) = gv2;  *(uint4*)(d_ + 12 * 144) = gv3;
      *(uint4*)(d_ + 16 * 144) = gv4; *(uint4*)(d_ + 20 * 144) = gv5; *(uint4*)(d_ + 24 * 144) = gv6; *(uint4*)(d_ + 28 * 144) = gv7;
    }
    { const int chn = ch + 1 < nch ? ch + 1 : nch - 1; DSA_GATHER(chn) }
    wave_sync();
    f32x4 acc[2];
#pragma unroll
    for (int rt = 0; rt < 2; ++rt) {
      const u16* kp = Cs + (16 * rt + r16) * 144 + 8 * lg;
      f32x4 c = {0.f, 0.f, 0.f, 0.f};
#pragma unroll
      for (int ks = 0; ks < 4; ++ks) c = MFMA16(*(const bf16x8*)(kp + 32 * ks), qf[ks], c);
      acc[rt] = c;
    }
    float mx = -INFINITY;
#pragma unroll
    for (int rt = 0; rt < 2; ++rt)
#pragma unroll
      for (int r = 0; r < 4; ++r) {
        const int pl = 16 * rt + 4 * lg + r;
        const int kk = __shfl(kidx, pl);
        int dc = t - kk;
        dc = dc < 0 ? 0 : (dc > 128 ? 128 : dc);
        const float sv = (pl < nval) ? fmaf(acc[rt][r], LOG2E, btab[hh * 132 + dc]) : -INFINITY;
        acc[rt][r] = sv;
        mx = fmaxf(mx, sv);
      }
    mx = x16_max(mx);
    mx = x32_max(mx);
    const float mn = fmaxf(m, mx);
    const float alpha = __builtin_amdgcn_exp2f(m - mn);
    float ls = 0.f;
#pragma unroll
    for (int rt = 0; rt < 2; ++rt)
#pragma unroll
      for (int r = 0; r < 4; ++r) {
        const float pv = __builtin_amdgcn_exp2f(acc[rt][r] - mn);
        acc[rt][r] = pv;
        ls += pv;
      }
    ls = x16_sum(ls);
    ls = x32_sum(ls);
    l = l * alpha + ls;
    m = mn;
    uint4 pw;
    pw.x = pack2(acc[0][0], acc[0][1]);
    pw.y = pack2(acc[0][2], acc[0][3]);
    pw.z = pack2(acc[1][0], acc[1][1]);
    pw.w = pack2(acc[1][2], acc[1][3]);
    const bf16x8 pb = __builtin_bit_cast(bf16x8, pw);
    const unsigned a_lo = cs_base + (unsigned)(((4 * lg + (r16 >> 2)) * 144 + 4 * (r16 & 3)) * 2);
    const unsigned a_hi = a_lo + 16 * 144 * 2;
#pragma unroll
    for (int ct = 0; ct < 8; ct += 2) {
      uint2 lo0, hi0, lo1, hi1;
      tr_read4(a_lo + ct * 32, a_hi + ct * 32, a_lo + ct * 32 + 32, a_hi + ct * 32 + 32, lo0, hi0, lo1, hi1);
      uint4 aw0, aw1;
      aw0.x = lo0.x; aw0.y = lo0.y; aw0.z = hi0.x; aw0.w = hi0.y;
      aw1.x = lo1.x; aw1.y = lo1.y; aw1.z = hi1.x; aw1.w = hi1.y;
      o[ct] = o[ct] * alpha;
      o[ct + 1] = o[ct + 1] * alpha;
      o[ct] = MFMA16(__builtin_bit_cast(bf16x8, aw0), pb, o[ct]);
      o[ct + 1] = MFMA16(__builtin_bit_cast(bf16x8, aw1), pb, o[ct + 1]);
    }
  }
#undef DSA_GATHER
#undef DSA_G1
  const float invl = 1.f / fmaxf(l, 1e-30f);
  if (r16 < 8) {
#pragma unroll
    for (int ct = 0; ct < 8; ++ct)
      *(uint2*)(p.olat + row * 1024 + r16 * 128 + 16 * ct + 4 * lg) = pack4(o[ct][0] * invl, o[ct][1] * invl, o[ct][2] * invl, o[ct][3] * invl);
  }
}
DI void phase6(const Params& p, char* smem, int bid, int nblk) {
  const int tid = TIDX(), lane = tid & 63, wid = __builtin_amdgcn_readfirstlane(tid >> 6);
  float* btab = (float*)smem;
  u16* Cs = (u16*)(smem + 8192) + wid * (32 * 144);
  for (int idx = tid; idx < 8 * 129; idx += 256) {
    const int h = idx / 129, d = idx % 129;
    const int bk = d < 128 ? BUCKET[d] : 31;
    btab[h * 132 + d] = p.rel_bias[bk * 16 + 8 + h] * LOG2E;
  }
  hb_sync();
  for (int item = bid; item < 2048; item += nblk) {
    const int it = item < 1024 ? 2047 - item : item - 1024;
    const int b = it & 1, tb = it >> 1;
    for (int q = 0; q < 2; ++q) dsa_query(p, Cs, btab, b, tb * 8 + wid * 2 + q, lane);
  }
}

struct EpiOdsa {
  u16* odsa; int h, m0;
  DI void operator()(f32x16 (&acc)[2][2], int wm, int wn, int lane) const {
    constexpr int MT = 2;
    SW_FOR {
      const int r = m0 + SW_R, c = SW_C0;
      if (c < 64) *(uint2*)(odsa + (long)r * 512 + h * 64 + c) = pack4(SW_V(0), SW_V(1), SW_V(2), SW_V(3));
    }
  }
};
DI void phase7(const Params& p, char* smem, int bid, int nblk) {
  for (int item = bid; item < 1024; item += nblk) {
    const int h = item & 7, mt_ = item >> 3;
    ARows af{p.olat + (long)mt_ * 128 * 1024 + h * 128, 1024, 128};
    BMat bf{p.dsa_w_uv + h * 64, 512, 64};
    EpiOdsa ef{p.odsa, h, mt_ * 128};
    gemm_tile(smem, 2, 64, af, bf, ef);
  }
}

struct EpiY {
  u16* y; const u16* proj; int m0, n0, second;
  template <int MT> DI void operator()(f32x16 (&acc)[MT][2], int wm, int wn, int lane) const {
    SW_FOR {
      const int r = m0 + SW_R, c = n0 + SW_C0;
      const uint2 gu = *(const uint2*)(proj + (long)r * LDP + C_GM + second * 1024 + c);
      float v0 = lo16(gu.x) * SW_V(0), v1 = hi16(gu.x) * SW_V(1), v2 = lo16(gu.y) * SW_V(2), v3 = hi16(gu.y) * SW_V(3);
      uint2* dst = (uint2*)(y + (long)r * 1024 + c);
      if (second) {
        const uint2 yu = *dst;
        v0 += lo16(yu.x); v1 += hi16(yu.x); v2 += lo16(yu.y); v3 += hi16(yu.y);
      }
      *dst = pack4(v0, v1, v2, v3);
    }
  }
};
struct Epi8Y {
  u16* y; const u16* proj; int m0, n0, second;
  DI void operator()(int q, int c, float v0, float v1, float v2, float v3) const {
    const long r = m0 + q; const int cc = n0 + c;
    const uint2 gu = *(const uint2*)(proj + r * LDP + C_GM + second * 1024 + cc);
    v0 *= lo16(gu.x); v1 *= hi16(gu.x); v2 *= lo16(gu.y); v3 *= hi16(gu.y);
    uint2* dst = (uint2*)(y + r * 1024 + cc);
    if (second) {
      const uint2 yu = *dst;
      v0 += lo16(yu.x); v1 += hi16(yu.x); v2 += lo16(yu.y); v3 += hi16(yu.y);
    }
    *dst = pack4(v0, v1, v2, v3);
  }
};
DI void phase8_8w(const Params& p, int wg, int nwg) {
  for (int item = wg; item < 256; item += nwg) {
    const int x_ = item & 7, s_ = item >> 3, nt_ = s_ & 3, mt_ = x_ * 8 + (s_ >> 2);
    {
      ARows wf{p.w_bnT + (long)nt_ * 256 * 512, 512, 256};
      ARows xf{p.onsa + (long)mt_ * 256 * 512, 512, 256};
      Epi8Y ef{p.y, p.proj, mt_ * 256, nt_ * 256, 0};
      gemm8p(8, wf, xf, ef);
    }
    {
      ARows wf{p.w_bdT + (long)nt_ * 256 * 512, 512, 256};
      ARows xf{p.odsa + (long)mt_ * 256 * 512, 512, 256};
      Epi8Y ef{p.y, p.proj, mt_ * 256, nt_ * 256, 1};
      gemm8p(8, wf, xf, ef);
    }
  }
}
struct EpiStoreBf {
  u16* dst; long ld; int m0, n0;
  template <int MT> DI void operator()(f32x16 (&acc)[MT][2], int wm, int wn, int lane) const {
    SW_FOR { *(uint2*)(dst + (long)(m0 + SW_R) * ld + n0 + SW_C0) = pack4(SW_V(0), SW_V(1), SW_V(2), SW_V(3)); }
  }
};
struct Epi8StoreBf {
  u16* dst; long ld; int m0, n0;
  DI void operator()(int q, int c, float v0, float v1, float v2, float v3) const { *(uint2*)(dst + (long)(m0 + q) * ld + n0 + c) = pack4(v0, v1, v2, v3); }
};
DI void phase9_8w(const Params& p, int wg, int nwg) {
  for (int item = wg; item < 256; item += nwg) {
    const int x_ = item & 7, s_ = item >> 3, nt_ = s_ & 3, mt_ = x_ * 8 + (s_ >> 2);
    ARows wf{p.w_outT + (long)nt_ * 256 * 1024, 1024, 256};
    ARows xf{p.y + (long)mt_ * 256 * 1024, 1024, 256};
    Epi8StoreBf ef{p.z, 1024, mt_ * 256, nt_ * 256};
    gemm8p(16, wf, xf, ef);
  }
}

DI void phase10(const Params& p, int bid, int nblk) {
  const int tid = TIDX(), lane = tid & 63, wid = __builtin_amdgcn_readfirstlane(tid >> 6);
  const int b = bid & 1;
  const float* modb = p.mod + b * 6144;
  float cz[16], cm[16], ca[16];
#pragma unroll
  for (int i = 0; i < 4; ++i) {
    const int col = i * 256 + lane * 4;
    const float4 gt = *(const float4*)(modb + 2048 + col), gp = *(const float4*)(p.g_post_mix + col);
    const float4 gf = *(const float4*)(p.g_pre_ffn + col), sc = *(const float4*)(modb + 4096 + col), sh = *(const float4*)(modb + 3072 + col);
    cz[i * 4 + 0] = gt.x * gp.x; cz[i * 4 + 1] = gt.y * gp.y; cz[i * 4 + 2] = gt.z * gp.z; cz[i * 4 + 3] = gt.w * gp.w;
    cm[i * 4 + 0] = gf.x * (1.f + sc.x); cm[i * 4 + 1] = gf.y * (1.f + sc.y); cm[i * 4 + 2] = gf.z * (1.f + sc.z); cm[i * 4 + 3] = gf.w * (1.f + sc.w);
    ca[i * 4 + 0] = sh.x; ca[i * 4 + 1] = sh.y; ca[i * 4 + 2] = sh.z; ca[i * 4 + 3] = sh.w;
  }
  const int stride = (nblk >> 1) * 4;
  for (int t0 = (bid >> 1) * 4 + wid; t0 < T; t0 += 2 * stride) {
    uint2 zu[2][4]; float4 xx[2][4];
#pragma unroll
    for (int k = 0; k < 2; ++k) {
      const int t = t0 + k * stride < T ? t0 + k * stride : T - 1;
      const long row = (long)b * T + t;
#pragma unroll
      for (int i = 0; i < 4; ++i) {
        zu[k][i] = *(const uint2*)(p.z + row * 1024 + i * 256 + lane * 4);
        xx[k][i] = *(const float4*)(p.x + row * 1024 + i * 256 + lane * 4);
      }
    }
#pragma unroll
    for (int k = 0; k < 2; ++k) {
      float zv[16], xv[16];
      float ss = 0.f;
#pragma unroll
      for (int i = 0; i < 4; ++i) {
        zv[i * 4 + 0] = lo16(zu[k][i].x); zv[i * 4 + 1] = hi16(zu[k][i].x); zv[i * 4 + 2] = lo16(zu[k][i].y); zv[i * 4 + 3] = hi16(zu[k][i].y);
        xv[i * 4 + 0] = xx[k][i].x; xv[i * 4 + 1] = xx[k][i].y; xv[i * 4 + 2] = xx[k][i].z; xv[i * 4 + 3] = xx[k][i].w;
#pragma unroll
        for (int j = 0; j < 4; ++j) ss += zv[i * 4 + j] * zv[i * 4 + j];
      }
      ss = wave_sum(ss);
      const float r = rsqrtf(ss * (1.f / 1024.f) + 1e-6f);
      float ss2 = 0.f;
#pragma unroll
      for (int j = 0; j < 16; ++j) {
        const float v = xv[j] + cz[j] * (zv[j] * r);
        xv[j] = v;
        ss2 += v * v;
      }
      ss2 = wave_sum(ss2);
      const float r2 = rsqrtf(ss2 * (1.f / 1024.f) + 1e-6f);
      if (t0 + k * stride < T) {
        const long row = (long)b * T + t0 + k * stride;
#pragma unroll
        for (int i = 0; i < 4; ++i) {
          const int col = i * 256 + lane * 4;
          *(float4*)(p.x1 + row * 1024 + col) = make_float4(xv[i * 4], xv[i * 4 + 1], xv[i * 4 + 2], xv[i * 4 + 3]);
          *(uint2*)(p.h + row * 1024 + col) = pack4(xv[i * 4] * r2 * cm[i * 4] + ca[i * 4], xv[i * 4 + 1] * r2 * cm[i * 4 + 1] + ca[i * 4 + 1],
                                                    xv[i * 4 + 2] * r2 * cm[i * 4 + 2] + ca[i * 4 + 2], xv[i * 4 + 3] * r2 * cm[i * 4 + 3] + ca[i * 4 + 3]);
        }
      }
    }
  }
}

struct EpiStoreF32 {
  float* dst; long ld; int m0, n0;
  DI void operator()(f32x16 (&acc)[2][2], int wm, int wn, int lane) const {
    constexpr int MT = 2;
    SW_FOR { *(float4*)(dst + (long)(m0 + SW_R) * ld + n0 + SW_C0) = make_float4(SW_V(0), SW_V(1), SW_V(2), SW_V(3)); }
  }
};
DI void phase11(const Params& p, char* smem, int bid, int nblk) {
  for (int item = bid; item < 256; item += nblk) {
    const int nt_ = item & 1, mt_ = item >> 1;
    ARows af{p.h + (long)mt_ * 128 * 1024, 1024, 128};
    BMatT bf{p.routerT + (long)nt_ * 128 * 1024, 1024};
    EpiStoreF32 ef{p.logits, 256, mt_ * 128, nt_ * 128};
    gemm_tile<true, false, true>(smem, 16, 64, af, bf, ef);
  }
}
DI void phase12(const Params& p, int bid, int nblk) {
  const int tid = TIDX(), lane = tid & 63, wid = __builtin_amdgcn_readfirstlane(tid >> 6);
  for (int tok = bid * 4 + wid; tok < NTOK; tok += nblk * 4) {
    const float4 lg = *(const float4*)(p.logits + (long)tok * 256 + lane * 4);
    const float4 rbv = *(const float4*)(p.router_bias + lane * 4);
    float sg[4] = {sigmoidf(lg.x), sigmoidf(lg.y), sigmoidf(lg.z), sigmoidf(lg.w)};
    float sl[4] = {sg[0] + rbv.x, sg[1] + rbv.y, sg[2] + rbv.z, sg[3] + rbv.w};
    float t1 = fmaxf(sl[0], sl[1]), t2 = fminf(sl[0], sl[1]);
#pragma unroll
    for (int j = 2; j < 4; ++j) {
      const float v = sl[j];
      t2 = fmaxf(t2, fminf(t1, v));
      t1 = fmaxf(t1, v);
    }
#define R_MERGE(CTRL)                                                                                                            \
    {                                                                                                                            \
      const float a1 = __int_as_float(__builtin_amdgcn_update_dpp(0, __float_as_int(t1), CTRL, 0xF, 0xF, true));                 \
      const float a2 = __int_as_float(__builtin_amdgcn_update_dpp(0, __float_as_int(t2), CTRL, 0xF, 0xF, true));                 \
      const float n1 = fmaxf(t1, a1);                                                                                            \
      const float n2 = fmaxf(fminf(t1, a1), fmaxf(t2, a2));                                                                      \
      t1 = n1; t2 = n2;                                                                                                          \
    }
    R_MERGE(DPP_QP1) R_MERGE(DPP_QP2) R_MERGE(DPP_RHM)
#undef R_MERGE
    const float gscore = t1 + t2;
    const int grp = lane >> 3;
    int rank = 0;
#pragma unroll
    for (int g2 = 0; g2 < 8; ++g2) {
      const float og = rdlane(gscore, g2 * 8);
      rank += (og > gscore || (og == gscore && g2 < grp)) ? 1 : 0;
    }
    const bool gsel = rank < 4;
    float cv[4];
#pragma unroll
    for (int j = 0; j < 4; ++j) cv[j] = gsel ? sl[j] : -1e30f;
    int my_e = -1; float my_s = 0.f; float ssum = 0.f;
    for (int r = 0; r < 8; ++r) {
      float bv = cv[0]; int bj = 0;
#pragma unroll
      for (int j = 1; j < 4; ++j) if (cv[j] > bv) { bv = cv[j]; bj = j; }
      int be = lane * 4 + bj;
      wave_argmax(bv, be);
      const int wl_ = be >> 2, wj = be & 3;
      const float s0 = rdlane(sg[0], wl_), s1 = rdlane(sg[1], wl_), s2 = rdlane(sg[2], wl_), s3 = rdlane(sg[3], wl_);
      const float bs = wj == 0 ? s0 : (wj == 1 ? s1 : (wj == 2 ? s2 : s3));
      if (wl_ == lane) {
        if (wj == 0) cv[0] = -3e30f; else if (wj == 1) cv[1] = -3e30f; else if (wj == 2) cv[2] = -3e30f; else cv[3] = -3e30f;
      }
      if (lane == r) { my_e = be; my_s = bs; }
      ssum += bs;
    }
    if (lane < 8) {
      const float w = my_s / ssum * 2.5f;
      const int rk = atomicAdd(p.counts + my_e * 32, 1);
      p.eidx[tok * 8 + lane] = my_e;
      p.ewt[tok * 8 + lane] = w;
      p.erank[tok * 8 + lane] = rk;
    }
  }
}
DI void phase14(const Params& p, char* smem, int bid, int nblk) {
  const int tid = TIDX();
  int* s_cnt = (int*)smem;
  int* s_off = s_cnt + 256;
  const int cnt = p.counts[tid * 32];
  s_cnt[tid] = cnt;
  hb_sync();
  int run = 0, nt = 0, nt2 = 0;
  for (int e = 0; e < tid; ++e) { const int c = s_cnt[e]; run += c; nt += (c + 127) >> 7; nt2 += (c + 255) >> 8; }
  s_off[tid] = run;
  hb_sync();
  if (bid == 0) {
    p.offs[tid] = run;
    for (int m = 0; m * 256 < cnt; ++m) {
      p.tile2_e[nt2] = tid;
      p.tile2_r0[nt2] = run + m * 256;
      p.tile2_nr[nt2] = (cnt - m * 256) > 256 ? 256 : (cnt - m * 256);
      ++nt2;
    }
    for (int m = 0; m * 128 < cnt; ++m) {
      p.tile_e[nt] = tid;
      p.tile_r0[nt] = run + m * 128;
      p.tile_nr[nt] = (cnt - m * 128) > 128 ? 128 : (cnt - m * 128);
      ++nt;
    }
    if (tid == 255) {
      p.offs[256] = run + cnt;
      for (int m = 0; m < 128; ++m) {
        p.tile_e[nt] = 256;
        p.tile_r0[nt] = 131072 + m * 128;
        p.tile_nr[nt] = 128;
        ++nt;
      }
      p.ntiles[0] = nt;
      for (int m = 0; m < 64; ++m) {
        p.tile2_e[nt2] = 256;
        p.tile2_r0[nt2] = 131072 + m * 256;
        p.tile2_nr[nt2] = 256;
        ++nt2;
      }
      p.ntiles[1] = nt2;
    }
  }
  for (int i = bid * 256 + tid; i < NSLOT; i += nblk * 256) {
    if (i < 131072) {
      const int e = p.eidx[i];
      const int slot = s_off[e] + p.erank[i];
      p.slot_tok[slot] = i >> 3;
      p.slot_wt[slot] = p.ewt[i];
      p.tok_slot[i] = slot;
    } else {
      p.slot_tok[i] = i - 131072;
      p.slot_wt[i] = 1.f;
    }
  }
}

struct AGather {
  const u16* h; const int* slot_tok; int r0, nr;
  DI const u16* operator()(int r) const { return h + (long)slot_tok[r0 + (r < nr ? r : 0)] * 1024; }
  DI const u16* origin() const { return h; } DI int off(int r) const { return slot_tok[r0 + (r < nr ? r : 0)] * 1024; }
};
struct BGateUp {
  const float* wg; long udiff; long ldb; int n0;
  DI const float* operator()(int c4) const {
    const int wn = c4 >> 6, ntl = (c4 >> 5) & 1, j = c4 & 31;
    return wg + (long)ntl * udiff + n0 + wn * 32 + j;
  }
  DI const u16* row(int) const { return nullptr; }
};
struct EpiH {
  u16* H; int r0, nr, n0;
  template <int MT> DI void operator()(f32x16 (&acc)[MT][2], int wm, int wn, int lane) const {
#pragma unroll
    for (int mt = 0; mt < MT; ++mt) {
      const int r = SW_R;
      if (r < nr) {
#pragma unroll
        for (int q4 = 0; q4 < 4; ++q4) {
          float v[4];
#pragma unroll
          for (int j = 0; j < 4; ++j) v[j] = siluf(acc[mt][0][4 * q4 + j]) * acc[mt][1][4 * q4 + j];
          *(uint2*)(H + (long)(r0 + r) * 256 + n0 + wn * 32 + 8 * q4 + 4 * (lane >> 5)) = pack4(v[0], v[1], v[2], v[3]);
        }
      }
    }
  }
};
struct BGateUp8 {
  const float* wg; long udiff; long ldb; int n0;
  DI const float* operator()(int c4) const {
    const int wn = c4 >> 6, ntl = (c4 >> 5) & 1, j = c4 & 31;
    return wg + (long)ntl * udiff + n0 + wn * 32 + j;
  }
};
DI void phase15_8w(const Params& p, int wg, int nwg) {
  const int ntl = p.ntiles[1];
  const int nit = ntl * 2, nrounds = (nit + 255) >> 8;
  for (int i = wg; i < nrounds * 256; i += nwg) {
    const int item = ((((i >> 8) << 3) + (i & 7)) << 5) + ((i >> 3) & 31);
    if (item >= nit) continue;
    const int ti = item >> 1, nt_ = item & 1;
    const int e = p.tile2_e[ti], r0 = p.tile2_r0[ti], nr = p.tile2_nr[ti];
    AGather af{p.h, p.slot_tok, r0, nr};
    const float* wgp = e < 256 ? p.w_eg + (long)e * 1024 * 256 : p.w_sg;
    const float* wup = e < 256 ? p.w_eu + (long)e * 1024 * 256 : p.w_su;
    BGateUp8 bf{wgp, (long)(wup - wgp), 256, nt_ * 128};
    EpiH ef{p.H, r0, nr, nt_ * 128};
    gemm8w<false>(16, af, bf, ef);
  }
}
struct EpiYexp {
  u16* Y; const float* slot_wt; int r0, nr, n0;
  template <int MT> DI void operator()(f32x16 (&acc)[MT][2], int wm, int wn, int lane) const {
#pragma unroll
    for (int mt = 0; mt < MT; ++mt) {
      const int r = SW_R;
      if (r < nr) {
        const float w = slot_wt[r0 + r];
#pragma unroll
        for (int nt = 0; nt < 2; ++nt)
#pragma unroll
          for (int q4 = 0; q4 < 4; ++q4)
            *(uint2*)(Y + (long)(r0 + r) * 1024 + n0 + SW_C0) = pack4(SW_V(0) * w, SW_V(1) * w, SW_V(2) * w, SW_V(3) * w);
      }
    }
  }
};
DI void phase16_8w(const Params& p, int wg, int nwg) {
  const int ntl = p.ntiles[1];
  const int nit = ntl * 4, nrounds = (nit + 255) >> 8;
  for (int i = wg; i < nrounds * 256; i += nwg) {
    const int item = ((((i >> 8) << 3) + (i & 7)) << 5) + ((i >> 3) & 31);
    if (item >= nit) continue;
    const int ti = item >> 2, nt_ = item & 3;
    const int e = p.tile2_e[ti], r0 = p.tile2_r0[ti], nr = p.tile2_nr[ti];
    ARows af{p.H + (long)r0 * 256, 256, nr};
    const float* wd = e < 256 ? p.w_ed + (long)e * 256 * 1024 : p.w_sd;
    BMat bf{wd + nt_ * 256, 1024, 256};
    EpiYexp ef{p.Y, p.slot_wt, r0, nr, nt_ * 256};
    gemm8w<false>(4, af, bf, ef);
  }
}
DI void phase17(const Params& p, int bid, int nblk) {
  const int tid = TIDX(), lane = tid & 63, wid = __builtin_amdgcn_readfirstlane(tid >> 6);
  const int b = bid & 1;
  const float* modb = p.mod + b * 6144;
  float cy[16];
#pragma unroll
  for (int i = 0; i < 4; ++i) {
    const int col = i * 256 + lane * 4;
    const float4 gt = *(const float4*)(modb + 5120 + col), gp = *(const float4*)(p.g_post_ffn + col);
    cy[i * 4 + 0] = gt.x * gp.x; cy[i * 4 + 1] = gt.y * gp.y; cy[i * 4 + 2] = gt.z * gp.z; cy[i * 4 + 3] = gt.w * gp.w;
  }
  const int stride = (nblk >> 1) * 4;
  for (int t0 = (bid >> 1) * 4 + wid; t0 < T; t0 += 2 * stride) {
    long rows[2];
    int slots[2][8];
#pragma unroll
    for (int k = 0; k < 2; ++k) {
      const int t = t0 + k * stride < T ? t0 + k * stride : T - 1;
      rows[k] = (long)b * T + t;
      const int4 s0 = *(const int4*)(p.tok_slot + rows[k] * 8), s1 = *(const int4*)(p.tok_slot + rows[k] * 8 + 4);
      slots[k][0] = s0.x; slots[k][1] = s0.y; slots[k][2] = s0.z; slots[k][3] = s0.w;
      slots[k][4] = s1.x; slots[k][5] = s1.y; slots[k][6] = s1.z; slots[k][7] = s1.w;
    }
    float4 xx[2][4];
#pragma unroll
    for (int k = 0; k < 2; ++k)
#pragma unroll
      for (int i = 0; i < 4; ++i) xx[k][i] = *(const float4*)(p.x1 + rows[k] * 1024 + i * 256 + lane * 4);
#pragma unroll
    for (int k = 0; k < 2; ++k) {
      float yv[16];
#pragma unroll
      for (int j = 0; j < 16; ++j) yv[j] = 0.f;
#pragma unroll
      for (int q = 0; q < 9; ++q) {
        const long sl = q < 8 ? (long)slots[k][q] : 131072 + rows[k];
#pragma unroll
        for (int i = 0; i < 4; ++i) {
          const uint2 u = *(const uint2*)(p.Y + sl * 1024 + i * 256 + lane * 4);
          yv[i * 4 + 0] += lo16(u.x); yv[i * 4 + 1] += hi16(u.x); yv[i * 4 + 2] += lo16(u.y); yv[i * 4 + 3] += hi16(u.y);
        }
      }
      float ss = 0.f;
#pragma unroll
      for (int j = 0; j < 16; ++j) ss += yv[j] * yv[j];
      ss = wave_sum(ss);
      const float r = rsqrtf(ss * (1.f / 1024.f) + 1e-6f);
      if (t0 + k * stride < T) {
#pragma unroll
        for (int i = 0; i < 4; ++i) {
          const int col = i * 256 + lane * 4;
          *(float4*)(p.out + rows[k] * 1024 + col) = make_float4(xx[k][i].x + cy[i * 4] * (yv[i * 4] * r), xx[k][i].y + cy[i * 4 + 1] * (yv[i * 4 + 1] * r),
                                                                 xx[k][i].z + cy[i * 4 + 2] * (yv[i * 4 + 2] * r), xx[k][i].w + cy[i * 4 + 3] * (yv[i * 4 + 3] * r));
        }
      }
    }
  }
}

__global__ void __launch_bounds__(512, 2) mega(Params p) {
  cg::grid_group grid = cg::this_grid();
  const int vb = __builtin_amdgcn_readfirstlane((int)(threadIdx.x >> 8));
  char* smem = g_smem + vb * HALF_LDS;
  const int bid = blockIdx.x * 2 + vb, nblk = gridDim.x * 2;
  if (p.phase_hi == 12345) grid.sync();
  if (threadIdx.x < 32) ((unsigned*)(g_smem + 2 * HALF_LDS))[threadIdx.x] = 0u;
  __syncthreads();
  const XcdBarrier xb = xcd_barrier_post(p.bar, (volatile LAS unsigned*)(g_smem + 2 * HALF_LDS));
#if !defined(ONLY) || ONLY==0
  if (p.phase_lo <= 0 && 0 < p.phase_hi) {
    phase0(p, smem, bid, nblk);
#if (REPEAT_MASK >> 0) & 1
    xcd_barrier(xb);
    phase0(p, smem, bid, nblk);
#endif
    if (0 + 1 < p.phase_hi) xcd_barrier(xb);
  }
#endif
#if !defined(ONLY) || ONLY==1
  if (p.phase_lo <= 1 && 1 < p.phase_hi) {
    phase1(p, smem, bid, nblk);
#if (REPEAT_MASK >> 1) & 1
    xcd_barrier(xb);
    phase1(p, smem, bid, nblk);
#endif
    if (1 + 1 < p.phase_hi) xcd_barrier(xb);
  }
#endif
#if !defined(ONLY) || ONLY==2
  if (p.phase_lo <= 2 && 2 < p.phase_hi) {
    phase2_8w(p, blockIdx.x, gridDim.x);
    __syncthreads();
    phase2(p, smem, bid, nblk);
#if (REPEAT_MASK >> 2) & 1
    xcd_barrier(xb);
    phase2_8w(p, blockIdx.x, gridDim.x);
    __syncthreads();
    phase2(p, smem, bid, nblk);
#endif
    if (2 + 1 < p.phase_hi) xcd_barrier(xb);
  }
#endif
#if !defined(ONLY) || ONLY==3
  if (p.phase_lo <= 3 && 3 < p.phase_hi) {
    phase3(p, smem, bid, nblk);
#if (REPEAT_MASK >> 3) & 1
    xcd_barrier(xb);
    phase3(p, smem, bid, nblk);
#endif
    if (3 + 1 < p.phase_hi) xcd_barrier(xb);
  }
#endif
#if !defined(ONLY) || ONLY==4
  if (p.phase_lo <= 4 && 4 < p.phase_hi) {
    phase4(p, smem, bid, nblk);
#if (REPEAT_MASK >> 4) & 1
    xcd_barrier(xb);
    phase4(p, smem, bid, nblk);
#endif
    if (4 + 1 < p.phase_hi) xcd_barrier(xb);
  }
#endif
#if !defined(ONLY) || ONLY==5
  if (p.phase_lo <= 5 && 5 < p.phase_hi) {
    phase5_nsa8(p);
    phase5(p, smem, bid, nblk);
#if (REPEAT_MASK >> 5) & 1
    xcd_barrier(xb);
    phase5_nsa8(p);
    phase5(p, smem, bid, nblk);
#endif
    if (5 + 1 < p.phase_hi) xcd_barrier(xb);
  }
#endif
#if !defined(ONLY) || ONLY==7
  if (p.phase_lo <= 7 && 7 < p.phase_hi) {
    phase7(p, smem, bid, nblk);
#if (REPEAT_MASK >> 7) & 1
    xcd_barrier(xb);
    phase7(p, smem, bid, nblk);
#endif
    if (7 + 1 < p.phase_hi) xcd_barrier(xb);
  }
#endif
#if !defined(ONLY) || ONLY==8
  if (p.phase_lo <= 8 && 8 < p.phase_hi) {
    phase8_8w(p, blockIdx.x, gridDim.x);
#if (REPEAT_MASK >> 8) & 1
    xcd_barrier(xb);
    phase8_8w(p, blockIdx.x, gridDim.x);
#endif
    if (8 + 1 < p.phase_hi) xcd_barrier(xb);
  }
#endif
#if !defined(ONLY) || ONLY==9
  if (p.phase_lo <= 9 && 9 < p.phase_hi) {
    phase9_8w(p, blockIdx.x, gridDim.x);
#if (REPEAT_MASK >> 9) & 1
    xcd_barrier(xb);
    phase9_8w(p, blockIdx.x, gridDim.x);
#endif
    if (9 + 1 < p.phase_hi) xcd_barrier(xb);
  }
#endif
#if !defined(ONLY) || ONLY==10
  if (p.phase_lo <= 10 && 10 < p.phase_hi) {
    phase10(p, bid, nblk);
#if (REPEAT_MASK >> 10) & 1
    xcd_barrier(xb);
    phase10(p, bid, nblk);
#endif
    if (10 + 1 < p.phase_hi) xcd_barrier(xb);
  }
#endif
#if !defined(ONLY) || ONLY==11
  if (p.phase_lo <= 11 && 11 < p.phase_hi) {
    phase11(p, smem, bid, nblk);
#if (REPEAT_MASK >> 11) & 1
    xcd_barrier(xb);
    phase11(p, smem, bid, nblk);
#endif
    if (11 + 1 < p.phase_hi) xcd_barrier(xb);
  }
#endif
#if !defined(ONLY) || ONLY==12
  if (p.phase_lo <= 12 && 12 < p.phase_hi) {
    phase12(p, bid, nblk);
#if (REPEAT_MASK >> 12) & 1
    xcd_barrier(xb);
    phase12(p, bid, nblk);
#endif
    if (12 + 1 < p.phase_hi) xcd_barrier(xb);
  }
#endif
#if !defined(ONLY) || ONLY==14
  if (p.phase_lo <= 14 && 14 < p.phase_hi) {
    phase14(p, smem, bid, nblk);
#if (REPEAT_MASK >> 14) & 1
    xcd_barrier(xb);
    phase14(p, smem, bid, nblk);
#endif
    if (14 + 1 < p.phase_hi) xcd_barrier(xb);
  }
#endif
#if !defined(ONLY) || ONLY==15
  if (p.phase_lo <= 15 && 15 < p.phase_hi) {
    phase15_8w(p, blockIdx.x, gridDim.x);
#if (REPEAT_MASK >> 15) & 1
    xcd_barrier(xb);
    phase15_8w(p, blockIdx.x, gridDim.x);
#endif
    if (15 + 1 < p.phase_hi) xcd_barrier(xb);
  }
#endif
#if !defined(ONLY) || ONLY==16
  if (p.phase_lo <= 16 && 16 < p.phase_hi) {
    phase16_8w(p, blockIdx.x, gridDim.x);
#if (REPEAT_MASK >> 16) & 1
    xcd_barrier(xb);
    phase16_8w(p, blockIdx.x, gridDim.x);
#endif
    if (16 + 1 < p.phase_hi) xcd_barrier(xb);
  }
#endif
#if !defined(ONLY) || ONLY==17
  if (p.phase_lo <= 17 && 17 < p.phase_hi) {
    phase17(p, bid, nblk);
#if (REPEAT_MASK >> 17) & 1
    xcd_barrier(xb);
    phase17(p, bid, nblk);
#endif
    if (17 + 1 < p.phase_hi) xcd_barrier(xb);
  }
#endif
}

extern "C" void kernel_launch(void* const* d_in, const int* in_sizes, int n_in, void* d_out, int out_size, void* d_ws, size_t ws_size,
                              hipStream_t stream) {
  static int grid_blocks = 0;
  if (!grid_blocks) {
    int dev = 0, cus = 0, per_cu = 0;
    (void)hipGetDevice(&dev);
    (void)hipDeviceGetAttribute(&cus, hipDeviceAttributeMultiprocessorCount, dev);
    (void)hipOccupancyMaxActiveBlocksPerMultiprocessor(&per_cu, mega, 512, 0);
    if (per_cu > 1) per_cu = 1;
    if (per_cu < 1) per_cu = 1;
    grid_blocks = cus * per_cu;
  }
  Params p{};
  const float* const* in = (const float* const*)d_in;
  p.x = in[0]; p.c = in[1]; p.w_ada = in[2]; p.b_ada = in[3]; p.g_pre_mix = in[4]; p.g_post_mix = in[5]; p.g_pre_ffn = in[6]; p.g_post_ffn = in[7];
  p.w_in = in[8]; p.rel_bias = in[9]; p.cmp_pe = in[10]; p.cmp_w1 = in[11]; p.cmp_b1 = in[12]; p.cmp_w2 = in[13]; p.dsa_kv_norm = in[14];
  p.dsa_w_uk = in[15]; p.dsa_w_uv = in[16]; p.w_bn = in[17]; p.w_bd = in[18]; p.w_out = in[19]; p.router_w = in[20]; p.router_bias = in[21];
  p.w_eg = in[22]; p.w_eu = in[23]; p.w_ed = in[24]; p.w_sg = in[25]; p.w_su = in[26]; p.w_sd = in[27];
  p.out = (float*)d_out;
  char* ws = (char*)d_ws;
  size_t off = 0;
  auto alloc = [&](size_t bytes) { char* r = ws + off; off += (bytes + 255) & ~(size_t)255; return r; };
  p.bar = (unsigned*)alloc((XCD_BAR_WORDS + 64) * 4);
  p.modp = (float*)alloc(16 * 2 * 6144 * 4);
  p.mod = (float*)alloc(2 * 6144 * 4);
  p.pe_part = (float*)alloc(16 * 256 * 4);
  p.cpart = (float*)alloc((size_t)4 * 4096 * 128 * 4);
  p.w_ukT = (float*)alloc(8 * 64 * 128 * 4);
  p.w_inT = (u16*)alloc((size_t)4608 * 1024 * 2);
  p.w_bnT = (u16*)alloc((size_t)1024 * 512 * 2);
  p.w_bdT = (u16*)alloc((size_t)1024 * 512 * 2);
  p.w_outT = (u16*)alloc((size_t)1024 * 1024 * 2);
  p.routerT = (u16*)alloc((size_t)256 * 1024 * 2);
  p.counts = (int*)alloc(256 * 32 * 4);
  p.offs = (int*)alloc(257 * 4);
  p.tile_e = (int*)alloc(1536 * 4);
  p.tile_r0 = (int*)alloc(1536 * 4);
  p.tile_nr = (int*)alloc(1536 * 4);
  p.ntiles = (int*)alloc(8);
  p.tile2_e = (int*)alloc(1024 * 4);
  p.tile2_r0 = (int*)alloc(1024 * 4);
  p.tile2_nr = (int*)alloc(1024 * 4);
  p.h = (u16*)alloc((size_t)NTOK * 1024 * 2);
  p.proj = (u16*)alloc((size_t)NTOK * LDP * 2);
  p.widx = (float*)alloc((size_t)NTOK * 8 * 4);
  p.zc = (u16*)alloc((size_t)2 * 2048 * 128 * 2);
  p.kc = (u16*)alloc((size_t)4 * 512 * 64 * 2);
  p.vcT = (u16*)alloc((size_t)4 * 512 * 64 * 2);
  p.vts = (u16*)alloc((size_t)4 * 64 * T * 2);
  p.vtw = (u16*)alloc((size_t)4 * 64 * T * 2);
  p.qlat = (u16*)alloc((size_t)NTOK * 1024 * 2);
  p.ckv = (u16*)alloc((size_t)NTOK * 128 * 2);
  p.selk = (int*)alloc((size_t)NTOK * 256 * 4);
  p.onsa = (u16*)alloc((size_t)NTOK * 512 * 2);
  p.olat = (u16*)alloc((size_t)NTOK * 1024 * 2);
  p.odsa = (u16*)alloc((size_t)NTOK * 512 * 2);
  p.y = p.qlat;
  p.z = p.olat;
  p.eidx = (int*)alloc((size_t)NTOK * 8 * 4);
  p.ewt = (float*)alloc((size_t)NTOK * 8 * 4);
  p.erank = (int*)alloc((size_t)NTOK * 8 * 4);
  p.slot_tok = (int*)alloc((size_t)NSLOT * 4);
  p.slot_wt = (float*)alloc((size_t)NSLOT * 4);
  p.tok_slot = (int*)alloc((size_t)NTOK * 8 * 4);
  char* big = alloc((size_t)2 * T * T * 4);
  p.scores = (float*)big;
  {
    size_t o2 = 0;
    auto sub = [&](size_t bytes) { char* r = big + o2; o2 += (bytes + 255) & ~(size_t)255; return r; };
    p.H = (u16*)sub((size_t)NSLOT * 256 * 2);
    p.Y = (u16*)sub((size_t)NSLOT * 1024 * 2);
    p.x1 = (float*)sub((size_t)NTOK * 1024 * 4);
    p.logits = (float*)sub((size_t)NTOK * 256 * 4);
  }
  if (off > ws_size) fprintf(stderr, "workspace too small: need %zu have %zu\n", off, ws_size);
  p.phase_lo = 0;
  p.phase_hi = 18;
  (void)hipMemsetAsync(p.bar, 0, (XCD_BAR_WORDS + 64) * 4, stream);
  void* args[] = {&p};
  hipError_t e = hipLaunchCooperativeKernel((void*)mega, dim3(grid_blocks), dim3(512), args, 0, stream);
  if (e != hipSuccess) fprintf(stderr, "coop launch failed: %s (grid %d)\n", hipGetErrorString(e), grid_blocks);
}
```

```cpp
#include <hip/hip_runtime.h>
#include <hip/hip_cooperative_groups.h>
#include <cstdio>
namespace cg = cooperative_groups;

#define DI __device__ __forceinline__
typedef unsigned short u16;
typedef unsigned long long u64;
using bf16x8 = __attribute__((ext_vector_type(8))) short;
using f32x16 = __attribute__((ext_vector_type(16))) float;
using f32x4 = __attribute__((ext_vector_type(4))) float;

constexpr int T = 8192;
constexpr int NTOK = 16384;
constexpr int LDP = 4576;
constexpr int C_QN = 0, C_KV = 512, C_GN = 1280, C_QD = 1304, C_CKV = 1816, C_QI = 1944, C_KI = 2456, C_WI = 2520, C_GM = 2528;
constexpr int NSLOT = 131072 + 16384;
constexpr int HALF_LDS = 73728;
constexpr int LDS_BYTES = 2 * HALF_LDS + 128;
__shared__ __attribute__((aligned(16))) char g_smem[LDS_BYTES];
#ifndef REPEAT_MASK
#define REPEAT_MASK 0
#endif

__device__ const unsigned char BUCKET[128] = {
  0, 1, 2, 3, 4, 5, 6, 7, 8, 9, 10, 11, 12, 13, 14, 15, 16, 16, 16, 17, 17, 18, 18, 18, 19, 19, 19, 20, 20, 20, 20, 21,
  21, 21, 21, 22, 22, 22, 22, 22, 23, 23, 23, 23, 23, 23, 24, 24, 24, 24, 24, 24, 25, 25, 25, 25, 25, 25, 25, 26, 26, 26, 26, 26,
  26, 26, 26, 27, 27, 27, 27, 27, 27, 27, 27, 27, 27, 28, 28, 28, 28, 28, 28, 28, 28, 28, 28, 29, 29, 29, 29, 29, 29, 29, 29, 29,
  29, 29, 29, 30, 30, 30, 30, 30, 30, 30, 30, 30, 30, 30, 30, 30, 30, 31, 31, 31, 31, 31, 31, 31, 31, 31, 31, 31, 31, 31, 31, 31};

struct Params {
  const float *x, *c, *w_ada, *b_ada, *g_pre_mix, *g_post_mix, *g_pre_ffn, *g_post_ffn, *w_in, *rel_bias;
  const float *cmp_pe, *cmp_w1, *cmp_b1, *cmp_w2, *dsa_kv_norm, *dsa_w_uk, *dsa_w_uv, *w_bn, *w_bd, *w_out;
  const float *router_w, *router_bias, *w_eg, *w_eu, *w_ed, *w_sg, *w_su, *w_sd;
  float* out;
  float* modp;
  float* mod;
  float* pe_part;
  float* cpart;
  float* w_ukT;
  u16 *w_inT, *w_bnT, *w_bdT, *w_outT, *routerT;
  u16* w_guT;
  u16* h;
  u16* proj;
  float* widx;
  u16* zc;
  u16* kc;
  u16* vcT;
  u16* vts;
  u16* vtw;
  u16* qlat;
  u16* ckv;
  float* scores;
  int* selk;
  u16* onsa;
  u16* olat;
  u16* odsa;
  u16* y;
  u16* z;
  float* x1;
  float* logits;
  int* eidx;
  float* ewt;
  int* erank;
  int* counts;
  int* offs;
  int* tile_e;
  int* tile_r0;
  int* tile_nr;
  int* ntiles;
  int *tile2_e, *tile2_r0, *tile2_nr;
  int* slot_tok;
  float* slot_wt;
  int* tok_slot;
  u16* H;
  u16* Y;
  unsigned* bar;
  int phase_lo, phase_hi;
};

DI float bf2f(u16 v) { return __uint_as_float(((unsigned)v) << 16); }
typedef __bf16 bf16x2_t __attribute__((ext_vector_type(2)));
typedef float f32x2_t __attribute__((ext_vector_type(2)));
DI unsigned pack2(float a, float b) { f32x2_t v = {a, b}; return __builtin_bit_cast(unsigned, __builtin_convertvector(v, bf16x2_t)); }
DI u16 f2bf(float x) { return (u16)(pack2(x, x) & 0xffffu); }
DI float lo16(unsigned u) { return __uint_as_float(u << 16); }
DI float hi16(unsigned u) { return __uint_as_float(u & 0xffff0000u); }
DI float wave_sum_shfl(float v) { for (int o = 32; o; o >>= 1) v += __shfl_xor(v, o); return v; }
DI float wave_max(float v) { for (int o = 32; o; o >>= 1) v = fmaxf(v, __shfl_xor(v, o)); return v; }
#define DPP_QP1 0xB1
#define DPP_QP2 0x4E
#define DPP_RHM 0x141
#define DPP_RM  0x140
#define DPP_B15 0x142
#define DPP_B31 0x143
#define DPP_F0(x, CTRL, RM) __int_as_float(__builtin_amdgcn_update_dpp(0, __float_as_int(x), CTRL, RM, 0xF, true))
DI float wave_sum(float v) {
  v += DPP_F0(v, DPP_QP1, 0xF); v += DPP_F0(v, DPP_QP2, 0xF); v += DPP_F0(v, DPP_RHM, 0xF); v += DPP_F0(v, DPP_RM, 0xF);
  v += DPP_F0(v, DPP_B15, 0xA); v += DPP_F0(v, DPP_B31, 0xC);
  return __int_as_float(__builtin_amdgcn_readlane(__float_as_int(v), 63));
}
DI int wave_sum_i(int x) {
  x += __builtin_amdgcn_update_dpp(0, x, DPP_QP1, 0xF, 0xF, true);
  x += __builtin_amdgcn_update_dpp(0, x, DPP_QP2, 0xF, 0xF, true);
  x += __builtin_amdgcn_update_dpp(0, x, DPP_RHM, 0xF, 0xF, true);
  x += __builtin_amdgcn_update_dpp(0, x, DPP_RM, 0xF, 0xF, true);
  x += __builtin_amdgcn_update_dpp(0, x, DPP_B15, 0xA, 0xF, true);
  x += __builtin_amdgcn_update_dpp(0, x, DPP_B31, 0xC, 0xF, true);
  return __builtin_amdgcn_readlane(x, 63);
}
#define DPP_SELF(x, CTRL, RM) ((unsigned)__builtin_amdgcn_update_dpp((int)(x), (int)(x), CTRL, RM, 0xF, false))
DI unsigned wave_max_u(unsigned x) {
  x = max(x, DPP_SELF(x, DPP_QP1, 0xF)); x = max(x, DPP_SELF(x, DPP_QP2, 0xF)); x = max(x, DPP_SELF(x, DPP_RHM, 0xF));
  x = max(x, DPP_SELF(x, DPP_RM, 0xF)); x = max(x, DPP_SELF(x, DPP_B15, 0xA)); x = max(x, DPP_SELF(x, DPP_B31, 0xC));
  return (unsigned)__builtin_amdgcn_readlane((int)x, 63);
}
DI unsigned wave_min_u(unsigned x) {
  x = min(x, DPP_SELF(x, DPP_QP1, 0xF)); x = min(x, DPP_SELF(x, DPP_QP2, 0xF)); x = min(x, DPP_SELF(x, DPP_RHM, 0xF));
  x = min(x, DPP_SELF(x, DPP_RM, 0xF)); x = min(x, DPP_SELF(x, DPP_B15, 0xA)); x = min(x, DPP_SELF(x, DPP_B31, 0xC));
  return (unsigned)__builtin_amdgcn_readlane((int)x, 63);
}
DI void wave_argmax(float& v, int& idx) {
#define AM_STEP(CTRL, RM)                                                                                                   \
  {                                                                                                                         \
    const float ov_ = __int_as_float(__builtin_amdgcn_update_dpp(__float_as_int(v), __float_as_int(v), CTRL, RM, 0xF, false)); \
    const int oi_ = __builtin_amdgcn_update_dpp(idx, idx, CTRL, RM, 0xF, false);                                            \
    const bool tk_ = ov_ > v || (ov_ == v && oi_ < idx);                                                                    \
    v = tk_ ? ov_ : v;                                                                                                      \
    idx = tk_ ? oi_ : idx;                                                                                                  \
  }
  AM_STEP(DPP_QP1, 0xF) AM_STEP(DPP_QP2, 0xF) AM_STEP(DPP_RHM, 0xF) AM_STEP(DPP_RM, 0xF) AM_STEP(DPP_B15, 0xA) AM_STEP(DPP_B31, 0xC)
#undef AM_STEP
  v = __int_as_float(__builtin_amdgcn_readlane(__float_as_int(v), 63));
  idx = __builtin_amdgcn_readlane(idx, 63);
}
DI float rdlane(float v, int l) { return __int_as_float(__builtin_amdgcn_readlane(__float_as_int(v), l)); }
DI int rdlane_i(int v, int l) { return __builtin_amdgcn_readlane(v, l); }
DI float x32_sum(float v) { const auto r = __builtin_amdgcn_permlane32_swap(__float_as_uint(v), __float_as_uint(v), false, false); return __uint_as_float(r[0]) + __uint_as_float(r[1]); }
DI float x32_max(float v) { const auto r = __builtin_amdgcn_permlane32_swap(__float_as_uint(v), __float_as_uint(v), false, false); return fmaxf(__uint_as_float(r[0]), __uint_as_float(r[1])); }
DI float x16_sum(float v) { const auto r = __builtin_amdgcn_permlane16_swap(__float_as_uint(v), __float_as_uint(v), false, false); return __uint_as_float(r[0]) + __uint_as_float(r[1]); }
DI float x16_max(float v) { const auto r = __builtin_amdgcn_permlane16_swap(__float_as_uint(v), __float_as_uint(v), false, false); return fmaxf(__uint_as_float(r[0]), __uint_as_float(r[1])); }
DI int TIDX() { int t = threadIdx.x & 255; asm volatile("" : "+v"(t)); return t; }
DI int TIDX8() { int t = threadIdx.x; asm volatile("" : "+v"(t)); return t; }
DI void hb_sync() {
  asm volatile("s_waitcnt vmcnt(0) lgkmcnt(0)" ::: "memory");
  const int vb = __builtin_amdgcn_readfirstlane((int)(threadIdx.x >> 8));
  volatile __attribute__((address_space(3))) unsigned* cnt = (volatile __attribute__((address_space(3))) unsigned*)(g_smem + 2 * HALF_LDS + 64) + vb * 8;
  if ((threadIdx.x & 63) == 0) {
    const unsigned old = __hip_atomic_fetch_add((__attribute__((address_space(3))) unsigned*)cnt, 1u, __ATOMIC_RELAXED, __HIP_MEMORY_SCOPE_WORKGROUP);
    const unsigned target = (old & ~3u) + 4u;
    while ((int)(*cnt - target) < 0) __builtin_amdgcn_s_sleep(0);
  }
  asm volatile("s_waitcnt lgkmcnt(0)" ::: "memory");
  __builtin_amdgcn_wave_barrier();
}
DI void cbar(const void* p) { asm volatile("" ::"v"(p) : "memory"); }
DI void wave_sync() { asm volatile("s_waitcnt lgkmcnt(0)" ::: "memory"); __builtin_amdgcn_wave_barrier(); }
DI float sigmoidf(float x) { return 1.f / (1.f + __expf(-x)); }
DI float siluf(float x) { return x / (1.f + __expf(-x)); }
DI float gelu_tanh(float x) { float u = 0.7978845608028654f * (x + 0.044715f * x * x * x); float e = __expf(2.f * u); float th = 1.f - 2.f / (e + 1.f); return 0.5f * x * (1.f + th); }


#define XB_TMO      128
#define XB_XCNT(j)  (256  + 64 * (j))
#define XB_XSUB(j)  (1280 + 64 * (j))
#define XB_XGEN(j)  (2304 + 64 * (j))
#define XB_TOP      3328
#define XB_TOPGEN   3392
#define XCD_BAR_WORDS 3456
#define XB_SPIN_CAP (1u << 22)
#define LAS __attribute__((address_space(3)))
DI unsigned xb_ld(unsigned* p) { return __hip_atomic_load(p, __ATOMIC_RELAXED, __HIP_MEMORY_SCOPE_AGENT); }
DI unsigned xb_add(unsigned* p, unsigned v) { return __hip_atomic_fetch_add(p, v, __ATOMIC_RELAXED, __HIP_MEMORY_SCOPE_AGENT); }
DI unsigned xb_xcc_id() { return (unsigned)__builtin_amdgcn_s_getreg((3 << 11) | 20) & 0xFu; }
#define XB_SPIN(cond, bar) do { unsigned _sp = 0; while (cond) { __builtin_amdgcn_s_sleep(1); \
    if ((++_sp & 255u) == 0u) { if (xb_ld(&(bar)[XB_TMO])) break; if (_sp > XB_SPIN_CAP) { atomicAdd(&(bar)[XB_TMO], 1u); break; } } } } while (0)
struct XcdBarrier { unsigned* bar; unsigned x; volatile LAS unsigned* st; };
DI XcdBarrier xcd_barrier_post(unsigned* bar, volatile LAS unsigned* st) {
  XcdBarrier b; b.bar = bar; b.x = xb_xcc_id(); b.st = st;
  if (threadIdx.x == 0) (void)xb_add(&bar[XB_XCNT(b.x)], 1u);
  return b;
}
DI void xcd_barrier_complete(unsigned* bar, unsigned x, unsigned& nloc, unsigned& nx) {
  const unsigned G = gridDim.x * gridDim.y * gridDim.z;
  unsigned sum, cnt, mine, sp = 0u;
  for (;;) {
    sum = 0u; cnt = 0u; mine = 0u;
#pragma unroll
    for (unsigned j = 0; j < 16; ++j) { const unsigned c = xb_ld(&bar[XB_XCNT(j)]); sum += c; cnt += (c > 0u) ? 1u : 0u; mine = (j == x) ? c : mine; }
    if (sum == G) break;
    __builtin_amdgcn_s_sleep(1);
    if ((++sp & 255u) == 0u) { if (xb_ld(&bar[XB_TMO])) break; if (sp > XB_SPIN_CAP) { atomicAdd(&bar[XB_TMO], 1u); break; } }
  }
  nloc = mine > 0u ? mine : 1u; nx = cnt > 0u ? cnt : 1u;
}
DI void xcd_barrier(const XcdBarrier& b) {
  asm volatile("s_waitcnt vmcnt(0)" ::: "memory");
  __syncthreads();
  if (threadIdx.x == 0) {
    unsigned* bar = b.bar;
    __builtin_amdgcn_s_waitcnt(0);
    unsigned nloc = b.st[0], nx = b.st[1];
    if (nloc == 0u) { xcd_barrier_complete(bar, b.x, nloc, nx); b.st[0] = nloc; b.st[1] = nx; }
    const unsigned old = xb_add(&bar[XB_XSUB(b.x)], 1u);
    const unsigned gen = old / nloc;
    if (old + 1u == (gen + 1u) * nloc) {
      __builtin_amdgcn_fence(__ATOMIC_RELEASE, "agent");
      asm volatile("s_waitcnt vmcnt(0)" ::: "memory");
      const unsigned og = xb_add(&bar[XB_TOP], 1u);
      const unsigned tg = og / nx;
      if (og + 1u == (tg + 1u) * nx) xb_add(&bar[XB_TOPGEN], 1u);
      else XB_SPIN(xb_ld(&bar[XB_TOPGEN]) == tg, bar);
      __builtin_amdgcn_fence(__ATOMIC_ACQUIRE, "agent");
      xb_add(&bar[XB_XGEN(b.x)], 1u);
      asm volatile("s_waitcnt vmcnt(0)" ::: "memory");
    } else {
      XB_SPIN(xb_ld(&bar[XB_XGEN(b.x)]) == gen, bar);
      __builtin_amdgcn_fence(__ATOMIC_ACQUIRE, "agent");
      asm volatile("s_waitcnt vmcnt(0)" ::: "memory");
    }
  }
  __syncthreads();
}

template <bool SWAP = true, bool SINGLE = false, bool BT16 = false, class AF, class BF, class EF>
DI void gemm_tile(char* smem, int nk, long a_kstep, const AF& af, const BF& bf, const EF& ef) {
  asm volatile("" ::: "memory");
  u16* As = (u16*)smem;
  const int tid = TIDX(), lane = tid & 63, wid = __builtin_amdgcn_readfirstlane(tid >> 6), wm = wid >> 1, wn = wid & 1;
  const int arow = tid >> 1, ahalf = tid & 1;
  const u16* ap = af(arow) + ahalf * 32;
  const int bkq = lane & 7, bnq = wid * 8 + (lane >> 3);
  const long ldb = bf.ldb;
  const float* bp = nullptr;
  const u16* bp16 = nullptr;
  if constexpr (BT16) bp16 = bf.row(arow) + ahalf * 32;
  else bp = bf(bnq * 4) + (long)(bkq * 4) * ldb;
  uint4 sa0_0, sa0_1, sa0_2, sa0_3, sa1_0, sa1_1, sa1_2, sa1_3;
  float4 sb0_0, sb0_1, sb0_2, sb0_3, sb0_4, sb0_5, sb0_6, sb0_7, sb1_0, sb1_1, sb1_2, sb1_3, sb1_4, sb1_5, sb1_6, sb1_7;
  uint4 tb0_0, tb0_1, tb0_2, tb0_3, tb1_0, tb1_1, tb1_2, tb1_3;
  f32x16 acc[2][2];
#pragma unroll
  for (int a = 0; a < 2; ++a)
#pragma unroll
    for (int b = 0; b < 2; ++b)
#pragma unroll
      for (int i = 0; i < 16; ++i) acc[a][b][i] = 0.f;

#define GEMM_LOAD(S, KT)                                                                  \
  {                                                                                       \
    const uint4* pa_ = (const uint4*)(ap + (long)(KT) * a_kstep);                         \
    sa##S##_0 = pa_[0]; sa##S##_1 = pa_[1]; sa##S##_2 = pa_[2]; sa##S##_3 = pa_[3];       \
    if constexpr (BT16) {                                                                 \
      const uint4* pt_ = (const uint4*)(bp16 + (long)(KT) * 64);                          \
      tb##S##_0 = pt_[0]; tb##S##_1 = pt_[1]; tb##S##_2 = pt_[2]; tb##S##_3 = pt_[3];     \
    } else {                                                                              \
      const float* pb_ = bp + (long)(KT) * 64 * ldb;                                      \
      sb##S##_0 = *(const float4*)(pb_);                                                  \
      sb##S##_1 = *(const float4*)(pb_ + ldb);                                            \
      sb##S##_2 = *(const float4*)(pb_ + 2 * ldb);                                        \
      sb##S##_3 = *(const float4*)(pb_ + 3 * ldb);                                        \
      sb##S##_4 = *(const float4*)(pb_ + 32 * ldb);                                       \
      sb##S##_5 = *(const float4*)(pb_ + 33 * ldb);                                       \
      sb##S##_6 = *(const float4*)(pb_ + 34 * ldb);                                       \
      sb##S##_7 = *(const float4*)(pb_ + 35 * ldb);                                       \
    }                                                                                     \
  }
#define GEMM_BW(V0, V1, V2, V3, C, I, QOFF)                                               \
  {                                                                                       \
    uint2 w_;                                                                             \
    w_.x = pack2(V0.C, V1.C);                                                             \
    w_.y = pack2(V2.C, V3.C);                                                             \
    *(uint2*)&Bs_[(bnq * 4 + (I)) * 72 + (QOFF) + bkq * 4] = w_;                          \
  }
#define GEMM_STORE(S, BUF)                                                                \
  {                                                                                       \
    u16* As_ = As + (BUF) * (2 * 128 * 72);                                               \
    u16* Bs_ = As_ + 128 * 72;                                                            \
    uint4* da_ = (uint4*)&As_[arow * 72 + ahalf * 32];                                    \
    da_[0] = sa##S##_0; da_[1] = sa##S##_1; da_[2] = sa##S##_2; da_[3] = sa##S##_3;       \
    if constexpr (BT16) {                                                                 \
      uint4* db_ = (uint4*)&Bs_[arow * 72 + ahalf * 32];                                  \
      db_[0] = tb##S##_0; db_[1] = tb##S##_1; db_[2] = tb##S##_2; db_[3] = tb##S##_3;     \
    } else {                                                                              \
      GEMM_BW(sb##S##_0, sb##S##_1, sb##S##_2, sb##S##_3, x, 0, 0)                        \
      GEMM_BW(sb##S##_0, sb##S##_1, sb##S##_2, sb##S##_3, y, 1, 0)                        \
      GEMM_BW(sb##S##_0, sb##S##_1, sb##S##_2, sb##S##_3, z, 2, 0)                        \
      GEMM_BW(sb##S##_0, sb##S##_1, sb##S##_2, sb##S##_3, w, 3, 0)                        \
      GEMM_BW(sb##S##_4, sb##S##_5, sb##S##_6, sb##S##_7, x, 0, 32)                       \
      GEMM_BW(sb##S##_4, sb##S##_5, sb##S##_6, sb##S##_7, y, 1, 32)                       \
      GEMM_BW(sb##S##_4, sb##S##_5, sb##S##_6, sb##S##_7, z, 2, 32)                       \
      GEMM_BW(sb##S##_4, sb##S##_5, sb##S##_6, sb##S##_7, w, 3, 32)                       \
    }                                                                                     \
  }
#define GEMM_COMPUTE(BUF)                                                                 \
  {                                                                                       \
    const u16* Ac = As + (BUF) * (2 * 128 * 72);                                          \
    const u16* Bc = Ac + 128 * 72;                                                        \
    _Pragma("unroll") for (int ks = 0; ks < 4; ++ks) {                                    \
      bf16x8 a[2], b[2];                                                                  \
      _Pragma("unroll") for (int mt = 0; mt < 2; ++mt) a[mt] = *(const bf16x8*)&Ac[(wm * 64 + mt * 32 + (lane & 31)) * 72 + ks * 16 + (lane >> 5) * 8]; \
      _Pragma("unroll") for (int nt = 0; nt < 2; ++nt) b[nt] = *(const bf16x8*)&Bc[(wn * 64 + nt * 32 + (lane & 31)) * 72 + ks * 16 + (lane >> 5) * 8]; \
      _Pragma("unroll") for (int mt = 0; mt < 2; ++mt)                                    \
      _Pragma("unroll") for (int nt = 0; nt < 2; ++nt)                                    \
        acc[mt][nt] = SWAP ? __builtin_amdgcn_mfma_f32_32x32x16_bf16(b[nt], a[mt], acc[mt][nt], 0, 0, 0) \
                           : __builtin_amdgcn_mfma_f32_32x32x16_bf16(a[mt], b[nt], acc[mt][nt], 0, 0, 0); \
    }                                                                                     \
  }
  GEMM_LOAD(0, 0)
  hb_sync();
  if (SINGLE) {
    GEMM_STORE(0, 0)
    hb_sync();
    GEMM_COMPUTE(0)
  } else {
    GEMM_LOAD(1, 1)
    GEMM_STORE(0, 0)
    hb_sync();
    const int last = nk - 1;
    for (int kt = 0; kt < nk; kt += 2) {
      const int k2 = kt + 2 < last ? kt + 2 : last, k3 = kt + 3 < last ? kt + 3 : last;
      GEMM_LOAD(0, k2)
      asm volatile("" ::: "memory");
      GEMM_COMPUTE(0)
      asm volatile("" ::: "memory");
      GEMM_STORE(1, 1)
      hb_sync();
      GEMM_LOAD(1, k3)
      asm volatile("" ::: "memory");
      GEMM_COMPUTE(1)
      asm volatile("" ::: "memory");
      GEMM_STORE(0, 0)
      hb_sync();
    }
  }
#undef GEMM_LOAD
#undef GEMM_STORE
#undef GEMM_BW
#undef GEMM_COMPUTE
  ef(acc, wm, wn, lane);
}

template <bool BT16, class AF, class BF, class EF>
DI void gemm_tile256(char* smem, int nk, const AF& af, const BF& bf, const EF& ef) {
  asm volatile("" ::: "memory");
  u16* As = (u16*)smem;
  u16* Bs = As + 256 * 72;
  const int tid = TIDX(), lane = tid & 63, wid = __builtin_amdgcn_readfirstlane(tid >> 6), wm = wid >> 1, wn = wid & 1;
  const int piece = tid & 7, rbase = tid >> 3;
  const u16* abase = af(0);
  int ao0, ao1, ao2, ao3, ao4, ao5, ao6, ao7;
  ao0 = (int)(af(rbase) - abase) + piece * 8;        ao1 = (int)(af(rbase + 32) - abase) + piece * 8;
  ao2 = (int)(af(rbase + 64) - abase) + piece * 8;   ao3 = (int)(af(rbase + 96) - abase) + piece * 8;
  ao4 = (int)(af(rbase + 128) - abase) + piece * 8;  ao5 = (int)(af(rbase + 160) - abase) + piece * 8;
  ao6 = (int)(af(rbase + 192) - abase) + piece * 8;  ao7 = (int)(af(rbase + 224) - abase) + piece * 8;
  const u16* bp16 = nullptr; long bstride = 0;
  const float* bp = nullptr; long ldb = 0;
  const int bkq = lane & 7, bnq = wid * 8 + (lane >> 3);
  if constexpr (BT16) { bp16 = bf.row(rbase) + piece * 8; bstride = bf.ldb * 32; }
  else { ldb = bf.ldb; bp = bf(bnq * 4) + (long)(bkq * 4) * ldb; }
  uint4 ra0, ra1, ra2, ra3, ra4, ra5, ra6, ra7, rb0, rb1, rb2, rb3;
  float4 fb0, fb1, fb2, fb3, fb4, fb5, fb6, fb7;
  f32x16 acc[4][2];
#pragma unroll
  for (int a = 0; a < 4; ++a)
#pragma unroll
    for (int b = 0; b < 2; ++b)
#pragma unroll
      for (int i = 0; i < 16; ++i) acc[a][b][i] = 0.f;
#define G256_LOAD(KT)                                                   \
  {                                                                     \
    const u16* pa_ = abase + (long)(KT) * 64;                           \
    ra0 = *(const uint4*)(pa_ + ao0); ra1 = *(const uint4*)(pa_ + ao1); \
    ra2 = *(const uint4*)(pa_ + ao2); ra3 = *(const uint4*)(pa_ + ao3); \
    ra4 = *(const uint4*)(pa_ + ao4); ra5 = *(const uint4*)(pa_ + ao5); \
    ra6 = *(const uint4*)(pa_ + ao6); ra7 = *(const uint4*)(pa_ + ao7); \
    if constexpr (BT16) {                                               \
      const u16* pb_ = bp16 + (long)(KT) * 64;                          \
      rb0 = *(const uint4*)(pb_);                                       \
      rb1 = *(const uint4*)(pb_ + bstride);                             \
      rb2 = *(const uint4*)(pb_ + 2 * bstride);                         \
      rb3 = *(const uint4*)(pb_ + 3 * bstride);                         \
    } else {                                                            \
      const float* pf_ = bp + (long)(KT) * 64 * ldb;                    \
      fb0 = *(const float4*)(pf_);            fb1 = *(const float4*)(pf_ + ldb);      \
      fb2 = *(const float4*)(pf_ + 2 * ldb);  fb3 = *(const float4*)(pf_ + 3 * ldb);  \
      fb4 = *(const float4*)(pf_ + 32 * ldb); fb5 = *(const float4*)(pf_ + 33 * ldb); \
      fb6 = *(const float4*)(pf_ + 34 * ldb); fb7 = *(const float4*)(pf_ + 35 * ldb); \
    }                                                                   \
  }
#define G256_BW(V0, V1, V2, V3, C, I, QOFF)                             \
  {                                                                     \
    uint2 w_;                                                           \
    w_.x = pack2(V0.C, V1.C);                                           \
    w_.y = pack2(V2.C, V3.C);                                           \
    *(uint2*)&Bs[(bnq * 4 + (I)) * 72 + (QOFF) + bkq * 4] = w_;         \
  }
  G256_LOAD(0)
  const int last = nk - 1;
  for (int kt = 0; kt < nk; ++kt) {
    hb_sync();
    {
      u16* da = As + rbase * 72 + piece * 8;
      *(uint4*)(da) = ra0;            *(uint4*)(da + 32 * 72) = ra1;  *(uint4*)(da + 64 * 72) = ra2;  *(uint4*)(da + 96 * 72) = ra3;
      *(uint4*)(da + 128 * 72) = ra4; *(uint4*)(da + 160 * 72) = ra5; *(uint4*)(da + 192 * 72) = ra6; *(uint4*)(da + 224 * 72) = ra7;
      if constexpr (BT16) {
        u16* db = Bs + rbase * 72 + piece * 8;
        *(uint4*)(db) = rb0; *(uint4*)(db + 32 * 72) = rb1; *(uint4*)(db + 64 * 72) = rb2; *(uint4*)(db + 96 * 72) = rb3;
      } else {
        G256_BW(fb0, fb1, fb2, fb3, x, 0, 0)  G256_BW(fb0, fb1, fb2, fb3, y, 1, 0)
        G256_BW(fb0, fb1, fb2, fb3, z, 2, 0)  G256_BW(fb0, fb1, fb2, fb3, w, 3, 0)
        G256_BW(fb4, fb5, fb6, fb7, x, 0, 32) G256_BW(fb4, fb5, fb6, fb7, y, 1, 32)
        G256_BW(fb4, fb5, fb6, fb7, z, 2, 32) G256_BW(fb4, fb5, fb6, fb7, w, 3, 32)
      }
    }
    hb_sync();
    const int kn = kt + 1 < last ? kt + 1 : last;
    G256_LOAD(kn)
    asm volatile("" ::: "memory");
#pragma unroll
    for (int ks = 0; ks < 4; ++ks) {
      bf16x8 a[4], b[2];
#pragma unroll
      for (int mt = 0; mt < 4; ++mt) a[mt] = *(const bf16x8*)&As[(wm * 128 + mt * 32 + (lane & 31)) * 72 + ks * 16 + (lane >> 5) * 8];
#pragma unroll
      for (int nt = 0; nt < 2; ++nt) b[nt] = *(const bf16x8*)&Bs[(wn * 64 + nt * 32 + (lane & 31)) * 72 + ks * 16 + (lane >> 5) * 8];
#pragma unroll
      for (int mt = 0; mt < 4; ++mt)
#pragma unroll
        for (int nt = 0; nt < 2; ++nt) acc[mt][nt] = __builtin_amdgcn_mfma_f32_32x32x16_bf16(b[nt], a[mt], acc[mt][nt], 0, 0, 0);
    }
    asm volatile("" ::: "memory");
  }
#undef G256_LOAD
#undef G256_BW
  ef(acc, wm, wn, lane);
}

template <bool BT16, class AF, class BF, class EF>
DI void gemm8w(int nk, const AF& af, const BF& bf, const EF& ef) {
  asm volatile("" ::: "memory");
  u16* S0 = (u16*)g_smem;
  int tid = threadIdx.x; asm volatile("" : "+v"(tid));
  const int lane = tid & 63, wid = __builtin_amdgcn_readfirstlane(tid >> 6), wm = wid >> 2, wn = wid & 3;
  const int piece = tid & 7, rbase = tid >> 3;
  const u16* abase = af.origin();
  const int ao0 = af.off(rbase) + piece * 8, ao1 = af.off(rbase + 64) + piece * 8, ao2 = af.off(rbase + 128) + piece * 8, ao3 = af.off(rbase + 192) + piece * 8;
  const u16 *bq0 = nullptr, *bq1 = nullptr, *bq2 = nullptr, *bq3 = nullptr;
  const float* bp = nullptr; long ldb = 0;
  const int bkq = lane & 7, bnq = wid * 8 + (lane >> 3);
  if constexpr (BT16) { bq0 = bf.row(rbase) + piece * 8; bq1 = bf.row(rbase + 64) + piece * 8; bq2 = bf.row(rbase + 128) + piece * 8; bq3 = bf.row(rbase + 192) + piece * 8; }
  else { ldb = bf.ldb; bp = bf(bnq * 4) + (long)(bkq * 4) * ldb; }
  uint4 ra0, ra1, ra2, ra3, rb0, rb1, rb2, rb3;
  float4 fb0, fb1, fb2, fb3, fb4, fb5, fb6, fb7;
  f32x16 acc[4][2];
#pragma unroll
  for (int a = 0; a < 4; ++a)
#pragma unroll
    for (int b = 0; b < 2; ++b)
#pragma unroll
      for (int i = 0; i < 16; ++i) acc[a][b][i] = 0.f;
#define G8_LOAD(KT)                                                     \
  {                                                                     \
    const u16* pa_ = abase + (long)(KT) * 64;                           \
    ra0 = *(const uint4*)(pa_ + ao0); ra1 = *(const uint4*)(pa_ + ao1); \
    ra2 = *(const uint4*)(pa_ + ao2); ra3 = *(const uint4*)(pa_ + ao3); \
    if constexpr (BT16) {                                               \
      rb0 = *(const uint4*)(bq0 + (long)(KT) * 64); rb1 = *(const uint4*)(bq1 + (long)(KT) * 64); \
      rb2 = *(const uint4*)(bq2 + (long)(KT) * 64); rb3 = *(const uint4*)(bq3 + (long)(KT) * 64); \
    } else {                                                            \
      const float* pf_ = bp + (long)(KT) * 64 * ldb;                    \
      fb0 = *(const float4*)(pf_);            fb1 = *(const float4*)(pf_ + ldb);      \
      fb2 = *(const float4*)(pf_ + 2 * ldb);  fb3 = *(const float4*)(pf_ + 3 * ldb);  \
      fb4 = *(const float4*)(pf_ + 32 * ldb); fb5 = *(const float4*)(pf_ + 33 * ldb); \
      fb6 = *(const float4*)(pf_ + 34 * ldb); fb7 = *(const float4*)(pf_ + 35 * ldb); \
    }                                                                   \
  }
#define G8_BW(V0, V1, V2, V3, C, I, QOFF)                               \
  {                                                                     \
    uint2 w_;                                                           \
    w_.x = pack2(V0.C, V1.C);                                           \
    w_.y = pack2(V2.C, V3.C);                                           \
    *(uint2*)&Bs_[(bnq * 4 + (I)) * 72 + (QOFF) + bkq * 4] = w_;        \
  }
#define G8_STORE(BUF)                                                   \
  {                                                                     \
    u16* As_ = S0 + (BUF) * (512 * 72);                                 \
    u16* Bs_ = As_ + 256 * 72;                                          \
    u16* da = As_ + rbase * 72 + piece * 8;                             \
    *(uint4*)(da) = ra0; *(uint4*)(da + 64 * 72) = ra1; *(uint4*)(da + 128 * 72) = ra2; *(uint4*)(da + 192 * 72) = ra3; \
    if constexpr (BT16) {                                               \
      u16* db = Bs_ + rbase * 72 + piece * 8;                           \
      *(uint4*)(db) = rb0; *(uint4*)(db + 64 * 72) = rb1; *(uint4*)(db + 128 * 72) = rb2; *(uint4*)(db + 192 * 72) = rb3; \
    } else {                                                            \
      G8_BW(fb0, fb1, fb2, fb3, x, 0, 0)  G8_BW(fb0, fb1, fb2, fb3, y, 1, 0)   \
      G8_BW(fb0, fb1, fb2, fb3, z, 2, 0)  G8_BW(fb0, fb1, fb2, fb3, w, 3, 0)   \
      G8_BW(fb4, fb5, fb6, fb7, x, 0, 32) G8_BW(fb4, fb5, fb6, fb7, y, 1, 32)  \
      G8_BW(fb4, fb5, fb6, fb7, z, 2, 32) G8_BW(fb4, fb5, fb6, fb7, w, 3, 32)  \
    }                                                                   \
  }
  G8_LOAD(0)
  __syncthreads();
  G8_STORE(0)
  __syncthreads();
  const int last = nk - 1;
  for (int kt = 0; kt < nk; ++kt) {
    const int kn = kt + 1 < last ? kt + 1 : last;
    G8_LOAD(kn)
    asm volatile("" ::: "memory");
    {
      const u16* Ac = S0 + (kt & 1) * (512 * 72);
      const u16* Bc = Ac + 256 * 72;
#pragma unroll
      for (int ks = 0; ks < 4; ++ks) {
        bf16x8 a[4], b[2];
#pragma unroll
        for (int mt = 0; mt < 4; ++mt) a[mt] = *(const bf16x8*)&Ac[(wm * 128 + mt * 32 + (lane & 31)) * 72 + ks * 16 + (lane >> 5) * 8];
#pragma unroll
        for (int nt = 0; nt < 2; ++nt) b[nt] = *(const bf16x8*)&Bc[(wn * 64 + nt * 32 + (lane & 31)) * 72 + ks * 16 + (lane >> 5) * 8];
#pragma unroll
        for (int mt = 0; mt < 4; ++mt)
#pragma unroll
          for (int nt = 0; nt < 2; ++nt) acc[mt][nt] = __builtin_amdgcn_mfma_f32_32x32x16_bf16(b[nt], a[mt], acc[mt][nt], 0, 0, 0);
      }
    }
    asm volatile("" ::: "memory");
    if (kt + 1 < nk) {
      G8_STORE((kt + 1) & 1)
      __syncthreads();
    }
  }
#undef G8_LOAD
#undef G8_BW
#undef G8_STORE
  ef(acc, wm, wn, lane);
}

DI void st_stage_rc(int b, int& R, int& C) {
  const int st = b >> 10, sb = b & 1023, swz = sb ^ (((sb >> 9) & 1) << 5);
  R = (st >> 1) * 16 + (swz >> 6); C = (st & 1) * 32 + ((swz & 63) >> 1);
}
template <bool PAIR = false, bool BATCH = false, bool HALFQ = false, class PF, class QF, class EF>
DI void gemm8p(int nt, const PF& pf, const QF& qf, const EF& ef) {
  asm volatile("" ::: "memory");
  constexpr int HTB = 128 * 64 * 2;
  int tid = threadIdx.x; asm volatile("" : "+v"(tid));
  const int lane = tid & 63, wid = __builtin_amdgcn_readfirstlane(tid >> 6), wr = wid >> 2, wc = wid & 3, fr = lane & 15, fq = lane >> 4;
  int r0, c0, r1, c1;
  st_stage_rc(tid * 16, r0, c0);
  st_stage_rc(tid * 16 + 8192, r1, c1);
  const u16* pbase = pf.origin();
  const u16* qbase = qf.origin();
  const unsigned po00 = (unsigned)(pf.off(r0) + c0) * 2u, po01 = (unsigned)(pf.off(r1) + c1) * 2u;
  const unsigned po10 = (unsigned)(pf.off(128 + r0) + c0) * 2u, po11 = (unsigned)(pf.off(128 + r1) + c1) * 2u;
  const unsigned qo00 = (unsigned)(qf.off(r0) + c0) * 2u, qo01 = (unsigned)(qf.off(r1) + c1) * 2u;
  const unsigned qo10 = (unsigned)(qf.off(128 + r0) + c0) * 2u, qo11 = (unsigned)(qf.off(128 + r1) + c1) * 2u;
  const unsigned sdst = (unsigned)__builtin_amdgcn_readfirstlane((int)((unsigned)(size_t)g_smem + (unsigned)(tid & ~63) * 16u));
  const int laneoff = (fr * 64 + fq * 16) ^ ((fr >> 3) << 5);
  const char* rdP = g_smem + wr * 8192 + laneoff;
  const char* rdQ = g_smem + 4 * HTB + wc * 4096 + laneoff;
#define G8P_ST(SLOT, BASE, O0, O1, KT)                                                                                     \
  {                                                                                                                        \
    const char* g_ = (const char*)(BASE) + (long)(KT) * 128;                                                               \
    __builtin_amdgcn_global_load_lds((const unsigned*)(g_ + (O0)), (LAS unsigned*)(size_t)(sdst + (SLOT) * HTB), 16, 0, 0);          \
    __builtin_amdgcn_global_load_lds((const unsigned*)(g_ + (O1)), (LAS unsigned*)(size_t)(sdst + (SLOT) * HTB + 8192), 16, 0, 0);   \
  }
#define G8P_STP(b, h, KT) { if ((h) == 0) G8P_ST((b) * 2, pbase, po00, po01, KT) else G8P_ST((b) * 2 + 1, pbase, po10, po11, KT) }
#define G8P_STQ(b, h, KT) { if ((h) == 0) G8P_ST(4 + (b) * 2, qbase, qo00, qo01, KT) else G8P_ST(4 + (b) * 2 + 1, qbase, qo10, qo11, KT) }
#define G8P_LDP(b, h)                                                                                                      \
  _Pragma("unroll") for (int m = 0; m < 4; ++m) _Pragma("unroll") for (int k = 0; k < 2; ++k)                              \
    Pt[m][k] = *(const bf16x8*)(rdP + ((b) * 2 + (h)) * HTB + m * 2048 + k * 1024);
#define G8P_LDQ(dst, b, h)                                                                                                 \
  _Pragma("unroll") for (int n = 0; n < 2; ++n) _Pragma("unroll") for (int k = 0; k < 2; ++k)                              \
    dst[n][k] = *(const bf16x8*)(rdQ + ((b) * 2 + (h)) * HTB + n * 2048 + k * 1024);
#define G8P_MMA(ai, bj, QT)                                                                                                \
  {                                                                                                                        \
    __builtin_amdgcn_s_setprio(1);                                                                                         \
    _Pragma("unroll") for (int m = 0; m < 4; ++m) _Pragma("unroll") for (int n = 0; n < 2; ++n)                            \
      _Pragma("unroll") for (int k = 0; k < 2; ++k)                                                                        \
        acc[ai][bj][m][n] = __builtin_amdgcn_mfma_f32_16x16x32_bf16(Pt[m][k], QT[n][k], acc[ai][bj][m][n], 0, 0, 0);       \
    __builtin_amdgcn_s_setprio(0);                                                                                         \
  }
#define G8P_WV(n) asm volatile("s_waitcnt vmcnt(" #n ")" ::: "memory")
#define G8P_WL(n) asm volatile("s_waitcnt lgkmcnt(" #n ")" ::: "memory")
#define G8P_BAR __builtin_amdgcn_s_barrier()
#define G8P_SCHED __builtin_amdgcn_sched_barrier(0)
  f32x4 acc[2][2][4][2];
#pragma unroll
  for (int a = 0; a < 2; ++a)
#pragma unroll
    for (int b = 0; b < 2; ++b)
#pragma unroll
      for (int m = 0; m < 4; ++m)
#pragma unroll
        for (int n = 0; n < 2; ++n) acc[a][b][m][n] = (f32x4){0.f, 0.f, 0.f, 0.f};
  bf16x8 Pt[4][2], Q0[2][2], Q1[2][2];
  __syncthreads();
#define G8P_STQ1(b, KT) { if constexpr (!HALFQ) G8P_STQ(b, 1, KT) }
#define G8P_LDQ1(b) { if constexpr (!HALFQ) { G8P_LDQ(Q1, b, 1) } }
#define G8P_MMA1(ai) { if constexpr (!HALFQ) G8P_MMA(ai, 1, Q1) }
#define G8P_WV2(F, H) { if constexpr (HALFQ) { G8P_WV(H); } else { G8P_WV(F); } }
  G8P_STQ(0, 0, 0) G8P_STP(0, 0, 0) G8P_STQ1(0, 0) G8P_STP(0, 1, 0)
  if (wr == 1) G8P_BAR;
  G8P_WV2(4, 2) G8P_BAR;
  G8P_STQ(1, 0, 1) G8P_STP(1, 0, 1) G8P_STQ1(1, 1)
  G8P_WV2(6, 4) G8P_BAR;
  for (int t = 0; t < nt - 2; t += 2) {
    G8P_LDQ(Q0, 0, 0) G8P_SCHED; G8P_LDP(0, 0) G8P_STP(1, 1, t + 1)
    G8P_WL(8); G8P_BAR; G8P_WL(0); G8P_MMA(0, 0, Q0) G8P_BAR; G8P_SCHED;
    G8P_LDQ1(0) G8P_STQ(0, 0, t + 2)
    G8P_BAR; G8P_WL(0); G8P_MMA1(0) G8P_BAR;
    G8P_LDP(0, 1) G8P_STP(0, 0, t + 2)
    G8P_BAR; G8P_WL(0); G8P_MMA(1, 0, Q0) G8P_BAR; G8P_SCHED;
    G8P_STQ1(0, t + 2)
    G8P_WV2(6, 4) G8P_BAR; G8P_MMA1(1) G8P_BAR;
    G8P_LDQ(Q0, 1, 0) G8P_SCHED; G8P_LDP(1, 0) G8P_STP(0, 1, t + 2)
    G8P_WL(8); G8P_BAR; G8P_WL(0); G8P_MMA(0, 0, Q0) G8P_BAR; G8P_SCHED;
    G8P_LDQ1(1) G8P_STQ(1, 0, t + 3)
    G8P_BAR; G8P_WL(0); G8P_MMA1(0) G8P_BAR;
    G8P_LDP(1, 1) G8P_STP(1, 0, t + 3)
    G8P_BAR; G8P_WL(0); G8P_MMA(1, 0, Q0) G8P_BAR; G8P_SCHED;
    G8P_STQ1(1, t + 3)
    G8P_WV2(6, 4) G8P_BAR; G8P_MMA1(1) G8P_BAR;
  }
  {
    G8P_LDQ(Q0, 0, 0) G8P_LDP(0, 0) G8P_STP(1, 1, nt - 1)
    G8P_BAR; G8P_WL(0); G8P_MMA(0, 0, Q0) G8P_BAR;
    G8P_LDQ1(0) G8P_BAR; G8P_WL(0); G8P_MMA1(0) G8P_BAR;
    G8P_LDP(0, 1) G8P_WV2(4, 2) G8P_BAR; G8P_WL(0); G8P_MMA(1, 0, Q0) G8P_MMA1(1) G8P_BAR;
  }
  {
    G8P_LDQ(Q0, 1, 0) G8P_LDP(1, 0) G8P_WV(2); G8P_BAR; G8P_WL(0); G8P_MMA(0, 0, Q0) G8P_BAR;
    G8P_LDQ1(1) G8P_WV(0); G8P_BAR; G8P_WL(0); G8P_MMA1(0) G8P_BAR;
    G8P_LDP(1, 1) G8P_BAR; G8P_WL(0); G8P_MMA(1, 0, Q0) G8P_MMA1(1) G8P_BAR;
  }
  if (wr == 0) G8P_BAR;
#undef G8P_STQ1
#undef G8P_LDQ1
#undef G8P_MMA1
#undef G8P_WV2
#undef G8P_ST
#undef G8P_STP
#undef G8P_STQ
#undef G8P_LDP
#undef G8P_LDQ
#undef G8P_MMA
#undef G8P_WV
#undef G8P_WL
#undef G8P_BAR
#undef G8P_SCHED
  if constexpr (BATCH) {
#pragma unroll
    for (int ai = 0; ai < 2; ++ai)
#pragma unroll
      for (int bj = 0; bj < (HALFQ ? 1 : 2); ++bj) {
        typedef unsigned u32x2_t __attribute__((ext_vector_type(2)));
        u32x2_t ga[8], ya[8];
#pragma unroll
        for (int k = 0; k < 8; ++k) ef.load(bj * 128 + wc * 32 + (k & 1) * 16 + fr, ai * 128 + wr * 64 + (k >> 1) * 16 + fq * 4, ga[k], ya[k]);
        asm volatile("" : "+v"(ga[0]), "+v"(ga[1]), "+v"(ga[2]), "+v"(ga[3]), "+v"(ga[4]), "+v"(ga[5]), "+v"(ga[6]), "+v"(ga[7]),
                          "+v"(ya[0]), "+v"(ya[1]), "+v"(ya[2]), "+v"(ya[3]), "+v"(ya[4]), "+v"(ya[5]), "+v"(ya[6]), "+v"(ya[7]));
#pragma unroll
        for (int k = 0; k < 8; ++k) {
          const int m = k >> 1, n = k & 1;
          ef.apply(bj * 128 + wc * 32 + n * 16 + fr, ai * 128 + wr * 64 + m * 16 + fq * 4, acc[ai][bj][m][n][0], acc[ai][bj][m][n][1], acc[ai][bj][m][n][2],
                   acc[ai][bj][m][n][3], ga[k], ya[k]);
        }
      }
  } else if constexpr (PAIR) {
#pragma unroll
    for (int bj = 0; bj < (HALFQ ? 1 : 2); ++bj)
#pragma unroll
      for (int m = 0; m < 4; ++m)
#pragma unroll
        for (int n = 0; n < 2; ++n) ef(bj * 128 + wc * 32 + n * 16 + fr, wr * 64 + m * 16 + fq * 4, acc[0][bj][m][n], acc[1][bj][m][n]);
  } else {
#pragma unroll
    for (int ai = 0; ai < 2; ++ai)
#pragma unroll
      for (int bj = 0; bj < (HALFQ ? 1 : 2); ++bj)
#pragma unroll
        for (int m = 0; m < 4; ++m)
#pragma unroll
          for (int n = 0; n < 2; ++n)
            ef(bj * 128 + wc * 32 + n * 16 + fr, ai * 128 + wr * 64 + m * 16 + fq * 4, acc[ai][bj][m][n][0], acc[ai][bj][m][n][1], acc[ai][bj][m][n][2], acc[ai][bj][m][n][3]);
  }
}

#define EPI_FOR                                                   \
  _Pragma("unroll") for (int mt = 0; mt < 2; ++mt)                \
  _Pragma("unroll") for (int nt = 0; nt < 2; ++nt)                \
  _Pragma("unroll") for (int i = 0; i < 16; ++i)
#define EPI_R (wm * 64 + mt * 32 + (i & 3) + 8 * (i >> 2) + 4 * (lane >> 5))
#define EPI_C (wn * 64 + nt * 32 + (lane & 31))
#define SW_FOR                                                    \
  _Pragma("unroll") for (int mt = 0; mt < MT; ++mt)               \
  _Pragma("unroll") for (int nt = 0; nt < 2; ++nt)                \
  _Pragma("unroll") for (int q4 = 0; q4 < 4; ++q4)
#define SW_R (wm * (32 * MT) + mt * 32 + (lane & 31))
#define SW_C0 (wn * 64 + nt * 32 + 8 * q4 + 4 * (lane >> 5))
#define SW_V(j) acc[mt][nt][4 * q4 + (j)]
DI uint2 pack4(float a, float b, float c, float d) { uint2 w; w.x = pack2(a, b); w.y = pack2(c, d); return w; }

struct ARows { const u16* base; long ld; int nrows; DI const u16* operator()(int r) const { return base + (long)(r < nrows ? r : 0) * ld; }
  DI const u16* origin() const { return base; } DI int off(int r) const { return (r < nrows ? r : 0) * (int)ld; } };
struct BMat { const float* base; long ldb; int ncols; DI const float* operator()(int c4) const { return base + (c4 < ncols ? c4 : 0); } DI const u16* row(int) const { return nullptr; } };
struct BMatT { const u16* base; long ldb; DI const float* operator()(int) const { return nullptr; } DI const u16* row(int n) const { return base + (long)n * ldb; } };

DI void transpose_tile(const float* W, u16* WT, int K, int N, int k0b, int n0, int tid) {
  const int k0 = k0b + (tid >> 6) * 16, n = n0 + (tid & 63) * 4;
  float4 v[16];
#pragma unroll
  for (int ps = 0; ps < 16; ++ps) {
    v[ps] = make_float4(0.f, 0.f, 0.f, 0.f);
    if (n < N) v[ps] = *(const float4*)(W + (long)(k0 + ps) * N + n);
  }
#define TR_ROW(J, C)                                                                                                         \
  {                                                                                                                          \
    uint4 a_, b_;                                                                                                            \
    a_.x = pack2(v[0].C, v[1].C); a_.y = pack2(v[2].C, v[3].C); a_.z = pack2(v[4].C, v[5].C); a_.w = pack2(v[6].C, v[7].C);          \
    b_.x = pack2(v[8].C, v[9].C); b_.y = pack2(v[10].C, v[11].C); b_.z = pack2(v[12].C, v[13].C); b_.w = pack2(v[14].C, v[15].C);    \
    uint4* dst_ = (uint4*)(WT + (long)(n + (J)) * K + k0);                                                                   \
    dst_[0] = a_; dst_[1] = b_;                                                                                              \
  }
  TR_ROW(0, x) TR_ROW(1, y) TR_ROW(2, z) TR_ROW(3, w)
#undef TR_ROW
}
constexpr int CONV_WITEMS = 257 * 2 * 16 * 4;
constexpr int CONV_PER_ROW = 1;
constexpr int CONV_HOOKED = 2 * NTOK;
DI const float* conv_src(const Params& p, int w, int lane) {
  const int kr = w & 3, kt = (w >> 2) & 15, up = (w >> 6) & 1, e = w >> 7;
  const float* W = e < 256 ? (up ? p.w_eu : p.w_eg) + (long)e * 1024 * 256 : (up ? p.w_su : p.w_sg);
  return W + (long)(kt * 64 + kr * 16) * 256 + lane * 4;
}
DI u16* conv_dst(const Params& p, int w, int lane) {
  const int kr = w & 3, kt = (w >> 2) & 15, up = (w >> 6) & 1, e = w >> 7;
  return p.w_guT + (((long)up * 257 + e) * 256 + lane * 4) * 1024 + kt * 64 + kr * 16;
}
#define CONV_ISSUE(P, W, LANE, V)                                                                                            \
  {                                                                                                                          \
    const float* src_ = conv_src(P, W, LANE);                                                                                \
    _Pragma("unroll") for (int ps = 0; ps < 16; ++ps) V[ps] = *(const float4*)(src_ + ps * 256);                             \
  }
#define CONV_ROW(V, D, J, C)                                                                                                 \
  {                                                                                                                          \
    uint4 a_, b_;                                                                                                            \
    a_.x = pack2(V[0].C, V[1].C); a_.y = pack2(V[2].C, V[3].C); a_.z = pack2(V[4].C, V[5].C); a_.w = pack2(V[6].C, V[7].C);          \
    b_.x = pack2(V[8].C, V[9].C); b_.y = pack2(V[10].C, V[11].C); b_.z = pack2(V[12].C, V[13].C); b_.w = pack2(V[14].C, V[15].C);    \
    uint4* dst_ = (uint4*)(D + (J) * 1024);                                                                                  \
    dst_[0] = a_; dst_[1] = b_;                                                                                              \
  }
#define CONV_FINISH(P, W, LANE, V)                                                                                           \
  {                                                                                                                          \
    u16* d_ = conv_dst(P, W, LANE);                                                                                          \
    CONV_ROW(V, d_, 0, x) CONV_ROW(V, d_, 1, y) CONV_ROW(V, d_, 2, z) CONV_ROW(V, d_, 3, w)                                  \
  }
DI void phase0(const Params& p, char* smem, int bid, int nblk) {
  const int tid = TIDX();
  for (int item = bid; item < 384 + 256 + 16 + 1 + 432; item += nblk) {
    if (item < 384) {
      const int cc = item % 24, kc = item / 24;
      const int col = cc * 256 + tid;
      float a0 = 0.f, a1 = 0.f;
#pragma unroll 1
      for (int half = 0; half < 2; ++half) {
        const int k0 = kc * 64 + half * 32;
        float w[32];
#pragma unroll
        for (int j = 0; j < 32; ++j) w[j] = p.w_ada[(long)(k0 + j) * 6144 + col];
#pragma unroll
        for (int j = 0; j < 32; ++j) {
          a0 += siluf(p.c[k0 + j]) * w[j];
          a1 += siluf(p.c[1024 + k0 + j]) * w[j];
        }
      }
      p.modp[(kc * 2 + 0) * 6144 + col] = a0;
      p.modp[(kc * 2 + 1) * 6144 + col] = a1;
    } else if (item < 640) {
      const int idx = (item - 384) * 256 + tid;
      const int c = idx & 127, d = (idx >> 7) & 63, h = idx >> 13;
      p.w_ukT[idx] = p.dsa_w_uk[c * 512 + h * 64 + d];
    } else if (item < 656) {
      const int part = item - 640;
      const int slot = tid >> 7, kk = tid & 127;
      float a = 0.f;
#pragma unroll 1
      for (int l0 = part * 128; l0 < part * 128 + 128; l0 += 32) {
        float wv[32], pv[32];
#pragma unroll
        for (int j = 0; j < 32; ++j) {
          wv[j] = p.cmp_w1[((long)slot * 2048 + l0 + j) * 128 + kk];
          pv[j] = p.cmp_pe[slot * 2048 + l0 + j];
        }
#pragma unroll
        for (int j = 0; j < 32; ++j) a += pv[j] * wv[j];
      }
      p.pe_part[part * 256 + tid] = a;
    } else if (item == 656) {
      p.counts[tid * 32] = 0;
    } else {
      int it = item - 657;
      const float* W; u16* WT; int K, N, ntn;
      if (it < 288) { W = p.w_in; WT = p.w_inT; K = 1024; N = LDP; ntn = 18; }
      else if (it < 320) { it -= 288; W = p.w_bn; WT = p.w_bnT; K = 512; N = 1024; ntn = 4; }
      else if (it < 352) { it -= 320; W = p.w_bd; WT = p.w_bdT; K = 512; N = 1024; ntn = 4; }
      else if (it < 416) { it -= 352; W = p.w_out; WT = p.w_outT; K = 1024; N = 1024; ntn = 4; }
      else { it -= 416; W = p.router_w; WT = p.routerT; K = 1024; N = 256; ntn = 1; }
      transpose_tile(W, WT, K, N, (it / ntn) * 64, (it % ntn) * 256, tid);
    }
  }
  {
    const int lane = tid & 63, gw = bid * 4 + (tid >> 6), ngw = nblk * 4;
    for (int w = CONV_HOOKED + gw; w < CONV_WITEMS; w += 2 * ngw) {
      float4 va[16], vb[16];
      const int w2 = w + ngw < CONV_WITEMS ? w + ngw : w;
      CONV_ISSUE(p, w, lane, va)
      CONV_ISSUE(p, w2, lane, vb)
      CONV_FINISH(p, w, lane, va)
      CONV_FINISH(p, w2, lane, vb)
    }
  }
}

DI void phase1(const Params& p, char* smem, int bid, int nblk) {
  const int tid = TIDX(), lane = tid & 63, wid = __builtin_amdgcn_readfirstlane(tid >> 6);
  float* modl = (float*)smem;
  const int b = bid & 1;
#pragma unroll
  for (int i0 = 0; i0 < 8; i0 += 4) {
    float v[4], pv[16][4];
#pragma unroll
    for (int ii = 0; ii < 4; ++ii) v[ii] = p.b_ada[tid + 256 * (i0 + ii)];
#pragma unroll
    for (int kc = 0; kc < 16; ++kc)
#pragma unroll
      for (int ii = 0; ii < 4; ++ii) pv[kc][ii] = p.modp[(kc * 2 + b) * 6144 + tid + 256 * (i0 + ii)];
    asm volatile("" ::: "memory");
#pragma unroll
    for (int kc = 0; kc < 16; ++kc)
#pragma unroll
      for (int ii = 0; ii < 4; ++ii) v[ii] += pv[kc][ii];
#pragma unroll
    for (int ii = 0; ii < 4; ++ii) modl[tid + 256 * (i0 + ii)] = v[ii];
  }
  if (bid < 48) {
    const int idx = bid * 256 + tid;
    const int bb = idx / 6144, n = idx % 6144;
    float v = p.b_ada[n], pv[16];
#pragma unroll
    for (int kc = 0; kc < 16; ++kc) pv[kc] = p.modp[(kc * 2 + bb) * 6144 + n];
    asm volatile("" ::: "memory");
#pragma unroll
    for (int kc = 0; kc < 16; ++kc) v += pv[kc];
    p.mod[idx] = v;
  }
  hb_sync();
  float cm[16], ca[16];
#pragma unroll
  for (int i = 0; i < 4; ++i) {
    const int col = i * 256 + lane * 4;
    const float4 g = *(const float4*)(p.g_pre_mix + col);
    const float4 sh = *(const float4*)(modl + col), sc = *(const float4*)(modl + 1024 + col);
    cm[i * 4 + 0] = g.x * (1.f + sc.x); cm[i * 4 + 1] = g.y * (1.f + sc.y); cm[i * 4 + 2] = g.z * (1.f + sc.z); cm[i * 4 + 3] = g.w * (1.f + sc.w);
    ca[i * 4 + 0] = sh.x; ca[i * 4 + 1] = sh.y; ca[i * 4 + 2] = sh.z; ca[i * 4 + 3] = sh.w;
  }
  const int stride = (nblk >> 1) * 4;
  for (int t0 = (bid >> 1) * 4 + wid; t0 < T; t0 += 4 * stride) {
    float4 v[4][4];
#pragma unroll
    for (int k = 0; k < 4; ++k) {
      const int t = t0 + k * stride < T ? t0 + k * stride : T - 1;
      const float* xr = p.x + ((long)b * T + t) * 1024;
#pragma unroll
      for (int i = 0; i < 4; ++i) v[k][i] = *(const float4*)(xr + i * 256 + lane * 4);
    }
#pragma unroll
    for (int k = 0; k < 4; ++k) {
      float ss = 0.f;
#pragma unroll
      for (int i = 0; i < 4; ++i) ss += v[k][i].x * v[k][i].x + v[k][i].y * v[k][i].y + v[k][i].z * v[k][i].z + v[k][i].w * v[k][i].w;
      ss = wave_sum(ss);
      const float r = rsqrtf(ss * (1.f / 1024.f) + 1e-6f);
      if (t0 + k * stride < T) {
        u16* hr = p.h + ((long)b * T + t0 + k * stride) * 1024;
#pragma unroll
        for (int i = 0; i < 4; ++i) {
          const float o0 = v[k][i].x * r * cm[i * 4 + 0] + ca[i * 4 + 0];
          const float o1 = v[k][i].y * r * cm[i * 4 + 1] + ca[i * 4 + 1];
          const float o2 = v[k][i].z * r * cm[i * 4 + 2] + ca[i * 4 + 2];
          const float o3 = v[k][i].w * r * cm[i * 4 + 3] + ca[i * 4 + 3];
          *(uint2*)(hr + i * 256 + lane * 4) = pack4(o0, o1, o2, o3);
        }
      }
    }
  }
}

struct EpiProj {
  u16* proj; float* widx; int m0, n0;
  template <int MT> DI void operator()(f32x16 (&acc)[MT][2], int wm, int wn, int lane) const {
    SW_FOR {
      const int r = m0 + SW_R, c = n0 + SW_C0;
      if (c < LDP) {
        float v[4] = {SW_V(0), SW_V(1), SW_V(2), SW_V(3)};
        if (c < C_KV) { for (int j = 0; j < 4; ++j) v[j] *= 0.125f; }
        else if (c < C_GN) {}
        else if (c < C_QD) { for (int j = 0; j < 4; ++j) v[j] = sigmoidf(v[j]); }
        else if (c < C_QI) {}
        else if (c < C_KI) { for (int j = 0; j < 4; ++j) v[j] *= 0.125f; }
        else if (c < C_WI) {}
        else if (c < C_GM) {
          for (int j = 0; j < 4; ++j) v[j] *= 0.35355339059327373f;
          *(float4*)(widx + (long)r * 8 + (c - C_WI)) = make_float4(v[0], v[1], v[2], v[3]);
        } else { for (int j = 0; j < 4; ++j) v[j] = sigmoidf(v[j]); }
        *(uint2*)(proj + (long)r * LDP + c) = pack4(v[0], v[1], v[2], v[3]);
      }
    }
  }
};
struct EpiProjVT {
  u16* vt; int m0;
  DI void operator()(f32x16 (&acc)[2][2], int wm, int wn, int lane) const {
#pragma unroll
    for (int mt = 0; mt < 2; ++mt)
#pragma unroll
      for (int nt = 0; nt < 2; ++nt) {
        const int cc = EPI_C;
#pragma unroll
        for (int q4 = 0; q4 < 4; ++q4) {
          const int r = m0 + wm * 64 + mt * 32 + 8 * q4 + 4 * (lane >> 5);
          const int b = r >> 13, t = r & 8191;
          uint2 w;
          w.x = pack2(acc[mt][nt][q4 * 4 + 0], acc[mt][nt][q4 * 4 + 1]);
          w.y = pack2(acc[mt][nt][q4 * 4 + 2], acc[mt][nt][q4 * 4 + 3]);
          *(uint2*)(vt + ((long)(b * 128 + cc)) * T + t) = w;
        }
      }
  }
};
DI int proj_group(int q) { return q < 7 ? q : (q < 8 ? q + 1 : q + 2); }
DI void proj_store4(u16* proj, float* widx, long r, int c, float v0, float v1, float v2, float v3) {
  if (c < LDP) {
    float v[4] = {v0, v1, v2, v3};
    if (c < C_KV) { for (int j = 0; j < 4; ++j) v[j] *= 0.125f; }
    else if (c < C_GN) {}
    else if (c < C_QD) { for (int j = 0; j < 4; ++j) v[j] = sigmoidf(v[j]); }
    else if (c < C_QI) {}
    else if (c < C_KI) { for (int j = 0; j < 4; ++j) v[j] *= 0.125f; }
    else if (c < C_WI) {}
    else if (c < C_GM) {
      for (int j = 0; j < 4; ++j) v[j] *= 0.35355339059327373f;
      *(float4*)(widx + r * 8 + (c - C_WI)) = make_float4(v[0], v[1], v[2], v[3]);
    } else { for (int j = 0; j < 4; ++j) v[j] = sigmoidf(v[j]); }
    *(uint2*)(proj + r * LDP + c) = pack4(v[0], v[1], v[2], v[3]);
  }
}
struct WRows2 { const u16* base; int ra, rb; DI const u16* origin() const { return base; } DI int off(int r) const { return ((r < 128 ? ra : rb) + (r & 127)) * 1024; } };
struct Epi8Proj {
  u16* proj; float* widx; int m0, n0a, n0b;
  DI void operator()(int q, int c, float v0, float v1, float v2, float v3) const {
    proj_store4(proj, widx, m0 + q, (c < 128 ? n0a : n0b) + (c & 127), v0, v1, v2, v3);
  }
};
struct Epi8ProjVT {
  u16* vts; u16* vtw; int m0;
  DI void operator()(int q, int c, float v0, float v1, float v2, float v3) const {
    const int r = m0 + c, b = r >> 13, t = r & 8191;
    u16* vt = q < 128 ? vts : vtw;
    *(uint2*)(vt + ((long)(b * 128 + (q & 127))) * T + t) = pack4(v0, v1, v2, v3);
  }
};
DI void phase2_8w(const Params& p, int wg, int nwg) {
  for (int i = wg; i < 1280; i += nwg) {
    const int x_ = i & 7, s_ = (i >> 3) & 31, rnd = i >> 8;
    const int blk = rnd < 4 ? rnd * 8 + x_ : 32 + (x_ & 3), half = rnd < 4 ? -1 : (x_ >> 2);
    const int nb = blk % 9, mb = blk / 9;
    const int mt_ = mb * 16 + (s_ >> 1), v = 2 * nb + (s_ & 1);
    if (v < 17) {
      const int ga = proj_group(2 * v), gb = proj_group(2 * v + 1);
      WRows2 wf{p.w_inT, ga * 128, gb * 128};
      if (half < 0) {
        ARows tf{p.h + (long)mt_ * 256 * 1024, 1024, 256};
        Epi8Proj ef{p.proj, p.widx, mt_ * 256, ga * 128, gb * 128};
        gemm8p(16, wf, tf, ef);
      } else {
        ARows tf{p.h + ((long)mt_ * 256 + half * 128) * 1024, 1024, 128};
        Epi8Proj ef{p.proj, p.widx, mt_ * 256 + half * 128, ga * 128, gb * 128};
        gemm8p<false, false, true>(16, wf, tf, ef);
      }
    } else {
      ARows tf{p.h + (long)mt_ * 256 * 1024, 1024, 256};
      if (half < 0) {
        WRows2 wf{p.w_inT, 7 * 128, 9 * 128};
        Epi8ProjVT ef{p.vts, p.vtw, mt_ * 256};
        gemm8p(16, tf, wf, ef);
      } else {
        const int gq = half ? 9 : 7;
        WRows2 wf{p.w_inT, gq * 128, gq * 128};
        Epi8ProjVT ef{half ? p.vtw : p.vts, half ? p.vtw : p.vts, mt_ * 256};
        gemm8p<false, false, true>(16, tf, wf, ef);
      }
    }
  }
}
DI void phase2(const Params& p, char* smem, int bid, int nblk) {}

struct ACmp {
  const u16* proj; int slot, m0, kt0;
  DI const u16* operator()(int r) const {
    const int R = m0 + r, bg = R >> 9, n = R & 511, b = bg >> 1, g = bg & 1;
    const int nc = n >= 511 ? 510 : n;
    return proj + ((long)b * T + 16 * nc + kt0) * LDP + C_KV + slot * 128 + g * 64;
  }
};
struct EpiPartF32 {
  float* dst; int m0;
  DI void operator()(f32x16 (&acc)[2][2], int wm, int wn, int lane) const {
    constexpr int MT = 2;
    SW_FOR { *(float4*)(dst + (long)(m0 + SW_R) * 128 + SW_C0) = make_float4(SW_V(0), SW_V(1), SW_V(2), SW_V(3)); }
  }
};
struct EpiCmp1 {
  u16* zc; const float* b1; const float* pe_part; int slot, m0;
  DI void operator()(f32x16 (&acc)[2][2], int wm, int wn, int lane) const {
    constexpr int MT = 2;
#pragma unroll
    for (int nt = 0; nt < 2; ++nt)
#pragma unroll
      for (int q4 = 0; q4 < 4; ++q4) {
        const int c = SW_C0;
        float4 bias = *(const float4*)(b1 + slot * 128 + c);
        for (int q = 0; q < 16; ++q) {
          const float4 t = *(const float4*)(pe_part + q * 256 + slot * 128 + c);
          bias.x += t.x; bias.y += t.y; bias.z += t.z; bias.w += t.w;
        }
#pragma unroll
        for (int mt = 0; mt < 2; ++mt) {
          const int R = m0 + SW_R;
          *(uint2*)(zc + ((long)slot * 2048 + R) * 128 + c) =
              pack4(gelu_tanh(SW_V(0) + bias.x), gelu_tanh(SW_V(1) + bias.y), gelu_tanh(SW_V(2) + bias.z), gelu_tanh(SW_V(3) + bias.w));
        }
      }
  }
};
struct EpiQlat {
  u16* qlat; int h, m0;
  DI void operator()(f32x16 (&acc)[2][2], int wm, int wn, int lane) const {
    constexpr int MT = 2;
    SW_FOR {
      const int r = m0 + SW_R, c = SW_C0;
      *(uint2*)(qlat + ((long)r * 8 + h) * 128 + c) = pack4(SW_V(0) * 0.125f, SW_V(1) * 0.125f, SW_V(2) * 0.125f, SW_V(3) * 0.125f);
    }
  }
};
constexpr int IDX_QLD = 520;
constexpr int IDX_NITEMS = 1152;
DI void indexer_item2(const Params& p, char* smem, int b, int tq, int c) {
  const int tid = TIDX(), lane = tid & 63, wid = __builtin_amdgcn_readfirstlane(tid >> 6);
  u16* Qs = (u16*)smem;
  float* wl = (float*)(smem + 64 * IDX_QLD * 2);
  const u16* projb = p.proj + (long)b * T * LDP;
  const int t0 = tq * 64;
  {
    typedef unsigned u32x4_t __attribute__((ext_vector_type(4)));
    u32x4_t q[16];
#pragma unroll
    for (int i = 0; i < 16; ++i) q[i] = *(const u32x4_t*)(projb + (long)(t0 + i * 4 + wid) * LDP + C_QI + lane * 8);
    const float2 wv = *(const float2*)(p.widx + ((long)b * T + t0) * 8 + tid * 2);
    asm volatile("" : "+v"(q[0]), "+v"(q[1]), "+v"(q[2]), "+v"(q[3]), "+v"(q[4]), "+v"(q[5]), "+v"(q[6]), "+v"(q[7]),
                      "+v"(q[8]), "+v"(q[9]), "+v"(q[10]), "+v"(q[11]), "+v"(q[12]), "+v"(q[13]), "+v"(q[14]), "+v"(q[15]));
#pragma unroll
    for (int i = 0; i < 16; ++i) *(u32x4_t*)(Qs + (i * 4 + wid) * IDX_QLD + lane * 8) = q[i];
    *(float2*)(wl + tid * 2) = wv;
  }
  hb_sync();
  const int r31 = lane & 31, hf = lane >> 5;
  const int kt_lo = c * 16, kt_hi = (kt_lo + 16 < tq + 1) ? kt_lo + 16 : tq + 1;
  const u16* qfrag = Qs + r31 * IDX_QLD + hf * 8;
  const float* wq = wl + r31 * 8;
  const u16* kbase = projb + (long)r31 * LDP + C_KI + hf * 8;
  bf16x8 kn[2][4];
#define IDX2_LOADK(KT)                                                                                   \
  {                                                                                                      \
    const int kk_ = (KT) < kt_hi ? (KT) : kt_hi - 1;                                                     \
    _Pragma("unroll") for (int nt = 0; nt < 2; ++nt)                                                     \
      _Pragma("unroll") for (int ks = 0; ks < 4; ++ks) kn[nt][ks] = *(const bf16x8*)(kbase + (long)(kk_ * 64 + nt * 32) * LDP + ks * 16); \
  }
  IDX2_LOADK(kt_lo + wid)
#pragma unroll 1
  for (int kt = kt_lo + wid; kt < kt_hi; kt += 4) {
    bf16x8 kf[2][4];
#pragma unroll
    for (int nt = 0; nt < 2; ++nt)
#pragma unroll
      for (int ks = 0; ks < 4; ++ks) kf[nt][ks] = kn[nt][ks];
    IDX2_LOADK(kt + 4)
    asm volatile("" ::: "memory");
    f32x16 sum[2][2];
#pragma unroll
    for (int a = 0; a < 2; ++a)
#pragma unroll
      for (int d = 0; d < 2; ++d)
#pragma unroll
        for (int i = 0; i < 16; ++i) sum[a][d][i] = 0.f;
#define IDX2_LOADQ(DST, MT, H)                                                                          \
  {                                                                                                      \
    const int h_ = (H) < 7 ? (H) : 7;                                                                    \
    _Pragma("unroll") for (int ks = 0; ks < 4; ++ks) DST[ks] = *(const bf16x8*)(qfrag + (MT) * 32 * IDX_QLD + h_ * 64 + ks * 16); \
  }
#define IDX2_CHAIN(ACC, SRC, NT)                                                                         \
  {                                                                                                      \
    _Pragma("unroll") for (int i = 0; i < 16; ++i) ACC[i] = 0.f;                                         \
    _Pragma("unroll") for (int ks = 0; ks < 4; ++ks) ACC = __builtin_amdgcn_mfma_f32_32x32x16_bf16(kf[NT][ks], SRC[ks], ACC, 0, 0, 0); \
  }
#define IDX2_ACCUM(ACC, MT, NT, W)                                                                       \
  {                                                                                                      \
    _Pragma("unroll") for (int i = 0; i < 16; ++i) {                                                     \
      const int rb_ = __float_as_int(ACC[i]);                                                            \
      sum[MT][NT][i] += (W) * __int_as_float(rb_ > 0 ? rb_ : 0);                                         \
    }                                                                                                    \
  }
#define IDX2_SGB4 \
  __builtin_amdgcn_sched_group_barrier(0x008, 1, 0); __builtin_amdgcn_sched_group_barrier(0x002, 6, 0); \
  __builtin_amdgcn_sched_group_barrier(0x008, 1, 0); __builtin_amdgcn_sched_group_barrier(0x002, 6, 0); \
  __builtin_amdgcn_sched_group_barrier(0x008, 1, 0); __builtin_amdgcn_sched_group_barrier(0x002, 6, 0); \
  __builtin_amdgcn_sched_group_barrier(0x008, 1, 0); __builtin_amdgcn_sched_group_barrier(0x002, 6, 0);
    bf16x8 sa[4], sb[4];
    f32x16 accA, accB;
    IDX2_LOADQ(sa, 0, 0)
    IDX2_LOADQ(sb, 1, 0)
    float w0 = wq[0], w1 = wq[256];
    IDX2_CHAIN(accA, sa, 0)
#pragma unroll 1
    for (int h = 0; h < 8; ++h) {
      const int hn = h < 7 ? h + 1 : 7;
      IDX2_CHAIN(accB, sa, 1)
      IDX2_ACCUM(accA, 0, 0, w0)
      IDX2_LOADQ(sa, 0, h + 1)
      IDX2_CHAIN(accA, sb, 0)
      IDX2_ACCUM(accB, 0, 1, w0)
      IDX2_CHAIN(accB, sb, 1)
      IDX2_ACCUM(accA, 1, 0, w1)
      IDX2_LOADQ(sb, 1, h + 1)
      const float w0n = wq[hn], w1n = wq[256 + hn];
      IDX2_CHAIN(accA, sa, 0)
      IDX2_ACCUM(accB, 1, 1, w1)
      w0 = w0n; w1 = w1n;
      IDX2_SGB4
      IDX2_SGB4
      __builtin_amdgcn_sched_group_barrier(0x100, 5, 0);
      IDX2_SGB4
      IDX2_SGB4
      __builtin_amdgcn_sched_group_barrier(0x100, 5, 0);
    }
#undef IDX2_LOADQ
#undef IDX2_CHAIN
#undef IDX2_ACCUM
#undef IDX2_SGB4
    const int s0 = kt * 64;
#pragma unroll
    for (int mt = 0; mt < 2; ++mt)
#pragma unroll
      for (int nt = 0; nt < 2; ++nt)
#pragma unroll
        for (int q4 = 0; q4 < 4; ++q4) {
          typedef _Float16 h4_t __attribute__((ext_vector_type(4)));
          typedef float f4_t __attribute__((ext_vector_type(4)));
          const f4_t v4 = {sum[mt][nt][4 * q4], sum[mt][nt][4 * q4 + 1], sum[mt][nt][4 * q4 + 2], sum[mt][nt][4 * q4 + 3]};
          *(h4_t*)((u16*)p.scores + ((long)b * T + t0 + mt * 32 + r31) * T + s0 + nt * 32 + 8 * q4 + 4 * hf) = __builtin_convertvector(v4, h4_t);
        }
  }
#undef IDX2_LOADK
}
DI void phase3(const Params& p, char* smem, int bid, int nblk) {
  const int tid = TIDX(), lane = tid & 63, wid = __builtin_amdgcn_readfirstlane(tid >> 6);
  if (bid < 128) {
    const int kq = bid & 3, tile = bid >> 2, slot = tile >> 4, mt_ = tile & 15;
    ACmp af{p.proj, slot, mt_ * 128, kq * 8};
    BMat bf{p.cmp_w1 + ((long)slot * 2048 + kq * 512) * 128, 128, 128};
    EpiPartF32 ef{p.cpart + ((long)kq * 4096 + slot * 2048) * 128, mt_ * 128};
    gemm_tile(smem, 8, LDP, af, bf, ef);
  }
  int* qslot = (int*)(smem + 64 * IDX_QLD * 2 + 2048);
  unsigned* qctr = p.bar + XCD_BAR_WORDS;
  hb_sync();
  if (tid == 0) *qslot = (int)atomicAdd(qctr, 1u);
  for (;;) {
    hb_sync();
    const int i = __builtin_amdgcn_readfirstlane(*qslot);
    if (i >= IDX_NITEMS + 1024 + 512) break;
    int nxt = 0;
    if (tid == 0) nxt = (int)atomicAdd(qctr, 1u);
    if (i < IDX_NITEMS) {
      const int b = i & 1;
      int j = i >> 1, c = 0;
      while (j >= 128 - 16 * c) { j -= 128 - 16 * c; ++c; }
      indexer_item2(p, smem, b, 127 - j, c);
    } else if (i < IDX_NITEMS + 1024) {
      const int it = i - IDX_NITEMS, h = it & 7, mt_ = it >> 3;
      ARows af{p.proj + (long)mt_ * 128 * LDP + C_QD + h * 64, LDP, 128};
      BMat bf{p.w_ukT + h * 64 * 128, 128, 128};
      EpiQlat ef{p.qlat, h, mt_ * 128};
      gemm_tile<true, true>(smem, 1, 64, af, bf, ef);
    } else {
      const int it = i - IDX_NITEMS - 1024;
      const float n0 = p.dsa_kv_norm[lane * 2], n1 = p.dsa_kv_norm[lane * 2 + 1];
      unsigned u[8];
#pragma unroll
      for (int q = 0; q < 8; ++q) u[q] = *(const unsigned*)(p.proj + (long)(it * 32 + wid * 8 + q) * LDP + C_CKV + lane * 2);
#pragma unroll
      for (int q = 0; q < 8; ++q) {
        const float a = lo16(u[q]), b = hi16(u[q]);
        const float ss = wave_sum(a * a + b * b);
        const float r = rsqrtf(ss * (1.f / 128.f) + 1e-6f);
        *(unsigned*)(p.ckv + (long)(it * 32 + wid * 8 + q) * 128 + lane * 2) = pack2(a * r * n0, b * r * n1);
      }
    }
    hb_sync();
    if (tid == 0) *qslot = nxt;
  }
}

struct EpiCmp2 {
  u16* dst; int m0;
  DI void operator()(f32x16 (&acc)[2][2], int wm, int wn, int lane) const {
    constexpr int MT = 2;
    SW_FOR {
      const int R = m0 + SW_R, c = SW_C0;
      if (c < 64) *(uint2*)(dst + (long)R * 64 + c) = pack4(SW_V(0), SW_V(1), SW_V(2), SW_V(3));
    }
  }
};
struct EpiCmp2T {
  u16* dst; int m0;
  DI void operator()(f32x16 (&acc)[2][2], int wm, int wn, int lane) const {
#pragma unroll
    for (int mt = 0; mt < 2; ++mt)
#pragma unroll
      for (int nt = 0; nt < 2; ++nt) {
        const int c = EPI_C;
        if (c < 64) {
#pragma unroll
          for (int q4 = 0; q4 < 4; ++q4) {
            const int R = m0 + wm * 64 + mt * 32 + 8 * q4 + 4 * (lane >> 5);
            const int bg = R >> 9, n = R & 511;
            *(uint2*)(dst + ((long)(bg * 64 + c)) * 512 + n) =
                pack4(acc[mt][nt][q4 * 4 + 0], acc[mt][nt][q4 * 4 + 1], acc[mt][nt][q4 * 4 + 2], acc[mt][nt][q4 * 4 + 3]);
          }
        }
      }
  }
};
DI void indexer_item(const Params& p, char* smem, int item) {
  const int tid = TIDX(), lane = tid & 63, wid = __builtin_amdgcn_readfirstlane(tid >> 6);
  int b = 0, rem = item;
  if (rem >= 2080) { b = 1; rem -= 2080; }
  int qt = (int)((sqrtf(8.f * rem + 1.f) - 1.f) * 0.5f);
  while ((qt + 1) * (qt + 2) / 2 <= rem) ++qt;
  while (qt * (qt + 1) / 2 > rem) --qt;
  const int kt = rem - qt * (qt + 1) / 2;
  const int t0 = qt * 128 + (wid >> 1) * 64, s0 = kt * 128 + (wid & 1) * 64;
  if (s0 > t0 + 63) return;
  float* wl = (float*)smem + wid * 512;
  const float* wsrc = p.widx + ((long)b * T + t0) * 8;
#pragma unroll
  for (int i = 0; i < 8; ++i) wl[i * 64 + lane] = wsrc[i * 64 + lane];
  wave_sync();
  const u16* projb = p.proj + (long)b * T * LDP;
  const int r31 = lane & 31, hf = lane >> 5;
  u16* Kt = (u16*)(smem + 8192) + wid * (64 * 72);
  {
    const int piece = lane & 7, rb = lane >> 3;
#pragma unroll
    for (int i = 0; i < 8; ++i) {
      const uint4 v = *(const uint4*)(projb + (long)(s0 + rb + 8 * i) * LDP + C_KI + piece * 8);
      *(uint4*)(Kt + (rb + 8 * i) * 72 + piece * 8) = v;
    }
  }
  wave_sync();
  const u16* kfrag = Kt + r31 * 72 + hf * 8;
  f32x16 sum[2][2];
#pragma unroll
  for (int a = 0; a < 2; ++a)
#pragma unroll
    for (int c = 0; c < 2; ++c)
#pragma unroll
      for (int i = 0; i < 16; ++i) sum[a][c][i] = 0.f;
  const u16* qbase = projb + (long)(t0 + r31) * LDP + C_QI + hf * 8;
  bf16x8 af0[4], af1[4], af2[4], af3[4];
#define IDX_LOADQ(DST, STEP)                                                                            \
  {                                                                                                     \
    const int st_ = (STEP) < 15 ? (STEP) : 15;                                                          \
    _Pragma("unroll") for (int ks = 0; ks < 4; ++ks) DST[ks] = *(const bf16x8*)(qbase + (long)(st_ & 1) * 32 * LDP + (st_ >> 1) * 64 + ks * 16); \
  }
#define IDX_STEP(SRC, MT, H)                                                                            \
  {                                                                                                     \
    const float w_ = wl[((MT) * 32 + r31) * 8 + (H)];                                                   \
    _Pragma("unroll") for (int nt = 0; nt < 2; ++nt) {                                                  \
      f32x16 acc;                                                                                       \
      _Pragma("unroll") for (int i = 0; i < 16; ++i) acc[i] = 0.f;                                      \
      _Pragma("unroll") for (int ks = 0; ks < 4; ++ks) acc = __builtin_amdgcn_mfma_f32_32x32x16_bf16(*(const bf16x8*)(kfrag + nt * 32 * 72 + ks * 16), SRC[ks], acc, 0, 0, 0); \
      _Pragma("unroll") for (int i = 0; i < 16; ++i) sum[MT][nt][i] += w_ * fmaxf(acc[i], 0.f);        \
    }                                                                                                   \
  }
  IDX_LOADQ(af0, 0) IDX_LOADQ(af1, 1) IDX_LOADQ(af2, 2)
#pragma unroll 1
  for (int s4 = 0; s4 < 16; s4 += 4) {
    IDX_LOADQ(af3, s4 + 3)
    asm volatile("" ::: "memory");
    IDX_STEP(af0, 0, s4 >> 1)
    asm volatile("" ::: "memory");
    IDX_LOADQ(af0, s4 + 4)
    asm volatile("" ::: "memory");
    IDX_STEP(af1, 1, s4 >> 1)
    asm volatile("" ::: "memory");
    IDX_LOADQ(af1, s4 + 5)
    asm volatile("" ::: "memory");
    IDX_STEP(af2, 0, (s4 >> 1) + 1)
    asm volatile("" ::: "memory");
    IDX_LOADQ(af2, s4 + 6)
    asm volatile("" ::: "memory");
    IDX_STEP(af3, 1, (s4 >> 1) + 1)
    asm volatile("" ::: "memory");
  }
#undef IDX_LOADQ
#undef IDX_STEP
#pragma unroll
  for (int mt = 0; mt < 2; ++mt)
#pragma unroll
    for (int nt = 0; nt < 2; ++nt)
#pragma unroll
      for (int q4 = 0; q4 < 4; ++q4)
      {
        typedef _Float16 h4_t __attribute__((ext_vector_type(4)));
        typedef float f4_t __attribute__((ext_vector_type(4)));
        const f4_t v4 = {sum[mt][nt][4 * q4], sum[mt][nt][4 * q4 + 1], sum[mt][nt][4 * q4 + 2], sum[mt][nt][4 * q4 + 3]};
        *(h4_t*)((u16*)p.scores + ((long)b * T + t0 + mt * 32 + r31) * T + s0 + nt * 32 + 8 * q4 + 4 * hf) = __builtin_convertvector(v4, h4_t);
      }
}
DI void topk_row(const Params& p, int b, int t, int lane, int* obuf);
DI void phase4(const Params& p, char* smem, int bid, int nblk) {
  if (bid < 32) {
    const int slot = bid >> 4, mt_ = bid & 15;
    {
      const int tid = TIDX(), c = (tid & 31) * 4;
      float4 bias = *(const float4*)(p.cmp_b1 + slot * 128 + c);
      {
        float4 tq[16];
#pragma unroll
        for (int q = 0; q < 16; ++q) tq[q] = *(const float4*)(p.pe_part + q * 256 + slot * 128 + c);
        asm volatile("" ::: "memory");
#pragma unroll
        for (int q = 0; q < 16; ++q) { bias.x += tq[q].x; bias.y += tq[q].y; bias.z += tq[q].z; bias.w += tq[q].w; }
      }
#pragma unroll 1
      for (int i0 = 0; i0 < 16; i0 += 4) {
        float4 pv[4][4];
#pragma unroll
        for (int ii = 0; ii < 4; ++ii)
#pragma unroll
          for (int kq = 0; kq < 4; ++kq)
            pv[ii][kq] = *(const float4*)(p.cpart + ((long)kq * 4096 + (long)slot * 2048 + mt_ * 128 + (tid >> 5) + 8 * (i0 + ii)) * 128 + c);
        asm volatile("" ::: "memory");
#pragma unroll
        for (int ii = 0; ii < 4; ++ii) {
          const long R = (long)slot * 2048 + mt_ * 128 + (tid >> 5) + 8 * (i0 + ii);
          float4 v = pv[ii][0];
#pragma unroll
          for (int kq = 1; kq < 4; ++kq) { v.x += pv[ii][kq].x; v.y += pv[ii][kq].y; v.z += pv[ii][kq].z; v.w += pv[ii][kq].w; }
          *(uint2*)(p.zc + R * 128 + c) = pack4(gelu_tanh(v.x + bias.x), gelu_tanh(v.y + bias.y), gelu_tanh(v.z + bias.z), gelu_tanh(v.w + bias.w));
        }
      }
      hb_sync();
    }
    ARows af{p.zc + ((long)slot * 2048 + mt_ * 128) * 128, 128, 128};
    BMat bf{p.cmp_w2 + slot * 128 * 64, 64, 64};
    if (slot) { EpiCmp2T ef{p.vcT, mt_ * 128}; gemm_tile<false>(smem, 2, 64, af, bf, ef); }
    else { EpiCmp2 ef{p.kc, mt_ * 128}; gemm_tile(smem, 2, 64, af, bf, ef); }
    hb_sync();
  }
  const int tid = TIDX(), lane = tid & 63, wid = __builtin_amdgcn_readfirstlane(tid >> 6);
  for (int item = bid; item < 2048; item += nblk) {
    const int it = item < 1024 ? 2047 - item : item - 1024;
    const int b = it & 1, tb = it >> 1;
#pragma unroll 1
    for (int q = 0; q < 2; ++q) {
      asm volatile("" ::: "memory");
      topk_row(p, b, tb * 8 + wid * 2 + q, lane, (int*)smem + wid * 256);
    }
  }
}

#define MFMA16(a, b, c) __builtin_amdgcn_mfma_f32_16x16x32_bf16((a), (b), (c), 0, 0, 0)
#define MFMA32(a, b, c) __builtin_amdgcn_mfma_f32_32x32x16_bf16((a), (b), (c), 0, 0, 0)

constexpr int NSA_STAGE_BYTES = 64 * 72 * 2 + 64 * 68 * 2;
DI void dense_scores(f32x16 (&acc)[2], const u16* Ks, const bf16x8 (&qf)[4], int lane) {
  const int r = lane & 31, hf = lane >> 5;
  bf16x8 kf[2][4];
#pragma unroll
  for (int tile = 0; tile < 2; ++tile)
#pragma unroll
    for (int ks = 0; ks < 4; ++ks) kf[tile][ks] = *(const bf16x8*)(Ks + (32 * tile + r) * 72 + 8 * hf + 16 * ks);
  asm volatile("" ::: "memory");
#pragma unroll
  for (int tile = 0; tile < 2; ++tile) {
    f32x16 c;
#pragma unroll
    for (int i = 0; i < 16; ++i) c[i] = 0.f;
#pragma unroll
    for (int ks = 0; ks < 4; ++ks) c = MFMA32(kf[tile][ks], qf[ks], c);
    acc[tile] = c;
  }
}
DI void dense_pv(const f32x16 (&acc)[2], const u16* Vs, int lane, f32x16 (&o)[2]) {
  const int r = lane & 31, hf = lane >> 5;
  uint2 vlo[2][2][2], vhi[2][2][2];
#pragma unroll
  for (int tile = 0; tile < 2; ++tile)
#pragma unroll
    for (int s = 0; s < 2; ++s)
#pragma unroll
      for (int dt = 0; dt < 2; ++dt) {
        const u16* vp = Vs + (32 * dt + r) * 68 + 32 * tile + 16 * s + 4 * hf;
        vlo[tile][s][dt] = *(const uint2*)vp;
        vhi[tile][s][dt] = *(const uint2*)(vp + 8);
      }
  asm volatile("" ::: "memory");
#pragma unroll
  for (int tile = 0; tile < 2; ++tile)
#pragma unroll
    for (int s = 0; s < 2; ++s) {
      uint4 w;
      w.x = pack2(acc[tile][8 * s + 0], acc[tile][8 * s + 1]);
      w.y = pack2(acc[tile][8 * s + 2], acc[tile][8 * s + 3]);
      w.z = pack2(acc[tile][8 * s + 4], acc[tile][8 * s + 5]);
      w.w = pack2(acc[tile][8 * s + 6], acc[tile][8 * s + 7]);
      const bf16x8 pb = __builtin_bit_cast(bf16x8, w);
#pragma unroll
      for (int dt = 0; dt < 2; ++dt) {
        uint4 a;
        a.x = vlo[tile][s][dt].x; a.y = vlo[tile][s][dt].y; a.z = vhi[tile][s][dt].x; a.w = vhi[tile][s][dt].y;
        o[dt] = MFMA32(__builtin_bit_cast(bf16x8, a), pb, o[dt]);
      }
    }
}
constexpr float LOG2E = 1.4426950408889634f;
template <int DSTEP>
DI float dense_mask(f32x16 (&acc)[2], bool active, int lo_c, int hi_c, int dist0_c, int dmin_u, const float* btab_h, int lane) {
  const int hf = lane >> 5;
  const bool colfull = !active || (lo_c <= 0 && hi_c >= 63);
  float mx = -INFINITY;
  if (dmin_u >= 128 && __ballot(colfull) == ~0ull) {
    const float be = active ? btab_h[128] : -INFINITY;
#pragma unroll
    for (int tile = 0; tile < 2; ++tile)
#pragma unroll
      for (int i = 0; i < 16; ++i) {
        const float sv = fmaf(acc[tile][i], LOG2E, be);
        acc[tile][i] = sv;
        mx = fmaxf(mx, sv);
      }
  } else {
    const int lo2 = active ? lo_c : 1, hi2 = active ? hi_c : 0;
#pragma unroll
    for (int tile = 0; tile < 2; ++tile)
#pragma unroll
      for (int i = 0; i < 16; ++i) {
        const int kl = 32 * tile + (i & 3) + 8 * (i >> 2) + 4 * hf;
        int dc = dist0_c - DSTEP * kl;
        dc = dc < 0 ? 0 : (dc > 128 ? 128 : dc);
        const float bias = btab_h[dc];
        const float s2 = fmaf(acc[tile][i], LOG2E, bias);
        const float sv = (kl >= lo2 && kl <= hi2) ? s2 : -INFINITY;
        acc[tile][i] = sv;
        mx = fmaxf(mx, sv);
      }
  }
  return x32_max(mx);
}
DI void dense_chunk(const u16* Ks, const u16* Vs, bool active, int lo_c, int hi_c, int dist0_c, int dmin_u, const bf16x8 (&qf)[4],
                    const float* btab_h, int lane, float& m, float& l, f32x16 (&o)[2]) {
  f32x16 acc[2];
  dense_scores(acc, Ks, qf, lane);
  const float mx = dense_mask<1>(acc, active, lo_c, hi_c, dist0_c, dmin_u, btab_h, lane);
  const float mn = fmaxf(m, mx);
  const float alpha = __builtin_amdgcn_exp2f(m - mn);
  float ls = 0.f;
#pragma unroll
  for (int tile = 0; tile < 2; ++tile)
#pragma unroll
    for (int i = 0; i < 16; ++i) {
      const float pv = __builtin_amdgcn_exp2f(acc[tile][i] - mn);
      acc[tile][i] = pv;
      ls += pv;
    }
  ls = x32_sum(ls);
  l = l * alpha + ls;
  m = mn;
  o[0] *= alpha;
  o[1] *= alpha;
  dense_pv(acc, Vs, lane, o);
}

template <int KSG, int VSG, bool NEEDV, class Next, class Body>
DI void chunk_pipeline(char* stage, const u16* kg0, const u16* vg0, int first, int tid, const Next& next, const Body& body) {
  const int srow = tid >> 3, spiece = tid & 7;
  if (first < 0) return;
  uint4 ak, av, bk, bv;
  av = bv = make_uint4(0, 0, 0, 0);
#define NSA_GLOAD(RK, RV, D)                                                              \
  {                                                                                       \
    const int dd_ = (D);                                                                  \
    RK = *(const uint4*)(kg0 + ((long)dd_ * 64 + srow) * KSG + spiece * 8);               \
    if (NEEDV) RV = *(const uint4*)(vg0 + (long)srow * VSG + dd_ * 64 + spiece * 8);      \
  }
#define NSA_WRITE(RK, RV)                                                                 \
  u16* Ks = (u16*)(stage + ph * NSA_STAGE_BYTES);                                         \
  u16* Vs = Ks + 64 * 72;                                                                 \
  *(uint4*)(Ks + srow * 72 + spiece * 8) = RK;                                            \
  if (NEEDV) {                                                                            \
    uint2* dv = (uint2*)(Vs + srow * 68 + spiece * 8);                                    \
    dv[0] = make_uint2(RV.x, RV.y); dv[1] = make_uint2(RV.z, RV.w);                       \
  }
  int dA = first, dB = next(first);
  NSA_GLOAD(ak, av, dA)
  NSA_GLOAD(bk, bv, dB >= 0 ? dB : dA)
  int ph = 0;
  __syncthreads();
  for (;;) {
    int dC, dD;
    {
      NSA_WRITE(ak, av)
      dC = dB >= 0 ? next(dB) : -1;
      NSA_GLOAD(ak, av, dC >= 0 ? dC : dA)
      __syncthreads();
      body(dA, Ks, Vs);
      ph ^= 1;
    }
    if (dB < 0) break;
    {
      NSA_WRITE(bk, bv)
      dD = dC >= 0 ? next(dC) : -1;
      NSA_GLOAD(bk, bv, dD >= 0 ? dD : dB)
      __syncthreads();
      body(dB, Ks, Vs);
      ph ^= 1;
    }
    if (dC < 0) break;
    dA = dC; dB = dD;
  }
#undef NSA_GLOAD
#undef NSA_WRITE
}

DI void nsa_item(const Params& p, char* smem, int item) {
  const int tid = TIDX8(), lane = tid & 63, wid = __builtin_amdgcn_readfirstlane(tid >> 6);
  const int chunk = item & 127, g = (item >> 7) & 1, b = item >> 8;
  const int bg = b * 2 + g;
  float* btab = (float*)smem;
  u64* wun = (u64*)(smem + 2304);
  float* imps = (float*)(smem + 4096) + wid * 1056;
  char* stage = smem + 37888;
  for (int idx = tid; idx < 4 * 129; idx += 512) {
    const int h = idx / 129, d = idx % 129;
    const int bk = d < 128 ? BUCKET[d] : 31;
    btab[h * 132 + d] = p.rel_bias[bk * 16 + g * 4 + h] * LOG2E;
  }
  __syncthreads();
  const int t0 = chunk * 64;
  const int tw = t0 + wid * 8;
  const int c = lane & 31, hf = lane >> 5, qi = c >> 2, hh = c & 3;
  const int t_c = tw + qi;
  const int cur = t0 >> 6;
  const long row = (long)b * T + t_c;
  const u16* prow = p.proj + row * LDP;
  const u16* projb = p.proj + (long)b * T * LDP;
  const float* btab_h = btab + hh * 132;
  bf16x8 qf[4];
#pragma unroll
  for (int ks = 0; ks < 4; ++ks) qf[ks] = *(const bf16x8*)(prow + C_QN + (g * 4 + hh) * 64 + ks * 16 + hf * 8);
  const u16* gptr = prow + C_GN + (g * 4 + hh) * 3;
  for (int k = lane; k < 1056; k += 64) imps[k] = 0.f;
  u16* orow = p.onsa + row * 512 + (g * 4 + hh) * 64 + 4 * hf;
  auto emit = [&](const f32x16 (&o)[2], float sc, bool first) {
    typedef unsigned u32x2_t __attribute__((ext_vector_type(2)));
    u32x2_t pr[8];
#pragma unroll
    for (int k = 0; k < 8; ++k) pr[k] = (u32x2_t){0u, 0u};
    if (!first) {
#pragma unroll
      for (int k = 0; k < 8; ++k) pr[k] = *(const u32x2_t*)(orow + 32 * (k >> 2) + 8 * (k & 3));
      asm volatile("" : "+v"(pr[0]), "+v"(pr[1]), "+v"(pr[2]), "+v"(pr[3]), "+v"(pr[4]), "+v"(pr[5]), "+v"(pr[6]), "+v"(pr[7]));
    }
#pragma unroll
    for (int dt = 0; dt < 2; ++dt)
#pragma unroll
      for (int q4 = 0; q4 < 4; ++q4) {
        uint2* dst = (uint2*)(orow + 32 * dt + 8 * q4);
        float v0 = o[dt][4 * q4 + 0] * sc, v1 = o[dt][4 * q4 + 1] * sc, v2 = o[dt][4 * q4 + 2] * sc, v3 = o[dt][4 * q4 + 3] * sc;
        if (!first) {
          const u32x2_t u = pr[dt * 4 + q4];
          v0 += lo16(u.x); v1 += hi16(u.x); v2 += lo16(u.y); v3 += hi16(u.y);
        }
        uint2 w;
        w.x = pack2(v0, v1);
        w.y = pack2(v2, v3);
        *dst = w;
      }
  };
  const int ncv_c = (t_c >= 31) ? ((t_c - 31) >> 4) + 1 : 0;
  const int ncv_max = ((t0 + 63 - 31) >> 4) + 1;
  const int nchunk_c = (ncv_max + 63) >> 6;
  {
    const u16* kcb = p.kc + (long)bg * 512 * 64;
    const u16* vcb = p.vcT + (long)bg * 64 * 512;
    float m = -1e30f, l = 0.f;
    auto next_c = [&](int d) { return d + 1 < nchunk_c ? d + 1 : -1; };
    chunk_pipeline<64, 512, false>(stage, kcb, vcb, 0, tid, next_c, [&](int i, const u16* Ks, const u16* Vs) {
      f32x16 acc[2];
      dense_scores(acc, Ks, qf, lane);
      const float mx = dense_mask<16>(acc, true, 0, ncv_c - 1 - i * 64, t_c - 31 - 1024 * i, tw - 31 - 1024 * i - 1008, btab_h, lane);
      const float mn = fmaxf(m, mx);
      float ls = 0.f;
#pragma unroll
      for (int tile = 0; tile < 2; ++tile)
#pragma unroll
        for (int q = 0; q < 16; ++q) ls += __builtin_amdgcn_exp2f(acc[tile][q] - mn);
      ls = x32_sum(ls);
      l = l * __builtin_amdgcn_exp2f(m - mn) + ls;
      m = mn;
    });
    const float invl = 1.f / fmaxf(l, 1e-30f);
    f32x16 oc[2];
#pragma unroll
    for (int i = 0; i < 16; ++i) { oc[0][i] = 0.f; oc[1][i] = 0.f; }
    chunk_pipeline<64, 512, true>(stage, kcb, vcb, 0, tid, next_c, [&](int i, const u16* Ks, const u16* Vs) {
      f32x16 acc[2];
      dense_scores(acc, Ks, qf, lane);
      (void)dense_mask<16>(acc, true, 0, ncv_c - 1 - i * 64, t_c - 31 - 1024 * i, tw - 31 - 1024 * i - 1008, btab_h, lane);
      float part[2][4], spill[2][4];
#pragma unroll
      for (int tile = 0; tile < 2; ++tile) {
#pragma unroll
        for (int q = 0; q < 16; ++q) acc[tile][q] = __builtin_amdgcn_exp2f(acc[tile][q] - m) * invl;
#pragma unroll
        for (int q4 = 0; q4 < 4; ++q4) {
          float pa = acc[tile][4 * q4] + acc[tile][4 * q4 + 1] + acc[tile][4 * q4 + 2] + 0.5f * acc[tile][4 * q4 + 3];
          float sp = 0.5f * acc[tile][4 * q4 + 3];
          pa += DPP_F0(pa, DPP_QP1, 0xF); pa += DPP_F0(pa, DPP_QP2, 0xF);
          sp += DPP_F0(sp, DPP_QP1, 0xF); sp += DPP_F0(sp, DPP_QP2, 0xF);
          part[tile][q4] = pa; spill[tile][q4] = sp;
        }
      }
      if (hh == 0) {
#pragma unroll
        for (int tile = 0; tile < 2; ++tile)
#pragma unroll
          for (int q4 = 0; q4 < 4; ++q4) imps[qi * 132 + 16 * i + 8 * tile + 2 * q4 + hf] += part[tile][q4];
      }
      wave_sync();
      if (hh == 0) {
#pragma unroll
        for (int tile = 0; tile < 2; ++tile)
#pragma unroll
          for (int q4 = 0; q4 < 4; ++q4) imps[qi * 132 + 16 * i + 8 * tile + 2 * q4 + hf + 1] += spill[tile][q4];
      }
      wave_sync();
      dense_pv(acc, Vs, lane, oc);
    });
    emit(oc, bf2f(gptr[0]), true);
  }
  wave_sync();
  u64 my0 = 0, my1 = 0, wu0 = 0, wu1 = 0;
  float4 cva[16], cvb[16];
  const int cw = NTOK + (item * 8 + wid) * 2;
  CONV_ISSUE(p, cw, lane, cva)
  CONV_ISSUE(p, cw + 1, lane, cvb)
  for (int q = 0; q < 8; ++q) {
    u64 mask0, mask1;
    if (cur <= 15) {
      mask0 = (2ull << cur) - 1ull;
      mask1 = 0ull;
    } else {
      const float imp_lo = imps[q * 132 + lane], imp_hi = imps[q * 132 + lane + 64];
      const int jl = lane, jh = lane + 64;
      const int b0 = (jl >= 1 && jl <= cur - 2) ? __float_as_int(imp_lo) : -1;
      const int b1 = (jh <= cur - 2) ? __float_as_int(imp_hi) : -1;
      int thr = 0;
      bool exact = false;
      for (int bit = 30; bit >= 0; --bit) {
        const int cand = thr | (1 << bit);
        const int c = __popcll(__ballot(b0 >= cand)) + __popcll(__ballot(b1 >= cand));
        if (c >= 13) {
          thr = cand;
          if (c == 13) { exact = true; break; }
        }
      }
      u64 g0, g1;
      if (exact) {
        g0 = __ballot(b0 >= thr); g1 = __ballot(b1 >= thr);
      } else {
        g0 = __ballot(b0 > thr); g1 = __ballot(b1 > thr);
        int need = 13 - __popcll(g0) - __popcll(g1);
        u64 e0 = __ballot(b0 == thr), e1 = __ballot(b1 == thr);
        while (need > 0 && e0 != 0ull) { const u64 low = e0 & (~e0 + 1ull); g0 |= low; e0 ^= low; --need; }
        while (need > 0 && e1 != 0ull) { const u64 low = e1 & (~e1 + 1ull); g1 |= low; e1 ^= low; --need; }
      }
      mask0 = g0 | __ballot((jl == 0) || (jl == cur) || (jl == cur - 1));
      mask1 = g1 | __ballot((jh == cur) || (jh == cur - 1));
    }
    if (qi == q) { my0 = mask0; my1 = mask1; }
    wu0 |= mask0; wu1 |= mask1;
  }
  CONV_FINISH(p, cw, lane, cva)
  CONV_FINISH(p, cw + 1, lane, cvb)
  if (lane == 0) { wun[wid * 2] = wu0; wun[wid * 2 + 1] = wu1; }
  __syncthreads();
  u64 bu0 = wun[0] | wun[2] | wun[4] | wun[6] | wun[8] | wun[10] | wun[12] | wun[14];
  u64 bu1 = wun[1] | wun[3] | wun[5] | wun[7] | wun[9] | wun[11] | wun[13] | wun[15];
  bu0 = ((u64)(unsigned)__builtin_amdgcn_readfirstlane((int)(bu0 >> 32)) << 32) | (unsigned)__builtin_amdgcn_readfirstlane((int)bu0);
  bu1 = ((u64)(unsigned)__builtin_amdgcn_readfirstlane((int)(bu1 >> 32)) << 32) | (unsigned)__builtin_amdgcn_readfirstlane((int)bu1);
  {
    float m = -1e30f, l = 0.f;
    f32x16 o[2];
#pragma unroll
    for (int i = 0; i < 16; ++i) { o[0][i] = 0.f; o[1][i] = 0.f; }
    const int kcol = C_KV + 2 * 128 + g * 64;
    auto next_s = [&](int j) {
      ++j;
      if (j < 64) {
        const u64 mm = bu0 & (~0ull << j);
        if (mm) return (int)__builtin_ctzll(mm);
        j = 64;
      }
      if (j >= 128) return -1;
      const u64 mm = bu1 & (~0ull << (j - 64));
      return mm ? 64 + (int)__builtin_ctzll(mm) : -1;
    };
    chunk_pipeline<LDP, T, true>(stage, projb + kcol, p.vts + (long)bg * 64 * T, 0, tid, next_s, [&](int j, const u16* Ks, const u16* Vs) {
      const bool bit = ((j < 64 ? (my0 >> j) : (my1 >> (j - 64))) & 1ull) != 0;
      if (__ballot(bit) != 0ull) {
        const int pos0 = 64 * j;
        dense_chunk(Ks, Vs, bit, 0, t_c - pos0, t_c - pos0, tw - pos0 - 63, qf, btab_h, lane, m, l, o);
      }
    });
    emit(o, bf2f(gptr[1]) / fmaxf(l, 1e-30f), false);
  }
  {
    float m = -1e30f, l = 0.f;
    f32x16 o[2];
#pragma unroll
    for (int i = 0; i < 16; ++i) { o[0][i] = 0.f; o[1][i] = 0.f; }
    const int kcol = C_KV + 4 * 128 + g * 64;
    const int wlo_c = t_c - 511 < 0 ? 0 : t_c - 511;
    const int wlo_min = t0 - 511 < 0 ? 0 : t0 - 511;
    auto next_w = [&](int j) { return j + 1 <= cur ? j + 1 : -1; };
    chunk_pipeline<LDP, T, true>(stage, projb + kcol, p.vtw + (long)bg * 64 * T, wlo_min >> 6, tid, next_w, [&](int jw, const u16* Ks, const u16* Vs) {
      const int pos0 = 64 * jw;
      const int lo_c = wlo_c - pos0 < 0 ? 0 : wlo_c - pos0;
      dense_chunk(Ks, Vs, true, lo_c, t_c - pos0, t_c - pos0, tw - pos0 - 63, qf, btab_h, lane, m, l, o);
    });
    emit(o, bf2f(gptr[2]) / fmaxf(l, 1e-30f), false);
  }
}

DI unsigned f2ord(float v) { const unsigned u = __float_as_uint(v); return (u & 0x80000000u) ? ~u : (u | 0x80000000u); }

DI unsigned pk_subsat_u16_asm(unsigned a, unsigned b) { unsigned r; asm("v_pk_sub_u16 %0, %1, %2 clamp" : "=v"(r) : "v"(a), "v"(b)); return r; }
DI unsigned pk_min_u16_asm(unsigned a, unsigned b) { unsigned r; asm("v_pk_min_u16 %0, %1, %2" : "=v"(r) : "v"(a), "v"(b)); return r; }
typedef short s16x2_t __attribute__((ext_vector_type(2)));
DI unsigned topk_key2(unsigned d) {
  const s16x2_t sg = __builtin_bit_cast(s16x2_t, d) >> 15;
  return d ^ ((__builtin_bit_cast(unsigned, sg) & 0x7FFF7FFFu) | 0x80008000u);
}
DI void topk_row(const Params& p, int b, int t, int lane, int* obuf) {
  const long row = (long)b * T + t;
  int* dst = p.selk + row * 256;
  float4 cv[16];
  if (t < 256) {
    CONV_ISSUE(p, (int)row, lane, cv)
#pragma unroll
    for (int i = 0; i < 4; ++i) { const int s = i * 64 + lane; dst[s] = (s <= t) ? s : -1; }
    CONV_FINISH(p, (int)row, lane, cv)
    return;
  }
  const u16* srow = (const u16*)p.scores + row * T;
  const int ngrp = (t >> 10) + 1;
  typedef unsigned short u16x2_t __attribute__((ext_vector_type(2)));
  unsigned w[64];
  int ln = lane;
  asm volatile("" : "+v"(ln));
#pragma unroll
  for (int gq = 0; gq < 8; ++gq) {
    if (gq < ngrp) {
#pragma unroll
      for (int h = 0; h < 2; ++h) {
        const uint4 x = *(const uint4*)(srow + gq * 1024 + h * 512 + ln * 8);
        w[gq * 8 + h * 4 + 0] = topk_key2(x.x); w[gq * 8 + h * 4 + 1] = topk_key2(x.y);
        w[gq * 8 + h * 4 + 2] = topk_key2(x.z); w[gq * 8 + h * 4 + 3] = topk_key2(x.w);
      }
    } else {
#pragma unroll
      for (int e = 0; e < 8; ++e) w[gq * 8 + e] = 0u;
    }
  }
  CONV_ISSUE(p, (int)row, lane, cv)
  asm volatile("" ::: "memory");
#pragma unroll
  for (int gq = 0; gq < 8; ++gq) {
    if (gq == ngrp - 1) {
#pragma unroll
      for (int e = 0; e < 8; ++e) {
        const int s0 = gq * 1024 + (e >> 2) * 512 + ln * 8 + 2 * (e & 3);
        const unsigned mk = (s0 <= t ? 0x0000FFFFu : 0u) | (s0 + 1 <= t ? 0xFFFF0000u : 0u);
        w[gq * 8 + e] &= mk;
      }
    }
  }
#define PK_MAX(a, b) __builtin_bit_cast(unsigned, __builtin_elementwise_max(__builtin_bit_cast(u16x2_t, (unsigned)(a)), __builtin_bit_cast(u16x2_t, (unsigned)(b))))
#define PK_MIN(a, b) pk_min_u16_asm((unsigned)(a), (unsigned)(b))
#define PK_SUBSAT(a, b) pk_subsat_u16_asm((unsigned)(a), (unsigned)(b))
#define PK_ADD(a, b) __builtin_bit_cast(unsigned, (u16x2_t)(__builtin_bit_cast(u16x2_t, (unsigned)(a)) + __builtin_bit_cast(u16x2_t, (unsigned)(b))))
  unsigned pm0 = 0u, pm1 = 0u, pm2 = 0u, pm3 = 0u;
#pragma unroll
  for (int gq = 0; gq < 8; ++gq) {
    if (gq < ngrp) {
#pragma unroll
      for (int e = 0; e < 8; e += 4) {
        pm0 = PK_MAX(pm0, w[gq * 8 + e]); pm1 = PK_MAX(pm1, w[gq * 8 + e + 1]); pm2 = PK_MAX(pm2, w[gq * 8 + e + 2]); pm3 = PK_MAX(pm3, w[gq * 8 + e + 3]);
      }
    }
  }
  const unsigned a0 = pm0 & 0xFFFFu, b0 = pm0 >> 16, a1 = pm1 & 0xFFFFu, b1 = pm1 >> 16, a2 = pm2 & 0xFFFFu, b2 = pm2 >> 16, a3 = pm3 & 0xFFFFu, b3 = pm3 >> 16;
  const unsigned x0 = max(a0, b0), x1 = max(a1, b1), x2 = max(a2, b2), x3 = max(a3, b3);
  unsigned lo = wave_min_u(min(min(min(a0, b0), min(a1, b1)), min(min(a2, b2), min(a3, b3))));
  unsigned hi = wave_max_u(max(max(x0, x1), max(x2, x3))) + 1u;
  lo = lo < 1u ? 1u : lo;
#define TOPK_COUNT_GE(PIV, OUT)                                                         \
  {                                                                                     \
    const unsigned pv1_ = ((PIV) - 1u) * 0x10001u;     \
    unsigned acc_ = 0u;                                                                 \
    _Pragma("unroll") for (int gq = 0; gq < 8; ++gq) {                                  \
      if (gq < ngrp) {                                                                  \
        _Pragma("unroll") for (int e = 0; e < 8; ++e) acc_ = PK_ADD(acc_, PK_MIN(PK_SUBSAT(w[gq * 8 + e], pv1_), 0x00010001u)); \
      }                                                                                 \
    }                                                                                   \
    OUT = wave_sum_i((int)((acc_ & 0xFFFFu) + (acc_ >> 16)));                           \
  }
  int c_lo, c_hi = 0;
  {
    unsigned piv0 = (unsigned)wave_sum_i((int)(x0 + x1 + x2 + x3)) >> 8;
    piv0 = piv0 <= lo ? lo : (piv0 >= hi ? hi - 1u : piv0);
    if (piv0 > lo) {
      int c0;
      TOPK_COUNT_GE(piv0, c0)
      if (c0 >= 256) { lo = piv0; c_lo = c0; }
      else {
        hi = piv0; c_hi = c0;
        TOPK_COUNT_GE(lo, c_lo)
      }
    } else {
      TOPK_COUNT_GE(lo, c_lo)
    }
  }
  int iter = 0;
  while (c_lo != 256 && hi - lo > 1u) {
    const unsigned span = hi - lo;
    unsigned step;
    if ((++iter & 3) == 0) step = span >> 1;
    else step = (unsigned)((float)span * ((float)(c_lo - 256) / (float)(c_lo - c_hi)));
    step = step < 1u ? 1u : (step > span - 1u ? span - 1u : step);
    const unsigned piv = lo + step;
    int c;
    TOPK_COUNT_GE(piv, c)
    if (c >= 256) { lo = piv; c_lo = c; } else { hi = piv; c_hi = c; }
  }
#undef TOPK_COUNT_GE
  const unsigned thr = lo;
  int ln2 = lane;
  asm volatile("" : "+v"(ln2));
#define TOPK_POS(GQ, E) ((GQ) * 1024 + ((E) >> 2) * 512 + ln2 * 8 + 2 * ((E) & 3))
  if (c_lo == 256) {
    int base = 0;
#pragma unroll
    for (int gq = 0; gq < 8; ++gq) {
      if (gq < ngrp) {
#pragma unroll
        for (int e = 0; e < 8; ++e) {
          const unsigned d = w[gq * 8 + e];
#pragma unroll
          for (int hh = 0; hh < 2; ++hh) {
            const bool ge = (hh ? (d >> 16) : (d & 0xFFFFu)) >= thr;
            const u64 mg = __ballot(ge);
            const int pg = __builtin_amdgcn_mbcnt_hi((unsigned)(mg >> 32), __builtin_amdgcn_mbcnt_lo((unsigned)mg, 0));
            if (ge) obuf[base + pg] = TOPK_POS(gq, e) + hh;
            base += __popcll(mg);
          }
        }
      }
    }
  } else {
    int ngt = 0;
#pragma unroll
    for (int gq = 0; gq < 8; ++gq) {
      if (gq < ngrp) {
#pragma unroll
        for (int e = 0; e < 8; ++e) {
          const unsigned d = w[gq * 8 + e];
          ngt += __popcll(__ballot((d & 0xFFFFu) > thr)) + __popcll(__ballot((d >> 16) > thr));
        }
      }
    }
    int base_gt = 0, base_eq = 0;
    const int need_eq = 256 - ngt;
#pragma unroll
    for (int gq = 0; gq < 8; ++gq) {
      if (gq < ngrp) {
#pragma unroll
        for (int e = 0; e < 8; ++e) {
          const unsigned d = w[gq * 8 + e];
#pragma unroll
          for (int hh = 0; hh < 2; ++hh) {
            const unsigned uv = hh ? (d >> 16) : (d & 0xFFFFu);
            const int s = TOPK_POS(gq, e) + hh;
            const bool gt = uv > thr, eq = uv == thr;
            const u64 mg = __ballot(gt), me = __ballot(eq);
            const int pg = __builtin_amdgcn_mbcnt_hi((unsigned)(mg >> 32), __builtin_amdgcn_mbcnt_lo((unsigned)mg, 0));
            const int pe = __builtin_amdgcn_mbcnt_hi((unsigned)(me >> 32), __builtin_amdgcn_mbcnt_lo((unsigned)me, 0));
            if (gt) obuf[base_gt + pg] = s;
            if (eq && (base_eq + pe) < need_eq) obuf[ngt + base_eq + pe] = s;
            base_gt += __popcll(mg);
            base_eq += __popcll(me);
          }
        }
      }
    }
  }
#undef TOPK_POS
#undef PK_MAX
#undef PK_MIN
#undef PK_SUBSAT
#undef PK_ADD
  wave_sync();
  *(int4*)(dst + lane * 4) = *(const int4*)(obuf + lane * 4);
  CONV_FINISH(p, (int)row, lane, cv)
}

DI void phase6(const Params& p, char* smem, int bid, int nblk);
DI void phase5_nsa8(const Params& p) {
  for (int item = blockIdx.x; item < 512; item += gridDim.x) {
    __syncthreads();
    const int it = item < 256 ? 511 - item : item - 256;
    const int chunk = it >> 2, bgi = it & 3;
    nsa_item(p, g_smem, (bgi << 7) | chunk);
  }
  __syncthreads();
}
DI void phase5(const Params& p, char* smem, int bid, int nblk) {
  hb_sync();
  phase6(p, smem, bid, nblk);
}

DI void tr_read2(unsigned a0, unsigned a1, uint2& r0, uint2& r1) {
  asm volatile("ds_read_b64_tr_b16 %0, %2\n\tds_read_b64_tr_b16 %1, %3\n\ts_waitcnt lgkmcnt(0)" : "=&v"(r0), "=&v"(r1) : "v"(a0), "v"(a1) : "memory");
}
DI void tr_read4(unsigned a0, unsigned a1, unsigned a2, unsigned a3, uint2& r0, uint2& r1, uint2& r2, uint2& r3) {
  asm volatile("ds_read_b64_tr_b16 %0, %4\n\tds_read_b64_tr_b16 %1, %5\n\tds_read_b64_tr_b16 %2, %6\n\tds_read_b64_tr_b16 %3, %7\n\ts_waitcnt lgkmcnt(0)"
               : "=&v"(r0), "=&v"(r1), "=&v"(r2), "=&v"(r3) : "v"(a0), "v"(a1), "v"(a2), "v"(a3) : "memory");
}
DI void dsa_query(const Params& p, u16* Cs, int* sel, const float* btab, int b, int t, int lane) {
  const long row = (long)b * T + t;
  const int lg = lane >> 4, r16 = lane & 15, hh = lane & 7;
  bf16x8 qf[4];
#pragma unroll
  for (int ks = 0; ks < 4; ++ks) {
    bf16x8 z = {0, 0, 0, 0, 0, 0, 0, 0};
    if (r16 < 8) z = *(const bf16x8*)(p.qlat + (row * 8 + r16) * 128 + ks * 32 + lg * 8);
    qf[ks] = z;
  }
  const u16* ckvb = p.ckv + (long)b * T * 128;
  const int nvalid = (t + 1) < 256 ? (t + 1) : 256;
  float m = -1e30f, l = 0.f;
  f32x4 o[8];
#pragma unroll
  for (int ct = 0; ct < 8; ++ct) o[ct] = (f32x4){0.f, 0.f, 0.f, 0.f};
  const unsigned cs_base = (unsigned)(size_t)Cs;
  const int nch = (nvalid + 31) >> 5;
  uint4 gv0, gv1, gv2, gv3, gv4, gv5, gv6, gv7;
  {
    const int4 sv = *(const int4*)(p.selk + row * 256 + lane * 4);
    int4 w;
    w.x = (lane * 4 + 0 >= nvalid || sv.x < 0 || sv.x > t) ? t : sv.x;
    w.y = (lane * 4 + 1 >= nvalid || sv.y < 0 || sv.y > t) ? t : sv.y;
    w.z = (lane * 4 + 2 >= nvalid || sv.z < 0 || sv.z > t) ? t : sv.z;
    w.w = (lane * 4 + 3 >= nvalid || sv.w < 0 || sv.w > t) ? t : sv.w;
    wave_sync();
    *(int4*)(sel + lane * 4) = w;
    wave_sync();
  }
#define DSA_G1(V, I, CH) { const int kr_ = sel[(CH) * 32 + 4 * (I) + lg]; V = *(const uint4*)(ckvb + (long)kr_ * 128 + r16 * 8); }
#define DSA_GATHER(CH)                                                            \
  {                                                                               \
    DSA_G1(gv0, 0, CH) DSA_G1(gv1, 1, CH) DSA_G1(gv2, 2, CH) DSA_G1(gv3, 3, CH) DSA_G1(gv4, 4, CH) DSA_G1(gv5, 5, CH) DSA_G1(gv6, 6, CH) DSA_G1(gv7, 7, CH) \
  }
  DSA_GATHER(0)
  float4 cv[16];
  const bool cvq = (row & 1) == 0;
  const int cwq = NTOK + NTOK / 2 + (int)(row >> 1);
  if (cvq) CONV_ISSUE(p, cwq, lane, cv)
  for (int ch = 0; ch < nch; ++ch) {
    const int nval = (nvalid - ch * 32) > 32 ? 32 : (nvalid - ch * 32);
    wave_sync();
    {
      u16* d_ = Cs + lg * 144 + r16 * 8;
      *(uint4*)(d_) = gv0;            *(uint4*)(d_ + 4 * 144) = gv1;  *(uint4*)(d_ + 8 * 144) = gv2;  *(uint4*)(d_ + 12 * 144) = gv3;
      *(uint4*)(d_ + 16 * 144) = gv4; *(uint4*)(d_ + 20 * 144) = gv5; *(uint4*)(d_ + 24 * 144) = gv6; *(uint4*)(d_ + 28 * 144) = gv7;
    }
    { const int chn = ch + 1 < nch ? ch + 1 : nch - 1; DSA_GATHER(chn) }
    wave_sync();
    f32x4 acc[2];
    typedef int i32x4_t __attribute__((ext_vector_type(4)));
    bf16x8 kf[2][4];
#pragma unroll
    for (int rt = 0; rt < 2; ++rt)
#pragma unroll
      for (int ks = 0; ks < 4; ++ks) kf[rt][ks] = *(const bf16x8*)(Cs + (16 * rt + r16) * 144 + 8 * lg + 32 * ks);
    i32x4_t kq0 = *(const i32x4_t*)(sel + ch * 32 + 4 * lg), kq1 = *(const i32x4_t*)(sel + ch * 32 + 16 + 4 * lg);
    asm volatile("" : "+v"(kf[0][0]), "+v"(kf[0][1]), "+v"(kf[0][2]), "+v"(kf[0][3]), "+v"(kf[1][0]), "+v"(kf[1][1]), "+v"(kf[1][2]), "+v"(kf[1][3]),
                      "+v"(kq0), "+v"(kq1));
    float bs[8];
#pragma unroll
    for (int e = 0; e < 8; ++e) {
      const int kk = e < 4 ? kq0[e & 3] : kq1[e & 3];
      int dc = t - kk;
      dc = dc < 0 ? 0 : (dc > 128 ? 128 : dc);
      bs[e] = btab[hh * 132 + dc];
    }
#pragma unroll
    for (int rt = 0; rt < 2; ++rt) {
      f32x4 c = {0.f, 0.f, 0.f, 0.f};
#pragma unroll
      for (int ks = 0; ks < 4; ++ks) c = MFMA16(kf[rt][ks], qf[ks], c);
      acc[rt] = c;
    }
    asm volatile("" : "+v"(bs[0]), "+v"(bs[1]), "+v"(bs[2]), "+v"(bs[3]), "+v"(bs[4]), "+v"(bs[5]), "+v"(bs[6]), "+v"(bs[7]));
    float mx = -INFINITY;
#pragma unroll
    for (int rt = 0; rt < 2; ++rt)
#pragma unroll
      for (int r = 0; r < 4; ++r) {
        const int pl = 16 * rt + 4 * lg + r;
        const float sv = (pl < nval) ? fmaf(acc[rt][r], LOG2E, bs[rt * 4 + r]) : -INFINITY;
        acc[rt][r] = sv;
        mx = fmaxf(mx, sv);
      }
    mx = x16_max(mx);
    mx = x32_max(mx);
    const float mn = fmaxf(m, mx);
    const float alpha = __builtin_amdgcn_exp2f(m - mn);
    float ls = 0.f;
#pragma unroll
    for (int rt = 0; rt < 2; ++rt)
#pragma unroll
      for (int r = 0; r < 4; ++r) {
        const float pv = __builtin_amdgcn_exp2f(acc[rt][r] - mn);
        acc[rt][r] = pv;
        ls += pv;
      }
    ls = x16_sum(ls);
    ls = x32_sum(ls);
    l = l * alpha + ls;
    m = mn;
    uint4 pw;
    pw.x = pack2(acc[0][0], acc[0][1]);
    pw.y = pack2(acc[0][2], acc[0][3]);
    pw.z = pack2(acc[1][0], acc[1][1]);
    pw.w = pack2(acc[1][2], acc[1][3]);
    const bf16x8 pb = __builtin_bit_cast(bf16x8, pw);
    const unsigned a_lo = cs_base + (unsigned)(((4 * lg + (r16 >> 2)) * 144 + 4 * (r16 & 3)) * 2);
    const unsigned a_hi = a_lo + 16 * 144 * 2;
#pragma unroll
    for (int ct = 0; ct < 8; ct += 2) {
      uint2 lo0, hi0, lo1, hi1;
      tr_read4(a_lo + ct * 32, a_hi + ct * 32, a_lo + ct * 32 + 32, a_hi + ct * 32 + 32, lo0, hi0, lo1, hi1);
      uint4 aw0, aw1;
      aw0.x = lo0.x; aw0.y = lo0.y; aw0.z = hi0.x; aw0.w = hi0.y;
      aw1.x = lo1.x; aw1.y = lo1.y; aw1.z = hi1.x; aw1.w = hi1.y;
      o[ct] = o[ct] * alpha;
      o[ct + 1] = o[ct + 1] * alpha;
      o[ct] = MFMA16(__builtin_bit_cast(bf16x8, aw0), pb, o[ct]);
      o[ct + 1] = MFMA16(__builtin_bit_cast(bf16x8, aw1), pb, o[ct + 1]);
    }
  }
#undef DSA_GATHER
#undef DSA_G1
  if (cvq) CONV_FINISH(p, cwq, lane, cv)
  const float invl = 1.f / fmaxf(l, 1e-30f);
  if (r16 < 8) {
#pragma unroll
    for (int ct = 0; ct < 8; ++ct)
      *(uint2*)(p.olat + row * 1024 + r16 * 128 + 16 * ct + 4 * lg) = pack4(o[ct][0] * invl, o[ct][1] * invl, o[ct][2] * invl, o[ct][3] * invl);
  }
}
DI void phase6(const Params& p, char* smem, int bid, int nblk) {
  const int tid = TIDX(), lane = tid & 63, wid = __builtin_amdgcn_readfirstlane(tid >> 6);
  float* btab = (float*)smem;
  u16* Cs = (u16*)(smem + 8192) + wid * (32 * 144);
  int* sel = (int*)(smem + 8192 + 4 * 32 * 144 * 2) + wid * 256;
  for (int idx = tid; idx < 8 * 129; idx += 256) {
    const int h = idx / 129, d = idx % 129;
    const int bk = d < 128 ? BUCKET[d] : 31;
    btab[h * 132 + d] = p.rel_bias[bk * 16 + 8 + h] * LOG2E;
  }
  hb_sync();
  for (int item = bid; item < 2048; item += nblk) {
    const int it = item < 1024 ? 2047 - item : item - 1024;
    const int b = it & 1, tb = it >> 1;
    for (int q = 0; q < 2; ++q) dsa_query(p, Cs, sel, btab, b, tb * 8 + wid * 2 + q, lane);
  }
}

struct EpiOdsa {
  u16* odsa; int h, m0;
  DI void operator()(f32x16 (&acc)[2][2], int wm, int wn, int lane) const {
    constexpr int MT = 2;
    SW_FOR {
      const int r = m0 + SW_R, c = SW_C0;
      if (c < 64) *(uint2*)(odsa + (long)r * 512 + h * 64 + c) = pack4(SW_V(0), SW_V(1), SW_V(2), SW_V(3));
    }
  }
};
DI void phase7(const Params& p, char* smem, int bid, int nblk) {
  for (int item = bid; item < 1024; item += nblk) {
    const int h = item & 7, mt_ = item >> 3;
    ARows af{p.olat + (long)mt_ * 128 * 1024 + h * 128, 1024, 128};
    BMat bf{p.dsa_w_uv + h * 64, 512, 64};
    EpiOdsa ef{p.odsa, h, mt_ * 128};
    gemm_tile(smem, 2, 64, af, bf, ef);
  }
}

struct EpiY {
  u16* y; const u16* proj; int m0, n0, second;
  template <int MT> DI void operator()(f32x16 (&acc)[MT][2], int wm, int wn, int lane) const {
    SW_FOR {
      const int r = m0 + SW_R, c = n0 + SW_C0;
      const uint2 gu = *(const uint2*)(proj + (long)r * LDP + C_GM + second * 1024 + c);
      float v0 = lo16(gu.x) * SW_V(0), v1 = hi16(gu.x) * SW_V(1), v2 = lo16(gu.y) * SW_V(2), v3 = hi16(gu.y) * SW_V(3);
      uint2* dst = (uint2*)(y + (long)r * 1024 + c);
      if (second) {
        const uint2 yu = *dst;
        v0 += lo16(yu.x); v1 += hi16(yu.x); v2 += lo16(yu.y); v3 += hi16(yu.y);
      }
      *dst = pack4(v0, v1, v2, v3);
    }
  }
};
typedef unsigned u32x2_t __attribute__((ext_vector_type(2)));
struct Epi8Y {
  u16* y; const u16* proj; int m0, n0, second;
  static constexpr bool kBatched = true;
  DI void load(int q, int c, u32x2_t& gu, u32x2_t& yu) const {
    const long r = m0 + q; const int cc = n0 + c;
    gu = *(const u32x2_t*)(proj + r * LDP + C_GM + second * 1024 + cc);
    yu = (u32x2_t){0u, 0u};
    if (second) yu = *(const u32x2_t*)(y + r * 1024 + cc);
  }
  DI void apply(int q, int c, float v0, float v1, float v2, float v3, const u32x2_t& gu, const u32x2_t& yu) const {
    const long r = m0 + q; const int cc = n0 + c;
    v0 *= lo16(gu.x); v1 *= hi16(gu.x); v2 *= lo16(gu.y); v3 *= hi16(gu.y);
    if (second) { v0 += lo16(yu.x); v1 += hi16(yu.x); v2 += lo16(yu.y); v3 += hi16(yu.y); }
    *(uint2*)(y + r * 1024 + cc) = pack4(v0, v1, v2, v3);
  }
};
DI void phase8_8w(const Params& p, int wg, int nwg) {
  for (int item = wg; item < 256; item += nwg) {
    const int x_ = item & 7, s_ = item >> 3, nt_ = s_ & 3, mt_ = x_ * 8 + (s_ >> 2);
    {
      ARows wf{p.w_bnT + (long)nt_ * 256 * 512, 512, 256};
      ARows xf{p.onsa + (long)mt_ * 256 * 512, 512, 256};
      Epi8Y ef{p.y, p.proj, mt_ * 256, nt_ * 256, 0};
      gemm8p<false, true>(8, wf, xf, ef);
    }
    {
      ARows wf{p.w_bdT + (long)nt_ * 256 * 512, 512, 256};
      ARows xf{p.odsa + (long)mt_ * 256 * 512, 512, 256};
      Epi8Y ef{p.y, p.proj, mt_ * 256, nt_ * 256, 1};
      gemm8p<false, true>(8, wf, xf, ef);
    }
  }
}
struct EpiStoreBf {
  u16* dst; long ld; int m0, n0;
  template <int MT> DI void operator()(f32x16 (&acc)[MT][2], int wm, int wn, int lane) const {
    SW_FOR { *(uint2*)(dst + (long)(m0 + SW_R) * ld + n0 + SW_C0) = pack4(SW_V(0), SW_V(1), SW_V(2), SW_V(3)); }
  }
};
struct Epi8StoreBf {
  u16* dst; long ld; int m0, n0;
  DI void operator()(int q, int c, float v0, float v1, float v2, float v3) const { *(uint2*)(dst + (long)(m0 + q) * ld + n0 + c) = pack4(v0, v1, v2, v3); }
};
DI void phase9_8w(const Params& p, int wg, int nwg) {
  for (int item = wg; item < 256; item += nwg) {
    const int x_ = item & 7, s_ = item >> 3, nt_ = s_ & 3, mt_ = x_ * 8 + (s_ >> 2);
    ARows wf{p.w_outT + (long)nt_ * 256 * 1024, 1024, 256};
    ARows xf{p.y + (long)mt_ * 256 * 1024, 1024, 256};
    Epi8StoreBf ef{p.z, 1024, mt_ * 256, nt_ * 256};
    gemm8p(16, wf, xf, ef);
  }
}

DI void phase10(const Params& p, int bid, int nblk) {
  const int tid = TIDX(), lane = tid & 63, wid = __builtin_amdgcn_readfirstlane(tid >> 6);
  const int b = bid & 1;
  const float* modb = p.mod + b * 6144;
  float cz[16], cm[16], ca[16];
#pragma unroll
  for (int i = 0; i < 4; ++i) {
    const int col = i * 256 + lane * 4;
    const float4 gt = *(const float4*)(modb + 2048 + col), gp = *(const float4*)(p.g_post_mix + col);
    const float4 gf = *(const float4*)(p.g_pre_ffn + col), sc = *(const float4*)(modb + 4096 + col), sh = *(const float4*)(modb + 3072 + col);
    cz[i * 4 + 0] = gt.x * gp.x; cz[i * 4 + 1] = gt.y * gp.y; cz[i * 4 + 2] = gt.z * gp.z; cz[i * 4 + 3] = gt.w * gp.w;
    cm[i * 4 + 0] = gf.x * (1.f + sc.x); cm[i * 4 + 1] = gf.y * (1.f + sc.y); cm[i * 4 + 2] = gf.z * (1.f + sc.z); cm[i * 4 + 3] = gf.w * (1.f + sc.w);
    ca[i * 4 + 0] = sh.x; ca[i * 4 + 1] = sh.y; ca[i * 4 + 2] = sh.z; ca[i * 4 + 3] = sh.w;
  }
  const int stride = (nblk >> 1) * 4;
  for (int t0 = (bid >> 1) * 4 + wid; t0 < T; t0 += 2 * stride) {
    uint2 zu[2][4]; float4 xx[2][4];
#pragma unroll
    for (int k = 0; k < 2; ++k) {
      const int t = t0 + k * stride < T ? t0 + k * stride : T - 1;
      const long row = (long)b * T + t;
#pragma unroll
      for (int i = 0; i < 4; ++i) {
        zu[k][i] = *(const uint2*)(p.z + row * 1024 + i * 256 + lane * 4);
        xx[k][i] = *(const float4*)(p.x + row * 1024 + i * 256 + lane * 4);
      }
    }
#pragma unroll
    for (int k = 0; k < 2; ++k) {
      float zv[16], xv[16];
      float ss = 0.f;
#pragma unroll
      for (int i = 0; i < 4; ++i) {
        zv[i * 4 + 0] = lo16(zu[k][i].x); zv[i * 4 + 1] = hi16(zu[k][i].x); zv[i * 4 + 2] = lo16(zu[k][i].y); zv[i * 4 + 3] = hi16(zu[k][i].y);
        xv[i * 4 + 0] = xx[k][i].x; xv[i * 4 + 1] = xx[k][i].y; xv[i * 4 + 2] = xx[k][i].z; xv[i * 4 + 3] = xx[k][i].w;
#pragma unroll
        for (int j = 0; j < 4; ++j) ss += zv[i * 4 + j] * zv[i * 4 + j];
      }
      ss = wave_sum(ss);
      const float r = rsqrtf(ss * (1.f / 1024.f) + 1e-6f);
      float ss2 = 0.f;
#pragma unroll
      for (int j = 0; j < 16; ++j) {
        const float v = xv[j] + cz[j] * (zv[j] * r);
        xv[j] = v;
        ss2 += v * v;
      }
      ss2 = wave_sum(ss2);
      const float r2 = rsqrtf(ss2 * (1.f / 1024.f) + 1e-6f);
      if (t0 + k * stride < T) {
        const long row = (long)b * T + t0 + k * stride;
#pragma unroll
        for (int i = 0; i < 4; ++i) {
          const int col = i * 256 + lane * 4;
          *(float4*)(p.x1 + row * 1024 + col) = make_float4(xv[i * 4], xv[i * 4 + 1], xv[i * 4 + 2], xv[i * 4 + 3]);
          *(uint2*)(p.h + row * 1024 + col) = pack4(xv[i * 4] * r2 * cm[i * 4] + ca[i * 4], xv[i * 4 + 1] * r2 * cm[i * 4 + 1] + ca[i * 4 + 1],
                                                    xv[i * 4 + 2] * r2 * cm[i * 4 + 2] + ca[i * 4 + 2], xv[i * 4 + 3] * r2 * cm[i * 4 + 3] + ca[i * 4 + 3]);
        }
      }
    }
  }
}

struct EpiStoreF32 {
  float* dst; long ld; int m0, n0;
  DI void operator()(f32x16 (&acc)[2][2], int wm, int wn, int lane) const {
    constexpr int MT = 2;
    SW_FOR { *(float4*)(dst + (long)(m0 + SW_R) * ld + n0 + SW_C0) = make_float4(SW_V(0), SW_V(1), SW_V(2), SW_V(3)); }
  }
};
DI void phase11(const Params& p, char* smem, int bid, int nblk) {
  for (int item = bid; item < 256; item += nblk) {
    const int nt_ = item & 1, mt_ = item >> 1;
    ARows af{p.h + (long)mt_ * 128 * 1024, 1024, 128};
    BMatT bf{p.routerT + (long)nt_ * 128 * 1024, 1024};
    EpiStoreF32 ef{p.logits, 256, mt_ * 128, nt_ * 128};
    gemm_tile<true, false, true>(smem, 16, 64, af, bf, ef);
  }
}
DI void phase12(const Params& p, int bid, int nblk) {
  const int tid = TIDX(), lane = tid & 63, wid = __builtin_amdgcn_readfirstlane(tid >> 6);
  const float4 rbv = *(const float4*)(p.router_bias + lane * 4);
  const int tok0 = bid * 4 + wid, tstep = nblk * 4;
  float4 lg_n = *(const float4*)(p.logits + (long)(tok0 < NTOK ? tok0 : 0) * 256 + lane * 4);
  for (int tok = tok0; tok < NTOK; tok += tstep) {
    const float4 lg = lg_n;
    {
      const int tn = tok + tstep < NTOK ? tok + tstep : tok;
      lg_n = *(const float4*)(p.logits + (long)tn * 256 + lane * 4);
    }
    float sg[4] = {sigmoidf(lg.x), sigmoidf(lg.y), sigmoidf(lg.z), sigmoidf(lg.w)};
    float sl[4] = {sg[0] + rbv.x, sg[1] + rbv.y, sg[2] + rbv.z, sg[3] + rbv.w};
    float t1 = fmaxf(sl[0], sl[1]), t2 = fminf(sl[0], sl[1]);
#pragma unroll
    for (int j = 2; j < 4; ++j) {
      const float v = sl[j];
      t2 = fmaxf(t2, fminf(t1, v));
      t1 = fmaxf(t1, v);
    }
#define R_MERGE(CTRL)                                                                                                            \
    {                                                                                                                            \
      const float a1 = __int_as_float(__builtin_amdgcn_update_dpp(0, __float_as_int(t1), CTRL, 0xF, 0xF, true));                 \
      const float a2 = __int_as_float(__builtin_amdgcn_update_dpp(0, __float_as_int(t2), CTRL, 0xF, 0xF, true));                 \
      const float n1 = fmaxf(t1, a1);                                                                                            \
      const float n2 = fmaxf(fminf(t1, a1), fmaxf(t2, a2));                                                                      \
      t1 = n1; t2 = n2;                                                                                                          \
    }
    R_MERGE(DPP_QP1) R_MERGE(DPP_QP2) R_MERGE(DPP_RHM)
#undef R_MERGE
    const float gscore = t1 + t2;
    const int grp = lane >> 3;
    int rank = 0;
#pragma unroll
    for (int g2 = 0; g2 < 8; ++g2) {
      const float og = rdlane(gscore, g2 * 8);
      rank += (og > gscore || (og == gscore && g2 < grp)) ? 1 : 0;
    }
    const bool gsel = rank < 4;
    float cv[4];
#pragma unroll
    for (int j = 0; j < 4; ++j) cv[j] = gsel ? sl[j] : -1e30f;
    int my_e = -1; float my_s = 0.f; float ssum = 0.f;
    for (int r = 0; r < 8; ++r) {
      float bv = cv[0]; int bj = 0;
#pragma unroll
      for (int j = 1; j < 4; ++j) if (cv[j] > bv) { bv = cv[j]; bj = j; }
      int be = lane * 4 + bj;
      wave_argmax(bv, be);
      const int wl_ = be >> 2, wj = be & 3;
      const float s0 = rdlane(sg[0], wl_), s1 = rdlane(sg[1], wl_), s2 = rdlane(sg[2], wl_), s3 = rdlane(sg[3], wl_);
      const float bs = wj == 0 ? s0 : (wj == 1 ? s1 : (wj == 2 ? s2 : s3));
      if (wl_ == lane) {
        if (wj == 0) cv[0] = -3e30f; else if (wj == 1) cv[1] = -3e30f; else if (wj == 2) cv[2] = -3e30f; else cv[3] = -3e30f;
      }
      if (lane == r) { my_e = be; my_s = bs; }
      ssum += bs;
    }
    if (lane < 8) {
      const float w = my_s / ssum * 2.5f;
      const int rk = atomicAdd(p.counts + my_e * 32, 1);
      p.eidx[tok * 8 + lane] = my_e;
      p.ewt[tok * 8 + lane] = w;
      p.erank[tok * 8 + lane] = rk;
    }
  }
}
DI void phase14(const Params& p, char* smem, int bid, int nblk) {
  const int tid = TIDX();
  int* s_cnt = (int*)smem;
  int* s_off = s_cnt + 256;
  const int cnt = p.counts[tid * 32];
  s_cnt[tid] = cnt;
  hb_sync();
  int run = 0, nt2 = 0;
  for (int e = 0; e < tid; ++e) { const int c = s_cnt[e]; run += c; nt2 += (c + 255) >> 8; }
  s_off[tid] = run;
  hb_sync();
  if (bid == 0) {
    p.offs[tid] = run;
    for (int m = 0; m * 256 < cnt; ++m) {
      p.tile2_e[nt2] = tid;
      p.tile2_r0[nt2] = run + m * 256;
      p.tile2_nr[nt2] = (cnt - m * 256) > 256 ? 256 : (cnt - m * 256);
      ++nt2;
    }
    int* s_tot = s_off + 256;
    if (tid == 255) { p.offs[256] = run + cnt; s_tot[0] = nt2; }
    hb_sync();
    const int base2 = s_tot[0];
    if (tid < 64) {
      p.tile2_e[base2 + tid] = 256;
      p.tile2_r0[base2 + tid] = 131072 + tid * 256;
      p.tile2_nr[base2 + tid] = 256;
    }
    if (tid == 0) p.ntiles[1] = base2 + 64;
  }
  for (int i = bid * 256 + tid; i < NSLOT; i += nblk * 256) {
    if (i < 131072) {
      const int e = p.eidx[i];
      const int slot = s_off[e] + p.erank[i];
      p.slot_tok[slot] = i >> 3;
      p.slot_wt[slot] = p.ewt[i];
      p.tok_slot[i] = slot;
    } else {
      p.slot_tok[i] = i - 131072;
      p.slot_wt[i] = 1.f;
    }
  }
}

struct AGather {
  const u16* h; const int* slot_tok; int r0, nr;
  DI const u16* operator()(int r) const { return h + (long)slot_tok[r0 + (r < nr ? r : 0)] * 1024; }
  DI const u16* origin() const { return h; } DI int off(int r) const { return slot_tok[r0 + (r < nr ? r : 0)] * 1024; }
};
struct BGateUp {
  const float* wg; long udiff; long ldb; int n0;
  DI const float* operator()(int c4) const {
    const int wn = c4 >> 6, ntl = (c4 >> 5) & 1, j = c4 & 31;
    return wg + (long)ntl * udiff + n0 + wn * 32 + j;
  }
  DI const u16* row(int) const { return nullptr; }
};
struct EpiH {
  u16* H; int r0, nr, n0;
  template <int MT> DI void operator()(f32x16 (&acc)[MT][2], int wm, int wn, int lane) const {
#pragma unroll
    for (int mt = 0; mt < MT; ++mt) {
      const int r = SW_R;
      if (r < nr) {
#pragma unroll
        for (int q4 = 0; q4 < 4; ++q4) {
          float v[4];
#pragma unroll
          for (int j = 0; j < 4; ++j) v[j] = siluf(acc[mt][0][4 * q4 + j]) * acc[mt][1][4 * q4 + j];
          *(uint2*)(H + (long)(r0 + r) * 256 + n0 + wn * 32 + 8 * q4 + 4 * (lane >> 5)) = pack4(v[0], v[1], v[2], v[3]);
        }
      }
    }
  }
};
struct BGateUp8 {
  const float* wg; long udiff; long ldb; int n0;
  DI const float* operator()(int c4) const {
    const int wn = c4 >> 6, ntl = (c4 >> 5) & 1, j = c4 & 31;
    return wg + (long)ntl * udiff + n0 + wn * 32 + j;
  }
};
struct WRowsGU { const u16* base; int rg, ru; DI const u16* origin() const { return base; } DI int off(int r) const { return ((r < 128 ? rg : ru) + (r & 127)) * 1024; } };
struct Epi8H {
  u16* H; int r0, nr, n0;
  DI void operator()(int q, int c, const f32x4& g, const f32x4& u) const {
    if (q < nr) *(uint2*)(H + (long)(r0 + q) * 256 + n0 + c) = pack4(siluf(g[0]) * u[0], siluf(g[1]) * u[1], siluf(g[2]) * u[2], siluf(g[3]) * u[3]);
  }
};
DI void phase15_8w(const Params& p, int wg, int nwg) {
  const int ntl = p.ntiles[1];
  const int nit = ntl * 2, nrounds = (nit + 255) >> 8;
  const bool split_last = nit - (nrounds - 1) * 256 <= 128;
  for (int i = wg; i < nrounds * 256; i += nwg) {
    const int rnd = i >> 8, x_ = i & 7, s_ = (i >> 3) & 31;
    const bool halved = split_last && rnd == nrounds - 1;
    const int item = halved ? (rnd << 8) + ((x_ & 3) << 5) + s_ : (((rnd << 3) + x_) << 5) + s_;
    if (item >= nit) continue;
    const int ti = item >> 1, nt_ = item & 1;
    const int e = p.tile2_e[ti];
    int r0 = p.tile2_r0[ti], nr = p.tile2_nr[ti];
    WRowsGU wf{p.w_guT, e * 256 + nt_ * 128, (257 + e) * 256 + nt_ * 128};
    if (!halved) {
      AGather xf{p.h, p.slot_tok, r0, nr};
      Epi8H ef{p.H, r0, nr, nt_ * 128};
      gemm8p<true>(16, wf, xf, ef);
    } else {
      const int hq = x_ >> 2;
      r0 += hq * 128; nr -= hq * 128;
      if (nr <= 0) continue;
      if (nr > 128) nr = 128;
      AGather xf{p.h, p.slot_tok, r0, nr};
      Epi8H ef{p.H, r0, nr, nt_ * 128};
      gemm8p<true, false, true>(16, wf, xf, ef);
    }
  }
}
struct EpiYexp {
  u16* Y; const float* slot_wt; int r0, nr, n0;
  template <int MT> DI void operator()(f32x16 (&acc)[MT][2], int wm, int wn, int lane) const {
    float wts[MT];
#pragma unroll
    for (int mt = 0; mt < MT; ++mt) { const int r = SW_R; wts[mt] = slot_wt[r0 + (r < nr ? r : 0)]; }
#pragma unroll
    for (int mt = 0; mt < MT; ++mt) {
      const int r = SW_R;
      if (r < nr) {
        const float w = wts[mt];
#pragma unroll
        for (int nt = 0; nt < 2; ++nt)
#pragma unroll
          for (int q4 = 0; q4 < 4; ++q4)
            *(uint2*)(Y + (long)(r0 + r) * 1024 + n0 + SW_C0) = pack4(SW_V(0) * w, SW_V(1) * w, SW_V(2) * w, SW_V(3) * w);
      }
    }
  }
};
DI void phase16_8w(const Params& p, int wg, int nwg) {
  const int ntl = p.ntiles[1];
  const int nit = ntl * 4, nrounds = (nit + 255) >> 8;
  for (int i = wg; i < nrounds * 256; i += nwg) {
    const int item = ((((i >> 8) << 3) + (i & 7)) << 5) + ((i >> 3) & 31);
    if (item >= nit) continue;
    const int ti = item >> 2, nt_ = item & 3;
    const int e = p.tile2_e[ti], r0 = p.tile2_r0[ti], nr = p.tile2_nr[ti];
    ARows af{p.H + (long)r0 * 256, 256, nr};
    const float* wd = e < 256 ? p.w_ed + (long)e * 256 * 1024 : p.w_sd;
    BMat bf{wd + nt_ * 256, 1024, 256};
    EpiYexp ef{p.Y, p.slot_wt, r0, nr, nt_ * 256};
    gemm8w<false>(4, af, bf, ef);
  }
}
DI void phase17(const Params& p, int bid, int nblk) {
  const int tid = TIDX(), lane = tid & 63, wid = __builtin_amdgcn_readfirstlane(tid >> 6);
  const int b = bid & 1;
  const float* modb = p.mod + b * 6144;
  float cy[16];
#pragma unroll
  for (int i = 0; i < 4; ++i) {
    const int col = i * 256 + lane * 4;
    const float4 gt = *(const float4*)(modb + 5120 + col), gp = *(const float4*)(p.g_post_ffn + col);
    cy[i * 4 + 0] = gt.x * gp.x; cy[i * 4 + 1] = gt.y * gp.y; cy[i * 4 + 2] = gt.z * gp.z; cy[i * 4 + 3] = gt.w * gp.w;
  }
  const int stride = (nblk >> 1) * 4;
  for (int t0 = (bid >> 1) * 4 + wid; t0 < T; t0 += 2 * stride) {
    long rows[2];
    int slots[2][8];
#pragma unroll
    for (int k = 0; k < 2; ++k) {
      const int t = t0 + k * stride < T ? t0 + k * stride : T - 1;
      rows[k] = (long)b * T + t;
      const int4 s0 = *(const int4*)(p.tok_slot + rows[k] * 8), s1 = *(const int4*)(p.tok_slot + rows[k] * 8 + 4);
      slots[k][0] = s0.x; slots[k][1] = s0.y; slots[k][2] = s0.z; slots[k][3] = s0.w;
      slots[k][4] = s1.x; slots[k][5] = s1.y; slots[k][6] = s1.z; slots[k][7] = s1.w;
    }
    float4 xx[2][4];
#pragma unroll
    for (int k = 0; k < 2; ++k)
#pragma unroll
      for (int i = 0; i < 4; ++i) xx[k][i] = *(const float4*)(p.x1 + rows[k] * 1024 + i * 256 + lane * 4);
#pragma unroll
    for (int k = 0; k < 2; ++k) {
      float yv[16];
#pragma unroll
      for (int j = 0; j < 16; ++j) yv[j] = 0.f;
#pragma unroll
      for (int q = 0; q < 9; ++q) {
        const long sl = q < 8 ? (long)slots[k][q] : 131072 + rows[k];
#pragma unroll
        for (int i = 0; i < 4; ++i) {
          const uint2 u = *(const uint2*)(p.Y + sl * 1024 + i * 256 + lane * 4);
          yv[i * 4 + 0] += lo16(u.x); yv[i * 4 + 1] += hi16(u.x); yv[i * 4 + 2] += lo16(u.y); yv[i * 4 + 3] += hi16(u.y);
        }
      }
      float ss = 0.f;
#pragma unroll
      for (int j = 0; j < 16; ++j) ss += yv[j] * yv[j];
      ss = wave_sum(ss);
      const float r = rsqrtf(ss * (1.f / 1024.f) + 1e-6f);
      if (t0 + k * stride < T) {
#pragma unroll
        for (int i = 0; i < 4; ++i) {
          const int col = i * 256 + lane * 4;
          *(float4*)(p.out + rows[k] * 1024 + col) = make_float4(xx[k][i].x + cy[i * 4] * (yv[i * 4] * r), xx[k][i].y + cy[i * 4 + 1] * (yv[i * 4 + 1] * r),
                                                                 xx[k][i].z + cy[i * 4 + 2] * (yv[i * 4 + 2] * r), xx[k][i].w + cy[i * 4 + 3] * (yv[i * 4 + 3] * r));
        }
      }
    }
  }
}

__global__ void __launch_bounds__(512, 2) mega(Params p) {
  cg::grid_group grid = cg::this_grid();
  const int vb = __builtin_amdgcn_readfirstlane((int)(threadIdx.x >> 8));
  char* smem = g_smem + vb * HALF_LDS;
  const int bid = blockIdx.x * 2 + vb, nblk = gridDim.x * 2;
  if (p.phase_hi == 12345) grid.sync();
  if (threadIdx.x < 32) ((unsigned*)(g_smem + 2 * HALF_LDS))[threadIdx.x] = 0u;
  __syncthreads();
  const XcdBarrier xb = xcd_barrier_post(p.bar, (volatile LAS unsigned*)(g_smem + 2 * HALF_LDS));
#if !defined(ONLY) || ONLY==0
  if (p.phase_lo <= 0 && 0 < p.phase_hi) {
    phase0(p, smem, bid, nblk);
#if (REPEAT_MASK >> 0) & 1
    xcd_barrier(xb);
    phase0(p, smem, bid, nblk);
#endif
    if (0 + 1 < p.phase_hi) xcd_barrier(xb);
  }
#endif
#if !defined(ONLY) || ONLY==1
  if (p.phase_lo <= 1 && 1 < p.phase_hi) {
    phase1(p, smem, bid, nblk);
#if (REPEAT_MASK >> 1) & 1
    xcd_barrier(xb);
    phase1(p, smem, bid, nblk);
#endif
    if (1 + 1 < p.phase_hi) xcd_barrier(xb);
  }
#endif
#if !defined(ONLY) || ONLY==2
  if (p.phase_lo <= 2 && 2 < p.phase_hi) {
    phase2_8w(p, blockIdx.x, gridDim.x);
    __syncthreads();
    phase2(p, smem, bid, nblk);
#if (REPEAT_MASK >> 2) & 1
    xcd_barrier(xb);
    phase2_8w(p, blockIdx.x, gridDim.x);
    __syncthreads();
    phase2(p, smem, bid, nblk);
#endif
    if (2 + 1 < p.phase_hi) xcd_barrier(xb);
  }
#endif
#if !defined(ONLY) || ONLY==3
  if (p.phase_lo <= 3 && 3 < p.phase_hi) {
    phase3(p, smem, bid, nblk);
#if (REPEAT_MASK >> 3) & 1
    xcd_barrier(xb);
    phase3(p, smem, bid, nblk);
#endif
    if (3 + 1 < p.phase_hi) xcd_barrier(xb);
  }
#endif
#if !defined(ONLY) || ONLY==4
  if (p.phase_lo <= 4 && 4 < p.phase_hi) {
    phase4(p, smem, bid, nblk);
#if (REPEAT_MASK >> 4) & 1
    xcd_barrier(xb);
    phase4(p, smem, bid, nblk);
#endif
    if (4 + 1 < p.phase_hi) xcd_barrier(xb);
  }
#endif
#if !defined(ONLY) || ONLY==5
  if (p.phase_lo <= 5 && 5 < p.phase_hi) {
    phase5_nsa8(p);
    phase5(p, smem, bid, nblk);
#if (REPEAT_MASK >> 5) & 1
    xcd_barrier(xb);
    phase5_nsa8(p);
    phase5(p, smem, bid, nblk);
#endif
    if (5 + 1 < p.phase_hi) xcd_barrier(xb);
  }
#endif
#if !defined(ONLY) || ONLY==7
  if (p.phase_lo <= 7 && 7 < p.phase_hi) {
    phase7(p, smem, bid, nblk);
#if (REPEAT_MASK >> 7) & 1
    xcd_barrier(xb);
    phase7(p, smem, bid, nblk);
#endif
    if (7 + 1 < p.phase_hi) xcd_barrier(xb);
  }
#endif
#if !defined(ONLY) || ONLY==8
  if (p.phase_lo <= 8 && 8 < p.phase_hi) {
    phase8_8w(p, blockIdx.x, gridDim.x);
#if (REPEAT_MASK >> 8) & 1
    xcd_barrier(xb);
    phase8_8w(p, blockIdx.x, gridDim.x);
#endif
    if (8 + 1 < p.phase_hi) xcd_barrier(xb);
  }
#endif
#if !defined(ONLY) || ONLY==9
  if (p.phase_lo <= 9 && 9 < p.phase_hi) {
    phase9_8w(p, blockIdx.x, gridDim.x);
#if (REPEAT_MASK >> 9) & 1
    xcd_barrier(xb);
    phase9_8w(p, blockIdx.x, gridDim.x);
#endif
    if (9 + 1 < p.phase_hi) xcd_barrier(xb);
  }
#endif
#if !defined(ONLY) || ONLY==10
  if (p.phase_lo <= 10 && 10 < p.phase_hi) {
    phase10(p, bid, nblk);
#if (REPEAT_MASK >> 10) & 1
    xcd_barrier(xb);
    phase10(p, bid, nblk);
#endif
    if (10 + 1 < p.phase_hi) xcd_barrier(xb);
  }
#endif
#if !defined(ONLY) || ONLY==11
  if (p.phase_lo <= 11 && 11 < p.phase_hi) {
    phase11(p, smem, bid, nblk);
#if (REPEAT_MASK >> 11) & 1
    xcd_barrier(xb);
    phase11(p, smem, bid, nblk);
#endif
    if (11 + 1 < p.phase_hi) xcd_barrier(xb);
  }
#endif
#if !defined(ONLY) || ONLY==12
  if (p.phase_lo <= 12 && 12 < p.phase_hi) {
    phase12(p, bid, nblk);
#if (REPEAT_MASK >> 12) & 1
    xcd_barrier(xb);
    phase12(p, bid, nblk);
#endif
    if (12 + 1 < p.phase_hi) xcd_barrier(xb);
  }
#endif
#if !defined(ONLY) || ONLY==14
  if (p.phase_lo <= 14 && 14 < p.phase_hi) {
    phase14(p, smem, bid, nblk);
#if (REPEAT_MASK >> 14) & 1
    xcd_barrier(xb);
    phase14(p, smem, bid, nblk);
#endif
    if (14 + 1 < p.phase_hi) xcd_barrier(xb);
  }
#endif
#if !defined(ONLY) || ONLY==15
  if (p.phase_lo <= 15 && 15 < p.phase_hi) {
    phase15_8w(p, blockIdx.x, gridDim.x);
#if (REPEAT_MASK >> 15) & 1
    xcd_barrier(xb);
    phase15_8w(p, blockIdx.x, gridDim.x);
#endif
    if (15 + 1 < p.phase_hi) xcd_barrier(xb);
  }
#endif
#if !defined(ONLY) || ONLY==16
  if (p.phase_lo <= 16 && 16 < p.phase_hi) {
    phase16_8w(p, blockIdx.x, gridDim.x);
#if (REPEAT_MASK >> 16) & 1
    xcd_barrier(xb);
    phase16_8w(p, blockIdx.x, gridDim.x);
#endif
    if (16 + 1 < p.phase_hi) xcd_barrier(xb);
  }
#endif
#if !defined(ONLY) || ONLY==17
  if (p.phase_lo <= 17 && 17 < p.phase_hi) {
    phase17(p, bid, nblk);
#if (REPEAT_MASK >> 17) & 1
    xcd_barrier(xb);
    phase17(p, bid, nblk);
#endif
    if (17 + 1 < p.phase_hi) xcd_barrier(xb);
  }
#endif
}

extern "C" void kernel_launch(void* const* d_in, const int* in_sizes, int n_in, void* d_out, int out_size, void* d_ws, size_t ws_size,
                              hipStream_t stream) {
  static int grid_blocks = 0;
  if (!grid_blocks) {
    int dev = 0, cus = 0, per_cu = 0;
    (void)hipGetDevice(&dev);
    (void)hipDeviceGetAttribute(&cus, hipDeviceAttributeMultiprocessorCount, dev);
    (void)hipOccupancyMaxActiveBlocksPerMultiprocessor(&per_cu, mega, 512, 0);
    if (per_cu > 1) per_cu = 1;
    if (per_cu < 1) per_cu = 1;
    grid_blocks = cus * per_cu;
  }
  Params p{};
  const float* const* in = (const float* const*)d_in;
  p.x = in[0]; p.c = in[1]; p.w_ada = in[2]; p.b_ada = in[3]; p.g_pre_mix = in[4]; p.g_post_mix = in[5]; p.g_pre_ffn = in[6]; p.g_post_ffn = in[7];
  p.w_in = in[8]; p.rel_bias = in[9]; p.cmp_pe = in[10]; p.cmp_w1 = in[11]; p.cmp_b1 = in[12]; p.cmp_w2 = in[13]; p.dsa_kv_norm = in[14];
  p.dsa_w_uk = in[15]; p.dsa_w_uv = in[16]; p.w_bn = in[17]; p.w_bd = in[18]; p.w_out = in[19]; p.router_w = in[20]; p.router_bias = in[21];
  p.w_eg = in[22]; p.w_eu = in[23]; p.w_ed = in[24]; p.w_sg = in[25]; p.w_su = in[26]; p.w_sd = in[27];
  p.out = (float*)d_out;
  char* ws = (char*)d_ws;
  size_t off = 0;
  auto alloc = [&](size_t bytes) { char* r = ws + off; off += (bytes + 255) & ~(size_t)255; return r; };
  p.bar = (unsigned*)alloc((XCD_BAR_WORDS + 64) * 4);
  p.modp = (float*)alloc(16 * 2 * 6144 * 4);
  p.mod = (float*)alloc(2 * 6144 * 4);
  p.pe_part = (float*)alloc(16 * 256 * 4);
  p.cpart = (float*)alloc((size_t)4 * 4096 * 128 * 4);
  p.w_ukT = (float*)alloc(8 * 64 * 128 * 4);
  p.w_inT = (u16*)alloc((size_t)4608 * 1024 * 2);
  p.w_bnT = (u16*)alloc((size_t)1024 * 512 * 2);
  p.w_bdT = (u16*)alloc((size_t)1024 * 512 * 2);
  p.w_outT = (u16*)alloc((size_t)1024 * 1024 * 2);
  p.routerT = (u16*)alloc((size_t)256 * 1024 * 2);
  p.counts = (int*)alloc(256 * 32 * 4);
  p.offs = (int*)alloc(257 * 4);
  p.tile_e = (int*)alloc(1536 * 4);
  p.tile_r0 = (int*)alloc(1536 * 4);
  p.tile_nr = (int*)alloc(1536 * 4);
  p.ntiles = (int*)alloc(8);
  p.tile2_e = (int*)alloc(1024 * 4);
  p.tile2_r0 = (int*)alloc(1024 * 4);
  p.tile2_nr = (int*)alloc(1024 * 4);
  p.h = (u16*)alloc((size_t)NTOK * 1024 * 2);
  p.proj = (u16*)alloc((size_t)NTOK * LDP * 2);
  p.widx = (float*)alloc((size_t)NTOK * 8 * 4);
  p.zc = (u16*)alloc((size_t)2 * 2048 * 128 * 2);
  p.kc = (u16*)alloc((size_t)4 * 512 * 64 * 2);
  p.vcT = (u16*)alloc((size_t)4 * 512 * 64 * 2);
  p.vts = (u16*)alloc((size_t)4 * 64 * T * 2);
  p.vtw = (u16*)alloc((size_t)4 * 64 * T * 2);
  p.qlat = (u16*)alloc((size_t)NTOK * 1024 * 2);
  p.ckv = (u16*)alloc((size_t)NTOK * 128 * 2);
  p.selk = (int*)alloc((size_t)NTOK * 256 * 4);
  p.onsa = (u16*)alloc((size_t)NTOK * 512 * 2);
  p.olat = (u16*)alloc((size_t)NTOK * 1024 * 2);
  p.odsa = (u16*)alloc((size_t)NTOK * 512 * 2);
  p.y = p.qlat;
  p.z = p.olat;
  p.eidx = (int*)alloc((size_t)NTOK * 8 * 4);
  p.ewt = (float*)alloc((size_t)NTOK * 8 * 4);
  p.erank = (int*)alloc((size_t)NTOK * 8 * 4);
  p.slot_tok = (int*)alloc((size_t)NSLOT * 4);
  p.slot_wt = (float*)alloc((size_t)NSLOT * 4);
  p.tok_slot = (int*)alloc((size_t)NTOK * 8 * 4);
  char* big = alloc((size_t)NSLOT * 1024 * 2);
  p.scores = (float*)big;
  p.Y = (u16*)big;
  p.H = p.proj;
  p.x1 = (float*)((char*)p.proj + (((size_t)NSLOT * 256 * 2 + 255) & ~(size_t)255));
  p.logits = (float*)p.qlat;
  p.w_guT = (u16*)alloc((size_t)2 * 257 * 256 * 1024 * 2);
  if (off > ws_size) fprintf(stderr, "workspace too small: need %zu have %zu\n", off, ws_size);
  p.phase_lo = 0;
  p.phase_hi = 18;
  (void)hipMemsetAsync(p.bar, 0, (XCD_BAR_WORDS + 64) * 4, stream);
  void* args[] = {&p};
  hipError_t e = hipLaunchCooperativeKernel((void*)mega, dim3(grid_blocks), dim3(512), args, 0, stream);
  if (e != hipSuccess) fprintf(stderr, "coop launch failed: %s (grid %d)\n", hipGetErrorString(e), grid_blocks);
}
```
